# Optimizing an MI355X kernel written in HIP

```python
import jax, jax.numpy as jnp
from jax import lax
import numpy as np

D_MODEL = 1024
BATCH = 8
SEQ = 4096
DEPTH = 4

GRID_W = 64
CTX_LEN = 256
N_Q_HEADS = 8
N_KV_HEADS = 2
Q_PER_KV = N_Q_HEADS // N_KV_HEADS
HEAD_DIM = 64
WINDOW = 128
ATTN_BLOCK = WINDOW
ROPE_THETA = 10000.0
FNET_GROUPS = 4
FNET_GROUP_DIM = 128
ATTN_WIDTH = N_Q_HEADS * HEAD_DIM
KV_WIDTH = N_KV_HEADS * HEAD_DIM
FNET_WIDTH = FNET_GROUPS * FNET_GROUP_DIM
AB_IN_WIDTH = ATTN_WIDTH + 2 * KV_WIDTH + FNET_WIDTH
AB_OUT_WIDTH = ATTN_WIDTH + FNET_WIDTH
SGU_GROUPS = 8
SGU_GROUP_DIM = 128
SGU_WIDTH = SGU_GROUPS * SGU_GROUP_DIM
SGU_CHUNK = 128
PEER_HEADS = 8
PEER_NKEYS = 128
PEER_TOPK = 16
PEER_KEY_DIM = 256
PEER_EXPERTS = PEER_NKEYS * PEER_NKEYS
PEER_BLOCK = 128
N_MOD = 6
N_EVEN = (DEPTH + 1) // 2
N_ODD = DEPTH // 2
RMS_EPS = 1e-6
NEG_INF = -1e30

kernel_name = "hybrid_dit_swa_fnet_sgu_peer"


def rmsnorm(x, w):
    x32 = x.astype(jnp.float32)
    y = x32 * lax.rsqrt(jnp.mean(x32 * x32, axis=-1, keepdims=True) + RMS_EPS)
    return (y * w.astype(jnp.float32)).astype(x.dtype)


def modulate(h, shift, scale):
    return h * (1 + scale) + shift


def ada_params(cond, w, b):
    m = jax.nn.silu(cond) @ w + b
    return jnp.split(m, N_MOD, axis=-1)


def axial_angles(n_tokens):
    rows = n_tokens // GRID_W
    r, cl = jnp.meshgrid(jnp.arange(rows), jnp.arange(GRID_W), indexing="ij")
    row = r.reshape(-1).astype(jnp.float32)
    col = cl.reshape(-1).astype(jnp.float32)
    half = HEAD_DIM // 2
    inv = ROPE_THETA ** (-jnp.arange(0, half, 2, dtype=jnp.float32) / half)
    return row[:, None] * inv, col[:, None] * inv


def rope_half(x, ang):
    h = x.shape[-1] // 2
    a, b = x[..., :h], x[..., h:]
    shape = (ang.shape[0],) + (1,) * (x.ndim - 3) + (h,)
    cos = jnp.cos(ang).reshape(shape).astype(x.dtype)
    sin = jnp.sin(ang).reshape(shape).astype(x.dtype)
    return jnp.concatenate([a * cos - b * sin, b * cos + a * sin], axis=-1)


def rope_axial(x, ang_row, ang_col):
    h = HEAD_DIM // 2
    return jnp.concatenate([rope_half(x[..., :h], ang_row), rope_half(x[..., h:], ang_col)], axis=-1)


def banded(t, nb):
    pad = [(0, 0), (ATTN_BLOCK, ATTN_BLOCK)] + [(0, 0)] * (t.ndim - 2)
    tp = jnp.pad(t, pad).reshape((t.shape[0], nb + 2, ATTN_BLOCK) + t.shape[2:])
    return jnp.concatenate([tp[:, :-2], tp[:, 1:-1], tp[:, 2:]], axis=2)


def latent_window_attention(q, k, v, k_ctx, v_ctx, sink):
    B, S = q.shape[:2]
    nb = S // ATTN_BLOCK
    scale = HEAD_DIM ** -0.5
    qb = q.reshape(B, nb, ATTN_BLOCK, N_KV_HEADS, Q_PER_KV, HEAD_DIM)
    kb = banded(k, nb)
    vb = banded(v, nb)
    qi = jnp.arange(ATTN_BLOCK)[:, None]
    kj = jnp.arange(3 * ATTN_BLOCK)[None, :] - ATTN_BLOCK
    kpos = jnp.arange(nb)[:, None, None] * ATTN_BLOCK + kj
    mask = (jnp.abs(qi - kj) <= WINDOW) & (kpos >= 0) & (kpos < S)
    s_loc = jnp.einsum("bnqhgd,bnkhd->bnhgqk", qb, kb).astype(jnp.float32) * scale
    s_loc = jnp.where(mask[None, :, None, None], s_loc, NEG_INF)
    s_ctx = jnp.einsum("bnqhgd,bchd->bnhgqc", qb, k_ctx).astype(jnp.float32) * scale
    sk = sink.astype(jnp.float32).reshape(N_KV_HEADS, Q_PER_KV)[:, :, None, None]
    m = jnp.maximum(jnp.maximum(s_loc.max(-1, keepdims=True), s_ctx.max(-1, keepdims=True)), sk)
    p_loc = jnp.exp(s_loc - m)
    p_ctx = jnp.exp(s_ctx - m)
    inv_den = 1.0 / (p_loc.sum(-1, keepdims=True) + p_ctx.sum(-1, keepdims=True) + jnp.exp(sk - m))
    o = (jnp.einsum("bnhgqk,bnkhd->bnqhgd", (p_loc * inv_den).astype(v.dtype), vb)
         + jnp.einsum("bnhgqc,bchd->bnqhgd", (p_ctx * inv_den).astype(v.dtype), v_ctx))
    return o.reshape(B, S, ATTN_WIDTH)


def context_attention(q, k, v, sink):
    B, C = q.shape[:2]
    scale = HEAD_DIM ** -0.5
    s = jnp.einsum("bqhgd,bkhd->bhgqk", q, k).astype(jnp.float32) * scale
    sk = sink.astype(jnp.float32).reshape(N_KV_HEADS, Q_PER_KV)[:, :, None, None]
    m = jnp.maximum(s.max(-1, keepdims=True), sk)
    p = jnp.exp(s - m)
    p = p / (p.sum(-1, keepdims=True) + jnp.exp(sk - m))
    o = jnp.einsum("bhgqk,bkhd->bqhgd", p.astype(v.dtype), v)
    return o.reshape(B, C, ATTN_WIDTH)


def fourier_mix(f):
    B, n = f.shape[:2]
    fg = f.reshape(B, n, FNET_GROUPS, FNET_GROUP_DIM).astype(jnp.float32)
    y = jnp.fft.fft2(fg, axes=(1, 3), norm="ortho").real
    return y.reshape(B, n, FNET_WIDTH).astype(f.dtype)


def ab_mixer(h_l, h_c, w_in, w_out, sink, ang_row, ang_col, with_ctx_out):
    B, S = h_l.shape[:2]
    C = h_c.shape[1]
    p_l = h_l @ w_in
    q_l = p_l[..., :ATTN_WIDTH].reshape(B, S, N_KV_HEADS, Q_PER_KV, HEAD_DIM)
    k_l = p_l[..., ATTN_WIDTH:ATTN_WIDTH + KV_WIDTH].reshape(B, S, N_KV_HEADS, HEAD_DIM)
    v_l = p_l[..., ATTN_WIDTH + KV_WIDTH:ATTN_WIDTH + 2 * KV_WIDTH].reshape(B, S, N_KV_HEADS, HEAD_DIM)
    f_l = p_l[..., ATTN_WIDTH + 2 * KV_WIDTH:]
    q_l = rope_axial(q_l, ang_row, ang_col)
    k_l = rope_axial(k_l, ang_row, ang_col)
    off = ATTN_WIDTH if with_ctx_out else 0
    p_c = h_c @ (w_in if with_ctx_out else w_in[:, ATTN_WIDTH:ATTN_WIDTH + 2 * KV_WIDTH])
    k_c = p_c[..., off:off + KV_WIDTH].reshape(B, C, N_KV_HEADS, HEAD_DIM)
    v_c = p_c[..., off + KV_WIDTH:off + 2 * KV_WIDTH].reshape(B, C, N_KV_HEADS, HEAD_DIM)
    a_l = latent_window_attention(q_l, k_l, v_l, k_c, v_c, sink)
    y_l = jnp.concatenate([a_l, fourier_mix(f_l)], axis=-1) @ w_out
    y_c = None
    if with_ctx_out:
        q_c = p_c[..., :ATTN_WIDTH].reshape(B, C, N_KV_HEADS, Q_PER_KV, HEAD_DIM)
        f_c = p_c[..., ATTN_WIDTH + 2 * KV_WIDTH:]
        a_c = context_attention(q_c, k_c, v_c, sink)
        y_c = jnp.concatenate([a_c, fourier_mix(f_c)], axis=-1) @ w_out
    return y_l, y_c


def sgu_mixer(h, w_in, norm_w, w_s, b_s, w_out):
    B, n = h.shape[:2]
    nc = n // SGU_CHUNK
    z = jax.nn.gelu(h @ w_in)
    u, v = z[..., :SGU_WIDTH], z[..., SGU_WIDTH:]
    v = rmsnorm(v, norm_w).reshape(B, nc, SGU_CHUNK, SGU_GROUPS, SGU_GROUP_DIM)
    sv = jnp.einsum("gpq,bnqgc->bnpgc", w_s, v) + b_s.T[:, :, None]
    return (u * sv.reshape(B, n, SGU_WIDTH)) @ w_out


def peer_ffn(h, w_q, keys, u_tab, v_tab):
    shp = h.shape
    xb = h.reshape(-1, PEER_BLOCK, D_MODEL)

    def block(xc):
        q = (xc @ w_q).reshape(PEER_BLOCK, PEER_HEADS, 2, PEER_KEY_DIM // 2)
        s = jnp.einsum("chsd,hskd->chsk", q, keys).astype(jnp.float32)
        top_s, top_i = lax.top_k(s, PEER_TOPK)
        cand = top_s[:, :, 0, :, None] + top_s[:, :, 1, None, :]
        best_s, best = lax.top_k(cand.reshape(PEER_BLOCK, PEER_HEADS, PEER_TOPK * PEER_TOPK), PEER_TOPK)
        i1 = jnp.take_along_axis(top_i[:, :, 0], best // PEER_TOPK, axis=-1)
        i2 = jnp.take_along_axis(top_i[:, :, 1], best % PEER_TOPK, axis=-1)
        e = i1 * PEER_NKEYS + i2
        g = jax.nn.softmax(best_s, axis=-1).astype(xc.dtype)
        act = jax.nn.gelu(jnp.einsum("cd,chkd->chk", xc, u_tab[e]))
        return jnp.einsum("chk,chkd->cd", g * act, v_tab[e])

    return lax.map(block, xb).reshape(shp)


def setup_inputs(seed: int = 0) -> dict:
    key = jax.random.key(seed)
    ks = jax.random.split(key, 21)
    D = D_MODEL

    def nrm(k, shape, s):
        return jax.random.normal(k, shape, jnp.float32) * s

    return {
        "x": nrm(ks[0], (BATCH, SEQ, D), 1.0),
        "c": nrm(ks[1], (BATCH, D), 1.0),
        "ctx": nrm(ks[2], (BATCH, CTX_LEN, D), 1.0),
        "c_ctx": nrm(ks[3], (D,), 1.0),
        "ada_w": nrm(ks[4], (DEPTH, D, N_MOD * D), 0.3 * D ** -0.5),
        "ada_b": nrm(ks[5], (DEPTH, N_MOD * D), 0.02),
        "norm_mix_w": 1.0 + nrm(ks[6], (DEPTH, D), 0.02),
        "norm_ffn_w": 1.0 + nrm(ks[7], (DEPTH, D), 0.02),
        "ab_w_in": nrm(ks[8], (N_EVEN, D, AB_IN_WIDTH), D ** -0.5),
        "ab_w_out": nrm(ks[9], (N_EVEN, AB_OUT_WIDTH, D), AB_OUT_WIDTH ** -0.5),
        "attn_sink": nrm(ks[10], (N_EVEN, N_Q_HEADS), 0.5),
        "gs_w_in": nrm(ks[11], (N_ODD, D, 2 * SGU_WIDTH), D ** -0.5),
        "gs_norm_w": 1.0 + nrm(ks[12], (N_ODD, SGU_WIDTH), 0.02),
        "gs_w_s": nrm(ks[13], (N_ODD, SGU_GROUPS, SGU_CHUNK, SGU_CHUNK), SGU_CHUNK ** -0.5),
        "gs_b_s": 1.0 + nrm(ks[14], (N_ODD, SGU_GROUPS, SGU_CHUNK), 0.1),
        "gs_w_out": nrm(ks[15], (N_ODD, SGU_WIDTH, D), SGU_WIDTH ** -0.5),
        "peer_w_q": nrm(ks[16], (DEPTH, D, PEER_HEADS * PEER_KEY_DIM), D ** -0.5),
        "peer_keys": nrm(ks[17], (DEPTH, PEER_HEADS, 2, PEER_NKEYS, PEER_KEY_DIM // 2), (PEER_KEY_DIM // 2) ** -0.5),
        "peer_u": nrm(ks[18], (DEPTH, PEER_EXPERTS, D), D ** -0.5),
        "peer_v": nrm(ks[19], (DEPTH, PEER_EXPERTS, D), 1.0),
        "norm_out_w": 1.0 + nrm(ks[20], (D,), 0.02),
    }


def reference(x, c, ctx, c_ctx, ada_w, ada_b, norm_mix_w, norm_ffn_w, ab_w_in, ab_w_out, attn_sink,
              gs_w_in, gs_norm_w, gs_w_s, gs_b_s, gs_w_out, peer_w_q, peer_keys, peer_u, peer_v, norm_out_w):
    ang_row, ang_col = axial_angles(x.shape[1])
    last_attn = ((DEPTH - 1) // 2) * 2
    for i in range(DEPTH):
        j = i // 2
        is_ab = i % 2 == 0
        upd_ctx = i < last_attn
        need_ctx = upd_ctx or is_ab
        sh_m, sc_m, g_m, sh_f, sc_f, g_f = [m[:, None, :] for m in ada_params(c, ada_w[i], ada_b[i])]
        h_l = modulate(rmsnorm(x, norm_mix_w[i]), sh_m, sc_m)
        y_c = None
        if need_ctx:
            csh_m, csc_m, cg_m, csh_f, csc_f, cg_f = ada_params(c_ctx, ada_w[i], ada_b[i])
            h_c = modulate(rmsnorm(ctx, norm_mix_w[i]), csh_m, csc_m)
        if is_ab:
            y_l, y_c = ab_mixer(h_l, h_c, ab_w_in[j], ab_w_out[j], attn_sink[j], ang_row, ang_col, upd_ctx)
        else:
            y_l = sgu_mixer(h_l, gs_w_in[j], gs_norm_w[j], gs_w_s[j], gs_b_s[j], gs_w_out[j])
            if upd_ctx:
                y_c = sgu_mixer(h_c, gs_w_in[j], gs_norm_w[j], gs_w_s[j], gs_b_s[j], gs_w_out[j])
        x = x + g_m * y_l
        x = x + g_f * peer_ffn(modulate(rmsnorm(x, norm_ffn_w[i]), sh_f, sc_f),
                               peer_w_q[i], peer_keys[i], peer_u[i], peer_v[i])
        if upd_ctx:
            ctx = ctx + cg_m * y_c
            ctx = ctx + cg_f * peer_ffn(modulate(rmsnorm(ctx, norm_ffn_w[i]), csh_f, csc_f),
                                        peer_w_q[i], peer_keys[i], peer_u[i], peer_v[i])
    return rmsnorm(x, norm_out_w)
```

```cpp
#include <hip/hip_runtime.h>
#include <hip/hip_bf16.h>
#include <hip/hip_cooperative_groups.h>
#include <cstdio>
namespace cg = cooperative_groups;

#ifndef ONE_LAUNCH
#define ONE_LAUNCH 1
#endif

#define DEVI __device__ __forceinline__
typedef unsigned short bf16_t;
using bf16x8 = __attribute__((ext_vector_type(8))) short;
using f32x4 = __attribute__((ext_vector_type(4))) float;

constexpr int D = 1024, NB = 8, SEQ = 4096, CTX = 256, DEPTH = 4;
constexpr int TL = NB * SEQ, TC = NB * CTX, TT = TL + TC;
constexpr int KVLEN = CTX + SEQ;
constexpr int NEXP = 16384;
constexpr int LDMIX = 1536;
constexpr int LDS_BYTES = 68 * 1024;
constexpr int NTHREADS = 256;
constexpr int STEPS_PER_LAYER = 9;
constexpr int NSTEPS = 1 + DEPTH * STEPS_PER_LAYER + 1;

struct Params {
  const float *x, *c, *ctx, *c_ctx, *ada_w, *ada_b, *norm_mix_w, *norm_ffn_w, *ab_w_in, *ab_w_out, *attn_sink,
      *gs_w_in, *gs_norm_w, *gs_w_s, *gs_b_s, *gs_w_out, *peer_w_q, *peer_keys, *peer_u, *peer_v, *norm_out_w;
  float* out;
  float* mod;
  float2* cs;
  float* xs;
  bf16_t* h;
  bf16_t* P;
  bf16_t* kbuf;
  bf16_t* vbuf;
  bf16_t* mix;
  bf16_t* fa;
  int* eidx;
  float* gate;
  bf16_t *wt_in_ab, *wt_out_ab, *wt_in_gs, *wt_out_gs, *wt_q, *keysb, *utab, *vtab;
};

typedef const __attribute__((address_space(4))) Params* PP;

DEVI int ltid() { int t = threadIdx.x; asm volatile("" : "+v"(t)); return t; }
DEVI int lbid() { int t = blockIdx.x; asm volatile("" : "+s"(t)); return t; }
DEVI int lnblk() { int t = gridDim.x; asm volatile("" : "+s"(t)); return t; }

DEVI bf16_t f2bf(float f) {
  unsigned u = __float_as_uint(f);
  u += 0x7fffu + ((u >> 16) & 1u);
  return (bf16_t)(u >> 16);
}
DEVI float bf2f(bf16_t h) { return __uint_as_float(((unsigned)h) << 16); }
DEVI float bflo(unsigned u) { return __uint_as_float(u << 16); }
DEVI float bfhi(unsigned u) { return __uint_as_float(u & 0xffff0000u); }
DEVI unsigned pack2(float a, float b) { return (unsigned)f2bf(a) | ((unsigned)f2bf(b) << 16); }
DEVI float wave_sum(float v) {
#pragma unroll
  for (int o = 32; o > 0; o >>= 1) v += __shfl_xor(v, o);
  return v;
}
DEVI float wave_max(float v) {
#pragma unroll
  for (int o = 32; o > 0; o >>= 1) v = fmaxf(v, __shfl_xor(v, o));
  return v;
}
DEVI float gelu_tanh(float x) {
  float u = 0.7978845608028654f * (x + 0.044715f * x * x * x);
  return 0.5f * x * (1.f + tanhf(u));
}
DEVI int tok_batch(int r) { return r < TL ? (r >> 12) : 8; }

DEVI void transpose_to_bf16(const float* __restrict__ src, int K, int N, bf16_t* __restrict__ dst, int ldk, float* tile) {
  int tilesN = N / 64, tiles = (K / 64) * tilesN;
  int tid = ltid();
  for (int t = lbid(); t < tiles; t += lnblk()) {
    int tk = t / tilesN, tn = t % tilesN;
#pragma unroll
    for (int i = 0; i < 16; ++i) {
      int r = (tid >> 6) + 4 * i;
      tile[r * 65 + (tid & 63)] = src[(size_t)(tk * 64 + r) * N + tn * 64 + (tid & 63)];
    }
    __syncthreads();
#pragma unroll
    for (int i = 0; i < 16; ++i) {
      int n = (tid >> 6) + 4 * i, k = tid & 63;
      dst[(size_t)(tn * 64 + n) * ldk + tk * 64 + k] = f2bf(tile[k * 65 + n]);
    }
    __syncthreads();
  }
}

DEVI void convert_bf16(const float* __restrict__ src, bf16_t* __restrict__ dst, size_t n) {
  size_t n4 = n / 4;
  size_t stride = (size_t)lnblk() * NTHREADS;
  for (size_t i = (size_t)lbid() * NTHREADS + ltid(); i < n4; i += stride) {
    float4 v = reinterpret_cast<const float4*>(src)[i];
    uint2 o;
    o.x = pack2(v.x, v.y);
    o.y = pack2(v.z, v.w);
    reinterpret_cast<uint2*>(dst)[i] = o;
  }
}

DEVI void phase_prep(PP p, unsigned char* lds) {
  int tid = ltid();
  size_t gtid = (size_t)lbid() * NTHREADS + tid;
  size_t gstride = (size_t)lnblk() * NTHREADS;
  {
    const float4* s0 = reinterpret_cast<const float4*>(p->x);
    const float4* s1 = reinterpret_cast<const float4*>(p->ctx);
    float4* d = reinterpret_cast<float4*>(p->xs);
    size_t n0 = (size_t)TL * D / 4, n1 = (size_t)TC * D / 4;
    for (size_t i = gtid; i < n0; i += gstride) d[i] = s0[i];
    for (size_t i = gtid; i < n1; i += gstride) d[n0 + i] = s1[i];
  }
  convert_bf16(p->peer_u, p->utab, (size_t)DEPTH * NEXP * D);
  convert_bf16(p->peer_v, p->vtab, (size_t)DEPTH * NEXP * D);
  convert_bf16(p->peer_keys, p->keysb, (size_t)DEPTH * 8 * 2 * 128 * 128);
  for (size_t i = gtid; i < 64 * 16; i += gstride) {
    int pos = (int)(i >> 4), k = (int)(i & 15);
    float inv = powf(10000.f, -(float)k / 16.f);
    float ang = (float)pos * inv;
    float sn, cn;
    sincosf(ang, &sn, &cn);
    p->cs[i] = make_float2(cn, sn);
  }
  float* tile = reinterpret_cast<float*>(lds);
  for (int j = 0; j < 2; ++j) {
    transpose_to_bf16(p->ab_w_in + (size_t)j * D * 1280, D, 1280, p->wt_in_ab + (size_t)j * 1280 * D, D, tile);
    transpose_to_bf16(p->gs_w_in + (size_t)j * D * 2048, D, 2048, p->wt_in_gs + (size_t)j * 2048 * D, D, tile);
    transpose_to_bf16(p->gs_w_out + (size_t)j * D * D, D, D, p->wt_out_gs + (size_t)j * D * D, D, tile);
    transpose_to_bf16(p->ab_w_out + (size_t)j * D * D, 512, D, p->wt_out_ab + (size_t)j * D * LDMIX, LDMIX, tile);
  }
  for (int i = 0; i < DEPTH; ++i)
    transpose_to_bf16(p->peer_w_q + (size_t)i * D * 2048, D, 2048, p->wt_q + (size_t)i * 2048 * D, D, tile);
  {
    float2* tw = reinterpret_cast<float2*>(lds) + 8192;
    if (tid < 128) {
      float sn, cn;
      sincospif((float)tid / 64.f, &sn, &cn);
      tw[tid] = make_float2(cn, sn);
    }
    __syncthreads();
    size_t total = (size_t)2 * 512 * 1024;
    for (size_t i = gtid; i < total; i += gstride) {
      int n = (int)(i & 1023);
      int gm = (int)((i >> 10) & 511);
      int j = (int)(i >> 19);
      int g = gm >> 7, m = gm & 127;
      const float* w = p->ab_w_out + (size_t)j * D * D + (size_t)(512 + g * 128) * D + n;
      float ar = 0.f, ai = 0.f;
      for (int l = 0; l < 128; ++l) {
        float2 t = tw[(m * l) & 127];
        float wv = w[(size_t)l * D];
        ar += t.x * wv;
        ai += t.y * wv;
      }
      bf16_t* dst = p->wt_out_ab + (size_t)j * D * LDMIX + (size_t)n * LDMIX;
      dst[512 + gm] = f2bf(ar);
      dst[1024 + gm] = f2bf(ai);
    }
    __syncthreads();
  }
  {
    float* sl = reinterpret_cast<float*>(lds);
    for (int i = tid; i < 9 * 1024; i += NTHREADS) {
      int r = i >> 10, k = i & 1023;
      float v = (r < 8) ? p->c[r * 1024 + k] : p->c_ctx[k];
      sl[i] = v / (1.f + __expf(-v));
    }
    __syncthreads();
    float* red = sl + 9 * 1024;
    int ks = tid >> 6, col = tid & 63;
    for (int u = lbid(); u < DEPTH * 96; u += lnblk()) {
      int layer = u / 96, c0 = (u % 96) * 64;
      const float* w = p->ada_w + (size_t)layer * D * 6144 + c0 + col;
      float acc[9];
#pragma unroll
      for (int r = 0; r < 9; ++r) acc[r] = 0.f;
      for (int k = ks * 256; k < ks * 256 + 256; ++k) {
        float wv = w[(size_t)k * 6144];
#pragma unroll
        for (int r = 0; r < 9; ++r) acc[r] += sl[r * 1024 + k] * wv;
      }
#pragma unroll
      for (int r = 0; r < 9; ++r) red[(ks * 9 + r) * 64 + col] = acc[r];
      __syncthreads();
      for (int i = tid; i < 9 * 64; i += NTHREADS) {
        int r = i >> 6, cc = i & 63;
        float s = red[(0 * 9 + r) * 64 + cc] + red[(1 * 9 + r) * 64 + cc] + red[(2 * 9 + r) * 64 + cc] +
                  red[(3 * 9 + r) * 64 + cc];
        s += p->ada_b[(size_t)layer * 6144 + c0 + cc];
        p->mod[((size_t)layer * 9 + r) * 6144 + c0 + cc] = s;
      }
      __syncthreads();
    }
  }
}

DEVI void phase_norm(PP p, int layer, int which, int ntok) {
  int lane = ltid() & 63;
  int gw = lbid() * 4 + (ltid() >> 6), nw = lnblk() * 4;
  const float* w = which == 0 ? p->norm_mix_w + layer * D : (which == 1 ? p->norm_ffn_w + layer * D : p->norm_out_w);
  for (int tok = gw; tok < ntok; tok += nw) {
    const float4* xr = reinterpret_cast<const float4*>(p->xs + (size_t)tok * D);
    float4 v[4];
    float ss = 0.f;
#pragma unroll
    for (int i = 0; i < 4; ++i) {
      v[i] = xr[lane + 64 * i];
      ss += v[i].x * v[i].x + v[i].y * v[i].y + v[i].z * v[i].z + v[i].w * v[i].w;
    }
    ss = wave_sum(ss);
    float rstd = rsqrtf(ss * (1.f / 1024.f) + 1e-6f);
    if (which == 2) {
      float4* o = reinterpret_cast<float4*>(p->out + (size_t)tok * D);
#pragma unroll
      for (int i = 0; i < 4; ++i) {
        float4 wv = reinterpret_cast<const float4*>(w)[lane + 64 * i];
        float4 r;
        r.x = v[i].x * rstd * wv.x;
        r.y = v[i].y * rstd * wv.y;
        r.z = v[i].z * rstd * wv.z;
        r.w = v[i].w * rstd * wv.w;
        o[lane + 64 * i] = r;
      }
    } else {
      int b = tok_batch(tok);
      const float* mb = p->mod + ((size_t)layer * 9 + b) * 6144 + (which == 0 ? 0 : 3072);
      uint2* o = reinterpret_cast<uint2*>(p->h + (size_t)tok * D);
#pragma unroll
      for (int i = 0; i < 4; ++i) {
        float4 wv = reinterpret_cast<const float4*>(w)[lane + 64 * i];
        float4 sh = reinterpret_cast<const float4*>(mb)[lane + 64 * i];
        float4 sc = reinterpret_cast<const float4*>(mb + 1024)[lane + 64 * i];
        float a0 = v[i].x * rstd * wv.x * (1.f + sc.x) + sh.x;
        float a1 = v[i].y * rstd * wv.y * (1.f + sc.y) + sh.y;
        float a2 = v[i].z * rstd * wv.z * (1.f + sc.z) + sh.z;
        float a3 = v[i].w * rstd * wv.w * (1.f + sc.w) + sh.w;
        uint2 r;
        r.x = pack2(a0, a1);
        r.y = pack2(a2, a3);
        o[lane + 64 * i] = r;
      }
    }
  }
}

enum { EPI_STORE = 0, EPI_GELU = 1, EPI_RESID = 2, EPI_INPROJ = 3 };

template <int EPI>
DEVI void gemm_phase(PP p, const bf16_t* __restrict__ A, int lda, const bf16_t* __restrict__ Bt, int ldb,
                     int Mtiles, int Ntiles, int K, int layer, unsigned char* lds) {
  const int tid = ltid();
  const int wid = tid >> 6, lane = tid & 63, wr = wid >> 1, wc = wid & 1, fr = lane & 15, fq = lane >> 4;
  unsigned char* SA = lds;
  unsigned char* SB = lds + 8192;
  int nblk = lnblk();
  int lb = ((nblk & 7) == 0) ? ((lbid() & 7) * (nblk >> 3) + (lbid() >> 3)) : lbid();
  int ntiles = Mtiles * Ntiles;
  for (int t = lb; t < ntiles; t += nblk) {
    int tm = t / Ntiles, tn = t % Ntiles;
    int brow = tm * 128, bcol = tn * 128;
    f32x4 acc[4][4];
#pragma unroll
    for (int m = 0; m < 4; ++m)
#pragma unroll
      for (int n = 0; n < 4; ++n) acc[m][n] = f32x4{0.f, 0.f, 0.f, 0.f};
    for (int kt = 0; kt < K / 32; ++kt) {
#pragma unroll
      for (int i = 0; i < 2; ++i) {
        int b = tid * 16 + i * 4096, r = b >> 6, c = (b & 63) >> 1;
        __builtin_amdgcn_global_load_lds((const unsigned*)(A + (size_t)(brow + r) * lda + kt * 32 + c),
                                         (__attribute__((address_space(3))) unsigned*)(SA + b), 16, 0, 0);
        __builtin_amdgcn_global_load_lds((const unsigned*)(Bt + (size_t)(bcol + r) * ldb + kt * 32 + c),
                                         (__attribute__((address_space(3))) unsigned*)(SB + b), 16, 0, 0);
      }
      asm volatile("s_waitcnt vmcnt(0)" ::: "memory");
      __syncthreads();
      bf16x8 At[4], Bl[4];
#pragma unroll
      for (int m = 0; m < 4; ++m) {
        At[m] = *reinterpret_cast<const bf16x8*>(SA + (wr * 64 + m * 16 + fr) * 64 + fq * 16);
        Bl[m] = *reinterpret_cast<const bf16x8*>(SB + (wc * 64 + m * 16 + fr) * 64 + fq * 16);
      }
#pragma unroll
      for (int m = 0; m < 4; ++m)
#pragma unroll
        for (int n = 0; n < 4; ++n)
          acc[m][n] = __builtin_amdgcn_mfma_f32_16x16x32_bf16(At[m], Bl[n], acc[m][n], 0, 0, 0);
      __syncthreads();
    }
    const int colbase = bcol + wc * 64;
    if constexpr (EPI == EPI_STORE || EPI == EPI_GELU) {
#pragma unroll
      for (int m = 0; m < 4; ++m)
#pragma unroll
        for (int j = 0; j < 4; ++j) {
          int row = brow + wr * 64 + m * 16 + fq * 4 + j;
          bf16_t* o = p->P + (size_t)row * 2048 + colbase + fr;
#pragma unroll
          for (int n = 0; n < 4; ++n) {
            float v = acc[m][n][j];
            if (EPI == EPI_GELU) v = gelu_tanh(v);
            o[n * 16] = f2bf(v);
          }
        }
    } else if constexpr (EPI == EPI_RESID) {
#pragma unroll
      for (int m = 0; m < 4; ++m)
#pragma unroll
        for (int j = 0; j < 4; ++j) {
          int row = brow + wr * 64 + m * 16 + fq * 4 + j;
          int b = tok_batch(row);
          const float* g = p->mod + ((size_t)layer * 9 + b) * 6144 + 2048 + colbase + fr;
          float* o = p->xs + (size_t)row * D + colbase + fr;
#pragma unroll
          for (int n = 0; n < 4; ++n) o[n * 16] += g[n * 16] * acc[m][n][j];
        }
    } else if constexpr (EPI == EPI_INPROJ) {
#pragma unroll
      for (int m = 0; m < 4; ++m)
#pragma unroll
        for (int j = 0; j < 4; ++j) {
          int row = brow + wr * 64 + m * 16 + fq * 4 + j;
          bool latent = row < TL;
          int b, pos;
          if (latent) {
            b = row >> 12;
            pos = row & 4095;
          } else {
            b = (row - TL) >> 8;
            pos = (row - TL) & 255;
          }
          float v0 = acc[m][0][j], v1 = acc[m][1][j], v2 = acc[m][2][j], v3 = acc[m][3][j];
          if (latent && colbase < 640) {
            float2 cr = p->cs[(pos >> 6) * 16 + fr];
            float2 cc = p->cs[(pos & 63) * 16 + fr];
            float a = v0, bb = v1;
            v0 = a * cr.x - bb * cr.y;
            v1 = bb * cr.x + a * cr.y;
            a = v2;
            bb = v3;
            v2 = a * cc.x - bb * cc.y;
            v3 = bb * cc.x + a * cc.y;
          }
          bf16_t* o;
          if (colbase < 512 || colbase >= 768) {
            o = p->P + (size_t)row * 2048 + colbase + fr;
          } else {
            int kvh = ((colbase - 512) >> 6) & 1;
            bf16_t* base = (colbase < 640) ? p->kbuf : p->vbuf;
            int kp = latent ? (CTX + pos) : pos;
            o = base + ((size_t)(b * 2 + kvh) * KVLEN + kp) * 64 + fr;
          }
          o[0] = f2bf(v0);
          o[16] = f2bf(v1);
          o[32] = f2bf(v2);
          o[48] = f2bf(v3);
        }
    }
  }
}

DEVI void phase_attn(PP p, int layer, bool with_ctx_q) {
  int lane = ltid() & 63;
  int gw = lbid() * 4 + (ltid() >> 6), nw = lnblk() * 4;
  int ntask = (with_ctx_q ? TT : TL) * 8;
  const float* sinkp = p->attn_sink + (layer >> 1) * 8;
  for (int task = gw; task < ntask; task += nw) {
    int tok = task >> 3, hd = task & 7, kvh = hd >> 2;
    bool latent = tok < TL;
    int b, s;
    if (latent) {
      b = tok >> 12;
      s = tok & 4095;
    } else {
      b = (tok - TL) >> 8;
      s = 0;
    }
    int lo = 0, nk = CTX;
    if (latent) {
      lo = max(0, s - 128);
      int hi = min(SEQ - 1, s + 128);
      nk = CTX + (hi - lo + 1);
    }
    const bf16_t* kb = p->kbuf + (size_t)(b * 2 + kvh) * KVLEN * 64;
    const bf16_t* vb = p->vbuf + (size_t)(b * 2 + kvh) * KVLEN * 64;
    float q[64];
    {
      const uint4* qp = reinterpret_cast<const uint4*>(p->P + (size_t)tok * 2048 + hd * 64);
#pragma unroll
      for (int i = 0; i < 8; ++i) {
        uint4 u = qp[i];
        q[i * 8 + 0] = bflo(u.x);
        q[i * 8 + 1] = bfhi(u.x);
        q[i * 8 + 2] = bflo(u.y);
        q[i * 8 + 3] = bfhi(u.y);
        q[i * 8 + 4] = bflo(u.z);
        q[i * 8 + 5] = bfhi(u.z);
        q[i * 8 + 6] = bflo(u.w);
        q[i * 8 + 7] = bfhi(u.w);
      }
    }
    float sc[9];
    float mx = sinkp[hd];
    const float sinkv = mx;
#pragma unroll
    for (int r = 0; r < 9; ++r) {
      int ki = r * 64 + lane;
      float sv = -1e30f;
      if (ki < nk) {
        int pos = ki < CTX ? ki : (CTX + lo + (ki - CTX));
        const uint4* kp = reinterpret_cast<const uint4*>(kb + (size_t)pos * 64);
        float a = 0.f;
#pragma unroll
        for (int i = 0; i < 8; ++i) {
          uint4 u = kp[i];
          a += q[i * 8 + 0] * bflo(u.x) + q[i * 8 + 1] * bfhi(u.x) + q[i * 8 + 2] * bflo(u.y) + q[i * 8 + 3] * bfhi(u.y) +
               q[i * 8 + 4] * bflo(u.z) + q[i * 8 + 5] * bfhi(u.z) + q[i * 8 + 6] * bflo(u.w) + q[i * 8 + 7] * bfhi(u.w);
        }
        sv = a * 0.125f;
      }
      sc[r] = sv;
      mx = fmaxf(mx, sv);
    }
    mx = wave_max(mx);
    float lsum = 0.f;
#pragma unroll
    for (int r = 0; r < 9; ++r) {
      int ki = r * 64 + lane;
      float e = (ki < nk) ? __expf(sc[r] - mx) : 0.f;
      sc[r] = e;
      lsum += e;
    }
    lsum = wave_sum(lsum) + __expf(sinkv - mx);
    float o = 0.f;
#pragma unroll
    for (int r = 0; r < 9; ++r) {
      int cnt = min(64, nk - r * 64);
      for (int j = 0; j < cnt; ++j) {
        float pj = __shfl(sc[r], j);
        int ki = r * 64 + j;
        int pos = ki < CTX ? ki : (CTX + lo + (ki - CTX));
        o += pj * bf2f(vb[(size_t)pos * 64 + lane]);
      }
    }
    p->mix[(size_t)tok * LDMIX + hd * 64 + lane] = f2bf(o / lsum);
  }
}

DEVI void fill_tw(float2* tw, int n) {
  for (int i = ltid(); i < n; i += NTHREADS) {
    float sn, cn;
    sincospif(2.f * (float)i / (float)n, &sn, &cn);
    tw[i] = make_float2(cn, sn);
  }
  __syncthreads();
}

DEVI void phase_fft_a(PP p, unsigned char* lds) {
  float2* tw = reinterpret_cast<float2*>(lds);
  fill_tw(tw, 64);
  int tid = ltid();
  for (int u = lbid(); u < NB * 64; u += lnblk()) {
    int b = u >> 6, n2 = u & 63;
    for (int pass = 0; pass < 2; ++pass) {
      int ch = tid + pass * 256;
      float in[64];
#pragma unroll
      for (int n1 = 0; n1 < 64; ++n1) in[n1] = bf2f(p->P[(size_t)(b * SEQ + 64 * n1 + n2) * 2048 + 768 + ch]);
      for (int k1 = 0; k1 < 64; ++k1) {
        float re = 0.f, im = 0.f;
#pragma unroll
        for (int n1 = 0; n1 < 64; ++n1) {
          float2 t = tw[(n1 * k1) & 63];
          re += in[n1] * t.x;
          im -= in[n1] * t.y;
        }
        float sn, cn;
        sincospif((float)(n2 * k1) / 2048.f, &sn, &cn);
        float r2 = re * cn + im * sn;
        float i2 = im * cn - re * sn;
        bf16_t* o = p->fa + (size_t)(b * SEQ + k1 * 64 + n2) * 1024;
        o[ch] = f2bf(r2);
        o[512 + ch] = f2bf(i2);
      }
    }
  }
  __syncthreads();
}

DEVI void phase_fft_b(PP p, unsigned char* lds) {
  float2* tw = reinterpret_cast<float2*>(lds);
  fill_tw(tw, 64);
  int tid = ltid();
  const float scale = 0.0013810679320049757f;
  for (int u = lbid(); u < NB * 64; u += lnblk()) {
    int b = u >> 6, k1 = u & 63;
    for (int pass = 0; pass < 2; ++pass) {
      int ch = tid + pass * 256;
      unsigned in[64];
#pragma unroll
      for (int n2 = 0; n2 < 64; ++n2) {
        const bf16_t* s = p->fa + (size_t)(b * SEQ + k1 * 64 + n2) * 1024;
        in[n2] = (unsigned)s[ch] | ((unsigned)s[512 + ch] << 16);
      }
      for (int k2 = 0; k2 < 64; ++k2) {
        float zr = 0.f, zi = 0.f;
#pragma unroll
        for (int n2 = 0; n2 < 64; ++n2) {
          float2 t = tw[(n2 * k2) & 63];
          float mr = bflo(in[n2]), mi = bfhi(in[n2]);
          zr += mr * t.x + mi * t.y;
          zi += mi * t.x - mr * t.y;
        }
        bf16_t* o = p->mix + (size_t)(b * SEQ + k1 + 64 * k2) * LDMIX;
        o[512 + ch] = f2bf(zr * scale);
        o[1024 + ch] = f2bf(zi * scale);
      }
    }
  }
  __syncthreads();
}

DEVI void phase_dft_ctx(PP p, unsigned char* lds) {
  float2* tw = reinterpret_cast<float2*>(lds);
  fill_tw(tw, 256);
  int tid = ltid();
  const float scale = 0.005524271728019903f;
  for (int u = lbid(); u < NB * 16; u += lnblk()) {
    int b = u >> 4, k0 = (u & 15) * 16;
    for (int pass = 0; pass < 2; ++pass) {
      int ch = tid + pass * 256;
      float zr[16], zi[16];
#pragma unroll
      for (int kk = 0; kk < 16; ++kk) zr[kk] = zi[kk] = 0.f;
      for (int n = 0; n < 256; ++n) {
        float v = bf2f(p->P[(size_t)(TL + b * CTX + n) * 2048 + 768 + ch]);
#pragma unroll
        for (int kk = 0; kk < 16; ++kk) {
          float2 t = tw[(n * (k0 + kk)) & 255];
          zr[kk] += v * t.x;
          zi[kk] -= v * t.y;
        }
      }
#pragma unroll
      for (int kk = 0; kk < 16; ++kk) {
        bf16_t* o = p->mix + (size_t)(TL + b * CTX + k0 + kk) * LDMIX;
        o[512 + ch] = f2bf(zr[kk] * scale);
        o[1024 + ch] = f2bf(zi[kk] * scale);
      }
    }
  }
  __syncthreads();
}

DEVI void phase_sgu(PP p, int j, int nchunks, unsigned char* lds) {
  float* rs = reinterpret_cast<float*>(lds);
  int tid = ltid(), lane = tid & 63, wid = tid >> 6;
  const float* nw = p->gs_norm_w + j * 1024;
  for (int u = lbid(); u < nchunks * 8; u += lnblk()) {
    int chunk = u >> 3, g = u & 7;
    int tok0 = chunk * 128;
    for (int r = wid; r < 128; r += 4) {
      const uint4* vp = reinterpret_cast<const uint4*>(p->P + (size_t)(tok0 + r) * 2048 + 1024);
      float ss = 0.f;
#pragma unroll
      for (int i = 0; i < 2; ++i) {
        uint4 q = vp[lane + 64 * i];
        float a;
        a = bflo(q.x); ss += a * a; a = bfhi(q.x); ss += a * a;
        a = bflo(q.y); ss += a * a; a = bfhi(q.y); ss += a * a;
        a = bflo(q.z); ss += a * a; a = bfhi(q.z); ss += a * a;
        a = bflo(q.w); ss += a * a; a = bfhi(q.w); ss += a * a;
      }
      ss = wave_sum(ss);
      if (lane == 0) rs[r] = rsqrtf(ss * (1.f / 1024.f) + 1e-6f);
    }
    __syncthreads();
    int c = tid & 127, ph = tid >> 7;
    float nwc = nw[g * 128 + c];
    unsigned vn[64];
#pragma unroll
    for (int qq = 0; qq < 64; ++qq) {
      float a = bf2f(p->P[(size_t)(tok0 + 2 * qq) * 2048 + 1024 + g * 128 + c]) * rs[2 * qq] * nwc;
      float bq = bf2f(p->P[(size_t)(tok0 + 2 * qq + 1) * 2048 + 1024 + g * 128 + c]) * rs[2 * qq + 1] * nwc;
      vn[qq] = pack2(a, bq);
    }
    const float* wsg = p->gs_w_s + ((size_t)j * 8 + g) * 128 * 128;
    const float* bsg = p->gs_b_s + ((size_t)j * 8 + g) * 128;
    for (int pp = ph * 64; pp < ph * 64 + 64; ++pp) {
      const float4* wrow = reinterpret_cast<const float4*>(wsg + (size_t)pp * 128);
      float acc = 0.f;
#pragma unroll
      for (int q4 = 0; q4 < 32; ++q4) {
        float4 w = wrow[q4];
        acc += w.x * bflo(vn[q4 * 2]) + w.y * bfhi(vn[q4 * 2]) + w.z * bflo(vn[q4 * 2 + 1]) + w.w * bfhi(vn[q4 * 2 + 1]);
      }
      float sv = acc + bsg[pp];
      float uu = bf2f(p->P[(size_t)(tok0 + pp) * 2048 + g * 128 + c]);
      p->mix[(size_t)(tok0 + pp) * LDMIX + g * 128 + c] = f2bf(uu * sv);
    }
    __syncthreads();
  }
}

DEVI void phase_route(PP p, int layer, int ntok, unsigned char* lds) {
  int tid = ltid(), lane = tid & 63, wid = tid >> 6, fr = lane & 15, fq = lane >> 4;
  float* scw = reinterpret_cast<float*>(lds) + wid * (16 * 260);
  int nunits = (ntok / 64) * 8;
  const float NEG = -3.0e38f;
  for (int u = lbid(); u < nunits; u += lnblk()) {
    int tt = u >> 3, hh = u & 7;
    int tokw = tt * 64 + wid * 16;
#pragma unroll
    for (int half = 0; half < 2; ++half) {
      const bf16_t* qa = p->P + (size_t)(tokw + fr) * 2048 + hh * 256 + half * 128 + fq * 8;
      const bf16_t* kb = p->keysb + ((size_t)((layer * 8 + hh) * 2 + half) * 128) * 128 + fq * 8;
      bf16x8 a[4];
#pragma unroll
      for (int ks = 0; ks < 4; ++ks) a[ks] = *reinterpret_cast<const bf16x8*>(qa + ks * 32);
      f32x4 acc[8];
#pragma unroll
      for (int nf = 0; nf < 8; ++nf) {
        acc[nf] = f32x4{0.f, 0.f, 0.f, 0.f};
#pragma unroll
        for (int ks = 0; ks < 4; ++ks) {
          bf16x8 bb = *reinterpret_cast<const bf16x8*>(kb + (size_t)(nf * 16 + fr) * 128 + ks * 32);
          acc[nf] = __builtin_amdgcn_mfma_f32_16x16x32_bf16(a[ks], bb, acc[nf], 0, 0, 0);
        }
      }
#pragma unroll
      for (int nf = 0; nf < 8; ++nf)
#pragma unroll
        for (int j = 0; j < 4; ++j) scw[(fq * 4 + j) * 260 + half * 128 + nf * 16 + fr] = acc[nf][j];
    }
    __syncthreads();
    for (int r = 0; r < 16; ++r) {
      const float* row = scw + r * 260;
      float ts[2];
      int ti[2];
#pragma unroll
      for (int half = 0; half < 2; ++half) {
        float a0 = row[half * 128 + lane], a1 = row[half * 128 + 64 + lane];
        float mys = 0.f;
        int myi = 0;
        for (int it = 0; it < 16; ++it) {
          float m = fmaxf(a0, a1);
          float wm = wave_max(m);
          unsigned long long bal = __ballot(m == wm);
          int src = __ffsll((long long)bal) - 1;
          bool isA0 = (a0 == wm);
          int cand = isA0 ? lane : lane + 64;
          int widx = __shfl(cand, src);
          if (lane == src) {
            if (isA0) a0 = NEG; else a1 = NEG;
          }
          if (lane == it) {
            mys = wm;
            myi = widx;
          }
        }
        ts[half] = mys;
        ti[half] = myi;
      }
      float cv[4];
      {
        float sa = __shfl(ts[0], lane >> 2);
#pragma unroll
        for (int j = 0; j < 4; ++j) cv[j] = sa + __shfl(ts[1], (lane & 3) * 4 + j);
      }
      float bs = 0.f;
      int bc = 0;
      for (int it = 0; it < 16; ++it) {
        float m = fmaxf(fmaxf(cv[0], cv[1]), fmaxf(cv[2], cv[3]));
        float wm = wave_max(m);
        unsigned long long bal = __ballot(m == wm);
        int src = __ffsll((long long)bal) - 1;
        int jw = (cv[0] == wm) ? 0 : ((cv[1] == wm) ? 1 : ((cv[2] == wm) ? 2 : 3));
        int cidx = (lane >> 2) * 16 + (lane & 3) * 4 + jw;
        int widx = __shfl(cidx, src);
        if (lane == src) {
          if (jw == 0) cv[0] = NEG;
          else if (jw == 1) cv[1] = NEG;
          else if (jw == 2) cv[2] = NEG;
          else cv[3] = NEG;
        }
        if (lane == it) {
          bs = wm;
          bc = widx;
        }
      }
      float mx0 = __shfl(bs, 0);
      float e = (lane < 16) ? __expf(bs - mx0) : 0.f;
      float sum = wave_sum(e);
      int i1 = __shfl(ti[0], bc >> 4);
      int i2 = __shfl(ti[1], bc & 15);
      if (lane < 16) {
        size_t o = (size_t)(tokw + r) * 128 + hh * 16 + lane;
        p->eidx[o] = i1 * 128 + i2;
        p->gate[o] = e / sum;
      }
    }
    __syncthreads();
  }
}

DEVI void phase_expert(PP p, int layer, int ntok) {
  int lane = ltid() & 63;
  int gw = lbid() * 4 + (ltid() >> 6), nw = lnblk() * 4;
  const bf16_t* ut = p->utab + (size_t)layer * NEXP * D;
  const bf16_t* vt = p->vtab + (size_t)layer * NEXP * D;
  for (int tok = gw; tok < ntok; tok += nw) {
    float xv[16];
    {
      const uint4* hp = reinterpret_cast<const uint4*>(p->h + (size_t)tok * D + lane * 16);
#pragma unroll
      for (int i = 0; i < 2; ++i) {
        uint4 u = hp[i];
        xv[i * 8 + 0] = bflo(u.x); xv[i * 8 + 1] = bfhi(u.x);
        xv[i * 8 + 2] = bflo(u.y); xv[i * 8 + 3] = bfhi(u.y);
        xv[i * 8 + 4] = bflo(u.z); xv[i * 8 + 5] = bfhi(u.z);
        xv[i * 8 + 6] = bflo(u.w); xv[i * 8 + 7] = bfhi(u.w);
      }
    }
    int e0 = p->eidx[(size_t)tok * 128 + lane], e1 = p->eidx[(size_t)tok * 128 + 64 + lane];
    float g0 = p->gate[(size_t)tok * 128 + lane], g1 = p->gate[(size_t)tok * 128 + 64 + lane];
    float out[16];
#pragma unroll
    for (int i = 0; i < 16; ++i) out[i] = 0.f;
#pragma unroll 1
    for (int k = 0; k < 128; k += 4) {
      int e[4];
      float g[4];
      uint4 uu[4][2], vv[4][2];
#pragma unroll
      for (int q = 0; q < 4; ++q) {
        int kk = k + q;
        e[q] = __shfl(kk < 64 ? e0 : e1, kk & 63);
        g[q] = __shfl(kk < 64 ? g0 : g1, kk & 63);
        const uint4* up = reinterpret_cast<const uint4*>(ut + (size_t)e[q] * D + lane * 16);
        const uint4* vp = reinterpret_cast<const uint4*>(vt + (size_t)e[q] * D + lane * 16);
        uu[q][0] = up[0]; uu[q][1] = up[1];
        vv[q][0] = vp[0]; vv[q][1] = vp[1];
      }
#pragma unroll
      for (int q = 0; q < 4; ++q) {
        float d = 0.f;
#pragma unroll
        for (int i = 0; i < 2; ++i) {
          uint4 u = uu[q][i];
          d += xv[i * 8 + 0] * bflo(u.x) + xv[i * 8 + 1] * bfhi(u.x) + xv[i * 8 + 2] * bflo(u.y) + xv[i * 8 + 3] * bfhi(u.y) +
               xv[i * 8 + 4] * bflo(u.z) + xv[i * 8 + 5] * bfhi(u.z) + xv[i * 8 + 6] * bflo(u.w) + xv[i * 8 + 7] * bfhi(u.w);
        }
        d = wave_sum(d);
        float w = g[q] * gelu_tanh(d);
#pragma unroll
        for (int i = 0; i < 2; ++i) {
          uint4 u = vv[q][i];
          out[i * 8 + 0] += w * bflo(u.x); out[i * 8 + 1] += w * bfhi(u.x);
          out[i * 8 + 2] += w * bflo(u.y); out[i * 8 + 3] += w * bfhi(u.y);
          out[i * 8 + 4] += w * bflo(u.z); out[i * 8 + 5] += w * bfhi(u.z);
          out[i * 8 + 6] += w * bflo(u.w); out[i * 8 + 7] += w * bfhi(u.w);
        }
      }
    }
    int b = tok_batch(tok);
    const float4* gf = reinterpret_cast<const float4*>(p->mod + ((size_t)layer * 9 + b) * 6144 + 5 * 1024 + lane * 16);
    float4* xo = reinterpret_cast<float4*>(p->xs + (size_t)tok * D + lane * 16);
#pragma unroll
    for (int i = 0; i < 4; ++i) {
      float4 gq = gf[i], xq = xo[i];
      xq.x += gq.x * out[i * 4 + 0];
      xq.y += gq.y * out[i * 4 + 1];
      xq.z += gq.z * out[i * 4 + 2];
      xq.w += gq.w * out[i * 4 + 3];
      xo[i] = xq;
    }
  }
}

DEVI bool step_active(int step) {
  if (step == 0 || step == NSTEPS - 1) return true;
  int layer = (step - 1) / STEPS_PER_LAYER, ph = (step - 1) % STEPS_PER_LAYER;
  if (ph == 3 && (layer & 1)) return false;
  return true;
}

DEVI void run_step(PP p, int step, unsigned char* lds) {
  if (step == 0) {
    phase_prep(p, lds);
    return;
  }
  if (step == NSTEPS - 1) {
    phase_norm(p, 0, 2, TL);
    return;
  }
  int layer = (step - 1) / STEPS_PER_LAYER, ph = (step - 1) % STEPS_PER_LAYER;
  bool even = (layer & 1) == 0;
  int j = layer >> 1;
  bool upd_ctx = layer < 2;
  bool need_ctx = layer < 3;
  int nt_in = need_ctx ? TT : TL;
  int nt = upd_ctx ? TT : TL;
  switch (ph) {
    case 0: phase_norm(p, layer, 0, nt_in); break;
    case 1:
      if (even)
        gemm_phase<EPI_INPROJ>(p, p->h, D, p->wt_in_ab + (size_t)j * 1280 * D, D, nt_in / 128, 10, D, layer, lds);
      else
        gemm_phase<EPI_GELU>(p, p->h, D, p->wt_in_gs + (size_t)j * 2048 * D, D, nt / 128, 16, D, layer, lds);
      break;
    case 2:
      if (even) {
        phase_fft_a(p, lds);
        if (upd_ctx) phase_dft_ctx(p, lds);
        phase_attn(p, layer, upd_ctx);
      } else {
        phase_sgu(p, j, nt / 128, lds);
      }
      break;
    case 3:
      if (even) phase_fft_b(p, lds);
      break;
    case 4:
      if (even)
        gemm_phase<EPI_RESID>(p, p->mix, LDMIX, p->wt_out_ab + (size_t)j * D * LDMIX, LDMIX, nt / 128, 8, LDMIX, layer, lds);
      else
        gemm_phase<EPI_RESID>(p, p->mix, LDMIX, p->wt_out_gs + (size_t)j * D * D, D, nt / 128, 8, D, layer, lds);
      break;
    case 5: phase_norm(p, layer, 1, nt); break;
    case 6: gemm_phase<EPI_STORE>(p, p->h, D, p->wt_q + (size_t)layer * 2048 * D, D, nt / 128, 16, D, layer, lds); break;
    case 7: phase_route(p, layer, nt, lds); break;
    case 8: phase_expert(p, layer, nt); break;
  }
}

__global__ void __launch_bounds__(NTHREADS, 2) mega(Params p_unused, int step_lo, int step_hi) {
  __shared__ __attribute__((aligned(16))) unsigned char lds[LDS_BYTES];
  PP pp = (PP)__builtin_amdgcn_kernarg_segment_ptr();
  bool first = true;
  for (int s = step_lo; s < step_hi; ++s) {
    if (!step_active(s)) continue;
    if (!first) cg::this_grid().sync();
    first = false;
    PP q = pp;
    asm volatile("" : "+s"(q));
    run_step(q, s, lds);
  }
}

static size_t align_up(size_t v) { return (v + 255) & ~(size_t)255; }

extern "C" void kernel_launch(void* const* d_in, const int* in_sizes, int n_in, void* d_out, int out_size, void* d_ws,
                              size_t ws_size, hipStream_t stream) {
  Params p{};
  p.x = (const float*)d_in[0];
  p.c = (const float*)d_in[1];
  p.ctx = (const float*)d_in[2];
  p.c_ctx = (const float*)d_in[3];
  p.ada_w = (const float*)d_in[4];
  p.ada_b = (const float*)d_in[5];
  p.norm_mix_w = (const float*)d_in[6];
  p.norm_ffn_w = (const float*)d_in[7];
  p.ab_w_in = (const float*)d_in[8];
  p.ab_w_out = (const float*)d_in[9];
  p.attn_sink = (const float*)d_in[10];
  p.gs_w_in = (const float*)d_in[11];
  p.gs_norm_w = (const float*)d_in[12];
  p.gs_w_s = (const float*)d_in[13];
  p.gs_b_s = (const float*)d_in[14];
  p.gs_w_out = (const float*)d_in[15];
  p.peer_w_q = (const float*)d_in[16];
  p.peer_keys = (const float*)d_in[17];
  p.peer_u = (const float*)d_in[18];
  p.peer_v = (const float*)d_in[19];
  p.norm_out_w = (const float*)d_in[20];
  p.out = (float*)d_out;
  unsigned char* w = (unsigned char*)d_ws;
  size_t off = 0;
  auto take = [&](size_t bytes) {
    unsigned char* r = w + off;
    off = align_up(off + bytes);
    return r;
  };
  p.mod = (float*)take((size_t)DEPTH * 9 * 6144 * 4);
  p.cs = (float2*)take(64 * 16 * 8);
  p.xs = (float*)take((size_t)TT * D * 4);
  p.h = (bf16_t*)take((size_t)TT * D * 2);
  p.P = (bf16_t*)take((size_t)TT * 2048 * 2);
  p.kbuf = (bf16_t*)take((size_t)NB * 2 * KVLEN * 64 * 2);
  p.vbuf = (bf16_t*)take((size_t)NB * 2 * KVLEN * 64 * 2);
  p.mix = (bf16_t*)take((size_t)TT * LDMIX * 2);
  p.fa = (bf16_t*)take((size_t)TL * 1024 * 2);
  p.eidx = (int*)take((size_t)TT * 128 * 4);
  p.gate = (float*)take((size_t)TT * 128 * 4);
  p.wt_in_ab = (bf16_t*)take((size_t)2 * 1280 * D * 2);
  p.wt_out_ab = (bf16_t*)take((size_t)2 * D * LDMIX * 2);
  p.wt_in_gs = (bf16_t*)take((size_t)2 * 2048 * D * 2);
  p.wt_out_gs = (bf16_t*)take((size_t)2 * D * D * 2);
  p.wt_q = (bf16_t*)take((size_t)DEPTH * 2048 * D * 2);
  p.keysb = (bf16_t*)take((size_t)DEPTH * 8 * 2 * 128 * 128 * 2);
  p.utab = (bf16_t*)take((size_t)DEPTH * NEXP * D * 2);
  p.vtab = (bf16_t*)take((size_t)DEPTH * NEXP * D * 2);
  if (off > ws_size) {
    fprintf(stderr, "workspace too small: need %zu have %zu\n", off, ws_size);
    return;
  }
  static int grid_blocks = 0;
  if (!grid_blocks) {
    int dev = 0, cus = 0, per_cu = 0;
    hipGetDevice(&dev);
    hipDeviceGetAttribute(&cus, hipDeviceAttributeMultiprocessorCount, dev);
    hipOccupancyMaxActiveBlocksPerMultiprocessor(&per_cu, mega, NTHREADS, 0);
    if (per_cu > 2) per_cu = 2;
    if (per_cu < 1) per_cu = 1;
    grid_blocks = cus * per_cu;
  }
#if ONE_LAUNCH
  int lo = 0, hi = NSTEPS;
  void* args[] = {&p, &lo, &hi};
  hipError_t e = hipLaunchCooperativeKernel((void*)mega, dim3(grid_blocks), dim3(NTHREADS), args, 0, stream);
  if (e != hipSuccess) fprintf(stderr, "cooperative launch failed: %s (grid %d)\n", hipGetErrorString(e), grid_blocks);
#else
  for (int s = 0; s < NSTEPS; ++s) {
    if (s != 0 && s != NSTEPS - 1) {
      int layer = (s - 1) / STEPS_PER_LAYER, ph = (s - 1) % STEPS_PER_LAYER;
      if (ph == 3 && (layer & 1)) continue;
    }
    hipLaunchKernelGGL(mega, dim3(grid_blocks), dim3(NTHREADS), 0, stream, p, s, s + 1);
  }
#endif
}
```

```cpp
#include <hip/hip_runtime.h>
#include <hip/hip_bf16.h>
#include <hip/hip_cooperative_groups.h>
#include <cstdio>
namespace cg = cooperative_groups;

#ifndef REP_MASK
#define REP_MASK 0
#endif
#ifndef ONE_LAUNCH
#define ONE_LAUNCH 1
#endif

#define DEVI __device__ __forceinline__
typedef unsigned short bf16_t;
using bf16x8 = __attribute__((ext_vector_type(8))) short;
using f32x4 = __attribute__((ext_vector_type(4))) float;
using f32x16 = __attribute__((ext_vector_type(16))) float;

constexpr int D = 1024, NB = 8, SEQ = 4096, CTX = 256, DEPTH = 4;
constexpr int TL = NB * SEQ, TC = NB * CTX, TT = TL + TC;
constexpr int KVLEN = CTX + SEQ;
constexpr int NEXP = 16384;
constexpr int LDMIX = 1536;
constexpr float USCALE = 64.f, VSCALE = 8.f;
constexpr int TPB = 68;
constexpr int LDS_BYTES = 68 * 1024;
constexpr int NTHREADS = 256;
constexpr int STEPS_PER_LAYER = 9;
constexpr int NSTEPS = 1 + DEPTH * STEPS_PER_LAYER + 1;

struct Params {
  const float *x, *c, *ctx, *c_ctx, *ada_w, *ada_b, *norm_mix_w, *norm_ffn_w, *ab_w_in, *ab_w_out, *attn_sink,
      *gs_w_in, *gs_norm_w, *gs_w_s, *gs_b_s, *gs_w_out, *peer_w_q, *peer_keys, *peer_u, *peer_v, *norm_out_w;
  float* out;
  float* mod;
  float2* cs;
  float* xs;
  bf16_t* h;
  bf16_t* P;
  bf16_t* kbuf;
  bf16_t* vbuf;
  bf16_t* zvT;
  bf16_t* mix;
  bf16_t* fa;
  int* eidx;
  float* gate;
  bf16_t *wt_in_ab, *wt_out_ab, *wt_in_gs, *wt_out_gs, *wt_q, *keysb;
  unsigned char *utab, *vtab;
};

typedef const __attribute__((address_space(4))) Params* PP;

DEVI int ltid() { int t = threadIdx.x; asm volatile("" : "+v"(t)); return t; }
DEVI int lbid() { int t = blockIdx.x; asm volatile("" : "+s"(t)); return t; }
DEVI int lnblk() { int t = gridDim.x; asm volatile("" : "+s"(t)); return t; }

DEVI bf16_t f2bf(float f) {
  unsigned u = __float_as_uint(f);
  u += 0x7fffu + ((u >> 16) & 1u);
  return (bf16_t)(u >> 16);
}
DEVI float bf2f(bf16_t h) { return __uint_as_float(((unsigned)h) << 16); }
DEVI float bflo(unsigned u) { return __uint_as_float(u << 16); }
DEVI float bfhi(unsigned u) { return __uint_as_float(u & 0xffff0000u); }
DEVI unsigned pack2(float a, float b) { return (unsigned)f2bf(a) | ((unsigned)f2bf(b) << 16); }
DEVI float wave_sum(float v) {
#pragma unroll
  for (int o = 32; o > 0; o >>= 1) v += __shfl_xor(v, o);
  return v;
}
DEVI float wave_max(float v) {
#pragma unroll
  for (int o = 32; o > 0; o >>= 1) v = fmaxf(v, __shfl_xor(v, o));
  return v;
}
DEVI float gelu_tanh(float x) {
  float u = 0.7978845608028654f * (x + 0.044715f * x * x * x);
  return 0.5f * x * (1.f + tanhf(u));
}
DEVI int tok_batch(int r) { return r < TL ? (r >> 12) : 8; }

DEVI void transpose_to_bf16(const float* __restrict__ src, int K, int N, bf16_t* __restrict__ dst, int ldk, float* tile) {
  int tilesN = N / 64, tiles = (K / 64) * tilesN;
  int tid = ltid();
  for (int t = lbid(); t < tiles; t += lnblk()) {
    int tk = t / tilesN, tn = t % tilesN;
#pragma unroll
    for (int i = 0; i < 16; ++i) {
      int r = (tid >> 6) + 4 * i;
      tile[r * 65 + (tid & 63)] = src[(size_t)(tk * 64 + r) * N + tn * 64 + (tid & 63)];
    }
    __syncthreads();
#pragma unroll
    for (int i = 0; i < 16; ++i) {
      int n = (tid >> 6) + 4 * i, k = tid & 63;
      dst[(size_t)(tn * 64 + n) * ldk + tk * 64 + k] = f2bf(tile[k * 65 + n]);
    }
    __syncthreads();
  }
}

DEVI void convert_bf16(const float* __restrict__ src, bf16_t* __restrict__ dst, size_t n) {
  size_t n4 = n / 4;
  size_t stride = (size_t)lnblk() * NTHREADS;
  for (size_t i = (size_t)lbid() * NTHREADS + ltid(); i < n4; i += stride) {
    float4 v = reinterpret_cast<const float4*>(src)[i];
    uint2 o;
    o.x = pack2(v.x, v.y);
    o.y = pack2(v.z, v.w);
    reinterpret_cast<uint2*>(dst)[i] = o;
  }
}

DEVI void convert_fp8(const float* __restrict__ src, unsigned char* __restrict__ dst, size_t n, float scale) {
  size_t n4 = n / 4;
  size_t stride = (size_t)lnblk() * NTHREADS;
  for (size_t i = (size_t)lbid() * NTHREADS + ltid(); i < n4; i += stride) {
    float4 v = reinterpret_cast<const float4*>(src)[i];
    int w = 0;
    w = __builtin_amdgcn_cvt_pk_fp8_f32(v.x * scale, v.y * scale, w, false);
    w = __builtin_amdgcn_cvt_pk_fp8_f32(v.z * scale, v.w * scale, w, true);
    reinterpret_cast<int*>(dst)[i] = w;
  }
}

DEVI void phase_prep(PP p, unsigned char* lds) {
  int tid = ltid();
  size_t gtid = (size_t)lbid() * NTHREADS + tid;
  size_t gstride = (size_t)lnblk() * NTHREADS;
  {
    const float4* s0 = reinterpret_cast<const float4*>(p->x);
    const float4* s1 = reinterpret_cast<const float4*>(p->ctx);
    float4* d = reinterpret_cast<float4*>(p->xs);
    size_t n0 = (size_t)TL * D / 4, n1 = (size_t)TC * D / 4;
    for (size_t i = gtid; i < n0; i += gstride) d[i] = s0[i];
    for (size_t i = gtid; i < n1; i += gstride) d[n0 + i] = s1[i];
  }
  convert_fp8(p->peer_u, p->utab, (size_t)DEPTH * NEXP * D, USCALE);
  convert_fp8(p->peer_v, p->vtab, (size_t)DEPTH * NEXP * D, VSCALE);
  convert_bf16(p->peer_keys, p->keysb, (size_t)DEPTH * 8 * 2 * 128 * 128);
  for (size_t i = gtid; i < 64 * 16; i += gstride) {
    int pos = (int)(i >> 4), k = (int)(i & 15);
    float inv = powf(10000.f, -(float)k / 16.f);
    float ang = (float)pos * inv;
    float sn, cn;
    sincosf(ang, &sn, &cn);
    p->cs[i] = make_float2(cn, sn);
  }
  float* tile = reinterpret_cast<float*>(lds);
  for (int j = 0; j < 2; ++j) {
    transpose_to_bf16(p->ab_w_in + (size_t)j * D * 1280, D, 1280, p->wt_in_ab + (size_t)j * 1280 * D, D, tile);
    transpose_to_bf16(p->gs_w_in + (size_t)j * D * 2048, D, 2048, p->wt_in_gs + (size_t)j * 2048 * D, D, tile);
    transpose_to_bf16(p->gs_w_out + (size_t)j * D * D, D, D, p->wt_out_gs + (size_t)j * D * D, D, tile);
    transpose_to_bf16(p->ab_w_out + (size_t)j * D * D, 512, D, p->wt_out_ab + (size_t)j * D * LDMIX, LDMIX, tile);
  }
  for (int i = 0; i < DEPTH; ++i)
    transpose_to_bf16(p->peer_w_q + (size_t)i * D * 2048, D, 2048, p->wt_q + (size_t)i * 2048 * D, D, tile);
  {
    float2* tw = reinterpret_cast<float2*>(lds) + 8192;
    if (tid < 128) {
      float sn, cn;
      sincospif((float)tid / 64.f, &sn, &cn);
      tw[tid] = make_float2(cn, sn);
    }
    __syncthreads();
    size_t total = (size_t)2 * 512 * 1024;
    for (size_t i = gtid; i < total; i += gstride) {
      int n = (int)(i & 1023);
      int gm = (int)((i >> 10) & 511);
      int j = (int)(i >> 19);
      int g = gm >> 7, m = gm & 127;
      const float* w = p->ab_w_out + (size_t)j * D * D + (size_t)(512 + g * 128) * D + n;
      float ar = 0.f, ai = 0.f;
      for (int l = 0; l < 128; ++l) {
        float2 t = tw[(m * l) & 127];
        float wv = w[(size_t)l * D];
        ar += t.x * wv;
        ai += t.y * wv;
      }
      bf16_t* dst = p->wt_out_ab + (size_t)j * D * LDMIX + (size_t)n * LDMIX;
      dst[512 + gm] = f2bf(ar);
      dst[1024 + gm] = f2bf(ai);
    }
    __syncthreads();
  }
  {
    float* sl = reinterpret_cast<float*>(lds);
    for (int i = tid; i < 9 * 1024; i += NTHREADS) {
      int r = i >> 10, k = i & 1023;
      float v = (r < 8) ? p->c[r * 1024 + k] : p->c_ctx[k];
      sl[i] = v / (1.f + __expf(-v));
    }
    __syncthreads();
    float* red = sl + 9 * 1024;
    int ks = tid >> 6, col = tid & 63;
    for (int u = lbid(); u < DEPTH * 96; u += lnblk()) {
      int layer = u / 96, c0 = (u % 96) * 64;
      const float* w = p->ada_w + (size_t)layer * D * 6144 + c0 + col;
      float acc[9];
#pragma unroll
      for (int r = 0; r < 9; ++r) acc[r] = 0.f;
      for (int k = ks * 256; k < ks * 256 + 256; ++k) {
        float wv = w[(size_t)k * 6144];
#pragma unroll
        for (int r = 0; r < 9; ++r) acc[r] += sl[r * 1024 + k] * wv;
      }
#pragma unroll
      for (int r = 0; r < 9; ++r) red[(ks * 9 + r) * 64 + col] = acc[r];
      __syncthreads();
      for (int i = tid; i < 9 * 64; i += NTHREADS) {
        int r = i >> 6, cc = i & 63;
        float s = red[(0 * 9 + r) * 64 + cc] + red[(1 * 9 + r) * 64 + cc] + red[(2 * 9 + r) * 64 + cc] +
                  red[(3 * 9 + r) * 64 + cc];
        s += p->ada_b[(size_t)layer * 6144 + c0 + cc];
        p->mod[((size_t)layer * 9 + r) * 6144 + c0 + cc] = s;
      }
      __syncthreads();
    }
  }
}

DEVI void phase_norm(PP p, int layer, int which, int ntok) {
  int lane = ltid() & 63;
  int gw = lbid() * 4 + (ltid() >> 6), nw = lnblk() * 4;
  const float* w = which == 0 ? p->norm_mix_w + layer * D : (which == 1 ? p->norm_ffn_w + layer * D : p->norm_out_w);
  for (int tok = gw; tok < ntok; tok += nw) {
    const float4* xr = reinterpret_cast<const float4*>(p->xs + (size_t)tok * D);
    float4 v[4];
    float ss = 0.f;
#pragma unroll
    for (int i = 0; i < 4; ++i) {
      v[i] = xr[lane + 64 * i];
      ss += v[i].x * v[i].x + v[i].y * v[i].y + v[i].z * v[i].z + v[i].w * v[i].w;
    }
    ss = wave_sum(ss);
    float rstd = rsqrtf(ss * (1.f / 1024.f) + 1e-6f);
    if (which == 2) {
      float4* o = reinterpret_cast<float4*>(p->out + (size_t)tok * D);
#pragma unroll
      for (int i = 0; i < 4; ++i) {
        float4 wv = reinterpret_cast<const float4*>(w)[lane + 64 * i];
        float4 r;
        r.x = v[i].x * rstd * wv.x;
        r.y = v[i].y * rstd * wv.y;
        r.z = v[i].z * rstd * wv.z;
        r.w = v[i].w * rstd * wv.w;
        o[lane + 64 * i] = r;
      }
    } else {
      int b = tok_batch(tok);
      const float* mb = p->mod + ((size_t)layer * 9 + b) * 6144 + (which == 0 ? 0 : 3072);
      uint2* o = reinterpret_cast<uint2*>(p->h + (size_t)tok * D);
#pragma unroll
      for (int i = 0; i < 4; ++i) {
        float4 wv = reinterpret_cast<const float4*>(w)[lane + 64 * i];
        float4 sh = reinterpret_cast<const float4*>(mb)[lane + 64 * i];
        float4 sc = reinterpret_cast<const float4*>(mb + 1024)[lane + 64 * i];
        float a0 = v[i].x * rstd * wv.x * (1.f + sc.x) + sh.x;
        float a1 = v[i].y * rstd * wv.y * (1.f + sc.y) + sh.y;
        float a2 = v[i].z * rstd * wv.z * (1.f + sc.z) + sh.z;
        float a3 = v[i].w * rstd * wv.w * (1.f + sc.w) + sh.w;
        uint2 r;
        r.x = pack2(a0, a1);
        r.y = pack2(a2, a3);
        o[lane + 64 * i] = r;
      }
    }
  }
}

enum { EPI_STORE = 0, EPI_GELU = 1, EPI_RESID = 2, EPI_INPROJ = 3 };

template <int EPI>
DEVI void gemm_phase(PP p, const bf16_t* __restrict__ A, int lda, const bf16_t* __restrict__ Bt, int ldb,
                     int Mtiles, int Ntiles, int K, int layer, unsigned char* lds, float gscale = 1.f) {
  const int tid = ltid();
  const int wid = tid >> 6, lane = tid & 63, wr = wid >> 1, wc = wid & 1, fr = lane & 15, fq = lane >> 4;
  unsigned char* SA = lds;
  unsigned char* SB = lds + 8192;
  int nblk = lnblk();
  int lb = ((nblk & 7) == 0) ? ((lbid() & 7) * (nblk >> 3) + (lbid() >> 3)) : lbid();
  int ntiles = Mtiles * Ntiles;
  for (int t = lb; t < ntiles; t += nblk) {
    int tm = t / Ntiles, tn = t % Ntiles;
    int brow = tm * 128, bcol = tn * 128;
    f32x4 acc[4][4];
#pragma unroll
    for (int m = 0; m < 4; ++m)
#pragma unroll
      for (int n = 0; n < 4; ++n) acc[m][n] = f32x4{0.f, 0.f, 0.f, 0.f};
    for (int kt = 0; kt < K / 32; ++kt) {
#pragma unroll
      for (int i = 0; i < 2; ++i) {
        int b = tid * 16 + i * 4096, r = b >> 6, c = (b & 63) >> 1;
        __builtin_amdgcn_global_load_lds((const unsigned*)(A + (size_t)(brow + r) * lda + kt * 32 + c),
                                         (__attribute__((address_space(3))) unsigned*)(SA + b), 16, 0, 0);
        __builtin_amdgcn_global_load_lds((const unsigned*)(Bt + (size_t)(bcol + r) * ldb + kt * 32 + c),
                                         (__attribute__((address_space(3))) unsigned*)(SB + b), 16, 0, 0);
      }
      asm volatile("s_waitcnt vmcnt(0)" ::: "memory");
      __syncthreads();
      bf16x8 At[4], Bl[4];
#pragma unroll
      for (int m = 0; m < 4; ++m) {
        At[m] = *reinterpret_cast<const bf16x8*>(SA + (wr * 64 + m * 16 + fr) * 64 + fq * 16);
        Bl[m] = *reinterpret_cast<const bf16x8*>(SB + (wc * 64 + m * 16 + fr) * 64 + fq * 16);
      }
#pragma unroll
      for (int m = 0; m < 4; ++m)
#pragma unroll
        for (int n = 0; n < 4; ++n)
          acc[m][n] = __builtin_amdgcn_mfma_f32_16x16x32_bf16(At[m], Bl[n], acc[m][n], 0, 0, 0);
      __syncthreads();
    }
    const int colbase = bcol + wc * 64;
    if constexpr (EPI == EPI_STORE || EPI == EPI_GELU) {
      if (EPI == EPI_GELU && colbase >= 1024) {
#pragma unroll
        for (int m = 0; m < 4; ++m)
#pragma unroll
          for (int n = 0; n < 4; ++n) {
            int ch = colbase - 1024 + n * 16 + fr;
            int q0 = wr * 64 + m * 16 + fq * 4;
            uint2 o;
            o.x = pack2(gelu_tanh(acc[m][n][0]), gelu_tanh(acc[m][n][1]));
            o.y = pack2(gelu_tanh(acc[m][n][2]), gelu_tanh(acc[m][n][3]));
            *reinterpret_cast<uint2*>(p->zvT + ((size_t)tm * 1024 + ch) * 128 + q0) = o;
          }
      } else {
#pragma unroll
        for (int m = 0; m < 4; ++m)
#pragma unroll
          for (int j = 0; j < 4; ++j) {
            int row = brow + wr * 64 + m * 16 + fq * 4 + j;
            bf16_t* o = p->P + (size_t)row * 2048 + colbase + fr;
#pragma unroll
            for (int n = 0; n < 4; ++n) {
              float v = acc[m][n][j];
              if (EPI == EPI_GELU) v = gelu_tanh(v);
              o[n * 16] = f2bf(v);
            }
          }
      }
    } else if constexpr (EPI == EPI_RESID) {
#pragma unroll
      for (int m = 0; m < 4; ++m)
#pragma unroll
        for (int j = 0; j < 4; ++j) {
          int row = brow + wr * 64 + m * 16 + fq * 4 + j;
          int b = tok_batch(row);
          const float* g = p->mod + ((size_t)layer * 9 + b) * 6144 + 2048 + colbase + fr;
          float* o = p->xs + (size_t)row * D + colbase + fr;
#pragma unroll
          for (int n = 0; n < 4; ++n) o[n * 16] += gscale * g[n * 16] * acc[m][n][j];
        }
    } else if constexpr (EPI == EPI_INPROJ) {
      if (colbase >= 640 && colbase < 768) {
        int kvh = (colbase - 640) >> 6;
#pragma unroll
        for (int m = 0; m < 4; ++m) {
          int row0 = brow + wr * 64 + m * 16;
          bool latent = row0 < TL;
          int b = latent ? (row0 >> 12) : ((row0 - TL) >> 8);
          int kp16 = latent ? (CTX + (row0 & 4095)) : ((row0 - TL) & 255);
          int slot = kp16 + 8 * (fq & 1) + 4 * (fq >> 1);
#pragma unroll
          for (int n = 0; n < 4; ++n) {
            int dim = n * 16 + fr;
            uint2 o;
            o.x = pack2(acc[m][n][0], acc[m][n][1]);
            o.y = pack2(acc[m][n][2], acc[m][n][3]);
            *reinterpret_cast<uint2*>(p->vbuf + ((size_t)(b * 2 + kvh) * 64 + dim) * KVLEN + slot) = o;
          }
        }
      } else {
#pragma unroll
        for (int m = 0; m < 4; ++m)
#pragma unroll
          for (int j = 0; j < 4; ++j) {
            int row = brow + wr * 64 + m * 16 + fq * 4 + j;
            bool latent = row < TL;
            int b, pos;
            if (latent) {
              b = row >> 12;
              pos = row & 4095;
            } else {
              b = (row - TL) >> 8;
              pos = (row - TL) & 255;
            }
            float v0 = acc[m][0][j], v1 = acc[m][1][j], v2 = acc[m][2][j], v3 = acc[m][3][j];
            if (latent && colbase < 640) {
              float2 cr = p->cs[(pos >> 6) * 16 + fr];
              float2 cc = p->cs[(pos & 63) * 16 + fr];
              float a = v0, bb = v1;
              v0 = a * cr.x - bb * cr.y;
              v1 = bb * cr.x + a * cr.y;
              a = v2;
              bb = v3;
              v2 = a * cc.x - bb * cc.y;
              v3 = bb * cc.x + a * cc.y;
            }
            bf16_t* o;
            if (colbase < 512 || colbase >= 768) {
              o = p->P + (size_t)row * 2048 + colbase + fr;
            } else {
              int kvh = (colbase - 512) >> 6;
              int kp = latent ? (CTX + pos) : pos;
              o = p->kbuf + ((size_t)(b * 2 + kvh) * KVLEN + kp) * 64 + fr;
            }
            o[0] = f2bf(v0);
            o[16] = f2bf(v1);
            o[32] = f2bf(v2);
            o[48] = f2bf(v3);
          }
      }
    }
  }
}

DEVI bf16x8 scale_q(uint4 u) {
  uint4 r;
  r.x = pack2(bflo(u.x) * 0.125f, bfhi(u.x) * 0.125f);
  r.y = pack2(bflo(u.y) * 0.125f, bfhi(u.y) * 0.125f);
  r.z = pack2(bflo(u.z) * 0.125f, bfhi(u.z) * 0.125f);
  r.w = pack2(bflo(u.w) * 0.125f, bfhi(u.w) * 0.125f);
  return __builtin_bit_cast(bf16x8, r);
}
DEVI void phase_attn(PP p, int layer, bool with_ctx_q) {
  const int tid = ltid();
  const int lane = tid & 63, wid = tid >> 6, r = lane & 31, h = lane >> 5;
  const float* sinkp = p->attn_sink + (layer >> 1) * 8;
  const int nunits = 2048 + (with_ctx_q ? 128 : 0);
  for (int u = lbid(); u < nunits; u += lnblk()) {
    bool latent = u < 2048;
    int b, kvh, qg, tokbase;
    if (latent) {
      b = u >> 8;
      kvh = (u >> 7) & 1;
      qg = u & 127;
      tokbase = b * SEQ + qg * 32;
    } else {
      int v = u - 2048;
      b = v >> 4;
      kvh = (v >> 3) & 1;
      qg = v & 7;
      tokbase = TL + b * CTX + qg * 32;
    }
    const int hd = kvh * 4 + wid;
    const bf16_t* kb = p->kbuf + (size_t)(b * 2 + kvh) * KVLEN * 64;
    const bf16_t* vt = p->vbuf + (size_t)(b * 2 + kvh) * 64 * KVLEN;
    bf16x8 qf[4];
    {
      const bf16_t* qp = p->P + (size_t)(tokbase + r) * 2048 + hd * 64 + 8 * h;
#pragma unroll
      for (int st = 0; st < 4; ++st) qf[st] = scale_q(*reinterpret_cast<const uint4*>(qp + 16 * st));
    }
    f32x16 O0, O1;
#pragma unroll
    for (int i = 0; i < 16; ++i) {
      O0[i] = 0.f;
      O1[i] = 0.f;
    }
    float m_run = sinkp[hd];
    float l_run = (h == 0) ? 1.f : 0.f;
    const int nkb = latent ? 17 : 8;
    for (int kbi = 0; kbi < nkb; ++kbi) {
      int kpos, mode = 0;
      if (kbi < 8) {
        kpos = kbi * 32;
      } else {
        int d = kbi - 12;
        int kblk = qg + d;
        if (kblk < 0 || kblk > 127) continue;
        kpos = CTX + kblk * 32;
        mode = (d == -4) ? 1 : ((d == 4) ? 2 : 0);
      }
      f32x16 S;
#pragma unroll
      for (int i = 0; i < 16; ++i) S[i] = 0.f;
#pragma unroll
      for (int st = 0; st < 4; ++st) {
        bf16x8 kf = *reinterpret_cast<const bf16x8*>(kb + (size_t)(kpos + r) * 64 + 16 * st + 8 * h);
        S = __builtin_amdgcn_mfma_f32_32x32x16_bf16(kf, qf[st], S, 0, 0, 0);
      }
      if (mode) {
#pragma unroll
        for (int i = 0; i < 16; ++i) {
          int kk = (i & 3) + 8 * (i >> 2) + 4 * h;
          bool ok = (mode == 1) ? (kk >= r) : (kk <= r);
          if (!ok) S[i] = -1e30f;
        }
      }
      float bm = S[0];
#pragma unroll
      for (int i = 1; i < 16; ++i) bm = fmaxf(bm, S[i]);
      bm = fmaxf(bm, __shfl_xor(bm, 32));
      float m_new = fmaxf(m_run, bm);
      float alpha = __expf(m_run - m_new);
      float psum = 0.f;
#pragma unroll
      for (int i = 0; i < 16; ++i) {
        S[i] = __expf(S[i] - m_new);
        psum += S[i];
      }
      l_run = l_run * alpha + psum;
      m_run = m_new;
#pragma unroll
      for (int i = 0; i < 16; ++i) {
        O0[i] *= alpha;
        O1[i] *= alpha;
      }
#pragma unroll
      for (int sidx = 0; sidx < 2; ++sidx) {
        uint4 pk;
        pk.x = pack2(S[8 * sidx + 0], S[8 * sidx + 1]);
        pk.y = pack2(S[8 * sidx + 2], S[8 * sidx + 3]);
        pk.z = pack2(S[8 * sidx + 4], S[8 * sidx + 5]);
        pk.w = pack2(S[8 * sidx + 6], S[8 * sidx + 7]);
        bf16x8 pf = __builtin_bit_cast(bf16x8, pk);
        bf16x8 v0 = *reinterpret_cast<const bf16x8*>(vt + (size_t)r * KVLEN + kpos + 16 * sidx + 8 * h);
        bf16x8 v1 = *reinterpret_cast<const bf16x8*>(vt + (size_t)(32 + r) * KVLEN + kpos + 16 * sidx + 8 * h);
        O0 = __builtin_amdgcn_mfma_f32_32x32x16_bf16(v0, pf, O0, 0, 0, 0);
        O1 = __builtin_amdgcn_mfma_f32_32x32x16_bf16(v1, pf, O1, 0, 0, 0);
      }
    }
    float l_tot = l_run + __shfl_xor(l_run, 32);
    float inv = 1.f / l_tot;
    bf16_t* op = p->mix + (size_t)(tokbase + r) * LDMIX + hd * 64 + 4 * h;
#pragma unroll
    for (int g4 = 0; g4 < 4; ++g4) {
      uint2 o;
      o.x = pack2(O0[4 * g4 + 0] * inv, O0[4 * g4 + 1] * inv);
      o.y = pack2(O0[4 * g4 + 2] * inv, O0[4 * g4 + 3] * inv);
      *reinterpret_cast<uint2*>(op + 8 * g4) = o;
      o.x = pack2(O1[4 * g4 + 0] * inv, O1[4 * g4 + 1] * inv);
      o.y = pack2(O1[4 * g4 + 2] * inv, O1[4 * g4 + 3] * inv);
      *reinterpret_cast<uint2*>(op + 32 + 8 * g4) = o;
    }
  }
}

DEVI void fill_tw(float2* tw, int n) {
  for (int i = ltid(); i < n; i += NTHREADS) {
    float sn, cn;
    sincospif(2.f * (float)i / (float)n, &sn, &cn);
    tw[i] = make_float2(cn, sn);
  }
  __syncthreads();
}

DEVI void phase_fft_a(PP p, unsigned char* lds) {
  float2* tw = reinterpret_cast<float2*>(lds);
  fill_tw(tw, 64);
  int tid = ltid();
  for (int u = lbid(); u < NB * 64; u += lnblk()) {
    int b = u >> 6, n2 = u & 63;
    for (int pass = 0; pass < 2; ++pass) {
      int ch = tid + pass * 256;
      float in[64];
#pragma unroll
      for (int n1 = 0; n1 < 64; ++n1) in[n1] = bf2f(p->P[(size_t)(b * SEQ + 64 * n1 + n2) * 2048 + 768 + ch]);
      for (int k1 = 0; k1 < 64; ++k1) {
        float re = 0.f, im = 0.f;
#pragma unroll
        for (int n1 = 0; n1 < 64; ++n1) {
          float2 t = tw[(n1 * k1) & 63];
          re += in[n1] * t.x;
          im -= in[n1] * t.y;
        }
        float sn, cn;
        sincospif((float)(n2 * k1) / 2048.f, &sn, &cn);
        float r2 = re * cn + im * sn;
        float i2 = im * cn - re * sn;
        bf16_t* o = p->fa + (size_t)(b * SEQ + k1 * 64 + n2) * 1024;
        o[ch] = f2bf(r2);
        o[512 + ch] = f2bf(i2);
      }
    }
  }
  __syncthreads();
}

DEVI void phase_fft_b(PP p, unsigned char* lds) {
  float2* tw = reinterpret_cast<float2*>(lds);
  fill_tw(tw, 64);
  int tid = ltid();
  const float scale = 0.0013810679320049757f;
  for (int u = lbid(); u < NB * 64; u += lnblk()) {
    int b = u >> 6, k1 = u & 63;
    for (int pass = 0; pass < 2; ++pass) {
      int ch = tid + pass * 256;
      unsigned in[64];
#pragma unroll
      for (int n2 = 0; n2 < 64; ++n2) {
        const bf16_t* s = p->fa + (size_t)(b * SEQ + k1 * 64 + n2) * 1024;
        in[n2] = (unsigned)s[ch] | ((unsigned)s[512 + ch] << 16);
      }
      for (int k2 = 0; k2 < 64; ++k2) {
        float zr = 0.f, zi = 0.f;
#pragma unroll
        for (int n2 = 0; n2 < 64; ++n2) {
          float2 t = tw[(n2 * k2) & 63];
          float mr = bflo(in[n2]), mi = bfhi(in[n2]);
          zr += mr * t.x + mi * t.y;
          zi += mi * t.x - mr * t.y;
        }
        bf16_t* o = p->mix + (size_t)(b * SEQ + k1 + 64 * k2) * LDMIX;
        o[512 + ch] = f2bf(zr * scale);
        o[1024 + ch] = f2bf(zi * scale);
      }
    }
  }
  __syncthreads();
}

DEVI void phase_dft_ctx(PP p, unsigned char* lds) {
  float2* tw = reinterpret_cast<float2*>(lds);
  fill_tw(tw, 256);
  int tid = ltid();
  const float scale = 0.005524271728019903f;
  for (int u = lbid(); u < NB * 16; u += lnblk()) {
    int b = u >> 4, k0 = (u & 15) * 16;
    for (int pass = 0; pass < 2; ++pass) {
      int ch = tid + pass * 256;
      float zr[16], zi[16];
#pragma unroll
      for (int kk = 0; kk < 16; ++kk) zr[kk] = zi[kk] = 0.f;
      for (int n = 0; n < 256; ++n) {
        float v = bf2f(p->P[(size_t)(TL + b * CTX + n) * 2048 + 768 + ch]);
#pragma unroll
        for (int kk = 0; kk < 16; ++kk) {
          float2 t = tw[(n * (k0 + kk)) & 255];
          zr[kk] += v * t.x;
          zi[kk] -= v * t.y;
        }
      }
#pragma unroll
      for (int kk = 0; kk < 16; ++kk) {
        bf16_t* o = p->mix + (size_t)(TL + b * CTX + k0 + kk) * LDMIX;
        o[512 + ch] = f2bf(zr[kk] * scale);
        o[1024 + ch] = f2bf(zi[kk] * scale);
      }
    }
  }
  __syncthreads();
}

DEVI void phase_sgu(PP p, int j, int nchunks, unsigned char* lds) {
  float* rs = reinterpret_cast<float*>(lds);
  float* part = rs + 128;
  const int tid = ltid();
  const int lane = tid & 63, wid = tid >> 6, fr = lane & 15, fq = lane >> 4;
  const float* nw = p->gs_norm_w + j * 1024;
  for (int chunk = lbid(); chunk < nchunks; chunk += lnblk()) {
    const int tok0 = chunk * 128;
    const bf16_t* vT = p->zvT + (size_t)chunk * 1024 * 128;
    {
      int q = tid & 127, hf = tid >> 7;
      float ss = 0.f;
      for (int ch = hf * 512; ch < hf * 512 + 512; ++ch) {
        float a = bf2f(vT[(size_t)ch * 128 + q]);
        ss += a * a;
      }
      part[tid] = ss;
      __syncthreads();
      if (tid < 128) rs[tid] = rsqrtf((part[tid] + part[tid + 128]) * (1.f / 1024.f) + 1e-6f);
      __syncthreads();
    }
    for (int g = 0; g < 8; ++g) {
      const float* wsg = p->gs_w_s + ((size_t)j * 8 + g) * 128 * 128;
      const float* bsg = p->gs_b_s + ((size_t)j * 8 + g) * 128;
      f32x4 acc[2][8];
#pragma unroll
      for (int m = 0; m < 2; ++m)
#pragma unroll
        for (int n = 0; n < 8; ++n) acc[m][n] = f32x4{0.f, 0.f, 0.f, 0.f};
#pragma unroll
      for (int ks = 0; ks < 4; ++ks) {
        bf16x8 a[2];
        const float* rsk = rs + 32 * ks + 8 * fq;
#pragma unroll
        for (int m = 0; m < 2; ++m) {
          const float4* wp = reinterpret_cast<const float4*>(wsg + (size_t)(32 * wid + 16 * m + fr) * 128 + 32 * ks + 8 * fq);
          float4 w0 = wp[0], w1 = wp[1];
          uint4 pk;
          pk.x = pack2(w0.x * rsk[0], w0.y * rsk[1]);
          pk.y = pack2(w0.z * rsk[2], w0.w * rsk[3]);
          pk.z = pack2(w1.x * rsk[4], w1.y * rsk[5]);
          pk.w = pack2(w1.z * rsk[6], w1.w * rsk[7]);
          a[m] = __builtin_bit_cast(bf16x8, pk);
        }
#pragma unroll
        for (int n = 0; n < 8; ++n) {
          bf16x8 bfr = *reinterpret_cast<const bf16x8*>(vT + (size_t)(g * 128 + 16 * n + fr) * 128 + 32 * ks + 8 * fq);
          acc[0][n] = __builtin_amdgcn_mfma_f32_16x16x32_bf16(a[0], bfr, acc[0][n], 0, 0, 0);
          acc[1][n] = __builtin_amdgcn_mfma_f32_16x16x32_bf16(a[1], bfr, acc[1][n], 0, 0, 0);
        }
      }
#pragma unroll
      for (int m = 0; m < 2; ++m)
#pragma unroll
        for (int jj = 0; jj < 4; ++jj) {
          int pp = 32 * wid + 16 * m + 4 * fq + jj;
          float bias = bsg[pp];
          const bf16_t* up = p->P + (size_t)(tok0 + pp) * 2048 + g * 128 + fr;
          bf16_t* op = p->mix + (size_t)(tok0 + pp) * LDMIX + g * 128 + fr;
#pragma unroll
          for (int n = 0; n < 8; ++n) {
            float sv = nw[g * 128 + 16 * n + fr] * acc[m][n][jj] + bias;
            op[16 * n] = f2bf(bf2f(up[16 * n]) * sv);
          }
        }
    }
    __syncthreads();
  }
}

DEVI unsigned sortable(float f) {
  unsigned b = __float_as_uint(f);
  return (b & 0x80000000u) ? ~b : (b | 0x80000000u);
}
DEVI float unsortable(unsigned u) {
  unsigned b = (u & 0x80000000u) ? (u & 0x7fffffffu) : ~u;
  return __uint_as_float(b);
}
#define INSERT16(list, x)                  \
  _Pragma("unroll") for (int i_ = 0; i_ < 16; ++i_) { \
    unsigned t_ = max(list[i_], x);        \
    x = min(list[i_], x);                  \
    list[i_] = t_;                         \
  }

DEVI void phase_route(PP p, int layer, int ntok, unsigned char* lds) {
  const int tid = ltid();
  const int lane = tid & 63, wid = tid >> 6, fr = lane & 15, fq = lane >> 4;
  unsigned* keys = reinterpret_cast<unsigned*>(lds);
  unsigned* ex = keys;
  unsigned* fin = keys + 128 * 17;
  const int nunits = (ntok / 64) * 8;
  for (int u = lbid(); u < nunits; u += lnblk()) {
    const int tt = u >> 3, hh = u & 7;
    const int tok0 = tt * 64;
#pragma unroll
    for (int half = 0; half < 2; ++half) {
      const bf16_t* qa = p->P + (size_t)(tok0 + wid * 16 + fr) * 2048 + hh * 256 + half * 128 + fq * 8;
      const bf16_t* kb = p->keysb + ((size_t)((layer * 8 + hh) * 2 + half) * 128) * 128 + fq * 8;
      bf16x8 a[4];
#pragma unroll
      for (int ks = 0; ks < 4; ++ks) a[ks] = *reinterpret_cast<const bf16x8*>(qa + ks * 32);
#pragma unroll
      for (int nf = 0; nf < 8; ++nf) {
        f32x4 acc = f32x4{0.f, 0.f, 0.f, 0.f};
#pragma unroll
        for (int ks = 0; ks < 4; ++ks) {
          bf16x8 bb = *reinterpret_cast<const bf16x8*>(kb + (size_t)(nf * 16 + fr) * 128 + ks * 32);
          acc = __builtin_amdgcn_mfma_f32_16x16x32_bf16(a[ks], bb, acc, 0, 0, 0);
        }
#pragma unroll
        for (int j = 0; j < 4; ++j) {
          int row = (wid * 16 + fq * 4 + j) * 2 + half;
          int kidx = nf * 16 + fr;
          keys[row * 129 + kidx] = (sortable(acc[j]) & ~127u) | (unsigned)kidx;
        }
      }
    }
    __syncthreads();
    const int row = tid & 127, part = tid >> 7;
    unsigned list[16];
#pragma unroll
    for (int i = 0; i < 16; ++i) list[i] = 0u;
    {
      const unsigned* kr = keys + row * 129 + part * 64;
#pragma unroll 4
      for (int e = 0; e < 64; ++e) {
        unsigned x = kr[e];
        INSERT16(list, x)
      }
    }
    __syncthreads();
    if (part == 1) {
#pragma unroll
      for (int i = 0; i < 16; ++i) ex[row * 17 + i] = list[i];
    }
    __syncthreads();
    if (part == 0) {
#pragma unroll
      for (int i = 0; i < 16; ++i) {
        unsigned x = ex[row * 17 + i];
        INSERT16(list, x)
      }
#pragma unroll
      for (int i = 0; i < 16; ++i) fin[row * 17 + i] = list[i];
    }
    __syncthreads();
    if (tid < 64) {
      const unsigned* f0 = fin + (2 * tid) * 17;
      const unsigned* f1 = fin + (2 * tid + 1) * 17;
      float v0[16], v1[16];
#pragma unroll
      for (int i = 0; i < 16; ++i) {
        v0[i] = unsortable(f0[i] & ~127u);
        v1[i] = unsortable(f1[i] & ~127u);
      }
      unsigned l2[16];
#pragma unroll
      for (int i = 0; i < 16; ++i) l2[i] = 0u;
#pragma unroll
      for (int a = 0; a < 16; ++a)
#pragma unroll
        for (int bq = 0; bq < 16; ++bq)
          if ((a + 1) * (bq + 1) <= 16) {
            unsigned x = (sortable(v0[a] + v1[bq]) & ~255u) | (unsigned)(a * 16 + bq);
            INSERT16(l2, x)
          }
      float sv[16];
      int ev[16];
      float mx = -3.0e38f;
#pragma unroll
      for (int k = 0; k < 16; ++k) {
        unsigned ab = l2[k] & 255u;
        unsigned k0 = f0[ab >> 4], k1 = f1[ab & 15u];
        sv[k] = unsortable(k0 & ~127u) + unsortable(k1 & ~127u);
        ev[k] = (int)((k0 & 127u) * 128u + (k1 & 127u));
        mx = fmaxf(mx, sv[k]);
      }
      float sum = 0.f;
#pragma unroll
      for (int k = 0; k < 16; ++k) {
        sv[k] = __expf(sv[k] - mx);
        sum += sv[k];
      }
      float inv = 1.f / sum;
      size_t o = (size_t)(tok0 + tid) * 128 + hh * 16;
      int4* eo = reinterpret_cast<int4*>(p->eidx + o);
      float4* go = reinterpret_cast<float4*>(p->gate + o);
#pragma unroll
      for (int k4 = 0; k4 < 4; ++k4) {
        eo[k4] = make_int4(ev[4 * k4], ev[4 * k4 + 1], ev[4 * k4 + 2], ev[4 * k4 + 3]);
        go[k4] = make_float4(sv[4 * k4] * inv, sv[4 * k4 + 1] * inv, sv[4 * k4 + 2] * inv, sv[4 * k4 + 3] * inv);
      }
    }
    __syncthreads();
  }
}

typedef float v2f __attribute__((ext_vector_type(2)));
template <int CTRL>
DEVI float dpp_mov(float v) {
  return __builtin_bit_cast(float, __builtin_amdgcn_mov_dpp(__builtin_bit_cast(int, v), CTRL, 0xF, 0xF, true));
}
DEVI void dec16(uint4 q, float* f) {
  v2f t;
  t = __builtin_amdgcn_cvt_pk_f32_fp8((int)q.x, false); f[0] = t.x; f[1] = t.y;
  t = __builtin_amdgcn_cvt_pk_f32_fp8((int)q.x, true);  f[2] = t.x; f[3] = t.y;
  t = __builtin_amdgcn_cvt_pk_f32_fp8((int)q.y, false); f[4] = t.x; f[5] = t.y;
  t = __builtin_amdgcn_cvt_pk_f32_fp8((int)q.y, true);  f[6] = t.x; f[7] = t.y;
  t = __builtin_amdgcn_cvt_pk_f32_fp8((int)q.z, false); f[8] = t.x; f[9] = t.y;
  t = __builtin_amdgcn_cvt_pk_f32_fp8((int)q.z, true);  f[10] = t.x; f[11] = t.y;
  t = __builtin_amdgcn_cvt_pk_f32_fp8((int)q.w, false); f[12] = t.x; f[13] = t.y;
  t = __builtin_amdgcn_cvt_pk_f32_fp8((int)q.w, true);  f[14] = t.x; f[15] = t.y;
}
DEVI void phase_expert(PP p, int layer, int ntok, unsigned char* lds, float gscale = 1.f) {
  const int tid = ltid();
  const int lane = tid & 63, wid = tid >> 6, j8 = lane & 7, grp = lane >> 3;
  const int nb = lnblk(), bid = lbid();
  unsigned short* ids = reinterpret_cast<unsigned short*>(lds);
  float* part = reinterpret_cast<float*>(lds + TPB * 128 * 2);
  const unsigned char* ut = p->utab + (size_t)layer * NEXP * D;
  const unsigned char* vt = p->vtab + (size_t)layer * NEXP * D;
  int tpb = (ntok + nb - 1) / nb;
  if (tpb > TPB) tpb = TPB;
  const int npass = (ntok + nb * tpb - 1) / (nb * tpb);
  for (int pass = 0; pass < npass; ++pass) {
    const int tok0 = (pass * nb + bid) * tpb;
    int cnt = ntok - tok0;
    if (cnt > tpb) cnt = tpb;
    if (cnt < 0) cnt = 0;
    for (int i = tid; i < cnt * 128; i += NTHREADS) {
      ids[i] = (unsigned short)p->eidx[(size_t)tok0 * 128 + i];
      part[i] = 0.f;
    }
    __syncthreads();
    for (int c = 0; c < 8; ++c) {
      for (int tl = wid; tl < cnt; tl += 4) {
        float xr[16];
        {
          const uint4* hp = reinterpret_cast<const uint4*>(p->h + (size_t)(tok0 + tl) * D + 128 * c + 16 * j8);
          uint4 h0 = hp[0], h1 = hp[1];
          xr[0] = bflo(h0.x); xr[1] = bfhi(h0.x); xr[2] = bflo(h0.y); xr[3] = bfhi(h0.y);
          xr[4] = bflo(h0.z); xr[5] = bfhi(h0.z); xr[6] = bflo(h0.w); xr[7] = bfhi(h0.w);
          xr[8] = bflo(h1.x); xr[9] = bfhi(h1.x); xr[10] = bflo(h1.y); xr[11] = bfhi(h1.y);
          xr[12] = bflo(h1.z); xr[13] = bfhi(h1.z); xr[14] = bflo(h1.w); xr[15] = bfhi(h1.w);
        }
        const unsigned short* idp = ids + tl * 128 + grp;
        const unsigned char* ub = ut + 128 * c + 16 * j8;
        uint4 q[16];
#pragma unroll
        for (int i = 0; i < 16; ++i) {
          int e = idp[8 * i];
          q[i] = *reinterpret_cast<const uint4*>(ub + (size_t)e * D);
        }
        float s0 = 0.f, s1 = 0.f;
#pragma unroll
        for (int i = 0; i < 16; ++i) {
          float f[16];
          dec16(q[i], f);
          float d = 0.f;
#pragma unroll
          for (int k = 0; k < 16; ++k) d += xr[k] * f[k];
          d += dpp_mov<0xB1>(d);
          d += dpp_mov<0x4E>(d);
          d += dpp_mov<0x141>(d);
          if (i < 8) s0 = (j8 == i) ? d : s0;
          else s1 = (j8 == i - 8) ? d : s1;
        }
        float* pp = part + tl * 128 + 8 * j8 + grp;
        pp[0] += s0;
        pp[64] += s1;
      }
    }
    __syncthreads();
    for (int i = tid; i < cnt * 128; i += NTHREADS)
      part[i] = p->gate[(size_t)tok0 * 128 + i] * gelu_tanh(part[i] * (1.f / USCALE));
    __syncthreads();
    for (int c = 0; c < 8; ++c) {
      for (int tl = wid; tl < cnt; tl += 4) {
        const unsigned short* idp = ids + tl * 128 + grp;
        const float* pp = part + tl * 128 + grp;
        const unsigned char* vb = vt + 128 * c + 16 * j8;
        float acc[16];
#pragma unroll
        for (int k = 0; k < 16; ++k) acc[k] = 0.f;
        uint4 q[16];
        float wv[16];
#pragma unroll
        for (int i = 0; i < 16; ++i) {
          int e = idp[8 * i];
          wv[i] = pp[8 * i];
          q[i] = *reinterpret_cast<const uint4*>(vb + (size_t)e * D);
        }
#pragma unroll
        for (int i = 0; i < 16; ++i) {
          float f[16];
          dec16(q[i], f);
#pragma unroll
          for (int k = 0; k < 16; ++k) acc[k] += wv[i] * f[k];
        }
#pragma unroll
        for (int k = 0; k < 16; ++k) {
          float a = acc[k];
          a += dpp_mov<0x128>(a);
          a += __shfl_xor(a, 16);
          a += __shfl_xor(a, 32);
          acc[k] = a;
        }
        if (grp == 0) {
          int tok = tok0 + tl;
          int b = tok_batch(tok);
          const float4* gf = reinterpret_cast<const float4*>(p->mod + ((size_t)layer * 9 + b) * 6144 + 5 * 1024 + 128 * c + 16 * j8);
          float4* xo = reinterpret_cast<float4*>(p->xs + (size_t)tok * D + 128 * c + 16 * j8);
          const float sc = gscale * (1.f / VSCALE);
#pragma unroll
          for (int i4 = 0; i4 < 4; ++i4) {
            float4 gq = gf[i4], xq = xo[i4];
            xq.x += sc * gq.x * acc[i4 * 4 + 0];
            xq.y += sc * gq.y * acc[i4 * 4 + 1];
            xq.z += sc * gq.z * acc[i4 * 4 + 2];
            xq.w += sc * gq.w * acc[i4 * 4 + 3];
            xo[i4] = xq;
          }
        }
      }
    }
    __syncthreads();
  }
}

DEVI bool step_active(int step) {
  if (step == 0 || step == NSTEPS - 1) return true;
  int layer = (step - 1) / STEPS_PER_LAYER, ph = (step - 1) % STEPS_PER_LAYER;
  if (ph == 3 && (layer & 1)) return false;
  return true;
}

DEVI void run_step(PP p, int step, unsigned char* lds, float gscale = 1.f) {
  if (step == 0) {
    phase_prep(p, lds);
    return;
  }
  if (step == NSTEPS - 1) {
    phase_norm(p, 0, 2, TL);
    return;
  }
  int layer = (step - 1) / STEPS_PER_LAYER, ph = (step - 1) % STEPS_PER_LAYER;
  bool even = (layer & 1) == 0;
  int j = layer >> 1;
  bool upd_ctx = layer < 2;
  bool need_ctx = layer < 3;
  int nt_in = need_ctx ? TT : TL;
  int nt = upd_ctx ? TT : TL;
  switch (ph) {
    case 0: phase_norm(p, layer, 0, nt_in); break;
    case 1:
      if (even)
        gemm_phase<EPI_INPROJ>(p, p->h, D, p->wt_in_ab + (size_t)j * 1280 * D, D, nt_in / 128, 10, D, layer, lds);
      else
        gemm_phase<EPI_GELU>(p, p->h, D, p->wt_in_gs + (size_t)j * 2048 * D, D, nt / 128, 16, D, layer, lds);
      break;
    case 2:
      if (even) {
        phase_fft_a(p, lds);
        if (upd_ctx) phase_dft_ctx(p, lds);
        phase_attn(p, layer, upd_ctx);
      } else {
        phase_sgu(p, j, nt / 128, lds);
      }
      break;
    case 3:
      if (even) phase_fft_b(p, lds);
      break;
    case 4:
      if (even)
        gemm_phase<EPI_RESID>(p, p->mix, LDMIX, p->wt_out_ab + (size_t)j * D * LDMIX, LDMIX, nt / 128, 8, LDMIX, layer, lds, gscale);
      else
        gemm_phase<EPI_RESID>(p, p->mix, LDMIX, p->wt_out_gs + (size_t)j * D * D, D, nt / 128, 8, D, layer, lds, gscale);
      break;
    case 5: phase_norm(p, layer, 1, nt); break;
    case 6: gemm_phase<EPI_STORE>(p, p->h, D, p->wt_q + (size_t)layer * 2048 * D, D, nt / 128, 16, D, layer, lds); break;
    case 7: phase_route(p, layer, nt, lds); break;
    case 8: phase_expert(p, layer, nt, lds, gscale); break;
  }
}

__global__ void __launch_bounds__(NTHREADS, 2) mega(Params p_unused, int step_lo, int step_hi) {
  __shared__ __attribute__((aligned(16))) unsigned char lds[LDS_BYTES];
  PP pp = (PP)__builtin_amdgcn_kernarg_segment_ptr();
  bool first = true;
  for (int s = step_lo; s < step_hi; ++s) {
    if (!step_active(s)) continue;
    if (!first) cg::this_grid().sync();
    first = false;
    PP q = pp;
    asm volatile("" : "+s"(q));
    run_step(q, s, lds);
#if REP_MASK
    if (s > 0 && s < NSTEPS - 1 && ((REP_MASK >> ((s - 1) % STEPS_PER_LAYER)) & 1)) {
      cg::this_grid().sync();
      PP q2 = pp;
      asm volatile("" : "+s"(q2));
      float z = 0.f;
      asm volatile("" : "+s"(z));
      run_step(q2, s, lds, z);
    }
#endif
  }
}

static size_t align_up(size_t v) { return (v + 255) & ~(size_t)255; }

extern "C" void kernel_launch(void* const* d_in, const int* in_sizes, int n_in, void* d_out, int out_size, void* d_ws,
                              size_t ws_size, hipStream_t stream) {
  Params p{};
  p.x = (const float*)d_in[0];
  p.c = (const float*)d_in[1];
  p.ctx = (const float*)d_in[2];
  p.c_ctx = (const float*)d_in[3];
  p.ada_w = (const float*)d_in[4];
  p.ada_b = (const float*)d_in[5];
  p.norm_mix_w = (const float*)d_in[6];
  p.norm_ffn_w = (const float*)d_in[7];
  p.ab_w_in = (const float*)d_in[8];
  p.ab_w_out = (const float*)d_in[9];
  p.attn_sink = (const float*)d_in[10];
  p.gs_w_in = (const float*)d_in[11];
  p.gs_norm_w = (const float*)d_in[12];
  p.gs_w_s = (const float*)d_in[13];
  p.gs_b_s = (const float*)d_in[14];
  p.gs_w_out = (const float*)d_in[15];
  p.peer_w_q = (const float*)d_in[16];
  p.peer_keys = (const float*)d_in[17];
  p.peer_u = (const float*)d_in[18];
  p.peer_v = (const float*)d_in[19];
  p.norm_out_w = (const float*)d_in[20];
  p.out = (float*)d_out;
  unsigned char* w = (unsigned char*)d_ws;
  size_t off = 0;
  auto take = [&](size_t bytes) {
    unsigned char* r = w + off;
    off = align_up(off + bytes);
    return r;
  };
  p.mod = (float*)take((size_t)DEPTH * 9 * 6144 * 4);
  p.cs = (float2*)take(64 * 16 * 8);
  p.xs = (float*)take((size_t)TT * D * 4);
  p.h = (bf16_t*)take((size_t)TT * D * 2);
  p.P = (bf16_t*)take((size_t)TT * 2048 * 2);
  p.kbuf = (bf16_t*)take((size_t)NB * 2 * KVLEN * 64 * 2);
  p.vbuf = (bf16_t*)take((size_t)NB * 2 * KVLEN * 64 * 2);
  p.zvT = (bf16_t*)take((size_t)TT * 1024 * 2);
  p.mix = (bf16_t*)take((size_t)TT * LDMIX * 2);
  p.fa = (bf16_t*)take((size_t)TL * 1024 * 2);
  p.eidx = (int*)take((size_t)TT * 128 * 4);
  p.gate = (float*)take((size_t)TT * 128 * 4);
  p.wt_in_ab = (bf16_t*)take((size_t)2 * 1280 * D * 2);
  p.wt_out_ab = (bf16_t*)take((size_t)2 * D * LDMIX * 2);
  p.wt_in_gs = (bf16_t*)take((size_t)2 * 2048 * D * 2);
  p.wt_out_gs = (bf16_t*)take((size_t)2 * D * D * 2);
  p.wt_q = (bf16_t*)take((size_t)DEPTH * 2048 * D * 2);
  p.keysb = (bf16_t*)take((size_t)DEPTH * 8 * 2 * 128 * 128 * 2);
  p.utab = (unsigned char*)take((size_t)DEPTH * NEXP * D);
  p.vtab = (unsigned char*)take((size_t)DEPTH * NEXP * D);
  if (off > ws_size) {
    fprintf(stderr, "workspace too small: need %zu have %zu\n", off, ws_size);
    return;
  }
  static int grid_blocks = 0;
  if (!grid_blocks) {
    int dev = 0, cus = 0, per_cu = 0;
    hipGetDevice(&dev);
    hipDeviceGetAttribute(&cus, hipDeviceAttributeMultiprocessorCount, dev);
    hipOccupancyMaxActiveBlocksPerMultiprocessor(&per_cu, mega, NTHREADS, 0);
    if (per_cu > 2) per_cu = 2;
    if (per_cu < 1) per_cu = 1;
    grid_blocks = cus * per_cu;
  }
#if ONE_LAUNCH
  int lo = 0, hi = NSTEPS;
  void* args[] = {&p, &lo, &hi};
  hipError_t e = hipLaunchCooperativeKernel((void*)mega, dim3(grid_blocks), dim3(NTHREADS), args, 0, stream);
  if (e != hipSuccess) fprintf(stderr, "cooperative launch failed: %s (grid %d)\n", hipGetErrorString(e), grid_blocks);
#else
  for (int s = 0; s < NSTEPS; ++s) {
    if (s != 0 && s != NSTEPS - 1) {
      int layer = (s - 1) / STEPS_PER_LAYER, ph = (s - 1) % STEPS_PER_LAYER;
      if (ph == 3 && (layer & 1)) continue;
    }
    hipLaunchKernelGGL(mega, dim3(grid_blocks), dim3(NTHREADS), 0, stream, p, s, s + 1);
  }
#endif
}
```

```cpp
#include <hip/hip_runtime.h>
#include <hip/hip_bf16.h>
#include <hip/hip_cooperative_groups.h>
#include <cstdio>
namespace cg = cooperative_groups;

#ifndef REP_MASK
#define REP_MASK 0
#endif
#ifndef ONE_LAUNCH
#define ONE_LAUNCH 1
#endif

#define DEVI __device__ __forceinline__
typedef unsigned short bf16_t;
using bf16x8 = __attribute__((ext_vector_type(8))) short;
using f32x4 = __attribute__((ext_vector_type(4))) float;
using f32x16 = __attribute__((ext_vector_type(16))) float;

constexpr int D = 1024, NB = 8, SEQ = 4096, CTX = 256, DEPTH = 4;
constexpr int TL = NB * SEQ, TC = NB * CTX, TT = TL + TC;
constexpr int KVLEN = CTX + SEQ;
constexpr int NEXP = 16384;
constexpr int LDMIX = 1536;
constexpr float USCALE = 64.f, VSCALE = 8.f;
constexpr int TPB = 68;
constexpr int LDS_BYTES = 68 * 1024;
constexpr int NTHREADS = 256;
constexpr int STEPS_PER_LAYER = 9;
constexpr int NSTEPS = 1 + DEPTH * STEPS_PER_LAYER + 1;

struct Params {
  const float *x, *c, *ctx, *c_ctx, *ada_w, *ada_b, *norm_mix_w, *norm_ffn_w, *ab_w_in, *ab_w_out, *attn_sink,
      *gs_w_in, *gs_norm_w, *gs_w_s, *gs_b_s, *gs_w_out, *peer_w_q, *peer_keys, *peer_u, *peer_v, *norm_out_w;
  float* out;
  float* mod;
  float2* cs;
  float* xs;
  bf16_t* h;
  bf16_t* P;
  bf16_t* kbuf;
  bf16_t* vbuf;
  float* rowss;
  bf16_t* zvT;
  bf16_t* mix;
  bf16_t* fa;
  unsigned* bar;
  int* eidx;
  float* gate;
  bf16_t *wt_in_ab, *wt_out_ab, *wt_in_gs, *wt_out_gs, *wt_q, *keysb;
  unsigned char *utab, *vtab;
};

typedef const __attribute__((address_space(4))) Params* PP;

DEVI int ltid() { int t = threadIdx.x; asm volatile("" : "+v"(t)); return t; }
DEVI int lbid() { int t = blockIdx.x; asm volatile("" : "+s"(t)); return t; }
DEVI int lnblk() { int t = gridDim.x; asm volatile("" : "+s"(t)); return t; }

DEVI bf16_t f2bf(float f) {
  unsigned u = __float_as_uint(f);
  u += 0x7fffu + ((u >> 16) & 1u);
  return (bf16_t)(u >> 16);
}
DEVI float bf2f(bf16_t h) { return __uint_as_float(((unsigned)h) << 16); }
DEVI float bflo(unsigned u) { return __uint_as_float(u << 16); }
DEVI float bfhi(unsigned u) { return __uint_as_float(u & 0xffff0000u); }
DEVI unsigned pack2(float a, float b) { return (unsigned)f2bf(a) | ((unsigned)f2bf(b) << 16); }
DEVI float wave_sum(float v) {
#pragma unroll
  for (int o = 32; o > 0; o >>= 1) v += __shfl_xor(v, o);
  return v;
}
DEVI float wave_max(float v) {
#pragma unroll
  for (int o = 32; o > 0; o >>= 1) v = fmaxf(v, __shfl_xor(v, o));
  return v;
}
DEVI float gelu_tanh(float x) {
  float u = 0.7978845608028654f * (x + 0.044715f * x * x * x);
  return 0.5f * x * (1.f + tanhf(u));
}
template <int CTRL>
DEVI float dpp_mov(float v) {
  return __builtin_bit_cast(float, __builtin_amdgcn_mov_dpp(__builtin_bit_cast(int, v), CTRL, 0xF, 0xF, true));
}
DEVI int tok_batch(int r) { return r < TL ? (r >> 12) : 8; }

DEVI void transpose_to_bf16(const float* __restrict__ src, int K, int N, bf16_t* __restrict__ dst, int ldk, float* tile) {
  int tilesN = N / 64, tiles = (K / 64) * tilesN;
  int tid = ltid();
  for (int t = lbid(); t < tiles; t += lnblk()) {
    int tk = t / tilesN, tn = t % tilesN;
#pragma unroll
    for (int i = 0; i < 16; ++i) {
      int r = (tid >> 6) + 4 * i;
      tile[r * 65 + (tid & 63)] = src[(size_t)(tk * 64 + r) * N + tn * 64 + (tid & 63)];
    }
    __syncthreads();
#pragma unroll
    for (int i = 0; i < 16; ++i) {
      int n = (tid >> 6) + 4 * i, k = tid & 63;
      dst[(size_t)(tn * 64 + n) * ldk + tk * 64 + k] = f2bf(tile[k * 65 + n]);
    }
    __syncthreads();
  }
}

DEVI void convert_bf16(const float* __restrict__ src, bf16_t* __restrict__ dst, size_t n) {
  size_t n4 = n / 4;
  size_t stride = (size_t)lnblk() * NTHREADS;
  for (size_t i = (size_t)lbid() * NTHREADS + ltid(); i < n4; i += stride) {
    float4 v = reinterpret_cast<const float4*>(src)[i];
    uint2 o;
    o.x = pack2(v.x, v.y);
    o.y = pack2(v.z, v.w);
    reinterpret_cast<uint2*>(dst)[i] = o;
  }
}

DEVI void convert_fp8(const float* __restrict__ src, unsigned char* __restrict__ dst, size_t n, float scale) {
  size_t n4 = n / 4;
  size_t stride = (size_t)lnblk() * NTHREADS;
  for (size_t i = (size_t)lbid() * NTHREADS + ltid(); i < n4; i += stride) {
    float4 v = reinterpret_cast<const float4*>(src)[i];
    int w = 0;
    w = __builtin_amdgcn_cvt_pk_fp8_f32(v.x * scale, v.y * scale, w, false);
    w = __builtin_amdgcn_cvt_pk_fp8_f32(v.z * scale, v.w * scale, w, true);
    reinterpret_cast<int*>(dst)[i] = w;
  }
}

DEVI void phase_prep(PP p, unsigned char* lds) {
  int tid = ltid();
  size_t gtid = (size_t)lbid() * NTHREADS + tid;
  size_t gstride = (size_t)lnblk() * NTHREADS;
  {
    const float4* s0 = reinterpret_cast<const float4*>(p->x);
    const float4* s1 = reinterpret_cast<const float4*>(p->ctx);
    float4* d = reinterpret_cast<float4*>(p->xs);
    size_t n0 = (size_t)TL * D / 4, n1 = (size_t)TC * D / 4;
    for (size_t i = gtid; i < n0; i += gstride) d[i] = s0[i];
    for (size_t i = gtid; i < n1; i += gstride) d[n0 + i] = s1[i];
  }
  convert_fp8(p->peer_u, p->utab, (size_t)DEPTH * NEXP * D, USCALE);
  convert_fp8(p->peer_v, p->vtab, (size_t)DEPTH * NEXP * D, VSCALE);
  convert_bf16(p->peer_keys, p->keysb, (size_t)DEPTH * 8 * 2 * 128 * 128);
  for (size_t i = gtid; i < 64 * 16; i += gstride) {
    int pos = (int)(i >> 4), k = (int)(i & 15);
    float inv = powf(10000.f, -(float)k / 16.f);
    float ang = (float)pos * inv;
    float sn, cn;
    sincosf(ang, &sn, &cn);
    p->cs[i] = make_float2(cn, sn);
  }
  float* tile = reinterpret_cast<float*>(lds);
  for (int j = 0; j < 2; ++j) {
    transpose_to_bf16(p->ab_w_in + (size_t)j * D * 1280, D, 1280, p->wt_in_ab + (size_t)j * 1280 * D, D, tile);
    transpose_to_bf16(p->gs_w_in + (size_t)j * D * 2048, D, 2048, p->wt_in_gs + (size_t)j * 2048 * D, D, tile);
    transpose_to_bf16(p->gs_w_out + (size_t)j * D * D, D, D, p->wt_out_gs + (size_t)j * D * D, D, tile);
    transpose_to_bf16(p->ab_w_out + (size_t)j * D * D, 512, D, p->wt_out_ab + (size_t)j * D * LDMIX, LDMIX, tile);
  }
  for (int i = 0; i < DEPTH; ++i)
    transpose_to_bf16(p->peer_w_q + (size_t)i * D * 2048, D, 2048, p->wt_q + (size_t)i * 2048 * D, D, tile);
  {
    float2* tw = reinterpret_cast<float2*>(lds) + 8192;
    if (tid < 128) {
      float sn, cn;
      sincospif((float)tid / 64.f, &sn, &cn);
      tw[tid] = make_float2(cn, sn);
    }
    __syncthreads();
    size_t total = (size_t)2 * 512 * 1024;
    for (size_t i = gtid; i < total; i += gstride) {
      int n = (int)(i & 1023);
      int gm = (int)((i >> 10) & 511);
      int j = (int)(i >> 19);
      int g = gm >> 7, m = gm & 127;
      const float* w = p->ab_w_out + (size_t)j * D * D + (size_t)(512 + g * 128) * D + n;
      float ar = 0.f, ai = 0.f;
      for (int l = 0; l < 128; ++l) {
        float2 t = tw[(m * l) & 127];
        float wv = w[(size_t)l * D];
        ar += t.x * wv;
        ai += t.y * wv;
      }
      bf16_t* dst = p->wt_out_ab + (size_t)j * D * LDMIX + (size_t)n * LDMIX;
      dst[512 + gm] = f2bf(ar);
      dst[1024 + gm] = f2bf(ai);
    }
    __syncthreads();
  }
  {
    float* sl = reinterpret_cast<float*>(lds);
    for (int i = tid; i < 9 * 1024; i += NTHREADS) {
      int r = i >> 10, k = i & 1023;
      float v = (r < 8) ? p->c[r * 1024 + k] : p->c_ctx[k];
      sl[i] = v / (1.f + __expf(-v));
    }
    __syncthreads();
    float* red = sl + 9 * 1024;
    int ks = tid >> 6, col = tid & 63;
    for (int u = lbid(); u < DEPTH * 96; u += lnblk()) {
      int layer = u / 96, c0 = (u % 96) * 64;
      const float* w = p->ada_w + (size_t)layer * D * 6144 + c0 + col;
      float acc[9];
#pragma unroll
      for (int r = 0; r < 9; ++r) acc[r] = 0.f;
      for (int k = ks * 256; k < ks * 256 + 256; ++k) {
        float wv = w[(size_t)k * 6144];
#pragma unroll
        for (int r = 0; r < 9; ++r) acc[r] += sl[r * 1024 + k] * wv;
      }
#pragma unroll
      for (int r = 0; r < 9; ++r) red[(ks * 9 + r) * 64 + col] = acc[r];
      __syncthreads();
      for (int i = tid; i < 9 * 64; i += NTHREADS) {
        int r = i >> 6, cc = i & 63;
        float s = red[(0 * 9 + r) * 64 + cc] + red[(1 * 9 + r) * 64 + cc] + red[(2 * 9 + r) * 64 + cc] +
                  red[(3 * 9 + r) * 64 + cc];
        s += p->ada_b[(size_t)layer * 6144 + c0 + cc];
        p->mod[((size_t)layer * 9 + r) * 6144 + c0 + cc] = s;
      }
      __syncthreads();
    }
  }
}

DEVI void phase_norm(PP p, int layer, int which, int ntok) {
  int lane = ltid() & 63;
  int gw = lbid() * 4 + (ltid() >> 6), nw = lnblk() * 4;
  const float* w = which == 0 ? p->norm_mix_w + layer * D : (which == 1 ? p->norm_ffn_w + layer * D : p->norm_out_w);
  for (int tok = gw; tok < ntok; tok += nw) {
    const float4* xr = reinterpret_cast<const float4*>(p->xs + (size_t)tok * D);
    float4 v[4];
    float ss = 0.f;
#pragma unroll
    for (int i = 0; i < 4; ++i) {
      v[i] = xr[lane + 64 * i];
      ss += v[i].x * v[i].x + v[i].y * v[i].y + v[i].z * v[i].z + v[i].w * v[i].w;
    }
    ss = wave_sum(ss);
    float rstd = rsqrtf(ss * (1.f / 1024.f) + 1e-6f);
    if (which == 2) {
      float4* o = reinterpret_cast<float4*>(p->out + (size_t)tok * D);
#pragma unroll
      for (int i = 0; i < 4; ++i) {
        float4 wv = reinterpret_cast<const float4*>(w)[lane + 64 * i];
        float4 r;
        r.x = v[i].x * rstd * wv.x;
        r.y = v[i].y * rstd * wv.y;
        r.z = v[i].z * rstd * wv.z;
        r.w = v[i].w * rstd * wv.w;
        o[lane + 64 * i] = r;
      }
    } else {
      int b = tok_batch(tok);
      const float* mb = p->mod + ((size_t)layer * 9 + b) * 6144 + (which == 0 ? 0 : 3072);
      uint2* o = reinterpret_cast<uint2*>(p->h + (size_t)tok * D);
#pragma unroll
      for (int i = 0; i < 4; ++i) {
        float4 wv = reinterpret_cast<const float4*>(w)[lane + 64 * i];
        float4 sh = reinterpret_cast<const float4*>(mb)[lane + 64 * i];
        float4 sc = reinterpret_cast<const float4*>(mb + 1024)[lane + 64 * i];
        float a0 = v[i].x * rstd * wv.x * (1.f + sc.x) + sh.x;
        float a1 = v[i].y * rstd * wv.y * (1.f + sc.y) + sh.y;
        float a2 = v[i].z * rstd * wv.z * (1.f + sc.z) + sh.z;
        float a3 = v[i].w * rstd * wv.w * (1.f + sc.w) + sh.w;
        uint2 r;
        r.x = pack2(a0, a1);
        r.y = pack2(a2, a3);
        o[lane + 64 * i] = r;
      }
    }
  }
}

enum { EPI_STORE = 0, EPI_GELU = 1, EPI_RESID = 2, EPI_INPROJ = 3 };

template <int EPI>
DEVI void gemm_phase(PP p, const bf16_t* __restrict__ A, int lda, const bf16_t* __restrict__ Bt, int ldb,
                     int Mtiles, int Ntiles, int K, int layer, unsigned char* lds, float gscale = 1.f) {
  const int tid = ltid();
  const int wid = tid >> 6, lane = tid & 63, wr = wid >> 1, wc = wid & 1, fr = lane & 15, fq = lane >> 4;
  int nblk = lnblk();
  int bid = lbid();
  int lb = ((nblk & 7) == 0) ? ((bid & 7) * (nblk >> 3) + (bid >> 3)) : bid;
  int ntiles = Mtiles * Ntiles;
  const int nk = K / 64;
  const int srow = tid >> 3;
  const int scol = ((tid & 7) ^ ((tid >> 3) & 7)) * 8;
  for (int t = lb; t < ntiles; t += nblk) {
    int tm = t / Ntiles, tn = t % Ntiles;
    int brow = tm * 128, bcol = tn * 128;
    f32x4 acc[4][4];
#pragma unroll
    for (int m = 0; m < 4; ++m)
#pragma unroll
      for (int n = 0; n < 4; ++n) acc[m][n] = f32x4{0.f, 0.f, 0.f, 0.f};
    const bf16_t* ga = A + (size_t)(brow + srow) * lda + scol;
    const bf16_t* gb = Bt + (size_t)(bcol + srow) * ldb + scol;
#define GEMM_STAGE(kt_, buf_)                                                                                         \
  {                                                                                                                   \
    _Pragma("unroll") for (int i_ = 0; i_ < 4; ++i_) {                                                                \
      __builtin_amdgcn_global_load_lds((const unsigned*)(ga + (size_t)(32 * i_) * lda + (kt_) * 64),                  \
                                       (__attribute__((address_space(3))) unsigned*)(lds + (buf_) * 32768 + tid * 16 + i_ * 4096), 16, 0, 0); \
      __builtin_amdgcn_global_load_lds((const unsigned*)(gb + (size_t)(32 * i_) * ldb + (kt_) * 64),                  \
                                       (__attribute__((address_space(3))) unsigned*)(lds + (buf_) * 32768 + 16384 + tid * 16 + i_ * 4096), 16, 0, 0); \
    }                                                                                                                 \
  }
    GEMM_STAGE(0, 0)
    for (int kt = 0; kt < nk; ++kt) {
      const int buf = kt & 1;
      asm volatile("s_waitcnt vmcnt(0)" ::: "memory");
      __syncthreads();
      if (kt + 1 < nk) GEMM_STAGE(kt + 1, buf ^ 1)
      const unsigned char* SA = lds + buf * 32768;
      const unsigned char* SB = SA + 16384;
      bf16x8 At[2][4], Bl[2][4];
#pragma unroll
      for (int ks = 0; ks < 2; ++ks)
#pragma unroll
        for (int m = 0; m < 4; ++m) {
          const int sl = ((ks * 4 + fq) ^ (fr & 7)) << 4;
          At[ks][m] = *reinterpret_cast<const bf16x8*>(SA + (wr * 64 + m * 16 + fr) * 128 + sl);
          Bl[ks][m] = *reinterpret_cast<const bf16x8*>(SB + (wc * 64 + m * 16 + fr) * 128 + sl);
        }
#pragma unroll
      for (int ks = 0; ks < 2; ++ks)
#pragma unroll
        for (int m = 0; m < 4; ++m)
#pragma unroll
          for (int n = 0; n < 4; ++n)
            acc[m][n] = __builtin_amdgcn_mfma_f32_16x16x32_bf16(At[ks][m], Bl[ks][n], acc[m][n], 0, 0, 0);
    }
    __syncthreads();
#undef GEMM_STAGE
    const int colbase = bcol + wc * 64;
    if constexpr (EPI == EPI_STORE || EPI == EPI_GELU) {
      if (EPI == EPI_GELU && colbase >= 1024) {
        float* rsp = p->rowss + ((size_t)tm * 16 + (tn - 8) * 2 + wc) * 128;
#pragma unroll
        for (int m = 0; m < 4; ++m) {
          float ssq[4] = {0.f, 0.f, 0.f, 0.f};
#pragma unroll
          for (int n = 0; n < 4; ++n) {
            int ch = colbase - 1024 + n * 16 + fr;
            int q0 = wr * 64 + m * 16 + fq * 4;
            float g0 = gelu_tanh(acc[m][n][0]), g1 = gelu_tanh(acc[m][n][1]), g2 = gelu_tanh(acc[m][n][2]), g3 = gelu_tanh(acc[m][n][3]);
            ssq[0] += g0 * g0;
            ssq[1] += g1 * g1;
            ssq[2] += g2 * g2;
            ssq[3] += g3 * g3;
            uint2 o;
            o.x = pack2(g0, g1);
            o.y = pack2(g2, g3);
            *reinterpret_cast<uint2*>(p->zvT + ((size_t)tm * 1024 + ch) * 128 + q0) = o;
          }
#pragma unroll
          for (int j = 0; j < 4; ++j) {
            float v = ssq[j];
            v += dpp_mov<0xB1>(v);
            v += dpp_mov<0x4E>(v);
            v += dpp_mov<0x141>(v);
            v += dpp_mov<0x140>(v);
            if (fr == 0) rsp[wr * 64 + m * 16 + fq * 4 + j] = v;
          }
        }
      } else {
#pragma unroll
        for (int m = 0; m < 4; ++m)
#pragma unroll
          for (int j = 0; j < 4; ++j) {
            int row = brow + wr * 64 + m * 16 + fq * 4 + j;
            bf16_t* o = p->P + (size_t)row * 2048 + colbase + fr;
#pragma unroll
            for (int n = 0; n < 4; ++n) {
              float v = acc[m][n][j];
              if (EPI == EPI_GELU) v = gelu_tanh(v);
              o[n * 16] = f2bf(v);
            }
          }
      }
    } else if constexpr (EPI == EPI_RESID) {
#pragma unroll
      for (int m = 0; m < 4; ++m)
#pragma unroll
        for (int j = 0; j < 4; ++j) {
          int row = brow + wr * 64 + m * 16 + fq * 4 + j;
          int b = tok_batch(row);
          const float* g = p->mod + ((size_t)layer * 9 + b) * 6144 + 2048 + colbase + fr;
          float* o = p->xs + (size_t)row * D + colbase + fr;
#pragma unroll
          for (int n = 0; n < 4; ++n) o[n * 16] += gscale * g[n * 16] * acc[m][n][j];
        }
    } else if constexpr (EPI == EPI_INPROJ) {
      if (colbase >= 640 && colbase < 768) {
        int kvh = (colbase - 640) >> 6;
#pragma unroll
        for (int m = 0; m < 4; ++m) {
          int row0 = brow + wr * 64 + m * 16;
          bool latent = row0 < TL;
          int b = latent ? (row0 >> 12) : ((row0 - TL) >> 8);
          int kp16 = latent ? (CTX + (row0 & 4095)) : ((row0 - TL) & 255);
          int slot = kp16 + 8 * (fq & 1) + 4 * (fq >> 1);
#pragma unroll
          for (int n = 0; n < 4; ++n) {
            int dim = n * 16 + fr;
            uint2 o;
            o.x = pack2(acc[m][n][0], acc[m][n][1]);
            o.y = pack2(acc[m][n][2], acc[m][n][3]);
            *reinterpret_cast<uint2*>(p->vbuf + ((size_t)(b * 2 + kvh) * 64 + dim) * KVLEN + slot) = o;
          }
        }
      } else {
#pragma unroll
        for (int m = 0; m < 4; ++m)
#pragma unroll
          for (int j = 0; j < 4; ++j) {
            int row = brow + wr * 64 + m * 16 + fq * 4 + j;
            bool latent = row < TL;
            int b, pos;
            if (latent) {
              b = row >> 12;
              pos = row & 4095;
            } else {
              b = (row - TL) >> 8;
              pos = (row - TL) & 255;
            }
            float v0 = acc[m][0][j], v1 = acc[m][1][j], v2 = acc[m][2][j], v3 = acc[m][3][j];
            if (latent && colbase < 640) {
              float2 cr = p->cs[(pos >> 6) * 16 + fr];
              float2 cc = p->cs[(pos & 63) * 16 + fr];
              float a = v0, bb = v1;
              v0 = a * cr.x - bb * cr.y;
              v1 = bb * cr.x + a * cr.y;
              a = v2;
              bb = v3;
              v2 = a * cc.x - bb * cc.y;
              v3 = bb * cc.x + a * cc.y;
            }
            bf16_t* o;
            if (colbase < 512 || colbase >= 768) {
              o = p->P + (size_t)row * 2048 + colbase + fr;
            } else {
              int kvh = (colbase - 512) >> 6;
              int kp = latent ? (CTX + pos) : pos;
              o = p->kbuf + ((size_t)(b * 2 + kvh) * KVLEN + kp) * 64 + fr;
            }
            o[0] = f2bf(v0);
            o[16] = f2bf(v1);
            o[32] = f2bf(v2);
            o[48] = f2bf(v3);
          }
      }
    }
  }
}

DEVI bf16x8 scale_q(uint4 u) {
  uint4 r;
  r.x = pack2(bflo(u.x) * 0.125f, bfhi(u.x) * 0.125f);
  r.y = pack2(bflo(u.y) * 0.125f, bfhi(u.y) * 0.125f);
  r.z = pack2(bflo(u.z) * 0.125f, bfhi(u.z) * 0.125f);
  r.w = pack2(bflo(u.w) * 0.125f, bfhi(u.w) * 0.125f);
  return __builtin_bit_cast(bf16x8, r);
}
DEVI void phase_attn(PP p, int layer, bool with_ctx_q) {
  const int tid = ltid();
  const int lane = tid & 63, wid = tid >> 6, r = lane & 31, h = lane >> 5;
  const float* sinkp = p->attn_sink + (layer >> 1) * 8;
  const int nunits = 2048 + (with_ctx_q ? 128 : 0);
  for (int u = lbid(); u < nunits; u += lnblk()) {
    bool latent = u < 2048;
    int b, kvh, qg, tokbase;
    if (latent) {
      b = u >> 8;
      kvh = (u >> 7) & 1;
      qg = u & 127;
      tokbase = b * SEQ + qg * 32;
    } else {
      int v = u - 2048;
      b = v >> 4;
      kvh = (v >> 3) & 1;
      qg = v & 7;
      tokbase = TL + b * CTX + qg * 32;
    }
    const int hd = kvh * 4 + wid;
    const bf16_t* kb = p->kbuf + (size_t)(b * 2 + kvh) * KVLEN * 64;
    const bf16_t* vt = p->vbuf + (size_t)(b * 2 + kvh) * 64 * KVLEN;
    bf16x8 qf[4];
    {
      const bf16_t* qp = p->P + (size_t)(tokbase + r) * 2048 + hd * 64 + 8 * h;
#pragma unroll
      for (int st = 0; st < 4; ++st) qf[st] = scale_q(*reinterpret_cast<const uint4*>(qp + 16 * st));
    }
    f32x16 O0, O1;
#pragma unroll
    for (int i = 0; i < 16; ++i) {
      O0[i] = 0.f;
      O1[i] = 0.f;
    }
    float m_run = sinkp[hd];
    float l_run = (h == 0) ? 1.f : 0.f;
    const int nkb = latent ? 17 : 8;
    for (int kbi = 0; kbi < nkb; ++kbi) {
      int kpos, mode = 0;
      if (kbi < 8) {
        kpos = kbi * 32;
      } else {
        int d = kbi - 12;
        int kblk = qg + d;
        if (kblk < 0 || kblk > 127) continue;
        kpos = CTX + kblk * 32;
        mode = (d == -4) ? 1 : ((d == 4) ? 2 : 0);
      }
      f32x16 S;
#pragma unroll
      for (int i = 0; i < 16; ++i) S[i] = 0.f;
#pragma unroll
      for (int st = 0; st < 4; ++st) {
        bf16x8 kf = *reinterpret_cast<const bf16x8*>(kb + (size_t)(kpos + r) * 64 + 16 * st + 8 * h);
        S = __builtin_amdgcn_mfma_f32_32x32x16_bf16(kf, qf[st], S, 0, 0, 0);
      }
      if (mode) {
#pragma unroll
        for (int i = 0; i < 16; ++i) {
          int kk = (i & 3) + 8 * (i >> 2) + 4 * h;
          bool ok = (mode == 1) ? (kk >= r) : (kk <= r);
          if (!ok) S[i] = -1e30f;
        }
      }
      float bm = S[0];
#pragma unroll
      for (int i = 1; i < 16; ++i) bm = fmaxf(bm, S[i]);
      bm = fmaxf(bm, __shfl_xor(bm, 32));
      float m_new = fmaxf(m_run, bm);
      float alpha = __expf(m_run - m_new);
      float psum = 0.f;
#pragma unroll
      for (int i = 0; i < 16; ++i) {
        S[i] = __expf(S[i] - m_new);
        psum += S[i];
      }
      l_run = l_run * alpha + psum;
      m_run = m_new;
#pragma unroll
      for (int i = 0; i < 16; ++i) {
        O0[i] *= alpha;
        O1[i] *= alpha;
      }
#pragma unroll
      for (int sidx = 0; sidx < 2; ++sidx) {
        uint4 pk;
        pk.x = pack2(S[8 * sidx + 0], S[8 * sidx + 1]);
        pk.y = pack2(S[8 * sidx + 2], S[8 * sidx + 3]);
        pk.z = pack2(S[8 * sidx + 4], S[8 * sidx + 5]);
        pk.w = pack2(S[8 * sidx + 6], S[8 * sidx + 7]);
        bf16x8 pf = __builtin_bit_cast(bf16x8, pk);
        bf16x8 v0 = *reinterpret_cast<const bf16x8*>(vt + (size_t)r * KVLEN + kpos + 16 * sidx + 8 * h);
        bf16x8 v1 = *reinterpret_cast<const bf16x8*>(vt + (size_t)(32 + r) * KVLEN + kpos + 16 * sidx + 8 * h);
        O0 = __builtin_amdgcn_mfma_f32_32x32x16_bf16(v0, pf, O0, 0, 0, 0);
        O1 = __builtin_amdgcn_mfma_f32_32x32x16_bf16(v1, pf, O1, 0, 0, 0);
      }
    }
    float l_tot = l_run + __shfl_xor(l_run, 32);
    float inv = 1.f / l_tot;
    bf16_t* op = p->mix + (size_t)(tokbase + r) * LDMIX + hd * 64 + 4 * h;
#pragma unroll
    for (int g4 = 0; g4 < 4; ++g4) {
      uint2 o;
      o.x = pack2(O0[4 * g4 + 0] * inv, O0[4 * g4 + 1] * inv);
      o.y = pack2(O0[4 * g4 + 2] * inv, O0[4 * g4 + 3] * inv);
      *reinterpret_cast<uint2*>(op + 8 * g4) = o;
      o.x = pack2(O1[4 * g4 + 0] * inv, O1[4 * g4 + 1] * inv);
      o.y = pack2(O1[4 * g4 + 2] * inv, O1[4 * g4 + 3] * inv);
      *reinterpret_cast<uint2*>(op + 32 + 8 * g4) = o;
    }
  }
}

DEVI void fill_tw(float2* tw, int n) {
  for (int i = ltid(); i < n; i += NTHREADS) {
    float sn, cn;
    sincospif(2.f * (float)i / (float)n, &sn, &cn);
    tw[i] = make_float2(cn, sn);
  }
  __syncthreads();
}

DEVI bf16x8 lds_col8(const bf16_t* bp, int stride) {
  unsigned e0 = bp[0], e1 = bp[stride], e2 = bp[2 * stride], e3 = bp[3 * stride];
  unsigned e4 = bp[4 * stride], e5 = bp[5 * stride], e6 = bp[6 * stride], e7 = bp[7 * stride];
  uint4 pk;
  pk.x = e0 | (e1 << 16);
  pk.y = e2 | (e3 << 16);
  pk.z = e4 | (e5 << 16);
  pk.w = e6 | (e7 << 16);
  return __builtin_bit_cast(bf16x8, pk);
}

DEVI void phase_fft_a(PP p, unsigned char* lds) {
  const int tid = ltid();
  const int lane = tid & 63, wid = tid >> 6, fr = lane & 15, fq = lane >> 4;
  float2* tw = reinterpret_cast<float2*>(lds + 66560);
  fill_tw(tw, 64);
  bf16x8 af[2][2];
#pragma unroll
  for (int ks = 0; ks < 2; ++ks) {
    unsigned short cr[8], ci[8];
#pragma unroll
    for (int j = 0; j < 8; ++j) {
      int n1 = 32 * ks + 8 * fq + j, k1 = 16 * wid + fr;
      float2 t = tw[(k1 * n1) & 63];
      cr[j] = f2bf(t.x);
      ci[j] = f2bf(-t.y);
    }
    uint4 a0, a1;
    a0.x = cr[0] | ((unsigned)cr[1] << 16); a0.y = cr[2] | ((unsigned)cr[3] << 16);
    a0.z = cr[4] | ((unsigned)cr[5] << 16); a0.w = cr[6] | ((unsigned)cr[7] << 16);
    a1.x = ci[0] | ((unsigned)ci[1] << 16); a1.y = ci[2] | ((unsigned)ci[3] << 16);
    a1.z = ci[4] | ((unsigned)ci[5] << 16); a1.w = ci[6] | ((unsigned)ci[7] << 16);
    af[0][ks] = __builtin_bit_cast(bf16x8, a0);
    af[1][ks] = __builtin_bit_cast(bf16x8, a1);
  }
  const bf16_t* l16 = reinterpret_cast<const bf16_t*>(lds);
  for (int u = lbid(); u < NB * 64; u += lnblk()) {
    int b = u >> 6, n2 = u & 63;
    __syncthreads();
#pragma unroll
    for (int i = 0; i < 16; ++i) {
      int row = (tid >> 6) + 4 * i, piece = tid & 63;
      uint4 v = *reinterpret_cast<const uint4*>(p->P + (size_t)(b * SEQ + 64 * row + n2) * 2048 + 768 + piece * 8);
      *reinterpret_cast<uint4*>(lds + row * 1040 + piece * 16) = v;
    }
    __syncthreads();
    float tc[4], ts[4];
#pragma unroll
    for (int j = 0; j < 4; ++j) sincospif((float)(n2 * (16 * wid + 4 * fq + j)) / 2048.f, &ts[j], &tc[j]);
    for (int nb = 0; nb < 4; ++nb) {
      f32x4 acc[2][8];
#pragma unroll
      for (int n = 0; n < 8; ++n) {
        acc[0][n] = f32x4{0.f, 0.f, 0.f, 0.f};
        acc[1][n] = f32x4{0.f, 0.f, 0.f, 0.f};
      }
#pragma unroll
      for (int ks = 0; ks < 2; ++ks)
#pragma unroll
        for (int nf = 0; nf < 8; ++nf) {
          bf16x8 bfr = lds_col8(l16 + (32 * ks + 8 * fq) * 520 + 128 * nb + 16 * nf + fr, 520);
          acc[0][nf] = __builtin_amdgcn_mfma_f32_16x16x32_bf16(af[0][ks], bfr, acc[0][nf], 0, 0, 0);
          acc[1][nf] = __builtin_amdgcn_mfma_f32_16x16x32_bf16(af[1][ks], bfr, acc[1][nf], 0, 0, 0);
        }
#pragma unroll
      for (int j = 0; j < 4; ++j) {
        int k1 = 16 * wid + 4 * fq + j;
        bf16_t* o = p->fa + (size_t)(b * SEQ + k1 * 64 + n2) * 1024 + 128 * nb + fr;
#pragma unroll
        for (int nf = 0; nf < 8; ++nf) {
          float re = acc[0][nf][j], im = acc[1][nf][j];
          o[16 * nf] = f2bf(re * tc[j] + im * ts[j]);
          o[512 + 16 * nf] = f2bf(im * tc[j] - re * ts[j]);
        }
      }
    }
  }
  __syncthreads();
}

DEVI void phase_fft_b(PP p, unsigned char* lds) {
  const int tid = ltid();
  const int lane = tid & 63, wid = tid >> 6, fr = lane & 15, fq = lane >> 4;
  float2* tw = reinterpret_cast<float2*>(lds + 67584);
  fill_tw(tw, 64);
  bf16x8 wb[2][4];
#pragma unroll
  for (int ks = 0; ks < 4; ++ks) {
    unsigned short zr[8], zi[8];
#pragma unroll
    for (int j = 0; j < 8; ++j) {
      int k = 32 * ks + 8 * fq + j, part = k >> 6, n2 = k & 63, k2 = 16 * wid + fr;
      float2 t = tw[(k2 * n2) & 63];
      zr[j] = f2bf(part ? t.y : t.x);
      zi[j] = f2bf(part ? t.x : -t.y);
    }
    uint4 a0, a1;
    a0.x = zr[0] | ((unsigned)zr[1] << 16); a0.y = zr[2] | ((unsigned)zr[3] << 16);
    a0.z = zr[4] | ((unsigned)zr[5] << 16); a0.w = zr[6] | ((unsigned)zr[7] << 16);
    a1.x = zi[0] | ((unsigned)zi[1] << 16); a1.y = zi[2] | ((unsigned)zi[3] << 16);
    a1.z = zi[4] | ((unsigned)zi[5] << 16); a1.w = zi[6] | ((unsigned)zi[7] << 16);
    wb[0][ks] = __builtin_bit_cast(bf16x8, a0);
    wb[1][ks] = __builtin_bit_cast(bf16x8, a1);
  }
  const bf16_t* l16 = reinterpret_cast<const bf16_t*>(lds);
  const float scale = 0.0013810679320049757f;
  for (int u = lbid(); u < NB * 128; u += lnblk()) {
    int b = u >> 7, k1 = (u >> 1) & 63, hf = u & 1;
    __syncthreads();
#pragma unroll
    for (int i = 0; i < 16; ++i) {
      int row = (tid >> 5) + 8 * i, piece = tid & 31;
      int part = row >> 6, n2 = row & 63;
      uint4 v = *reinterpret_cast<const uint4*>(p->fa + (size_t)(b * SEQ + k1 * 64 + n2) * 1024 + part * 512 + hf * 256 + piece * 8);
      *reinterpret_cast<uint4*>(lds + row * 528 + piece * 16) = v;
    }
    __syncthreads();
    for (int nb = 0; nb < 2; ++nb) {
      f32x4 acc[2][8];
#pragma unroll
      for (int n = 0; n < 8; ++n) {
        acc[0][n] = f32x4{0.f, 0.f, 0.f, 0.f};
        acc[1][n] = f32x4{0.f, 0.f, 0.f, 0.f};
      }
#pragma unroll
      for (int ks = 0; ks < 4; ++ks)
#pragma unroll
        for (int nf = 0; nf < 8; ++nf) {
          bf16x8 bfr = lds_col8(l16 + (32 * ks + 8 * fq) * 264 + 128 * nb + 16 * nf + fr, 264);
          acc[0][nf] = __builtin_amdgcn_mfma_f32_16x16x32_bf16(wb[0][ks], bfr, acc[0][nf], 0, 0, 0);
          acc[1][nf] = __builtin_amdgcn_mfma_f32_16x16x32_bf16(wb[1][ks], bfr, acc[1][nf], 0, 0, 0);
        }
#pragma unroll
      for (int j = 0; j < 4; ++j) {
        int k2 = 16 * wid + 4 * fq + j;
        bf16_t* o = p->mix + (size_t)(b * SEQ + k1 + 64 * k2) * LDMIX + 512 + hf * 256 + 128 * nb + fr;
#pragma unroll
        for (int nf = 0; nf < 8; ++nf) {
          o[16 * nf] = f2bf(acc[0][nf][j] * scale);
          o[512 + 16 * nf] = f2bf(acc[1][nf][j] * scale);
        }
      }
    }
  }
  __syncthreads();
}

DEVI void phase_dft_ctx(PP p, unsigned char* lds) {
  float2* tw = reinterpret_cast<float2*>(lds);
  fill_tw(tw, 256);
  int tid = ltid();
  const float scale = 0.005524271728019903f;
  for (int u = lbid(); u < NB * 16; u += lnblk()) {
    int b = u >> 4, k0 = (u & 15) * 16;
    for (int pass = 0; pass < 2; ++pass) {
      int ch = tid + pass * 256;
      float zr[16], zi[16];
#pragma unroll
      for (int kk = 0; kk < 16; ++kk) zr[kk] = zi[kk] = 0.f;
      for (int n = 0; n < 256; ++n) {
        float v = bf2f(p->P[(size_t)(TL + b * CTX + n) * 2048 + 768 + ch]);
#pragma unroll
        for (int kk = 0; kk < 16; ++kk) {
          float2 t = tw[(n * (k0 + kk)) & 255];
          zr[kk] += v * t.x;
          zi[kk] -= v * t.y;
        }
      }
#pragma unroll
      for (int kk = 0; kk < 16; ++kk) {
        bf16_t* o = p->mix + (size_t)(TL + b * CTX + k0 + kk) * LDMIX;
        o[512 + ch] = f2bf(zr[kk] * scale);
        o[1024 + ch] = f2bf(zi[kk] * scale);
      }
    }
  }
  __syncthreads();
}

DEVI void phase_sgu(PP p, int j, int nchunks, unsigned char* lds) {
  float* rs = reinterpret_cast<float*>(lds);
  const int tid = ltid();
  const int lane = tid & 63, wid = tid >> 6, fr = lane & 15, fq = lane >> 4;
  const float* nw = p->gs_norm_w + j * 1024;
  for (int u = lbid(); u < nchunks * 8; u += lnblk()) {
    const int chunk = u >> 3, g = u & 7;
    const int tok0 = chunk * 128;
    const bf16_t* vT = p->zvT + (size_t)chunk * 1024 * 128;
    if (tid < 128) {
      const float* rp = p->rowss + (size_t)chunk * 16 * 128 + tid;
      float ss = 0.f;
#pragma unroll
      for (int sl = 0; sl < 16; ++sl) ss += rp[sl * 128];
      rs[tid] = rsqrtf(ss * (1.f / 1024.f) + 1e-6f);
    }
    __syncthreads();
    const float* wsg = p->gs_w_s + ((size_t)j * 8 + g) * 128 * 128;
    const float* bsg = p->gs_b_s + ((size_t)j * 8 + g) * 128;
    f32x4 acc[2][8];
#pragma unroll
    for (int m = 0; m < 2; ++m)
#pragma unroll
      for (int n = 0; n < 8; ++n) acc[m][n] = f32x4{0.f, 0.f, 0.f, 0.f};
#pragma unroll
    for (int ks = 0; ks < 4; ++ks) {
      bf16x8 a[2];
      const float* rsk = rs + 32 * ks + 8 * fq;
#pragma unroll
      for (int m = 0; m < 2; ++m) {
        const float4* wp = reinterpret_cast<const float4*>(wsg + (size_t)(32 * wid + 16 * m + fr) * 128 + 32 * ks + 8 * fq);
        float4 w0 = wp[0], w1 = wp[1];
        uint4 pk;
        pk.x = pack2(w0.x * rsk[0], w0.y * rsk[1]);
        pk.y = pack2(w0.z * rsk[2], w0.w * rsk[3]);
        pk.z = pack2(w1.x * rsk[4], w1.y * rsk[5]);
        pk.w = pack2(w1.z * rsk[6], w1.w * rsk[7]);
        a[m] = __builtin_bit_cast(bf16x8, pk);
      }
#pragma unroll
      for (int n = 0; n < 8; ++n) {
        bf16x8 bfr = *reinterpret_cast<const bf16x8*>(vT + (size_t)(g * 128 + 16 * n + fr) * 128 + 32 * ks + 8 * fq);
        acc[0][n] = __builtin_amdgcn_mfma_f32_16x16x32_bf16(a[0], bfr, acc[0][n], 0, 0, 0);
        acc[1][n] = __builtin_amdgcn_mfma_f32_16x16x32_bf16(a[1], bfr, acc[1][n], 0, 0, 0);
      }
    }
#pragma unroll
    for (int m = 0; m < 2; ++m)
#pragma unroll
      for (int jj = 0; jj < 4; ++jj) {
        int pp = 32 * wid + 16 * m + 4 * fq + jj;
        float bias = bsg[pp];
        const bf16_t* up = p->P + (size_t)(tok0 + pp) * 2048 + g * 128 + fr;
        bf16_t* op = p->mix + (size_t)(tok0 + pp) * LDMIX + g * 128 + fr;
#pragma unroll
        for (int n = 0; n < 8; ++n) {
          float sv = nw[g * 128 + 16 * n + fr] * acc[m][n][jj] + bias;
          op[16 * n] = f2bf(bf2f(up[16 * n]) * sv);
        }
      }
    __syncthreads();
  }
}

DEVI float mkkey(float v, unsigned idx, unsigned mask) { return __uint_as_float((__float_as_uint(v) & ~mask) | idx); }
#define INSERT16(list, x)                                                                                               \
  {                                                                                                                     \
    _Pragma("unroll") for (int i_ = 15; i_ >= 1; --i_) list[i_] = __builtin_amdgcn_fmed3f(list[i_ - 1], list[i_], x); \
    list[0] = fmaxf(list[0], x);                                                                                        \
  }

DEVI void phase_route(PP p, int layer, int ntok, unsigned char* lds) {
  const int tid = ltid();
  const int lane = tid & 63, wid = tid >> 6, fr = lane & 15, fq = lane >> 4;
  float* keys = reinterpret_cast<float*>(lds);
  float* ex = keys;
  float* fin = keys + 128 * 17;
  const int nunits = (ntok / 64) * 8;
  const float NEGK = -3.0e38f;
  for (int u = lbid(); u < nunits; u += lnblk()) {
    const int tt = u >> 3, hh = u & 7;
    const int tok0 = tt * 64;
#pragma unroll
    for (int half = 0; half < 2; ++half) {
      const bf16_t* qa = p->P + (size_t)(tok0 + wid * 16 + fr) * 2048 + hh * 256 + half * 128 + fq * 8;
      const bf16_t* kb = p->keysb + ((size_t)((layer * 8 + hh) * 2 + half) * 128) * 128 + fq * 8;
      bf16x8 a[4];
#pragma unroll
      for (int ks = 0; ks < 4; ++ks) a[ks] = *reinterpret_cast<const bf16x8*>(qa + ks * 32);
#pragma unroll
      for (int nf = 0; nf < 8; ++nf) {
        f32x4 acc = f32x4{0.f, 0.f, 0.f, 0.f};
#pragma unroll
        for (int ks = 0; ks < 4; ++ks) {
          bf16x8 bb = *reinterpret_cast<const bf16x8*>(kb + (size_t)(nf * 16 + fr) * 128 + ks * 32);
          acc = __builtin_amdgcn_mfma_f32_16x16x32_bf16(a[ks], bb, acc, 0, 0, 0);
        }
#pragma unroll
        for (int j = 0; j < 4; ++j) {
          int row = (wid * 16 + fq * 4 + j) * 2 + half;
          int kidx = nf * 16 + fr;
          keys[row * 129 + kidx] = mkkey(acc[j], (unsigned)kidx, 127u);
        }
      }
    }
    __syncthreads();
    const int row = tid & 127, part = tid >> 7;
    float list[16];
#pragma unroll
    for (int i = 0; i < 16; ++i) list[i] = NEGK;
    {
      const float* kr = keys + row * 129 + part * 64;
#pragma unroll 4
      for (int e = 0; e < 64; ++e) {
        float x = kr[e];
        INSERT16(list, x)
      }
    }
    __syncthreads();
    if (part == 1) {
#pragma unroll
      for (int i = 0; i < 16; ++i) ex[row * 17 + i] = list[i];
    }
    __syncthreads();
    if (part == 0) {
#pragma unroll
      for (int i = 0; i < 16; ++i) {
        float x = ex[row * 17 + i];
        INSERT16(list, x)
      }
#pragma unroll
      for (int i = 0; i < 16; ++i) fin[row * 17 + i] = list[i];
    }
    __syncthreads();
    if (tid < 64) {
      const float* f0 = fin + (2 * tid) * 17;
      const float* f1 = fin + (2 * tid + 1) * 17;
      float v0[16], v1[16];
#pragma unroll
      for (int i = 0; i < 16; ++i) {
        v0[i] = f0[i];
        v1[i] = f1[i];
      }
      float l2[16];
#pragma unroll
      for (int i = 0; i < 16; ++i) l2[i] = NEGK;
#pragma unroll
      for (int a = 0; a < 16; ++a)
#pragma unroll
        for (int bq = 0; bq < 16; ++bq)
          if ((a + 1) * (bq + 1) <= 16) {
            float x = mkkey(v0[a] + v1[bq], (unsigned)(a * 16 + bq), 255u);
            INSERT16(l2, x)
          }
      float sv[16];
      int ev[16];
      float mx = NEGK;
#pragma unroll
      for (int k = 0; k < 16; ++k) {
        unsigned ab = __float_as_uint(l2[k]) & 255u;
        unsigned k0 = __float_as_uint(f0[ab >> 4]), k1 = __float_as_uint(f1[ab & 15u]);
        sv[k] = __uint_as_float(k0 & ~127u) + __uint_as_float(k1 & ~127u);
        ev[k] = (int)((k0 & 127u) * 128u + (k1 & 127u));
        mx = fmaxf(mx, sv[k]);
      }
      float sum = 0.f;
#pragma unroll
      for (int k = 0; k < 16; ++k) {
        sv[k] = __expf(sv[k] - mx);
        sum += sv[k];
      }
      float inv = 1.f / sum;
      size_t o = (size_t)(tok0 + tid) * 128 + hh * 16;
      int4* eo = reinterpret_cast<int4*>(p->eidx + o);
      float4* go = reinterpret_cast<float4*>(p->gate + o);
#pragma unroll
      for (int k4 = 0; k4 < 4; ++k4) {
        eo[k4] = make_int4(ev[4 * k4], ev[4 * k4 + 1], ev[4 * k4 + 2], ev[4 * k4 + 3]);
        go[k4] = make_float4(sv[4 * k4] * inv, sv[4 * k4 + 1] * inv, sv[4 * k4 + 2] * inv, sv[4 * k4 + 3] * inv);
      }
    }
    __syncthreads();
  }
}

typedef float v2f __attribute__((ext_vector_type(2)));
DEVI void dec16(uint4 q, float* f) {
  v2f t;
  t = __builtin_amdgcn_cvt_pk_f32_fp8((int)q.x, false); f[0] = t.x; f[1] = t.y;
  t = __builtin_amdgcn_cvt_pk_f32_fp8((int)q.x, true);  f[2] = t.x; f[3] = t.y;
  t = __builtin_amdgcn_cvt_pk_f32_fp8((int)q.y, false); f[4] = t.x; f[5] = t.y;
  t = __builtin_amdgcn_cvt_pk_f32_fp8((int)q.y, true);  f[6] = t.x; f[7] = t.y;
  t = __builtin_amdgcn_cvt_pk_f32_fp8((int)q.z, false); f[8] = t.x; f[9] = t.y;
  t = __builtin_amdgcn_cvt_pk_f32_fp8((int)q.z, true);  f[10] = t.x; f[11] = t.y;
  t = __builtin_amdgcn_cvt_pk_f32_fp8((int)q.w, false); f[12] = t.x; f[13] = t.y;
  t = __builtin_amdgcn_cvt_pk_f32_fp8((int)q.w, true);  f[14] = t.x; f[15] = t.y;
}
DEVI void phase_expert(PP p, int layer, int ntok, unsigned char* lds, float gscale = 1.f) {
  const int tid = ltid();
  const int lane = tid & 63, wid = tid >> 6, j8 = lane & 7, grp = lane >> 3;
  const int nb = lnblk(), bid = lbid();
  unsigned short* ids = reinterpret_cast<unsigned short*>(lds);
  float* part = reinterpret_cast<float*>(lds + TPB * 128 * 2);
  const unsigned char* ut = p->utab + (size_t)layer * NEXP * D;
  const unsigned char* vt = p->vtab + (size_t)layer * NEXP * D;
  int tpb = (ntok + nb - 1) / nb;
  if (tpb > TPB) tpb = TPB;
  const int npass = (ntok + nb * tpb - 1) / (nb * tpb);
  for (int pass = 0; pass < npass; ++pass) {
    const int tok0 = (pass * nb + bid) * tpb;
    int cnt = ntok - tok0;
    if (cnt > tpb) cnt = tpb;
    if (cnt < 0) cnt = 0;
    for (int i = tid; i < cnt * 128; i += NTHREADS) {
      ids[i] = (unsigned short)p->eidx[(size_t)tok0 * 128 + i];
      part[i] = 0.f;
    }
    __syncthreads();
    for (int c = 0; c < 8; ++c) {
      for (int tl = wid; tl < cnt; tl += 4) {
        float xr[16];
        {
          const uint4* hp = reinterpret_cast<const uint4*>(p->h + (size_t)(tok0 + tl) * D + 128 * c + 16 * j8);
          uint4 h0 = hp[0], h1 = hp[1];
          xr[0] = bflo(h0.x); xr[1] = bfhi(h0.x); xr[2] = bflo(h0.y); xr[3] = bfhi(h0.y);
          xr[4] = bflo(h0.z); xr[5] = bfhi(h0.z); xr[6] = bflo(h0.w); xr[7] = bfhi(h0.w);
          xr[8] = bflo(h1.x); xr[9] = bfhi(h1.x); xr[10] = bflo(h1.y); xr[11] = bfhi(h1.y);
          xr[12] = bflo(h1.z); xr[13] = bfhi(h1.z); xr[14] = bflo(h1.w); xr[15] = bfhi(h1.w);
        }
        const unsigned short* idp = ids + tl * 128 + grp;
        const unsigned char* ub = ut + 128 * c + 16 * j8;
        uint4 q[16];
#pragma unroll
        for (int i = 0; i < 16; ++i) {
          int e = idp[8 * i];
          q[i] = *reinterpret_cast<const uint4*>(ub + (size_t)e * D);
        }
        float s0 = 0.f, s1 = 0.f;
#pragma unroll
        for (int i = 0; i < 16; ++i) {
          float f[16];
          dec16(q[i], f);
          float d = 0.f;
#pragma unroll
          for (int k = 0; k < 16; ++k) d += xr[k] * f[k];
          d += dpp_mov<0xB1>(d);
          d += dpp_mov<0x4E>(d);
          d += dpp_mov<0x141>(d);
          if (i < 8) s0 = (j8 == i) ? d : s0;
          else s1 = (j8 == i - 8) ? d : s1;
        }
        float* pp = part + tl * 128 + 8 * j8 + grp;
        pp[0] += s0;
        pp[64] += s1;
      }
    }
    __syncthreads();
    for (int i = tid; i < cnt * 128; i += NTHREADS)
      part[i] = p->gate[(size_t)tok0 * 128 + i] * gelu_tanh(part[i] * (1.f / USCALE));
    __syncthreads();
    for (int c = 0; c < 8; ++c) {
      for (int tl = wid; tl < cnt; tl += 4) {
        const unsigned short* idp = ids + tl * 128 + grp;
        const float* pp = part + tl * 128 + grp;
        const unsigned char* vb = vt + 128 * c + 16 * j8;
        float acc[16];
#pragma unroll
        for (int k = 0; k < 16; ++k) acc[k] = 0.f;
        uint4 q[16];
        float wv[16];
#pragma unroll
        for (int i = 0; i < 16; ++i) {
          int e = idp[8 * i];
          wv[i] = pp[8 * i];
          q[i] = *reinterpret_cast<const uint4*>(vb + (size_t)e * D);
        }
#pragma unroll
        for (int i = 0; i < 16; ++i) {
          float f[16];
          dec16(q[i], f);
#pragma unroll
          for (int k = 0; k < 16; ++k) acc[k] += wv[i] * f[k];
        }
#pragma unroll
        for (int k = 0; k < 16; ++k) {
          float a = acc[k];
          a += dpp_mov<0x128>(a);
          a += __shfl_xor(a, 16);
          a += __shfl_xor(a, 32);
          acc[k] = a;
        }
        if (grp == 0) {
          int tok = tok0 + tl;
          int b = tok_batch(tok);
          const float4* gf = reinterpret_cast<const float4*>(p->mod + ((size_t)layer * 9 + b) * 6144 + 5 * 1024 + 128 * c + 16 * j8);
          float4* xo = reinterpret_cast<float4*>(p->xs + (size_t)tok * D + 128 * c + 16 * j8);
          const float sc = gscale * (1.f / VSCALE);
#pragma unroll
          for (int i4 = 0; i4 < 4; ++i4) {
            float4 gq = gf[i4], xq = xo[i4];
            xq.x += sc * gq.x * acc[i4 * 4 + 0];
            xq.y += sc * gq.y * acc[i4 * 4 + 1];
            xq.z += sc * gq.z * acc[i4 * 4 + 2];
            xq.w += sc * gq.w * acc[i4 * 4 + 3];
            xo[i4] = xq;
          }
        }
      }
    }
    __syncthreads();
  }
}

#define XB_TMO 128
#define XB_XCNT(j) (256 + 64 * (j))
#define XB_XSUB(j) (1280 + 64 * (j))
#define XB_XGEN(j) (2304 + 64 * (j))
#define XB_TOP 3328
#define XB_TOPGEN 3392
#define XCD_BAR_WORDS 3456
#define XB_SPIN_CAP (1u << 22)
#define LAS __attribute__((address_space(3)))
DEVI unsigned xb_ld(unsigned* p) { return __hip_atomic_load(p, __ATOMIC_RELAXED, __HIP_MEMORY_SCOPE_AGENT); }
DEVI unsigned xb_add(unsigned* p, unsigned v) { return __hip_atomic_fetch_add(p, v, __ATOMIC_RELAXED, __HIP_MEMORY_SCOPE_AGENT); }
DEVI unsigned xb_xcc_id() { return (unsigned)__builtin_amdgcn_s_getreg((3 << 11) | 20) & 0xFu; }
#define XB_SPIN(cond, bar)                                   \
  do {                                                       \
    unsigned _sp = 0;                                        \
    while (cond) {                                           \
      __builtin_amdgcn_s_sleep(1);                           \
      if ((++_sp & 255u) == 0u) {                            \
        if (xb_ld(&(bar)[XB_TMO])) break;                    \
        if (_sp > XB_SPIN_CAP) {                             \
          atomicAdd(&(bar)[XB_TMO], 1u);                     \
          break;                                             \
        }                                                    \
      }                                                      \
    }                                                        \
  } while (0)
struct XcdBarrier {
  unsigned* bar;
  unsigned x;
  volatile LAS unsigned* st;
};
DEVI XcdBarrier xcd_barrier_post(unsigned* bar, volatile LAS unsigned* st) {
  XcdBarrier b;
  b.bar = bar;
  b.x = xb_xcc_id();
  b.st = st;
  if (threadIdx.x == 0) (void)xb_add(&bar[XB_XCNT(b.x)], 1u);
  return b;
}
DEVI void xcd_barrier_complete(unsigned* bar, unsigned x, unsigned& nloc, unsigned& nx) {
  const unsigned G = gridDim.x * gridDim.y * gridDim.z;
  unsigned sum, cnt, mine, sp = 0u;
  for (;;) {
    sum = 0u;
    cnt = 0u;
    mine = 0u;
#pragma unroll
    for (unsigned j = 0; j < 16; ++j) {
      const unsigned c = xb_ld(&bar[XB_XCNT(j)]);
      sum += c;
      cnt += (c > 0u) ? 1u : 0u;
      mine = (j == x) ? c : mine;
    }
    if (sum == G) break;
    __builtin_amdgcn_s_sleep(1);
    if ((++sp & 255u) == 0u) {
      if (xb_ld(&bar[XB_TMO])) break;
      if (sp > XB_SPIN_CAP) {
        atomicAdd(&bar[XB_TMO], 1u);
        break;
      }
    }
  }
  nloc = mine > 0u ? mine : 1u;
  nx = cnt > 0u ? cnt : 1u;
}
DEVI void xcd_barrier(const XcdBarrier& b) {
  asm volatile("s_waitcnt vmcnt(0)" ::: "memory");
  __syncthreads();
  if (threadIdx.x == 0) {
    unsigned* bar = b.bar;
    __builtin_amdgcn_s_waitcnt(0);
    unsigned nloc = b.st[0], nx = b.st[1];
    if (nloc == 0u) {
      xcd_barrier_complete(bar, b.x, nloc, nx);
      b.st[0] = nloc;
      b.st[1] = nx;
    }
    const unsigned old = xb_add(&bar[XB_XSUB(b.x)], 1u);
    const unsigned gen = old / nloc;
    if (old + 1u == (gen + 1u) * nloc) {
      __builtin_amdgcn_fence(__ATOMIC_RELEASE, "agent");
      asm volatile("s_waitcnt vmcnt(0)" ::: "memory");
      const unsigned og = xb_add(&bar[XB_TOP], 1u);
      const unsigned tg = og / nx;
      if (og + 1u == (tg + 1u) * nx) xb_add(&bar[XB_TOPGEN], 1u);
      else XB_SPIN(xb_ld(&bar[XB_TOPGEN]) == tg, bar);
      __builtin_amdgcn_fence(__ATOMIC_ACQUIRE, "agent");
      xb_add(&bar[XB_XGEN(b.x)], 1u);
      asm volatile("s_waitcnt vmcnt(0)" ::: "memory");
    } else {
      XB_SPIN(xb_ld(&bar[XB_XGEN(b.x)]) == gen, bar);
      __builtin_amdgcn_fence(__ATOMIC_ACQUIRE, "agent");
      asm volatile("s_waitcnt vmcnt(0)" ::: "memory");
    }
  }
  __syncthreads();
}

DEVI bool step_active(int step) {
  if (step == 0 || step == NSTEPS - 1) return true;
  int layer = (step - 1) / STEPS_PER_LAYER, ph = (step - 1) % STEPS_PER_LAYER;
  if (ph == 3 && (layer & 1)) return false;
  return true;
}

DEVI void run_step(PP p, int step, unsigned char* lds, float gscale = 1.f) {
  if (step == 0) {
    phase_prep(p, lds);
    return;
  }
  if (step == NSTEPS - 1) {
    phase_norm(p, 0, 2, TL);
    return;
  }
  int layer = (step - 1) / STEPS_PER_LAYER, ph = (step - 1) % STEPS_PER_LAYER;
  bool even = (layer & 1) == 0;
  int j = layer >> 1;
  bool upd_ctx = layer < 2;
  bool need_ctx = layer < 3;
  int nt_in = need_ctx ? TT : TL;
  int nt = upd_ctx ? TT : TL;
  switch (ph) {
    case 0: phase_norm(p, layer, 0, nt_in); break;
    case 1:
      if (even)
        gemm_phase<EPI_INPROJ>(p, p->h, D, p->wt_in_ab + (size_t)j * 1280 * D, D, nt_in / 128, 10, D, layer, lds);
      else
        gemm_phase<EPI_GELU>(p, p->h, D, p->wt_in_gs + (size_t)j * 2048 * D, D, nt / 128, 16, D, layer, lds);
      break;
    case 2:
      if (even) {
        phase_fft_a(p, lds);
        if (upd_ctx) phase_dft_ctx(p, lds);
        phase_attn(p, layer, upd_ctx);
      } else {
        phase_sgu(p, j, nt / 128, lds);
      }
      break;
    case 3:
      if (even) phase_fft_b(p, lds);
      break;
    case 4:
      if (even)
        gemm_phase<EPI_RESID>(p, p->mix, LDMIX, p->wt_out_ab + (size_t)j * D * LDMIX, LDMIX, nt / 128, 8, LDMIX, layer, lds, gscale);
      else
        gemm_phase<EPI_RESID>(p, p->mix, LDMIX, p->wt_out_gs + (size_t)j * D * D, D, nt / 128, 8, D, layer, lds, gscale);
      break;
    case 5: phase_norm(p, layer, 1, nt); break;
    case 6: gemm_phase<EPI_STORE>(p, p->h, D, p->wt_q + (size_t)layer * 2048 * D, D, nt / 128, 16, D, layer, lds); break;
    case 7: phase_route(p, layer, nt, lds); break;
    case 8: phase_expert(p, layer, nt, lds, gscale); break;
  }
}

__global__ void __launch_bounds__(NTHREADS, 2) mega(Params p_unused, int step_lo, int step_hi) {
  __shared__ __attribute__((aligned(16))) unsigned char lds[LDS_BYTES];
  PP pp = (PP)__builtin_amdgcn_kernarg_segment_ptr();
  volatile LAS unsigned* st = (volatile LAS unsigned*)(lds + LDS_BYTES - 16);
  if (threadIdx.x == 0) {
    st[0] = 0u;
    st[1] = 0u;
  }
  __syncthreads();
  XcdBarrier xb = xcd_barrier_post(pp->bar, st);
  int nsync = 0;
  bool first = true;
  for (int s = step_lo; s < step_hi; ++s) {
    if (!step_active(s)) continue;
    if (!first) {
      if (nsync == 0) cg::this_grid().sync();
      else xcd_barrier(xb);
      ++nsync;
    }
    first = false;
    PP q = pp;
    asm volatile("" : "+s"(q));
    run_step(q, s, lds);
#if REP_MASK
    if (s > 0 && s < NSTEPS - 1) {
      int lay_ = (s - 1) / STEPS_PER_LAYER, ph_ = (s - 1) % STEPS_PER_LAYER;
      bool rep_ = (REP_MASK >> ph_) & 1;
      if (ph_ == 2 && ((REP_MASK >> 9) & 1) && !(lay_ & 1)) rep_ = true;
      if (ph_ == 2 && ((REP_MASK >> 10) & 1) && (lay_ & 1)) rep_ = true;
      if (rep_) {
        xcd_barrier(xb);
        PP q2 = pp;
        asm volatile("" : "+s"(q2));
        float z = 0.f;
        asm volatile("" : "+s"(z));
        run_step(q2, s, lds, z);
      }
      if (ph_ == 2 && ((REP_MASK >> 11) & 1) && !(lay_ & 1)) {
        xcd_barrier(xb);
        PP q2 = pp;
        asm volatile("" : "+s"(q2));
        phase_attn(q2, lay_, lay_ < 2);
      }
    }
#endif
  }
}

static size_t align_up(size_t v) { return (v + 255) & ~(size_t)255; }

extern "C" void kernel_launch(void* const* d_in, const int* in_sizes, int n_in, void* d_out, int out_size, void* d_ws,
                              size_t ws_size, hipStream_t stream) {
  Params p{};
  p.x = (const float*)d_in[0];
  p.c = (const float*)d_in[1];
  p.ctx = (const float*)d_in[2];
  p.c_ctx = (const float*)d_in[3];
  p.ada_w = (const float*)d_in[4];
  p.ada_b = (const float*)d_in[5];
  p.norm_mix_w = (const float*)d_in[6];
  p.norm_ffn_w = (const float*)d_in[7];
  p.ab_w_in = (const float*)d_in[8];
  p.ab_w_out = (const float*)d_in[9];
  p.attn_sink = (const float*)d_in[10];
  p.gs_w_in = (const float*)d_in[11];
  p.gs_norm_w = (const float*)d_in[12];
  p.gs_w_s = (const float*)d_in[13];
  p.gs_b_s = (const float*)d_in[14];
  p.gs_w_out = (const float*)d_in[15];
  p.peer_w_q = (const float*)d_in[16];
  p.peer_keys = (const float*)d_in[17];
  p.peer_u = (const float*)d_in[18];
  p.peer_v = (const float*)d_in[19];
  p.norm_out_w = (const float*)d_in[20];
  p.out = (float*)d_out;
  unsigned char* w = (unsigned char*)d_ws;
  size_t off = 0;
  auto take = [&](size_t bytes) {
    unsigned char* r = w + off;
    off = align_up(off + bytes);
    return r;
  };
  p.bar = (unsigned*)take((size_t)XCD_BAR_WORDS * 4);
  p.mod = (float*)take((size_t)DEPTH * 9 * 6144 * 4);
  p.cs = (float2*)take(64 * 16 * 8);
  p.xs = (float*)take((size_t)TT * D * 4);
  p.h = (bf16_t*)take((size_t)TT * D * 2);
  p.P = (bf16_t*)take((size_t)TT * 2048 * 2);
  p.kbuf = (bf16_t*)take((size_t)NB * 2 * KVLEN * 64 * 2);
  p.vbuf = (bf16_t*)take((size_t)NB * 2 * KVLEN * 64 * 2);
  p.zvT = (bf16_t*)take((size_t)TT * 1024 * 2);
  p.rowss = (float*)take((size_t)(TT / 128) * 16 * 128 * 4);
  p.mix = (bf16_t*)take((size_t)TT * LDMIX * 2);
  p.fa = (bf16_t*)take((size_t)TL * 1024 * 2);
  p.eidx = (int*)take((size_t)TT * 128 * 4);
  p.gate = (float*)take((size_t)TT * 128 * 4);
  p.wt_in_ab = (bf16_t*)take((size_t)2 * 1280 * D * 2);
  p.wt_out_ab = (bf16_t*)take((size_t)2 * D * LDMIX * 2);
  p.wt_in_gs = (bf16_t*)take((size_t)2 * 2048 * D * 2);
  p.wt_out_gs = (bf16_t*)take((size_t)2 * D * D * 2);
  p.wt_q = (bf16_t*)take((size_t)DEPTH * 2048 * D * 2);
  p.keysb = (bf16_t*)take((size_t)DEPTH * 8 * 2 * 128 * 128 * 2);
  p.utab = (unsigned char*)take((size_t)DEPTH * NEXP * D);
  p.vtab = (unsigned char*)take((size_t)DEPTH * NEXP * D);
  if (off > ws_size) {
    fprintf(stderr, "workspace too small: need %zu have %zu\n", off, ws_size);
    return;
  }
  hipMemsetAsync(p.bar, 0, (size_t)XCD_BAR_WORDS * 4, stream);
  static int grid_blocks = 0;
  if (!grid_blocks) {
    int dev = 0, cus = 0, per_cu = 0;
    hipGetDevice(&dev);
    hipDeviceGetAttribute(&cus, hipDeviceAttributeMultiprocessorCount, dev);
    hipOccupancyMaxActiveBlocksPerMultiprocessor(&per_cu, mega, NTHREADS, 0);
    if (per_cu > 2) per_cu = 2;
    if (per_cu < 1) per_cu = 1;
    grid_blocks = cus * per_cu;
  }
#if ONE_LAUNCH
  int lo = 0, hi = NSTEPS;
  void* args[] = {&p, &lo, &hi};
  hipError_t e = hipLaunchCooperativeKernel((void*)mega, dim3(grid_blocks), dim3(NTHREADS), args, 0, stream);
  if (e != hipSuccess) fprintf(stderr, "cooperative launch failed: %s (grid %d)\n", hipGetErrorString(e), grid_blocks);
#else
  for (int s = 0; s < NSTEPS; ++s) {
    if (s != 0 && s != NSTEPS - 1) {
      int layer = (s - 1) / STEPS_PER_LAYER, ph = (s - 1) % STEPS_PER_LAYER;
      if (ph == 3 && (layer & 1)) continue;
    }
    hipLaunchKernelGGL(mega, dim3(grid_blocks), dim3(NTHREADS), 0, stream, p, s, s + 1);
  }
#endif
}
```

```cpp
#include <hip/hip_runtime.h>
#include <hip/hip_bf16.h>
#include <hip/hip_cooperative_groups.h>
#include <cstdio>
namespace cg = cooperative_groups;

#ifndef REP_MASK
#define REP_MASK 0
#endif
#ifndef REP_MODE
#define REP_MODE 0
#endif
#ifndef REP_IDMASK
#define REP_IDMASK 0xffff
#endif
#ifndef ONE_LAUNCH
#define ONE_LAUNCH 1
#endif

#define DEVI __device__ __forceinline__
typedef unsigned short bf16_t;
using bf16x8 = __attribute__((ext_vector_type(8))) short;
using f32x4 = __attribute__((ext_vector_type(4))) float;
using f32x16 = __attribute__((ext_vector_type(16))) float;

constexpr int D = 1024, NB = 8, SEQ = 4096, CTX = 256, DEPTH = 4;
constexpr int TL = NB * SEQ, TC = NB * CTX, TT = TL + TC;
constexpr int KVLEN = CTX + SEQ;
constexpr int NEXP = 16384;
constexpr int LDMIX = 1536;
constexpr float USCALE = 64.f, VSCALE = 8.f;
constexpr int TPB = 68;
constexpr int LDS_BYTES = 68 * 1024;
constexpr int NTHREADS = 256;
constexpr int STEPS_PER_LAYER = 9;
constexpr int NSTEPS = 1 + DEPTH * STEPS_PER_LAYER + 1;

struct Params {
  const float *x, *c, *ctx, *c_ctx, *ada_w, *ada_b, *norm_mix_w, *norm_ffn_w, *ab_w_in, *ab_w_out, *attn_sink,
      *gs_w_in, *gs_norm_w, *gs_w_s, *gs_b_s, *gs_w_out, *peer_w_q, *peer_keys, *peer_u, *peer_v, *norm_out_w;
  float* out;
  float* mod;
  float2* cs;
  float* xs;
  bf16_t* h;
  bf16_t* P;
  bf16_t* kbuf;
  bf16_t* vbuf;
  float* rowss;
  bf16_t* zvT;
  bf16_t* mix;
  bf16_t* fa;
  unsigned* bar;
  int* eidx;
  float* gate;
  bf16_t *wt_in_ab, *wt_out_ab, *wt_in_gs, *wt_out_gs, *wt_q, *keysb;
  unsigned char *utab, *vtab;
  float* su;
  float* sv;
  signed char* h8;
  float* sx;
};

typedef const __attribute__((address_space(4))) Params* PP;

DEVI int ltid() { int t = threadIdx.x; asm volatile("" : "+v"(t)); return t; }
DEVI int lbid() { int t = blockIdx.x; asm volatile("" : "+s"(t)); return t; }
DEVI int lnblk() { int t = gridDim.x; asm volatile("" : "+s"(t)); return t; }

DEVI bf16_t f2bf(float f) {
  unsigned u = __float_as_uint(f);
  u += 0x7fffu + ((u >> 16) & 1u);
  return (bf16_t)(u >> 16);
}
DEVI float bf2f(bf16_t h) { return __uint_as_float(((unsigned)h) << 16); }
DEVI float bflo(unsigned u) { return __uint_as_float(u << 16); }
DEVI float bfhi(unsigned u) { return __uint_as_float(u & 0xffff0000u); }
DEVI unsigned pack2(float a, float b) { return (unsigned)f2bf(a) | ((unsigned)f2bf(b) << 16); }
DEVI float wave_sum(float v) {
#pragma unroll
  for (int o = 32; o > 0; o >>= 1) v += __shfl_xor(v, o);
  return v;
}
DEVI float wave_max(float v) {
#pragma unroll
  for (int o = 32; o > 0; o >>= 1) v = fmaxf(v, __shfl_xor(v, o));
  return v;
}
DEVI float gelu_tanh(float x) {
  float u = 0.7978845608028654f * (x + 0.044715f * x * x * x);
  return 0.5f * x * (1.f + tanhf(u));
}
template <int CTRL>
DEVI float dpp_mov(float v) {
  return __builtin_bit_cast(float, __builtin_amdgcn_mov_dpp(__builtin_bit_cast(int, v), CTRL, 0xF, 0xF, true));
}
DEVI int tok_batch(int r) { return r < TL ? (r >> 12) : 8; }

DEVI void prep_transpose_tile(const float* __restrict__ src, int N, bf16_t* __restrict__ dst, int ldk, int tk, int tn, float* tile, int tid) {
#pragma unroll
  for (int i = 0; i < 16; ++i) {
    int r = (tid >> 6) + 4 * i;
    tile[r * 65 + (tid & 63)] = src[(size_t)(tk * 64 + r) * N + tn * 64 + (tid & 63)];
  }
  __syncthreads();
#pragma unroll
  for (int i = 0; i < 16; ++i) {
    int n = (tid >> 6) + 4 * i, k = tid & 63;
    dst[(size_t)(tn * 64 + n) * ldk + tk * 64 + k] = f2bf(tile[k * 65 + n]);
  }
}

constexpr int PU_ADA = DEPTH * 96;
constexpr int PU_T_ABIN = 2 * 16 * 20;
constexpr int PU_T_GSIN = 2 * 16 * 32;
constexpr int PU_T_GSOUT = 2 * 16 * 16;
constexpr int PU_T_ABOUT = 2 * 8 * 16;
constexpr int PU_T_Q = DEPTH * 16 * 32;
constexpr int PU_FOLD = 2 * 512 * 1024 / 256;
constexpr int PU_CONV = DEPTH * NEXP * D / 4 / 2048;
constexpr int PU_KEYS = DEPTH * 8 * 2 * 128 * 128 / 4 / 2048;
constexpr int PU_UROWS = DEPTH * NEXP / 32;
constexpr int PU_TOTAL = PU_ADA + PU_T_ABIN + PU_T_GSIN + PU_T_GSOUT + PU_T_ABOUT + PU_T_Q + PU_FOLD + 2 * PU_UROWS + PU_KEYS + 1;

DEVI void phase_prep(PP p, unsigned char* lds) {
  const int tid = ltid();
  float* fl = reinterpret_cast<float*>(lds);
  for (int u0 = lbid(); u0 < PU_TOTAL; u0 += lnblk()) {
    int u = u0;
    if (u < PU_ADA) {
      float* sl = fl;
      for (int i = tid; i < 9 * 1024; i += NTHREADS) {
        int r = i >> 10, k = i & 1023;
        float v = (r < 8) ? p->c[r * 1024 + k] : p->c_ctx[k];
        sl[i] = v / (1.f + __expf(-v));
      }
      __syncthreads();
      float* red = sl + 9 * 1024;
      int ks = tid >> 6, col = tid & 63;
      int layer = u / 96, c0 = (u % 96) * 64;
      const float* w = p->ada_w + (size_t)layer * D * 6144 + c0 + col;
      float acc[9];
#pragma unroll
      for (int r = 0; r < 9; ++r) acc[r] = 0.f;
      for (int k0 = ks * 256; k0 < ks * 256 + 256; k0 += 16) {
        float wv[16];
#pragma unroll
        for (int kk = 0; kk < 16; ++kk) wv[kk] = w[(size_t)(k0 + kk) * 6144];
#pragma unroll
        for (int kk = 0; kk < 16; ++kk)
#pragma unroll
          for (int r = 0; r < 9; ++r) acc[r] += sl[r * 1024 + k0 + kk] * wv[kk];
      }
#pragma unroll
      for (int r = 0; r < 9; ++r) red[(ks * 9 + r) * 64 + col] = acc[r];
      __syncthreads();
      for (int i = tid; i < 9 * 64; i += NTHREADS) {
        int r = i >> 6, cc = i & 63;
        float sm = red[(0 * 9 + r) * 64 + cc] + red[(1 * 9 + r) * 64 + cc] + red[(2 * 9 + r) * 64 + cc] + red[(3 * 9 + r) * 64 + cc];
        sm += p->ada_b[(size_t)layer * 6144 + c0 + cc];
        p->mod[((size_t)layer * 9 + r) * 6144 + c0 + cc] = sm;
      }
      __syncthreads();
      continue;
    }
    u -= PU_ADA;
    if (u < PU_T_ABIN) {
      int j = u / 320, t = u % 320;
      prep_transpose_tile(p->ab_w_in + (size_t)j * D * 1280, 1280, p->wt_in_ab + (size_t)j * 1280 * D, D, t / 20, t % 20, fl, tid);
      __syncthreads();
      continue;
    }
    u -= PU_T_ABIN;
    if (u < PU_T_GSIN) {
      int j = u / 512, t = u % 512;
      prep_transpose_tile(p->gs_w_in + (size_t)j * D * 2048, 2048, p->wt_in_gs + (size_t)j * 2048 * D, D, t / 32, t % 32, fl, tid);
      __syncthreads();
      continue;
    }
    u -= PU_T_GSIN;
    if (u < PU_T_GSOUT) {
      int j = u / 256, t = u % 256;
      prep_transpose_tile(p->gs_w_out + (size_t)j * D * D, D, p->wt_out_gs + (size_t)j * D * D, D, t / 16, t % 16, fl, tid);
      __syncthreads();
      continue;
    }
    u -= PU_T_GSOUT;
    if (u < PU_T_ABOUT) {
      int j = u / 128, t = u % 128;
      prep_transpose_tile(p->ab_w_out + (size_t)j * D * D, D, p->wt_out_ab + (size_t)j * D * LDMIX, LDMIX, t / 16, t % 16, fl, tid);
      __syncthreads();
      continue;
    }
    u -= PU_T_ABOUT;
    if (u < PU_T_Q) {
      int i = u / 512, t = u % 512;
      prep_transpose_tile(p->peer_w_q + (size_t)i * D * 2048, 2048, p->wt_q + (size_t)i * 2048 * D, D, t / 32, t % 32, fl, tid);
      __syncthreads();
      continue;
    }
    u -= PU_T_Q;
    if (u < PU_FOLD) {
      float2* tw = reinterpret_cast<float2*>(lds);
      if (tid < 128) {
        float sn, cn;
        sincospif((float)tid / 64.f, &sn, &cn);
        tw[tid] = make_float2(cn, sn);
      }
      __syncthreads();
      size_t i = (size_t)u * 256 + tid;
      int n = (int)(i & 1023);
      int gm = (int)((i >> 10) & 511);
      int j = (int)(i >> 19);
      int g = gm >> 7, m = gm & 127;
      const float* w = p->ab_w_out + (size_t)j * D * D + (size_t)(512 + g * 128) * D + n;
      float ar = 0.f, ai = 0.f;
#pragma unroll 16
      for (int l = 0; l < 128; ++l) {
        float2 t = tw[(m * l) & 127];
        float wv = w[(size_t)l * D];
        ar += t.x * wv;
        ai += t.y * wv;
      }
      bf16_t* dst = p->wt_out_ab + (size_t)j * D * LDMIX + (size_t)n * LDMIX;
      dst[512 + gm] = f2bf(ar);
      dst[1024 + gm] = f2bf(ai);
      __syncthreads();
      continue;
    }
    u -= PU_FOLD;
    if (u < 2 * PU_UROWS) {
      const bool isv = u >= PU_UROWS;
      if (isv) u -= PU_UROWS;
      const float* src = isv ? p->peer_v : p->peer_u;
      unsigned char* dst = isv ? p->vtab : p->utab;
      float* sdst = isv ? p->sv : p->su;
      const int lane = tid & 63, wv = tid >> 6;
#pragma unroll 1
      for (int rr = 0; rr < 8; rr += 2) {
        size_t row0 = (size_t)u * 32 + wv * 8 + rr;
        float4 v[2][4];
#pragma unroll
        for (int k = 0; k < 2; ++k)
#pragma unroll
          for (int i = 0; i < 4; ++i) v[k][i] = reinterpret_cast<const float4*>(src + (row0 + k) * D)[lane * 4 + i];
#pragma unroll
        for (int k = 0; k < 2; ++k) {
          float am = 0.f;
#pragma unroll
          for (int i = 0; i < 4; ++i)
            am = fmaxf(am, fmaxf(fmaxf(fabsf(v[k][i].x), fabsf(v[k][i].y)), fmaxf(fabsf(v[k][i].z), fabsf(v[k][i].w))));
          am = wave_max(am);
          am = fmaxf(am, 1e-30f);
          float qs = 127.f / am;
          uint4 o;
          unsigned* op = reinterpret_cast<unsigned*>(&o);
#pragma unroll
          for (int i = 0; i < 4; ++i) {
            int q0 = (int)rintf(v[k][i].x * qs), q1 = (int)rintf(v[k][i].y * qs), q2 = (int)rintf(v[k][i].z * qs), q3 = (int)rintf(v[k][i].w * qs);
            op[i] = (unsigned)(q0 & 255) | ((unsigned)(q1 & 255) << 8) | ((unsigned)(q2 & 255) << 16) | ((unsigned)(q3 & 255) << 24);
          }
          reinterpret_cast<uint4*>(dst + (row0 + k) * D)[lane] = o;
          if (lane == 0) sdst[row0 + k] = am * (1.f / 127.f);
        }
      }
      continue;
    }
    u -= 2 * PU_UROWS;
    if (u < PU_KEYS) {
      const float4* s4 = reinterpret_cast<const float4*>(p->peer_keys) + (size_t)u * 2048 + tid;
      uint2* d2 = reinterpret_cast<uint2*>(p->keysb) + (size_t)u * 2048 + tid;
#pragma unroll
      for (int k = 0; k < 8; ++k) {
        float4 v = s4[k * 256];
        uint2 o;
        o.x = pack2(v.x, v.y);
        o.y = pack2(v.z, v.w);
        d2[k * 256] = o;
      }
      continue;
    }
    for (int i = tid; i < 64 * 16; i += NTHREADS) {
      int pos = i >> 4, k = i & 15;
      float inv = powf(10000.f, -(float)k / 16.f);
      float ang = (float)pos * inv;
      float sn, cn;
      sincosf(ang, &sn, &cn);
      p->cs[i] = make_float2(cn, sn);
    }
  }
}

DEVI void phase_norm(PP p, int layer, int which, int ntok) {
  int lane = ltid() & 63;
  int gw = lbid() * 4 + (ltid() >> 6), nw = lnblk() * 4;
  const float* w = which == 0 ? p->norm_mix_w + layer * D : (which == 1 ? p->norm_ffn_w + layer * D : p->norm_out_w);
  for (int tok = gw; tok < ntok; tok += nw) {
    const float* xsrc = p->xs + (size_t)tok * D;
    if (which == 0 && layer == 0) xsrc = (tok < TL) ? p->x + (size_t)tok * D : p->ctx + (size_t)(tok - TL) * D;
    const float4* xr = reinterpret_cast<const float4*>(xsrc);
    float4 v[4];
    float ss = 0.f;
#pragma unroll
    for (int i = 0; i < 4; ++i) {
      v[i] = xr[lane + 64 * i];
      ss += v[i].x * v[i].x + v[i].y * v[i].y + v[i].z * v[i].z + v[i].w * v[i].w;
    }
    ss = wave_sum(ss);
    float rstd = rsqrtf(ss * (1.f / 1024.f) + 1e-6f);
    if (which == 2) {
      float4* o = reinterpret_cast<float4*>(p->out + (size_t)tok * D);
#pragma unroll
      for (int i = 0; i < 4; ++i) {
        float4 wv = reinterpret_cast<const float4*>(w)[lane + 64 * i];
        float4 r;
        r.x = v[i].x * rstd * wv.x;
        r.y = v[i].y * rstd * wv.y;
        r.z = v[i].z * rstd * wv.z;
        r.w = v[i].w * rstd * wv.w;
        o[lane + 64 * i] = r;
      }
    } else {
      int b = tok_batch(tok);
      const float* mb = p->mod + ((size_t)layer * 9 + b) * 6144 + (which == 0 ? 0 : 3072);
      uint2* o = reinterpret_cast<uint2*>(p->h + (size_t)tok * D);
      float av[4][4];
      float am = 0.f;
#pragma unroll
      for (int i = 0; i < 4; ++i) {
        float4 wv = reinterpret_cast<const float4*>(w)[lane + 64 * i];
        float4 sh = reinterpret_cast<const float4*>(mb)[lane + 64 * i];
        float4 sc = reinterpret_cast<const float4*>(mb + 1024)[lane + 64 * i];
        float a0 = v[i].x * rstd * wv.x * (1.f + sc.x) + sh.x;
        float a1 = v[i].y * rstd * wv.y * (1.f + sc.y) + sh.y;
        float a2 = v[i].z * rstd * wv.z * (1.f + sc.z) + sh.z;
        float a3 = v[i].w * rstd * wv.w * (1.f + sc.w) + sh.w;
        uint2 r;
        r.x = pack2(a0, a1);
        r.y = pack2(a2, a3);
        o[lane + 64 * i] = r;
        av[i][0] = a0; av[i][1] = a1; av[i][2] = a2; av[i][3] = a3;
        am = fmaxf(am, fmaxf(fmaxf(fabsf(a0), fabsf(a1)), fmaxf(fabsf(a2), fabsf(a3))));
      }
      if (which == 1) {
        am = fmaxf(wave_max(am), 1e-30f);
        float qs = 127.f / am;
        unsigned* o8 = reinterpret_cast<unsigned*>(p->h8 + (size_t)tok * D);
#pragma unroll
        for (int i = 0; i < 4; ++i) {
          int q0 = (int)rintf(av[i][0] * qs), q1 = (int)rintf(av[i][1] * qs), q2 = (int)rintf(av[i][2] * qs), q3 = (int)rintf(av[i][3] * qs);
          o8[lane + 64 * i] = (unsigned)(q0 & 255) | ((unsigned)(q1 & 255) << 8) | ((unsigned)(q2 & 255) << 16) | ((unsigned)(q3 & 255) << 24);
        }
        if (lane == 0) p->sx[tok] = am * (1.f / 127.f);
      }
    }
  }
}

enum { EPI_STORE = 0, EPI_GELU = 1, EPI_RESID = 2, EPI_INPROJ = 3 };

template <int EPI>
DEVI void gemm_phase(PP p, const bf16_t* __restrict__ A, int lda, const bf16_t* __restrict__ Bt, int ldb,
                     int Mtiles, int Ntiles, int K, int layer, unsigned char* lds, float gscale = 1.f) {
  const int tid = ltid();
  const int wid = tid >> 6, lane = tid & 63, wr = wid >> 1, wc = wid & 1, fr = lane & 15, fq = lane >> 4;
  int nblk = lnblk();
  int bid = lbid();
  int lb = ((nblk & 7) == 0) ? ((bid & 7) * (nblk >> 3) + (bid >> 3)) : bid;
  int ntiles = Mtiles * Ntiles;
  const int nk = K / 64;
  const int srow = tid >> 3;
  const int scol = ((tid & 7) ^ ((tid >> 3) & 7)) * 8;
#define GEMM_STAGE(ga_, gb_, kt_, buf_)                                                                               \
  {                                                                                                                   \
    _Pragma("unroll") for (int i_ = 0; i_ < 4; ++i_) {                                                                \
      __builtin_amdgcn_global_load_lds((const unsigned*)((ga_) + (size_t)(32 * i_) * lda + (kt_) * 64),               \
                                       (__attribute__((address_space(3))) unsigned*)(lds + (buf_) * 32768 + tid * 16 + i_ * 4096), 16, 0, 0); \
      __builtin_amdgcn_global_load_lds((const unsigned*)((gb_) + (size_t)(32 * i_) * ldb + (kt_) * 64),               \
                                       (__attribute__((address_space(3))) unsigned*)(lds + (buf_) * 32768 + 16384 + tid * 16 + i_ * 4096), 16, 0, 0); \
    }                                                                                                                 \
  }
  if (lb < ntiles) {
    int tm0 = lb / Ntiles, tn0 = lb % Ntiles;
    const bf16_t* ga0 = A + (size_t)(tm0 * 128 + srow) * lda + scol;
    const bf16_t* gb0 = Bt + (size_t)(tn0 * 128 + srow) * ldb + scol;
    GEMM_STAGE(ga0, gb0, 0, 0)
  }
  for (int t = lb; t < ntiles; t += nblk) {
    int tm = t / Ntiles, tn = t % Ntiles;
    int brow = tm * 128, bcol = tn * 128;
    f32x4 acc[4][4];
#pragma unroll
    for (int m = 0; m < 4; ++m)
#pragma unroll
      for (int n = 0; n < 4; ++n) acc[m][n] = f32x4{0.f, 0.f, 0.f, 0.f};
    const bf16_t* ga = A + (size_t)(brow + srow) * lda + scol;
    const bf16_t* gb = Bt + (size_t)(bcol + srow) * ldb + scol;
    for (int kt = 0; kt < nk; ++kt) {
      const int buf = kt & 1;
      asm volatile("s_waitcnt vmcnt(0)" ::: "memory");
      __syncthreads();
      if (kt + 1 < nk) GEMM_STAGE(ga, gb, kt + 1, buf ^ 1)
      const unsigned char* SA = lds + buf * 32768;
      const unsigned char* SB = SA + 16384;
      bf16x8 At[2][4], Bl[2][4];
#pragma unroll
      for (int ks = 0; ks < 2; ++ks)
#pragma unroll
        for (int m = 0; m < 4; ++m) {
          const int sl = ((ks * 4 + fq) ^ (fr & 7)) << 4;
          At[ks][m] = *reinterpret_cast<const bf16x8*>(SA + (wr * 64 + m * 16 + fr) * 128 + sl);
          Bl[ks][m] = *reinterpret_cast<const bf16x8*>(SB + (wc * 64 + m * 16 + fr) * 128 + sl);
        }
#pragma unroll
      for (int ks = 0; ks < 2; ++ks)
#pragma unroll
        for (int m = 0; m < 4; ++m)
#pragma unroll
          for (int n = 0; n < 4; ++n)
            acc[m][n] = __builtin_amdgcn_mfma_f32_16x16x32_bf16(At[ks][m], Bl[ks][n], acc[m][n], 0, 0, 0);
    }
    {
      int t2 = t + nblk;
      if (t2 < ntiles) {
        int tm2 = t2 / Ntiles, tn2 = t2 % Ntiles;
        const bf16_t* ga2 = A + (size_t)(tm2 * 128 + srow) * lda + scol;
        const bf16_t* gb2 = Bt + (size_t)(tn2 * 128 + srow) * ldb + scol;
        GEMM_STAGE(ga2, gb2, 0, 0)
      }
    }
    const int colbase = bcol + wc * 64;
    if constexpr (EPI == EPI_STORE || EPI == EPI_GELU) {
      if (EPI == EPI_GELU && colbase >= 1024) {
        float* rsp = p->rowss + ((size_t)tm * 16 + (tn - 8) * 2 + wc) * 128;
#pragma unroll
        for (int m = 0; m < 4; ++m) {
          float ssq[4] = {0.f, 0.f, 0.f, 0.f};
#pragma unroll
          for (int n = 0; n < 4; ++n) {
            int ch = colbase - 1024 + n * 16 + fr;
            int q0 = wr * 64 + m * 16 + fq * 4;
            float g0 = gelu_tanh(acc[m][n][0]), g1 = gelu_tanh(acc[m][n][1]), g2 = gelu_tanh(acc[m][n][2]), g3 = gelu_tanh(acc[m][n][3]);
            ssq[0] += g0 * g0;
            ssq[1] += g1 * g1;
            ssq[2] += g2 * g2;
            ssq[3] += g3 * g3;
            uint2 o;
            o.x = pack2(g0, g1);
            o.y = pack2(g2, g3);
            *reinterpret_cast<uint2*>(p->zvT + ((size_t)tm * 1024 + ch) * 128 + q0) = o;
          }
#pragma unroll
          for (int j = 0; j < 4; ++j) {
            float v = ssq[j];
            v += dpp_mov<0xB1>(v);
            v += dpp_mov<0x4E>(v);
            v += dpp_mov<0x141>(v);
            v += dpp_mov<0x140>(v);
            if (fr == 0) rsp[wr * 64 + m * 16 + fq * 4 + j] = v;
          }
        }
      } else {
#pragma unroll
        for (int m = 0; m < 4; ++m)
#pragma unroll
          for (int j = 0; j < 4; ++j) {
            int row = brow + wr * 64 + m * 16 + fq * 4 + j;
            bf16_t* o = p->P + (size_t)row * 2048 + colbase + fr;
#pragma unroll
            for (int n = 0; n < 4; ++n) {
              float v = acc[m][n][j];
              if (EPI == EPI_GELU) v = gelu_tanh(v);
              o[n * 16] = f2bf(v);
            }
          }
      }
    } else if constexpr (EPI == EPI_RESID) {
#pragma unroll
      for (int m = 0; m < 4; ++m)
#pragma unroll
        for (int j = 0; j < 4; ++j) {
          int row = brow + wr * 64 + m * 16 + fq * 4 + j;
          int b = tok_batch(row);
          const float* g = p->mod + ((size_t)layer * 9 + b) * 6144 + 2048 + colbase + fr;
          float* o = p->xs + (size_t)row * D + colbase + fr;
          const float* xi = o;
          if (layer == 0 && gscale == 1.f)
            xi = ((row < TL) ? p->x + (size_t)row * D : p->ctx + (size_t)(row - TL) * D) + colbase + fr;
#pragma unroll
          for (int n = 0; n < 4; ++n) o[n * 16] = xi[n * 16] + gscale * g[n * 16] * acc[m][n][j];
        }
    } else if constexpr (EPI == EPI_INPROJ) {
      if (colbase >= 640 && colbase < 768) {
        int kvh = (colbase - 640) >> 6;
#pragma unroll
        for (int m = 0; m < 4; ++m) {
          int row0 = brow + wr * 64 + m * 16;
          bool latent = row0 < TL;
          int b = latent ? (row0 >> 12) : ((row0 - TL) >> 8);
          int kp16 = latent ? (CTX + (row0 & 4095)) : ((row0 - TL) & 255);
          int slot = kp16 + 8 * (fq & 1) + 4 * (fq >> 1);
#pragma unroll
          for (int n = 0; n < 4; ++n) {
            int dim = n * 16 + fr;
            uint2 o;
            o.x = pack2(acc[m][n][0], acc[m][n][1]);
            o.y = pack2(acc[m][n][2], acc[m][n][3]);
            *reinterpret_cast<uint2*>(p->vbuf + ((size_t)(b * 2 + kvh) * 64 + dim) * KVLEN + slot) = o;
          }
        }
      } else {
#pragma unroll
        for (int m = 0; m < 4; ++m)
#pragma unroll
          for (int j = 0; j < 4; ++j) {
            int row = brow + wr * 64 + m * 16 + fq * 4 + j;
            bool latent = row < TL;
            int b, pos;
            if (latent) {
              b = row >> 12;
              pos = row & 4095;
            } else {
              b = (row - TL) >> 8;
              pos = (row - TL) & 255;
            }
            float v0 = acc[m][0][j], v1 = acc[m][1][j], v2 = acc[m][2][j], v3 = acc[m][3][j];
            if (latent && colbase < 640) {
              float2 cr = p->cs[(pos >> 6) * 16 + fr];
              float2 cc = p->cs[(pos & 63) * 16 + fr];
              float a = v0, bb = v1;
              v0 = a * cr.x - bb * cr.y;
              v1 = bb * cr.x + a * cr.y;
              a = v2;
              bb = v3;
              v2 = a * cc.x - bb * cc.y;
              v3 = bb * cc.x + a * cc.y;
            }
            bf16_t* o;
            if (colbase < 512 || colbase >= 768) {
              o = p->P + (size_t)row * 2048 + colbase + fr;
            } else {
              int kvh = (colbase - 512) >> 6;
              int kp = latent ? (CTX + pos) : pos;
              o = p->kbuf + ((size_t)(b * 2 + kvh) * KVLEN + kp) * 64 + fr;
            }
            o[0] = f2bf(v0);
            o[16] = f2bf(v1);
            o[32] = f2bf(v2);
            o[48] = f2bf(v3);
          }
      }
    }
  }
}

DEVI bf16x8 scale_q(uint4 u) {
  uint4 r;
  r.x = pack2(bflo(u.x) * 0.125f, bfhi(u.x) * 0.125f);
  r.y = pack2(bflo(u.y) * 0.125f, bfhi(u.y) * 0.125f);
  r.z = pack2(bflo(u.z) * 0.125f, bfhi(u.z) * 0.125f);
  r.w = pack2(bflo(u.w) * 0.125f, bfhi(u.w) * 0.125f);
  return __builtin_bit_cast(bf16x8, r);
}
DEVI void phase_attn(PP p, int layer, bool with_ctx_q) {
  const int tid = ltid();
  const int lane = tid & 63, wid = tid >> 6, r = lane & 31, h = lane >> 5;
  const float* sinkp = p->attn_sink + (layer >> 1) * 8;
  const int nunits = 2048 + (with_ctx_q ? 128 : 0);
  for (int u = lbid(); u < nunits; u += lnblk()) {
    bool latent = u < 2048;
    int b, kvh, qg, tokbase;
    if (latent) {
      b = u >> 8;
      kvh = (u >> 7) & 1;
      qg = u & 127;
      tokbase = b * SEQ + qg * 32;
    } else {
      int v = u - 2048;
      b = v >> 4;
      kvh = (v >> 3) & 1;
      qg = v & 7;
      tokbase = TL + b * CTX + qg * 32;
    }
    const int hd = kvh * 4 + wid;
    const bf16_t* kb = p->kbuf + (size_t)(b * 2 + kvh) * KVLEN * 64;
    const bf16_t* vt = p->vbuf + (size_t)(b * 2 + kvh) * 64 * KVLEN;
    bf16x8 qf[4];
    {
      const bf16_t* qp = p->P + (size_t)(tokbase + r) * 2048 + hd * 64 + 8 * h;
#pragma unroll
      for (int st = 0; st < 4; ++st) qf[st] = scale_q(*reinterpret_cast<const uint4*>(qp + 16 * st));
    }
    f32x16 O0, O1;
#pragma unroll
    for (int i = 0; i < 16; ++i) {
      O0[i] = 0.f;
      O1[i] = 0.f;
    }
    float m_run = sinkp[hd];
    float l_run = (h == 0) ? 1.f : 0.f;
    const int nkb = latent ? 17 : 8;
    for (int kbi = 0; kbi < nkb; ++kbi) {
      int kpos, mode = 0;
      if (kbi < 8) {
        kpos = kbi * 32;
      } else {
        int d = kbi - 12;
        int kblk = qg + d;
        if (kblk < 0 || kblk > 127) continue;
        kpos = CTX + kblk * 32;
        mode = (d == -4) ? 1 : ((d == 4) ? 2 : 0);
      }
      f32x16 S;
#pragma unroll
      for (int i = 0; i < 16; ++i) S[i] = 0.f;
#pragma unroll
      for (int st = 0; st < 4; ++st) {
        bf16x8 kf = *reinterpret_cast<const bf16x8*>(kb + (size_t)(kpos + r) * 64 + 16 * st + 8 * h);
        S = __builtin_amdgcn_mfma_f32_32x32x16_bf16(kf, qf[st], S, 0, 0, 0);
      }
      if (mode) {
#pragma unroll
        for (int i = 0; i < 16; ++i) {
          int kk = (i & 3) + 8 * (i >> 2) + 4 * h;
          bool ok = (mode == 1) ? (kk >= r) : (kk <= r);
          if (!ok) S[i] = -1e30f;
        }
      }
      float bm = S[0];
#pragma unroll
      for (int i = 1; i < 16; ++i) bm = fmaxf(bm, S[i]);
      bm = fmaxf(bm, __shfl_xor(bm, 32));
      float m_new = fmaxf(m_run, bm);
      float alpha = __expf(m_run - m_new);
      float psum = 0.f;
#pragma unroll
      for (int i = 0; i < 16; ++i) {
        S[i] = __expf(S[i] - m_new);
        psum += S[i];
      }
      l_run = l_run * alpha + psum;
      m_run = m_new;
#pragma unroll
      for (int i = 0; i < 16; ++i) {
        O0[i] *= alpha;
        O1[i] *= alpha;
      }
#pragma unroll
      for (int sidx = 0; sidx < 2; ++sidx) {
        uint4 pk;
        pk.x = pack2(S[8 * sidx + 0], S[8 * sidx + 1]);
        pk.y = pack2(S[8 * sidx + 2], S[8 * sidx + 3]);
        pk.z = pack2(S[8 * sidx + 4], S[8 * sidx + 5]);
        pk.w = pack2(S[8 * sidx + 6], S[8 * sidx + 7]);
        bf16x8 pf = __builtin_bit_cast(bf16x8, pk);
        bf16x8 v0 = *reinterpret_cast<const bf16x8*>(vt + (size_t)r * KVLEN + kpos + 16 * sidx + 8 * h);
        bf16x8 v1 = *reinterpret_cast<const bf16x8*>(vt + (size_t)(32 + r) * KVLEN + kpos + 16 * sidx + 8 * h);
        O0 = __builtin_amdgcn_mfma_f32_32x32x16_bf16(v0, pf, O0, 0, 0, 0);
        O1 = __builtin_amdgcn_mfma_f32_32x32x16_bf16(v1, pf, O1, 0, 0, 0);
      }
    }
    float l_tot = l_run + __shfl_xor(l_run, 32);
    float inv = 1.f / l_tot;
    bf16_t* op = p->mix + (size_t)(tokbase + r) * LDMIX + hd * 64 + 4 * h;
#pragma unroll
    for (int g4 = 0; g4 < 4; ++g4) {
      uint2 o;
      o.x = pack2(O0[4 * g4 + 0] * inv, O0[4 * g4 + 1] * inv);
      o.y = pack2(O0[4 * g4 + 2] * inv, O0[4 * g4 + 3] * inv);
      *reinterpret_cast<uint2*>(op + 8 * g4) = o;
      o.x = pack2(O1[4 * g4 + 0] * inv, O1[4 * g4 + 1] * inv);
      o.y = pack2(O1[4 * g4 + 2] * inv, O1[4 * g4 + 3] * inv);
      *reinterpret_cast<uint2*>(op + 32 + 8 * g4) = o;
    }
  }
}

DEVI void fill_tw(float2* tw, int n) {
  for (int i = ltid(); i < n; i += NTHREADS) {
    float sn, cn;
    sincospif(2.f * (float)i / (float)n, &sn, &cn);
    tw[i] = make_float2(cn, sn);
  }
  __syncthreads();
}

DEVI bf16x8 lds_col8(const bf16_t* bp, int stride) {
  unsigned e0 = bp[0], e1 = bp[stride], e2 = bp[2 * stride], e3 = bp[3 * stride];
  unsigned e4 = bp[4 * stride], e5 = bp[5 * stride], e6 = bp[6 * stride], e7 = bp[7 * stride];
  uint4 pk;
  pk.x = e0 | (e1 << 16);
  pk.y = e2 | (e3 << 16);
  pk.z = e4 | (e5 << 16);
  pk.w = e6 | (e7 << 16);
  return __builtin_bit_cast(bf16x8, pk);
}

DEVI void phase_fft_a(PP p, unsigned char* lds) {
  const int tid = ltid();
  const int lane = tid & 63, wid = tid >> 6, fr = lane & 15, fq = lane >> 4;
  float2* tw = reinterpret_cast<float2*>(lds + 66560);
  fill_tw(tw, 64);
  bf16x8 af[2][2];
#pragma unroll
  for (int ks = 0; ks < 2; ++ks) {
    unsigned short cr[8], ci[8];
#pragma unroll
    for (int j = 0; j < 8; ++j) {
      int n1 = 32 * ks + 8 * fq + j, k1 = 16 * wid + fr;
      float2 t = tw[(k1 * n1) & 63];
      cr[j] = f2bf(t.x);
      ci[j] = f2bf(-t.y);
    }
    uint4 a0, a1;
    a0.x = cr[0] | ((unsigned)cr[1] << 16); a0.y = cr[2] | ((unsigned)cr[3] << 16);
    a0.z = cr[4] | ((unsigned)cr[5] << 16); a0.w = cr[6] | ((unsigned)cr[7] << 16);
    a1.x = ci[0] | ((unsigned)ci[1] << 16); a1.y = ci[2] | ((unsigned)ci[3] << 16);
    a1.z = ci[4] | ((unsigned)ci[5] << 16); a1.w = ci[6] | ((unsigned)ci[7] << 16);
    af[0][ks] = __builtin_bit_cast(bf16x8, a0);
    af[1][ks] = __builtin_bit_cast(bf16x8, a1);
  }
  const bf16_t* l16 = reinterpret_cast<const bf16_t*>(lds);
  for (int u = lbid(); u < NB * 64; u += lnblk()) {
    int b = u >> 6, n2 = u & 63;
    __syncthreads();
#pragma unroll
    for (int i = 0; i < 16; ++i) {
      int row = (tid >> 6) + 4 * i, piece = tid & 63;
      uint4 v = *reinterpret_cast<const uint4*>(p->P + (size_t)(b * SEQ + 64 * row + n2) * 2048 + 768 + piece * 8);
      *reinterpret_cast<uint4*>(lds + row * 1040 + piece * 16) = v;
    }
    __syncthreads();
    float tc[4], ts[4];
#pragma unroll
    for (int j = 0; j < 4; ++j) sincospif((float)(n2 * (16 * wid + 4 * fq + j)) / 2048.f, &ts[j], &tc[j]);
    for (int nb = 0; nb < 4; ++nb) {
      f32x4 acc[2][8];
#pragma unroll
      for (int n = 0; n < 8; ++n) {
        acc[0][n] = f32x4{0.f, 0.f, 0.f, 0.f};
        acc[1][n] = f32x4{0.f, 0.f, 0.f, 0.f};
      }
#pragma unroll
      for (int ks = 0; ks < 2; ++ks)
#pragma unroll
        for (int nf = 0; nf < 8; ++nf) {
          bf16x8 bfr = lds_col8(l16 + (32 * ks + 8 * fq) * 520 + 128 * nb + 16 * nf + fr, 520);
          acc[0][nf] = __builtin_amdgcn_mfma_f32_16x16x32_bf16(af[0][ks], bfr, acc[0][nf], 0, 0, 0);
          acc[1][nf] = __builtin_amdgcn_mfma_f32_16x16x32_bf16(af[1][ks], bfr, acc[1][nf], 0, 0, 0);
        }
#pragma unroll
      for (int j = 0; j < 4; ++j) {
        int k1 = 16 * wid + 4 * fq + j;
        bf16_t* o = p->fa + (size_t)(b * SEQ + k1 * 64 + n2) * 1024 + 128 * nb + fr;
#pragma unroll
        for (int nf = 0; nf < 8; ++nf) {
          float re = acc[0][nf][j], im = acc[1][nf][j];
          o[16 * nf] = f2bf(re * tc[j] + im * ts[j]);
          o[512 + 16 * nf] = f2bf(im * tc[j] - re * ts[j]);
        }
      }
    }
  }
  __syncthreads();
}

DEVI void phase_fft_b(PP p, unsigned char* lds) {
  const int tid = ltid();
  const int lane = tid & 63, wid = tid >> 6, fr = lane & 15, fq = lane >> 4;
  float2* tw = reinterpret_cast<float2*>(lds + 67584);
  fill_tw(tw, 64);
  bf16x8 wb[2][4];
#pragma unroll
  for (int ks = 0; ks < 4; ++ks) {
    unsigned short zr[8], zi[8];
#pragma unroll
    for (int j = 0; j < 8; ++j) {
      int k = 32 * ks + 8 * fq + j, part = k >> 6, n2 = k & 63, k2 = 16 * wid + fr;
      float2 t = tw[(k2 * n2) & 63];
      zr[j] = f2bf(part ? t.y : t.x);
      zi[j] = f2bf(part ? t.x : -t.y);
    }
    uint4 a0, a1;
    a0.x = zr[0] | ((unsigned)zr[1] << 16); a0.y = zr[2] | ((unsigned)zr[3] << 16);
    a0.z = zr[4] | ((unsigned)zr[5] << 16); a0.w = zr[6] | ((unsigned)zr[7] << 16);
    a1.x = zi[0] | ((unsigned)zi[1] << 16); a1.y = zi[2] | ((unsigned)zi[3] << 16);
    a1.z = zi[4] | ((unsigned)zi[5] << 16); a1.w = zi[6] | ((unsigned)zi[7] << 16);
    wb[0][ks] = __builtin_bit_cast(bf16x8, a0);
    wb[1][ks] = __builtin_bit_cast(bf16x8, a1);
  }
  const bf16_t* l16 = reinterpret_cast<const bf16_t*>(lds);
  const float scale = 0.0013810679320049757f;
  for (int u = lbid(); u < NB * 128; u += lnblk()) {
    int b = u >> 7, k1 = (u >> 1) & 63, hf = u & 1;
    __syncthreads();
#pragma unroll
    for (int i = 0; i < 16; ++i) {
      int row = (tid >> 5) + 8 * i, piece = tid & 31;
      int part = row >> 6, n2 = row & 63;
      uint4 v = *reinterpret_cast<const uint4*>(p->fa + (size_t)(b * SEQ + k1 * 64 + n2) * 1024 + part * 512 + hf * 256 + piece * 8);
      *reinterpret_cast<uint4*>(lds + row * 528 + piece * 16) = v;
    }
    __syncthreads();
    for (int nb = 0; nb < 2; ++nb) {
      f32x4 acc[2][8];
#pragma unroll
      for (int n = 0; n < 8; ++n) {
        acc[0][n] = f32x4{0.f, 0.f, 0.f, 0.f};
        acc[1][n] = f32x4{0.f, 0.f, 0.f, 0.f};
      }
#pragma unroll
      for (int ks = 0; ks < 4; ++ks)
#pragma unroll
        for (int nf = 0; nf < 8; ++nf) {
          bf16x8 bfr = lds_col8(l16 + (32 * ks + 8 * fq) * 264 + 128 * nb + 16 * nf + fr, 264);
          acc[0][nf] = __builtin_amdgcn_mfma_f32_16x16x32_bf16(wb[0][ks], bfr, acc[0][nf], 0, 0, 0);
          acc[1][nf] = __builtin_amdgcn_mfma_f32_16x16x32_bf16(wb[1][ks], bfr, acc[1][nf], 0, 0, 0);
        }
#pragma unroll
      for (int j = 0; j < 4; ++j) {
        int k2 = 16 * wid + 4 * fq + j;
        bf16_t* o = p->mix + (size_t)(b * SEQ + k1 + 64 * k2) * LDMIX + 512 + hf * 256 + 128 * nb + fr;
#pragma unroll
        for (int nf = 0; nf < 8; ++nf) {
          o[16 * nf] = f2bf(acc[0][nf][j] * scale);
          o[512 + 16 * nf] = f2bf(acc[1][nf][j] * scale);
        }
      }
    }
  }
  __syncthreads();
}

DEVI void phase_dft_ctx(PP p, unsigned char* lds) {
  float2* tw = reinterpret_cast<float2*>(lds);
  fill_tw(tw, 256);
  int tid = ltid();
  const float scale = 0.005524271728019903f;
  for (int u = lbid(); u < NB * 16; u += lnblk()) {
    int b = u >> 4, k0 = (u & 15) * 16;
    for (int pass = 0; pass < 2; ++pass) {
      int ch = tid + pass * 256;
      float zr[16], zi[16];
#pragma unroll
      for (int kk = 0; kk < 16; ++kk) zr[kk] = zi[kk] = 0.f;
      for (int n = 0; n < 256; ++n) {
        float v = bf2f(p->P[(size_t)(TL + b * CTX + n) * 2048 + 768 + ch]);
#pragma unroll
        for (int kk = 0; kk < 16; ++kk) {
          float2 t = tw[(n * (k0 + kk)) & 255];
          zr[kk] += v * t.x;
          zi[kk] -= v * t.y;
        }
      }
#pragma unroll
      for (int kk = 0; kk < 16; ++kk) {
        bf16_t* o = p->mix + (size_t)(TL + b * CTX + k0 + kk) * LDMIX;
        o[512 + ch] = f2bf(zr[kk] * scale);
        o[1024 + ch] = f2bf(zi[kk] * scale);
      }
    }
  }
  __syncthreads();
}

DEVI void phase_sgu(PP p, int j, int nchunks, unsigned char* lds) {
  float* rs = reinterpret_cast<float*>(lds);
  const int tid = ltid();
  const int lane = tid & 63, wid = tid >> 6, fr = lane & 15, fq = lane >> 4;
  const float* nw = p->gs_norm_w + j * 1024;
  for (int u = lbid(); u < nchunks * 8; u += lnblk()) {
    const int chunk = u >> 3, g = u & 7;
    const int tok0 = chunk * 128;
    const bf16_t* vT = p->zvT + (size_t)chunk * 1024 * 128;
    if (tid < 128) {
      const float* rp = p->rowss + (size_t)chunk * 16 * 128 + tid;
      float ss = 0.f;
#pragma unroll
      for (int sl = 0; sl < 16; ++sl) ss += rp[sl * 128];
      rs[tid] = rsqrtf(ss * (1.f / 1024.f) + 1e-6f);
    }
    __syncthreads();
    const float* wsg = p->gs_w_s + ((size_t)j * 8 + g) * 128 * 128;
    const float* bsg = p->gs_b_s + ((size_t)j * 8 + g) * 128;
    f32x4 acc[2][8];
#pragma unroll
    for (int m = 0; m < 2; ++m)
#pragma unroll
      for (int n = 0; n < 8; ++n) acc[m][n] = f32x4{0.f, 0.f, 0.f, 0.f};
#pragma unroll
    for (int ks = 0; ks < 4; ++ks) {
      bf16x8 a[2];
      const float* rsk = rs + 32 * ks + 8 * fq;
#pragma unroll
      for (int m = 0; m < 2; ++m) {
        const float4* wp = reinterpret_cast<const float4*>(wsg + (size_t)(32 * wid + 16 * m + fr) * 128 + 32 * ks + 8 * fq);
        float4 w0 = wp[0], w1 = wp[1];
        uint4 pk;
        pk.x = pack2(w0.x * rsk[0], w0.y * rsk[1]);
        pk.y = pack2(w0.z * rsk[2], w0.w * rsk[3]);
        pk.z = pack2(w1.x * rsk[4], w1.y * rsk[5]);
        pk.w = pack2(w1.z * rsk[6], w1.w * rsk[7]);
        a[m] = __builtin_bit_cast(bf16x8, pk);
      }
#pragma unroll
      for (int n = 0; n < 8; ++n) {
        bf16x8 bfr = *reinterpret_cast<const bf16x8*>(vT + (size_t)(g * 128 + 16 * n + fr) * 128 + 32 * ks + 8 * fq);
        acc[0][n] = __builtin_amdgcn_mfma_f32_16x16x32_bf16(a[0], bfr, acc[0][n], 0, 0, 0);
        acc[1][n] = __builtin_amdgcn_mfma_f32_16x16x32_bf16(a[1], bfr, acc[1][n], 0, 0, 0);
      }
    }
#pragma unroll
    for (int m = 0; m < 2; ++m)
#pragma unroll
      for (int jj = 0; jj < 4; ++jj) {
        int pp = 32 * wid + 16 * m + 4 * fq + jj;
        float bias = bsg[pp];
        const bf16_t* up = p->P + (size_t)(tok0 + pp) * 2048 + g * 128 + fr;
        bf16_t* op = p->mix + (size_t)(tok0 + pp) * LDMIX + g * 128 + fr;
#pragma unroll
        for (int n = 0; n < 8; ++n) {
          float sv = nw[g * 128 + 16 * n + fr] * acc[m][n][jj] + bias;
          op[16 * n] = f2bf(bf2f(up[16 * n]) * sv);
        }
      }
    __syncthreads();
  }
}

DEVI float mkkey(float v, unsigned idx, unsigned mask) { return __uint_as_float((__float_as_uint(v) & ~mask) | idx); }
#define INSERT16(list, x)                                                                                               \
  {                                                                                                                     \
    _Pragma("unroll") for (int i_ = 15; i_ >= 1; --i_) list[i_] = __builtin_amdgcn_fmed3f(list[i_ - 1], list[i_], x); \
    list[0] = fmaxf(list[0], x);                                                                                        \
  }

DEVI void phase_route(PP p, int layer, int ntok, unsigned char* lds) {
  const int tid = ltid();
  const int lane = tid & 63, wid = tid >> 6, fr = lane & 15, fq = lane >> 4;
  float* keys = reinterpret_cast<float*>(lds);
  float* ex = keys;
  float* fin = keys + 128 * 17;
  const int nunits = (ntok / 64) * 8;
  const float NEGK = -3.0e38f;
  for (int u = lbid(); u < nunits; u += lnblk()) {
    const int tt = u >> 3, hh = u & 7;
    const int tok0 = tt * 64;
#pragma unroll
    for (int half = 0; half < 2; ++half) {
      const bf16_t* qa = p->P + (size_t)(tok0 + wid * 16 + fr) * 2048 + hh * 256 + half * 128 + fq * 8;
      const bf16_t* kb = p->keysb + ((size_t)((layer * 8 + hh) * 2 + half) * 128) * 128 + fq * 8;
      bf16x8 a[4];
#pragma unroll
      for (int ks = 0; ks < 4; ++ks) a[ks] = *reinterpret_cast<const bf16x8*>(qa + ks * 32);
#pragma unroll
      for (int nf = 0; nf < 8; ++nf) {
        f32x4 acc = f32x4{0.f, 0.f, 0.f, 0.f};
#pragma unroll
        for (int ks = 0; ks < 4; ++ks) {
          bf16x8 bb = *reinterpret_cast<const bf16x8*>(kb + (size_t)(nf * 16 + fr) * 128 + ks * 32);
          acc = __builtin_amdgcn_mfma_f32_16x16x32_bf16(a[ks], bb, acc, 0, 0, 0);
        }
#pragma unroll
        for (int j = 0; j < 4; ++j) {
          int row = (wid * 16 + fq * 4 + j) * 2 + half;
          int kidx = nf * 16 + fr;
          keys[row * 129 + kidx] = mkkey(acc[j], (unsigned)kidx, 127u);
        }
      }
    }
    __syncthreads();
    const int row = tid & 127, part = tid >> 7;
    float list[16];
#pragma unroll
    for (int i = 0; i < 16; ++i) list[i] = NEGK;
    {
      const float* kr = keys + row * 129 + part * 64;
#pragma unroll 4
      for (int e = 0; e < 64; ++e) {
        float x = kr[e];
        INSERT16(list, x)
      }
    }
    __syncthreads();
    if (part == 1) {
#pragma unroll
      for (int i = 0; i < 16; ++i) ex[row * 17 + i] = list[i];
    }
    __syncthreads();
    if (part == 0) {
#pragma unroll
      for (int i = 0; i < 16; ++i) {
        float x = ex[row * 17 + i];
        INSERT16(list, x)
      }
#pragma unroll
      for (int i = 0; i < 16; ++i) fin[row * 17 + i] = list[i];
    }
    __syncthreads();
    if (tid < 64) {
      const float* f0 = fin + (2 * tid) * 17;
      const float* f1 = fin + (2 * tid + 1) * 17;
      float v0[16], v1[16];
#pragma unroll
      for (int i = 0; i < 16; ++i) {
        v0[i] = f0[i];
        v1[i] = f1[i];
      }
      float l2[16];
#pragma unroll
      for (int i = 0; i < 16; ++i) l2[i] = NEGK;
#pragma unroll
      for (int a = 0; a < 16; ++a)
#pragma unroll
        for (int bq = 0; bq < 16; ++bq)
          if ((a + 1) * (bq + 1) <= 16) {
            float x = mkkey(v0[a] + v1[bq], (unsigned)(a * 16 + bq), 255u);
            INSERT16(l2, x)
          }
      float sv[16];
      int ev[16];
      float mx = NEGK;
#pragma unroll
      for (int k = 0; k < 16; ++k) {
        unsigned ab = __float_as_uint(l2[k]) & 255u;
        unsigned k0 = __float_as_uint(f0[ab >> 4]), k1 = __float_as_uint(f1[ab & 15u]);
        sv[k] = __uint_as_float(k0 & ~127u) + __uint_as_float(k1 & ~127u);
        ev[k] = (int)((k0 & 127u) * 128u + (k1 & 127u));
        mx = fmaxf(mx, sv[k]);
      }
      float sum = 0.f;
#pragma unroll
      for (int k = 0; k < 16; ++k) {
        sv[k] = __expf(sv[k] - mx);
        sum += sv[k];
      }
      float inv = 1.f / sum;
      size_t o = (size_t)(tok0 + tid) * 128 + hh * 16;
      int4* eo = reinterpret_cast<int4*>(p->eidx + o);
      float4* go = reinterpret_cast<float4*>(p->gate + o);
#pragma unroll
      for (int k4 = 0; k4 < 4; ++k4) {
        eo[k4] = make_int4(ev[4 * k4], ev[4 * k4 + 1], ev[4 * k4 + 2], ev[4 * k4 + 3]);
        go[k4] = make_float4(sv[4 * k4] * inv, sv[4 * k4 + 1] * inv, sv[4 * k4 + 2] * inv, sv[4 * k4 + 3] * inv);
      }
    }
    __syncthreads();
  }
}

typedef float v2f __attribute__((ext_vector_type(2)));
DEVI void dec16(uint4 q, v2f* f) {
  f[0] = __builtin_amdgcn_cvt_pk_f32_fp8((int)q.x, false);
  f[1] = __builtin_amdgcn_cvt_pk_f32_fp8((int)q.x, true);
  f[2] = __builtin_amdgcn_cvt_pk_f32_fp8((int)q.y, false);
  f[3] = __builtin_amdgcn_cvt_pk_f32_fp8((int)q.y, true);
  f[4] = __builtin_amdgcn_cvt_pk_f32_fp8((int)q.z, false);
  f[5] = __builtin_amdgcn_cvt_pk_f32_fp8((int)q.z, true);
  f[6] = __builtin_amdgcn_cvt_pk_f32_fp8((int)q.w, false);
  f[7] = __builtin_amdgcn_cvt_pk_f32_fp8((int)q.w, true);
}
struct ExpBuf {
  uint4 q[8];
  uint4 h0, h1;
};
DEVI void exp_load(ExpBuf& B, const unsigned char* tab, const signed char* hrow, const unsigned short* idp, int j8, bool want_x) {
#pragma unroll
  for (int i = 0; i < 8; ++i) {
    unsigned off = (unsigned)idp[8 * i] * (unsigned)D + 16u * j8;
    B.q[i] = *reinterpret_cast<const uint4*>(tab + off);
  }
  if (want_x) B.h0 = *reinterpret_cast<const uint4*>(hrow + 16 * j8);
}
template <int CTRL>
DEVI int dpp_movi(int v) { return __builtin_amdgcn_mov_dpp(v, CTRL, 0xF, 0xF, true); }
DEVI void exp_u_compute(const ExpBuf& B, int* pp, int j8) {
  int s0 = 0;
#pragma unroll
  for (int i = 0; i < 8; ++i) {
    int d = __builtin_amdgcn_sdot4((int)B.q[i].x, (int)B.h0.x, 0, false);
    d = __builtin_amdgcn_sdot4((int)B.q[i].y, (int)B.h0.y, d, false);
    d = __builtin_amdgcn_sdot4((int)B.q[i].z, (int)B.h0.z, d, false);
    d = __builtin_amdgcn_sdot4((int)B.q[i].w, (int)B.h0.w, d, false);
    d += dpp_movi<0xB1>(d);
    d += dpp_movi<0x4E>(d);
    d += dpp_movi<0x141>(d);
    s0 = (j8 == i) ? d : s0;
  }
  pp[0] += s0;
}
DEVI void exp_v_accum(const ExpBuf& B, unsigned w0, unsigned w1, int* acc) {
#pragma unroll
  for (int ig = 0; ig < 2; ++ig) {
    const unsigned wq = ig ? w1 : w0;
    const uint4 R0 = B.q[4 * ig], R1 = B.q[4 * ig + 1], R2 = B.q[4 * ig + 2], R3 = B.q[4 * ig + 3];
    const unsigned r0[4] = {R0.x, R0.y, R0.z, R0.w}, r1[4] = {R1.x, R1.y, R1.z, R1.w};
    const unsigned r2[4] = {R2.x, R2.y, R2.z, R2.w}, r3[4] = {R3.x, R3.y, R3.z, R3.w};
#pragma unroll
    for (int q = 0; q < 4; ++q) {
      unsigned A = __builtin_amdgcn_perm(r1[q], r0[q], 0x05010400u);
      unsigned Bq = __builtin_amdgcn_perm(r1[q], r0[q], 0x07030602u);
      unsigned C = __builtin_amdgcn_perm(r3[q], r2[q], 0x05010400u);
      unsigned E = __builtin_amdgcn_perm(r3[q], r2[q], 0x07030602u);
      unsigned D0 = __builtin_amdgcn_perm(C, A, 0x05040100u);
      unsigned D1 = __builtin_amdgcn_perm(C, A, 0x07060302u);
      unsigned D2 = __builtin_amdgcn_perm(E, Bq, 0x05040100u);
      unsigned D3 = __builtin_amdgcn_perm(E, Bq, 0x07060302u);
      acc[4 * q + 0] = __builtin_amdgcn_sdot4((int)D0, (int)wq, acc[4 * q + 0], false);
      acc[4 * q + 1] = __builtin_amdgcn_sdot4((int)D1, (int)wq, acc[4 * q + 1], false);
      acc[4 * q + 2] = __builtin_amdgcn_sdot4((int)D2, (int)wq, acc[4 * q + 2], false);
      acc[4 * q + 3] = __builtin_amdgcn_sdot4((int)D3, (int)wq, acc[4 * q + 3], false);
    }
  }
}
DEVI void exp_v_finish(float4* xo, const float4* xq, const float4* gq, int* acc, float swt, int grp, float gscale) {
  float o[16];
#pragma unroll
  for (int k = 0; k < 16; ++k) {
    int a = acc[k];
    a += dpp_movi<0x128>(a);
    a += __shfl_xor(a, 16);
    a += __shfl_xor(a, 32);
    o[k] = (float)a;
    acc[k] = 0;
  }
  if (grp == 0) {
    const float sc = gscale * swt;
#pragma unroll
    for (int i4 = 0; i4 < 4; ++i4) {
      float4 r = xq[i4];
      r.x += sc * gq[i4].x * o[i4 * 4 + 0];
      r.y += sc * gq[i4].y * o[i4 * 4 + 1];
      r.z += sc * gq[i4].z * o[i4 * 4 + 2];
      r.w += sc * gq[i4].w * o[i4 * 4 + 3];
      xo[i4] = r;
    }
  }
}
DEVI void phase_expert(PP p, int layer, int ntok, unsigned char* lds, float gscale = 1.f, int idmask = 0xffff) {
  const int tid = ltid();
  const int lane = tid & 63, wid = tid >> 6, j8 = lane & 7, grp = lane >> 3;
  const int nb = lnblk(), bid = lbid();
  unsigned short* ids = reinterpret_cast<unsigned short*>(lds);
  float* part = reinterpret_cast<float*>(lds + TPB * 128 * 2);
  unsigned char* w8 = lds + TPB * 128 * 2 + TPB * 128 * 4;
  float* swl = reinterpret_cast<float*>(lds + TPB * 128 * 2 + TPB * 128 * 4 + TPB * 128);
  const unsigned char* ut = p->utab + (size_t)layer * NEXP * D;
  const unsigned char* vt = p->vtab + (size_t)layer * NEXP * D;
  int tpb = (ntok + nb - 1) / nb;
  if (tpb > TPB) tpb = TPB;
  const int npass = (ntok + nb * tpb - 1) / (nb * tpb);
  for (int pass = 0; pass < npass; ++pass) {
    const int tok0 = (pass * nb + bid) * tpb;
    int cnt = ntok - tok0;
    if (cnt > tpb) cnt = tpb;
    if (cnt < 0) cnt = 0;
    for (int i = tid; i < cnt * 128; i += NTHREADS) {
      ids[i] = (unsigned short)(p->eidx[(size_t)tok0 * 128 + i] & idmask);
      part[i] = 0.f;
    }
    __syncthreads();
    const int ntw = (cnt - wid + 3) >> 2;
    const int npair = ntw * 8;
#define EXP_PAIR(pr_, c_, tl_) const int c_ = (pr_) / ntw, tl_ = wid + 4 * ((pr_) - c_ * ntw);
    if (!(REP_MODE == 1 && gscale != 1.f)) {
      ExpBuf B0, B1;
      if (npair > 0) {
        EXP_PAIR(0, c0, t0)
        exp_load(B0, ut + 128 * c0, p->h8 + (size_t)(tok0 + t0) * D + 128 * c0, ids + t0 * 128 + grp, j8, true);
      }
      for (int pr = 0; pr < npair; ++pr) {
        EXP_PAIR(pr, c0, t0)
        exp_load(B1, ut + 128 * c0, p->h8 + (size_t)(tok0 + t0) * D + 128 * c0, ids + t0 * 128 + 64 + grp, j8, true);
        exp_u_compute(B0, reinterpret_cast<int*>(part) + t0 * 128 + 8 * j8 + grp, j8);
        {
          const int prn = (pr + 1 < npair) ? pr + 1 : pr;
          EXP_PAIR(prn, c1, t1)
          exp_load(B0, ut + 128 * c1, p->h8 + (size_t)(tok0 + t1) * D + 128 * c1, ids + t1 * 128 + grp, j8, true);
        }
        exp_u_compute(B1, reinterpret_cast<int*>(part) + t0 * 128 + 64 + 8 * j8 + grp, j8);
      }
    }
    __syncthreads();
    for (int t = wid; t < cnt; t += 4) {
      float wv2[2];
      float am = 0.f;
#pragma unroll
      for (int hh = 0; hh < 2; ++hh) {
        int k = lane + 64 * hh;
        int e = ids[t * 128 + k];
        float dq = (float)reinterpret_cast<int*>(part)[t * 128 + k] * p->su[(size_t)layer * NEXP + e] * p->sx[tok0 + t];
        float wv = p->gate[(size_t)(tok0 + t) * 128 + k] * gelu_tanh(dq) * p->sv[(size_t)layer * NEXP + e];
        wv2[hh] = wv;
        am = fmaxf(am, fabsf(wv));
      }
      am = fmaxf(wave_max(am), 1e-30f);
      float qs = 127.f / am;
#pragma unroll
      for (int hh = 0; hh < 2; ++hh) {
        int k = lane + 64 * hh;
        int q = (int)rintf(wv2[hh] * qs);
        w8[t * 128 + (k & 7) * 16 + hh * 8 + ((k >> 3) & 7)] = (unsigned char)(q & 255);
      }
      if (lane == 0) swl[t] = am * (1.f / 127.f);
    }
    __syncthreads();
    if (!(REP_MODE == 2 && gscale != 1.f)) {
      ExpBuf B0, B1;
      int acc[16];
#pragma unroll
      for (int k = 0; k < 16; ++k) acc[k] = 0;
      if (npair > 0) {
        EXP_PAIR(0, c0, t0)
        exp_load(B0, vt + 128 * c0, (const signed char*)nullptr, ids + t0 * 128 + grp, j8, false);
      }
      for (int pr = 0; pr < npair; ++pr) {
        EXP_PAIR(pr, c0, t0)
        float4 xq[4], gq[4];
        float4* xo = reinterpret_cast<float4*>(p->xs + (size_t)(tok0 + t0) * D + 128 * c0 + 16 * j8);
        {
          const float4* gf = reinterpret_cast<const float4*>(p->mod + ((size_t)layer * 9 + tok_batch(tok0 + t0)) * 6144 + 5 * 1024 + 128 * c0 + 16 * j8);
#pragma unroll
          for (int i4 = 0; i4 < 4; ++i4) {
            xq[i4] = xo[i4];
            gq[i4] = gf[i4];
          }
        }
        exp_load(B1, vt + 128 * c0, (const signed char*)nullptr, ids + t0 * 128 + 64 + grp, j8, false);
        const uint4 wq = *reinterpret_cast<const uint4*>(w8 + t0 * 128 + grp * 16);
        exp_v_accum(B0, wq.x, wq.y, acc);
        {
          const int prn = (pr + 1 < npair) ? pr + 1 : pr;
          EXP_PAIR(prn, c1, t1)
          exp_load(B0, vt + 128 * c1, (const signed char*)nullptr, ids + t1 * 128 + grp, j8, false);
        }
        exp_v_accum(B1, wq.z, wq.w, acc);
        exp_v_finish(xo, xq, gq, acc, swl[t0], grp, gscale);
      }
    }
#undef EXP_PAIR
    __syncthreads();
  }
}

#define XB_TMO 128
#define XB_XCNT(j) (256 + 64 * (j))
#define XB_XSUB(j) (1280 + 64 * (j))
#define XB_XGEN(j) (2304 + 64 * (j))
#define XB_TOP 3328
#define XB_TOPGEN 3392
#define XCD_BAR_WORDS 3456
#define XB_SPIN_CAP (1u << 22)
#define LAS __attribute__((address_space(3)))
DEVI unsigned xb_ld(unsigned* p) { return __hip_atomic_load(p, __ATOMIC_RELAXED, __HIP_MEMORY_SCOPE_AGENT); }
DEVI unsigned xb_add(unsigned* p, unsigned v) { return __hip_atomic_fetch_add(p, v, __ATOMIC_RELAXED, __HIP_MEMORY_SCOPE_AGENT); }
DEVI unsigned xb_xcc_id() { return (unsigned)__builtin_amdgcn_s_getreg((3 << 11) | 20) & 0xFu; }
#define XB_SPIN(cond, bar)                                   \
  do {                                                       \
    unsigned _sp = 0;                                        \
    while (cond) {                                           \
      __builtin_amdgcn_s_sleep(1);                           \
      if ((++_sp & 255u) == 0u) {                            \
        if (xb_ld(&(bar)[XB_TMO])) break;                    \
        if (_sp > XB_SPIN_CAP) {                             \
          atomicAdd(&(bar)[XB_TMO], 1u);                     \
          break;                                             \
        }                                                    \
      }                                                      \
    }                                                        \
  } while (0)
struct XcdBarrier {
  unsigned* bar;
  unsigned x;
  volatile LAS unsigned* st;
};
DEVI XcdBarrier xcd_barrier_post(unsigned* bar, volatile LAS unsigned* st) {
  XcdBarrier b;
  b.bar = bar;
  b.x = xb_xcc_id();
  b.st = st;
  if (threadIdx.x == 0) (void)xb_add(&bar[XB_XCNT(b.x)], 1u);
  return b;
}
DEVI void xcd_barrier_complete(unsigned* bar, unsigned x, unsigned& nloc, unsigned& nx) {
  const unsigned G = gridDim.x * gridDim.y * gridDim.z;
  unsigned sum, cnt, mine, sp = 0u;
  for (;;) {
    sum = 0u;
    cnt = 0u;
    mine = 0u;
#pragma unroll
    for (unsigned j = 0; j < 16; ++j) {
      const unsigned c = xb_ld(&bar[XB_XCNT(j)]);
      sum += c;
      cnt += (c > 0u) ? 1u : 0u;
      mine = (j == x) ? c : mine;
    }
    if (sum == G) break;
    __builtin_amdgcn_s_sleep(1);
    if ((++sp & 255u) == 0u) {
      if (xb_ld(&bar[XB_TMO])) break;
      if (sp > XB_SPIN_CAP) {
        atomicAdd(&bar[XB_TMO], 1u);
        break;
      }
    }
  }
  nloc = mine > 0u ? mine : 1u;
  nx = cnt > 0u ? cnt : 1u;
}
DEVI void xcd_barrier(const XcdBarrier& b) {
  asm volatile("s_waitcnt vmcnt(0)" ::: "memory");
  __syncthreads();
  if (threadIdx.x == 0) {
    unsigned* bar = b.bar;
    __builtin_amdgcn_s_waitcnt(0);
    unsigned nloc = b.st[0], nx = b.st[1];
    if (nloc == 0u) {
      xcd_barrier_complete(bar, b.x, nloc, nx);
      b.st[0] = nloc;
      b.st[1] = nx;
    }
    const unsigned old = xb_add(&bar[XB_XSUB(b.x)], 1u);
    const unsigned gen = old / nloc;
    if (old + 1u == (gen + 1u) * nloc) {
      __builtin_amdgcn_fence(__ATOMIC_RELEASE, "agent");
      asm volatile("s_waitcnt vmcnt(0)" ::: "memory");
      const unsigned og = xb_add(&bar[XB_TOP], 1u);
      const unsigned tg = og / nx;
      if (og + 1u == (tg + 1u) * nx) xb_add(&bar[XB_TOPGEN], 1u);
      else XB_SPIN(xb_ld(&bar[XB_TOPGEN]) == tg, bar);
      __builtin_amdgcn_fence(__ATOMIC_ACQUIRE, "agent");
      xb_add(&bar[XB_XGEN(b.x)], 1u);
      asm volatile("s_waitcnt vmcnt(0)" ::: "memory");
    } else {
      XB_SPIN(xb_ld(&bar[XB_XGEN(b.x)]) == gen, bar);
      __builtin_amdgcn_fence(__ATOMIC_ACQUIRE, "agent");
      asm volatile("s_waitcnt vmcnt(0)" ::: "memory");
    }
  }
  __syncthreads();
}

DEVI bool step_active(int step) {
  if (step == 0 || step == NSTEPS - 1) return true;
  int layer = (step - 1) / STEPS_PER_LAYER, ph = (step - 1) % STEPS_PER_LAYER;
  if (ph == 3 && (layer & 1)) return false;
  return true;
}

DEVI void run_step(PP p, int step, unsigned char* lds, float gscale = 1.f) {
  if (step == 0) {
    phase_prep(p, lds);
    return;
  }
  if (step == NSTEPS - 1) {
    phase_norm(p, 0, 2, TL);
    return;
  }
  int layer = (step - 1) / STEPS_PER_LAYER, ph = (step - 1) % STEPS_PER_LAYER;
  bool even = (layer & 1) == 0;
  int j = layer >> 1;
  bool upd_ctx = layer < 2;
  bool need_ctx = layer < 3;
  int nt_in = need_ctx ? TT : TL;
  int nt = upd_ctx ? TT : TL;
  switch (ph) {
    case 0: phase_norm(p, layer, 0, nt_in); break;
    case 1:
      if (even)
        gemm_phase<EPI_INPROJ>(p, p->h, D, p->wt_in_ab + (size_t)j * 1280 * D, D, nt_in / 128, 10, D, layer, lds);
      else
        gemm_phase<EPI_GELU>(p, p->h, D, p->wt_in_gs + (size_t)j * 2048 * D, D, nt / 128, 16, D, layer, lds);
      break;
    case 2:
      if (even) {
        phase_fft_a(p, lds);
        if (upd_ctx) phase_dft_ctx(p, lds);
        phase_attn(p, layer, upd_ctx);
      } else {
        phase_sgu(p, j, nt / 128, lds);
      }
      break;
    case 3:
      if (even) phase_fft_b(p, lds);
      break;
    case 4:
      if (even)
        gemm_phase<EPI_RESID>(p, p->mix, LDMIX, p->wt_out_ab + (size_t)j * D * LDMIX, LDMIX, nt / 128, 8, LDMIX, layer, lds, gscale);
      else
        gemm_phase<EPI_RESID>(p, p->mix, LDMIX, p->wt_out_gs + (size_t)j * D * D, D, nt / 128, 8, D, layer, lds, gscale);
      break;
    case 5: phase_norm(p, layer, 1, nt); break;
    case 6: gemm_phase<EPI_STORE>(p, p->h, D, p->wt_q + (size_t)layer * 2048 * D, D, nt / 128, 16, D, layer, lds); break;
    case 7: phase_route(p, layer, nt, lds); break;
    case 8: phase_expert(p, layer, nt, lds, gscale, (gscale == 1.f) ? 0xffff : REP_IDMASK); break;
  }
}

__global__ void __launch_bounds__(NTHREADS, 2) mega(Params p_unused, int step_lo, int step_hi) {
  __shared__ __attribute__((aligned(16))) unsigned char lds[LDS_BYTES];
  PP pp = (PP)__builtin_amdgcn_kernarg_segment_ptr();
  volatile LAS unsigned* st = (volatile LAS unsigned*)(lds + LDS_BYTES - 16);
  if (threadIdx.x == 0) {
    st[0] = 0u;
    st[1] = 0u;
  }
  __syncthreads();
  XcdBarrier xb = xcd_barrier_post(pp->bar, st);
  int nsync = 0;
  bool first = true;
  for (int s = step_lo; s < step_hi; ++s) {
    if (!step_active(s)) continue;
    if (!first) {
      if (nsync == 0) cg::this_grid().sync();
      else xcd_barrier(xb);
      ++nsync;
    }
    first = false;
    PP q = pp;
    asm volatile("" : "+s"(q));
    run_step(q, s, lds);
#if REP_MASK
    if (s == 0 && ((REP_MASK >> 15) & 1)) {
      xcd_barrier(xb);
      PP q2 = pp;
      asm volatile("" : "+s"(q2));
      run_step(q2, 0, lds);
    }
    if (s > 0 && s < NSTEPS - 1) {
      int lay_ = (s - 1) / STEPS_PER_LAYER, ph_ = (s - 1) % STEPS_PER_LAYER;
      bool rep_ = (REP_MASK >> ph_) & 1;
      if (ph_ == 2 && ((REP_MASK >> 9) & 1) && !(lay_ & 1)) rep_ = true;
      if (ph_ == 2 && ((REP_MASK >> 10) & 1) && (lay_ & 1)) rep_ = true;
      if (rep_) {
        xcd_barrier(xb);
        PP q2 = pp;
        asm volatile("" : "+s"(q2));
        float z = 0.f;
        asm volatile("" : "+s"(z));
        run_step(q2, s, lds, z);
      }
      if (ph_ == 2 && ((REP_MASK >> 11) & 1) && !(lay_ & 1)) {
        xcd_barrier(xb);
        PP q2 = pp;
        asm volatile("" : "+s"(q2));
        phase_attn(q2, lay_, lay_ < 2);
      }
    }
#endif
  }
}

static size_t align_up(size_t v) { return (v + 255) & ~(size_t)255; }

extern "C" void kernel_launch(void* const* d_in, const int* in_sizes, int n_in, void* d_out, int out_size, void* d_ws,
                              size_t ws_size, hipStream_t stream) {
  Params p{};
  p.x = (const float*)d_in[0];
  p.c = (const float*)d_in[1];
  p.ctx = (const float*)d_in[2];
  p.c_ctx = (const float*)d_in[3];
  p.ada_w = (const float*)d_in[4];
  p.ada_b = (const float*)d_in[5];
  p.norm_mix_w = (const float*)d_in[6];
  p.norm_ffn_w = (const float*)d_in[7];
  p.ab_w_in = (const float*)d_in[8];
  p.ab_w_out = (const float*)d_in[9];
  p.attn_sink = (const float*)d_in[10];
  p.gs_w_in = (const float*)d_in[11];
  p.gs_norm_w = (const float*)d_in[12];
  p.gs_w_s = (const float*)d_in[13];
  p.gs_b_s = (const float*)d_in[14];
  p.gs_w_out = (const float*)d_in[15];
  p.peer_w_q = (const float*)d_in[16];
  p.peer_keys = (const float*)d_in[17];
  p.peer_u = (const float*)d_in[18];
  p.peer_v = (const float*)d_in[19];
  p.norm_out_w = (const float*)d_in[20];
  p.out = (float*)d_out;
  unsigned char* w = (unsigned char*)d_ws;
  size_t off = 0;
  auto take = [&](size_t bytes) {
    unsigned char* r = w + off;
    off = align_up(off + bytes);
    return r;
  };
  p.bar = (unsigned*)take((size_t)XCD_BAR_WORDS * 4);
  p.mod = (float*)take((size_t)DEPTH * 9 * 6144 * 4);
  p.cs = (float2*)take(64 * 16 * 8);
  p.xs = (float*)take((size_t)TT * D * 4);
  p.h = (bf16_t*)take((size_t)TT * D * 2);
  p.P = (bf16_t*)take((size_t)TT * 2048 * 2);
  p.kbuf = (bf16_t*)take((size_t)NB * 2 * KVLEN * 64 * 2);
  p.vbuf = (bf16_t*)take((size_t)NB * 2 * KVLEN * 64 * 2);
  p.zvT = (bf16_t*)take((size_t)TT * 1024 * 2);
  p.rowss = (float*)take((size_t)(TT / 128) * 16 * 128 * 4);
  p.mix = (bf16_t*)take((size_t)TT * LDMIX * 2);
  p.fa = (bf16_t*)take((size_t)TL * 1024 * 2);
  p.eidx = (int*)take((size_t)TT * 128 * 4);
  p.gate = (float*)take((size_t)TT * 128 * 4);
  p.wt_in_ab = (bf16_t*)take((size_t)2 * 1280 * D * 2);
  p.wt_out_ab = (bf16_t*)take((size_t)2 * D * LDMIX * 2);
  p.wt_in_gs = (bf16_t*)take((size_t)2 * 2048 * D * 2);
  p.wt_out_gs = (bf16_t*)take((size_t)2 * D * D * 2);
  p.wt_q = (bf16_t*)take((size_t)DEPTH * 2048 * D * 2);
  p.keysb = (bf16_t*)take((size_t)DEPTH * 8 * 2 * 128 * 128 * 2);
  p.su = (float*)take((size_t)DEPTH * NEXP * 4);
  p.sv = (float*)take((size_t)DEPTH * NEXP * 4);
  p.h8 = (signed char*)take((size_t)TT * D);
  p.sx = (float*)take((size_t)TT * 4);
  p.utab = (unsigned char*)take((size_t)DEPTH * NEXP * D);
  p.vtab = (unsigned char*)take((size_t)DEPTH * NEXP * D);
  if (off > ws_size) {
    fprintf(stderr, "workspace too small: need %zu have %zu\n", off, ws_size);
    return;
  }
  hipMemsetAsync(p.bar, 0, (size_t)XCD_BAR_WORDS * 4, stream);
  static int grid_blocks = 0;
  if (!grid_blocks) {
    int dev = 0, cus = 0, per_cu = 0;
    hipGetDevice(&dev);
    hipDeviceGetAttribute(&cus, hipDeviceAttributeMultiprocessorCount, dev);
    hipOccupancyMaxActiveBlocksPerMultiprocessor(&per_cu, mega, NTHREADS, 0);
    if (per_cu > 2) per_cu = 2;
    if (per_cu < 1) per_cu = 1;
    grid_blocks = cus * per_cu;
  }
#if ONE_LAUNCH
  int lo = 0, hi = NSTEPS;
  void* args[] = {&p, &lo, &hi};
  hipError_t e = hipLaunchCooperativeKernel((void*)mega, dim3(grid_blocks), dim3(NTHREADS), args, 0, stream);
  if (e != hipSuccess) fprintf(stderr, "cooperative launch failed: %s (grid %d)\n", hipGetErrorString(e), grid_blocks);
#else
  for (int s = 0; s < NSTEPS; ++s) {
    if (s != 0 && s != NSTEPS - 1) {
      int layer = (s - 1) / STEPS_PER_LAYER, ph = (s - 1) % STEPS_PER_LAYER;
      if (ph == 3 && (layer & 1)) continue;
    }
    hipLaunchKernelGGL(mega, dim3(grid_blocks), dim3(NTHREADS), 0, stream, p, s, s + 1);
  }
#endif
}
```

```cpp
#include <hip/hip_runtime.h>
#include <hip/hip_bf16.h>
#include <hip/hip_cooperative_groups.h>
#include <cstdio>
namespace cg = cooperative_groups;

#ifndef REP_MASK
#define REP_MASK 0
#endif
#ifndef REP_MODE
#define REP_MODE 0
#endif
#ifndef REP_IDMASK
#define REP_IDMASK 0xffff
#endif
#ifndef ONE_LAUNCH
#define ONE_LAUNCH 1
#endif

#define DEVI __device__ __forceinline__
typedef unsigned short bf16_t;
using bf16x8 = __attribute__((ext_vector_type(8))) short;
using f32x4 = __attribute__((ext_vector_type(4))) float;
using f32x16 = __attribute__((ext_vector_type(16))) float;

constexpr int D = 1024, NB = 8, SEQ = 4096, CTX = 256, DEPTH = 4;
constexpr int TL = NB * SEQ, TC = NB * CTX, TT = TL + TC;
constexpr int KVLEN = CTX + SEQ;
constexpr int NEXP = 16384;
constexpr int LDMIX = 1536;
constexpr float USCALE = 64.f, VSCALE = 8.f;
constexpr int TPB = 68;
constexpr int LDS_BYTES = 68 * 1024;
constexpr int NTHREADS = 256;
constexpr int STEPS_PER_LAYER = 9;
constexpr int NSTEPS = 1 + DEPTH * STEPS_PER_LAYER + 1;

struct Params {
  const float *x, *c, *ctx, *c_ctx, *ada_w, *ada_b, *norm_mix_w, *norm_ffn_w, *ab_w_in, *ab_w_out, *attn_sink,
      *gs_w_in, *gs_norm_w, *gs_w_s, *gs_b_s, *gs_w_out, *peer_w_q, *peer_keys, *peer_u, *peer_v, *norm_out_w;
  float* out;
  float* mod;
  float2* cs;
  float* xs;
  bf16_t* h;
  bf16_t* P;
  bf16_t* kbuf;
  bf16_t* vbuf;
  float* rowss;
  bf16_t* zvT;
  bf16_t* mix;
  bf16_t* fa;
  unsigned* bar;
  float* tops;
  int* eidx;
  float* gate;
  bf16_t *wt_in_ab, *wt_out_ab, *wt_in_gs, *wt_out_gs, *wt_q, *keysb;
  unsigned char *utab, *vtab;
  float* su;
  float* sv;
  signed char* h8;
  float* sx;
};

typedef const __attribute__((address_space(4))) Params* PP;

DEVI int ltid() { int t = threadIdx.x; asm volatile("" : "+v"(t)); return t; }
DEVI int lbid() { int t = blockIdx.x; asm volatile("" : "+s"(t)); return t; }
DEVI int lnblk() { int t = gridDim.x; asm volatile("" : "+s"(t)); return t; }

DEVI bf16_t f2bf(float f) {
  unsigned u = __float_as_uint(f);
  u += 0x7fffu + ((u >> 16) & 1u);
  return (bf16_t)(u >> 16);
}
DEVI float bf2f(bf16_t h) { return __uint_as_float(((unsigned)h) << 16); }
DEVI float bflo(unsigned u) { return __uint_as_float(u << 16); }
DEVI float bfhi(unsigned u) { return __uint_as_float(u & 0xffff0000u); }
DEVI unsigned pack2(float a, float b) { return (unsigned)f2bf(a) | ((unsigned)f2bf(b) << 16); }
DEVI float wave_sum(float v) {
#pragma unroll
  for (int o = 32; o > 0; o >>= 1) v += __shfl_xor(v, o);
  return v;
}
DEVI float wave_max(float v) {
#pragma unroll
  for (int o = 32; o > 0; o >>= 1) v = fmaxf(v, __shfl_xor(v, o));
  return v;
}
DEVI float gelu_tanh(float x) {
  float u = 0.7978845608028654f * (x + 0.044715f * x * x * x);
  return 0.5f * x * (1.f + tanhf(u));
}
template <int CTRL>
DEVI float dpp_mov(float v) {
  return __builtin_bit_cast(float, __builtin_amdgcn_mov_dpp(__builtin_bit_cast(int, v), CTRL, 0xF, 0xF, true));
}
DEVI int tok_batch(int r) { return r < TL ? (r >> 12) : 8; }

DEVI void prep_transpose_tile(const float* __restrict__ src, int N, bf16_t* __restrict__ dst, int ldk, int tk, int tn, float* tile, int tid) {
#pragma unroll
  for (int i = 0; i < 16; ++i) {
    int r = (tid >> 6) + 4 * i;
    tile[r * 65 + (tid & 63)] = src[(size_t)(tk * 64 + r) * N + tn * 64 + (tid & 63)];
  }
  __syncthreads();
#pragma unroll
  for (int i = 0; i < 16; ++i) {
    int n = (tid >> 6) + 4 * i, k = tid & 63;
    dst[(size_t)(tn * 64 + n) * ldk + tk * 64 + k] = f2bf(tile[k * 65 + n]);
  }
}

constexpr int PU_ADA = DEPTH * 96;
constexpr int PU_T_ABIN = 2 * 16 * 20;
constexpr int PU_T_GSIN = 2 * 16 * 32;
constexpr int PU_T_GSOUT = 2 * 16 * 16;
constexpr int PU_T_ABOUT = 2 * 8 * 16;
constexpr int PU_T_Q = DEPTH * 16 * 32;
constexpr int PU_FOLD = 2 * 512 * 1024 / 256;
constexpr int PU_CONV = DEPTH * NEXP * D / 4 / 2048;
constexpr int PU_KEYS = DEPTH * 8 * 2 * 128 * 128 / 4 / 2048;
constexpr int PU_UROWS = DEPTH * NEXP / 32;
constexpr int PU_TOTAL = PU_ADA + PU_T_ABIN + PU_T_GSIN + PU_T_GSOUT + PU_T_ABOUT + PU_T_Q + PU_FOLD + 2 * PU_UROWS + PU_KEYS + 1;

DEVI void phase_prep(PP p, unsigned char* lds) {
  const int tid = ltid();
  float* fl = reinterpret_cast<float*>(lds);
  for (int u0 = lbid(); u0 < PU_TOTAL; u0 += lnblk()) {
    int u = u0;
    if (u < PU_ADA) {
      float* sl = fl;
      for (int i = tid; i < 9 * 1024; i += NTHREADS) {
        int r = i >> 10, k = i & 1023;
        float v = (r < 8) ? p->c[r * 1024 + k] : p->c_ctx[k];
        sl[i] = v / (1.f + __expf(-v));
      }
      __syncthreads();
      float* red = sl + 9 * 1024;
      int ks = tid >> 6, col = tid & 63;
      int layer = u / 96, c0 = (u % 96) * 64;
      const float* w = p->ada_w + (size_t)layer * D * 6144 + c0 + col;
      float acc[9];
#pragma unroll
      for (int r = 0; r < 9; ++r) acc[r] = 0.f;
      for (int k0 = ks * 256; k0 < ks * 256 + 256; k0 += 16) {
        float wv[16];
#pragma unroll
        for (int kk = 0; kk < 16; ++kk) wv[kk] = w[(size_t)(k0 + kk) * 6144];
#pragma unroll
        for (int kk = 0; kk < 16; ++kk)
#pragma unroll
          for (int r = 0; r < 9; ++r) acc[r] += sl[r * 1024 + k0 + kk] * wv[kk];
      }
#pragma unroll
      for (int r = 0; r < 9; ++r) red[(ks * 9 + r) * 64 + col] = acc[r];
      __syncthreads();
      for (int i = tid; i < 9 * 64; i += NTHREADS) {
        int r = i >> 6, cc = i & 63;
        float sm = red[(0 * 9 + r) * 64 + cc] + red[(1 * 9 + r) * 64 + cc] + red[(2 * 9 + r) * 64 + cc] + red[(3 * 9 + r) * 64 + cc];
        sm += p->ada_b[(size_t)layer * 6144 + c0 + cc];
        p->mod[((size_t)layer * 9 + r) * 6144 + c0 + cc] = sm;
      }
      __syncthreads();
      continue;
    }
    u -= PU_ADA;
    if (u < PU_T_ABIN) {
      int j = u / 320, t = u % 320;
      prep_transpose_tile(p->ab_w_in + (size_t)j * D * 1280, 1280, p->wt_in_ab + (size_t)j * 1280 * D, D, t / 20, t % 20, fl, tid);
      __syncthreads();
      continue;
    }
    u -= PU_T_ABIN;
    if (u < PU_T_GSIN) {
      int j = u / 512, t = u % 512;
      prep_transpose_tile(p->gs_w_in + (size_t)j * D * 2048, 2048, p->wt_in_gs + (size_t)j * 2048 * D, D, t / 32, t % 32, fl, tid);
      __syncthreads();
      continue;
    }
    u -= PU_T_GSIN;
    if (u < PU_T_GSOUT) {
      int j = u / 256, t = u % 256;
      prep_transpose_tile(p->gs_w_out + (size_t)j * D * D, D, p->wt_out_gs + (size_t)j * D * D, D, t / 16, t % 16, fl, tid);
      __syncthreads();
      continue;
    }
    u -= PU_T_GSOUT;
    if (u < PU_T_ABOUT) {
      int j = u / 128, t = u % 128;
      prep_transpose_tile(p->ab_w_out + (size_t)j * D * D, D, p->wt_out_ab + (size_t)j * D * LDMIX, LDMIX, t / 16, t % 16, fl, tid);
      __syncthreads();
      continue;
    }
    u -= PU_T_ABOUT;
    if (u < PU_T_Q) {
      int i = u / 512, t = u % 512;
      prep_transpose_tile(p->peer_w_q + (size_t)i * D * 2048, 2048, p->wt_q + (size_t)i * 2048 * D, D, t / 32, t % 32, fl, tid);
      __syncthreads();
      continue;
    }
    u -= PU_T_Q;
    if (u < PU_FOLD) {
      float2* tw = reinterpret_cast<float2*>(lds);
      if (tid < 128) {
        float sn, cn;
        sincospif((float)tid / 64.f, &sn, &cn);
        tw[tid] = make_float2(cn, sn);
      }
      __syncthreads();
      size_t i = (size_t)u * 256 + tid;
      int n = (int)(i & 1023);
      int gm = (int)((i >> 10) & 511);
      int j = (int)(i >> 19);
      int g = gm >> 7, m = gm & 127;
      const float* w = p->ab_w_out + (size_t)j * D * D + (size_t)(512 + g * 128) * D + n;
      float ar = 0.f, ai = 0.f;
#pragma unroll 16
      for (int l = 0; l < 128; ++l) {
        float2 t = tw[(m * l) & 127];
        float wv = w[(size_t)l * D];
        ar += t.x * wv;
        ai += t.y * wv;
      }
      bf16_t* dst = p->wt_out_ab + (size_t)j * D * LDMIX + (size_t)n * LDMIX;
      dst[512 + gm] = f2bf(ar);
      dst[1024 + gm] = f2bf(ai);
      __syncthreads();
      continue;
    }
    u -= PU_FOLD;
    if (u < 2 * PU_UROWS) {
      const bool isv = u >= PU_UROWS;
      if (isv) u -= PU_UROWS;
      const float* src = isv ? p->peer_v : p->peer_u;
      unsigned char* dst = isv ? p->vtab : p->utab;
      float* sdst = isv ? p->sv : p->su;
      const int lane = tid & 63, wv = tid >> 6;
#pragma unroll 1
      for (int rr = 0; rr < 8; rr += 4) {
        size_t row0 = (size_t)u * 32 + wv * 8 + rr;
        float4 v[4][4];
#pragma unroll
        for (int k = 0; k < 4; ++k)
#pragma unroll
          for (int i = 0; i < 4; ++i) v[k][i] = reinterpret_cast<const float4*>(src + (row0 + k) * D)[lane * 4 + i];
#pragma unroll
        for (int k = 0; k < 4; ++k) {
          float am = 0.f;
#pragma unroll
          for (int i = 0; i < 4; ++i)
            am = fmaxf(am, fmaxf(fmaxf(fabsf(v[k][i].x), fabsf(v[k][i].y)), fmaxf(fabsf(v[k][i].z), fabsf(v[k][i].w))));
          am = wave_max(am);
          am = fmaxf(am, 1e-30f);
          float qs = 127.f / am;
          uint4 o;
          unsigned* op = reinterpret_cast<unsigned*>(&o);
#pragma unroll
          for (int i = 0; i < 4; ++i) {
            int q0 = (int)rintf(v[k][i].x * qs), q1 = (int)rintf(v[k][i].y * qs), q2 = (int)rintf(v[k][i].z * qs), q3 = (int)rintf(v[k][i].w * qs);
            op[i] = (unsigned)(q0 & 255) | ((unsigned)(q1 & 255) << 8) | ((unsigned)(q2 & 255) << 16) | ((unsigned)(q3 & 255) << 24);
          }
          reinterpret_cast<uint4*>(dst + (row0 + k) * D)[lane] = o;
          if (lane == 0) sdst[row0 + k] = am * (1.f / 127.f);
        }
      }
      continue;
    }
    u -= 2 * PU_UROWS;
    if (u < PU_KEYS) {
      const float4* s4 = reinterpret_cast<const float4*>(p->peer_keys) + (size_t)u * 2048 + tid;
      uint2* d2 = reinterpret_cast<uint2*>(p->keysb) + (size_t)u * 2048 + tid;
#pragma unroll
      for (int k = 0; k < 8; ++k) {
        float4 v = s4[k * 256];
        uint2 o;
        o.x = pack2(v.x, v.y);
        o.y = pack2(v.z, v.w);
        d2[k * 256] = o;
      }
      continue;
    }
    for (int i = tid; i < 64 * 16; i += NTHREADS) {
      int pos = i >> 4, k = i & 15;
      float inv = powf(10000.f, -(float)k / 16.f);
      float ang = (float)pos * inv;
      float sn, cn;
      sincosf(ang, &sn, &cn);
      p->cs[i] = make_float2(cn, sn);
    }
  }
}

DEVI void phase_norm(PP p, int layer, int which, int ntok) {
  int lane = ltid() & 63;
  int gw = lbid() * 4 + (ltid() >> 6), nw = lnblk() * 4;
  const float* w = which == 0 ? p->norm_mix_w + layer * D : (which == 1 ? p->norm_ffn_w + layer * D : p->norm_out_w);
  for (int tok = gw; tok < ntok; tok += nw) {
    const float* xsrc = p->xs + (size_t)tok * D;
    if (which == 0 && layer == 0) xsrc = (tok < TL) ? p->x + (size_t)tok * D : p->ctx + (size_t)(tok - TL) * D;
    const float4* xr = reinterpret_cast<const float4*>(xsrc);
    float4 v[4];
    float ss = 0.f;
#pragma unroll
    for (int i = 0; i < 4; ++i) {
      v[i] = xr[lane + 64 * i];
      ss += v[i].x * v[i].x + v[i].y * v[i].y + v[i].z * v[i].z + v[i].w * v[i].w;
    }
    ss = wave_sum(ss);
    float rstd = rsqrtf(ss * (1.f / 1024.f) + 1e-6f);
    if (which == 2) {
      float4* o = reinterpret_cast<float4*>(p->out + (size_t)tok * D);
#pragma unroll
      for (int i = 0; i < 4; ++i) {
        float4 wv = reinterpret_cast<const float4*>(w)[lane + 64 * i];
        float4 r;
        r.x = v[i].x * rstd * wv.x;
        r.y = v[i].y * rstd * wv.y;
        r.z = v[i].z * rstd * wv.z;
        r.w = v[i].w * rstd * wv.w;
        o[lane + 64 * i] = r;
      }
    } else {
      int b = tok_batch(tok);
      const float* mb = p->mod + ((size_t)layer * 9 + b) * 6144 + (which == 0 ? 0 : 3072);
      uint2* o = reinterpret_cast<uint2*>(p->h + (size_t)tok * D);
      float av[4][4];
      float am = 0.f;
#pragma unroll
      for (int i = 0; i < 4; ++i) {
        float4 wv = reinterpret_cast<const float4*>(w)[lane + 64 * i];
        float4 sh = reinterpret_cast<const float4*>(mb)[lane + 64 * i];
        float4 sc = reinterpret_cast<const float4*>(mb + 1024)[lane + 64 * i];
        float a0 = v[i].x * rstd * wv.x * (1.f + sc.x) + sh.x;
        float a1 = v[i].y * rstd * wv.y * (1.f + sc.y) + sh.y;
        float a2 = v[i].z * rstd * wv.z * (1.f + sc.z) + sh.z;
        float a3 = v[i].w * rstd * wv.w * (1.f + sc.w) + sh.w;
        uint2 r;
        r.x = pack2(a0, a1);
        r.y = pack2(a2, a3);
        o[lane + 64 * i] = r;
        av[i][0] = a0; av[i][1] = a1; av[i][2] = a2; av[i][3] = a3;
        am = fmaxf(am, fmaxf(fmaxf(fabsf(a0), fabsf(a1)), fmaxf(fabsf(a2), fabsf(a3))));
      }
      if (which == 1) {
        am = fmaxf(wave_max(am), 1e-30f);
        float qs = 127.f / am;
        unsigned* o8 = reinterpret_cast<unsigned*>(p->h8 + (size_t)tok * D);
#pragma unroll
        for (int i = 0; i < 4; ++i) {
          int q0 = (int)rintf(av[i][0] * qs), q1 = (int)rintf(av[i][1] * qs), q2 = (int)rintf(av[i][2] * qs), q3 = (int)rintf(av[i][3] * qs);
          o8[lane + 64 * i] = (unsigned)(q0 & 255) | ((unsigned)(q1 & 255) << 8) | ((unsigned)(q2 & 255) << 16) | ((unsigned)(q3 & 255) << 24);
        }
        if (lane == 0) p->sx[tok] = am * (1.f / 127.f);
      }
    }
  }
}

enum { EPI_STORE = 0, EPI_GELU = 1, EPI_RESID = 2, EPI_INPROJ = 3 };

template <int EPI>
DEVI void gemm_phase(PP p, const bf16_t* __restrict__ A, int lda, const bf16_t* __restrict__ Bt, int ldb,
                     int Mtiles, int Ntiles, int K, int layer, unsigned char* lds, float gscale = 1.f) {
  const int tid = ltid();
  const int wid = tid >> 6, lane = tid & 63, wr = wid >> 1, wc = wid & 1, fr = lane & 15, fq = lane >> 4;
  int nblk = lnblk();
  int bid = lbid();
  int lb = ((nblk & 7) == 0) ? ((bid & 7) * (nblk >> 3) + (bid >> 3)) : bid;
  int ntiles = Mtiles * Ntiles;
  const int nk = K / 64;
  const int srow = tid >> 3;
  const int scol = ((tid & 7) ^ ((tid >> 3) & 7)) * 8;
#define GEMM_STAGE(ga_, gb_, kt_, buf_)                                                                               \
  {                                                                                                                   \
    _Pragma("unroll") for (int i_ = 0; i_ < 4; ++i_) {                                                                \
      __builtin_amdgcn_global_load_lds((const unsigned*)((ga_) + (size_t)(32 * i_) * lda + (kt_) * 64),               \
                                       (__attribute__((address_space(3))) unsigned*)(lds + (buf_) * 32768 + tid * 16 + i_ * 4096), 16, 0, 0); \
      __builtin_amdgcn_global_load_lds((const unsigned*)((gb_) + (size_t)(32 * i_) * ldb + (kt_) * 64),               \
                                       (__attribute__((address_space(3))) unsigned*)(lds + (buf_) * 32768 + 16384 + tid * 16 + i_ * 4096), 16, 0, 0); \
    }                                                                                                                 \
  }
  if (lb < ntiles) {
    int tm0 = lb / Ntiles, tn0 = lb % Ntiles;
    const bf16_t* ga0 = A + (size_t)(tm0 * 128 + srow) * lda + scol;
    const bf16_t* gb0 = Bt + (size_t)(tn0 * 128 + srow) * ldb + scol;
    GEMM_STAGE(ga0, gb0, 0, 0)
  }
  for (int t = lb; t < ntiles; t += nblk) {
    int tm = t / Ntiles, tn = t % Ntiles;
    int brow = tm * 128, bcol = tn * 128;
    f32x4 acc[4][4];
#pragma unroll
    for (int m = 0; m < 4; ++m)
#pragma unroll
      for (int n = 0; n < 4; ++n) acc[m][n] = f32x4{0.f, 0.f, 0.f, 0.f};
    const bf16_t* ga = A + (size_t)(brow + srow) * lda + scol;
    const bf16_t* gb = Bt + (size_t)(bcol + srow) * ldb + scol;
    for (int kt = 0; kt < nk; ++kt) {
      const int buf = kt & 1;
      asm volatile("s_waitcnt vmcnt(0)" ::: "memory");
      __syncthreads();
      if (kt + 1 < nk) GEMM_STAGE(ga, gb, kt + 1, buf ^ 1)
      const unsigned char* SA = lds + buf * 32768;
      const unsigned char* SB = SA + 16384;
      bf16x8 At[2][4], Bl[2][4];
#pragma unroll
      for (int ks = 0; ks < 2; ++ks)
#pragma unroll
        for (int m = 0; m < 4; ++m) {
          const int sl = ((ks * 4 + fq) ^ (fr & 7)) << 4;
          At[ks][m] = *reinterpret_cast<const bf16x8*>(SA + (wr * 64 + m * 16 + fr) * 128 + sl);
          Bl[ks][m] = *reinterpret_cast<const bf16x8*>(SB + (wc * 64 + m * 16 + fr) * 128 + sl);
        }
#pragma unroll
      for (int ks = 0; ks < 2; ++ks)
#pragma unroll
        for (int m = 0; m < 4; ++m)
#pragma unroll
          for (int n = 0; n < 4; ++n)
            acc[m][n] = __builtin_amdgcn_mfma_f32_16x16x32_bf16(At[ks][m], Bl[ks][n], acc[m][n], 0, 0, 0);
    }
    {
      int t2 = t + nblk;
      if (t2 < ntiles) {
        int tm2 = t2 / Ntiles, tn2 = t2 % Ntiles;
        const bf16_t* ga2 = A + (size_t)(tm2 * 128 + srow) * lda + scol;
        const bf16_t* gb2 = Bt + (size_t)(tn2 * 128 + srow) * ldb + scol;
        GEMM_STAGE(ga2, gb2, 0, 0)
      }
    }
    const int colbase = bcol + wc * 64;
    if constexpr (EPI == EPI_STORE || EPI == EPI_GELU) {
      if (EPI == EPI_GELU && colbase >= 1024) {
        float* rsp = p->rowss + ((size_t)tm * 16 + (tn - 8) * 2 + wc) * 128;
#pragma unroll
        for (int m = 0; m < 4; ++m) {
          float ssq[4] = {0.f, 0.f, 0.f, 0.f};
#pragma unroll
          for (int n = 0; n < 4; ++n) {
            int ch = colbase - 1024 + n * 16 + fr;
            int q0 = wr * 64 + m * 16 + fq * 4;
            float g0 = gelu_tanh(acc[m][n][0]), g1 = gelu_tanh(acc[m][n][1]), g2 = gelu_tanh(acc[m][n][2]), g3 = gelu_tanh(acc[m][n][3]);
            ssq[0] += g0 * g0;
            ssq[1] += g1 * g1;
            ssq[2] += g2 * g2;
            ssq[3] += g3 * g3;
            uint2 o;
            o.x = pack2(g0, g1);
            o.y = pack2(g2, g3);
            *reinterpret_cast<uint2*>(p->zvT + ((size_t)tm * 1024 + ch) * 128 + q0) = o;
          }
#pragma unroll
          for (int j = 0; j < 4; ++j) {
            float v = ssq[j];
            v += dpp_mov<0xB1>(v);
            v += dpp_mov<0x4E>(v);
            v += dpp_mov<0x141>(v);
            v += dpp_mov<0x140>(v);
            if (fr == 0) rsp[wr * 64 + m * 16 + fq * 4 + j] = v;
          }
        }
      } else {
#pragma unroll
        for (int m = 0; m < 4; ++m)
#pragma unroll
          for (int j = 0; j < 4; ++j) {
            int row = brow + wr * 64 + m * 16 + fq * 4 + j;
            bf16_t* o = p->P + (size_t)row * 2048 + colbase + fr;
#pragma unroll
            for (int n = 0; n < 4; ++n) {
              float v = acc[m][n][j];
              if (EPI == EPI_GELU) v = gelu_tanh(v);
              o[n * 16] = f2bf(v);
            }
          }
      }
    } else if constexpr (EPI == EPI_RESID) {
#pragma unroll
      for (int m = 0; m < 4; ++m)
#pragma unroll
        for (int j = 0; j < 4; ++j) {
          int row = brow + wr * 64 + m * 16 + fq * 4 + j;
          int b = tok_batch(row);
          const float* g = p->mod + ((size_t)layer * 9 + b) * 6144 + 2048 + colbase + fr;
          float* o = p->xs + (size_t)row * D + colbase + fr;
          const float* xi = o;
          if (layer == 0 && gscale == 1.f)
            xi = ((row < TL) ? p->x + (size_t)row * D : p->ctx + (size_t)(row - TL) * D) + colbase + fr;
#pragma unroll
          for (int n = 0; n < 4; ++n) o[n * 16] = xi[n * 16] + gscale * g[n * 16] * acc[m][n][j];
        }
    } else if constexpr (EPI == EPI_INPROJ) {
      if (colbase >= 640 && colbase < 768) {
        int kvh = (colbase - 640) >> 6;
#pragma unroll
        for (int m = 0; m < 4; ++m) {
          int row0 = brow + wr * 64 + m * 16;
          bool latent = row0 < TL;
          int b = latent ? (row0 >> 12) : ((row0 - TL) >> 8);
          int kp16 = latent ? (CTX + (row0 & 4095)) : ((row0 - TL) & 255);
          int slot = kp16 + 8 * (fq & 1) + 4 * (fq >> 1);
#pragma unroll
          for (int n = 0; n < 4; ++n) {
            int dim = n * 16 + fr;
            uint2 o;
            o.x = pack2(acc[m][n][0], acc[m][n][1]);
            o.y = pack2(acc[m][n][2], acc[m][n][3]);
            *reinterpret_cast<uint2*>(p->vbuf + ((size_t)(b * 2 + kvh) * 64 + dim) * KVLEN + slot) = o;
          }
        }
      } else {
#pragma unroll
        for (int m = 0; m < 4; ++m)
#pragma unroll
          for (int j = 0; j < 4; ++j) {
            int row = brow + wr * 64 + m * 16 + fq * 4 + j;
            bool latent = row < TL;
            int b, pos;
            if (latent) {
              b = row >> 12;
              pos = row & 4095;
            } else {
              b = (row - TL) >> 8;
              pos = (row - TL) & 255;
            }
            float v0 = acc[m][0][j], v1 = acc[m][1][j], v2 = acc[m][2][j], v3 = acc[m][3][j];
            if (latent && colbase < 640) {
              float2 cr = p->cs[(pos >> 6) * 16 + fr];
              float2 cc = p->cs[(pos & 63) * 16 + fr];
              float a = v0, bb = v1;
              v0 = a * cr.x - bb * cr.y;
              v1 = bb * cr.x + a * cr.y;
              a = v2;
              bb = v3;
              v2 = a * cc.x - bb * cc.y;
              v3 = bb * cc.x + a * cc.y;
            }
            bf16_t* o;
            if (colbase < 512 || colbase >= 768) {
              o = p->P + (size_t)row * 2048 + colbase + fr;
            } else {
              int kvh = (colbase - 512) >> 6;
              int kp = latent ? (CTX + pos) : pos;
              o = p->kbuf + ((size_t)(b * 2 + kvh) * KVLEN + kp) * 64 + fr;
            }
            o[0] = f2bf(v0);
            o[16] = f2bf(v1);
            o[32] = f2bf(v2);
            o[48] = f2bf(v3);
          }
      }
    }
  }
}

DEVI bf16x8 scale_q(uint4 u) {
  uint4 r;
  r.x = pack2(bflo(u.x) * 0.125f, bfhi(u.x) * 0.125f);
  r.y = pack2(bflo(u.y) * 0.125f, bfhi(u.y) * 0.125f);
  r.z = pack2(bflo(u.z) * 0.125f, bfhi(u.z) * 0.125f);
  r.w = pack2(bflo(u.w) * 0.125f, bfhi(u.w) * 0.125f);
  return __builtin_bit_cast(bf16x8, r);
}
DEVI void phase_attn(PP p, int layer, bool with_ctx_q) {
  const int tid = ltid();
  const int lane = tid & 63, wid = tid >> 6, r = lane & 31, h = lane >> 5;
  const float* sinkp = p->attn_sink + (layer >> 1) * 8;
  const int nunits = 2048 + (with_ctx_q ? 128 : 0);
  for (int u = lbid(); u < nunits; u += lnblk()) {
    bool latent = u < 2048;
    int b, kvh, qg, tokbase;
    if (latent) {
      b = u >> 8;
      kvh = (u >> 7) & 1;
      qg = u & 127;
      tokbase = b * SEQ + qg * 32;
    } else {
      int v = u - 2048;
      b = v >> 4;
      kvh = (v >> 3) & 1;
      qg = v & 7;
      tokbase = TL + b * CTX + qg * 32;
    }
    const int hd = kvh * 4 + wid;
    const bf16_t* kb = p->kbuf + (size_t)(b * 2 + kvh) * KVLEN * 64;
    const bf16_t* vt = p->vbuf + (size_t)(b * 2 + kvh) * 64 * KVLEN;
    bf16x8 qf[4];
    {
      const bf16_t* qp = p->P + (size_t)(tokbase + r) * 2048 + hd * 64 + 8 * h;
#pragma unroll
      for (int st = 0; st < 4; ++st) qf[st] = scale_q(*reinterpret_cast<const uint4*>(qp + 16 * st));
    }
    f32x16 O0, O1;
#pragma unroll
    for (int i = 0; i < 16; ++i) {
      O0[i] = 0.f;
      O1[i] = 0.f;
    }
    float m_run = sinkp[hd];
    float l_run = (h == 0) ? 1.f : 0.f;
    const int nkb = latent ? 17 : 8;
    for (int kbi = 0; kbi < nkb; ++kbi) {
      int kpos, mode = 0;
      if (kbi < 8) {
        kpos = kbi * 32;
      } else {
        int d = kbi - 12;
        int kblk = qg + d;
        if (kblk < 0 || kblk > 127) continue;
        kpos = CTX + kblk * 32;
        mode = (d == -4) ? 1 : ((d == 4) ? 2 : 0);
      }
      f32x16 S;
#pragma unroll
      for (int i = 0; i < 16; ++i) S[i] = 0.f;
#pragma unroll
      for (int st = 0; st < 4; ++st) {
        bf16x8 kf = *reinterpret_cast<const bf16x8*>(kb + (size_t)(kpos + r) * 64 + 16 * st + 8 * h);
        S = __builtin_amdgcn_mfma_f32_32x32x16_bf16(kf, qf[st], S, 0, 0, 0);
      }
      if (mode) {
#pragma unroll
        for (int i = 0; i < 16; ++i) {
          int kk = (i & 3) + 8 * (i >> 2) + 4 * h;
          bool ok = (mode == 1) ? (kk >= r) : (kk <= r);
          if (!ok) S[i] = -1e30f;
        }
      }
      float bm = S[0];
#pragma unroll
      for (int i = 1; i < 16; ++i) bm = fmaxf(bm, S[i]);
      bm = fmaxf(bm, __shfl_xor(bm, 32));
      float m_new = fmaxf(m_run, bm);
      float alpha = __expf(m_run - m_new);
      float psum = 0.f;
#pragma unroll
      for (int i = 0; i < 16; ++i) {
        S[i] = __expf(S[i] - m_new);
        psum += S[i];
      }
      l_run = l_run * alpha + psum;
      m_run = m_new;
#pragma unroll
      for (int i = 0; i < 16; ++i) {
        O0[i] *= alpha;
        O1[i] *= alpha;
      }
#pragma unroll
      for (int sidx = 0; sidx < 2; ++sidx) {
        uint4 pk;
        pk.x = pack2(S[8 * sidx + 0], S[8 * sidx + 1]);
        pk.y = pack2(S[8 * sidx + 2], S[8 * sidx + 3]);
        pk.z = pack2(S[8 * sidx + 4], S[8 * sidx + 5]);
        pk.w = pack2(S[8 * sidx + 6], S[8 * sidx + 7]);
        bf16x8 pf = __builtin_bit_cast(bf16x8, pk);
        bf16x8 v0 = *reinterpret_cast<const bf16x8*>(vt + (size_t)r * KVLEN + kpos + 16 * sidx + 8 * h);
        bf16x8 v1 = *reinterpret_cast<const bf16x8*>(vt + (size_t)(32 + r) * KVLEN + kpos + 16 * sidx + 8 * h);
        O0 = __builtin_amdgcn_mfma_f32_32x32x16_bf16(v0, pf, O0, 0, 0, 0);
        O1 = __builtin_amdgcn_mfma_f32_32x32x16_bf16(v1, pf, O1, 0, 0, 0);
      }
    }
    float l_tot = l_run + __shfl_xor(l_run, 32);
    float inv = 1.f / l_tot;
    bf16_t* op = p->mix + (size_t)(tokbase + r) * LDMIX + hd * 64 + 4 * h;
#pragma unroll
    for (int g4 = 0; g4 < 4; ++g4) {
      uint2 o;
      o.x = pack2(O0[4 * g4 + 0] * inv, O0[4 * g4 + 1] * inv);
      o.y = pack2(O0[4 * g4 + 2] * inv, O0[4 * g4 + 3] * inv);
      *reinterpret_cast<uint2*>(op + 8 * g4) = o;
      o.x = pack2(O1[4 * g4 + 0] * inv, O1[4 * g4 + 1] * inv);
      o.y = pack2(O1[4 * g4 + 2] * inv, O1[4 * g4 + 3] * inv);
      *reinterpret_cast<uint2*>(op + 32 + 8 * g4) = o;
    }
  }
}

DEVI void fill_tw(float2* tw, int n) {
  for (int i = ltid(); i < n; i += NTHREADS) {
    float sn, cn;
    sincospif(2.f * (float)i / (float)n, &sn, &cn);
    tw[i] = make_float2(cn, sn);
  }
  __syncthreads();
}

DEVI bf16x8 lds_col8(const bf16_t* bp, int stride) {
  unsigned e0 = bp[0], e1 = bp[stride], e2 = bp[2 * stride], e3 = bp[3 * stride];
  unsigned e4 = bp[4 * stride], e5 = bp[5 * stride], e6 = bp[6 * stride], e7 = bp[7 * stride];
  uint4 pk;
  pk.x = e0 | (e1 << 16);
  pk.y = e2 | (e3 << 16);
  pk.z = e4 | (e5 << 16);
  pk.w = e6 | (e7 << 16);
  return __builtin_bit_cast(bf16x8, pk);
}

DEVI void phase_fft_a(PP p, unsigned char* lds) {
  const int tid = ltid();
  const int lane = tid & 63, wid = tid >> 6, fr = lane & 15, fq = lane >> 4;
  float2* tw = reinterpret_cast<float2*>(lds + 66560);
  fill_tw(tw, 64);
  bf16x8 af[2][2];
#pragma unroll
  for (int ks = 0; ks < 2; ++ks) {
    unsigned short cr[8], ci[8];
#pragma unroll
    for (int j = 0; j < 8; ++j) {
      int n1 = 32 * ks + 8 * fq + j, k1 = 16 * wid + fr;
      float2 t = tw[(k1 * n1) & 63];
      cr[j] = f2bf(t.x);
      ci[j] = f2bf(-t.y);
    }
    uint4 a0, a1;
    a0.x = cr[0] | ((unsigned)cr[1] << 16); a0.y = cr[2] | ((unsigned)cr[3] << 16);
    a0.z = cr[4] | ((unsigned)cr[5] << 16); a0.w = cr[6] | ((unsigned)cr[7] << 16);
    a1.x = ci[0] | ((unsigned)ci[1] << 16); a1.y = ci[2] | ((unsigned)ci[3] << 16);
    a1.z = ci[4] | ((unsigned)ci[5] << 16); a1.w = ci[6] | ((unsigned)ci[7] << 16);
    af[0][ks] = __builtin_bit_cast(bf16x8, a0);
    af[1][ks] = __builtin_bit_cast(bf16x8, a1);
  }
  const bf16_t* l16 = reinterpret_cast<const bf16_t*>(lds);
  for (int u = lbid(); u < NB * 64; u += lnblk()) {
    int b = u >> 6, n2 = u & 63;
    __syncthreads();
#pragma unroll
    for (int i = 0; i < 16; ++i) {
      int row = (tid >> 6) + 4 * i, piece = tid & 63;
      uint4 v = *reinterpret_cast<const uint4*>(p->P + (size_t)(b * SEQ + 64 * row + n2) * 2048 + 768 + piece * 8);
      *reinterpret_cast<uint4*>(lds + row * 1040 + piece * 16) = v;
    }
    __syncthreads();
    float tc[4], ts[4];
#pragma unroll
    for (int j = 0; j < 4; ++j) sincospif((float)(n2 * (16 * wid + 4 * fq + j)) / 2048.f, &ts[j], &tc[j]);
    for (int nb = 0; nb < 4; ++nb) {
      f32x4 acc[2][8];
#pragma unroll
      for (int n = 0; n < 8; ++n) {
        acc[0][n] = f32x4{0.f, 0.f, 0.f, 0.f};
        acc[1][n] = f32x4{0.f, 0.f, 0.f, 0.f};
      }
#pragma unroll
      for (int ks = 0; ks < 2; ++ks)
#pragma unroll
        for (int nf = 0; nf < 8; ++nf) {
          bf16x8 bfr = lds_col8(l16 + (32 * ks + 8 * fq) * 520 + 128 * nb + 16 * nf + fr, 520);
          acc[0][nf] = __builtin_amdgcn_mfma_f32_16x16x32_bf16(af[0][ks], bfr, acc[0][nf], 0, 0, 0);
          acc[1][nf] = __builtin_amdgcn_mfma_f32_16x16x32_bf16(af[1][ks], bfr, acc[1][nf], 0, 0, 0);
        }
#pragma unroll
      for (int j = 0; j < 4; ++j) {
        int k1 = 16 * wid + 4 * fq + j;
        bf16_t* o = p->fa + (size_t)(b * SEQ + k1 * 64 + n2) * 1024 + 128 * nb + fr;
#pragma unroll
        for (int nf = 0; nf < 8; ++nf) {
          float re = acc[0][nf][j], im = acc[1][nf][j];
          o[16 * nf] = f2bf(re * tc[j] + im * ts[j]);
          o[512 + 16 * nf] = f2bf(im * tc[j] - re * ts[j]);
        }
      }
    }
  }
  __syncthreads();
}

DEVI void phase_fft_b(PP p, unsigned char* lds) {
  const int tid = ltid();
  const int lane = tid & 63, wid = tid >> 6, fr = lane & 15, fq = lane >> 4;
  float2* tw = reinterpret_cast<float2*>(lds + 67584);
  fill_tw(tw, 64);
  bf16x8 wb[2][4];
#pragma unroll
  for (int ks = 0; ks < 4; ++ks) {
    unsigned short zr[8], zi[8];
#pragma unroll
    for (int j = 0; j < 8; ++j) {
      int k = 32 * ks + 8 * fq + j, part = k >> 6, n2 = k & 63, k2 = 16 * wid + fr;
      float2 t = tw[(k2 * n2) & 63];
      zr[j] = f2bf(part ? t.y : t.x);
      zi[j] = f2bf(part ? t.x : -t.y);
    }
    uint4 a0, a1;
    a0.x = zr[0] | ((unsigned)zr[1] << 16); a0.y = zr[2] | ((unsigned)zr[3] << 16);
    a0.z = zr[4] | ((unsigned)zr[5] << 16); a0.w = zr[6] | ((unsigned)zr[7] << 16);
    a1.x = zi[0] | ((unsigned)zi[1] << 16); a1.y = zi[2] | ((unsigned)zi[3] << 16);
    a1.z = zi[4] | ((unsigned)zi[5] << 16); a1.w = zi[6] | ((unsigned)zi[7] << 16);
    wb[0][ks] = __builtin_bit_cast(bf16x8, a0);
    wb[1][ks] = __builtin_bit_cast(bf16x8, a1);
  }
  const bf16_t* l16 = reinterpret_cast<const bf16_t*>(lds);
  const float scale = 0.0013810679320049757f;
  for (int u = lbid(); u < NB * 128; u += lnblk()) {
    int b = u >> 7, k1 = (u >> 1) & 63, hf = u & 1;
    __syncthreads();
#pragma unroll
    for (int i = 0; i < 16; ++i) {
      int row = (tid >> 5) + 8 * i, piece = tid & 31;
      int part = row >> 6, n2 = row & 63;
      uint4 v = *reinterpret_cast<const uint4*>(p->fa + (size_t)(b * SEQ + k1 * 64 + n2) * 1024 + part * 512 + hf * 256 + piece * 8);
      *reinterpret_cast<uint4*>(lds + row * 528 + piece * 16) = v;
    }
    __syncthreads();
    for (int nb = 0; nb < 2; ++nb) {
      f32x4 acc[2][8];
#pragma unroll
      for (int n = 0; n < 8; ++n) {
        acc[0][n] = f32x4{0.f, 0.f, 0.f, 0.f};
        acc[1][n] = f32x4{0.f, 0.f, 0.f, 0.f};
      }
#pragma unroll
      for (int ks = 0; ks < 4; ++ks)
#pragma unroll
        for (int nf = 0; nf < 8; ++nf) {
          bf16x8 bfr = lds_col8(l16 + (32 * ks + 8 * fq) * 264 + 128 * nb + 16 * nf + fr, 264);
          acc[0][nf] = __builtin_amdgcn_mfma_f32_16x16x32_bf16(wb[0][ks], bfr, acc[0][nf], 0, 0, 0);
          acc[1][nf] = __builtin_amdgcn_mfma_f32_16x16x32_bf16(wb[1][ks], bfr, acc[1][nf], 0, 0, 0);
        }
#pragma unroll
      for (int j = 0; j < 4; ++j) {
        int k2 = 16 * wid + 4 * fq + j;
        bf16_t* o = p->mix + (size_t)(b * SEQ + k1 + 64 * k2) * LDMIX + 512 + hf * 256 + 128 * nb + fr;
#pragma unroll
        for (int nf = 0; nf < 8; ++nf) {
          o[16 * nf] = f2bf(acc[0][nf][j] * scale);
          o[512 + 16 * nf] = f2bf(acc[1][nf][j] * scale);
        }
      }
    }
  }
  __syncthreads();
}

DEVI void phase_dft_ctx(PP p, unsigned char* lds) {
  float2* tw = reinterpret_cast<float2*>(lds);
  fill_tw(tw, 256);
  int tid = ltid();
  const float scale = 0.005524271728019903f;
  for (int u = lbid(); u < NB * 64; u += lnblk()) {
    int b = u >> 6, k0 = (u & 63) * 4;
    for (int pass = 0; pass < 2; ++pass) {
      int ch = tid + pass * 256;
      float zr[4], zi[4];
#pragma unroll
      for (int kk = 0; kk < 4; ++kk) zr[kk] = zi[kk] = 0.f;
#pragma unroll 8
      for (int n = 0; n < 256; ++n) {
        float v = bf2f(p->P[(size_t)(TL + b * CTX + n) * 2048 + 768 + ch]);
#pragma unroll
        for (int kk = 0; kk < 4; ++kk) {
          float2 t = tw[(n * (k0 + kk)) & 255];
          zr[kk] += v * t.x;
          zi[kk] -= v * t.y;
        }
      }
#pragma unroll
      for (int kk = 0; kk < 4; ++kk) {
        bf16_t* o = p->mix + (size_t)(TL + b * CTX + k0 + kk) * LDMIX;
        o[512 + ch] = f2bf(zr[kk] * scale);
        o[1024 + ch] = f2bf(zi[kk] * scale);
      }
    }
  }
  __syncthreads();
}

DEVI void phase_sgu(PP p, int j, int nchunks, unsigned char* lds) {
  float* rs = reinterpret_cast<float*>(lds);
  const int tid = ltid();
  const int lane = tid & 63, wid = tid >> 6, fr = lane & 15, fq = lane >> 4;
  const float* nw = p->gs_norm_w + j * 1024;
  for (int u = lbid(); u < nchunks * 8; u += lnblk()) {
    const int chunk = u >> 3, g = u & 7;
    const int tok0 = chunk * 128;
    const bf16_t* vT = p->zvT + (size_t)chunk * 1024 * 128;
    if (tid < 128) {
      const float* rp = p->rowss + (size_t)chunk * 16 * 128 + tid;
      float ss = 0.f;
#pragma unroll
      for (int sl = 0; sl < 16; ++sl) ss += rp[sl * 128];
      rs[tid] = rsqrtf(ss * (1.f / 1024.f) + 1e-6f);
    }
    __syncthreads();
    const float* wsg = p->gs_w_s + ((size_t)j * 8 + g) * 128 * 128;
    const float* bsg = p->gs_b_s + ((size_t)j * 8 + g) * 128;
    f32x4 acc[2][8];
#pragma unroll
    for (int m = 0; m < 2; ++m)
#pragma unroll
      for (int n = 0; n < 8; ++n) acc[m][n] = f32x4{0.f, 0.f, 0.f, 0.f};
#pragma unroll
    for (int ks = 0; ks < 4; ++ks) {
      bf16x8 a[2];
      const float* rsk = rs + 32 * ks + 8 * fq;
#pragma unroll
      for (int m = 0; m < 2; ++m) {
        const float4* wp = reinterpret_cast<const float4*>(wsg + (size_t)(32 * wid + 16 * m + fr) * 128 + 32 * ks + 8 * fq);
        float4 w0 = wp[0], w1 = wp[1];
        uint4 pk;
        pk.x = pack2(w0.x * rsk[0], w0.y * rsk[1]);
        pk.y = pack2(w0.z * rsk[2], w0.w * rsk[3]);
        pk.z = pack2(w1.x * rsk[4], w1.y * rsk[5]);
        pk.w = pack2(w1.z * rsk[6], w1.w * rsk[7]);
        a[m] = __builtin_bit_cast(bf16x8, pk);
      }
#pragma unroll
      for (int n = 0; n < 8; ++n) {
        bf16x8 bfr = *reinterpret_cast<const bf16x8*>(vT + (size_t)(g * 128 + 16 * n + fr) * 128 + 32 * ks + 8 * fq);
        acc[0][n] = __builtin_amdgcn_mfma_f32_16x16x32_bf16(a[0], bfr, acc[0][n], 0, 0, 0);
        acc[1][n] = __builtin_amdgcn_mfma_f32_16x16x32_bf16(a[1], bfr, acc[1][n], 0, 0, 0);
      }
    }
#pragma unroll
    for (int m = 0; m < 2; ++m)
#pragma unroll
      for (int jj = 0; jj < 4; ++jj) {
        int pp = 32 * wid + 16 * m + 4 * fq + jj;
        float bias = bsg[pp];
        const bf16_t* up = p->P + (size_t)(tok0 + pp) * 2048 + g * 128 + fr;
        bf16_t* op = p->mix + (size_t)(tok0 + pp) * LDMIX + g * 128 + fr;
#pragma unroll
        for (int n = 0; n < 8; ++n) {
          float sv = nw[g * 128 + 16 * n + fr] * acc[m][n][jj] + bias;
          op[16 * n] = f2bf(bf2f(up[16 * n]) * sv);
        }
      }
    __syncthreads();
  }
}

DEVI float mkkey(float v, unsigned idx, unsigned mask) { return __uint_as_float((__float_as_uint(v) & ~mask) | idx); }
#define INSERT16(list, x)                                                                                               \
  {                                                                                                                     \
    _Pragma("unroll") for (int i_ = 15; i_ >= 1; --i_) list[i_] = __builtin_amdgcn_fmed3f(list[i_ - 1], list[i_], x); \
    list[0] = fmaxf(list[0], x);                                                                                        \
  }

DEVI void phase_route(PP p, int layer, int ntok, unsigned char* lds) {
  const int tid = ltid();
  const int lane = tid & 63, wid = tid >> 6, fr = lane & 15, fq = lane >> 4;
  const int nb8 = lnblk() >> 3, bid = lbid();
  const int hh = bid & 7, slot = bid >> 3;
  const int ntiles = ntok / 64;
  const bool active = slot < nb8;
  float* sc = reinterpret_cast<float*>(lds + 32768);
  const float NEGK = -3.0e38f;
  for (int half = 0; half < 2; ++half) {
    __syncthreads();
    {
      const bf16_t* ksrc = p->keysb + ((size_t)((layer * 8 + hh) * 2 + half) * 128) * 128;
#pragma unroll
      for (int i = 0; i < 8; ++i) {
        int idx = tid + 256 * i, row = idx >> 4, c = idx & 15;
        uint4 v = *reinterpret_cast<const uint4*>(ksrc + (size_t)row * 128 + c * 8);
        *reinterpret_cast<uint4*>(lds + row * 256 + ((c ^ (row & 15)) << 4)) = v;
      }
    }
    __syncthreads();
    bf16x8 an[4];
    if (active && slot < ntiles) {
      const bf16_t* qa = p->P + (size_t)(slot * 64 + wid * 16 + fr) * 2048 + hh * 256 + half * 128 + fq * 8;
#pragma unroll
      for (int ks = 0; ks < 4; ++ks) an[ks] = *reinterpret_cast<const bf16x8*>(qa + ks * 32);
    }
    for (int tt = slot; active && tt < ntiles; tt += nb8) {
      const int tok0 = tt * 64;
      {
        bf16x8 a[4];
#pragma unroll
        for (int ks = 0; ks < 4; ++ks) a[ks] = an[ks];
        {
          const int ttn = (tt + nb8 < ntiles) ? tt + nb8 : tt;
          const bf16_t* qa = p->P + (size_t)(ttn * 64 + wid * 16 + fr) * 2048 + hh * 256 + half * 128 + fq * 8;
#pragma unroll
          for (int ks = 0; ks < 4; ++ks) an[ks] = *reinterpret_cast<const bf16x8*>(qa + ks * 32);
        }
#pragma unroll
        for (int nf = 0; nf < 8; ++nf) {
          f32x4 acc = f32x4{0.f, 0.f, 0.f, 0.f};
          const int krow = nf * 16 + fr;
#pragma unroll
          for (int ks = 0; ks < 4; ++ks) {
            bf16x8 bb = *reinterpret_cast<const bf16x8*>(lds + krow * 256 + (((4 * ks + fq) ^ (krow & 15)) << 4));
            acc = __builtin_amdgcn_mfma_f32_16x16x32_bf16(a[ks], bb, acc, 0, 0, 0);
          }
#pragma unroll
          for (int j = 0; j < 4; ++j) sc[(wid * 16 + fq * 4 + j) * 129 + krow] = mkkey(acc[j], (unsigned)krow, 127u);
        }
      }
      __syncthreads();
      const int row = tid & 63, part = tid >> 6;
      float list[16];
#pragma unroll
      for (int i = 0; i < 16; ++i) list[i] = NEGK;
      {
        const float* kr = sc + row * 129 + part * 32;
#pragma unroll 4
        for (int e = 0; e < 32; ++e) {
          float x = kr[e];
          INSERT16(list, x)
        }
      }
      __syncthreads();
      if (part & 1) {
#pragma unroll
        for (int i = 0; i < 16; ++i) sc[(row * 2 + (part >> 1)) * 17 + i] = list[i];
      }
      __syncthreads();
      if (!(part & 1)) {
#pragma unroll
        for (int i = 0; i < 16; ++i) {
          float x = sc[(row * 2 + (part >> 1)) * 17 + i];
          INSERT16(list, x)
        }
      }
      __syncthreads();
      if (part == 2) {
#pragma unroll
        for (int i = 0; i < 16; ++i) sc[row * 17 + i] = list[i];
      }
      __syncthreads();
      if (part == 0) {
#pragma unroll
        for (int i = 0; i < 16; ++i) {
          float x = sc[row * 17 + i];
          INSERT16(list, x)
        }
        float4* o = reinterpret_cast<float4*>(p->tops + ((size_t)(tok0 + row) * 16 + hh * 2 + half) * 16);
        o[0] = make_float4(list[0], list[1], list[2], list[3]);
        o[1] = make_float4(list[4], list[5], list[6], list[7]);
        o[2] = make_float4(list[8], list[9], list[10], list[11]);
        o[3] = make_float4(list[12], list[13], list[14], list[15]);
      }
      __syncthreads();
    }
  }
  __syncthreads();
  float* fl = reinterpret_cast<float*>(lds);
  for (int t4 = slot; active && t4 < ntiles + 3 * nb8; t4 += 4 * nb8) {
    const int tt = t4 + (tid >> 6) * nb8;
    if (tt < ntiles) {
      const int tok = tt * 64 + (tid & 63);
      const float4* src = reinterpret_cast<const float4*>(p->tops + ((size_t)tok * 16 + hh * 2) * 16);
      float v0[16], v1[16];
#pragma unroll
      for (int i = 0; i < 4; ++i) {
        float4 a = src[i], bq = src[4 + i];
        v0[4 * i] = a.x; v0[4 * i + 1] = a.y; v0[4 * i + 2] = a.z; v0[4 * i + 3] = a.w;
        v1[4 * i] = bq.x; v1[4 * i + 1] = bq.y; v1[4 * i + 2] = bq.z; v1[4 * i + 3] = bq.w;
      }
      float* f0 = fl + tid * 33;
      float* f1 = f0 + 16;
#pragma unroll
      for (int i = 0; i < 16; ++i) {
        f0[i] = v0[i];
        f1[i] = v1[i];
      }
      float l2[16];
#pragma unroll
      for (int i = 0; i < 16; ++i) l2[i] = mkkey(v0[0] + v1[i], (unsigned)(15 - i), 255u);
#pragma unroll
      for (int a = 1; a < 16; ++a)
#pragma unroll
        for (int bq = 0; bq < 16; ++bq)
          if ((a + 1) * (bq + 1) <= 16) {
            float x = mkkey(v0[a] + v1[bq], (unsigned)(a * 16 + 15 - bq), 255u);
            INSERT16(l2, x)
          }
      float sv[16];
      int ev[16];
      float mx = NEGK;
#pragma unroll
      for (int k = 0; k < 16; ++k) {
        unsigned ab = __float_as_uint(l2[k]) & 255u;
        unsigned k0 = __float_as_uint(f0[ab >> 4]), k1 = __float_as_uint(f1[15u - (ab & 15u)]);
        sv[k] = __uint_as_float(k0 & ~127u) + __uint_as_float(k1 & ~127u);
        ev[k] = (int)((k0 & 127u) * 128u + (k1 & 127u));
        mx = fmaxf(mx, sv[k]);
      }
      float sum = 0.f;
#pragma unroll
      for (int k = 0; k < 16; ++k) {
        sv[k] = __expf(sv[k] - mx);
        sum += sv[k];
      }
      float inv = 1.f / sum;
      size_t o = (size_t)tok * 128 + hh * 16;
      int4* eo = reinterpret_cast<int4*>(p->eidx + o);
      float4* go = reinterpret_cast<float4*>(p->gate + o);
#pragma unroll
      for (int k4 = 0; k4 < 4; ++k4) {
        eo[k4] = make_int4(ev[4 * k4], ev[4 * k4 + 1], ev[4 * k4 + 2], ev[4 * k4 + 3]);
        go[k4] = make_float4(sv[4 * k4] * inv, sv[4 * k4 + 1] * inv, sv[4 * k4 + 2] * inv, sv[4 * k4 + 3] * inv);
      }
    }
  }
  __syncthreads();
}

typedef float v2f __attribute__((ext_vector_type(2)));
DEVI void dec16(uint4 q, v2f* f) {
  f[0] = __builtin_amdgcn_cvt_pk_f32_fp8((int)q.x, false);
  f[1] = __builtin_amdgcn_cvt_pk_f32_fp8((int)q.x, true);
  f[2] = __builtin_amdgcn_cvt_pk_f32_fp8((int)q.y, false);
  f[3] = __builtin_amdgcn_cvt_pk_f32_fp8((int)q.y, true);
  f[4] = __builtin_amdgcn_cvt_pk_f32_fp8((int)q.z, false);
  f[5] = __builtin_amdgcn_cvt_pk_f32_fp8((int)q.z, true);
  f[6] = __builtin_amdgcn_cvt_pk_f32_fp8((int)q.w, false);
  f[7] = __builtin_amdgcn_cvt_pk_f32_fp8((int)q.w, true);
}
struct ExpBuf {
  uint4 q[8];
  uint4 h0, h1;
};
DEVI void exp_load(ExpBuf& B, const unsigned char* tab, const signed char* hrow, const unsigned short* idp, int j8, bool want_x) {
#pragma unroll
  for (int i = 0; i < 8; ++i) {
    unsigned off = (unsigned)idp[8 * i] * (unsigned)D + 16u * j8;
    B.q[i] = *reinterpret_cast<const uint4*>(tab + off);
  }
  if (want_x) B.h0 = *reinterpret_cast<const uint4*>(hrow + 16 * j8);
}
template <int CTRL>
DEVI int dpp_movi(int v) { return __builtin_amdgcn_mov_dpp(v, CTRL, 0xF, 0xF, true); }
DEVI void exp_u_compute(const ExpBuf& B, int* pp, int j8) {
  int s0 = 0;
#pragma unroll
  for (int i = 0; i < 8; ++i) {
    int d = __builtin_amdgcn_sdot4((int)B.q[i].x, (int)B.h0.x, 0, false);
    d = __builtin_amdgcn_sdot4((int)B.q[i].y, (int)B.h0.y, d, false);
    d = __builtin_amdgcn_sdot4((int)B.q[i].z, (int)B.h0.z, d, false);
    d = __builtin_amdgcn_sdot4((int)B.q[i].w, (int)B.h0.w, d, false);
    d += dpp_movi<0xB1>(d);
    d += dpp_movi<0x4E>(d);
    d += dpp_movi<0x141>(d);
    s0 = (j8 == i) ? d : s0;
  }
  pp[0] += s0;
}
DEVI void exp_v_accum(const ExpBuf& B, unsigned w0, unsigned w1, int* acc) {
#pragma unroll
  for (int ig = 0; ig < 2; ++ig) {
    const unsigned wq = ig ? w1 : w0;
    const uint4 R0 = B.q[4 * ig], R1 = B.q[4 * ig + 1], R2 = B.q[4 * ig + 2], R3 = B.q[4 * ig + 3];
    const unsigned r0[4] = {R0.x, R0.y, R0.z, R0.w}, r1[4] = {R1.x, R1.y, R1.z, R1.w};
    const unsigned r2[4] = {R2.x, R2.y, R2.z, R2.w}, r3[4] = {R3.x, R3.y, R3.z, R3.w};
#pragma unroll
    for (int q = 0; q < 4; ++q) {
      unsigned A = __builtin_amdgcn_perm(r1[q], r0[q], 0x05010400u);
      unsigned Bq = __builtin_amdgcn_perm(r1[q], r0[q], 0x07030602u);
      unsigned C = __builtin_amdgcn_perm(r3[q], r2[q], 0x05010400u);
      unsigned E = __builtin_amdgcn_perm(r3[q], r2[q], 0x07030602u);
      unsigned D0 = __builtin_amdgcn_perm(C, A, 0x05040100u);
      unsigned D1 = __builtin_amdgcn_perm(C, A, 0x07060302u);
      unsigned D2 = __builtin_amdgcn_perm(E, Bq, 0x05040100u);
      unsigned D3 = __builtin_amdgcn_perm(E, Bq, 0x07060302u);
      acc[4 * q + 0] = __builtin_amdgcn_sdot4((int)D0, (int)wq, acc[4 * q + 0], false);
      acc[4 * q + 1] = __builtin_amdgcn_sdot4((int)D1, (int)wq, acc[4 * q + 1], false);
      acc[4 * q + 2] = __builtin_amdgcn_sdot4((int)D2, (int)wq, acc[4 * q + 2], false);
      acc[4 * q + 3] = __builtin_amdgcn_sdot4((int)D3, (int)wq, acc[4 * q + 3], false);
    }
  }
}
DEVI void exp_v_finish(float4* xo, const float4* xq, const float4* gq, int* acc, float swt, int grp, float gscale) {
  float o[16];
#pragma unroll
  for (int k = 0; k < 16; ++k) {
    int a = acc[k];
    a += dpp_movi<0x128>(a);
    a += __shfl_xor(a, 16);
    a += __shfl_xor(a, 32);
    o[k] = (float)a;
    acc[k] = 0;
  }
  if (grp == 0) {
    const float sc = gscale * swt;
#pragma unroll
    for (int i4 = 0; i4 < 4; ++i4) {
      float4 r = xq[i4];
      r.x += sc * gq[i4].x * o[i4 * 4 + 0];
      r.y += sc * gq[i4].y * o[i4 * 4 + 1];
      r.z += sc * gq[i4].z * o[i4 * 4 + 2];
      r.w += sc * gq[i4].w * o[i4 * 4 + 3];
      xo[i4] = r;
    }
  }
}
DEVI void phase_expert(PP p, int layer, int ntok, unsigned char* lds, float gscale = 1.f, int idmask = 0xffff) {
  const int tid = ltid();
  const int lane = tid & 63, wid = tid >> 6, j8 = lane & 7, grp = lane >> 3;
  const int nb = lnblk(), bid = lbid();
  unsigned short* ids = reinterpret_cast<unsigned short*>(lds);
  float* part = reinterpret_cast<float*>(lds + TPB * 128 * 2);
  unsigned char* w8 = lds + TPB * 128 * 2 + TPB * 128 * 4;
  float* swl = reinterpret_cast<float*>(lds + TPB * 128 * 2 + TPB * 128 * 4 + TPB * 128);
  const unsigned char* ut = p->utab + (size_t)layer * NEXP * D;
  const unsigned char* vt = p->vtab + (size_t)layer * NEXP * D;
  int tpb = (ntok + nb - 1) / nb;
  if (tpb > TPB) tpb = TPB;
  const int npass = (ntok + nb * tpb - 1) / (nb * tpb);
  for (int pass = 0; pass < npass; ++pass) {
    const int tok0 = (pass * nb + bid) * tpb;
    int cnt = ntok - tok0;
    if (cnt > tpb) cnt = tpb;
    if (cnt < 0) cnt = 0;
    for (int i = tid; i < cnt * 128; i += NTHREADS) {
      ids[i] = (unsigned short)(p->eidx[(size_t)tok0 * 128 + i] & idmask);
      part[i] = 0.f;
    }
    __syncthreads();
    const int ntw = (cnt - wid + 3) >> 2;
    const int npair = ntw * 8;
#define EXP_PAIR(pr_, c_, tl_) const int c_ = (pr_) / ntw, tl_ = wid + 4 * ((pr_) - c_ * ntw);
    if (!(REP_MODE == 1 && gscale != 1.f)) {
      ExpBuf B0, B1;
      if (npair > 0) {
        EXP_PAIR(0, c0, t0)
        exp_load(B0, ut + 128 * c0, p->h8 + (size_t)(tok0 + t0) * D + 128 * c0, ids + t0 * 128 + grp, j8, true);
      }
      for (int pr = 0; pr < npair; ++pr) {
        EXP_PAIR(pr, c0, t0)
        exp_load(B1, ut + 128 * c0, p->h8 + (size_t)(tok0 + t0) * D + 128 * c0, ids + t0 * 128 + 64 + grp, j8, true);
        exp_u_compute(B0, reinterpret_cast<int*>(part) + t0 * 128 + 8 * j8 + grp, j8);
        {
          const int prn = (pr + 1 < npair) ? pr + 1 : pr;
          EXP_PAIR(prn, c1, t1)
          exp_load(B0, ut + 128 * c1, p->h8 + (size_t)(tok0 + t1) * D + 128 * c1, ids + t1 * 128 + grp, j8, true);
        }
        exp_u_compute(B1, reinterpret_cast<int*>(part) + t0 * 128 + 64 + 8 * j8 + grp, j8);
      }
    }
    __syncthreads();
    for (int t = wid; t < cnt; t += 4) {
      float wv2[2];
      float am = 0.f;
#pragma unroll
      for (int hh = 0; hh < 2; ++hh) {
        int k = lane + 64 * hh;
        int e = ids[t * 128 + k];
        float dq = (float)reinterpret_cast<int*>(part)[t * 128 + k] * p->su[(size_t)layer * NEXP + e] * p->sx[tok0 + t];
        float wv = p->gate[(size_t)(tok0 + t) * 128 + k] * gelu_tanh(dq) * p->sv[(size_t)layer * NEXP + e];
        wv2[hh] = wv;
        am = fmaxf(am, fabsf(wv));
      }
      am = fmaxf(wave_max(am), 1e-30f);
      float qs = 127.f / am;
#pragma unroll
      for (int hh = 0; hh < 2; ++hh) {
        int k = lane + 64 * hh;
        int q = (int)rintf(wv2[hh] * qs);
        w8[t * 128 + (k & 7) * 16 + hh * 8 + ((k >> 3) & 7)] = (unsigned char)(q & 255);
      }
      if (lane == 0) swl[t] = am * (1.f / 127.f);
    }
    __syncthreads();
    if (!(REP_MODE == 2 && gscale != 1.f)) {
      ExpBuf B0, B1;
      int acc[16];
#pragma unroll
      for (int k = 0; k < 16; ++k) acc[k] = 0;
      if (npair > 0) {
        EXP_PAIR(0, c0, t0)
        exp_load(B0, vt + 128 * c0, (const signed char*)nullptr, ids + t0 * 128 + grp, j8, false);
      }
      for (int pr = 0; pr < npair; ++pr) {
        EXP_PAIR(pr, c0, t0)
        float4 xq[4], gq[4];
        float4* xo = reinterpret_cast<float4*>(p->xs + (size_t)(tok0 + t0) * D + 128 * c0 + 16 * j8);
        {
          const float4* gf = reinterpret_cast<const float4*>(p->mod + ((size_t)layer * 9 + tok_batch(tok0 + t0)) * 6144 + 5 * 1024 + 128 * c0 + 16 * j8);
#pragma unroll
          for (int i4 = 0; i4 < 4; ++i4) {
            xq[i4] = xo[i4];
            gq[i4] = gf[i4];
          }
        }
        exp_load(B1, vt + 128 * c0, (const signed char*)nullptr, ids + t0 * 128 + 64 + grp, j8, false);
        const uint4 wq = *reinterpret_cast<const uint4*>(w8 + t0 * 128 + grp * 16);
        exp_v_accum(B0, wq.x, wq.y, acc);
        {
          const int prn = (pr + 1 < npair) ? pr + 1 : pr;
          EXP_PAIR(prn, c1, t1)
          exp_load(B0, vt + 128 * c1, (const signed char*)nullptr, ids + t1 * 128 + grp, j8, false);
        }
        exp_v_accum(B1, wq.z, wq.w, acc);
        exp_v_finish(xo, xq, gq, acc, swl[t0], grp, gscale);
      }
    }
#undef EXP_PAIR
    __syncthreads();
  }
}

#define XB_TMO 128
#define XB_XCNT(j) (256 + 64 * (j))
#define XB_XSUB(j) (1280 + 64 * (j))
#define XB_XGEN(j) (2304 + 64 * (j))
#define XB_TOP 3328
#define XB_TOPGEN 3392
#define XCD_BAR_WORDS 3456
#define XB_SPIN_CAP (1u << 22)
#define LAS __attribute__((address_space(3)))
DEVI unsigned xb_ld(unsigned* p) { return __hip_atomic_load(p, __ATOMIC_RELAXED, __HIP_MEMORY_SCOPE_AGENT); }
DEVI unsigned xb_add(unsigned* p, unsigned v) { return __hip_atomic_fetch_add(p, v, __ATOMIC_RELAXED, __HIP_MEMORY_SCOPE_AGENT); }
DEVI unsigned xb_xcc_id() { return (unsigned)__builtin_amdgcn_s_getreg((3 << 11) | 20) & 0xFu; }
#define XB_SPIN(cond, bar)                                   \
  do {                                                       \
    unsigned _sp = 0;                                        \
    while (cond) {                                           \
      __builtin_amdgcn_s_sleep(1);                           \
      if ((++_sp & 255u) == 0u) {                            \
        if (xb_ld(&(bar)[XB_TMO])) break;                    \
        if (_sp > XB_SPIN_CAP) {                             \
          atomicAdd(&(bar)[XB_TMO], 1u);                     \
          break;                                             \
        }                                                    \
      }                                                      \
    }                                                        \
  } while (0)
struct XcdBarrier {
  unsigned* bar;
  unsigned x;
  volatile LAS unsigned* st;
};
DEVI XcdBarrier xcd_barrier_post(unsigned* bar, volatile LAS unsigned* st) {
  XcdBarrier b;
  b.bar = bar;
  b.x = xb_xcc_id();
  b.st = st;
  if (threadIdx.x == 0) (void)xb_add(&bar[XB_XCNT(b.x)], 1u);
  return b;
}
DEVI void xcd_barrier_complete(unsigned* bar, unsigned x, unsigned& nloc, unsigned& nx) {
  const unsigned G = gridDim.x * gridDim.y * gridDim.z;
  unsigned sum, cnt, mine, sp = 0u;
  for (;;) {
    sum = 0u;
    cnt = 0u;
    mine = 0u;
#pragma unroll
    for (unsigned j = 0; j < 16; ++j) {
      const unsigned c = xb_ld(&bar[XB_XCNT(j)]);
      sum += c;
      cnt += (c > 0u) ? 1u : 0u;
      mine = (j == x) ? c : mine;
    }
    if (sum == G) break;
    __builtin_amdgcn_s_sleep(1);
    if ((++sp & 255u) == 0u) {
      if (xb_ld(&bar[XB_TMO])) break;
      if (sp > XB_SPIN_CAP) {
        atomicAdd(&bar[XB_TMO], 1u);
        break;
      }
    }
  }
  nloc = mine > 0u ? mine : 1u;
  nx = cnt > 0u ? cnt : 1u;
}
DEVI void xcd_barrier(const XcdBarrier& b) {
  asm volatile("s_waitcnt vmcnt(0)" ::: "memory");
  __syncthreads();
  if (threadIdx.x == 0) {
    unsigned* bar = b.bar;
    __builtin_amdgcn_s_waitcnt(0);
    unsigned nloc = b.st[0], nx = b.st[1];
    if (nloc == 0u) {
      xcd_barrier_complete(bar, b.x, nloc, nx);
      b.st[0] = nloc;
      b.st[1] = nx;
    }
    const unsigned old = xb_add(&bar[XB_XSUB(b.x)], 1u);
    const unsigned gen = old / nloc;
    if (old + 1u == (gen + 1u) * nloc) {
      __builtin_amdgcn_fence(__ATOMIC_RELEASE, "agent");
      asm volatile("s_waitcnt vmcnt(0)" ::: "memory");
      const unsigned og = xb_add(&bar[XB_TOP], 1u);
      const unsigned tg = og / nx;
      if (og + 1u == (tg + 1u) * nx) xb_add(&bar[XB_TOPGEN], 1u);
      else XB_SPIN(xb_ld(&bar[XB_TOPGEN]) == tg, bar);
      __builtin_amdgcn_fence(__ATOMIC_ACQUIRE, "agent");
      xb_add(&bar[XB_XGEN(b.x)], 1u);
      asm volatile("s_waitcnt vmcnt(0)" ::: "memory");
    } else {
      XB_SPIN(xb_ld(&bar[XB_XGEN(b.x)]) == gen, bar);
      __builtin_amdgcn_fence(__ATOMIC_ACQUIRE, "agent");
      asm volatile("s_waitcnt vmcnt(0)" ::: "memory");
    }
  }
  __syncthreads();
}

DEVI bool step_active(int step) {
  if (step == 0 || step == NSTEPS - 1) return true;
  int layer = (step - 1) / STEPS_PER_LAYER, ph = (step - 1) % STEPS_PER_LAYER;
  if (ph == 3 && (layer & 1)) return false;
  return true;
}

DEVI void run_step(PP p, int step, unsigned char* lds, float gscale = 1.f) {
  if (step == 0) {
    phase_prep(p, lds);
    return;
  }
  if (step == NSTEPS - 1) {
    phase_norm(p, 0, 2, TL);
    return;
  }
  int layer = (step - 1) / STEPS_PER_LAYER, ph = (step - 1) % STEPS_PER_LAYER;
  bool even = (layer & 1) == 0;
  int j = layer >> 1;
  bool upd_ctx = layer < 2;
  bool need_ctx = layer < 3;
  int nt_in = need_ctx ? TT : TL;
  int nt = upd_ctx ? TT : TL;
  switch (ph) {
    case 0: phase_norm(p, layer, 0, nt_in); break;
    case 1:
      if (even)
        gemm_phase<EPI_INPROJ>(p, p->h, D, p->wt_in_ab + (size_t)j * 1280 * D, D, nt_in / 128, 10, D, layer, lds);
      else
        gemm_phase<EPI_GELU>(p, p->h, D, p->wt_in_gs + (size_t)j * 2048 * D, D, nt / 128, 16, D, layer, lds);
      break;
    case 2:
      if (even) {
        phase_fft_a(p, lds);
        if (upd_ctx) phase_dft_ctx(p, lds);
        phase_attn(p, layer, upd_ctx);
      } else {
        phase_sgu(p, j, nt / 128, lds);
      }
      break;
    case 3:
      if (even) phase_fft_b(p, lds);
      break;
    case 4:
      if (even)
        gemm_phase<EPI_RESID>(p, p->mix, LDMIX, p->wt_out_ab + (size_t)j * D * LDMIX, LDMIX, nt / 128, 8, LDMIX, layer, lds, gscale);
      else
        gemm_phase<EPI_RESID>(p, p->mix, LDMIX, p->wt_out_gs + (size_t)j * D * D, D, nt / 128, 8, D, layer, lds, gscale);
      break;
    case 5: phase_norm(p, layer, 1, nt); break;
    case 6: gemm_phase<EPI_STORE>(p, p->h, D, p->wt_q + (size_t)layer * 2048 * D, D, nt / 128, 16, D, layer, lds); break;
    case 7: phase_route(p, layer, nt, lds); break;
    case 8: phase_expert(p, layer, nt, lds, gscale, (gscale == 1.f) ? 0xffff : REP_IDMASK); break;
  }
}

__global__ void __launch_bounds__(NTHREADS, 2) mega(Params p_unused, int step_lo, int step_hi) {
  __shared__ __attribute__((aligned(16))) unsigned char lds[LDS_BYTES];
  PP pp = (PP)__builtin_amdgcn_kernarg_segment_ptr();
  volatile LAS unsigned* st = (volatile LAS unsigned*)(lds + LDS_BYTES - 16);
  if (threadIdx.x == 0) {
    st[0] = 0u;
    st[1] = 0u;
  }
  __syncthreads();
  XcdBarrier xb = xcd_barrier_post(pp->bar, st);
  int nsync = 0;
  bool first = true;
  for (int s = step_lo; s < step_hi; ++s) {
    if (!step_active(s)) continue;
    if (!first) {
      if (nsync == 0) cg::this_grid().sync();
      else xcd_barrier(xb);
      ++nsync;
    }
    first = false;
    PP q = pp;
    asm volatile("" : "+s"(q));
    run_step(q, s, lds);
#if REP_MASK
    if (s == 0 && ((REP_MASK >> 15) & 1)) {
      xcd_barrier(xb);
      PP q2 = pp;
      asm volatile("" : "+s"(q2));
      run_step(q2, 0, lds);
    }
    if (s > 0 && s < NSTEPS - 1) {
      int lay_ = (s - 1) / STEPS_PER_LAYER, ph_ = (s - 1) % STEPS_PER_LAYER;
      bool rep_ = (REP_MASK >> ph_) & 1;
      if (ph_ == 2 && ((REP_MASK >> 9) & 1) && !(lay_ & 1)) rep_ = true;
      if (ph_ == 2 && ((REP_MASK >> 10) & 1) && (lay_ & 1)) rep_ = true;
      if (rep_) {
        xcd_barrier(xb);
        PP q2 = pp;
        asm volatile("" : "+s"(q2));
        float z = 0.f;
        asm volatile("" : "+s"(z));
        run_step(q2, s, lds, z);
      }
      if (ph_ == 2 && ((REP_MASK >> 11) & 1) && !(lay_ & 1)) {
        xcd_barrier(xb);
        PP q2 = pp;
        asm volatile("" : "+s"(q2));
        phase_attn(q2, lay_, lay_ < 2);
      }
    }
#endif
  }
}

static size_t align_up(size_t v) { return (v + 255) & ~(size_t)255; }

extern "C" void kernel_launch(void* const* d_in, const int* in_sizes, int n_in, void* d_out, int out_size, void* d_ws,
                              size_t ws_size, hipStream_t stream) {
  Params p{};
  p.x = (const float*)d_in[0];
  p.c = (const float*)d_in[1];
  p.ctx = (const float*)d_in[2];
  p.c_ctx = (const float*)d_in[3];
  p.ada_w = (const float*)d_in[4];
  p.ada_b = (const float*)d_in[5];
  p.norm_mix_w = (const float*)d_in[6];
  p.norm_ffn_w = (const float*)d_in[7];
  p.ab_w_in = (const float*)d_in[8];
  p.ab_w_out = (const float*)d_in[9];
  p.attn_sink = (const float*)d_in[10];
  p.gs_w_in = (const float*)d_in[11];
  p.gs_norm_w = (const float*)d_in[12];
  p.gs_w_s = (const float*)d_in[13];
  p.gs_b_s = (const float*)d_in[14];
  p.gs_w_out = (const float*)d_in[15];
  p.peer_w_q = (const float*)d_in[16];
  p.peer_keys = (const float*)d_in[17];
  p.peer_u = (const float*)d_in[18];
  p.peer_v = (const float*)d_in[19];
  p.norm_out_w = (const float*)d_in[20];
  p.out = (float*)d_out;
  unsigned char* w = (unsigned char*)d_ws;
  size_t off = 0;
  auto take = [&](size_t bytes) {
    unsigned char* r = w + off;
    off = align_up(off + bytes);
    return r;
  };
  p.bar = (unsigned*)take((size_t)XCD_BAR_WORDS * 4);
  p.mod = (float*)take((size_t)DEPTH * 9 * 6144 * 4);
  p.cs = (float2*)take(64 * 16 * 8);
  p.xs = (float*)take((size_t)TT * D * 4);
  p.h = (bf16_t*)take((size_t)TT * D * 2);
  p.P = (bf16_t*)take((size_t)TT * 2048 * 2);
  p.kbuf = (bf16_t*)take((size_t)NB * 2 * KVLEN * 64 * 2);
  p.vbuf = (bf16_t*)take((size_t)NB * 2 * KVLEN * 64 * 2);
  p.zvT = (bf16_t*)take((size_t)TT * 1024 * 2);
  p.rowss = (float*)take((size_t)(TT / 128) * 16 * 128 * 4);
  p.mix = (bf16_t*)take((size_t)TT * LDMIX * 2);
  p.fa = (bf16_t*)take((size_t)TL * 1024 * 2);
  p.tops = (float*)take((size_t)TT * 256 * 4);
  p.eidx = (int*)take((size_t)TT * 128 * 4);
  p.gate = (float*)take((size_t)TT * 128 * 4);
  p.wt_in_ab = (bf16_t*)take((size_t)2 * 1280 * D * 2);
  p.wt_out_ab = (bf16_t*)take((size_t)2 * D * LDMIX * 2);
  p.wt_in_gs = (bf16_t*)take((size_t)2 * 2048 * D * 2);
  p.wt_out_gs = (bf16_t*)take((size_t)2 * D * D * 2);
  p.wt_q = (bf16_t*)take((size_t)DEPTH * 2048 * D * 2);
  p.keysb = (bf16_t*)take((size_t)DEPTH * 8 * 2 * 128 * 128 * 2);
  p.su = (float*)take((size_t)DEPTH * NEXP * 4);
  p.sv = (float*)take((size_t)DEPTH * NEXP * 4);
  p.h8 = (signed char*)take((size_t)TT * D);
  p.sx = (float*)take((size_t)TT * 4);
  p.utab = (unsigned char*)take((size_t)DEPTH * NEXP * D);
  p.vtab = (unsigned char*)take((size_t)DEPTH * NEXP * D);
  if (off > ws_size) {
    fprintf(stderr, "workspace too small: need %zu have %zu\n", off, ws_size);
    return;
  }
  hipMemsetAsync(p.bar, 0, (size_t)XCD_BAR_WORDS * 4, stream);
  static int grid_blocks = 0;
  if (!grid_blocks) {
    int dev = 0, cus = 0, per_cu = 0;
    hipGetDevice(&dev);
    hipDeviceGetAttribute(&cus, hipDeviceAttributeMultiprocessorCount, dev);
    hipOccupancyMaxActiveBlocksPerMultiprocessor(&per_cu, mega, NTHREADS, 0);
    if (per_cu > 2) per_cu = 2;
    if (per_cu < 1) per_cu = 1;
    grid_blocks = cus * per_cu;
  }
#if ONE_LAUNCH
  int lo = 0, hi = NSTEPS;
  void* args[] = {&p, &lo, &hi};
  hipError_t e = hipLaunchCooperativeKernel((void*)mega, dim3(grid_blocks), dim3(NTHREADS), args, 0, stream);
  if (e != hipSuccess) fprintf(stderr, "cooperative launch failed: %s (grid %d)\n", hipGetErrorString(e), grid_blocks);
#else
  for (int s = 0; s < NSTEPS; ++s) {
    if (s != 0 && s != NSTEPS - 1) {
      int layer = (s - 1) / STEPS_PER_LAYER, ph = (s - 1) % STEPS_PER_LAYER;
      if (ph == 3 && (layer & 1)) continue;
    }
    hipLaunchKernelGGL(mega, dim3(grid_blocks), dim3(NTHREADS), 0, stream, p, s, s + 1);
  }
#endif
}
```

```cpp
#include <hip/hip_runtime.h>
#include <hip/hip_bf16.h>
#include <hip/hip_cooperative_groups.h>
#include <cstdio>
namespace cg = cooperative_groups;

#ifndef REP_MASK
#define REP_MASK 0
#endif
#ifndef REP_MODE
#define REP_MODE 0
#endif
#ifndef REP_IDMASK
#define REP_IDMASK 0xffff
#endif
#ifndef ONE_LAUNCH
#define ONE_LAUNCH 1
#endif

#define DEVI __device__ __forceinline__
typedef unsigned short bf16_t;
using bf16x8 = __attribute__((ext_vector_type(8))) short;
using f32x4 = __attribute__((ext_vector_type(4))) float;
using f32x16 = __attribute__((ext_vector_type(16))) float;

constexpr int D = 1024, NB = 8, SEQ = 4096, CTX = 256, DEPTH = 4;
constexpr int TL = NB * SEQ, TC = NB * CTX, TT = TL + TC;
constexpr int KVLEN = CTX + SEQ;
constexpr int NEXP = 16384;
constexpr int LDMIX = 1536;
constexpr float USCALE = 64.f, VSCALE = 8.f;
constexpr int TPB = 68;
constexpr int LDS_BYTES = 68 * 1024;
constexpr int NTHREADS = 256;
constexpr int STEPS_PER_LAYER = 9;
constexpr int NSTEPS = 1 + DEPTH * STEPS_PER_LAYER + 1;

struct Params {
  const float *x, *c, *ctx, *c_ctx, *ada_w, *ada_b, *norm_mix_w, *norm_ffn_w, *ab_w_in, *ab_w_out, *attn_sink,
      *gs_w_in, *gs_norm_w, *gs_w_s, *gs_b_s, *gs_w_out, *peer_w_q, *peer_keys, *peer_u, *peer_v, *norm_out_w;
  float* out;
  float* mod;
  float2* cs;
  float* xs;
  bf16_t* h;
  bf16_t* P;
  bf16_t* kbuf;
  bf16_t* vbuf;
  float* rowss;
  bf16_t* zvT;
  bf16_t* mix;
  bf16_t* fa;
  unsigned* bar;
  float* tops;
  int* eidx;
  float* gate;
  bf16_t *wt_in_ab, *wt_out_ab, *wt_in_gs, *wt_out_gs, *wt_q, *keysb;
  unsigned char *utab, *vtab;
  float* su;
  float* sv;
  signed char* h8;
  float* sx;
};

typedef const __attribute__((address_space(4))) Params* PP;

DEVI int ltid() { int t = threadIdx.x; asm volatile("" : "+v"(t)); return t; }
DEVI int lbid() { int t = blockIdx.x; asm volatile("" : "+s"(t)); return t; }
DEVI int lnblk() { int t = gridDim.x; asm volatile("" : "+s"(t)); return t; }

typedef __bf16 bf2v_t __attribute__((ext_vector_type(2)));
typedef float f2v_t __attribute__((ext_vector_type(2)));
DEVI bf16_t f2bf(float f) { return __builtin_bit_cast(unsigned short, (__bf16)f); }
DEVI float bf2f(bf16_t h) { return __uint_as_float(((unsigned)h) << 16); }
DEVI float bflo(unsigned u) { return __uint_as_float(u << 16); }
DEVI float bfhi(unsigned u) { return __uint_as_float(u & 0xffff0000u); }
DEVI unsigned pack2(float a, float b) {
  f2v_t v = {a, b};
  return __builtin_bit_cast(unsigned, __builtin_convertvector(v, bf2v_t));
}
DEVI float wave_sum(float v) {
#pragma unroll
  for (int o = 32; o > 0; o >>= 1) v += __shfl_xor(v, o);
  return v;
}
DEVI float wave_max(float v) {
#pragma unroll
  for (int o = 32; o > 0; o >>= 1) v = fmaxf(v, __shfl_xor(v, o));
  return v;
}
DEVI float gelu_tanh(float x) {
  float u = 0.7978845608028654f * (x + 0.044715f * x * x * x);
  return 0.5f * x * (1.f + tanhf(u));
}
template <int CTRL>
DEVI float dpp_mov(float v) {
  return __builtin_bit_cast(float, __builtin_amdgcn_mov_dpp(__builtin_bit_cast(int, v), CTRL, 0xF, 0xF, true));
}
DEVI int tok_batch(int r) { return r < TL ? (r >> 12) : 8; }

DEVI void prep_transpose_tile(const float* __restrict__ src, int N, bf16_t* __restrict__ dst, int ldk, int tk, int tn, float* tile, int tid) {
#pragma unroll
  for (int i = 0; i < 16; ++i) {
    int r = (tid >> 6) + 4 * i;
    tile[r * 65 + (tid & 63)] = src[(size_t)(tk * 64 + r) * N + tn * 64 + (tid & 63)];
  }
  __syncthreads();
#pragma unroll
  for (int i = 0; i < 16; ++i) {
    int n = (tid >> 6) + 4 * i, k = tid & 63;
    dst[(size_t)(tn * 64 + n) * ldk + tk * 64 + k] = f2bf(tile[k * 65 + n]);
  }
}

constexpr int PU_ADA = DEPTH * 96;
constexpr int PU_T_ABIN = 2 * 16 * 20;
constexpr int PU_T_GSIN = 2 * 16 * 32;
constexpr int PU_T_GSOUT = 2 * 16 * 16;
constexpr int PU_T_ABOUT = 2 * 8 * 16;
constexpr int PU_T_Q = DEPTH * 16 * 32;
constexpr int PU_FOLD = 2 * 512 * 1024 / 256;
constexpr int PU_CONV = DEPTH * NEXP * D / 4 / 2048;
constexpr int PU_KEYS = DEPTH * 8 * 2 * 128 * 128 / 4 / 2048;
constexpr int PU_UROWS = DEPTH * NEXP / 32;
constexpr int PU_TOTAL = PU_ADA + PU_T_ABIN + PU_T_GSIN + PU_T_GSOUT + PU_T_ABOUT + PU_T_Q + PU_FOLD + 2 * PU_UROWS + PU_KEYS + 1;

DEVI void phase_prep(PP p, unsigned char* lds) {
  const int tid = ltid();
  float* fl = reinterpret_cast<float*>(lds);
  for (int u0 = lbid(); u0 < PU_TOTAL; u0 += lnblk()) {
    int u = u0;
    if (u < PU_ADA) {
      float* sl = fl;
      for (int i = tid; i < 9 * 1024; i += NTHREADS) {
        int r = i >> 10, k = i & 1023;
        float v = (r < 8) ? p->c[r * 1024 + k] : p->c_ctx[k];
        sl[i] = v / (1.f + __expf(-v));
      }
      __syncthreads();
      float* red = sl + 9 * 1024;
      int ks = tid >> 6, col = tid & 63;
      int layer = u / 96, c0 = (u % 96) * 64;
      const float* w = p->ada_w + (size_t)layer * D * 6144 + c0 + col;
      float acc[9];
#pragma unroll
      for (int r = 0; r < 9; ++r) acc[r] = 0.f;
      for (int k0 = ks * 256; k0 < ks * 256 + 256; k0 += 16) {
        float wv[16];
#pragma unroll
        for (int kk = 0; kk < 16; ++kk) wv[kk] = w[(size_t)(k0 + kk) * 6144];
#pragma unroll
        for (int kk = 0; kk < 16; ++kk)
#pragma unroll
          for (int r = 0; r < 9; ++r) acc[r] += sl[r * 1024 + k0 + kk] * wv[kk];
      }
#pragma unroll
      for (int r = 0; r < 9; ++r) red[(ks * 9 + r) * 64 + col] = acc[r];
      __syncthreads();
      for (int i = tid; i < 9 * 64; i += NTHREADS) {
        int r = i >> 6, cc = i & 63;
        float sm = red[(0 * 9 + r) * 64 + cc] + red[(1 * 9 + r) * 64 + cc] + red[(2 * 9 + r) * 64 + cc] + red[(3 * 9 + r) * 64 + cc];
        sm += p->ada_b[(size_t)layer * 6144 + c0 + cc];
        p->mod[((size_t)layer * 9 + r) * 6144 + c0 + cc] = sm;
      }
      __syncthreads();
      continue;
    }
    u -= PU_ADA;
    if (u < PU_T_ABIN) {
      int j = u / 320, t = u % 320;
      prep_transpose_tile(p->ab_w_in + (size_t)j * D * 1280, 1280, p->wt_in_ab + (size_t)j * 1280 * D, D, t / 20, t % 20, fl, tid);
      __syncthreads();
      continue;
    }
    u -= PU_T_ABIN;
    if (u < PU_T_GSIN) {
      int j = u / 512, t = u % 512;
      prep_transpose_tile(p->gs_w_in + (size_t)j * D * 2048, 2048, p->wt_in_gs + (size_t)j * 2048 * D, D, t / 32, t % 32, fl, tid);
      __syncthreads();
      continue;
    }
    u -= PU_T_GSIN;
    if (u < PU_T_GSOUT) {
      int j = u / 256, t = u % 256;
      prep_transpose_tile(p->gs_w_out + (size_t)j * D * D, D, p->wt_out_gs + (size_t)j * D * D, D, t / 16, t % 16, fl, tid);
      __syncthreads();
      continue;
    }
    u -= PU_T_GSOUT;
    if (u < PU_T_ABOUT) {
      int j = u / 128, t = u % 128;
      prep_transpose_tile(p->ab_w_out + (size_t)j * D * D, D, p->wt_out_ab + (size_t)j * D * LDMIX, LDMIX, t / 16, t % 16, fl, tid);
      __syncthreads();
      continue;
    }
    u -= PU_T_ABOUT;
    if (u < PU_T_Q) {
      int i = u / 512, t = u % 512;
      prep_transpose_tile(p->peer_w_q + (size_t)i * D * 2048, 2048, p->wt_q + (size_t)i * 2048 * D, D, t / 32, t % 32, fl, tid);
      __syncthreads();
      continue;
    }
    u -= PU_T_Q;
    if (u < PU_FOLD) {
      float2* tw = reinterpret_cast<float2*>(lds);
      if (tid < 128) {
        float sn, cn;
        sincospif((float)tid / 64.f, &sn, &cn);
        tw[tid] = make_float2(cn, sn);
      }
      __syncthreads();
      size_t i = (size_t)u * 256 + tid;
      int n = (int)(i & 1023);
      int gm = (int)((i >> 10) & 511);
      int j = (int)(i >> 19);
      int g = gm >> 7, m = gm & 127;
      const float* w = p->ab_w_out + (size_t)j * D * D + (size_t)(512 + g * 128) * D + n;
      float ar = 0.f, ai = 0.f;
#pragma unroll 16
      for (int l = 0; l < 128; ++l) {
        float2 t = tw[(m * l) & 127];
        float wv = w[(size_t)l * D];
        ar += t.x * wv;
        ai += t.y * wv;
      }
      bf16_t* dst = p->wt_out_ab + (size_t)j * D * LDMIX + (size_t)n * LDMIX;
      dst[512 + gm] = f2bf(ar);
      dst[1024 + gm] = f2bf(ai);
      __syncthreads();
      continue;
    }
    u -= PU_FOLD;
    if (u < 2 * PU_UROWS) {
      const bool isv = u >= PU_UROWS;
      if (isv) u -= PU_UROWS;
      const float* src = isv ? p->peer_v : p->peer_u;
      unsigned char* dst = isv ? p->vtab : p->utab;
      float* sdst = isv ? p->sv : p->su;
      const int lane = tid & 63, wv = tid >> 6;
#pragma unroll 1
      for (int rr = 0; rr < 8; rr += 4) {
        size_t row0 = (size_t)u * 32 + wv * 8 + rr;
        float4 v[4][4];
#pragma unroll
        for (int k = 0; k < 4; ++k)
#pragma unroll
          for (int i = 0; i < 4; ++i) v[k][i] = reinterpret_cast<const float4*>(src + (row0 + k) * D)[lane * 4 + i];
#pragma unroll
        for (int k = 0; k < 4; ++k) {
          float am = 0.f;
#pragma unroll
          for (int i = 0; i < 4; ++i)
            am = fmaxf(am, fmaxf(fmaxf(fabsf(v[k][i].x), fabsf(v[k][i].y)), fmaxf(fabsf(v[k][i].z), fabsf(v[k][i].w))));
          am = wave_max(am);
          am = fmaxf(am, 1e-30f);
          float qs = 127.f / am;
          uint4 o;
          unsigned* op = reinterpret_cast<unsigned*>(&o);
#pragma unroll
          for (int i = 0; i < 4; ++i) {
            int q0 = (int)rintf(v[k][i].x * qs), q1 = (int)rintf(v[k][i].y * qs), q2 = (int)rintf(v[k][i].z * qs), q3 = (int)rintf(v[k][i].w * qs);
            op[i] = (unsigned)(q0 & 255) | ((unsigned)(q1 & 255) << 8) | ((unsigned)(q2 & 255) << 16) | ((unsigned)(q3 & 255) << 24);
          }
          reinterpret_cast<uint4*>(dst + (row0 + k) * D)[lane] = o;
          if (lane == 0) sdst[row0 + k] = am * (1.f / 127.f);
        }
      }
      continue;
    }
    u -= 2 * PU_UROWS;
    if (u < PU_KEYS) {
      const float4* s4 = reinterpret_cast<const float4*>(p->peer_keys) + (size_t)u * 2048 + tid;
      uint2* d2 = reinterpret_cast<uint2*>(p->keysb) + (size_t)u * 2048 + tid;
#pragma unroll
      for (int k = 0; k < 8; ++k) {
        float4 v = s4[k * 256];
        uint2 o;
        o.x = pack2(v.x, v.y);
        o.y = pack2(v.z, v.w);
        d2[k * 256] = o;
      }
      continue;
    }
    for (int i = tid; i < 64 * 16; i += NTHREADS) {
      int pos = i >> 4, k = i & 15;
      float inv = powf(10000.f, -(float)k / 16.f);
      float ang = (float)pos * inv;
      float sn, cn;
      sincosf(ang, &sn, &cn);
      p->cs[i] = make_float2(cn, sn);
    }
  }
}

DEVI void norm_row(PP p, int layer, int which, int tok, int lane) {
  const float* w = which == 0 ? p->norm_mix_w + layer * D : (which == 1 ? p->norm_ffn_w + layer * D : p->norm_out_w);
  const float* xsrc = p->xs + (size_t)tok * D;
  if (which == 0 && layer == 0) xsrc = (tok < TL) ? p->x + (size_t)tok * D : p->ctx + (size_t)(tok - TL) * D;
  const float4* xr = reinterpret_cast<const float4*>(xsrc);
  float4 v[4];
  float ss = 0.f;
#pragma unroll
  for (int i = 0; i < 4; ++i) {
    v[i] = xr[lane + 64 * i];
    ss += v[i].x * v[i].x + v[i].y * v[i].y + v[i].z * v[i].z + v[i].w * v[i].w;
  }
  ss = wave_sum(ss);
  float rstd = rsqrtf(ss * (1.f / 1024.f) + 1e-6f);
  if (which == 2) {
    float4* o = reinterpret_cast<float4*>(p->out + (size_t)tok * D);
#pragma unroll
    for (int i = 0; i < 4; ++i) {
      float4 wv = reinterpret_cast<const float4*>(w)[lane + 64 * i];
      float4 r;
      r.x = v[i].x * rstd * wv.x;
      r.y = v[i].y * rstd * wv.y;
      r.z = v[i].z * rstd * wv.z;
      r.w = v[i].w * rstd * wv.w;
      o[lane + 64 * i] = r;
    }
  } else {
    int b = tok_batch(tok);
    const float* mb = p->mod + ((size_t)layer * 9 + b) * 6144 + (which == 0 ? 0 : 3072);
    uint2* o = reinterpret_cast<uint2*>(p->h + (size_t)tok * D);
    float av[4][4];
    float am = 0.f;
#pragma unroll
    for (int i = 0; i < 4; ++i) {
      float4 wv = reinterpret_cast<const float4*>(w)[lane + 64 * i];
      float4 sh = reinterpret_cast<const float4*>(mb)[lane + 64 * i];
      float4 sc = reinterpret_cast<const float4*>(mb + 1024)[lane + 64 * i];
      float a0 = v[i].x * rstd * wv.x * (1.f + sc.x) + sh.x;
      float a1 = v[i].y * rstd * wv.y * (1.f + sc.y) + sh.y;
      float a2 = v[i].z * rstd * wv.z * (1.f + sc.z) + sh.z;
      float a3 = v[i].w * rstd * wv.w * (1.f + sc.w) + sh.w;
      uint2 r;
      r.x = pack2(a0, a1);
      r.y = pack2(a2, a3);
      o[lane + 64 * i] = r;
      av[i][0] = a0; av[i][1] = a1; av[i][2] = a2; av[i][3] = a3;
      am = fmaxf(am, fmaxf(fmaxf(fabsf(a0), fabsf(a1)), fmaxf(fabsf(a2), fabsf(a3))));
    }
    if (which == 1) {
      am = fmaxf(wave_max(am), 1e-30f);
      float qs = 127.f / am;
      unsigned* o8 = reinterpret_cast<unsigned*>(p->h8 + (size_t)tok * D);
#pragma unroll
      for (int i = 0; i < 4; ++i) {
        int q0 = (int)rintf(av[i][0] * qs), q1 = (int)rintf(av[i][1] * qs), q2 = (int)rintf(av[i][2] * qs), q3 = (int)rintf(av[i][3] * qs);
        o8[lane + 64 * i] = (unsigned)(q0 & 255) | ((unsigned)(q1 & 255) << 8) | ((unsigned)(q2 & 255) << 16) | ((unsigned)(q3 & 255) << 24);
      }
      if (lane == 0) p->sx[tok] = am * (1.f / 127.f);
    }
  }
}

DEVI void phase_norm(PP p, int layer, int which, int ntok) {
  int lane = ltid() & 63;
  int gw = lbid() * 4 + __builtin_amdgcn_readfirstlane(ltid() >> 6), nw = lnblk() * 4;
  for (int tok = gw; tok < ntok; tok += nw) norm_row(p, layer, which, tok, lane);
}

enum { EPI_STORE = 0, EPI_GELU = 1, EPI_RESID = 2, EPI_INPROJ = 3 };

template <int EPI>
DEVI void gemm_phase(PP p, const bf16_t* __restrict__ A, int lda, const bf16_t* __restrict__ Bt, int ldb,
                     int Mtiles, int Ntiles, int K, int layer, unsigned char* lds, float gscale = 1.f) {
  const int tid = ltid();
  const int wid = __builtin_amdgcn_readfirstlane(tid >> 6), lane = tid & 63, wr = wid >> 1, wc = wid & 1, fr = lane & 15, fq = lane >> 4;
  int nblk = lnblk();
  int bid = lbid();
  int lb = ((nblk & 7) == 0) ? ((bid & 7) * (nblk >> 3) + (bid >> 3)) : bid;
  int ntiles = Mtiles * Ntiles;
  const int nk = K / 64;
  const int srow = tid >> 3;
  const int scol = ((tid & 7) ^ ((tid >> 3) & 7)) * 8;
#define GEMM_STAGE(ga_, gb_, kt_, buf_)                                                                               \
  {                                                                                                                   \
    _Pragma("unroll") for (int i_ = 0; i_ < 4; ++i_) {                                                                \
      __builtin_amdgcn_global_load_lds((const unsigned*)((ga_) + (size_t)(32 * i_) * lda + (kt_) * 64),               \
                                       (__attribute__((address_space(3))) unsigned*)(lds + (buf_) * 32768 + tid * 16 + i_ * 4096), 16, 0, 0); \
      __builtin_amdgcn_global_load_lds((const unsigned*)((gb_) + (size_t)(32 * i_) * ldb + (kt_) * 64),               \
                                       (__attribute__((address_space(3))) unsigned*)(lds + (buf_) * 32768 + 16384 + tid * 16 + i_ * 4096), 16, 0, 0); \
    }                                                                                                                 \
  }
  if (lb < ntiles) {
    int tm0 = lb / Ntiles, tn0 = lb % Ntiles;
    const bf16_t* ga0 = A + (size_t)(tm0 * 128 + srow) * lda + scol;
    const bf16_t* gb0 = Bt + (size_t)(tn0 * 128 + srow) * ldb + scol;
    GEMM_STAGE(ga0, gb0, 0, 0)
  }
  for (int t = lb; t < ntiles; t += nblk) {
    int tm = t / Ntiles, tn = t % Ntiles;
    int brow = tm * 128, bcol = tn * 128;
    f32x4 acc[4][4];
#pragma unroll
    for (int m = 0; m < 4; ++m)
#pragma unroll
      for (int n = 0; n < 4; ++n) acc[m][n] = f32x4{0.f, 0.f, 0.f, 0.f};
    const bf16_t* ga = A + (size_t)(brow + srow) * lda + scol;
    const bf16_t* gb = Bt + (size_t)(bcol + srow) * ldb + scol;
    for (int kt = 0; kt < nk; ++kt) {
      const int buf = kt & 1;
      asm volatile("s_waitcnt vmcnt(0)" ::: "memory");
      __syncthreads();
      if (kt + 1 < nk) GEMM_STAGE(ga, gb, kt + 1, buf ^ 1)
      const unsigned char* SA = lds + buf * 32768;
      const unsigned char* SB = SA + 16384;
      bf16x8 At[2][4], Bl[2][4];
#pragma unroll
      for (int ks = 0; ks < 2; ++ks)
#pragma unroll
        for (int m = 0; m < 4; ++m) {
          const int sl = ((ks * 4 + fq) ^ (fr & 7)) << 4;
          At[ks][m] = *reinterpret_cast<const bf16x8*>(SA + (wr * 64 + m * 16 + fr) * 128 + sl);
          Bl[ks][m] = *reinterpret_cast<const bf16x8*>(SB + (wc * 64 + m * 16 + fr) * 128 + sl);
        }
#pragma unroll
      for (int ks = 0; ks < 2; ++ks)
#pragma unroll
        for (int m = 0; m < 4; ++m)
#pragma unroll
          for (int n = 0; n < 4; ++n)
            acc[m][n] = __builtin_amdgcn_mfma_f32_16x16x32_bf16(At[ks][m], Bl[ks][n], acc[m][n], 0, 0, 0);
    }
    {
      int t2 = t + nblk;
      if (t2 < ntiles) {
        int tm2 = t2 / Ntiles, tn2 = t2 % Ntiles;
        const bf16_t* ga2 = A + (size_t)(tm2 * 128 + srow) * lda + scol;
        const bf16_t* gb2 = Bt + (size_t)(tn2 * 128 + srow) * ldb + scol;
        GEMM_STAGE(ga2, gb2, 0, 0)
      }
    }
    const int colbase = bcol + wc * 64;
    if constexpr (EPI == EPI_STORE || EPI == EPI_GELU) {
      if (EPI == EPI_GELU && colbase >= 1024) {
        float* rsp = p->rowss + ((size_t)tm * 16 + (tn - 8) * 2 + wc) * 128;
#pragma unroll
        for (int m = 0; m < 4; ++m) {
          float ssq[4] = {0.f, 0.f, 0.f, 0.f};
#pragma unroll
          for (int n = 0; n < 4; ++n) {
            int ch = colbase - 1024 + n * 16 + fr;
            int q0 = wr * 64 + m * 16 + fq * 4;
            float g0 = gelu_tanh(acc[m][n][0]), g1 = gelu_tanh(acc[m][n][1]), g2 = gelu_tanh(acc[m][n][2]), g3 = gelu_tanh(acc[m][n][3]);
            ssq[0] += g0 * g0;
            ssq[1] += g1 * g1;
            ssq[2] += g2 * g2;
            ssq[3] += g3 * g3;
            uint2 o;
            o.x = pack2(g0, g1);
            o.y = pack2(g2, g3);
            *reinterpret_cast<uint2*>(p->zvT + ((size_t)tm * 1024 + ch) * 128 + q0) = o;
          }
#pragma unroll
          for (int j = 0; j < 4; ++j) {
            float v = ssq[j];
            v += dpp_mov<0xB1>(v);
            v += dpp_mov<0x4E>(v);
            v += dpp_mov<0x141>(v);
            v += dpp_mov<0x140>(v);
            if (fr == 0) rsp[wr * 64 + m * 16 + fq * 4 + j] = v;
          }
        }
      } else {
#pragma unroll
        for (int m = 0; m < 4; ++m)
#pragma unroll
          for (int j = 0; j < 4; ++j) {
            int row = brow + wr * 64 + m * 16 + fq * 4 + j;
            bf16_t* o = p->P + (size_t)row * 2048 + colbase + fr;
#pragma unroll
            for (int n = 0; n < 4; ++n) {
              float v = acc[m][n][j];
              if (EPI == EPI_GELU) v = gelu_tanh(v);
              o[n * 16] = f2bf(v);
            }
          }
      }
    } else if constexpr (EPI == EPI_RESID) {
#pragma unroll
      for (int m = 0; m < 4; ++m)
#pragma unroll
        for (int j = 0; j < 4; ++j) {
          int row = brow + wr * 64 + m * 16 + fq * 4 + j;
          int b = tok_batch(row);
          const float* g = p->mod + ((size_t)layer * 9 + b) * 6144 + 2048 + colbase + fr;
          float* o = p->xs + (size_t)row * D + colbase + fr;
          const float* xi = o;
          if (layer == 0 && gscale == 1.f)
            xi = ((row < TL) ? p->x + (size_t)row * D : p->ctx + (size_t)(row - TL) * D) + colbase + fr;
#pragma unroll
          for (int n = 0; n < 4; ++n) o[n * 16] = xi[n * 16] + gscale * g[n * 16] * acc[m][n][j];
        }
    } else if constexpr (EPI == EPI_INPROJ) {
      if (colbase >= 640 && colbase < 768) {
        int kvh = (colbase - 640) >> 6;
#pragma unroll
        for (int m = 0; m < 4; ++m) {
          int row0 = brow + wr * 64 + m * 16;
          bool latent = row0 < TL;
          int b = latent ? (row0 >> 12) : ((row0 - TL) >> 8);
          int kp16 = latent ? (CTX + (row0 & 4095)) : ((row0 - TL) & 255);
          int slot = kp16 + 8 * (fq & 1) + 4 * (fq >> 1);
#pragma unroll
          for (int n = 0; n < 4; ++n) {
            int dim = n * 16 + fr;
            uint2 o;
            o.x = pack2(acc[m][n][0], acc[m][n][1]);
            o.y = pack2(acc[m][n][2], acc[m][n][3]);
            *reinterpret_cast<uint2*>(p->vbuf + ((size_t)(b * 2 + kvh) * 64 + dim) * KVLEN + slot) = o;
          }
        }
      } else {
#pragma unroll
        for (int m = 0; m < 4; ++m)
#pragma unroll
          for (int j = 0; j < 4; ++j) {
            int row = brow + wr * 64 + m * 16 + fq * 4 + j;
            bool latent = row < TL;
            int b, pos;
            if (latent) {
              b = row >> 12;
              pos = row & 4095;
            } else {
              b = (row - TL) >> 8;
              pos = (row - TL) & 255;
            }
            float v0 = acc[m][0][j], v1 = acc[m][1][j], v2 = acc[m][2][j], v3 = acc[m][3][j];
            if (latent && colbase < 640) {
              float2 cr = p->cs[(pos >> 6) * 16 + fr];
              float2 cc = p->cs[(pos & 63) * 16 + fr];
              float a = v0, bb = v1;
              v0 = a * cr.x - bb * cr.y;
              v1 = bb * cr.x + a * cr.y;
              a = v2;
              bb = v3;
              v2 = a * cc.x - bb * cc.y;
              v3 = bb * cc.x + a * cc.y;
            }
            bf16_t* o;
            if (colbase < 512 || colbase >= 768) {
              o = p->P + (size_t)row * 2048 + colbase + fr;
            } else {
              int kvh = (colbase - 512) >> 6;
              int kp = latent ? (CTX + pos) : pos;
              o = p->kbuf + ((size_t)(b * 2 + kvh) * KVLEN + kp) * 64 + fr;
            }
            o[0] = f2bf(v0);
            o[16] = f2bf(v1);
            o[32] = f2bf(v2);
            o[48] = f2bf(v3);
          }
      }
    }
  }
}

DEVI bf16x8 scale_q(uint4 u) {
  uint4 r;
  r.x = pack2(bflo(u.x) * 0.125f, bfhi(u.x) * 0.125f);
  r.y = pack2(bflo(u.y) * 0.125f, bfhi(u.y) * 0.125f);
  r.z = pack2(bflo(u.z) * 0.125f, bfhi(u.z) * 0.125f);
  r.w = pack2(bflo(u.w) * 0.125f, bfhi(u.w) * 0.125f);
  return __builtin_bit_cast(bf16x8, r);
}
DEVI void phase_attn(PP p, int layer, bool with_ctx_q) {
  const int tid = ltid();
  const int lane = tid & 63, wid = __builtin_amdgcn_readfirstlane(tid >> 6), r = lane & 31, h = lane >> 5;
  const float* sinkp = p->attn_sink + (layer >> 1) * 8;
  const int nunits = 2048 + (with_ctx_q ? 128 : 0);
  for (int u = lbid(); u < nunits; u += lnblk()) {
    bool latent = u < 2048;
    int b, kvh, qg, tokbase;
    if (latent) {
      b = u >> 8;
      kvh = (u >> 7) & 1;
      qg = u & 127;
      tokbase = b * SEQ + qg * 32;
    } else {
      int v = u - 2048;
      b = v >> 4;
      kvh = (v >> 3) & 1;
      qg = v & 7;
      tokbase = TL + b * CTX + qg * 32;
    }
    const int hd = kvh * 4 + wid;
    const bf16_t* kb = p->kbuf + (size_t)(b * 2 + kvh) * KVLEN * 64;
    const bf16_t* vt = p->vbuf + (size_t)(b * 2 + kvh) * 64 * KVLEN;
    bf16x8 qf[4];
    {
      const bf16_t* qp = p->P + (size_t)(tokbase + r) * 2048 + hd * 64 + 8 * h;
#pragma unroll
      for (int st = 0; st < 4; ++st) qf[st] = scale_q(*reinterpret_cast<const uint4*>(qp + 16 * st));
    }
    f32x16 O0, O1;
#pragma unroll
    for (int i = 0; i < 16; ++i) {
      O0[i] = 0.f;
      O1[i] = 0.f;
    }
    float m_run = sinkp[hd];
    float l_run = (h == 0) ? 1.f : 0.f;
    const int nkb = latent ? 17 : 8;
    for (int kbi = 0; kbi < nkb; ++kbi) {
      int kpos, mode = 0;
      if (kbi < 8) {
        kpos = kbi * 32;
      } else {
        int d = kbi - 12;
        int kblk = qg + d;
        if (kblk < 0 || kblk > 127) continue;
        kpos = CTX + kblk * 32;
        mode = (d == -4) ? 1 : ((d == 4) ? 2 : 0);
      }
      f32x16 S;
#pragma unroll
      for (int i = 0; i < 16; ++i) S[i] = 0.f;
#pragma unroll
      for (int st = 0; st < 4; ++st) {
        bf16x8 kf = *reinterpret_cast<const bf16x8*>(kb + (size_t)(kpos + r) * 64 + 16 * st + 8 * h);
        S = __builtin_amdgcn_mfma_f32_32x32x16_bf16(kf, qf[st], S, 0, 0, 0);
      }
      if (mode) {
#pragma unroll
        for (int i = 0; i < 16; ++i) {
          int kk = (i & 3) + 8 * (i >> 2) + 4 * h;
          bool ok = (mode == 1) ? (kk >= r) : (kk <= r);
          if (!ok) S[i] = -1e30f;
        }
      }
      float bm = S[0];
#pragma unroll
      for (int i = 1; i < 16; ++i) bm = fmaxf(bm, S[i]);
      bm = fmaxf(bm, __shfl_xor(bm, 32));
      float m_new = fmaxf(m_run, bm);
      const float L2E = 1.4426950408889634f;
      float nm = -m_new * L2E;
      float psum = 0.f;
#pragma unroll
      for (int i = 0; i < 16; ++i) {
        S[i] = __builtin_amdgcn_exp2f(fmaf(S[i], L2E, nm));
        psum += S[i];
      }
      if (__any(m_new > m_run)) {
        float alpha = __builtin_amdgcn_exp2f((m_run - m_new) * L2E);
        l_run *= alpha;
#pragma unroll
        for (int i = 0; i < 16; ++i) {
          O0[i] *= alpha;
          O1[i] *= alpha;
        }
      }
      l_run += psum;
      m_run = m_new;
#pragma unroll
      for (int sidx = 0; sidx < 2; ++sidx) {
        uint4 pk;
        pk.x = pack2(S[8 * sidx + 0], S[8 * sidx + 1]);
        pk.y = pack2(S[8 * sidx + 2], S[8 * sidx + 3]);
        pk.z = pack2(S[8 * sidx + 4], S[8 * sidx + 5]);
        pk.w = pack2(S[8 * sidx + 6], S[8 * sidx + 7]);
        bf16x8 pf = __builtin_bit_cast(bf16x8, pk);
        bf16x8 v0 = *reinterpret_cast<const bf16x8*>(vt + (size_t)r * KVLEN + kpos + 16 * sidx + 8 * h);
        bf16x8 v1 = *reinterpret_cast<const bf16x8*>(vt + (size_t)(32 + r) * KVLEN + kpos + 16 * sidx + 8 * h);
        O0 = __builtin_amdgcn_mfma_f32_32x32x16_bf16(v0, pf, O0, 0, 0, 0);
        O1 = __builtin_amdgcn_mfma_f32_32x32x16_bf16(v1, pf, O1, 0, 0, 0);
      }
    }
    float l_tot = l_run + __shfl_xor(l_run, 32);
    float inv = 1.f / l_tot;
    bf16_t* op = p->mix + (size_t)(tokbase + r) * LDMIX + hd * 64 + 4 * h;
#pragma unroll
    for (int g4 = 0; g4 < 4; ++g4) {
      uint2 o;
      o.x = pack2(O0[4 * g4 + 0] * inv, O0[4 * g4 + 1] * inv);
      o.y = pack2(O0[4 * g4 + 2] * inv, O0[4 * g4 + 3] * inv);
      *reinterpret_cast<uint2*>(op + 8 * g4) = o;
      o.x = pack2(O1[4 * g4 + 0] * inv, O1[4 * g4 + 1] * inv);
      o.y = pack2(O1[4 * g4 + 2] * inv, O1[4 * g4 + 3] * inv);
      *reinterpret_cast<uint2*>(op + 32 + 8 * g4) = o;
    }
  }
}

DEVI void fill_tw(float2* tw, int n) {
  for (int i = ltid(); i < n; i += NTHREADS) {
    float sn, cn;
    sincospif(2.f * (float)i / (float)n, &sn, &cn);
    tw[i] = make_float2(cn, sn);
  }
  __syncthreads();
}

DEVI bf16x8 lds_col8(const bf16_t* bp, int stride) {
  unsigned e0 = bp[0], e1 = bp[stride], e2 = bp[2 * stride], e3 = bp[3 * stride];
  unsigned e4 = bp[4 * stride], e5 = bp[5 * stride], e6 = bp[6 * stride], e7 = bp[7 * stride];
  uint4 pk;
  pk.x = e0 | (e1 << 16);
  pk.y = e2 | (e3 << 16);
  pk.z = e4 | (e5 << 16);
  pk.w = e6 | (e7 << 16);
  return __builtin_bit_cast(bf16x8, pk);
}

DEVI void phase_fft_a(PP p, unsigned char* lds) {
  const int tid = ltid();
  const int lane = tid & 63, wid = __builtin_amdgcn_readfirstlane(tid >> 6), fr = lane & 15, fq = lane >> 4;
  float2* tw = reinterpret_cast<float2*>(lds + 66560);
  fill_tw(tw, 64);
  bf16x8 af[2][2];
#pragma unroll
  for (int ks = 0; ks < 2; ++ks) {
    unsigned short cr[8], ci[8];
#pragma unroll
    for (int j = 0; j < 8; ++j) {
      int n1 = 32 * ks + 8 * fq + j, k1 = 16 * wid + fr;
      float2 t = tw[(k1 * n1) & 63];
      cr[j] = f2bf(t.x);
      ci[j] = f2bf(-t.y);
    }
    uint4 a0, a1;
    a0.x = cr[0] | ((unsigned)cr[1] << 16); a0.y = cr[2] | ((unsigned)cr[3] << 16);
    a0.z = cr[4] | ((unsigned)cr[5] << 16); a0.w = cr[6] | ((unsigned)cr[7] << 16);
    a1.x = ci[0] | ((unsigned)ci[1] << 16); a1.y = ci[2] | ((unsigned)ci[3] << 16);
    a1.z = ci[4] | ((unsigned)ci[5] << 16); a1.w = ci[6] | ((unsigned)ci[7] << 16);
    af[0][ks] = __builtin_bit_cast(bf16x8, a0);
    af[1][ks] = __builtin_bit_cast(bf16x8, a1);
  }
  const bf16_t* l16 = reinterpret_cast<const bf16_t*>(lds);
  for (int u = lbid(); u < NB * 64; u += lnblk()) {
    int b = u >> 6, n2 = u & 63;
    __syncthreads();
#pragma unroll
    for (int i = 0; i < 16; ++i) {
      int row = (tid >> 6) + 4 * i, piece = tid & 63;
      uint4 v = *reinterpret_cast<const uint4*>(p->P + (size_t)(b * SEQ + 64 * row + n2) * 2048 + 768 + piece * 8);
      *reinterpret_cast<uint4*>(lds + row * 1040 + piece * 16) = v;
    }
    __syncthreads();
    float tc[4], ts[4];
#pragma unroll
    for (int j = 0; j < 4; ++j) sincospif((float)(n2 * (16 * wid + 4 * fq + j)) / 2048.f, &ts[j], &tc[j]);
    for (int nb = 0; nb < 4; ++nb) {
      f32x4 acc[2][8];
#pragma unroll
      for (int n = 0; n < 8; ++n) {
        acc[0][n] = f32x4{0.f, 0.f, 0.f, 0.f};
        acc[1][n] = f32x4{0.f, 0.f, 0.f, 0.f};
      }
#pragma unroll
      for (int ks = 0; ks < 2; ++ks)
#pragma unroll
        for (int nf = 0; nf < 8; ++nf) {
          bf16x8 bfr = lds_col8(l16 + (32 * ks + 8 * fq) * 520 + 128 * nb + 16 * nf + fr, 520);
          acc[0][nf] = __builtin_amdgcn_mfma_f32_16x16x32_bf16(af[0][ks], bfr, acc[0][nf], 0, 0, 0);
          acc[1][nf] = __builtin_amdgcn_mfma_f32_16x16x32_bf16(af[1][ks], bfr, acc[1][nf], 0, 0, 0);
        }
#pragma unroll
      for (int j = 0; j < 4; ++j) {
        int k1 = 16 * wid + 4 * fq + j;
        bf16_t* o = p->fa + (size_t)(b * SEQ + k1 * 64 + n2) * 1024 + 128 * nb + fr;
#pragma unroll
        for (int nf = 0; nf < 8; ++nf) {
          float re = acc[0][nf][j], im = acc[1][nf][j];
          o[16 * nf] = f2bf(re * tc[j] + im * ts[j]);
          o[512 + 16 * nf] = f2bf(im * tc[j] - re * ts[j]);
        }
      }
    }
  }
  __syncthreads();
}

DEVI void phase_fft_b(PP p, unsigned char* lds) {
  const int tid = ltid();
  const int lane = tid & 63, wid = __builtin_amdgcn_readfirstlane(tid >> 6), fr = lane & 15, fq = lane >> 4;
  float2* tw = reinterpret_cast<float2*>(lds + 67584);
  fill_tw(tw, 64);
  bf16x8 wb[2][4];
#pragma unroll
  for (int ks = 0; ks < 4; ++ks) {
    unsigned short zr[8], zi[8];
#pragma unroll
    for (int j = 0; j < 8; ++j) {
      int k = 32 * ks + 8 * fq + j, part = k >> 6, n2 = k & 63, k2 = 16 * wid + fr;
      float2 t = tw[(k2 * n2) & 63];
      zr[j] = f2bf(part ? t.y : t.x);
      zi[j] = f2bf(part ? t.x : -t.y);
    }
    uint4 a0, a1;
    a0.x = zr[0] | ((unsigned)zr[1] << 16); a0.y = zr[2] | ((unsigned)zr[3] << 16);
    a0.z = zr[4] | ((unsigned)zr[5] << 16); a0.w = zr[6] | ((unsigned)zr[7] << 16);
    a1.x = zi[0] | ((unsigned)zi[1] << 16); a1.y = zi[2] | ((unsigned)zi[3] << 16);
    a1.z = zi[4] | ((unsigned)zi[5] << 16); a1.w = zi[6] | ((unsigned)zi[7] << 16);
    wb[0][ks] = __builtin_bit_cast(bf16x8, a0);
    wb[1][ks] = __builtin_bit_cast(bf16x8, a1);
  }
  const bf16_t* l16 = reinterpret_cast<const bf16_t*>(lds);
  const float scale = 0.0013810679320049757f;
  for (int u = lbid(); u < NB * 128; u += lnblk()) {
    int b = u >> 7, k1 = (u >> 1) & 63, hf = u & 1;
    __syncthreads();
#pragma unroll
    for (int i = 0; i < 16; ++i) {
      int row = (tid >> 5) + 8 * i, piece = tid & 31;
      int part = row >> 6, n2 = row & 63;
      uint4 v = *reinterpret_cast<const uint4*>(p->fa + (size_t)(b * SEQ + k1 * 64 + n2) * 1024 + part * 512 + hf * 256 + piece * 8);
      *reinterpret_cast<uint4*>(lds + row * 528 + piece * 16) = v;
    }
    __syncthreads();
    for (int nb = 0; nb < 2; ++nb) {
      f32x4 acc[2][8];
#pragma unroll
      for (int n = 0; n < 8; ++n) {
        acc[0][n] = f32x4{0.f, 0.f, 0.f, 0.f};
        acc[1][n] = f32x4{0.f, 0.f, 0.f, 0.f};
      }
#pragma unroll
      for (int ks = 0; ks < 4; ++ks)
#pragma unroll
        for (int nf = 0; nf < 8; ++nf) {
          bf16x8 bfr = lds_col8(l16 + (32 * ks + 8 * fq) * 264 + 128 * nb + 16 * nf + fr, 264);
          acc[0][nf] = __builtin_amdgcn_mfma_f32_16x16x32_bf16(wb[0][ks], bfr, acc[0][nf], 0, 0, 0);
          acc[1][nf] = __builtin_amdgcn_mfma_f32_16x16x32_bf16(wb[1][ks], bfr, acc[1][nf], 0, 0, 0);
        }
#pragma unroll
      for (int j = 0; j < 4; ++j) {
        int k2 = 16 * wid + 4 * fq + j;
        bf16_t* o = p->mix + (size_t)(b * SEQ + k1 + 64 * k2) * LDMIX + 512 + hf * 256 + 128 * nb + fr;
#pragma unroll
        for (int nf = 0; nf < 8; ++nf) {
          o[16 * nf] = f2bf(acc[0][nf][j] * scale);
          o[512 + 16 * nf] = f2bf(acc[1][nf][j] * scale);
        }
      }
    }
  }
  __syncthreads();
}

DEVI void phase_dft_ctx(PP p, unsigned char* lds) {
  float2* tw = reinterpret_cast<float2*>(lds);
  fill_tw(tw, 256);
  int tid = ltid();
  const float scale = 0.005524271728019903f;
  for (int u = lbid(); u < NB * 64; u += lnblk()) {
    int b = u >> 6, k0 = (u & 63) * 4;
    for (int pass = 0; pass < 2; ++pass) {
      int ch = tid + pass * 256;
      float zr[4], zi[4];
#pragma unroll
      for (int kk = 0; kk < 4; ++kk) zr[kk] = zi[kk] = 0.f;
#pragma unroll 8
      for (int n = 0; n < 256; ++n) {
        float v = bf2f(p->P[(size_t)(TL + b * CTX + n) * 2048 + 768 + ch]);
#pragma unroll
        for (int kk = 0; kk < 4; ++kk) {
          float2 t = tw[(n * (k0 + kk)) & 255];
          zr[kk] += v * t.x;
          zi[kk] -= v * t.y;
        }
      }
#pragma unroll
      for (int kk = 0; kk < 4; ++kk) {
        bf16_t* o = p->mix + (size_t)(TL + b * CTX + k0 + kk) * LDMIX;
        o[512 + ch] = f2bf(zr[kk] * scale);
        o[1024 + ch] = f2bf(zi[kk] * scale);
      }
    }
  }
  __syncthreads();
}

DEVI void phase_sgu(PP p, int j, int nchunks, unsigned char* lds) {
  float* rs = reinterpret_cast<float*>(lds);
  const int tid = ltid();
  const int lane = tid & 63, wid = __builtin_amdgcn_readfirstlane(tid >> 6), fr = lane & 15, fq = lane >> 4;
  const float* nw = p->gs_norm_w + j * 1024;
  for (int u = lbid(); u < nchunks * 8; u += lnblk()) {
    const int chunk = u >> 3, g = u & 7;
    const int tok0 = chunk * 128;
    const bf16_t* vT = p->zvT + (size_t)chunk * 1024 * 128;
    if (tid < 128) {
      const float* rp = p->rowss + (size_t)chunk * 16 * 128 + tid;
      float ss = 0.f;
#pragma unroll
      for (int sl = 0; sl < 16; ++sl) ss += rp[sl * 128];
      rs[tid] = rsqrtf(ss * (1.f / 1024.f) + 1e-6f);
    }
    __syncthreads();
    const float* wsg = p->gs_w_s + ((size_t)j * 8 + g) * 128 * 128;
    const float* bsg = p->gs_b_s + ((size_t)j * 8 + g) * 128;
    f32x4 acc[2][8];
#pragma unroll
    for (int m = 0; m < 2; ++m)
#pragma unroll
      for (int n = 0; n < 8; ++n) acc[m][n] = f32x4{0.f, 0.f, 0.f, 0.f};
#pragma unroll
    for (int ks = 0; ks < 4; ++ks) {
      bf16x8 a[2];
      const float* rsk = rs + 32 * ks + 8 * fq;
#pragma unroll
      for (int m = 0; m < 2; ++m) {
        const float4* wp = reinterpret_cast<const float4*>(wsg + (size_t)(32 * wid + 16 * m + fr) * 128 + 32 * ks + 8 * fq);
        float4 w0 = wp[0], w1 = wp[1];
        uint4 pk;
        pk.x = pack2(w0.x * rsk[0], w0.y * rsk[1]);
        pk.y = pack2(w0.z * rsk[2], w0.w * rsk[3]);
        pk.z = pack2(w1.x * rsk[4], w1.y * rsk[5]);
        pk.w = pack2(w1.z * rsk[6], w1.w * rsk[7]);
        a[m] = __builtin_bit_cast(bf16x8, pk);
      }
#pragma unroll
      for (int n = 0; n < 8; ++n) {
        bf16x8 bfr = *reinterpret_cast<const bf16x8*>(vT + (size_t)(g * 128 + 16 * n + fr) * 128 + 32 * ks + 8 * fq);
        acc[0][n] = __builtin_amdgcn_mfma_f32_16x16x32_bf16(a[0], bfr, acc[0][n], 0, 0, 0);
        acc[1][n] = __builtin_amdgcn_mfma_f32_16x16x32_bf16(a[1], bfr, acc[1][n], 0, 0, 0);
      }
    }
#pragma unroll
    for (int m = 0; m < 2; ++m)
#pragma unroll
      for (int jj = 0; jj < 4; ++jj) {
        int pp = 32 * wid + 16 * m + 4 * fq + jj;
        float bias = bsg[pp];
        const bf16_t* up = p->P + (size_t)(tok0 + pp) * 2048 + g * 128 + fr;
        bf16_t* op = p->mix + (size_t)(tok0 + pp) * LDMIX + g * 128 + fr;
#pragma unroll
        for (int n = 0; n < 8; ++n) {
          float sv = nw[g * 128 + 16 * n + fr] * acc[m][n][jj] + bias;
          op[16 * n] = f2bf(bf2f(up[16 * n]) * sv);
        }
      }
    __syncthreads();
  }
}

DEVI float mkkey(float v, unsigned idx, unsigned mask) { return __uint_as_float((__float_as_uint(v) & ~mask) | idx); }
#define INSERT16(list, x)                                                                                               \
  {                                                                                                                     \
    _Pragma("unroll") for (int i_ = 15; i_ >= 1; --i_) list[i_] = __builtin_amdgcn_fmed3f(list[i_ - 1], list[i_], x); \
    list[0] = fmaxf(list[0], x);                                                                                        \
  }

DEVI void phase_route(PP p, int layer, int ntok, unsigned char* lds) {
  const int tid = ltid();
  const int lane = tid & 63, wid = __builtin_amdgcn_readfirstlane(tid >> 6), fr = lane & 15, fq = lane >> 4;
  const int nb8 = lnblk() >> 3, bid = lbid();
  const int hh = bid & 7, slot = bid >> 3;
  const int ntiles = ntok / 64;
  const bool active = slot < nb8;
  float* sc = reinterpret_cast<float*>(lds + 32768);
  const float NEGK = -3.0e38f;
  for (int half = 0; half < 2; ++half) {
    __syncthreads();
    {
      const bf16_t* ksrc = p->keysb + ((size_t)((layer * 8 + hh) * 2 + half) * 128) * 128;
#pragma unroll
      for (int i = 0; i < 8; ++i) {
        int idx = tid + 256 * i, row = idx >> 4, c = idx & 15;
        uint4 v = *reinterpret_cast<const uint4*>(ksrc + (size_t)row * 128 + c * 8);
        *reinterpret_cast<uint4*>(lds + row * 256 + ((c ^ (row & 15)) << 4)) = v;
      }
    }
    __syncthreads();
    bf16x8 an[4];
    if (active && slot < ntiles) {
      const bf16_t* qa = p->P + (size_t)(slot * 64 + wid * 16 + fr) * 2048 + hh * 256 + half * 128 + fq * 8;
#pragma unroll
      for (int ks = 0; ks < 4; ++ks) an[ks] = *reinterpret_cast<const bf16x8*>(qa + ks * 32);
    }
    for (int tt = slot; active && tt < ntiles; tt += nb8) {
      const int tok0 = tt * 64;
      {
        bf16x8 a[4];
#pragma unroll
        for (int ks = 0; ks < 4; ++ks) a[ks] = an[ks];
        {
          const int ttn = (tt + nb8 < ntiles) ? tt + nb8 : tt;
          const bf16_t* qa = p->P + (size_t)(ttn * 64 + wid * 16 + fr) * 2048 + hh * 256 + half * 128 + fq * 8;
#pragma unroll
          for (int ks = 0; ks < 4; ++ks) an[ks] = *reinterpret_cast<const bf16x8*>(qa + ks * 32);
        }
#pragma unroll
        for (int nf = 0; nf < 8; ++nf) {
          f32x4 acc = f32x4{0.f, 0.f, 0.f, 0.f};
          const int krow = nf * 16 + fr;
#pragma unroll
          for (int ks = 0; ks < 4; ++ks) {
            bf16x8 bb = *reinterpret_cast<const bf16x8*>(lds + krow * 256 + (((4 * ks + fq) ^ (krow & 15)) << 4));
            acc = __builtin_amdgcn_mfma_f32_16x16x32_bf16(a[ks], bb, acc, 0, 0, 0);
          }
#pragma unroll
          for (int j = 0; j < 4; ++j) sc[(wid * 16 + fq * 4 + j) * 129 + krow] = mkkey(acc[j], (unsigned)krow, 127u);
        }
      }
      __syncthreads();
      const int row = tid & 63, part = tid >> 6;
      float list[16];
#pragma unroll
      for (int i = 0; i < 16; ++i) list[i] = NEGK;
      {
        const float* kr = sc + row * 129 + part * 32;
#pragma unroll 4
        for (int e = 0; e < 32; ++e) {
          float x = kr[e];
          INSERT16(list, x)
        }
      }
      __syncthreads();
      if (part & 1) {
#pragma unroll
        for (int i = 0; i < 16; ++i) sc[(row * 2 + (part >> 1)) * 17 + i] = list[i];
      }
      __syncthreads();
      if (!(part & 1)) {
#pragma unroll
        for (int i = 0; i < 16; ++i) {
          float x = sc[(row * 2 + (part >> 1)) * 17 + i];
          INSERT16(list, x)
        }
      }
      __syncthreads();
      if (part == 2) {
#pragma unroll
        for (int i = 0; i < 16; ++i) sc[row * 17 + i] = list[i];
      }
      __syncthreads();
      if (part == 0) {
#pragma unroll
        for (int i = 0; i < 16; ++i) {
          float x = sc[row * 17 + i];
          INSERT16(list, x)
        }
        float4* o = reinterpret_cast<float4*>(p->tops + ((size_t)(tok0 + row) * 16 + hh * 2 + half) * 16);
        o[0] = make_float4(list[0], list[1], list[2], list[3]);
        o[1] = make_float4(list[4], list[5], list[6], list[7]);
        o[2] = make_float4(list[8], list[9], list[10], list[11]);
        o[3] = make_float4(list[12], list[13], list[14], list[15]);
      }
      __syncthreads();
    }
  }
  __syncthreads();
  float* fl = reinterpret_cast<float*>(lds);
  for (int t4 = slot; active && t4 < ntiles + 3 * nb8; t4 += 4 * nb8) {
    const int tt = t4 + (tid >> 6) * nb8;
    if (tt < ntiles) {
      const int tok = tt * 64 + (tid & 63);
      const float4* src = reinterpret_cast<const float4*>(p->tops + ((size_t)tok * 16 + hh * 2) * 16);
      float v0[16], v1[16];
#pragma unroll
      for (int i = 0; i < 4; ++i) {
        float4 a = src[i], bq = src[4 + i];
        v0[4 * i] = a.x; v0[4 * i + 1] = a.y; v0[4 * i + 2] = a.z; v0[4 * i + 3] = a.w;
        v1[4 * i] = bq.x; v1[4 * i + 1] = bq.y; v1[4 * i + 2] = bq.z; v1[4 * i + 3] = bq.w;
      }
      float* f0 = fl + tid * 33;
      float* f1 = f0 + 16;
#pragma unroll
      for (int i = 0; i < 16; ++i) {
        f0[i] = v0[i];
        f1[i] = v1[i];
      }
      float l2[16];
#pragma unroll
      for (int i = 0; i < 16; ++i) l2[i] = mkkey(v0[0] + v1[i], (unsigned)(15 - i), 255u);
#pragma unroll
      for (int a = 1; a < 16; ++a)
#pragma unroll
        for (int bq = 0; bq < 16; ++bq)
          if ((a + 1) * (bq + 1) <= 16) {
            float x = mkkey(v0[a] + v1[bq], (unsigned)(a * 16 + 15 - bq), 255u);
            INSERT16(l2, x)
          }
      float sv[16];
      int ev[16];
      float mx = NEGK;
#pragma unroll
      for (int k = 0; k < 16; ++k) {
        unsigned ab = __float_as_uint(l2[k]) & 255u;
        unsigned k0 = __float_as_uint(f0[ab >> 4]), k1 = __float_as_uint(f1[15u - (ab & 15u)]);
        sv[k] = __uint_as_float(k0 & ~127u) + __uint_as_float(k1 & ~127u);
        ev[k] = (int)((k0 & 127u) * 128u + (k1 & 127u));
        mx = fmaxf(mx, sv[k]);
      }
      float sum = 0.f;
#pragma unroll
      for (int k = 0; k < 16; ++k) {
        sv[k] = __expf(sv[k] - mx);
        sum += sv[k];
      }
      float inv = 1.f / sum;
      size_t o = (size_t)tok * 128 + hh * 16;
      int4* eo = reinterpret_cast<int4*>(p->eidx + o);
      float4* go = reinterpret_cast<float4*>(p->gate + o);
#pragma unroll
      for (int k4 = 0; k4 < 4; ++k4) {
        eo[k4] = make_int4(ev[4 * k4], ev[4 * k4 + 1], ev[4 * k4 + 2], ev[4 * k4 + 3]);
        go[k4] = make_float4(sv[4 * k4] * inv, sv[4 * k4 + 1] * inv, sv[4 * k4 + 2] * inv, sv[4 * k4 + 3] * inv);
      }
    }
  }
  __syncthreads();
}

typedef float v2f __attribute__((ext_vector_type(2)));
DEVI void dec16(uint4 q, v2f* f) {
  f[0] = __builtin_amdgcn_cvt_pk_f32_fp8((int)q.x, false);
  f[1] = __builtin_amdgcn_cvt_pk_f32_fp8((int)q.x, true);
  f[2] = __builtin_amdgcn_cvt_pk_f32_fp8((int)q.y, false);
  f[3] = __builtin_amdgcn_cvt_pk_f32_fp8((int)q.y, true);
  f[4] = __builtin_amdgcn_cvt_pk_f32_fp8((int)q.z, false);
  f[5] = __builtin_amdgcn_cvt_pk_f32_fp8((int)q.z, true);
  f[6] = __builtin_amdgcn_cvt_pk_f32_fp8((int)q.w, false);
  f[7] = __builtin_amdgcn_cvt_pk_f32_fp8((int)q.w, true);
}
struct ExpBuf {
  uint4 q[8];
  uint4 h0, h1;
};
DEVI void exp_load(ExpBuf& B, const unsigned char* tab, const signed char* hrow, const unsigned short* idp, int j8, bool want_x) {
  const uint4 idv = *reinterpret_cast<const uint4*>(idp);
  const unsigned idw[4] = {idv.x, idv.y, idv.z, idv.w};
#pragma unroll
  for (int i = 0; i < 8; ++i) {
    unsigned e = (i & 1) ? (idw[i >> 1] >> 16) : (idw[i >> 1] & 0xffffu);
    unsigned off = e * (unsigned)D + 16u * j8;
    B.q[i] = *reinterpret_cast<const uint4*>(tab + off);
  }
  if (want_x) B.h0 = *reinterpret_cast<const uint4*>(hrow + 16 * j8);
}
template <int CTRL>
DEVI int dpp_movi(int v) { return __builtin_amdgcn_mov_dpp(v, CTRL, 0xF, 0xF, true); }
DEVI void exp_u_compute(const ExpBuf& B, int* pp, int j8) {
  int s0 = 0;
#pragma unroll
  for (int i = 0; i < 8; ++i) {
    int d = __builtin_amdgcn_sdot4((int)B.q[i].x, (int)B.h0.x, 0, false);
    d = __builtin_amdgcn_sdot4((int)B.q[i].y, (int)B.h0.y, d, false);
    d = __builtin_amdgcn_sdot4((int)B.q[i].z, (int)B.h0.z, d, false);
    d = __builtin_amdgcn_sdot4((int)B.q[i].w, (int)B.h0.w, d, false);
    d += dpp_movi<0xB1>(d);
    d += dpp_movi<0x4E>(d);
    d += dpp_movi<0x141>(d);
    s0 = (j8 == i) ? d : s0;
  }
  pp[0] += s0;
}
DEVI void exp_v_accum(const ExpBuf& B, unsigned w0, unsigned w1, int* acc) {
#pragma unroll
  for (int ig = 0; ig < 2; ++ig) {
    const unsigned wq = ig ? w1 : w0;
    const uint4 R0 = B.q[4 * ig], R1 = B.q[4 * ig + 1], R2 = B.q[4 * ig + 2], R3 = B.q[4 * ig + 3];
    const unsigned r0[4] = {R0.x, R0.y, R0.z, R0.w}, r1[4] = {R1.x, R1.y, R1.z, R1.w};
    const unsigned r2[4] = {R2.x, R2.y, R2.z, R2.w}, r3[4] = {R3.x, R3.y, R3.z, R3.w};
#pragma unroll
    for (int q = 0; q < 4; ++q) {
      unsigned A = __builtin_amdgcn_perm(r1[q], r0[q], 0x05010400u);
      unsigned Bq = __builtin_amdgcn_perm(r1[q], r0[q], 0x07030602u);
      unsigned C = __builtin_amdgcn_perm(r3[q], r2[q], 0x05010400u);
      unsigned E = __builtin_amdgcn_perm(r3[q], r2[q], 0x07030602u);
      unsigned D0 = __builtin_amdgcn_perm(C, A, 0x05040100u);
      unsigned D1 = __builtin_amdgcn_perm(C, A, 0x07060302u);
      unsigned D2 = __builtin_amdgcn_perm(E, Bq, 0x05040100u);
      unsigned D3 = __builtin_amdgcn_perm(E, Bq, 0x07060302u);
      acc[4 * q + 0] = __builtin_amdgcn_sdot4((int)D0, (int)wq, acc[4 * q + 0], false);
      acc[4 * q + 1] = __builtin_amdgcn_sdot4((int)D1, (int)wq, acc[4 * q + 1], false);
      acc[4 * q + 2] = __builtin_amdgcn_sdot4((int)D2, (int)wq, acc[4 * q + 2], false);
      acc[4 * q + 3] = __builtin_amdgcn_sdot4((int)D3, (int)wq, acc[4 * q + 3], false);
    }
  }
}
DEVI void exp_v_finish(float4* xo, const float4* xq, const float4* gq, int* acc, float swt, int grp, float gscale) {
  float o[16];
#pragma unroll
  for (int k = 0; k < 16; ++k) {
    int a = acc[k];
    a += dpp_movi<0x128>(a);
    a += __shfl_xor(a, 16);
    a += __shfl_xor(a, 32);
    o[k] = (float)a;
    acc[k] = 0;
  }
  if (grp == 0) {
    const float sc = gscale * swt;
#pragma unroll
    for (int i4 = 0; i4 < 4; ++i4) {
      float4 r = xq[i4];
      r.x += sc * gq[i4].x * o[i4 * 4 + 0];
      r.y += sc * gq[i4].y * o[i4 * 4 + 1];
      r.z += sc * gq[i4].z * o[i4 * 4 + 2];
      r.w += sc * gq[i4].w * o[i4 * 4 + 3];
      xo[i4] = r;
    }
  }
}
DEVI void phase_expert(PP p, int layer, int ntok, unsigned char* lds, float gscale = 1.f, int idmask = 0xffff) {
  const int tid = ltid();
  const int lane = tid & 63, wid = __builtin_amdgcn_readfirstlane(tid >> 6), j8 = lane & 7, grp = lane >> 3;
  const int nb = lnblk(), bid = lbid();
  unsigned short* ids = reinterpret_cast<unsigned short*>(lds);
  float* part = reinterpret_cast<float*>(lds + TPB * 128 * 2);
  unsigned char* w8 = lds + TPB * 128 * 2 + TPB * 128 * 4;
  float* swl = reinterpret_cast<float*>(lds + TPB * 128 * 2 + TPB * 128 * 4 + TPB * 128);
  const unsigned char* ut = p->utab + (size_t)layer * NEXP * D;
  const unsigned char* vt = p->vtab + (size_t)layer * NEXP * D;
  int tpb = (ntok + nb - 1) / nb;
  if (tpb > TPB) tpb = TPB;
  const int npass = (ntok + nb * tpb - 1) / (nb * tpb);
  for (int pass = 0; pass < npass; ++pass) {
    const int tok0 = (pass * nb + bid) * tpb;
    int cnt = ntok - tok0;
    if (cnt > tpb) cnt = tpb;
    if (cnt < 0) cnt = 0;
    for (int i = tid; i < cnt * 128; i += NTHREADS) {
      {
        int k = i & 127, hf = k >> 6, kk = k & 63;
        ids[(i & ~127) + hf * 64 + (kk & 7) * 8 + (kk >> 3)] = (unsigned short)(p->eidx[(size_t)tok0 * 128 + i] & idmask);
      }
      part[i] = 0.f;
    }
    __syncthreads();
    const int ntw = (cnt - wid + 3) >> 2;
    const int npair = ntw * 8;

    if (!(REP_MODE == 1 && gscale != 1.f)) {
      ExpBuf B0, B1;
      int c0 = 0, k0 = 0;
      if (npair > 0) {
        const int t0 = wid;
        exp_load(B0, ut, p->h8 + (size_t)(tok0 + t0) * D, ids + t0 * 128 + grp * 8, j8, true);
      }
      for (int pr = 0; pr < npair; ++pr) {
        const int t0 = wid + 4 * k0;
        exp_load(B1, ut + 128 * c0, p->h8 + (size_t)(tok0 + t0) * D + 128 * c0, ids + t0 * 128 + 64 + grp * 8, j8, true);
        exp_u_compute(B0, reinterpret_cast<int*>(part) + t0 * 128 + 8 * j8 + grp, j8);
        int c1 = c0, k1 = k0;
        if (pr + 1 < npair) {
          k1 = k0 + 1;
          if (k1 == ntw) {
            k1 = 0;
            c1 = c0 + 1;
          }
        }
        {
          const int t1 = wid + 4 * k1;
          exp_load(B0, ut + 128 * c1, p->h8 + (size_t)(tok0 + t1) * D + 128 * c1, ids + t1 * 128 + grp * 8, j8, true);
        }
        exp_u_compute(B1, reinterpret_cast<int*>(part) + t0 * 128 + 64 + 8 * j8 + grp, j8);
        c0 = c1;
        k0 = k1;
      }
    }
    __syncthreads();
    for (int t = wid; t < cnt; t += 4) {
      float wv2[2];
      float am = 0.f;
#pragma unroll
      for (int hh = 0; hh < 2; ++hh) {
        int k = lane + 64 * hh;
        int e = ids[t * 128 + hh * 64 + (lane & 7) * 8 + (lane >> 3)];
        float dq = (float)reinterpret_cast<int*>(part)[t * 128 + k] * p->su[(size_t)layer * NEXP + e] * p->sx[tok0 + t];
        float wv = p->gate[(size_t)(tok0 + t) * 128 + k] * gelu_tanh(dq) * p->sv[(size_t)layer * NEXP + e];
        wv2[hh] = wv;
        am = fmaxf(am, fabsf(wv));
      }
      am = fmaxf(wave_max(am), 1e-30f);
      float qs = 127.f / am;
#pragma unroll
      for (int hh = 0; hh < 2; ++hh) {
        int k = lane + 64 * hh;
        int q = (int)rintf(wv2[hh] * qs);
        w8[t * 128 + (k & 7) * 16 + hh * 8 + ((k >> 3) & 7)] = (unsigned char)(q & 255);
      }
      if (lane == 0) swl[t] = am * (1.f / 127.f);
    }
    __syncthreads();
    if (!(REP_MODE == 2 && gscale != 1.f)) {
      ExpBuf B0, B1;
      int acc[16];
#pragma unroll
      for (int k = 0; k < 16; ++k) acc[k] = 0;
      int c0 = 0, k0 = 0;
      if (npair > 0) {
        const int t0 = wid;
        exp_load(B0, vt, (const signed char*)nullptr, ids + t0 * 128 + grp * 8, j8, false);
      }
      for (int pr = 0; pr < npair; ++pr) {
        const int t0 = wid + 4 * k0;
        float4 xq[4], gq[4];
        float4* xo = reinterpret_cast<float4*>(p->xs + (size_t)(tok0 + t0) * D + 128 * c0 + 16 * j8);
        {
          const float4* gf = reinterpret_cast<const float4*>(p->mod + ((size_t)layer * 9 + tok_batch(tok0 + t0)) * 6144 + 5 * 1024 + 128 * c0 + 16 * j8);
#pragma unroll
          for (int i4 = 0; i4 < 4; ++i4) {
            xq[i4] = xo[i4];
            gq[i4] = gf[i4];
          }
        }
        exp_load(B1, vt + 128 * c0, (const signed char*)nullptr, ids + t0 * 128 + 64 + grp * 8, j8, false);
        const uint4 wq = *reinterpret_cast<const uint4*>(w8 + t0 * 128 + grp * 16);
        exp_v_accum(B0, wq.x, wq.y, acc);
        int c1 = c0, k1 = k0;
        if (pr + 1 < npair) {
          k1 = k0 + 1;
          if (k1 == ntw) {
            k1 = 0;
            c1 = c0 + 1;
          }
        }
        {
          const int t1 = wid + 4 * k1;
          exp_load(B0, vt + 128 * c1, (const signed char*)nullptr, ids + t1 * 128 + grp * 8, j8, false);
        }
        exp_v_accum(B1, wq.z, wq.w, acc);
        exp_v_finish(xo, xq, gq, acc, swl[t0], grp, gscale);
        c0 = c1;
        k0 = k1;
      }
    }
    asm volatile("s_waitcnt vmcnt(0)" ::: "memory");
    __syncthreads();
    if (gscale == 1.f) {
      for (int t = wid; t < cnt; t += 4) {
        if (layer + 1 < DEPTH) norm_row(p, layer + 1, 0, tok0 + t, lane);
        else if (tok0 + t < TL) norm_row(p, 0, 2, tok0 + t, lane);
      }
    }
    __syncthreads();
  }
}

#define XB_TMO 128
#define XB_XCNT(j) (256 + 64 * (j))
#define XB_XSUB(j) (1280 + 64 * (j))
#define XB_XGEN(j) (2304 + 64 * (j))
#define XB_TOP 3328
#define XB_TOPGEN 3392
#define XCD_BAR_WORDS 3456
#define XB_SPIN_CAP (1u << 22)
#define LAS __attribute__((address_space(3)))
DEVI unsigned xb_ld(unsigned* p) { return __hip_atomic_load(p, __ATOMIC_RELAXED, __HIP_MEMORY_SCOPE_AGENT); }
DEVI unsigned xb_add(unsigned* p, unsigned v) { return __hip_atomic_fetch_add(p, v, __ATOMIC_RELAXED, __HIP_MEMORY_SCOPE_AGENT); }
DEVI unsigned xb_xcc_id() { return (unsigned)__builtin_amdgcn_s_getreg((3 << 11) | 20) & 0xFu; }
#define XB_SPIN(cond, bar)                                   \
  do {                                                       \
    unsigned _sp = 0;                                        \
    while (cond) {                                           \
      __builtin_amdgcn_s_sleep(1);                           \
      if ((++_sp & 255u) == 0u) {                            \
        if (xb_ld(&(bar)[XB_TMO])) break;                    \
        if (_sp > XB_SPIN_CAP) {                             \
          atomicAdd(&(bar)[XB_TMO], 1u);                     \
          break;                                             \
        }                                                    \
      }                                                      \
    }                                                        \
  } while (0)
struct XcdBarrier {
  unsigned* bar;
  unsigned x;
  volatile LAS unsigned* st;
};
DEVI XcdBarrier xcd_barrier_post(unsigned* bar, volatile LAS unsigned* st) {
  XcdBarrier b;
  b.bar = bar;
  b.x = xb_xcc_id();
  b.st = st;
  if (threadIdx.x == 0) (void)xb_add(&bar[XB_XCNT(b.x)], 1u);
  return b;
}
DEVI void xcd_barrier_complete(unsigned* bar, unsigned x, unsigned& nloc, unsigned& nx) {
  const unsigned G = gridDim.x * gridDim.y * gridDim.z;
  unsigned sum, cnt, mine, sp = 0u;
  for (;;) {
    sum = 0u;
    cnt = 0u;
    mine = 0u;
#pragma unroll
    for (unsigned j = 0; j < 16; ++j) {
      const unsigned c = xb_ld(&bar[XB_XCNT(j)]);
      sum += c;
      cnt += (c > 0u) ? 1u : 0u;
      mine = (j == x) ? c : mine;
    }
    if (sum == G) break;
    __builtin_amdgcn_s_sleep(1);
    if ((++sp & 255u) == 0u) {
      if (xb_ld(&bar[XB_TMO])) break;
      if (sp > XB_SPIN_CAP) {
        atomicAdd(&bar[XB_TMO], 1u);
        break;
      }
    }
  }
  nloc = mine > 0u ? mine : 1u;
  nx = cnt > 0u ? cnt : 1u;
}
DEVI void xcd_barrier(const XcdBarrier& b) {
  asm volatile("s_waitcnt vmcnt(0)" ::: "memory");
  __syncthreads();
  if (threadIdx.x == 0) {
    unsigned* bar = b.bar;
    __builtin_amdgcn_s_waitcnt(0);
    unsigned nloc = b.st[0], nx = b.st[1];
    if (nloc == 0u) {
      xcd_barrier_complete(bar, b.x, nloc, nx);
      b.st[0] = nloc;
      b.st[1] = nx;
    }
    const unsigned old = xb_add(&bar[XB_XSUB(b.x)], 1u);
    const unsigned gen = old / nloc;
    if (old + 1u == (gen + 1u) * nloc) {
      __builtin_amdgcn_fence(__ATOMIC_RELEASE, "agent");
      asm volatile("s_waitcnt vmcnt(0)" ::: "memory");
      const unsigned og = xb_add(&bar[XB_TOP], 1u);
      const unsigned tg = og / nx;
      if (og + 1u == (tg + 1u) * nx) xb_add(&bar[XB_TOPGEN], 1u);
      else XB_SPIN(xb_ld(&bar[XB_TOPGEN]) == tg, bar);
      __builtin_amdgcn_fence(__ATOMIC_ACQUIRE, "agent");
      xb_add(&bar[XB_XGEN(b.x)], 1u);
      asm volatile("s_waitcnt vmcnt(0)" ::: "memory");
    } else {
      XB_SPIN(xb_ld(&bar[XB_XGEN(b.x)]) == gen, bar);
      __builtin_amdgcn_fence(__ATOMIC_ACQUIRE, "agent");
      asm volatile("s_waitcnt vmcnt(0)" ::: "memory");
    }
  }
  __syncthreads();
}

DEVI bool step_active(int step) {
  if (step == 0) return true;
  if (step == NSTEPS - 1) return false;
  int layer = (step - 1) / STEPS_PER_LAYER, ph = (step - 1) % STEPS_PER_LAYER;
  if (ph == 3 && (layer & 1)) return false;
  if (ph == 0 && layer > 0) return false;
  return true;
}

DEVI void run_step(PP p, int step, unsigned char* lds, float gscale = 1.f) {
  if (step == 0) {
    phase_prep(p, lds);
    return;
  }
  if (step == NSTEPS - 1) {
    phase_norm(p, 0, 2, TL);
    return;
  }
  int layer = (step - 1) / STEPS_PER_LAYER, ph = (step - 1) % STEPS_PER_LAYER;
  bool even = (layer & 1) == 0;
  int j = layer >> 1;
  bool upd_ctx = layer < 2;
  bool need_ctx = layer < 3;
  int nt_in = need_ctx ? TT : TL;
  int nt = upd_ctx ? TT : TL;
  switch (ph) {
    case 0: phase_norm(p, layer, 0, nt_in); break;
    case 1:
      if (even)
        gemm_phase<EPI_INPROJ>(p, p->h, D, p->wt_in_ab + (size_t)j * 1280 * D, D, nt_in / 128, 10, D, layer, lds);
      else
        gemm_phase<EPI_GELU>(p, p->h, D, p->wt_in_gs + (size_t)j * 2048 * D, D, nt / 128, 16, D, layer, lds);
      break;
    case 2:
      if (even) {
        phase_fft_a(p, lds);
        if (upd_ctx) phase_dft_ctx(p, lds);
        phase_attn(p, layer, upd_ctx);
      } else {
        phase_sgu(p, j, nt / 128, lds);
      }
      break;
    case 3:
      if (even) phase_fft_b(p, lds);
      break;
    case 4:
      if (even)
        gemm_phase<EPI_RESID>(p, p->mix, LDMIX, p->wt_out_ab + (size_t)j * D * LDMIX, LDMIX, nt / 128, 8, LDMIX, layer, lds, gscale);
      else
        gemm_phase<EPI_RESID>(p, p->mix, LDMIX, p->wt_out_gs + (size_t)j * D * D, D, nt / 128, 8, D, layer, lds, gscale);
      break;
    case 5: phase_norm(p, layer, 1, nt); break;
    case 6: gemm_phase<EPI_STORE>(p, p->h, D, p->wt_q + (size_t)layer * 2048 * D, D, nt / 128, 16, D, layer, lds); break;
    case 7: phase_route(p, layer, nt, lds); break;
    case 8: phase_expert(p, layer, nt, lds, gscale, (gscale == 1.f) ? 0xffff : REP_IDMASK); break;
  }
}

__global__ void __launch_bounds__(NTHREADS, 2) mega(Params p_unused, int step_lo, int step_hi) {
  __shared__ __attribute__((aligned(16))) unsigned char lds[LDS_BYTES];
  PP pp = (PP)__builtin_amdgcn_kernarg_segment_ptr();
  volatile LAS unsigned* st = (volatile LAS unsigned*)(lds + LDS_BYTES - 16);
  if (threadIdx.x == 0) {
    st[0] = 0u;
    st[1] = 0u;
  }
  __syncthreads();
  XcdBarrier xb = xcd_barrier_post(pp->bar, st);
  int nsync = 0;
  bool first = true;
  for (int s = step_lo; s < step_hi; ++s) {
    if (!step_active(s)) continue;
    if (!first) {
      if (nsync == 0) cg::this_grid().sync();
      else xcd_barrier(xb);
      ++nsync;
    }
    first = false;
    PP q = pp;
    asm volatile("" : "+s"(q));
    run_step(q, s, lds);
#if REP_MASK
    if (s == 0 && ((REP_MASK >> 15) & 1)) {
      xcd_barrier(xb);
      PP q2 = pp;
      asm volatile("" : "+s"(q2));
      run_step(q2, 0, lds);
    }
    if (s > 0 && s < NSTEPS - 1) {
      int lay_ = (s - 1) / STEPS_PER_LAYER, ph_ = (s - 1) % STEPS_PER_LAYER;
      bool rep_ = (REP_MASK >> ph_) & 1;
      if (ph_ == 2 && ((REP_MASK >> 9) & 1) && !(lay_ & 1)) rep_ = true;
      if (ph_ == 2 && ((REP_MASK >> 10) & 1) && (lay_ & 1)) rep_ = true;
      if (rep_) {
        xcd_barrier(xb);
        PP q2 = pp;
        asm volatile("" : "+s"(q2));
        float z = 0.f;
        asm volatile("" : "+s"(z));
        run_step(q2, s, lds, z);
      }
      if (ph_ == 2 && ((REP_MASK >> 11) & 1) && !(lay_ & 1)) {
        xcd_barrier(xb);
        PP q2 = pp;
        asm volatile("" : "+s"(q2));
        phase_attn(q2, lay_, lay_ < 2);
      }
    }
#endif
  }
}

static size_t align_up(size_t v) { return (v + 255) & ~(size_t)255; }

extern "C" void kernel_launch(void* const* d_in, const int* in_sizes, int n_in, void* d_out, int out_size, void* d_ws,
                              size_t ws_size, hipStream_t stream) {
  Params p{};
  p.x = (const float*)d_in[0];
  p.c = (const float*)d_in[1];
  p.ctx = (const float*)d_in[2];
  p.c_ctx = (const float*)d_in[3];
  p.ada_w = (const float*)d_in[4];
  p.ada_b = (const float*)d_in[5];
  p.norm_mix_w = (const float*)d_in[6];
  p.norm_ffn_w = (const float*)d_in[7];
  p.ab_w_in = (const float*)d_in[8];
  p.ab_w_out = (const float*)d_in[9];
  p.attn_sink = (const float*)d_in[10];
  p.gs_w_in = (const float*)d_in[11];
  p.gs_norm_w = (const float*)d_in[12];
  p.gs_w_s = (const float*)d_in[13];
  p.gs_b_s = (const float*)d_in[14];
  p.gs_w_out = (const float*)d_in[15];
  p.peer_w_q = (const float*)d_in[16];
  p.peer_keys = (const float*)d_in[17];
  p.peer_u = (const float*)d_in[18];
  p.peer_v = (const float*)d_in[19];
  p.norm_out_w = (const float*)d_in[20];
  p.out = (float*)d_out;
  unsigned char* w = (unsigned char*)d_ws;
  size_t off = 0;
  auto take = [&](size_t bytes) {
    unsigned char* r = w + off;
    off = align_up(off + bytes);
    return r;
  };
  p.bar = (unsigned*)take((size_t)XCD_BAR_WORDS * 4);
  p.mod = (float*)take((size_t)DEPTH * 9 * 6144 * 4);
  p.cs = (float2*)take(64 * 16 * 8);
  p.xs = (float*)take((size_t)TT * D * 4);
  p.h = (bf16_t*)take((size_t)TT * D * 2);
  p.P = (bf16_t*)take((size_t)TT * 2048 * 2);
  p.kbuf = (bf16_t*)take((size_t)NB * 2 * KVLEN * 64 * 2);
  p.vbuf = (bf16_t*)take((size_t)NB * 2 * KVLEN * 64 * 2);
  p.zvT = (bf16_t*)take((size_t)TT * 1024 * 2);
  p.rowss = (float*)take((size_t)(TT / 128) * 16 * 128 * 4);
  p.mix = (bf16_t*)take((size_t)TT * LDMIX * 2);
  p.fa = (bf16_t*)take((size_t)TL * 1024 * 2);
  p.tops = (float*)take((size_t)TT * 256 * 4);
  p.eidx = (int*)take((size_t)TT * 128 * 4);
  p.gate = (float*)take((size_t)TT * 128 * 4);
  p.wt_in_ab = (bf16_t*)take((size_t)2 * 1280 * D * 2);
  p.wt_out_ab = (bf16_t*)take((size_t)2 * D * LDMIX * 2);
  p.wt_in_gs = (bf16_t*)take((size_t)2 * 2048 * D * 2);
  p.wt_out_gs = (bf16_t*)take((size_t)2 * D * D * 2);
  p.wt_q = (bf16_t*)take((size_t)DEPTH * 2048 * D * 2);
  p.keysb = (bf16_t*)take((size_t)DEPTH * 8 * 2 * 128 * 128 * 2);
  p.su = (float*)take((size_t)DEPTH * NEXP * 4);
  p.sv = (float*)take((size_t)DEPTH * NEXP * 4);
  p.h8 = (signed char*)take((size_t)TT * D);
  p.sx = (float*)take((size_t)TT * 4);
  p.utab = (unsigned char*)take((size_t)DEPTH * NEXP * D);
  p.vtab = (unsigned char*)take((size_t)DEPTH * NEXP * D);
  if (off > ws_size) {
    fprintf(stderr, "workspace too small: need %zu have %zu\n", off, ws_size);
    return;
  }
  hipMemsetAsync(p.bar, 0, (size_t)XCD_BAR_WORDS * 4, stream);
  static int grid_blocks = 0;
  if (!grid_blocks) {
    int dev = 0, cus = 0, per_cu = 0;
    hipGetDevice(&dev);
    hipDeviceGetAttribute(&cus, hipDeviceAttributeMultiprocessorCount, dev);
    hipOccupancyMaxActiveBlocksPerMultiprocessor(&per_cu, mega, NTHREADS, 0);
    if (per_cu > 2) per_cu = 2;
    if (per_cu < 1) per_cu = 1;
    grid_blocks = cus * per_cu;
  }
#if ONE_LAUNCH
  int lo = 0, hi = NSTEPS;
  void* args[] = {&p, &lo, &hi};
  hipError_t e = hipLaunchCooperativeKernel((void*)mega, dim3(grid_blocks), dim3(NTHREADS), args, 0, stream);
  if (e != hipSuccess) fprintf(stderr, "cooperative launch failed: %s (grid %d)\n", hipGetErrorString(e), grid_blocks);
#else
  for (int s = 0; s < NSTEPS; ++s) {
    if (s != 0 && s != NSTEPS - 1) {
      int layer = (s - 1) / STEPS_PER_LAYER, ph = (s - 1) % STEPS_PER_LAYER;
      if (ph == 3 && (layer & 1)) continue;
    }
    hipLaunchKernelGGL(mega, dim3(grid_blocks), dim3(NTHREADS), 0, stream, p, s, s + 1);
  }
#endif
}
```

```cpp
#include <hip/hip_runtime.h>
#include <hip/hip_bf16.h>
#include <hip/hip_cooperative_groups.h>
#include <cstdio>
namespace cg = cooperative_groups;

#ifndef REP_MASK
#define REP_MASK 0
#endif
#ifndef REP_MODE
#define REP_MODE 0
#endif
#ifndef REP_IDMASK
#define REP_IDMASK 0xffff
#endif
#ifndef ONE_LAUNCH
#define ONE_LAUNCH 1
#endif

#define DEVI __device__ __forceinline__
typedef unsigned short bf16_t;
using bf16x8 = __attribute__((ext_vector_type(8))) short;
using f32x4 = __attribute__((ext_vector_type(4))) float;
using f32x16 = __attribute__((ext_vector_type(16))) float;

constexpr int D = 1024, NB = 8, SEQ = 4096, CTX = 256, DEPTH = 4;
constexpr int TL = NB * SEQ, TC = NB * CTX, TT = TL + TC;
constexpr int KVLEN = CTX + SEQ;
constexpr int NEXP = 16384;
constexpr int LDMIX = 1536;
constexpr float USCALE = 64.f, VSCALE = 8.f;
constexpr int TPB = 68;
constexpr int LDS_HALF = 68 * 1024;
constexpr int LDS_BYTES = 2 * LDS_HALF;
constexpr int PHYS_THREADS = 512;
constexpr int NTHREADS = 256;
constexpr int STEPS_PER_LAYER = 9;
constexpr int NSTEPS = 1 + DEPTH * STEPS_PER_LAYER + 1;

struct Params {
  const float *x, *c, *ctx, *c_ctx, *ada_w, *ada_b, *norm_mix_w, *norm_ffn_w, *ab_w_in, *ab_w_out, *attn_sink,
      *gs_w_in, *gs_norm_w, *gs_w_s, *gs_b_s, *gs_w_out, *peer_w_q, *peer_keys, *peer_u, *peer_v, *norm_out_w;
  float* out;
  float* mod;
  float2* cs;
  float* xs;
  bf16_t* h;
  bf16_t* P;
  bf16_t* kbuf;
  bf16_t* vbuf;
  float* rowss;
  bf16_t* zvT;
  bf16_t* mix;
  bf16_t* fa;
  unsigned* bar;
  float* tops;
  int* eidx;
  float* gate;
  bf16_t *wt_in_ab, *wt_out_ab, *wt_in_gs, *wt_out_gs, *wt_q, *keysb;
  unsigned char *utab, *vtab;
  float* su;
  float* sv;
  signed char* h8;
  float* sx;
};

typedef const __attribute__((address_space(4))) Params* PP;

DEVI int ltid() { int t = threadIdx.x & 255; asm volatile("" : "+v"(t)); return t; }
DEVI int lbid() { int t = 2 * blockIdx.x + __builtin_amdgcn_readfirstlane(threadIdx.x >> 8); asm volatile("" : "+s"(t)); return t; }
DEVI int lnblk() { int t = 2 * gridDim.x; asm volatile("" : "+s"(t)); return t; }
DEVI int ptid() { int t = threadIdx.x; asm volatile("" : "+v"(t)); return t; }
DEVI int pbid() { int t = blockIdx.x; asm volatile("" : "+s"(t)); return t; }
DEVI int pnblk() { int t = gridDim.x; asm volatile("" : "+s"(t)); return t; }

typedef __bf16 bf2v_t __attribute__((ext_vector_type(2)));
typedef float f2v_t __attribute__((ext_vector_type(2)));
DEVI bf16_t f2bf(float f) { return __builtin_bit_cast(unsigned short, (__bf16)f); }
DEVI float bf2f(bf16_t h) { return __uint_as_float(((unsigned)h) << 16); }
DEVI float bflo(unsigned u) { return __uint_as_float(u << 16); }
DEVI float bfhi(unsigned u) { return __uint_as_float(u & 0xffff0000u); }
DEVI unsigned pack2(float a, float b) {
  f2v_t v = {a, b};
  return __builtin_bit_cast(unsigned, __builtin_convertvector(v, bf2v_t));
}
DEVI float wave_sum(float v) {
#pragma unroll
  for (int o = 32; o > 0; o >>= 1) v += __shfl_xor(v, o);
  return v;
}
DEVI float wave_max(float v) {
#pragma unroll
  for (int o = 32; o > 0; o >>= 1) v = fmaxf(v, __shfl_xor(v, o));
  return v;
}
DEVI float gelu_tanh(float x) {
  float u = 0.7978845608028654f * (x + 0.044715f * x * x * x);
  return 0.5f * x * (1.f + tanhf(u));
}
template <int CTRL>
DEVI float dpp_mov(float v) {
  return __builtin_bit_cast(float, __builtin_amdgcn_mov_dpp(__builtin_bit_cast(int, v), CTRL, 0xF, 0xF, true));
}
DEVI int tok_batch(int r) { return r < TL ? (r >> 12) : 8; }

DEVI void prep_transpose_tile(const float* __restrict__ src, int N, bf16_t* __restrict__ dst, int ldk, int tk, int tn, float* tile, int tid) {
#pragma unroll
  for (int i = 0; i < 16; ++i) {
    int r = (tid >> 6) + 4 * i;
    tile[r * 65 + (tid & 63)] = src[(size_t)(tk * 64 + r) * N + tn * 64 + (tid & 63)];
  }
  __syncthreads();
#pragma unroll
  for (int i = 0; i < 16; ++i) {
    int n = (tid >> 6) + 4 * i, k = tid & 63;
    dst[(size_t)(tn * 64 + n) * ldk + tk * 64 + k] = f2bf(tile[k * 65 + n]);
  }
}

constexpr int PU_ADA = DEPTH * 96;
constexpr int PU_T_ABIN = 2 * 16 * 20;
constexpr int PU_T_GSIN = 2 * 16 * 32;
constexpr int PU_T_GSOUT = 2 * 16 * 16;
constexpr int PU_T_ABOUT = 2 * 8 * 16;
constexpr int PU_T_Q = DEPTH * 16 * 32;
constexpr int PU_FOLD = 2 * 4 * 16 * 2;
constexpr int PU_CONV = DEPTH * NEXP * D / 4 / 2048;
constexpr int PU_KEYS = DEPTH * 8 * 2 * 128 * 128 / 4 / 2048;
constexpr int PU_UROWS = DEPTH * NEXP / 32;
constexpr int PU_TOTAL = PU_ADA + PU_T_ABIN + PU_T_GSIN + PU_T_GSOUT + PU_T_ABOUT + PU_T_Q + PU_FOLD + 2 * PU_UROWS + PU_KEYS + 1;

DEVI void phase_prep(PP p, unsigned char* lds) {
  const int tid = ltid();
  float* fl = reinterpret_cast<float*>(lds);
  for (int u0 = lbid(); u0 < PU_TOTAL; u0 += lnblk()) {
    int u = u0;
    if (u < PU_ADA) {
      float* sl = fl;
      for (int i = tid; i < 9 * 1024; i += NTHREADS) {
        int r = i >> 10, k = i & 1023;
        float v = (r < 8) ? p->c[r * 1024 + k] : p->c_ctx[k];
        sl[i] = v / (1.f + __expf(-v));
      }
      __syncthreads();
      float* red = sl + 9 * 1024;
      int ks = tid >> 6, col = tid & 63;
      int layer = u / 96, c0 = (u % 96) * 64;
      const float* w = p->ada_w + (size_t)layer * D * 6144 + c0 + col;
      float acc[9];
#pragma unroll
      for (int r = 0; r < 9; ++r) acc[r] = 0.f;
      for (int k0 = ks * 256; k0 < ks * 256 + 256; k0 += 16) {
        float wv[16];
#pragma unroll
        for (int kk = 0; kk < 16; ++kk) wv[kk] = w[(size_t)(k0 + kk) * 6144];
#pragma unroll
        for (int kk = 0; kk < 16; ++kk)
#pragma unroll
          for (int r = 0; r < 9; ++r) acc[r] += sl[r * 1024 + k0 + kk] * wv[kk];
      }
#pragma unroll
      for (int r = 0; r < 9; ++r) red[(ks * 9 + r) * 64 + col] = acc[r];
      __syncthreads();
      for (int i = tid; i < 9 * 64; i += NTHREADS) {
        int r = i >> 6, cc = i & 63;
        float sm = red[(0 * 9 + r) * 64 + cc] + red[(1 * 9 + r) * 64 + cc] + red[(2 * 9 + r) * 64 + cc] + red[(3 * 9 + r) * 64 + cc];
        sm += p->ada_b[(size_t)layer * 6144 + c0 + cc];
        p->mod[((size_t)layer * 9 + r) * 6144 + c0 + cc] = sm;
      }
      __syncthreads();
      continue;
    }
    u -= PU_ADA;
    if (u < PU_T_ABIN) {
      int j = u / 320, t = u % 320;
      prep_transpose_tile(p->ab_w_in + (size_t)j * D * 1280, 1280, p->wt_in_ab + (size_t)j * 1280 * D, D, t / 20, t % 20, fl, tid);
      __syncthreads();
      continue;
    }
    u -= PU_T_ABIN;
    if (u < PU_T_GSIN) {
      int j = u / 512, t = u % 512;
      prep_transpose_tile(p->gs_w_in + (size_t)j * D * 2048, 2048, p->wt_in_gs + (size_t)j * 2048 * D, D, t / 32, t % 32, fl, tid);
      __syncthreads();
      continue;
    }
    u -= PU_T_GSIN;
    if (u < PU_T_GSOUT) {
      int j = u / 256, t = u % 256;
      prep_transpose_tile(p->gs_w_out + (size_t)j * D * D, D, p->wt_out_gs + (size_t)j * D * D, D, t / 16, t % 16, fl, tid);
      __syncthreads();
      continue;
    }
    u -= PU_T_GSOUT;
    if (u < PU_T_ABOUT) {
      int j = u / 128, t = u % 128;
      prep_transpose_tile(p->ab_w_out + (size_t)j * D * D, D, p->wt_out_ab + (size_t)j * D * LDMIX, LDMIX, t / 16, t % 16, fl, tid);
      __syncthreads();
      continue;
    }
    u -= PU_T_ABOUT;
    if (u < PU_T_Q) {
      int i = u / 512, t = u % 512;
      prep_transpose_tile(p->peer_w_q + (size_t)i * D * 2048, 2048, p->wt_q + (size_t)i * 2048 * D, D, t / 32, t % 32, fl, tid);
      __syncthreads();
      continue;
    }
    u -= PU_T_Q;
    if (u < PU_FOLD) {
      const int mh = u & 1, nc = (u >> 1) & 15, g = (u >> 5) & 3, j = u >> 7;
      float2* tw = reinterpret_cast<float2*>(lds);
      float* wt = reinterpret_cast<float*>(lds + 1024);
      if (tid < 128) {
        float sn, cn;
        sincospif((float)tid / 64.f, &sn, &cn);
        tw[tid] = make_float2(cn, sn);
      }
      {
        const float* wsrc = p->ab_w_out + (size_t)j * D * D + (size_t)(512 + g * 128) * D + nc * 64;
#pragma unroll 8
        for (int i = 0; i < 32; ++i) {
          int l = (tid >> 6) + 4 * i;
          wt[l * 64 + (tid & 63)] = wsrc[(size_t)l * D + (tid & 63)];
        }
      }
      __syncthreads();
      const int n = tid & 63, mq = __builtin_amdgcn_readfirstlane(tid >> 6);
      bf16_t* dst = p->wt_out_ab + (size_t)j * D * LDMIX + (size_t)(nc * 64 + n) * LDMIX + g * 128;
#pragma unroll 1
      for (int mi = 0; mi < 16; ++mi) {
        const int m = mh * 64 + mq * 16 + mi;
        float ar = 0.f, ai = 0.f;
#pragma unroll 16
        for (int l = 0; l < 128; ++l) {
          float2 t = tw[(m * l) & 127];
          float wv = wt[l * 64 + n];
          ar += t.x * wv;
          ai += t.y * wv;
        }
        dst[512 + m] = f2bf(ar);
        dst[1024 + m] = f2bf(ai);
      }
      __syncthreads();
      continue;
    }
    u -= PU_FOLD;
    if (u < 2 * PU_UROWS) {
      const bool isv = u >= PU_UROWS;
      if (isv) u -= PU_UROWS;
      const float* src = isv ? p->peer_v : p->peer_u;
      unsigned char* dst = isv ? p->vtab : p->utab;
      float* sdst = isv ? p->sv : p->su;
      const int lane = tid & 63, wv = tid >> 6;
#pragma unroll 1
      for (int rr = 0; rr < 8; rr += 4) {
        size_t row0 = (size_t)u * 32 + wv * 8 + rr;
        float4 v[4][4];
#pragma unroll
        for (int k = 0; k < 4; ++k)
#pragma unroll
          for (int i = 0; i < 4; ++i) v[k][i] = reinterpret_cast<const float4*>(src + (row0 + k) * D)[lane * 4 + i];
#pragma unroll
        for (int k = 0; k < 4; ++k) {
          float am = 0.f;
#pragma unroll
          for (int i = 0; i < 4; ++i)
            am = fmaxf(am, fmaxf(fmaxf(fabsf(v[k][i].x), fabsf(v[k][i].y)), fmaxf(fabsf(v[k][i].z), fabsf(v[k][i].w))));
          am = wave_max(am);
          am = fmaxf(am, 1e-30f);
          float qs = 127.f / am;
          uint4 o;
          unsigned* op = reinterpret_cast<unsigned*>(&o);
#pragma unroll
          for (int i = 0; i < 4; ++i) {
            int q0 = (int)rintf(v[k][i].x * qs), q1 = (int)rintf(v[k][i].y * qs), q2 = (int)rintf(v[k][i].z * qs), q3 = (int)rintf(v[k][i].w * qs);
            op[i] = (unsigned)(q0 & 255) | ((unsigned)(q1 & 255) << 8) | ((unsigned)(q2 & 255) << 16) | ((unsigned)(q3 & 255) << 24);
          }
          reinterpret_cast<uint4*>(dst + (row0 + k) * D)[lane] = o;
          if (lane == 0) sdst[row0 + k] = am * (1.f / 127.f);
        }
      }
      continue;
    }
    u -= 2 * PU_UROWS;
    if (u < PU_KEYS) {
      const float4* s4 = reinterpret_cast<const float4*>(p->peer_keys) + (size_t)u * 2048 + tid;
      uint2* d2 = reinterpret_cast<uint2*>(p->keysb) + (size_t)u * 2048 + tid;
#pragma unroll
      for (int k = 0; k < 8; ++k) {
        float4 v = s4[k * 256];
        uint2 o;
        o.x = pack2(v.x, v.y);
        o.y = pack2(v.z, v.w);
        d2[k * 256] = o;
      }
      continue;
    }
    for (int i = tid; i < 64 * 16; i += NTHREADS) {
      int pos = i >> 4, k = i & 15;
      float inv = powf(10000.f, -(float)k / 16.f);
      float ang = (float)pos * inv;
      float sn, cn;
      sincosf(ang, &sn, &cn);
      p->cs[i] = make_float2(cn, sn);
    }
  }
}

DEVI void norm_row(PP p, int layer, int which, int tok, int lane) {
  const float* w = which == 0 ? p->norm_mix_w + layer * D : (which == 1 ? p->norm_ffn_w + layer * D : p->norm_out_w);
  const float* xsrc = p->xs + (size_t)tok * D;
  if (which == 0 && layer == 0) xsrc = (tok < TL) ? p->x + (size_t)tok * D : p->ctx + (size_t)(tok - TL) * D;
  const float4* xr = reinterpret_cast<const float4*>(xsrc);
  float4 v[4];
  float ss = 0.f;
#pragma unroll
  for (int i = 0; i < 4; ++i) {
    v[i] = xr[lane + 64 * i];
    ss += v[i].x * v[i].x + v[i].y * v[i].y + v[i].z * v[i].z + v[i].w * v[i].w;
  }
  ss = wave_sum(ss);
  float rstd = rsqrtf(ss * (1.f / 1024.f) + 1e-6f);
  if (which == 2) {
    float4* o = reinterpret_cast<float4*>(p->out + (size_t)tok * D);
#pragma unroll
    for (int i = 0; i < 4; ++i) {
      float4 wv = reinterpret_cast<const float4*>(w)[lane + 64 * i];
      float4 r;
      r.x = v[i].x * rstd * wv.x;
      r.y = v[i].y * rstd * wv.y;
      r.z = v[i].z * rstd * wv.z;
      r.w = v[i].w * rstd * wv.w;
      o[lane + 64 * i] = r;
    }
  } else {
    int b = tok_batch(tok);
    const float* mb = p->mod + ((size_t)layer * 9 + b) * 6144 + (which == 0 ? 0 : 3072);
    uint2* o = reinterpret_cast<uint2*>(p->h + (size_t)tok * D);
    float av[4][4];
    float am = 0.f;
#pragma unroll
    for (int i = 0; i < 4; ++i) {
      float4 wv = reinterpret_cast<const float4*>(w)[lane + 64 * i];
      float4 sh = reinterpret_cast<const float4*>(mb)[lane + 64 * i];
      float4 sc = reinterpret_cast<const float4*>(mb + 1024)[lane + 64 * i];
      float a0 = v[i].x * rstd * wv.x * (1.f + sc.x) + sh.x;
      float a1 = v[i].y * rstd * wv.y * (1.f + sc.y) + sh.y;
      float a2 = v[i].z * rstd * wv.z * (1.f + sc.z) + sh.z;
      float a3 = v[i].w * rstd * wv.w * (1.f + sc.w) + sh.w;
      uint2 r;
      r.x = pack2(a0, a1);
      r.y = pack2(a2, a3);
      o[lane + 64 * i] = r;
      av[i][0] = a0; av[i][1] = a1; av[i][2] = a2; av[i][3] = a3;
      am = fmaxf(am, fmaxf(fmaxf(fabsf(a0), fabsf(a1)), fmaxf(fabsf(a2), fabsf(a3))));
    }
    if (which == 1) {
      am = fmaxf(wave_max(am), 1e-30f);
      float qs = 127.f / am;
      unsigned* o8 = reinterpret_cast<unsigned*>(p->h8 + (size_t)tok * D);
#pragma unroll
      for (int i = 0; i < 4; ++i) {
        int q0 = (int)rintf(av[i][0] * qs), q1 = (int)rintf(av[i][1] * qs), q2 = (int)rintf(av[i][2] * qs), q3 = (int)rintf(av[i][3] * qs);
        o8[lane + 64 * i] = (unsigned)(q0 & 255) | ((unsigned)(q1 & 255) << 8) | ((unsigned)(q2 & 255) << 16) | ((unsigned)(q3 & 255) << 24);
      }
      if (lane == 0) p->sx[tok] = am * (1.f / 127.f);
    }
  }
}

DEVI void phase_norm(PP p, int layer, int which, int ntok) {
  int lane = ltid() & 63;
  int gw = lbid() * 4 + __builtin_amdgcn_readfirstlane(ltid() >> 6), nw = lnblk() * 4;
  for (int tok = gw; tok < ntok; tok += nw) norm_row(p, layer, which, tok, lane);
}

enum { EPI_STORE = 0, EPI_GELU = 1, EPI_RESID = 2, EPI_INPROJ = 3 };

template <int EPI>
DEVI void gemm_phase(PP p, const bf16_t* __restrict__ A, int lda, const bf16_t* __restrict__ Bt, int ldb,
                     int Mtiles, int Ntiles, int K, int layer, unsigned char* lds, float gscale = 1.f) {
  const int tid = ltid();
  const int wid = __builtin_amdgcn_readfirstlane(tid >> 6), lane = tid & 63, wr = wid >> 1, wc = wid & 1, fr = lane & 15, fq = lane >> 4;
  int nblk = lnblk();
  int bid = lbid();
  int lb = bid;
  {
    const int pn = nblk >> 1, pb = bid >> 1;
    if ((pn & 7) == 0) lb = 2 * ((pb & 7) * (pn >> 3) + (pb >> 3)) + (bid & 1);
  }
  int ntiles = Mtiles * Ntiles;
  const int nk = K / 64;
  const int srow = tid >> 3;
  const int scol = ((tid & 7) ^ ((tid >> 3) & 7)) * 8;
#define GEMM_STAGE(ga_, gb_, kt_, buf_)                                                                               \
  {                                                                                                                   \
    _Pragma("unroll") for (int i_ = 0; i_ < 4; ++i_) {                                                                \
      __builtin_amdgcn_global_load_lds((const unsigned*)((ga_) + (size_t)(32 * i_) * lda + (kt_) * 64),               \
                                       (__attribute__((address_space(3))) unsigned*)(lds + (buf_) * 32768 + tid * 16 + i_ * 4096), 16, 0, 0); \
      __builtin_amdgcn_global_load_lds((const unsigned*)((gb_) + (size_t)(32 * i_) * ldb + (kt_) * 64),               \
                                       (__attribute__((address_space(3))) unsigned*)(lds + (buf_) * 32768 + 16384 + tid * 16 + i_ * 4096), 16, 0, 0); \
    }                                                                                                                 \
  }
  if (lb < ntiles) {
    int tm0 = lb / Ntiles, tn0 = lb % Ntiles;
    const bf16_t* ga0 = A + (size_t)(tm0 * 128 + srow) * lda + scol;
    const bf16_t* gb0 = Bt + (size_t)(tn0 * 128 + srow) * ldb + scol;
    GEMM_STAGE(ga0, gb0, 0, 0)
  }
  for (int t = lb; t < ntiles; t += nblk) {
    int tm = t / Ntiles, tn = t % Ntiles;
    int brow = tm * 128, bcol = tn * 128;
    f32x4 acc[4][4];
#pragma unroll
    for (int m = 0; m < 4; ++m)
#pragma unroll
      for (int n = 0; n < 4; ++n) acc[m][n] = f32x4{0.f, 0.f, 0.f, 0.f};
    const bf16_t* ga = A + (size_t)(brow + srow) * lda + scol;
    const bf16_t* gb = Bt + (size_t)(bcol + srow) * ldb + scol;
    for (int kt = 0; kt < nk; ++kt) {
      const int buf = kt & 1;
      asm volatile("s_waitcnt vmcnt(0)" ::: "memory");
      __syncthreads();
      if (kt + 1 < nk) GEMM_STAGE(ga, gb, kt + 1, buf ^ 1)
      const unsigned char* SA = lds + buf * 32768;
      const unsigned char* SB = SA + 16384;
      bf16x8 At[2][4], Bl[2][4];
#pragma unroll
      for (int ks = 0; ks < 2; ++ks)
#pragma unroll
        for (int m = 0; m < 4; ++m) {
          const int sl = ((ks * 4 + fq) ^ (fr & 7)) << 4;
          At[ks][m] = *reinterpret_cast<const bf16x8*>(SA + (wr * 64 + m * 16 + fr) * 128 + sl);
          Bl[ks][m] = *reinterpret_cast<const bf16x8*>(SB + (wc * 64 + m * 16 + fr) * 128 + sl);
        }
#pragma unroll
      for (int ks = 0; ks < 2; ++ks)
#pragma unroll
        for (int m = 0; m < 4; ++m)
#pragma unroll
          for (int n = 0; n < 4; ++n)
            acc[m][n] = __builtin_amdgcn_mfma_f32_16x16x32_bf16(At[ks][m], Bl[ks][n], acc[m][n], 0, 0, 0);
    }
    {
      int t2 = t + nblk;
      if (t2 < ntiles) {
        int tm2 = t2 / Ntiles, tn2 = t2 % Ntiles;
        const bf16_t* ga2 = A + (size_t)(tm2 * 128 + srow) * lda + scol;
        const bf16_t* gb2 = Bt + (size_t)(tn2 * 128 + srow) * ldb + scol;
        GEMM_STAGE(ga2, gb2, 0, 0)
      }
    }
    const int colbase = bcol + wc * 64;
    if constexpr (EPI == EPI_STORE || EPI == EPI_GELU) {
      if (EPI == EPI_GELU && colbase >= 1024) {
        float* rsp = p->rowss + ((size_t)tm * 16 + (tn - 8) * 2 + wc) * 128;
#pragma unroll
        for (int m = 0; m < 4; ++m) {
          float ssq[4] = {0.f, 0.f, 0.f, 0.f};
#pragma unroll
          for (int n = 0; n < 4; ++n) {
            int ch = colbase - 1024 + n * 16 + fr;
            int q0 = wr * 64 + m * 16 + fq * 4;
            float g0 = gelu_tanh(acc[m][n][0]), g1 = gelu_tanh(acc[m][n][1]), g2 = gelu_tanh(acc[m][n][2]), g3 = gelu_tanh(acc[m][n][3]);
            ssq[0] += g0 * g0;
            ssq[1] += g1 * g1;
            ssq[2] += g2 * g2;
            ssq[3] += g3 * g3;
            uint2 o;
            o.x = pack2(g0, g1);
            o.y = pack2(g2, g3);
            *reinterpret_cast<uint2*>(p->zvT + ((size_t)tm * 1024 + ch) * 128 + q0) = o;
          }
#pragma unroll
          for (int j = 0; j < 4; ++j) {
            float v = ssq[j];
            v += dpp_mov<0xB1>(v);
            v += dpp_mov<0x4E>(v);
            v += dpp_mov<0x141>(v);
            v += dpp_mov<0x140>(v);
            if (fr == 0) rsp[wr * 64 + m * 16 + fq * 4 + j] = v;
          }
        }
      } else {
#pragma unroll
        for (int m = 0; m < 4; ++m)
#pragma unroll
          for (int j = 0; j < 4; ++j) {
            int row = brow + wr * 64 + m * 16 + fq * 4 + j;
            bf16_t* o = p->P + (size_t)row * 2048 + colbase + fr;
#pragma unroll
            for (int n = 0; n < 4; ++n) {
              float v = acc[m][n][j];
              if (EPI == EPI_GELU) v = gelu_tanh(v);
              o[n * 16] = f2bf(v);
            }
          }
      }
    } else if constexpr (EPI == EPI_RESID) {
#pragma unroll
      for (int m = 0; m < 4; ++m)
#pragma unroll
        for (int j = 0; j < 4; ++j) {
          int row = brow + wr * 64 + m * 16 + fq * 4 + j;
          int b = tok_batch(row);
          const float* g = p->mod + ((size_t)layer * 9 + b) * 6144 + 2048 + colbase + fr;
          float* o = p->xs + (size_t)row * D + colbase + fr;
          const float* xi = o;
          if (layer == 0 && gscale == 1.f)
            xi = ((row < TL) ? p->x + (size_t)row * D : p->ctx + (size_t)(row - TL) * D) + colbase + fr;
#pragma unroll
          for (int n = 0; n < 4; ++n) o[n * 16] = xi[n * 16] + gscale * g[n * 16] * acc[m][n][j];
        }
    } else if constexpr (EPI == EPI_INPROJ) {
      if (colbase >= 640 && colbase < 768) {
        int kvh = (colbase - 640) >> 6;
#pragma unroll
        for (int m = 0; m < 4; ++m) {
          int row0 = brow + wr * 64 + m * 16;
          bool latent = row0 < TL;
          int b = latent ? (row0 >> 12) : ((row0 - TL) >> 8);
          int kp16 = latent ? (CTX + (row0 & 4095)) : ((row0 - TL) & 255);
          int slot = kp16 + 8 * (fq & 1) + 4 * (fq >> 1);
#pragma unroll
          for (int n = 0; n < 4; ++n) {
            int dim = n * 16 + fr;
            uint2 o;
            o.x = pack2(acc[m][n][0], acc[m][n][1]);
            o.y = pack2(acc[m][n][2], acc[m][n][3]);
            *reinterpret_cast<uint2*>(p->vbuf + ((size_t)(b * 2 + kvh) * 64 + dim) * KVLEN + slot) = o;
          }
        }
      } else {
#pragma unroll
        for (int m = 0; m < 4; ++m)
#pragma unroll
          for (int j = 0; j < 4; ++j) {
            int row = brow + wr * 64 + m * 16 + fq * 4 + j;
            bool latent = row < TL;
            int b, pos;
            if (latent) {
              b = row >> 12;
              pos = row & 4095;
            } else {
              b = (row - TL) >> 8;
              pos = (row - TL) & 255;
            }
            float v0 = acc[m][0][j], v1 = acc[m][1][j], v2 = acc[m][2][j], v3 = acc[m][3][j];
            if (latent && colbase < 640) {
              float2 cr = p->cs[(pos >> 6) * 16 + fr];
              float2 cc = p->cs[(pos & 63) * 16 + fr];
              float a = v0, bb = v1;
              v0 = a * cr.x - bb * cr.y;
              v1 = bb * cr.x + a * cr.y;
              a = v2;
              bb = v3;
              v2 = a * cc.x - bb * cc.y;
              v3 = bb * cc.x + a * cc.y;
            }
            bf16_t* o;
            if (colbase < 512 || colbase >= 768) {
              o = p->P + (size_t)row * 2048 + colbase + fr;
            } else {
              int kvh = (colbase - 512) >> 6;
              int kp = latent ? (CTX + pos) : pos;
              o = p->kbuf + ((size_t)(b * 2 + kvh) * KVLEN + kp) * 64 + fr;
            }
            o[0] = f2bf(v0);
            o[16] = f2bf(v1);
            o[32] = f2bf(v2);
            o[48] = f2bf(v3);
          }
      }
    }
  }
}

constexpr int G8_HT = 128 * 64;
DEVI int g8_lds_byte(int r, int c) {
  int st = (r >> 4) * 2 + (c >> 5), rr = r & 15, cc = c & 31, ob = rr * 64 + cc * 2;
  return st * 1024 + (ob ^ (((ob >> 9) & 1) << 5));
}
DEVI void g8_stage_rc(int b, int& R, int& C) {
  int st = b / 1024, sb = b % 1024, swz = sb ^ (((sb >> 9) & 1) << 5);
  R = (st >> 1) * 16 + swz / 64;
  C = (st & 1) * 32 + (swz % 64) / 2;
}
template <int EPI>
DEVI void gemm8_epilogue(PP p, f32x4 (&acc)[2][2][4][2], int brow, int bcol, int wr, int wc, int fr, int fq, int layer, float gscale) {
#pragma unroll
  for (int ai = 0; ai < 2; ++ai)
#pragma unroll
    for (int bj = 0; bj < 2; ++bj) {
      const int r0 = brow + ai * 128 + wr * 64;
      const int c0 = bcol + bj * 128 + wc * 32;
      if constexpr (EPI == EPI_STORE) {
#pragma unroll
        for (int m = 0; m < 4; ++m)
#pragma unroll
          for (int j = 0; j < 4; ++j) {
            bf16_t* o = p->P + (size_t)(r0 + m * 16 + fq * 4 + j) * 2048 + c0 + fr;
            o[0] = f2bf(acc[ai][bj][m][0][j]);
            o[16] = f2bf(acc[ai][bj][m][1][j]);
          }
      } else if constexpr (EPI == EPI_GELU) {
        if (c0 >= 1024) {
          const int chunk = r0 >> 7;
          float* rsp = p->rowss + ((size_t)chunk * 32 + ((c0 - 1024) >> 5)) * 128;
#pragma unroll
          for (int m = 0; m < 4; ++m) {
            float ssq[4] = {0.f, 0.f, 0.f, 0.f};
            const int q0 = (r0 & 127) + m * 16 + fq * 4;
#pragma unroll
            for (int n = 0; n < 2; ++n) {
              int ch = c0 - 1024 + n * 16 + fr;
              float g0 = gelu_tanh(acc[ai][bj][m][n][0]), g1 = gelu_tanh(acc[ai][bj][m][n][1]);
              float g2 = gelu_tanh(acc[ai][bj][m][n][2]), g3 = gelu_tanh(acc[ai][bj][m][n][3]);
              ssq[0] += g0 * g0;
              ssq[1] += g1 * g1;
              ssq[2] += g2 * g2;
              ssq[3] += g3 * g3;
              uint2 o;
              o.x = pack2(g0, g1);
              o.y = pack2(g2, g3);
              *reinterpret_cast<uint2*>(p->zvT + ((size_t)chunk * 1024 + ch) * 128 + q0) = o;
            }
#pragma unroll
            for (int j = 0; j < 4; ++j) {
              float v = ssq[j];
              v += dpp_mov<0xB1>(v);
              v += dpp_mov<0x4E>(v);
              v += dpp_mov<0x141>(v);
              v += dpp_mov<0x140>(v);
              if (fr == 0) rsp[q0 + j] = v;
            }
          }
        } else {
#pragma unroll
          for (int m = 0; m < 4; ++m)
#pragma unroll
            for (int j = 0; j < 4; ++j) {
              bf16_t* o = p->P + (size_t)(r0 + m * 16 + fq * 4 + j) * 2048 + c0 + fr;
              o[0] = f2bf(gelu_tanh(acc[ai][bj][m][0][j]));
              o[16] = f2bf(gelu_tanh(acc[ai][bj][m][1][j]));
            }
        }
      } else if constexpr (EPI == EPI_RESID) {
#pragma unroll
        for (int m = 0; m < 4; ++m)
#pragma unroll
          for (int j = 0; j < 4; ++j) {
            int row = r0 + m * 16 + fq * 4 + j;
            int b = tok_batch(row);
            const float* g = p->mod + ((size_t)layer * 9 + b) * 6144 + 2048 + c0 + fr;
            float* o = p->xs + (size_t)row * D + c0 + fr;
            const float* xi = o;
            if (layer == 0 && gscale == 1.f)
              xi = ((row < TL) ? p->x + (size_t)row * D : p->ctx + (size_t)(row - TL) * D) + c0 + fr;
            o[0] = xi[0] + gscale * g[0] * acc[ai][bj][m][0][j];
            o[16] = xi[16] + gscale * g[16] * acc[ai][bj][m][1][j];
          }
      } else if constexpr (EPI == EPI_INPROJ) {
        if (c0 >= 640 && c0 < 768) {
          const int kvh = (c0 - 640) >> 6, d0 = (c0 - 640) & 63;
#pragma unroll
          for (int m = 0; m < 4; ++m) {
            int row0 = r0 + m * 16;
            bool latent = row0 < TL;
            int b = latent ? (row0 >> 12) : ((row0 - TL) >> 8);
            int kp16 = latent ? (CTX + (row0 & 4095)) : ((row0 - TL) & 255);
            int slot = kp16 + 8 * (fq & 1) + 4 * (fq >> 1);
#pragma unroll
            for (int n = 0; n < 2; ++n) {
              int dim = d0 + n * 16 + fr;
              uint2 o;
              o.x = pack2(acc[ai][bj][m][n][0], acc[ai][bj][m][n][1]);
              o.y = pack2(acc[ai][bj][m][n][2], acc[ai][bj][m][n][3]);
              *reinterpret_cast<uint2*>(p->vbuf + ((size_t)(b * 2 + kvh) * 64 + dim) * KVLEN + slot) = o;
            }
          }
        } else {
          const int hsel = (c0 >> 5) & 1;
#pragma unroll
          for (int m = 0; m < 4; ++m)
#pragma unroll
            for (int j = 0; j < 4; ++j) {
              int row = r0 + m * 16 + fq * 4 + j;
              bool latent = row < TL;
              int b, pos;
              if (latent) {
                b = row >> 12;
                pos = row & 4095;
              } else {
                b = (row - TL) >> 8;
                pos = (row - TL) & 255;
              }
              float v0 = acc[ai][bj][m][0][j], v1 = acc[ai][bj][m][1][j];
              if (latent && c0 < 640) {
                float2 cs = p->cs[(hsel ? (pos & 63) : (pos >> 6)) * 16 + fr];
                float a = v0, bb = v1;
                v0 = a * cs.x - bb * cs.y;
                v1 = bb * cs.x + a * cs.y;
              }
              bf16_t* o;
              if (c0 < 512 || c0 >= 768) {
                o = p->P + (size_t)row * 2048 + c0 + fr;
              } else {
                int kvh = (c0 - 512) >> 6, d0 = (c0 - 512) & 63;
                int kp = latent ? (CTX + pos) : pos;
                o = p->kbuf + ((size_t)(b * 2 + kvh) * KVLEN + kp) * 64 + d0 + fr;
              }
              o[0] = f2bf(v0);
              o[16] = f2bf(v1);
            }
        }
      }
      __builtin_amdgcn_sched_barrier(0);
    }
}

template <int EPI>
DEVI void gemm8_phase(PP p, const bf16_t* __restrict__ A, int lda, const bf16_t* __restrict__ Bt, int ldb, int Mtiles, int Ntiles,
                      int K, int layer, unsigned char* lds_all, float gscale = 1.f) {
  bf16_t* shm = reinterpret_cast<bf16_t*>(lds_all);
  const int tid = ptid();
  const int wid = __builtin_amdgcn_readfirstlane(tid >> 6), lane = tid & 63, wr = wid >> 2, wc = wid & 3, fr = lane & 15, fq = lane >> 4;
#define G8_SA(b, h) (shm + ((b) * 2 + (h)) * G8_HT)
#define G8_SB(b, h) (shm + (4 + (b) * 2 + (h)) * G8_HT)
  const __amdgpu_buffer_rsrc_t rsA = __builtin_amdgcn_make_buffer_rsrc((void*)A, (short)0, -1, 0x00020000);
  const __amdgpu_buffer_rsrc_t rsB = __builtin_amdgcn_make_buffer_rsrc((void*)Bt, (short)0, -1, 0x00020000);
  unsigned voA[2], voB[2];
#pragma unroll
  for (int i = 0; i < 2; ++i) {
    int r_, c_;
    g8_stage_rc(tid * 16 + i * 8192, r_, c_);
    voA[i] = (unsigned)((r_ * lda + c_) * 2);
    voB[i] = (unsigned)((r_ * ldb + c_) * 2);
  }
#define G8_STAGE(P_, RS_, VO_, ld_, br_, kt_)                                                                         \
  do {                                                                                                                \
    const unsigned so_ = (unsigned)(((br_) * (ld_) + (kt_) * 64) * 2);                                                \
    _Pragma("unroll") for (int i_ = 0; i_ < 2; ++i_)                                                                  \
      __builtin_amdgcn_raw_ptr_buffer_load_lds(RS_, (__attribute__((address_space(3))) void*)((unsigned char*)(P_) + wid * 1024 + i_ * 8192), 16, VO_[i_], so_, 0, 0); \
  } while (0)
#define G8_LDA(dst, b, h)                                                                                             \
  _Pragma("unroll") for (int m_ = 0; m_ < 4; ++m_) _Pragma("unroll") for (int k_ = 0; k_ < 2; ++k_)                   \
      dst[m_][k_] = *reinterpret_cast<const bf16x8*>((const unsigned char*)G8_SA(b, h) + g8_lds_byte(wr * 64 + m_ * 16 + fr, k_ * 32 + fq * 8))
#define G8_LDB(dst, b, h)                                                                                             \
  _Pragma("unroll") for (int n_ = 0; n_ < 2; ++n_) _Pragma("unroll") for (int k_ = 0; k_ < 2; ++k_)                   \
      dst[n_][k_] = *reinterpret_cast<const bf16x8*>((const unsigned char*)G8_SB(b, h) + g8_lds_byte(wc * 32 + n_ * 16 + fr, k_ * 32 + fq * 8))
#define G8_MMA(ai, bj, At_, Bt_)                                                                                      \
  do {                                                                                                                \
    __builtin_amdgcn_s_setprio(1);                                                                                    \
    _Pragma("unroll") for (int m_ = 0; m_ < 4; ++m_) _Pragma("unroll") for (int n_ = 0; n_ < 2; ++n_)                 \
        _Pragma("unroll") for (int k_ = 0; k_ < 2; ++k_) acc[ai][bj][m_][n_] =                                        \
            __builtin_amdgcn_mfma_f32_16x16x32_bf16(At_[m_][k_], Bt_[n_][k_], acc[ai][bj][m_][n_], 0, 0, 0);          \
    __builtin_amdgcn_s_setprio(0);                                                                                    \
  } while (0)
#define G8_WAIT_V(n) asm volatile("s_waitcnt vmcnt(" #n ")" ::: "memory")
#define G8_WAIT_L(n) asm volatile("s_waitcnt lgkmcnt(" #n ")" ::: "memory")
#define G8_BAR __builtin_amdgcn_s_barrier()
#define G8_SCHED __builtin_amdgcn_sched_barrier(0)
  const int nblk = pnblk(), bid = pbid();
  const int lb = ((nblk & 7) == 0) ? ((bid & 7) * (nblk >> 3) + (bid >> 3)) : bid;
  const int ntiles = Mtiles * Ntiles;
  const int nt = K / 64;
  for (int t = lb; t < ntiles; t += nblk) {
    const int tm = t / Ntiles, tn = t % Ntiles;
    const int brow = tm * 256, bcol = tn * 256;
    f32x4 acc[2][2][4][2];
#pragma unroll
    for (int a0 = 0; a0 < 2; ++a0)
#pragma unroll
      for (int b0 = 0; b0 < 2; ++b0)
#pragma unroll
        for (int m = 0; m < 4; ++m)
#pragma unroll
          for (int n = 0; n < 2; ++n) acc[a0][b0][m][n] = f32x4{0.f, 0.f, 0.f, 0.f};
    bf16x8 At[4][2], B0[2][2], B1[2][2];
    G8_STAGE(G8_SB(0, 0), rsB, voB, ldb, bcol, 0);
    G8_STAGE(G8_SA(0, 0), rsA, voA, lda, brow, 0);
    G8_STAGE(G8_SB(0, 1), rsB, voB, ldb, bcol + 128, 0);
    G8_STAGE(G8_SA(0, 1), rsA, voA, lda, brow + 128, 0);
    if (wr == 1) G8_BAR;
    G8_WAIT_V(4);
    G8_BAR;
    G8_STAGE(G8_SB(1, 0), rsB, voB, ldb, bcol, 1);
    G8_STAGE(G8_SA(1, 0), rsA, voA, lda, brow, 1);
    G8_STAGE(G8_SB(1, 1), rsB, voB, ldb, bcol + 128, 1);
    G8_WAIT_V(6);
    G8_BAR;
    for (int kt = 0; kt < nt - 2; kt += 2) {
      G8_LDB(B0, 0, 0); G8_SCHED; G8_LDA(At, 0, 0); G8_STAGE(G8_SA(1, 1), rsA, voA, lda, brow + 128, kt + 1);
      G8_WAIT_L(8); G8_BAR; G8_WAIT_L(0); G8_MMA(0, 0, At, B0); G8_BAR; G8_SCHED;
      G8_LDB(B1, 0, 1); G8_STAGE(G8_SB(0, 0), rsB, voB, ldb, bcol, kt + 2);
      G8_BAR; G8_WAIT_L(0); G8_MMA(0, 1, At, B1); G8_BAR;
      G8_LDA(At, 0, 1); G8_STAGE(G8_SA(0, 0), rsA, voA, lda, brow, kt + 2);
      G8_BAR; G8_WAIT_L(0); G8_MMA(1, 0, At, B0); G8_BAR; G8_SCHED;
      G8_STAGE(G8_SB(0, 1), rsB, voB, ldb, bcol + 128, kt + 2);
      G8_WAIT_V(6); G8_BAR; G8_MMA(1, 1, At, B1); G8_BAR;
      G8_LDB(B0, 1, 0); G8_SCHED; G8_LDA(At, 1, 0); G8_STAGE(G8_SA(0, 1), rsA, voA, lda, brow + 128, kt + 2);
      G8_WAIT_L(8); G8_BAR; G8_WAIT_L(0); G8_MMA(0, 0, At, B0); G8_BAR; G8_SCHED;
      G8_LDB(B1, 1, 1); G8_STAGE(G8_SB(1, 0), rsB, voB, ldb, bcol, kt + 3);
      G8_BAR; G8_WAIT_L(0); G8_MMA(0, 1, At, B1); G8_BAR;
      G8_LDA(At, 1, 1); G8_STAGE(G8_SA(1, 0), rsA, voA, lda, brow, kt + 3);
      G8_BAR; G8_WAIT_L(0); G8_MMA(1, 0, At, B0); G8_BAR; G8_SCHED;
      G8_STAGE(G8_SB(1, 1), rsB, voB, ldb, bcol + 128, kt + 3);
      G8_WAIT_V(6); G8_BAR; G8_MMA(1, 1, At, B1); G8_BAR;
    }
    {
      G8_LDB(B0, 0, 0); G8_LDA(At, 0, 0); G8_STAGE(G8_SA(1, 1), rsA, voA, lda, brow + 128, nt - 1);
      G8_BAR; G8_WAIT_L(0); G8_MMA(0, 0, At, B0); G8_BAR;
      G8_LDB(B1, 0, 1); G8_BAR; G8_WAIT_L(0); G8_MMA(0, 1, At, B1); G8_BAR;
      G8_LDA(At, 0, 1); G8_WAIT_V(4); G8_BAR; G8_WAIT_L(0); G8_MMA(1, 0, At, B0); G8_MMA(1, 1, At, B1); G8_BAR;
    }
    {
      G8_LDB(B0, 1, 0); G8_LDA(At, 1, 0); G8_WAIT_V(2); G8_BAR; G8_WAIT_L(0); G8_MMA(0, 0, At, B0); G8_BAR;
      G8_LDB(B1, 1, 1); G8_WAIT_V(0); G8_BAR; G8_WAIT_L(0); G8_MMA(0, 1, At, B1); G8_BAR;
      G8_LDA(At, 1, 1); G8_BAR; G8_WAIT_L(0); G8_MMA(1, 0, At, B0); G8_MMA(1, 1, At, B1); G8_BAR;
    }
    if (wr == 0) G8_BAR;
    gemm8_epilogue<EPI>(p, acc, brow, bcol, wr, wc, fr, fq, layer, gscale);
    asm volatile("s_waitcnt vmcnt(0)" ::: "memory");
  }
  __syncthreads();
#undef G8_SA
#undef G8_SB
#undef G8_STAGE
#undef G8_LDA
#undef G8_LDB
#undef G8_MMA
#undef G8_WAIT_V
#undef G8_WAIT_L
#undef G8_BAR
#undef G8_SCHED
}

DEVI bf16x8 scale_q(uint4 u) {
  uint4 r;
  r.x = pack2(bflo(u.x) * 0.125f, bfhi(u.x) * 0.125f);
  r.y = pack2(bflo(u.y) * 0.125f, bfhi(u.y) * 0.125f);
  r.z = pack2(bflo(u.z) * 0.125f, bfhi(u.z) * 0.125f);
  r.w = pack2(bflo(u.w) * 0.125f, bfhi(u.w) * 0.125f);
  return __builtin_bit_cast(bf16x8, r);
}
DEVI void phase_attn(PP p, int layer, bool with_ctx_q) {
  const int tid = ltid();
  const int lane = tid & 63, wid = __builtin_amdgcn_readfirstlane(tid >> 6), r = lane & 31, h = lane >> 5;
  const float* sinkp = p->attn_sink + (layer >> 1) * 8;
  const int nunits = 2048 + (with_ctx_q ? 128 : 0);
  for (int u = lbid(); u < nunits; u += lnblk()) {
    bool latent = u < 2048;
    int b, kvh, qg, tokbase;
    if (latent) {
      b = u >> 8;
      kvh = (u >> 7) & 1;
      qg = u & 127;
      tokbase = b * SEQ + qg * 32;
    } else {
      int v = u - 2048;
      b = v >> 4;
      kvh = (v >> 3) & 1;
      qg = v & 7;
      tokbase = TL + b * CTX + qg * 32;
    }
    const int hd = kvh * 4 + wid;
    const bf16_t* kb = p->kbuf + (size_t)(b * 2 + kvh) * KVLEN * 64;
    const bf16_t* vt = p->vbuf + (size_t)(b * 2 + kvh) * 64 * KVLEN;
    bf16x8 qf[4];
    {
      const bf16_t* qp = p->P + (size_t)(tokbase + r) * 2048 + hd * 64 + 8 * h;
#pragma unroll
      for (int st = 0; st < 4; ++st) qf[st] = scale_q(*reinterpret_cast<const uint4*>(qp + 16 * st));
    }
    f32x16 O0, O1;
#pragma unroll
    for (int i = 0; i < 16; ++i) {
      O0[i] = 0.f;
      O1[i] = 0.f;
    }
    float m_run = sinkp[hd];
    float l_run = (h == 0) ? 1.f : 0.f;
    const int nkb = latent ? 17 : 8;
    for (int kbi = 0; kbi < nkb; ++kbi) {
      int kpos, mode = 0;
      if (kbi < 8) {
        kpos = kbi * 32;
      } else {
        int d = kbi - 12;
        int kblk = qg + d;
        if (kblk < 0 || kblk > 127) continue;
        kpos = CTX + kblk * 32;
        mode = (d == -4) ? 1 : ((d == 4) ? 2 : 0);
      }
      f32x16 S;
#pragma unroll
      for (int i = 0; i < 16; ++i) S[i] = 0.f;
#pragma unroll
      for (int st = 0; st < 4; ++st) {
        bf16x8 kf = *reinterpret_cast<const bf16x8*>(kb + (size_t)(kpos + r) * 64 + 16 * st + 8 * h);
        S = __builtin_amdgcn_mfma_f32_32x32x16_bf16(kf, qf[st], S, 0, 0, 0);
      }
      if (mode) {
#pragma unroll
        for (int i = 0; i < 16; ++i) {
          int kk = (i & 3) + 8 * (i >> 2) + 4 * h;
          bool ok = (mode == 1) ? (kk >= r) : (kk <= r);
          if (!ok) S[i] = -1e30f;
        }
      }
      float bm = S[0];
#pragma unroll
      for (int i = 1; i < 16; ++i) bm = fmaxf(bm, S[i]);
      bm = fmaxf(bm, __shfl_xor(bm, 32));
      float m_new = fmaxf(m_run, bm);
      const float L2E = 1.4426950408889634f;
      float nm = -m_new * L2E;
      float psum = 0.f;
#pragma unroll
      for (int i = 0; i < 16; ++i) {
        S[i] = __builtin_amdgcn_exp2f(fmaf(S[i], L2E, nm));
        psum += S[i];
      }
      if (__any(m_new > m_run)) {
        float alpha = __builtin_amdgcn_exp2f((m_run - m_new) * L2E);
        l_run *= alpha;
#pragma unroll
        for (int i = 0; i < 16; ++i) {
          O0[i] *= alpha;
          O1[i] *= alpha;
        }
      }
      l_run += psum;
      m_run = m_new;
#pragma unroll
      for (int sidx = 0; sidx < 2; ++sidx) {
        uint4 pk;
        pk.x = pack2(S[8 * sidx + 0], S[8 * sidx + 1]);
        pk.y = pack2(S[8 * sidx + 2], S[8 * sidx + 3]);
        pk.z = pack2(S[8 * sidx + 4], S[8 * sidx + 5]);
        pk.w = pack2(S[8 * sidx + 6], S[8 * sidx + 7]);
        bf16x8 pf = __builtin_bit_cast(bf16x8, pk);
        bf16x8 v0 = *reinterpret_cast<const bf16x8*>(vt + (size_t)r * KVLEN + kpos + 16 * sidx + 8 * h);
        bf16x8 v1 = *reinterpret_cast<const bf16x8*>(vt + (size_t)(32 + r) * KVLEN + kpos + 16 * sidx + 8 * h);
        O0 = __builtin_amdgcn_mfma_f32_32x32x16_bf16(v0, pf, O0, 0, 0, 0);
        O1 = __builtin_amdgcn_mfma_f32_32x32x16_bf16(v1, pf, O1, 0, 0, 0);
      }
    }
    float l_tot = l_run + __shfl_xor(l_run, 32);
    float inv = 1.f / l_tot;
    bf16_t* op = p->mix + (size_t)(tokbase + r) * LDMIX + hd * 64 + 4 * h;
#pragma unroll
    for (int g4 = 0; g4 < 4; ++g4) {
      uint2 o;
      o.x = pack2(O0[4 * g4 + 0] * inv, O0[4 * g4 + 1] * inv);
      o.y = pack2(O0[4 * g4 + 2] * inv, O0[4 * g4 + 3] * inv);
      *reinterpret_cast<uint2*>(op + 8 * g4) = o;
      o.x = pack2(O1[4 * g4 + 0] * inv, O1[4 * g4 + 1] * inv);
      o.y = pack2(O1[4 * g4 + 2] * inv, O1[4 * g4 + 3] * inv);
      *reinterpret_cast<uint2*>(op + 32 + 8 * g4) = o;
    }
  }
}

DEVI void fill_tw(float2* tw, int n) {
  for (int i = ltid(); i < n; i += NTHREADS) {
    float sn, cn;
    sincospif(2.f * (float)i / (float)n, &sn, &cn);
    tw[i] = make_float2(cn, sn);
  }
  __syncthreads();
}

DEVI bf16x8 lds_col8(const bf16_t* bp, int stride) {
  unsigned e0 = bp[0], e1 = bp[stride], e2 = bp[2 * stride], e3 = bp[3 * stride];
  unsigned e4 = bp[4 * stride], e5 = bp[5 * stride], e6 = bp[6 * stride], e7 = bp[7 * stride];
  uint4 pk;
  pk.x = e0 | (e1 << 16);
  pk.y = e2 | (e3 << 16);
  pk.z = e4 | (e5 << 16);
  pk.w = e6 | (e7 << 16);
  return __builtin_bit_cast(bf16x8, pk);
}

DEVI void phase_fft_a(PP p, unsigned char* lds) {
  const int tid = ltid();
  const int lane = tid & 63, wid = __builtin_amdgcn_readfirstlane(tid >> 6), fr = lane & 15, fq = lane >> 4;
  float2* tw = reinterpret_cast<float2*>(lds + 66560);
  fill_tw(tw, 64);
  bf16x8 af[2][2];
#pragma unroll
  for (int ks = 0; ks < 2; ++ks) {
    unsigned short cr[8], ci[8];
#pragma unroll
    for (int j = 0; j < 8; ++j) {
      int n1 = 32 * ks + 8 * fq + j, k1 = 16 * wid + fr;
      float2 t = tw[(k1 * n1) & 63];
      cr[j] = f2bf(t.x);
      ci[j] = f2bf(-t.y);
    }
    uint4 a0, a1;
    a0.x = cr[0] | ((unsigned)cr[1] << 16); a0.y = cr[2] | ((unsigned)cr[3] << 16);
    a0.z = cr[4] | ((unsigned)cr[5] << 16); a0.w = cr[6] | ((unsigned)cr[7] << 16);
    a1.x = ci[0] | ((unsigned)ci[1] << 16); a1.y = ci[2] | ((unsigned)ci[3] << 16);
    a1.z = ci[4] | ((unsigned)ci[5] << 16); a1.w = ci[6] | ((unsigned)ci[7] << 16);
    af[0][ks] = __builtin_bit_cast(bf16x8, a0);
    af[1][ks] = __builtin_bit_cast(bf16x8, a1);
  }
  const bf16_t* l16 = reinterpret_cast<const bf16_t*>(lds);
  for (int u = lbid(); u < NB * 64; u += lnblk()) {
    int b = u >> 6, n2 = u & 63;
    __syncthreads();
#pragma unroll
    for (int i = 0; i < 16; ++i) {
      int row = (tid >> 6) + 4 * i, piece = tid & 63;
      uint4 v = *reinterpret_cast<const uint4*>(p->P + (size_t)(b * SEQ + 64 * row + n2) * 2048 + 768 + piece * 8);
      *reinterpret_cast<uint4*>(lds + row * 1040 + piece * 16) = v;
    }
    __syncthreads();
    float tc[4], ts[4];
#pragma unroll
    for (int j = 0; j < 4; ++j) sincospif((float)(n2 * (16 * wid + 4 * fq + j)) / 2048.f, &ts[j], &tc[j]);
    for (int nb = 0; nb < 4; ++nb) {
      f32x4 acc[2][8];
#pragma unroll
      for (int n = 0; n < 8; ++n) {
        acc[0][n] = f32x4{0.f, 0.f, 0.f, 0.f};
        acc[1][n] = f32x4{0.f, 0.f, 0.f, 0.f};
      }
#pragma unroll
      for (int ks = 0; ks < 2; ++ks)
#pragma unroll
        for (int nf = 0; nf < 8; ++nf) {
          bf16x8 bfr = lds_col8(l16 + (32 * ks + 8 * fq) * 520 + 128 * nb + 16 * nf + fr, 520);
          acc[0][nf] = __builtin_amdgcn_mfma_f32_16x16x32_bf16(af[0][ks], bfr, acc[0][nf], 0, 0, 0);
          acc[1][nf] = __builtin_amdgcn_mfma_f32_16x16x32_bf16(af[1][ks], bfr, acc[1][nf], 0, 0, 0);
        }
#pragma unroll
      for (int j = 0; j < 4; ++j) {
        int k1 = 16 * wid + 4 * fq + j;
        bf16_t* o = p->fa + (size_t)(b * SEQ + k1 * 64 + n2) * 1024 + 128 * nb + fr;
#pragma unroll
        for (int nf = 0; nf < 8; ++nf) {
          float re = acc[0][nf][j], im = acc[1][nf][j];
          o[16 * nf] = f2bf(re * tc[j] + im * ts[j]);
          o[512 + 16 * nf] = f2bf(im * tc[j] - re * ts[j]);
        }
      }
    }
  }
  __syncthreads();
}

DEVI void phase_fft_b(PP p, unsigned char* lds) {
  const int tid = ltid();
  const int lane = tid & 63, wid = __builtin_amdgcn_readfirstlane(tid >> 6), fr = lane & 15, fq = lane >> 4;
  float2* tw = reinterpret_cast<float2*>(lds + 67584);
  fill_tw(tw, 64);
  bf16x8 wb[2][4];
#pragma unroll
  for (int ks = 0; ks < 4; ++ks) {
    unsigned short zr[8], zi[8];
#pragma unroll
    for (int j = 0; j < 8; ++j) {
      int k = 32 * ks + 8 * fq + j, part = k >> 6, n2 = k & 63, k2 = 16 * wid + fr;
      float2 t = tw[(k2 * n2) & 63];
      zr[j] = f2bf(part ? t.y : t.x);
      zi[j] = f2bf(part ? t.x : -t.y);
    }
    uint4 a0, a1;
    a0.x = zr[0] | ((unsigned)zr[1] << 16); a0.y = zr[2] | ((unsigned)zr[3] << 16);
    a0.z = zr[4] | ((unsigned)zr[5] << 16); a0.w = zr[6] | ((unsigned)zr[7] << 16);
    a1.x = zi[0] | ((unsigned)zi[1] << 16); a1.y = zi[2] | ((unsigned)zi[3] << 16);
    a1.z = zi[4] | ((unsigned)zi[5] << 16); a1.w = zi[6] | ((unsigned)zi[7] << 16);
    wb[0][ks] = __builtin_bit_cast(bf16x8, a0);
    wb[1][ks] = __builtin_bit_cast(bf16x8, a1);
  }
  const bf16_t* l16 = reinterpret_cast<const bf16_t*>(lds);
  const float scale = 0.0013810679320049757f;
  for (int u = lbid(); u < NB * 128; u += lnblk()) {
    int b = u >> 7, k1 = (u >> 1) & 63, hf = u & 1;
    __syncthreads();
#pragma unroll
    for (int i = 0; i < 16; ++i) {
      int row = (tid >> 5) + 8 * i, piece = tid & 31;
      int part = row >> 6, n2 = row & 63;
      uint4 v = *reinterpret_cast<const uint4*>(p->fa + (size_t)(b * SEQ + k1 * 64 + n2) * 1024 + part * 512 + hf * 256 + piece * 8);
      *reinterpret_cast<uint4*>(lds + row * 528 + piece * 16) = v;
    }
    __syncthreads();
    for (int nb = 0; nb < 2; ++nb) {
      f32x4 acc[2][8];
#pragma unroll
      for (int n = 0; n < 8; ++n) {
        acc[0][n] = f32x4{0.f, 0.f, 0.f, 0.f};
        acc[1][n] = f32x4{0.f, 0.f, 0.f, 0.f};
      }
#pragma unroll
      for (int ks = 0; ks < 4; ++ks)
#pragma unroll
        for (int nf = 0; nf < 8; ++nf) {
          bf16x8 bfr = lds_col8(l16 + (32 * ks + 8 * fq) * 264 + 128 * nb + 16 * nf + fr, 264);
          acc[0][nf] = __builtin_amdgcn_mfma_f32_16x16x32_bf16(wb[0][ks], bfr, acc[0][nf], 0, 0, 0);
          acc[1][nf] = __builtin_amdgcn_mfma_f32_16x16x32_bf16(wb[1][ks], bfr, acc[1][nf], 0, 0, 0);
        }
#pragma unroll
      for (int j = 0; j < 4; ++j) {
        int k2 = 16 * wid + 4 * fq + j;
        bf16_t* o = p->mix + (size_t)(b * SEQ + k1 + 64 * k2) * LDMIX + 512 + hf * 256 + 128 * nb + fr;
#pragma unroll
        for (int nf = 0; nf < 8; ++nf) {
          o[16 * nf] = f2bf(acc[0][nf][j] * scale);
          o[512 + 16 * nf] = f2bf(acc[1][nf][j] * scale);
        }
      }
    }
  }
  __syncthreads();
}

DEVI void phase_dft_ctx(PP p, unsigned char* lds) {
  float2* tw = reinterpret_cast<float2*>(lds);
  fill_tw(tw, 256);
  int tid = ltid();
  const float scale = 0.005524271728019903f;
  for (int u = lbid(); u < NB * 64; u += lnblk()) {
    int b = u >> 6, k0 = (u & 63) * 4;
    for (int pass = 0; pass < 2; ++pass) {
      int ch = tid + pass * 256;
      float zr[4], zi[4];
#pragma unroll
      for (int kk = 0; kk < 4; ++kk) zr[kk] = zi[kk] = 0.f;
#pragma unroll 8
      for (int n = 0; n < 256; ++n) {
        float v = bf2f(p->P[(size_t)(TL + b * CTX + n) * 2048 + 768 + ch]);
#pragma unroll
        for (int kk = 0; kk < 4; ++kk) {
          float2 t = tw[(n * (k0 + kk)) & 255];
          zr[kk] += v * t.x;
          zi[kk] -= v * t.y;
        }
      }
#pragma unroll
      for (int kk = 0; kk < 4; ++kk) {
        bf16_t* o = p->mix + (size_t)(TL + b * CTX + k0 + kk) * LDMIX;
        o[512 + ch] = f2bf(zr[kk] * scale);
        o[1024 + ch] = f2bf(zi[kk] * scale);
      }
    }
  }
  __syncthreads();
}

DEVI void phase_sgu(PP p, int j, int nchunks, unsigned char* lds) {
  float* rs = reinterpret_cast<float*>(lds);
  const int tid = ltid();
  const int lane = tid & 63, wid = __builtin_amdgcn_readfirstlane(tid >> 6), fr = lane & 15, fq = lane >> 4;
  const float* nw = p->gs_norm_w + j * 1024;
  for (int u = lbid(); u < nchunks * 8; u += lnblk()) {
    const int chunk = u >> 3, g = u & 7;
    const int tok0 = chunk * 128;
    const bf16_t* vT = p->zvT + (size_t)chunk * 1024 * 128;
    if (tid < 128) {
      const float* rp = p->rowss + (size_t)chunk * 32 * 128 + tid;
      float ss = 0.f;
#pragma unroll
      for (int sl = 0; sl < 32; ++sl) ss += rp[sl * 128];
      rs[tid] = rsqrtf(ss * (1.f / 1024.f) + 1e-6f);
    }
    __syncthreads();
    const float* wsg = p->gs_w_s + ((size_t)j * 8 + g) * 128 * 128;
    const float* bsg = p->gs_b_s + ((size_t)j * 8 + g) * 128;
    f32x4 acc[2][8];
#pragma unroll
    for (int m = 0; m < 2; ++m)
#pragma unroll
      for (int n = 0; n < 8; ++n) acc[m][n] = f32x4{0.f, 0.f, 0.f, 0.f};
#pragma unroll
    for (int ks = 0; ks < 4; ++ks) {
      bf16x8 a[2];
      const float* rsk = rs + 32 * ks + 8 * fq;
#pragma unroll
      for (int m = 0; m < 2; ++m) {
        const float4* wp = reinterpret_cast<const float4*>(wsg + (size_t)(32 * wid + 16 * m + fr) * 128 + 32 * ks + 8 * fq);
        float4 w0 = wp[0], w1 = wp[1];
        uint4 pk;
        pk.x = pack2(w0.x * rsk[0], w0.y * rsk[1]);
        pk.y = pack2(w0.z * rsk[2], w0.w * rsk[3]);
        pk.z = pack2(w1.x * rsk[4], w1.y * rsk[5]);
        pk.w = pack2(w1.z * rsk[6], w1.w * rsk[7]);
        a[m] = __builtin_bit_cast(bf16x8, pk);
      }
#pragma unroll
      for (int n = 0; n < 8; ++n) {
        bf16x8 bfr = *reinterpret_cast<const bf16x8*>(vT + (size_t)(g * 128 + 16 * n + fr) * 128 + 32 * ks + 8 * fq);
        acc[0][n] = __builtin_amdgcn_mfma_f32_16x16x32_bf16(a[0], bfr, acc[0][n], 0, 0, 0);
        acc[1][n] = __builtin_amdgcn_mfma_f32_16x16x32_bf16(a[1], bfr, acc[1][n], 0, 0, 0);
      }
    }
#pragma unroll
    for (int m = 0; m < 2; ++m)
#pragma unroll
      for (int jj = 0; jj < 4; ++jj) {
        int pp = 32 * wid + 16 * m + 4 * fq + jj;
        float bias = bsg[pp];
        const bf16_t* up = p->P + (size_t)(tok0 + pp) * 2048 + g * 128 + fr;
        bf16_t* op = p->mix + (size_t)(tok0 + pp) * LDMIX + g * 128 + fr;
#pragma unroll
        for (int n = 0; n < 8; ++n) {
          float sv = nw[g * 128 + 16 * n + fr] * acc[m][n][jj] + bias;
          op[16 * n] = f2bf(bf2f(up[16 * n]) * sv);
        }
      }
    __syncthreads();
  }
}

DEVI float mkkey(float v, unsigned idx, unsigned mask) { return __uint_as_float((__float_as_uint(v) & ~mask) | idx); }
#define INSERT16(list, x)                                                                                               \
  {                                                                                                                     \
    _Pragma("unroll") for (int i_ = 15; i_ >= 1; --i_) list[i_] = __builtin_amdgcn_fmed3f(list[i_ - 1], list[i_], x); \
    list[0] = fmaxf(list[0], x);                                                                                        \
  }

DEVI void phase_route(PP p, int layer, int ntok, unsigned char* lds) {
  const int tid = ltid();
  const int lane = tid & 63, wid = __builtin_amdgcn_readfirstlane(tid >> 6), fr = lane & 15, fq = lane >> 4;
  const int nb8 = lnblk() >> 3, bid = lbid();
  const int hh = bid & 7, slot = bid >> 3;
  const int ntiles = ntok / 64;
  const bool active = slot < nb8;
  float* sc = reinterpret_cast<float*>(lds + 32768);
  const float NEGK = -3.0e38f;
  for (int half = 0; half < 2; ++half) {
    __syncthreads();
    {
      const bf16_t* ksrc = p->keysb + ((size_t)((layer * 8 + hh) * 2 + half) * 128) * 128;
#pragma unroll
      for (int i = 0; i < 8; ++i) {
        int idx = tid + 256 * i, row = idx >> 4, c = idx & 15;
        uint4 v = *reinterpret_cast<const uint4*>(ksrc + (size_t)row * 128 + c * 8);
        *reinterpret_cast<uint4*>(lds + row * 256 + ((c ^ (row & 15)) << 4)) = v;
      }
    }
    __syncthreads();
    bf16x8 an[4];
    if (active && slot < ntiles) {
      const bf16_t* qa = p->P + (size_t)(slot * 64 + wid * 16 + fr) * 2048 + hh * 256 + half * 128 + fq * 8;
#pragma unroll
      for (int ks = 0; ks < 4; ++ks) an[ks] = *reinterpret_cast<const bf16x8*>(qa + ks * 32);
    }
    for (int tt = slot; active && tt < ntiles; tt += nb8) {
      const int tok0 = tt * 64;
      {
        bf16x8 a[4];
#pragma unroll
        for (int ks = 0; ks < 4; ++ks) a[ks] = an[ks];
        {
          const int ttn = (tt + nb8 < ntiles) ? tt + nb8 : tt;
          const bf16_t* qa = p->P + (size_t)(ttn * 64 + wid * 16 + fr) * 2048 + hh * 256 + half * 128 + fq * 8;
#pragma unroll
          for (int ks = 0; ks < 4; ++ks) an[ks] = *reinterpret_cast<const bf16x8*>(qa + ks * 32);
        }
#pragma unroll
        for (int nf = 0; nf < 8; ++nf) {
          f32x4 acc = f32x4{0.f, 0.f, 0.f, 0.f};
          const int krow = nf * 16 + fr;
#pragma unroll
          for (int ks = 0; ks < 4; ++ks) {
            bf16x8 bb = *reinterpret_cast<const bf16x8*>(lds + krow * 256 + (((4 * ks + fq) ^ (krow & 15)) << 4));
            acc = __builtin_amdgcn_mfma_f32_16x16x32_bf16(a[ks], bb, acc, 0, 0, 0);
          }
#pragma unroll
          for (int j = 0; j < 4; ++j) sc[(wid * 16 + fq * 4 + j) * 129 + krow] = mkkey(acc[j], (unsigned)krow, 127u);
        }
      }
      __syncthreads();
      const int row = tid & 63, part = tid >> 6;
      float list[16];
#pragma unroll
      for (int i = 0; i < 16; ++i) list[i] = NEGK;
      {
        const float* kr = sc + row * 129 + part * 32;
#pragma unroll 4
        for (int e = 0; e < 32; ++e) {
          float x = kr[e];
          INSERT16(list, x)
        }
      }
      __syncthreads();
      if (part & 1) {
#pragma unroll
        for (int i = 0; i < 16; ++i) sc[(row * 2 + (part >> 1)) * 17 + i] = list[i];
      }
      __syncthreads();
      if (!(part & 1)) {
#pragma unroll
        for (int i = 0; i < 16; ++i) {
          float x = sc[(row * 2 + (part >> 1)) * 17 + i];
          INSERT16(list, x)
        }
      }
      __syncthreads();
      if (part == 2) {
#pragma unroll
        for (int i = 0; i < 16; ++i) sc[row * 17 + i] = list[i];
      }
      __syncthreads();
      if (part == 0) {
#pragma unroll
        for (int i = 0; i < 16; ++i) {
          float x = sc[row * 17 + i];
          INSERT16(list, x)
        }
        float4* o = reinterpret_cast<float4*>(p->tops + ((size_t)(tok0 + row) * 16 + hh * 2 + half) * 16);
        o[0] = make_float4(list[0], list[1], list[2], list[3]);
        o[1] = make_float4(list[4], list[5], list[6], list[7]);
        o[2] = make_float4(list[8], list[9], list[10], list[11]);
        o[3] = make_float4(list[12], list[13], list[14], list[15]);
      }
      __syncthreads();
    }
  }
  __syncthreads();
  float* fl = reinterpret_cast<float*>(lds);
  for (int t4 = slot; active && t4 < ntiles + 3 * nb8; t4 += 4 * nb8) {
    const int tt = t4 + (tid >> 6) * nb8;
    if (tt < ntiles) {
      const int tok = tt * 64 + (tid & 63);
      const float4* src = reinterpret_cast<const float4*>(p->tops + ((size_t)tok * 16 + hh * 2) * 16);
      float v0[16], v1[16];
#pragma unroll
      for (int i = 0; i < 4; ++i) {
        float4 a = src[i], bq = src[4 + i];
        v0[4 * i] = a.x; v0[4 * i + 1] = a.y; v0[4 * i + 2] = a.z; v0[4 * i + 3] = a.w;
        v1[4 * i] = bq.x; v1[4 * i + 1] = bq.y; v1[4 * i + 2] = bq.z; v1[4 * i + 3] = bq.w;
      }
      float* f0 = fl + tid * 33;
      float* f1 = f0 + 16;
#pragma unroll
      for (int i = 0; i < 16; ++i) {
        f0[i] = v0[i];
        f1[i] = v1[i];
      }
      float l2[16];
#pragma unroll
      for (int i = 0; i < 16; ++i) l2[i] = mkkey(v0[0] + v1[i], (unsigned)(15 - i), 255u);
#pragma unroll
      for (int a = 1; a < 16; ++a)
#pragma unroll
        for (int bq = 0; bq < 16; ++bq)
          if ((a + 1) * (bq + 1) <= 16) {
            float x = mkkey(v0[a] + v1[bq], (unsigned)(a * 16 + 15 - bq), 255u);
            INSERT16(l2, x)
          }
      float sv[16];
      int ev[16];
      float mx = NEGK;
#pragma unroll
      for (int k = 0; k < 16; ++k) {
        unsigned ab = __float_as_uint(l2[k]) & 255u;
        unsigned k0 = __float_as_uint(f0[ab >> 4]), k1 = __float_as_uint(f1[15u - (ab & 15u)]);
        sv[k] = __uint_as_float(k0 & ~127u) + __uint_as_float(k1 & ~127u);
        ev[k] = (int)((k0 & 127u) * 128u + (k1 & 127u));
        mx = fmaxf(mx, sv[k]);
      }
      float sum = 0.f;
#pragma unroll
      for (int k = 0; k < 16; ++k) {
        sv[k] = __expf(sv[k] - mx);
        sum += sv[k];
      }
      float inv = 1.f / sum;
      size_t o = (size_t)tok * 128 + hh * 16;
      int4* eo = reinterpret_cast<int4*>(p->eidx + o);
      float4* go = reinterpret_cast<float4*>(p->gate + o);
#pragma unroll
      for (int k4 = 0; k4 < 4; ++k4) {
        eo[k4] = make_int4(ev[4 * k4], ev[4 * k4 + 1], ev[4 * k4 + 2], ev[4 * k4 + 3]);
        go[k4] = make_float4(sv[4 * k4] * inv, sv[4 * k4 + 1] * inv, sv[4 * k4 + 2] * inv, sv[4 * k4 + 3] * inv);
      }
    }
  }
  __syncthreads();
}

typedef float v2f __attribute__((ext_vector_type(2)));
DEVI void dec16(uint4 q, v2f* f) {
  f[0] = __builtin_amdgcn_cvt_pk_f32_fp8((int)q.x, false);
  f[1] = __builtin_amdgcn_cvt_pk_f32_fp8((int)q.x, true);
  f[2] = __builtin_amdgcn_cvt_pk_f32_fp8((int)q.y, false);
  f[3] = __builtin_amdgcn_cvt_pk_f32_fp8((int)q.y, true);
  f[4] = __builtin_amdgcn_cvt_pk_f32_fp8((int)q.z, false);
  f[5] = __builtin_amdgcn_cvt_pk_f32_fp8((int)q.z, true);
  f[6] = __builtin_amdgcn_cvt_pk_f32_fp8((int)q.w, false);
  f[7] = __builtin_amdgcn_cvt_pk_f32_fp8((int)q.w, true);
}
struct ExpBuf {
  uint4 q[8];
  uint4 h0, h1;
};
DEVI void exp_load(ExpBuf& B, const unsigned char* tab, const signed char* hrow, const unsigned short* idp, int j8, bool want_x) {
  const uint4 idv = *reinterpret_cast<const uint4*>(idp);
  const unsigned idw[4] = {idv.x, idv.y, idv.z, idv.w};
#pragma unroll
  for (int i = 0; i < 8; ++i) {
    unsigned e = (i & 1) ? (idw[i >> 1] >> 16) : (idw[i >> 1] & 0xffffu);
    unsigned off = e * (unsigned)D + 16u * j8;
    B.q[i] = *reinterpret_cast<const uint4*>(tab + off);
  }
  if (want_x) B.h0 = *reinterpret_cast<const uint4*>(hrow + 16 * j8);
}
template <int CTRL>
DEVI int dpp_movi(int v) { return __builtin_amdgcn_mov_dpp(v, CTRL, 0xF, 0xF, true); }
DEVI void exp_u_compute(const ExpBuf& B, int* pp, int j8) {
  int s0 = 0;
#pragma unroll
  for (int i = 0; i < 8; ++i) {
    int d = __builtin_amdgcn_sdot4((int)B.q[i].x, (int)B.h0.x, 0, false);
    d = __builtin_amdgcn_sdot4((int)B.q[i].y, (int)B.h0.y, d, false);
    d = __builtin_amdgcn_sdot4((int)B.q[i].z, (int)B.h0.z, d, false);
    d = __builtin_amdgcn_sdot4((int)B.q[i].w, (int)B.h0.w, d, false);
    d += dpp_movi<0xB1>(d);
    d += dpp_movi<0x4E>(d);
    d += dpp_movi<0x141>(d);
    s0 = (j8 == i) ? d : s0;
  }
  pp[0] += s0;
}
DEVI void exp_v_accum(const ExpBuf& B, unsigned w0, unsigned w1, int* acc) {
#pragma unroll
  for (int ig = 0; ig < 2; ++ig) {
    const unsigned wq = ig ? w1 : w0;
    const uint4 R0 = B.q[4 * ig], R1 = B.q[4 * ig + 1], R2 = B.q[4 * ig + 2], R3 = B.q[4 * ig + 3];
    const unsigned r0[4] = {R0.x, R0.y, R0.z, R0.w}, r1[4] = {R1.x, R1.y, R1.z, R1.w};
    const unsigned r2[4] = {R2.x, R2.y, R2.z, R2.w}, r3[4] = {R3.x, R3.y, R3.z, R3.w};
#pragma unroll
    for (int q = 0; q < 4; ++q) {
      unsigned A = __builtin_amdgcn_perm(r1[q], r0[q], 0x05010400u);
      unsigned Bq = __builtin_amdgcn_perm(r1[q], r0[q], 0x07030602u);
      unsigned C = __builtin_amdgcn_perm(r3[q], r2[q], 0x05010400u);
      unsigned E = __builtin_amdgcn_perm(r3[q], r2[q], 0x07030602u);
      unsigned D0 = __builtin_amdgcn_perm(C, A, 0x05040100u);
      unsigned D1 = __builtin_amdgcn_perm(C, A, 0x07060302u);
      unsigned D2 = __builtin_amdgcn_perm(E, Bq, 0x05040100u);
      unsigned D3 = __builtin_amdgcn_perm(E, Bq, 0x07060302u);
      acc[4 * q + 0] = __builtin_amdgcn_sdot4((int)D0, (int)wq, acc[4 * q + 0], false);
      acc[4 * q + 1] = __builtin_amdgcn_sdot4((int)D1, (int)wq, acc[4 * q + 1], false);
      acc[4 * q + 2] = __builtin_amdgcn_sdot4((int)D2, (int)wq, acc[4 * q + 2], false);
      acc[4 * q + 3] = __builtin_amdgcn_sdot4((int)D3, (int)wq, acc[4 * q + 3], false);
    }
  }
}
DEVI void exp_v_finish(float4* xo, const float4* xq, const float4* gq, int* acc, float swt, int grp, float gscale) {
  float o[16];
#pragma unroll
  for (int k = 0; k < 16; ++k) {
    int a = acc[k];
    a += dpp_movi<0x128>(a);
    a += __shfl_xor(a, 16);
    a += __shfl_xor(a, 32);
    o[k] = (float)a;
    acc[k] = 0;
  }
  if (grp == 0) {
    const float sc = gscale * swt;
#pragma unroll
    for (int i4 = 0; i4 < 4; ++i4) {
      float4 r = xq[i4];
      r.x += sc * gq[i4].x * o[i4 * 4 + 0];
      r.y += sc * gq[i4].y * o[i4 * 4 + 1];
      r.z += sc * gq[i4].z * o[i4 * 4 + 2];
      r.w += sc * gq[i4].w * o[i4 * 4 + 3];
      xo[i4] = r;
    }
  }
}
DEVI void phase_expert(PP p, int layer, int ntok, unsigned char* lds, float gscale = 1.f, int idmask = 0xffff) {
  const int tid = ltid();
  const int lane = tid & 63, wid = __builtin_amdgcn_readfirstlane(tid >> 6), j8 = lane & 7, grp = lane >> 3;
  const int nb = lnblk(), bid = lbid();
  unsigned short* ids = reinterpret_cast<unsigned short*>(lds);
  float* part = reinterpret_cast<float*>(lds + TPB * 128 * 2);
  unsigned char* w8 = lds + TPB * 128 * 2 + TPB * 128 * 4;
  float* swl = reinterpret_cast<float*>(lds + TPB * 128 * 2 + TPB * 128 * 4 + TPB * 128);
  const unsigned char* ut = p->utab + (size_t)layer * NEXP * D;
  const unsigned char* vt = p->vtab + (size_t)layer * NEXP * D;
  int tpb = (ntok + nb - 1) / nb;
  if (tpb > TPB) tpb = TPB;
  const int npass = (ntok + nb * tpb - 1) / (nb * tpb);
  for (int pass = 0; pass < npass; ++pass) {
    const int tok0 = (pass * nb + bid) * tpb;
    int cnt = ntok - tok0;
    if (cnt > tpb) cnt = tpb;
    if (cnt < 0) cnt = 0;
    for (int i = tid; i < cnt * 128; i += NTHREADS) {
      {
        int k = i & 127, hf = k >> 6, kk = k & 63;
        ids[(i & ~127) + hf * 64 + (kk & 7) * 8 + (kk >> 3)] = (unsigned short)(p->eidx[(size_t)tok0 * 128 + i] & idmask);
      }
      part[i] = 0.f;
    }
    __syncthreads();
    const int ntw = (cnt - wid + 3) >> 2;
    const int npair = ntw * 8;

    if (!(REP_MODE == 1 && gscale != 1.f)) {
      ExpBuf B0, B1;
      int c0 = 0, k0 = 0;
      if (npair > 0) {
        const int t0 = wid;
        exp_load(B0, ut, p->h8 + (size_t)(tok0 + t0) * D, ids + t0 * 128 + grp * 8, j8, true);
      }
      for (int pr = 0; pr < npair; ++pr) {
        const int t0 = wid + 4 * k0;
        exp_load(B1, ut + 128 * c0, p->h8 + (size_t)(tok0 + t0) * D + 128 * c0, ids + t0 * 128 + 64 + grp * 8, j8, true);
        exp_u_compute(B0, reinterpret_cast<int*>(part) + t0 * 128 + 8 * j8 + grp, j8);
        int c1 = c0, k1 = k0;
        if (pr + 1 < npair) {
          k1 = k0 + 1;
          if (k1 == ntw) {
            k1 = 0;
            c1 = c0 + 1;
          }
        }
        {
          const int t1 = wid + 4 * k1;
          exp_load(B0, ut + 128 * c1, p->h8 + (size_t)(tok0 + t1) * D + 128 * c1, ids + t1 * 128 + grp * 8, j8, true);
        }
        exp_u_compute(B1, reinterpret_cast<int*>(part) + t0 * 128 + 64 + 8 * j8 + grp, j8);
        c0 = c1;
        k0 = k1;
      }
    }
    __syncthreads();
    for (int t = wid; t < cnt; t += 4) {
      float wv2[2];
      float am = 0.f;
#pragma unroll
      for (int hh = 0; hh < 2; ++hh) {
        int k = lane + 64 * hh;
        int e = ids[t * 128 + hh * 64 + (lane & 7) * 8 + (lane >> 3)];
        float dq = (float)reinterpret_cast<int*>(part)[t * 128 + k] * p->su[(size_t)layer * NEXP + e] * p->sx[tok0 + t];
        float wv = p->gate[(size_t)(tok0 + t) * 128 + k] * gelu_tanh(dq) * p->sv[(size_t)layer * NEXP + e];
        wv2[hh] = wv;
        am = fmaxf(am, fabsf(wv));
      }
      am = fmaxf(wave_max(am), 1e-30f);
      float qs = 127.f / am;
#pragma unroll
      for (int hh = 0; hh < 2; ++hh) {
        int k = lane + 64 * hh;
        int q = (int)rintf(wv2[hh] * qs);
        w8[t * 128 + (k & 7) * 16 + hh * 8 + ((k >> 3) & 7)] = (unsigned char)(q & 255);
      }
      if (lane == 0) swl[t] = am * (1.f / 127.f);
    }
    __syncthreads();
    if (!(REP_MODE == 2 && gscale != 1.f)) {
      ExpBuf B0, B1;
      int acc[16];
#pragma unroll
      for (int k = 0; k < 16; ++k) acc[k] = 0;
      int c0 = 0, k0 = 0;
      if (npair > 0) {
        const int t0 = wid;
        exp_load(B0, vt, (const signed char*)nullptr, ids + t0 * 128 + grp * 8, j8, false);
      }
      for (int pr = 0; pr < npair; ++pr) {
        const int t0 = wid + 4 * k0;
        float4 xq[4], gq[4];
        float4* xo = reinterpret_cast<float4*>(p->xs + (size_t)(tok0 + t0) * D + 128 * c0 + 16 * j8);
        {
          const float4* gf = reinterpret_cast<const float4*>(p->mod + ((size_t)layer * 9 + tok_batch(tok0 + t0)) * 6144 + 5 * 1024 + 128 * c0 + 16 * j8);
#pragma unroll
          for (int i4 = 0; i4 < 4; ++i4) {
            xq[i4] = xo[i4];
            gq[i4] = gf[i4];
          }
        }
        exp_load(B1, vt + 128 * c0, (const signed char*)nullptr, ids + t0 * 128 + 64 + grp * 8, j8, false);
        const uint4 wq = *reinterpret_cast<const uint4*>(w8 + t0 * 128 + grp * 16);
        exp_v_accum(B0, wq.x, wq.y, acc);
        int c1 = c0, k1 = k0;
        if (pr + 1 < npair) {
          k1 = k0 + 1;
          if (k1 == ntw) {
            k1 = 0;
            c1 = c0 + 1;
          }
        }
        {
          const int t1 = wid + 4 * k1;
          exp_load(B0, vt + 128 * c1, (const signed char*)nullptr, ids + t1 * 128 + grp * 8, j8, false);
        }
        exp_v_accum(B1, wq.z, wq.w, acc);
        exp_v_finish(xo, xq, gq, acc, swl[t0], grp, gscale);
        c0 = c1;
        k0 = k1;
      }
    }
    asm volatile("s_waitcnt vmcnt(0)" ::: "memory");
    __syncthreads();
    if (gscale == 1.f) {
      for (int t = wid; t < cnt; t += 4) {
        if (layer + 1 < DEPTH) norm_row(p, layer + 1, 0, tok0 + t, lane);
        else if (tok0 + t < TL) norm_row(p, 0, 2, tok0 + t, lane);
      }
    }
    __syncthreads();
  }
}

#define XB_TMO 128
#define XB_XCNT(j) (256 + 64 * (j))
#define XB_XSUB(j) (1280 + 64 * (j))
#define XB_XGEN(j) (2304 + 64 * (j))
#define XB_TOP 3328
#define XB_TOPGEN 3392
#define XCD_BAR_WORDS 3456
#define XB_SPIN_CAP (1u << 22)
#define LAS __attribute__((address_space(3)))
DEVI unsigned xb_ld(unsigned* p) { return __hip_atomic_load(p, __ATOMIC_RELAXED, __HIP_MEMORY_SCOPE_AGENT); }
DEVI unsigned xb_add(unsigned* p, unsigned v) { return __hip_atomic_fetch_add(p, v, __ATOMIC_RELAXED, __HIP_MEMORY_SCOPE_AGENT); }
DEVI unsigned xb_xcc_id() { return (unsigned)__builtin_amdgcn_s_getreg((3 << 11) | 20) & 0xFu; }
#define XB_SPIN(cond, bar)                                   \
  do {                                                       \
    unsigned _sp = 0;                                        \
    while (cond) {                                           \
      __builtin_amdgcn_s_sleep(1);                           \
      if ((++_sp & 255u) == 0u) {                            \
        if (xb_ld(&(bar)[XB_TMO])) break;                    \
        if (_sp > XB_SPIN_CAP) {                             \
          atomicAdd(&(bar)[XB_TMO], 1u);                     \
          break;                                             \
        }                                                    \
      }                                                      \
    }                                                        \
  } while (0)
struct XcdBarrier {
  unsigned* bar;
  unsigned x;
  volatile LAS unsigned* st;
};
DEVI XcdBarrier xcd_barrier_post(unsigned* bar, volatile LAS unsigned* st) {
  XcdBarrier b;
  b.bar = bar;
  b.x = xb_xcc_id();
  b.st = st;
  if (threadIdx.x == 0) (void)xb_add(&bar[XB_XCNT(b.x)], 1u);
  return b;
}
DEVI void xcd_barrier_complete(unsigned* bar, unsigned x, unsigned& nloc, unsigned& nx) {
  const unsigned G = gridDim.x * gridDim.y * gridDim.z;
  unsigned sum, cnt, mine, sp = 0u;
  for (;;) {
    sum = 0u;
    cnt = 0u;
    mine = 0u;
#pragma unroll
    for (unsigned j = 0; j < 16; ++j) {
      const unsigned c = xb_ld(&bar[XB_XCNT(j)]);
      sum += c;
      cnt += (c > 0u) ? 1u : 0u;
      mine = (j == x) ? c : mine;
    }
    if (sum == G) break;
    __builtin_amdgcn_s_sleep(1);
    if ((++sp & 255u) == 0u) {
      if (xb_ld(&bar[XB_TMO])) break;
      if (sp > XB_SPIN_CAP) {
        atomicAdd(&bar[XB_TMO], 1u);
        break;
      }
    }
  }
  nloc = mine > 0u ? mine : 1u;
  nx = cnt > 0u ? cnt : 1u;
}
DEVI void xcd_barrier(const XcdBarrier& b) {
  asm volatile("s_waitcnt vmcnt(0)" ::: "memory");
  __syncthreads();
  if (threadIdx.x == 0) {
    unsigned* bar = b.bar;
    __builtin_amdgcn_s_waitcnt(0);
    unsigned nloc = b.st[0], nx = b.st[1];
    if (nloc == 0u) {
      xcd_barrier_complete(bar, b.x, nloc, nx);
      b.st[0] = nloc;
      b.st[1] = nx;
    }
    const unsigned old = xb_add(&bar[XB_XSUB(b.x)], 1u);
    const unsigned gen = old / nloc;
    if (old + 1u == (gen + 1u) * nloc) {
      __builtin_amdgcn_fence(__ATOMIC_RELEASE, "agent");
      asm volatile("s_waitcnt vmcnt(0)" ::: "memory");
      const unsigned og = xb_add(&bar[XB_TOP], 1u);
      const unsigned tg = og / nx;
      if (og + 1u == (tg + 1u) * nx) xb_add(&bar[XB_TOPGEN], 1u);
      else XB_SPIN(xb_ld(&bar[XB_TOPGEN]) == tg, bar);
      __builtin_amdgcn_fence(__ATOMIC_ACQUIRE, "agent");
      xb_add(&bar[XB_XGEN(b.x)], 1u);
      asm volatile("s_waitcnt vmcnt(0)" ::: "memory");
    } else {
      XB_SPIN(xb_ld(&bar[XB_XGEN(b.x)]) == gen, bar);
      __builtin_amdgcn_fence(__ATOMIC_ACQUIRE, "agent");
      asm volatile("s_waitcnt vmcnt(0)" ::: "memory");
    }
  }
  __syncthreads();
}

DEVI bool step_active(int step) {
  if (step == 0) return true;
  if (step == NSTEPS - 1) return false;
  int layer = (step - 1) / STEPS_PER_LAYER, ph = (step - 1) % STEPS_PER_LAYER;
  if (ph == 3 && (layer & 1)) return false;
  if (ph == 0 && layer > 0) return false;
  return true;
}

DEVI void run_step(PP p, int step, unsigned char* lds, unsigned char* lds_all, float gscale = 1.f) {
  if (step == 0) {
    phase_prep(p, lds);
    return;
  }
  if (step == NSTEPS - 1) {
    phase_norm(p, 0, 2, TL);
    return;
  }
  int layer = (step - 1) / STEPS_PER_LAYER, ph = (step - 1) % STEPS_PER_LAYER;
  bool even = (layer & 1) == 0;
  int j = layer >> 1;
  bool upd_ctx = layer < 2;
  bool need_ctx = layer < 3;
  int nt_in = need_ctx ? TT : TL;
  int nt = upd_ctx ? TT : TL;
  switch (ph) {
    case 0: phase_norm(p, layer, 0, nt_in); break;
    case 1:
      if (even)
        gemm_phase<EPI_INPROJ>(p, p->h, D, p->wt_in_ab + (size_t)j * 1280 * D, D, nt_in / 128, 10, D, layer, lds);
      else
        gemm8_phase<EPI_GELU>(p, p->h, D, p->wt_in_gs + (size_t)j * 2048 * D, D, nt / 256, 8, D, layer, lds_all);
      break;
    case 2:
      if (even) {
        phase_fft_a(p, lds);
        if (upd_ctx) phase_dft_ctx(p, lds);
        phase_attn(p, layer, upd_ctx);
      } else {
        phase_sgu(p, j, nt / 128, lds);
      }
      break;
    case 3:
      if (even) phase_fft_b(p, lds);
      break;
    case 4:
      if (even)
        gemm_phase<EPI_RESID>(p, p->mix, LDMIX, p->wt_out_ab + (size_t)j * D * LDMIX, LDMIX, nt / 128, 8, LDMIX, layer, lds, gscale);
      else
        gemm_phase<EPI_RESID>(p, p->mix, LDMIX, p->wt_out_gs + (size_t)j * D * D, D, nt / 128, 8, D, layer, lds, gscale);
      break;
    case 5: phase_norm(p, layer, 1, nt); break;
    case 6: gemm8_phase<EPI_STORE>(p, p->h, D, p->wt_q + (size_t)layer * 2048 * D, D, nt / 256, 8, D, layer, lds_all); break;
    case 7: phase_route(p, layer, nt, lds); break;
    case 8: phase_expert(p, layer, nt, lds, gscale, (gscale == 1.f) ? 0xffff : REP_IDMASK); break;
  }
}

__global__ void __launch_bounds__(PHYS_THREADS, 2) mega(Params p_unused, int step_lo, int step_hi) {
  __shared__ __attribute__((aligned(16))) unsigned char lds_all[LDS_BYTES];
  unsigned char* lds = lds_all + __builtin_amdgcn_readfirstlane(threadIdx.x >> 8) * LDS_HALF;
  PP pp = (PP)__builtin_amdgcn_kernarg_segment_ptr();
  volatile LAS unsigned* st = (volatile LAS unsigned*)(lds_all + LDS_BYTES - 16);
  if (threadIdx.x == 0) {
    st[0] = 0u;
    st[1] = 0u;
  }
  __syncthreads();
  XcdBarrier xb = xcd_barrier_post(pp->bar, st);
  int nsync = 0;
  bool first = true;
  for (int s = step_lo; s < step_hi; ++s) {
    if (!step_active(s)) continue;
    if (!first) {
      if (nsync == 0) cg::this_grid().sync();
      else xcd_barrier(xb);
      ++nsync;
    }
    first = false;
    PP q = pp;
    asm volatile("" : "+s"(q));
    run_step(q, s, lds, lds_all);
#if REP_MASK
    if (s == 0 && ((REP_MASK >> 15) & 1)) {
      xcd_barrier(xb);
      PP q2 = pp;
      asm volatile("" : "+s"(q2));
      run_step(q2, 0, lds, lds_all);
    }
    if (s > 0 && s < NSTEPS - 1) {
      int lay_ = (s - 1) / STEPS_PER_LAYER, ph_ = (s - 1) % STEPS_PER_LAYER;
      bool rep_ = (REP_MASK >> ph_) & 1;
      if (ph_ == 2 && ((REP_MASK >> 9) & 1) && !(lay_ & 1)) rep_ = true;
      if (ph_ == 2 && ((REP_MASK >> 10) & 1) && (lay_ & 1)) rep_ = true;
      if (rep_) {
        xcd_barrier(xb);
        PP q2 = pp;
        asm volatile("" : "+s"(q2));
        float z = 0.f;
        asm volatile("" : "+s"(z));
        run_step(q2, s, lds, lds_all, z);
      }
      if (ph_ == 2 && ((REP_MASK >> 11) & 1) && !(lay_ & 1)) {
        xcd_barrier(xb);
        PP q2 = pp;
        asm volatile("" : "+s"(q2));
        phase_attn(q2, lay_, lay_ < 2);
      }
    }
#endif
  }
}

static size_t align_up(size_t v) { return (v + 255) & ~(size_t)255; }

extern "C" void kernel_launch(void* const* d_in, const int* in_sizes, int n_in, void* d_out, int out_size, void* d_ws,
                              size_t ws_size, hipStream_t stream) {
  Params p{};
  p.x = (const float*)d_in[0];
  p.c = (const float*)d_in[1];
  p.ctx = (const float*)d_in[2];
  p.c_ctx = (const float*)d_in[3];
  p.ada_w = (const float*)d_in[4];
  p.ada_b = (const float*)d_in[5];
  p.norm_mix_w = (const float*)d_in[6];
  p.norm_ffn_w = (const float*)d_in[7];
  p.ab_w_in = (const float*)d_in[8];
  p.ab_w_out = (const float*)d_in[9];
  p.attn_sink = (const float*)d_in[10];
  p.gs_w_in = (const float*)d_in[11];
  p.gs_norm_w = (const float*)d_in[12];
  p.gs_w_s = (const float*)d_in[13];
  p.gs_b_s = (const float*)d_in[14];
  p.gs_w_out = (const float*)d_in[15];
  p.peer_w_q = (const float*)d_in[16];
  p.peer_keys = (const float*)d_in[17];
  p.peer_u = (const float*)d_in[18];
  p.peer_v = (const float*)d_in[19];
  p.norm_out_w = (const float*)d_in[20];
  p.out = (float*)d_out;
  unsigned char* w = (unsigned char*)d_ws;
  size_t off = 0;
  auto take = [&](size_t bytes) {
    unsigned char* r = w + off;
    off = align_up(off + bytes);
    return r;
  };
  p.bar = (unsigned*)take((size_t)XCD_BAR_WORDS * 4);
  p.mod = (float*)take((size_t)DEPTH * 9 * 6144 * 4);
  p.cs = (float2*)take(64 * 16 * 8);
  p.xs = (float*)take((size_t)TT * D * 4);
  p.h = (bf16_t*)take((size_t)TT * D * 2);
  p.P = (bf16_t*)take((size_t)TT * 2048 * 2);
  p.kbuf = (bf16_t*)take((size_t)NB * 2 * KVLEN * 64 * 2);
  p.vbuf = (bf16_t*)take((size_t)NB * 2 * KVLEN * 64 * 2);
  p.zvT = (bf16_t*)take((size_t)TT * 1024 * 2);
  p.rowss = (float*)take((size_t)(TT / 128) * 32 * 128 * 4);
  p.mix = (bf16_t*)take((size_t)TT * LDMIX * 2);
  p.fa = (bf16_t*)take((size_t)TL * 1024 * 2);
  p.tops = (float*)take((size_t)TT * 256 * 4);
  p.eidx = (int*)take((size_t)TT * 128 * 4);
  p.gate = (float*)take((size_t)TT * 128 * 4);
  p.wt_in_ab = (bf16_t*)take((size_t)2 * 1280 * D * 2);
  p.wt_out_ab = (bf16_t*)take((size_t)2 * D * LDMIX * 2);
  p.wt_in_gs = (bf16_t*)take((size_t)2 * 2048 * D * 2);
  p.wt_out_gs = (bf16_t*)take((size_t)2 * D * D * 2);
  p.wt_q = (bf16_t*)take((size_t)DEPTH * 2048 * D * 2);
  p.keysb = (bf16_t*)take((size_t)DEPTH * 8 * 2 * 128 * 128 * 2);
  p.su = (float*)take((size_t)DEPTH * NEXP * 4);
  p.sv = (float*)take((size_t)DEPTH * NEXP * 4);
  p.h8 = (signed char*)take((size_t)TT * D);
  p.sx = (float*)take((size_t)TT * 4);
  p.utab = (unsigned char*)take((size_t)DEPTH * NEXP * D);
  p.vtab = (unsigned char*)take((size_t)DEPTH * NEXP * D);
  if (off > ws_size) {
    fprintf(stderr, "workspace too small: need %zu have %zu\n", off, ws_size);
    return;
  }
  hipMemsetAsync(p.bar, 0, (size_t)XCD_BAR_WORDS * 4, stream);
  static int grid_blocks = 0;
  if (!grid_blocks) {
    int dev = 0, cus = 0, per_cu = 0;
    hipGetDevice(&dev);
    hipDeviceGetAttribute(&cus, hipDeviceAttributeMultiprocessorCount, dev);
    hipOccupancyMaxActiveBlocksPerMultiprocessor(&per_cu, mega, PHYS_THREADS, 0);
    if (per_cu > 1) per_cu = 1;
    if (per_cu < 1) per_cu = 1;
    grid_blocks = cus * per_cu;
  }
#if ONE_LAUNCH
  int lo = 0, hi = NSTEPS;
  void* args[] = {&p, &lo, &hi};
  hipError_t e = hipLaunchCooperativeKernel((void*)mega, dim3(grid_blocks), dim3(PHYS_THREADS), args, 0, stream);
  if (e != hipSuccess) fprintf(stderr, "cooperative launch failed: %s (grid %d)\n", hipGetErrorString(e), grid_blocks);
#else
  for (int s = 0; s < NSTEPS; ++s) {
    if (s != 0 && s != NSTEPS - 1) {
      int layer = (s - 1) / STEPS_PER_LAYER, ph = (s - 1) % STEPS_PER_LAYER;
      if (ph == 3 && (layer & 1)) continue;
    }
    hipLaunchKernelGGL(mega, dim3(grid_blocks), dim3(NTHREADS), 0, stream, p, s, s + 1);
  }
#endif
}
```

```cpp
#include <hip/hip_runtime.h>
#include <hip/hip_bf16.h>
#include <hip/hip_cooperative_groups.h>
#include <cstdio>
namespace cg = cooperative_groups;

#ifndef REP_MASK
#define REP_MASK 0
#endif
#ifndef REP_MODE
#define REP_MODE 0
#endif
#ifndef REP_IDMASK
#define REP_IDMASK 0xffff
#endif
#ifndef ONE_LAUNCH
#define ONE_LAUNCH 1
#endif

#define DEVI __device__ __forceinline__
typedef unsigned short bf16_t;
using bf16x8 = __attribute__((ext_vector_type(8))) short;
using f32x4 = __attribute__((ext_vector_type(4))) float;
using f32x16 = __attribute__((ext_vector_type(16))) float;

constexpr int D = 1024, NB = 8, SEQ = 4096, CTX = 256, DEPTH = 4;
constexpr int TL = NB * SEQ, TC = NB * CTX, TT = TL + TC;
constexpr int KVLEN = CTX + SEQ;
constexpr int NEXP = 16384;
constexpr int LDMIX = 1536;
constexpr float USCALE = 64.f, VSCALE = 8.f;
constexpr int TPB = 68;
constexpr int LDS_HALF = 68 * 1024;
constexpr int LDS_BYTES = 2 * LDS_HALF;
constexpr int PHYS_THREADS = 512;
constexpr int NTHREADS = 256;
constexpr int STEPS_PER_LAYER = 9;
constexpr int NSTEPS = 1 + DEPTH * STEPS_PER_LAYER + 1;

struct Params {
  const float *x, *c, *ctx, *c_ctx, *ada_w, *ada_b, *norm_mix_w, *norm_ffn_w, *ab_w_in, *ab_w_out, *attn_sink,
      *gs_w_in, *gs_norm_w, *gs_w_s, *gs_b_s, *gs_w_out, *peer_w_q, *peer_keys, *peer_u, *peer_v, *norm_out_w;
  float* out;
  float* mod;
  float2* cs;
  float* xs;
  bf16_t* h;
  bf16_t* P;
  bf16_t* kbuf;
  bf16_t* vbuf;
  float* rowss;
  bf16_t* zvT;
  bf16_t* mix;
  bf16_t* fa;
  unsigned* bar;
  float* tops;
  int* eidx;
  float* gate;
  bf16_t *wt_in_ab, *wt_out_ab, *wt_in_gs, *wt_out_gs, *wt_q, *keysb;
  unsigned char *utab, *vtab;
  float* su;
  float* sv;
  signed char* h8;
  float* sx;
};

typedef const __attribute__((address_space(4))) Params* PP;

__shared__ __attribute__((aligned(16))) unsigned char g_lds[LDS_BYTES];
DEVI int hw_slot() { return (int)(__builtin_amdgcn_s_getreg((6 - 1) << 11 | 0 << 6 | 4) & 63u); }
DEVI int wave_index() {
  int w = *reinterpret_cast<volatile int*>(g_lds + LDS_BYTES - 16 - 256 + 4 * hw_slot());
  return __builtin_amdgcn_readfirstlane(w);
}
DEVI int lane_id() { return (int)__builtin_amdgcn_mbcnt_hi(~0u, __builtin_amdgcn_mbcnt_lo(~0u, 0u)); }
DEVI int ltid() { int t = ((wave_index() & 3) << 6) | lane_id(); asm volatile("" : "+v"(t)); return t; }
DEVI int lbid() { int t = 2 * blockIdx.x + (wave_index() >> 2); asm volatile("" : "+s"(t)); return t; }
DEVI int lnblk() { int t = 2 * gridDim.x; asm volatile("" : "+s"(t)); return t; }
DEVI int ptid() { int t = (wave_index() << 6) | lane_id(); asm volatile("" : "+v"(t)); return t; }
DEVI int pbid() { int t = blockIdx.x; asm volatile("" : "+s"(t)); return t; }
DEVI int pnblk() { int t = gridDim.x; asm volatile("" : "+s"(t)); return t; }

typedef __bf16 bf2v_t __attribute__((ext_vector_type(2)));
typedef float f2v_t __attribute__((ext_vector_type(2)));
DEVI bf16_t f2bf(float f) { return __builtin_bit_cast(unsigned short, (__bf16)f); }
DEVI float bf2f(bf16_t h) { return __uint_as_float(((unsigned)h) << 16); }
DEVI float bflo(unsigned u) { return __uint_as_float(u << 16); }
DEVI float bfhi(unsigned u) { return __uint_as_float(u & 0xffff0000u); }
DEVI unsigned pack2(float a, float b) {
  f2v_t v = {a, b};
  return __builtin_bit_cast(unsigned, __builtin_convertvector(v, bf2v_t));
}
DEVI float wave_sum(float v) {
#pragma unroll
  for (int o = 32; o > 0; o >>= 1) v += __shfl_xor(v, o);
  return v;
}
DEVI float wave_max(float v) {
#pragma unroll
  for (int o = 32; o > 0; o >>= 1) v = fmaxf(v, __shfl_xor(v, o));
  return v;
}
DEVI float gelu_tanh(float x) {
  float u = 0.7978845608028654f * (x + 0.044715f * x * x * x);
  return 0.5f * x * (1.f + tanhf(u));
}
template <int CTRL>
DEVI float dpp_mov(float v) {
  return __builtin_bit_cast(float, __builtin_amdgcn_mov_dpp(__builtin_bit_cast(int, v), CTRL, 0xF, 0xF, true));
}
DEVI int tok_batch(int r) { return r < TL ? (r >> 12) : 8; }

DEVI void prep_transpose_tile(const float* __restrict__ src, int N, bf16_t* __restrict__ dst, int ldk, int tk, int tn, float* tile, int tid) {
#pragma unroll
  for (int i = 0; i < 16; ++i) {
    int r = (tid >> 6) + 4 * i;
    tile[r * 65 + (tid & 63)] = src[(size_t)(tk * 64 + r) * N + tn * 64 + (tid & 63)];
  }
  __syncthreads();
#pragma unroll
  for (int i = 0; i < 16; ++i) {
    int n = (tid >> 6) + 4 * i, k = tid & 63;
    dst[(size_t)(tn * 64 + n) * ldk + tk * 64 + k] = f2bf(tile[k * 65 + n]);
  }
}

constexpr int PU_ADA = DEPTH * 96;
constexpr int PU_T_ABIN = 2 * 16 * 20;
constexpr int PU_T_GSIN = 2 * 16 * 32;
constexpr int PU_T_GSOUT = 2 * 16 * 16;
constexpr int PU_T_ABOUT = 2 * 8 * 16;
constexpr int PU_T_Q = DEPTH * 16 * 32;
constexpr int PU_FOLD = 2 * 4 * 16 * 2;
constexpr int PU_CONV = DEPTH * NEXP * D / 4 / 2048;
constexpr int PU_KEYS = DEPTH * 8 * 2 * 128 * 128 / 4 / 2048;
constexpr int PU_UROWS = DEPTH * NEXP / 32;
constexpr int PU_TOTAL = PU_ADA + PU_T_ABIN + PU_T_GSIN + PU_T_GSOUT + PU_T_ABOUT + PU_T_Q + PU_FOLD + 2 * PU_UROWS + PU_KEYS + 1;

DEVI void phase_prep(PP p, unsigned char* lds) {
  const int tid = ltid();
  float* fl = reinterpret_cast<float*>(lds);
  for (int u0 = lbid(); u0 < PU_TOTAL; u0 += lnblk()) {
    int u = u0;
    if (u < PU_ADA) {
      float* sl = fl;
      for (int i = tid; i < 9 * 1024; i += NTHREADS) {
        int r = i >> 10, k = i & 1023;
        float v = (r < 8) ? p->c[r * 1024 + k] : p->c_ctx[k];
        sl[i] = v / (1.f + __expf(-v));
      }
      __syncthreads();
      float* red = sl + 9 * 1024;
      int ks = tid >> 6, col = tid & 63;
      int layer = u / 96, c0 = (u % 96) * 64;
      const float* w = p->ada_w + (size_t)layer * D * 6144 + c0 + col;
      float acc[9];
#pragma unroll
      for (int r = 0; r < 9; ++r) acc[r] = 0.f;
      for (int k0 = ks * 256; k0 < ks * 256 + 256; k0 += 16) {
        float wv[16];
#pragma unroll
        for (int kk = 0; kk < 16; ++kk) wv[kk] = w[(size_t)(k0 + kk) * 6144];
#pragma unroll
        for (int kk = 0; kk < 16; ++kk)
#pragma unroll
          for (int r = 0; r < 9; ++r) acc[r] += sl[r * 1024 + k0 + kk] * wv[kk];
      }
#pragma unroll
      for (int r = 0; r < 9; ++r) red[(ks * 9 + r) * 64 + col] = acc[r];
      __syncthreads();
      for (int i = tid; i < 9 * 64; i += NTHREADS) {
        int r = i >> 6, cc = i & 63;
        float sm = red[(0 * 9 + r) * 64 + cc] + red[(1 * 9 + r) * 64 + cc] + red[(2 * 9 + r) * 64 + cc] + red[(3 * 9 + r) * 64 + cc];
        sm += p->ada_b[(size_t)layer * 6144 + c0 + cc];
        p->mod[((size_t)layer * 9 + r) * 6144 + c0 + cc] = sm;
      }
      __syncthreads();
      continue;
    }
    u -= PU_ADA;
    if (u < PU_T_ABIN) {
      int j = u / 320, t = u % 320;
      prep_transpose_tile(p->ab_w_in + (size_t)j * D * 1280, 1280, p->wt_in_ab + (size_t)j * 1280 * D, D, t / 20, t % 20, fl, tid);
      __syncthreads();
      continue;
    }
    u -= PU_T_ABIN;
    if (u < PU_T_GSIN) {
      int j = u / 512, t = u % 512;
      prep_transpose_tile(p->gs_w_in + (size_t)j * D * 2048, 2048, p->wt_in_gs + (size_t)j * 2048 * D, D, t / 32, t % 32, fl, tid);
      __syncthreads();
      continue;
    }
    u -= PU_T_GSIN;
    if (u < PU_T_GSOUT) {
      int j = u / 256, t = u % 256;
      prep_transpose_tile(p->gs_w_out + (size_t)j * D * D, D, p->wt_out_gs + (size_t)j * D * D, D, t / 16, t % 16, fl, tid);
      __syncthreads();
      continue;
    }
    u -= PU_T_GSOUT;
    if (u < PU_T_ABOUT) {
      int j = u / 128, t = u % 128;
      prep_transpose_tile(p->ab_w_out + (size_t)j * D * D, D, p->wt_out_ab + (size_t)j * D * LDMIX, LDMIX, t / 16, t % 16, fl, tid);
      __syncthreads();
      continue;
    }
    u -= PU_T_ABOUT;
    if (u < PU_T_Q) {
      int i = u / 512, t = u % 512;
      prep_transpose_tile(p->peer_w_q + (size_t)i * D * 2048, 2048, p->wt_q + (size_t)i * 2048 * D, D, t / 32, t % 32, fl, tid);
      __syncthreads();
      continue;
    }
    u -= PU_T_Q;
    if (u < PU_FOLD) {
      const int mh = u & 1, nc = (u >> 1) & 15, g = (u >> 5) & 3, j = u >> 7;
      float2* tw = reinterpret_cast<float2*>(lds);
      float* wt = reinterpret_cast<float*>(lds + 1024);
      if (tid < 128) {
        float sn, cn;
        sincospif((float)tid / 64.f, &sn, &cn);
        tw[tid] = make_float2(cn, sn);
      }
      {
        const float* wsrc = p->ab_w_out + (size_t)j * D * D + (size_t)(512 + g * 128) * D + nc * 64;
#pragma unroll 8
        for (int i = 0; i < 32; ++i) {
          int l = (tid >> 6) + 4 * i;
          wt[l * 64 + (tid & 63)] = wsrc[(size_t)l * D + (tid & 63)];
        }
      }
      __syncthreads();
      const int n = tid & 63, mq = __builtin_amdgcn_readfirstlane(tid >> 6);
      bf16_t* dst = p->wt_out_ab + (size_t)j * D * LDMIX + (size_t)(nc * 64 + n) * LDMIX + g * 128;
#pragma unroll 1
      for (int mi = 0; mi < 16; ++mi) {
        const int m = mh * 64 + mq * 16 + mi;
        float ar = 0.f, ai = 0.f;
#pragma unroll 16
        for (int l = 0; l < 128; ++l) {
          float2 t = tw[(m * l) & 127];
          float wv = wt[l * 64 + n];
          ar += t.x * wv;
          ai += t.y * wv;
        }
        dst[512 + m] = f2bf(ar);
        dst[1024 + m] = f2bf(ai);
      }
      __syncthreads();
      continue;
    }
    u -= PU_FOLD;
    if (u < 2 * PU_UROWS) {
      const bool isv = u >= PU_UROWS;
      if (isv) u -= PU_UROWS;
      const float* src = isv ? p->peer_v : p->peer_u;
      unsigned char* dst = isv ? p->vtab : p->utab;
      float* sdst = isv ? p->sv : p->su;
      const int lane = tid & 63, wv = tid >> 6;
#pragma unroll 1
      for (int rr = 0; rr < 8; rr += 4) {
        size_t row0 = (size_t)u * 32 + wv * 8 + rr;
        float4 v[4][4];
#pragma unroll
        for (int k = 0; k < 4; ++k)
#pragma unroll
          for (int i = 0; i < 4; ++i) v[k][i] = reinterpret_cast<const float4*>(src + (row0 + k) * D)[lane * 4 + i];
#pragma unroll
        for (int k = 0; k < 4; ++k) {
          float am = 0.f;
#pragma unroll
          for (int i = 0; i < 4; ++i)
            am = fmaxf(am, fmaxf(fmaxf(fabsf(v[k][i].x), fabsf(v[k][i].y)), fmaxf(fabsf(v[k][i].z), fabsf(v[k][i].w))));
          am = wave_max(am);
          am = fmaxf(am, 1e-30f);
          float qs = 127.f / am;
          uint4 o;
          unsigned* op = reinterpret_cast<unsigned*>(&o);
#pragma unroll
          for (int i = 0; i < 4; ++i) {
            int q0 = (int)rintf(v[k][i].x * qs), q1 = (int)rintf(v[k][i].y * qs), q2 = (int)rintf(v[k][i].z * qs), q3 = (int)rintf(v[k][i].w * qs);
            op[i] = (unsigned)(q0 & 255) | ((unsigned)(q1 & 255) << 8) | ((unsigned)(q2 & 255) << 16) | ((unsigned)(q3 & 255) << 24);
          }
          reinterpret_cast<uint4*>(dst + (row0 + k) * D)[lane] = o;
          if (lane == 0) sdst[row0 + k] = am * (1.f / 127.f);
        }
      }
      continue;
    }
    u -= 2 * PU_UROWS;
    if (u < PU_KEYS) {
      const float4* s4 = reinterpret_cast<const float4*>(p->peer_keys) + (size_t)u * 2048 + tid;
      uint2* d2 = reinterpret_cast<uint2*>(p->keysb) + (size_t)u * 2048 + tid;
#pragma unroll
      for (int k = 0; k < 8; ++k) {
        float4 v = s4[k * 256];
        uint2 o;
        o.x = pack2(v.x, v.y);
        o.y = pack2(v.z, v.w);
        d2[k * 256] = o;
      }
      continue;
    }
    for (int i = tid; i < 64 * 16; i += NTHREADS) {
      int pos = i >> 4, k = i & 15;
      float inv = powf(10000.f, -(float)k / 16.f);
      float ang = (float)pos * inv;
      float sn, cn;
      sincosf(ang, &sn, &cn);
      p->cs[i] = make_float2(cn, sn);
    }
  }
}

DEVI void norm_row(PP p, int layer, int which, int tok, int lane) {
  const float* w = which == 0 ? p->norm_mix_w + layer * D : (which == 1 ? p->norm_ffn_w + layer * D : p->norm_out_w);
  const float* xsrc = p->xs + (size_t)tok * D;
  if (which == 0 && layer == 0) xsrc = (tok < TL) ? p->x + (size_t)tok * D : p->ctx + (size_t)(tok - TL) * D;
  const float4* xr = reinterpret_cast<const float4*>(xsrc);
  float4 v[4];
  float ss = 0.f;
#pragma unroll
  for (int i = 0; i < 4; ++i) {
    v[i] = xr[lane + 64 * i];
    ss += v[i].x * v[i].x + v[i].y * v[i].y + v[i].z * v[i].z + v[i].w * v[i].w;
  }
  ss = wave_sum(ss);
  float rstd = rsqrtf(ss * (1.f / 1024.f) + 1e-6f);
  if (which == 2) {
    float4* o = reinterpret_cast<float4*>(p->out + (size_t)tok * D);
#pragma unroll
    for (int i = 0; i < 4; ++i) {
      float4 wv = reinterpret_cast<const float4*>(w)[lane + 64 * i];
      float4 r;
      r.x = v[i].x * rstd * wv.x;
      r.y = v[i].y * rstd * wv.y;
      r.z = v[i].z * rstd * wv.z;
      r.w = v[i].w * rstd * wv.w;
      o[lane + 64 * i] = r;
    }
  } else {
    int b = tok_batch(tok);
    const float* mb = p->mod + ((size_t)layer * 9 + b) * 6144 + (which == 0 ? 0 : 3072);
    uint2* o = reinterpret_cast<uint2*>(p->h + (size_t)tok * D);
    float av[4][4];
    float am = 0.f;
#pragma unroll
    for (int i = 0; i < 4; ++i) {
      float4 wv = reinterpret_cast<const float4*>(w)[lane + 64 * i];
      float4 sh = reinterpret_cast<const float4*>(mb)[lane + 64 * i];
      float4 sc = reinterpret_cast<const float4*>(mb + 1024)[lane + 64 * i];
      float a0 = v[i].x * rstd * wv.x * (1.f + sc.x) + sh.x;
      float a1 = v[i].y * rstd * wv.y * (1.f + sc.y) + sh.y;
      float a2 = v[i].z * rstd * wv.z * (1.f + sc.z) + sh.z;
      float a3 = v[i].w * rstd * wv.w * (1.f + sc.w) + sh.w;
      uint2 r;
      r.x = pack2(a0, a1);
      r.y = pack2(a2, a3);
      o[lane + 64 * i] = r;
      av[i][0] = a0; av[i][1] = a1; av[i][2] = a2; av[i][3] = a3;
      am = fmaxf(am, fmaxf(fmaxf(fabsf(a0), fabsf(a1)), fmaxf(fabsf(a2), fabsf(a3))));
    }
    if (which == 1) {
      am = fmaxf(wave_max(am), 1e-30f);
      float qs = 127.f / am;
      unsigned* o8 = reinterpret_cast<unsigned*>(p->h8 + (size_t)tok * D);
#pragma unroll
      for (int i = 0; i < 4; ++i) {
        int q0 = (int)rintf(av[i][0] * qs), q1 = (int)rintf(av[i][1] * qs), q2 = (int)rintf(av[i][2] * qs), q3 = (int)rintf(av[i][3] * qs);
        o8[lane + 64 * i] = (unsigned)(q0 & 255) | ((unsigned)(q1 & 255) << 8) | ((unsigned)(q2 & 255) << 16) | ((unsigned)(q3 & 255) << 24);
      }
      if (lane == 0) p->sx[tok] = am * (1.f / 127.f);
    }
  }
}

DEVI void phase_norm(PP p, int layer, int which, int ntok) {
  int lane = ltid() & 63;
  int gw = lbid() * 4 + __builtin_amdgcn_readfirstlane(ltid() >> 6), nw = lnblk() * 4;
  for (int tok = gw; tok < ntok; tok += nw) norm_row(p, layer, which, tok, lane);
}

enum { EPI_STORE = 0, EPI_GELU = 1, EPI_RESID = 2, EPI_INPROJ = 3, EPI_RESID0 = 4 };

template <int EPI>
DEVI void gemm_phase(PP p, const bf16_t* __restrict__ A, int lda, const bf16_t* __restrict__ Bt, int ldb,
                     int Mtiles, int Ntiles, int K, int layer, unsigned char* lds, float gscale = 1.f) {
  const int tid = ltid();
  const int wid = __builtin_amdgcn_readfirstlane(tid >> 6), lane = tid & 63, wr = wid >> 1, wc = wid & 1, fr = lane & 15, fq = lane >> 4;
  int nblk = lnblk();
  int bid = lbid();
  int lb = bid;
  {
    const int pn = nblk >> 1, pb = bid >> 1;
    if ((pn & 7) == 0) lb = 2 * ((pb & 7) * (pn >> 3) + (pb >> 3)) + (bid & 1);
  }
  int ntiles = Mtiles * Ntiles;
  const int nk = K / 64;
  const int srow = tid >> 3;
  const int scol = ((tid & 7) ^ ((tid >> 3) & 7)) * 8;
#define GEMM_STAGE(ga_, gb_, kt_, buf_)                                                                               \
  {                                                                                                                   \
    _Pragma("unroll") for (int i_ = 0; i_ < 4; ++i_) {                                                                \
      __builtin_amdgcn_global_load_lds((const unsigned*)((ga_) + (size_t)(32 * i_) * lda + (kt_) * 64),               \
                                       (__attribute__((address_space(3))) unsigned*)(lds + (buf_) * 32768 + tid * 16 + i_ * 4096), 16, 0, 0); \
      __builtin_amdgcn_global_load_lds((const unsigned*)((gb_) + (size_t)(32 * i_) * ldb + (kt_) * 64),               \
                                       (__attribute__((address_space(3))) unsigned*)(lds + (buf_) * 32768 + 16384 + tid * 16 + i_ * 4096), 16, 0, 0); \
    }                                                                                                                 \
  }
  if (lb < ntiles) {
    int tm0 = lb / Ntiles, tn0 = lb % Ntiles;
    const bf16_t* ga0 = A + (size_t)(tm0 * 128 + srow) * lda + scol;
    const bf16_t* gb0 = Bt + (size_t)(tn0 * 128 + srow) * ldb + scol;
    GEMM_STAGE(ga0, gb0, 0, 0)
  }
  for (int t = lb; t < ntiles; t += nblk) {
    int tm = t / Ntiles, tn = t % Ntiles;
    int brow = tm * 128, bcol = tn * 128;
    f32x4 acc[4][4];
#pragma unroll
    for (int m = 0; m < 4; ++m)
#pragma unroll
      for (int n = 0; n < 4; ++n) acc[m][n] = f32x4{0.f, 0.f, 0.f, 0.f};
    const bf16_t* ga = A + (size_t)(brow + srow) * lda + scol;
    const bf16_t* gb = Bt + (size_t)(bcol + srow) * ldb + scol;
    for (int kt = 0; kt < nk; ++kt) {
      const int buf = kt & 1;
      asm volatile("s_waitcnt vmcnt(0)" ::: "memory");
      __syncthreads();
      if (kt + 1 < nk) GEMM_STAGE(ga, gb, kt + 1, buf ^ 1)
      const unsigned char* SA = lds + buf * 32768;
      const unsigned char* SB = SA + 16384;
      bf16x8 At[2][4], Bl[2][4];
#pragma unroll
      for (int ks = 0; ks < 2; ++ks)
#pragma unroll
        for (int m = 0; m < 4; ++m) {
          const int sl = ((ks * 4 + fq) ^ (fr & 7)) << 4;
          At[ks][m] = *reinterpret_cast<const bf16x8*>(SA + (wr * 64 + m * 16 + fr) * 128 + sl);
          Bl[ks][m] = *reinterpret_cast<const bf16x8*>(SB + (wc * 64 + m * 16 + fr) * 128 + sl);
        }
#pragma unroll
      for (int ks = 0; ks < 2; ++ks)
#pragma unroll
        for (int m = 0; m < 4; ++m)
#pragma unroll
          for (int n = 0; n < 4; ++n)
            acc[m][n] = __builtin_amdgcn_mfma_f32_16x16x32_bf16(At[ks][m], Bl[ks][n], acc[m][n], 0, 0, 0);
    }
    {
      int t2 = t + nblk;
      if (t2 < ntiles) {
        int tm2 = t2 / Ntiles, tn2 = t2 % Ntiles;
        const bf16_t* ga2 = A + (size_t)(tm2 * 128 + srow) * lda + scol;
        const bf16_t* gb2 = Bt + (size_t)(tn2 * 128 + srow) * ldb + scol;
        GEMM_STAGE(ga2, gb2, 0, 0)
      }
    }
    const int colbase = bcol + wc * 64;
    if constexpr (EPI == EPI_STORE || EPI == EPI_GELU) {
      if (EPI == EPI_GELU && colbase >= 1024) {
        float* rsp = p->rowss + ((size_t)tm * 16 + (tn - 8) * 2 + wc) * 128;
#pragma unroll
        for (int m = 0; m < 4; ++m) {
          float ssq[4] = {0.f, 0.f, 0.f, 0.f};
#pragma unroll
          for (int n = 0; n < 4; ++n) {
            int ch = colbase - 1024 + n * 16 + fr;
            int q0 = wr * 64 + m * 16 + fq * 4;
            float g0 = gelu_tanh(acc[m][n][0]), g1 = gelu_tanh(acc[m][n][1]), g2 = gelu_tanh(acc[m][n][2]), g3 = gelu_tanh(acc[m][n][3]);
            ssq[0] += g0 * g0;
            ssq[1] += g1 * g1;
            ssq[2] += g2 * g2;
            ssq[3] += g3 * g3;
            uint2 o;
            o.x = pack2(g0, g1);
            o.y = pack2(g2, g3);
            *reinterpret_cast<uint2*>(p->zvT + ((size_t)tm * 1024 + ch) * 128 + q0) = o;
          }
#pragma unroll
          for (int j = 0; j < 4; ++j) {
            float v = ssq[j];
            v += dpp_mov<0xB1>(v);
            v += dpp_mov<0x4E>(v);
            v += dpp_mov<0x141>(v);
            v += dpp_mov<0x140>(v);
            if (fr == 0) rsp[wr * 64 + m * 16 + fq * 4 + j] = v;
          }
        }
      } else {
#pragma unroll
        for (int m = 0; m < 4; ++m)
#pragma unroll
          for (int j = 0; j < 4; ++j) {
            int row = brow + wr * 64 + m * 16 + fq * 4 + j;
            bf16_t* o = p->P + (size_t)row * 2048 + colbase + fr;
#pragma unroll
            for (int n = 0; n < 4; ++n) {
              float v = acc[m][n][j];
              if (EPI == EPI_GELU) v = gelu_tanh(v);
              o[n * 16] = f2bf(v);
            }
          }
      }
    } else if constexpr (EPI == EPI_RESID) {
#pragma unroll
      for (int m = 0; m < 4; ++m)
#pragma unroll
        for (int j = 0; j < 4; ++j) {
          int row = brow + wr * 64 + m * 16 + fq * 4 + j;
          int b = tok_batch(row);
          const float* g = p->mod + ((size_t)layer * 9 + b) * 6144 + 2048 + colbase + fr;
          float* o = p->xs + (size_t)row * D + colbase + fr;
          const float* xi = o;
          if (layer == 0 && gscale == 1.f)
            xi = ((row < TL) ? p->x + (size_t)row * D : p->ctx + (size_t)(row - TL) * D) + colbase + fr;
#pragma unroll
          for (int n = 0; n < 4; ++n) o[n * 16] = xi[n * 16] + gscale * g[n * 16] * acc[m][n][j];
        }
    } else if constexpr (EPI == EPI_INPROJ) {
      if (colbase >= 640 && colbase < 768) {
        int kvh = (colbase - 640) >> 6;
#pragma unroll
        for (int m = 0; m < 4; ++m) {
          int row0 = brow + wr * 64 + m * 16;
          bool latent = row0 < TL;
          int b = latent ? (row0 >> 12) : ((row0 - TL) >> 8);
          int kp16 = latent ? (CTX + (row0 & 4095)) : ((row0 - TL) & 255);
          int slot = kp16 + 8 * (fq & 1) + 4 * (fq >> 1);
#pragma unroll
          for (int n = 0; n < 4; ++n) {
            int dim = n * 16 + fr;
            uint2 o;
            o.x = pack2(acc[m][n][0], acc[m][n][1]);
            o.y = pack2(acc[m][n][2], acc[m][n][3]);
            *reinterpret_cast<uint2*>(p->vbuf + ((size_t)(b * 2 + kvh) * 64 + dim) * KVLEN + slot) = o;
          }
        }
      } else {
#pragma unroll
        for (int m = 0; m < 4; ++m)
#pragma unroll
          for (int j = 0; j < 4; ++j) {
            int row = brow + wr * 64 + m * 16 + fq * 4 + j;
            bool latent = row < TL;
            int b, pos;
            if (latent) {
              b = row >> 12;
              pos = row & 4095;
            } else {
              b = (row - TL) >> 8;
              pos = (row - TL) & 255;
            }
            float v0 = acc[m][0][j], v1 = acc[m][1][j], v2 = acc[m][2][j], v3 = acc[m][3][j];
            if (latent && colbase < 640) {
              float2 cr = p->cs[(pos >> 6) * 16 + fr];
              float2 cc = p->cs[(pos & 63) * 16 + fr];
              float a = v0, bb = v1;
              v0 = a * cr.x - bb * cr.y;
              v1 = bb * cr.x + a * cr.y;
              a = v2;
              bb = v3;
              v2 = a * cc.x - bb * cc.y;
              v3 = bb * cc.x + a * cc.y;
            }
            bf16_t* o;
            if (colbase < 512 || colbase >= 768) {
              o = p->P + (size_t)row * 2048 + colbase + fr;
            } else {
              int kvh = (colbase - 512) >> 6;
              int kp = latent ? (CTX + pos) : pos;
              o = p->kbuf + ((size_t)(b * 2 + kvh) * KVLEN + kp) * 64 + fr;
            }
            o[0] = f2bf(v0);
            o[16] = f2bf(v1);
            o[32] = f2bf(v2);
            o[48] = f2bf(v3);
          }
      }
    }
  }
}

constexpr int G8_HT = 128 * 64;
DEVI int g8_lds_byte(int r, int c) {
  int st = (r >> 4) * 2 + (c >> 5), rr = r & 15, cc = c & 31, ob = rr * 64 + cc * 2;
  return st * 1024 + (ob ^ (((ob >> 9) & 1) << 5));
}
DEVI void g8_stage_rc(int b, int& R, int& C) {
  int st = b / 1024, sb = b % 1024, swz = sb ^ (((sb >> 9) & 1) << 5);
  R = (st >> 1) * 16 + swz / 64;
  C = (st & 1) * 32 + (swz % 64) / 2;
}
template <int EPI, bool STAGED>
DEVI void gemm8_epilogue(PP p, f32x4 (&acc)[2][2][4][2], const f32x4* stg, int lane, int brow, int bcol, int wr, int wc, int fr, int fq, int layer, float gscale) {
#pragma unroll
  for (int ai_ = 0; ai_ < 2; ++ai_)
#pragma unroll
    for (int bj = 0; bj < 2; ++bj) {
      const int ai = STAGED ? 1 - ai_ : ai_;
      f32x4 q[4][2];
#pragma unroll
      for (int m = 0; m < 4; ++m)
#pragma unroll
        for (int n = 0; n < 2; ++n) q[m][n] = (STAGED && ai == 0) ? stg[(((bj * 4 + m) * 2 + n) * 64) + lane] : acc[ai][bj][m][n];
      const int r0 = brow + ai * 128 + wr * 64;
      const int c0 = bcol + bj * 128 + wc * 32;
      if constexpr (EPI == EPI_STORE) {
#pragma unroll
        for (int m = 0; m < 4; ++m)
#pragma unroll
          for (int j = 0; j < 4; ++j) {
            bf16_t* o = p->P + (size_t)(r0 + m * 16 + fq * 4 + j) * 2048 + c0 + fr;
            o[0] = f2bf(q[m][0][j]);
            o[16] = f2bf(q[m][1][j]);
          }
      } else if constexpr (EPI == EPI_GELU) {
        if (c0 >= 1024) {
          const int chunk = r0 >> 7;
          float* rsp = p->rowss + ((size_t)chunk * 32 + ((c0 - 1024) >> 5)) * 128;
#pragma unroll
          for (int m = 0; m < 4; ++m) {
            float ssq[4] = {0.f, 0.f, 0.f, 0.f};
            const int q0 = (r0 & 127) + m * 16 + fq * 4;
#pragma unroll
            for (int n = 0; n < 2; ++n) {
              int ch = c0 - 1024 + n * 16 + fr;
              float g0 = gelu_tanh(q[m][n][0]), g1 = gelu_tanh(q[m][n][1]);
              float g2 = gelu_tanh(q[m][n][2]), g3 = gelu_tanh(q[m][n][3]);
              ssq[0] += g0 * g0;
              ssq[1] += g1 * g1;
              ssq[2] += g2 * g2;
              ssq[3] += g3 * g3;
              uint2 o;
              o.x = pack2(g0, g1);
              o.y = pack2(g2, g3);
              *reinterpret_cast<uint2*>(p->zvT + ((size_t)chunk * 1024 + ch) * 128 + q0) = o;
            }
#pragma unroll
            for (int j = 0; j < 4; ++j) {
              float v = ssq[j];
              v += dpp_mov<0xB1>(v);
              v += dpp_mov<0x4E>(v);
              v += dpp_mov<0x141>(v);
              v += dpp_mov<0x140>(v);
              if (fr == 0) rsp[q0 + j] = v;
            }
          }
        } else {
#pragma unroll
          for (int m = 0; m < 4; ++m)
#pragma unroll
            for (int j = 0; j < 4; ++j) {
              bf16_t* o = p->P + (size_t)(r0 + m * 16 + fq * 4 + j) * 2048 + c0 + fr;
              o[0] = f2bf(gelu_tanh(q[m][0][j]));
              o[16] = f2bf(gelu_tanh(q[m][1][j]));
            }
        }
      } else if constexpr (EPI == EPI_RESID || EPI == EPI_RESID0) {
        const float* g = p->mod + ((size_t)layer * 9 + tok_batch(brow)) * 6144 + 2048 + c0 + fr;
        const float g0 = g[0], g1 = g[16];
        const float* xin = (brow < TL) ? p->x : p->ctx - (size_t)TL * D;
#pragma unroll
        for (int m = 0; m < 4; ++m)
#pragma unroll
          for (int j = 0; j < 4; ++j) {
            const size_t ro = (size_t)(r0 + m * 16 + fq * 4 + j) * D + c0 + fr;
            float* o = p->xs + ro;
            const float* xi = (EPI == EPI_RESID0) ? xin + ro : o;
            o[0] = xi[0] + g0 * q[m][0][j];
            o[16] = xi[16] + g1 * q[m][1][j];
          }
      } else if constexpr (EPI == EPI_INPROJ) {
        if (c0 >= 640 && c0 < 768) {
          const int kvh = (c0 - 640) >> 6, d0 = (c0 - 640) & 63;
#pragma unroll
          for (int m = 0; m < 4; ++m) {
            int row0 = r0 + m * 16;
            bool latent = row0 < TL;
            int b = latent ? (row0 >> 12) : ((row0 - TL) >> 8);
            int kp16 = latent ? (CTX + (row0 & 4095)) : ((row0 - TL) & 255);
            int slot = kp16 + 8 * (fq & 1) + 4 * (fq >> 1);
#pragma unroll
            for (int n = 0; n < 2; ++n) {
              int dim = d0 + n * 16 + fr;
              uint2 o;
              o.x = pack2(q[m][n][0], q[m][n][1]);
              o.y = pack2(q[m][n][2], q[m][n][3]);
              *reinterpret_cast<uint2*>(p->vbuf + ((size_t)(b * 2 + kvh) * 64 + dim) * KVLEN + slot) = o;
            }
          }
        } else {
          const int hsel = (c0 >> 5) & 1;
#pragma unroll
          for (int m = 0; m < 4; ++m)
#pragma unroll
            for (int j = 0; j < 4; ++j) {
              int row = r0 + m * 16 + fq * 4 + j;
              bool latent = row < TL;
              int b, pos;
              if (latent) {
                b = row >> 12;
                pos = row & 4095;
              } else {
                b = (row - TL) >> 8;
                pos = (row - TL) & 255;
              }
              float v0 = q[m][0][j], v1 = q[m][1][j];
              if (latent && c0 < 640) {
                float2 cs = p->cs[(hsel ? (pos & 63) : (pos >> 6)) * 16 + fr];
                float a = v0, bb = v1;
                v0 = a * cs.x - bb * cs.y;
                v1 = bb * cs.x + a * cs.y;
              }
              bf16_t* o;
              if (c0 < 512 || c0 >= 768) {
                o = p->P + (size_t)row * 2048 + c0 + fr;
              } else {
                int kvh = (c0 - 512) >> 6, d0 = (c0 - 512) & 63;
                int kp = latent ? (CTX + pos) : pos;
                o = p->kbuf + ((size_t)(b * 2 + kvh) * KVLEN + kp) * 64 + d0 + fr;
              }
              o[0] = f2bf(v0);
              o[16] = f2bf(v1);
            }
        }
      }
      __builtin_amdgcn_sched_barrier(0);
    }
}

template <int EPI>
DEVI void gemm8_phase(PP p, const bf16_t* __restrict__ A, int lda, const bf16_t* __restrict__ Bt, int ldb, int Mtiles, int Ntiles,
                      int K, int layer, unsigned char* lds_all, float gscale = 1.f) {
  bf16_t* shm = reinterpret_cast<bf16_t*>(lds_all);
  const int tid = ptid();
  const int wid = __builtin_amdgcn_readfirstlane(tid >> 6), lane = tid & 63, wr = wid >> 2, wc = wid & 3, fr = lane & 15, fq = lane >> 4;
#define G8_SA(b, h) (shm + ((b) * 2 + (h)) * G8_HT)
#define G8_SB(b, h) (shm + (4 + (b) * 2 + (h)) * G8_HT)
  const __amdgpu_buffer_rsrc_t rsA = __builtin_amdgcn_make_buffer_rsrc((void*)A, (short)0, -1, 0x00020000);
  const __amdgpu_buffer_rsrc_t rsB = __builtin_amdgcn_make_buffer_rsrc((void*)Bt, (short)0, -1, 0x00020000);
  unsigned voA[2], voB[2];
#pragma unroll
  for (int i = 0; i < 2; ++i) {
    int r_, c_;
    g8_stage_rc(tid * 16 + i * 8192, r_, c_);
    voA[i] = (unsigned)((r_ * lda + c_) * 2);
    voB[i] = (unsigned)((r_ * ldb + c_) * 2);
  }
#define G8_STAGE(P_, RS_, VO_, ld_, br_, kt_)                                                                         \
  do {                                                                                                                \
    const unsigned so_ = (unsigned)(((br_) * (ld_) + (kt_) * 64) * 2);                                                \
    _Pragma("unroll") for (int i_ = 0; i_ < 2; ++i_)                                                                  \
      __builtin_amdgcn_raw_ptr_buffer_load_lds(RS_, (__attribute__((address_space(3))) void*)((unsigned char*)(P_) + wid * 1024 + i_ * 8192), 16, VO_[i_], so_, 0, 0); \
  } while (0)
#define G8_LDA(dst, b, h)                                                                                             \
  _Pragma("unroll") for (int m_ = 0; m_ < 4; ++m_) _Pragma("unroll") for (int k_ = 0; k_ < 2; ++k_)                   \
      dst[m_][k_] = *reinterpret_cast<const bf16x8*>((const unsigned char*)G8_SA(b, h) + g8_lds_byte(wr * 64 + m_ * 16 + fr, k_ * 32 + fq * 8))
#define G8_LDB(dst, b, h)                                                                                             \
  _Pragma("unroll") for (int n_ = 0; n_ < 2; ++n_) _Pragma("unroll") for (int k_ = 0; k_ < 2; ++k_)                   \
      dst[n_][k_] = *reinterpret_cast<const bf16x8*>((const unsigned char*)G8_SB(b, h) + g8_lds_byte(wc * 32 + n_ * 16 + fr, k_ * 32 + fq * 8))
#define G8_MMA(ai, bj, At_, Bt_)                                                                                      \
  do {                                                                                                                \
    __builtin_amdgcn_s_setprio(1);                                                                                    \
    _Pragma("unroll") for (int m_ = 0; m_ < 4; ++m_) _Pragma("unroll") for (int n_ = 0; n_ < 2; ++n_)                 \
        _Pragma("unroll") for (int k_ = 0; k_ < 2; ++k_) acc[ai][bj][m_][n_] =                                        \
            __builtin_amdgcn_mfma_f32_16x16x32_bf16(At_[m_][k_], Bt_[n_][k_], acc[ai][bj][m_][n_], 0, 0, 0);          \
    __builtin_amdgcn_s_setprio(0);                                                                                    \
  } while (0)
#define G8_WAIT_V(n) asm volatile("s_waitcnt vmcnt(" #n ")" ::: "memory")
#define G8_WAIT_L(n) asm volatile("s_waitcnt lgkmcnt(" #n ")" ::: "memory")
#define G8_BAR __builtin_amdgcn_s_barrier()
#define G8_SCHED __builtin_amdgcn_sched_barrier(0)
  const int nblk = pnblk(), bid = pbid();
  const int lb = ((nblk & 7) == 0) ? ((bid & 7) * (nblk >> 3) + (bid >> 3)) : bid;
  const int ntiles = Mtiles * Ntiles;
  const int nt = K / 64;
  for (int t = lb; t < ntiles; t += nblk) {
    const int tm = t / Ntiles, tn = t % Ntiles;
    const int brow = tm * 256, bcol = tn * 256;
    f32x4 acc[2][2][4][2];
#pragma unroll
    for (int a0 = 0; a0 < 2; ++a0)
#pragma unroll
      for (int b0 = 0; b0 < 2; ++b0)
#pragma unroll
        for (int m = 0; m < 4; ++m)
#pragma unroll
          for (int n = 0; n < 2; ++n) acc[a0][b0][m][n] = f32x4{0.f, 0.f, 0.f, 0.f};
    bf16x8 At[4][2], B0[2][2], B1[2][2];
    G8_STAGE(G8_SB(0, 0), rsB, voB, ldb, bcol, 0);
    G8_STAGE(G8_SA(0, 0), rsA, voA, lda, brow, 0);
    G8_STAGE(G8_SB(0, 1), rsB, voB, ldb, bcol + 128, 0);
    G8_STAGE(G8_SA(0, 1), rsA, voA, lda, brow + 128, 0);
    if (wr == 1) G8_BAR;
    G8_WAIT_V(4);
    G8_BAR;
    G8_STAGE(G8_SB(1, 0), rsB, voB, ldb, bcol, 1);
    G8_STAGE(G8_SA(1, 0), rsA, voA, lda, brow, 1);
    G8_STAGE(G8_SB(1, 1), rsB, voB, ldb, bcol + 128, 1);
    G8_WAIT_V(6);
    G8_BAR;
    for (int kt = 0; kt < nt - 2; kt += 2) {
      G8_LDB(B0, 0, 0); G8_SCHED; G8_LDA(At, 0, 0); G8_STAGE(G8_SA(1, 1), rsA, voA, lda, brow + 128, kt + 1);
      G8_WAIT_L(8); G8_BAR; G8_WAIT_L(0); G8_MMA(0, 0, At, B0); G8_BAR; G8_SCHED;
      G8_LDB(B1, 0, 1); G8_STAGE(G8_SB(0, 0), rsB, voB, ldb, bcol, kt + 2);
      G8_BAR; G8_WAIT_L(0); G8_MMA(0, 1, At, B1); G8_BAR;
      G8_LDA(At, 0, 1); G8_STAGE(G8_SA(0, 0), rsA, voA, lda, brow, kt + 2);
      G8_BAR; G8_WAIT_L(0); G8_MMA(1, 0, At, B0); G8_BAR; G8_SCHED;
      G8_STAGE(G8_SB(0, 1), rsB, voB, ldb, bcol + 128, kt + 2);
      G8_WAIT_V(6); G8_BAR; G8_MMA(1, 1, At, B1); G8_BAR;
      G8_LDB(B0, 1, 0); G8_SCHED; G8_LDA(At, 1, 0); G8_STAGE(G8_SA(0, 1), rsA, voA, lda, brow + 128, kt + 2);
      G8_WAIT_L(8); G8_BAR; G8_WAIT_L(0); G8_MMA(0, 0, At, B0); G8_BAR; G8_SCHED;
      G8_LDB(B1, 1, 1); G8_STAGE(G8_SB(1, 0), rsB, voB, ldb, bcol, kt + 3);
      G8_BAR; G8_WAIT_L(0); G8_MMA(0, 1, At, B1); G8_BAR;
      G8_LDA(At, 1, 1); G8_STAGE(G8_SA(1, 0), rsA, voA, lda, brow, kt + 3);
      G8_BAR; G8_WAIT_L(0); G8_MMA(1, 0, At, B0); G8_BAR; G8_SCHED;
      G8_STAGE(G8_SB(1, 1), rsB, voB, ldb, bcol + 128, kt + 3);
      G8_WAIT_V(6); G8_BAR; G8_MMA(1, 1, At, B1); G8_BAR;
    }
    {
      G8_LDB(B0, 0, 0); G8_LDA(At, 0, 0); G8_STAGE(G8_SA(1, 1), rsA, voA, lda, brow + 128, nt - 1);
      G8_BAR; G8_WAIT_L(0); G8_MMA(0, 0, At, B0); G8_BAR;
      G8_LDB(B1, 0, 1); G8_BAR; G8_WAIT_L(0); G8_MMA(0, 1, At, B1); G8_BAR;
      G8_LDA(At, 0, 1); G8_WAIT_V(4); G8_BAR; G8_WAIT_L(0); G8_MMA(1, 0, At, B0); G8_MMA(1, 1, At, B1); G8_BAR;
    }
    {
      G8_LDB(B0, 1, 0); G8_LDA(At, 1, 0); G8_WAIT_V(2); G8_BAR; G8_WAIT_L(0); G8_MMA(0, 0, At, B0); G8_BAR;
      G8_LDB(B1, 1, 1); G8_WAIT_V(0); G8_BAR; G8_WAIT_L(0); G8_MMA(0, 1, At, B1); G8_BAR;
      G8_LDA(At, 1, 1); G8_BAR; G8_WAIT_L(0); G8_MMA(1, 0, At, B0); G8_MMA(1, 1, At, B1); G8_BAR;
    }
    if (wr == 0) G8_BAR;
    constexpr bool STAGED = (EPI == EPI_RESID || EPI == EPI_RESID0 || EPI == EPI_INPROJ);
    int lane2 = lane_id();
    asm volatile("" : "+v"(lane2));
    const int fr2 = lane2 & 15, fq2 = lane2 >> 4;
    f32x4* stg = reinterpret_cast<f32x4*>(lds_all + wid * 16384);
    if constexpr (STAGED) {
#pragma unroll
      for (int b0 = 0; b0 < 2; ++b0)
#pragma unroll
        for (int m = 0; m < 4; ++m)
#pragma unroll
          for (int n = 0; n < 2; ++n) stg[(((b0 * 4 + m) * 2 + n) * 64) + lane2] = acc[0][b0][m][n];
    }
    gemm8_epilogue<EPI, STAGED>(p, acc, stg, lane2, brow, bcol, wr, wc, fr2, fq2, layer, gscale);
    asm volatile("s_waitcnt vmcnt(0)" ::: "memory");
    if constexpr (STAGED) __syncthreads();
  }
  __syncthreads();
#undef G8_SA
#undef G8_SB
#undef G8_STAGE
#undef G8_LDA
#undef G8_LDB
#undef G8_MMA
#undef G8_WAIT_V
#undef G8_WAIT_L
#undef G8_BAR
#undef G8_SCHED
}

DEVI bf16x8 scale_q(uint4 u) {
  uint4 r;
  r.x = pack2(bflo(u.x) * 0.125f, bfhi(u.x) * 0.125f);
  r.y = pack2(bflo(u.y) * 0.125f, bfhi(u.y) * 0.125f);
  r.z = pack2(bflo(u.z) * 0.125f, bfhi(u.z) * 0.125f);
  r.w = pack2(bflo(u.w) * 0.125f, bfhi(u.w) * 0.125f);
  return __builtin_bit_cast(bf16x8, r);
}
DEVI void phase_attn(PP p, int layer, bool with_ctx_q) {
  const int tid = ltid();
  const int lane = tid & 63, wid = __builtin_amdgcn_readfirstlane(tid >> 6), r = lane & 31, h = lane >> 5;
  const float* sinkp = p->attn_sink + (layer >> 1) * 8;
  const int nunits = 2048 + (with_ctx_q ? 128 : 0);
  for (int u = lbid(); u < nunits; u += lnblk()) {
    bool latent = u < 2048;
    int b, kvh, qg, tokbase;
    if (latent) {
      b = u >> 8;
      kvh = (u >> 7) & 1;
      qg = u & 127;
      tokbase = b * SEQ + qg * 32;
    } else {
      int v = u - 2048;
      b = v >> 4;
      kvh = (v >> 3) & 1;
      qg = v & 7;
      tokbase = TL + b * CTX + qg * 32;
    }
    const int hd = kvh * 4 + wid;
    const bf16_t* kb = p->kbuf + (size_t)(b * 2 + kvh) * KVLEN * 64;
    const bf16_t* vt = p->vbuf + (size_t)(b * 2 + kvh) * 64 * KVLEN;
    bf16x8 qf[4];
    {
      const bf16_t* qp = p->P + (size_t)(tokbase + r) * 2048 + hd * 64 + 8 * h;
#pragma unroll
      for (int st = 0; st < 4; ++st) qf[st] = scale_q(*reinterpret_cast<const uint4*>(qp + 16 * st));
    }
    f32x16 O0, O1;
#pragma unroll
    for (int i = 0; i < 16; ++i) {
      O0[i] = 0.f;
      O1[i] = 0.f;
    }
    float m_run = sinkp[hd];
    float l_run = (h == 0) ? 1.f : 0.f;
    const int nkb = latent ? 17 : 8;
    for (int kbi = 0; kbi < nkb; ++kbi) {
      int kpos, mode = 0;
      if (kbi < 8) {
        kpos = kbi * 32;
      } else {
        int d = kbi - 12;
        int kblk = qg + d;
        if (kblk < 0 || kblk > 127) continue;
        kpos = CTX + kblk * 32;
        mode = (d == -4) ? 1 : ((d == 4) ? 2 : 0);
      }
      f32x16 S;
#pragma unroll
      for (int i = 0; i < 16; ++i) S[i] = 0.f;
#pragma unroll
      for (int st = 0; st < 4; ++st) {
        bf16x8 kf = *reinterpret_cast<const bf16x8*>(kb + (size_t)(kpos + r) * 64 + 16 * st + 8 * h);
        S = __builtin_amdgcn_mfma_f32_32x32x16_bf16(kf, qf[st], S, 0, 0, 0);
      }
      if (mode) {
#pragma unroll
        for (int i = 0; i < 16; ++i) {
          int kk = (i & 3) + 8 * (i >> 2) + 4 * h;
          bool ok = (mode == 1) ? (kk >= r) : (kk <= r);
          if (!ok) S[i] = -1e30f;
        }
      }
      float bm = S[0];
#pragma unroll
      for (int i = 1; i < 16; ++i) bm = fmaxf(bm, S[i]);
      bm = fmaxf(bm, __shfl_xor(bm, 32));
      float m_new = fmaxf(m_run, bm);
      const float L2E = 1.4426950408889634f;
      float nm = -m_new * L2E;
      float psum = 0.f;
#pragma unroll
      for (int i = 0; i < 16; ++i) {
        S[i] = __builtin_amdgcn_exp2f(fmaf(S[i], L2E, nm));
        psum += S[i];
      }
      if (__any(m_new > m_run)) {
        float alpha = __builtin_amdgcn_exp2f((m_run - m_new) * L2E);
        l_run *= alpha;
#pragma unroll
        for (int i = 0; i < 16; ++i) {
          O0[i] *= alpha;
          O1[i] *= alpha;
        }
      }
      l_run += psum;
      m_run = m_new;
#pragma unroll
      for (int sidx = 0; sidx < 2; ++sidx) {
        uint4 pk;
        pk.x = pack2(S[8 * sidx + 0], S[8 * sidx + 1]);
        pk.y = pack2(S[8 * sidx + 2], S[8 * sidx + 3]);
        pk.z = pack2(S[8 * sidx + 4], S[8 * sidx + 5]);
        pk.w = pack2(S[8 * sidx + 6], S[8 * sidx + 7]);
        bf16x8 pf = __builtin_bit_cast(bf16x8, pk);
        bf16x8 v0 = *reinterpret_cast<const bf16x8*>(vt + (size_t)r * KVLEN + kpos + 16 * sidx + 8 * h);
        bf16x8 v1 = *reinterpret_cast<const bf16x8*>(vt + (size_t)(32 + r) * KVLEN + kpos + 16 * sidx + 8 * h);
        O0 = __builtin_amdgcn_mfma_f32_32x32x16_bf16(v0, pf, O0, 0, 0, 0);
        O1 = __builtin_amdgcn_mfma_f32_32x32x16_bf16(v1, pf, O1, 0, 0, 0);
      }
    }
    float l_tot = l_run + __shfl_xor(l_run, 32);
    float inv = 1.f / l_tot;
    bf16_t* op = p->mix + (size_t)(tokbase + r) * LDMIX + hd * 64 + 4 * h;
#pragma unroll
    for (int g4 = 0; g4 < 4; ++g4) {
      uint2 o;
      o.x = pack2(O0[4 * g4 + 0] * inv, O0[4 * g4 + 1] * inv);
      o.y = pack2(O0[4 * g4 + 2] * inv, O0[4 * g4 + 3] * inv);
      *reinterpret_cast<uint2*>(op + 8 * g4) = o;
      o.x = pack2(O1[4 * g4 + 0] * inv, O1[4 * g4 + 1] * inv);
      o.y = pack2(O1[4 * g4 + 2] * inv, O1[4 * g4 + 3] * inv);
      *reinterpret_cast<uint2*>(op + 32 + 8 * g4) = o;
    }
  }
}

DEVI void fill_tw(float2* tw, int n) {
  for (int i = ltid(); i < n; i += NTHREADS) {
    float sn, cn;
    sincospif(2.f * (float)i / (float)n, &sn, &cn);
    tw[i] = make_float2(cn, sn);
  }
  __syncthreads();
}

DEVI bf16x8 lds_col8(const bf16_t* bp, int stride) {
  unsigned e0 = bp[0], e1 = bp[stride], e2 = bp[2 * stride], e3 = bp[3 * stride];
  unsigned e4 = bp[4 * stride], e5 = bp[5 * stride], e6 = bp[6 * stride], e7 = bp[7 * stride];
  uint4 pk;
  pk.x = e0 | (e1 << 16);
  pk.y = e2 | (e3 << 16);
  pk.z = e4 | (e5 << 16);
  pk.w = e6 | (e7 << 16);
  return __builtin_bit_cast(bf16x8, pk);
}

DEVI void phase_fft_a(PP p, unsigned char* lds) {
  const int tid = ltid();
  const int lane = tid & 63, wid = __builtin_amdgcn_readfirstlane(tid >> 6), fr = lane & 15, fq = lane >> 4;
  float2* tw = reinterpret_cast<float2*>(lds + 66560);
  fill_tw(tw, 64);
  bf16x8 af[2][2];
#pragma unroll
  for (int ks = 0; ks < 2; ++ks) {
    unsigned short cr[8], ci[8];
#pragma unroll
    for (int j = 0; j < 8; ++j) {
      int n1 = 32 * ks + 8 * fq + j, k1 = 16 * wid + fr;
      float2 t = tw[(k1 * n1) & 63];
      cr[j] = f2bf(t.x);
      ci[j] = f2bf(-t.y);
    }
    uint4 a0, a1;
    a0.x = cr[0] | ((unsigned)cr[1] << 16); a0.y = cr[2] | ((unsigned)cr[3] << 16);
    a0.z = cr[4] | ((unsigned)cr[5] << 16); a0.w = cr[6] | ((unsigned)cr[7] << 16);
    a1.x = ci[0] | ((unsigned)ci[1] << 16); a1.y = ci[2] | ((unsigned)ci[3] << 16);
    a1.z = ci[4] | ((unsigned)ci[5] << 16); a1.w = ci[6] | ((unsigned)ci[7] << 16);
    af[0][ks] = __builtin_bit_cast(bf16x8, a0);
    af[1][ks] = __builtin_bit_cast(bf16x8, a1);
  }
  const bf16_t* l16 = reinterpret_cast<const bf16_t*>(lds);
  for (int u = lbid(); u < NB * 64; u += lnblk()) {
    int b = u >> 6, n2 = u & 63;
    __syncthreads();
#pragma unroll
    for (int i = 0; i < 16; ++i) {
      int row = (tid >> 6) + 4 * i, piece = tid & 63;
      uint4 v = *reinterpret_cast<const uint4*>(p->P + (size_t)(b * SEQ + 64 * row + n2) * 2048 + 768 + piece * 8);
      *reinterpret_cast<uint4*>(lds + row * 1040 + piece * 16) = v;
    }
    __syncthreads();
    float tc[4], ts[4];
#pragma unroll
    for (int j = 0; j < 4; ++j) sincospif((float)(n2 * (16 * wid + 4 * fq + j)) / 2048.f, &ts[j], &tc[j]);
    for (int nb = 0; nb < 4; ++nb) {
      f32x4 acc[2][8];
#pragma unroll
      for (int n = 0; n < 8; ++n) {
        acc[0][n] = f32x4{0.f, 0.f, 0.f, 0.f};
        acc[1][n] = f32x4{0.f, 0.f, 0.f, 0.f};
      }
#pragma unroll
      for (int ks = 0; ks < 2; ++ks)
#pragma unroll
        for (int nf = 0; nf < 8; ++nf) {
          bf16x8 bfr = lds_col8(l16 + (32 * ks + 8 * fq) * 520 + 128 * nb + 16 * nf + fr, 520);
          acc[0][nf] = __builtin_amdgcn_mfma_f32_16x16x32_bf16(af[0][ks], bfr, acc[0][nf], 0, 0, 0);
          acc[1][nf] = __builtin_amdgcn_mfma_f32_16x16x32_bf16(af[1][ks], bfr, acc[1][nf], 0, 0, 0);
        }
#pragma unroll
      for (int j = 0; j < 4; ++j) {
        int k1 = 16 * wid + 4 * fq + j;
        bf16_t* o = p->fa + (size_t)(b * SEQ + k1 * 64 + n2) * 1024 + 128 * nb + fr;
#pragma unroll
        for (int nf = 0; nf < 8; ++nf) {
          float re = acc[0][nf][j], im = acc[1][nf][j];
          o[16 * nf] = f2bf(re * tc[j] + im * ts[j]);
          o[512 + 16 * nf] = f2bf(im * tc[j] - re * ts[j]);
        }
      }
    }
  }
  __syncthreads();
}

DEVI void phase_fft_b(PP p, unsigned char* lds) {
  const int tid = ltid();
  const int lane = tid & 63, wid = __builtin_amdgcn_readfirstlane(tid >> 6), fr = lane & 15, fq = lane >> 4;
  float2* tw = reinterpret_cast<float2*>(lds + 67584);
  fill_tw(tw, 64);
  bf16x8 wb[2][4];
#pragma unroll
  for (int ks = 0; ks < 4; ++ks) {
    unsigned short zr[8], zi[8];
#pragma unroll
    for (int j = 0; j < 8; ++j) {
      int k = 32 * ks + 8 * fq + j, part = k >> 6, n2 = k & 63, k2 = 16 * wid + fr;
      float2 t = tw[(k2 * n2) & 63];
      zr[j] = f2bf(part ? t.y : t.x);
      zi[j] = f2bf(part ? t.x : -t.y);
    }
    uint4 a0, a1;
    a0.x = zr[0] | ((unsigned)zr[1] << 16); a0.y = zr[2] | ((unsigned)zr[3] << 16);
    a0.z = zr[4] | ((unsigned)zr[5] << 16); a0.w = zr[6] | ((unsigned)zr[7] << 16);
    a1.x = zi[0] | ((unsigned)zi[1] << 16); a1.y = zi[2] | ((unsigned)zi[3] << 16);
    a1.z = zi[4] | ((unsigned)zi[5] << 16); a1.w = zi[6] | ((unsigned)zi[7] << 16);
    wb[0][ks] = __builtin_bit_cast(bf16x8, a0);
    wb[1][ks] = __builtin_bit_cast(bf16x8, a1);
  }
  const bf16_t* l16 = reinterpret_cast<const bf16_t*>(lds);
  const float scale = 0.0013810679320049757f;
  for (int u = lbid(); u < NB * 128; u += lnblk()) {
    int b = u >> 7, k1 = (u >> 1) & 63, hf = u & 1;
    __syncthreads();
#pragma unroll
    for (int i = 0; i < 16; ++i) {
      int row = (tid >> 5) + 8 * i, piece = tid & 31;
      int part = row >> 6, n2 = row & 63;
      uint4 v = *reinterpret_cast<const uint4*>(p->fa + (size_t)(b * SEQ + k1 * 64 + n2) * 1024 + part * 512 + hf * 256 + piece * 8);
      *reinterpret_cast<uint4*>(lds + row * 528 + piece * 16) = v;
    }
    __syncthreads();
    for (int nb = 0; nb < 2; ++nb) {
      f32x4 acc[2][8];
#pragma unroll
      for (int n = 0; n < 8; ++n) {
        acc[0][n] = f32x4{0.f, 0.f, 0.f, 0.f};
        acc[1][n] = f32x4{0.f, 0.f, 0.f, 0.f};
      }
#pragma unroll
      for (int ks = 0; ks < 4; ++ks)
#pragma unroll
        for (int nf = 0; nf < 8; ++nf) {
          bf16x8 bfr = lds_col8(l16 + (32 * ks + 8 * fq) * 264 + 128 * nb + 16 * nf + fr, 264);
          acc[0][nf] = __builtin_amdgcn_mfma_f32_16x16x32_bf16(wb[0][ks], bfr, acc[0][nf], 0, 0, 0);
          acc[1][nf] = __builtin_amdgcn_mfma_f32_16x16x32_bf16(wb[1][ks], bfr, acc[1][nf], 0, 0, 0);
        }
#pragma unroll
      for (int j = 0; j < 4; ++j) {
        int k2 = 16 * wid + 4 * fq + j;
        bf16_t* o = p->mix + (size_t)(b * SEQ + k1 + 64 * k2) * LDMIX + 512 + hf * 256 + 128 * nb + fr;
#pragma unroll
        for (int nf = 0; nf < 8; ++nf) {
          o[16 * nf] = f2bf(acc[0][nf][j] * scale);
          o[512 + 16 * nf] = f2bf(acc[1][nf][j] * scale);
        }
      }
    }
  }
  __syncthreads();
}

DEVI void phase_dft_ctx(PP p, unsigned char* lds) {
  float2* tw = reinterpret_cast<float2*>(lds);
  fill_tw(tw, 256);
  int tid = ltid();
  const float scale = 0.005524271728019903f;
  for (int u = lbid(); u < NB * 64; u += lnblk()) {
    int b = u >> 6, k0 = (u & 63) * 4;
    for (int pass = 0; pass < 2; ++pass) {
      int ch = tid + pass * 256;
      float zr[4], zi[4];
#pragma unroll
      for (int kk = 0; kk < 4; ++kk) zr[kk] = zi[kk] = 0.f;
#pragma unroll 8
      for (int n = 0; n < 256; ++n) {
        float v = bf2f(p->P[(size_t)(TL + b * CTX + n) * 2048 + 768 + ch]);
#pragma unroll
        for (int kk = 0; kk < 4; ++kk) {
          float2 t = tw[(n * (k0 + kk)) & 255];
          zr[kk] += v * t.x;
          zi[kk] -= v * t.y;
        }
      }
#pragma unroll
      for (int kk = 0; kk < 4; ++kk) {
        bf16_t* o = p->mix + (size_t)(TL + b * CTX + k0 + kk) * LDMIX;
        o[512 + ch] = f2bf(zr[kk] * scale);
        o[1024 + ch] = f2bf(zi[kk] * scale);
      }
    }
  }
  __syncthreads();
}

DEVI void phase_sgu(PP p, int j, int nchunks, unsigned char* lds) {
  float* rs = reinterpret_cast<float*>(lds);
  const int tid = ltid();
  const int lane = tid & 63, wid = __builtin_amdgcn_readfirstlane(tid >> 6), fr = lane & 15, fq = lane >> 4;
  const float* nw = p->gs_norm_w + j * 1024;
  for (int u = lbid(); u < nchunks * 8; u += lnblk()) {
    const int chunk = u >> 3, g = u & 7;
    const int tok0 = chunk * 128;
    const bf16_t* vT = p->zvT + (size_t)chunk * 1024 * 128;
    if (tid < 128) {
      const float* rp = p->rowss + (size_t)chunk * 32 * 128 + tid;
      float ss = 0.f;
#pragma unroll
      for (int sl = 0; sl < 32; ++sl) ss += rp[sl * 128];
      rs[tid] = rsqrtf(ss * (1.f / 1024.f) + 1e-6f);
    }
    __syncthreads();
    const float* wsg = p->gs_w_s + ((size_t)j * 8 + g) * 128 * 128;
    const float* bsg = p->gs_b_s + ((size_t)j * 8 + g) * 128;
    f32x4 acc[2][8];
#pragma unroll
    for (int m = 0; m < 2; ++m)
#pragma unroll
      for (int n = 0; n < 8; ++n) acc[m][n] = f32x4{0.f, 0.f, 0.f, 0.f};
#pragma unroll
    for (int ks = 0; ks < 4; ++ks) {
      bf16x8 a[2];
      const float* rsk = rs + 32 * ks + 8 * fq;
#pragma unroll
      for (int m = 0; m < 2; ++m) {
        const float4* wp = reinterpret_cast<const float4*>(wsg + (size_t)(32 * wid + 16 * m + fr) * 128 + 32 * ks + 8 * fq);
        float4 w0 = wp[0], w1 = wp[1];
        uint4 pk;
        pk.x = pack2(w0.x * rsk[0], w0.y * rsk[1]);
        pk.y = pack2(w0.z * rsk[2], w0.w * rsk[3]);
        pk.z = pack2(w1.x * rsk[4], w1.y * rsk[5]);
        pk.w = pack2(w1.z * rsk[6], w1.w * rsk[7]);
        a[m] = __builtin_bit_cast(bf16x8, pk);
      }
#pragma unroll
      for (int n = 0; n < 8; ++n) {
        bf16x8 bfr = *reinterpret_cast<const bf16x8*>(vT + (size_t)(g * 128 + 16 * n + fr) * 128 + 32 * ks + 8 * fq);
        acc[0][n] = __builtin_amdgcn_mfma_f32_16x16x32_bf16(a[0], bfr, acc[0][n], 0, 0, 0);
        acc[1][n] = __builtin_amdgcn_mfma_f32_16x16x32_bf16(a[1], bfr, acc[1][n], 0, 0, 0);
      }
    }
#pragma unroll
    for (int m = 0; m < 2; ++m)
#pragma unroll
      for (int jj = 0; jj < 4; ++jj) {
        int pp = 32 * wid + 16 * m + 4 * fq + jj;
        float bias = bsg[pp];
        const bf16_t* up = p->P + (size_t)(tok0 + pp) * 2048 + g * 128 + fr;
        bf16_t* op = p->mix + (size_t)(tok0 + pp) * LDMIX + g * 128 + fr;
#pragma unroll
        for (int n = 0; n < 8; ++n) {
          float sv = nw[g * 128 + 16 * n + fr] * acc[m][n][jj] + bias;
          op[16 * n] = f2bf(bf2f(up[16 * n]) * sv);
        }
      }
    __syncthreads();
  }
}

DEVI float mkkey(float v, unsigned idx, unsigned mask) { return __uint_as_float((__float_as_uint(v) & ~mask) | idx); }
#define INSERT16(list, x)                                                                                               \
  {                                                                                                                     \
    _Pragma("unroll") for (int i_ = 15; i_ >= 1; --i_) list[i_] = __builtin_amdgcn_fmed3f(list[i_ - 1], list[i_], x); \
    list[0] = fmaxf(list[0], x);                                                                                        \
  }

DEVI void phase_route(PP p, int layer, int ntok, unsigned char* lds) {
  const int tid = ltid();
  const int lane = tid & 63, wid = __builtin_amdgcn_readfirstlane(tid >> 6), fr = lane & 15, fq = lane >> 4;
  const int nb8 = lnblk() >> 3, bid = lbid();
  const int hh = bid & 7, slot = bid >> 3;
  const int ntiles = ntok / 64;
  const bool active = slot < nb8;
  float* sc = reinterpret_cast<float*>(lds + 32768);
  const float NEGK = -3.0e38f;
  for (int half = 0; half < 2; ++half) {
    __syncthreads();
    {
      const bf16_t* ksrc = p->keysb + ((size_t)((layer * 8 + hh) * 2 + half) * 128) * 128;
#pragma unroll
      for (int i = 0; i < 8; ++i) {
        int idx = tid + 256 * i, row = idx >> 4, c = idx & 15;
        uint4 v = *reinterpret_cast<const uint4*>(ksrc + (size_t)row * 128 + c * 8);
        *reinterpret_cast<uint4*>(lds + row * 256 + ((c ^ (row & 15)) << 4)) = v;
      }
    }
    __syncthreads();
    bf16x8 an[4];
    if (active && slot < ntiles) {
      const bf16_t* qa = p->P + (size_t)(slot * 64 + wid * 16 + fr) * 2048 + hh * 256 + half * 128 + fq * 8;
#pragma unroll
      for (int ks = 0; ks < 4; ++ks) an[ks] = *reinterpret_cast<const bf16x8*>(qa + ks * 32);
    }
    for (int tt = slot; active && tt < ntiles; tt += nb8) {
      const int tok0 = tt * 64;
      {
        bf16x8 a[4];
#pragma unroll
        for (int ks = 0; ks < 4; ++ks) a[ks] = an[ks];
        {
          const int ttn = (tt + nb8 < ntiles) ? tt + nb8 : tt;
          const bf16_t* qa = p->P + (size_t)(ttn * 64 + wid * 16 + fr) * 2048 + hh * 256 + half * 128 + fq * 8;
#pragma unroll
          for (int ks = 0; ks < 4; ++ks) an[ks] = *reinterpret_cast<const bf16x8*>(qa + ks * 32);
        }
#pragma unroll
        for (int nf = 0; nf < 8; ++nf) {
          f32x4 acc = f32x4{0.f, 0.f, 0.f, 0.f};
          const int krow = nf * 16 + fr;
#pragma unroll
          for (int ks = 0; ks < 4; ++ks) {
            bf16x8 bb = *reinterpret_cast<const bf16x8*>(lds + krow * 256 + (((4 * ks + fq) ^ (krow & 15)) << 4));
            acc = __builtin_amdgcn_mfma_f32_16x16x32_bf16(a[ks], bb, acc, 0, 0, 0);
          }
#pragma unroll
          for (int j = 0; j < 4; ++j) sc[(wid * 16 + fq * 4 + j) * 129 + krow] = mkkey(acc[j], (unsigned)krow, 127u);
        }
      }
      __syncthreads();
      const int row = tid & 63, part = tid >> 6;
      float list[16];
#pragma unroll
      for (int i = 0; i < 16; ++i) list[i] = NEGK;
      {
        const float* kr = sc + row * 129 + part * 32;
#pragma unroll 4
        for (int e = 0; e < 32; ++e) {
          float x = kr[e];
          INSERT16(list, x)
        }
      }
      __syncthreads();
      if (part & 1) {
#pragma unroll
        for (int i = 0; i < 16; ++i) sc[(row * 2 + (part >> 1)) * 17 + i] = list[i];
      }
      __syncthreads();
      if (!(part & 1)) {
#pragma unroll
        for (int i = 0; i < 16; ++i) {
          float x = sc[(row * 2 + (part >> 1)) * 17 + i];
          INSERT16(list, x)
        }
      }
      __syncthreads();
      if (part == 2) {
#pragma unroll
        for (int i = 0; i < 16; ++i) sc[row * 17 + i] = list[i];
      }
      __syncthreads();
      if (part == 0) {
#pragma unroll
        for (int i = 0; i < 16; ++i) {
          float x = sc[row * 17 + i];
          INSERT16(list, x)
        }
        float4* o = reinterpret_cast<float4*>(p->tops + ((size_t)(tok0 + row) * 16 + hh * 2 + half) * 16);
        o[0] = make_float4(list[0], list[1], list[2], list[3]);
        o[1] = make_float4(list[4], list[5], list[6], list[7]);
        o[2] = make_float4(list[8], list[9], list[10], list[11]);
        o[3] = make_float4(list[12], list[13], list[14], list[15]);
      }
      __syncthreads();
    }
  }
  __syncthreads();
  float* fl = reinterpret_cast<float*>(lds);
  for (int t4 = slot; active && t4 < ntiles + 3 * nb8; t4 += 4 * nb8) {
    const int tt = t4 + (tid >> 6) * nb8;
    if (tt < ntiles) {
      const int tok = tt * 64 + (tid & 63);
      const float4* src = reinterpret_cast<const float4*>(p->tops + ((size_t)tok * 16 + hh * 2) * 16);
      float v0[16], v1[16];
#pragma unroll
      for (int i = 0; i < 4; ++i) {
        float4 a = src[i], bq = src[4 + i];
        v0[4 * i] = a.x; v0[4 * i + 1] = a.y; v0[4 * i + 2] = a.z; v0[4 * i + 3] = a.w;
        v1[4 * i] = bq.x; v1[4 * i + 1] = bq.y; v1[4 * i + 2] = bq.z; v1[4 * i + 3] = bq.w;
      }
      float* f0 = fl + tid * 33;
      float* f1 = f0 + 16;
#pragma unroll
      for (int i = 0; i < 16; ++i) {
        f0[i] = v0[i];
        f1[i] = v1[i];
      }
      float l2[16];
#pragma unroll
      for (int i = 0; i < 16; ++i) l2[i] = mkkey(v0[0] + v1[i], (unsigned)(15 - i), 255u);
#pragma unroll
      for (int a = 1; a < 16; ++a)
#pragma unroll
        for (int bq = 0; bq < 16; ++bq)
          if ((a + 1) * (bq + 1) <= 16) {
            float x = mkkey(v0[a] + v1[bq], (unsigned)(a * 16 + 15 - bq), 255u);
            INSERT16(l2, x)
          }
      float sv[16];
      int ev[16];
      float mx = NEGK;
#pragma unroll
      for (int k = 0; k < 16; ++k) {
        unsigned ab = __float_as_uint(l2[k]) & 255u;
        unsigned k0 = __float_as_uint(f0[ab >> 4]), k1 = __float_as_uint(f1[15u - (ab & 15u)]);
        sv[k] = __uint_as_float(k0 & ~127u) + __uint_as_float(k1 & ~127u);
        ev[k] = (int)((k0 & 127u) * 128u + (k1 & 127u));
        mx = fmaxf(mx, sv[k]);
      }
      float sum = 0.f;
#pragma unroll
      for (int k = 0; k < 16; ++k) {
        sv[k] = __expf(sv[k] - mx);
        sum += sv[k];
      }
      float inv = 1.f / sum;
      size_t o = (size_t)tok * 128 + hh * 16;
      int4* eo = reinterpret_cast<int4*>(p->eidx + o);
      float4* go = reinterpret_cast<float4*>(p->gate + o);
#pragma unroll
      for (int k4 = 0; k4 < 4; ++k4) {
        eo[k4] = make_int4(ev[4 * k4], ev[4 * k4 + 1], ev[4 * k4 + 2], ev[4 * k4 + 3]);
        go[k4] = make_float4(sv[4 * k4] * inv, sv[4 * k4 + 1] * inv, sv[4 * k4 + 2] * inv, sv[4 * k4 + 3] * inv);
      }
    }
  }
  __syncthreads();
}

typedef float v2f __attribute__((ext_vector_type(2)));
DEVI void dec16(uint4 q, v2f* f) {
  f[0] = __builtin_amdgcn_cvt_pk_f32_fp8((int)q.x, false);
  f[1] = __builtin_amdgcn_cvt_pk_f32_fp8((int)q.x, true);
  f[2] = __builtin_amdgcn_cvt_pk_f32_fp8((int)q.y, false);
  f[3] = __builtin_amdgcn_cvt_pk_f32_fp8((int)q.y, true);
  f[4] = __builtin_amdgcn_cvt_pk_f32_fp8((int)q.z, false);
  f[5] = __builtin_amdgcn_cvt_pk_f32_fp8((int)q.z, true);
  f[6] = __builtin_amdgcn_cvt_pk_f32_fp8((int)q.w, false);
  f[7] = __builtin_amdgcn_cvt_pk_f32_fp8((int)q.w, true);
}
struct ExpBuf {
  uint4 q[8];
  uint4 h0, h1;
};
DEVI void exp_load(ExpBuf& B, const unsigned char* tab, const signed char* hrow, const unsigned short* idp, int j8, bool want_x) {
  const uint4 idv = *reinterpret_cast<const uint4*>(idp);
  const unsigned idw[4] = {idv.x, idv.y, idv.z, idv.w};
#pragma unroll
  for (int i = 0; i < 8; ++i) {
    unsigned e = (i & 1) ? (idw[i >> 1] >> 16) : (idw[i >> 1] & 0xffffu);
    unsigned off = e * (unsigned)D + 16u * j8;
    B.q[i] = *reinterpret_cast<const uint4*>(tab + off);
  }
  if (want_x) B.h0 = *reinterpret_cast<const uint4*>(hrow + 16 * j8);
}
template <int CTRL>
DEVI int dpp_movi(int v) { return __builtin_amdgcn_mov_dpp(v, CTRL, 0xF, 0xF, true); }
DEVI void exp_u_compute(const ExpBuf& B, int* pp, int j8) {
  int s0 = 0;
#pragma unroll
  for (int i = 0; i < 8; ++i) {
    int d = __builtin_amdgcn_sdot4((int)B.q[i].x, (int)B.h0.x, 0, false);
    d = __builtin_amdgcn_sdot4((int)B.q[i].y, (int)B.h0.y, d, false);
    d = __builtin_amdgcn_sdot4((int)B.q[i].z, (int)B.h0.z, d, false);
    d = __builtin_amdgcn_sdot4((int)B.q[i].w, (int)B.h0.w, d, false);
    d += dpp_movi<0xB1>(d);
    d += dpp_movi<0x4E>(d);
    d += dpp_movi<0x141>(d);
    s0 = (j8 == i) ? d : s0;
  }
  pp[0] += s0;
}
DEVI void exp_v_accum(const ExpBuf& B, unsigned w0, unsigned w1, int* acc) {
#pragma unroll
  for (int ig = 0; ig < 2; ++ig) {
    const unsigned wq = ig ? w1 : w0;
    const uint4 R0 = B.q[4 * ig], R1 = B.q[4 * ig + 1], R2 = B.q[4 * ig + 2], R3 = B.q[4 * ig + 3];
    const unsigned r0[4] = {R0.x, R0.y, R0.z, R0.w}, r1[4] = {R1.x, R1.y, R1.z, R1.w};
    const unsigned r2[4] = {R2.x, R2.y, R2.z, R2.w}, r3[4] = {R3.x, R3.y, R3.z, R3.w};
#pragma unroll
    for (int q = 0; q < 4; ++q) {
      unsigned A = __builtin_amdgcn_perm(r1[q], r0[q], 0x05010400u);
      unsigned Bq = __builtin_amdgcn_perm(r1[q], r0[q], 0x07030602u);
      unsigned C = __builtin_amdgcn_perm(r3[q], r2[q], 0x05010400u);
      unsigned E = __builtin_amdgcn_perm(r3[q], r2[q], 0x07030602u);
      unsigned D0 = __builtin_amdgcn_perm(C, A, 0x05040100u);
      unsigned D1 = __builtin_amdgcn_perm(C, A, 0x07060302u);
      unsigned D2 = __builtin_amdgcn_perm(E, Bq, 0x05040100u);
      unsigned D3 = __builtin_amdgcn_perm(E, Bq, 0x07060302u);
      acc[4 * q + 0] = __builtin_amdgcn_sdot4((int)D0, (int)wq, acc[4 * q + 0], false);
      acc[4 * q + 1] = __builtin_amdgcn_sdot4((int)D1, (int)wq, acc[4 * q + 1], false);
      acc[4 * q + 2] = __builtin_amdgcn_sdot4((int)D2, (int)wq, acc[4 * q + 2], false);
      acc[4 * q + 3] = __builtin_amdgcn_sdot4((int)D3, (int)wq, acc[4 * q + 3], false);
    }
  }
}
DEVI void exp_v_finish(float4* xo, const float4* xq, const float4* gq, int* acc, float swt, int grp, float gscale) {
  float o[16];
#pragma unroll
  for (int k = 0; k < 16; ++k) {
    int a = acc[k];
    a += dpp_movi<0x128>(a);
    a += __shfl_xor(a, 16);
    a += __shfl_xor(a, 32);
    o[k] = (float)a;
    acc[k] = 0;
  }
  if (grp == 0) {
    const float sc = gscale * swt;
#pragma unroll
    for (int i4 = 0; i4 < 4; ++i4) {
      float4 r = xq[i4];
      r.x += sc * gq[i4].x * o[i4 * 4 + 0];
      r.y += sc * gq[i4].y * o[i4 * 4 + 1];
      r.z += sc * gq[i4].z * o[i4 * 4 + 2];
      r.w += sc * gq[i4].w * o[i4 * 4 + 3];
      xo[i4] = r;
    }
  }
}
DEVI void phase_expert(PP p, int layer, int ntok, unsigned char* lds, float gscale = 1.f, int idmask = 0xffff) {
  const int tid = ltid();
  const int lane = tid & 63, wid = __builtin_amdgcn_readfirstlane(tid >> 6), j8 = lane & 7, grp = lane >> 3;
  const int nb = lnblk(), bid = lbid();
  unsigned short* ids = reinterpret_cast<unsigned short*>(lds);
  float* part = reinterpret_cast<float*>(lds + TPB * 128 * 2);
  unsigned char* w8 = lds + TPB * 128 * 2 + TPB * 128 * 4;
  float* swl = reinterpret_cast<float*>(lds + TPB * 128 * 2 + TPB * 128 * 4 + TPB * 128);
  const unsigned char* ut = p->utab + (size_t)layer * NEXP * D;
  const unsigned char* vt = p->vtab + (size_t)layer * NEXP * D;
  int tpb = (ntok + nb - 1) / nb;
  if (tpb > TPB) tpb = TPB;
  const int npass = (ntok + nb * tpb - 1) / (nb * tpb);
  for (int pass = 0; pass < npass; ++pass) {
    const int tok0 = (pass * nb + bid) * tpb;
    int cnt = ntok - tok0;
    if (cnt > tpb) cnt = tpb;
    if (cnt < 0) cnt = 0;
    for (int i = tid; i < cnt * 128; i += NTHREADS) {
      {
        int k = i & 127, hf = k >> 6, kk = k & 63;
        ids[(i & ~127) + hf * 64 + (kk & 7) * 8 + (kk >> 3)] = (unsigned short)(p->eidx[(size_t)tok0 * 128 + i] & idmask);
      }
      part[i] = 0.f;
    }
    __syncthreads();
    const int ntw = (cnt - wid + 3) >> 2;
    const int npair = ntw * 8;

    if (!(REP_MODE == 1 && gscale != 1.f)) {
      ExpBuf B0, B1;
      int c0 = 0, k0 = 0;
      if (npair > 0) {
        const int t0 = wid;
        exp_load(B0, ut, p->h8 + (size_t)(tok0 + t0) * D, ids + t0 * 128 + grp * 8, j8, true);
      }
      for (int pr = 0; pr < npair; ++pr) {
        const int t0 = wid + 4 * k0;
        exp_load(B1, ut + 128 * c0, p->h8 + (size_t)(tok0 + t0) * D + 128 * c0, ids + t0 * 128 + 64 + grp * 8, j8, true);
        exp_u_compute(B0, reinterpret_cast<int*>(part) + t0 * 128 + 8 * j8 + grp, j8);
        int c1 = c0, k1 = k0;
        if (pr + 1 < npair) {
          k1 = k0 + 1;
          if (k1 == ntw) {
            k1 = 0;
            c1 = c0 + 1;
          }
        }
        {
          const int t1 = wid + 4 * k1;
          exp_load(B0, ut + 128 * c1, p->h8 + (size_t)(tok0 + t1) * D + 128 * c1, ids + t1 * 128 + grp * 8, j8, true);
        }
        exp_u_compute(B1, reinterpret_cast<int*>(part) + t0 * 128 + 64 + 8 * j8 + grp, j8);
        c0 = c1;
        k0 = k1;
      }
    }
    __syncthreads();
    for (int t = wid; t < cnt; t += 4) {
      float wv2[2];
      float am = 0.f;
#pragma unroll
      for (int hh = 0; hh < 2; ++hh) {
        int k = lane + 64 * hh;
        int e = ids[t * 128 + hh * 64 + (lane & 7) * 8 + (lane >> 3)];
        float dq = (float)reinterpret_cast<int*>(part)[t * 128 + k] * p->su[(size_t)layer * NEXP + e] * p->sx[tok0 + t];
        float wv = p->gate[(size_t)(tok0 + t) * 128 + k] * gelu_tanh(dq) * p->sv[(size_t)layer * NEXP + e];
        wv2[hh] = wv;
        am = fmaxf(am, fabsf(wv));
      }
      am = fmaxf(wave_max(am), 1e-30f);
      float qs = 127.f / am;
#pragma unroll
      for (int hh = 0; hh < 2; ++hh) {
        int k = lane + 64 * hh;
        int q = (int)rintf(wv2[hh] * qs);
        w8[t * 128 + (k & 7) * 16 + hh * 8 + ((k >> 3) & 7)] = (unsigned char)(q & 255);
      }
      if (lane == 0) swl[t] = am * (1.f / 127.f);
    }
    __syncthreads();
    if (!(REP_MODE == 2 && gscale != 1.f)) {
      ExpBuf B0, B1;
      int acc[16];
#pragma unroll
      for (int k = 0; k < 16; ++k) acc[k] = 0;
      int c0 = 0, k0 = 0;
      if (npair > 0) {
        const int t0 = wid;
        exp_load(B0, vt, (const signed char*)nullptr, ids + t0 * 128 + grp * 8, j8, false);
      }
      for (int pr = 0; pr < npair; ++pr) {
        const int t0 = wid + 4 * k0;
        float4 xq[4], gq[4];
        float4* xo = reinterpret_cast<float4*>(p->xs + (size_t)(tok0 + t0) * D + 128 * c0 + 16 * j8);
        {
          const float4* gf = reinterpret_cast<const float4*>(p->mod + ((size_t)layer * 9 + tok_batch(tok0 + t0)) * 6144 + 5 * 1024 + 128 * c0 + 16 * j8);
#pragma unroll
          for (int i4 = 0; i4 < 4; ++i4) {
            xq[i4] = xo[i4];
            gq[i4] = gf[i4];
          }
        }
        exp_load(B1, vt + 128 * c0, (const signed char*)nullptr, ids + t0 * 128 + 64 + grp * 8, j8, false);
        const uint4 wq = *reinterpret_cast<const uint4*>(w8 + t0 * 128 + grp * 16);
        exp_v_accum(B0, wq.x, wq.y, acc);
        int c1 = c0, k1 = k0;
        if (pr + 1 < npair) {
          k1 = k0 + 1;
          if (k1 == ntw) {
            k1 = 0;
            c1 = c0 + 1;
          }
        }
        {
          const int t1 = wid + 4 * k1;
          exp_load(B0, vt + 128 * c1, (const signed char*)nullptr, ids + t1 * 128 + grp * 8, j8, false);
        }
        exp_v_accum(B1, wq.z, wq.w, acc);
        exp_v_finish(xo, xq, gq, acc, swl[t0], grp, gscale);
        c0 = c1;
        k0 = k1;
      }
    }
    asm volatile("s_waitcnt vmcnt(0)" ::: "memory");
    __syncthreads();
    if (gscale == 1.f) {
      for (int t = wid; t < cnt; t += 4) {
        if (layer + 1 < DEPTH) norm_row(p, layer + 1, 0, tok0 + t, lane);
        else if (tok0 + t < TL) norm_row(p, 0, 2, tok0 + t, lane);
      }
    }
    __syncthreads();
  }
}

#define XB_TMO 128
#define XB_XCNT(j) (256 + 64 * (j))
#define XB_XSUB(j) (1280 + 64 * (j))
#define XB_XGEN(j) (2304 + 64 * (j))
#define XB_TOP 3328
#define XB_TOPGEN 3392
#define XCD_BAR_WORDS 3456
#define XB_SPIN_CAP (1u << 22)
#define LAS __attribute__((address_space(3)))
DEVI unsigned xb_ld(unsigned* p) { return __hip_atomic_load(p, __ATOMIC_RELAXED, __HIP_MEMORY_SCOPE_AGENT); }
DEVI unsigned xb_add(unsigned* p, unsigned v) { return __hip_atomic_fetch_add(p, v, __ATOMIC_RELAXED, __HIP_MEMORY_SCOPE_AGENT); }
DEVI unsigned xb_xcc_id() { return (unsigned)__builtin_amdgcn_s_getreg((3 << 11) | 20) & 0xFu; }
#define XB_SPIN(cond, bar)                                   \
  do {                                                       \
    unsigned _sp = 0;                                        \
    while (cond) {                                           \
      __builtin_amdgcn_s_sleep(1);                           \
      if ((++_sp & 255u) == 0u) {                            \
        if (xb_ld(&(bar)[XB_TMO])) break;                    \
        if (_sp > XB_SPIN_CAP) {                             \
          atomicAdd(&(bar)[XB_TMO], 1u);                     \
          break;                                             \
        }                                                    \
      }                                                      \
    }                                                        \
  } while (0)
struct XcdBarrier {
  unsigned* bar;
  unsigned x;
  volatile LAS unsigned* st;
};
DEVI XcdBarrier xcd_barrier_post(unsigned* bar, volatile LAS unsigned* st) {
  XcdBarrier b;
  b.bar = bar;
  b.x = xb_xcc_id();
  b.st = st;
  if (threadIdx.x == 0) (void)xb_add(&bar[XB_XCNT(b.x)], 1u);
  return b;
}
DEVI void xcd_barrier_complete(unsigned* bar, unsigned x, unsigned& nloc, unsigned& nx) {
  const unsigned G = gridDim.x * gridDim.y * gridDim.z;
  unsigned sum, cnt, mine, sp = 0u;
  for (;;) {
    sum = 0u;
    cnt = 0u;
    mine = 0u;
#pragma unroll
    for (unsigned j = 0; j < 16; ++j) {
      const unsigned c = xb_ld(&bar[XB_XCNT(j)]);
      sum += c;
      cnt += (c > 0u) ? 1u : 0u;
      mine = (j == x) ? c : mine;
    }
    if (sum == G) break;
    __builtin_amdgcn_s_sleep(1);
    if ((++sp & 255u) == 0u) {
      if (xb_ld(&bar[XB_TMO])) break;
      if (sp > XB_SPIN_CAP) {
        atomicAdd(&bar[XB_TMO], 1u);
        break;
      }
    }
  }
  nloc = mine > 0u ? mine : 1u;
  nx = cnt > 0u ? cnt : 1u;
}
DEVI void xcd_barrier(const XcdBarrier& b) {
  asm volatile("s_waitcnt vmcnt(0)" ::: "memory");
  __syncthreads();
  if (threadIdx.x == 0) {
    unsigned* bar = b.bar;
    __builtin_amdgcn_s_waitcnt(0);
    unsigned nloc = b.st[0], nx = b.st[1];
    if (nloc == 0u) {
      xcd_barrier_complete(bar, b.x, nloc, nx);
      b.st[0] = nloc;
      b.st[1] = nx;
    }
    const unsigned old = xb_add(&bar[XB_XSUB(b.x)], 1u);
    const unsigned gen = old / nloc;
    if (old + 1u == (gen + 1u) * nloc) {
      __builtin_amdgcn_fence(__ATOMIC_RELEASE, "agent");
      asm volatile("s_waitcnt vmcnt(0)" ::: "memory");
      const unsigned og = xb_add(&bar[XB_TOP], 1u);
      const unsigned tg = og / nx;
      if (og + 1u == (tg + 1u) * nx) xb_add(&bar[XB_TOPGEN], 1u);
      else XB_SPIN(xb_ld(&bar[XB_TOPGEN]) == tg, bar);
      __builtin_amdgcn_fence(__ATOMIC_ACQUIRE, "agent");
      xb_add(&bar[XB_XGEN(b.x)], 1u);
      asm volatile("s_waitcnt vmcnt(0)" ::: "memory");
    } else {
      XB_SPIN(xb_ld(&bar[XB_XGEN(b.x)]) == gen, bar);
      __builtin_amdgcn_fence(__ATOMIC_ACQUIRE, "agent");
      asm volatile("s_waitcnt vmcnt(0)" ::: "memory");
    }
  }
  __syncthreads();
}

DEVI bool step_active(int step) {
  if (step == 0) return true;
  if (step == NSTEPS - 1) return false;
  int layer = (step - 1) / STEPS_PER_LAYER, ph = (step - 1) % STEPS_PER_LAYER;
  if (ph == 3 && (layer & 1)) return false;
  if (ph == 0 && layer > 0) return false;
  return true;
}

DEVI void run_step(PP p, int step, unsigned char* lds, unsigned char* lds_all, float gscale = 1.f) {
  if (step == 0) {
    phase_prep(p, lds);
    return;
  }
  if (step == NSTEPS - 1) {
    phase_norm(p, 0, 2, TL);
    return;
  }
  int layer = (step - 1) / STEPS_PER_LAYER, ph = (step - 1) % STEPS_PER_LAYER;
  bool even = (layer & 1) == 0;
  int j = layer >> 1;
  bool upd_ctx = layer < 2;
  bool need_ctx = layer < 3;
  int nt_in = need_ctx ? TT : TL;
  int nt = upd_ctx ? TT : TL;
  switch (ph) {
    case 0: phase_norm(p, layer, 0, nt_in); break;
    case 1:
      if (even)
        gemm8_phase<EPI_INPROJ>(p, p->h, D, p->wt_in_ab + (size_t)j * 1280 * D, D, nt_in / 256, 5, D, layer, lds_all);
      else
        gemm8_phase<EPI_GELU>(p, p->h, D, p->wt_in_gs + (size_t)j * 2048 * D, D, nt / 256, 8, D, layer, lds_all);
      break;
    case 2:
      if (even) {
        phase_fft_a(p, lds);
        if (upd_ctx) phase_dft_ctx(p, lds);
        phase_attn(p, layer, upd_ctx);
      } else {
        phase_sgu(p, j, nt / 128, lds);
      }
      break;
    case 3:
      if (even) phase_fft_b(p, lds);
      break;
    case 4:
      if (even)
      {
        if (gscale != 1.f) gemm_phase<EPI_RESID>(p, p->mix, LDMIX, p->wt_out_ab + (size_t)j * D * LDMIX, LDMIX, nt / 128, 8, LDMIX, layer, lds, gscale);
        else if (layer == 0) gemm8_phase<EPI_RESID0>(p, p->mix, LDMIX, p->wt_out_ab + (size_t)j * D * LDMIX, LDMIX, nt / 256, 4, LDMIX, layer, lds_all);
        else gemm8_phase<EPI_RESID>(p, p->mix, LDMIX, p->wt_out_ab + (size_t)j * D * LDMIX, LDMIX, nt / 256, 4, LDMIX, layer, lds_all);
      }
      else
      {
        if (gscale != 1.f) gemm_phase<EPI_RESID>(p, p->mix, LDMIX, p->wt_out_gs + (size_t)j * D * D, D, nt / 128, 8, D, layer, lds, gscale);
        else gemm8_phase<EPI_RESID>(p, p->mix, LDMIX, p->wt_out_gs + (size_t)j * D * D, D, nt / 256, 4, D, layer, lds_all);
      }
      break;
    case 5: phase_norm(p, layer, 1, nt); break;
    case 6: gemm8_phase<EPI_STORE>(p, p->h, D, p->wt_q + (size_t)layer * 2048 * D, D, nt / 256, 8, D, layer, lds_all); break;
    case 7: phase_route(p, layer, nt, lds); break;
    case 8: phase_expert(p, layer, nt, lds, gscale, (gscale == 1.f) ? 0xffff : REP_IDMASK); break;
  }
}

__global__ void __launch_bounds__(PHYS_THREADS, 2) mega(Params p_unused, int step_lo, int step_hi) {
  unsigned char* lds_all = g_lds;
  if ((threadIdx.x & 63) == 0) *reinterpret_cast<volatile int*>(g_lds + LDS_BYTES - 16 - 256 + 4 * hw_slot()) = (int)(threadIdx.x >> 6);
  __syncthreads();
  unsigned char* lds = lds_all + (wave_index() >> 2) * LDS_HALF;
  PP pp = (PP)__builtin_amdgcn_kernarg_segment_ptr();
  volatile LAS unsigned* st = (volatile LAS unsigned*)(lds_all + LDS_BYTES - 16);
  if (threadIdx.x == 0) {
    st[0] = 0u;
    st[1] = 0u;
  }
  __syncthreads();
  XcdBarrier xb = xcd_barrier_post(pp->bar, st);
  int nsync = 0;
  bool first = true;
  for (int s = step_lo; s < step_hi; ++s) {
    if (!step_active(s)) continue;
    if (!first) {
      if (nsync == 0) cg::this_grid().sync();
      else xcd_barrier(xb);
      ++nsync;
    }
    first = false;
    PP q = pp;
    asm volatile("" : "+s"(q));
    run_step(q, s, lds, lds_all);
#if REP_MASK
    if (s == 0 && ((REP_MASK >> 15) & 1)) {
      xcd_barrier(xb);
      PP q2 = pp;
      asm volatile("" : "+s"(q2));
      run_step(q2, 0, lds, lds_all);
    }
    if (s > 0 && s < NSTEPS - 1) {
      int lay_ = (s - 1) / STEPS_PER_LAYER, ph_ = (s - 1) % STEPS_PER_LAYER;
      bool rep_ = (REP_MASK >> ph_) & 1;
      if (ph_ == 2 && ((REP_MASK >> 9) & 1) && !(lay_ & 1)) rep_ = true;
      if (ph_ == 2 && ((REP_MASK >> 10) & 1) && (lay_ & 1)) rep_ = true;
      if (rep_) {
        xcd_barrier(xb);
        PP q2 = pp;
        asm volatile("" : "+s"(q2));
        float z = 0.f;
        asm volatile("" : "+s"(z));
        run_step(q2, s, lds, lds_all, z);
      }
      if (ph_ == 2 && ((REP_MASK >> 11) & 1) && !(lay_ & 1)) {
        xcd_barrier(xb);
        PP q2 = pp;
        asm volatile("" : "+s"(q2));
        phase_attn(q2, lay_, lay_ < 2);
      }
    }
#endif
  }
}

static size_t align_up(size_t v) { return (v + 255) & ~(size_t)255; }

extern "C" void kernel_launch(void* const* d_in, const int* in_sizes, int n_in, void* d_out, int out_size, void* d_ws,
                              size_t ws_size, hipStream_t stream) {
  Params p{};
  p.x = (const float*)d_in[0];
  p.c = (const float*)d_in[1];
  p.ctx = (const float*)d_in[2];
  p.c_ctx = (const float*)d_in[3];
  p.ada_w = (const float*)d_in[4];
  p.ada_b = (const float*)d_in[5];
  p.norm_mix_w = (const float*)d_in[6];
  p.norm_ffn_w = (const float*)d_in[7];
  p.ab_w_in = (const float*)d_in[8];
  p.ab_w_out = (const float*)d_in[9];
  p.attn_sink = (const float*)d_in[10];
  p.gs_w_in = (const float*)d_in[11];
  p.gs_norm_w = (const float*)d_in[12];
  p.gs_w_s = (const float*)d_in[13];
  p.gs_b_s = (const float*)d_in[14];
  p.gs_w_out = (const float*)d_in[15];
  p.peer_w_q = (const float*)d_in[16];
  p.peer_keys = (const float*)d_in[17];
  p.peer_u = (const float*)d_in[18];
  p.peer_v = (const float*)d_in[19];
  p.norm_out_w = (const float*)d_in[20];
  p.out = (float*)d_out;
  unsigned char* w = (unsigned char*)d_ws;
  size_t off = 0;
  auto take = [&](size_t bytes) {
    unsigned char* r = w + off;
    off = align_up(off + bytes);
    return r;
  };
  p.bar = (unsigned*)take((size_t)XCD_BAR_WORDS * 4);
  p.mod = (float*)take((size_t)DEPTH * 9 * 6144 * 4);
  p.cs = (float2*)take(64 * 16 * 8);
  p.xs = (float*)take((size_t)TT * D * 4);
  p.h = (bf16_t*)take((size_t)TT * D * 2);
  p.P = (bf16_t*)take((size_t)TT * 2048 * 2);
  p.kbuf = (bf16_t*)take((size_t)NB * 2 * KVLEN * 64 * 2);
  p.vbuf = (bf16_t*)take((size_t)NB * 2 * KVLEN * 64 * 2);
  p.zvT = (bf16_t*)take((size_t)TT * 1024 * 2);
  p.rowss = (float*)take((size_t)(TT / 128) * 32 * 128 * 4);
  p.mix = (bf16_t*)take((size_t)TT * LDMIX * 2);
  p.fa = (bf16_t*)take((size_t)TL * 1024 * 2);
  p.tops = (float*)take((size_t)TT * 256 * 4);
  p.eidx = (int*)take((size_t)TT * 128 * 4);
  p.gate = (float*)take((size_t)TT * 128 * 4);
  p.wt_in_ab = (bf16_t*)take((size_t)2 * 1280 * D * 2);
  p.wt_out_ab = (bf16_t*)take((size_t)2 * D * LDMIX * 2);
  p.wt_in_gs = (bf16_t*)take((size_t)2 * 2048 * D * 2);
  p.wt_out_gs = (bf16_t*)take((size_t)2 * D * D * 2);
  p.wt_q = (bf16_t*)take((size_t)DEPTH * 2048 * D * 2);
  p.keysb = (bf16_t*)take((size_t)DEPTH * 8 * 2 * 128 * 128 * 2);
  p.su = (float*)take((size_t)DEPTH * NEXP * 4);
  p.sv = (float*)take((size_t)DEPTH * NEXP * 4);
  p.h8 = (signed char*)take((size_t)TT * D);
  p.sx = (float*)take((size_t)TT * 4);
  p.utab = (unsigned char*)take((size_t)DEPTH * NEXP * D);
  p.vtab = (unsigned char*)take((size_t)DEPTH * NEXP * D);
  if (off > ws_size) {
    fprintf(stderr, "workspace too small: need %zu have %zu\n", off, ws_size);
    return;
  }
  hipMemsetAsync(p.bar, 0, (size_t)XCD_BAR_WORDS * 4, stream);
  static int grid_blocks = 0;
  if (!grid_blocks) {
    int dev = 0, cus = 0, per_cu = 0;
    hipGetDevice(&dev);
    hipDeviceGetAttribute(&cus, hipDeviceAttributeMultiprocessorCount, dev);
    hipOccupancyMaxActiveBlocksPerMultiprocessor(&per_cu, mega, PHYS_THREADS, 0);
    if (per_cu > 1) per_cu = 1;
    if (per_cu < 1) per_cu = 1;
    grid_blocks = cus * per_cu;
  }
#if ONE_LAUNCH
  int lo = 0, hi = NSTEPS;
  void* args[] = {&p, &lo, &hi};
  hipError_t e = hipLaunchCooperativeKernel((void*)mega, dim3(grid_blocks), dim3(PHYS_THREADS), args, 0, stream);
  if (e != hipSuccess) fprintf(stderr, "cooperative launch failed: %s (grid %d)\n", hipGetErrorString(e), grid_blocks);
#else
  for (int s = 0; s < NSTEPS; ++s) {
    if (s != 0 && s != NSTEPS - 1) {
      int layer = (s - 1) / STEPS_PER_LAYER, ph = (s - 1) % STEPS_PER_LAYER;
      if (ph == 3 && (layer & 1)) continue;
    }
    hipLaunchKernelGGL(mega, dim3(grid_blocks), dim3(NTHREADS), 0, stream, p, s, s + 1);
  }
#endif
}
```

```cpp
#include <hip/hip_runtime.h>
#include <hip/hip_bf16.h>
#include <hip/hip_cooperative_groups.h>
#include <cstdio>
namespace cg = cooperative_groups;

#ifndef REP_MASK
#define REP_MASK 0
#endif
#ifndef REP_MODE
#define REP_MODE 0
#endif
#ifndef REP_IDMASK
#define REP_IDMASK 0xffff
#endif
#ifndef ONE_LAUNCH
#define ONE_LAUNCH 1
#endif

#define DEVI __device__ __forceinline__
typedef unsigned short bf16_t;
using bf16x8 = __attribute__((ext_vector_type(8))) short;
using f32x4 = __attribute__((ext_vector_type(4))) float;
using f32x16 = __attribute__((ext_vector_type(16))) float;

constexpr int D = 1024, NB = 8, SEQ = 4096, CTX = 256, DEPTH = 4;
constexpr int TL = NB * SEQ, TC = NB * CTX, TT = TL + TC;
constexpr int KVLEN = CTX + SEQ;
constexpr int NEXP = 16384;
constexpr int LDMIX = 1536;
constexpr float USCALE = 64.f, VSCALE = 8.f;
constexpr int TPB = 68;
constexpr int LDS_HALF = 68 * 1024;
constexpr int LDS_BYTES = 2 * LDS_HALF;
constexpr int PHYS_THREADS = 512;
constexpr int NTHREADS = 256;
constexpr int STEPS_PER_LAYER = 9;
constexpr int NSTEPS = 1 + DEPTH * STEPS_PER_LAYER + 1;

struct Params {
  const float *x, *c, *ctx, *c_ctx, *ada_w, *ada_b, *norm_mix_w, *norm_ffn_w, *ab_w_in, *ab_w_out, *attn_sink,
      *gs_w_in, *gs_norm_w, *gs_w_s, *gs_b_s, *gs_w_out, *peer_w_q, *peer_keys, *peer_u, *peer_v, *norm_out_w;
  float* out;
  float* mod;
  float2* cs;
  float* xs;
  bf16_t* h;
  bf16_t* P;
  bf16_t* kbuf;
  bf16_t* vbuf;
  float* rowss;
  bf16_t* zvT;
  bf16_t* mix;
  bf16_t* fa;
  unsigned* bar;
  float* tops;
  int* eidx;
  float* gate;
  bf16_t *wt_in_ab, *wt_out_ab, *wt_in_gs, *wt_out_gs, *wt_q, *keysb;
  unsigned char *utab, *vtab;
  float* su;
  float* sv;
  signed char* h8;
  float* sx;
};

typedef const __attribute__((address_space(4))) Params* PP;

__shared__ __attribute__((aligned(16))) unsigned char g_lds[LDS_BYTES];
DEVI int hw_slot() {
  int h = (int)(__builtin_amdgcn_s_getreg((6 - 1) << 11 | 0 << 6 | 4) & 63u);
  asm volatile("" : "+s"(h));
  return h;
}
DEVI int wave_index() {
  int w = *reinterpret_cast<volatile int*>(g_lds + LDS_BYTES - 16 - 256 + 4 * hw_slot());
  return __builtin_amdgcn_readfirstlane(w);
}
DEVI int lane_id() { return (int)__builtin_amdgcn_mbcnt_hi(~0u, __builtin_amdgcn_mbcnt_lo(~0u, 0u)); }
DEVI int ltid() { int t = ((wave_index() & 3) << 6) | lane_id(); asm volatile("" : "+v"(t)); return t; }
DEVI int lbid() { int t = 2 * blockIdx.x + (wave_index() >> 2); asm volatile("" : "+s"(t)); return t; }
DEVI int lnblk() { int t = 2 * gridDim.x; asm volatile("" : "+s"(t)); return t; }
DEVI int ptid() { int t = (wave_index() << 6) | lane_id(); asm volatile("" : "+v"(t)); return t; }
DEVI int pbid() { int t = blockIdx.x; asm volatile("" : "+s"(t)); return t; }
DEVI int pnblk() { int t = gridDim.x; asm volatile("" : "+s"(t)); return t; }

typedef __bf16 bf2v_t __attribute__((ext_vector_type(2)));
typedef float f2v_t __attribute__((ext_vector_type(2)));
DEVI bf16_t f2bf(float f) { return __builtin_bit_cast(unsigned short, (__bf16)f); }
DEVI float bf2f(bf16_t h) { return __uint_as_float(((unsigned)h) << 16); }
DEVI float bflo(unsigned u) { return __uint_as_float(u << 16); }
DEVI float bfhi(unsigned u) { return __uint_as_float(u & 0xffff0000u); }
DEVI unsigned pack2(float a, float b) {
  f2v_t v = {a, b};
  return __builtin_bit_cast(unsigned, __builtin_convertvector(v, bf2v_t));
}
DEVI float gelu_tanh(float x) {
  float u = 0.7978845608028654f * (x + 0.044715f * x * x * x);
  return 0.5f * x * (1.f + tanhf(u));
}
template <int CTRL>
DEVI float dpp_mov(float v) {
  return __builtin_bit_cast(float, __builtin_amdgcn_mov_dpp(__builtin_bit_cast(int, v), CTRL, 0xF, 0xF, true));
}
DEVI int shx_i(int v, int m) { return __builtin_amdgcn_ds_bpermute((lane_id() ^ m) << 2, v); }
DEVI float shx_f(float v, int m) { return __builtin_bit_cast(float, shx_i(__builtin_bit_cast(int, v), m)); }
DEVI float wave_sum(float v) {
  v += dpp_mov<0xB1>(v);
  v += dpp_mov<0x4E>(v);
  v += dpp_mov<0x141>(v);
  v += dpp_mov<0x140>(v);
  v += shx_f(v, 16);
  v += shx_f(v, 32);
  return v;
}
DEVI float wave_max(float v) {
  v = fmaxf(v, dpp_mov<0xB1>(v));
  v = fmaxf(v, dpp_mov<0x4E>(v));
  v = fmaxf(v, dpp_mov<0x141>(v));
  v = fmaxf(v, dpp_mov<0x140>(v));
  v = fmaxf(v, shx_f(v, 16));
  v = fmaxf(v, shx_f(v, 32));
  return v;
}
DEVI int tok_batch(int r) { return r < TL ? (r >> 12) : 8; }

DEVI void prep_transpose_tile(const float* __restrict__ src, int N, bf16_t* __restrict__ dst, int ldk, int tk, int tn, float* tile, int tid) {
#pragma unroll
  for (int i = 0; i < 16; ++i) {
    int r = (tid >> 6) + 4 * i;
    tile[r * 65 + (tid & 63)] = src[(size_t)(tk * 64 + r) * N + tn * 64 + (tid & 63)];
  }
  __syncthreads();
#pragma unroll
  for (int i = 0; i < 16; ++i) {
    int n = (tid >> 6) + 4 * i, k = tid & 63;
    dst[(size_t)(tn * 64 + n) * ldk + tk * 64 + k] = f2bf(tile[k * 65 + n]);
  }
}

constexpr int PU_ADA = DEPTH * 96;
constexpr int PU_T_ABIN = 2 * 16 * 20;
constexpr int PU_T_GSIN = 2 * 16 * 32;
constexpr int PU_T_GSOUT = 2 * 16 * 16;
constexpr int PU_T_ABOUT = 2 * 8 * 16;
constexpr int PU_T_Q = DEPTH * 16 * 32;
constexpr int PU_FOLD = 2 * 4 * 16 * 2;
constexpr int PU_CONV = DEPTH * NEXP * D / 4 / 2048;
constexpr int PU_KEYS = DEPTH * 8 * 2 * 128 * 128 / 4 / 2048;
constexpr int PU_UROWS = DEPTH * NEXP / 32;
constexpr int PU_TOTAL = PU_ADA + PU_T_ABIN + PU_T_GSIN + PU_T_GSOUT + PU_T_ABOUT + PU_T_Q + PU_FOLD + 2 * PU_UROWS + PU_KEYS + 1;

DEVI void phase_prep(PP p, unsigned char* lds) {
  const int tid = ltid();
  float* fl = reinterpret_cast<float*>(lds);
  for (int u0 = lbid(); u0 < PU_TOTAL; u0 += lnblk()) {
    int u = u0;
    if (u < PU_ADA) {
      float* sl = fl;
      for (int i = tid; i < 9 * 1024; i += NTHREADS) {
        int r = i >> 10, k = i & 1023;
        float v = (r < 8) ? p->c[r * 1024 + k] : p->c_ctx[k];
        sl[i] = v / (1.f + __expf(-v));
      }
      __syncthreads();
      float* red = sl + 9 * 1024;
      int ks = tid >> 6, col = tid & 63;
      int layer = u / 96, c0 = (u % 96) * 64;
      const float* w = p->ada_w + (size_t)layer * D * 6144 + c0 + col;
      float acc[9];
#pragma unroll
      for (int r = 0; r < 9; ++r) acc[r] = 0.f;
      for (int k0 = ks * 256; k0 < ks * 256 + 256; k0 += 16) {
        float wv[16];
#pragma unroll
        for (int kk = 0; kk < 16; ++kk) wv[kk] = w[(size_t)(k0 + kk) * 6144];
#pragma unroll
        for (int kk = 0; kk < 16; ++kk)
#pragma unroll
          for (int r = 0; r < 9; ++r) acc[r] += sl[r * 1024 + k0 + kk] * wv[kk];
      }
#pragma unroll
      for (int r = 0; r < 9; ++r) red[(ks * 9 + r) * 64 + col] = acc[r];
      __syncthreads();
      for (int i = tid; i < 9 * 64; i += NTHREADS) {
        int r = i >> 6, cc = i & 63;
        float sm = red[(0 * 9 + r) * 64 + cc] + red[(1 * 9 + r) * 64 + cc] + red[(2 * 9 + r) * 64 + cc] + red[(3 * 9 + r) * 64 + cc];
        sm += p->ada_b[(size_t)layer * 6144 + c0 + cc];
        p->mod[((size_t)layer * 9 + r) * 6144 + c0 + cc] = sm;
      }
      __syncthreads();
      continue;
    }
    u -= PU_ADA;
    if (u < PU_T_ABIN) {
      int j = u / 320, t = u % 320;
      prep_transpose_tile(p->ab_w_in + (size_t)j * D * 1280, 1280, p->wt_in_ab + (size_t)j * 1280 * D, D, t / 20, t % 20, fl, tid);
      __syncthreads();
      continue;
    }
    u -= PU_T_ABIN;
    if (u < PU_T_GSIN) {
      int j = u / 512, t = u % 512;
      prep_transpose_tile(p->gs_w_in + (size_t)j * D * 2048, 2048, p->wt_in_gs + (size_t)j * 2048 * D, D, t / 32, t % 32, fl, tid);
      __syncthreads();
      continue;
    }
    u -= PU_T_GSIN;
    if (u < PU_T_GSOUT) {
      int j = u / 256, t = u % 256;
      prep_transpose_tile(p->gs_w_out + (size_t)j * D * D, D, p->wt_out_gs + (size_t)j * D * D, D, t / 16, t % 16, fl, tid);
      __syncthreads();
      continue;
    }
    u -= PU_T_GSOUT;
    if (u < PU_T_ABOUT) {
      int j = u / 128, t = u % 128;
      prep_transpose_tile(p->ab_w_out + (size_t)j * D * D, D, p->wt_out_ab + (size_t)j * D * LDMIX, LDMIX, t / 16, t % 16, fl, tid);
      __syncthreads();
      continue;
    }
    u -= PU_T_ABOUT;
    if (u < PU_T_Q) {
      int i = u / 512, t = u % 512;
      prep_transpose_tile(p->peer_w_q + (size_t)i * D * 2048, 2048, p->wt_q + (size_t)i * 2048 * D, D, t / 32, t % 32, fl, tid);
      __syncthreads();
      continue;
    }
    u -= PU_T_Q;
    if (u < PU_FOLD) {
      const int mh = u & 1, nc = (u >> 1) & 15, g = (u >> 5) & 3, j = u >> 7;
      float2* tw = reinterpret_cast<float2*>(lds);
      float* wt = reinterpret_cast<float*>(lds + 1024);
      if (tid < 128) {
        float sn, cn;
        sincospif((float)tid / 64.f, &sn, &cn);
        tw[tid] = make_float2(cn, sn);
      }
      {
        const float* wsrc = p->ab_w_out + (size_t)j * D * D + (size_t)(512 + g * 128) * D + nc * 64;
#pragma unroll 8
        for (int i = 0; i < 32; ++i) {
          int l = (tid >> 6) + 4 * i;
          wt[l * 64 + (tid & 63)] = wsrc[(size_t)l * D + (tid & 63)];
        }
      }
      __syncthreads();
      const int n = tid & 63, mq = __builtin_amdgcn_readfirstlane(tid >> 6);
      bf16_t* dst = p->wt_out_ab + (size_t)j * D * LDMIX + (size_t)(nc * 64 + n) * LDMIX + g * 128;
#pragma unroll 1
      for (int mi = 0; mi < 16; ++mi) {
        const int m = mh * 64 + mq * 16 + mi;
        float ar = 0.f, ai = 0.f;
#pragma unroll 16
        for (int l = 0; l < 128; ++l) {
          float2 t = tw[(m * l) & 127];
          float wv = wt[l * 64 + n];
          ar += t.x * wv;
          ai += t.y * wv;
        }
        dst[512 + m] = f2bf(ar);
        dst[1024 + m] = f2bf(ai);
      }
      __syncthreads();
      continue;
    }
    u -= PU_FOLD;
    if (u < 2 * PU_UROWS) {
      const bool isv = u >= PU_UROWS;
      if (isv) u -= PU_UROWS;
      const float* src = isv ? p->peer_v : p->peer_u;
      unsigned char* dst = isv ? p->vtab : p->utab;
      float* sdst = isv ? p->sv : p->su;
      const int lane = tid & 63, wv = tid >> 6;
#pragma unroll 1
      for (int rr = 0; rr < 8; rr += 4) {
        size_t row0 = (size_t)u * 32 + wv * 8 + rr;
        float4 v[4][4];
#pragma unroll
        for (int k = 0; k < 4; ++k)
#pragma unroll
          for (int i = 0; i < 4; ++i) v[k][i] = reinterpret_cast<const float4*>(src + (row0 + k) * D)[lane * 4 + i];
#pragma unroll
        for (int k = 0; k < 4; ++k) {
          float am = 0.f;
#pragma unroll
          for (int i = 0; i < 4; ++i)
            am = fmaxf(am, fmaxf(fmaxf(fabsf(v[k][i].x), fabsf(v[k][i].y)), fmaxf(fabsf(v[k][i].z), fabsf(v[k][i].w))));
          am = wave_max(am);
          am = fmaxf(am, 1e-30f);
          float qs = 127.f / am;
          uint4 o;
          unsigned* op = reinterpret_cast<unsigned*>(&o);
#pragma unroll
          for (int i = 0; i < 4; ++i) {
            int q0 = (int)rintf(v[k][i].x * qs), q1 = (int)rintf(v[k][i].y * qs), q2 = (int)rintf(v[k][i].z * qs), q3 = (int)rintf(v[k][i].w * qs);
            op[i] = (unsigned)(q0 & 255) | ((unsigned)(q1 & 255) << 8) | ((unsigned)(q2 & 255) << 16) | ((unsigned)(q3 & 255) << 24);
          }
          reinterpret_cast<uint4*>(dst + (row0 + k) * D)[lane] = o;
          if (lane == 0) sdst[row0 + k] = am * (1.f / 127.f);
        }
      }
      continue;
    }
    u -= 2 * PU_UROWS;
    if (u < PU_KEYS) {
      const float4* s4 = reinterpret_cast<const float4*>(p->peer_keys) + (size_t)u * 2048 + tid;
      uint2* d2 = reinterpret_cast<uint2*>(p->keysb) + (size_t)u * 2048 + tid;
#pragma unroll
      for (int k = 0; k < 8; ++k) {
        float4 v = s4[k * 256];
        uint2 o;
        o.x = pack2(v.x, v.y);
        o.y = pack2(v.z, v.w);
        d2[k * 256] = o;
      }
      continue;
    }
    for (int i = tid; i < 64 * 16; i += NTHREADS) {
      int pos = i >> 4, k = i & 15;
      float inv = powf(10000.f, -(float)k / 16.f);
      float ang = (float)pos * inv;
      float sn, cn;
      sincosf(ang, &sn, &cn);
      p->cs[i] = make_float2(cn, sn);
    }
  }
}

DEVI void norm_row(PP p, int layer, int which, int tok, int lane) {
  const float* w = which == 0 ? p->norm_mix_w + layer * D : (which == 1 ? p->norm_ffn_w + layer * D : p->norm_out_w);
  const float* xsrc = p->xs + (size_t)tok * D;
  if (which == 0 && layer == 0) xsrc = (tok < TL) ? p->x + (size_t)tok * D : p->ctx + (size_t)(tok - TL) * D;
  const float4* xr = reinterpret_cast<const float4*>(xsrc);
  float4 v[4];
  float ss = 0.f;
#pragma unroll
  for (int i = 0; i < 4; ++i) {
    v[i] = xr[lane + 64 * i];
    ss += v[i].x * v[i].x + v[i].y * v[i].y + v[i].z * v[i].z + v[i].w * v[i].w;
  }
  ss = wave_sum(ss);
  float rstd = rsqrtf(ss * (1.f / 1024.f) + 1e-6f);
  if (which == 2) {
    float4* o = reinterpret_cast<float4*>(p->out + (size_t)tok * D);
#pragma unroll
    for (int i = 0; i < 4; ++i) {
      float4 wv = reinterpret_cast<const float4*>(w)[lane + 64 * i];
      float4 r;
      r.x = v[i].x * rstd * wv.x;
      r.y = v[i].y * rstd * wv.y;
      r.z = v[i].z * rstd * wv.z;
      r.w = v[i].w * rstd * wv.w;
      o[lane + 64 * i] = r;
    }
  } else {
    int b = tok_batch(tok);
    const float* mb = p->mod + ((size_t)layer * 9 + b) * 6144 + (which == 0 ? 0 : 3072);
    uint2* o = reinterpret_cast<uint2*>(p->h + (size_t)tok * D);
    float av[4][4];
    float am = 0.f;
#pragma unroll
    for (int i = 0; i < 4; ++i) {
      float4 wv = reinterpret_cast<const float4*>(w)[lane + 64 * i];
      float4 sh = reinterpret_cast<const float4*>(mb)[lane + 64 * i];
      float4 sc = reinterpret_cast<const float4*>(mb + 1024)[lane + 64 * i];
      float a0 = v[i].x * rstd * wv.x * (1.f + sc.x) + sh.x;
      float a1 = v[i].y * rstd * wv.y * (1.f + sc.y) + sh.y;
      float a2 = v[i].z * rstd * wv.z * (1.f + sc.z) + sh.z;
      float a3 = v[i].w * rstd * wv.w * (1.f + sc.w) + sh.w;
      uint2 r;
      r.x = pack2(a0, a1);
      r.y = pack2(a2, a3);
      o[lane + 64 * i] = r;
      av[i][0] = a0; av[i][1] = a1; av[i][2] = a2; av[i][3] = a3;
      am = fmaxf(am, fmaxf(fmaxf(fabsf(a0), fabsf(a1)), fmaxf(fabsf(a2), fabsf(a3))));
    }
    if (which == 1) {
      am = fmaxf(wave_max(am), 1e-30f);
      float qs = 127.f / am;
      unsigned* o8 = reinterpret_cast<unsigned*>(p->h8 + (size_t)tok * D);
#pragma unroll
      for (int i = 0; i < 4; ++i) {
        int q0 = (int)rintf(av[i][0] * qs), q1 = (int)rintf(av[i][1] * qs), q2 = (int)rintf(av[i][2] * qs), q3 = (int)rintf(av[i][3] * qs);
        o8[lane + 64 * i] = (unsigned)(q0 & 255) | ((unsigned)(q1 & 255) << 8) | ((unsigned)(q2 & 255) << 16) | ((unsigned)(q3 & 255) << 24);
      }
      if (lane == 0) p->sx[tok] = am * (1.f / 127.f);
    }
  }
}

DEVI void phase_norm(PP p, int layer, int which, int ntok) {
  int lane = ltid() & 63;
  int gw = lbid() * 4 + __builtin_amdgcn_readfirstlane(ltid() >> 6), nw = lnblk() * 4;
  for (int tok = gw; tok < ntok; tok += nw) norm_row(p, layer, which, tok, lane);
}

enum { EPI_STORE = 0, EPI_GELU = 1, EPI_RESID = 2, EPI_INPROJ = 3, EPI_RESID0 = 4 };

template <int EPI>
DEVI void gemm_phase(PP p, const bf16_t* __restrict__ A, int lda, const bf16_t* __restrict__ Bt, int ldb,
                     int Mtiles, int Ntiles, int K, int layer, unsigned char* lds, float gscale = 1.f, int big_t0 = -1, int big_n = 0,
                     int big_ntn = 1) {
  const int tid = ltid();
  const int wid = __builtin_amdgcn_readfirstlane(tid >> 6), lane = tid & 63, wr = wid >> 1, wc = wid & 1, fr = lane & 15, fq = lane >> 4;
  int nblk = lnblk();
  int bid = lbid();
  int lb = bid;
  {
    const int pn = nblk >> 1, pb = bid >> 1;
    if ((pn & 7) == 0) lb = 2 * ((pb & 7) * (pn >> 3) + (pb >> 3)) + (bid & 1);
  }
  int ntiles = (big_t0 >= 0) ? 4 * big_n : Mtiles * Ntiles;
  const int nk = K / 64;
  const int srow = tid >> 3;
  const int scol = ((tid & 7) ^ ((tid >> 3) & 7)) * 8;
#define GEMM_STAGE(ga_, gb_, kt_, buf_)                                                                               \
  {                                                                                                                   \
    _Pragma("unroll") for (int i_ = 0; i_ < 4; ++i_) {                                                                \
      __builtin_amdgcn_global_load_lds((const unsigned*)((ga_) + (size_t)(32 * i_) * lda + (kt_) * 64),               \
                                       (__attribute__((address_space(3))) unsigned*)(lds + (buf_) * 32768 + tid * 16 + i_ * 4096), 16, 0, 0); \
      __builtin_amdgcn_global_load_lds((const unsigned*)((gb_) + (size_t)(32 * i_) * ldb + (kt_) * 64),               \
                                       (__attribute__((address_space(3))) unsigned*)(lds + (buf_) * 32768 + 16384 + tid * 16 + i_ * 4096), 16, 0, 0); \
    }                                                                                                                 \
  }
  auto tile_rc = [&](int t, int& tm_, int& tn_) {
    if (big_t0 >= 0) {
      int bt = big_t0 + (t >> 2), q = t & 3;
      tm_ = 2 * (bt / big_ntn) + (q >> 1);
      tn_ = 2 * (bt % big_ntn) + (q & 1);
    } else {
      tm_ = t / Ntiles;
      tn_ = t % Ntiles;
    }
  };
  if (lb < ntiles) {
    int tm0, tn0;
    tile_rc(lb, tm0, tn0);
    const bf16_t* ga0 = A + (size_t)(tm0 * 128 + srow) * lda + scol;
    const bf16_t* gb0 = Bt + (size_t)(tn0 * 128 + srow) * ldb + scol;
    GEMM_STAGE(ga0, gb0, 0, 0)
  }
  for (int t = lb; t < ntiles; t += nblk) {
    int tm, tn;
    tile_rc(t, tm, tn);
    int brow = tm * 128, bcol = tn * 128;
    f32x4 acc[4][4];
#pragma unroll
    for (int m = 0; m < 4; ++m)
#pragma unroll
      for (int n = 0; n < 4; ++n) acc[m][n] = f32x4{0.f, 0.f, 0.f, 0.f};
    const bf16_t* ga = A + (size_t)(brow + srow) * lda + scol;
    const bf16_t* gb = Bt + (size_t)(bcol + srow) * ldb + scol;
    for (int kt = 0; kt < nk; ++kt) {
      const int buf = kt & 1;
      asm volatile("s_waitcnt vmcnt(0)" ::: "memory");
      __syncthreads();
      if (kt + 1 < nk) GEMM_STAGE(ga, gb, kt + 1, buf ^ 1)
      const unsigned char* SA = lds + buf * 32768;
      const unsigned char* SB = SA + 16384;
      bf16x8 At[2][4], Bl[2][4];
#pragma unroll
      for (int ks = 0; ks < 2; ++ks)
#pragma unroll
        for (int m = 0; m < 4; ++m) {
          const int sl = ((ks * 4 + fq) ^ (fr & 7)) << 4;
          At[ks][m] = *reinterpret_cast<const bf16x8*>(SA + (wr * 64 + m * 16 + fr) * 128 + sl);
          Bl[ks][m] = *reinterpret_cast<const bf16x8*>(SB + (wc * 64 + m * 16 + fr) * 128 + sl);
        }
#pragma unroll
      for (int ks = 0; ks < 2; ++ks)
#pragma unroll
        for (int m = 0; m < 4; ++m)
#pragma unroll
          for (int n = 0; n < 4; ++n)
            acc[m][n] = __builtin_amdgcn_mfma_f32_16x16x32_bf16(At[ks][m], Bl[ks][n], acc[m][n], 0, 0, 0);
    }
    {
      int t2 = t + nblk;
      if (t2 < ntiles) {
        int tm2, tn2;
        tile_rc(t2, tm2, tn2);
        const bf16_t* ga2 = A + (size_t)(tm2 * 128 + srow) * lda + scol;
        const bf16_t* gb2 = Bt + (size_t)(tn2 * 128 + srow) * ldb + scol;
        GEMM_STAGE(ga2, gb2, 0, 0)
      }
    }
    const int colbase = bcol + wc * 64;
    if constexpr (EPI == EPI_STORE || EPI == EPI_GELU) {
      if (EPI == EPI_GELU && colbase >= 1024) {
        float* rsp = p->rowss + ((size_t)tm * 32 + ((colbase - 1024) >> 5)) * 128;
#pragma unroll
        for (int m = 0; m < 4; ++m) {
          float ssq[4] = {0.f, 0.f, 0.f, 0.f};
#pragma unroll
          for (int n = 0; n < 4; ++n) {
            int ch = colbase - 1024 + n * 16 + fr;
            int q0 = wr * 64 + m * 16 + fq * 4;
            float g0 = gelu_tanh(acc[m][n][0]), g1 = gelu_tanh(acc[m][n][1]), g2 = gelu_tanh(acc[m][n][2]), g3 = gelu_tanh(acc[m][n][3]);
            ssq[0] += g0 * g0;
            ssq[1] += g1 * g1;
            ssq[2] += g2 * g2;
            ssq[3] += g3 * g3;
            uint2 o;
            o.x = pack2(g0, g1);
            o.y = pack2(g2, g3);
            *reinterpret_cast<uint2*>(p->zvT + ((size_t)tm * 1024 + ch) * 128 + q0) = o;
          }
#pragma unroll
          for (int j = 0; j < 4; ++j) {
            float v = ssq[j];
            v += dpp_mov<0xB1>(v);
            v += dpp_mov<0x4E>(v);
            v += dpp_mov<0x141>(v);
            v += dpp_mov<0x140>(v);
            if (fr == 0) {
              rsp[wr * 64 + m * 16 + fq * 4 + j] = v;
              rsp[128 + wr * 64 + m * 16 + fq * 4 + j] = 0.f;
            }
          }
        }
      } else {
#pragma unroll
        for (int m = 0; m < 4; ++m)
#pragma unroll
          for (int j = 0; j < 4; ++j) {
            int row = brow + wr * 64 + m * 16 + fq * 4 + j;
            bf16_t* o = p->P + (size_t)row * 2048 + colbase + fr;
#pragma unroll
            for (int n = 0; n < 4; ++n) {
              float v = acc[m][n][j];
              if (EPI == EPI_GELU) v = gelu_tanh(v);
              o[n * 16] = f2bf(v);
            }
          }
      }
    } else if constexpr (EPI == EPI_RESID) {
#pragma unroll
      for (int m = 0; m < 4; ++m)
#pragma unroll
        for (int j = 0; j < 4; ++j) {
          int row = brow + wr * 64 + m * 16 + fq * 4 + j;
          int b = tok_batch(row);
          const float* g = p->mod + ((size_t)layer * 9 + b) * 6144 + 2048 + colbase + fr;
          float* o = p->xs + (size_t)row * D + colbase + fr;
          const float* xi = o;
          if (layer == 0 && gscale == 1.f)
            xi = ((row < TL) ? p->x + (size_t)row * D : p->ctx + (size_t)(row - TL) * D) + colbase + fr;
#pragma unroll
          for (int n = 0; n < 4; ++n) o[n * 16] = xi[n * 16] + gscale * g[n * 16] * acc[m][n][j];
        }
    } else if constexpr (EPI == EPI_INPROJ) {
      if (colbase >= 640 && colbase < 768) {
        int kvh = (colbase - 640) >> 6;
#pragma unroll
        for (int m = 0; m < 4; ++m) {
          int row0 = brow + wr * 64 + m * 16;
          bool latent = row0 < TL;
          int b = latent ? (row0 >> 12) : ((row0 - TL) >> 8);
          int kp16 = latent ? (CTX + (row0 & 4095)) : ((row0 - TL) & 255);
          int slot = kp16 + 8 * (fq & 1) + 4 * (fq >> 1);
#pragma unroll
          for (int n = 0; n < 4; ++n) {
            int dim = n * 16 + fr;
            uint2 o;
            o.x = pack2(acc[m][n][0], acc[m][n][1]);
            o.y = pack2(acc[m][n][2], acc[m][n][3]);
            *reinterpret_cast<uint2*>(p->vbuf + ((size_t)(b * 2 + kvh) * 64 + dim) * KVLEN + slot) = o;
          }
        }
      } else {
#pragma unroll
        for (int m = 0; m < 4; ++m)
#pragma unroll
          for (int j = 0; j < 4; ++j) {
            int row = brow + wr * 64 + m * 16 + fq * 4 + j;
            bool latent = row < TL;
            int b, pos;
            if (latent) {
              b = row >> 12;
              pos = row & 4095;
            } else {
              b = (row - TL) >> 8;
              pos = (row - TL) & 255;
            }
            float v0 = acc[m][0][j], v1 = acc[m][1][j], v2 = acc[m][2][j], v3 = acc[m][3][j];
            if (latent && colbase < 640) {
              float2 cr = p->cs[(pos >> 6) * 16 + fr];
              float2 cc = p->cs[(pos & 63) * 16 + fr];
              float a = v0, bb = v1;
              v0 = a * cr.x - bb * cr.y;
              v1 = bb * cr.x + a * cr.y;
              a = v2;
              bb = v3;
              v2 = a * cc.x - bb * cc.y;
              v3 = bb * cc.x + a * cc.y;
            }
            bf16_t* o;
            if (colbase < 512 || colbase >= 768) {
              o = p->P + (size_t)row * 2048 + colbase + fr;
            } else {
              int kvh = (colbase - 512) >> 6;
              int kp = latent ? (CTX + pos) : pos;
              o = p->kbuf + ((size_t)(b * 2 + kvh) * KVLEN + kp) * 64 + fr;
            }
            o[0] = f2bf(v0);
            o[16] = f2bf(v1);
            o[32] = f2bf(v2);
            o[48] = f2bf(v3);
          }
      }
    }
  }
}

constexpr int G8_HT = 128 * 64;
DEVI int g8_lds_byte(int r, int c) {
  int st = (r >> 4) * 2 + (c >> 5), rr = r & 15, cc = c & 31, ob = rr * 64 + cc * 2;
  return st * 1024 + (ob ^ (((ob >> 9) & 1) << 5));
}
DEVI void g8_stage_rc(int b, int& R, int& C) {
  int st = b / 1024, sb = b % 1024, swz = sb ^ (((sb >> 9) & 1) << 5);
  R = (st >> 1) * 16 + swz / 64;
  C = (st & 1) * 32 + (swz % 64) / 2;
}
template <int EPI, bool STAGED>
DEVI void gemm8_epilogue(PP p, f32x4 (&acc)[2][2][4][2], const f32x4* stg, int lane, int brow, int bcol, int wr, int wc, int fr, int fq, int layer, float gscale) {
#pragma unroll
  for (int ai_ = 0; ai_ < 2; ++ai_)
#pragma unroll
    for (int bj = 0; bj < 2; ++bj) {
      const int ai = STAGED ? 1 - ai_ : ai_;
      f32x4 q[4][2];
#pragma unroll
      for (int m = 0; m < 4; ++m)
#pragma unroll
        for (int n = 0; n < 2; ++n) q[m][n] = (STAGED && ai == 0) ? stg[(((bj * 4 + m) * 2 + n) * 64) + lane] : acc[ai][bj][m][n];
      const int r0 = brow + ai * 128 + wr * 64;
      const int c0 = bcol + bj * 128 + wc * 32;
      if constexpr (EPI == EPI_STORE) {
#pragma unroll
        for (int m = 0; m < 4; ++m)
#pragma unroll
          for (int j = 0; j < 4; ++j) {
            bf16_t* o = p->P + (size_t)(r0 + m * 16 + fq * 4 + j) * 2048 + c0 + fr;
            o[0] = f2bf(q[m][0][j]);
            o[16] = f2bf(q[m][1][j]);
          }
      } else if constexpr (EPI == EPI_GELU) {
        if (c0 >= 1024) {
          const int chunk = r0 >> 7;
          float* rsp = p->rowss + ((size_t)chunk * 32 + ((c0 - 1024) >> 5)) * 128;
#pragma unroll
          for (int m = 0; m < 4; ++m) {
            float ssq[4] = {0.f, 0.f, 0.f, 0.f};
            const int q0 = (r0 & 127) + m * 16 + fq * 4;
#pragma unroll
            for (int n = 0; n < 2; ++n) {
              int ch = c0 - 1024 + n * 16 + fr;
              float g0 = gelu_tanh(q[m][n][0]), g1 = gelu_tanh(q[m][n][1]);
              float g2 = gelu_tanh(q[m][n][2]), g3 = gelu_tanh(q[m][n][3]);
              ssq[0] += g0 * g0;
              ssq[1] += g1 * g1;
              ssq[2] += g2 * g2;
              ssq[3] += g3 * g3;
              uint2 o;
              o.x = pack2(g0, g1);
              o.y = pack2(g2, g3);
              *reinterpret_cast<uint2*>(p->zvT + ((size_t)chunk * 1024 + ch) * 128 + q0) = o;
            }
#pragma unroll
            for (int j = 0; j < 4; ++j) {
              float v = ssq[j];
              v += dpp_mov<0xB1>(v);
              v += dpp_mov<0x4E>(v);
              v += dpp_mov<0x141>(v);
              v += dpp_mov<0x140>(v);
              if (fr == 0) rsp[q0 + j] = v;
            }
          }
        } else {
#pragma unroll
          for (int m = 0; m < 4; ++m)
#pragma unroll
            for (int j = 0; j < 4; ++j) {
              bf16_t* o = p->P + (size_t)(r0 + m * 16 + fq * 4 + j) * 2048 + c0 + fr;
              o[0] = f2bf(gelu_tanh(q[m][0][j]));
              o[16] = f2bf(gelu_tanh(q[m][1][j]));
            }
        }
      } else if constexpr (EPI == EPI_RESID || EPI == EPI_RESID0) {
        const float* g = p->mod + ((size_t)layer * 9 + tok_batch(brow)) * 6144 + 2048 + c0 + fr;
        const float g0 = g[0], g1 = g[16];
        const float* xin = (brow < TL) ? p->x : p->ctx - (size_t)TL * D;
#pragma unroll
        for (int m = 0; m < 4; ++m)
#pragma unroll
          for (int j = 0; j < 4; ++j) {
            const size_t ro = (size_t)(r0 + m * 16 + fq * 4 + j) * D + c0 + fr;
            float* o = p->xs + ro;
            const float* xi = (EPI == EPI_RESID0) ? xin + ro : o;
            o[0] = xi[0] + g0 * q[m][0][j];
            o[16] = xi[16] + g1 * q[m][1][j];
          }
      } else if constexpr (EPI == EPI_INPROJ) {
        if (c0 >= 640 && c0 < 768) {
          const int kvh = (c0 - 640) >> 6, d0 = (c0 - 640) & 63;
#pragma unroll
          for (int m = 0; m < 4; ++m) {
            int row0 = r0 + m * 16;
            bool latent = row0 < TL;
            int b = latent ? (row0 >> 12) : ((row0 - TL) >> 8);
            int kp16 = latent ? (CTX + (row0 & 4095)) : ((row0 - TL) & 255);
            int slot = kp16 + 8 * (fq & 1) + 4 * (fq >> 1);
#pragma unroll
            for (int n = 0; n < 2; ++n) {
              int dim = d0 + n * 16 + fr;
              uint2 o;
              o.x = pack2(q[m][n][0], q[m][n][1]);
              o.y = pack2(q[m][n][2], q[m][n][3]);
              *reinterpret_cast<uint2*>(p->vbuf + ((size_t)(b * 2 + kvh) * 64 + dim) * KVLEN + slot) = o;
            }
          }
        } else {
          const int hsel = (c0 >> 5) & 1;
#pragma unroll
          for (int m = 0; m < 4; ++m)
#pragma unroll
            for (int j = 0; j < 4; ++j) {
              int row = r0 + m * 16 + fq * 4 + j;
              bool latent = row < TL;
              int b, pos;
              if (latent) {
                b = row >> 12;
                pos = row & 4095;
              } else {
                b = (row - TL) >> 8;
                pos = (row - TL) & 255;
              }
              float v0 = q[m][0][j], v1 = q[m][1][j];
              if (latent && c0 < 640) {
                float2 cs = p->cs[(hsel ? (pos & 63) : (pos >> 6)) * 16 + fr];
                float a = v0, bb = v1;
                v0 = a * cs.x - bb * cs.y;
                v1 = bb * cs.x + a * cs.y;
              }
              bf16_t* o;
              if (c0 < 512 || c0 >= 768) {
                o = p->P + (size_t)row * 2048 + c0 + fr;
              } else {
                int kvh = (c0 - 512) >> 6, d0 = (c0 - 512) & 63;
                int kp = latent ? (CTX + pos) : pos;
                o = p->kbuf + ((size_t)(b * 2 + kvh) * KVLEN + kp) * 64 + d0 + fr;
              }
              o[0] = f2bf(v0);
              o[16] = f2bf(v1);
            }
        }
      }
      __builtin_amdgcn_sched_barrier(0);
    }
}

template <int EPI>
DEVI void gemm8_phase(PP p, const bf16_t* __restrict__ A, int lda, const bf16_t* __restrict__ Bt, int ldb, int Mtiles, int Ntiles,
                      int K, int layer, unsigned char* lds_all, float gscale = 1.f) {
  bf16_t* shm = reinterpret_cast<bf16_t*>(lds_all);
  const int tid = ptid();
  const int wid = __builtin_amdgcn_readfirstlane(tid >> 6), lane = tid & 63, wr = wid >> 2, wc = wid & 3, fr = lane & 15, fq = lane >> 4;
#define G8_SA(b, h) (shm + ((b) * 2 + (h)) * G8_HT)
#define G8_SB(b, h) (shm + (4 + (b) * 2 + (h)) * G8_HT)
  const __amdgpu_buffer_rsrc_t rsA = __builtin_amdgcn_make_buffer_rsrc((void*)A, (short)0, -1, 0x00020000);
  const __amdgpu_buffer_rsrc_t rsB = __builtin_amdgcn_make_buffer_rsrc((void*)Bt, (short)0, -1, 0x00020000);
  unsigned voA[2], voB[2];
#pragma unroll
  for (int i = 0; i < 2; ++i) {
    int r_, c_;
    g8_stage_rc(tid * 16 + i * 8192, r_, c_);
    voA[i] = (unsigned)((r_ * lda + c_) * 2);
    voB[i] = (unsigned)((r_ * ldb + c_) * 2);
  }
#define G8_STAGE(P_, RS_, VO_, ld_, br_, kt_)                                                                         \
  do {                                                                                                                \
    const unsigned so_ = (unsigned)(((br_) * (ld_) + (kt_) * 64) * 2);                                                \
    _Pragma("unroll") for (int i_ = 0; i_ < 2; ++i_)                                                                  \
      __builtin_amdgcn_raw_ptr_buffer_load_lds(RS_, (__attribute__((address_space(3))) void*)((unsigned char*)(P_) + wid * 1024 + i_ * 8192), 16, VO_[i_], so_, 0, 0); \
  } while (0)
#define G8_LDA(dst, b, h)                                                                                             \
  _Pragma("unroll") for (int m_ = 0; m_ < 4; ++m_) _Pragma("unroll") for (int k_ = 0; k_ < 2; ++k_)                   \
      dst[m_][k_] = *reinterpret_cast<const bf16x8*>((const unsigned char*)G8_SA(b, h) + g8_lds_byte(wr * 64 + m_ * 16 + fr, k_ * 32 + fq * 8))
#define G8_LDB(dst, b, h)                                                                                             \
  _Pragma("unroll") for (int n_ = 0; n_ < 2; ++n_) _Pragma("unroll") for (int k_ = 0; k_ < 2; ++k_)                   \
      dst[n_][k_] = *reinterpret_cast<const bf16x8*>((const unsigned char*)G8_SB(b, h) + g8_lds_byte(wc * 32 + n_ * 16 + fr, k_ * 32 + fq * 8))
#define G8_MMA(ai, bj, At_, Bt_)                                                                                      \
  do {                                                                                                                \
    __builtin_amdgcn_s_setprio(1);                                                                                    \
    _Pragma("unroll") for (int m_ = 0; m_ < 4; ++m_) _Pragma("unroll") for (int n_ = 0; n_ < 2; ++n_)                 \
        _Pragma("unroll") for (int k_ = 0; k_ < 2; ++k_) acc[ai][bj][m_][n_] =                                        \
            __builtin_amdgcn_mfma_f32_16x16x32_bf16(At_[m_][k_], Bt_[n_][k_], acc[ai][bj][m_][n_], 0, 0, 0);          \
    __builtin_amdgcn_s_setprio(0);                                                                                    \
  } while (0)
#define G8_WAIT_V(n) asm volatile("s_waitcnt vmcnt(" #n ")" ::: "memory")
#define G8_WAIT_L(n) asm volatile("s_waitcnt lgkmcnt(" #n ")" ::: "memory")
#define G8_BAR __builtin_amdgcn_s_barrier()
#define G8_SCHED __builtin_amdgcn_sched_barrier(0)
  const int nblk = pnblk(), bid = pbid();
  const int lb = ((nblk & 7) == 0) ? ((bid & 7) * (nblk >> 3) + (bid >> 3)) : bid;
  const int ntiles_all = Mtiles * Ntiles;
  const int ntiles = (EPI == EPI_RESID0 || gscale != 1.f) ? ntiles_all : (ntiles_all / nblk) * nblk;
  const int nt = K / 64;
  for (int t = lb; t < ntiles; t += nblk) {
    const int tm = t / Ntiles, tn = t % Ntiles;
    const int brow = tm * 256, bcol = tn * 256;
    f32x4 acc[2][2][4][2];
#pragma unroll
    for (int a0 = 0; a0 < 2; ++a0)
#pragma unroll
      for (int b0 = 0; b0 < 2; ++b0)
#pragma unroll
        for (int m = 0; m < 4; ++m)
#pragma unroll
          for (int n = 0; n < 2; ++n) acc[a0][b0][m][n] = f32x4{0.f, 0.f, 0.f, 0.f};
    bf16x8 At[4][2], B0[2][2], B1[2][2];
    G8_STAGE(G8_SB(0, 0), rsB, voB, ldb, bcol, 0);
    G8_STAGE(G8_SA(0, 0), rsA, voA, lda, brow, 0);
    G8_STAGE(G8_SB(0, 1), rsB, voB, ldb, bcol + 128, 0);
    G8_STAGE(G8_SA(0, 1), rsA, voA, lda, brow + 128, 0);
    if (wr == 1) G8_BAR;
    G8_WAIT_V(4);
    G8_BAR;
    G8_STAGE(G8_SB(1, 0), rsB, voB, ldb, bcol, 1);
    G8_STAGE(G8_SA(1, 0), rsA, voA, lda, brow, 1);
    G8_STAGE(G8_SB(1, 1), rsB, voB, ldb, bcol + 128, 1);
    G8_WAIT_V(6);
    G8_BAR;
    for (int kt = 0; kt < nt - 2; kt += 2) {
      G8_LDB(B0, 0, 0); G8_SCHED; G8_LDA(At, 0, 0); G8_STAGE(G8_SA(1, 1), rsA, voA, lda, brow + 128, kt + 1);
      G8_WAIT_L(8); G8_BAR; G8_WAIT_L(0); G8_MMA(0, 0, At, B0); G8_BAR; G8_SCHED;
      G8_LDB(B1, 0, 1); G8_STAGE(G8_SB(0, 0), rsB, voB, ldb, bcol, kt + 2);
      G8_BAR; G8_WAIT_L(0); G8_MMA(0, 1, At, B1); G8_BAR;
      G8_LDA(At, 0, 1); G8_STAGE(G8_SA(0, 0), rsA, voA, lda, brow, kt + 2);
      G8_BAR; G8_WAIT_L(0); G8_MMA(1, 0, At, B0); G8_BAR; G8_SCHED;
      G8_STAGE(G8_SB(0, 1), rsB, voB, ldb, bcol + 128, kt + 2);
      G8_WAIT_V(6); G8_BAR; G8_MMA(1, 1, At, B1); G8_BAR;
      G8_LDB(B0, 1, 0); G8_SCHED; G8_LDA(At, 1, 0); G8_STAGE(G8_SA(0, 1), rsA, voA, lda, brow + 128, kt + 2);
      G8_WAIT_L(8); G8_BAR; G8_WAIT_L(0); G8_MMA(0, 0, At, B0); G8_BAR; G8_SCHED;
      G8_LDB(B1, 1, 1); G8_STAGE(G8_SB(1, 0), rsB, voB, ldb, bcol, kt + 3);
      G8_BAR; G8_WAIT_L(0); G8_MMA(0, 1, At, B1); G8_BAR;
      G8_LDA(At, 1, 1); G8_STAGE(G8_SA(1, 0), rsA, voA, lda, brow, kt + 3);
      G8_BAR; G8_WAIT_L(0); G8_MMA(1, 0, At, B0); G8_BAR; G8_SCHED;
      G8_STAGE(G8_SB(1, 1), rsB, voB, ldb, bcol + 128, kt + 3);
      G8_WAIT_V(6); G8_BAR; G8_MMA(1, 1, At, B1); G8_BAR;
    }
    {
      G8_LDB(B0, 0, 0); G8_LDA(At, 0, 0); G8_STAGE(G8_SA(1, 1), rsA, voA, lda, brow + 128, nt - 1);
      G8_BAR; G8_WAIT_L(0); G8_MMA(0, 0, At, B0); G8_BAR;
      G8_LDB(B1, 0, 1); G8_BAR; G8_WAIT_L(0); G8_MMA(0, 1, At, B1); G8_BAR;
      G8_LDA(At, 0, 1); G8_WAIT_V(4); G8_BAR; G8_WAIT_L(0); G8_MMA(1, 0, At, B0); G8_MMA(1, 1, At, B1); G8_BAR;
    }
    {
      G8_LDB(B0, 1, 0); G8_LDA(At, 1, 0); G8_WAIT_V(2); G8_BAR; G8_WAIT_L(0); G8_MMA(0, 0, At, B0); G8_BAR;
      G8_LDB(B1, 1, 1); G8_WAIT_V(0); G8_BAR; G8_WAIT_L(0); G8_MMA(0, 1, At, B1); G8_BAR;
      G8_LDA(At, 1, 1); G8_BAR; G8_WAIT_L(0); G8_MMA(1, 0, At, B0); G8_MMA(1, 1, At, B1); G8_BAR;
    }
    if (wr == 0) G8_BAR;
    constexpr bool STAGED = (EPI == EPI_RESID || EPI == EPI_RESID0 || EPI == EPI_INPROJ);
    int lane2 = lane_id();
    asm volatile("" : "+v"(lane2));
    const int fr2 = lane2 & 15, fq2 = lane2 >> 4;
    f32x4* stg = reinterpret_cast<f32x4*>(lds_all + wid * 16384);
    if constexpr (STAGED) {
#pragma unroll
      for (int b0 = 0; b0 < 2; ++b0)
#pragma unroll
        for (int m = 0; m < 4; ++m)
#pragma unroll
          for (int n = 0; n < 2; ++n) stg[(((b0 * 4 + m) * 2 + n) * 64) + lane2] = acc[0][b0][m][n];
    }
    gemm8_epilogue<EPI, STAGED>(p, acc, stg, lane2, brow, bcol, wr, wc, fr2, fq2, layer, gscale);
    asm volatile("s_waitcnt vmcnt(0)" ::: "memory");
    if constexpr (STAGED) __syncthreads();
  }
  __syncthreads();
  if (ntiles < ntiles_all) {
    constexpr int EPI_T = (EPI == EPI_RESID0) ? EPI_RESID : EPI;
    gemm_phase<EPI_T>(p, A, lda, Bt, ldb, 0, 0, K, layer, lds_all + (wid >> 2) * LDS_HALF, 1.f, ntiles, ntiles_all - ntiles, Ntiles);
  }
#undef G8_SA
#undef G8_SB
#undef G8_STAGE
#undef G8_LDA
#undef G8_LDB
#undef G8_MMA
#undef G8_WAIT_V
#undef G8_WAIT_L
#undef G8_BAR
#undef G8_SCHED
}

DEVI bf16x8 scale_q(uint4 u) {
  uint4 r;
  r.x = pack2(bflo(u.x) * 0.125f, bfhi(u.x) * 0.125f);
  r.y = pack2(bflo(u.y) * 0.125f, bfhi(u.y) * 0.125f);
  r.z = pack2(bflo(u.z) * 0.125f, bfhi(u.z) * 0.125f);
  r.w = pack2(bflo(u.w) * 0.125f, bfhi(u.w) * 0.125f);
  return __builtin_bit_cast(bf16x8, r);
}
DEVI void phase_attn(PP p, int layer, bool with_ctx_q, unsigned char* lds) {
  const int tid = ltid();
  const int lane = tid & 63, wid = __builtin_amdgcn_readfirstlane(tid >> 6), r = lane & 31, h = lane >> 5;
  const float* sinkp = p->attn_sink + (layer >> 1) * 8;
  const int nlat = NB * 2 * 128;
  const int nunits = nlat + (with_ctx_q ? NB * 2 * 8 : 0);
  for (int u = lbid(); u < nunits; u += lnblk()) {
    bool latent = u < nlat;
    int b, kvh, qg, tokbase;
    if (latent) {
      b = u >> 8;
      kvh = (u >> 7) & 1;
      qg = u & 127;
      tokbase = b * SEQ + qg * 32;
    } else {
      int v = u - nlat;
      b = v >> 4;
      kvh = (v >> 3) & 1;
      qg = v & 7;
      tokbase = TL + b * CTX + qg * 32;
    }
    const int hd = kvh * 4 + wid;
    const bf16_t* kb = p->kbuf + (size_t)(b * 2 + kvh) * KVLEN * 64;
    const bf16_t* vt = p->vbuf + (size_t)(b * 2 + kvh) * 64 * KVLEN;
    const int nch = latent ? 5 : 2;
    const int lbase = CTX + (qg - 4) * 32;
#define ATT_STAGE(c_, buf_)                                                                                           \
  {                                                                                                                   \
    const int kp0_ = ((c_) < 2) ? (c_) * 128 : lbase + ((c_) - 2) * 128;                                              \
    _Pragma("unroll") for (int i_ = 0; i_ < 4; ++i_) {                                                                \
      const int P_ = tid * 16 + i_ * 4096;                                                                            \
      const int krow_ = P_ >> 7, kslot_ = (P_ >> 4) & 7;                                                              \
      int kp_ = kp0_ + krow_;                                                                                         \
      kp_ = kp_ < 0 ? 0 : (kp_ > KVLEN - 1 ? KVLEN - 1 : kp_);                                                        \
      __builtin_amdgcn_global_load_lds((const unsigned*)(kb + (size_t)kp_ * 64 + ((kslot_ ^ ((krow_ >> 1) & 7)) << 3)), \
                                       (__attribute__((address_space(3))) unsigned*)(lds + (buf_) * 32768 + P_), 16, 0, 0); \
      const int vrow_ = P_ >> 8, vslot_ = (P_ >> 4) & 15;                                                             \
      int vp_ = kp0_ + ((vslot_ ^ (vrow_ & 15)) << 3);                                                                \
      vp_ = vp_ < 0 ? 0 : (vp_ > KVLEN - 8 ? KVLEN - 8 : vp_);                                                        \
      __builtin_amdgcn_global_load_lds((const unsigned*)(vt + (size_t)vrow_ * KVLEN + vp_),                           \
                                       (__attribute__((address_space(3))) unsigned*)(lds + (buf_) * 32768 + 16384 + P_), 16, 0, 0); \
    }                                                                                                                 \
  }
    __syncthreads();
    ATT_STAGE(0, 0)
    bf16x8 qf[4];
    {
      const bf16_t* qp = p->P + (size_t)(tokbase + r) * 2048 + hd * 64 + 8 * h;
#pragma unroll
      for (int st = 0; st < 4; ++st) qf[st] = scale_q(*reinterpret_cast<const uint4*>(qp + 16 * st));
    }
    f32x16 O0, O1;
#pragma unroll
    for (int i = 0; i < 16; ++i) {
      O0[i] = 0.f;
      O1[i] = 0.f;
    }
    float m_run = sinkp[hd];
    float l_run = (h == 0) ? 1.f : 0.f;
    for (int c = 0; c < nch; ++c) {
      const int buf = c & 1;
      asm volatile("s_waitcnt vmcnt(0)" ::: "memory");
      __syncthreads();
      if (c + 1 < nch) ATT_STAGE(c + 1, buf ^ 1)
      const unsigned char* LK = lds + buf * 32768;
      const unsigned char* LV = LK + 16384;
#pragma unroll 1
      for (int kbi = 0; kbi < 4; ++kbi) {
        int mode = 0;
        if (c >= 2) {
          const int d = (c - 2) * 4 + kbi - 4;
          const int kblk = qg + d;
          if (d > 4 || kblk < 0 || kblk > 127) continue;
          mode = (d == -4) ? 1 : ((d == 4) ? 2 : 0);
        }
        f32x16 S;
#pragma unroll
        for (int i = 0; i < 16; ++i) S[i] = 0.f;
        {
          const int krow = kbi * 32 + r;
#pragma unroll
          for (int st = 0; st < 4; ++st) {
            bf16x8 kf = *reinterpret_cast<const bf16x8*>(LK + krow * 128 + (((2 * st + h) ^ ((krow >> 1) & 7)) << 4));
            S = __builtin_amdgcn_mfma_f32_32x32x16_bf16(kf, qf[st], S, 0, 0, 0);
          }
        }
        if (mode) {
          float negbig;
          asm volatile("v_mov_b32 %0, 0xf149f2ca" : "=v"(negbig));
#pragma unroll
          for (int i = 0; i < 16; ++i) {
            int kk = (i & 3) + 8 * (i >> 2) + 4 * h;
            bool ok = (mode == 1) ? (kk >= r) : (kk <= r);
            if (!ok) S[i] = negbig;
          }
        }
        float bm = S[0];
#pragma unroll
        for (int i = 1; i < 16; ++i) bm = fmaxf(bm, S[i]);
        bm = fmaxf(bm, shx_f(bm, 32));
        float m_new = fmaxf(m_run, bm);
        const float L2E = 1.4426950408889634f;
        float nm = -m_new * L2E;
        float psum = 0.f;
#pragma unroll
        for (int i = 0; i < 16; ++i) {
          S[i] = __builtin_amdgcn_exp2f(fmaf(S[i], L2E, nm));
          psum += S[i];
        }
        if (__any(m_new > m_run)) {
          float alpha = __builtin_amdgcn_exp2f((m_run - m_new) * L2E);
          l_run *= alpha;
#pragma unroll
          for (int i = 0; i < 16; ++i) {
            O0[i] *= alpha;
            O1[i] *= alpha;
          }
        }
        l_run += psum;
        m_run = m_new;
#pragma unroll
        for (int sidx = 0; sidx < 2; ++sidx) {
          uint4 pk;
          pk.x = pack2(S[8 * sidx + 0], S[8 * sidx + 1]);
          pk.y = pack2(S[8 * sidx + 2], S[8 * sidx + 3]);
          pk.z = pack2(S[8 * sidx + 4], S[8 * sidx + 5]);
          pk.w = pack2(S[8 * sidx + 6], S[8 * sidx + 7]);
          bf16x8 pf = __builtin_bit_cast(bf16x8, pk);
          const int vch = 4 * kbi + 2 * sidx + h;
          bf16x8 v0 = *reinterpret_cast<const bf16x8*>(LV + r * 256 + ((vch ^ (r & 15)) << 4));
          bf16x8 v1 = *reinterpret_cast<const bf16x8*>(LV + (32 + r) * 256 + ((vch ^ (r & 15)) << 4));
          O0 = __builtin_amdgcn_mfma_f32_32x32x16_bf16(v0, pf, O0, 0, 0, 0);
          O1 = __builtin_amdgcn_mfma_f32_32x32x16_bf16(v1, pf, O1, 0, 0, 0);
        }
      }
    }
#undef ATT_STAGE
    float l_tot = l_run + shx_f(l_run, 32);
    float inv = 1.f / l_tot;
    bf16_t* op = p->mix + (size_t)(tokbase + r) * LDMIX + hd * 64 + 4 * h;
#pragma unroll
    for (int g4 = 0; g4 < 4; ++g4) {
      uint2 o;
      o.x = pack2(O0[4 * g4 + 0] * inv, O0[4 * g4 + 1] * inv);
      o.y = pack2(O0[4 * g4 + 2] * inv, O0[4 * g4 + 3] * inv);
      *reinterpret_cast<uint2*>(op + 8 * g4) = o;
      o.x = pack2(O1[4 * g4 + 0] * inv, O1[4 * g4 + 1] * inv);
      o.y = pack2(O1[4 * g4 + 2] * inv, O1[4 * g4 + 3] * inv);
      *reinterpret_cast<uint2*>(op + 32 + 8 * g4) = o;
    }
  }
  __syncthreads();
}

DEVI void fill_tw(float2* tw, int n) {
  for (int i = ltid(); i < n; i += NTHREADS) {
    float sn, cn;
    sincospif(2.f * (float)i / (float)n, &sn, &cn);
    tw[i] = make_float2(cn, sn);
  }
  __syncthreads();
}

DEVI bf16x8 lds_col8(const bf16_t* bp, int stride) {
  unsigned e0 = bp[0], e1 = bp[stride], e2 = bp[2 * stride], e3 = bp[3 * stride];
  unsigned e4 = bp[4 * stride], e5 = bp[5 * stride], e6 = bp[6 * stride], e7 = bp[7 * stride];
  uint4 pk;
  pk.x = e0 | (e1 << 16);
  pk.y = e2 | (e3 << 16);
  pk.z = e4 | (e5 << 16);
  pk.w = e6 | (e7 << 16);
  return __builtin_bit_cast(bf16x8, pk);
}

DEVI void phase_fft_a(PP p, unsigned char* lds) {
  const int tid = ltid();
  const int lane = tid & 63, wid = __builtin_amdgcn_readfirstlane(tid >> 6), fr = lane & 15, fq = lane >> 4;
  float2* tw = reinterpret_cast<float2*>(lds + 66560);
  fill_tw(tw, 64);
  bf16x8 af[2][2];
#pragma unroll
  for (int ks = 0; ks < 2; ++ks) {
    unsigned short cr[8], ci[8];
#pragma unroll
    for (int j = 0; j < 8; ++j) {
      int n1 = 32 * ks + 8 * fq + j, k1 = 16 * wid + fr;
      float2 t = tw[(k1 * n1) & 63];
      cr[j] = f2bf(t.x);
      ci[j] = f2bf(-t.y);
    }
    uint4 a0, a1;
    a0.x = cr[0] | ((unsigned)cr[1] << 16); a0.y = cr[2] | ((unsigned)cr[3] << 16);
    a0.z = cr[4] | ((unsigned)cr[5] << 16); a0.w = cr[6] | ((unsigned)cr[7] << 16);
    a1.x = ci[0] | ((unsigned)ci[1] << 16); a1.y = ci[2] | ((unsigned)ci[3] << 16);
    a1.z = ci[4] | ((unsigned)ci[5] << 16); a1.w = ci[6] | ((unsigned)ci[7] << 16);
    af[0][ks] = __builtin_bit_cast(bf16x8, a0);
    af[1][ks] = __builtin_bit_cast(bf16x8, a1);
  }
  const bf16_t* l16 = reinterpret_cast<const bf16_t*>(lds);
  for (int u = lbid(); u < NB * 64; u += lnblk()) {
    int b = u >> 6, n2 = u & 63;
    __syncthreads();
#pragma unroll
    for (int i = 0; i < 16; ++i) {
      int row = (tid >> 6) + 4 * i, piece = tid & 63;
      uint4 v = *reinterpret_cast<const uint4*>(p->P + (size_t)(b * SEQ + 64 * row + n2) * 2048 + 768 + piece * 8);
      *reinterpret_cast<uint4*>(lds + row * 1040 + piece * 16) = v;
    }
    __syncthreads();
    float tc[4], ts[4];
#pragma unroll
    for (int j = 0; j < 4; ++j) sincospif((float)(n2 * (16 * wid + 4 * fq + j)) / 2048.f, &ts[j], &tc[j]);
    for (int nb = 0; nb < 4; ++nb) {
      f32x4 acc[2][8];
#pragma unroll
      for (int n = 0; n < 8; ++n) {
        acc[0][n] = f32x4{0.f, 0.f, 0.f, 0.f};
        acc[1][n] = f32x4{0.f, 0.f, 0.f, 0.f};
      }
#pragma unroll
      for (int ks = 0; ks < 2; ++ks)
#pragma unroll
        for (int nf = 0; nf < 8; ++nf) {
          bf16x8 bfr = lds_col8(l16 + (32 * ks + 8 * fq) * 520 + 128 * nb + 16 * nf + fr, 520);
          acc[0][nf] = __builtin_amdgcn_mfma_f32_16x16x32_bf16(af[0][ks], bfr, acc[0][nf], 0, 0, 0);
          acc[1][nf] = __builtin_amdgcn_mfma_f32_16x16x32_bf16(af[1][ks], bfr, acc[1][nf], 0, 0, 0);
        }
#pragma unroll
      for (int j = 0; j < 4; ++j) {
        int k1 = 16 * wid + 4 * fq + j;
        bf16_t* o = p->fa + (size_t)(b * SEQ + k1 * 64 + n2) * 1024 + 128 * nb + fr;
#pragma unroll
        for (int nf = 0; nf < 8; ++nf) {
          float re = acc[0][nf][j], im = acc[1][nf][j];
          o[16 * nf] = f2bf(re * tc[j] + im * ts[j]);
          o[512 + 16 * nf] = f2bf(im * tc[j] - re * ts[j]);
        }
      }
    }
  }
  __syncthreads();
}

DEVI void phase_fft_b(PP p, unsigned char* lds) {
  const int tid = ltid();
  const int lane = tid & 63, wid = __builtin_amdgcn_readfirstlane(tid >> 6), fr = lane & 15, fq = lane >> 4;
  float2* tw = reinterpret_cast<float2*>(lds + 67584);
  fill_tw(tw, 64);
  bf16x8 wb[2][4];
#pragma unroll
  for (int ks = 0; ks < 4; ++ks) {
    unsigned short zr[8], zi[8];
#pragma unroll
    for (int j = 0; j < 8; ++j) {
      int k = 32 * ks + 8 * fq + j, part = k >> 6, n2 = k & 63, k2 = 16 * wid + fr;
      float2 t = tw[(k2 * n2) & 63];
      zr[j] = f2bf(part ? t.y : t.x);
      zi[j] = f2bf(part ? t.x : -t.y);
    }
    uint4 a0, a1;
    a0.x = zr[0] | ((unsigned)zr[1] << 16); a0.y = zr[2] | ((unsigned)zr[3] << 16);
    a0.z = zr[4] | ((unsigned)zr[5] << 16); a0.w = zr[6] | ((unsigned)zr[7] << 16);
    a1.x = zi[0] | ((unsigned)zi[1] << 16); a1.y = zi[2] | ((unsigned)zi[3] << 16);
    a1.z = zi[4] | ((unsigned)zi[5] << 16); a1.w = zi[6] | ((unsigned)zi[7] << 16);
    wb[0][ks] = __builtin_bit_cast(bf16x8, a0);
    wb[1][ks] = __builtin_bit_cast(bf16x8, a1);
  }
  const bf16_t* l16 = reinterpret_cast<const bf16_t*>(lds);
  const float scale = 0.0013810679320049757f;
  for (int u = lbid(); u < NB * 128; u += lnblk()) {
    int b = u >> 7, k1 = (u >> 1) & 63, hf = u & 1;
    __syncthreads();
#pragma unroll
    for (int i = 0; i < 16; ++i) {
      int row = (tid >> 5) + 8 * i, piece = tid & 31;
      int part = row >> 6, n2 = row & 63;
      uint4 v = *reinterpret_cast<const uint4*>(p->fa + (size_t)(b * SEQ + k1 * 64 + n2) * 1024 + part * 512 + hf * 256 + piece * 8);
      *reinterpret_cast<uint4*>(lds + row * 528 + piece * 16) = v;
    }
    __syncthreads();
    for (int nb = 0; nb < 2; ++nb) {
      f32x4 acc[2][8];
#pragma unroll
      for (int n = 0; n < 8; ++n) {
        acc[0][n] = f32x4{0.f, 0.f, 0.f, 0.f};
        acc[1][n] = f32x4{0.f, 0.f, 0.f, 0.f};
      }
#pragma unroll
      for (int ks = 0; ks < 4; ++ks)
#pragma unroll
        for (int nf = 0; nf < 8; ++nf) {
          bf16x8 bfr = lds_col8(l16 + (32 * ks + 8 * fq) * 264 + 128 * nb + 16 * nf + fr, 264);
          acc[0][nf] = __builtin_amdgcn_mfma_f32_16x16x32_bf16(wb[0][ks], bfr, acc[0][nf], 0, 0, 0);
          acc[1][nf] = __builtin_amdgcn_mfma_f32_16x16x32_bf16(wb[1][ks], bfr, acc[1][nf], 0, 0, 0);
        }
#pragma unroll
      for (int j = 0; j < 4; ++j) {
        int k2 = 16 * wid + 4 * fq + j;
        bf16_t* o = p->mix + (size_t)(b * SEQ + k1 + 64 * k2) * LDMIX + 512 + hf * 256 + 128 * nb + fr;
#pragma unroll
        for (int nf = 0; nf < 8; ++nf) {
          o[16 * nf] = f2bf(acc[0][nf][j] * scale);
          o[512 + 16 * nf] = f2bf(acc[1][nf][j] * scale);
        }
      }
    }
  }
  __syncthreads();
}

DEVI void phase_dft_ctx(PP p, unsigned char* lds) {
  float2* tw = reinterpret_cast<float2*>(lds);
  fill_tw(tw, 256);
  int tid = ltid();
  const float scale = 0.005524271728019903f;
  for (int u = lbid(); u < NB * 64; u += lnblk()) {
    int b = u >> 6, k0 = (u & 63) * 4;
    for (int pass = 0; pass < 2; ++pass) {
      int ch = tid + pass * 256;
      float zr[4], zi[4];
#pragma unroll
      for (int kk = 0; kk < 4; ++kk) zr[kk] = zi[kk] = 0.f;
#pragma unroll 8
      for (int n = 0; n < 256; ++n) {
        float v = bf2f(p->P[(size_t)(TL + b * CTX + n) * 2048 + 768 + ch]);
#pragma unroll
        for (int kk = 0; kk < 4; ++kk) {
          float2 t = tw[(n * (k0 + kk)) & 255];
          zr[kk] += v * t.x;
          zi[kk] -= v * t.y;
        }
      }
#pragma unroll
      for (int kk = 0; kk < 4; ++kk) {
        bf16_t* o = p->mix + (size_t)(TL + b * CTX + k0 + kk) * LDMIX;
        o[512 + ch] = f2bf(zr[kk] * scale);
        o[1024 + ch] = f2bf(zi[kk] * scale);
      }
    }
  }
  __syncthreads();
}

DEVI void phase_sgu(PP p, int j, int nchunks, unsigned char* lds) {
  float* rs = reinterpret_cast<float*>(lds);
  unsigned char* LA = lds + 1024;
  unsigned char* LB = lds + 1024 + 32768;
  const int tid = ltid();
  const int lane = tid & 63, wid = __builtin_amdgcn_readfirstlane(tid >> 6), fr = lane & 15, fq = lane >> 4;
  const float* nw = p->gs_norm_w + j * 1024;
  for (int u = lbid(); u < nchunks * 8; u += lnblk()) {
    const int chunk = u >> 3, g = u & 7;
    const int tok0 = chunk * 128;
    const bf16_t* vT = p->zvT + ((size_t)chunk * 1024 + g * 128) * 128;
    __syncthreads();
    if (tid < 128) {
      const float* rp = p->rowss + (size_t)chunk * 32 * 128 + tid;
      float ss = 0.f;
#pragma unroll
      for (int sl = 0; sl < 32; ++sl) ss += rp[sl * 128];
      rs[tid] = rsqrtf(ss * (1.f / 1024.f) + 1e-6f);
    }
#pragma unroll
    for (int i = 0; i < 8; ++i) {
      int idx = tid + 256 * i, row = idx >> 4, c = idx & 15;
      uint4 v = *reinterpret_cast<const uint4*>(vT + (size_t)row * 128 + c * 8);
      *reinterpret_cast<uint4*>(LB + row * 256 + ((c ^ (row & 15)) << 4)) = v;
    }
    __syncthreads();
    {
      const float* wsg = p->gs_w_s + ((size_t)j * 8 + g) * 128 * 128;
#pragma unroll
      for (int i = 0; i < 8; ++i) {
        int idx = tid + 256 * i, row = idx >> 4, c = idx & 15;
        const float4* wp = reinterpret_cast<const float4*>(wsg + (size_t)row * 128 + c * 8);
        float4 w0 = wp[0], w1 = wp[1];
        const float* rk = rs + c * 8;
        uint4 pk;
        pk.x = pack2(w0.x * rk[0], w0.y * rk[1]);
        pk.y = pack2(w0.z * rk[2], w0.w * rk[3]);
        pk.z = pack2(w1.x * rk[4], w1.y * rk[5]);
        pk.w = pack2(w1.z * rk[6], w1.w * rk[7]);
        *reinterpret_cast<uint4*>(LA + row * 256 + ((c ^ (row & 15)) << 4)) = pk;
      }
    }
    __syncthreads();
    f32x4 acc[2][8];
#pragma unroll
    for (int m = 0; m < 2; ++m)
#pragma unroll
      for (int n = 0; n < 8; ++n) acc[m][n] = f32x4{0.f, 0.f, 0.f, 0.f};
#pragma unroll
    for (int ks = 0; ks < 4; ++ks) {
      const int sl = ((4 * ks + fq) ^ fr) << 4;
      bf16x8 a0 = *reinterpret_cast<const bf16x8*>(LA + (32 * wid + fr) * 256 + sl);
      bf16x8 a1 = *reinterpret_cast<const bf16x8*>(LA + (32 * wid + 16 + fr) * 256 + sl);
#pragma unroll
      for (int n = 0; n < 8; ++n) {
        bf16x8 bfr = *reinterpret_cast<const bf16x8*>(LB + (16 * n + fr) * 256 + sl);
        acc[0][n] = __builtin_amdgcn_mfma_f32_16x16x32_bf16(a0, bfr, acc[0][n], 0, 0, 0);
        acc[1][n] = __builtin_amdgcn_mfma_f32_16x16x32_bf16(a1, bfr, acc[1][n], 0, 0, 0);
      }
    }
    __syncthreads();
    {
      const float* bsg = p->gs_b_s + ((size_t)j * 8 + g) * 128;
#pragma unroll
      for (int m = 0; m < 2; ++m)
#pragma unroll
        for (int jj = 0; jj < 4; ++jj) {
          const int pp = 32 * wid + 16 * m + 4 * fq + jj;
          const float bias = bsg[pp];
#pragma unroll
          for (int n = 0; n < 8; ++n) {
            const int c = 16 * n + fr;
            float sv = nw[g * 128 + c] * acc[m][n][jj] + bias;
            *reinterpret_cast<bf16_t*>(LA + pp * 256 + (((c >> 3) ^ (pp & 15)) << 4) + (c & 7) * 2) = f2bf(sv);
          }
        }
    }
    __syncthreads();
#pragma unroll
    for (int i = 0; i < 8; ++i) {
      int idx = tid + 256 * i, row = idx >> 4, c = idx & 15;
      uint4 sv8 = *reinterpret_cast<const uint4*>(LA + row * 256 + ((c ^ (row & 15)) << 4));
      uint4 u8 = *reinterpret_cast<const uint4*>(p->P + (size_t)(tok0 + row) * 2048 + g * 128 + c * 8);
      uint4 o;
      o.x = pack2(bflo(u8.x) * bflo(sv8.x), bfhi(u8.x) * bfhi(sv8.x));
      o.y = pack2(bflo(u8.y) * bflo(sv8.y), bfhi(u8.y) * bfhi(sv8.y));
      o.z = pack2(bflo(u8.z) * bflo(sv8.z), bfhi(u8.z) * bfhi(sv8.z));
      o.w = pack2(bflo(u8.w) * bflo(sv8.w), bfhi(u8.w) * bfhi(sv8.w));
      *reinterpret_cast<uint4*>(p->mix + (size_t)(tok0 + row) * LDMIX + g * 128 + c * 8) = o;
    }
  }
  __syncthreads();
}

DEVI float mkkey(float v, unsigned idx, unsigned mask) { return __uint_as_float((__float_as_uint(v) & ~mask) | idx); }
#define INSERT16(list, x)                                                                                               \
  {                                                                                                                     \
    _Pragma("unroll") for (int i_ = 15; i_ >= 1; --i_) list[i_] = __builtin_amdgcn_fmed3f(list[i_ - 1], list[i_], x); \
    list[0] = fmaxf(list[0], x);                                                                                        \
  }

DEVI void phase_route(PP p, int layer, int ntok, unsigned char* lds) {
  const int tid = ltid();
  const int lane = tid & 63, wid = __builtin_amdgcn_readfirstlane(tid >> 6), fr = lane & 15, fq = lane >> 4;
  const int nb8 = lnblk() >> 3, bid = lbid();
  const int hh = bid & 7, slot = bid >> 3;
  const int ntiles = ntok / 64;
  const bool active = slot < nb8;
  float* sc = reinterpret_cast<float*>(lds + 32768);
  const float NEGK = -3.0e38f;
  for (int half = 0; half < 2; ++half) {
    __syncthreads();
    {
      const bf16_t* ksrc = p->keysb + ((size_t)((layer * 8 + hh) * 2 + half) * 128) * 128;
#pragma unroll
      for (int i = 0; i < 8; ++i) {
        int idx = tid + 256 * i, row = idx >> 4, c = idx & 15;
        uint4 v = *reinterpret_cast<const uint4*>(ksrc + (size_t)row * 128 + c * 8);
        *reinterpret_cast<uint4*>(lds + row * 256 + ((c ^ (row & 15)) << 4)) = v;
      }
    }
    __syncthreads();
    bf16x8 an[4];
    if (active && slot < ntiles) {
      const bf16_t* qa = p->P + (size_t)(slot * 64 + wid * 16 + fr) * 2048 + hh * 256 + half * 128 + fq * 8;
#pragma unroll
      for (int ks = 0; ks < 4; ++ks) an[ks] = *reinterpret_cast<const bf16x8*>(qa + ks * 32);
    }
    for (int tt = slot; active && tt < ntiles; tt += nb8) {
      const int tok0 = tt * 64;
      {
        bf16x8 a[4];
#pragma unroll
        for (int ks = 0; ks < 4; ++ks) a[ks] = an[ks];
        {
          const int ttn = (tt + nb8 < ntiles) ? tt + nb8 : tt;
          const bf16_t* qa = p->P + (size_t)(ttn * 64 + wid * 16 + fr) * 2048 + hh * 256 + half * 128 + fq * 8;
#pragma unroll
          for (int ks = 0; ks < 4; ++ks) an[ks] = *reinterpret_cast<const bf16x8*>(qa + ks * 32);
        }
#pragma unroll
        for (int nf = 0; nf < 8; ++nf) {
          f32x4 acc = f32x4{0.f, 0.f, 0.f, 0.f};
          const int krow = nf * 16 + fr;
#pragma unroll
          for (int ks = 0; ks < 4; ++ks) {
            bf16x8 bb = *reinterpret_cast<const bf16x8*>(lds + krow * 256 + (((4 * ks + fq) ^ (krow & 15)) << 4));
            acc = __builtin_amdgcn_mfma_f32_16x16x32_bf16(a[ks], bb, acc, 0, 0, 0);
          }
#pragma unroll
          for (int j = 0; j < 4; ++j) sc[(wid * 16 + fq * 4 + j) * 129 + krow] = mkkey(acc[j], (unsigned)krow, 127u);
        }
      }
      __syncthreads();
      const int row = tid & 63, part = tid >> 6;
      float list[16];
#pragma unroll
      for (int i = 0; i < 16; ++i) list[i] = NEGK;
      {
        const float* kr = sc + row * 129 + part * 32;
#pragma unroll 4
        for (int e = 0; e < 32; ++e) {
          float x = kr[e];
          INSERT16(list, x)
        }
      }
      __syncthreads();
      if (part & 1) {
#pragma unroll
        for (int i = 0; i < 16; ++i) sc[(row * 2 + (part >> 1)) * 17 + i] = list[i];
      }
      __syncthreads();
      if (!(part & 1)) {
#pragma unroll
        for (int i = 0; i < 16; ++i) {
          float x = sc[(row * 2 + (part >> 1)) * 17 + i];
          INSERT16(list, x)
        }
      }
      __syncthreads();
      if (part == 2) {
#pragma unroll
        for (int i = 0; i < 16; ++i) sc[row * 17 + i] = list[i];
      }
      __syncthreads();
      if (part == 0) {
#pragma unroll
        for (int i = 0; i < 16; ++i) {
          float x = sc[row * 17 + i];
          INSERT16(list, x)
        }
        float4* o = reinterpret_cast<float4*>(p->tops + ((size_t)(tok0 + row) * 16 + hh * 2 + half) * 16);
        o[0] = make_float4(list[0], list[1], list[2], list[3]);
        o[1] = make_float4(list[4], list[5], list[6], list[7]);
        o[2] = make_float4(list[8], list[9], list[10], list[11]);
        o[3] = make_float4(list[12], list[13], list[14], list[15]);
      }
      __syncthreads();
    }
  }
  __syncthreads();
  float* fl = reinterpret_cast<float*>(lds);
  for (int t4 = slot; active && t4 < ntiles + 3 * nb8; t4 += 4 * nb8) {
    const int tt = t4 + (tid >> 6) * nb8;
    if (tt < ntiles) {
      const int tok = tt * 64 + (tid & 63);
      const float4* src = reinterpret_cast<const float4*>(p->tops + ((size_t)tok * 16 + hh * 2) * 16);
      float v0[16], v1[16];
#pragma unroll
      for (int i = 0; i < 4; ++i) {
        float4 a = src[i], bq = src[4 + i];
        v0[4 * i] = a.x; v0[4 * i + 1] = a.y; v0[4 * i + 2] = a.z; v0[4 * i + 3] = a.w;
        v1[4 * i] = bq.x; v1[4 * i + 1] = bq.y; v1[4 * i + 2] = bq.z; v1[4 * i + 3] = bq.w;
      }
      float* f0 = fl + tid * 33;
      float* f1 = f0 + 16;
#pragma unroll
      for (int i = 0; i < 16; ++i) {
        f0[i] = v0[i];
        f1[i] = v1[i];
      }
      float l2[16];
#pragma unroll
      for (int i = 0; i < 16; ++i) l2[i] = mkkey(v0[0] + v1[i], (unsigned)(15 - i), 255u);
#pragma unroll
      for (int a = 1; a < 16; ++a)
#pragma unroll
        for (int bq = 0; bq < 16; ++bq)
          if ((a + 1) * (bq + 1) <= 16) {
            float x = mkkey(v0[a] + v1[bq], (unsigned)(a * 16 + 15 - bq), 255u);
            INSERT16(l2, x)
          }
      float sv[16];
      int ev[16];
      float mx = NEGK;
#pragma unroll
      for (int k = 0; k < 16; ++k) {
        unsigned ab = __float_as_uint(l2[k]) & 255u;
        unsigned k0 = __float_as_uint(f0[ab >> 4]), k1 = __float_as_uint(f1[15u - (ab & 15u)]);
        sv[k] = __uint_as_float(k0 & ~127u) + __uint_as_float(k1 & ~127u);
        ev[k] = (int)((k0 & 127u) * 128u + (k1 & 127u));
        mx = fmaxf(mx, sv[k]);
      }
      float sum = 0.f;
#pragma unroll
      for (int k = 0; k < 16; ++k) {
        sv[k] = __expf(sv[k] - mx);
        sum += sv[k];
      }
      float inv = 1.f / sum;
      size_t o = (size_t)tok * 128 + hh * 16;
      int4* eo = reinterpret_cast<int4*>(p->eidx + o);
      float4* go = reinterpret_cast<float4*>(p->gate + o);
#pragma unroll
      for (int k4 = 0; k4 < 4; ++k4) {
        eo[k4] = make_int4(ev[4 * k4], ev[4 * k4 + 1], ev[4 * k4 + 2], ev[4 * k4 + 3]);
        go[k4] = make_float4(sv[4 * k4] * inv, sv[4 * k4 + 1] * inv, sv[4 * k4 + 2] * inv, sv[4 * k4 + 3] * inv);
      }
    }
  }
  __syncthreads();
}

typedef float v2f __attribute__((ext_vector_type(2)));
DEVI void dec16(uint4 q, v2f* f) {
  f[0] = __builtin_amdgcn_cvt_pk_f32_fp8((int)q.x, false);
  f[1] = __builtin_amdgcn_cvt_pk_f32_fp8((int)q.x, true);
  f[2] = __builtin_amdgcn_cvt_pk_f32_fp8((int)q.y, false);
  f[3] = __builtin_amdgcn_cvt_pk_f32_fp8((int)q.y, true);
  f[4] = __builtin_amdgcn_cvt_pk_f32_fp8((int)q.z, false);
  f[5] = __builtin_amdgcn_cvt_pk_f32_fp8((int)q.z, true);
  f[6] = __builtin_amdgcn_cvt_pk_f32_fp8((int)q.w, false);
  f[7] = __builtin_amdgcn_cvt_pk_f32_fp8((int)q.w, true);
}
struct ExpBuf {
  uint4 q[8];
  uint4 h0, h1;
};
DEVI void exp_load(ExpBuf& B, const unsigned char* tab, const signed char* hrow, const unsigned short* idp, int j8, bool want_x) {
  const uint4 idv = *reinterpret_cast<const uint4*>(idp);
  const unsigned idw[4] = {idv.x, idv.y, idv.z, idv.w};
#pragma unroll
  for (int i = 0; i < 8; ++i) {
    unsigned e = (i & 1) ? (idw[i >> 1] >> 16) : (idw[i >> 1] & 0xffffu);
    unsigned off = e * (unsigned)D + 16u * j8;
    B.q[i] = *reinterpret_cast<const uint4*>(tab + off);
  }
  if (want_x) B.h0 = *reinterpret_cast<const uint4*>(hrow + 16 * j8);
}
template <int CTRL>
DEVI int dpp_movi(int v) { return __builtin_amdgcn_mov_dpp(v, CTRL, 0xF, 0xF, true); }
DEVI void exp_u_compute(const ExpBuf& B, int* pp, int j8) {
  int s0 = 0;
#pragma unroll
  for (int i = 0; i < 8; ++i) {
    int d = __builtin_amdgcn_sdot4((int)B.q[i].x, (int)B.h0.x, 0, false);
    d = __builtin_amdgcn_sdot4((int)B.q[i].y, (int)B.h0.y, d, false);
    d = __builtin_amdgcn_sdot4((int)B.q[i].z, (int)B.h0.z, d, false);
    d = __builtin_amdgcn_sdot4((int)B.q[i].w, (int)B.h0.w, d, false);
    d += dpp_movi<0xB1>(d);
    d += dpp_movi<0x4E>(d);
    d += dpp_movi<0x141>(d);
    s0 = (j8 == i) ? d : s0;
  }
  pp[0] += s0;
}
DEVI void exp_v_accum(const ExpBuf& B, unsigned w0, unsigned w1, int* acc) {
#pragma unroll
  for (int ig = 0; ig < 2; ++ig) {
    const unsigned wq = ig ? w1 : w0;
    const uint4 R0 = B.q[4 * ig], R1 = B.q[4 * ig + 1], R2 = B.q[4 * ig + 2], R3 = B.q[4 * ig + 3];
    const unsigned r0[4] = {R0.x, R0.y, R0.z, R0.w}, r1[4] = {R1.x, R1.y, R1.z, R1.w};
    const unsigned r2[4] = {R2.x, R2.y, R2.z, R2.w}, r3[4] = {R3.x, R3.y, R3.z, R3.w};
#pragma unroll
    for (int q = 0; q < 4; ++q) {
      unsigned A = __builtin_amdgcn_perm(r1[q], r0[q], 0x05010400u);
      unsigned Bq = __builtin_amdgcn_perm(r1[q], r0[q], 0x07030602u);
      unsigned C = __builtin_amdgcn_perm(r3[q], r2[q], 0x05010400u);
      unsigned E = __builtin_amdgcn_perm(r3[q], r2[q], 0x07030602u);
      unsigned D0 = __builtin_amdgcn_perm(C, A, 0x05040100u);
      unsigned D1 = __builtin_amdgcn_perm(C, A, 0x07060302u);
      unsigned D2 = __builtin_amdgcn_perm(E, Bq, 0x05040100u);
      unsigned D3 = __builtin_amdgcn_perm(E, Bq, 0x07060302u);
      acc[4 * q + 0] = __builtin_amdgcn_sdot4((int)D0, (int)wq, acc[4 * q + 0], false);
      acc[4 * q + 1] = __builtin_amdgcn_sdot4((int)D1, (int)wq, acc[4 * q + 1], false);
      acc[4 * q + 2] = __builtin_amdgcn_sdot4((int)D2, (int)wq, acc[4 * q + 2], false);
      acc[4 * q + 3] = __builtin_amdgcn_sdot4((int)D3, (int)wq, acc[4 * q + 3], false);
    }
  }
}
DEVI void exp_v_finish(float4* xo, const float4* xq, const float4* gq, int* acc, float swt, int grp, float gscale) {
  float o[16];
#pragma unroll
  for (int k = 0; k < 16; ++k) {
    int a = acc[k];
    a += dpp_movi<0x128>(a);
    a += shx_i(a, 16);
    a += shx_i(a, 32);
    o[k] = (float)a;
    acc[k] = 0;
  }
  if (grp == 0) {
    const float sc = gscale * swt;
#pragma unroll
    for (int i4 = 0; i4 < 4; ++i4) {
      float4 r = xq[i4];
      r.x += sc * gq[i4].x * o[i4 * 4 + 0];
      r.y += sc * gq[i4].y * o[i4 * 4 + 1];
      r.z += sc * gq[i4].z * o[i4 * 4 + 2];
      r.w += sc * gq[i4].w * o[i4 * 4 + 3];
      xo[i4] = r;
    }
  }
}
DEVI void phase_expert(PP p, int layer, int ntok, unsigned char* lds, float gscale = 1.f, int idmask = 0xffff) {
  const int tid = ltid();
  const int lane = tid & 63, wid = __builtin_amdgcn_readfirstlane(tid >> 6), j8 = lane & 7, grp = lane >> 3;
  const int nb = lnblk(), bid = lbid();
  unsigned short* ids = reinterpret_cast<unsigned short*>(lds);
  float* part = reinterpret_cast<float*>(lds + TPB * 128 * 2);
  unsigned char* w8 = lds + TPB * 128 * 2 + TPB * 128 * 4;
  float* swl = reinterpret_cast<float*>(lds + TPB * 128 * 2 + TPB * 128 * 4 + TPB * 128);
  const unsigned char* ut = p->utab + (size_t)layer * NEXP * D;
  const unsigned char* vt = p->vtab + (size_t)layer * NEXP * D;
  int tpb = (ntok + nb - 1) / nb;
  if (tpb > TPB) tpb = TPB;
  const int npass = (ntok + nb * tpb - 1) / (nb * tpb);
  for (int pass = 0; pass < npass; ++pass) {
    const int tok0 = (pass * nb + bid) * tpb;
    int cnt = ntok - tok0;
    if (cnt > tpb) cnt = tpb;
    if (cnt < 0) cnt = 0;
    for (int i = tid; i < cnt * 128; i += NTHREADS) {
      {
        int k = i & 127, hf = k >> 6, kk = k & 63;
        ids[(i & ~127) + hf * 64 + (kk & 7) * 8 + (kk >> 3)] = (unsigned short)(p->eidx[(size_t)tok0 * 128 + i] & idmask);
      }
      part[i] = 0.f;
    }
    __syncthreads();
    const int ntw = (cnt - wid + 3) >> 2;
    const int npair = ntw * 8;

    if (!(REP_MODE == 1 && gscale != 1.f)) {
      ExpBuf B0, B1;
      int c0 = 0, k0 = 0;
      if (npair > 0) {
        const int t0 = wid;
        exp_load(B0, ut, p->h8 + (size_t)(tok0 + t0) * D, ids + t0 * 128 + grp * 8, j8, true);
      }
      for (int pr = 0; pr < npair; ++pr) {
        const int t0 = wid + 4 * k0;
        exp_load(B1, ut + 128 * c0, p->h8 + (size_t)(tok0 + t0) * D + 128 * c0, ids + t0 * 128 + 64 + grp * 8, j8, true);
        exp_u_compute(B0, reinterpret_cast<int*>(part) + t0 * 128 + 8 * j8 + grp, j8);
        int c1 = c0, k1 = k0;
        if (pr + 1 < npair) {
          k1 = k0 + 1;
          if (k1 == ntw) {
            k1 = 0;
            c1 = c0 + 1;
          }
        }
        {
          const int t1 = wid + 4 * k1;
          exp_load(B0, ut + 128 * c1, p->h8 + (size_t)(tok0 + t1) * D + 128 * c1, ids + t1 * 128 + grp * 8, j8, true);
        }
        exp_u_compute(B1, reinterpret_cast<int*>(part) + t0 * 128 + 64 + 8 * j8 + grp, j8);
        c0 = c1;
        k0 = k1;
      }
    }
    __syncthreads();
    for (int t = wid; t < cnt; t += 4) {
      float wv2[2];
      float am = 0.f;
#pragma unroll
      for (int hh = 0; hh < 2; ++hh) {
        int k = lane + 64 * hh;
        int e = ids[t * 128 + hh * 64 + (lane & 7) * 8 + (lane >> 3)];
        float dq = (float)reinterpret_cast<int*>(part)[t * 128 + k] * p->su[(size_t)layer * NEXP + e] * p->sx[tok0 + t];
        float wv = p->gate[(size_t)(tok0 + t) * 128 + k] * gelu_tanh(dq) * p->sv[(size_t)layer * NEXP + e];
        wv2[hh] = wv;
        am = fmaxf(am, fabsf(wv));
      }
      am = fmaxf(wave_max(am), 1e-30f);
      float qs = 127.f / am;
#pragma unroll
      for (int hh = 0; hh < 2; ++hh) {
        int k = lane + 64 * hh;
        int q = (int)rintf(wv2[hh] * qs);
        w8[t * 128 + (k & 7) * 16 + hh * 8 + ((k >> 3) & 7)] = (unsigned char)(q & 255);
      }
      if (lane == 0) swl[t] = am * (1.f / 127.f);
    }
    __syncthreads();
    if (!(REP_MODE == 2 && gscale != 1.f)) {
      ExpBuf B0, B1;
      int acc[16];
#pragma unroll
      for (int k = 0; k < 16; ++k) acc[k] = 0;
      int c0 = 0, k0 = 0;
      if (npair > 0) {
        const int t0 = wid;
        exp_load(B0, vt, (const signed char*)nullptr, ids + t0 * 128 + grp * 8, j8, false);
      }
      for (int pr = 0; pr < npair; ++pr) {
        const int t0 = wid + 4 * k0;
        float4 xq[4], gq[4];
        float4* xo = reinterpret_cast<float4*>(p->xs + (size_t)(tok0 + t0) * D + 128 * c0 + 16 * j8);
        {
          const float4* gf = reinterpret_cast<const float4*>(p->mod + ((size_t)layer * 9 + tok_batch(tok0 + t0)) * 6144 + 5 * 1024 + 128 * c0 + 16 * j8);
#pragma unroll
          for (int i4 = 0; i4 < 4; ++i4) {
            xq[i4] = xo[i4];
            gq[i4] = gf[i4];
          }
        }
        exp_load(B1, vt + 128 * c0, (const signed char*)nullptr, ids + t0 * 128 + 64 + grp * 8, j8, false);
        const uint4 wq = *reinterpret_cast<const uint4*>(w8 + t0 * 128 + grp * 16);
        exp_v_accum(B0, wq.x, wq.y, acc);
        int c1 = c0, k1 = k0;
        if (pr + 1 < npair) {
          k1 = k0 + 1;
          if (k1 == ntw) {
            k1 = 0;
            c1 = c0 + 1;
          }
        }
        {
          const int t1 = wid + 4 * k1;
          exp_load(B0, vt + 128 * c1, (const signed char*)nullptr, ids + t1 * 128 + grp * 8, j8, false);
        }
        exp_v_accum(B1, wq.z, wq.w, acc);
        exp_v_finish(xo, xq, gq, acc, swl[t0], grp, gscale);
        c0 = c1;
        k0 = k1;
      }
    }
    asm volatile("s_waitcnt vmcnt(0)" ::: "memory");
    __syncthreads();
    if (gscale == 1.f) {
      for (int t = wid; t < cnt; t += 4) {
        if (layer + 1 < DEPTH) norm_row(p, layer + 1, 0, tok0 + t, lane);
        else if (tok0 + t < TL) norm_row(p, 0, 2, tok0 + t, lane);
      }
    }
    __syncthreads();
  }
}

#define XB_TMO 128
#define XB_XCNT(j) (256 + 64 * (j))
#define XB_XSUB(j) (1280 + 64 * (j))
#define XB_XGEN(j) (2304 + 64 * (j))
#define XB_TOP 3328
#define XB_TOPGEN 3392
#define XCD_BAR_WORDS 3456
#define XB_SPIN_CAP (1u << 22)
#define LAS __attribute__((address_space(3)))
DEVI unsigned xb_ld(unsigned* p) { return __hip_atomic_load(p, __ATOMIC_RELAXED, __HIP_MEMORY_SCOPE_AGENT); }
DEVI unsigned xb_add(unsigned* p, unsigned v) { return __hip_atomic_fetch_add(p, v, __ATOMIC_RELAXED, __HIP_MEMORY_SCOPE_AGENT); }
DEVI unsigned xb_xcc_id() { return (unsigned)__builtin_amdgcn_s_getreg((3 << 11) | 20) & 0xFu; }
#define XB_SPIN(cond, bar)                                   \
  do {                                                       \
    unsigned _sp = 0;                                        \
    while (cond) {                                           \
      __builtin_amdgcn_s_sleep(1);                           \
      if ((++_sp & 255u) == 0u) {                            \
        if (xb_ld(&(bar)[XB_TMO])) break;                    \
        if (_sp > XB_SPIN_CAP) {                             \
          atomicAdd(&(bar)[XB_TMO], 1u);                     \
          break;                                             \
        }                                                    \
      }                                                      \
    }                                                        \
  } while (0)
struct XcdBarrier {
  unsigned* bar;
  unsigned x;
  volatile LAS unsigned* st;
};
DEVI XcdBarrier xcd_barrier_post(unsigned* bar, volatile LAS unsigned* st) {
  XcdBarrier b;
  b.bar = bar;
  b.x = xb_xcc_id();
  b.st = st;
  if (threadIdx.x == 0) (void)xb_add(&bar[XB_XCNT(b.x)], 1u);
  return b;
}
DEVI void xcd_barrier_complete(unsigned* bar, unsigned x, unsigned& nloc, unsigned& nx) {
  const unsigned G = gridDim.x * gridDim.y * gridDim.z;
  unsigned sum, cnt, mine, sp = 0u;
  for (;;) {
    sum = 0u;
    cnt = 0u;
    mine = 0u;
#pragma unroll
    for (unsigned j = 0; j < 16; ++j) {
      const unsigned c = xb_ld(&bar[XB_XCNT(j)]);
      sum += c;
      cnt += (c > 0u) ? 1u : 0u;
      mine = (j == x) ? c : mine;
    }
    if (sum == G) break;
    __builtin_amdgcn_s_sleep(1);
    if ((++sp & 255u) == 0u) {
      if (xb_ld(&bar[XB_TMO])) break;
      if (sp > XB_SPIN_CAP) {
        atomicAdd(&bar[XB_TMO], 1u);
        break;
      }
    }
  }
  nloc = mine > 0u ? mine : 1u;
  nx = cnt > 0u ? cnt : 1u;
}
DEVI void xcd_barrier(const XcdBarrier& b) {
  asm volatile("s_waitcnt vmcnt(0)" ::: "memory");
  __syncthreads();
  if (threadIdx.x == 0) {
    unsigned* bar = b.bar;
    __builtin_amdgcn_s_waitcnt(0);
    unsigned nloc = b.st[0], nx = b.st[1];
    if (nloc == 0u) {
      xcd_barrier_complete(bar, b.x, nloc, nx);
      b.st[0] = nloc;
      b.st[1] = nx;
    }
    const unsigned old = xb_add(&bar[XB_XSUB(b.x)], 1u);
    const unsigned gen = old / nloc;
    if (old + 1u == (gen + 1u) * nloc) {
      __builtin_amdgcn_fence(__ATOMIC_RELEASE, "agent");
      asm volatile("s_waitcnt vmcnt(0)" ::: "memory");
      const unsigned og = xb_add(&bar[XB_TOP], 1u);
      const unsigned tg = og / nx;
      if (og + 1u == (tg + 1u) * nx) xb_add(&bar[XB_TOPGEN], 1u);
      else XB_SPIN(xb_ld(&bar[XB_TOPGEN]) == tg, bar);
      __builtin_amdgcn_fence(__ATOMIC_ACQUIRE, "agent");
      xb_add(&bar[XB_XGEN(b.x)], 1u);
      asm volatile("s_waitcnt vmcnt(0)" ::: "memory");
    } else {
      XB_SPIN(xb_ld(&bar[XB_XGEN(b.x)]) == gen, bar);
      __builtin_amdgcn_fence(__ATOMIC_ACQUIRE, "agent");
      asm volatile("s_waitcnt vmcnt(0)" ::: "memory");
    }
  }
  __syncthreads();
}

DEVI bool step_active(int step) {
  if (step == 0) return true;
  if (step == NSTEPS - 1) return false;
  int layer = (step - 1) / STEPS_PER_LAYER, ph = (step - 1) % STEPS_PER_LAYER;
  if (ph == 3 && (layer & 1)) return false;
  if (ph == 0 && layer > 0) return false;
  return true;
}

DEVI void run_step(PP p, int step, unsigned char* lds, unsigned char* lds_all, float gscale = 1.f) {
  if (step == 0) {
    phase_prep(p, lds);
    return;
  }
  if (step == NSTEPS - 1) {
    phase_norm(p, 0, 2, TL);
    return;
  }
  int layer = (step - 1) / STEPS_PER_LAYER, ph = (step - 1) % STEPS_PER_LAYER;
  bool even = (layer & 1) == 0;
  int j = layer >> 1;
  bool upd_ctx = layer < 2;
  bool need_ctx = layer < 3;
  int nt_in = need_ctx ? TT : TL;
  int nt = upd_ctx ? TT : TL;
  switch (ph) {
    case 0: phase_norm(p, layer, 0, nt_in); break;
    case 1:
      if (even)
        gemm8_phase<EPI_INPROJ>(p, p->h, D, p->wt_in_ab + (size_t)j * 1280 * D, D, nt_in / 256, 5, D, layer, lds_all);
      else
        gemm8_phase<EPI_GELU>(p, p->h, D, p->wt_in_gs + (size_t)j * 2048 * D, D, nt / 256, 8, D, layer, lds_all);
      break;
    case 2:
      if (even) {
        phase_fft_a(p, lds);
        if (upd_ctx) phase_dft_ctx(p, lds);
        phase_attn(p, layer, upd_ctx, lds);
      } else {
        phase_sgu(p, j, nt / 128, lds);
      }
      break;
    case 3:
      if (even) phase_fft_b(p, lds);
      break;
    case 4:
      if (even)
      {
        if (gscale != 1.f) gemm_phase<EPI_RESID>(p, p->mix, LDMIX, p->wt_out_ab + (size_t)j * D * LDMIX, LDMIX, nt / 128, 8, LDMIX, layer, lds, gscale);
        else if (layer == 0) gemm8_phase<EPI_RESID0>(p, p->mix, LDMIX, p->wt_out_ab + (size_t)j * D * LDMIX, LDMIX, nt / 256, 4, LDMIX, layer, lds_all);
        else gemm8_phase<EPI_RESID>(p, p->mix, LDMIX, p->wt_out_ab + (size_t)j * D * LDMIX, LDMIX, nt / 256, 4, LDMIX, layer, lds_all);
      }
      else
      {
        if (gscale != 1.f) gemm_phase<EPI_RESID>(p, p->mix, LDMIX, p->wt_out_gs + (size_t)j * D * D, D, nt / 128, 8, D, layer, lds, gscale);
        else gemm8_phase<EPI_RESID>(p, p->mix, LDMIX, p->wt_out_gs + (size_t)j * D * D, D, nt / 256, 4, D, layer, lds_all);
      }
      break;
    case 5: phase_norm(p, layer, 1, nt); break;
    case 6: gemm8_phase<EPI_STORE>(p, p->h, D, p->wt_q + (size_t)layer * 2048 * D, D, nt / 256, 8, D, layer, lds_all); break;
    case 7: phase_route(p, layer, nt, lds); break;
    case 8: phase_expert(p, layer, nt, lds, gscale, (gscale == 1.f) ? 0xffff : REP_IDMASK); break;
  }
}

__global__ void __launch_bounds__(PHYS_THREADS, 2) mega(Params p_unused, int step_lo, int step_hi) {
  unsigned char* lds_all = g_lds;
  if ((threadIdx.x & 63) == 0) *reinterpret_cast<volatile int*>(g_lds + LDS_BYTES - 16 - 256 + 4 * hw_slot()) = (int)(threadIdx.x >> 6);
  __syncthreads();
  unsigned char* lds = lds_all + (wave_index() >> 2) * LDS_HALF;
  PP pp = (PP)__builtin_amdgcn_kernarg_segment_ptr();
  volatile LAS unsigned* st = (volatile LAS unsigned*)(lds_all + LDS_BYTES - 16);
  if (threadIdx.x == 0) {
    st[0] = 0u;
    st[1] = 0u;
  }
  __syncthreads();
  XcdBarrier xb = xcd_barrier_post(pp->bar, st);
  int nsync = 0;
  bool first = true;
  for (int s = step_lo; s < step_hi; ++s) {
    if (!step_active(s)) continue;
    if (!first) {
      if (nsync == 0) cg::this_grid().sync();
      else xcd_barrier(xb);
      ++nsync;
    }
    first = false;
    PP q = pp;
    asm volatile("" : "+s"(q));
    run_step(q, s, lds, lds_all);
#if REP_MASK
    if (s == 0 && ((REP_MASK >> 15) & 1)) {
      xcd_barrier(xb);
      PP q2 = pp;
      asm volatile("" : "+s"(q2));
      run_step(q2, 0, lds, lds_all);
    }
    if (s > 0 && s < NSTEPS - 1) {
      int lay_ = (s - 1) / STEPS_PER_LAYER, ph_ = (s - 1) % STEPS_PER_LAYER;
      bool rep_ = (REP_MASK >> ph_) & 1;
      if (ph_ == 2 && ((REP_MASK >> 9) & 1) && !(lay_ & 1)) rep_ = true;
      if (ph_ == 2 && ((REP_MASK >> 10) & 1) && (lay_ & 1)) rep_ = true;
      if (rep_) {
        xcd_barrier(xb);
        PP q2 = pp;
        asm volatile("" : "+s"(q2));
        float z = 0.f;
        asm volatile("" : "+s"(z));
        run_step(q2, s, lds, lds_all, z);
      }
      if (ph_ == 2 && ((REP_MASK >> 11) & 1) && !(lay_ & 1)) {
        xcd_barrier(xb);
        PP q2 = pp;
        asm volatile("" : "+s"(q2));
        phase_attn(q2, lay_, lay_ < 2, lds);
      }
    }
#endif
  }
}

static size_t align_up(size_t v) { return (v + 255) & ~(size_t)255; }

extern "C" void kernel_launch(void* const* d_in, const int* in_sizes, int n_in, void* d_out, int out_size, void* d_ws,
                              size_t ws_size, hipStream_t stream) {
  Params p{};
  p.x = (const float*)d_in[0];
  p.c = (const float*)d_in[1];
  p.ctx = (const float*)d_in[2];
  p.c_ctx = (const float*)d_in[3];
  p.ada_w = (const float*)d_in[4];
  p.ada_b = (const float*)d_in[5];
  p.norm_mix_w = (const float*)d_in[6];
  p.norm_ffn_w = (const float*)d_in[7];
  p.ab_w_in = (const float*)d_in[8];
  p.ab_w_out = (const float*)d_in[9];
  p.attn_sink = (const float*)d_in[10];
  p.gs_w_in = (const float*)d_in[11];
  p.gs_norm_w = (const float*)d_in[12];
  p.gs_w_s = (const float*)d_in[13];
  p.gs_b_s = (const float*)d_in[14];
  p.gs_w_out = (const float*)d_in[15];
  p.peer_w_q = (const float*)d_in[16];
  p.peer_keys = (const float*)d_in[17];
  p.peer_u = (const float*)d_in[18];
  p.peer_v = (const float*)d_in[19];
  p.norm_out_w = (const float*)d_in[20];
  p.out = (float*)d_out;
  unsigned char* w = (unsigned char*)d_ws;
  size_t off = 0;
  auto take = [&](size_t bytes) {
    unsigned char* r = w + off;
    off = align_up(off + bytes);
    return r;
  };
  p.bar = (unsigned*)take((size_t)XCD_BAR_WORDS * 4);
  p.mod = (float*)take((size_t)DEPTH * 9 * 6144 * 4);
  p.cs = (float2*)take(64 * 16 * 8);
  p.xs = (float*)take((size_t)TT * D * 4);
  p.h = (bf16_t*)take((size_t)TT * D * 2);
  p.P = (bf16_t*)take((size_t)TT * 2048 * 2);
  p.kbuf = (bf16_t*)take((size_t)NB * 2 * KVLEN * 64 * 2);
  p.vbuf = (bf16_t*)take((size_t)NB * 2 * KVLEN * 64 * 2);
  p.zvT = (bf16_t*)take((size_t)TT * 1024 * 2);
  p.rowss = (float*)take((size_t)(TT / 128) * 32 * 128 * 4);
  p.mix = (bf16_t*)take((size_t)TT * LDMIX * 2);
  p.fa = (bf16_t*)take((size_t)TL * 1024 * 2);
  p.tops = (float*)take((size_t)TT * 256 * 4);
  p.eidx = (int*)take((size_t)TT * 128 * 4);
  p.gate = (float*)take((size_t)TT * 128 * 4);
  p.wt_in_ab = (bf16_t*)take((size_t)2 * 1280 * D * 2);
  p.wt_out_ab = (bf16_t*)take((size_t)2 * D * LDMIX * 2);
  p.wt_in_gs = (bf16_t*)take((size_t)2 * 2048 * D * 2);
  p.wt_out_gs = (bf16_t*)take((size_t)2 * D * D * 2);
  p.wt_q = (bf16_t*)take((size_t)DEPTH * 2048 * D * 2);
  p.keysb = (bf16_t*)take((size_t)DEPTH * 8 * 2 * 128 * 128 * 2);
  p.su = (float*)take((size_t)DEPTH * NEXP * 4);
  p.sv = (float*)take((size_t)DEPTH * NEXP * 4);
  p.h8 = (signed char*)take((size_t)TT * D);
  p.sx = (float*)take((size_t)TT * 4);
  p.utab = (unsigned char*)take((size_t)DEPTH * NEXP * D);
  p.vtab = (unsigned char*)take((size_t)DEPTH * NEXP * D);
  if (off > ws_size) {
    fprintf(stderr, "workspace too small: need %zu have %zu\n", off, ws_size);
    return;
  }
  hipMemsetAsync(p.bar, 0, (size_t)XCD_BAR_WORDS * 4, stream);
  static int grid_blocks = 0;
  if (!grid_blocks) {
    int dev = 0, cus = 0, per_cu = 0;
    hipGetDevice(&dev);
    hipDeviceGetAttribute(&cus, hipDeviceAttributeMultiprocessorCount, dev);
    hipOccupancyMaxActiveBlocksPerMultiprocessor(&per_cu, mega, PHYS_THREADS, 0);
    if (per_cu > 1) per_cu = 1;
    if (per_cu < 1) per_cu = 1;
    grid_blocks = cus * per_cu;
  }
#if ONE_LAUNCH
  int lo = 0, hi = NSTEPS;
  void* args[] = {&p, &lo, &hi};
  hipError_t e = hipLaunchCooperativeKernel((void*)mega, dim3(grid_blocks), dim3(PHYS_THREADS), args, 0, stream);
  if (e != hipSuccess) fprintf(stderr, "cooperative launch failed: %s (grid %d)\n", hipGetErrorString(e), grid_blocks);
#else
  for (int s = 0; s < NSTEPS; ++s) {
    if (s != 0 && s != NSTEPS - 1) {
      int layer = (s - 1) / STEPS_PER_LAYER, ph = (s - 1) % STEPS_PER_LAYER;
      if (ph == 3 && (layer & 1)) continue;
    }
    hipLaunchKernelGGL(mega, dim3(grid_blocks), dim3(NTHREADS), 0, stream, p, s, s + 1);
  }
#endif
}
```

```cpp
#include <hip/hip_runtime.h>
#include <hip/hip_bf16.h>
#include <hip/hip_cooperative_groups.h>
#include <cstdio>
namespace cg = cooperative_groups;

#ifndef REP_MASK
#define REP_MASK 0
#endif
#ifndef REP_MODE
#define REP_MODE 0
#endif
#ifndef REP_IDMASK
#define REP_IDMASK 0xffff
#endif
#ifndef ONE_LAUNCH
#define ONE_LAUNCH 1
#endif

#define DEVI __device__ __forceinline__
typedef unsigned short bf16_t;
using bf16x8 = __attribute__((ext_vector_type(8))) short;
using f32x4 = __attribute__((ext_vector_type(4))) float;
using f32x16 = __attribute__((ext_vector_type(16))) float;

constexpr int D = 1024, NB = 8, SEQ = 4096, CTX = 256, DEPTH = 4;
constexpr int TL = NB * SEQ, TC = NB * CTX, TT = TL + TC;
constexpr int KVLEN = CTX + SEQ;
constexpr int NEXP = 16384;
constexpr int LDMIX = 1536;
constexpr float USCALE = 64.f, VSCALE = 8.f;
constexpr int TPB = 68;
constexpr int LDS_HALF = 68 * 1024;
constexpr int LDS_BYTES = 2 * LDS_HALF;
constexpr int PHYS_THREADS = 512;
constexpr int NTHREADS = 256;
constexpr int STEPS_PER_LAYER = 9;
constexpr int NSTEPS = 1 + DEPTH * STEPS_PER_LAYER + 1;

struct Params {
  const float *x, *c, *ctx, *c_ctx, *ada_w, *ada_b, *norm_mix_w, *norm_ffn_w, *ab_w_in, *ab_w_out, *attn_sink,
      *gs_w_in, *gs_norm_w, *gs_w_s, *gs_b_s, *gs_w_out, *peer_w_q, *peer_keys, *peer_u, *peer_v, *norm_out_w;
  float* out;
  float* mod;
  float2* cs;
  float* xs;
  bf16_t* h;
  bf16_t* P;
  bf16_t* kbuf;
  bf16_t* vbuf;
  float* rowss;
  bf16_t* zvT;
  bf16_t* mix;
  bf16_t* fa;
  unsigned* bar;
  float* tops;
  int* eidx;
  float* gate;
  bf16_t *wt_in_ab, *wt_out_ab, *wt_in_gs, *wt_out_gs, *wt_q, *keysb;
  unsigned char *utab, *vtab;
  float* su;
  float* sv;
  signed char* h8;
  float* sx;
};

typedef const __attribute__((address_space(4))) Params* PP;

__shared__ __attribute__((aligned(16))) unsigned char g_lds[LDS_BYTES];
DEVI int hw_slot() {
  int h = (int)(__builtin_amdgcn_s_getreg((6 - 1) << 11 | 0 << 6 | 4) & 63u);
  asm volatile("" : "+s"(h));
  return h;
}
DEVI int wave_index() {
  int w = *reinterpret_cast<volatile int*>(g_lds + LDS_BYTES - 16 - 256 + 4 * hw_slot());
  return __builtin_amdgcn_readfirstlane(w);
}
DEVI int lane_id() { return (int)__builtin_amdgcn_mbcnt_hi(~0u, __builtin_amdgcn_mbcnt_lo(~0u, 0u)); }
DEVI int ltid() { int t = ((wave_index() & 3) << 6) | lane_id(); asm volatile("" : "+v"(t)); return t; }
DEVI int lbid() { int t = 2 * blockIdx.x + (wave_index() >> 2); asm volatile("" : "+s"(t)); return t; }
DEVI int lnblk() { int t = 2 * gridDim.x; asm volatile("" : "+s"(t)); return t; }
DEVI int ptid() { int t = (wave_index() << 6) | lane_id(); asm volatile("" : "+v"(t)); return t; }
DEVI int pbid() { int t = blockIdx.x; asm volatile("" : "+s"(t)); return t; }
DEVI int pnblk() { int t = gridDim.x; asm volatile("" : "+s"(t)); return t; }

typedef __bf16 bf2v_t __attribute__((ext_vector_type(2)));
typedef float f2v_t __attribute__((ext_vector_type(2)));
DEVI bf16_t f2bf(float f) { return __builtin_bit_cast(unsigned short, (__bf16)f); }
DEVI float bf2f(bf16_t h) { return __uint_as_float(((unsigned)h) << 16); }
DEVI float bflo(unsigned u) { return __uint_as_float(u << 16); }
DEVI float bfhi(unsigned u) { return __uint_as_float(u & 0xffff0000u); }
DEVI unsigned pack2(float a, float b) {
  f2v_t v = {a, b};
  return __builtin_bit_cast(unsigned, __builtin_convertvector(v, bf2v_t));
}
DEVI float gelu_tanh(float x) {
  float u = 0.7978845608028654f * (x + 0.044715f * x * x * x);
  return 0.5f * x * (1.f + tanhf(u));
}
template <int CTRL>
DEVI float dpp_mov(float v) {
  return __builtin_bit_cast(float, __builtin_amdgcn_mov_dpp(__builtin_bit_cast(int, v), CTRL, 0xF, 0xF, true));
}
DEVI int shx_i(int v, int m) { return __builtin_amdgcn_ds_bpermute((lane_id() ^ m) << 2, v); }
DEVI float shx_f(float v, int m) { return __builtin_bit_cast(float, shx_i(__builtin_bit_cast(int, v), m)); }
DEVI float wave_sum(float v) {
  v += dpp_mov<0xB1>(v);
  v += dpp_mov<0x4E>(v);
  v += dpp_mov<0x141>(v);
  v += dpp_mov<0x140>(v);
  v += shx_f(v, 16);
  v += shx_f(v, 32);
  return v;
}
DEVI float wave_max(float v) {
  v = fmaxf(v, dpp_mov<0xB1>(v));
  v = fmaxf(v, dpp_mov<0x4E>(v));
  v = fmaxf(v, dpp_mov<0x141>(v));
  v = fmaxf(v, dpp_mov<0x140>(v));
  v = fmaxf(v, shx_f(v, 16));
  v = fmaxf(v, shx_f(v, 32));
  return v;
}
DEVI int tok_batch(int r) { return r < TL ? (r >> 12) : 8; }

DEVI void prep_transpose_tile(const float* __restrict__ src, int N, bf16_t* __restrict__ dst, int ldk, int tk, int tn, float* tile, int tid) {
#pragma unroll
  for (int i = 0; i < 16; ++i) {
    int r = (tid >> 6) + 4 * i;
    tile[r * 65 + (tid & 63)] = src[(size_t)(tk * 64 + r) * N + tn * 64 + (tid & 63)];
  }
  __syncthreads();
#pragma unroll
  for (int i = 0; i < 16; ++i) {
    int n = (tid >> 6) + 4 * i, k = tid & 63;
    dst[(size_t)(tn * 64 + n) * ldk + tk * 64 + k] = f2bf(tile[k * 65 + n]);
  }
}

constexpr int PU_ADA = DEPTH * 96;
constexpr int PU_T_ABIN = 2 * 16 * 20;
constexpr int PU_T_GSIN = 2 * 16 * 32;
constexpr int PU_T_GSOUT = 2 * 16 * 16;
constexpr int PU_T_ABOUT = 2 * 8 * 16;
constexpr int PU_T_Q = DEPTH * 16 * 32;
constexpr int PU_FOLD = 2 * 4 * 16 * 2;
constexpr int PU_CONV = DEPTH * NEXP * D / 4 / 2048;
constexpr int PU_KEYS = DEPTH * 8 * 2 * 128 * 128 / 4 / 2048;
constexpr int PU_UROWS = DEPTH * NEXP / 32;
constexpr int PU_TOTAL = PU_ADA + PU_T_ABIN + PU_T_GSIN + PU_T_GSOUT + PU_T_ABOUT + PU_T_Q + PU_FOLD + 2 * PU_UROWS + PU_KEYS + 1;

DEVI void phase_prep(PP p, unsigned char* lds) {
  const int tid = ltid();
  float* fl = reinterpret_cast<float*>(lds);
  for (int u0 = lbid(); u0 < PU_TOTAL; u0 += lnblk()) {
    int u = u0;
    if (u < PU_ADA) {
      float* sl = fl;
      for (int i = tid; i < 9 * 1024; i += NTHREADS) {
        int r = i >> 10, k = i & 1023;
        float v = (r < 8) ? p->c[r * 1024 + k] : p->c_ctx[k];
        sl[i] = v / (1.f + __expf(-v));
      }
      __syncthreads();
      float* red = sl + 9 * 1024;
      int ks = tid >> 6, col = tid & 63;
      int layer = u / 96, c0 = (u % 96) * 64;
      const float* w = p->ada_w + (size_t)layer * D * 6144 + c0 + col;
      float acc[9];
#pragma unroll
      for (int r = 0; r < 9; ++r) acc[r] = 0.f;
      for (int k0 = ks * 256; k0 < ks * 256 + 256; k0 += 16) {
        float wv[16];
#pragma unroll
        for (int kk = 0; kk < 16; ++kk) wv[kk] = w[(size_t)(k0 + kk) * 6144];
#pragma unroll
        for (int kk = 0; kk < 16; ++kk)
#pragma unroll
          for (int r = 0; r < 9; ++r) acc[r] += sl[r * 1024 + k0 + kk] * wv[kk];
      }
#pragma unroll
      for (int r = 0; r < 9; ++r) red[(ks * 9 + r) * 64 + col] = acc[r];
      __syncthreads();
      for (int i = tid; i < 9 * 64; i += NTHREADS) {
        int r = i >> 6, cc = i & 63;
        float sm = red[(0 * 9 + r) * 64 + cc] + red[(1 * 9 + r) * 64 + cc] + red[(2 * 9 + r) * 64 + cc] + red[(3 * 9 + r) * 64 + cc];
        sm += p->ada_b[(size_t)layer * 6144 + c0 + cc];
        p->mod[((size_t)layer * 9 + r) * 6144 + c0 + cc] = sm;
      }
      __syncthreads();
      continue;
    }
    u -= PU_ADA;
    if (u < PU_T_ABIN) {
      int j = u / 320, t = u % 320;
      prep_transpose_tile(p->ab_w_in + (size_t)j * D * 1280, 1280, p->wt_in_ab + (size_t)j * 1280 * D, D, t / 20, t % 20, fl, tid);
      __syncthreads();
      continue;
    }
    u -= PU_T_ABIN;
    if (u < PU_T_GSIN) {
      int j = u / 512, t = u % 512;
      prep_transpose_tile(p->gs_w_in + (size_t)j * D * 2048, 2048, p->wt_in_gs + (size_t)j * 2048 * D, D, t / 32, t % 32, fl, tid);
      __syncthreads();
      continue;
    }
    u -= PU_T_GSIN;
    if (u < PU_T_GSOUT) {
      int j = u / 256, t = u % 256;
      prep_transpose_tile(p->gs_w_out + (size_t)j * D * D, D, p->wt_out_gs + (size_t)j * D * D, D, t / 16, t % 16, fl, tid);
      __syncthreads();
      continue;
    }
    u -= PU_T_GSOUT;
    if (u < PU_T_ABOUT) {
      int j = u / 128, t = u % 128;
      prep_transpose_tile(p->ab_w_out + (size_t)j * D * D, D, p->wt_out_ab + (size_t)j * D * LDMIX, LDMIX, t / 16, t % 16, fl, tid);
      __syncthreads();
      continue;
    }
    u -= PU_T_ABOUT;
    if (u < PU_T_Q) {
      int i = u / 512, t = u % 512;
      prep_transpose_tile(p->peer_w_q + (size_t)i * D * 2048, 2048, p->wt_q + (size_t)i * 2048 * D, D, t / 32, t % 32, fl, tid);
      __syncthreads();
      continue;
    }
    u -= PU_T_Q;
    if (u < PU_FOLD) {
      const int mh = u & 1, nc = (u >> 1) & 15, g = (u >> 5) & 3, j = u >> 7;
      float2* tw = reinterpret_cast<float2*>(lds);
      float* wt = reinterpret_cast<float*>(lds + 1024);
      if (tid < 128) {
        float sn, cn;
        sincospif((float)tid / 64.f, &sn, &cn);
        tw[tid] = make_float2(cn, sn);
      }
      {
        const float* wsrc = p->ab_w_out + (size_t)j * D * D + (size_t)(512 + g * 128) * D + nc * 64;
#pragma unroll 8
        for (int i = 0; i < 32; ++i) {
          int l = (tid >> 6) + 4 * i;
          wt[l * 64 + (tid & 63)] = wsrc[(size_t)l * D + (tid & 63)];
        }
      }
      __syncthreads();
      const int n = tid & 63, mq = __builtin_amdgcn_readfirstlane(tid >> 6);
      bf16_t* dst = p->wt_out_ab + (size_t)j * D * LDMIX + (size_t)(nc * 64 + n) * LDMIX + g * 128;
#pragma unroll 1
      for (int mi = 0; mi < 16; ++mi) {
        const int m = mh * 64 + mq * 16 + mi;
        float ar = 0.f, ai = 0.f;
#pragma unroll 16
        for (int l = 0; l < 128; ++l) {
          float2 t = tw[(m * l) & 127];
          float wv = wt[l * 64 + n];
          ar += t.x * wv;
          ai += t.y * wv;
        }
        dst[512 + m] = f2bf(ar);
        dst[1024 + m] = f2bf(ai);
      }
      __syncthreads();
      continue;
    }
    u -= PU_FOLD;
    if (u < 2 * PU_UROWS) {
      const bool isv = u >= PU_UROWS;
      if (isv) u -= PU_UROWS;
      const float* src = isv ? p->peer_v : p->peer_u;
      unsigned char* dst = isv ? p->vtab : p->utab;
      float* sdst = isv ? p->sv : p->su;
      const int lane = tid & 63, wv = tid >> 6;
#pragma unroll 1
      for (int rr = 0; rr < 8; rr += 4) {
        size_t row0 = (size_t)u * 32 + wv * 8 + rr;
        float4 v[4][4];
#pragma unroll
        for (int k = 0; k < 4; ++k)
#pragma unroll
          for (int i = 0; i < 4; ++i) v[k][i] = reinterpret_cast<const float4*>(src + (row0 + k) * D)[lane * 4 + i];
#pragma unroll
        for (int k = 0; k < 4; ++k) {
          float am = 0.f;
#pragma unroll
          for (int i = 0; i < 4; ++i)
            am = fmaxf(am, fmaxf(fmaxf(fabsf(v[k][i].x), fabsf(v[k][i].y)), fmaxf(fabsf(v[k][i].z), fabsf(v[k][i].w))));
          am = wave_max(am);
          am = fmaxf(am, 1e-30f);
          float qs = 127.f / am;
          uint4 o;
          unsigned* op = reinterpret_cast<unsigned*>(&o);
#pragma unroll
          for (int i = 0; i < 4; ++i) {
            int q0 = (int)rintf(v[k][i].x * qs), q1 = (int)rintf(v[k][i].y * qs), q2 = (int)rintf(v[k][i].z * qs), q3 = (int)rintf(v[k][i].w * qs);
            op[i] = (unsigned)(q0 & 255) | ((unsigned)(q1 & 255) << 8) | ((unsigned)(q2 & 255) << 16) | ((unsigned)(q3 & 255) << 24);
          }
          reinterpret_cast<uint4*>(dst + (row0 + k) * D)[lane] = o;
          if (lane == 0) sdst[row0 + k] = am * (1.f / 127.f);
        }
      }
      continue;
    }
    u -= 2 * PU_UROWS;
    if (u < PU_KEYS) {
      const float4* s4 = reinterpret_cast<const float4*>(p->peer_keys) + (size_t)u * 2048 + tid;
      uint2* d2 = reinterpret_cast<uint2*>(p->keysb) + (size_t)u * 2048 + tid;
#pragma unroll
      for (int k = 0; k < 8; ++k) {
        float4 v = s4[k * 256];
        uint2 o;
        o.x = pack2(v.x, v.y);
        o.y = pack2(v.z, v.w);
        d2[k * 256] = o;
      }
      continue;
    }
    for (int i = tid; i < 64 * 16; i += NTHREADS) {
      int pos = i >> 4, k = i & 15;
      float inv = powf(10000.f, -(float)k / 16.f);
      float ang = (float)pos * inv;
      float sn, cn;
      sincosf(ang, &sn, &cn);
      p->cs[i] = make_float2(cn, sn);
    }
  }
}

DEVI void norm_row(PP p, int layer, int which, int tok, int lane) {
  const float* w = which == 0 ? p->norm_mix_w + layer * D : (which == 1 ? p->norm_ffn_w + layer * D : p->norm_out_w);
  const float* xsrc = p->xs + (size_t)tok * D;
  if (which == 0 && layer == 0) xsrc = (tok < TL) ? p->x + (size_t)tok * D : p->ctx + (size_t)(tok - TL) * D;
  const float4* xr = reinterpret_cast<const float4*>(xsrc);
  float4 v[4];
  float ss = 0.f;
#pragma unroll
  for (int i = 0; i < 4; ++i) {
    v[i] = xr[lane + 64 * i];
    ss += v[i].x * v[i].x + v[i].y * v[i].y + v[i].z * v[i].z + v[i].w * v[i].w;
  }
  ss = wave_sum(ss);
  float rstd = rsqrtf(ss * (1.f / 1024.f) + 1e-6f);
  if (which == 2) {
    float4* o = reinterpret_cast<float4*>(p->out + (size_t)tok * D);
#pragma unroll
    for (int i = 0; i < 4; ++i) {
      float4 wv = reinterpret_cast<const float4*>(w)[lane + 64 * i];
      float4 r;
      r.x = v[i].x * rstd * wv.x;
      r.y = v[i].y * rstd * wv.y;
      r.z = v[i].z * rstd * wv.z;
      r.w = v[i].w * rstd * wv.w;
      o[lane + 64 * i] = r;
    }
  } else {
    int b = tok_batch(tok);
    const float* mb = p->mod + ((size_t)layer * 9 + b) * 6144 + (which == 0 ? 0 : 3072);
    uint2* o = reinterpret_cast<uint2*>(p->h + (size_t)tok * D);
    float av[4][4];
    float am = 0.f;
#pragma unroll
    for (int i = 0; i < 4; ++i) {
      float4 wv = reinterpret_cast<const float4*>(w)[lane + 64 * i];
      float4 sh = reinterpret_cast<const float4*>(mb)[lane + 64 * i];
      float4 sc = reinterpret_cast<const float4*>(mb + 1024)[lane + 64 * i];
      float a0 = v[i].x * rstd * wv.x * (1.f + sc.x) + sh.x;
      float a1 = v[i].y * rstd * wv.y * (1.f + sc.y) + sh.y;
      float a2 = v[i].z * rstd * wv.z * (1.f + sc.z) + sh.z;
      float a3 = v[i].w * rstd * wv.w * (1.f + sc.w) + sh.w;
      uint2 r;
      r.x = pack2(a0, a1);
      r.y = pack2(a2, a3);
      o[lane + 64 * i] = r;
      av[i][0] = a0; av[i][1] = a1; av[i][2] = a2; av[i][3] = a3;
      am = fmaxf(am, fmaxf(fmaxf(fabsf(a0), fabsf(a1)), fmaxf(fabsf(a2), fabsf(a3))));
    }
    if (which == 1) {
      am = fmaxf(wave_max(am), 1e-30f);
      float qs = 127.f / am;
      unsigned* o8 = reinterpret_cast<unsigned*>(p->h8 + (size_t)tok * D);
#pragma unroll
      for (int i = 0; i < 4; ++i) {
        int q0 = (int)rintf(av[i][0] * qs), q1 = (int)rintf(av[i][1] * qs), q2 = (int)rintf(av[i][2] * qs), q3 = (int)rintf(av[i][3] * qs);
        o8[lane + 64 * i] = (unsigned)(q0 & 255) | ((unsigned)(q1 & 255) << 8) | ((unsigned)(q2 & 255) << 16) | ((unsigned)(q3 & 255) << 24);
      }
      if (lane == 0) p->sx[tok] = am * (1.f / 127.f);
    }
  }
}

DEVI void phase_norm(PP p, int layer, int which, int ntok) {
  int lane = ltid() & 63;
  int gw = lbid() * 4 + __builtin_amdgcn_readfirstlane(ltid() >> 6), nw = lnblk() * 4;
  for (int tok = gw; tok < ntok; tok += nw) norm_row(p, layer, which, tok, lane);
}

enum { EPI_STORE = 0, EPI_GELU = 1, EPI_RESID = 2, EPI_INPROJ = 3, EPI_RESID0 = 4 };

template <int EPI>
DEVI void gemm_phase(PP p, const bf16_t* __restrict__ A, int lda, const bf16_t* __restrict__ Bt, int ldb,
                     int Mtiles, int Ntiles, int K, int layer, unsigned char* lds, float gscale = 1.f, int big_t0 = -1, int big_n = 0,
                     int big_ntn = 1) {
  const int tid = ltid();
  const int wid = __builtin_amdgcn_readfirstlane(tid >> 6), lane = tid & 63, wr = wid >> 1, wc = wid & 1, fr = lane & 15, fq = lane >> 4;
  int nblk = lnblk();
  int bid = lbid();
  int lb = bid;
  {
    const int pn = nblk >> 1, pb = bid >> 1;
    if ((pn & 7) == 0) lb = 2 * ((pb & 7) * (pn >> 3) + (pb >> 3)) + (bid & 1);
  }
  int ntiles = (big_t0 >= 0) ? 4 * big_n : Mtiles * Ntiles;
  const int nk = K / 64;
  const int srow = tid >> 3;
  const int scol = ((tid & 7) ^ ((tid >> 3) & 7)) * 8;
#define GEMM_STAGE(ga_, gb_, kt_, buf_)                                                                               \
  {                                                                                                                   \
    _Pragma("unroll") for (int i_ = 0; i_ < 4; ++i_) {                                                                \
      __builtin_amdgcn_global_load_lds((const unsigned*)((ga_) + (size_t)(32 * i_) * lda + (kt_) * 64),               \
                                       (__attribute__((address_space(3))) unsigned*)(lds + (buf_) * 32768 + tid * 16 + i_ * 4096), 16, 0, 0); \
      __builtin_amdgcn_global_load_lds((const unsigned*)((gb_) + (size_t)(32 * i_) * ldb + (kt_) * 64),               \
                                       (__attribute__((address_space(3))) unsigned*)(lds + (buf_) * 32768 + 16384 + tid * 16 + i_ * 4096), 16, 0, 0); \
    }                                                                                                                 \
  }
  auto tile_rc = [&](int t, int& tm_, int& tn_) {
    if (big_t0 >= 0) {
      int bt = big_t0 + (t >> 2), q = t & 3;
      tm_ = 2 * (bt / big_ntn) + (q >> 1);
      tn_ = 2 * (bt % big_ntn) + (q & 1);
    } else {
      tm_ = t / Ntiles;
      tn_ = t % Ntiles;
    }
  };
  if (lb < ntiles) {
    int tm0, tn0;
    tile_rc(lb, tm0, tn0);
    const bf16_t* ga0 = A + (size_t)(tm0 * 128 + srow) * lda + scol;
    const bf16_t* gb0 = Bt + (size_t)(tn0 * 128 + srow) * ldb + scol;
    GEMM_STAGE(ga0, gb0, 0, 0)
  }
  for (int t = lb; t < ntiles; t += nblk) {
    int tm, tn;
    tile_rc(t, tm, tn);
    int brow = tm * 128, bcol = tn * 128;
    f32x4 acc[4][4];
#pragma unroll
    for (int m = 0; m < 4; ++m)
#pragma unroll
      for (int n = 0; n < 4; ++n) acc[m][n] = f32x4{0.f, 0.f, 0.f, 0.f};
    const bf16_t* ga = A + (size_t)(brow + srow) * lda + scol;
    const bf16_t* gb = Bt + (size_t)(bcol + srow) * ldb + scol;
    for (int kt = 0; kt < nk; ++kt) {
      const int buf = kt & 1;
      asm volatile("s_waitcnt vmcnt(0)" ::: "memory");
      __syncthreads();
      if (kt + 1 < nk) GEMM_STAGE(ga, gb, kt + 1, buf ^ 1)
      const unsigned char* SA = lds + buf * 32768;
      const unsigned char* SB = SA + 16384;
      bf16x8 At[2][4], Bl[2][4];
#pragma unroll
      for (int ks = 0; ks < 2; ++ks)
#pragma unroll
        for (int m = 0; m < 4; ++m) {
          const int sl = ((ks * 4 + fq) ^ (fr & 7)) << 4;
          At[ks][m] = *reinterpret_cast<const bf16x8*>(SA + (wr * 64 + m * 16 + fr) * 128 + sl);
          Bl[ks][m] = *reinterpret_cast<const bf16x8*>(SB + (wc * 64 + m * 16 + fr) * 128 + sl);
        }
#pragma unroll
      for (int ks = 0; ks < 2; ++ks)
#pragma unroll
        for (int m = 0; m < 4; ++m)
#pragma unroll
          for (int n = 0; n < 4; ++n)
            acc[m][n] = __builtin_amdgcn_mfma_f32_16x16x32_bf16(At[ks][m], Bl[ks][n], acc[m][n], 0, 0, 0);
    }
    {
      int t2 = t + nblk;
      if (t2 < ntiles) {
        int tm2, tn2;
        tile_rc(t2, tm2, tn2);
        const bf16_t* ga2 = A + (size_t)(tm2 * 128 + srow) * lda + scol;
        const bf16_t* gb2 = Bt + (size_t)(tn2 * 128 + srow) * ldb + scol;
        GEMM_STAGE(ga2, gb2, 0, 0)
      }
    }
    const int colbase = bcol + wc * 64;
    if constexpr (EPI == EPI_STORE || EPI == EPI_GELU) {
      if (EPI == EPI_GELU && colbase >= 1024) {
        float* rsp = p->rowss + ((size_t)tm * 32 + ((colbase - 1024) >> 5)) * 128;
#pragma unroll
        for (int m = 0; m < 4; ++m) {
          float ssq[4] = {0.f, 0.f, 0.f, 0.f};
#pragma unroll
          for (int n = 0; n < 4; ++n) {
            int ch = colbase - 1024 + n * 16 + fr;
            int q0 = wr * 64 + m * 16 + fq * 4;
            float g0 = gelu_tanh(acc[m][n][0]), g1 = gelu_tanh(acc[m][n][1]), g2 = gelu_tanh(acc[m][n][2]), g3 = gelu_tanh(acc[m][n][3]);
            ssq[0] += g0 * g0;
            ssq[1] += g1 * g1;
            ssq[2] += g2 * g2;
            ssq[3] += g3 * g3;
            uint2 o;
            o.x = pack2(g0, g1);
            o.y = pack2(g2, g3);
            *reinterpret_cast<uint2*>(p->zvT + ((size_t)tm * 1024 + ch) * 128 + q0) = o;
          }
#pragma unroll
          for (int j = 0; j < 4; ++j) {
            float v = ssq[j];
            v += dpp_mov<0xB1>(v);
            v += dpp_mov<0x4E>(v);
            v += dpp_mov<0x141>(v);
            v += dpp_mov<0x140>(v);
            if (fr == 0) {
              rsp[wr * 64 + m * 16 + fq * 4 + j] = v;
              rsp[128 + wr * 64 + m * 16 + fq * 4 + j] = 0.f;
            }
          }
        }
      } else {
#pragma unroll
        for (int m = 0; m < 4; ++m)
#pragma unroll
          for (int j = 0; j < 4; ++j) {
            int row = brow + wr * 64 + m * 16 + fq * 4 + j;
            bf16_t* o = p->P + (size_t)row * 2048 + colbase + fr;
#pragma unroll
            for (int n = 0; n < 4; ++n) {
              float v = acc[m][n][j];
              if (EPI == EPI_GELU) v = gelu_tanh(v);
              o[n * 16] = f2bf(v);
            }
          }
      }
    } else if constexpr (EPI == EPI_RESID) {
#pragma unroll
      for (int m = 0; m < 4; ++m)
#pragma unroll
        for (int j = 0; j < 4; ++j) {
          int row = brow + wr * 64 + m * 16 + fq * 4 + j;
          int b = tok_batch(row);
          const float* g = p->mod + ((size_t)layer * 9 + b) * 6144 + 2048 + colbase + fr;
          float* o = p->xs + (size_t)row * D + colbase + fr;
          const float* xi = o;
          if (layer == 0 && gscale == 1.f)
            xi = ((row < TL) ? p->x + (size_t)row * D : p->ctx + (size_t)(row - TL) * D) + colbase + fr;
#pragma unroll
          for (int n = 0; n < 4; ++n) o[n * 16] = xi[n * 16] + gscale * g[n * 16] * acc[m][n][j];
        }
    } else if constexpr (EPI == EPI_INPROJ) {
      if (colbase >= 640 && colbase < 768) {
        int kvh = (colbase - 640) >> 6;
#pragma unroll
        for (int m = 0; m < 4; ++m) {
          int row0 = brow + wr * 64 + m * 16;
          bool latent = row0 < TL;
          int b = latent ? (row0 >> 12) : ((row0 - TL) >> 8);
          int kp16 = latent ? (CTX + (row0 & 4095)) : ((row0 - TL) & 255);
          int slot = kp16 + 8 * (fq & 1) + 4 * (fq >> 1);
#pragma unroll
          for (int n = 0; n < 4; ++n) {
            int dim = n * 16 + fr;
            uint2 o;
            o.x = pack2(acc[m][n][0], acc[m][n][1]);
            o.y = pack2(acc[m][n][2], acc[m][n][3]);
            *reinterpret_cast<uint2*>(p->vbuf + ((size_t)(b * 2 + kvh) * 64 + dim) * KVLEN + slot) = o;
          }
        }
      } else {
#pragma unroll
        for (int m = 0; m < 4; ++m)
#pragma unroll
          for (int j = 0; j < 4; ++j) {
            int row = brow + wr * 64 + m * 16 + fq * 4 + j;
            bool latent = row < TL;
            int b, pos;
            if (latent) {
              b = row >> 12;
              pos = row & 4095;
            } else {
              b = (row - TL) >> 8;
              pos = (row - TL) & 255;
            }
            float v0 = acc[m][0][j], v1 = acc[m][1][j], v2 = acc[m][2][j], v3 = acc[m][3][j];
            if (latent && colbase < 640) {
              float2 cr = p->cs[(pos >> 6) * 16 + fr];
              float2 cc = p->cs[(pos & 63) * 16 + fr];
              float a = v0, bb = v1;
              v0 = a * cr.x - bb * cr.y;
              v1 = bb * cr.x + a * cr.y;
              a = v2;
              bb = v3;
              v2 = a * cc.x - bb * cc.y;
              v3 = bb * cc.x + a * cc.y;
            }
            bf16_t* o;
            if (colbase < 512 || colbase >= 768) {
              o = p->P + (size_t)row * 2048 + colbase + fr;
            } else {
              int kvh = (colbase - 512) >> 6;
              int kp = latent ? (CTX + pos) : pos;
              o = p->kbuf + ((size_t)(b * 2 + kvh) * KVLEN + kp) * 64 + fr;
            }
            o[0] = f2bf(v0);
            o[16] = f2bf(v1);
            o[32] = f2bf(v2);
            o[48] = f2bf(v3);
          }
      }
    }
  }
}

constexpr int G8_HT = 128 * 64;
DEVI int g8_lds_byte(int r, int c) {
  int st = (r >> 4) * 2 + (c >> 5), rr = r & 15, cc = c & 31, ob = rr * 64 + cc * 2;
  return st * 1024 + (ob ^ (((ob >> 9) & 1) << 5));
}
DEVI void g8_stage_rc(int b, int& R, int& C) {
  int st = b / 1024, sb = b % 1024, swz = sb ^ (((sb >> 9) & 1) << 5);
  R = (st >> 1) * 16 + swz / 64;
  C = (st & 1) * 32 + (swz % 64) / 2;
}
template <int EPI, bool STAGED>
DEVI void gemm8_epilogue(PP p, f32x4 (&acc)[2][2][4][2], const f32x4* stg, int lane, int brow, int bcol, int wr, int wc, int fr, int fq, int layer, float gscale) {
#pragma unroll
  for (int ai_ = 0; ai_ < 2; ++ai_)
#pragma unroll
    for (int bj = 0; bj < 2; ++bj) {
      const int ai = STAGED ? 1 - ai_ : ai_;
      f32x4 q[4][2];
#pragma unroll
      for (int m = 0; m < 4; ++m)
#pragma unroll
        for (int n = 0; n < 2; ++n) q[m][n] = (STAGED && ai == 0) ? stg[(((bj * 4 + m) * 2 + n) * 64) + lane] : acc[ai][bj][m][n];
      const int r0 = brow + ai * 128 + wr * 64;
      const int c0 = bcol + bj * 128 + wc * 32;
      if constexpr (EPI == EPI_STORE) {
#pragma unroll
        for (int m = 0; m < 4; ++m)
#pragma unroll
          for (int j = 0; j < 4; ++j) {
            bf16_t* o = p->P + (size_t)(r0 + m * 16 + fq * 4 + j) * 2048 + c0 + fr;
            o[0] = f2bf(q[m][0][j]);
            o[16] = f2bf(q[m][1][j]);
          }
      } else if constexpr (EPI == EPI_GELU) {
        if (c0 >= 1024) {
          const int chunk = r0 >> 7;
          float* rsp = p->rowss + ((size_t)chunk * 32 + ((c0 - 1024) >> 5)) * 128;
#pragma unroll
          for (int m = 0; m < 4; ++m) {
            float ssq[4] = {0.f, 0.f, 0.f, 0.f};
            const int q0 = (r0 & 127) + m * 16 + fq * 4;
#pragma unroll
            for (int n = 0; n < 2; ++n) {
              int ch = c0 - 1024 + n * 16 + fr;
              float g0 = gelu_tanh(q[m][n][0]), g1 = gelu_tanh(q[m][n][1]);
              float g2 = gelu_tanh(q[m][n][2]), g3 = gelu_tanh(q[m][n][3]);
              ssq[0] += g0 * g0;
              ssq[1] += g1 * g1;
              ssq[2] += g2 * g2;
              ssq[3] += g3 * g3;
              uint2 o;
              o.x = pack2(g0, g1);
              o.y = pack2(g2, g3);
              *reinterpret_cast<uint2*>(p->zvT + ((size_t)chunk * 1024 + ch) * 128 + q0) = o;
            }
#pragma unroll
            for (int j = 0; j < 4; ++j) {
              float v = ssq[j];
              v += dpp_mov<0xB1>(v);
              v += dpp_mov<0x4E>(v);
              v += dpp_mov<0x141>(v);
              v += dpp_mov<0x140>(v);
              if (fr == 0) rsp[q0 + j] = v;
            }
          }
        } else {
#pragma unroll
          for (int m = 0; m < 4; ++m)
#pragma unroll
            for (int j = 0; j < 4; ++j) {
              bf16_t* o = p->P + (size_t)(r0 + m * 16 + fq * 4 + j) * 2048 + c0 + fr;
              o[0] = f2bf(gelu_tanh(q[m][0][j]));
              o[16] = f2bf(gelu_tanh(q[m][1][j]));
            }
        }
      } else if constexpr (EPI == EPI_RESID || EPI == EPI_RESID0) {
        const float* g = p->mod + ((size_t)layer * 9 + tok_batch(brow)) * 6144 + 2048 + c0 + fr;
        const float g0 = g[0], g1 = g[16];
        const float* xin = (brow < TL) ? p->x : p->ctx - (size_t)TL * D;
#pragma unroll
        for (int m = 0; m < 4; ++m)
#pragma unroll
          for (int j = 0; j < 4; ++j) {
            const size_t ro = (size_t)(r0 + m * 16 + fq * 4 + j) * D + c0 + fr;
            float* o = p->xs + ro;
            const float* xi = (EPI == EPI_RESID0) ? xin + ro : o;
            o[0] = xi[0] + g0 * q[m][0][j];
            o[16] = xi[16] + g1 * q[m][1][j];
          }
      } else if constexpr (EPI == EPI_INPROJ) {
        if (c0 >= 640 && c0 < 768) {
          const int kvh = (c0 - 640) >> 6, d0 = (c0 - 640) & 63;
#pragma unroll
          for (int m = 0; m < 4; ++m) {
            int row0 = r0 + m * 16;
            bool latent = row0 < TL;
            int b = latent ? (row0 >> 12) : ((row0 - TL) >> 8);
            int kp16 = latent ? (CTX + (row0 & 4095)) : ((row0 - TL) & 255);
            int slot = kp16 + 8 * (fq & 1) + 4 * (fq >> 1);
#pragma unroll
            for (int n = 0; n < 2; ++n) {
              int dim = d0 + n * 16 + fr;
              uint2 o;
              o.x = pack2(q[m][n][0], q[m][n][1]);
              o.y = pack2(q[m][n][2], q[m][n][3]);
              *reinterpret_cast<uint2*>(p->vbuf + ((size_t)(b * 2 + kvh) * 64 + dim) * KVLEN + slot) = o;
            }
          }
        } else {
          const int hsel = (c0 >> 5) & 1;
#pragma unroll
          for (int m = 0; m < 4; ++m)
#pragma unroll
            for (int j = 0; j < 4; ++j) {
              int row = r0 + m * 16 + fq * 4 + j;
              bool latent = row < TL;
              int b, pos;
              if (latent) {
                b = row >> 12;
                pos = row & 4095;
              } else {
                b = (row - TL) >> 8;
                pos = (row - TL) & 255;
              }
              float v0 = q[m][0][j], v1 = q[m][1][j];
              if (latent && c0 < 640) {
                float2 cs = p->cs[(hsel ? (pos & 63) : (pos >> 6)) * 16 + fr];
                float a = v0, bb = v1;
                v0 = a * cs.x - bb * cs.y;
                v1 = bb * cs.x + a * cs.y;
              }
              bf16_t* o;
              if (c0 < 512 || c0 >= 768) {
                o = p->P + (size_t)row * 2048 + c0 + fr;
              } else {
                int kvh = (c0 - 512) >> 6, d0 = (c0 - 512) & 63;
                int kp = latent ? (CTX + pos) : pos;
                o = p->kbuf + ((size_t)(b * 2 + kvh) * KVLEN + kp) * 64 + d0 + fr;
              }
              o[0] = f2bf(v0);
              o[16] = f2bf(v1);
            }
        }
      }
      __builtin_amdgcn_sched_barrier(0);
    }
}

template <int EPI>
DEVI void gemm8_phase(PP p, const bf16_t* __restrict__ A, int lda, const bf16_t* __restrict__ Bt, int ldb, int Mtiles, int Ntiles,
                      int K, int layer, unsigned char* lds_all, float gscale = 1.f) {
  bf16_t* shm = reinterpret_cast<bf16_t*>(lds_all);
  const int tid = ptid();
  const int wid = __builtin_amdgcn_readfirstlane(tid >> 6), lane = tid & 63, wr = wid >> 2, wc = wid & 3, fr = lane & 15, fq = lane >> 4;
#define G8_SA(b, h) (shm + ((b) * 2 + (h)) * G8_HT)
#define G8_SB(b, h) (shm + (4 + (b) * 2 + (h)) * G8_HT)
  const __amdgpu_buffer_rsrc_t rsA = __builtin_amdgcn_make_buffer_rsrc((void*)A, (short)0, -1, 0x00020000);
  const __amdgpu_buffer_rsrc_t rsB = __builtin_amdgcn_make_buffer_rsrc((void*)Bt, (short)0, -1, 0x00020000);
  unsigned voA[2], voB[2];
#pragma unroll
  for (int i = 0; i < 2; ++i) {
    int r_, c_;
    g8_stage_rc(tid * 16 + i * 8192, r_, c_);
    voA[i] = (unsigned)((r_ * lda + c_) * 2);
    voB[i] = (unsigned)((r_ * ldb + c_) * 2);
  }
#define G8_STAGE(P_, RS_, VO_, ld_, br_, kt_)                                                                         \
  do {                                                                                                                \
    const unsigned so_ = (unsigned)(((br_) * (ld_) + (kt_) * 64) * 2);                                                \
    _Pragma("unroll") for (int i_ = 0; i_ < 2; ++i_)                                                                  \
      __builtin_amdgcn_raw_ptr_buffer_load_lds(RS_, (__attribute__((address_space(3))) void*)((unsigned char*)(P_) + wid * 1024 + i_ * 8192), 16, VO_[i_], so_, 0, 0); \
  } while (0)
#define G8_LDA(dst, b, h)                                                                                             \
  _Pragma("unroll") for (int m_ = 0; m_ < 4; ++m_) _Pragma("unroll") for (int k_ = 0; k_ < 2; ++k_)                   \
      dst[m_][k_] = *reinterpret_cast<const bf16x8*>((const unsigned char*)G8_SA(b, h) + g8_lds_byte(wr * 64 + m_ * 16 + fr, k_ * 32 + fq * 8))
#define G8_LDB(dst, b, h)                                                                                             \
  _Pragma("unroll") for (int n_ = 0; n_ < 2; ++n_) _Pragma("unroll") for (int k_ = 0; k_ < 2; ++k_)                   \
      dst[n_][k_] = *reinterpret_cast<const bf16x8*>((const unsigned char*)G8_SB(b, h) + g8_lds_byte(wc * 32 + n_ * 16 + fr, k_ * 32 + fq * 8))
#define G8_MMA(ai, bj, At_, Bt_)                                                                                      \
  do {                                                                                                                \
    __builtin_amdgcn_s_setprio(1);                                                                                    \
    _Pragma("unroll") for (int m_ = 0; m_ < 4; ++m_) _Pragma("unroll") for (int n_ = 0; n_ < 2; ++n_)                 \
        _Pragma("unroll") for (int k_ = 0; k_ < 2; ++k_) acc[ai][bj][m_][n_] =                                        \
            __builtin_amdgcn_mfma_f32_16x16x32_bf16(At_[m_][k_], Bt_[n_][k_], acc[ai][bj][m_][n_], 0, 0, 0);          \
    __builtin_amdgcn_s_setprio(0);                                                                                    \
  } while (0)
#define G8_WAIT_V(n) asm volatile("s_waitcnt vmcnt(" #n ")" ::: "memory")
#define G8_WAIT_L(n) asm volatile("s_waitcnt lgkmcnt(" #n ")" ::: "memory")
#define G8_BAR __builtin_amdgcn_s_barrier()
#define G8_SCHED __builtin_amdgcn_sched_barrier(0)
  const int nblk = pnblk(), bid = pbid();
  const int lb = ((nblk & 7) == 0) ? ((bid & 7) * (nblk >> 3) + (bid >> 3)) : bid;
  const int ntiles_all = Mtiles * Ntiles;
  const int ntiles = (EPI == EPI_RESID0 || gscale != 1.f) ? ntiles_all : (ntiles_all / nblk) * nblk;
  const int nt = K / 64;
  for (int t = lb; t < ntiles; t += nblk) {
    const int tm = t / Ntiles, tn = t % Ntiles;
    const int brow = tm * 256, bcol = tn * 256;
    f32x4 acc[2][2][4][2];
#pragma unroll
    for (int a0 = 0; a0 < 2; ++a0)
#pragma unroll
      for (int b0 = 0; b0 < 2; ++b0)
#pragma unroll
        for (int m = 0; m < 4; ++m)
#pragma unroll
          for (int n = 0; n < 2; ++n) acc[a0][b0][m][n] = f32x4{0.f, 0.f, 0.f, 0.f};
    bf16x8 At[4][2], B0[2][2], B1[2][2];
    G8_STAGE(G8_SB(0, 0), rsB, voB, ldb, bcol, 0);
    G8_STAGE(G8_SA(0, 0), rsA, voA, lda, brow, 0);
    G8_STAGE(G8_SB(0, 1), rsB, voB, ldb, bcol + 128, 0);
    G8_STAGE(G8_SA(0, 1), rsA, voA, lda, brow + 128, 0);
    if (wr == 1) G8_BAR;
    G8_WAIT_V(4);
    G8_BAR;
    G8_STAGE(G8_SB(1, 0), rsB, voB, ldb, bcol, 1);
    G8_STAGE(G8_SA(1, 0), rsA, voA, lda, brow, 1);
    G8_STAGE(G8_SB(1, 1), rsB, voB, ldb, bcol + 128, 1);
    G8_WAIT_V(6);
    G8_BAR;
    for (int kt = 0; kt < nt - 2; kt += 2) {
      G8_LDB(B0, 0, 0); G8_SCHED; G8_LDA(At, 0, 0); G8_STAGE(G8_SA(1, 1), rsA, voA, lda, brow + 128, kt + 1);
      G8_WAIT_L(8); G8_BAR; G8_WAIT_L(0); G8_MMA(0, 0, At, B0); G8_BAR; G8_SCHED;
      G8_LDB(B1, 0, 1); G8_STAGE(G8_SB(0, 0), rsB, voB, ldb, bcol, kt + 2);
      G8_BAR; G8_WAIT_L(0); G8_MMA(0, 1, At, B1); G8_BAR;
      G8_LDA(At, 0, 1); G8_STAGE(G8_SA(0, 0), rsA, voA, lda, brow, kt + 2);
      G8_BAR; G8_WAIT_L(0); G8_MMA(1, 0, At, B0); G8_BAR; G8_SCHED;
      G8_STAGE(G8_SB(0, 1), rsB, voB, ldb, bcol + 128, kt + 2);
      G8_WAIT_V(6); G8_BAR; G8_MMA(1, 1, At, B1); G8_BAR;
      G8_LDB(B0, 1, 0); G8_SCHED; G8_LDA(At, 1, 0); G8_STAGE(G8_SA(0, 1), rsA, voA, lda, brow + 128, kt + 2);
      G8_WAIT_L(8); G8_BAR; G8_WAIT_L(0); G8_MMA(0, 0, At, B0); G8_BAR; G8_SCHED;
      G8_LDB(B1, 1, 1); G8_STAGE(G8_SB(1, 0), rsB, voB, ldb, bcol, kt + 3);
      G8_BAR; G8_WAIT_L(0); G8_MMA(0, 1, At, B1); G8_BAR;
      G8_LDA(At, 1, 1); G8_STAGE(G8_SA(1, 0), rsA, voA, lda, brow, kt + 3);
      G8_BAR; G8_WAIT_L(0); G8_MMA(1, 0, At, B0); G8_BAR; G8_SCHED;
      G8_STAGE(G8_SB(1, 1), rsB, voB, ldb, bcol + 128, kt + 3);
      G8_WAIT_V(6); G8_BAR; G8_MMA(1, 1, At, B1); G8_BAR;
    }
    {
      G8_LDB(B0, 0, 0); G8_LDA(At, 0, 0); G8_STAGE(G8_SA(1, 1), rsA, voA, lda, brow + 128, nt - 1);
      G8_BAR; G8_WAIT_L(0); G8_MMA(0, 0, At, B0); G8_BAR;
      G8_LDB(B1, 0, 1); G8_BAR; G8_WAIT_L(0); G8_MMA(0, 1, At, B1); G8_BAR;
      G8_LDA(At, 0, 1); G8_WAIT_V(4); G8_BAR; G8_WAIT_L(0); G8_MMA(1, 0, At, B0); G8_MMA(1, 1, At, B1); G8_BAR;
    }
    {
      G8_LDB(B0, 1, 0); G8_LDA(At, 1, 0); G8_WAIT_V(2); G8_BAR; G8_WAIT_L(0); G8_MMA(0, 0, At, B0); G8_BAR;
      G8_LDB(B1, 1, 1); G8_WAIT_V(0); G8_BAR; G8_WAIT_L(0); G8_MMA(0, 1, At, B1); G8_BAR;
      G8_LDA(At, 1, 1); G8_BAR; G8_WAIT_L(0); G8_MMA(1, 0, At, B0); G8_MMA(1, 1, At, B1); G8_BAR;
    }
    if (wr == 0) G8_BAR;
    constexpr bool STAGED = (EPI == EPI_RESID || EPI == EPI_RESID0 || EPI == EPI_INPROJ);
    int lane2 = lane_id();
    asm volatile("" : "+v"(lane2));
    const int fr2 = lane2 & 15, fq2 = lane2 >> 4;
    f32x4* stg = reinterpret_cast<f32x4*>(lds_all + wid * 16384);
    if constexpr (STAGED) {
#pragma unroll
      for (int b0 = 0; b0 < 2; ++b0)
#pragma unroll
        for (int m = 0; m < 4; ++m)
#pragma unroll
          for (int n = 0; n < 2; ++n) stg[(((b0 * 4 + m) * 2 + n) * 64) + lane2] = acc[0][b0][m][n];
    }
    gemm8_epilogue<EPI, STAGED>(p, acc, stg, lane2, brow, bcol, wr, wc, fr2, fq2, layer, gscale);
    asm volatile("s_waitcnt vmcnt(0)" ::: "memory");
    if constexpr (STAGED) __syncthreads();
  }
  __syncthreads();
  if (ntiles < ntiles_all) {
    constexpr int EPI_T = (EPI == EPI_RESID0) ? EPI_RESID : EPI;
    gemm_phase<EPI_T>(p, A, lda, Bt, ldb, 0, 0, K, layer, lds_all + (wid >> 2) * LDS_HALF, 1.f, ntiles, ntiles_all - ntiles, Ntiles);
  }
#undef G8_SA
#undef G8_SB
#undef G8_STAGE
#undef G8_LDA
#undef G8_LDB
#undef G8_MMA
#undef G8_WAIT_V
#undef G8_WAIT_L
#undef G8_BAR
#undef G8_SCHED
}

DEVI bf16x8 scale_q(uint4 u) {
  uint4 r;
  r.x = pack2(bflo(u.x) * 0.125f, bfhi(u.x) * 0.125f);
  r.y = pack2(bflo(u.y) * 0.125f, bfhi(u.y) * 0.125f);
  r.z = pack2(bflo(u.z) * 0.125f, bfhi(u.z) * 0.125f);
  r.w = pack2(bflo(u.w) * 0.125f, bfhi(u.w) * 0.125f);
  return __builtin_bit_cast(bf16x8, r);
}
DEVI void phase_attn(PP p, int layer, bool with_ctx_q, unsigned char* lds) {
  const int tid = ltid();
  const int lane = tid & 63, wid = __builtin_amdgcn_readfirstlane(tid >> 6), r = lane & 31, h = lane >> 5;
  const float* sinkp = p->attn_sink + (layer >> 1) * 8;
  const int nlat = NB * 2 * 128;
  const int nunits = nlat + (with_ctx_q ? NB * 2 * 8 : 0);
  for (int u = lbid(); u < nunits; u += lnblk()) {
    bool latent = u < nlat;
    int b, kvh, qg, tokbase;
    if (latent) {
      b = u >> 8;
      kvh = (u >> 7) & 1;
      qg = u & 127;
      tokbase = b * SEQ + qg * 32;
    } else {
      int v = u - nlat;
      b = v >> 4;
      kvh = (v >> 3) & 1;
      qg = v & 7;
      tokbase = TL + b * CTX + qg * 32;
    }
    const int hd = kvh * 4 + wid;
    const bf16_t* kb = p->kbuf + (size_t)(b * 2 + kvh) * KVLEN * 64;
    const bf16_t* vt = p->vbuf + (size_t)(b * 2 + kvh) * 64 * KVLEN;
    const int nch = latent ? 5 : 2;
    const int lbase = CTX + (qg - 4) * 32;
#define ATT_STAGE(c_, buf_)                                                                                           \
  {                                                                                                                   \
    const int kp0_ = ((c_) < 2) ? (c_) * 128 : lbase + ((c_) - 2) * 128;                                              \
    _Pragma("unroll") for (int i_ = 0; i_ < 4; ++i_) {                                                                \
      const int P_ = tid * 16 + i_ * 4096;                                                                            \
      const int krow_ = P_ >> 7, kslot_ = (P_ >> 4) & 7;                                                              \
      int kp_ = kp0_ + krow_;                                                                                         \
      kp_ = kp_ < 0 ? 0 : (kp_ > KVLEN - 1 ? KVLEN - 1 : kp_);                                                        \
      __builtin_amdgcn_global_load_lds((const unsigned*)(kb + (size_t)kp_ * 64 + ((kslot_ ^ ((krow_ >> 1) & 7)) << 3)), \
                                       (__attribute__((address_space(3))) unsigned*)(lds + (buf_) * 32768 + P_), 16, 0, 0); \
      const int vrow_ = P_ >> 8, vslot_ = (P_ >> 4) & 15;                                                             \
      int vp_ = kp0_ + ((vslot_ ^ (vrow_ & 15)) << 3);                                                                \
      vp_ = vp_ < 0 ? 0 : (vp_ > KVLEN - 8 ? KVLEN - 8 : vp_);                                                        \
      __builtin_amdgcn_global_load_lds((const unsigned*)(vt + (size_t)vrow_ * KVLEN + vp_),                           \
                                       (__attribute__((address_space(3))) unsigned*)(lds + (buf_) * 32768 + 16384 + P_), 16, 0, 0); \
    }                                                                                                                 \
  }
    __syncthreads();
    ATT_STAGE(0, 0)
    bf16x8 qf[4];
    {
      const bf16_t* qp = p->P + (size_t)(tokbase + r) * 2048 + hd * 64 + 8 * h;
#pragma unroll
      for (int st = 0; st < 4; ++st) qf[st] = scale_q(*reinterpret_cast<const uint4*>(qp + 16 * st));
    }
    f32x16 O0, O1;
#pragma unroll
    for (int i = 0; i < 16; ++i) {
      O0[i] = 0.f;
      O1[i] = 0.f;
    }
    float m_run = sinkp[hd];
    float l_run = (h == 0) ? 1.f : 0.f;
    for (int c = 0; c < nch; ++c) {
      const int buf = c & 1;
      asm volatile("s_waitcnt vmcnt(0)" ::: "memory");
      __syncthreads();
      if (c + 1 < nch) ATT_STAGE(c + 1, buf ^ 1)
      const unsigned char* LK = lds + buf * 32768;
      const unsigned char* LV = LK + 16384;
#pragma unroll 1
      for (int kbi = 0; kbi < 4; ++kbi) {
        int mode = 0;
        if (c >= 2) {
          const int d = (c - 2) * 4 + kbi - 4;
          const int kblk = qg + d;
          if (d > 4 || kblk < 0 || kblk > 127) continue;
          mode = (d == -4) ? 1 : ((d == 4) ? 2 : 0);
        }
        f32x16 S;
#pragma unroll
        for (int i = 0; i < 16; ++i) S[i] = 0.f;
        {
          const int krow = kbi * 32 + r;
#pragma unroll
          for (int st = 0; st < 4; ++st) {
            bf16x8 kf = *reinterpret_cast<const bf16x8*>(LK + krow * 128 + (((2 * st + h) ^ ((krow >> 1) & 7)) << 4));
            S = __builtin_amdgcn_mfma_f32_32x32x16_bf16(kf, qf[st], S, 0, 0, 0);
          }
        }
        if (mode) {
          float negbig;
          asm volatile("v_mov_b32 %0, 0xf149f2ca" : "=v"(negbig));
#pragma unroll
          for (int i = 0; i < 16; ++i) {
            int kk = (i & 3) + 8 * (i >> 2) + 4 * h;
            bool ok = (mode == 1) ? (kk >= r) : (kk <= r);
            if (!ok) S[i] = negbig;
          }
        }
        float bm = S[0];
#pragma unroll
        for (int i = 1; i < 16; ++i) bm = fmaxf(bm, S[i]);
        bm = fmaxf(bm, shx_f(bm, 32));
        float m_new = fmaxf(m_run, bm);
        const float L2E = 1.4426950408889634f;
        float nm = -m_new * L2E;
        float psum = 0.f;
#pragma unroll
        for (int i = 0; i < 16; ++i) {
          S[i] = __builtin_amdgcn_exp2f(fmaf(S[i], L2E, nm));
          psum += S[i];
        }
        if (__any(m_new > m_run)) {
          float alpha = __builtin_amdgcn_exp2f((m_run - m_new) * L2E);
          l_run *= alpha;
#pragma unroll
          for (int i = 0; i < 16; ++i) {
            O0[i] *= alpha;
            O1[i] *= alpha;
          }
        }
        l_run += psum;
        m_run = m_new;
#pragma unroll
        for (int sidx = 0; sidx < 2; ++sidx) {
          uint4 pk;
          pk.x = pack2(S[8 * sidx + 0], S[8 * sidx + 1]);
          pk.y = pack2(S[8 * sidx + 2], S[8 * sidx + 3]);
          pk.z = pack2(S[8 * sidx + 4], S[8 * sidx + 5]);
          pk.w = pack2(S[8 * sidx + 6], S[8 * sidx + 7]);
          bf16x8 pf = __builtin_bit_cast(bf16x8, pk);
          const int vch = 4 * kbi + 2 * sidx + h;
          bf16x8 v0 = *reinterpret_cast<const bf16x8*>(LV + r * 256 + ((vch ^ (r & 15)) << 4));
          bf16x8 v1 = *reinterpret_cast<const bf16x8*>(LV + (32 + r) * 256 + ((vch ^ (r & 15)) << 4));
          O0 = __builtin_amdgcn_mfma_f32_32x32x16_bf16(v0, pf, O0, 0, 0, 0);
          O1 = __builtin_amdgcn_mfma_f32_32x32x16_bf16(v1, pf, O1, 0, 0, 0);
        }
      }
    }
#undef ATT_STAGE
    float l_tot = l_run + shx_f(l_run, 32);
    float inv = 1.f / l_tot;
    bf16_t* op = p->mix + (size_t)(tokbase + r) * LDMIX + hd * 64 + 4 * h;
#pragma unroll
    for (int g4 = 0; g4 < 4; ++g4) {
      uint2 o;
      o.x = pack2(O0[4 * g4 + 0] * inv, O0[4 * g4 + 1] * inv);
      o.y = pack2(O0[4 * g4 + 2] * inv, O0[4 * g4 + 3] * inv);
      *reinterpret_cast<uint2*>(op + 8 * g4) = o;
      o.x = pack2(O1[4 * g4 + 0] * inv, O1[4 * g4 + 1] * inv);
      o.y = pack2(O1[4 * g4 + 2] * inv, O1[4 * g4 + 3] * inv);
      *reinterpret_cast<uint2*>(op + 32 + 8 * g4) = o;
    }
  }
  __syncthreads();
}

DEVI void fill_tw(float2* tw, int n) {
  for (int i = ltid(); i < n; i += NTHREADS) {
    float sn, cn;
    sincospif(2.f * (float)i / (float)n, &sn, &cn);
    tw[i] = make_float2(cn, sn);
  }
  __syncthreads();
}

DEVI bf16x8 lds_col8(const bf16_t* bp, int stride) {
  unsigned e0 = bp[0], e1 = bp[stride], e2 = bp[2 * stride], e3 = bp[3 * stride];
  unsigned e4 = bp[4 * stride], e5 = bp[5 * stride], e6 = bp[6 * stride], e7 = bp[7 * stride];
  uint4 pk;
  pk.x = e0 | (e1 << 16);
  pk.y = e2 | (e3 << 16);
  pk.z = e4 | (e5 << 16);
  pk.w = e6 | (e7 << 16);
  return __builtin_bit_cast(bf16x8, pk);
}

DEVI void phase_fft_a(PP p, unsigned char* lds) {
  const int tid = ltid();
  const int lane = tid & 63, wid = __builtin_amdgcn_readfirstlane(tid >> 6), fr = lane & 15, fq = lane >> 4;
  float2* tw = reinterpret_cast<float2*>(lds + 66560);
  fill_tw(tw, 64);
  bf16x8 af[2][2];
#pragma unroll
  for (int ks = 0; ks < 2; ++ks) {
    unsigned short cr[8], ci[8];
#pragma unroll
    for (int j = 0; j < 8; ++j) {
      int n1 = 32 * ks + 8 * fq + j, k1 = 16 * wid + fr;
      float2 t = tw[(k1 * n1) & 63];
      cr[j] = f2bf(t.x);
      ci[j] = f2bf(-t.y);
    }
    uint4 a0, a1;
    a0.x = cr[0] | ((unsigned)cr[1] << 16); a0.y = cr[2] | ((unsigned)cr[3] << 16);
    a0.z = cr[4] | ((unsigned)cr[5] << 16); a0.w = cr[6] | ((unsigned)cr[7] << 16);
    a1.x = ci[0] | ((unsigned)ci[1] << 16); a1.y = ci[2] | ((unsigned)ci[3] << 16);
    a1.z = ci[4] | ((unsigned)ci[5] << 16); a1.w = ci[6] | ((unsigned)ci[7] << 16);
    af[0][ks] = __builtin_bit_cast(bf16x8, a0);
    af[1][ks] = __builtin_bit_cast(bf16x8, a1);
  }
  const bf16_t* l16 = reinterpret_cast<const bf16_t*>(lds);
  for (int u = lbid(); u < NB * 64; u += lnblk()) {
    int b = u >> 6, n2 = u & 63;
    __syncthreads();
#pragma unroll
    for (int i = 0; i < 16; ++i) {
      int row = (tid >> 6) + 4 * i, piece = tid & 63;
      uint4 v = *reinterpret_cast<const uint4*>(p->P + (size_t)(b * SEQ + 64 * row + n2) * 2048 + 768 + piece * 8);
      *reinterpret_cast<uint4*>(lds + row * 1040 + piece * 16) = v;
    }
    __syncthreads();
    float tc[4], ts[4];
#pragma unroll
    for (int j = 0; j < 4; ++j) sincospif((float)(n2 * (16 * wid + 4 * fq + j)) / 2048.f, &ts[j], &tc[j]);
    for (int nb = 0; nb < 4; ++nb) {
      f32x4 acc[2][8];
#pragma unroll
      for (int n = 0; n < 8; ++n) {
        acc[0][n] = f32x4{0.f, 0.f, 0.f, 0.f};
        acc[1][n] = f32x4{0.f, 0.f, 0.f, 0.f};
      }
#pragma unroll
      for (int ks = 0; ks < 2; ++ks)
#pragma unroll
        for (int nf = 0; nf < 8; ++nf) {
          bf16x8 bfr = lds_col8(l16 + (32 * ks + 8 * fq) * 520 + 128 * nb + 16 * nf + fr, 520);
          acc[0][nf] = __builtin_amdgcn_mfma_f32_16x16x32_bf16(af[0][ks], bfr, acc[0][nf], 0, 0, 0);
          acc[1][nf] = __builtin_amdgcn_mfma_f32_16x16x32_bf16(af[1][ks], bfr, acc[1][nf], 0, 0, 0);
        }
#pragma unroll
      for (int j = 0; j < 4; ++j) {
        int k1 = 16 * wid + 4 * fq + j;
        bf16_t* o = p->fa + (size_t)(b * SEQ + k1 * 64 + n2) * 1024 + 128 * nb + fr;
#pragma unroll
        for (int nf = 0; nf < 8; ++nf) {
          float re = acc[0][nf][j], im = acc[1][nf][j];
          o[16 * nf] = f2bf(re * tc[j] + im * ts[j]);
          o[512 + 16 * nf] = f2bf(im * tc[j] - re * ts[j]);
        }
      }
    }
  }
  __syncthreads();
}

DEVI void phase_fft_b(PP p, unsigned char* lds) {
  const int tid = ltid();
  const int lane = tid & 63, wid = __builtin_amdgcn_readfirstlane(tid >> 6), fr = lane & 15, fq = lane >> 4;
  float2* tw = reinterpret_cast<float2*>(lds + 67584);
  fill_tw(tw, 64);
  bf16x8 wb[2][4];
#pragma unroll
  for (int ks = 0; ks < 4; ++ks) {
    unsigned short zr[8], zi[8];
#pragma unroll
    for (int j = 0; j < 8; ++j) {
      int k = 32 * ks + 8 * fq + j, part = k >> 6, n2 = k & 63, k2 = 16 * wid + fr;
      float2 t = tw[(k2 * n2) & 63];
      zr[j] = f2bf(part ? t.y : t.x);
      zi[j] = f2bf(part ? t.x : -t.y);
    }
    uint4 a0, a1;
    a0.x = zr[0] | ((unsigned)zr[1] << 16); a0.y = zr[2] | ((unsigned)zr[3] << 16);
    a0.z = zr[4] | ((unsigned)zr[5] << 16); a0.w = zr[6] | ((unsigned)zr[7] << 16);
    a1.x = zi[0] | ((unsigned)zi[1] << 16); a1.y = zi[2] | ((unsigned)zi[3] << 16);
    a1.z = zi[4] | ((unsigned)zi[5] << 16); a1.w = zi[6] | ((unsigned)zi[7] << 16);
    wb[0][ks] = __builtin_bit_cast(bf16x8, a0);
    wb[1][ks] = __builtin_bit_cast(bf16x8, a1);
  }
  const bf16_t* l16 = reinterpret_cast<const bf16_t*>(lds);
  const float scale = 0.0013810679320049757f;
  for (int u = lbid(); u < NB * 128; u += lnblk()) {
    int b = u >> 7, k1 = (u >> 1) & 63, hf = u & 1;
    __syncthreads();
#pragma unroll
    for (int i = 0; i < 16; ++i) {
      int row = (tid >> 5) + 8 * i, piece = tid & 31;
      int part = row >> 6, n2 = row & 63;
      uint4 v = *reinterpret_cast<const uint4*>(p->fa + (size_t)(b * SEQ + k1 * 64 + n2) * 1024 + part * 512 + hf * 256 + piece * 8);
      *reinterpret_cast<uint4*>(lds + row * 528 + piece * 16) = v;
    }
    __syncthreads();
    for (int nb = 0; nb < 2; ++nb) {
      f32x4 acc[2][8];
#pragma unroll
      for (int n = 0; n < 8; ++n) {
        acc[0][n] = f32x4{0.f, 0.f, 0.f, 0.f};
        acc[1][n] = f32x4{0.f, 0.f, 0.f, 0.f};
      }
#pragma unroll
      for (int ks = 0; ks < 4; ++ks)
#pragma unroll
        for (int nf = 0; nf < 8; ++nf) {
          bf16x8 bfr = lds_col8(l16 + (32 * ks + 8 * fq) * 264 + 128 * nb + 16 * nf + fr, 264);
          acc[0][nf] = __builtin_amdgcn_mfma_f32_16x16x32_bf16(wb[0][ks], bfr, acc[0][nf], 0, 0, 0);
          acc[1][nf] = __builtin_amdgcn_mfma_f32_16x16x32_bf16(wb[1][ks], bfr, acc[1][nf], 0, 0, 0);
        }
#pragma unroll
      for (int j = 0; j < 4; ++j) {
        int k2 = 16 * wid + 4 * fq + j;
        bf16_t* o = p->mix + (size_t)(b * SEQ + k1 + 64 * k2) * LDMIX + 512 + hf * 256 + 128 * nb + fr;
#pragma unroll
        for (int nf = 0; nf < 8; ++nf) {
          o[16 * nf] = f2bf(acc[0][nf][j] * scale);
          o[512 + 16 * nf] = f2bf(acc[1][nf][j] * scale);
        }
      }
    }
  }
  __syncthreads();
}

DEVI void phase_dft_ctx(PP p, unsigned char* lds) {
  float2* tw = reinterpret_cast<float2*>(lds);
  fill_tw(tw, 256);
  int tid = ltid();
  const float scale = 0.005524271728019903f;
  for (int u = lbid(); u < NB * 64; u += lnblk()) {
    int b = u >> 6, k0 = (u & 63) * 4;
    for (int pass = 0; pass < 2; ++pass) {
      int ch = tid + pass * 256;
      float zr[4], zi[4];
#pragma unroll
      for (int kk = 0; kk < 4; ++kk) zr[kk] = zi[kk] = 0.f;
#pragma unroll 8
      for (int n = 0; n < 256; ++n) {
        float v = bf2f(p->P[(size_t)(TL + b * CTX + n) * 2048 + 768 + ch]);
#pragma unroll
        for (int kk = 0; kk < 4; ++kk) {
          float2 t = tw[(n * (k0 + kk)) & 255];
          zr[kk] += v * t.x;
          zi[kk] -= v * t.y;
        }
      }
#pragma unroll
      for (int kk = 0; kk < 4; ++kk) {
        bf16_t* o = p->mix + (size_t)(TL + b * CTX + k0 + kk) * LDMIX;
        o[512 + ch] = f2bf(zr[kk] * scale);
        o[1024 + ch] = f2bf(zi[kk] * scale);
      }
    }
  }
  __syncthreads();
}

DEVI void phase_sgu(PP p, int j, int nchunks, unsigned char* lds) {
  float* rs = reinterpret_cast<float*>(lds);
  unsigned char* LA = lds + 1024;
  unsigned char* LB = lds + 1024 + 32768;
  const int tid = ltid();
  const int lane = tid & 63, wid = __builtin_amdgcn_readfirstlane(tid >> 6), fr = lane & 15, fq = lane >> 4;
  const float* nw = p->gs_norm_w + j * 1024;
  for (int u = lbid(); u < nchunks * 8; u += lnblk()) {
    const int chunk = u >> 3, g = u & 7;
    const int tok0 = chunk * 128;
    const bf16_t* vT = p->zvT + ((size_t)chunk * 1024 + g * 128) * 128;
    __syncthreads();
    if (tid < 128) {
      const float* rp = p->rowss + (size_t)chunk * 32 * 128 + tid;
      float ss = 0.f;
#pragma unroll
      for (int sl = 0; sl < 32; ++sl) ss += rp[sl * 128];
      rs[tid] = rsqrtf(ss * (1.f / 1024.f) + 1e-6f);
    }
#pragma unroll
    for (int i = 0; i < 8; ++i) {
      int idx = tid + 256 * i, row = idx >> 4, c = idx & 15;
      uint4 v = *reinterpret_cast<const uint4*>(vT + (size_t)row * 128 + c * 8);
      *reinterpret_cast<uint4*>(LB + row * 256 + ((c ^ (row & 15)) << 4)) = v;
    }
    __syncthreads();
    {
      const float* wsg = p->gs_w_s + ((size_t)j * 8 + g) * 128 * 128;
#pragma unroll
      for (int i = 0; i < 8; ++i) {
        int idx = tid + 256 * i, row = idx >> 4, c = idx & 15;
        const float4* wp = reinterpret_cast<const float4*>(wsg + (size_t)row * 128 + c * 8);
        float4 w0 = wp[0], w1 = wp[1];
        const float* rk = rs + c * 8;
        uint4 pk;
        pk.x = pack2(w0.x * rk[0], w0.y * rk[1]);
        pk.y = pack2(w0.z * rk[2], w0.w * rk[3]);
        pk.z = pack2(w1.x * rk[4], w1.y * rk[5]);
        pk.w = pack2(w1.z * rk[6], w1.w * rk[7]);
        *reinterpret_cast<uint4*>(LA + row * 256 + ((c ^ (row & 15)) << 4)) = pk;
      }
    }
    __syncthreads();
    f32x4 acc[2][8];
#pragma unroll
    for (int m = 0; m < 2; ++m)
#pragma unroll
      for (int n = 0; n < 8; ++n) acc[m][n] = f32x4{0.f, 0.f, 0.f, 0.f};
#pragma unroll
    for (int ks = 0; ks < 4; ++ks) {
      const int sl = ((4 * ks + fq) ^ fr) << 4;
      bf16x8 a0 = *reinterpret_cast<const bf16x8*>(LA + (32 * wid + fr) * 256 + sl);
      bf16x8 a1 = *reinterpret_cast<const bf16x8*>(LA + (32 * wid + 16 + fr) * 256 + sl);
#pragma unroll
      for (int n = 0; n < 8; ++n) {
        bf16x8 bfr = *reinterpret_cast<const bf16x8*>(LB + (16 * n + fr) * 256 + sl);
        acc[0][n] = __builtin_amdgcn_mfma_f32_16x16x32_bf16(a0, bfr, acc[0][n], 0, 0, 0);
        acc[1][n] = __builtin_amdgcn_mfma_f32_16x16x32_bf16(a1, bfr, acc[1][n], 0, 0, 0);
      }
    }
    __syncthreads();
    {
      const float* bsg = p->gs_b_s + ((size_t)j * 8 + g) * 128;
#pragma unroll
      for (int m = 0; m < 2; ++m)
#pragma unroll
        for (int jj = 0; jj < 4; ++jj) {
          const int pp = 32 * wid + 16 * m + 4 * fq + jj;
          const float bias = bsg[pp];
#pragma unroll
          for (int n = 0; n < 8; ++n) {
            const int c = 16 * n + fr;
            float sv = nw[g * 128 + c] * acc[m][n][jj] + bias;
            *reinterpret_cast<bf16_t*>(LA + pp * 256 + (((c >> 3) ^ (pp & 15)) << 4) + (c & 7) * 2) = f2bf(sv);
          }
        }
    }
    __syncthreads();
#pragma unroll
    for (int i = 0; i < 8; ++i) {
      int idx = tid + 256 * i, row = idx >> 4, c = idx & 15;
      uint4 sv8 = *reinterpret_cast<const uint4*>(LA + row * 256 + ((c ^ (row & 15)) << 4));
      uint4 u8 = *reinterpret_cast<const uint4*>(p->P + (size_t)(tok0 + row) * 2048 + g * 128 + c * 8);
      uint4 o;
      o.x = pack2(bflo(u8.x) * bflo(sv8.x), bfhi(u8.x) * bfhi(sv8.x));
      o.y = pack2(bflo(u8.y) * bflo(sv8.y), bfhi(u8.y) * bfhi(sv8.y));
      o.z = pack2(bflo(u8.z) * bflo(sv8.z), bfhi(u8.z) * bfhi(sv8.z));
      o.w = pack2(bflo(u8.w) * bflo(sv8.w), bfhi(u8.w) * bfhi(sv8.w));
      *reinterpret_cast<uint4*>(p->mix + (size_t)(tok0 + row) * LDMIX + g * 128 + c * 8) = o;
    }
  }
  __syncthreads();
}

DEVI float mkkey(float v, unsigned idx, unsigned mask) { return __uint_as_float((__float_as_uint(v) & ~mask) | idx); }
#define INSERT16(list, x)                                                                                               \
  {                                                                                                                     \
    _Pragma("unroll") for (int i_ = 15; i_ >= 1; --i_) list[i_] = __builtin_amdgcn_fmed3f(list[i_ - 1], list[i_], x); \
    list[0] = fmaxf(list[0], x);                                                                                        \
  }

DEVI void phase_route(PP p, int layer, int ntok, unsigned char* lds) {
  const int tid = ltid();
  const int lane = tid & 63, wid = __builtin_amdgcn_readfirstlane(tid >> 6), fr = lane & 15, fq = lane >> 4;
  const int nb8 = lnblk() >> 3, bid = lbid();
  const int hh = bid & 7, slot = bid >> 3;
  const int ntiles = ntok / 64;
  const bool active = slot < nb8;
  float* sc = reinterpret_cast<float*>(lds + 32768);
  const float NEGK = -3.0e38f;
  for (int half = 0; half < 2; ++half) {
    __syncthreads();
    {
      const bf16_t* ksrc = p->keysb + ((size_t)((layer * 8 + hh) * 2 + half) * 128) * 128;
#pragma unroll
      for (int i = 0; i < 8; ++i) {
        int idx = tid + 256 * i, row = idx >> 4, c = idx & 15;
        uint4 v = *reinterpret_cast<const uint4*>(ksrc + (size_t)row * 128 + c * 8);
        *reinterpret_cast<uint4*>(lds + row * 256 + ((c ^ (row & 15)) << 4)) = v;
      }
    }
    __syncthreads();
    bf16x8 an[4];
    if (active && slot < ntiles) {
      const bf16_t* qa = p->P + (size_t)(slot * 64 + wid * 16 + fr) * 2048 + hh * 256 + half * 128 + fq * 8;
#pragma unroll
      for (int ks = 0; ks < 4; ++ks) an[ks] = *reinterpret_cast<const bf16x8*>(qa + ks * 32);
    }
    for (int tt = slot; active && tt < ntiles; tt += nb8) {
      const int tok0 = tt * 64;
      {
        bf16x8 a[4];
#pragma unroll
        for (int ks = 0; ks < 4; ++ks) a[ks] = an[ks];
        {
          const int ttn = (tt + nb8 < ntiles) ? tt + nb8 : tt;
          const bf16_t* qa = p->P + (size_t)(ttn * 64 + wid * 16 + fr) * 2048 + hh * 256 + half * 128 + fq * 8;
#pragma unroll
          for (int ks = 0; ks < 4; ++ks) an[ks] = *reinterpret_cast<const bf16x8*>(qa + ks * 32);
        }
#pragma unroll
        for (int nf = 0; nf < 8; ++nf) {
          f32x4 acc = f32x4{0.f, 0.f, 0.f, 0.f};
          const int krow = nf * 16 + fr;
#pragma unroll
          for (int ks = 0; ks < 4; ++ks) {
            bf16x8 bb = *reinterpret_cast<const bf16x8*>(lds + krow * 256 + (((4 * ks + fq) ^ (krow & 15)) << 4));
            acc = __builtin_amdgcn_mfma_f32_16x16x32_bf16(a[ks], bb, acc, 0, 0, 0);
          }
#pragma unroll
          for (int j = 0; j < 4; ++j) sc[(wid * 16 + fq * 4 + j) * 133 + krow + (krow >> 5)] = mkkey(acc[j], (unsigned)krow, 127u);
        }
      }
      const int prt = lane >> 4;
      float list[16];
#pragma unroll
      for (int i = 0; i < 16; ++i) list[i] = NEGK;
      {
        const float* kr = sc + (wid * 16 + fr) * 133 + prt * 33;
#pragma unroll 4
        for (int e = 0; e < 32; ++e) {
          float x = kr[e];
          INSERT16(list, x)
        }
      }
#pragma unroll 1
      for (int step = 16; step <= 32; step <<= 1) {
        float other[16];
#pragma unroll
        for (int i = 0; i < 16; ++i) other[i] = shx_f(list[i], step);
#pragma unroll
        for (int i = 0; i < 16; ++i) {
          float x = other[i];
          INSERT16(list, x)
        }
      }
      if (prt == 0) {
        float4* o = reinterpret_cast<float4*>(p->tops + ((size_t)(tok0 + wid * 16 + fr) * 16 + hh * 2 + half) * 16);
        o[0] = make_float4(list[0], list[1], list[2], list[3]);
        o[1] = make_float4(list[4], list[5], list[6], list[7]);
        o[2] = make_float4(list[8], list[9], list[10], list[11]);
        o[3] = make_float4(list[12], list[13], list[14], list[15]);
      }
    }
  }
  __syncthreads();
  float* fl = reinterpret_cast<float*>(lds);
  for (int t4 = slot; active && t4 < ntiles + 3 * nb8; t4 += 4 * nb8) {
    const int tt = t4 + (tid >> 6) * nb8;
    if (tt < ntiles) {
      const int tok = tt * 64 + (tid & 63);
      const float4* src = reinterpret_cast<const float4*>(p->tops + ((size_t)tok * 16 + hh * 2) * 16);
      float v0[16], v1[16];
#pragma unroll
      for (int i = 0; i < 4; ++i) {
        float4 a = src[i], bq = src[4 + i];
        v0[4 * i] = a.x; v0[4 * i + 1] = a.y; v0[4 * i + 2] = a.z; v0[4 * i + 3] = a.w;
        v1[4 * i] = bq.x; v1[4 * i + 1] = bq.y; v1[4 * i + 2] = bq.z; v1[4 * i + 3] = bq.w;
      }
      float* f0 = fl + tid * 33;
      float* f1 = f0 + 16;
#pragma unroll
      for (int i = 0; i < 16; ++i) {
        f0[i] = v0[i];
        f1[i] = v1[i];
      }
      float l2[16];
#pragma unroll
      for (int i = 0; i < 16; ++i) l2[i] = mkkey(v0[0] + v1[i], (unsigned)(15 - i), 255u);
#pragma unroll
      for (int a = 1; a < 16; ++a)
#pragma unroll
        for (int bq = 0; bq < 16; ++bq)
          if ((a + 1) * (bq + 1) <= 16) {
            float x = mkkey(v0[a] + v1[bq], (unsigned)(a * 16 + 15 - bq), 255u);
            INSERT16(l2, x)
          }
      float sv[16];
      int ev[16];
      float mx = NEGK;
#pragma unroll
      for (int k = 0; k < 16; ++k) {
        unsigned ab = __float_as_uint(l2[k]) & 255u;
        unsigned k0 = __float_as_uint(f0[ab >> 4]), k1 = __float_as_uint(f1[15u - (ab & 15u)]);
        sv[k] = __uint_as_float(k0 & ~127u) + __uint_as_float(k1 & ~127u);
        ev[k] = (int)((k0 & 127u) * 128u + (k1 & 127u));
        mx = fmaxf(mx, sv[k]);
      }
      float sum = 0.f;
#pragma unroll
      for (int k = 0; k < 16; ++k) {
        sv[k] = __expf(sv[k] - mx);
        sum += sv[k];
      }
      float inv = 1.f / sum;
      size_t o = (size_t)tok * 128 + hh * 16;
      int4* eo = reinterpret_cast<int4*>(p->eidx + o);
      float4* go = reinterpret_cast<float4*>(p->gate + o);
#pragma unroll
      for (int k4 = 0; k4 < 4; ++k4) {
        eo[k4] = make_int4(ev[4 * k4], ev[4 * k4 + 1], ev[4 * k4 + 2], ev[4 * k4 + 3]);
        go[k4] = make_float4(sv[4 * k4] * inv, sv[4 * k4 + 1] * inv, sv[4 * k4 + 2] * inv, sv[4 * k4 + 3] * inv);
      }
    }
  }
  __syncthreads();
}

typedef float v2f __attribute__((ext_vector_type(2)));
DEVI void dec16(uint4 q, v2f* f) {
  f[0] = __builtin_amdgcn_cvt_pk_f32_fp8((int)q.x, false);
  f[1] = __builtin_amdgcn_cvt_pk_f32_fp8((int)q.x, true);
  f[2] = __builtin_amdgcn_cvt_pk_f32_fp8((int)q.y, false);
  f[3] = __builtin_amdgcn_cvt_pk_f32_fp8((int)q.y, true);
  f[4] = __builtin_amdgcn_cvt_pk_f32_fp8((int)q.z, false);
  f[5] = __builtin_amdgcn_cvt_pk_f32_fp8((int)q.z, true);
  f[6] = __builtin_amdgcn_cvt_pk_f32_fp8((int)q.w, false);
  f[7] = __builtin_amdgcn_cvt_pk_f32_fp8((int)q.w, true);
}
struct ExpBuf {
  uint4 q[8];
  uint4 h0, h1;
};
DEVI void exp_load(ExpBuf& B, const unsigned char* tab, const signed char* hrow, const unsigned short* idp, int j8, bool want_x) {
  const uint4 idv = *reinterpret_cast<const uint4*>(idp);
  const unsigned idw[4] = {idv.x, idv.y, idv.z, idv.w};
#pragma unroll
  for (int i = 0; i < 8; ++i) {
    unsigned e = (i & 1) ? (idw[i >> 1] >> 16) : (idw[i >> 1] & 0xffffu);
    unsigned off = e * (unsigned)D + 16u * j8;
    B.q[i] = *reinterpret_cast<const uint4*>(tab + off);
  }
  if (want_x) B.h0 = *reinterpret_cast<const uint4*>(hrow + 16 * j8);
}
template <int CTRL>
DEVI int dpp_movi(int v) { return __builtin_amdgcn_mov_dpp(v, CTRL, 0xF, 0xF, true); }
DEVI void exp_u_compute(const ExpBuf& B, int* pp, int j8) {
  int s0 = 0;
#pragma unroll
  for (int i = 0; i < 8; ++i) {
    int d = __builtin_amdgcn_sdot4((int)B.q[i].x, (int)B.h0.x, 0, false);
    d = __builtin_amdgcn_sdot4((int)B.q[i].y, (int)B.h0.y, d, false);
    d = __builtin_amdgcn_sdot4((int)B.q[i].z, (int)B.h0.z, d, false);
    d = __builtin_amdgcn_sdot4((int)B.q[i].w, (int)B.h0.w, d, false);
    d += dpp_movi<0xB1>(d);
    d += dpp_movi<0x4E>(d);
    d += dpp_movi<0x141>(d);
    s0 = (j8 == i) ? d : s0;
  }
  pp[0] += s0;
}
DEVI void exp_v_accum(const ExpBuf& B, unsigned w0, unsigned w1, int* acc) {
#pragma unroll
  for (int ig = 0; ig < 2; ++ig) {
    const unsigned wq = ig ? w1 : w0;
    const uint4 R0 = B.q[4 * ig], R1 = B.q[4 * ig + 1], R2 = B.q[4 * ig + 2], R3 = B.q[4 * ig + 3];
    const unsigned r0[4] = {R0.x, R0.y, R0.z, R0.w}, r1[4] = {R1.x, R1.y, R1.z, R1.w};
    const unsigned r2[4] = {R2.x, R2.y, R2.z, R2.w}, r3[4] = {R3.x, R3.y, R3.z, R3.w};
#pragma unroll
    for (int q = 0; q < 4; ++q) {
      unsigned A = __builtin_amdgcn_perm(r1[q], r0[q], 0x05010400u);
      unsigned Bq = __builtin_amdgcn_perm(r1[q], r0[q], 0x07030602u);
      unsigned C = __builtin_amdgcn_perm(r3[q], r2[q], 0x05010400u);
      unsigned E = __builtin_amdgcn_perm(r3[q], r2[q], 0x07030602u);
      unsigned D0 = __builtin_amdgcn_perm(C, A, 0x05040100u);
      unsigned D1 = __builtin_amdgcn_perm(C, A, 0x07060302u);
      unsigned D2 = __builtin_amdgcn_perm(E, Bq, 0x05040100u);
      unsigned D3 = __builtin_amdgcn_perm(E, Bq, 0x07060302u);
      acc[4 * q + 0] = __builtin_amdgcn_sdot4((int)D0, (int)wq, acc[4 * q + 0], false);
      acc[4 * q + 1] = __builtin_amdgcn_sdot4((int)D1, (int)wq, acc[4 * q + 1], false);
      acc[4 * q + 2] = __builtin_amdgcn_sdot4((int)D2, (int)wq, acc[4 * q + 2], false);
      acc[4 * q + 3] = __builtin_amdgcn_sdot4((int)D3, (int)wq, acc[4 * q + 3], false);
    }
  }
}
DEVI void exp_v_finish(float4* xo, const float4* xq, const float4* gq, int* acc, float swt, int grp, float gscale) {
  float o[16];
#pragma unroll
  for (int k = 0; k < 16; ++k) {
    int a = acc[k];
    a += dpp_movi<0x128>(a);
    a += shx_i(a, 16);
    a += shx_i(a, 32);
    o[k] = (float)a;
    acc[k] = 0;
  }
  if (grp == 0) {
    const float sc = gscale * swt;
#pragma unroll
    for (int i4 = 0; i4 < 4; ++i4) {
      float4 r = xq[i4];
      r.x += sc * gq[i4].x * o[i4 * 4 + 0];
      r.y += sc * gq[i4].y * o[i4 * 4 + 1];
      r.z += sc * gq[i4].z * o[i4 * 4 + 2];
      r.w += sc * gq[i4].w * o[i4 * 4 + 3];
      xo[i4] = r;
    }
  }
}
DEVI void phase_expert(PP p, int layer, int ntok, unsigned char* lds, float gscale = 1.f, int idmask = 0xffff) {
  const int tid = ltid();
  const int lane = tid & 63, wid = __builtin_amdgcn_readfirstlane(tid >> 6), j8 = lane & 7, grp = lane >> 3;
  const int nb = lnblk(), bid = lbid();
  unsigned short* ids = reinterpret_cast<unsigned short*>(lds);
  float* part = reinterpret_cast<float*>(lds + TPB * 128 * 2);
  unsigned char* w8 = lds + TPB * 128 * 2 + TPB * 128 * 4;
  float* swl = reinterpret_cast<float*>(lds + TPB * 128 * 2 + TPB * 128 * 4 + TPB * 128);
  const unsigned char* ut = p->utab + (size_t)layer * NEXP * D;
  const unsigned char* vt = p->vtab + (size_t)layer * NEXP * D;
  int tpb = (ntok + nb - 1) / nb;
  if (tpb > TPB) tpb = TPB;
  const int npass = (ntok + nb * tpb - 1) / (nb * tpb);
  for (int pass = 0; pass < npass; ++pass) {
    const int tok0 = (pass * nb + bid) * tpb;
    int cnt = ntok - tok0;
    if (cnt > tpb) cnt = tpb;
    if (cnt < 0) cnt = 0;
    for (int i = tid; i < cnt * 128; i += NTHREADS) {
      {
        int k = i & 127, hf = k >> 6, kk = k & 63;
        ids[(i & ~127) + hf * 64 + (kk & 7) * 8 + (kk >> 3)] = (unsigned short)(p->eidx[(size_t)tok0 * 128 + i] & idmask);
      }
      part[i] = 0.f;
    }
    __syncthreads();
    const int ntw = (cnt - wid + 3) >> 2;
    const int npair = ntw * 8;

    if (!(REP_MODE == 1 && gscale != 1.f)) {
      ExpBuf B0, B1;
      int c0 = 0, k0 = 0;
      if (npair > 0) {
        const int t0 = wid;
        exp_load(B0, ut, p->h8 + (size_t)(tok0 + t0) * D, ids + t0 * 128 + grp * 8, j8, true);
      }
      for (int pr = 0; pr < npair; ++pr) {
        const int t0 = wid + 4 * k0;
        exp_load(B1, ut + 128 * c0, p->h8 + (size_t)(tok0 + t0) * D + 128 * c0, ids + t0 * 128 + 64 + grp * 8, j8, true);
        exp_u_compute(B0, reinterpret_cast<int*>(part) + t0 * 128 + 8 * j8 + grp, j8);
        int c1 = c0, k1 = k0;
        if (pr + 1 < npair) {
          k1 = k0 + 1;
          if (k1 == ntw) {
            k1 = 0;
            c1 = c0 + 1;
          }
        }
        {
          const int t1 = wid + 4 * k1;
          exp_load(B0, ut + 128 * c1, p->h8 + (size_t)(tok0 + t1) * D + 128 * c1, ids + t1 * 128 + grp * 8, j8, true);
        }
        exp_u_compute(B1, reinterpret_cast<int*>(part) + t0 * 128 + 64 + 8 * j8 + grp, j8);
        c0 = c1;
        k0 = k1;
      }
    }
    __syncthreads();
    for (int t = wid; t < cnt; t += 4) {
      float wv2[2];
      float am = 0.f;
#pragma unroll
      for (int hh = 0; hh < 2; ++hh) {
        int k = lane + 64 * hh;
        int e = ids[t * 128 + hh * 64 + (lane & 7) * 8 + (lane >> 3)];
        float dq = (float)reinterpret_cast<int*>(part)[t * 128 + k] * p->su[(size_t)layer * NEXP + e] * p->sx[tok0 + t];
        float wv = p->gate[(size_t)(tok0 + t) * 128 + k] * gelu_tanh(dq) * p->sv[(size_t)layer * NEXP + e];
        wv2[hh] = wv;
        am = fmaxf(am, fabsf(wv));
      }
      am = fmaxf(wave_max(am), 1e-30f);
      float qs = 127.f / am;
#pragma unroll
      for (int hh = 0; hh < 2; ++hh) {
        int k = lane + 64 * hh;
        int q = (int)rintf(wv2[hh] * qs);
        w8[t * 128 + (k & 7) * 16 + hh * 8 + ((k >> 3) & 7)] = (unsigned char)(q & 255);
      }
      if (lane == 0) swl[t] = am * (1.f / 127.f);
    }
    __syncthreads();
    if (!(REP_MODE == 2 && gscale != 1.f)) {
      ExpBuf B0, B1;
      int acc[16];
#pragma unroll
      for (int k = 0; k < 16; ++k) acc[k] = 0;
      int c0 = 0, k0 = 0;
      if (npair > 0) {
        const int t0 = wid;
        exp_load(B0, vt, (const signed char*)nullptr, ids + t0 * 128 + grp * 8, j8, false);
      }
      for (int pr = 0; pr < npair; ++pr) {
        const int t0 = wid + 4 * k0;
        float4 xq[4], gq[4];
        float4* xo = reinterpret_cast<float4*>(p->xs + (size_t)(tok0 + t0) * D + 128 * c0 + 16 * j8);
        {
          const float4* gf = reinterpret_cast<const float4*>(p->mod + ((size_t)layer * 9 + tok_batch(tok0 + t0)) * 6144 + 5 * 1024 + 128 * c0 + 16 * j8);
#pragma unroll
          for (int i4 = 0; i4 < 4; ++i4) {
            xq[i4] = xo[i4];
            gq[i4] = gf[i4];
          }
        }
        exp_load(B1, vt + 128 * c0, (const signed char*)nullptr, ids + t0 * 128 + 64 + grp * 8, j8, false);
        const uint4 wq = *reinterpret_cast<const uint4*>(w8 + t0 * 128 + grp * 16);
        exp_v_accum(B0, wq.x, wq.y, acc);
        int c1 = c0, k1 = k0;
        if (pr + 1 < npair) {
          k1 = k0 + 1;
          if (k1 == ntw) {
            k1 = 0;
            c1 = c0 + 1;
          }
        }
        {
          const int t1 = wid + 4 * k1;
          exp_load(B0, vt + 128 * c1, (const signed char*)nullptr, ids + t1 * 128 + grp * 8, j8, false);
        }
        exp_v_accum(B1, wq.z, wq.w, acc);
        exp_v_finish(xo, xq, gq, acc, swl[t0], grp, gscale);
        c0 = c1;
        k0 = k1;
      }
    }
    asm volatile("s_waitcnt vmcnt(0)" ::: "memory");
    __syncthreads();
    if (gscale == 1.f) {
      for (int t = wid; t < cnt; t += 4) {
        if (layer + 1 < DEPTH) norm_row(p, layer + 1, 0, tok0 + t, lane);
        else if (tok0 + t < TL) norm_row(p, 0, 2, tok0 + t, lane);
      }
    }
    __syncthreads();
  }
}

#define XB_TMO 128
#define XB_XCNT(j) (256 + 64 * (j))
#define XB_XSUB(j) (1280 + 64 * (j))
#define XB_XGEN(j) (2304 + 64 * (j))
#define XB_TOP 3328
#define XB_TOPGEN 3392
#define XCD_BAR_WORDS 3456
#define XB_SPIN_CAP (1u << 22)
#define LAS __attribute__((address_space(3)))
DEVI unsigned xb_ld(unsigned* p) { return __hip_atomic_load(p, __ATOMIC_RELAXED, __HIP_MEMORY_SCOPE_AGENT); }
DEVI unsigned xb_add(unsigned* p, unsigned v) { return __hip_atomic_fetch_add(p, v, __ATOMIC_RELAXED, __HIP_MEMORY_SCOPE_AGENT); }
DEVI unsigned xb_xcc_id() { return (unsigned)__builtin_amdgcn_s_getreg((3 << 11) | 20) & 0xFu; }
#define XB_SPIN(cond, bar)                                   \
  do {                                                       \
    unsigned _sp = 0;                                        \
    while (cond) {                                           \
      __builtin_amdgcn_s_sleep(1);                           \
      if ((++_sp & 255u) == 0u) {                            \
        if (xb_ld(&(bar)[XB_TMO])) break;                    \
        if (_sp > XB_SPIN_CAP) {                             \
          atomicAdd(&(bar)[XB_TMO], 1u);                     \
          break;                                             \
        }                                                    \
      }                                                      \
    }                                                        \
  } while (0)
struct XcdBarrier {
  unsigned* bar;
  unsigned x;
  volatile LAS unsigned* st;
};
DEVI XcdBarrier xcd_barrier_post(unsigned* bar, volatile LAS unsigned* st) {
  XcdBarrier b;
  b.bar = bar;
  b.x = xb_xcc_id();
  b.st = st;
  if (threadIdx.x == 0) (void)xb_add(&bar[XB_XCNT(b.x)], 1u);
  return b;
}
DEVI void xcd_barrier_complete(unsigned* bar, unsigned x, unsigned& nloc, unsigned& nx) {
  const unsigned G = gridDim.x * gridDim.y * gridDim.z;
  unsigned sum, cnt, mine, sp = 0u;
  for (;;) {
    sum = 0u;
    cnt = 0u;
    mine = 0u;
#pragma unroll
    for (unsigned j = 0; j < 16; ++j) {
      const unsigned c = xb_ld(&bar[XB_XCNT(j)]);
      sum += c;
      cnt += (c > 0u) ? 1u : 0u;
      mine = (j == x) ? c : mine;
    }
    if (sum == G) break;
    __builtin_amdgcn_s_sleep(1);
    if ((++sp & 255u) == 0u) {
      if (xb_ld(&bar[XB_TMO])) break;
      if (sp > XB_SPIN_CAP) {
        atomicAdd(&bar[XB_TMO], 1u);
        break;
      }
    }
  }
  nloc = mine > 0u ? mine : 1u;
  nx = cnt > 0u ? cnt : 1u;
}
DEVI void xcd_barrier(const XcdBarrier& b) {
  asm volatile("s_waitcnt vmcnt(0)" ::: "memory");
  __syncthreads();
  if (threadIdx.x == 0) {
    unsigned* bar = b.bar;
    __builtin_amdgcn_s_waitcnt(0);
    unsigned nloc = b.st[0], nx = b.st[1];
    if (nloc == 0u) {
      xcd_barrier_complete(bar, b.x, nloc, nx);
      b.st[0] = nloc;
      b.st[1] = nx;
    }
    const unsigned old = xb_add(&bar[XB_XSUB(b.x)], 1u);
    const unsigned gen = old / nloc;
    if (old + 1u == (gen + 1u) * nloc) {
      __builtin_amdgcn_fence(__ATOMIC_RELEASE, "agent");
      asm volatile("s_waitcnt vmcnt(0)" ::: "memory");
      const unsigned og = xb_add(&bar[XB_TOP], 1u);
      const unsigned tg = og / nx;
      if (og + 1u == (tg + 1u) * nx) xb_add(&bar[XB_TOPGEN], 1u);
      else XB_SPIN(xb_ld(&bar[XB_TOPGEN]) == tg, bar);
      __builtin_amdgcn_fence(__ATOMIC_ACQUIRE, "agent");
      xb_add(&bar[XB_XGEN(b.x)], 1u);
      asm volatile("s_waitcnt vmcnt(0)" ::: "memory");
    } else {
      XB_SPIN(xb_ld(&bar[XB_XGEN(b.x)]) == gen, bar);
      __builtin_amdgcn_fence(__ATOMIC_ACQUIRE, "agent");
      asm volatile("s_waitcnt vmcnt(0)" ::: "memory");
    }
  }
  __syncthreads();
}

DEVI bool step_active(int step) {
  if (step == 0) return true;
  if (step == NSTEPS - 1) return false;
  int layer = (step - 1) / STEPS_PER_LAYER, ph = (step - 1) % STEPS_PER_LAYER;
  if (ph == 3 && (layer & 1)) return false;
  if (ph == 0 && layer > 0) return false;
  return true;
}

DEVI void run_step(PP p, int step, unsigned char* lds, unsigned char* lds_all, float gscale = 1.f) {
  if (step == 0) {
    phase_prep(p, lds);
    return;
  }
  if (step == NSTEPS - 1) {
    phase_norm(p, 0, 2, TL);
    return;
  }
  int layer = (step - 1) / STEPS_PER_LAYER, ph = (step - 1) % STEPS_PER_LAYER;
  bool even = (layer & 1) == 0;
  int j = layer >> 1;
  bool upd_ctx = layer < 2;
  bool need_ctx = layer < 3;
  int nt_in = need_ctx ? TT : TL;
  int nt = upd_ctx ? TT : TL;
  switch (ph) {
    case 0: phase_norm(p, layer, 0, nt_in); break;
    case 1:
      if (even)
        gemm8_phase<EPI_INPROJ>(p, p->h, D, p->wt_in_ab + (size_t)j * 1280 * D, D, nt_in / 256, 5, D, layer, lds_all);
      else
        gemm8_phase<EPI_GELU>(p, p->h, D, p->wt_in_gs + (size_t)j * 2048 * D, D, nt / 256, 8, D, layer, lds_all);
      break;
    case 2:
      if (even) {
        phase_fft_a(p, lds);
        if (upd_ctx) phase_dft_ctx(p, lds);
        phase_attn(p, layer, upd_ctx, lds);
      } else {
        phase_sgu(p, j, nt / 128, lds);
      }
      break;
    case 3:
      if (even) phase_fft_b(p, lds);
      break;
    case 4:
      if (even)
      {
        if (gscale != 1.f) gemm_phase<EPI_RESID>(p, p->mix, LDMIX, p->wt_out_ab + (size_t)j * D * LDMIX, LDMIX, nt / 128, 8, LDMIX, layer, lds, gscale);
        else if (layer == 0) gemm8_phase<EPI_RESID0>(p, p->mix, LDMIX, p->wt_out_ab + (size_t)j * D * LDMIX, LDMIX, nt / 256, 4, LDMIX, layer, lds_all);
        else gemm8_phase<EPI_RESID>(p, p->mix, LDMIX, p->wt_out_ab + (size_t)j * D * LDMIX, LDMIX, nt / 256, 4, LDMIX, layer, lds_all);
      }
      else
      {
        if (gscale != 1.f) gemm_phase<EPI_RESID>(p, p->mix, LDMIX, p->wt_out_gs + (size_t)j * D * D, D, nt / 128, 8, D, layer, lds, gscale);
        else gemm8_phase<EPI_RESID>(p, p->mix, LDMIX, p->wt_out_gs + (size_t)j * D * D, D, nt / 256, 4, D, layer, lds_all);
      }
      break;
    case 5: phase_norm(p, layer, 1, nt); break;
    case 6: gemm8_phase<EPI_STORE>(p, p->h, D, p->wt_q + (size_t)layer * 2048 * D, D, nt / 256, 8, D, layer, lds_all); break;
    case 7: phase_route(p, layer, nt, lds); break;
    case 8: phase_expert(p, layer, nt, lds, gscale, (gscale == 1.f) ? 0xffff : REP_IDMASK); break;
  }
}

__global__ void __launch_bounds__(PHYS_THREADS, 2) mega(Params p_unused, int step_lo, int step_hi) {
  unsigned char* lds_all = g_lds;
  if ((threadIdx.x & 63) == 0) *reinterpret_cast<volatile int*>(g_lds + LDS_BYTES - 16 - 256 + 4 * hw_slot()) = (int)(threadIdx.x >> 6);
  __syncthreads();
  unsigned char* lds = lds_all + (wave_index() >> 2) * LDS_HALF;
  PP pp = (PP)__builtin_amdgcn_kernarg_segment_ptr();
  volatile LAS unsigned* st = (volatile LAS unsigned*)(lds_all + LDS_BYTES - 16);
  if (threadIdx.x == 0) {
    st[0] = 0u;
    st[1] = 0u;
  }
  __syncthreads();
  XcdBarrier xb = xcd_barrier_post(pp->bar, st);
  int nsync = 0;
  bool first = true;
  for (int s = step_lo; s < step_hi; ++s) {
    if (!step_active(s)) continue;
    if (!first) {
      if (nsync == 0) cg::this_grid().sync();
      else xcd_barrier(xb);
      ++nsync;
    }
    first = false;
    PP q = pp;
    asm volatile("" : "+s"(q));
    run_step(q, s, lds, lds_all);
#if REP_MASK
    if (s == 0 && ((REP_MASK >> 15) & 1)) {
      xcd_barrier(xb);
      PP q2 = pp;
      asm volatile("" : "+s"(q2));
      run_step(q2, 0, lds, lds_all);
    }
    if (s > 0 && s < NSTEPS - 1) {
      int lay_ = (s - 1) / STEPS_PER_LAYER, ph_ = (s - 1) % STEPS_PER_LAYER;
      bool rep_ = (REP_MASK >> ph_) & 1;
      if (ph_ == 2 && ((REP_MASK >> 9) & 1) && !(lay_ & 1)) rep_ = true;
      if (ph_ == 2 && ((REP_MASK >> 10) & 1) && (lay_ & 1)) rep_ = true;
      if (rep_) {
        xcd_barrier(xb);
        PP q2 = pp;
        asm volatile("" : "+s"(q2));
        float z = 0.f;
        asm volatile("" : "+s"(z));
        run_step(q2, s, lds, lds_all, z);
      }
      if (ph_ == 2 && ((REP_MASK >> 11) & 1) && !(lay_ & 1)) {
        xcd_barrier(xb);
        PP q2 = pp;
        asm volatile("" : "+s"(q2));
        phase_attn(q2, lay_, lay_ < 2, lds);
      }
    }
#endif
  }
}

static size_t align_up(size_t v) { return (v + 255) & ~(size_t)255; }

extern "C" void kernel_launch(void* const* d_in, const int* in_sizes, int n_in, void* d_out, int out_size, void* d_ws,
                              size_t ws_size, hipStream_t stream) {
  Params p{};
  p.x = (const float*)d_in[0];
  p.c = (const float*)d_in[1];
  p.ctx = (const float*)d_in[2];
  p.c_ctx = (const float*)d_in[3];
  p.ada_w = (const float*)d_in[4];
  p.ada_b = (const float*)d_in[5];
  p.norm_mix_w = (const float*)d_in[6];
  p.norm_ffn_w = (const float*)d_in[7];
  p.ab_w_in = (const float*)d_in[8];
  p.ab_w_out = (const float*)d_in[9];
  p.attn_sink = (const float*)d_in[10];
  p.gs_w_in = (const float*)d_in[11];
  p.gs_norm_w = (const float*)d_in[12];
  p.gs_w_s = (const float*)d_in[13];
  p.gs_b_s = (const float*)d_in[14];
  p.gs_w_out = (const float*)d_in[15];
  p.peer_w_q = (const float*)d_in[16];
  p.peer_keys = (const float*)d_in[17];
  p.peer_u = (const float*)d_in[18];
  p.peer_v = (const float*)d_in[19];
  p.norm_out_w = (const float*)d_in[20];
  p.out = (float*)d_out;
  unsigned char* w = (unsigned char*)d_ws;
  size_t off = 0;
  auto take = [&](size_t bytes) {
    unsigned char* r = w + off;
    off = align_up(off + bytes);
    return r;
  };
  p.bar = (unsigned*)take((size_t)XCD_BAR_WORDS * 4);
  p.mod = (float*)take((size_t)DEPTH * 9 * 6144 * 4);
  p.cs = (float2*)take(64 * 16 * 8);
  p.xs = (float*)take((size_t)TT * D * 4);
  p.h = (bf16_t*)take((size_t)TT * D * 2);
  p.P = (bf16_t*)take((size_t)TT * 2048 * 2);
  p.kbuf = (bf16_t*)take((size_t)NB * 2 * KVLEN * 64 * 2);
  p.vbuf = (bf16_t*)take((size_t)NB * 2 * KVLEN * 64 * 2);
  p.zvT = (bf16_t*)take((size_t)TT * 1024 * 2);
  p.rowss = (float*)take((size_t)(TT / 128) * 32 * 128 * 4);
  p.mix = (bf16_t*)take((size_t)TT * LDMIX * 2);
  p.fa = (bf16_t*)take((size_t)TL * 1024 * 2);
  p.tops = (float*)take((size_t)TT * 256 * 4);
  p.eidx = (int*)take((size_t)TT * 128 * 4);
  p.gate = (float*)take((size_t)TT * 128 * 4);
  p.wt_in_ab = (bf16_t*)take((size_t)2 * 1280 * D * 2);
  p.wt_out_ab = (bf16_t*)take((size_t)2 * D * LDMIX * 2);
  p.wt_in_gs = (bf16_t*)take((size_t)2 * 2048 * D * 2);
  p.wt_out_gs = (bf16_t*)take((size_t)2 * D * D * 2);
  p.wt_q = (bf16_t*)take((size_t)DEPTH * 2048 * D * 2);
  p.keysb = (bf16_t*)take((size_t)DEPTH * 8 * 2 * 128 * 128 * 2);
  p.su = (float*)take((size_t)DEPTH * NEXP * 4);
  p.sv = (float*)take((size_t)DEPTH * NEXP * 4);
  p.h8 = (signed char*)take((size_t)TT * D);
  p.sx = (float*)take((size_t)TT * 4);
  p.utab = (unsigned char*)take((size_t)DEPTH * NEXP * D);
  p.vtab = (unsigned char*)take((size_t)DEPTH * NEXP * D);
  if (off > ws_size) {
    fprintf(stderr, "workspace too small: need %zu have %zu\n", off, ws_size);
    return;
  }
  hipMemsetAsync(p.bar, 0, (size_t)XCD_BAR_WORDS * 4, stream);
  static int grid_blocks = 0;
  if (!grid_blocks) {
    int dev = 0, cus = 0, per_cu = 0;
    hipGetDevice(&dev);
    hipDeviceGetAttribute(&cus, hipDeviceAttributeMultiprocessorCount, dev);
    hipOccupancyMaxActiveBlocksPerMultiprocessor(&per_cu, mega, PHYS_THREADS, 0);
    if (per_cu > 1) per_cu = 1;
    if (per_cu < 1) per_cu = 1;
    grid_blocks = cus * per_cu;
  }
#if ONE_LAUNCH
  int lo = 0, hi = NSTEPS;
  void* args[] = {&p, &lo, &hi};
  hipError_t e = hipLaunchCooperativeKernel((void*)mega, dim3(grid_blocks), dim3(PHYS_THREADS), args, 0, stream);
  if (e != hipSuccess) fprintf(stderr, "cooperative launch failed: %s (grid %d)\n", hipGetErrorString(e), grid_blocks);
#else
  for (int s = 0; s < NSTEPS; ++s) {
    if (s != 0 && s != NSTEPS - 1) {
      int layer = (s - 1) / STEPS_PER_LAYER, ph = (s - 1) % STEPS_PER_LAYER;
      if (ph == 3 && (layer & 1)) continue;
    }
    hipLaunchKernelGGL(mega, dim3(grid_blocks), dim3(NTHREADS), 0, stream, p, s, s + 1);
  }
#endif
}
```

```cpp
#include <hip/hip_runtime.h>
#include <hip/hip_bf16.h>
#include <hip/hip_cooperative_groups.h>
#include <cstdio>
namespace cg = cooperative_groups;

#ifndef REP_MASK
#define REP_MASK 0
#endif
#ifndef REP_MODE
#define REP_MODE 0
#endif
#ifndef REP_IDMASK
#define REP_IDMASK 0xffff
#endif
#ifndef ONE_LAUNCH
#define ONE_LAUNCH 1
#endif

#define DEVI __device__ __forceinline__
typedef unsigned short bf16_t;
using bf16x8 = __attribute__((ext_vector_type(8))) short;
using f32x4 = __attribute__((ext_vector_type(4))) float;
using f32x16 = __attribute__((ext_vector_type(16))) float;

constexpr int D = 1024, NB = 8, SEQ = 4096, CTX = 256, DEPTH = 4;
constexpr int TL = NB * SEQ, TC = NB * CTX, TT = TL + TC;
constexpr int KVLEN = CTX + SEQ;
constexpr int NEXP = 16384;
constexpr int LDMIX = 1536;
constexpr float USCALE = 64.f, VSCALE = 8.f;
constexpr int TPB = 68;
constexpr int LDS_HALF = 68 * 1024;
constexpr int LDS_BYTES = 2 * LDS_HALF;
constexpr int PHYS_THREADS = 512;
constexpr int NTHREADS = 256;
constexpr int STEPS_PER_LAYER = 9;
constexpr int NSTEPS = 1 + DEPTH * STEPS_PER_LAYER + 1;

struct Params {
  const float *x, *c, *ctx, *c_ctx, *ada_w, *ada_b, *norm_mix_w, *norm_ffn_w, *ab_w_in, *ab_w_out, *attn_sink,
      *gs_w_in, *gs_norm_w, *gs_w_s, *gs_b_s, *gs_w_out, *peer_w_q, *peer_keys, *peer_u, *peer_v, *norm_out_w;
  float* out;
  float* mod;
  float2* cs;
  float* xs;
  bf16_t* h;
  bf16_t* P;
  bf16_t* kbuf;
  bf16_t* vbuf;
  float* rowss;
  bf16_t* zvT;
  bf16_t* mix;
  bf16_t* fa;
  unsigned* bar;
  float* tops;
  int* eidx;
  float* gate;
  bf16_t *wt_in_ab, *wt_out_ab, *wt_in_gs, *wt_out_gs, *wt_q, *keysb;
  unsigned char *utab, *vtab;
  float* su;
  float* sv;
  signed char* h8;
  float* sx;
};

typedef const __attribute__((address_space(4))) Params* PP;

__shared__ __attribute__((aligned(16))) unsigned char g_lds[LDS_BYTES];
DEVI int hw_slot() {
  int h = (int)(__builtin_amdgcn_s_getreg((6 - 1) << 11 | 0 << 6 | 4) & 63u);
  asm volatile("" : "+s"(h));
  return h;
}
DEVI int wave_index() {
  int w = *reinterpret_cast<volatile int*>(g_lds + LDS_BYTES - 16 - 256 + 4 * hw_slot());
  return __builtin_amdgcn_readfirstlane(w);
}
DEVI int lane_id() { return (int)__builtin_amdgcn_mbcnt_hi(~0u, __builtin_amdgcn_mbcnt_lo(~0u, 0u)); }
DEVI int ltid() { int t = ((wave_index() & 3) << 6) | lane_id(); asm volatile("" : "+v"(t)); return t; }
DEVI int lbid() { int t = 2 * blockIdx.x + (wave_index() >> 2); asm volatile("" : "+s"(t)); return t; }
DEVI int lnblk() { int t = 2 * gridDim.x; asm volatile("" : "+s"(t)); return t; }
DEVI int ptid() { int t = (wave_index() << 6) | lane_id(); asm volatile("" : "+v"(t)); return t; }
DEVI int pbid() { int t = blockIdx.x; asm volatile("" : "+s"(t)); return t; }
DEVI int pnblk() { int t = gridDim.x; asm volatile("" : "+s"(t)); return t; }

typedef __bf16 bf2v_t __attribute__((ext_vector_type(2)));
typedef float f2v_t __attribute__((ext_vector_type(2)));
DEVI bf16_t f2bf(float f) { return __builtin_bit_cast(unsigned short, (__bf16)f); }
DEVI float bf2f(bf16_t h) { return __uint_as_float(((unsigned)h) << 16); }
DEVI float bflo(unsigned u) { return __uint_as_float(u << 16); }
DEVI float bfhi(unsigned u) { return __uint_as_float(u & 0xffff0000u); }
DEVI unsigned pack2(float a, float b) {
  f2v_t v = {a, b};
  return __builtin_bit_cast(unsigned, __builtin_convertvector(v, bf2v_t));
}
DEVI float gelu_tanh(float x) {
  float u = 0.7978845608028654f * (x + 0.044715f * x * x * x);
  return 0.5f * x * (1.f + tanhf(u));
}
template <int CTRL>
DEVI float dpp_mov(float v) {
  return __builtin_bit_cast(float, __builtin_amdgcn_mov_dpp(__builtin_bit_cast(int, v), CTRL, 0xF, 0xF, true));
}
DEVI int shx_i(int v, int m) { return __builtin_amdgcn_ds_bpermute((lane_id() ^ m) << 2, v); }
DEVI float shx_f(float v, int m) { return __builtin_bit_cast(float, shx_i(__builtin_bit_cast(int, v), m)); }
DEVI float wave_sum(float v) {
  v += dpp_mov<0xB1>(v);
  v += dpp_mov<0x4E>(v);
  v += dpp_mov<0x141>(v);
  v += dpp_mov<0x140>(v);
  v += shx_f(v, 16);
  v += shx_f(v, 32);
  return v;
}
DEVI float wave_max(float v) {
  v = fmaxf(v, dpp_mov<0xB1>(v));
  v = fmaxf(v, dpp_mov<0x4E>(v));
  v = fmaxf(v, dpp_mov<0x141>(v));
  v = fmaxf(v, dpp_mov<0x140>(v));
  v = fmaxf(v, shx_f(v, 16));
  v = fmaxf(v, shx_f(v, 32));
  return v;
}
DEVI int tok_batch(int r) { return r < TL ? (r >> 12) : 8; }

DEVI void prep_transpose_tile(const float* __restrict__ src, int N, bf16_t* __restrict__ dst, int ldk, int tk, int tn, float* tile, int tid) {
#pragma unroll
  for (int i = 0; i < 16; ++i) {
    int r = (tid >> 6) + 4 * i;
    tile[r * 65 + (tid & 63)] = src[(size_t)(tk * 64 + r) * N + tn * 64 + (tid & 63)];
  }
  __syncthreads();
#pragma unroll
  for (int i = 0; i < 16; ++i) {
    int n = (tid >> 6) + 4 * i, k = tid & 63;
    dst[(size_t)(tn * 64 + n) * ldk + tk * 64 + k] = f2bf(tile[k * 65 + n]);
  }
}

constexpr int PU_ADA = DEPTH * 96;
constexpr int PU_T_ABIN = 2 * 16 * 20;
constexpr int PU_T_GSIN = 2 * 16 * 32;
constexpr int PU_T_GSOUT = 2 * 16 * 16;
constexpr int PU_T_ABOUT = 2 * 8 * 16;
constexpr int PU_T_Q = DEPTH * 16 * 32;
constexpr int PU_FOLD = 2 * 4 * 16 * 2;
constexpr int PU_CONV = DEPTH * NEXP * D / 4 / 2048;
constexpr int PU_KEYS = DEPTH * 8 * 2 * 128 * 128 / 4 / 2048;
constexpr int PU_UROWS = DEPTH * NEXP / 32;
constexpr int PU_TOTAL = PU_ADA + PU_T_ABIN + PU_T_GSIN + PU_T_GSOUT + PU_T_ABOUT + PU_T_Q + PU_FOLD + 2 * PU_UROWS + PU_KEYS + 1;

DEVI void phase_prep(PP p, unsigned char* lds) {
  const int tid = ltid();
  float* fl = reinterpret_cast<float*>(lds);
  for (int u0 = lbid(); u0 < PU_TOTAL; u0 += lnblk()) {
    int u = u0;
    if (u < PU_ADA) {
      float* sl = fl;
      for (int i = tid; i < 9 * 1024; i += NTHREADS) {
        int r = i >> 10, k = i & 1023;
        float v = (r < 8) ? p->c[r * 1024 + k] : p->c_ctx[k];
        sl[i] = v / (1.f + __expf(-v));
      }
      __syncthreads();
      float* red = sl + 9 * 1024;
      int ks = tid >> 6, col = tid & 63;
      int layer = u / 96, c0 = (u % 96) * 64;
      const float* w = p->ada_w + (size_t)layer * D * 6144 + c0 + col;
      float acc[9];
#pragma unroll
      for (int r = 0; r < 9; ++r) acc[r] = 0.f;
      for (int k0 = ks * 256; k0 < ks * 256 + 256; k0 += 16) {
        float wv[16];
#pragma unroll
        for (int kk = 0; kk < 16; ++kk) wv[kk] = w[(size_t)(k0 + kk) * 6144];
#pragma unroll
        for (int kk = 0; kk < 16; ++kk)
#pragma unroll
          for (int r = 0; r < 9; ++r) acc[r] += sl[r * 1024 + k0 + kk] * wv[kk];
      }
#pragma unroll
      for (int r = 0; r < 9; ++r) red[(ks * 9 + r) * 64 + col] = acc[r];
      __syncthreads();
      for (int i = tid; i < 9 * 64; i += NTHREADS) {
        int r = i >> 6, cc = i & 63;
        float sm = red[(0 * 9 + r) * 64 + cc] + red[(1 * 9 + r) * 64 + cc] + red[(2 * 9 + r) * 64 + cc] + red[(3 * 9 + r) * 64 + cc];
        sm += p->ada_b[(size_t)layer * 6144 + c0 + cc];
        p->mod[((size_t)layer * 9 + r) * 6144 + c0 + cc] = sm;
      }
      __syncthreads();
      continue;
    }
    u -= PU_ADA;
    if (u < PU_T_ABIN) {
      int j = u / 320, t = u % 320;
      prep_transpose_tile(p->ab_w_in + (size_t)j * D * 1280, 1280, p->wt_in_ab + (size_t)j * 1280 * D, D, t / 20, t % 20, fl, tid);
      __syncthreads();
      continue;
    }
    u -= PU_T_ABIN;
    if (u < PU_T_GSIN) {
      int j = u / 512, t = u % 512;
      prep_transpose_tile(p->gs_w_in + (size_t)j * D * 2048, 2048, p->wt_in_gs + (size_t)j * 2048 * D, D, t / 32, t % 32, fl, tid);
      __syncthreads();
      continue;
    }
    u -= PU_T_GSIN;
    if (u < PU_T_GSOUT) {
      int j = u / 256, t = u % 256;
      prep_transpose_tile(p->gs_w_out + (size_t)j * D * D, D, p->wt_out_gs + (size_t)j * D * D, D, t / 16, t % 16, fl, tid);
      __syncthreads();
      continue;
    }
    u -= PU_T_GSOUT;
    if (u < PU_T_ABOUT) {
      int j = u / 128, t = u % 128;
      prep_transpose_tile(p->ab_w_out + (size_t)j * D * D, D, p->wt_out_ab + (size_t)j * D * LDMIX, LDMIX, t / 16, t % 16, fl, tid);
      __syncthreads();
      continue;
    }
    u -= PU_T_ABOUT;
    if (u < PU_T_Q) {
      int i = u / 512, t = u % 512;
      prep_transpose_tile(p->peer_w_q + (size_t)i * D * 2048, 2048, p->wt_q + (size_t)i * 2048 * D, D, t / 32, t % 32, fl, tid);
      __syncthreads();
      continue;
    }
    u -= PU_T_Q;
    if (u < PU_FOLD) {
      const int mh = u & 1, nc = (u >> 1) & 15, g = (u >> 5) & 3, j = u >> 7;
      float2* tw = reinterpret_cast<float2*>(lds);
      float* wt = reinterpret_cast<float*>(lds + 1024);
      if (tid < 128) {
        float sn, cn;
        sincospif((float)tid / 64.f, &sn, &cn);
        tw[tid] = make_float2(cn, sn);
      }
      {
        const float* wsrc = p->ab_w_out + (size_t)j * D * D + (size_t)(512 + g * 128) * D + nc * 64;
#pragma unroll 8
        for (int i = 0; i < 32; ++i) {
          int l = (tid >> 6) + 4 * i;
          wt[l * 64 + (tid & 63)] = wsrc[(size_t)l * D + (tid & 63)];
        }
      }
      __syncthreads();
      const int n = tid & 63, mq = __builtin_amdgcn_readfirstlane(tid >> 6);
      bf16_t* dst = p->wt_out_ab + (size_t)j * D * LDMIX + (size_t)(nc * 64 + n) * LDMIX + g * 128;
#pragma unroll 1
      for (int mi = 0; mi < 16; ++mi) {
        const int m = mh * 64 + mq * 16 + mi;
        float ar = 0.f, ai = 0.f;
#pragma unroll 16
        for (int l = 0; l < 128; ++l) {
          float2 t = tw[(m * l) & 127];
          float wv = wt[l * 64 + n];
          ar += t.x * wv;
          ai += t.y * wv;
        }
        dst[512 + m] = f2bf(ar);
        dst[1024 + m] = f2bf(ai);
      }
      __syncthreads();
      continue;
    }
    u -= PU_FOLD;
    if (u < 2 * PU_UROWS) {
      const bool isv = u >= PU_UROWS;
      if (isv) u -= PU_UROWS;
      const float* src = isv ? p->peer_v : p->peer_u;
      unsigned char* dst = isv ? p->vtab : p->utab;
      float* sdst = isv ? p->sv : p->su;
      const int lane = tid & 63, wv = tid >> 6;
#pragma unroll 1
      for (int rr = 0; rr < 8; rr += 4) {
        size_t row0 = (size_t)u * 32 + wv * 8 + rr;
        float4 v[4][4];
#pragma unroll
        for (int k = 0; k < 4; ++k)
#pragma unroll
          for (int i = 0; i < 4; ++i) v[k][i] = reinterpret_cast<const float4*>(src + (row0 + k) * D)[lane * 4 + i];
#pragma unroll
        for (int k = 0; k < 4; ++k) {
          float am = 0.f;
#pragma unroll
          for (int i = 0; i < 4; ++i)
            am = fmaxf(am, fmaxf(fmaxf(fabsf(v[k][i].x), fabsf(v[k][i].y)), fmaxf(fabsf(v[k][i].z), fabsf(v[k][i].w))));
          am = wave_max(am);
          am = fmaxf(am, 1e-30f);
          float qs = 127.f / am;
          uint4 o;
          unsigned* op = reinterpret_cast<unsigned*>(&o);
#pragma unroll
          for (int i = 0; i < 4; ++i) {
            int q0 = (int)rintf(v[k][i].x * qs), q1 = (int)rintf(v[k][i].y * qs), q2 = (int)rintf(v[k][i].z * qs), q3 = (int)rintf(v[k][i].w * qs);
            op[i] = (unsigned)(q0 & 255) | ((unsigned)(q1 & 255) << 8) | ((unsigned)(q2 & 255) << 16) | ((unsigned)(q3 & 255) << 24);
          }
          reinterpret_cast<uint4*>(dst + (row0 + k) * D)[lane] = o;
          if (lane == 0) sdst[row0 + k] = am * (1.f / 127.f);
        }
      }
      continue;
    }
    u -= 2 * PU_UROWS;
    if (u < PU_KEYS) {
      const float4* s4 = reinterpret_cast<const float4*>(p->peer_keys) + (size_t)u * 2048 + tid;
      uint2* d2 = reinterpret_cast<uint2*>(p->keysb) + (size_t)u * 2048 + tid;
#pragma unroll
      for (int k = 0; k < 8; ++k) {
        float4 v = s4[k * 256];
        uint2 o;
        o.x = pack2(v.x, v.y);
        o.y = pack2(v.z, v.w);
        d2[k * 256] = o;
      }
      continue;
    }
    for (int i = tid; i < 64 * 16; i += NTHREADS) {
      int pos = i >> 4, k = i & 15;
      float inv = powf(10000.f, -(float)k / 16.f);
      float ang = (float)pos * inv;
      float sn, cn;
      sincosf(ang, &sn, &cn);
      p->cs[i] = make_float2(cn, sn);
    }
  }
}

DEVI void norm_row(PP p, int layer, int which, int tok, int lane) {
  const float* w = which == 0 ? p->norm_mix_w + layer * D : (which == 1 ? p->norm_ffn_w + layer * D : p->norm_out_w);
  const float* xsrc = p->xs + (size_t)tok * D;
  if (which == 0 && layer == 0) xsrc = (tok < TL) ? p->x + (size_t)tok * D : p->ctx + (size_t)(tok - TL) * D;
  const float4* xr = reinterpret_cast<const float4*>(xsrc);
  float4 v[4];
  float ss = 0.f;
#pragma unroll
  for (int i = 0; i < 4; ++i) {
    v[i] = xr[lane + 64 * i];
    ss += v[i].x * v[i].x + v[i].y * v[i].y + v[i].z * v[i].z + v[i].w * v[i].w;
  }
  ss = wave_sum(ss);
  float rstd = rsqrtf(ss * (1.f / 1024.f) + 1e-6f);
  if (which == 2) {
    float4* o = reinterpret_cast<float4*>(p->out + (size_t)tok * D);
#pragma unroll
    for (int i = 0; i < 4; ++i) {
      float4 wv = reinterpret_cast<const float4*>(w)[lane + 64 * i];
      float4 r;
      r.x = v[i].x * rstd * wv.x;
      r.y = v[i].y * rstd * wv.y;
      r.z = v[i].z * rstd * wv.z;
      r.w = v[i].w * rstd * wv.w;
      o[lane + 64 * i] = r;
    }
  } else {
    int b = tok_batch(tok);
    const float* mb = p->mod + ((size_t)layer * 9 + b) * 6144 + (which == 0 ? 0 : 3072);
    uint2* o = reinterpret_cast<uint2*>(p->h + (size_t)tok * D);
    float av[4][4];
    float am = 0.f;
#pragma unroll
    for (int i = 0; i < 4; ++i) {
      float4 wv = reinterpret_cast<const float4*>(w)[lane + 64 * i];
      float4 sh = reinterpret_cast<const float4*>(mb)[lane + 64 * i];
      float4 sc = reinterpret_cast<const float4*>(mb + 1024)[lane + 64 * i];
      float a0 = v[i].x * rstd * wv.x * (1.f + sc.x) + sh.x;
      float a1 = v[i].y * rstd * wv.y * (1.f + sc.y) + sh.y;
      float a2 = v[i].z * rstd * wv.z * (1.f + sc.z) + sh.z;
      float a3 = v[i].w * rstd * wv.w * (1.f + sc.w) + sh.w;
      uint2 r;
      r.x = pack2(a0, a1);
      r.y = pack2(a2, a3);
      o[lane + 64 * i] = r;
      av[i][0] = a0; av[i][1] = a1; av[i][2] = a2; av[i][3] = a3;
      am = fmaxf(am, fmaxf(fmaxf(fabsf(a0), fabsf(a1)), fmaxf(fabsf(a2), fabsf(a3))));
    }
    if (which == 1) {
      am = fmaxf(wave_max(am), 1e-30f);
      float qs = 127.f / am;
      unsigned* o8 = reinterpret_cast<unsigned*>(p->h8 + (size_t)tok * D);
#pragma unroll
      for (int i = 0; i < 4; ++i) {
        int q0 = (int)rintf(av[i][0] * qs), q1 = (int)rintf(av[i][1] * qs), q2 = (int)rintf(av[i][2] * qs), q3 = (int)rintf(av[i][3] * qs);
        o8[lane + 64 * i] = (unsigned)(q0 & 255) | ((unsigned)(q1 & 255) << 8) | ((unsigned)(q2 & 255) << 16) | ((unsigned)(q3 & 255) << 24);
      }
      if (lane == 0) p->sx[tok] = am * (1.f / 127.f);
    }
  }
}

DEVI void phase_norm(PP p, int layer, int which, int ntok) {
  int lane = ltid() & 63;
  int gw = lbid() * 4 + __builtin_amdgcn_readfirstlane(ltid() >> 6), nw = lnblk() * 4;
  for (int tok = gw; tok < ntok; tok += nw) norm_row(p, layer, which, tok, lane);
}

enum { EPI_STORE = 0, EPI_GELU = 1, EPI_RESID = 2, EPI_INPROJ = 3, EPI_RESID0 = 4 };

template <int EPI>
DEVI void gemm_phase(PP p, const bf16_t* __restrict__ A, int lda, const bf16_t* __restrict__ Bt, int ldb,
                     int Mtiles, int Ntiles, int K, int layer, unsigned char* lds, float gscale = 1.f, int big_t0 = -1, int big_n = 0,
                     int big_ntn = 1) {
  const int tid = ltid();
  const int wid = __builtin_amdgcn_readfirstlane(tid >> 6), lane = tid & 63, wr = wid >> 1, wc = wid & 1, fr = lane & 15, fq = lane >> 4;
  int nblk = lnblk();
  int bid = lbid();
  int lb = bid;
  {
    const int pn = nblk >> 1, pb = bid >> 1;
    if ((pn & 7) == 0) lb = 2 * ((pb & 7) * (pn >> 3) + (pb >> 3)) + (bid & 1);
  }
  int ntiles = (big_t0 >= 0) ? 4 * big_n : Mtiles * Ntiles;
  const int nk = K / 64;
  const int srow = tid >> 3;
  const int scol = ((tid & 7) ^ ((tid >> 3) & 7)) * 8;
#define GEMM_STAGE(ga_, gb_, kt_, buf_)                                                                               \
  {                                                                                                                   \
    _Pragma("unroll") for (int i_ = 0; i_ < 4; ++i_) {                                                                \
      __builtin_amdgcn_global_load_lds((const unsigned*)((ga_) + (size_t)(32 * i_) * lda + (kt_) * 64),               \
                                       (__attribute__((address_space(3))) unsigned*)(lds + (buf_) * 32768 + tid * 16 + i_ * 4096), 16, 0, 0); \
      __builtin_amdgcn_global_load_lds((const unsigned*)((gb_) + (size_t)(32 * i_) * ldb + (kt_) * 64),               \
                                       (__attribute__((address_space(3))) unsigned*)(lds + (buf_) * 32768 + 16384 + tid * 16 + i_ * 4096), 16, 0, 0); \
    }                                                                                                                 \
  }
  auto tile_rc = [&](int t, int& tm_, int& tn_) {
    if (big_t0 >= 0) {
      int bt = big_t0 + (t >> 2), q = t & 3;
      tm_ = 2 * (bt / big_ntn) + (q >> 1);
      tn_ = 2 * (bt % big_ntn) + (q & 1);
    } else {
      tm_ = t / Ntiles;
      tn_ = t % Ntiles;
    }
  };
  if (lb < ntiles) {
    int tm0, tn0;
    tile_rc(lb, tm0, tn0);
    const bf16_t* ga0 = A + (size_t)(tm0 * 128 + srow) * lda + scol;
    const bf16_t* gb0 = Bt + (size_t)(tn0 * 128 + srow) * ldb + scol;
    GEMM_STAGE(ga0, gb0, 0, 0)
  }
  for (int t = lb; t < ntiles; t += nblk) {
    int tm, tn;
    tile_rc(t, tm, tn);
    int brow = tm * 128, bcol = tn * 128;
    f32x4 acc[4][4];
#pragma unroll
    for (int m = 0; m < 4; ++m)
#pragma unroll
      for (int n = 0; n < 4; ++n) acc[m][n] = f32x4{0.f, 0.f, 0.f, 0.f};
    const bf16_t* ga = A + (size_t)(brow + srow) * lda + scol;
    const bf16_t* gb = Bt + (size_t)(bcol + srow) * ldb + scol;
    for (int kt = 0; kt < nk; ++kt) {
      const int buf = kt & 1;
      asm volatile("s_waitcnt vmcnt(0)" ::: "memory");
      __syncthreads();
      if (kt + 1 < nk) GEMM_STAGE(ga, gb, kt + 1, buf ^ 1)
      const unsigned char* SA = lds + buf * 32768;
      const unsigned char* SB = SA + 16384;
      bf16x8 At[2][4], Bl[2][4];
#pragma unroll
      for (int ks = 0; ks < 2; ++ks)
#pragma unroll
        for (int m = 0; m < 4; ++m) {
          const int sl = ((ks * 4 + fq) ^ (fr & 7)) << 4;
          At[ks][m] = *reinterpret_cast<const bf16x8*>(SA + (wr * 64 + m * 16 + fr) * 128 + sl);
          Bl[ks][m] = *reinterpret_cast<const bf16x8*>(SB + (wc * 64 + m * 16 + fr) * 128 + sl);
        }
#pragma unroll
      for (int ks = 0; ks < 2; ++ks)
#pragma unroll
        for (int m = 0; m < 4; ++m)
#pragma unroll
          for (int n = 0; n < 4; ++n)
            acc[m][n] = __builtin_amdgcn_mfma_f32_16x16x32_bf16(At[ks][m], Bl[ks][n], acc[m][n], 0, 0, 0);
    }
    {
      int t2 = t + nblk;
      if (t2 < ntiles) {
        int tm2, tn2;
        tile_rc(t2, tm2, tn2);
        const bf16_t* ga2 = A + (size_t)(tm2 * 128 + srow) * lda + scol;
        const bf16_t* gb2 = Bt + (size_t)(tn2 * 128 + srow) * ldb + scol;
        GEMM_STAGE(ga2, gb2, 0, 0)
      }
    }
    const int colbase = bcol + wc * 64;
    if constexpr (EPI == EPI_STORE || EPI == EPI_GELU) {
      if (EPI == EPI_GELU && colbase >= 1024) {
        float* rsp = p->rowss + ((size_t)tm * 32 + ((colbase - 1024) >> 5)) * 128;
#pragma unroll
        for (int m = 0; m < 4; ++m) {
          float ssq[4] = {0.f, 0.f, 0.f, 0.f};
#pragma unroll
          for (int n = 0; n < 4; ++n) {
            int ch = colbase - 1024 + n * 16 + fr;
            int q0 = wr * 64 + m * 16 + fq * 4;
            float g0 = gelu_tanh(acc[m][n][0]), g1 = gelu_tanh(acc[m][n][1]), g2 = gelu_tanh(acc[m][n][2]), g3 = gelu_tanh(acc[m][n][3]);
            ssq[0] += g0 * g0;
            ssq[1] += g1 * g1;
            ssq[2] += g2 * g2;
            ssq[3] += g3 * g3;
            uint2 o;
            o.x = pack2(g0, g1);
            o.y = pack2(g2, g3);
            *reinterpret_cast<uint2*>(p->zvT + ((size_t)tm * 1024 + ch) * 128 + q0) = o;
          }
#pragma unroll
          for (int j = 0; j < 4; ++j) {
            float v = ssq[j];
            v += dpp_mov<0xB1>(v);
            v += dpp_mov<0x4E>(v);
            v += dpp_mov<0x141>(v);
            v += dpp_mov<0x140>(v);
            if (fr == 0) {
              rsp[wr * 64 + m * 16 + fq * 4 + j] = v;
              rsp[128 + wr * 64 + m * 16 + fq * 4 + j] = 0.f;
            }
          }
        }
      } else {
#pragma unroll
        for (int m = 0; m < 4; ++m)
#pragma unroll
          for (int j = 0; j < 4; ++j) {
            int row = brow + wr * 64 + m * 16 + fq * 4 + j;
            bf16_t* o = p->P + (size_t)row * 2048 + colbase + fr;
#pragma unroll
            for (int n = 0; n < 4; ++n) {
              float v = acc[m][n][j];
              if (EPI == EPI_GELU) v = gelu_tanh(v);
              o[n * 16] = f2bf(v);
            }
          }
      }
    } else if constexpr (EPI == EPI_RESID) {
#pragma unroll
      for (int m = 0; m < 4; ++m)
#pragma unroll
        for (int j = 0; j < 4; ++j) {
          int row = brow + wr * 64 + m * 16 + fq * 4 + j;
          int b = tok_batch(row);
          const float* g = p->mod + ((size_t)layer * 9 + b) * 6144 + 2048 + colbase + fr;
          float* o = p->xs + (size_t)row * D + colbase + fr;
          const float* xi = o;
          if (layer == 0 && gscale == 1.f)
            xi = ((row < TL) ? p->x + (size_t)row * D : p->ctx + (size_t)(row - TL) * D) + colbase + fr;
#pragma unroll
          for (int n = 0; n < 4; ++n) o[n * 16] = xi[n * 16] + gscale * g[n * 16] * acc[m][n][j];
        }
    } else if constexpr (EPI == EPI_INPROJ) {
      if (colbase >= 640 && colbase < 768) {
        int kvh = (colbase - 640) >> 6;
#pragma unroll
        for (int m = 0; m < 4; ++m) {
          int row0 = brow + wr * 64 + m * 16;
          bool latent = row0 < TL;
          int b = latent ? (row0 >> 12) : ((row0 - TL) >> 8);
          int kp16 = latent ? (CTX + (row0 & 4095)) : ((row0 - TL) & 255);
          int slot = kp16 + 8 * (fq & 1) + 4 * (fq >> 1);
#pragma unroll
          for (int n = 0; n < 4; ++n) {
            int dim = n * 16 + fr;
            uint2 o;
            o.x = pack2(acc[m][n][0], acc[m][n][1]);
            o.y = pack2(acc[m][n][2], acc[m][n][3]);
            *reinterpret_cast<uint2*>(p->vbuf + ((size_t)(b * 2 + kvh) * 64 + dim) * KVLEN + slot) = o;
          }
        }
      } else {
#pragma unroll
        for (int m = 0; m < 4; ++m)
#pragma unroll
          for (int j = 0; j < 4; ++j) {
            int row = brow + wr * 64 + m * 16 + fq * 4 + j;
            bool latent = row < TL;
            int b, pos;
            if (latent) {
              b = row >> 12;
              pos = row & 4095;
            } else {
              b = (row - TL) >> 8;
              pos = (row - TL) & 255;
            }
            float v0 = acc[m][0][j], v1 = acc[m][1][j], v2 = acc[m][2][j], v3 = acc[m][3][j];
            if (latent && colbase < 640) {
              float2 cr = p->cs[(pos >> 6) * 16 + fr];
              float2 cc = p->cs[(pos & 63) * 16 + fr];
              float a = v0, bb = v1;
              v0 = a * cr.x - bb * cr.y;
              v1 = bb * cr.x + a * cr.y;
              a = v2;
              bb = v3;
              v2 = a * cc.x - bb * cc.y;
              v3 = bb * cc.x + a * cc.y;
            }
            bf16_t* o;
            if (colbase < 512 || colbase >= 768) {
              o = p->P + (size_t)row * 2048 + colbase + fr;
            } else {
              int kvh = (colbase - 512) >> 6;
              int kp = latent ? (CTX + pos) : pos;
              o = p->kbuf + ((size_t)(b * 2 + kvh) * KVLEN + kp) * 64 + fr;
            }
            o[0] = f2bf(v0);
            o[16] = f2bf(v1);
            o[32] = f2bf(v2);
            o[48] = f2bf(v3);
          }
      }
    }
  }
}

constexpr int G8_HT = 128 * 64;
DEVI int g8_lds_byte(int r, int c) {
  int st = (r >> 4) * 2 + (c >> 5), rr = r & 15, cc = c & 31, ob = rr * 64 + cc * 2;
  return st * 1024 + (ob ^ (((ob >> 9) & 1) << 5));
}
DEVI void g8_stage_rc(int b, int& R, int& C) {
  int st = b / 1024, sb = b % 1024, swz = sb ^ (((sb >> 9) & 1) << 5);
  R = (st >> 1) * 16 + swz / 64;
  C = (st & 1) * 32 + (swz % 64) / 2;
}
template <int EPI, bool STAGED>
DEVI void gemm8_epilogue(PP p, f32x4 (&acc)[2][2][4][2], const f32x4* stg, int lane, int brow, int bcol, int wr, int wc, int fr, int fq, int layer, float gscale) {
#pragma unroll
  for (int ai_ = 0; ai_ < 2; ++ai_)
#pragma unroll
    for (int bj = 0; bj < 2; ++bj) {
      const int ai = STAGED ? 1 - ai_ : ai_;
      f32x4 q[4][2];
#pragma unroll
      for (int m = 0; m < 4; ++m)
#pragma unroll
        for (int n = 0; n < 2; ++n) q[m][n] = (STAGED && ai == 0) ? stg[(((bj * 4 + m) * 2 + n) * 64) + lane] : acc[ai][bj][m][n];
      const int r0 = brow + ai * 128 + wr * 64;
      const int c0 = bcol + bj * 128 + wc * 32;
      if constexpr (EPI == EPI_STORE) {
#pragma unroll
        for (int m = 0; m < 4; ++m)
#pragma unroll
          for (int j = 0; j < 4; ++j) {
            bf16_t* o = p->P + (size_t)(r0 + m * 16 + fq * 4 + j) * 2048 + c0 + fr;
            o[0] = f2bf(q[m][0][j]);
            o[16] = f2bf(q[m][1][j]);
          }
      } else if constexpr (EPI == EPI_GELU) {
        if (c0 >= 1024) {
          const int chunk = r0 >> 7;
          float* rsp = p->rowss + ((size_t)chunk * 32 + ((c0 - 1024) >> 5)) * 128;
#pragma unroll
          for (int m = 0; m < 4; ++m) {
            float ssq[4] = {0.f, 0.f, 0.f, 0.f};
            const int q0 = (r0 & 127) + m * 16 + fq * 4;
#pragma unroll
            for (int n = 0; n < 2; ++n) {
              int ch = c0 - 1024 + n * 16 + fr;
              float g0 = gelu_tanh(q[m][n][0]), g1 = gelu_tanh(q[m][n][1]);
              float g2 = gelu_tanh(q[m][n][2]), g3 = gelu_tanh(q[m][n][3]);
              ssq[0] += g0 * g0;
              ssq[1] += g1 * g1;
              ssq[2] += g2 * g2;
              ssq[3] += g3 * g3;
              uint2 o;
              o.x = pack2(g0, g1);
              o.y = pack2(g2, g3);
              *reinterpret_cast<uint2*>(p->zvT + ((size_t)chunk * 1024 + ch) * 128 + q0) = o;
            }
#pragma unroll
            for (int j = 0; j < 4; ++j) {
              float v = ssq[j];
              v += dpp_mov<0xB1>(v);
              v += dpp_mov<0x4E>(v);
              v += dpp_mov<0x141>(v);
              v += dpp_mov<0x140>(v);
              if (fr == 0) rsp[q0 + j] = v;
            }
          }
        } else {
#pragma unroll
          for (int m = 0; m < 4; ++m)
#pragma unroll
            for (int j = 0; j < 4; ++j) {
              bf16_t* o = p->P + (size_t)(r0 + m * 16 + fq * 4 + j) * 2048 + c0 + fr;
              o[0] = f2bf(gelu_tanh(q[m][0][j]));
              o[16] = f2bf(gelu_tanh(q[m][1][j]));
            }
        }
      } else if constexpr (EPI == EPI_RESID || EPI == EPI_RESID0) {
        const float* g = p->mod + ((size_t)layer * 9 + tok_batch(brow)) * 6144 + 2048 + c0 + fr;
        const float g0 = g[0], g1 = g[16];
        const float* xin = (brow < TL) ? p->x : p->ctx - (size_t)TL * D;
#pragma unroll
        for (int m = 0; m < 4; ++m)
#pragma unroll
          for (int j = 0; j < 4; ++j) {
            const size_t ro = (size_t)(r0 + m * 16 + fq * 4 + j) * D + c0 + fr;
            float* o = p->xs + ro;
            const float* xi = (EPI == EPI_RESID0) ? xin + ro : o;
            o[0] = xi[0] + g0 * q[m][0][j];
            o[16] = xi[16] + g1 * q[m][1][j];
          }
      } else if constexpr (EPI == EPI_INPROJ) {
        if (c0 >= 640 && c0 < 768) {
          const int kvh = (c0 - 640) >> 6, d0 = (c0 - 640) & 63;
#pragma unroll
          for (int m = 0; m < 4; ++m) {
            int row0 = r0 + m * 16;
            bool latent = row0 < TL;
            int b = latent ? (row0 >> 12) : ((row0 - TL) >> 8);
            int kp16 = latent ? (CTX + (row0 & 4095)) : ((row0 - TL) & 255);
            int slot = kp16 + 8 * (fq & 1) + 4 * (fq >> 1);
#pragma unroll
            for (int n = 0; n < 2; ++n) {
              int dim = d0 + n * 16 + fr;
              uint2 o;
              o.x = pack2(q[m][n][0], q[m][n][1]);
              o.y = pack2(q[m][n][2], q[m][n][3]);
              *reinterpret_cast<uint2*>(p->vbuf + ((size_t)(b * 2 + kvh) * 64 + dim) * KVLEN + slot) = o;
            }
          }
        } else {
          const int hsel = (c0 >> 5) & 1;
#pragma unroll
          for (int m = 0; m < 4; ++m)
#pragma unroll
            for (int j = 0; j < 4; ++j) {
              int row = r0 + m * 16 + fq * 4 + j;
              bool latent = row < TL;
              int b, pos;
              if (latent) {
                b = row >> 12;
                pos = row & 4095;
              } else {
                b = (row - TL) >> 8;
                pos = (row - TL) & 255;
              }
              float v0 = q[m][0][j], v1 = q[m][1][j];
              if (latent && c0 < 640) {
                float2 cs = p->cs[(hsel ? (pos & 63) : (pos >> 6)) * 16 + fr];
                float a = v0, bb = v1;
                v0 = a * cs.x - bb * cs.y;
                v1 = bb * cs.x + a * cs.y;
              }
              bf16_t* o;
              if (c0 < 512 || c0 >= 768) {
                o = p->P + (size_t)row * 2048 + c0 + fr;
              } else {
                int kvh = (c0 - 512) >> 6, d0 = (c0 - 512) & 63;
                int kp = latent ? (CTX + pos) : pos;
                o = p->kbuf + ((size_t)(b * 2 + kvh) * KVLEN + kp) * 64 + d0 + fr;
              }
              o[0] = f2bf(v0);
              o[16] = f2bf(v1);
            }
        }
      }
      __builtin_amdgcn_sched_barrier(0);
    }
}

DEVI int g8_perm32(int rho) { const int n = rho >> 4, i = rho & 15; return 8 * (i >> 2) + 4 * n + (i & 3); }
template <int EPI>
DEVI void gemm8_epilogue_tr(PP p, f32x4 (&acc)[2][2][4][2], int brow, int bcol, int wr, int wc, int fr, int fq, int layer) {
  if constexpr (EPI == EPI_STORE) {
#pragma unroll
    for (int ai = 0; ai < 2; ++ai)
#pragma unroll
      for (int m = 0; m < 4; ++m) {
        bf16_t* o = p->P + (size_t)(brow + ai * 128 + wr * 64 + m * 16 + fr) * 2048 + bcol + wc * 32 + 8 * fq;
#pragma unroll
        for (int bj = 0; bj < 2; ++bj) {
          const f32x4 v0 = acc[ai][bj][m][0], v1 = acc[ai][bj][m][1];
          uint4 w;
          w.x = pack2(v0[0], v0[1]);
          w.y = pack2(v0[2], v0[3]);
          w.z = pack2(v1[0], v1[1]);
          w.w = pack2(v1[2], v1[3]);
          *reinterpret_cast<uint4*>(o + bj * 128) = w;
        }
      }
  } else if constexpr (EPI == EPI_RESID || EPI == EPI_RESID0) {
    const float* xin = (brow < TL) ? p->x : p->ctx - (size_t)TL * D;
#pragma unroll
    for (int bj = 0; bj < 2; ++bj) {
      const int c0 = bcol + bj * 128 + wc * 32 + 4 * fq;
      const float* g = p->mod + ((size_t)layer * 9 + tok_batch(brow)) * 6144 + 2048 + c0;
      const f32x4 g0 = *reinterpret_cast<const f32x4*>(g), g1 = *reinterpret_cast<const f32x4*>(g + 16);
#pragma unroll
      for (int ai = 0; ai < 2; ++ai)
#pragma unroll
        for (int m = 0; m < 4; ++m) {
          const size_t ro = (size_t)(brow + ai * 128 + wr * 64 + m * 16 + fr) * D + c0;
          float* o = p->xs + ro;
          const float* xi = (EPI == EPI_RESID0) ? xin + ro : o;
          const f32x4 x0 = *reinterpret_cast<const f32x4*>(xi), x1 = *reinterpret_cast<const f32x4*>(xi + 16);
          *reinterpret_cast<f32x4*>(o) = x0 + g0 * acc[ai][bj][m][0];
          *reinterpret_cast<f32x4*>(o + 16) = x1 + g1 * acc[ai][bj][m][1];
          if (m & 1) __builtin_amdgcn_sched_barrier(0);
        }
    }
  } else if constexpr (EPI == EPI_INPROJ) {
    const bool latent = brow < TL;
#pragma unroll
    for (int bj = 0; bj < 2; ++bj) {
      const int c0 = bcol + bj * 128 + wc * 32;
      if (c0 >= 640 && c0 < 768) {
        const int kvh = (c0 - 640) >> 6, d0 = ((c0 - 640) & 63) + 4 * fq;
        const int so = 8 * ((fr >> 2) & 1) + 4 * (fr >> 3) + (fr & 3);
#pragma unroll
        for (int ai = 0; ai < 2; ++ai)
#pragma unroll
          for (int m = 0; m < 4; ++m) {
            const int row0 = brow + ai * 128 + wr * 64 + m * 16;
            const int b = latent ? (row0 >> 12) : ((row0 - TL) >> 8);
            const int kp16 = latent ? (CTX + (row0 & 4095)) : ((row0 - TL) & 255);
            bf16_t* o = p->vbuf + ((size_t)(b * 2 + kvh) * 64 + d0) * KVLEN + kp16 + so;
#pragma unroll
            for (int n = 0; n < 2; ++n)
#pragma unroll
              for (int j = 0; j < 4; ++j) o[(size_t)(n * 16 + j) * KVLEN] = f2bf(acc[ai][bj][m][n][j]);
          }
      } else {
        const int hsel = (c0 >> 5) & 1;
#pragma unroll
        for (int ai = 0; ai < 2; ++ai)
#pragma unroll
          for (int m = 0; m < 4; ++m) {
            const int row = brow + ai * 128 + wr * 64 + m * 16 + fr;
            const int b = latent ? (row >> 12) : ((row - TL) >> 8);
            const int pos = latent ? (row & 4095) : ((row - TL) & 255);
            f32x4 v0 = acc[ai][bj][m][0], v1 = acc[ai][bj][m][1];
            if (latent && c0 < 640) {
              const f32x4* cp = reinterpret_cast<const f32x4*>(p->cs + (hsel ? (pos & 63) : (pos >> 6)) * 16 + 4 * fq);
              const f32x4 ca = cp[0], cb = cp[1];
              const f32x4 a = v0, bb = v1;
              v0[0] = a[0] * ca[0] - bb[0] * ca[1];
              v1[0] = bb[0] * ca[0] + a[0] * ca[1];
              v0[1] = a[1] * ca[2] - bb[1] * ca[3];
              v1[1] = bb[1] * ca[2] + a[1] * ca[3];
              v0[2] = a[2] * cb[0] - bb[2] * cb[1];
              v1[2] = bb[2] * cb[0] + a[2] * cb[1];
              v0[3] = a[3] * cb[2] - bb[3] * cb[3];
              v1[3] = bb[3] * cb[2] + a[3] * cb[3];
            }
            bf16_t* o;
            if (c0 < 512 || c0 >= 768) {
              o = p->P + (size_t)row * 2048 + c0 + 4 * fq;
            } else {
              const int kvh = (c0 - 512) >> 6, d0 = (c0 - 512) & 63;
              const int kp = latent ? (CTX + pos) : pos;
              o = p->kbuf + ((size_t)(b * 2 + kvh) * KVLEN + kp) * 64 + d0 + 4 * fq;
            }
            uint2 w0, w1;
            w0.x = pack2(v0[0], v0[1]);
            w0.y = pack2(v0[2], v0[3]);
            w1.x = pack2(v1[0], v1[1]);
            w1.y = pack2(v1[2], v1[3]);
            *reinterpret_cast<uint2*>(o) = w0;
            *reinterpret_cast<uint2*>(o + 16) = w1;
          }
      }
      __builtin_amdgcn_sched_barrier(0);
    }
  }
}

template <int EPI>
DEVI void gemm8_phase(PP p, const bf16_t* __restrict__ A, int lda, const bf16_t* __restrict__ Bt, int ldb, int Mtiles, int Ntiles,
                      int K, int layer, unsigned char* lds_all, float gscale = 1.f) {
  constexpr bool TR = (EPI != EPI_GELU);
  constexpr bool PERM = (EPI == EPI_STORE);
  bf16_t* shm = reinterpret_cast<bf16_t*>(lds_all);
  const int tid = ptid();
  const int wid = __builtin_amdgcn_readfirstlane(tid >> 6), lane = tid & 63, wr = wid >> 2, wc = wid & 3, fr = lane & 15, fq = lane >> 4;
#define G8_SA(b, h) (shm + ((b) * 2 + (h)) * G8_HT)
#define G8_SB(b, h) (shm + (4 + (b) * 2 + (h)) * G8_HT)
  const __amdgpu_buffer_rsrc_t rsA = __builtin_amdgcn_make_buffer_rsrc((void*)A, (short)0, -1, 0x00020000);
  const __amdgpu_buffer_rsrc_t rsB = __builtin_amdgcn_make_buffer_rsrc((void*)Bt, (short)0, -1, 0x00020000);
  unsigned voA[2], voB[2];
#pragma unroll
  for (int i = 0; i < 2; ++i) {
    int r_, c_;
    g8_stage_rc(tid * 16 + i * 8192, r_, c_);
    const int rb_ = PERM ? ((r_ & ~31) + g8_perm32(r_ & 31)) : r_;
    voA[i] = (unsigned)((r_ * lda + c_) * 2);
    voB[i] = (unsigned)((rb_ * ldb + c_) * 2);
  }
#define G8_STAGE(P_, RS_, VO_, ld_, br_, kt_)                                                                         \
  do {                                                                                                                \
    const unsigned so_ = (unsigned)(((br_) * (ld_) + (kt_) * 64) * 2);                                                \
    _Pragma("unroll") for (int i_ = 0; i_ < 2; ++i_)                                                                  \
      __builtin_amdgcn_raw_ptr_buffer_load_lds(RS_, (__attribute__((address_space(3))) void*)((unsigned char*)(P_) + wid * 1024 + i_ * 8192), 16, VO_[i_], so_, 0, 0); \
  } while (0)
#define G8_LDA(dst, b, h)                                                                                             \
  _Pragma("unroll") for (int m_ = 0; m_ < 4; ++m_) _Pragma("unroll") for (int k_ = 0; k_ < 2; ++k_)                   \
      dst[m_][k_] = *reinterpret_cast<const bf16x8*>((const unsigned char*)G8_SA(b, h) + g8_lds_byte(wr * 64 + m_ * 16 + fr, k_ * 32 + fq * 8))
#define G8_LDB(dst, b, h)                                                                                             \
  _Pragma("unroll") for (int n_ = 0; n_ < 2; ++n_) _Pragma("unroll") for (int k_ = 0; k_ < 2; ++k_)                   \
      dst[n_][k_] = *reinterpret_cast<const bf16x8*>((const unsigned char*)G8_SB(b, h) + g8_lds_byte(wc * 32 + n_ * 16 + fr, k_ * 32 + fq * 8))
#define G8_MMA(ai, bj, At_, Bt_)                                                                                      \
  do {                                                                                                                \
    __builtin_amdgcn_s_setprio(1);                                                                                    \
    _Pragma("unroll") for (int m_ = 0; m_ < 4; ++m_) _Pragma("unroll") for (int n_ = 0; n_ < 2; ++n_)                 \
        _Pragma("unroll") for (int k_ = 0; k_ < 2; ++k_) acc[ai][bj][m_][n_] =                                        \
            TR ? __builtin_amdgcn_mfma_f32_16x16x32_bf16(Bt_[n_][k_], At_[m_][k_], acc[ai][bj][m_][n_], 0, 0, 0)      \
               : __builtin_amdgcn_mfma_f32_16x16x32_bf16(At_[m_][k_], Bt_[n_][k_], acc[ai][bj][m_][n_], 0, 0, 0);     \
    __builtin_amdgcn_s_setprio(0);                                                                                    \
  } while (0)
#define G8_WAIT_V(n) asm volatile("s_waitcnt vmcnt(" #n ")" ::: "memory")
#define G8_WAIT_L(n) asm volatile("s_waitcnt lgkmcnt(" #n ")" ::: "memory")
#define G8_BAR __builtin_amdgcn_s_barrier()
#define G8_SCHED __builtin_amdgcn_sched_barrier(0)
  const int nblk = pnblk(), bid = pbid();
  const int lb = ((nblk & 7) == 0) ? ((bid & 7) * (nblk >> 3) + (bid >> 3)) : bid;
  const int ntiles_all = Mtiles * Ntiles;
  const int ntiles = (EPI == EPI_RESID0 || gscale != 1.f) ? ntiles_all : (ntiles_all / nblk) * nblk;
  const int nt = K / 64;
  if (lb < ntiles) {
    int t = lb;
    int brow = (t / Ntiles) * 256, bcol = (t % Ntiles) * 256;
    f32x4 acc[2][2][4][2];
#pragma unroll
    for (int a0 = 0; a0 < 2; ++a0)
#pragma unroll
      for (int b0 = 0; b0 < 2; ++b0)
#pragma unroll
        for (int m = 0; m < 4; ++m)
#pragma unroll
          for (int n = 0; n < 2; ++n) acc[a0][b0][m][n] = f32x4{0.f, 0.f, 0.f, 0.f};
    bf16x8 At[4][2], B0[2][2], B1[2][2];
    G8_STAGE(G8_SB(0, 0), rsB, voB, ldb, bcol, 0);
    G8_STAGE(G8_SA(0, 0), rsA, voA, lda, brow, 0);
    G8_STAGE(G8_SB(0, 1), rsB, voB, ldb, bcol + 128, 0);
    G8_STAGE(G8_SA(0, 1), rsA, voA, lda, brow + 128, 0);
    if (wr == 1) G8_BAR;
    G8_WAIT_V(4);
    G8_BAR;
    G8_STAGE(G8_SB(1, 0), rsB, voB, ldb, bcol, 1);
    G8_STAGE(G8_SA(1, 0), rsA, voA, lda, brow, 1);
    G8_STAGE(G8_SB(1, 1), rsB, voB, ldb, bcol + 128, 1);
    G8_WAIT_V(6);
    G8_BAR;
    for (;;) {
      const int tnx = t + nblk;
      const bool has_next = tnx < ntiles;
      const int nbrow = has_next ? (tnx / Ntiles) * 256 : brow, nbcol = has_next ? (tnx % Ntiles) * 256 : bcol;
      for (int kt = 0; kt < nt; kt += 2) {
        const bool last = (kt == nt - 2);
        const int a2 = last ? nbrow : brow, b2 = last ? nbcol : bcol, k2 = last ? 0 : kt + 2;
        G8_LDB(B0, 0, 0); G8_SCHED; G8_LDA(At, 0, 0); G8_STAGE(G8_SA(1, 1), rsA, voA, lda, brow + 128, kt + 1);
        G8_WAIT_L(8); G8_BAR; G8_WAIT_L(0); G8_MMA(0, 0, At, B0); G8_BAR; G8_SCHED;
        G8_LDB(B1, 0, 1); G8_STAGE(G8_SB(0, 0), rsB, voB, ldb, b2, k2);
        G8_BAR; G8_WAIT_L(0); G8_MMA(0, 1, At, B1); G8_BAR;
        G8_LDA(At, 0, 1); G8_STAGE(G8_SA(0, 0), rsA, voA, lda, a2, k2);
        G8_BAR; G8_WAIT_L(0); G8_MMA(1, 0, At, B0); G8_BAR; G8_SCHED;
        G8_STAGE(G8_SB(0, 1), rsB, voB, ldb, b2 + 128, k2);
        G8_WAIT_V(6); G8_BAR; G8_MMA(1, 1, At, B1); G8_BAR;
        G8_LDB(B0, 1, 0); G8_SCHED; G8_LDA(At, 1, 0); G8_STAGE(G8_SA(0, 1), rsA, voA, lda, a2 + 128, k2);
        G8_WAIT_L(8); G8_BAR; G8_WAIT_L(0); G8_MMA(0, 0, At, B0); G8_BAR; G8_SCHED;
        G8_LDB(B1, 1, 1); G8_STAGE(G8_SB(1, 0), rsB, voB, ldb, b2, k2 + 1);
        G8_BAR; G8_WAIT_L(0); G8_MMA(0, 1, At, B1); G8_BAR;
        G8_LDA(At, 1, 1); G8_STAGE(G8_SA(1, 0), rsA, voA, lda, a2, k2 + 1);
        G8_BAR; G8_WAIT_L(0); G8_MMA(1, 0, At, B0); G8_BAR; G8_SCHED;
        G8_STAGE(G8_SB(1, 1), rsB, voB, ldb, b2 + 128, k2 + 1);
        G8_WAIT_V(6); G8_BAR; G8_MMA(1, 1, At, B1); G8_BAR;
      }
      {
        int lane2 = lane_id();
        asm volatile("" : "+v"(lane2));
        const int fr2 = lane2 & 15, fq2 = lane2 >> 4;
        if constexpr (TR) gemm8_epilogue_tr<EPI>(p, acc, brow, bcol, wr, wc, fr2, fq2, layer);
        else gemm8_epilogue<EPI, false>(p, acc, nullptr, lane2, brow, bcol, wr, wc, fr2, fq2, layer, gscale);
      }
      if (!has_next) break;
#pragma unroll
      for (int a0 = 0; a0 < 2; ++a0)
#pragma unroll
        for (int b0 = 0; b0 < 2; ++b0)
#pragma unroll
          for (int m = 0; m < 4; ++m)
#pragma unroll
            for (int n = 0; n < 2; ++n) acc[a0][b0][m][n] = f32x4{0.f, 0.f, 0.f, 0.f};
      t = tnx;
      brow = nbrow;
      bcol = nbcol;
    }
    G8_WAIT_V(0);
    if (wr == 0) G8_BAR;
  }
  __syncthreads();
  if (ntiles < ntiles_all) {
    constexpr int EPI_T = (EPI == EPI_RESID0) ? EPI_RESID : EPI;
    gemm_phase<EPI_T>(p, A, lda, Bt, ldb, 0, 0, K, layer, lds_all + (wid >> 2) * LDS_HALF, 1.f, ntiles, ntiles_all - ntiles, Ntiles);
  }
#undef G8_SA
#undef G8_SB
#undef G8_STAGE
#undef G8_LDA
#undef G8_LDB
#undef G8_MMA
#undef G8_WAIT_V
#undef G8_WAIT_L
#undef G8_BAR
#undef G8_SCHED
}

DEVI bf16x8 scale_q(uint4 u) {
  uint4 r;
  r.x = pack2(bflo(u.x) * 0.125f, bfhi(u.x) * 0.125f);
  r.y = pack2(bflo(u.y) * 0.125f, bfhi(u.y) * 0.125f);
  r.z = pack2(bflo(u.z) * 0.125f, bfhi(u.z) * 0.125f);
  r.w = pack2(bflo(u.w) * 0.125f, bfhi(u.w) * 0.125f);
  return __builtin_bit_cast(bf16x8, r);
}
DEVI void phase_attn(PP p, int layer, bool with_ctx_q, unsigned char* lds) {
  const int tid = ltid();
  const int lane = tid & 63, wid = __builtin_amdgcn_readfirstlane(tid >> 6), r = lane & 31, h = lane >> 5;
  const float* sinkp = p->attn_sink + (layer >> 1) * 8;
  const int nlat = NB * 2 * 128;
  const int nunits = nlat + (with_ctx_q ? NB * 2 * 8 : 0);
  for (int u = lbid(); u < nunits; u += lnblk()) {
    bool latent = u < nlat;
    int b, kvh, qg, tokbase;
    if (latent) {
      b = u >> 8;
      kvh = (u >> 7) & 1;
      qg = u & 127;
      tokbase = b * SEQ + qg * 32;
    } else {
      int v = u - nlat;
      b = v >> 4;
      kvh = (v >> 3) & 1;
      qg = v & 7;
      tokbase = TL + b * CTX + qg * 32;
    }
    const int hd = kvh * 4 + wid;
    const bf16_t* kb = p->kbuf + (size_t)(b * 2 + kvh) * KVLEN * 64;
    const bf16_t* vt = p->vbuf + (size_t)(b * 2 + kvh) * 64 * KVLEN;
    const int nch = latent ? 5 : 2;
    const int lbase = CTX + (qg - 4) * 32;
#define ATT_STAGE(c_, buf_)                                                                                           \
  {                                                                                                                   \
    const int kp0_ = ((c_) < 2) ? (c_) * 128 : lbase + ((c_) - 2) * 128;                                              \
    _Pragma("unroll") for (int i_ = 0; i_ < 4; ++i_) {                                                                \
      const int P_ = tid * 16 + i_ * 4096;                                                                            \
      const int krow_ = P_ >> 7, kslot_ = (P_ >> 4) & 7;                                                              \
      int kp_ = kp0_ + krow_;                                                                                         \
      kp_ = kp_ < 0 ? 0 : (kp_ > KVLEN - 1 ? KVLEN - 1 : kp_);                                                        \
      __builtin_amdgcn_global_load_lds((const unsigned*)(kb + (size_t)kp_ * 64 + ((kslot_ ^ ((krow_ >> 1) & 7)) << 3)), \
                                       (__attribute__((address_space(3))) unsigned*)(lds + (buf_) * 32768 + P_), 16, 0, 0); \
      const int vrow_ = P_ >> 8, vslot_ = (P_ >> 4) & 15;                                                             \
      int vp_ = kp0_ + ((vslot_ ^ (vrow_ & 15)) << 3);                                                                \
      vp_ = vp_ < 0 ? 0 : (vp_ > KVLEN - 8 ? KVLEN - 8 : vp_);                                                        \
      __builtin_amdgcn_global_load_lds((const unsigned*)(vt + (size_t)vrow_ * KVLEN + vp_),                           \
                                       (__attribute__((address_space(3))) unsigned*)(lds + (buf_) * 32768 + 16384 + P_), 16, 0, 0); \
    }                                                                                                                 \
  }
    __syncthreads();
    ATT_STAGE(0, 0)
    bf16x8 qf[4];
    {
      const bf16_t* qp = p->P + (size_t)(tokbase + r) * 2048 + hd * 64 + 8 * h;
#pragma unroll
      for (int st = 0; st < 4; ++st) qf[st] = scale_q(*reinterpret_cast<const uint4*>(qp + 16 * st));
    }
    f32x16 O0, O1;
#pragma unroll
    for (int i = 0; i < 16; ++i) {
      O0[i] = 0.f;
      O1[i] = 0.f;
    }
    float m_run = sinkp[hd];
    float l_run = (h == 0) ? 1.f : 0.f;
    for (int c = 0; c < nch; ++c) {
      const int buf = c & 1;
      asm volatile("s_waitcnt vmcnt(0)" ::: "memory");
      __syncthreads();
      if (c + 1 < nch) ATT_STAGE(c + 1, buf ^ 1)
      const unsigned char* LK = lds + buf * 32768;
      const unsigned char* LV = LK + 16384;
#pragma unroll 1
      for (int kbi = 0; kbi < 4; ++kbi) {
        int mode = 0;
        if (c >= 2) {
          const int d = (c - 2) * 4 + kbi - 4;
          const int kblk = qg + d;
          if (d > 4 || kblk < 0 || kblk > 127) continue;
          mode = (d == -4) ? 1 : ((d == 4) ? 2 : 0);
        }
        f32x16 S;
#pragma unroll
        for (int i = 0; i < 16; ++i) S[i] = 0.f;
        {
          const int krow = kbi * 32 + r;
#pragma unroll
          for (int st = 0; st < 4; ++st) {
            bf16x8 kf = *reinterpret_cast<const bf16x8*>(LK + krow * 128 + (((2 * st + h) ^ ((krow >> 1) & 7)) << 4));
            S = __builtin_amdgcn_mfma_f32_32x32x16_bf16(kf, qf[st], S, 0, 0, 0);
          }
        }
        if (mode) {
          float negbig;
          asm volatile("v_mov_b32 %0, 0xf149f2ca" : "=v"(negbig));
#pragma unroll
          for (int i = 0; i < 16; ++i) {
            int kk = (i & 3) + 8 * (i >> 2) + 4 * h;
            bool ok = (mode == 1) ? (kk >= r) : (kk <= r);
            if (!ok) S[i] = negbig;
          }
        }
        float bm = S[0];
#pragma unroll
        for (int i = 1; i < 16; ++i) bm = fmaxf(bm, S[i]);
        bm = fmaxf(bm, shx_f(bm, 32));
        float m_new = fmaxf(m_run, bm);
        const float L2E = 1.4426950408889634f;
        float nm = -m_new * L2E;
        float psum = 0.f;
#pragma unroll
        for (int i = 0; i < 16; ++i) {
          S[i] = __builtin_amdgcn_exp2f(fmaf(S[i], L2E, nm));
          psum += S[i];
        }
        if (__any(m_new > m_run)) {
          float alpha = __builtin_amdgcn_exp2f((m_run - m_new) * L2E);
          l_run *= alpha;
#pragma unroll
          for (int i = 0; i < 16; ++i) {
            O0[i] *= alpha;
            O1[i] *= alpha;
          }
        }
        l_run += psum;
        m_run = m_new;
#pragma unroll
        for (int sidx = 0; sidx < 2; ++sidx) {
          uint4 pk;
          pk.x = pack2(S[8 * sidx + 0], S[8 * sidx + 1]);
          pk.y = pack2(S[8 * sidx + 2], S[8 * sidx + 3]);
          pk.z = pack2(S[8 * sidx + 4], S[8 * sidx + 5]);
          pk.w = pack2(S[8 * sidx + 6], S[8 * sidx + 7]);
          bf16x8 pf = __builtin_bit_cast(bf16x8, pk);
          const int vch = 4 * kbi + 2 * sidx + h;
          bf16x8 v0 = *reinterpret_cast<const bf16x8*>(LV + r * 256 + ((vch ^ (r & 15)) << 4));
          bf16x8 v1 = *reinterpret_cast<const bf16x8*>(LV + (32 + r) * 256 + ((vch ^ (r & 15)) << 4));
          O0 = __builtin_amdgcn_mfma_f32_32x32x16_bf16(v0, pf, O0, 0, 0, 0);
          O1 = __builtin_amdgcn_mfma_f32_32x32x16_bf16(v1, pf, O1, 0, 0, 0);
        }
      }
    }
#undef ATT_STAGE
    float l_tot = l_run + shx_f(l_run, 32);
    float inv = 1.f / l_tot;
    bf16_t* op = p->mix + (size_t)(tokbase + r) * LDMIX + hd * 64 + 4 * h;
#pragma unroll
    for (int g4 = 0; g4 < 4; ++g4) {
      uint2 o;
      o.x = pack2(O0[4 * g4 + 0] * inv, O0[4 * g4 + 1] * inv);
      o.y = pack2(O0[4 * g4 + 2] * inv, O0[4 * g4 + 3] * inv);
      *reinterpret_cast<uint2*>(op + 8 * g4) = o;
      o.x = pack2(O1[4 * g4 + 0] * inv, O1[4 * g4 + 1] * inv);
      o.y = pack2(O1[4 * g4 + 2] * inv, O1[4 * g4 + 3] * inv);
      *reinterpret_cast<uint2*>(op + 32 + 8 * g4) = o;
    }
  }
  __syncthreads();
}

DEVI void fill_tw(float2* tw, int n) {
  for (int i = ltid(); i < n; i += NTHREADS) {
    float sn, cn;
    sincospif(2.f * (float)i / (float)n, &sn, &cn);
    tw[i] = make_float2(cn, sn);
  }
  __syncthreads();
}

DEVI bf16x8 lds_col8(const bf16_t* bp, int stride) {
  unsigned e0 = bp[0], e1 = bp[stride], e2 = bp[2 * stride], e3 = bp[3 * stride];
  unsigned e4 = bp[4 * stride], e5 = bp[5 * stride], e6 = bp[6 * stride], e7 = bp[7 * stride];
  uint4 pk;
  pk.x = e0 | (e1 << 16);
  pk.y = e2 | (e3 << 16);
  pk.z = e4 | (e5 << 16);
  pk.w = e6 | (e7 << 16);
  return __builtin_bit_cast(bf16x8, pk);
}

DEVI void phase_fft_a(PP p, unsigned char* lds) {
  const int tid = ltid();
  const int lane = tid & 63, wid = __builtin_amdgcn_readfirstlane(tid >> 6), fr = lane & 15, fq = lane >> 4;
  float2* tw = reinterpret_cast<float2*>(lds + 66560);
  fill_tw(tw, 64);
  bf16x8 af[2][2];
#pragma unroll
  for (int ks = 0; ks < 2; ++ks) {
    unsigned short cr[8], ci[8];
#pragma unroll
    for (int j = 0; j < 8; ++j) {
      int n1 = 32 * ks + 8 * fq + j, k1 = 16 * wid + fr;
      float2 t = tw[(k1 * n1) & 63];
      cr[j] = f2bf(t.x);
      ci[j] = f2bf(-t.y);
    }
    uint4 a0, a1;
    a0.x = cr[0] | ((unsigned)cr[1] << 16); a0.y = cr[2] | ((unsigned)cr[3] << 16);
    a0.z = cr[4] | ((unsigned)cr[5] << 16); a0.w = cr[6] | ((unsigned)cr[7] << 16);
    a1.x = ci[0] | ((unsigned)ci[1] << 16); a1.y = ci[2] | ((unsigned)ci[3] << 16);
    a1.z = ci[4] | ((unsigned)ci[5] << 16); a1.w = ci[6] | ((unsigned)ci[7] << 16);
    af[0][ks] = __builtin_bit_cast(bf16x8, a0);
    af[1][ks] = __builtin_bit_cast(bf16x8, a1);
  }
  const bf16_t* l16 = reinterpret_cast<const bf16_t*>(lds);
  for (int u = lbid(); u < NB * 64; u += lnblk()) {
    int b = u >> 6, n2 = u & 63;
    __syncthreads();
#pragma unroll
    for (int i = 0; i < 16; ++i) {
      int row = (tid >> 6) + 4 * i, piece = tid & 63;
      uint4 v = *reinterpret_cast<const uint4*>(p->P + (size_t)(b * SEQ + 64 * row + n2) * 2048 + 768 + piece * 8);
      *reinterpret_cast<uint4*>(lds + row * 1040 + piece * 16) = v;
    }
    __syncthreads();
    float tc[4], ts[4];
#pragma unroll
    for (int j = 0; j < 4; ++j) sincospif((float)(n2 * (16 * wid + 4 * fq + j)) / 2048.f, &ts[j], &tc[j]);
    for (int nb = 0; nb < 4; ++nb) {
      f32x4 acc[2][8];
#pragma unroll
      for (int n = 0; n < 8; ++n) {
        acc[0][n] = f32x4{0.f, 0.f, 0.f, 0.f};
        acc[1][n] = f32x4{0.f, 0.f, 0.f, 0.f};
      }
#pragma unroll
      for (int ks = 0; ks < 2; ++ks)
#pragma unroll
        for (int nf = 0; nf < 8; ++nf) {
          bf16x8 bfr = lds_col8(l16 + (32 * ks + 8 * fq) * 520 + 128 * nb + 16 * nf + fr, 520);
          acc[0][nf] = __builtin_amdgcn_mfma_f32_16x16x32_bf16(af[0][ks], bfr, acc[0][nf], 0, 0, 0);
          acc[1][nf] = __builtin_amdgcn_mfma_f32_16x16x32_bf16(af[1][ks], bfr, acc[1][nf], 0, 0, 0);
        }
#pragma unroll
      for (int j = 0; j < 4; ++j) {
        int k1 = 16 * wid + 4 * fq + j;
        bf16_t* o = p->fa + (size_t)(b * SEQ + k1 * 64 + n2) * 1024 + 128 * nb + fr;
#pragma unroll
        for (int nf = 0; nf < 8; ++nf) {
          float re = acc[0][nf][j], im = acc[1][nf][j];
          o[16 * nf] = f2bf(re * tc[j] + im * ts[j]);
          o[512 + 16 * nf] = f2bf(im * tc[j] - re * ts[j]);
        }
      }
    }
  }
  __syncthreads();
}

DEVI void phase_fft_b(PP p, unsigned char* lds) {
  const int tid = ltid();
  const int lane = tid & 63, wid = __builtin_amdgcn_readfirstlane(tid >> 6), fr = lane & 15, fq = lane >> 4;
  float2* tw = reinterpret_cast<float2*>(lds + 67584);
  fill_tw(tw, 64);
  bf16x8 wb[2][4];
#pragma unroll
  for (int ks = 0; ks < 4; ++ks) {
    unsigned short zr[8], zi[8];
#pragma unroll
    for (int j = 0; j < 8; ++j) {
      int k = 32 * ks + 8 * fq + j, part = k >> 6, n2 = k & 63, k2 = 16 * wid + fr;
      float2 t = tw[(k2 * n2) & 63];
      zr[j] = f2bf(part ? t.y : t.x);
      zi[j] = f2bf(part ? t.x : -t.y);
    }
    uint4 a0, a1;
    a0.x = zr[0] | ((unsigned)zr[1] << 16); a0.y = zr[2] | ((unsigned)zr[3] << 16);
    a0.z = zr[4] | ((unsigned)zr[5] << 16); a0.w = zr[6] | ((unsigned)zr[7] << 16);
    a1.x = zi[0] | ((unsigned)zi[1] << 16); a1.y = zi[2] | ((unsigned)zi[3] << 16);
    a1.z = zi[4] | ((unsigned)zi[5] << 16); a1.w = zi[6] | ((unsigned)zi[7] << 16);
    wb[0][ks] = __builtin_bit_cast(bf16x8, a0);
    wb[1][ks] = __builtin_bit_cast(bf16x8, a1);
  }
  const bf16_t* l16 = reinterpret_cast<const bf16_t*>(lds);
  const float scale = 0.0013810679320049757f;
  for (int u = lbid(); u < NB * 128; u += lnblk()) {
    int b = u >> 7, k1 = (u >> 1) & 63, hf = u & 1;
    __syncthreads();
#pragma unroll
    for (int i = 0; i < 16; ++i) {
      int row = (tid >> 5) + 8 * i, piece = tid & 31;
      int part = row >> 6, n2 = row & 63;
      uint4 v = *reinterpret_cast<const uint4*>(p->fa + (size_t)(b * SEQ + k1 * 64 + n2) * 1024 + part * 512 + hf * 256 + piece * 8);
      *reinterpret_cast<uint4*>(lds + row * 528 + piece * 16) = v;
    }
    __syncthreads();
    for (int nb = 0; nb < 2; ++nb) {
      f32x4 acc[2][8];
#pragma unroll
      for (int n = 0; n < 8; ++n) {
        acc[0][n] = f32x4{0.f, 0.f, 0.f, 0.f};
        acc[1][n] = f32x4{0.f, 0.f, 0.f, 0.f};
      }
#pragma unroll
      for (int ks = 0; ks < 4; ++ks)
#pragma unroll
        for (int nf = 0; nf < 8; ++nf) {
          bf16x8 bfr = lds_col8(l16 + (32 * ks + 8 * fq) * 264 + 128 * nb + 16 * nf + fr, 264);
          acc[0][nf] = __builtin_amdgcn_mfma_f32_16x16x32_bf16(wb[0][ks], bfr, acc[0][nf], 0, 0, 0);
          acc[1][nf] = __builtin_amdgcn_mfma_f32_16x16x32_bf16(wb[1][ks], bfr, acc[1][nf], 0, 0, 0);
        }
#pragma unroll
      for (int j = 0; j < 4; ++j) {
        int k2 = 16 * wid + 4 * fq + j;
        bf16_t* o = p->mix + (size_t)(b * SEQ + k1 + 64 * k2) * LDMIX + 512 + hf * 256 + 128 * nb + fr;
#pragma unroll
        for (int nf = 0; nf < 8; ++nf) {
          o[16 * nf] = f2bf(acc[0][nf][j] * scale);
          o[512 + 16 * nf] = f2bf(acc[1][nf][j] * scale);
        }
      }
    }
  }
  __syncthreads();
}

DEVI void phase_dft_ctx(PP p, unsigned char* lds) {
  float2* tw = reinterpret_cast<float2*>(lds);
  fill_tw(tw, 256);
  int tid = ltid();
  const float scale = 0.005524271728019903f;
  for (int u = lbid(); u < NB * 64; u += lnblk()) {
    int b = u >> 6, k0 = (u & 63) * 4;
    for (int pass = 0; pass < 2; ++pass) {
      int ch = tid + pass * 256;
      float zr[4], zi[4];
#pragma unroll
      for (int kk = 0; kk < 4; ++kk) zr[kk] = zi[kk] = 0.f;
#pragma unroll 8
      for (int n = 0; n < 256; ++n) {
        float v = bf2f(p->P[(size_t)(TL + b * CTX + n) * 2048 + 768 + ch]);
#pragma unroll
        for (int kk = 0; kk < 4; ++kk) {
          float2 t = tw[(n * (k0 + kk)) & 255];
          zr[kk] += v * t.x;
          zi[kk] -= v * t.y;
        }
      }
#pragma unroll
      for (int kk = 0; kk < 4; ++kk) {
        bf16_t* o = p->mix + (size_t)(TL + b * CTX + k0 + kk) * LDMIX;
        o[512 + ch] = f2bf(zr[kk] * scale);
        o[1024 + ch] = f2bf(zi[kk] * scale);
      }
    }
  }
  __syncthreads();
}

DEVI void phase_sgu(PP p, int j, int nchunks, unsigned char* lds) {
  float* rs = reinterpret_cast<float*>(lds);
  unsigned char* LA = lds + 1024;
  unsigned char* LB = lds + 1024 + 32768;
  const int tid = ltid();
  const int lane = tid & 63, wid = __builtin_amdgcn_readfirstlane(tid >> 6), fr = lane & 15, fq = lane >> 4;
  const float* nw = p->gs_norm_w + j * 1024;
  for (int u = lbid(); u < nchunks * 8; u += lnblk()) {
    const int chunk = u >> 3, g = u & 7;
    const int tok0 = chunk * 128;
    const bf16_t* vT = p->zvT + ((size_t)chunk * 1024 + g * 128) * 128;
    __syncthreads();
    if (tid < 128) {
      const float* rp = p->rowss + (size_t)chunk * 32 * 128 + tid;
      float ss = 0.f;
#pragma unroll
      for (int sl = 0; sl < 32; ++sl) ss += rp[sl * 128];
      rs[tid] = rsqrtf(ss * (1.f / 1024.f) + 1e-6f);
    }
#pragma unroll
    for (int i = 0; i < 8; ++i) {
      int idx = tid + 256 * i, row = idx >> 4, c = idx & 15;
      uint4 v = *reinterpret_cast<const uint4*>(vT + (size_t)row * 128 + c * 8);
      *reinterpret_cast<uint4*>(LB + row * 256 + ((c ^ (row & 15)) << 4)) = v;
    }
    __syncthreads();
    {
      const float* wsg = p->gs_w_s + ((size_t)j * 8 + g) * 128 * 128;
#pragma unroll
      for (int i = 0; i < 8; ++i) {
        int idx = tid + 256 * i, row = idx >> 4, c = idx & 15;
        const float4* wp = reinterpret_cast<const float4*>(wsg + (size_t)row * 128 + c * 8);
        float4 w0 = wp[0], w1 = wp[1];
        const float* rk = rs + c * 8;
        uint4 pk;
        pk.x = pack2(w0.x * rk[0], w0.y * rk[1]);
        pk.y = pack2(w0.z * rk[2], w0.w * rk[3]);
        pk.z = pack2(w1.x * rk[4], w1.y * rk[5]);
        pk.w = pack2(w1.z * rk[6], w1.w * rk[7]);
        *reinterpret_cast<uint4*>(LA + row * 256 + ((c ^ (row & 15)) << 4)) = pk;
      }
    }
    __syncthreads();
    f32x4 acc[2][8];
#pragma unroll
    for (int m = 0; m < 2; ++m)
#pragma unroll
      for (int n = 0; n < 8; ++n) acc[m][n] = f32x4{0.f, 0.f, 0.f, 0.f};
#pragma unroll
    for (int ks = 0; ks < 4; ++ks) {
      const int sl = ((4 * ks + fq) ^ fr) << 4;
      bf16x8 a0 = *reinterpret_cast<const bf16x8*>(LA + (32 * wid + fr) * 256 + sl);
      bf16x8 a1 = *reinterpret_cast<const bf16x8*>(LA + (32 * wid + 16 + fr) * 256 + sl);
#pragma unroll
      for (int n = 0; n < 8; ++n) {
        bf16x8 bfr = *reinterpret_cast<const bf16x8*>(LB + (16 * n + fr) * 256 + sl);
        acc[0][n] = __builtin_amdgcn_mfma_f32_16x16x32_bf16(a0, bfr, acc[0][n], 0, 0, 0);
        acc[1][n] = __builtin_amdgcn_mfma_f32_16x16x32_bf16(a1, bfr, acc[1][n], 0, 0, 0);
      }
    }
    __syncthreads();
    {
      const float* bsg = p->gs_b_s + ((size_t)j * 8 + g) * 128;
#pragma unroll
      for (int m = 0; m < 2; ++m)
#pragma unroll
        for (int jj = 0; jj < 4; ++jj) {
          const int pp = 32 * wid + 16 * m + 4 * fq + jj;
          const float bias = bsg[pp];
#pragma unroll
          for (int n = 0; n < 8; ++n) {
            const int c = 16 * n + fr;
            float sv = nw[g * 128 + c] * acc[m][n][jj] + bias;
            *reinterpret_cast<bf16_t*>(LA + pp * 256 + (((c >> 3) ^ (pp & 15)) << 4) + (c & 7) * 2) = f2bf(sv);
          }
        }
    }
    __syncthreads();
#pragma unroll
    for (int i = 0; i < 8; ++i) {
      int idx = tid + 256 * i, row = idx >> 4, c = idx & 15;
      uint4 sv8 = *reinterpret_cast<const uint4*>(LA + row * 256 + ((c ^ (row & 15)) << 4));
      uint4 u8 = *reinterpret_cast<const uint4*>(p->P + (size_t)(tok0 + row) * 2048 + g * 128 + c * 8);
      uint4 o;
      o.x = pack2(bflo(u8.x) * bflo(sv8.x), bfhi(u8.x) * bfhi(sv8.x));
      o.y = pack2(bflo(u8.y) * bflo(sv8.y), bfhi(u8.y) * bfhi(sv8.y));
      o.z = pack2(bflo(u8.z) * bflo(sv8.z), bfhi(u8.z) * bfhi(sv8.z));
      o.w = pack2(bflo(u8.w) * bflo(sv8.w), bfhi(u8.w) * bfhi(sv8.w));
      *reinterpret_cast<uint4*>(p->mix + (size_t)(tok0 + row) * LDMIX + g * 128 + c * 8) = o;
    }
  }
  __syncthreads();
}

DEVI float mkkey(float v, unsigned idx, unsigned mask) { return __uint_as_float((__float_as_uint(v) & ~mask) | idx); }
#define INSERT16(list, x)                                                                                               \
  {                                                                                                                     \
    _Pragma("unroll") for (int i_ = 15; i_ >= 1; --i_) list[i_] = __builtin_amdgcn_fmed3f(list[i_ - 1], list[i_], x); \
    list[0] = fmaxf(list[0], x);                                                                                        \
  }

DEVI void phase_route(PP p, int layer, int ntok, unsigned char* lds) {
  const int tid = ltid();
  const int lane = tid & 63, wid = __builtin_amdgcn_readfirstlane(tid >> 6), fr = lane & 15, fq = lane >> 4;
  const int nb8 = lnblk() >> 3, bid = lbid();
  const int hh = bid & 7, slot = bid >> 3;
  const int ntiles = ntok / 64;
  const bool active = slot < nb8;
  float* sc = reinterpret_cast<float*>(lds + 32768);
  const float NEGK = -3.0e38f;
  for (int half = 0; half < 2; ++half) {
    __syncthreads();
    {
      const bf16_t* ksrc = p->keysb + ((size_t)((layer * 8 + hh) * 2 + half) * 128) * 128;
#pragma unroll
      for (int i = 0; i < 8; ++i) {
        int idx = tid + 256 * i, row = idx >> 4, c = idx & 15;
        uint4 v = *reinterpret_cast<const uint4*>(ksrc + (size_t)row * 128 + c * 8);
        *reinterpret_cast<uint4*>(lds + row * 256 + ((c ^ (row & 15)) << 4)) = v;
      }
    }
    __syncthreads();
    bf16x8 an[4];
    if (active && slot < ntiles) {
      const bf16_t* qa = p->P + (size_t)(slot * 64 + wid * 16 + fr) * 2048 + hh * 256 + half * 128 + fq * 8;
#pragma unroll
      for (int ks = 0; ks < 4; ++ks) an[ks] = *reinterpret_cast<const bf16x8*>(qa + ks * 32);
    }
    for (int tt = slot; active && tt < ntiles; tt += nb8) {
      const int tok0 = tt * 64;
      {
        bf16x8 a[4];
#pragma unroll
        for (int ks = 0; ks < 4; ++ks) a[ks] = an[ks];
        {
          const int ttn = (tt + nb8 < ntiles) ? tt + nb8 : tt;
          const bf16_t* qa = p->P + (size_t)(ttn * 64 + wid * 16 + fr) * 2048 + hh * 256 + half * 128 + fq * 8;
#pragma unroll
          for (int ks = 0; ks < 4; ++ks) an[ks] = *reinterpret_cast<const bf16x8*>(qa + ks * 32);
        }
#pragma unroll
        for (int nf = 0; nf < 8; ++nf) {
          f32x4 acc = f32x4{0.f, 0.f, 0.f, 0.f};
          const int krow = nf * 16 + fr;
#pragma unroll
          for (int ks = 0; ks < 4; ++ks) {
            bf16x8 bb = *reinterpret_cast<const bf16x8*>(lds + krow * 256 + (((4 * ks + fq) ^ (krow & 15)) << 4));
            acc = __builtin_amdgcn_mfma_f32_16x16x32_bf16(a[ks], bb, acc, 0, 0, 0);
          }
#pragma unroll
          for (int j = 0; j < 4; ++j) sc[(wid * 16 + fq * 4 + j) * 133 + krow + (krow >> 5)] = mkkey(acc[j], (unsigned)krow, 127u);
        }
      }
      const int prt = lane >> 4;
      float list[16];
#pragma unroll
      for (int i = 0; i < 16; ++i) list[i] = NEGK;
      {
        const float* kr = sc + (wid * 16 + fr) * 133 + prt * 33;
#pragma unroll 4
        for (int e = 0; e < 32; ++e) {
          float x = kr[e];
          INSERT16(list, x)
        }
      }
#pragma unroll 1
      for (int step = 16; step <= 32; step <<= 1) {
        float other[16];
#pragma unroll
        for (int i = 0; i < 16; ++i) other[i] = shx_f(list[i], step);
#pragma unroll
        for (int i = 0; i < 16; ++i) {
          float x = other[i];
          INSERT16(list, x)
        }
      }
      if (prt == 0) {
        float4* o = reinterpret_cast<float4*>(p->tops + ((size_t)(tok0 + wid * 16 + fr) * 16 + hh * 2 + half) * 16);
        o[0] = make_float4(list[0], list[1], list[2], list[3]);
        o[1] = make_float4(list[4], list[5], list[6], list[7]);
        o[2] = make_float4(list[8], list[9], list[10], list[11]);
        o[3] = make_float4(list[12], list[13], list[14], list[15]);
      }
    }
  }
  __syncthreads();
  float* fl = reinterpret_cast<float*>(lds);
  for (int t4 = slot; active && t4 < ntiles + 3 * nb8; t4 += 4 * nb8) {
    const int tt = t4 + (tid >> 6) * nb8;
    if (tt < ntiles) {
      const int tok = tt * 64 + (tid & 63);
      const float4* src = reinterpret_cast<const float4*>(p->tops + ((size_t)tok * 16 + hh * 2) * 16);
      float v0[16], v1[16];
#pragma unroll
      for (int i = 0; i < 4; ++i) {
        float4 a = src[i], bq = src[4 + i];
        v0[4 * i] = a.x; v0[4 * i + 1] = a.y; v0[4 * i + 2] = a.z; v0[4 * i + 3] = a.w;
        v1[4 * i] = bq.x; v1[4 * i + 1] = bq.y; v1[4 * i + 2] = bq.z; v1[4 * i + 3] = bq.w;
      }
      float* f0 = fl + tid * 33;
      float* f1 = f0 + 16;
#pragma unroll
      for (int i = 0; i < 16; ++i) {
        f0[i] = v0[i];
        f1[i] = v1[i];
      }
      float l2[16];
#pragma unroll
      for (int i = 0; i < 16; ++i) l2[i] = mkkey(v0[0] + v1[i], (unsigned)(15 - i), 255u);
#pragma unroll
      for (int a = 1; a < 16; ++a)
#pragma unroll
        for (int bq = 0; bq < 16; ++bq)
          if ((a + 1) * (bq + 1) <= 16) {
            float x = mkkey(v0[a] + v1[bq], (unsigned)(a * 16 + 15 - bq), 255u);
            INSERT16(l2, x)
          }
      float sv[16];
      int ev[16];
      float mx = NEGK;
#pragma unroll
      for (int k = 0; k < 16; ++k) {
        unsigned ab = __float_as_uint(l2[k]) & 255u;
        unsigned k0 = __float_as_uint(f0[ab >> 4]), k1 = __float_as_uint(f1[15u - (ab & 15u)]);
        sv[k] = __uint_as_float(k0 & ~127u) + __uint_as_float(k1 & ~127u);
        ev[k] = (int)((k0 & 127u) * 128u + (k1 & 127u));
        mx = fmaxf(mx, sv[k]);
      }
      float sum = 0.f;
#pragma unroll
      for (int k = 0; k < 16; ++k) {
        sv[k] = __expf(sv[k] - mx);
        sum += sv[k];
      }
      float inv = 1.f / sum;
      size_t o = (size_t)tok * 128 + hh * 16;
      int4* eo = reinterpret_cast<int4*>(p->eidx + o);
      float4* go = reinterpret_cast<float4*>(p->gate + o);
#pragma unroll
      for (int k4 = 0; k4 < 4; ++k4) {
        eo[k4] = make_int4(ev[4 * k4], ev[4 * k4 + 1], ev[4 * k4 + 2], ev[4 * k4 + 3]);
        go[k4] = make_float4(sv[4 * k4] * inv, sv[4 * k4 + 1] * inv, sv[4 * k4 + 2] * inv, sv[4 * k4 + 3] * inv);
      }
    }
  }
  __syncthreads();
}

typedef float v2f __attribute__((ext_vector_type(2)));
DEVI void dec16(uint4 q, v2f* f) {
  f[0] = __builtin_amdgcn_cvt_pk_f32_fp8((int)q.x, false);
  f[1] = __builtin_amdgcn_cvt_pk_f32_fp8((int)q.x, true);
  f[2] = __builtin_amdgcn_cvt_pk_f32_fp8((int)q.y, false);
  f[3] = __builtin_amdgcn_cvt_pk_f32_fp8((int)q.y, true);
  f[4] = __builtin_amdgcn_cvt_pk_f32_fp8((int)q.z, false);
  f[5] = __builtin_amdgcn_cvt_pk_f32_fp8((int)q.z, true);
  f[6] = __builtin_amdgcn_cvt_pk_f32_fp8((int)q.w, false);
  f[7] = __builtin_amdgcn_cvt_pk_f32_fp8((int)q.w, true);
}
struct ExpBuf {
  uint4 q[8];
  uint4 h0, h1;
};
DEVI void exp_load(ExpBuf& B, const unsigned char* tab, const signed char* hrow, const unsigned short* idp, int j8, bool want_x) {
  const uint4 idv = *reinterpret_cast<const uint4*>(idp);
  const unsigned idw[4] = {idv.x, idv.y, idv.z, idv.w};
#pragma unroll
  for (int i = 0; i < 8; ++i) {
    unsigned e = (i & 1) ? (idw[i >> 1] >> 16) : (idw[i >> 1] & 0xffffu);
    unsigned off = e * (unsigned)D + 16u * j8;
    B.q[i] = *reinterpret_cast<const uint4*>(tab + off);
  }
  if (want_x) B.h0 = *reinterpret_cast<const uint4*>(hrow + 16 * j8);
}
template <int CTRL>
DEVI int dpp_movi(int v) { return __builtin_amdgcn_mov_dpp(v, CTRL, 0xF, 0xF, true); }
DEVI void exp_u_compute(const ExpBuf& B, int* pp, int j8) {
  int s0 = 0;
#pragma unroll
  for (int i = 0; i < 8; ++i) {
    int d = __builtin_amdgcn_sdot4((int)B.q[i].x, (int)B.h0.x, 0, false);
    d = __builtin_amdgcn_sdot4((int)B.q[i].y, (int)B.h0.y, d, false);
    d = __builtin_amdgcn_sdot4((int)B.q[i].z, (int)B.h0.z, d, false);
    d = __builtin_amdgcn_sdot4((int)B.q[i].w, (int)B.h0.w, d, false);
    d += dpp_movi<0xB1>(d);
    d += dpp_movi<0x4E>(d);
    d += dpp_movi<0x141>(d);
    s0 = (j8 == i) ? d : s0;
  }
  pp[0] += s0;
}
DEVI void exp_v_accum(const ExpBuf& B, unsigned w0, unsigned w1, int* acc) {
#pragma unroll
  for (int ig = 0; ig < 2; ++ig) {
    const unsigned wq = ig ? w1 : w0;
    const uint4 R0 = B.q[4 * ig], R1 = B.q[4 * ig + 1], R2 = B.q[4 * ig + 2], R3 = B.q[4 * ig + 3];
    const unsigned r0[4] = {R0.x, R0.y, R0.z, R0.w}, r1[4] = {R1.x, R1.y, R1.z, R1.w};
    const unsigned r2[4] = {R2.x, R2.y, R2.z, R2.w}, r3[4] = {R3.x, R3.y, R3.z, R3.w};
#pragma unroll
    for (int q = 0; q < 4; ++q) {
      unsigned A = __builtin_amdgcn_perm(r1[q], r0[q], 0x05010400u);
      unsigned Bq = __builtin_amdgcn_perm(r1[q], r0[q], 0x07030602u);
      unsigned C = __builtin_amdgcn_perm(r3[q], r2[q], 0x05010400u);
      unsigned E = __builtin_amdgcn_perm(r3[q], r2[q], 0x07030602u);
      unsigned D0 = __builtin_amdgcn_perm(C, A, 0x05040100u);
      unsigned D1 = __builtin_amdgcn_perm(C, A, 0x07060302u);
      unsigned D2 = __builtin_amdgcn_perm(E, Bq, 0x05040100u);
      unsigned D3 = __builtin_amdgcn_perm(E, Bq, 0x07060302u);
      acc[4 * q + 0] = __builtin_amdgcn_sdot4((int)D0, (int)wq, acc[4 * q + 0], false);
      acc[4 * q + 1] = __builtin_amdgcn_sdot4((int)D1, (int)wq, acc[4 * q + 1], false);
      acc[4 * q + 2] = __builtin_amdgcn_sdot4((int)D2, (int)wq, acc[4 * q + 2], false);
      acc[4 * q + 3] = __builtin_amdgcn_sdot4((int)D3, (int)wq, acc[4 * q + 3], false);
    }
  }
}
DEVI void exp_v_finish(float4* xo, const float4* xq, const float4* gq, int* acc, float swt, int grp, float gscale) {
  float o[16];
#pragma unroll
  for (int k = 0; k < 16; ++k) {
    int a = acc[k];
    a += dpp_movi<0x128>(a);
    a += shx_i(a, 16);
    a += shx_i(a, 32);
    o[k] = (float)a;
    acc[k] = 0;
  }
  if (grp == 0) {
    const float sc = gscale * swt;
#pragma unroll
    for (int i4 = 0; i4 < 4; ++i4) {
      float4 r = xq[i4];
      r.x += sc * gq[i4].x * o[i4 * 4 + 0];
      r.y += sc * gq[i4].y * o[i4 * 4 + 1];
      r.z += sc * gq[i4].z * o[i4 * 4 + 2];
      r.w += sc * gq[i4].w * o[i4 * 4 + 3];
      xo[i4] = r;
    }
  }
}
DEVI void phase_expert(PP p, int layer, int ntok, unsigned char* lds, float gscale = 1.f, int idmask = 0xffff) {
  const int tid = ltid();
  const int lane = tid & 63, wid = __builtin_amdgcn_readfirstlane(tid >> 6), j8 = lane & 7, grp = lane >> 3;
  const int nb = lnblk(), bid = lbid();
  unsigned short* ids = reinterpret_cast<unsigned short*>(lds);
  float* part = reinterpret_cast<float*>(lds + TPB * 128 * 2);
  unsigned char* w8 = lds + TPB * 128 * 2 + TPB * 128 * 4;
  float* swl = reinterpret_cast<float*>(lds + TPB * 128 * 2 + TPB * 128 * 4 + TPB * 128);
  const unsigned char* ut = p->utab + (size_t)layer * NEXP * D;
  const unsigned char* vt = p->vtab + (size_t)layer * NEXP * D;
  int tpb = (ntok + nb - 1) / nb;
  if (tpb > TPB) tpb = TPB;
  const int npass = (ntok + nb * tpb - 1) / (nb * tpb);
  for (int pass = 0; pass < npass; ++pass) {
    const int tok0 = (pass * nb + bid) * tpb;
    int cnt = ntok - tok0;
    if (cnt > tpb) cnt = tpb;
    if (cnt < 0) cnt = 0;
    for (int i = tid; i < cnt * 128; i += NTHREADS) {
      {
        int k = i & 127, hf = k >> 6, kk = k & 63;
        ids[(i & ~127) + hf * 64 + (kk & 7) * 8 + (kk >> 3)] = (unsigned short)(p->eidx[(size_t)tok0 * 128 + i] & idmask);
      }
      part[i] = 0.f;
    }
    __syncthreads();
    const int ntw = (cnt - wid + 3) >> 2;
    const int npair = ntw * 8;

    if (!(REP_MODE == 1 && gscale != 1.f)) {
      ExpBuf B0, B1;
      int c0 = 0, k0 = 0;
      if (npair > 0) {
        const int t0 = wid;
        exp_load(B0, ut, p->h8 + (size_t)(tok0 + t0) * D, ids + t0 * 128 + grp * 8, j8, true);
      }
      for (int pr = 0; pr < npair; ++pr) {
        const int t0 = wid + 4 * k0;
        exp_load(B1, ut + 128 * c0, p->h8 + (size_t)(tok0 + t0) * D + 128 * c0, ids + t0 * 128 + 64 + grp * 8, j8, true);
        exp_u_compute(B0, reinterpret_cast<int*>(part) + t0 * 128 + 8 * j8 + grp, j8);
        int c1 = c0, k1 = k0;
        if (pr + 1 < npair) {
          k1 = k0 + 1;
          if (k1 == ntw) {
            k1 = 0;
            c1 = c0 + 1;
          }
        }
        {
          const int t1 = wid + 4 * k1;
          exp_load(B0, ut + 128 * c1, p->h8 + (size_t)(tok0 + t1) * D + 128 * c1, ids + t1 * 128 + grp * 8, j8, true);
        }
        exp_u_compute(B1, reinterpret_cast<int*>(part) + t0 * 128 + 64 + 8 * j8 + grp, j8);
        c0 = c1;
        k0 = k1;
      }
    }
    __syncthreads();
    for (int t = wid; t < cnt; t += 4) {
      float wv2[2];
      float am = 0.f;
#pragma unroll
      for (int hh = 0; hh < 2; ++hh) {
        int k = lane + 64 * hh;
        int e = ids[t * 128 + hh * 64 + (lane & 7) * 8 + (lane >> 3)];
        float dq = (float)reinterpret_cast<int*>(part)[t * 128 + k] * p->su[(size_t)layer * NEXP + e] * p->sx[tok0 + t];
        float wv = p->gate[(size_t)(tok0 + t) * 128 + k] * gelu_tanh(dq) * p->sv[(size_t)layer * NEXP + e];
        wv2[hh] = wv;
        am = fmaxf(am, fabsf(wv));
      }
      am = fmaxf(wave_max(am), 1e-30f);
      float qs = 127.f / am;
#pragma unroll
      for (int hh = 0; hh < 2; ++hh) {
        int k = lane + 64 * hh;
        int q = (int)rintf(wv2[hh] * qs);
        w8[t * 128 + (k & 7) * 16 + hh * 8 + ((k >> 3) & 7)] = (unsigned char)(q & 255);
      }
      if (lane == 0) swl[t] = am * (1.f / 127.f);
    }
    __syncthreads();
    if (!(REP_MODE == 2 && gscale != 1.f)) {
      ExpBuf B0, B1;
      int acc[16];
#pragma unroll
      for (int k = 0; k < 16; ++k) acc[k] = 0;
      int c0 = 0, k0 = 0;
      if (npair > 0) {
        const int t0 = wid;
        exp_load(B0, vt, (const signed char*)nullptr, ids + t0 * 128 + grp * 8, j8, false);
      }
      for (int pr = 0; pr < npair; ++pr) {
        const int t0 = wid + 4 * k0;
        float4 xq[4], gq[4];
        float4* xo = reinterpret_cast<float4*>(p->xs + (size_t)(tok0 + t0) * D + 128 * c0 + 16 * j8);
        {
          const float4* gf = reinterpret_cast<const float4*>(p->mod + ((size_t)layer * 9 + tok_batch(tok0 + t0)) * 6144 + 5 * 1024 + 128 * c0 + 16 * j8);
#pragma unroll
          for (int i4 = 0; i4 < 4; ++i4) {
            xq[i4] = xo[i4];
            gq[i4] = gf[i4];
          }
        }
        exp_load(B1, vt + 128 * c0, (const signed char*)nullptr, ids + t0 * 128 + 64 + grp * 8, j8, false);
        const uint4 wq = *reinterpret_cast<const uint4*>(w8 + t0 * 128 + grp * 16);
        exp_v_accum(B0, wq.x, wq.y, acc);
        int c1 = c0, k1 = k0;
        if (pr + 1 < npair) {
          k1 = k0 + 1;
          if (k1 == ntw) {
            k1 = 0;
            c1 = c0 + 1;
          }
        }
        {
          const int t1 = wid + 4 * k1;
          exp_load(B0, vt + 128 * c1, (const signed char*)nullptr, ids + t1 * 128 + grp * 8, j8, false);
        }
        exp_v_accum(B1, wq.z, wq.w, acc);
        exp_v_finish(xo, xq, gq, acc, swl[t0], grp, gscale);
        c0 = c1;
        k0 = k1;
      }
    }
    asm volatile("s_waitcnt vmcnt(0)" ::: "memory");
    __syncthreads();
    if (gscale == 1.f) {
      for (int t = wid; t < cnt; t += 4) {
        if (layer + 1 < DEPTH) norm_row(p, layer + 1, 0, tok0 + t, lane);
        else if (tok0 + t < TL) norm_row(p, 0, 2, tok0 + t, lane);
      }
    }
    __syncthreads();
  }
}

#define XB_TMO 128
#define XB_XCNT(j) (256 + 64 * (j))
#define XB_XSUB(j) (1280 + 64 * (j))
#define XB_XGEN(j) (2304 + 64 * (j))
#define XB_TOP 3328
#define XB_TOPGEN 3392
#define XCD_BAR_WORDS 3456
#define XB_SPIN_CAP (1u << 22)
#define LAS __attribute__((address_space(3)))
DEVI unsigned xb_ld(unsigned* p) { return __hip_atomic_load(p, __ATOMIC_RELAXED, __HIP_MEMORY_SCOPE_AGENT); }
DEVI unsigned xb_add(unsigned* p, unsigned v) { return __hip_atomic_fetch_add(p, v, __ATOMIC_RELAXED, __HIP_MEMORY_SCOPE_AGENT); }
DEVI unsigned xb_xcc_id() { return (unsigned)__builtin_amdgcn_s_getreg((3 << 11) | 20) & 0xFu; }
#define XB_SPIN(cond, bar)                                   \
  do {                                                       \
    unsigned _sp = 0;                                        \
    while (cond) {                                           \
      __builtin_amdgcn_s_sleep(1);                           \
      if ((++_sp & 255u) == 0u) {                            \
        if (xb_ld(&(bar)[XB_TMO])) break;                    \
        if (_sp > XB_SPIN_CAP) {                             \
          atomicAdd(&(bar)[XB_TMO], 1u);                     \
          break;                                             \
        }                                                    \
      }                                                      \
    }                                                        \
  } while (0)
struct XcdBarrier {
  unsigned* bar;
  unsigned x;
  volatile LAS unsigned* st;
};
DEVI XcdBarrier xcd_barrier_post(unsigned* bar, volatile LAS unsigned* st) {
  XcdBarrier b;
  b.bar = bar;
  b.x = xb_xcc_id();
  b.st = st;
  if (threadIdx.x == 0) (void)xb_add(&bar[XB_XCNT(b.x)], 1u);
  return b;
}
DEVI void xcd_barrier_complete(unsigned* bar, unsigned x, unsigned& nloc, unsigned& nx) {
  const unsigned G = gridDim.x * gridDim.y * gridDim.z;
  unsigned sum, cnt, mine, sp = 0u;
  for (;;) {
    sum = 0u;
    cnt = 0u;
    mine = 0u;
#pragma unroll
    for (unsigned j = 0; j < 16; ++j) {
      const unsigned c = xb_ld(&bar[XB_XCNT(j)]);
      sum += c;
      cnt += (c > 0u) ? 1u : 0u;
      mine = (j == x) ? c : mine;
    }
    if (sum == G) break;
    __builtin_amdgcn_s_sleep(1);
    if ((++sp & 255u) == 0u) {
      if (xb_ld(&bar[XB_TMO])) break;
      if (sp > XB_SPIN_CAP) {
        atomicAdd(&bar[XB_TMO], 1u);
        break;
      }
    }
  }
  nloc = mine > 0u ? mine : 1u;
  nx = cnt > 0u ? cnt : 1u;
}
DEVI void xcd_barrier(const XcdBarrier& b) {
  asm volatile("s_waitcnt vmcnt(0)" ::: "memory");
  __syncthreads();
  if (threadIdx.x == 0) {
    unsigned* bar = b.bar;
    __builtin_amdgcn_s_waitcnt(0);
    unsigned nloc = b.st[0], nx = b.st[1];
    if (nloc == 0u) {
      xcd_barrier_complete(bar, b.x, nloc, nx);
      b.st[0] = nloc;
      b.st[1] = nx;
    }
    const unsigned old = xb_add(&bar[XB_XSUB(b.x)], 1u);
    const unsigned gen = old / nloc;
    if (old + 1u == (gen + 1u) * nloc) {
      __builtin_amdgcn_fence(__ATOMIC_RELEASE, "agent");
      asm volatile("s_waitcnt vmcnt(0)" ::: "memory");
      const unsigned og = xb_add(&bar[XB_TOP], 1u);
      const unsigned tg = og / nx;
      if (og + 1u == (tg + 1u) * nx) xb_add(&bar[XB_TOPGEN], 1u);
      else XB_SPIN(xb_ld(&bar[XB_TOPGEN]) == tg, bar);
      __builtin_amdgcn_fence(__ATOMIC_ACQUIRE, "agent");
      xb_add(&bar[XB_XGEN(b.x)], 1u);
      asm volatile("s_waitcnt vmcnt(0)" ::: "memory");
    } else {
      XB_SPIN(xb_ld(&bar[XB_XGEN(b.x)]) == gen, bar);
      __builtin_amdgcn_fence(__ATOMIC_ACQUIRE, "agent");
      asm volatile("s_waitcnt vmcnt(0)" ::: "memory");
    }
  }
  __syncthreads();
}

DEVI bool step_active(int step) {
  if (step == 0) return true;
  if (step == NSTEPS - 1) return false;
  int layer = (step - 1) / STEPS_PER_LAYER, ph = (step - 1) % STEPS_PER_LAYER;
  if (ph == 3 && (layer & 1)) return false;
  if (ph == 0 && layer > 0) return false;
  return true;
}

DEVI void run_step(PP p, int step, unsigned char* lds, unsigned char* lds_all, float gscale = 1.f) {
  if (step == 0) {
    phase_prep(p, lds);
    return;
  }
  if (step == NSTEPS - 1) {
    phase_norm(p, 0, 2, TL);
    return;
  }
  int layer = (step - 1) / STEPS_PER_LAYER, ph = (step - 1) % STEPS_PER_LAYER;
  bool even = (layer & 1) == 0;
  int j = layer >> 1;
  bool upd_ctx = layer < 2;
  bool need_ctx = layer < 3;
  int nt_in = need_ctx ? TT : TL;
  int nt = upd_ctx ? TT : TL;
  switch (ph) {
    case 0: phase_norm(p, layer, 0, nt_in); break;
    case 1:
      if (even)
        gemm8_phase<EPI_INPROJ>(p, p->h, D, p->wt_in_ab + (size_t)j * 1280 * D, D, nt_in / 256, 5, D, layer, lds_all);
      else
        gemm8_phase<EPI_GELU>(p, p->h, D, p->wt_in_gs + (size_t)j * 2048 * D, D, nt / 256, 8, D, layer, lds_all);
      break;
    case 2:
      if (even) {
        phase_fft_a(p, lds);
        if (upd_ctx) phase_dft_ctx(p, lds);
        phase_attn(p, layer, upd_ctx, lds);
      } else {
        phase_sgu(p, j, nt / 128, lds);
      }
      break;
    case 3:
      if (even) phase_fft_b(p, lds);
      break;
    case 4:
      if (even)
      {
        if (gscale != 1.f) gemm_phase<EPI_RESID>(p, p->mix, LDMIX, p->wt_out_ab + (size_t)j * D * LDMIX, LDMIX, nt / 128, 8, LDMIX, layer, lds, gscale);
        else if (layer == 0) gemm8_phase<EPI_RESID0>(p, p->mix, LDMIX, p->wt_out_ab + (size_t)j * D * LDMIX, LDMIX, nt / 256, 4, LDMIX, layer, lds_all);
        else gemm8_phase<EPI_RESID>(p, p->mix, LDMIX, p->wt_out_ab + (size_t)j * D * LDMIX, LDMIX, nt / 256, 4, LDMIX, layer, lds_all);
      }
      else
      {
        if (gscale != 1.f) gemm_phase<EPI_RESID>(p, p->mix, LDMIX, p->wt_out_gs + (size_t)j * D * D, D, nt / 128, 8, D, layer, lds, gscale);
        else gemm8_phase<EPI_RESID>(p, p->mix, LDMIX, p->wt_out_gs + (size_t)j * D * D, D, nt / 256, 4, D, layer, lds_all);
      }
      break;
    case 5: phase_norm(p, layer, 1, nt); break;
    case 6: gemm8_phase<EPI_STORE>(p, p->h, D, p->wt_q + (size_t)layer * 2048 * D, D, nt / 256, 8, D, layer, lds_all); break;
    case 7: phase_route(p, layer, nt, lds); break;
    case 8: phase_expert(p, layer, nt, lds, gscale, (gscale == 1.f) ? 0xffff : REP_IDMASK); break;
  }
}

__global__ void __launch_bounds__(PHYS_THREADS, 2) mega(Params p_unused, int step_lo, int step_hi) {
  unsigned char* lds_all = g_lds;
  if ((threadIdx.x & 63) == 0) *reinterpret_cast<volatile int*>(g_lds + LDS_BYTES - 16 - 256 + 4 * hw_slot()) = (int)(threadIdx.x >> 6);
  __syncthreads();
  unsigned char* lds = lds_all + (wave_index() >> 2) * LDS_HALF;
  PP pp = (PP)__builtin_amdgcn_kernarg_segment_ptr();
  volatile LAS unsigned* st = (volatile LAS unsigned*)(lds_all + LDS_BYTES - 16);
  if (threadIdx.x == 0) {
    st[0] = 0u;
    st[1] = 0u;
  }
  __syncthreads();
  XcdBarrier xb = xcd_barrier_post(pp->bar, st);
  int nsync = 0;
  bool first = true;
  for (int s = step_lo; s < step_hi; ++s) {
    if (!step_active(s)) continue;
    if (!first) {
      if (nsync == 0) cg::this_grid().sync();
      else xcd_barrier(xb);
      ++nsync;
    }
    first = false;
    PP q = pp;
    asm volatile("" : "+s"(q));
    run_step(q, s, lds, lds_all);
#if REP_MASK
    if (s == 0 && ((REP_MASK >> 15) & 1)) {
      xcd_barrier(xb);
      PP q2 = pp;
      asm volatile("" : "+s"(q2));
      run_step(q2, 0, lds, lds_all);
    }
    if (s > 0 && s < NSTEPS - 1) {
      int lay_ = (s - 1) / STEPS_PER_LAYER, ph_ = (s - 1) % STEPS_PER_LAYER;
      bool rep_ = (REP_MASK >> ph_) & 1;
      if (ph_ == 2 && ((REP_MASK >> 9) & 1) && !(lay_ & 1)) rep_ = true;
      if (ph_ == 2 && ((REP_MASK >> 10) & 1) && (lay_ & 1)) rep_ = true;
      if (rep_) {
        xcd_barrier(xb);
        PP q2 = pp;
        asm volatile("" : "+s"(q2));
        float z = 0.f;
        asm volatile("" : "+s"(z));
        run_step(q2, s, lds, lds_all, z);
      }
      if (ph_ == 2 && ((REP_MASK >> 11) & 1) && !(lay_ & 1)) {
        xcd_barrier(xb);
        PP q2 = pp;
        asm volatile("" : "+s"(q2));
        phase_attn(q2, lay_, lay_ < 2, lds);
      }
    }
#endif
  }
}

static size_t align_up(size_t v) { return (v + 255) & ~(size_t)255; }

extern "C" void kernel_launch(void* const* d_in, const int* in_sizes, int n_in, void* d_out, int out_size, void* d_ws,
                              size_t ws_size, hipStream_t stream) {
  Params p{};
  p.x = (const float*)d_in[0];
  p.c = (const float*)d_in[1];
  p.ctx = (const float*)d_in[2];
  p.c_ctx = (const float*)d_in[3];
  p.ada_w = (const float*)d_in[4];
  p.ada_b = (const float*)d_in[5];
  p.norm_mix_w = (const float*)d_in[6];
  p.norm_ffn_w = (const float*)d_in[7];
  p.ab_w_in = (const float*)d_in[8];
  p.ab_w_out = (const float*)d_in[9];
  p.attn_sink = (const float*)d_in[10];
  p.gs_w_in = (const float*)d_in[11];
  p.gs_norm_w = (const float*)d_in[12];
  p.gs_w_s = (const float*)d_in[13];
  p.gs_b_s = (const float*)d_in[14];
  p.gs_w_out = (const float*)d_in[15];
  p.peer_w_q = (const float*)d_in[16];
  p.peer_keys = (const float*)d_in[17];
  p.peer_u = (const float*)d_in[18];
  p.peer_v = (const float*)d_in[19];
  p.norm_out_w = (const float*)d_in[20];
  p.out = (float*)d_out;
  unsigned char* w = (unsigned char*)d_ws;
  size_t off = 0;
  auto take = [&](size_t bytes) {
    unsigned char* r = w + off;
    off = align_up(off + bytes);
    return r;
  };
  p.bar = (unsigned*)take((size_t)XCD_BAR_WORDS * 4);
  p.mod = (float*)take((size_t)DEPTH * 9 * 6144 * 4);
  p.cs = (float2*)take(64 * 16 * 8);
  p.xs = (float*)take((size_t)TT * D * 4);
  p.h = (bf16_t*)take((size_t)TT * D * 2);
  p.P = (bf16_t*)take((size_t)TT * 2048 * 2);
  p.kbuf = (bf16_t*)take((size_t)NB * 2 * KVLEN * 64 * 2);
  p.vbuf = (bf16_t*)take((size_t)NB * 2 * KVLEN * 64 * 2);
  p.zvT = (bf16_t*)take((size_t)TT * 1024 * 2);
  p.rowss = (float*)take((size_t)(TT / 128) * 32 * 128 * 4);
  p.mix = (bf16_t*)take((size_t)TT * LDMIX * 2);
  p.fa = (bf16_t*)take((size_t)TL * 1024 * 2);
  p.tops = (float*)take((size_t)TT * 256 * 4);
  p.eidx = (int*)take((size_t)TT * 128 * 4);
  p.gate = (float*)take((size_t)TT * 128 * 4);
  p.wt_in_ab = (bf16_t*)take((size_t)2 * 1280 * D * 2);
  p.wt_out_ab = (bf16_t*)take((size_t)2 * D * LDMIX * 2);
  p.wt_in_gs = (bf16_t*)take((size_t)2 * 2048 * D * 2);
  p.wt_out_gs = (bf16_t*)take((size_t)2 * D * D * 2);
  p.wt_q = (bf16_t*)take((size_t)DEPTH * 2048 * D * 2);
  p.keysb = (bf16_t*)take((size_t)DEPTH * 8 * 2 * 128 * 128 * 2);
  p.su = (float*)take((size_t)DEPTH * NEXP * 4);
  p.sv = (float*)take((size_t)DEPTH * NEXP * 4);
  p.h8 = (signed char*)take((size_t)TT * D);
  p.sx = (float*)take((size_t)TT * 4);
  p.utab = (unsigned char*)take((size_t)DEPTH * NEXP * D);
  p.vtab = (unsigned char*)take((size_t)DEPTH * NEXP * D);
  if (off > ws_size) {
    fprintf(stderr, "workspace too small: need %zu have %zu\n", off, ws_size);
    return;
  }
  hipMemsetAsync(p.bar, 0, (size_t)XCD_BAR_WORDS * 4, stream);
  static int grid_blocks = 0;
  if (!grid_blocks) {
    int dev = 0, cus = 0, per_cu = 0;
    hipGetDevice(&dev);
    hipDeviceGetAttribute(&cus, hipDeviceAttributeMultiprocessorCount, dev);
    hipOccupancyMaxActiveBlocksPerMultiprocessor(&per_cu, mega, PHYS_THREADS, 0);
    if (per_cu > 1) per_cu = 1;
    if (per_cu < 1) per_cu = 1;
    grid_blocks = cus * per_cu;
  }
#if ONE_LAUNCH
  int lo = 0, hi = NSTEPS;
  void* args[] = {&p, &lo, &hi};
  hipError_t e = hipLaunchCooperativeKernel((void*)mega, dim3(grid_blocks), dim3(PHYS_THREADS), args, 0, stream);
  if (e != hipSuccess) fprintf(stderr, "cooperative launch failed: %s (grid %d)\n", hipGetErrorString(e), grid_blocks);
#else
  for (int s = 0; s < NSTEPS; ++s) {
    if (s != 0 && s != NSTEPS - 1) {
      int layer = (s - 1) / STEPS_PER_LAYER, ph = (s - 1) % STEPS_PER_LAYER;
      if (ph == 3 && (layer & 1)) continue;
    }
    hipLaunchKernelGGL(mega, dim3(grid_blocks), dim3(NTHREADS), 0, stream, p, s, s + 1);
  }
#endif
}
```

```cpp
#include <hip/hip_runtime.h>
#include <hip/hip_bf16.h>
#include <hip/hip_cooperative_groups.h>
#include <cstdio>
namespace cg = cooperative_groups;

#ifndef PROBE_PH
#define PROBE_PH 0
#endif
#ifndef REP_MASK
#define REP_MASK 0
#endif
#ifndef REP_MODE
#define REP_MODE 0
#endif
#ifndef REP_IDMASK
#define REP_IDMASK 0xffff
#endif
#ifndef ONE_LAUNCH
#define ONE_LAUNCH 1
#endif

#define DEVI __device__ __forceinline__
typedef unsigned short bf16_t;
using bf16x8 = __attribute__((ext_vector_type(8))) short;
using f32x4 = __attribute__((ext_vector_type(4))) float;
using f32x16 = __attribute__((ext_vector_type(16))) float;

constexpr int D = 1024, NB = 8, SEQ = 4096, CTX = 256, DEPTH = 4;
constexpr int TL = NB * SEQ, TC = NB * CTX, TT = TL + TC;
constexpr int KVLEN = CTX + SEQ;
constexpr int NEXP = 16384;
constexpr int LDMIX = 1536;
constexpr float USCALE = 64.f, VSCALE = 8.f;
constexpr int TPB = 68;
constexpr int LDS_HALF = 68 * 1024;
constexpr int LDS_BYTES = 2 * LDS_HALF;
constexpr int PHYS_THREADS = 512;
constexpr int NTHREADS = 256;
constexpr int STEPS_PER_LAYER = 9;
constexpr int NSTEPS = 1 + DEPTH * STEPS_PER_LAYER + 1;

struct Params {
  const float *x, *c, *ctx, *c_ctx, *ada_w, *ada_b, *norm_mix_w, *norm_ffn_w, *ab_w_in, *ab_w_out, *attn_sink,
      *gs_w_in, *gs_norm_w, *gs_w_s, *gs_b_s, *gs_w_out, *peer_w_q, *peer_keys, *peer_u, *peer_v, *norm_out_w;
  float* out;
  float* mod;
  float2* cs;
  float* xs;
  bf16_t* h;
  bf16_t* P;
  bf16_t* kbuf;
  bf16_t* vbuf;
  float* rowss;
  bf16_t* zvT;
  bf16_t* mix;
  bf16_t* fa;
  unsigned* bar;
  float* tops;
  int* eidx;
  float* gate;
  bf16_t *wt_in_ab, *wt_out_ab, *wt_in_gs, *wt_out_gs, *wt_q, *keysb;
  unsigned char *utab, *vtab;
  float* su;
  float* sv;
  signed char* h8;
  float* sx;
};

typedef const __attribute__((address_space(4))) Params* PP;

__shared__ __attribute__((aligned(16))) unsigned char g_lds[LDS_BYTES];
DEVI int hw_slot() {
  int h = (int)(__builtin_amdgcn_s_getreg((6 - 1) << 11 | 0 << 6 | 4) & 63u);
  asm volatile("" : "+s"(h));
  return h;
}
DEVI int wave_index() {
  int w = *reinterpret_cast<volatile int*>(g_lds + LDS_BYTES - 16 - 256 + 4 * hw_slot());
  return __builtin_amdgcn_readfirstlane(w);
}
DEVI int lane_id() { return (int)__builtin_amdgcn_mbcnt_hi(~0u, __builtin_amdgcn_mbcnt_lo(~0u, 0u)); }
DEVI int ltid() { int t = ((wave_index() & 3) << 6) | lane_id(); asm volatile("" : "+v"(t)); return t; }
DEVI int lbid() { int t = 2 * blockIdx.x + (wave_index() >> 2); asm volatile("" : "+s"(t)); return t; }
DEVI int lnblk() { int t = 2 * gridDim.x; asm volatile("" : "+s"(t)); return t; }
DEVI int ptid() { int t = (wave_index() << 6) | lane_id(); asm volatile("" : "+v"(t)); return t; }
DEVI int pbid() { int t = blockIdx.x; asm volatile("" : "+s"(t)); return t; }
DEVI int pnblk() { int t = gridDim.x; asm volatile("" : "+s"(t)); return t; }

typedef __bf16 bf2v_t __attribute__((ext_vector_type(2)));
typedef float f2v_t __attribute__((ext_vector_type(2)));
DEVI bf16_t f2bf(float f) { return __builtin_bit_cast(unsigned short, (__bf16)f); }
DEVI float bf2f(bf16_t h) { return __uint_as_float(((unsigned)h) << 16); }
DEVI float bflo(unsigned u) { return __uint_as_float(u << 16); }
DEVI float bfhi(unsigned u) { return __uint_as_float(u & 0xffff0000u); }
DEVI unsigned pack2(float a, float b) {
  f2v_t v = {a, b};
  return __builtin_bit_cast(unsigned, __builtin_convertvector(v, bf2v_t));
}
DEVI float gelu_tanh(float x) {
  const float k1 = -2.f * 0.7978845608028654f * 1.4426950408889634f;
  const float a = x * __builtin_fmaf(x * x, k1 * 0.044715f, k1);
  return x * __builtin_amdgcn_rcpf(1.f + __builtin_amdgcn_exp2f(a));
}
template <int CTRL>
DEVI float dpp_mov(float v) {
  return __builtin_bit_cast(float, __builtin_amdgcn_mov_dpp(__builtin_bit_cast(int, v), CTRL, 0xF, 0xF, true));
}
DEVI int shx_i(int v, int m) { return __builtin_amdgcn_ds_bpermute((lane_id() ^ m) << 2, v); }
DEVI float shx_f(float v, int m) { return __builtin_bit_cast(float, shx_i(__builtin_bit_cast(int, v), m)); }
DEVI float wave_sum(float v) {
  v += dpp_mov<0xB1>(v);
  v += dpp_mov<0x4E>(v);
  v += dpp_mov<0x141>(v);
  v += dpp_mov<0x140>(v);
  v += shx_f(v, 16);
  v += shx_f(v, 32);
  return v;
}
DEVI float wave_max(float v) {
  v = fmaxf(v, dpp_mov<0xB1>(v));
  v = fmaxf(v, dpp_mov<0x4E>(v));
  v = fmaxf(v, dpp_mov<0x141>(v));
  v = fmaxf(v, dpp_mov<0x140>(v));
  v = fmaxf(v, shx_f(v, 16));
  v = fmaxf(v, shx_f(v, 32));
  return v;
}
DEVI int tok_batch(int r) { return r < TL ? (r >> 12) : 8; }

DEVI void prep_transpose_tile(const float* __restrict__ src, int N, bf16_t* __restrict__ dst, int ldk, int tk, int tn, float* tile, int tid) {
#pragma unroll
  for (int i = 0; i < 16; ++i) {
    int r = (tid >> 6) + 4 * i;
    tile[r * 65 + (tid & 63)] = src[(size_t)(tk * 64 + r) * N + tn * 64 + (tid & 63)];
  }
  __syncthreads();
#pragma unroll
  for (int i = 0; i < 16; ++i) {
    int n = (tid >> 6) + 4 * i, k = tid & 63;
    dst[(size_t)(tn * 64 + n) * ldk + tk * 64 + k] = f2bf(tile[k * 65 + n]);
  }
}

constexpr int PU_ADA = DEPTH * 96;
constexpr int PU_T_ABIN = 2 * 16 * 20;
constexpr int PU_T_GSIN = 2 * 16 * 32;
constexpr int PU_T_GSOUT = 2 * 16 * 16;
constexpr int PU_T_ABOUT = 2 * 8 * 16;
constexpr int PU_T_Q = DEPTH * 16 * 32;
constexpr int PU_FOLD = 2 * 4 * 16 * 2;
constexpr int PU_CONV = DEPTH * NEXP * D / 4 / 2048;
constexpr int PU_KEYS = DEPTH * 8 * 2 * 128 * 128 / 4 / 2048;
constexpr int PU_UROWS = DEPTH * NEXP / 32;
constexpr int PU_TOTAL = PU_ADA + PU_T_ABIN + PU_T_GSIN + PU_T_GSOUT + PU_T_ABOUT + PU_T_Q + PU_FOLD + 2 * PU_UROWS + PU_KEYS + 1;

DEVI void phase_prep(PP p, unsigned char* lds) {
  const int tid = ltid();
  float* fl = reinterpret_cast<float*>(lds);
  for (int u0 = lbid(); u0 < PU_TOTAL; u0 += lnblk()) {
    int u = u0;
    if (u < PU_ADA) {
      float* sl = fl;
      for (int i = tid; i < 9 * 1024; i += NTHREADS) {
        int r = i >> 10, k = i & 1023;
        float v = (r < 8) ? p->c[r * 1024 + k] : p->c_ctx[k];
        sl[i] = v / (1.f + __expf(-v));
      }
      __syncthreads();
      float* red = sl + 9 * 1024;
      int ks = tid >> 6, col = tid & 63;
      int layer = u / 96, c0 = (u % 96) * 64;
      const float* w = p->ada_w + (size_t)layer * D * 6144 + c0 + col;
      float acc[9];
#pragma unroll
      for (int r = 0; r < 9; ++r) acc[r] = 0.f;
      for (int k0 = ks * 256; k0 < ks * 256 + 256; k0 += 16) {
        float wv[16];
#pragma unroll
        for (int kk = 0; kk < 16; ++kk) wv[kk] = w[(size_t)(k0 + kk) * 6144];
#pragma unroll
        for (int kk = 0; kk < 16; ++kk)
#pragma unroll
          for (int r = 0; r < 9; ++r) acc[r] += sl[r * 1024 + k0 + kk] * wv[kk];
      }
#pragma unroll
      for (int r = 0; r < 9; ++r) red[(ks * 9 + r) * 64 + col] = acc[r];
      __syncthreads();
      for (int i = tid; i < 9 * 64; i += NTHREADS) {
        int r = i >> 6, cc = i & 63;
        float sm = red[(0 * 9 + r) * 64 + cc] + red[(1 * 9 + r) * 64 + cc] + red[(2 * 9 + r) * 64 + cc] + red[(3 * 9 + r) * 64 + cc];
        sm += p->ada_b[(size_t)layer * 6144 + c0 + cc];
        p->mod[((size_t)layer * 9 + r) * 6144 + c0 + cc] = sm;
      }
      __syncthreads();
      continue;
    }
    u -= PU_ADA;
    if (u < PU_T_ABIN) {
      int j = u / 320, t = u % 320;
      prep_transpose_tile(p->ab_w_in + (size_t)j * D * 1280, 1280, p->wt_in_ab + (size_t)j * 1280 * D, D, t / 20, t % 20, fl, tid);
      __syncthreads();
      continue;
    }
    u -= PU_T_ABIN;
    if (u < PU_T_GSIN) {
      int j = u / 512, t = u % 512;
      prep_transpose_tile(p->gs_w_in + (size_t)j * D * 2048, 2048, p->wt_in_gs + (size_t)j * 2048 * D, D, t / 32, t % 32, fl, tid);
      __syncthreads();
      continue;
    }
    u -= PU_T_GSIN;
    if (u < PU_T_GSOUT) {
      int j = u / 256, t = u % 256;
      prep_transpose_tile(p->gs_w_out + (size_t)j * D * D, D, p->wt_out_gs + (size_t)j * D * D, D, t / 16, t % 16, fl, tid);
      __syncthreads();
      continue;
    }
    u -= PU_T_GSOUT;
    if (u < PU_T_ABOUT) {
      int j = u / 128, t = u % 128;
      prep_transpose_tile(p->ab_w_out + (size_t)j * D * D, D, p->wt_out_ab + (size_t)j * D * LDMIX, LDMIX, t / 16, t % 16, fl, tid);
      __syncthreads();
      continue;
    }
    u -= PU_T_ABOUT;
    if (u < PU_T_Q) {
      int i = u / 512, t = u % 512;
      prep_transpose_tile(p->peer_w_q + (size_t)i * D * 2048, 2048, p->wt_q + (size_t)i * 2048 * D, D, t / 32, t % 32, fl, tid);
      __syncthreads();
      continue;
    }
    u -= PU_T_Q;
    if (u < PU_FOLD) {
      const int mh = u & 1, nc = (u >> 1) & 15, g = (u >> 5) & 3, j = u >> 7;
      float2* tw = reinterpret_cast<float2*>(lds);
      float* wt = reinterpret_cast<float*>(lds + 1024);
      if (tid < 128) {
        float sn, cn;
        sincospif((float)tid / 64.f, &sn, &cn);
        tw[tid] = make_float2(cn, sn);
      }
      {
        const float* wsrc = p->ab_w_out + (size_t)j * D * D + (size_t)(512 + g * 128) * D + nc * 64;
#pragma unroll 8
        for (int i = 0; i < 32; ++i) {
          int l = (tid >> 6) + 4 * i;
          wt[l * 64 + (tid & 63)] = wsrc[(size_t)l * D + (tid & 63)];
        }
      }
      __syncthreads();
      const int n = tid & 63, mq = __builtin_amdgcn_readfirstlane(tid >> 6);
      bf16_t* dst = p->wt_out_ab + (size_t)j * D * LDMIX + (size_t)(nc * 64 + n) * LDMIX + g * 128;
#pragma unroll 1
      for (int mi = 0; mi < 16; ++mi) {
        const int m = mh * 64 + mq * 16 + mi;
        float ar = 0.f, ai = 0.f;
#pragma unroll 16
        for (int l = 0; l < 128; ++l) {
          float2 t = tw[(m * l) & 127];
          float wv = wt[l * 64 + n];
          ar += t.x * wv;
          ai += t.y * wv;
        }
        dst[512 + m] = f2bf(ar);
        dst[1024 + m] = f2bf(ai);
      }
      __syncthreads();
      continue;
    }
    u -= PU_FOLD;
    if (u < 2 * PU_UROWS) {
      const bool isv = u >= PU_UROWS;
      if (isv) u -= PU_UROWS;
      const float* src = isv ? p->peer_v : p->peer_u;
      unsigned char* dst = isv ? p->vtab : p->utab;
      float* sdst = isv ? p->sv : p->su;
      const int lane = tid & 63, wv = tid >> 6;
#pragma unroll 1
      for (int rr = 0; rr < 8; rr += 4) {
        size_t row0 = (size_t)u * 32 + wv * 8 + rr;
        float4 v[4][4];
#pragma unroll
        for (int k = 0; k < 4; ++k)
#pragma unroll
          for (int i = 0; i < 4; ++i) v[k][i] = reinterpret_cast<const float4*>(src + (row0 + k) * D)[lane * 4 + i];
#pragma unroll
        for (int k = 0; k < 4; ++k) {
          float am = 0.f;
#pragma unroll
          for (int i = 0; i < 4; ++i)
            am = fmaxf(am, fmaxf(fmaxf(fabsf(v[k][i].x), fabsf(v[k][i].y)), fmaxf(fabsf(v[k][i].z), fabsf(v[k][i].w))));
          am = wave_max(am);
          am = fmaxf(am, 1e-30f);
          float qs = 127.f / am;
          uint4 o;
          unsigned* op = reinterpret_cast<unsigned*>(&o);
#pragma unroll
          for (int i = 0; i < 4; ++i) {
            int q0 = (int)rintf(v[k][i].x * qs), q1 = (int)rintf(v[k][i].y * qs), q2 = (int)rintf(v[k][i].z * qs), q3 = (int)rintf(v[k][i].w * qs);
            op[i] = (unsigned)(q0 & 255) | ((unsigned)(q1 & 255) << 8) | ((unsigned)(q2 & 255) << 16) | ((unsigned)(q3 & 255) << 24);
          }
          reinterpret_cast<uint4*>(dst + (row0 + k) * D)[lane] = o;
          if (lane == 0) sdst[row0 + k] = am * (1.f / 127.f);
        }
      }
      continue;
    }
    u -= 2 * PU_UROWS;
    if (u < PU_KEYS) {
      const float4* s4 = reinterpret_cast<const float4*>(p->peer_keys) + (size_t)u * 2048 + tid;
      uint2* d2 = reinterpret_cast<uint2*>(p->keysb) + (size_t)u * 2048 + tid;
#pragma unroll
      for (int k = 0; k < 8; ++k) {
        float4 v = s4[k * 256];
        uint2 o;
        o.x = pack2(v.x, v.y);
        o.y = pack2(v.z, v.w);
        d2[k * 256] = o;
      }
      continue;
    }
    for (int i = tid; i < 64 * 16; i += NTHREADS) {
      int pos = i >> 4, k = i & 15;
      float inv = powf(10000.f, -(float)k / 16.f);
      float ang = (float)pos * inv;
      float sn, cn;
      sincosf(ang, &sn, &cn);
      p->cs[i] = make_float2(cn, sn);
    }
  }
}

DEVI void norm_row(PP p, int layer, int which, int tok, int lane) {
  const float* w = which == 0 ? p->norm_mix_w + layer * D : (which == 1 ? p->norm_ffn_w + layer * D : p->norm_out_w);
  const float* xsrc = p->xs + (size_t)tok * D;
  if (which == 0 && layer == 0) xsrc = (tok < TL) ? p->x + (size_t)tok * D : p->ctx + (size_t)(tok - TL) * D;
  const float4* xr = reinterpret_cast<const float4*>(xsrc);
  float4 v[4];
  float ss = 0.f;
#pragma unroll
  for (int i = 0; i < 4; ++i) {
    v[i] = xr[lane + 64 * i];
    ss += v[i].x * v[i].x + v[i].y * v[i].y + v[i].z * v[i].z + v[i].w * v[i].w;
  }
  ss = wave_sum(ss);
  float rstd = rsqrtf(ss * (1.f / 1024.f) + 1e-6f);
  if (which == 2) {
    float4* o = reinterpret_cast<float4*>(p->out + (size_t)tok * D);
#pragma unroll
    for (int i = 0; i < 4; ++i) {
      float4 wv = reinterpret_cast<const float4*>(w)[lane + 64 * i];
      float4 r;
      r.x = v[i].x * rstd * wv.x;
      r.y = v[i].y * rstd * wv.y;
      r.z = v[i].z * rstd * wv.z;
      r.w = v[i].w * rstd * wv.w;
      o[lane + 64 * i] = r;
    }
  } else {
    int b = tok_batch(tok);
    const float* mb = p->mod + ((size_t)layer * 9 + b) * 6144 + (which == 0 ? 0 : 3072);
    uint2* o = reinterpret_cast<uint2*>(p->h + (size_t)tok * D);
    float av[4][4];
    float am = 0.f;
#pragma unroll
    for (int i = 0; i < 4; ++i) {
      float4 wv = reinterpret_cast<const float4*>(w)[lane + 64 * i];
      float4 sh = reinterpret_cast<const float4*>(mb)[lane + 64 * i];
      float4 sc = reinterpret_cast<const float4*>(mb + 1024)[lane + 64 * i];
      float a0 = v[i].x * rstd * wv.x * (1.f + sc.x) + sh.x;
      float a1 = v[i].y * rstd * wv.y * (1.f + sc.y) + sh.y;
      float a2 = v[i].z * rstd * wv.z * (1.f + sc.z) + sh.z;
      float a3 = v[i].w * rstd * wv.w * (1.f + sc.w) + sh.w;
      uint2 r;
      r.x = pack2(a0, a1);
      r.y = pack2(a2, a3);
      o[lane + 64 * i] = r;
      av[i][0] = a0; av[i][1] = a1; av[i][2] = a2; av[i][3] = a3;
      am = fmaxf(am, fmaxf(fmaxf(fabsf(a0), fabsf(a1)), fmaxf(fabsf(a2), fabsf(a3))));
    }
    if (which == 1) {
      am = fmaxf(wave_max(am), 1e-30f);
      float qs = 127.f / am;
      unsigned* o8 = reinterpret_cast<unsigned*>(p->h8 + (size_t)tok * D);
#pragma unroll
      for (int i = 0; i < 4; ++i) {
        int q0 = (int)rintf(av[i][0] * qs), q1 = (int)rintf(av[i][1] * qs), q2 = (int)rintf(av[i][2] * qs), q3 = (int)rintf(av[i][3] * qs);
        o8[lane + 64 * i] = (unsigned)(q0 & 255) | ((unsigned)(q1 & 255) << 8) | ((unsigned)(q2 & 255) << 16) | ((unsigned)(q3 & 255) << 24);
      }
      if (lane == 0) p->sx[tok] = am * (1.f / 127.f);
    }
  }
}

DEVI void phase_norm(PP p, int layer, int which, int ntok) {
  int lane = ltid() & 63;
  int gw = lbid() * 4 + __builtin_amdgcn_readfirstlane(ltid() >> 6), nw = lnblk() * 4;
  for (int tok = gw; tok < ntok; tok += nw) norm_row(p, layer, which, tok, lane);
}

enum { EPI_STORE = 0, EPI_GELU = 1, EPI_RESID = 2, EPI_INPROJ = 3, EPI_RESID0 = 4 };

template <int EPI>
DEVI void gemm_phase(PP p, const bf16_t* __restrict__ A, int lda, const bf16_t* __restrict__ Bt, int ldb,
                     int Mtiles, int Ntiles, int K, int layer, unsigned char* lds, float gscale = 1.f, int big_t0 = -1, int big_n = 0,
                     int big_ntn = 1) {
  const int tid = ltid();
  const int wid = __builtin_amdgcn_readfirstlane(tid >> 6), lane = tid & 63, wr = wid >> 1, wc = wid & 1, fr = lane & 15, fq = lane >> 4;
  int nblk = lnblk();
  int bid = lbid();
  int lb = bid;
  {
    const int pn = nblk >> 1, pb = bid >> 1;
    if ((pn & 7) == 0) lb = 2 * ((pb & 7) * (pn >> 3) + (pb >> 3)) + (bid & 1);
  }
  int ntiles = (big_t0 >= 0) ? 4 * big_n : Mtiles * Ntiles;
  const int nk = K / 64;
  const int srow = tid >> 3;
  const int scol = ((tid & 7) ^ ((tid >> 3) & 7)) * 8;
#define GEMM_STAGE(ga_, gb_, kt_, buf_)                                                                               \
  {                                                                                                                   \
    _Pragma("unroll") for (int i_ = 0; i_ < 4; ++i_) {                                                                \
      __builtin_amdgcn_global_load_lds((const unsigned*)((ga_) + (size_t)(32 * i_) * lda + (kt_) * 64),               \
                                       (__attribute__((address_space(3))) unsigned*)(lds + (buf_) * 32768 + tid * 16 + i_ * 4096), 16, 0, 0); \
      __builtin_amdgcn_global_load_lds((const unsigned*)((gb_) + (size_t)(32 * i_) * ldb + (kt_) * 64),               \
                                       (__attribute__((address_space(3))) unsigned*)(lds + (buf_) * 32768 + 16384 + tid * 16 + i_ * 4096), 16, 0, 0); \
    }                                                                                                                 \
  }
  auto tile_rc = [&](int t, int& tm_, int& tn_) {
    if (big_t0 >= 0) {
      int bt = big_t0 + (t >> 2), q = t & 3;
      tm_ = 2 * (bt / big_ntn) + (q >> 1);
      tn_ = 2 * (bt % big_ntn) + (q & 1);
    } else {
      tm_ = t / Ntiles;
      tn_ = t % Ntiles;
    }
  };
  if (lb < ntiles) {
    int tm0, tn0;
    tile_rc(lb, tm0, tn0);
    const bf16_t* ga0 = A + (size_t)(tm0 * 128 + srow) * lda + scol;
    const bf16_t* gb0 = Bt + (size_t)(tn0 * 128 + srow) * ldb + scol;
    GEMM_STAGE(ga0, gb0, 0, 0)
  }
  for (int t = lb; t < ntiles; t += nblk) {
    int tm, tn;
    tile_rc(t, tm, tn);
    int brow = tm * 128, bcol = tn * 128;
    f32x4 acc[4][4];
#pragma unroll
    for (int m = 0; m < 4; ++m)
#pragma unroll
      for (int n = 0; n < 4; ++n) acc[m][n] = f32x4{0.f, 0.f, 0.f, 0.f};
    const bf16_t* ga = A + (size_t)(brow + srow) * lda + scol;
    const bf16_t* gb = Bt + (size_t)(bcol + srow) * ldb + scol;
    for (int kt = 0; kt < nk; ++kt) {
      const int buf = kt & 1;
      asm volatile("s_waitcnt vmcnt(0)" ::: "memory");
      __syncthreads();
      if (kt + 1 < nk) GEMM_STAGE(ga, gb, kt + 1, buf ^ 1)
      const unsigned char* SA = lds + buf * 32768;
      const unsigned char* SB = SA + 16384;
      bf16x8 At[2][4], Bl[2][4];
#pragma unroll
      for (int ks = 0; ks < 2; ++ks)
#pragma unroll
        for (int m = 0; m < 4; ++m) {
          const int sl = ((ks * 4 + fq) ^ (fr & 7)) << 4;
          At[ks][m] = *reinterpret_cast<const bf16x8*>(SA + (wr * 64 + m * 16 + fr) * 128 + sl);
          Bl[ks][m] = *reinterpret_cast<const bf16x8*>(SB + (wc * 64 + m * 16 + fr) * 128 + sl);
        }
#pragma unroll
      for (int ks = 0; ks < 2; ++ks)
#pragma unroll
        for (int m = 0; m < 4; ++m)
#pragma unroll
          for (int n = 0; n < 4; ++n)
            acc[m][n] = __builtin_amdgcn_mfma_f32_16x16x32_bf16(At[ks][m], Bl[ks][n], acc[m][n], 0, 0, 0);
    }
    {
      int t2 = t + nblk;
      if (t2 < ntiles) {
        int tm2, tn2;
        tile_rc(t2, tm2, tn2);
        const bf16_t* ga2 = A + (size_t)(tm2 * 128 + srow) * lda + scol;
        const bf16_t* gb2 = Bt + (size_t)(tn2 * 128 + srow) * ldb + scol;
        GEMM_STAGE(ga2, gb2, 0, 0)
      }
    }
    const int colbase = bcol + wc * 64;
    if constexpr (EPI == EPI_STORE || EPI == EPI_GELU) {
      if (EPI == EPI_GELU && colbase >= 1024) {
        float* rsp = p->rowss + ((size_t)tm * 32 + ((colbase - 1024) >> 5)) * 128;
#pragma unroll
        for (int m = 0; m < 4; ++m) {
          float ssq[4] = {0.f, 0.f, 0.f, 0.f};
#pragma unroll
          for (int n = 0; n < 4; ++n) {
            int ch = colbase - 1024 + n * 16 + fr;
            int q0 = wr * 64 + m * 16 + fq * 4;
            float g0 = gelu_tanh(acc[m][n][0]), g1 = gelu_tanh(acc[m][n][1]), g2 = gelu_tanh(acc[m][n][2]), g3 = gelu_tanh(acc[m][n][3]);
            ssq[0] += g0 * g0;
            ssq[1] += g1 * g1;
            ssq[2] += g2 * g2;
            ssq[3] += g3 * g3;
            uint2 o;
            o.x = pack2(g0, g1);
            o.y = pack2(g2, g3);
            *reinterpret_cast<uint2*>(p->zvT + ((size_t)tm * 1024 + ch) * 128 + q0) = o;
          }
#pragma unroll
          for (int j = 0; j < 4; ++j) {
            float v = ssq[j];
            v += dpp_mov<0xB1>(v);
            v += dpp_mov<0x4E>(v);
            v += dpp_mov<0x141>(v);
            v += dpp_mov<0x140>(v);
            if (fr == 0) {
              rsp[wr * 64 + m * 16 + fq * 4 + j] = v;
              rsp[128 + wr * 64 + m * 16 + fq * 4 + j] = 0.f;
            }
          }
        }
      } else {
#pragma unroll
        for (int m = 0; m < 4; ++m)
#pragma unroll
          for (int j = 0; j < 4; ++j) {
            int row = brow + wr * 64 + m * 16 + fq * 4 + j;
            bf16_t* o = p->P + (size_t)row * 2048 + colbase + fr;
#pragma unroll
            for (int n = 0; n < 4; ++n) {
              float v = acc[m][n][j];
              if (EPI == EPI_GELU) v = gelu_tanh(v);
              o[n * 16] = f2bf(v);
            }
          }
      }
    } else if constexpr (EPI == EPI_RESID) {
#pragma unroll
      for (int m = 0; m < 4; ++m)
#pragma unroll
        for (int j = 0; j < 4; ++j) {
          int row = brow + wr * 64 + m * 16 + fq * 4 + j;
          int b = tok_batch(row);
          const float* g = p->mod + ((size_t)layer * 9 + b) * 6144 + 2048 + colbase + fr;
          float* o = p->xs + (size_t)row * D + colbase + fr;
          const float* xi = o;
          if (layer == 0 && gscale == 1.f)
            xi = ((row < TL) ? p->x + (size_t)row * D : p->ctx + (size_t)(row - TL) * D) + colbase + fr;
#pragma unroll
          for (int n = 0; n < 4; ++n) o[n * 16] = xi[n * 16] + gscale * g[n * 16] * acc[m][n][j];
        }
    } else if constexpr (EPI == EPI_INPROJ) {
      if (colbase >= 640 && colbase < 768) {
        int kvh = (colbase - 640) >> 6;
#pragma unroll
        for (int m = 0; m < 4; ++m) {
          int row0 = brow + wr * 64 + m * 16;
          bool latent = row0 < TL;
          int b = latent ? (row0 >> 12) : ((row0 - TL) >> 8);
          int kp16 = latent ? (CTX + (row0 & 4095)) : ((row0 - TL) & 255);
          int slot = kp16 + 8 * (fq & 1) + 4 * (fq >> 1);
#pragma unroll
          for (int n = 0; n < 4; ++n) {
            int dim = n * 16 + fr;
            uint2 o;
            o.x = pack2(acc[m][n][0], acc[m][n][1]);
            o.y = pack2(acc[m][n][2], acc[m][n][3]);
            *reinterpret_cast<uint2*>(p->vbuf + ((size_t)(b * 2 + kvh) * 64 + dim) * KVLEN + slot) = o;
          }
        }
      } else {
#pragma unroll
        for (int m = 0; m < 4; ++m)
#pragma unroll
          for (int j = 0; j < 4; ++j) {
            int row = brow + wr * 64 + m * 16 + fq * 4 + j;
            bool latent = row < TL;
            int b, pos;
            if (latent) {
              b = row >> 12;
              pos = row & 4095;
            } else {
              b = (row - TL) >> 8;
              pos = (row - TL) & 255;
            }
            float v0 = acc[m][0][j], v1 = acc[m][1][j], v2 = acc[m][2][j], v3 = acc[m][3][j];
            if (latent && colbase < 640) {
              float2 cr = p->cs[(pos >> 6) * 16 + fr];
              float2 cc = p->cs[(pos & 63) * 16 + fr];
              float a = v0, bb = v1;
              v0 = a * cr.x - bb * cr.y;
              v1 = bb * cr.x + a * cr.y;
              a = v2;
              bb = v3;
              v2 = a * cc.x - bb * cc.y;
              v3 = bb * cc.x + a * cc.y;
            }
            bf16_t* o;
            if (colbase < 512 || colbase >= 768) {
              o = p->P + (size_t)row * 2048 + colbase + fr;
            } else {
              int kvh = (colbase - 512) >> 6;
              int kp = latent ? (CTX + pos) : pos;
              o = p->kbuf + ((size_t)(b * 2 + kvh) * KVLEN + kp) * 64 + fr;
            }
            o[0] = f2bf(v0);
            o[16] = f2bf(v1);
            o[32] = f2bf(v2);
            o[48] = f2bf(v3);
          }
      }
    }
  }
}

constexpr int G8_HT = 128 * 64;
DEVI int g8_lds_byte(int r, int c) {
  int st = (r >> 4) * 2 + (c >> 5), rr = r & 15, cc = c & 31, ob = rr * 64 + cc * 2;
  return st * 1024 + (ob ^ (((ob >> 9) & 1) << 5));
}
DEVI void g8_stage_rc(int b, int& R, int& C) {
  int st = b / 1024, sb = b % 1024, swz = sb ^ (((sb >> 9) & 1) << 5);
  R = (st >> 1) * 16 + swz / 64;
  C = (st & 1) * 32 + (swz % 64) / 2;
}
template <int EPI, bool STAGED>
DEVI void gemm8_epilogue(PP p, f32x4 (&acc)[2][2][4][2], const f32x4* stg, int lane, int brow, int bcol, int wr, int wc, int fr, int fq, int layer, float gscale) {
#pragma unroll
  for (int ai_ = 0; ai_ < 2; ++ai_)
#pragma unroll
    for (int bj = 0; bj < 2; ++bj) {
      const int ai = STAGED ? 1 - ai_ : ai_;
      f32x4 q[4][2];
#pragma unroll
      for (int m = 0; m < 4; ++m)
#pragma unroll
        for (int n = 0; n < 2; ++n) q[m][n] = (STAGED && ai == 0) ? stg[(((bj * 4 + m) * 2 + n) * 64) + lane] : acc[ai][bj][m][n];
      const int r0 = brow + ai * 128 + wr * 64;
      const int c0 = bcol + bj * 128 + wc * 32;
      if constexpr (EPI == EPI_STORE) {
#pragma unroll
        for (int m = 0; m < 4; ++m)
#pragma unroll
          for (int j = 0; j < 4; ++j) {
            bf16_t* o = p->P + (size_t)(r0 + m * 16 + fq * 4 + j) * 2048 + c0 + fr;
            o[0] = f2bf(q[m][0][j]);
            o[16] = f2bf(q[m][1][j]);
          }
      } else if constexpr (EPI == EPI_GELU) {
        if (c0 >= 1024) {
          const int chunk = r0 >> 7;
          float* rsp = p->rowss + ((size_t)chunk * 32 + ((c0 - 1024) >> 5)) * 128;
#pragma unroll
          for (int m = 0; m < 4; ++m) {
            float ssq[4] = {0.f, 0.f, 0.f, 0.f};
            const int q0 = (r0 & 127) + m * 16 + fq * 4;
#pragma unroll
            for (int n = 0; n < 2; ++n) {
              int ch = c0 - 1024 + n * 16 + fr;
              float g0 = gelu_tanh(q[m][n][0]), g1 = gelu_tanh(q[m][n][1]);
              float g2 = gelu_tanh(q[m][n][2]), g3 = gelu_tanh(q[m][n][3]);
              ssq[0] += g0 * g0;
              ssq[1] += g1 * g1;
              ssq[2] += g2 * g2;
              ssq[3] += g3 * g3;
              uint2 o;
              o.x = pack2(g0, g1);
              o.y = pack2(g2, g3);
              *reinterpret_cast<uint2*>(p->zvT + ((size_t)chunk * 1024 + ch) * 128 + q0) = o;
            }
#pragma unroll
            for (int j = 0; j < 4; ++j) {
              float v = ssq[j];
              v += dpp_mov<0xB1>(v);
              v += dpp_mov<0x4E>(v);
              v += dpp_mov<0x141>(v);
              v += dpp_mov<0x140>(v);
              if (fr == 0) rsp[q0 + j] = v;
            }
          }
        } else {
#pragma unroll
          for (int m = 0; m < 4; ++m)
#pragma unroll
            for (int j = 0; j < 4; ++j) {
              bf16_t* o = p->P + (size_t)(r0 + m * 16 + fq * 4 + j) * 2048 + c0 + fr;
              o[0] = f2bf(gelu_tanh(q[m][0][j]));
              o[16] = f2bf(gelu_tanh(q[m][1][j]));
            }
        }
      } else if constexpr (EPI == EPI_RESID || EPI == EPI_RESID0) {
        const float* g = p->mod + ((size_t)layer * 9 + tok_batch(brow)) * 6144 + 2048 + c0 + fr;
        const float g0 = g[0], g1 = g[16];
        const float* xin = (brow < TL) ? p->x : p->ctx - (size_t)TL * D;
#pragma unroll
        for (int m = 0; m < 4; ++m)
#pragma unroll
          for (int j = 0; j < 4; ++j) {
            const size_t ro = (size_t)(r0 + m * 16 + fq * 4 + j) * D + c0 + fr;
            float* o = p->xs + ro;
            const float* xi = (EPI == EPI_RESID0) ? xin + ro : o;
            o[0] = xi[0] + g0 * q[m][0][j];
            o[16] = xi[16] + g1 * q[m][1][j];
          }
      } else if constexpr (EPI == EPI_INPROJ) {
        if (c0 >= 640 && c0 < 768) {
          const int kvh = (c0 - 640) >> 6, d0 = (c0 - 640) & 63;
#pragma unroll
          for (int m = 0; m < 4; ++m) {
            int row0 = r0 + m * 16;
            bool latent = row0 < TL;
            int b = latent ? (row0 >> 12) : ((row0 - TL) >> 8);
            int kp16 = latent ? (CTX + (row0 & 4095)) : ((row0 - TL) & 255);
            int slot = kp16 + 8 * (fq & 1) + 4 * (fq >> 1);
#pragma unroll
            for (int n = 0; n < 2; ++n) {
              int dim = d0 + n * 16 + fr;
              uint2 o;
              o.x = pack2(q[m][n][0], q[m][n][1]);
              o.y = pack2(q[m][n][2], q[m][n][3]);
              *reinterpret_cast<uint2*>(p->vbuf + ((size_t)(b * 2 + kvh) * 64 + dim) * KVLEN + slot) = o;
            }
          }
        } else {
          const int hsel = (c0 >> 5) & 1;
#pragma unroll
          for (int m = 0; m < 4; ++m)
#pragma unroll
            for (int j = 0; j < 4; ++j) {
              int row = r0 + m * 16 + fq * 4 + j;
              bool latent = row < TL;
              int b, pos;
              if (latent) {
                b = row >> 12;
                pos = row & 4095;
              } else {
                b = (row - TL) >> 8;
                pos = (row - TL) & 255;
              }
              float v0 = q[m][0][j], v1 = q[m][1][j];
              if (latent && c0 < 640) {
                float2 cs = p->cs[(hsel ? (pos & 63) : (pos >> 6)) * 16 + fr];
                float a = v0, bb = v1;
                v0 = a * cs.x - bb * cs.y;
                v1 = bb * cs.x + a * cs.y;
              }
              bf16_t* o;
              if (c0 < 512 || c0 >= 768) {
                o = p->P + (size_t)row * 2048 + c0 + fr;
              } else {
                int kvh = (c0 - 512) >> 6, d0 = (c0 - 512) & 63;
                int kp = latent ? (CTX + pos) : pos;
                o = p->kbuf + ((size_t)(b * 2 + kvh) * KVLEN + kp) * 64 + d0 + fr;
              }
              o[0] = f2bf(v0);
              o[16] = f2bf(v1);
            }
        }
      }
      __builtin_amdgcn_sched_barrier(0);
    }
}

DEVI int g8_perm32(int rho) { const int n = rho >> 4, i = rho & 15; return 8 * (i >> 2) + 4 * n + (i & 3); }
template <int EPI>
DEVI void gemm8_epilogue_tr(PP p, f32x4 (&acc)[2][2][4][2], int brow, int bcol, int wr, int wc, int fr, int fq, int layer, float gscale) {
  if constexpr (EPI == EPI_STORE) {
#pragma unroll
    for (int ai = 0; ai < 2; ++ai)
#pragma unroll
      for (int m = 0; m < 4; ++m) {
        bf16_t* o = p->P + (size_t)(brow + ai * 128 + wr * 64 + m * 16 + fr) * 2048 + bcol + wc * 32 + 8 * fq;
#pragma unroll
        for (int bj = 0; bj < 2; ++bj) {
          const f32x4 v0 = acc[ai][bj][m][0], v1 = acc[ai][bj][m][1];
          uint4 w;
          w.x = pack2(v0[0], v0[1]);
          w.y = pack2(v0[2], v0[3]);
          w.z = pack2(v1[0], v1[1]);
          w.w = pack2(v1[2], v1[3]);
          *reinterpret_cast<uint4*>(o + bj * 128) = w;
        }
      }
  } else if constexpr (EPI == EPI_RESID || EPI == EPI_RESID0) {
    const float* xin = (brow < TL) ? p->x : p->ctx - (size_t)TL * D;
#pragma unroll
    for (int bj = 0; bj < 2; ++bj) {
      const int c0 = bcol + bj * 128 + wc * 32 + 4 * fq;
      const float* g = p->mod + ((size_t)layer * 9 + tok_batch(brow)) * 6144 + 2048 + c0;
      const f32x4 g0 = *reinterpret_cast<const f32x4*>(g) * gscale, g1 = *reinterpret_cast<const f32x4*>(g + 16) * gscale;
      f32x4 xr[2][4][2];
#pragma unroll
      for (int ai = 0; ai < 2; ++ai)
#pragma unroll
        for (int m = 0; m < 4; ++m) {
          const size_t ro = (size_t)(brow + ai * 128 + wr * 64 + m * 16 + fr) * D + c0;
          const float* xi = (EPI == EPI_RESID0) ? xin + ro : p->xs + ro;
          xr[ai][m][0] = *reinterpret_cast<const f32x4*>(xi);
          xr[ai][m][1] = *reinterpret_cast<const f32x4*>(xi + 16);
        }
      __builtin_amdgcn_sched_barrier(0);
#pragma unroll
      for (int ai = 0; ai < 2; ++ai)
#pragma unroll
        for (int m = 0; m < 4; ++m) {
          float* o = p->xs + (size_t)(brow + ai * 128 + wr * 64 + m * 16 + fr) * D + c0;
          *reinterpret_cast<f32x4*>(o) = xr[ai][m][0] + g0 * acc[ai][bj][m][0];
          *reinterpret_cast<f32x4*>(o + 16) = xr[ai][m][1] + g1 * acc[ai][bj][m][1];
        }
      __builtin_amdgcn_sched_barrier(0);
    }
  } else if constexpr (EPI == EPI_INPROJ) {
    const bool latent = brow < TL;
#pragma unroll
    for (int bj = 0; bj < 2; ++bj) {
      const int c0 = bcol + bj * 128 + wc * 32;
      if (c0 >= 640 && c0 < 768) {
        const int kvh = (c0 - 640) >> 6, d0 = ((c0 - 640) & 63) + 4 * fq;
        const int so = 8 * ((fr >> 2) & 1) + 4 * (fr >> 3) + (fr & 3);
#pragma unroll
        for (int ai = 0; ai < 2; ++ai)
#pragma unroll
          for (int m = 0; m < 4; ++m) {
            const int row0 = brow + ai * 128 + wr * 64 + m * 16;
            const int b = latent ? (row0 >> 12) : ((row0 - TL) >> 8);
            const int kp16 = latent ? (CTX + (row0 & 4095)) : ((row0 - TL) & 255);
            bf16_t* o = p->vbuf + ((size_t)(b * 2 + kvh) * 64 + d0) * KVLEN + kp16 + so;
#pragma unroll
            for (int n = 0; n < 2; ++n)
#pragma unroll
              for (int j = 0; j < 4; ++j) o[(size_t)(n * 16 + j) * KVLEN] = f2bf(acc[ai][bj][m][n][j]);
          }
      } else {
        const int hsel = (c0 >> 5) & 1;
#pragma unroll
        for (int ai = 0; ai < 2; ++ai)
#pragma unroll
          for (int m = 0; m < 4; ++m) {
            const int row = brow + ai * 128 + wr * 64 + m * 16 + fr;
            const int b = latent ? (row >> 12) : ((row - TL) >> 8);
            const int pos = latent ? (row & 4095) : ((row - TL) & 255);
            f32x4 v0 = acc[ai][bj][m][0], v1 = acc[ai][bj][m][1];
            if (latent && c0 < 640) {
              const f32x4* cp = reinterpret_cast<const f32x4*>(p->cs + (hsel ? (pos & 63) : (pos >> 6)) * 16 + 4 * fq);
              const f32x4 ca = cp[0], cb = cp[1];
              const f32x4 a = v0, bb = v1;
              v0[0] = a[0] * ca[0] - bb[0] * ca[1];
              v1[0] = bb[0] * ca[0] + a[0] * ca[1];
              v0[1] = a[1] * ca[2] - bb[1] * ca[3];
              v1[1] = bb[1] * ca[2] + a[1] * ca[3];
              v0[2] = a[2] * cb[0] - bb[2] * cb[1];
              v1[2] = bb[2] * cb[0] + a[2] * cb[1];
              v0[3] = a[3] * cb[2] - bb[3] * cb[3];
              v1[3] = bb[3] * cb[2] + a[3] * cb[3];
            }
            bf16_t* o;
            if (c0 < 512 || c0 >= 768) {
              o = p->P + (size_t)row * 2048 + c0 + 4 * fq;
            } else {
              const int kvh = (c0 - 512) >> 6, d0 = (c0 - 512) & 63;
              const int kp = latent ? (CTX + pos) : pos;
              o = p->kbuf + ((size_t)(b * 2 + kvh) * KVLEN + kp) * 64 + d0 + 4 * fq;
            }
            uint2 w0, w1;
            w0.x = pack2(v0[0], v0[1]);
            w0.y = pack2(v0[2], v0[3]);
            w1.x = pack2(v1[0], v1[1]);
            w1.y = pack2(v1[2], v1[3]);
            *reinterpret_cast<uint2*>(o) = w0;
            *reinterpret_cast<uint2*>(o + 16) = w1;
          }
      }
      __builtin_amdgcn_sched_barrier(0);
    }
  }
}

template <int EPI>
DEVI void gemm8_phase(PP p, const bf16_t* __restrict__ A, int lda, const bf16_t* __restrict__ Bt, int ldb, int Mtiles, int Ntiles,
                      int K, int layer, unsigned char* lds_all, float gscale = 1.f) {
  constexpr bool TR = (EPI != EPI_GELU);
  constexpr bool PERM = (EPI == EPI_STORE);
  bf16_t* shm = reinterpret_cast<bf16_t*>(lds_all);
  const int tid = ptid();
  const int wid = __builtin_amdgcn_readfirstlane(tid >> 6), lane = tid & 63, wr = wid >> 2, wc = wid & 3, fr = lane & 15, fq = lane >> 4;
#define G8_SA(b, h) (shm + ((b) * 2 + (h)) * G8_HT)
#define G8_SB(b, h) (shm + (4 + (b) * 2 + (h)) * G8_HT)
  const __amdgpu_buffer_rsrc_t rsA = __builtin_amdgcn_make_buffer_rsrc((void*)A, (short)0, -1, 0x00020000);
  const __amdgpu_buffer_rsrc_t rsB = __builtin_amdgcn_make_buffer_rsrc((void*)Bt, (short)0, -1, 0x00020000);
  unsigned voA[2], voB[2];
#pragma unroll
  for (int i = 0; i < 2; ++i) {
    int r_, c_;
    g8_stage_rc(tid * 16 + i * 8192, r_, c_);
    const int rb_ = PERM ? ((r_ & ~31) + g8_perm32(r_ & 31)) : r_;
    voA[i] = (unsigned)((r_ * lda + c_) * 2);
    voB[i] = (unsigned)((rb_ * ldb + c_) * 2);
  }
#define G8_STAGE(P_, RS_, VO_, ld_, br_, kt_)                                                                         \
  do {                                                                                                                \
    const unsigned so_ = (unsigned)(((br_) * (ld_) + (kt_) * 64) * 2);                                                \
    _Pragma("unroll") for (int i_ = 0; i_ < 2; ++i_)                                                                  \
      __builtin_amdgcn_raw_ptr_buffer_load_lds(RS_, (__attribute__((address_space(3))) void*)((unsigned char*)(P_) + wid * 1024 + i_ * 8192), 16, VO_[i_], so_, 0, 0); \
  } while (0)
#define G8_LDA(dst, b, h)                                                                                             \
  _Pragma("unroll") for (int m_ = 0; m_ < 4; ++m_) _Pragma("unroll") for (int k_ = 0; k_ < 2; ++k_)                   \
      dst[m_][k_] = *reinterpret_cast<const bf16x8*>((const unsigned char*)G8_SA(b, h) + g8_lds_byte(wr * 64 + m_ * 16 + fr, k_ * 32 + fq * 8))
#define G8_LDB(dst, b, h)                                                                                             \
  _Pragma("unroll") for (int n_ = 0; n_ < 2; ++n_) _Pragma("unroll") for (int k_ = 0; k_ < 2; ++k_)                   \
      dst[n_][k_] = *reinterpret_cast<const bf16x8*>((const unsigned char*)G8_SB(b, h) + g8_lds_byte(wc * 32 + n_ * 16 + fr, k_ * 32 + fq * 8))
#define G8_MMA(ai, bj, At_, Bt_)                                                                                      \
  do {                                                                                                                \
    __builtin_amdgcn_s_setprio(1);                                                                                    \
    _Pragma("unroll") for (int m_ = 0; m_ < 4; ++m_) _Pragma("unroll") for (int n_ = 0; n_ < 2; ++n_)                 \
        _Pragma("unroll") for (int k_ = 0; k_ < 2; ++k_) acc[ai][bj][m_][n_] =                                        \
            TR ? __builtin_amdgcn_mfma_f32_16x16x32_bf16(Bt_[n_][k_], At_[m_][k_], acc[ai][bj][m_][n_], 0, 0, 0)      \
               : __builtin_amdgcn_mfma_f32_16x16x32_bf16(At_[m_][k_], Bt_[n_][k_], acc[ai][bj][m_][n_], 0, 0, 0);     \
    __builtin_amdgcn_s_setprio(0);                                                                                    \
  } while (0)
#define G8_WAIT_V(n) asm volatile("s_waitcnt vmcnt(" #n ")" ::: "memory")
#define G8_WAIT_L(n) asm volatile("s_waitcnt lgkmcnt(" #n ")" ::: "memory")
#define G8_BAR __builtin_amdgcn_s_barrier()
#define G8_SCHED __builtin_amdgcn_sched_barrier(0)
  const int nblk = pnblk(), bid = pbid();
  const int lb = ((nblk & 7) == 0) ? ((bid & 7) * (nblk >> 3) + (bid >> 3)) : bid;
  const int ntiles_all = Mtiles * Ntiles;
  const int ntiles = (ntiles_all / nblk) * nblk;
  const int nt = K / 64;
  if (lb < ntiles) {
    int t = lb;
    int brow = (t / Ntiles) * 256, bcol = (t % Ntiles) * 256;
    f32x4 acc[2][2][4][2];
#pragma unroll
    for (int a0 = 0; a0 < 2; ++a0)
#pragma unroll
      for (int b0 = 0; b0 < 2; ++b0)
#pragma unroll
        for (int m = 0; m < 4; ++m)
#pragma unroll
          for (int n = 0; n < 2; ++n) acc[a0][b0][m][n] = f32x4{0.f, 0.f, 0.f, 0.f};
    bf16x8 At[4][2], B0[2][2], B1[2][2];
    G8_STAGE(G8_SB(0, 0), rsB, voB, ldb, bcol, 0);
    G8_STAGE(G8_SA(0, 0), rsA, voA, lda, brow, 0);
    G8_STAGE(G8_SB(0, 1), rsB, voB, ldb, bcol + 128, 0);
    G8_STAGE(G8_SA(0, 1), rsA, voA, lda, brow + 128, 0);
    if (wr == 1) G8_BAR;
    G8_WAIT_V(4);
    G8_BAR;
    G8_STAGE(G8_SB(1, 0), rsB, voB, ldb, bcol, 1);
    G8_STAGE(G8_SA(1, 0), rsA, voA, lda, brow, 1);
    G8_STAGE(G8_SB(1, 1), rsB, voB, ldb, bcol + 128, 1);
    G8_WAIT_V(6);
    G8_BAR;
    for (;;) {
      const int tnx = t + nblk;
      const bool has_next = tnx < ntiles;
      const int nbrow = has_next ? (tnx / Ntiles) * 256 : brow, nbcol = has_next ? (tnx % Ntiles) * 256 : bcol;
      for (int kt = 0; kt < nt; kt += 2) {
        const bool last = (kt == nt - 2);
        const int a2 = last ? nbrow : brow, b2 = last ? nbcol : bcol, k2 = last ? 0 : kt + 2;
        G8_LDB(B0, 0, 0); G8_SCHED; G8_LDA(At, 0, 0); G8_STAGE(G8_SA(1, 1), rsA, voA, lda, brow + 128, kt + 1);
        G8_WAIT_L(8); G8_BAR; G8_WAIT_L(0); G8_MMA(0, 0, At, B0); G8_BAR; G8_SCHED;
        G8_LDB(B1, 0, 1); G8_STAGE(G8_SB(0, 0), rsB, voB, ldb, b2, k2);
        G8_BAR; G8_WAIT_L(0); G8_MMA(0, 1, At, B1); G8_BAR;
        G8_LDA(At, 0, 1); G8_STAGE(G8_SA(0, 0), rsA, voA, lda, a2, k2);
        G8_BAR; G8_WAIT_L(0); G8_MMA(1, 0, At, B0); G8_BAR; G8_SCHED;
        G8_STAGE(G8_SB(0, 1), rsB, voB, ldb, b2 + 128, k2);
        G8_WAIT_V(6); G8_BAR; G8_MMA(1, 1, At, B1); G8_BAR;
        G8_LDB(B0, 1, 0); G8_SCHED; G8_LDA(At, 1, 0); G8_STAGE(G8_SA(0, 1), rsA, voA, lda, a2 + 128, k2);
        G8_WAIT_L(8); G8_BAR; G8_WAIT_L(0); G8_MMA(0, 0, At, B0); G8_BAR; G8_SCHED;
        G8_LDB(B1, 1, 1); G8_STAGE(G8_SB(1, 0), rsB, voB, ldb, b2, k2 + 1);
        G8_BAR; G8_WAIT_L(0); G8_MMA(0, 1, At, B1); G8_BAR;
        G8_LDA(At, 1, 1); G8_STAGE(G8_SA(1, 0), rsA, voA, lda, a2, k2 + 1);
        G8_BAR; G8_WAIT_L(0); G8_MMA(1, 0, At, B0); G8_BAR; G8_SCHED;
        G8_STAGE(G8_SB(1, 1), rsB, voB, ldb, b2 + 128, k2 + 1);
        G8_WAIT_V(6); G8_BAR; G8_MMA(1, 1, At, B1); G8_BAR;
      }
      {
        int lane2 = lane_id();
        asm volatile("" : "+v"(lane2));
        const int fr2 = lane2 & 15, fq2 = lane2 >> 4;
        if constexpr (TR) gemm8_epilogue_tr<EPI>(p, acc, brow, bcol, wr, wc, fr2, fq2, layer, gscale);
        else gemm8_epilogue<EPI, false>(p, acc, nullptr, lane2, brow, bcol, wr, wc, fr2, fq2, layer, gscale);
      }
      if (!has_next) break;
#pragma unroll
      for (int a0 = 0; a0 < 2; ++a0)
#pragma unroll
        for (int b0 = 0; b0 < 2; ++b0)
#pragma unroll
          for (int m = 0; m < 4; ++m)
#pragma unroll
            for (int n = 0; n < 2; ++n) acc[a0][b0][m][n] = f32x4{0.f, 0.f, 0.f, 0.f};
      t = tnx;
      brow = nbrow;
      bcol = nbcol;
    }
    G8_WAIT_V(0);
    if (wr == 0) G8_BAR;
  }
  __syncthreads();
  if (ntiles < ntiles_all) {
    constexpr int EPI_T = (EPI == EPI_RESID0) ? EPI_RESID : EPI;
    gemm_phase<EPI_T>(p, A, lda, Bt, ldb, 0, 0, K, layer, lds_all + (wid >> 2) * LDS_HALF, gscale, ntiles, ntiles_all - ntiles, Ntiles);
  }
#undef G8_SA
#undef G8_SB
#undef G8_STAGE
#undef G8_LDA
#undef G8_LDB
#undef G8_MMA
#undef G8_WAIT_V
#undef G8_WAIT_L
#undef G8_BAR
#undef G8_SCHED
}

DEVI bf16x8 scale_q(uint4 u) {
  uint4 r;
  r.x = pack2(bflo(u.x) * 0.125f, bfhi(u.x) * 0.125f);
  r.y = pack2(bflo(u.y) * 0.125f, bfhi(u.y) * 0.125f);
  r.z = pack2(bflo(u.z) * 0.125f, bfhi(u.z) * 0.125f);
  r.w = pack2(bflo(u.w) * 0.125f, bfhi(u.w) * 0.125f);
  return __builtin_bit_cast(bf16x8, r);
}
DEVI void phase_attn(PP p, int layer, bool with_ctx_q, unsigned char* lds) {
  const int tid = ltid();
  const int lane = tid & 63, wid = __builtin_amdgcn_readfirstlane(tid >> 6), r = lane & 31, h = lane >> 5;
  const float* sinkp = p->attn_sink + (layer >> 1) * 8;
  const int nlat = NB * 2 * 128;
  const int nunits = nlat + (with_ctx_q ? NB * 2 * 8 : 0);
  for (int u = lbid(); u < nunits; u += lnblk()) {
    bool latent = u < nlat;
    int b, kvh, qg, tokbase;
    if (latent) {
      b = u >> 8;
      kvh = (u >> 7) & 1;
      qg = u & 127;
      tokbase = b * SEQ + qg * 32;
    } else {
      int v = u - nlat;
      b = v >> 4;
      kvh = (v >> 3) & 1;
      qg = v & 7;
      tokbase = TL + b * CTX + qg * 32;
    }
    const int hd = kvh * 4 + wid;
    const bf16_t* kb = p->kbuf + (size_t)(b * 2 + kvh) * KVLEN * 64;
    const bf16_t* vt = p->vbuf + (size_t)(b * 2 + kvh) * 64 * KVLEN;
    const int nch = latent ? 5 : 2;
    const int lbase = CTX + (qg - 4) * 32;
#define ATT_STAGE(c_, buf_)                                                                                           \
  {                                                                                                                   \
    const int kp0_ = ((c_) < 2) ? (c_) * 128 : lbase + ((c_) - 2) * 128;                                              \
    _Pragma("unroll") for (int i_ = 0; i_ < 4; ++i_) {                                                                \
      const int P_ = tid * 16 + i_ * 4096;                                                                            \
      const int krow_ = P_ >> 7, kslot_ = (P_ >> 4) & 7;                                                              \
      int kp_ = kp0_ + krow_;                                                                                         \
      kp_ = kp_ < 0 ? 0 : (kp_ > KVLEN - 1 ? KVLEN - 1 : kp_);                                                        \
      __builtin_amdgcn_global_load_lds((const unsigned*)(kb + (size_t)kp_ * 64 + ((kslot_ ^ ((krow_ >> 1) & 7)) << 3)), \
                                       (__attribute__((address_space(3))) unsigned*)(lds + (buf_) * 32768 + P_), 16, 0, 0); \
      const int vrow_ = P_ >> 8, vslot_ = (P_ >> 4) & 15;                                                             \
      int vp_ = kp0_ + ((vslot_ ^ (vrow_ & 15)) << 3);                                                                \
      vp_ = vp_ < 0 ? 0 : (vp_ > KVLEN - 8 ? KVLEN - 8 : vp_);                                                        \
      __builtin_amdgcn_global_load_lds((const unsigned*)(vt + (size_t)vrow_ * KVLEN + vp_),                           \
                                       (__attribute__((address_space(3))) unsigned*)(lds + (buf_) * 32768 + 16384 + P_), 16, 0, 0); \
    }                                                                                                                 \
  }
    __syncthreads();
    ATT_STAGE(0, 0)
    bf16x8 qf[4];
    {
      const bf16_t* qp = p->P + (size_t)(tokbase + r) * 2048 + hd * 64 + 8 * h;
#pragma unroll
      for (int st = 0; st < 4; ++st) qf[st] = scale_q(*reinterpret_cast<const uint4*>(qp + 16 * st));
    }
    f32x16 O0, O1;
#pragma unroll
    for (int i = 0; i < 16; ++i) {
      O0[i] = 0.f;
      O1[i] = 0.f;
    }
    float m_run = sinkp[hd];
    float l_run = (h == 0) ? 1.f : 0.f;
    for (int c = 0; c < nch; ++c) {
      const int buf = c & 1;
      asm volatile("s_waitcnt vmcnt(0)" ::: "memory");
      __syncthreads();
      if (c + 1 < nch) ATT_STAGE(c + 1, buf ^ 1)
      const unsigned char* LK = lds + buf * 32768;
      const unsigned char* LV = LK + 16384;
#pragma unroll 1
      for (int kbi = 0; kbi < 4; ++kbi) {
        int mode = 0;
        if (c >= 2) {
          const int d = (c - 2) * 4 + kbi - 4;
          const int kblk = qg + d;
          if (d > 4 || kblk < 0 || kblk > 127) continue;
          mode = (d == -4) ? 1 : ((d == 4) ? 2 : 0);
        }
        f32x16 S;
#pragma unroll
        for (int i = 0; i < 16; ++i) S[i] = 0.f;
        {
          const int krow = kbi * 32 + r;
#pragma unroll
          for (int st = 0; st < 4; ++st) {
            bf16x8 kf = *reinterpret_cast<const bf16x8*>(LK + krow * 128 + (((2 * st + h) ^ ((krow >> 1) & 7)) << 4));
            S = __builtin_amdgcn_mfma_f32_32x32x16_bf16(kf, qf[st], S, 0, 0, 0);
          }
        }
        if (mode) {
          float negbig;
          asm volatile("v_mov_b32 %0, 0xf149f2ca" : "=v"(negbig));
#pragma unroll
          for (int i = 0; i < 16; ++i) {
            int kk = (i & 3) + 8 * (i >> 2) + 4 * h;
            bool ok = (mode == 1) ? (kk >= r) : (kk <= r);
            if (!ok) S[i] = negbig;
          }
        }
        float bm = S[0];
#pragma unroll
        for (int i = 1; i < 16; ++i) bm = fmaxf(bm, S[i]);
        bm = fmaxf(bm, shx_f(bm, 32));
        float m_new = fmaxf(m_run, bm);
        const float L2E = 1.4426950408889634f;
        float nm = -m_new * L2E;
        float psum = 0.f;
#pragma unroll
        for (int i = 0; i < 16; ++i) {
          S[i] = __builtin_amdgcn_exp2f(fmaf(S[i], L2E, nm));
          psum += S[i];
        }
        if (__any(m_new > m_run)) {
          float alpha = __builtin_amdgcn_exp2f((m_run - m_new) * L2E);
          l_run *= alpha;
#pragma unroll
          for (int i = 0; i < 16; ++i) {
            O0[i] *= alpha;
            O1[i] *= alpha;
          }
        }
        l_run += psum;
        m_run = m_new;
#pragma unroll
        for (int sidx = 0; sidx < 2; ++sidx) {
          uint4 pk;
          pk.x = pack2(S[8 * sidx + 0], S[8 * sidx + 1]);
          pk.y = pack2(S[8 * sidx + 2], S[8 * sidx + 3]);
          pk.z = pack2(S[8 * sidx + 4], S[8 * sidx + 5]);
          pk.w = pack2(S[8 * sidx + 6], S[8 * sidx + 7]);
          bf16x8 pf = __builtin_bit_cast(bf16x8, pk);
          const int vch = 4 * kbi + 2 * sidx + h;
          bf16x8 v0 = *reinterpret_cast<const bf16x8*>(LV + r * 256 + ((vch ^ (r & 15)) << 4));
          bf16x8 v1 = *reinterpret_cast<const bf16x8*>(LV + (32 + r) * 256 + ((vch ^ (r & 15)) << 4));
          O0 = __builtin_amdgcn_mfma_f32_32x32x16_bf16(v0, pf, O0, 0, 0, 0);
          O1 = __builtin_amdgcn_mfma_f32_32x32x16_bf16(v1, pf, O1, 0, 0, 0);
        }
      }
    }
#undef ATT_STAGE
    float l_tot = l_run + shx_f(l_run, 32);
    float inv = 1.f / l_tot;
    bf16_t* op = p->mix + (size_t)(tokbase + r) * LDMIX + hd * 64 + 4 * h;
#pragma unroll
    for (int g4 = 0; g4 < 4; ++g4) {
      uint2 o;
      o.x = pack2(O0[4 * g4 + 0] * inv, O0[4 * g4 + 1] * inv);
      o.y = pack2(O0[4 * g4 + 2] * inv, O0[4 * g4 + 3] * inv);
      *reinterpret_cast<uint2*>(op + 8 * g4) = o;
      o.x = pack2(O1[4 * g4 + 0] * inv, O1[4 * g4 + 1] * inv);
      o.y = pack2(O1[4 * g4 + 2] * inv, O1[4 * g4 + 3] * inv);
      *reinterpret_cast<uint2*>(op + 32 + 8 * g4) = o;
    }
  }
  __syncthreads();
}

DEVI void fill_tw(float2* tw, int n) {
  for (int i = ltid(); i < n; i += NTHREADS) {
    float sn, cn;
    sincospif(2.f * (float)i / (float)n, &sn, &cn);
    tw[i] = make_float2(cn, sn);
  }
  __syncthreads();
}

DEVI bf16x8 lds_col8(const bf16_t* bp, int stride) {
  unsigned e0 = bp[0], e1 = bp[stride], e2 = bp[2 * stride], e3 = bp[3 * stride];
  unsigned e4 = bp[4 * stride], e5 = bp[5 * stride], e6 = bp[6 * stride], e7 = bp[7 * stride];
  uint4 pk;
  pk.x = e0 | (e1 << 16);
  pk.y = e2 | (e3 << 16);
  pk.z = e4 | (e5 << 16);
  pk.w = e6 | (e7 << 16);
  return __builtin_bit_cast(bf16x8, pk);
}

DEVI void phase_fft_a(PP p, unsigned char* lds) {
  const int tid = ltid();
  const int lane = tid & 63, wid = __builtin_amdgcn_readfirstlane(tid >> 6), fr = lane & 15, fq = lane >> 4;
  float2* tw = reinterpret_cast<float2*>(lds + 66560);
  fill_tw(tw, 64);
  bf16x8 af[2][2];
#pragma unroll
  for (int ks = 0; ks < 2; ++ks) {
    unsigned short cr[8], ci[8];
#pragma unroll
    for (int j = 0; j < 8; ++j) {
      int n1 = 32 * ks + 8 * fq + j, k1 = 16 * wid + fr;
      float2 t = tw[(k1 * n1) & 63];
      cr[j] = f2bf(t.x);
      ci[j] = f2bf(-t.y);
    }
    uint4 a0, a1;
    a0.x = cr[0] | ((unsigned)cr[1] << 16); a0.y = cr[2] | ((unsigned)cr[3] << 16);
    a0.z = cr[4] | ((unsigned)cr[5] << 16); a0.w = cr[6] | ((unsigned)cr[7] << 16);
    a1.x = ci[0] | ((unsigned)ci[1] << 16); a1.y = ci[2] | ((unsigned)ci[3] << 16);
    a1.z = ci[4] | ((unsigned)ci[5] << 16); a1.w = ci[6] | ((unsigned)ci[7] << 16);
    af[0][ks] = __builtin_bit_cast(bf16x8, a0);
    af[1][ks] = __builtin_bit_cast(bf16x8, a1);
  }
  const bf16_t* l16 = reinterpret_cast<const bf16_t*>(lds);
  for (int u = lbid(); u < NB * 64; u += lnblk()) {
    int b = u >> 6, n2 = u & 63;
    __syncthreads();
#pragma unroll
    for (int i = 0; i < 16; ++i) {
      int row = (tid >> 6) + 4 * i, piece = tid & 63;
      uint4 v = *reinterpret_cast<const uint4*>(p->P + (size_t)(b * SEQ + 64 * row + n2) * 2048 + 768 + piece * 8);
      *reinterpret_cast<uint4*>(lds + row * 1040 + piece * 16) = v;
    }
    __syncthreads();
    float tc[4], ts[4];
#pragma unroll
    for (int j = 0; j < 4; ++j) sincospif((float)(n2 * (16 * wid + 4 * fq + j)) / 2048.f, &ts[j], &tc[j]);
    for (int nb = 0; nb < 4; ++nb) {
      f32x4 acc[2][8];
#pragma unroll
      for (int n = 0; n < 8; ++n) {
        acc[0][n] = f32x4{0.f, 0.f, 0.f, 0.f};
        acc[1][n] = f32x4{0.f, 0.f, 0.f, 0.f};
      }
#pragma unroll
      for (int ks = 0; ks < 2; ++ks)
#pragma unroll
        for (int nf = 0; nf < 8; ++nf) {
          bf16x8 bfr = lds_col8(l16 + (32 * ks + 8 * fq) * 520 + 128 * nb + 16 * nf + fr, 520);
          acc[0][nf] = __builtin_amdgcn_mfma_f32_16x16x32_bf16(af[0][ks], bfr, acc[0][nf], 0, 0, 0);
          acc[1][nf] = __builtin_amdgcn_mfma_f32_16x16x32_bf16(af[1][ks], bfr, acc[1][nf], 0, 0, 0);
        }
#pragma unroll
      for (int j = 0; j < 4; ++j) {
        int k1 = 16 * wid + 4 * fq + j;
        bf16_t* o = p->fa + (size_t)(b * SEQ + k1 * 64 + n2) * 1024 + 128 * nb + fr;
#pragma unroll
        for (int nf = 0; nf < 8; ++nf) {
          float re = acc[0][nf][j], im = acc[1][nf][j];
          o[16 * nf] = f2bf(re * tc[j] + im * ts[j]);
          o[512 + 16 * nf] = f2bf(im * tc[j] - re * ts[j]);
        }
      }
    }
  }
  __syncthreads();
}

DEVI void phase_fft_b(PP p, unsigned char* lds) {
  const int tid = ltid();
  const int lane = tid & 63, wid = __builtin_amdgcn_readfirstlane(tid >> 6), fr = lane & 15, fq = lane >> 4;
  float2* tw = reinterpret_cast<float2*>(lds + 67584);
  fill_tw(tw, 64);
  bf16x8 wb[2][4];
#pragma unroll
  for (int ks = 0; ks < 4; ++ks) {
    unsigned short zr[8], zi[8];
#pragma unroll
    for (int j = 0; j < 8; ++j) {
      int k = 32 * ks + 8 * fq + j, part = k >> 6, n2 = k & 63, k2 = 16 * wid + fr;
      float2 t = tw[(k2 * n2) & 63];
      zr[j] = f2bf(part ? t.y : t.x);
      zi[j] = f2bf(part ? t.x : -t.y);
    }
    uint4 a0, a1;
    a0.x = zr[0] | ((unsigned)zr[1] << 16); a0.y = zr[2] | ((unsigned)zr[3] << 16);
    a0.z = zr[4] | ((unsigned)zr[5] << 16); a0.w = zr[6] | ((unsigned)zr[7] << 16);
    a1.x = zi[0] | ((unsigned)zi[1] << 16); a1.y = zi[2] | ((unsigned)zi[3] << 16);
    a1.z = zi[4] | ((unsigned)zi[5] << 16); a1.w = zi[6] | ((unsigned)zi[7] << 16);
    wb[0][ks] = __builtin_bit_cast(bf16x8, a0);
    wb[1][ks] = __builtin_bit_cast(bf16x8, a1);
  }
  const bf16_t* l16 = reinterpret_cast<const bf16_t*>(lds);
  const float scale = 0.0013810679320049757f;
  for (int u = lbid(); u < NB * 128; u += lnblk()) {
    int b = u >> 7, k1 = (u >> 1) & 63, hf = u & 1;
    __syncthreads();
#pragma unroll
    for (int i = 0; i < 16; ++i) {
      int row = (tid >> 5) + 8 * i, piece = tid & 31;
      int part = row >> 6, n2 = row & 63;
      uint4 v = *reinterpret_cast<const uint4*>(p->fa + (size_t)(b * SEQ + k1 * 64 + n2) * 1024 + part * 512 + hf * 256 + piece * 8);
      *reinterpret_cast<uint4*>(lds + row * 528 + piece * 16) = v;
    }
    __syncthreads();
    for (int nb = 0; nb < 2; ++nb) {
      f32x4 acc[2][8];
#pragma unroll
      for (int n = 0; n < 8; ++n) {
        acc[0][n] = f32x4{0.f, 0.f, 0.f, 0.f};
        acc[1][n] = f32x4{0.f, 0.f, 0.f, 0.f};
      }
#pragma unroll
      for (int ks = 0; ks < 4; ++ks)
#pragma unroll
        for (int nf = 0; nf < 8; ++nf) {
          bf16x8 bfr = lds_col8(l16 + (32 * ks + 8 * fq) * 264 + 128 * nb + 16 * nf + fr, 264);
          acc[0][nf] = __builtin_amdgcn_mfma_f32_16x16x32_bf16(wb[0][ks], bfr, acc[0][nf], 0, 0, 0);
          acc[1][nf] = __builtin_amdgcn_mfma_f32_16x16x32_bf16(wb[1][ks], bfr, acc[1][nf], 0, 0, 0);
        }
#pragma unroll
      for (int j = 0; j < 4; ++j) {
        int k2 = 16 * wid + 4 * fq + j;
        bf16_t* o = p->mix + (size_t)(b * SEQ + k1 + 64 * k2) * LDMIX + 512 + hf * 256 + 128 * nb + fr;
#pragma unroll
        for (int nf = 0; nf < 8; ++nf) {
          o[16 * nf] = f2bf(acc[0][nf][j] * scale);
          o[512 + 16 * nf] = f2bf(acc[1][nf][j] * scale);
        }
      }
    }
  }
  __syncthreads();
}

DEVI void phase_dft_ctx(PP p, unsigned char* lds) {
  float2* tw = reinterpret_cast<float2*>(lds);
  fill_tw(tw, 256);
  int tid = ltid();
  const float scale = 0.005524271728019903f;
  for (int u = lbid(); u < NB * 64; u += lnblk()) {
    int b = u >> 6, k0 = (u & 63) * 4;
    for (int pass = 0; pass < 2; ++pass) {
      int ch = tid + pass * 256;
      float zr[4], zi[4];
#pragma unroll
      for (int kk = 0; kk < 4; ++kk) zr[kk] = zi[kk] = 0.f;
#pragma unroll 8
      for (int n = 0; n < 256; ++n) {
        float v = bf2f(p->P[(size_t)(TL + b * CTX + n) * 2048 + 768 + ch]);
#pragma unroll
        for (int kk = 0; kk < 4; ++kk) {
          float2 t = tw[(n * (k0 + kk)) & 255];
          zr[kk] += v * t.x;
          zi[kk] -= v * t.y;
        }
      }
#pragma unroll
      for (int kk = 0; kk < 4; ++kk) {
        bf16_t* o = p->mix + (size_t)(TL + b * CTX + k0 + kk) * LDMIX;
        o[512 + ch] = f2bf(zr[kk] * scale);
        o[1024 + ch] = f2bf(zi[kk] * scale);
      }
    }
  }
  __syncthreads();
}

DEVI void phase_sgu(PP p, int j, int nchunks, unsigned char* lds) {
  float* rs = reinterpret_cast<float*>(lds);
  unsigned char* LA = lds + 1024;
  unsigned char* LB = lds + 1024 + 32768;
  const int tid = ltid();
  const int lane = tid & 63, wid = __builtin_amdgcn_readfirstlane(tid >> 6), fr = lane & 15, fq = lane >> 4;
  const float* nw = p->gs_norm_w + j * 1024;
  for (int u = lbid(); u < nchunks * 8; u += lnblk()) {
    const int chunk = u >> 3, g = u & 7;
    const int tok0 = chunk * 128;
    const bf16_t* vT = p->zvT + ((size_t)chunk * 1024 + g * 128) * 128;
    __syncthreads();
    if (tid < 128) {
      const float* rp = p->rowss + (size_t)chunk * 32 * 128 + tid;
      float ss = 0.f;
#pragma unroll
      for (int sl = 0; sl < 32; ++sl) ss += rp[sl * 128];
      rs[tid] = rsqrtf(ss * (1.f / 1024.f) + 1e-6f);
    }
#pragma unroll
    for (int i = 0; i < 8; ++i) {
      int idx = tid + 256 * i, row = idx >> 4, c = idx & 15;
      uint4 v = *reinterpret_cast<const uint4*>(vT + (size_t)row * 128 + c * 8);
      *reinterpret_cast<uint4*>(LB + row * 256 + ((c ^ (row & 15)) << 4)) = v;
    }
    __syncthreads();
    {
      const float* wsg = p->gs_w_s + ((size_t)j * 8 + g) * 128 * 128;
#pragma unroll
      for (int i = 0; i < 8; ++i) {
        int idx = tid + 256 * i, row = idx >> 4, c = idx & 15;
        const float4* wp = reinterpret_cast<const float4*>(wsg + (size_t)row * 128 + c * 8);
        float4 w0 = wp[0], w1 = wp[1];
        const float* rk = rs + c * 8;
        uint4 pk;
        pk.x = pack2(w0.x * rk[0], w0.y * rk[1]);
        pk.y = pack2(w0.z * rk[2], w0.w * rk[3]);
        pk.z = pack2(w1.x * rk[4], w1.y * rk[5]);
        pk.w = pack2(w1.z * rk[6], w1.w * rk[7]);
        *reinterpret_cast<uint4*>(LA + row * 256 + ((c ^ (row & 15)) << 4)) = pk;
      }
    }
    __syncthreads();
    f32x4 acc[2][8];
#pragma unroll
    for (int m = 0; m < 2; ++m)
#pragma unroll
      for (int n = 0; n < 8; ++n) acc[m][n] = f32x4{0.f, 0.f, 0.f, 0.f};
#pragma unroll
    for (int ks = 0; ks < 4; ++ks) {
      const int sl = ((4 * ks + fq) ^ fr) << 4;
      bf16x8 a0 = *reinterpret_cast<const bf16x8*>(LA + (32 * wid + fr) * 256 + sl);
      bf16x8 a1 = *reinterpret_cast<const bf16x8*>(LA + (32 * wid + 16 + fr) * 256 + sl);
#pragma unroll
      for (int n = 0; n < 8; ++n) {
        bf16x8 bfr = *reinterpret_cast<const bf16x8*>(LB + (16 * n + fr) * 256 + sl);
        acc[0][n] = __builtin_amdgcn_mfma_f32_16x16x32_bf16(a0, bfr, acc[0][n], 0, 0, 0);
        acc[1][n] = __builtin_amdgcn_mfma_f32_16x16x32_bf16(a1, bfr, acc[1][n], 0, 0, 0);
      }
    }
    __syncthreads();
    {
      const float* bsg = p->gs_b_s + ((size_t)j * 8 + g) * 128;
#pragma unroll
      for (int m = 0; m < 2; ++m)
#pragma unroll
        for (int jj = 0; jj < 4; ++jj) {
          const int pp = 32 * wid + 16 * m + 4 * fq + jj;
          const float bias = bsg[pp];
#pragma unroll
          for (int n = 0; n < 8; ++n) {
            const int c = 16 * n + fr;
            float sv = nw[g * 128 + c] * acc[m][n][jj] + bias;
            *reinterpret_cast<bf16_t*>(LA + pp * 256 + (((c >> 3) ^ (pp & 15)) << 4) + (c & 7) * 2) = f2bf(sv);
          }
        }
    }
    __syncthreads();
#pragma unroll
    for (int i = 0; i < 8; ++i) {
      int idx = tid + 256 * i, row = idx >> 4, c = idx & 15;
      uint4 sv8 = *reinterpret_cast<const uint4*>(LA + row * 256 + ((c ^ (row & 15)) << 4));
      uint4 u8 = *reinterpret_cast<const uint4*>(p->P + (size_t)(tok0 + row) * 2048 + g * 128 + c * 8);
      uint4 o;
      o.x = pack2(bflo(u8.x) * bflo(sv8.x), bfhi(u8.x) * bfhi(sv8.x));
      o.y = pack2(bflo(u8.y) * bflo(sv8.y), bfhi(u8.y) * bfhi(sv8.y));
      o.z = pack2(bflo(u8.z) * bflo(sv8.z), bfhi(u8.z) * bfhi(sv8.z));
      o.w = pack2(bflo(u8.w) * bflo(sv8.w), bfhi(u8.w) * bfhi(sv8.w));
      *reinterpret_cast<uint4*>(p->mix + (size_t)(tok0 + row) * LDMIX + g * 128 + c * 8) = o;
    }
  }
  __syncthreads();
}

DEVI float mkkey(float v, unsigned idx, unsigned mask) { return __uint_as_float((__float_as_uint(v) & ~mask) | idx); }
#define INSERT16(list, x)                                                                                               \
  {                                                                                                                     \
    _Pragma("unroll") for (int i_ = 15; i_ >= 1; --i_) list[i_] = __builtin_amdgcn_fmed3f(list[i_ - 1], list[i_], x); \
    list[0] = fmaxf(list[0], x);                                                                                        \
  }

DEVI void phase_route(PP p, int layer, int ntok, unsigned char* lds) {
  const int tid = ltid();
  const int lane = tid & 63, wid = __builtin_amdgcn_readfirstlane(tid >> 6), fr = lane & 15, fq = lane >> 4;
  const int nb8 = lnblk() >> 3, bid = lbid();
  const int hh = bid & 7, slot = bid >> 3;
  const int ntiles = ntok / 64;
  const bool active = slot < nb8;
  float* sc = reinterpret_cast<float*>(lds + 32768);
  const float NEGK = -3.0e38f;
  for (int half = 0; half < 2; ++half) {
    __syncthreads();
    {
      const bf16_t* ksrc = p->keysb + ((size_t)((layer * 8 + hh) * 2 + half) * 128) * 128;
#pragma unroll
      for (int i = 0; i < 8; ++i) {
        int idx = tid + 256 * i, row = idx >> 4, c = idx & 15;
        uint4 v = *reinterpret_cast<const uint4*>(ksrc + (size_t)row * 128 + c * 8);
        *reinterpret_cast<uint4*>(lds + row * 256 + ((c ^ (row & 15)) << 4)) = v;
      }
    }
    __syncthreads();
    bf16x8 an[4];
    if (active && slot < ntiles) {
      const bf16_t* qa = p->P + (size_t)(slot * 64 + wid * 16 + fr) * 2048 + hh * 256 + half * 128 + fq * 8;
#pragma unroll
      for (int ks = 0; ks < 4; ++ks) an[ks] = *reinterpret_cast<const bf16x8*>(qa + ks * 32);
    }
    for (int tt = slot; active && tt < ntiles; tt += nb8) {
      const int tok0 = tt * 64;
      {
        bf16x8 a[4];
#pragma unroll
        for (int ks = 0; ks < 4; ++ks) a[ks] = an[ks];
        {
          const int ttn = (tt + nb8 < ntiles) ? tt + nb8 : tt;
          const bf16_t* qa = p->P + (size_t)(ttn * 64 + wid * 16 + fr) * 2048 + hh * 256 + half * 128 + fq * 8;
#pragma unroll
          for (int ks = 0; ks < 4; ++ks) an[ks] = *reinterpret_cast<const bf16x8*>(qa + ks * 32);
        }
#pragma unroll
        for (int nf = 0; nf < 8; ++nf) {
          f32x4 acc = f32x4{0.f, 0.f, 0.f, 0.f};
          const int krow = nf * 16 + fr;
#pragma unroll
          for (int ks = 0; ks < 4; ++ks) {
            bf16x8 bb = *reinterpret_cast<const bf16x8*>(lds + krow * 256 + (((4 * ks + fq) ^ (krow & 15)) << 4));
            acc = __builtin_amdgcn_mfma_f32_16x16x32_bf16(a[ks], bb, acc, 0, 0, 0);
          }
#pragma unroll
          for (int j = 0; j < 4; ++j) sc[(wid * 16 + fq * 4 + j) * 133 + krow + (krow >> 5)] = mkkey(acc[j], (unsigned)krow, 127u);
        }
      }
      const int prt = lane >> 4;
      float list[16];
#pragma unroll
      for (int i = 0; i < 16; ++i) list[i] = NEGK;
      {
        const float* kr = sc + (wid * 16 + fr) * 133 + prt * 33;
#pragma unroll 4
        for (int e = 0; e < 32; ++e) {
          float x = kr[e];
          INSERT16(list, x)
        }
      }
#pragma unroll 1
      for (int step = 16; step <= 32; step <<= 1) {
        float other[16];
#pragma unroll
        for (int i = 0; i < 16; ++i) other[i] = shx_f(list[i], step);
#pragma unroll
        for (int i = 0; i < 16; ++i) {
          float x = other[i];
          INSERT16(list, x)
        }
      }
      if (prt == 0) {
        float4* o = reinterpret_cast<float4*>(p->tops + ((size_t)(tok0 + wid * 16 + fr) * 16 + hh * 2 + half) * 16);
        o[0] = make_float4(list[0], list[1], list[2], list[3]);
        o[1] = make_float4(list[4], list[5], list[6], list[7]);
        o[2] = make_float4(list[8], list[9], list[10], list[11]);
        o[3] = make_float4(list[12], list[13], list[14], list[15]);
      }
    }
  }
  __syncthreads();
  float* fl = reinterpret_cast<float*>(lds);
  for (int t4 = slot; active && t4 < ntiles + 3 * nb8; t4 += 4 * nb8) {
    const int tt = t4 + (tid >> 6) * nb8;
    if (tt < ntiles) {
      const int tok = tt * 64 + (tid & 63);
      const float4* src = reinterpret_cast<const float4*>(p->tops + ((size_t)tok * 16 + hh * 2) * 16);
      float v0[16], v1[16];
#pragma unroll
      for (int i = 0; i < 4; ++i) {
        float4 a = src[i], bq = src[4 + i];
        v0[4 * i] = a.x; v0[4 * i + 1] = a.y; v0[4 * i + 2] = a.z; v0[4 * i + 3] = a.w;
        v1[4 * i] = bq.x; v1[4 * i + 1] = bq.y; v1[4 * i + 2] = bq.z; v1[4 * i + 3] = bq.w;
      }
      float* f0 = fl + tid * 33;
      float* f1 = f0 + 16;
#pragma unroll
      for (int i = 0; i < 16; ++i) {
        f0[i] = v0[i];
        f1[i] = v1[i];
      }
      float l2[16];
#pragma unroll
      for (int i = 0; i < 16; ++i) l2[i] = mkkey(v0[0] + v1[i], (unsigned)(15 - i), 255u);
#pragma unroll
      for (int a = 1; a < 16; ++a)
#pragma unroll
        for (int bq = 0; bq < 16; ++bq)
          if ((a + 1) * (bq + 1) <= 16) {
            float x = mkkey(v0[a] + v1[bq], (unsigned)(a * 16 + 15 - bq), 255u);
            INSERT16(l2, x)
          }
      float sv[16];
      int ev[16];
      float mx = NEGK;
#pragma unroll
      for (int k = 0; k < 16; ++k) {
        unsigned ab = __float_as_uint(l2[k]) & 255u;
        unsigned k0 = __float_as_uint(f0[ab >> 4]), k1 = __float_as_uint(f1[15u - (ab & 15u)]);
        sv[k] = __uint_as_float(k0 & ~127u) + __uint_as_float(k1 & ~127u);
        ev[k] = (int)((k0 & 127u) * 128u + (k1 & 127u));
        mx = fmaxf(mx, sv[k]);
      }
      float sum = 0.f;
#pragma unroll
      for (int k = 0; k < 16; ++k) {
        sv[k] = __expf(sv[k] - mx);
        sum += sv[k];
      }
      float inv = 1.f / sum;
      size_t o = (size_t)tok * 128 + hh * 16;
      int4* eo = reinterpret_cast<int4*>(p->eidx + o);
      float4* go = reinterpret_cast<float4*>(p->gate + o);
#pragma unroll
      for (int k4 = 0; k4 < 4; ++k4) {
        eo[k4] = make_int4(ev[4 * k4], ev[4 * k4 + 1], ev[4 * k4 + 2], ev[4 * k4 + 3]);
        go[k4] = make_float4(sv[4 * k4] * inv, sv[4 * k4 + 1] * inv, sv[4 * k4 + 2] * inv, sv[4 * k4 + 3] * inv);
      }
    }
  }
  __syncthreads();
}

typedef float v2f __attribute__((ext_vector_type(2)));
DEVI void dec16(uint4 q, v2f* f) {
  f[0] = __builtin_amdgcn_cvt_pk_f32_fp8((int)q.x, false);
  f[1] = __builtin_amdgcn_cvt_pk_f32_fp8((int)q.x, true);
  f[2] = __builtin_amdgcn_cvt_pk_f32_fp8((int)q.y, false);
  f[3] = __builtin_amdgcn_cvt_pk_f32_fp8((int)q.y, true);
  f[4] = __builtin_amdgcn_cvt_pk_f32_fp8((int)q.z, false);
  f[5] = __builtin_amdgcn_cvt_pk_f32_fp8((int)q.z, true);
  f[6] = __builtin_amdgcn_cvt_pk_f32_fp8((int)q.w, false);
  f[7] = __builtin_amdgcn_cvt_pk_f32_fp8((int)q.w, true);
}
struct ExpBuf {
  uint4 q[8];
  uint4 h0, h1;
};
DEVI void exp_load(ExpBuf& B, const unsigned char* tab, const signed char* hrow, const unsigned short* idp, int j8, bool want_x) {
  const uint4 idv = *reinterpret_cast<const uint4*>(idp);
  const unsigned idw[4] = {idv.x, idv.y, idv.z, idv.w};
#pragma unroll
  for (int i = 0; i < 8; ++i) {
    unsigned e = (i & 1) ? (idw[i >> 1] >> 16) : (idw[i >> 1] & 0xffffu);
    unsigned off = e * (unsigned)D + 16u * j8;
    B.q[i] = *reinterpret_cast<const uint4*>(tab + off);
  }
  if (want_x) B.h0 = *reinterpret_cast<const uint4*>(hrow + 16 * j8);
}
template <int CTRL>
DEVI int dpp_movi(int v) { return __builtin_amdgcn_mov_dpp(v, CTRL, 0xF, 0xF, true); }
DEVI void exp_u_compute(const ExpBuf& B, int* pp, int j8) {
  int s0 = 0;
#pragma unroll
  for (int i = 0; i < 8; ++i) {
    int d = __builtin_amdgcn_sdot4((int)B.q[i].x, (int)B.h0.x, 0, false);
    d = __builtin_amdgcn_sdot4((int)B.q[i].y, (int)B.h0.y, d, false);
    d = __builtin_amdgcn_sdot4((int)B.q[i].z, (int)B.h0.z, d, false);
    d = __builtin_amdgcn_sdot4((int)B.q[i].w, (int)B.h0.w, d, false);
    d += dpp_movi<0xB1>(d);
    d += dpp_movi<0x4E>(d);
    d += dpp_movi<0x141>(d);
    s0 = (j8 == i) ? d : s0;
  }
  pp[0] += s0;
}
DEVI void exp_v_accum(const ExpBuf& B, unsigned w0, unsigned w1, int* acc) {
#pragma unroll
  for (int ig = 0; ig < 2; ++ig) {
    const unsigned wq = ig ? w1 : w0;
    const uint4 R0 = B.q[4 * ig], R1 = B.q[4 * ig + 1], R2 = B.q[4 * ig + 2], R3 = B.q[4 * ig + 3];
    const unsigned r0[4] = {R0.x, R0.y, R0.z, R0.w}, r1[4] = {R1.x, R1.y, R1.z, R1.w};
    const unsigned r2[4] = {R2.x, R2.y, R2.z, R2.w}, r3[4] = {R3.x, R3.y, R3.z, R3.w};
#pragma unroll
    for (int q = 0; q < 4; ++q) {
      unsigned A = __builtin_amdgcn_perm(r1[q], r0[q], 0x05010400u);
      unsigned Bq = __builtin_amdgcn_perm(r1[q], r0[q], 0x07030602u);
      unsigned C = __builtin_amdgcn_perm(r3[q], r2[q], 0x05010400u);
      unsigned E = __builtin_amdgcn_perm(r3[q], r2[q], 0x07030602u);
      unsigned D0 = __builtin_amdgcn_perm(C, A, 0x05040100u);
      unsigned D1 = __builtin_amdgcn_perm(C, A, 0x07060302u);
      unsigned D2 = __builtin_amdgcn_perm(E, Bq, 0x05040100u);
      unsigned D3 = __builtin_amdgcn_perm(E, Bq, 0x07060302u);
      acc[4 * q + 0] = __builtin_amdgcn_sdot4((int)D0, (int)wq, acc[4 * q + 0], false);
      acc[4 * q + 1] = __builtin_amdgcn_sdot4((int)D1, (int)wq, acc[4 * q + 1], false);
      acc[4 * q + 2] = __builtin_amdgcn_sdot4((int)D2, (int)wq, acc[4 * q + 2], false);
      acc[4 * q + 3] = __builtin_amdgcn_sdot4((int)D3, (int)wq, acc[4 * q + 3], false);
    }
  }
}
DEVI void exp_v_finish(float4* xo, const float4* xq, const float4* gq, int* acc, float swt, int grp, float gscale) {
  float o[16];
#pragma unroll
  for (int k = 0; k < 16; ++k) {
    int a = acc[k];
    a += dpp_movi<0x128>(a);
    a += shx_i(a, 16);
    a += shx_i(a, 32);
    o[k] = (float)a;
    acc[k] = 0;
  }
  if (grp == 0) {
    const float sc = gscale * swt;
#pragma unroll
    for (int i4 = 0; i4 < 4; ++i4) {
      float4 r = xq[i4];
      r.x += sc * gq[i4].x * o[i4 * 4 + 0];
      r.y += sc * gq[i4].y * o[i4 * 4 + 1];
      r.z += sc * gq[i4].z * o[i4 * 4 + 2];
      r.w += sc * gq[i4].w * o[i4 * 4 + 3];
      xo[i4] = r;
    }
  }
}
DEVI void phase_expert(PP p, int layer, int ntok, unsigned char* lds, float gscale = 1.f, int idmask = 0xffff) {
  const int tid = ltid();
  const int lane = tid & 63, wid = __builtin_amdgcn_readfirstlane(tid >> 6), j8 = lane & 7, grp = lane >> 3;
  const int nb = lnblk(), bid = lbid();
  unsigned short* ids = reinterpret_cast<unsigned short*>(lds);
  float* part = reinterpret_cast<float*>(lds + TPB * 128 * 2);
  unsigned char* w8 = lds + TPB * 128 * 2 + TPB * 128 * 4;
  float* swl = reinterpret_cast<float*>(lds + TPB * 128 * 2 + TPB * 128 * 4 + TPB * 128);
  const unsigned char* ut = p->utab + (size_t)layer * NEXP * D;
  const unsigned char* vt = p->vtab + (size_t)layer * NEXP * D;
  int tpb = (ntok + nb - 1) / nb;
  if (tpb > TPB) tpb = TPB;
  const int npass = (ntok + nb * tpb - 1) / (nb * tpb);
  for (int pass = 0; pass < npass; ++pass) {
    const int tok0 = (pass * nb + bid) * tpb;
    int cnt = ntok - tok0;
    if (cnt > tpb) cnt = tpb;
    if (cnt < 0) cnt = 0;
    for (int i = tid; i < cnt * 128; i += NTHREADS) {
      {
        int k = i & 127, hf = k >> 6, kk = k & 63;
        ids[(i & ~127) + hf * 64 + (kk & 7) * 8 + (kk >> 3)] = (unsigned short)(p->eidx[(size_t)tok0 * 128 + i] & idmask);
      }
      part[i] = 0.f;
    }
    __syncthreads();
    const int ntw = (cnt - wid + 3) >> 2;
    const int npair = ntw * 8;

    if (!(REP_MODE == 1 && gscale != 1.f)) {
      ExpBuf B0, B1;
      int c0 = 0, k0 = 0;
      if (npair > 0) {
        const int t0 = wid;
        exp_load(B0, ut, p->h8 + (size_t)(tok0 + t0) * D, ids + t0 * 128 + grp * 8, j8, true);
      }
      for (int pr = 0; pr < npair; ++pr) {
        const int t0 = wid + 4 * k0;
        exp_load(B1, ut + 128 * c0, p->h8 + (size_t)(tok0 + t0) * D + 128 * c0, ids + t0 * 128 + 64 + grp * 8, j8, true);
        exp_u_compute(B0, reinterpret_cast<int*>(part) + t0 * 128 + 8 * j8 + grp, j8);
        int c1 = c0, k1 = k0;
        if (pr + 1 < npair) {
          k1 = k0 + 1;
          if (k1 == ntw) {
            k1 = 0;
            c1 = c0 + 1;
          }
        }
        {
          const int t1 = wid + 4 * k1;
          exp_load(B0, ut + 128 * c1, p->h8 + (size_t)(tok0 + t1) * D + 128 * c1, ids + t1 * 128 + grp * 8, j8, true);
        }
        exp_u_compute(B1, reinterpret_cast<int*>(part) + t0 * 128 + 64 + 8 * j8 + grp, j8);
        c0 = c1;
        k0 = k1;
      }
    }
    __syncthreads();
    for (int t = wid; t < cnt; t += 4) {
      float wv2[2];
      float am = 0.f;
#pragma unroll
      for (int hh = 0; hh < 2; ++hh) {
        int k = lane + 64 * hh;
        int e = ids[t * 128 + hh * 64 + (lane & 7) * 8 + (lane >> 3)];
        float dq = (float)reinterpret_cast<int*>(part)[t * 128 + k] * p->su[(size_t)layer * NEXP + e] * p->sx[tok0 + t];
        float wv = p->gate[(size_t)(tok0 + t) * 128 + k] * gelu_tanh(dq) * p->sv[(size_t)layer * NEXP + e];
        wv2[hh] = wv;
        am = fmaxf(am, fabsf(wv));
      }
      am = fmaxf(wave_max(am), 1e-30f);
      float qs = 127.f / am;
#pragma unroll
      for (int hh = 0; hh < 2; ++hh) {
        int k = lane + 64 * hh;
        int q = (int)rintf(wv2[hh] * qs);
        w8[t * 128 + (k & 7) * 16 + hh * 8 + ((k >> 3) & 7)] = (unsigned char)(q & 255);
      }
      if (lane == 0) swl[t] = am * (1.f / 127.f);
    }
    __syncthreads();
    if (!(REP_MODE == 2 && gscale != 1.f)) {
      ExpBuf B0, B1;
      int acc[16];
#pragma unroll
      for (int k = 0; k < 16; ++k) acc[k] = 0;
      int c0 = 0, k0 = 0;
      if (npair > 0) {
        const int t0 = wid;
        exp_load(B0, vt, (const signed char*)nullptr, ids + t0 * 128 + grp * 8, j8, false);
      }
      for (int pr = 0; pr < npair; ++pr) {
        const int t0 = wid + 4 * k0;
        float4 xq[4], gq[4];
        float4* xo = reinterpret_cast<float4*>(p->xs + (size_t)(tok0 + t0) * D + 128 * c0 + 16 * j8);
        {
          const float4* gf = reinterpret_cast<const float4*>(p->mod + ((size_t)layer * 9 + tok_batch(tok0 + t0)) * 6144 + 5 * 1024 + 128 * c0 + 16 * j8);
#pragma unroll
          for (int i4 = 0; i4 < 4; ++i4) {
            xq[i4] = xo[i4];
            gq[i4] = gf[i4];
          }
        }
        exp_load(B1, vt + 128 * c0, (const signed char*)nullptr, ids + t0 * 128 + 64 + grp * 8, j8, false);
        const uint4 wq = *reinterpret_cast<const uint4*>(w8 + t0 * 128 + grp * 16);
        exp_v_accum(B0, wq.x, wq.y, acc);
        int c1 = c0, k1 = k0;
        if (pr + 1 < npair) {
          k1 = k0 + 1;
          if (k1 == ntw) {
            k1 = 0;
            c1 = c0 + 1;
          }
        }
        {
          const int t1 = wid + 4 * k1;
          exp_load(B0, vt + 128 * c1, (const signed char*)nullptr, ids + t1 * 128 + grp * 8, j8, false);
        }
        exp_v_accum(B1, wq.z, wq.w, acc);
        exp_v_finish(xo, xq, gq, acc, swl[t0], grp, gscale);
        c0 = c1;
        k0 = k1;
      }
    }
    asm volatile("s_waitcnt vmcnt(0)" ::: "memory");
    __syncthreads();
    if (gscale == 1.f) {
      for (int t = wid; t < cnt; t += 4) {
        if (layer + 1 < DEPTH) norm_row(p, layer + 1, 0, tok0 + t, lane);
        else if (tok0 + t < TL) norm_row(p, 0, 2, tok0 + t, lane);
      }
    }
    __syncthreads();
  }
}

#define XB_TMO 128
#define XB_XCNT(j) (256 + 64 * (j))
#define XB_XSUB(j) (1280 + 64 * (j))
#define XB_XGEN(j) (2304 + 64 * (j))
#define XB_TOP 3328
#define XB_TOPGEN 3392
#define XCD_BAR_WORDS 3456
#define XB_SPIN_CAP (1u << 22)
#define LAS __attribute__((address_space(3)))
DEVI unsigned xb_ld(unsigned* p) { return __hip_atomic_load(p, __ATOMIC_RELAXED, __HIP_MEMORY_SCOPE_AGENT); }
DEVI unsigned xb_add(unsigned* p, unsigned v) { return __hip_atomic_fetch_add(p, v, __ATOMIC_RELAXED, __HIP_MEMORY_SCOPE_AGENT); }
DEVI unsigned xb_xcc_id() { return (unsigned)__builtin_amdgcn_s_getreg((3 << 11) | 20) & 0xFu; }
#define XB_SPIN(cond, bar)                                   \
  do {                                                       \
    unsigned _sp = 0;                                        \
    while (cond) {                                           \
      __builtin_amdgcn_s_sleep(1);                           \
      if ((++_sp & 255u) == 0u) {                            \
        if (xb_ld(&(bar)[XB_TMO])) break;                    \
        if (_sp > XB_SPIN_CAP) {                             \
          atomicAdd(&(bar)[XB_TMO], 1u);                     \
          break;                                             \
        }                                                    \
      }                                                      \
    }                                                        \
  } while (0)
struct XcdBarrier {
  unsigned* bar;
  unsigned x;
  volatile LAS unsigned* st;
};
DEVI XcdBarrier xcd_barrier_post(unsigned* bar, volatile LAS unsigned* st) {
  XcdBarrier b;
  b.bar = bar;
  b.x = xb_xcc_id();
  b.st = st;
  if (threadIdx.x == 0) (void)xb_add(&bar[XB_XCNT(b.x)], 1u);
  return b;
}
DEVI void xcd_barrier_complete(unsigned* bar, unsigned x, unsigned& nloc, unsigned& nx) {
  const unsigned G = gridDim.x * gridDim.y * gridDim.z;
  unsigned sum, cnt, mine, sp = 0u;
  for (;;) {
    sum = 0u;
    cnt = 0u;
    mine = 0u;
#pragma unroll
    for (unsigned j = 0; j < 16; ++j) {
      const unsigned c = xb_ld(&bar[XB_XCNT(j)]);
      sum += c;
      cnt += (c > 0u) ? 1u : 0u;
      mine = (j == x) ? c : mine;
    }
    if (sum == G) break;
    __builtin_amdgcn_s_sleep(1);
    if ((++sp & 255u) == 0u) {
      if (xb_ld(&bar[XB_TMO])) break;
      if (sp > XB_SPIN_CAP) {
        atomicAdd(&bar[XB_TMO], 1u);
        break;
      }
    }
  }
  nloc = mine > 0u ? mine : 1u;
  nx = cnt > 0u ? cnt : 1u;
}
DEVI void xcd_barrier(const XcdBarrier& b) {
  asm volatile("s_waitcnt vmcnt(0)" ::: "memory");
  __syncthreads();
  if (threadIdx.x == 0) {
    unsigned* bar = b.bar;
    __builtin_amdgcn_s_waitcnt(0);
    unsigned nloc = b.st[0], nx = b.st[1];
    if (nloc == 0u) {
      xcd_barrier_complete(bar, b.x, nloc, nx);
      b.st[0] = nloc;
      b.st[1] = nx;
    }
    const unsigned old = xb_add(&bar[XB_XSUB(b.x)], 1u);
    const unsigned gen = old / nloc;
    if (old + 1u == (gen + 1u) * nloc) {
      __builtin_amdgcn_fence(__ATOMIC_RELEASE, "agent");
      asm volatile("s_waitcnt vmcnt(0)" ::: "memory");
      const unsigned og = xb_add(&bar[XB_TOP], 1u);
      const unsigned tg = og / nx;
      if (og + 1u == (tg + 1u) * nx) xb_add(&bar[XB_TOPGEN], 1u);
      else XB_SPIN(xb_ld(&bar[XB_TOPGEN]) == tg, bar);
      __builtin_amdgcn_fence(__ATOMIC_ACQUIRE, "agent");
      xb_add(&bar[XB_XGEN(b.x)], 1u);
      asm volatile("s_waitcnt vmcnt(0)" ::: "memory");
    } else {
      XB_SPIN(xb_ld(&bar[XB_XGEN(b.x)]) == gen, bar);
      __builtin_amdgcn_fence(__ATOMIC_ACQUIRE, "agent");
      asm volatile("s_waitcnt vmcnt(0)" ::: "memory");
    }
  }
  __syncthreads();
}

DEVI bool step_active(int step) {
  if (step == 0) return true;
  if (step == NSTEPS - 1) return false;
  int layer = (step - 1) / STEPS_PER_LAYER, ph = (step - 1) % STEPS_PER_LAYER;
  if (ph == 3 && (layer & 1)) return false;
  if (ph == 0 && layer > 0) return false;
  return true;
}

DEVI void run_step(PP p, int step, unsigned char* lds, unsigned char* lds_all, float gscale = 1.f) {
  if (step == 0) {
    phase_prep(p, lds);
    return;
  }
  if (step == NSTEPS - 1) {
    phase_norm(p, 0, 2, TL);
    return;
  }
  int layer = (step - 1) / STEPS_PER_LAYER, ph = (step - 1) % STEPS_PER_LAYER;
  bool even = (layer & 1) == 0;
  int j = layer >> 1;
  bool upd_ctx = layer < 2;
  bool need_ctx = layer < 3;
  int nt_in = need_ctx ? TT : TL;
  int nt = upd_ctx ? TT : TL;
  switch (ph) {
    case 0: phase_norm(p, layer, 0, nt_in); break;
    case 1:
      if (even)
        gemm8_phase<EPI_INPROJ>(p, p->h, D, p->wt_in_ab + (size_t)j * 1280 * D, D, nt_in / 256, 5, D, layer, lds_all);
      else
        gemm8_phase<EPI_GELU>(p, p->h, D, p->wt_in_gs + (size_t)j * 2048 * D, D, nt / 256, 8, D, layer, lds_all);
      break;
    case 2:
      if (even) {
        phase_fft_a(p, lds);
        if (upd_ctx) phase_dft_ctx(p, lds);
        phase_attn(p, layer, upd_ctx, lds);
      } else {
        phase_sgu(p, j, nt / 128, lds);
      }
      break;
    case 3:
      if (even) phase_fft_b(p, lds);
      break;
    case 4:
      if (even)
      {
        if (layer == 0) gemm8_phase<EPI_RESID0>(p, p->mix, LDMIX, p->wt_out_ab + (size_t)j * D * LDMIX, LDMIX, nt / 256, 4, LDMIX, layer, lds_all, gscale);
        else gemm8_phase<EPI_RESID>(p, p->mix, LDMIX, p->wt_out_ab + (size_t)j * D * LDMIX, LDMIX, nt / 256, 4, LDMIX, layer, lds_all, gscale);
      }
      else
      {
        gemm8_phase<EPI_RESID>(p, p->mix, LDMIX, p->wt_out_gs + (size_t)j * D * D, D, nt / 256, 4, D, layer, lds_all, gscale);
      }
      break;
    case 5: phase_norm(p, layer, 1, nt); break;
    case 6: gemm8_phase<EPI_STORE>(p, p->h, D, p->wt_q + (size_t)layer * 2048 * D, D, nt / 256, 8, D, layer, lds_all); break;
    case 7: phase_route(p, layer, nt, lds); break;
    case 8: phase_expert(p, layer, nt, lds, gscale, (gscale == 1.f) ? 0xffff : REP_IDMASK); break;
  }
}

__global__ void __launch_bounds__(PHYS_THREADS, 2) mega(Params p_unused, int step_lo, int step_hi) {
  unsigned char* lds_all = g_lds;
  if ((threadIdx.x & 63) == 0) *reinterpret_cast<volatile int*>(g_lds + LDS_BYTES - 16 - 256 + 4 * hw_slot()) = (int)(threadIdx.x >> 6);
  __syncthreads();
  unsigned char* lds = lds_all + (wave_index() >> 2) * LDS_HALF;
  PP pp = (PP)__builtin_amdgcn_kernarg_segment_ptr();
  volatile LAS unsigned* st = (volatile LAS unsigned*)(lds_all + LDS_BYTES - 16);
  if (threadIdx.x == 0) {
    st[0] = 0u;
    st[1] = 0u;
  }
  __syncthreads();
  XcdBarrier xb = xcd_barrier_post(pp->bar, st);
  int nsync = 0;
  bool first = true;
  for (int s = step_lo; s < step_hi; ++s) {
    if (!step_active(s)) continue;
    if (!first) {
      if (nsync == 0) cg::this_grid().sync();
      else xcd_barrier(xb);
      ++nsync;
    }
    first = false;
    int nrep = 1;
    if (PROBE_PH) {
      if (s == 0) nrep += (PROBE_PH >> 15) & 1;
      else if (s < NSTEPS - 1) {
        const int lay_ = (s - 1) / STEPS_PER_LAYER, ph_ = (s - 1) % STEPS_PER_LAYER;
        nrep += (PROBE_PH >> ph_) & 1;
        if (ph_ == 2 && ((PROBE_PH >> 9) & 1) && !(lay_ & 1)) nrep = 2;
        if (ph_ == 2 && ((PROBE_PH >> 10) & 1) && (lay_ & 1)) nrep = 2;
        if (ph_ == 1 && ((PROBE_PH >> 12) & 1) && !(lay_ & 1)) nrep = 2;
        if (ph_ == 1 && ((PROBE_PH >> 13) & 1) && (lay_ & 1)) nrep = 2;
        if (ph_ == 4 && ((PROBE_PH >> 11) & 1) && !(lay_ & 1)) nrep = 2;
        if (ph_ == 4 && ((PROBE_PH >> 14) & 1) && (lay_ & 1)) nrep = 2;
      }
      asm volatile("" : "+s"(nrep));
    }
#pragma nounroll
    for (int rep = nrep - 1; rep >= 0; --rep) {
      if (rep != nrep - 1) xcd_barrier(xb);
      PP q = pp;
      asm volatile("" : "+s"(q));
      int gi = __builtin_amdgcn_readfirstlane(rep ? 0 : 0x3f800000);
      if (PROBE_PH) asm volatile("" : "+s"(gi));
      const float gs = __int_as_float(gi);
      if (PROBE_PH) run_step(q, s, lds, lds_all, gs);
      else run_step(q, s, lds, lds_all);
    }
  }
}

static size_t align_up(size_t v) { return (v + 255) & ~(size_t)255; }

extern "C" void kernel_launch(void* const* d_in, const int* in_sizes, int n_in, void* d_out, int out_size, void* d_ws,
                              size_t ws_size, hipStream_t stream) {
  Params p{};
  p.x = (const float*)d_in[0];
  p.c = (const float*)d_in[1];
  p.ctx = (const float*)d_in[2];
  p.c_ctx = (const float*)d_in[3];
  p.ada_w = (const float*)d_in[4];
  p.ada_b = (const float*)d_in[5];
  p.norm_mix_w = (const float*)d_in[6];
  p.norm_ffn_w = (const float*)d_in[7];
  p.ab_w_in = (const float*)d_in[8];
  p.ab_w_out = (const float*)d_in[9];
  p.attn_sink = (const float*)d_in[10];
  p.gs_w_in = (const float*)d_in[11];
  p.gs_norm_w = (const float*)d_in[12];
  p.gs_w_s = (const float*)d_in[13];
  p.gs_b_s = (const float*)d_in[14];
  p.gs_w_out = (const float*)d_in[15];
  p.peer_w_q = (const float*)d_in[16];
  p.peer_keys = (const float*)d_in[17];
  p.peer_u = (const float*)d_in[18];
  p.peer_v = (const float*)d_in[19];
  p.norm_out_w = (const float*)d_in[20];
  p.out = (float*)d_out;
  unsigned char* w = (unsigned char*)d_ws;
  size_t off = 0;
  auto take = [&](size_t bytes) {
    unsigned char* r = w + off;
    off = align_up(off + bytes);
    return r;
  };
  p.bar = (unsigned*)take((size_t)XCD_BAR_WORDS * 4);
  p.mod = (float*)take((size_t)DEPTH * 9 * 6144 * 4);
  p.cs = (float2*)take(64 * 16 * 8);
  p.xs = (float*)take((size_t)TT * D * 4);
  p.h = (bf16_t*)take((size_t)TT * D * 2);
  p.P = (bf16_t*)take((size_t)TT * 2048 * 2);
  p.kbuf = (bf16_t*)take((size_t)NB * 2 * KVLEN * 64 * 2);
  p.vbuf = (bf16_t*)take((size_t)NB * 2 * KVLEN * 64 * 2);
  p.zvT = (bf16_t*)take((size_t)TT * 1024 * 2);
  p.rowss = (float*)take((size_t)(TT / 128) * 32 * 128 * 4);
  p.mix = (bf16_t*)take((size_t)TT * LDMIX * 2);
  p.fa = (bf16_t*)take((size_t)TL * 1024 * 2);
  p.tops = (float*)take((size_t)TT * 256 * 4);
  p.eidx = (int*)take((size_t)TT * 128 * 4);
  p.gate = (float*)take((size_t)TT * 128 * 4);
  p.wt_in_ab = (bf16_t*)take((size_t)2 * 1280 * D * 2);
  p.wt_out_ab = (bf16_t*)take((size_t)2 * D * LDMIX * 2);
  p.wt_in_gs = (bf16_t*)take((size_t)2 * 2048 * D * 2);
  p.wt_out_gs = (bf16_t*)take((size_t)2 * D * D * 2);
  p.wt_q = (bf16_t*)take((size_t)DEPTH * 2048 * D * 2);
  p.keysb = (bf16_t*)take((size_t)DEPTH * 8 * 2 * 128 * 128 * 2);
  p.su = (float*)take((size_t)DEPTH * NEXP * 4);
  p.sv = (float*)take((size_t)DEPTH * NEXP * 4);
  p.h8 = (signed char*)take((size_t)TT * D);
  p.sx = (float*)take((size_t)TT * 4);
  p.utab = (unsigned char*)take((size_t)DEPTH * NEXP * D);
  p.vtab = (unsigned char*)take((size_t)DEPTH * NEXP * D);
  if (off > ws_size) {
    fprintf(stderr, "workspace too small: need %zu have %zu\n", off, ws_size);
    return;
  }
  hipMemsetAsync(p.bar, 0, (size_t)XCD_BAR_WORDS * 4, stream);
  static int grid_blocks = 0;
  if (!grid_blocks) {
    int dev = 0, cus = 0, per_cu = 0;
    hipGetDevice(&dev);
    hipDeviceGetAttribute(&cus, hipDeviceAttributeMultiprocessorCount, dev);
    hipOccupancyMaxActiveBlocksPerMultiprocessor(&per_cu, mega, PHYS_THREADS, 0);
    if (per_cu > 1) per_cu = 1;
    if (per_cu < 1) per_cu = 1;
    grid_blocks = cus * per_cu;
  }
#if ONE_LAUNCH
  int lo = 0, hi = NSTEPS;
  void* args[] = {&p, &lo, &hi};
  hipError_t e = hipLaunchCooperativeKernel((void*)mega, dim3(grid_blocks), dim3(PHYS_THREADS), args, 0, stream);
  if (e != hipSuccess) fprintf(stderr, "cooperative launch failed: %s (grid %d)\n", hipGetErrorString(e), grid_blocks);
#else
  for (int s = 0; s < NSTEPS; ++s) {
    if (s != 0 && s != NSTEPS - 1) {
      int layer = (s - 1) / STEPS_PER_LAYER, ph = (s - 1) % STEPS_PER_LAYER;
      if (ph == 3 && (layer & 1)) continue;
    }
    hipLaunchKernelGGL(mega, dim3(grid_blocks), dim3(NTHREADS), 0, stream, p, s, s + 1);
  }
#endif
}
```

```cpp
#include <hip/hip_runtime.h>
#include <hip/hip_bf16.h>
#include <hip/hip_cooperative_groups.h>
#include <cstdio>
namespace cg = cooperative_groups;

#ifndef PROBE_PH
#define PROBE_PH 0
#endif
#ifndef REP_MASK
#define REP_MASK 0
#endif
#ifndef REP_MODE
#define REP_MODE 0
#endif
#ifndef REP_IDMASK
#define REP_IDMASK 0xffff
#endif
#ifndef ONE_LAUNCH
#define ONE_LAUNCH 1
#endif

#define DEVI __device__ __forceinline__
typedef unsigned short bf16_t;
using bf16x8 = __attribute__((ext_vector_type(8))) short;
using f32x4 = __attribute__((ext_vector_type(4))) float;
using f32x16 = __attribute__((ext_vector_type(16))) float;

constexpr int D = 1024, NB = 8, SEQ = 4096, CTX = 256, DEPTH = 4;
constexpr int TL = NB * SEQ, TC = NB * CTX, TT = TL + TC;
constexpr int KVLEN = CTX + SEQ;
constexpr int NEXP = 16384;
constexpr int LDMIX = 1536;
constexpr float USCALE = 64.f, VSCALE = 8.f;
constexpr int TPB = 68;
constexpr int LDS_HALF = 68 * 1024;
constexpr int LDS_BYTES = 2 * LDS_HALF;
constexpr int PHYS_THREADS = 512;
constexpr int NTHREADS = 256;
constexpr int STEPS_PER_LAYER = 9;
constexpr int NSTEPS = 1 + DEPTH * STEPS_PER_LAYER + 1;

struct Params {
  const float *x, *c, *ctx, *c_ctx, *ada_w, *ada_b, *norm_mix_w, *norm_ffn_w, *ab_w_in, *ab_w_out, *attn_sink,
      *gs_w_in, *gs_norm_w, *gs_w_s, *gs_b_s, *gs_w_out, *peer_w_q, *peer_keys, *peer_u, *peer_v, *norm_out_w;
  float* out;
  float* mod;
  float2* cs;
  float* xs;
  bf16_t* h;
  bf16_t* P;
  bf16_t* kbuf;
  bf16_t* vbuf;
  float* rowss;
  bf16_t* zvT;
  bf16_t* mix;
  bf16_t* fa;
  unsigned* bar;
  float* tops;
  int* eidx;
  float* gate;
  bf16_t *wt_in_ab, *wt_out_ab, *wt_in_gs, *wt_out_gs, *wt_q, *keysb;
  unsigned char *utab, *vtab;
  float* su;
  float* sv;
  signed char* h8;
  float* sx;
};

typedef const __attribute__((address_space(4))) Params* PP;

__shared__ __attribute__((aligned(16))) unsigned char g_lds[LDS_BYTES];
DEVI int hw_slot() {
  int h = (int)(__builtin_amdgcn_s_getreg((6 - 1) << 11 | 0 << 6 | 4) & 63u);
  asm volatile("" : "+s"(h));
  return h;
}
DEVI int wave_index() {
  int w = *reinterpret_cast<volatile int*>(g_lds + LDS_BYTES - 16 - 256 + 4 * hw_slot());
  return __builtin_amdgcn_readfirstlane(w);
}
DEVI int lane_id() { return (int)__builtin_amdgcn_mbcnt_hi(~0u, __builtin_amdgcn_mbcnt_lo(~0u, 0u)); }
DEVI int ltid() { int t = ((wave_index() & 3) << 6) | lane_id(); asm volatile("" : "+v"(t)); return t; }
DEVI int lbid() { int t = 2 * blockIdx.x + (wave_index() >> 2); asm volatile("" : "+s"(t)); return t; }
DEVI int lnblk() { int t = 2 * gridDim.x; asm volatile("" : "+s"(t)); return t; }
DEVI int ptid() { int t = (wave_index() << 6) | lane_id(); asm volatile("" : "+v"(t)); return t; }
DEVI int pbid() { int t = blockIdx.x; asm volatile("" : "+s"(t)); return t; }
DEVI int pnblk() { int t = gridDim.x; asm volatile("" : "+s"(t)); return t; }

typedef __bf16 bf2v_t __attribute__((ext_vector_type(2)));
typedef float f2v_t __attribute__((ext_vector_type(2)));
DEVI bf16_t f2bf(float f) { return __builtin_bit_cast(unsigned short, (__bf16)f); }
DEVI float bf2f(bf16_t h) { return __uint_as_float(((unsigned)h) << 16); }
DEVI float bflo(unsigned u) { return __uint_as_float(u << 16); }
DEVI float bfhi(unsigned u) { return __uint_as_float(u & 0xffff0000u); }
DEVI unsigned pack2(float a, float b) {
  f2v_t v = {a, b};
  return __builtin_bit_cast(unsigned, __builtin_convertvector(v, bf2v_t));
}
DEVI float gelu_tanh(float x) {
  const float k1 = -2.f * 0.7978845608028654f * 1.4426950408889634f;
  const float a = x * __builtin_fmaf(x * x, k1 * 0.044715f, k1);
  return x * __builtin_amdgcn_rcpf(1.f + __builtin_amdgcn_exp2f(a));
}
template <int CTRL>
DEVI float dpp_mov(float v) {
  return __builtin_bit_cast(float, __builtin_amdgcn_mov_dpp(__builtin_bit_cast(int, v), CTRL, 0xF, 0xF, true));
}
DEVI int shx_i(int v, int m) { return __builtin_amdgcn_ds_bpermute((lane_id() ^ m) << 2, v); }
DEVI float shx_f(float v, int m) { return __builtin_bit_cast(float, shx_i(__builtin_bit_cast(int, v), m)); }
DEVI float wave_sum(float v) {
  v += dpp_mov<0xB1>(v);
  v += dpp_mov<0x4E>(v);
  v += dpp_mov<0x141>(v);
  v += dpp_mov<0x140>(v);
  v += shx_f(v, 16);
  v += shx_f(v, 32);
  return v;
}
DEVI float wave_max(float v) {
  v = fmaxf(v, dpp_mov<0xB1>(v));
  v = fmaxf(v, dpp_mov<0x4E>(v));
  v = fmaxf(v, dpp_mov<0x141>(v));
  v = fmaxf(v, dpp_mov<0x140>(v));
  v = fmaxf(v, shx_f(v, 16));
  v = fmaxf(v, shx_f(v, 32));
  return v;
}
DEVI int tok_batch(int r) { return r < TL ? (r >> 12) : 8; }

DEVI void prep_transpose_tile(const float* __restrict__ src, int N, bf16_t* __restrict__ dst, int ldk, int tk, int tn, float* tile, int tid) {
#pragma unroll
  for (int i = 0; i < 16; ++i) {
    int r = (tid >> 6) + 4 * i;
    tile[r * 65 + (tid & 63)] = src[(size_t)(tk * 64 + r) * N + tn * 64 + (tid & 63)];
  }
  __syncthreads();
#pragma unroll
  for (int i = 0; i < 16; ++i) {
    int n = (tid >> 6) + 4 * i, k = tid & 63;
    dst[(size_t)(tn * 64 + n) * ldk + tk * 64 + k] = f2bf(tile[k * 65 + n]);
  }
}

constexpr int PU_ADA = DEPTH * 96;
constexpr int PU_T_ABIN = 2 * 16 * 20;
constexpr int PU_T_GSIN = 2 * 16 * 32;
constexpr int PU_T_GSOUT = 2 * 16 * 16;
constexpr int PU_T_ABOUT = 2 * 8 * 16;
constexpr int PU_T_Q = DEPTH * 16 * 32;
constexpr int PU_FOLD = 2 * 4 * 16 * 2;
constexpr int PU_CONV = DEPTH * NEXP * D / 4 / 2048;
constexpr int PU_KEYS = DEPTH * 8 * 2 * 128 * 128 / 4 / 2048;
constexpr int PU_UROWS = DEPTH * NEXP / 32;
constexpr int PU_TOTAL = PU_ADA + PU_T_ABIN + PU_T_GSIN + PU_T_GSOUT + PU_T_ABOUT + PU_T_Q + PU_FOLD + 2 * PU_UROWS + PU_KEYS + 1;

DEVI void phase_prep(PP p, unsigned char* lds) {
  const int tid = ltid();
  float* fl = reinterpret_cast<float*>(lds);
  for (int u0 = lbid(); u0 < PU_TOTAL; u0 += lnblk()) {
    int u = u0;
    if (u < PU_ADA) {
      float* sl = fl;
      for (int i = tid; i < 9 * 1024; i += NTHREADS) {
        int r = i >> 10, k = i & 1023;
        float v = (r < 8) ? p->c[r * 1024 + k] : p->c_ctx[k];
        sl[i] = v / (1.f + __expf(-v));
      }
      __syncthreads();
      float* red = sl + 9 * 1024;
      int ks = tid >> 6, col = tid & 63;
      int layer = u / 96, c0 = (u % 96) * 64;
      const float* w = p->ada_w + (size_t)layer * D * 6144 + c0 + col;
      float acc[9];
#pragma unroll
      for (int r = 0; r < 9; ++r) acc[r] = 0.f;
      for (int k0 = ks * 256; k0 < ks * 256 + 256; k0 += 16) {
        float wv[16];
#pragma unroll
        for (int kk = 0; kk < 16; ++kk) wv[kk] = w[(size_t)(k0 + kk) * 6144];
#pragma unroll
        for (int kk = 0; kk < 16; ++kk)
#pragma unroll
          for (int r = 0; r < 9; ++r) acc[r] += sl[r * 1024 + k0 + kk] * wv[kk];
      }
#pragma unroll
      for (int r = 0; r < 9; ++r) red[(ks * 9 + r) * 64 + col] = acc[r];
      __syncthreads();
      for (int i = tid; i < 9 * 64; i += NTHREADS) {
        int r = i >> 6, cc = i & 63;
        float sm = red[(0 * 9 + r) * 64 + cc] + red[(1 * 9 + r) * 64 + cc] + red[(2 * 9 + r) * 64 + cc] + red[(3 * 9 + r) * 64 + cc];
        sm += p->ada_b[(size_t)layer * 6144 + c0 + cc];
        p->mod[((size_t)layer * 9 + r) * 6144 + c0 + cc] = sm;
      }
      __syncthreads();
      continue;
    }
    u -= PU_ADA;
    if (u < PU_T_ABIN) {
      int j = u / 320, t = u % 320;
      prep_transpose_tile(p->ab_w_in + (size_t)j * D * 1280, 1280, p->wt_in_ab + (size_t)j * 1280 * D, D, t / 20, t % 20, fl, tid);
      __syncthreads();
      continue;
    }
    u -= PU_T_ABIN;
    if (u < PU_T_GSIN) {
      int j = u / 512, t = u % 512;
      prep_transpose_tile(p->gs_w_in + (size_t)j * D * 2048, 2048, p->wt_in_gs + (size_t)j * 2048 * D, D, t / 32, t % 32, fl, tid);
      __syncthreads();
      continue;
    }
    u -= PU_T_GSIN;
    if (u < PU_T_GSOUT) {
      int j = u / 256, t = u % 256;
      prep_transpose_tile(p->gs_w_out + (size_t)j * D * D, D, p->wt_out_gs + (size_t)j * D * D, D, t / 16, t % 16, fl, tid);
      __syncthreads();
      continue;
    }
    u -= PU_T_GSOUT;
    if (u < PU_T_ABOUT) {
      int j = u / 128, t = u % 128;
      prep_transpose_tile(p->ab_w_out + (size_t)j * D * D, D, p->wt_out_ab + (size_t)j * D * LDMIX, LDMIX, t / 16, t % 16, fl, tid);
      __syncthreads();
      continue;
    }
    u -= PU_T_ABOUT;
    if (u < PU_T_Q) {
      int i = u / 512, t = u % 512;
      prep_transpose_tile(p->peer_w_q + (size_t)i * D * 2048, 2048, p->wt_q + (size_t)i * 2048 * D, D, t / 32, t % 32, fl, tid);
      __syncthreads();
      continue;
    }
    u -= PU_T_Q;
    if (u < PU_FOLD) {
      const int mh = u & 1, nc = (u >> 1) & 15, g = (u >> 5) & 3, j = u >> 7;
      float2* tw = reinterpret_cast<float2*>(lds);
      float* wt = reinterpret_cast<float*>(lds + 1024);
      if (tid < 128) {
        float sn, cn;
        sincospif((float)tid / 64.f, &sn, &cn);
        tw[tid] = make_float2(cn, sn);
      }
      {
        const float* wsrc = p->ab_w_out + (size_t)j * D * D + (size_t)(512 + g * 128) * D + nc * 64;
#pragma unroll 8
        for (int i = 0; i < 32; ++i) {
          int l = (tid >> 6) + 4 * i;
          wt[l * 64 + (tid & 63)] = wsrc[(size_t)l * D + (tid & 63)];
        }
      }
      __syncthreads();
      const int n = tid & 63, mq = __builtin_amdgcn_readfirstlane(tid >> 6);
      bf16_t* dst = p->wt_out_ab + (size_t)j * D * LDMIX + (size_t)(nc * 64 + n) * LDMIX + g * 128;
#pragma unroll 1
      for (int mi = 0; mi < 16; ++mi) {
        const int m = mh * 64 + mq * 16 + mi;
        float ar = 0.f, ai = 0.f;
#pragma unroll 16
        for (int l = 0; l < 128; ++l) {
          float2 t = tw[(m * l) & 127];
          float wv = wt[l * 64 + n];
          ar += t.x * wv;
          ai += t.y * wv;
        }
        dst[512 + m] = f2bf(ar);
        dst[1024 + m] = f2bf(ai);
      }
      __syncthreads();
      continue;
    }
    u -= PU_FOLD;
    if (u < 2 * PU_UROWS) {
      const bool isv = u >= PU_UROWS;
      if (isv) u -= PU_UROWS;
      const float* src = isv ? p->peer_v : p->peer_u;
      unsigned char* dst = isv ? p->vtab : p->utab;
      float* sdst = isv ? p->sv : p->su;
      const int lane = tid & 63, wv = tid >> 6;
#pragma unroll 1
      for (int rr = 0; rr < 8; rr += 4) {
        size_t row0 = (size_t)u * 32 + wv * 8 + rr;
        float4 v[4][4];
#pragma unroll
        for (int k = 0; k < 4; ++k)
#pragma unroll
          for (int i = 0; i < 4; ++i) v[k][i] = reinterpret_cast<const float4*>(src + (row0 + k) * D)[lane * 4 + i];
#pragma unroll
        for (int k = 0; k < 4; ++k) {
          float am = 0.f;
#pragma unroll
          for (int i = 0; i < 4; ++i)
            am = fmaxf(am, fmaxf(fmaxf(fabsf(v[k][i].x), fabsf(v[k][i].y)), fmaxf(fabsf(v[k][i].z), fabsf(v[k][i].w))));
          am = wave_max(am);
          am = fmaxf(am, 1e-30f);
          float qs = 127.f / am;
          uint4 o;
          unsigned* op = reinterpret_cast<unsigned*>(&o);
#pragma unroll
          for (int i = 0; i < 4; ++i) {
            int q0 = (int)rintf(v[k][i].x * qs), q1 = (int)rintf(v[k][i].y * qs), q2 = (int)rintf(v[k][i].z * qs), q3 = (int)rintf(v[k][i].w * qs);
            op[i] = (unsigned)(q0 & 255) | ((unsigned)(q1 & 255) << 8) | ((unsigned)(q2 & 255) << 16) | ((unsigned)(q3 & 255) << 24);
          }
          reinterpret_cast<uint4*>(dst + (row0 + k) * D)[lane] = o;
          if (lane == 0) sdst[row0 + k] = am * (1.f / 127.f);
        }
      }
      continue;
    }
    u -= 2 * PU_UROWS;
    if (u < PU_KEYS) {
      const float4* s4 = reinterpret_cast<const float4*>(p->peer_keys) + (size_t)u * 2048 + tid;
      uint2* d2 = reinterpret_cast<uint2*>(p->keysb) + (size_t)u * 2048 + tid;
#pragma unroll
      for (int k = 0; k < 8; ++k) {
        float4 v = s4[k * 256];
        uint2 o;
        o.x = pack2(v.x, v.y);
        o.y = pack2(v.z, v.w);
        d2[k * 256] = o;
      }
      continue;
    }
    for (int i = tid; i < 64 * 16; i += NTHREADS) {
      int pos = i >> 4, k = i & 15;
      float inv = powf(10000.f, -(float)k / 16.f);
      float ang = (float)pos * inv;
      float sn, cn;
      sincosf(ang, &sn, &cn);
      p->cs[i] = make_float2(cn, sn);
    }
  }
}

DEVI void norm_row(PP p, int layer, int which, int tok, int lane) {
  const float* w = which == 0 ? p->norm_mix_w + layer * D : (which == 1 ? p->norm_ffn_w + layer * D : p->norm_out_w);
  const float* xsrc = p->xs + (size_t)tok * D;
  if (which == 0 && layer == 0) xsrc = (tok < TL) ? p->x + (size_t)tok * D : p->ctx + (size_t)(tok - TL) * D;
  const float4* xr = reinterpret_cast<const float4*>(xsrc);
  float4 v[4];
  float ss = 0.f;
#pragma unroll
  for (int i = 0; i < 4; ++i) {
    v[i] = xr[lane + 64 * i];
    ss += v[i].x * v[i].x + v[i].y * v[i].y + v[i].z * v[i].z + v[i].w * v[i].w;
  }
  ss = wave_sum(ss);
  float rstd = rsqrtf(ss * (1.f / 1024.f) + 1e-6f);
  if (which == 2) {
    float4* o = reinterpret_cast<float4*>(p->out + (size_t)tok * D);
#pragma unroll
    for (int i = 0; i < 4; ++i) {
      float4 wv = reinterpret_cast<const float4*>(w)[lane + 64 * i];
      float4 r;
      r.x = v[i].x * rstd * wv.x;
      r.y = v[i].y * rstd * wv.y;
      r.z = v[i].z * rstd * wv.z;
      r.w = v[i].w * rstd * wv.w;
      o[lane + 64 * i] = r;
    }
  } else {
    int b = tok_batch(tok);
    const float* mb = p->mod + ((size_t)layer * 9 + b) * 6144 + (which == 0 ? 0 : 3072);
    uint2* o = reinterpret_cast<uint2*>(p->h + (size_t)tok * D);
    float av[4][4];
    float am = 0.f;
#pragma unroll
    for (int i = 0; i < 4; ++i) {
      float4 wv = reinterpret_cast<const float4*>(w)[lane + 64 * i];
      float4 sh = reinterpret_cast<const float4*>(mb)[lane + 64 * i];
      float4 sc = reinterpret_cast<const float4*>(mb + 1024)[lane + 64 * i];
      float a0 = v[i].x * rstd * wv.x * (1.f + sc.x) + sh.x;
      float a1 = v[i].y * rstd * wv.y * (1.f + sc.y) + sh.y;
      float a2 = v[i].z * rstd * wv.z * (1.f + sc.z) + sh.z;
      float a3 = v[i].w * rstd * wv.w * (1.f + sc.w) + sh.w;
      uint2 r;
      r.x = pack2(a0, a1);
      r.y = pack2(a2, a3);
      o[lane + 64 * i] = r;
      av[i][0] = a0; av[i][1] = a1; av[i][2] = a2; av[i][3] = a3;
      am = fmaxf(am, fmaxf(fmaxf(fabsf(a0), fabsf(a1)), fmaxf(fabsf(a2), fabsf(a3))));
    }
    if (which == 1) {
      am = fmaxf(wave_max(am), 1e-30f);
      float qs = 127.f / am;
      unsigned* o8 = reinterpret_cast<unsigned*>(p->h8 + (size_t)tok * D);
#pragma unroll
      for (int i = 0; i < 4; ++i) {
        int q0 = (int)rintf(av[i][0] * qs), q1 = (int)rintf(av[i][1] * qs), q2 = (int)rintf(av[i][2] * qs), q3 = (int)rintf(av[i][3] * qs);
        o8[lane + 64 * i] = (unsigned)(q0 & 255) | ((unsigned)(q1 & 255) << 8) | ((unsigned)(q2 & 255) << 16) | ((unsigned)(q3 & 255) << 24);
      }
      if (lane == 0) p->sx[tok] = am * (1.f / 127.f);
    }
  }
}

DEVI void phase_norm(PP p, int layer, int which, int ntok) {
  int lane = ltid() & 63;
  int gw = lbid() * 4 + __builtin_amdgcn_readfirstlane(ltid() >> 6), nw = lnblk() * 4;
  for (int tok = gw; tok < ntok; tok += nw) norm_row(p, layer, which, tok, lane);
}

enum { EPI_STORE = 0, EPI_GELU = 1, EPI_RESID = 2, EPI_INPROJ = 3, EPI_RESID0 = 4 };

template <int EPI>
DEVI void gemm_phase(PP p, const bf16_t* __restrict__ A, int lda, const bf16_t* __restrict__ Bt, int ldb,
                     int Mtiles, int Ntiles, int K, int layer, unsigned char* lds, float gscale = 1.f, int big_t0 = -1, int big_n = 0,
                     int big_ntn = 1) {
  const int tid = ltid();
  const int wid = __builtin_amdgcn_readfirstlane(tid >> 6), lane = tid & 63, wr = wid >> 1, wc = wid & 1, fr = lane & 15, fq = lane >> 4;
  int nblk = lnblk();
  int bid = lbid();
  int lb = bid;
  {
    const int pn = nblk >> 1, pb = bid >> 1;
    if ((pn & 7) == 0) lb = 2 * ((pb & 7) * (pn >> 3) + (pb >> 3)) + (bid & 1);
  }
  int ntiles = (big_t0 >= 0) ? 4 * big_n : Mtiles * Ntiles;
  const int nk = K / 64;
  const int srow = tid >> 3;
  const int scol = ((tid & 7) ^ ((tid >> 3) & 7)) * 8;
#define GEMM_STAGE(ga_, gb_, kt_, buf_)                                                                               \
  {                                                                                                                   \
    _Pragma("unroll") for (int i_ = 0; i_ < 4; ++i_) {                                                                \
      __builtin_amdgcn_global_load_lds((const unsigned*)((ga_) + (size_t)(32 * i_) * lda + (kt_) * 64),               \
                                       (__attribute__((address_space(3))) unsigned*)(lds + (buf_) * 32768 + tid * 16 + i_ * 4096), 16, 0, 0); \
      __builtin_amdgcn_global_load_lds((const unsigned*)((gb_) + (size_t)(32 * i_) * ldb + (kt_) * 64),               \
                                       (__attribute__((address_space(3))) unsigned*)(lds + (buf_) * 32768 + 16384 + tid * 16 + i_ * 4096), 16, 0, 0); \
    }                                                                                                                 \
  }
  auto tile_rc = [&](int t, int& tm_, int& tn_) {
    if (big_t0 >= 0) {
      int bt = big_t0 + (t >> 2), q = t & 3;
      tm_ = 2 * (bt / big_ntn) + (q >> 1);
      tn_ = 2 * (bt % big_ntn) + (q & 1);
    } else {
      tm_ = t / Ntiles;
      tn_ = t % Ntiles;
    }
  };
  if (lb < ntiles) {
    int tm0, tn0;
    tile_rc(lb, tm0, tn0);
    const bf16_t* ga0 = A + (size_t)(tm0 * 128 + srow) * lda + scol;
    const bf16_t* gb0 = Bt + (size_t)(tn0 * 128 + srow) * ldb + scol;
    GEMM_STAGE(ga0, gb0, 0, 0)
  }
  for (int t = lb; t < ntiles; t += nblk) {
    int tm, tn;
    tile_rc(t, tm, tn);
    int brow = tm * 128, bcol = tn * 128;
    f32x4 acc[4][4];
#pragma unroll
    for (int m = 0; m < 4; ++m)
#pragma unroll
      for (int n = 0; n < 4; ++n) acc[m][n] = f32x4{0.f, 0.f, 0.f, 0.f};
    const bf16_t* ga = A + (size_t)(brow + srow) * lda + scol;
    const bf16_t* gb = Bt + (size_t)(bcol + srow) * ldb + scol;
    for (int kt = 0; kt < nk; ++kt) {
      const int buf = kt & 1;
      asm volatile("s_waitcnt vmcnt(0)" ::: "memory");
      __syncthreads();
      if (kt + 1 < nk) GEMM_STAGE(ga, gb, kt + 1, buf ^ 1)
      const unsigned char* SA = lds + buf * 32768;
      const unsigned char* SB = SA + 16384;
      bf16x8 At[2][4], Bl[2][4];
#pragma unroll
      for (int ks = 0; ks < 2; ++ks)
#pragma unroll
        for (int m = 0; m < 4; ++m) {
          const int sl = ((ks * 4 + fq) ^ (fr & 7)) << 4;
          At[ks][m] = *reinterpret_cast<const bf16x8*>(SA + (wr * 64 + m * 16 + fr) * 128 + sl);
          Bl[ks][m] = *reinterpret_cast<const bf16x8*>(SB + (wc * 64 + m * 16 + fr) * 128 + sl);
        }
#pragma unroll
      for (int ks = 0; ks < 2; ++ks)
#pragma unroll
        for (int m = 0; m < 4; ++m)
#pragma unroll
          for (int n = 0; n < 4; ++n)
            acc[m][n] = __builtin_amdgcn_mfma_f32_16x16x32_bf16(At[ks][m], Bl[ks][n], acc[m][n], 0, 0, 0);
    }
    {
      int t2 = t + nblk;
      if (t2 < ntiles) {
        int tm2, tn2;
        tile_rc(t2, tm2, tn2);
        const bf16_t* ga2 = A + (size_t)(tm2 * 128 + srow) * lda + scol;
        const bf16_t* gb2 = Bt + (size_t)(tn2 * 128 + srow) * ldb + scol;
        GEMM_STAGE(ga2, gb2, 0, 0)
      }
    }
    const int colbase = bcol + wc * 64;
    if constexpr (EPI == EPI_STORE || EPI == EPI_GELU) {
      if (EPI == EPI_GELU && colbase >= 1024) {
        float* rsp = p->rowss + ((size_t)tm * 32 + ((colbase - 1024) >> 5)) * 128;
#pragma unroll
        for (int m = 0; m < 4; ++m) {
          float ssq[4] = {0.f, 0.f, 0.f, 0.f};
#pragma unroll
          for (int n = 0; n < 4; ++n) {
            int ch = colbase - 1024 + n * 16 + fr;
            int q0 = wr * 64 + m * 16 + fq * 4;
            float g0 = gelu_tanh(acc[m][n][0]), g1 = gelu_tanh(acc[m][n][1]), g2 = gelu_tanh(acc[m][n][2]), g3 = gelu_tanh(acc[m][n][3]);
            ssq[0] += g0 * g0;
            ssq[1] += g1 * g1;
            ssq[2] += g2 * g2;
            ssq[3] += g3 * g3;
            uint2 o;
            o.x = pack2(g0, g1);
            o.y = pack2(g2, g3);
            *reinterpret_cast<uint2*>(p->zvT + ((size_t)tm * 1024 + ch) * 128 + q0) = o;
          }
#pragma unroll
          for (int j = 0; j < 4; ++j) {
            float v = ssq[j];
            v += dpp_mov<0xB1>(v);
            v += dpp_mov<0x4E>(v);
            v += dpp_mov<0x141>(v);
            v += dpp_mov<0x140>(v);
            if (fr == 0) {
              rsp[wr * 64 + m * 16 + fq * 4 + j] = v;
              rsp[128 + wr * 64 + m * 16 + fq * 4 + j] = 0.f;
            }
          }
        }
      } else {
#pragma unroll
        for (int m = 0; m < 4; ++m)
#pragma unroll
          for (int j = 0; j < 4; ++j) {
            int row = brow + wr * 64 + m * 16 + fq * 4 + j;
            bf16_t* o = p->P + (size_t)row * 2048 + colbase + fr;
#pragma unroll
            for (int n = 0; n < 4; ++n) {
              float v = acc[m][n][j];
              if (EPI == EPI_GELU) v = gelu_tanh(v);
              o[n * 16] = f2bf(v);
            }
          }
      }
    } else if constexpr (EPI == EPI_RESID) {
#pragma unroll
      for (int m = 0; m < 4; ++m)
#pragma unroll
        for (int j = 0; j < 4; ++j) {
          int row = brow + wr * 64 + m * 16 + fq * 4 + j;
          int b = tok_batch(row);
          const float* g = p->mod + ((size_t)layer * 9 + b) * 6144 + 2048 + colbase + fr;
          float* o = p->xs + (size_t)row * D + colbase + fr;
          const float* xi = o;
          if (layer == 0 && gscale == 1.f)
            xi = ((row < TL) ? p->x + (size_t)row * D : p->ctx + (size_t)(row - TL) * D) + colbase + fr;
#pragma unroll
          for (int n = 0; n < 4; ++n) o[n * 16] = xi[n * 16] + gscale * g[n * 16] * acc[m][n][j];
        }
    } else if constexpr (EPI == EPI_INPROJ) {
      if (colbase >= 640 && colbase < 768) {
        int kvh = (colbase - 640) >> 6;
#pragma unroll
        for (int m = 0; m < 4; ++m) {
          int row0 = brow + wr * 64 + m * 16;
          bool latent = row0 < TL;
          int b = latent ? (row0 >> 12) : ((row0 - TL) >> 8);
          int kp16 = latent ? (CTX + (row0 & 4095)) : ((row0 - TL) & 255);
          int slot = kp16 + 8 * (fq & 1) + 4 * (fq >> 1);
#pragma unroll
          for (int n = 0; n < 4; ++n) {
            int dim = n * 16 + fr;
            uint2 o;
            o.x = pack2(acc[m][n][0], acc[m][n][1]);
            o.y = pack2(acc[m][n][2], acc[m][n][3]);
            *reinterpret_cast<uint2*>(p->vbuf + ((size_t)(b * 2 + kvh) * 64 + dim) * KVLEN + slot) = o;
          }
        }
      } else {
#pragma unroll
        for (int m = 0; m < 4; ++m)
#pragma unroll
          for (int j = 0; j < 4; ++j) {
            int row = brow + wr * 64 + m * 16 + fq * 4 + j;
            bool latent = row < TL;
            int b, pos;
            if (latent) {
              b = row >> 12;
              pos = row & 4095;
            } else {
              b = (row - TL) >> 8;
              pos = (row - TL) & 255;
            }
            float v0 = acc[m][0][j], v1 = acc[m][1][j], v2 = acc[m][2][j], v3 = acc[m][3][j];
            if (latent && colbase < 640) {
              float2 cr = p->cs[(pos >> 6) * 16 + fr];
              float2 cc = p->cs[(pos & 63) * 16 + fr];
              float a = v0, bb = v1;
              v0 = a * cr.x - bb * cr.y;
              v1 = bb * cr.x + a * cr.y;
              a = v2;
              bb = v3;
              v2 = a * cc.x - bb * cc.y;
              v3 = bb * cc.x + a * cc.y;
            }
            bf16_t* o;
            if (colbase < 512 || colbase >= 768) {
              o = p->P + (size_t)row * 2048 + colbase + fr;
            } else {
              int kvh = (colbase - 512) >> 6;
              int kp = latent ? (CTX + pos) : pos;
              o = p->kbuf + ((size_t)(b * 2 + kvh) * KVLEN + kp) * 64 + fr;
            }
            o[0] = f2bf(v0);
            o[16] = f2bf(v1);
            o[32] = f2bf(v2);
            o[48] = f2bf(v3);
          }
      }
    }
  }
}

constexpr int G8_HT = 128 * 64;
DEVI int g8_lds_byte(int r, int c) {
  int st = (r >> 4) * 2 + (c >> 5), rr = r & 15, cc = c & 31, ob = rr * 64 + cc * 2;
  return st * 1024 + (ob ^ (((ob >> 9) & 1) << 5));
}
DEVI void g8_stage_rc(int b, int& R, int& C) {
  int st = b / 1024, sb = b % 1024, swz = sb ^ (((sb >> 9) & 1) << 5);
  R = (st >> 1) * 16 + swz / 64;
  C = (st & 1) * 32 + (swz % 64) / 2;
}
template <int EPI, bool STAGED>
DEVI void gemm8_epilogue(PP p, f32x4 (&acc)[2][2][4][2], const f32x4* stg, int lane, int brow, int bcol, int wr, int wc, int fr, int fq, int layer, float gscale) {
#pragma unroll
  for (int ai_ = 0; ai_ < 2; ++ai_)
#pragma unroll
    for (int bj = 0; bj < 2; ++bj) {
      const int ai = STAGED ? 1 - ai_ : ai_;
      f32x4 q[4][2];
#pragma unroll
      for (int m = 0; m < 4; ++m)
#pragma unroll
        for (int n = 0; n < 2; ++n) q[m][n] = (STAGED && ai == 0) ? stg[(((bj * 4 + m) * 2 + n) * 64) + lane] : acc[ai][bj][m][n];
      const int r0 = brow + ai * 128 + wr * 64;
      const int c0 = bcol + bj * 128 + wc * 32;
      if constexpr (EPI == EPI_STORE) {
#pragma unroll
        for (int m = 0; m < 4; ++m)
#pragma unroll
          for (int j = 0; j < 4; ++j) {
            bf16_t* o = p->P + (size_t)(r0 + m * 16 + fq * 4 + j) * 2048 + c0 + fr;
            o[0] = f2bf(q[m][0][j]);
            o[16] = f2bf(q[m][1][j]);
          }
      } else if constexpr (EPI == EPI_GELU) {
        if (c0 >= 1024) {
          const int chunk = r0 >> 7;
          float* rsp = p->rowss + ((size_t)chunk * 32 + ((c0 - 1024) >> 5)) * 128;
#pragma unroll
          for (int m = 0; m < 4; ++m) {
            float ssq[4] = {0.f, 0.f, 0.f, 0.f};
            const int q0 = (r0 & 127) + m * 16 + fq * 4;
#pragma unroll
            for (int n = 0; n < 2; ++n) {
              int ch = c0 - 1024 + n * 16 + fr;
              float g0 = gelu_tanh(q[m][n][0]), g1 = gelu_tanh(q[m][n][1]);
              float g2 = gelu_tanh(q[m][n][2]), g3 = gelu_tanh(q[m][n][3]);
              ssq[0] += g0 * g0;
              ssq[1] += g1 * g1;
              ssq[2] += g2 * g2;
              ssq[3] += g3 * g3;
              uint2 o;
              o.x = pack2(g0, g1);
              o.y = pack2(g2, g3);
              *reinterpret_cast<uint2*>(p->zvT + ((size_t)chunk * 1024 + ch) * 128 + q0) = o;
            }
#pragma unroll
            for (int j = 0; j < 4; ++j) {
              float v = ssq[j];
              v += dpp_mov<0xB1>(v);
              v += dpp_mov<0x4E>(v);
              v += dpp_mov<0x141>(v);
              v += dpp_mov<0x140>(v);
              if (fr == 0) rsp[q0 + j] = v;
            }
          }
        } else {
#pragma unroll
          for (int m = 0; m < 4; ++m)
#pragma unroll
            for (int j = 0; j < 4; ++j) {
              bf16_t* o = p->P + (size_t)(r0 + m * 16 + fq * 4 + j) * 2048 + c0 + fr;
              o[0] = f2bf(gelu_tanh(q[m][0][j]));
              o[16] = f2bf(gelu_tanh(q[m][1][j]));
            }
        }
      } else if constexpr (EPI == EPI_RESID || EPI == EPI_RESID0) {
        const float* g = p->mod + ((size_t)layer * 9 + tok_batch(brow)) * 6144 + 2048 + c0 + fr;
        const float g0 = g[0], g1 = g[16];
        const float* xin = (brow < TL) ? p->x : p->ctx - (size_t)TL * D;
#pragma unroll
        for (int m = 0; m < 4; ++m)
#pragma unroll
          for (int j = 0; j < 4; ++j) {
            const size_t ro = (size_t)(r0 + m * 16 + fq * 4 + j) * D + c0 + fr;
            float* o = p->xs + ro;
            const float* xi = (EPI == EPI_RESID0) ? xin + ro : o;
            o[0] = xi[0] + g0 * q[m][0][j];
            o[16] = xi[16] + g1 * q[m][1][j];
          }
      } else if constexpr (EPI == EPI_INPROJ) {
        if (c0 >= 640 && c0 < 768) {
          const int kvh = (c0 - 640) >> 6, d0 = (c0 - 640) & 63;
#pragma unroll
          for (int m = 0; m < 4; ++m) {
            int row0 = r0 + m * 16;
            bool latent = row0 < TL;
            int b = latent ? (row0 >> 12) : ((row0 - TL) >> 8);
            int kp16 = latent ? (CTX + (row0 & 4095)) : ((row0 - TL) & 255);
            int slot = kp16 + 8 * (fq & 1) + 4 * (fq >> 1);
#pragma unroll
            for (int n = 0; n < 2; ++n) {
              int dim = d0 + n * 16 + fr;
              uint2 o;
              o.x = pack2(q[m][n][0], q[m][n][1]);
              o.y = pack2(q[m][n][2], q[m][n][3]);
              *reinterpret_cast<uint2*>(p->vbuf + ((size_t)(b * 2 + kvh) * 64 + dim) * KVLEN + slot) = o;
            }
          }
        } else {
          const int hsel = (c0 >> 5) & 1;
#pragma unroll
          for (int m = 0; m < 4; ++m)
#pragma unroll
            for (int j = 0; j < 4; ++j) {
              int row = r0 + m * 16 + fq * 4 + j;
              bool latent = row < TL;
              int b, pos;
              if (latent) {
                b = row >> 12;
                pos = row & 4095;
              } else {
                b = (row - TL) >> 8;
                pos = (row - TL) & 255;
              }
              float v0 = q[m][0][j], v1 = q[m][1][j];
              if (latent && c0 < 640) {
                float2 cs = p->cs[(hsel ? (pos & 63) : (pos >> 6)) * 16 + fr];
                float a = v0, bb = v1;
                v0 = a * cs.x - bb * cs.y;
                v1 = bb * cs.x + a * cs.y;
              }
              bf16_t* o;
              if (c0 < 512 || c0 >= 768) {
                o = p->P + (size_t)row * 2048 + c0 + fr;
              } else {
                int kvh = (c0 - 512) >> 6, d0 = (c0 - 512) & 63;
                int kp = latent ? (CTX + pos) : pos;
                o = p->kbuf + ((size_t)(b * 2 + kvh) * KVLEN + kp) * 64 + d0 + fr;
              }
              o[0] = f2bf(v0);
              o[16] = f2bf(v1);
            }
        }
      }
      __builtin_amdgcn_sched_barrier(0);
    }
}

DEVI int g8_perm32(int rho) { const int n = rho >> 4, i = rho & 15; return 8 * (i >> 2) + 4 * n + (i & 3); }
template <int EPI>
DEVI void gemm8_epilogue_tr(PP p, f32x4 (&acc)[2][2][4][2], int brow, int bcol, int wr, int wc, int fr, int fq, int layer, float gscale) {
  if constexpr (EPI == EPI_STORE) {
#pragma unroll
    for (int ai = 0; ai < 2; ++ai)
#pragma unroll
      for (int m = 0; m < 4; ++m) {
        bf16_t* o = p->P + (size_t)(brow + ai * 128 + wr * 64 + m * 16 + fr) * 2048 + bcol + wc * 32 + 8 * fq;
#pragma unroll
        for (int bj = 0; bj < 2; ++bj) {
          const f32x4 v0 = acc[ai][bj][m][0], v1 = acc[ai][bj][m][1];
          uint4 w;
          w.x = pack2(v0[0], v0[1]);
          w.y = pack2(v0[2], v0[3]);
          w.z = pack2(v1[0], v1[1]);
          w.w = pack2(v1[2], v1[3]);
          *reinterpret_cast<uint4*>(o + bj * 128) = w;
        }
      }
  } else if constexpr (EPI == EPI_RESID || EPI == EPI_RESID0) {
    const float* xin = (brow < TL) ? p->x : p->ctx - (size_t)TL * D;
#pragma unroll
    for (int bj = 0; bj < 2; ++bj) {
      const int c0 = bcol + bj * 128 + wc * 32 + 4 * fq;
      const float* g = p->mod + ((size_t)layer * 9 + tok_batch(brow)) * 6144 + 2048 + c0;
      const f32x4 g0 = *reinterpret_cast<const f32x4*>(g) * gscale, g1 = *reinterpret_cast<const f32x4*>(g + 16) * gscale;
      f32x4 xr[2][4][2];
#pragma unroll
      for (int ai = 0; ai < 2; ++ai)
#pragma unroll
        for (int m = 0; m < 4; ++m) {
          const size_t ro = (size_t)(brow + ai * 128 + wr * 64 + m * 16 + fr) * D + c0;
          const float* xi = (EPI == EPI_RESID0) ? xin + ro : p->xs + ro;
          xr[ai][m][0] = *reinterpret_cast<const f32x4*>(xi);
          xr[ai][m][1] = *reinterpret_cast<const f32x4*>(xi + 16);
        }
      __builtin_amdgcn_sched_barrier(0);
#pragma unroll
      for (int ai = 0; ai < 2; ++ai)
#pragma unroll
        for (int m = 0; m < 4; ++m) {
          float* o = p->xs + (size_t)(brow + ai * 128 + wr * 64 + m * 16 + fr) * D + c0;
          *reinterpret_cast<f32x4*>(o) = xr[ai][m][0] + g0 * acc[ai][bj][m][0];
          *reinterpret_cast<f32x4*>(o + 16) = xr[ai][m][1] + g1 * acc[ai][bj][m][1];
        }
      __builtin_amdgcn_sched_barrier(0);
    }
  } else if constexpr (EPI == EPI_INPROJ) {
    const bool latent = brow < TL;
#pragma unroll
    for (int bj = 0; bj < 2; ++bj) {
      const int c0 = bcol + bj * 128 + wc * 32;
      if (c0 >= 640 && c0 < 768) {
        const int kvh = (c0 - 640) >> 6, d0 = ((c0 - 640) & 63) + 4 * fq;
        const int so = 8 * ((fr >> 2) & 1) + 4 * (fr >> 3) + (fr & 3);
#pragma unroll
        for (int ai = 0; ai < 2; ++ai)
#pragma unroll
          for (int m = 0; m < 4; ++m) {
            const int row0 = brow + ai * 128 + wr * 64 + m * 16;
            const int b = latent ? (row0 >> 12) : ((row0 - TL) >> 8);
            const int kp16 = latent ? (CTX + (row0 & 4095)) : ((row0 - TL) & 255);
            bf16_t* o = p->vbuf + ((size_t)(b * 2 + kvh) * 64 + d0) * KVLEN + kp16 + so;
#pragma unroll
            for (int n = 0; n < 2; ++n)
#pragma unroll
              for (int j = 0; j < 4; ++j) o[(size_t)(n * 16 + j) * KVLEN] = f2bf(acc[ai][bj][m][n][j]);
          }
      } else {
        const int hsel = (c0 >> 5) & 1;
#pragma unroll
        for (int ai = 0; ai < 2; ++ai)
#pragma unroll
          for (int m = 0; m < 4; ++m) {
            const int row = brow + ai * 128 + wr * 64 + m * 16 + fr;
            const int b = latent ? (row >> 12) : ((row - TL) >> 8);
            const int pos = latent ? (row & 4095) : ((row - TL) & 255);
            f32x4 v0 = acc[ai][bj][m][0], v1 = acc[ai][bj][m][1];
            if (latent && c0 < 640) {
              const f32x4* cp = reinterpret_cast<const f32x4*>(p->cs + (hsel ? (pos & 63) : (pos >> 6)) * 16 + 4 * fq);
              const f32x4 ca = cp[0], cb = cp[1];
              const f32x4 a = v0, bb = v1;
              v0[0] = a[0] * ca[0] - bb[0] * ca[1];
              v1[0] = bb[0] * ca[0] + a[0] * ca[1];
              v0[1] = a[1] * ca[2] - bb[1] * ca[3];
              v1[1] = bb[1] * ca[2] + a[1] * ca[3];
              v0[2] = a[2] * cb[0] - bb[2] * cb[1];
              v1[2] = bb[2] * cb[0] + a[2] * cb[1];
              v0[3] = a[3] * cb[2] - bb[3] * cb[3];
              v1[3] = bb[3] * cb[2] + a[3] * cb[3];
            }
            bf16_t* o;
            if (c0 < 512 || c0 >= 768) {
              o = p->P + (size_t)row * 2048 + c0 + 4 * fq;
            } else {
              const int kvh = (c0 - 512) >> 6, d0 = (c0 - 512) & 63;
              const int kp = latent ? (CTX + pos) : pos;
              o = p->kbuf + ((size_t)(b * 2 + kvh) * KVLEN + kp) * 64 + d0 + 4 * fq;
            }
            uint2 w0, w1;
            w0.x = pack2(v0[0], v0[1]);
            w0.y = pack2(v0[2], v0[3]);
            w1.x = pack2(v1[0], v1[1]);
            w1.y = pack2(v1[2], v1[3]);
            *reinterpret_cast<uint2*>(o) = w0;
            *reinterpret_cast<uint2*>(o + 16) = w1;
          }
      }
      __builtin_amdgcn_sched_barrier(0);
    }
  }
}

template <int EPI>
DEVI void gemm8_phase(PP p, const bf16_t* __restrict__ A, int lda, const bf16_t* __restrict__ Bt, int ldb, int Mtiles, int Ntiles,
                      int K, int layer, unsigned char* lds_all, float gscale = 1.f) {
  constexpr bool TR = (EPI != EPI_GELU);
  constexpr bool PERM = (EPI == EPI_STORE);
  bf16_t* shm = reinterpret_cast<bf16_t*>(lds_all);
  const int tid = ptid();
  const int wid = __builtin_amdgcn_readfirstlane(tid >> 6), lane = tid & 63, wr = wid >> 2, wc = wid & 3, fr = lane & 15, fq = lane >> 4;
#define G8_SA(b, h) (shm + ((b) * 2 + (h)) * G8_HT)
#define G8_SB(b, h) (shm + (4 + (b) * 2 + (h)) * G8_HT)
  const __amdgpu_buffer_rsrc_t rsA = __builtin_amdgcn_make_buffer_rsrc((void*)A, (short)0, -1, 0x00020000);
  const __amdgpu_buffer_rsrc_t rsB = __builtin_amdgcn_make_buffer_rsrc((void*)Bt, (short)0, -1, 0x00020000);
  unsigned voA[2], voB[2];
#pragma unroll
  for (int i = 0; i < 2; ++i) {
    int r_, c_;
    g8_stage_rc(tid * 16 + i * 8192, r_, c_);
    const int rb_ = PERM ? ((r_ & ~31) + g8_perm32(r_ & 31)) : r_;
    voA[i] = (unsigned)((r_ * lda + c_) * 2);
    voB[i] = (unsigned)((rb_ * ldb + c_) * 2);
  }
#define G8_STAGE(P_, RS_, VO_, ld_, br_, kt_)                                                                         \
  do {                                                                                                                \
    const unsigned so_ = (unsigned)(((br_) * (ld_) + (kt_) * 64) * 2);                                                \
    _Pragma("unroll") for (int i_ = 0; i_ < 2; ++i_)                                                                  \
      __builtin_amdgcn_raw_ptr_buffer_load_lds(RS_, (__attribute__((address_space(3))) void*)((unsigned char*)(P_) + wid * 1024 + i_ * 8192), 16, VO_[i_], so_, 0, 0); \
  } while (0)
#define G8_LDA(dst, b, h)                                                                                             \
  _Pragma("unroll") for (int m_ = 0; m_ < 4; ++m_) _Pragma("unroll") for (int k_ = 0; k_ < 2; ++k_)                   \
      dst[m_][k_] = *reinterpret_cast<const bf16x8*>((const unsigned char*)G8_SA(b, h) + g8_lds_byte(wr * 64 + m_ * 16 + fr, k_ * 32 + fq * 8))
#define G8_LDB(dst, b, h)                                                                                             \
  _Pragma("unroll") for (int n_ = 0; n_ < 2; ++n_) _Pragma("unroll") for (int k_ = 0; k_ < 2; ++k_)                   \
      dst[n_][k_] = *reinterpret_cast<const bf16x8*>((const unsigned char*)G8_SB(b, h) + g8_lds_byte(wc * 32 + n_ * 16 + fr, k_ * 32 + fq * 8))
#define G8_MMA(ai, bj, At_, Bt_)                                                                                      \
  do {                                                                                                                \
    __builtin_amdgcn_s_setprio(1);                                                                                    \
    _Pragma("unroll") for (int m_ = 0; m_ < 4; ++m_) _Pragma("unroll") for (int n_ = 0; n_ < 2; ++n_)                 \
        _Pragma("unroll") for (int k_ = 0; k_ < 2; ++k_) acc[ai][bj][m_][n_] =                                        \
            TR ? __builtin_amdgcn_mfma_f32_16x16x32_bf16(Bt_[n_][k_], At_[m_][k_], acc[ai][bj][m_][n_], 0, 0, 0)      \
               : __builtin_amdgcn_mfma_f32_16x16x32_bf16(At_[m_][k_], Bt_[n_][k_], acc[ai][bj][m_][n_], 0, 0, 0);     \
    __builtin_amdgcn_s_setprio(0);                                                                                    \
  } while (0)
#define G8_WAIT_V(n) asm volatile("s_waitcnt vmcnt(" #n ")" ::: "memory")
#define G8_WAIT_L(n) asm volatile("s_waitcnt lgkmcnt(" #n ")" ::: "memory")
#define G8_BAR __builtin_amdgcn_s_barrier()
#define G8_SCHED __builtin_amdgcn_sched_barrier(0)
  const int nblk = pnblk(), bid = pbid();
  const int lb = ((nblk & 7) == 0) ? ((bid & 7) * (nblk >> 3) + (bid >> 3)) : bid;
  const int ntiles_all = Mtiles * Ntiles;
  const int ntiles = (ntiles_all / nblk) * nblk;
  const int nt = K / 64;
  if (lb < ntiles) {
    int t = lb;
    int brow = (t / Ntiles) * 256, bcol = (t % Ntiles) * 256;
    f32x4 acc[2][2][4][2];
#pragma unroll
    for (int a0 = 0; a0 < 2; ++a0)
#pragma unroll
      for (int b0 = 0; b0 < 2; ++b0)
#pragma unroll
        for (int m = 0; m < 4; ++m)
#pragma unroll
          for (int n = 0; n < 2; ++n) acc[a0][b0][m][n] = f32x4{0.f, 0.f, 0.f, 0.f};
    bf16x8 At[4][2], B0[2][2], B1[2][2];
    G8_STAGE(G8_SB(0, 0), rsB, voB, ldb, bcol, 0);
    G8_STAGE(G8_SA(0, 0), rsA, voA, lda, brow, 0);
    G8_STAGE(G8_SB(0, 1), rsB, voB, ldb, bcol + 128, 0);
    G8_STAGE(G8_SA(0, 1), rsA, voA, lda, brow + 128, 0);
    if (wr == 1) G8_BAR;
    G8_WAIT_V(4);
    G8_BAR;
    G8_STAGE(G8_SB(1, 0), rsB, voB, ldb, bcol, 1);
    G8_STAGE(G8_SA(1, 0), rsA, voA, lda, brow, 1);
    G8_STAGE(G8_SB(1, 1), rsB, voB, ldb, bcol + 128, 1);
    G8_WAIT_V(6);
    G8_BAR;
    for (;;) {
      const int tnx = t + nblk;
      const bool has_next = tnx < ntiles;
      const int nbrow = has_next ? (tnx / Ntiles) * 256 : brow, nbcol = has_next ? (tnx % Ntiles) * 256 : bcol;
      for (int kt = 0; kt < nt; kt += 2) {
        const bool last = (kt == nt - 2);
        const int a2 = last ? nbrow : brow, b2 = last ? nbcol : bcol, k2 = last ? 0 : kt + 2;
        G8_LDB(B0, 0, 0); G8_SCHED; G8_LDA(At, 0, 0); G8_STAGE(G8_SA(1, 1), rsA, voA, lda, brow + 128, kt + 1);
        G8_WAIT_L(8); G8_BAR; G8_WAIT_L(0); G8_MMA(0, 0, At, B0); G8_BAR; G8_SCHED;
        G8_LDB(B1, 0, 1); G8_STAGE(G8_SB(0, 0), rsB, voB, ldb, b2, k2);
        G8_BAR; G8_WAIT_L(0); G8_MMA(0, 1, At, B1); G8_BAR;
        G8_LDA(At, 0, 1); G8_STAGE(G8_SA(0, 0), rsA, voA, lda, a2, k2);
        G8_BAR; G8_WAIT_L(0); G8_MMA(1, 0, At, B0); G8_BAR; G8_SCHED;
        G8_STAGE(G8_SB(0, 1), rsB, voB, ldb, b2 + 128, k2);
        G8_WAIT_V(6); G8_BAR; G8_MMA(1, 1, At, B1); G8_BAR;
        G8_LDB(B0, 1, 0); G8_SCHED; G8_LDA(At, 1, 0); G8_STAGE(G8_SA(0, 1), rsA, voA, lda, a2 + 128, k2);
        G8_WAIT_L(8); G8_BAR; G8_WAIT_L(0); G8_MMA(0, 0, At, B0); G8_BAR; G8_SCHED;
        G8_LDB(B1, 1, 1); G8_STAGE(G8_SB(1, 0), rsB, voB, ldb, b2, k2 + 1);
        G8_BAR; G8_WAIT_L(0); G8_MMA(0, 1, At, B1); G8_BAR;
        G8_LDA(At, 1, 1); G8_STAGE(G8_SA(1, 0), rsA, voA, lda, a2, k2 + 1);
        G8_BAR; G8_WAIT_L(0); G8_MMA(1, 0, At, B0); G8_BAR; G8_SCHED;
        G8_STAGE(G8_SB(1, 1), rsB, voB, ldb, b2 + 128, k2 + 1);
        G8_WAIT_V(6); G8_BAR; G8_MMA(1, 1, At, B1); G8_BAR;
      }
      {
        int lane2 = lane_id();
        asm volatile("" : "+v"(lane2));
        const int fr2 = lane2 & 15, fq2 = lane2 >> 4;
        if constexpr (TR) gemm8_epilogue_tr<EPI>(p, acc, brow, bcol, wr, wc, fr2, fq2, layer, gscale);
        else gemm8_epilogue<EPI, false>(p, acc, nullptr, lane2, brow, bcol, wr, wc, fr2, fq2, layer, gscale);
      }
      if (!has_next) break;
#pragma unroll
      for (int a0 = 0; a0 < 2; ++a0)
#pragma unroll
        for (int b0 = 0; b0 < 2; ++b0)
#pragma unroll
          for (int m = 0; m < 4; ++m)
#pragma unroll
            for (int n = 0; n < 2; ++n) acc[a0][b0][m][n] = f32x4{0.f, 0.f, 0.f, 0.f};
      t = tnx;
      brow = nbrow;
      bcol = nbcol;
    }
    G8_WAIT_V(0);
    if (wr == 0) G8_BAR;
  }
  __syncthreads();
  if (ntiles < ntiles_all) {
    constexpr int EPI_T = (EPI == EPI_RESID0) ? EPI_RESID : EPI;
    gemm_phase<EPI_T>(p, A, lda, Bt, ldb, 0, 0, K, layer, lds_all + (wid >> 2) * LDS_HALF, gscale, ntiles, ntiles_all - ntiles, Ntiles);
  }
#undef G8_SA
#undef G8_SB
#undef G8_STAGE
#undef G8_LDA
#undef G8_LDB
#undef G8_MMA
#undef G8_WAIT_V
#undef G8_WAIT_L
#undef G8_BAR
#undef G8_SCHED
}

DEVI bf16x8 scale_q(uint4 u) {
  uint4 r;
  r.x = pack2(bflo(u.x) * 0.125f, bfhi(u.x) * 0.125f);
  r.y = pack2(bflo(u.y) * 0.125f, bfhi(u.y) * 0.125f);
  r.z = pack2(bflo(u.z) * 0.125f, bfhi(u.z) * 0.125f);
  r.w = pack2(bflo(u.w) * 0.125f, bfhi(u.w) * 0.125f);
  return __builtin_bit_cast(bf16x8, r);
}
DEVI void phase_attn(PP p, int layer, bool with_ctx_q, unsigned char* lds) {
  const int tid = ltid();
  const int lane = tid & 63, wid = __builtin_amdgcn_readfirstlane(tid >> 6), r = lane & 31, h = lane >> 5;
  const float* sinkp = p->attn_sink + (layer >> 1) * 8;
  const int nlat = NB * 2 * 128;
  const int nunits = nlat + (with_ctx_q ? NB * 2 * 8 : 0);
  for (int u = lbid(); u < nunits; u += lnblk()) {
    bool latent = u < nlat;
    int b, kvh, qg, tokbase;
    if (latent) {
      b = u >> 8;
      kvh = (u >> 7) & 1;
      qg = u & 127;
      tokbase = b * SEQ + qg * 32;
    } else {
      int v = u - nlat;
      b = v >> 4;
      kvh = (v >> 3) & 1;
      qg = v & 7;
      tokbase = TL + b * CTX + qg * 32;
    }
    const int hd = kvh * 4 + wid;
    const bf16_t* kb = p->kbuf + (size_t)(b * 2 + kvh) * KVLEN * 64;
    const bf16_t* vt = p->vbuf + (size_t)(b * 2 + kvh) * 64 * KVLEN;
    const int nch = latent ? 5 : 2;
    const int lbase = CTX + (qg - 4) * 32;
#define ATT_STAGE(c_, buf_)                                                                                           \
  {                                                                                                                   \
    const int kp0_ = ((c_) < 2) ? (c_) * 128 : lbase + ((c_) - 2) * 128;                                              \
    _Pragma("unroll") for (int i_ = 0; i_ < 4; ++i_) {                                                                \
      const int P_ = tid * 16 + i_ * 4096;                                                                            \
      const int krow_ = P_ >> 7, kslot_ = (P_ >> 4) & 7;                                                              \
      int kp_ = kp0_ + krow_;                                                                                         \
      kp_ = kp_ < 0 ? 0 : (kp_ > KVLEN - 1 ? KVLEN - 1 : kp_);                                                        \
      __builtin_amdgcn_global_load_lds((const unsigned*)(kb + (size_t)kp_ * 64 + ((kslot_ ^ ((krow_ >> 1) & 7)) << 3)), \
                                       (__attribute__((address_space(3))) unsigned*)(lds + (buf_) * 32768 + P_), 16, 0, 0); \
      const int vrow_ = P_ >> 8, vslot_ = (P_ >> 4) & 15;                                                             \
      int vp_ = kp0_ + ((vslot_ ^ (vrow_ & 15)) << 3);                                                                \
      vp_ = vp_ < 0 ? 0 : (vp_ > KVLEN - 8 ? KVLEN - 8 : vp_);                                                        \
      __builtin_amdgcn_global_load_lds((const unsigned*)(vt + (size_t)vrow_ * KVLEN + vp_),                           \
                                       (__attribute__((address_space(3))) unsigned*)(lds + (buf_) * 32768 + 16384 + P_), 16, 0, 0); \
    }                                                                                                                 \
  }
    __syncthreads();
    ATT_STAGE(0, 0)
    bf16x8 qf[4];
    {
      const bf16_t* qp = p->P + (size_t)(tokbase + r) * 2048 + hd * 64 + 8 * h;
#pragma unroll
      for (int st = 0; st < 4; ++st) qf[st] = scale_q(*reinterpret_cast<const uint4*>(qp + 16 * st));
    }
    f32x16 O0, O1;
#pragma unroll
    for (int i = 0; i < 16; ++i) {
      O0[i] = 0.f;
      O1[i] = 0.f;
    }
    float m_run = sinkp[hd];
    float l_run = (h == 0) ? 1.f : 0.f;
    for (int c = 0; c < nch; ++c) {
      const int buf = c & 1;
      asm volatile("s_waitcnt vmcnt(0)" ::: "memory");
      __syncthreads();
      if (c + 1 < nch) ATT_STAGE(c + 1, buf ^ 1)
      const unsigned char* LK = lds + buf * 32768;
      const unsigned char* LV = LK + 16384;
#pragma unroll 1
      for (int kbi = 0; kbi < 4; ++kbi) {
        int mode = 0;
        if (c >= 2) {
          const int d = (c - 2) * 4 + kbi - 4;
          const int kblk = qg + d;
          if (d > 4 || kblk < 0 || kblk > 127) continue;
          mode = (d == -4) ? 1 : ((d == 4) ? 2 : 0);
        }
        f32x16 S;
#pragma unroll
        for (int i = 0; i < 16; ++i) S[i] = 0.f;
        {
          const int krow = kbi * 32 + r;
#pragma unroll
          for (int st = 0; st < 4; ++st) {
            bf16x8 kf = *reinterpret_cast<const bf16x8*>(LK + krow * 128 + (((2 * st + h) ^ ((krow >> 1) & 7)) << 4));
            S = __builtin_amdgcn_mfma_f32_32x32x16_bf16(kf, qf[st], S, 0, 0, 0);
          }
        }
        if (mode) {
          float negbig;
          asm volatile("v_mov_b32 %0, 0xf149f2ca" : "=v"(negbig));
#pragma unroll
          for (int i = 0; i < 16; ++i) {
            int kk = (i & 3) + 8 * (i >> 2) + 4 * h;
            bool ok = (mode == 1) ? (kk >= r) : (kk <= r);
            if (!ok) S[i] = negbig;
          }
        }
        float bm = S[0];
#pragma unroll
        for (int i = 1; i < 16; ++i) bm = fmaxf(bm, S[i]);
        bm = fmaxf(bm, shx_f(bm, 32));
        float m_new = fmaxf(m_run, bm);
        const float L2E = 1.4426950408889634f;
        float nm = -m_new * L2E;
        float psum = 0.f;
#pragma unroll
        for (int i = 0; i < 16; ++i) {
          S[i] = __builtin_amdgcn_exp2f(fmaf(S[i], L2E, nm));
          psum += S[i];
        }
        if (__any(m_new > m_run)) {
          float alpha = __builtin_amdgcn_exp2f((m_run - m_new) * L2E);
          l_run *= alpha;
#pragma unroll
          for (int i = 0; i < 16; ++i) {
            O0[i] *= alpha;
            O1[i] *= alpha;
          }
        }
        l_run += psum;
        m_run = m_new;
#pragma unroll
        for (int sidx = 0; sidx < 2; ++sidx) {
          uint4 pk;
          pk.x = pack2(S[8 * sidx + 0], S[8 * sidx + 1]);
          pk.y = pack2(S[8 * sidx + 2], S[8 * sidx + 3]);
          pk.z = pack2(S[8 * sidx + 4], S[8 * sidx + 5]);
          pk.w = pack2(S[8 * sidx + 6], S[8 * sidx + 7]);
          bf16x8 pf = __builtin_bit_cast(bf16x8, pk);
          const int vch = 4 * kbi + 2 * sidx + h;
          bf16x8 v0 = *reinterpret_cast<const bf16x8*>(LV + r * 256 + ((vch ^ (r & 15)) << 4));
          bf16x8 v1 = *reinterpret_cast<const bf16x8*>(LV + (32 + r) * 256 + ((vch ^ (r & 15)) << 4));
          O0 = __builtin_amdgcn_mfma_f32_32x32x16_bf16(v0, pf, O0, 0, 0, 0);
          O1 = __builtin_amdgcn_mfma_f32_32x32x16_bf16(v1, pf, O1, 0, 0, 0);
        }
      }
    }
#undef ATT_STAGE
    float l_tot = l_run + shx_f(l_run, 32);
    float inv = 1.f / l_tot;
    bf16_t* op = p->mix + (size_t)(tokbase + r) * LDMIX + hd * 64 + 4 * h;
#pragma unroll
    for (int g4 = 0; g4 < 4; ++g4) {
      uint2 o;
      o.x = pack2(O0[4 * g4 + 0] * inv, O0[4 * g4 + 1] * inv);
      o.y = pack2(O0[4 * g4 + 2] * inv, O0[4 * g4 + 3] * inv);
      *reinterpret_cast<uint2*>(op + 8 * g4) = o;
      o.x = pack2(O1[4 * g4 + 0] * inv, O1[4 * g4 + 1] * inv);
      o.y = pack2(O1[4 * g4 + 2] * inv, O1[4 * g4 + 3] * inv);
      *reinterpret_cast<uint2*>(op + 32 + 8 * g4) = o;
    }
  }
  __syncthreads();
}

DEVI void fill_tw(float2* tw, int n) {
  for (int i = ltid(); i < n; i += NTHREADS) {
    float sn, cn;
    sincospif(2.f * (float)i / (float)n, &sn, &cn);
    tw[i] = make_float2(cn, sn);
  }
  __syncthreads();
}

DEVI bf16x8 lds_col8(const bf16_t* bp, int stride) {
  unsigned e0 = bp[0], e1 = bp[stride], e2 = bp[2 * stride], e3 = bp[3 * stride];
  unsigned e4 = bp[4 * stride], e5 = bp[5 * stride], e6 = bp[6 * stride], e7 = bp[7 * stride];
  uint4 pk;
  pk.x = e0 | (e1 << 16);
  pk.y = e2 | (e3 << 16);
  pk.z = e4 | (e5 << 16);
  pk.w = e6 | (e7 << 16);
  return __builtin_bit_cast(bf16x8, pk);
}

DEVI void phase_fft_a(PP p, unsigned char* lds) {
  const int tid = ltid();
  const int lane = tid & 63, wid = __builtin_amdgcn_readfirstlane(tid >> 6), fr = lane & 15, fq = lane >> 4;
  float2* tw = reinterpret_cast<float2*>(lds + 66560);
  fill_tw(tw, 64);
  bf16x8 af[2][2];
#pragma unroll
  for (int ks = 0; ks < 2; ++ks) {
    unsigned short cr[8], ci[8];
#pragma unroll
    for (int j = 0; j < 8; ++j) {
      int n1 = 32 * ks + 8 * fq + j, k1 = 16 * wid + fr;
      float2 t = tw[(k1 * n1) & 63];
      cr[j] = f2bf(t.x);
      ci[j] = f2bf(-t.y);
    }
    uint4 a0, a1;
    a0.x = cr[0] | ((unsigned)cr[1] << 16); a0.y = cr[2] | ((unsigned)cr[3] << 16);
    a0.z = cr[4] | ((unsigned)cr[5] << 16); a0.w = cr[6] | ((unsigned)cr[7] << 16);
    a1.x = ci[0] | ((unsigned)ci[1] << 16); a1.y = ci[2] | ((unsigned)ci[3] << 16);
    a1.z = ci[4] | ((unsigned)ci[5] << 16); a1.w = ci[6] | ((unsigned)ci[7] << 16);
    af[0][ks] = __builtin_bit_cast(bf16x8, a0);
    af[1][ks] = __builtin_bit_cast(bf16x8, a1);
  }
  const bf16_t* l16 = reinterpret_cast<const bf16_t*>(lds);
  for (int u = lbid(); u < NB * 64; u += lnblk()) {
    int b = u >> 6, n2 = u & 63;
    __syncthreads();
#pragma unroll
    for (int i = 0; i < 16; ++i) {
      int row = (tid >> 6) + 4 * i, piece = tid & 63;
      uint4 v = *reinterpret_cast<const uint4*>(p->P + (size_t)(b * SEQ + 64 * row + n2) * 2048 + 768 + piece * 8);
      *reinterpret_cast<uint4*>(lds + row * 1040 + piece * 16) = v;
    }
    __syncthreads();
    float tc[4], ts[4];
#pragma unroll
    for (int j = 0; j < 4; ++j) sincospif((float)(n2 * (16 * wid + 4 * fq + j)) / 2048.f, &ts[j], &tc[j]);
    for (int nb = 0; nb < 4; ++nb) {
      f32x4 acc[2][8];
#pragma unroll
      for (int n = 0; n < 8; ++n) {
        acc[0][n] = f32x4{0.f, 0.f, 0.f, 0.f};
        acc[1][n] = f32x4{0.f, 0.f, 0.f, 0.f};
      }
#pragma unroll
      for (int ks = 0; ks < 2; ++ks)
#pragma unroll
        for (int nf = 0; nf < 8; ++nf) {
          bf16x8 bfr = lds_col8(l16 + (32 * ks + 8 * fq) * 520 + 128 * nb + 16 * nf + fr, 520);
          acc[0][nf] = __builtin_amdgcn_mfma_f32_16x16x32_bf16(af[0][ks], bfr, acc[0][nf], 0, 0, 0);
          acc[1][nf] = __builtin_amdgcn_mfma_f32_16x16x32_bf16(af[1][ks], bfr, acc[1][nf], 0, 0, 0);
        }
#pragma unroll
      for (int j = 0; j < 4; ++j) {
        int k1 = 16 * wid + 4 * fq + j;
        bf16_t* o = p->fa + (size_t)(b * SEQ + k1 * 64 + n2) * 1024 + 128 * nb + fr;
#pragma unroll
        for (int nf = 0; nf < 8; ++nf) {
          float re = acc[0][nf][j], im = acc[1][nf][j];
          o[16 * nf] = f2bf(re * tc[j] + im * ts[j]);
          o[512 + 16 * nf] = f2bf(im * tc[j] - re * ts[j]);
        }
      }
    }
  }
  __syncthreads();
}

DEVI void phase_fft_b(PP p, unsigned char* lds) {
  const int tid = ltid();
  const int lane = tid & 63, wid = __builtin_amdgcn_readfirstlane(tid >> 6), fr = lane & 15, fq = lane >> 4;
  float2* tw = reinterpret_cast<float2*>(lds + 67584);
  fill_tw(tw, 64);
  bf16x8 wb[2][4];
#pragma unroll
  for (int ks = 0; ks < 4; ++ks) {
    unsigned short zr[8], zi[8];
#pragma unroll
    for (int j = 0; j < 8; ++j) {
      int k = 32 * ks + 8 * fq + j, part = k >> 6, n2 = k & 63, k2 = 16 * wid + fr;
      float2 t = tw[(k2 * n2) & 63];
      zr[j] = f2bf(part ? t.y : t.x);
      zi[j] = f2bf(part ? t.x : -t.y);
    }
    uint4 a0, a1;
    a0.x = zr[0] | ((unsigned)zr[1] << 16); a0.y = zr[2] | ((unsigned)zr[3] << 16);
    a0.z = zr[4] | ((unsigned)zr[5] << 16); a0.w = zr[6] | ((unsigned)zr[7] << 16);
    a1.x = zi[0] | ((unsigned)zi[1] << 16); a1.y = zi[2] | ((unsigned)zi[3] << 16);
    a1.z = zi[4] | ((unsigned)zi[5] << 16); a1.w = zi[6] | ((unsigned)zi[7] << 16);
    wb[0][ks] = __builtin_bit_cast(bf16x8, a0);
    wb[1][ks] = __builtin_bit_cast(bf16x8, a1);
  }
  const bf16_t* l16 = reinterpret_cast<const bf16_t*>(lds);
  const float scale = 0.0013810679320049757f;
  for (int u = lbid(); u < NB * 128; u += lnblk()) {
    int b = u >> 7, k1 = (u >> 1) & 63, hf = u & 1;
    __syncthreads();
#pragma unroll
    for (int i = 0; i < 16; ++i) {
      int row = (tid >> 5) + 8 * i, piece = tid & 31;
      int part = row >> 6, n2 = row & 63;
      uint4 v = *reinterpret_cast<const uint4*>(p->fa + (size_t)(b * SEQ + k1 * 64 + n2) * 1024 + part * 512 + hf * 256 + piece * 8);
      *reinterpret_cast<uint4*>(lds + row * 528 + piece * 16) = v;
    }
    __syncthreads();
    for (int nb = 0; nb < 2; ++nb) {
      f32x4 acc[2][8];
#pragma unroll
      for (int n = 0; n < 8; ++n) {
        acc[0][n] = f32x4{0.f, 0.f, 0.f, 0.f};
        acc[1][n] = f32x4{0.f, 0.f, 0.f, 0.f};
      }
#pragma unroll
      for (int ks = 0; ks < 4; ++ks)
#pragma unroll
        for (int nf = 0; nf < 8; ++nf) {
          bf16x8 bfr = lds_col8(l16 + (32 * ks + 8 * fq) * 264 + 128 * nb + 16 * nf + fr, 264);
          acc[0][nf] = __builtin_amdgcn_mfma_f32_16x16x32_bf16(wb[0][ks], bfr, acc[0][nf], 0, 0, 0);
          acc[1][nf] = __builtin_amdgcn_mfma_f32_16x16x32_bf16(wb[1][ks], bfr, acc[1][nf], 0, 0, 0);
        }
#pragma unroll
      for (int j = 0; j < 4; ++j) {
        int k2 = 16 * wid + 4 * fq + j;
        bf16_t* o = p->mix + (size_t)(b * SEQ + k1 + 64 * k2) * LDMIX + 512 + hf * 256 + 128 * nb + fr;
#pragma unroll
        for (int nf = 0; nf < 8; ++nf) {
          o[16 * nf] = f2bf(acc[0][nf][j] * scale);
          o[512 + 16 * nf] = f2bf(acc[1][nf][j] * scale);
        }
      }
    }
  }
  __syncthreads();
}

DEVI void phase_dft_ctx(PP p, unsigned char* lds) {
  float2* tw = reinterpret_cast<float2*>(lds);
  fill_tw(tw, 256);
  int tid = ltid();
  const float scale = 0.005524271728019903f;
  for (int u = lbid(); u < NB * 64; u += lnblk()) {
    int b = u >> 6, k0 = (u & 63) * 4;
    for (int pass = 0; pass < 2; ++pass) {
      int ch = tid + pass * 256;
      float zr[4], zi[4];
#pragma unroll
      for (int kk = 0; kk < 4; ++kk) zr[kk] = zi[kk] = 0.f;
#pragma unroll 8
      for (int n = 0; n < 256; ++n) {
        float v = bf2f(p->P[(size_t)(TL + b * CTX + n) * 2048 + 768 + ch]);
#pragma unroll
        for (int kk = 0; kk < 4; ++kk) {
          float2 t = tw[(n * (k0 + kk)) & 255];
          zr[kk] += v * t.x;
          zi[kk] -= v * t.y;
        }
      }
#pragma unroll
      for (int kk = 0; kk < 4; ++kk) {
        bf16_t* o = p->mix + (size_t)(TL + b * CTX + k0 + kk) * LDMIX;
        o[512 + ch] = f2bf(zr[kk] * scale);
        o[1024 + ch] = f2bf(zi[kk] * scale);
      }
    }
  }
  __syncthreads();
}

DEVI void phase_sgu(PP p, int j, int nchunks, unsigned char* lds) {
  float* rs = reinterpret_cast<float*>(lds);
  unsigned char* LA = lds + 1024;
  unsigned char* LB = lds + 1024 + 32768;
  const int tid = ltid();
  const int lane = tid & 63, wid = __builtin_amdgcn_readfirstlane(tid >> 6), fr = lane & 15, fq = lane >> 4;
  const float* nw = p->gs_norm_w + j * 1024;
  for (int u = lbid(); u < nchunks * 8; u += lnblk()) {
    const int chunk = u >> 3, g = u & 7;
    const int tok0 = chunk * 128;
    const bf16_t* vT = p->zvT + ((size_t)chunk * 1024 + g * 128) * 128;
    __syncthreads();
    if (tid < 128) {
      const float* rp = p->rowss + (size_t)chunk * 32 * 128 + tid;
      float ss = 0.f;
#pragma unroll
      for (int sl = 0; sl < 32; ++sl) ss += rp[sl * 128];
      rs[tid] = rsqrtf(ss * (1.f / 1024.f) + 1e-6f);
    }
#pragma unroll
    for (int i = 0; i < 8; ++i) {
      int idx = tid + 256 * i, row = idx >> 4, c = idx & 15;
      uint4 v = *reinterpret_cast<const uint4*>(vT + (size_t)row * 128 + c * 8);
      *reinterpret_cast<uint4*>(LB + row * 256 + ((c ^ (row & 15)) << 4)) = v;
    }
    __syncthreads();
    {
      const float* wsg = p->gs_w_s + ((size_t)j * 8 + g) * 128 * 128;
#pragma unroll
      for (int i = 0; i < 8; ++i) {
        int idx = tid + 256 * i, row = idx >> 4, c = idx & 15;
        const float4* wp = reinterpret_cast<const float4*>(wsg + (size_t)row * 128 + c * 8);
        float4 w0 = wp[0], w1 = wp[1];
        const float* rk = rs + c * 8;
        uint4 pk;
        pk.x = pack2(w0.x * rk[0], w0.y * rk[1]);
        pk.y = pack2(w0.z * rk[2], w0.w * rk[3]);
        pk.z = pack2(w1.x * rk[4], w1.y * rk[5]);
        pk.w = pack2(w1.z * rk[6], w1.w * rk[7]);
        *reinterpret_cast<uint4*>(LA + row * 256 + ((c ^ (row & 15)) << 4)) = pk;
      }
    }
    __syncthreads();
    f32x4 acc[2][8];
#pragma unroll
    for (int m = 0; m < 2; ++m)
#pragma unroll
      for (int n = 0; n < 8; ++n) acc[m][n] = f32x4{0.f, 0.f, 0.f, 0.f};
#pragma unroll
    for (int ks = 0; ks < 4; ++ks) {
      const int sl = ((4 * ks + fq) ^ fr) << 4;
      bf16x8 a0 = *reinterpret_cast<const bf16x8*>(LA + (32 * wid + fr) * 256 + sl);
      bf16x8 a1 = *reinterpret_cast<const bf16x8*>(LA + (32 * wid + 16 + fr) * 256 + sl);
#pragma unroll
      for (int n = 0; n < 8; ++n) {
        bf16x8 bfr = *reinterpret_cast<const bf16x8*>(LB + (16 * n + fr) * 256 + sl);
        acc[0][n] = __builtin_amdgcn_mfma_f32_16x16x32_bf16(a0, bfr, acc[0][n], 0, 0, 0);
        acc[1][n] = __builtin_amdgcn_mfma_f32_16x16x32_bf16(a1, bfr, acc[1][n], 0, 0, 0);
      }
    }
    __syncthreads();
    {
      const float* bsg = p->gs_b_s + ((size_t)j * 8 + g) * 128;
#pragma unroll
      for (int m = 0; m < 2; ++m)
#pragma unroll
        for (int jj = 0; jj < 4; ++jj) {
          const int pp = 32 * wid + 16 * m + 4 * fq + jj;
          const float bias = bsg[pp];
#pragma unroll
          for (int n = 0; n < 8; ++n) {
            const int c = 16 * n + fr;
            float sv = nw[g * 128 + c] * acc[m][n][jj] + bias;
            *reinterpret_cast<bf16_t*>(LA + pp * 256 + (((c >> 3) ^ (pp & 15)) << 4) + (c & 7) * 2) = f2bf(sv);
          }
        }
    }
    __syncthreads();
#pragma unroll
    for (int i = 0; i < 8; ++i) {
      int idx = tid + 256 * i, row = idx >> 4, c = idx & 15;
      uint4 sv8 = *reinterpret_cast<const uint4*>(LA + row * 256 + ((c ^ (row & 15)) << 4));
      uint4 u8 = *reinterpret_cast<const uint4*>(p->P + (size_t)(tok0 + row) * 2048 + g * 128 + c * 8);
      uint4 o;
      o.x = pack2(bflo(u8.x) * bflo(sv8.x), bfhi(u8.x) * bfhi(sv8.x));
      o.y = pack2(bflo(u8.y) * bflo(sv8.y), bfhi(u8.y) * bfhi(sv8.y));
      o.z = pack2(bflo(u8.z) * bflo(sv8.z), bfhi(u8.z) * bfhi(sv8.z));
      o.w = pack2(bflo(u8.w) * bflo(sv8.w), bfhi(u8.w) * bfhi(sv8.w));
      *reinterpret_cast<uint4*>(p->mix + (size_t)(tok0 + row) * LDMIX + g * 128 + c * 8) = o;
    }
  }
  __syncthreads();
}

DEVI float mkkey(float v, unsigned idx, unsigned mask) { return __uint_as_float((__float_as_uint(v) & ~mask) | idx); }
#define INSERT16(list, x)                                                                                               \
  {                                                                                                                     \
    _Pragma("unroll") for (int i_ = 15; i_ >= 1; --i_) list[i_] = __builtin_amdgcn_fmed3f(list[i_ - 1], list[i_], x); \
    list[0] = fmaxf(list[0], x);                                                                                        \
  }

DEVI float vmaxf(float a, float b) { float r; asm("v_max_f32 %0, %1, %2" : "=v"(r) : "v"(a), "v"(b)); return r; }
DEVI float vminf(float a, float b) { float r; asm("v_min_f32 %0, %1, %2" : "=v"(r) : "v"(a), "v"(b)); return r; }
DEVI void bitonic_merge16(float (&v)[16]) {
#pragma unroll
  for (int j = 8; j >= 1; j >>= 1)
#pragma unroll
    for (int i = 0; i < 16; ++i) {
      const int l = i ^ j;
      if (l > i) {
        const float hi = vmaxf(v[i], v[l]), lo = vminf(v[i], v[l]);
        v[i] = hi;
        v[l] = lo;
      }
    }
}
DEVI void bitonic_sort16(float (&v)[16]) {
#pragma unroll
  for (int k = 2; k <= 16; k <<= 1)
#pragma unroll
    for (int j = k >> 1; j >= 1; j >>= 1)
#pragma unroll
      for (int i = 0; i < 16; ++i) {
        const int l = i ^ j;
        if (l > i) {
          const float hi = vmaxf(v[i], v[l]), lo = vminf(v[i], v[l]);
          const bool desc = (i & k) == 0;
          v[i] = desc ? hi : lo;
          v[l] = desc ? lo : hi;
        }
      }
}

DEVI void phase_route(PP p, int layer, int ntok, unsigned char* lds) {
  const int tid = ltid();
  const int lane = tid & 63, wid = __builtin_amdgcn_readfirstlane(tid >> 6), fr = lane & 15, fq = lane >> 4;
  const int nb8 = lnblk() >> 3, bid = lbid();
  const int hh = bid & 7, slot = bid >> 3;
  const int ntiles = ntok / 64;
  const bool active = slot < nb8;
  float* sc = reinterpret_cast<float*>(lds + 32768);
  const float NEGK = -3.0e38f;
  for (int half = 0; half < 2; ++half) {
    __syncthreads();
    {
      const bf16_t* ksrc = p->keysb + ((size_t)((layer * 8 + hh) * 2 + half) * 128) * 128;
#pragma unroll
      for (int i = 0; i < 8; ++i) {
        int idx = tid + 256 * i, row = idx >> 4, c = idx & 15;
        uint4 v = *reinterpret_cast<const uint4*>(ksrc + (size_t)row * 128 + c * 8);
        *reinterpret_cast<uint4*>(lds + row * 256 + ((c ^ (row & 15)) << 4)) = v;
      }
    }
    __syncthreads();
    bf16x8 an[4];
    if (active && slot < ntiles) {
      const bf16_t* qa = p->P + (size_t)(slot * 64 + wid * 16 + fr) * 2048 + hh * 256 + half * 128 + fq * 8;
#pragma unroll
      for (int ks = 0; ks < 4; ++ks) an[ks] = *reinterpret_cast<const bf16x8*>(qa + ks * 32);
    }
    for (int tt = slot; active && tt < ntiles; tt += nb8) {
      const int tok0 = tt * 64;
      {
        bf16x8 a[4];
#pragma unroll
        for (int ks = 0; ks < 4; ++ks) a[ks] = an[ks];
        {
          const int ttn = (tt + nb8 < ntiles) ? tt + nb8 : tt;
          const bf16_t* qa = p->P + (size_t)(ttn * 64 + wid * 16 + fr) * 2048 + hh * 256 + half * 128 + fq * 8;
#pragma unroll
          for (int ks = 0; ks < 4; ++ks) an[ks] = *reinterpret_cast<const bf16x8*>(qa + ks * 32);
        }
#pragma unroll
        for (int nf = 0; nf < 8; ++nf) {
          f32x4 acc = f32x4{0.f, 0.f, 0.f, 0.f};
          const int krow = nf * 16 + fr;
#pragma unroll
          for (int ks = 0; ks < 4; ++ks) {
            bf16x8 bb = *reinterpret_cast<const bf16x8*>(lds + krow * 256 + (((4 * ks + fq) ^ (krow & 15)) << 4));
            acc = __builtin_amdgcn_mfma_f32_16x16x32_bf16(a[ks], bb, acc, 0, 0, 0);
          }
#pragma unroll
          for (int j = 0; j < 4; ++j) sc[(wid * 16 + fq * 4 + j) * 133 + krow + (krow >> 5)] = mkkey(acc[j], (unsigned)krow, 127u);
        }
      }
      const int prt = lane >> 4;
      float list[16];
      {
        const float* kr = sc + (wid * 16 + fr) * 133 + prt * 33;
        float lb[16];
#pragma unroll
        for (int i = 0; i < 16; ++i) {
          list[i] = kr[i];
          lb[i] = kr[16 + i];
        }
        bitonic_sort16(list);
        bitonic_sort16(lb);
#pragma unroll
        for (int i = 0; i < 16; ++i) list[i] = vmaxf(list[i], lb[15 - i]);
        bitonic_merge16(list);
      }
#pragma unroll 1
      for (int step = 16; step <= 32; step <<= 1) {
        float other[16];
#pragma unroll
        for (int i = 0; i < 16; ++i) other[i] = shx_f(list[i], step);
#pragma unroll
        for (int i = 0; i < 16; ++i) list[i] = vmaxf(list[i], other[15 - i]);
        bitonic_merge16(list);
      }
      if (prt == 0) {
        float4* o = reinterpret_cast<float4*>(p->tops + ((size_t)(tok0 + wid * 16 + fr) * 16 + hh * 2 + half) * 16);
        o[0] = make_float4(list[0], list[1], list[2], list[3]);
        o[1] = make_float4(list[4], list[5], list[6], list[7]);
        o[2] = make_float4(list[8], list[9], list[10], list[11]);
        o[3] = make_float4(list[12], list[13], list[14], list[15]);
      }
    }
  }
  __syncthreads();
  float* fl = reinterpret_cast<float*>(lds);
  for (int t4 = slot; active && t4 < ntiles + 3 * nb8; t4 += 4 * nb8) {
    const int tt = t4 + (tid >> 6) * nb8;
    if (tt < ntiles) {
      const int tok = tt * 64 + (tid & 63);
      const float4* src = reinterpret_cast<const float4*>(p->tops + ((size_t)tok * 16 + hh * 2) * 16);
      float v0[16], v1[16];
#pragma unroll
      for (int i = 0; i < 4; ++i) {
        float4 a = src[i], bq = src[4 + i];
        v0[4 * i] = a.x; v0[4 * i + 1] = a.y; v0[4 * i + 2] = a.z; v0[4 * i + 3] = a.w;
        v1[4 * i] = bq.x; v1[4 * i + 1] = bq.y; v1[4 * i + 2] = bq.z; v1[4 * i + 3] = bq.w;
      }
      float* f0 = fl + tid * 33;
      float* f1 = f0 + 16;
#pragma unroll
      for (int i = 0; i < 16; ++i) {
        f0[i] = v0[i];
        f1[i] = v1[i];
      }
      float l2[16];
#pragma unroll
      for (int i = 0; i < 16; ++i) l2[i] = mkkey(v0[0] + v1[i], (unsigned)(15 - i), 255u);
#pragma unroll
      for (int a = 1; a < 16; ++a)
#pragma unroll
        for (int bq = 0; bq < 16; ++bq)
          if ((a + 1) * (bq + 1) <= 16) {
            float x = mkkey(v0[a] + v1[bq], (unsigned)(a * 16 + 15 - bq), 255u);
            INSERT16(l2, x)
          }
      float sv[16];
      int ev[16];
      float mx = NEGK;
#pragma unroll
      for (int k = 0; k < 16; ++k) {
        unsigned ab = __float_as_uint(l2[k]) & 255u;
        unsigned k0 = __float_as_uint(f0[ab >> 4]), k1 = __float_as_uint(f1[15u - (ab & 15u)]);
        sv[k] = __uint_as_float(k0 & ~127u) + __uint_as_float(k1 & ~127u);
        ev[k] = (int)((k0 & 127u) * 128u + (k1 & 127u));
        mx = fmaxf(mx, sv[k]);
      }
      float sum = 0.f;
#pragma unroll
      for (int k = 0; k < 16; ++k) {
        sv[k] = __expf(sv[k] - mx);
        sum += sv[k];
      }
      float inv = 1.f / sum;
      size_t o = (size_t)tok * 128 + hh * 16;
      int4* eo = reinterpret_cast<int4*>(p->eidx + o);
      float4* go = reinterpret_cast<float4*>(p->gate + o);
#pragma unroll
      for (int k4 = 0; k4 < 4; ++k4) {
        eo[k4] = make_int4(ev[4 * k4], ev[4 * k4 + 1], ev[4 * k4 + 2], ev[4 * k4 + 3]);
        go[k4] = make_float4(sv[4 * k4] * inv, sv[4 * k4 + 1] * inv, sv[4 * k4 + 2] * inv, sv[4 * k4 + 3] * inv);
      }
    }
  }
  __syncthreads();
}

typedef float v2f __attribute__((ext_vector_type(2)));
DEVI void dec16(uint4 q, v2f* f) {
  f[0] = __builtin_amdgcn_cvt_pk_f32_fp8((int)q.x, false);
  f[1] = __builtin_amdgcn_cvt_pk_f32_fp8((int)q.x, true);
  f[2] = __builtin_amdgcn_cvt_pk_f32_fp8((int)q.y, false);
  f[3] = __builtin_amdgcn_cvt_pk_f32_fp8((int)q.y, true);
  f[4] = __builtin_amdgcn_cvt_pk_f32_fp8((int)q.z, false);
  f[5] = __builtin_amdgcn_cvt_pk_f32_fp8((int)q.z, true);
  f[6] = __builtin_amdgcn_cvt_pk_f32_fp8((int)q.w, false);
  f[7] = __builtin_amdgcn_cvt_pk_f32_fp8((int)q.w, true);
}
struct ExpBuf {
  uint4 q[8];
  uint4 h0, h1;
};
DEVI void exp_load(ExpBuf& B, const unsigned char* tab, const signed char* hrow, const unsigned short* idp, int j8, bool want_x) {
  const uint4 idv = *reinterpret_cast<const uint4*>(idp);
  const unsigned idw[4] = {idv.x, idv.y, idv.z, idv.w};
#pragma unroll
  for (int i = 0; i < 8; ++i) {
    unsigned e = (i & 1) ? (idw[i >> 1] >> 16) : (idw[i >> 1] & 0xffffu);
    unsigned off = e * (unsigned)D + 16u * j8;
    B.q[i] = *reinterpret_cast<const uint4*>(tab + off);
  }
  if (want_x) B.h0 = *reinterpret_cast<const uint4*>(hrow + 16 * j8);
}
template <int CTRL>
DEVI int dpp_movi(int v) { return __builtin_amdgcn_mov_dpp(v, CTRL, 0xF, 0xF, true); }
DEVI void exp_u_compute(const ExpBuf& B, int* pp, int j8) {
  int s0 = 0;
#pragma unroll
  for (int i = 0; i < 8; ++i) {
    int d = __builtin_amdgcn_sdot4((int)B.q[i].x, (int)B.h0.x, 0, false);
    d = __builtin_amdgcn_sdot4((int)B.q[i].y, (int)B.h0.y, d, false);
    d = __builtin_amdgcn_sdot4((int)B.q[i].z, (int)B.h0.z, d, false);
    d = __builtin_amdgcn_sdot4((int)B.q[i].w, (int)B.h0.w, d, false);
    d += dpp_movi<0xB1>(d);
    d += dpp_movi<0x4E>(d);
    d += dpp_movi<0x141>(d);
    s0 = (j8 == i) ? d : s0;
  }
  pp[0] += s0;
}
DEVI void exp_v_accum(const ExpBuf& B, unsigned w0, unsigned w1, int* acc) {
#pragma unroll
  for (int ig = 0; ig < 2; ++ig) {
    const unsigned wq = ig ? w1 : w0;
    const uint4 R0 = B.q[4 * ig], R1 = B.q[4 * ig + 1], R2 = B.q[4 * ig + 2], R3 = B.q[4 * ig + 3];
    const unsigned r0[4] = {R0.x, R0.y, R0.z, R0.w}, r1[4] = {R1.x, R1.y, R1.z, R1.w};
    const unsigned r2[4] = {R2.x, R2.y, R2.z, R2.w}, r3[4] = {R3.x, R3.y, R3.z, R3.w};
#pragma unroll
    for (int q = 0; q < 4; ++q) {
      unsigned A = __builtin_amdgcn_perm(r1[q], r0[q], 0x05010400u);
      unsigned Bq = __builtin_amdgcn_perm(r1[q], r0[q], 0x07030602u);
      unsigned C = __builtin_amdgcn_perm(r3[q], r2[q], 0x05010400u);
      unsigned E = __builtin_amdgcn_perm(r3[q], r2[q], 0x07030602u);
      unsigned D0 = __builtin_amdgcn_perm(C, A, 0x05040100u);
      unsigned D1 = __builtin_amdgcn_perm(C, A, 0x07060302u);
      unsigned D2 = __builtin_amdgcn_perm(E, Bq, 0x05040100u);
      unsigned D3 = __builtin_amdgcn_perm(E, Bq, 0x07060302u);
      acc[4 * q + 0] = __builtin_amdgcn_sdot4((int)D0, (int)wq, acc[4 * q + 0], false);
      acc[4 * q + 1] = __builtin_amdgcn_sdot4((int)D1, (int)wq, acc[4 * q + 1], false);
      acc[4 * q + 2] = __builtin_amdgcn_sdot4((int)D2, (int)wq, acc[4 * q + 2], false);
      acc[4 * q + 3] = __builtin_amdgcn_sdot4((int)D3, (int)wq, acc[4 * q + 3], false);
    }
  }
}
DEVI void exp_v_finish(float4* xo, const float4* xq, const float4* gq, int* acc, float swt, int grp, float gscale) {
  float o[16];
#pragma unroll
  for (int k = 0; k < 16; ++k) {
    int a = acc[k];
    a += dpp_movi<0x128>(a);
    a += shx_i(a, 16);
    a += shx_i(a, 32);
    o[k] = (float)a;
    acc[k] = 0;
  }
  if (grp == 0) {
    const float sc = gscale * swt;
#pragma unroll
    for (int i4 = 0; i4 < 4; ++i4) {
      float4 r = xq[i4];
      r.x += sc * gq[i4].x * o[i4 * 4 + 0];
      r.y += sc * gq[i4].y * o[i4 * 4 + 1];
      r.z += sc * gq[i4].z * o[i4 * 4 + 2];
      r.w += sc * gq[i4].w * o[i4 * 4 + 3];
      xo[i4] = r;
    }
  }
}
DEVI void phase_expert(PP p, int layer, int ntok, unsigned char* lds, float gscale = 1.f, int idmask = 0xffff) {
  const int tid = ltid();
  const int lane = tid & 63, wid = __builtin_amdgcn_readfirstlane(tid >> 6), j8 = lane & 7, grp = lane >> 3;
  const int nb = lnblk(), bid = lbid();
  unsigned short* ids = reinterpret_cast<unsigned short*>(lds);
  float* part = reinterpret_cast<float*>(lds + TPB * 128 * 2);
  unsigned char* w8 = lds + TPB * 128 * 2 + TPB * 128 * 4;
  float* swl = reinterpret_cast<float*>(lds + TPB * 128 * 2 + TPB * 128 * 4 + TPB * 128);
  const unsigned char* ut = p->utab + (size_t)layer * NEXP * D;
  const unsigned char* vt = p->vtab + (size_t)layer * NEXP * D;
  int tpb = (ntok + nb - 1) / nb;
  if (tpb > TPB) tpb = TPB;
  const int npass = (ntok + nb * tpb - 1) / (nb * tpb);
  for (int pass = 0; pass < npass; ++pass) {
    const int tok0 = (pass * nb + bid) * tpb;
    int cnt = ntok - tok0;
    if (cnt > tpb) cnt = tpb;
    if (cnt < 0) cnt = 0;
    for (int i = tid; i < cnt * 128; i += NTHREADS) {
      {
        int k = i & 127, hf = k >> 6, kk = k & 63;
        ids[(i & ~127) + hf * 64 + (kk & 7) * 8 + (kk >> 3)] = (unsigned short)(p->eidx[(size_t)tok0 * 128 + i] & idmask);
      }
      part[i] = 0.f;
    }
    __syncthreads();
    const int ntw = (cnt - wid + 3) >> 2;
    const int npair = ntw * 8;

    if (!(REP_MODE == 1 && gscale != 1.f)) {
      ExpBuf B0, B1;
      int c0 = 0, k0 = 0;
      if (npair > 0) {
        const int t0 = wid;
        exp_load(B0, ut, p->h8 + (size_t)(tok0 + t0) * D, ids + t0 * 128 + grp * 8, j8, true);
      }
      for (int pr = 0; pr < npair; ++pr) {
        const int t0 = wid + 4 * k0;
        exp_load(B1, ut + 128 * c0, p->h8 + (size_t)(tok0 + t0) * D + 128 * c0, ids + t0 * 128 + 64 + grp * 8, j8, true);
        exp_u_compute(B0, reinterpret_cast<int*>(part) + t0 * 128 + 8 * j8 + grp, j8);
        int c1 = c0, k1 = k0;
        if (pr + 1 < npair) {
          k1 = k0 + 1;
          if (k1 == ntw) {
            k1 = 0;
            c1 = c0 + 1;
          }
        }
        {
          const int t1 = wid + 4 * k1;
          exp_load(B0, ut + 128 * c1, p->h8 + (size_t)(tok0 + t1) * D + 128 * c1, ids + t1 * 128 + grp * 8, j8, true);
        }
        exp_u_compute(B1, reinterpret_cast<int*>(part) + t0 * 128 + 64 + 8 * j8 + grp, j8);
        c0 = c1;
        k0 = k1;
      }
    }
    __syncthreads();
    for (int t = wid; t < cnt; t += 4) {
      float wv2[2];
      float am = 0.f;
#pragma unroll
      for (int hh = 0; hh < 2; ++hh) {
        int k = lane + 64 * hh;
        int e = ids[t * 128 + hh * 64 + (lane & 7) * 8 + (lane >> 3)];
        float dq = (float)reinterpret_cast<int*>(part)[t * 128 + k] * p->su[(size_t)layer * NEXP + e] * p->sx[tok0 + t];
        float wv = p->gate[(size_t)(tok0 + t) * 128 + k] * gelu_tanh(dq) * p->sv[(size_t)layer * NEXP + e];
        wv2[hh] = wv;
        am = fmaxf(am, fabsf(wv));
      }
      am = fmaxf(wave_max(am), 1e-30f);
      float qs = 127.f / am;
#pragma unroll
      for (int hh = 0; hh < 2; ++hh) {
        int k = lane + 64 * hh;
        int q = (int)rintf(wv2[hh] * qs);
        w8[t * 128 + (k & 7) * 16 + hh * 8 + ((k >> 3) & 7)] = (unsigned char)(q & 255);
      }
      if (lane == 0) swl[t] = am * (1.f / 127.f);
    }
    __syncthreads();
    if (!(REP_MODE == 2 && gscale != 1.f)) {
      ExpBuf B0, B1;
      int acc[16];
#pragma unroll
      for (int k = 0; k < 16; ++k) acc[k] = 0;
      int c0 = 0, k0 = 0;
      if (npair > 0) {
        const int t0 = wid;
        exp_load(B0, vt, (const signed char*)nullptr, ids + t0 * 128 + grp * 8, j8, false);
      }
      for (int pr = 0; pr < npair; ++pr) {
        const int t0 = wid + 4 * k0;
        float4 xq[4], gq[4];
        float4* xo = reinterpret_cast<float4*>(p->xs + (size_t)(tok0 + t0) * D + 128 * c0 + 16 * j8);
        {
          const float4* gf = reinterpret_cast<const float4*>(p->mod + ((size_t)layer * 9 + tok_batch(tok0 + t0)) * 6144 + 5 * 1024 + 128 * c0 + 16 * j8);
#pragma unroll
          for (int i4 = 0; i4 < 4; ++i4) {
            xq[i4] = xo[i4];
            gq[i4] = gf[i4];
          }
        }
        exp_load(B1, vt + 128 * c0, (const signed char*)nullptr, ids + t0 * 128 + 64 + grp * 8, j8, false);
        const uint4 wq = *reinterpret_cast<const uint4*>(w8 + t0 * 128 + grp * 16);
        exp_v_accum(B0, wq.x, wq.y, acc);
        int c1 = c0, k1 = k0;
        if (pr + 1 < npair) {
          k1 = k0 + 1;
          if (k1 == ntw) {
            k1 = 0;
            c1 = c0 + 1;
          }
        }
        {
          const int t1 = wid + 4 * k1;
          exp_load(B0, vt + 128 * c1, (const signed char*)nullptr, ids + t1 * 128 + grp * 8, j8, false);
        }
        exp_v_accum(B1, wq.z, wq.w, acc);
        exp_v_finish(xo, xq, gq, acc, swl[t0], grp, gscale);
        c0 = c1;
        k0 = k1;
      }
    }
    asm volatile("s_waitcnt vmcnt(0)" ::: "memory");
    __syncthreads();
    if (gscale == 1.f) {
      for (int t = wid; t < cnt; t += 4) {
        if (layer + 1 < DEPTH) norm_row(p, layer + 1, 0, tok0 + t, lane);
        else if (tok0 + t < TL) norm_row(p, 0, 2, tok0 + t, lane);
      }
    }
    __syncthreads();
  }
}

#define XB_TMO 128
#define XB_XCNT(j) (256 + 64 * (j))
#define XB_XSUB(j) (1280 + 64 * (j))
#define XB_XGEN(j) (2304 + 64 * (j))
#define XB_TOP 3328
#define XB_TOPGEN 3392
#define XCD_BAR_WORDS 3456
#define XB_SPIN_CAP (1u << 22)
#define LAS __attribute__((address_space(3)))
DEVI unsigned xb_ld(unsigned* p) { return __hip_atomic_load(p, __ATOMIC_RELAXED, __HIP_MEMORY_SCOPE_AGENT); }
DEVI unsigned xb_add(unsigned* p, unsigned v) { return __hip_atomic_fetch_add(p, v, __ATOMIC_RELAXED, __HIP_MEMORY_SCOPE_AGENT); }
DEVI unsigned xb_xcc_id() { return (unsigned)__builtin_amdgcn_s_getreg((3 << 11) | 20) & 0xFu; }
#define XB_SPIN(cond, bar)                                   \
  do {                                                       \
    unsigned _sp = 0;                                        \
    while (cond) {                                           \
      __builtin_amdgcn_s_sleep(1);                           \
      if ((++_sp & 255u) == 0u) {                            \
        if (xb_ld(&(bar)[XB_TMO])) break;                    \
        if (_sp > XB_SPIN_CAP) {                             \
          atomicAdd(&(bar)[XB_TMO], 1u);                     \
          break;                                             \
        }                                                    \
      }                                                      \
    }                                                        \
  } while (0)
struct XcdBarrier {
  unsigned* bar;
  unsigned x;
  volatile LAS unsigned* st;
};
DEVI XcdBarrier xcd_barrier_post(unsigned* bar, volatile LAS unsigned* st) {
  XcdBarrier b;
  b.bar = bar;
  b.x = xb_xcc_id();
  b.st = st;
  if (threadIdx.x == 0) (void)xb_add(&bar[XB_XCNT(b.x)], 1u);
  return b;
}
DEVI void xcd_barrier_complete(unsigned* bar, unsigned x, unsigned& nloc, unsigned& nx) {
  const unsigned G = gridDim.x * gridDim.y * gridDim.z;
  unsigned sum, cnt, mine, sp = 0u;
  for (;;) {
    sum = 0u;
    cnt = 0u;
    mine = 0u;
#pragma unroll
    for (unsigned j = 0; j < 16; ++j) {
      const unsigned c = xb_ld(&bar[XB_XCNT(j)]);
      sum += c;
      cnt += (c > 0u) ? 1u : 0u;
      mine = (j == x) ? c : mine;
    }
    if (sum == G) break;
    __builtin_amdgcn_s_sleep(1);
    if ((++sp & 255u) == 0u) {
      if (xb_ld(&bar[XB_TMO])) break;
      if (sp > XB_SPIN_CAP) {
        atomicAdd(&bar[XB_TMO], 1u);
        break;
      }
    }
  }
  nloc = mine > 0u ? mine : 1u;
  nx = cnt > 0u ? cnt : 1u;
}
DEVI void xcd_barrier(const XcdBarrier& b) {
  asm volatile("s_waitcnt vmcnt(0)" ::: "memory");
  __syncthreads();
  if (threadIdx.x == 0) {
    unsigned* bar = b.bar;
    __builtin_amdgcn_s_waitcnt(0);
    unsigned nloc = b.st[0], nx = b.st[1];
    if (nloc == 0u) {
      xcd_barrier_complete(bar, b.x, nloc, nx);
      b.st[0] = nloc;
      b.st[1] = nx;
    }
    const unsigned old = xb_add(&bar[XB_XSUB(b.x)], 1u);
    const unsigned gen = old / nloc;
    if (old + 1u == (gen + 1u) * nloc) {
      __builtin_amdgcn_fence(__ATOMIC_RELEASE, "agent");
      asm volatile("s_waitcnt vmcnt(0)" ::: "memory");
      const unsigned og = xb_add(&bar[XB_TOP], 1u);
      const unsigned tg = og / nx;
      if (og + 1u == (tg + 1u) * nx) xb_add(&bar[XB_TOPGEN], 1u);
      else XB_SPIN(xb_ld(&bar[XB_TOPGEN]) == tg, bar);
      __builtin_amdgcn_fence(__ATOMIC_ACQUIRE, "agent");
      xb_add(&bar[XB_XGEN(b.x)], 1u);
      asm volatile("s_waitcnt vmcnt(0)" ::: "memory");
    } else {
      XB_SPIN(xb_ld(&bar[XB_XGEN(b.x)]) == gen, bar);
      __builtin_amdgcn_fence(__ATOMIC_ACQUIRE, "agent");
      asm volatile("s_waitcnt vmcnt(0)" ::: "memory");
    }
  }
  __syncthreads();
}

DEVI bool step_active(int step) {
  if (step == 0) return true;
  if (step == NSTEPS - 1) return false;
  int layer = (step - 1) / STEPS_PER_LAYER, ph = (step - 1) % STEPS_PER_LAYER;
  if (ph == 3 && (layer & 1)) return false;
  if (ph == 0 && layer > 0) return false;
  return true;
}

DEVI void run_step(PP p, int step, unsigned char* lds, unsigned char* lds_all, float gscale = 1.f) {
  if (step == 0) {
    phase_prep(p, lds);
    return;
  }
  if (step == NSTEPS - 1) {
    phase_norm(p, 0, 2, TL);
    return;
  }
  int layer = (step - 1) / STEPS_PER_LAYER, ph = (step - 1) % STEPS_PER_LAYER;
  bool even = (layer & 1) == 0;
  int j = layer >> 1;
  bool upd_ctx = layer < 2;
  bool need_ctx = layer < 3;
  int nt_in = need_ctx ? TT : TL;
  int nt = upd_ctx ? TT : TL;
  switch (ph) {
    case 0: phase_norm(p, layer, 0, nt_in); break;
    case 1:
      if (even)
        gemm8_phase<EPI_INPROJ>(p, p->h, D, p->wt_in_ab + (size_t)j * 1280 * D, D, nt_in / 256, 5, D, layer, lds_all);
      else
        gemm8_phase<EPI_GELU>(p, p->h, D, p->wt_in_gs + (size_t)j * 2048 * D, D, nt / 256, 8, D, layer, lds_all);
      break;
    case 2:
      if (even) {
        phase_fft_a(p, lds);
        if (upd_ctx) phase_dft_ctx(p, lds);
        phase_attn(p, layer, upd_ctx, lds);
      } else {
        phase_sgu(p, j, nt / 128, lds);
      }
      break;
    case 3:
      if (even) phase_fft_b(p, lds);
      break;
    case 4:
      if (even)
      {
        if (layer == 0) gemm8_phase<EPI_RESID0>(p, p->mix, LDMIX, p->wt_out_ab + (size_t)j * D * LDMIX, LDMIX, nt / 256, 4, LDMIX, layer, lds_all, gscale);
        else gemm8_phase<EPI_RESID>(p, p->mix, LDMIX, p->wt_out_ab + (size_t)j * D * LDMIX, LDMIX, nt / 256, 4, LDMIX, layer, lds_all, gscale);
      }
      else
      {
        gemm8_phase<EPI_RESID>(p, p->mix, LDMIX, p->wt_out_gs + (size_t)j * D * D, D, nt / 256, 4, D, layer, lds_all, gscale);
      }
      break;
    case 5: phase_norm(p, layer, 1, nt); break;
    case 6: gemm8_phase<EPI_STORE>(p, p->h, D, p->wt_q + (size_t)layer * 2048 * D, D, nt / 256, 8, D, layer, lds_all); break;
    case 7: phase_route(p, layer, nt, lds); break;
    case 8: phase_expert(p, layer, nt, lds, gscale, (gscale == 1.f) ? 0xffff : REP_IDMASK); break;
  }
}

__global__ void __launch_bounds__(PHYS_THREADS, 2) mega(Params p_unused, int step_lo, int step_hi) {
  unsigned char* lds_all = g_lds;
  if ((threadIdx.x & 63) == 0) *reinterpret_cast<volatile int*>(g_lds + LDS_BYTES - 16 - 256 + 4 * hw_slot()) = (int)(threadIdx.x >> 6);
  __syncthreads();
  unsigned char* lds = lds_all + (wave_index() >> 2) * LDS_HALF;
  PP pp = (PP)__builtin_amdgcn_kernarg_segment_ptr();
  volatile LAS unsigned* st = (volatile LAS unsigned*)(lds_all + LDS_BYTES - 16);
  if (threadIdx.x == 0) {
    st[0] = 0u;
    st[1] = 0u;
  }
  __syncthreads();
  XcdBarrier xb = xcd_barrier_post(pp->bar, st);
  int nsync = 0;
  bool first = true;
  for (int s = step_lo; s < step_hi; ++s) {
    if (!step_active(s)) continue;
    if (!first) {
      if (nsync == 0) cg::this_grid().sync();
      else xcd_barrier(xb);
      ++nsync;
    }
    first = false;
    int nrep = 1;
    if (PROBE_PH) {
      if (s == 0) nrep += (PROBE_PH >> 15) & 1;
      else if (s < NSTEPS - 1) {
        const int lay_ = (s - 1) / STEPS_PER_LAYER, ph_ = (s - 1) % STEPS_PER_LAYER;
        nrep += (PROBE_PH >> ph_) & 1;
        if (ph_ == 2 && ((PROBE_PH >> 9) & 1) && !(lay_ & 1)) nrep = 2;
        if (ph_ == 2 && ((PROBE_PH >> 10) & 1) && (lay_ & 1)) nrep = 2;
        if (ph_ == 1 && ((PROBE_PH >> 12) & 1) && !(lay_ & 1)) nrep = 2;
        if (ph_ == 1 && ((PROBE_PH >> 13) & 1) && (lay_ & 1)) nrep = 2;
        if (ph_ == 4 && ((PROBE_PH >> 11) & 1) && !(lay_ & 1)) nrep = 2;
        if (ph_ == 4 && ((PROBE_PH >> 14) & 1) && (lay_ & 1)) nrep = 2;
      }
      asm volatile("" : "+s"(nrep));
    }
#pragma nounroll
    for (int rep = nrep - 1; rep >= 0; --rep) {
      if (rep != nrep - 1) xcd_barrier(xb);
      PP q = pp;
      asm volatile("" : "+s"(q));
      int gi = __builtin_amdgcn_readfirstlane(rep ? 0 : 0x3f800000);
      if (PROBE_PH) asm volatile("" : "+s"(gi));
      const float gs = __int_as_float(gi);
      if (PROBE_PH) run_step(q, s, lds, lds_all, gs);
      else run_step(q, s, lds, lds_all);
    }
  }
}

static size_t align_up(size_t v) { return (v + 255) & ~(size_t)255; }

extern "C" void kernel_launch(void* const* d_in, const int* in_sizes, int n_in, void* d_out, int out_size, void* d_ws,
                              size_t ws_size, hipStream_t stream) {
  Params p{};
  p.x = (const float*)d_in[0];
  p.c = (const float*)d_in[1];
  p.ctx = (const float*)d_in[2];
  p.c_ctx = (const float*)d_in[3];
  p.ada_w = (const float*)d_in[4];
  p.ada_b = (const float*)d_in[5];
  p.norm_mix_w = (const float*)d_in[6];
  p.norm_ffn_w = (const float*)d_in[7];
  p.ab_w_in = (const float*)d_in[8];
  p.ab_w_out = (const float*)d_in[9];
  p.attn_sink = (const float*)d_in[10];
  p.gs_w_in = (const float*)d_in[11];
  p.gs_norm_w = (const float*)d_in[12];
  p.gs_w_s = (const float*)d_in[13];
  p.gs_b_s = (const float*)d_in[14];
  p.gs_w_out = (const float*)d_in[15];
  p.peer_w_q = (const float*)d_in[16];
  p.peer_keys = (const float*)d_in[17];
  p.peer_u = (const float*)d_in[18];
  p.peer_v = (const float*)d_in[19];
  p.norm_out_w = (const float*)d_in[20];
  p.out = (float*)d_out;
  unsigned char* w = (unsigned char*)d_ws;
  size_t off = 0;
  auto take = [&](size_t bytes) {
    unsigned char* r = w + off;
    off = align_up(off + bytes);
    return r;
  };
  p.bar = (unsigned*)take((size_t)XCD_BAR_WORDS * 4);
  p.mod = (float*)take((size_t)DEPTH * 9 * 6144 * 4);
  p.cs = (float2*)take(64 * 16 * 8);
  p.xs = (float*)take((size_t)TT * D * 4);
  p.h = (bf16_t*)take((size_t)TT * D * 2);
  p.P = (bf16_t*)take((size_t)TT * 2048 * 2);
  p.kbuf = (bf16_t*)take((size_t)NB * 2 * KVLEN * 64 * 2);
  p.vbuf = (bf16_t*)take((size_t)NB * 2 * KVLEN * 64 * 2);
  p.zvT = (bf16_t*)take((size_t)TT * 1024 * 2);
  p.rowss = (float*)take((size_t)(TT / 128) * 32 * 128 * 4);
  p.mix = (bf16_t*)take((size_t)TT * LDMIX * 2);
  p.fa = (bf16_t*)take((size_t)TL * 1024 * 2);
  p.tops = (float*)take((size_t)TT * 256 * 4);
  p.eidx = (int*)take((size_t)TT * 128 * 4);
  p.gate = (float*)take((size_t)TT * 128 * 4);
  p.wt_in_ab = (bf16_t*)take((size_t)2 * 1280 * D * 2);
  p.wt_out_ab = (bf16_t*)take((size_t)2 * D * LDMIX * 2);
  p.wt_in_gs = (bf16_t*)take((size_t)2 * 2048 * D * 2);
  p.wt_out_gs = (bf16_t*)take((size_t)2 * D * D * 2);
  p.wt_q = (bf16_t*)take((size_t)DEPTH * 2048 * D * 2);
  p.keysb = (bf16_t*)take((size_t)DEPTH * 8 * 2 * 128 * 128 * 2);
  p.su = (float*)take((size_t)DEPTH * NEXP * 4);
  p.sv = (float*)take((size_t)DEPTH * NEXP * 4);
  p.h8 = (signed char*)take((size_t)TT * D);
  p.sx = (float*)take((size_t)TT * 4);
  p.utab = (unsigned char*)take((size_t)DEPTH * NEXP * D);
  p.vtab = (unsigned char*)take((size_t)DEPTH * NEXP * D);
  if (off > ws_size) {
    fprintf(stderr, "workspace too small: need %zu have %zu\n", off, ws_size);
    return;
  }
  hipMemsetAsync(p.bar, 0, (size_t)XCD_BAR_WORDS * 4, stream);
  static int grid_blocks = 0;
  if (!grid_blocks) {
    int dev = 0, cus = 0, per_cu = 0;
    hipGetDevice(&dev);
    hipDeviceGetAttribute(&cus, hipDeviceAttributeMultiprocessorCount, dev);
    hipOccupancyMaxActiveBlocksPerMultiprocessor(&per_cu, mega, PHYS_THREADS, 0);
    if (per_cu > 1) per_cu = 1;
    if (per_cu < 1) per_cu = 1;
    grid_blocks = cus * per_cu;
  }
#if ONE_LAUNCH
  int lo = 0, hi = NSTEPS;
  void* args[] = {&p, &lo, &hi};
  hipError_t e = hipLaunchCooperativeKernel((void*)mega, dim3(grid_blocks), dim3(PHYS_THREADS), args, 0, stream);
  if (e != hipSuccess) fprintf(stderr, "cooperative launch failed: %s (grid %d)\n", hipGetErrorString(e), grid_blocks);
#else
  for (int s = 0; s < NSTEPS; ++s) {
    if (s != 0 && s != NSTEPS - 1) {
      int layer = (s - 1) / STEPS_PER_LAYER, ph = (s - 1) % STEPS_PER_LAYER;
      if (ph == 3 && (layer & 1)) continue;
    }
    hipLaunchKernelGGL(mega, dim3(grid_blocks), dim3(NTHREADS), 0, stream, p, s, s + 1);
  }
#endif
}
```

```cpp
#include <hip/hip_runtime.h>
#include <hip/hip_bf16.h>
#include <hip/hip_cooperative_groups.h>
#include <cstdio>
namespace cg = cooperative_groups;

#ifndef PROBE_PH
#define PROBE_PH 0
#endif
#ifndef REP_MASK
#define REP_MASK 0
#endif
#ifndef REP_MODE
#define REP_MODE 0
#endif
#ifndef REP_IDMASK
#define REP_IDMASK 0xffff
#endif
#ifndef ONE_LAUNCH
#define ONE_LAUNCH 1
#endif

#define DEVI __device__ __forceinline__
typedef unsigned short bf16_t;
using bf16x8 = __attribute__((ext_vector_type(8))) short;
using f32x4 = __attribute__((ext_vector_type(4))) float;
using f32x16 = __attribute__((ext_vector_type(16))) float;

constexpr int D = 1024, NB = 8, SEQ = 4096, CTX = 256, DEPTH = 4;
constexpr int TL = NB * SEQ, TC = NB * CTX, TT = TL + TC;
constexpr int KVLEN = CTX + SEQ;
constexpr int NEXP = 16384;
constexpr int LDMIX = 1536;
constexpr float USCALE = 64.f, VSCALE = 8.f;
constexpr int TPB = 68;
constexpr int LDS_HALF = 68 * 1024;
constexpr int LDS_BYTES = 2 * LDS_HALF;
constexpr int PHYS_THREADS = 512;
constexpr int NTHREADS = 256;
constexpr int STEPS_PER_LAYER = 9;
constexpr int NSTEPS = 1 + DEPTH * STEPS_PER_LAYER + 1;

struct Params {
  const float *x, *c, *ctx, *c_ctx, *ada_w, *ada_b, *norm_mix_w, *norm_ffn_w, *ab_w_in, *ab_w_out, *attn_sink,
      *gs_w_in, *gs_norm_w, *gs_w_s, *gs_b_s, *gs_w_out, *peer_w_q, *peer_keys, *peer_u, *peer_v, *norm_out_w;
  float* out;
  float* mod;
  float2* cs;
  float* xs;
  bf16_t* h;
  bf16_t* P;
  bf16_t* kbuf;
  bf16_t* vbuf;
  float* rowss;
  bf16_t* zvT;
  bf16_t* mix;
  bf16_t* fa;
  unsigned* bar;
  float* tops;
  int* eidx;
  float* gate;
  bf16_t *wt_in_ab, *wt_out_ab, *wt_in_gs, *wt_out_gs, *wt_q, *keysb;
  unsigned char *utab, *vtab;
  float* su;
  float* sv;
  signed char* h8;
  float* sx;
};

typedef const __attribute__((address_space(4))) Params* PP;

__shared__ __attribute__((aligned(16))) unsigned char g_lds[LDS_BYTES];
DEVI int hw_slot() {
  int h = (int)(__builtin_amdgcn_s_getreg((6 - 1) << 11 | 0 << 6 | 4) & 63u);
  asm volatile("" : "+s"(h));
  return h;
}
DEVI int wave_index() {
  int w = *reinterpret_cast<volatile int*>(g_lds + LDS_BYTES - 16 - 256 + 4 * hw_slot());
  return __builtin_amdgcn_readfirstlane(w);
}
DEVI int lane_id() { return (int)__builtin_amdgcn_mbcnt_hi(~0u, __builtin_amdgcn_mbcnt_lo(~0u, 0u)); }
DEVI int ltid() { int t = ((wave_index() & 3) << 6) | lane_id(); asm volatile("" : "+v"(t)); return t; }
DEVI int lbid() { int t = 2 * blockIdx.x + (wave_index() >> 2); asm volatile("" : "+s"(t)); return t; }
DEVI int lnblk() { int t = 2 * gridDim.x; asm volatile("" : "+s"(t)); return t; }
DEVI int ptid() { int t = (wave_index() << 6) | lane_id(); asm volatile("" : "+v"(t)); return t; }
DEVI int pbid() { int t = blockIdx.x; asm volatile("" : "+s"(t)); return t; }
DEVI int pnblk() { int t = gridDim.x; asm volatile("" : "+s"(t)); return t; }

typedef __bf16 bf2v_t __attribute__((ext_vector_type(2)));
typedef float f2v_t __attribute__((ext_vector_type(2)));
DEVI bf16_t f2bf(float f) { return __builtin_bit_cast(unsigned short, (__bf16)f); }
DEVI float bf2f(bf16_t h) { return __uint_as_float(((unsigned)h) << 16); }
DEVI float bflo(unsigned u) { return __uint_as_float(u << 16); }
DEVI float bfhi(unsigned u) { return __uint_as_float(u & 0xffff0000u); }
DEVI unsigned pack2(float a, float b) {
  f2v_t v = {a, b};
  return __builtin_bit_cast(unsigned, __builtin_convertvector(v, bf2v_t));
}
DEVI float gelu_tanh(float x) {
  const float k1 = -2.f * 0.7978845608028654f * 1.4426950408889634f;
  const float a = x * __builtin_fmaf(x * x, k1 * 0.044715f, k1);
  return x * __builtin_amdgcn_rcpf(1.f + __builtin_amdgcn_exp2f(a));
}
template <int CTRL>
DEVI float dpp_mov(float v) {
  return __builtin_bit_cast(float, __builtin_amdgcn_mov_dpp(__builtin_bit_cast(int, v), CTRL, 0xF, 0xF, true));
}
DEVI int shx_i(int v, int m) { return __builtin_amdgcn_ds_bpermute((lane_id() ^ m) << 2, v); }
DEVI float shx_f(float v, int m) { return __builtin_bit_cast(float, shx_i(__builtin_bit_cast(int, v), m)); }
DEVI float wave_sum(float v) {
  v += dpp_mov<0xB1>(v);
  v += dpp_mov<0x4E>(v);
  v += dpp_mov<0x141>(v);
  v += dpp_mov<0x140>(v);
  v += shx_f(v, 16);
  v += shx_f(v, 32);
  return v;
}
DEVI float wave_max(float v) {
  v = fmaxf(v, dpp_mov<0xB1>(v));
  v = fmaxf(v, dpp_mov<0x4E>(v));
  v = fmaxf(v, dpp_mov<0x141>(v));
  v = fmaxf(v, dpp_mov<0x140>(v));
  v = fmaxf(v, shx_f(v, 16));
  v = fmaxf(v, shx_f(v, 32));
  return v;
}
DEVI int tok_batch(int r) { return r < TL ? (r >> 12) : 8; }

DEVI void prep_transpose_tile(const float* __restrict__ src, int N, bf16_t* __restrict__ dst, int ldk, int tk, int tn, float* tile, int tid) {
#pragma unroll
  for (int i = 0; i < 16; ++i) {
    int r = (tid >> 6) + 4 * i;
    tile[r * 65 + (tid & 63)] = src[(size_t)(tk * 64 + r) * N + tn * 64 + (tid & 63)];
  }
  __syncthreads();
#pragma unroll
  for (int i = 0; i < 16; ++i) {
    int n = (tid >> 6) + 4 * i, k = tid & 63;
    dst[(size_t)(tn * 64 + n) * ldk + tk * 64 + k] = f2bf(tile[k * 65 + n]);
  }
}

constexpr int PU_ADA = DEPTH * 96;
constexpr int PU_T_ABIN = 2 * 16 * 20;
constexpr int PU_T_GSIN = 2 * 16 * 32;
constexpr int PU_T_GSOUT = 2 * 16 * 16;
constexpr int PU_T_ABOUT = 2 * 8 * 16;
constexpr int PU_T_Q = DEPTH * 16 * 32;
constexpr int PU_FOLD = 2 * 4 * 16 * 2;
constexpr int PU_CONV = DEPTH * NEXP * D / 4 / 2048;
constexpr int PU_KEYS = DEPTH * 8 * 2 * 128 * 128 / 4 / 2048;
constexpr int PU_UROWS = DEPTH * NEXP / 32;
constexpr int PU_TOTAL = PU_ADA + PU_T_ABIN + PU_T_GSIN + PU_T_GSOUT + PU_T_ABOUT + PU_T_Q + PU_FOLD + 2 * PU_UROWS + PU_KEYS + 1;

DEVI void phase_prep(PP p, unsigned char* lds) {
  const int tid = ltid();
  float* fl = reinterpret_cast<float*>(lds);
  for (int u0 = lbid(); u0 < PU_TOTAL; u0 += lnblk()) {
    int u = u0;
    if (u < PU_ADA) {
      float* sl = fl;
      for (int i = tid; i < 9 * 1024; i += NTHREADS) {
        int r = i >> 10, k = i & 1023;
        float v = (r < 8) ? p->c[r * 1024 + k] : p->c_ctx[k];
        sl[i] = v / (1.f + __expf(-v));
      }
      __syncthreads();
      float* red = sl + 9 * 1024;
      int ks = tid >> 6, col = tid & 63;
      int layer = u / 96, c0 = (u % 96) * 64;
      const float* w = p->ada_w + (size_t)layer * D * 6144 + c0 + col;
      float acc[9];
#pragma unroll
      for (int r = 0; r < 9; ++r) acc[r] = 0.f;
      for (int k0 = ks * 256; k0 < ks * 256 + 256; k0 += 16) {
        float wv[16];
#pragma unroll
        for (int kk = 0; kk < 16; ++kk) wv[kk] = w[(size_t)(k0 + kk) * 6144];
#pragma unroll
        for (int kk = 0; kk < 16; ++kk)
#pragma unroll
          for (int r = 0; r < 9; ++r) acc[r] += sl[r * 1024 + k0 + kk] * wv[kk];
      }
#pragma unroll
      for (int r = 0; r < 9; ++r) red[(ks * 9 + r) * 64 + col] = acc[r];
      __syncthreads();
      for (int i = tid; i < 9 * 64; i += NTHREADS) {
        int r = i >> 6, cc = i & 63;
        float sm = red[(0 * 9 + r) * 64 + cc] + red[(1 * 9 + r) * 64 + cc] + red[(2 * 9 + r) * 64 + cc] + red[(3 * 9 + r) * 64 + cc];
        sm += p->ada_b[(size_t)layer * 6144 + c0 + cc];
        p->mod[((size_t)layer * 9 + r) * 6144 + c0 + cc] = sm;
      }
      __syncthreads();
      continue;
    }
    u -= PU_ADA;
    if (u < PU_T_ABIN) {
      int j = u / 320, t = u % 320;
      prep_transpose_tile(p->ab_w_in + (size_t)j * D * 1280, 1280, p->wt_in_ab + (size_t)j * 1280 * D, D, t / 20, t % 20, fl, tid);
      __syncthreads();
      continue;
    }
    u -= PU_T_ABIN;
    if (u < PU_T_GSIN) {
      int j = u / 512, t = u % 512;
      prep_transpose_tile(p->gs_w_in + (size_t)j * D * 2048, 2048, p->wt_in_gs + (size_t)j * 2048 * D, D, t / 32, t % 32, fl, tid);
      __syncthreads();
      continue;
    }
    u -= PU_T_GSIN;
    if (u < PU_T_GSOUT) {
      int j = u / 256, t = u % 256;
      prep_transpose_tile(p->gs_w_out + (size_t)j * D * D, D, p->wt_out_gs + (size_t)j * D * D, D, t / 16, t % 16, fl, tid);
      __syncthreads();
      continue;
    }
    u -= PU_T_GSOUT;
    if (u < PU_T_ABOUT) {
      int j = u / 128, t = u % 128;
      prep_transpose_tile(p->ab_w_out + (size_t)j * D * D, D, p->wt_out_ab + (size_t)j * D * LDMIX, LDMIX, t / 16, t % 16, fl, tid);
      __syncthreads();
      continue;
    }
    u -= PU_T_ABOUT;
    if (u < PU_T_Q) {
      int i = u / 512, t = u % 512;
      prep_transpose_tile(p->peer_w_q + (size_t)i * D * 2048, 2048, p->wt_q + (size_t)i * 2048 * D, D, t / 32, t % 32, fl, tid);
      __syncthreads();
      continue;
    }
    u -= PU_T_Q;
    if (u < PU_FOLD) {
      const int mh = u & 1, nc = (u >> 1) & 15, g = (u >> 5) & 3, j = u >> 7;
      float2* tw = reinterpret_cast<float2*>(lds);
      float* wt = reinterpret_cast<float*>(lds + 1024);
      if (tid < 128) {
        float sn, cn;
        sincospif((float)tid / 64.f, &sn, &cn);
        tw[tid] = make_float2(cn, sn);
      }
      {
        const float* wsrc = p->ab_w_out + (size_t)j * D * D + (size_t)(512 + g * 128) * D + nc * 64;
#pragma unroll 8
        for (int i = 0; i < 32; ++i) {
          int l = (tid >> 6) + 4 * i;
          wt[l * 64 + (tid & 63)] = wsrc[(size_t)l * D + (tid & 63)];
        }
      }
      __syncthreads();
      const int n = tid & 63, mq = __builtin_amdgcn_readfirstlane(tid >> 6);
      bf16_t* dst = p->wt_out_ab + (size_t)j * D * LDMIX + (size_t)(nc * 64 + n) * LDMIX + g * 128;
#pragma unroll 1
      for (int mi = 0; mi < 16; ++mi) {
        const int m = mh * 64 + mq * 16 + mi;
        float ar = 0.f, ai = 0.f;
#pragma unroll 16
        for (int l = 0; l < 128; ++l) {
          float2 t = tw[(m * l) & 127];
          float wv = wt[l * 64 + n];
          ar += t.x * wv;
          ai += t.y * wv;
        }
        dst[512 + m] = f2bf(ar);
        dst[1024 + m] = f2bf(ai);
      }
      __syncthreads();
      continue;
    }
    u -= PU_FOLD;
    if (u < 2 * PU_UROWS) {
      const bool isv = u >= PU_UROWS;
      if (isv) u -= PU_UROWS;
      const float* src = isv ? p->peer_v : p->peer_u;
      unsigned char* dst = isv ? p->vtab : p->utab;
      float* sdst = isv ? p->sv : p->su;
      const int lane = tid & 63, wv = tid >> 6;
#pragma unroll 1
      for (int rr = 0; rr < 8; rr += 4) {
        size_t row0 = (size_t)u * 32 + wv * 8 + rr;
        float4 v[4][4];
#pragma unroll
        for (int k = 0; k < 4; ++k)
#pragma unroll
          for (int i = 0; i < 4; ++i) v[k][i] = reinterpret_cast<const float4*>(src + (row0 + k) * D)[lane * 4 + i];
#pragma unroll
        for (int k = 0; k < 4; ++k) {
          float am = 0.f;
#pragma unroll
          for (int i = 0; i < 4; ++i)
            am = fmaxf(am, fmaxf(fmaxf(fabsf(v[k][i].x), fabsf(v[k][i].y)), fmaxf(fabsf(v[k][i].z), fabsf(v[k][i].w))));
          am = wave_max(am);
          am = fmaxf(am, 1e-30f);
          float qs = 127.f / am;
          uint4 o;
          unsigned* op = reinterpret_cast<unsigned*>(&o);
#pragma unroll
          for (int i = 0; i < 4; ++i) {
            int q0 = (int)rintf(v[k][i].x * qs), q1 = (int)rintf(v[k][i].y * qs), q2 = (int)rintf(v[k][i].z * qs), q3 = (int)rintf(v[k][i].w * qs);
            op[i] = (unsigned)(q0 & 255) | ((unsigned)(q1 & 255) << 8) | ((unsigned)(q2 & 255) << 16) | ((unsigned)(q3 & 255) << 24);
          }
          reinterpret_cast<uint4*>(dst + (row0 + k) * D)[lane] = o;
          if (lane == 0) sdst[row0 + k] = am * (1.f / 127.f);
        }
      }
      continue;
    }
    u -= 2 * PU_UROWS;
    if (u < PU_KEYS) {
      const float4* s4 = reinterpret_cast<const float4*>(p->peer_keys) + (size_t)u * 2048 + tid;
      uint2* d2 = reinterpret_cast<uint2*>(p->keysb) + (size_t)u * 2048 + tid;
#pragma unroll
      for (int k = 0; k < 8; ++k) {
        float4 v = s4[k * 256];
        uint2 o;
        o.x = pack2(v.x, v.y);
        o.y = pack2(v.z, v.w);
        d2[k * 256] = o;
      }
      continue;
    }
    for (int i = tid; i < 64 * 16; i += NTHREADS) {
      int pos = i >> 4, k = i & 15;
      float inv = powf(10000.f, -(float)k / 16.f);
      float ang = (float)pos * inv;
      float sn, cn;
      sincosf(ang, &sn, &cn);
      p->cs[i] = make_float2(cn, sn);
    }
  }
}

DEVI void norm_row(PP p, int layer, int which, int tok, int lane) {
  const float* w = which == 0 ? p->norm_mix_w + layer * D : (which == 1 ? p->norm_ffn_w + layer * D : p->norm_out_w);
  const float* xsrc = p->xs + (size_t)tok * D;
  if (which == 0 && layer == 0) xsrc = (tok < TL) ? p->x + (size_t)tok * D : p->ctx + (size_t)(tok - TL) * D;
  const float4* xr = reinterpret_cast<const float4*>(xsrc);
  float4 v[4];
  float ss = 0.f;
#pragma unroll
  for (int i = 0; i < 4; ++i) {
    v[i] = xr[lane + 64 * i];
    ss += v[i].x * v[i].x + v[i].y * v[i].y + v[i].z * v[i].z + v[i].w * v[i].w;
  }
  ss = wave_sum(ss);
  float rstd = rsqrtf(ss * (1.f / 1024.f) + 1e-6f);
  if (which == 2) {
    float4* o = reinterpret_cast<float4*>(p->out + (size_t)tok * D);
#pragma unroll
    for (int i = 0; i < 4; ++i) {
      float4 wv = reinterpret_cast<const float4*>(w)[lane + 64 * i];
      float4 r;
      r.x = v[i].x * rstd * wv.x;
      r.y = v[i].y * rstd * wv.y;
      r.z = v[i].z * rstd * wv.z;
      r.w = v[i].w * rstd * wv.w;
      o[lane + 64 * i] = r;
    }
  } else {
    int b = tok_batch(tok);
    const float* mb = p->mod + ((size_t)layer * 9 + b) * 6144 + (which == 0 ? 0 : 3072);
    uint2* o = reinterpret_cast<uint2*>(p->h + (size_t)tok * D);
    float av[4][4];
    float am = 0.f;
#pragma unroll
    for (int i = 0; i < 4; ++i) {
      float4 wv = reinterpret_cast<const float4*>(w)[lane + 64 * i];
      float4 sh = reinterpret_cast<const float4*>(mb)[lane + 64 * i];
      float4 sc = reinterpret_cast<const float4*>(mb + 1024)[lane + 64 * i];
      float a0 = v[i].x * rstd * wv.x * (1.f + sc.x) + sh.x;
      float a1 = v[i].y * rstd * wv.y * (1.f + sc.y) + sh.y;
      float a2 = v[i].z * rstd * wv.z * (1.f + sc.z) + sh.z;
      float a3 = v[i].w * rstd * wv.w * (1.f + sc.w) + sh.w;
      uint2 r;
      r.x = pack2(a0, a1);
      r.y = pack2(a2, a3);
      o[lane + 64 * i] = r;
      av[i][0] = a0; av[i][1] = a1; av[i][2] = a2; av[i][3] = a3;
      am = fmaxf(am, fmaxf(fmaxf(fabsf(a0), fabsf(a1)), fmaxf(fabsf(a2), fabsf(a3))));
    }
    if (which == 1) {
      am = fmaxf(wave_max(am), 1e-30f);
      float qs = 127.f / am;
      unsigned* o8 = reinterpret_cast<unsigned*>(p->h8 + (size_t)tok * D);
#pragma unroll
      for (int i = 0; i < 4; ++i) {
        int q0 = (int)rintf(av[i][0] * qs), q1 = (int)rintf(av[i][1] * qs), q2 = (int)rintf(av[i][2] * qs), q3 = (int)rintf(av[i][3] * qs);
        o8[lane + 64 * i] = (unsigned)(q0 & 255) | ((unsigned)(q1 & 255) << 8) | ((unsigned)(q2 & 255) << 16) | ((unsigned)(q3 & 255) << 24);
      }
      if (lane == 0) p->sx[tok] = am * (1.f / 127.f);
    }
  }
}

DEVI void phase_norm(PP p, int layer, int which, int ntok) {
  int lane = ltid() & 63;
  int gw = lbid() * 4 + __builtin_amdgcn_readfirstlane(ltid() >> 6), nw = lnblk() * 4;
  for (int tok = gw; tok < ntok; tok += nw) norm_row(p, layer, which, tok, lane);
}

enum { EPI_STORE = 0, EPI_GELU = 1, EPI_RESID = 2, EPI_INPROJ = 3, EPI_RESID0 = 4 };

template <int EPI>
DEVI void gemm_phase(PP p, const bf16_t* __restrict__ A, int lda, const bf16_t* __restrict__ Bt, int ldb,
                     int Mtiles, int Ntiles, int K, int layer, unsigned char* lds, float gscale = 1.f, int big_t0 = -1, int big_n = 0,
                     int big_ntn = 1) {
  const int tid = ltid();
  const int wid = __builtin_amdgcn_readfirstlane(tid >> 6), lane = tid & 63, wr = wid >> 1, wc = wid & 1, fr = lane & 15, fq = lane >> 4;
  int nblk = lnblk();
  int bid = lbid();
  int lb = bid;
  {
    const int pn = nblk >> 1, pb = bid >> 1;
    if ((pn & 7) == 0) lb = 2 * ((pb & 7) * (pn >> 3) + (pb >> 3)) + (bid & 1);
  }
  int ntiles = (big_t0 >= 0) ? 4 * big_n : Mtiles * Ntiles;
  const int nk = K / 64;
  const int srow = tid >> 3;
  const int scol = ((tid & 7) ^ ((tid >> 3) & 7)) * 8;
#define GEMM_STAGE(ga_, gb_, kt_, buf_)                                                                               \
  {                                                                                                                   \
    _Pragma("unroll") for (int i_ = 0; i_ < 4; ++i_) {                                                                \
      __builtin_amdgcn_global_load_lds((const unsigned*)((ga_) + (size_t)(32 * i_) * lda + (kt_) * 64),               \
                                       (__attribute__((address_space(3))) unsigned*)(lds + (buf_) * 32768 + tid * 16 + i_ * 4096), 16, 0, 0); \
      __builtin_amdgcn_global_load_lds((const unsigned*)((gb_) + (size_t)(32 * i_) * ldb + (kt_) * 64),               \
                                       (__attribute__((address_space(3))) unsigned*)(lds + (buf_) * 32768 + 16384 + tid * 16 + i_ * 4096), 16, 0, 0); \
    }                                                                                                                 \
  }
  auto tile_rc = [&](int t, int& tm_, int& tn_) {
    if (big_t0 >= 0) {
      int bt = big_t0 + (t >> 2), q = t & 3;
      tm_ = 2 * (bt / big_ntn) + (q >> 1);
      tn_ = 2 * (bt % big_ntn) + (q & 1);
    } else {
      tm_ = t / Ntiles;
      tn_ = t % Ntiles;
    }
  };
  if (lb < ntiles) {
    int tm0, tn0;
    tile_rc(lb, tm0, tn0);
    const bf16_t* ga0 = A + (size_t)(tm0 * 128 + srow) * lda + scol;
    const bf16_t* gb0 = Bt + (size_t)(tn0 * 128 + srow) * ldb + scol;
    GEMM_STAGE(ga0, gb0, 0, 0)
  }
  for (int t = lb; t < ntiles; t += nblk) {
    int tm, tn;
    tile_rc(t, tm, tn);
    int brow = tm * 128, bcol = tn * 128;
    f32x4 acc[4][4];
#pragma unroll
    for (int m = 0; m < 4; ++m)
#pragma unroll
      for (int n = 0; n < 4; ++n) acc[m][n] = f32x4{0.f, 0.f, 0.f, 0.f};
    const bf16_t* ga = A + (size_t)(brow + srow) * lda + scol;
    const bf16_t* gb = Bt + (size_t)(bcol + srow) * ldb + scol;
    for (int kt = 0; kt < nk; ++kt) {
      const int buf = kt & 1;
      asm volatile("s_waitcnt vmcnt(0)" ::: "memory");
      __syncthreads();
      if (kt + 1 < nk) GEMM_STAGE(ga, gb, kt + 1, buf ^ 1)
      const unsigned char* SA = lds + buf * 32768;
      const unsigned char* SB = SA + 16384;
      bf16x8 At[2][4], Bl[2][4];
#pragma unroll
      for (int ks = 0; ks < 2; ++ks)
#pragma unroll
        for (int m = 0; m < 4; ++m) {
          const int sl = ((ks * 4 + fq) ^ (fr & 7)) << 4;
          At[ks][m] = *reinterpret_cast<const bf16x8*>(SA + (wr * 64 + m * 16 + fr) * 128 + sl);
          Bl[ks][m] = *reinterpret_cast<const bf16x8*>(SB + (wc * 64 + m * 16 + fr) * 128 + sl);
        }
#pragma unroll
      for (int ks = 0; ks < 2; ++ks)
#pragma unroll
        for (int m = 0; m < 4; ++m)
#pragma unroll
          for (int n = 0; n < 4; ++n)
            acc[m][n] = __builtin_amdgcn_mfma_f32_16x16x32_bf16(At[ks][m], Bl[ks][n], acc[m][n], 0, 0, 0);
    }
    {
      int t2 = t + nblk;
      if (t2 < ntiles) {
        int tm2, tn2;
        tile_rc(t2, tm2, tn2);
        const bf16_t* ga2 = A + (size_t)(tm2 * 128 + srow) * lda + scol;
        const bf16_t* gb2 = Bt + (size_t)(tn2 * 128 + srow) * ldb + scol;
        GEMM_STAGE(ga2, gb2, 0, 0)
      }
    }
    const int colbase = bcol + wc * 64;
    if constexpr (EPI == EPI_STORE || EPI == EPI_GELU) {
      if (EPI == EPI_GELU && colbase >= 1024) {
        float* rsp = p->rowss + ((size_t)tm * 32 + ((colbase - 1024) >> 5)) * 128;
#pragma unroll
        for (int m = 0; m < 4; ++m) {
          float ssq[4] = {0.f, 0.f, 0.f, 0.f};
#pragma unroll
          for (int n = 0; n < 4; ++n) {
            int ch = colbase - 1024 + n * 16 + fr;
            int q0 = wr * 64 + m * 16 + fq * 4;
            float g0 = gelu_tanh(acc[m][n][0]), g1 = gelu_tanh(acc[m][n][1]), g2 = gelu_tanh(acc[m][n][2]), g3 = gelu_tanh(acc[m][n][3]);
            ssq[0] += g0 * g0;
            ssq[1] += g1 * g1;
            ssq[2] += g2 * g2;
            ssq[3] += g3 * g3;
            uint2 o;
            o.x = pack2(g0, g1);
            o.y = pack2(g2, g3);
            *reinterpret_cast<uint2*>(p->zvT + ((size_t)tm * 1024 + ch) * 128 + q0) = o;
          }
#pragma unroll
          for (int j = 0; j < 4; ++j) {
            float v = ssq[j];
            v += dpp_mov<0xB1>(v);
            v += dpp_mov<0x4E>(v);
            v += dpp_mov<0x141>(v);
            v += dpp_mov<0x140>(v);
            if (fr == 0) {
              rsp[wr * 64 + m * 16 + fq * 4 + j] = v;
              rsp[128 + wr * 64 + m * 16 + fq * 4 + j] = 0.f;
            }
          }
        }
      } else {
#pragma unroll
        for (int m = 0; m < 4; ++m)
#pragma unroll
          for (int j = 0; j < 4; ++j) {
            int row = brow + wr * 64 + m * 16 + fq * 4 + j;
            bf16_t* o = p->P + (size_t)row * 2048 + colbase + fr;
#pragma unroll
            for (int n = 0; n < 4; ++n) {
              float v = acc[m][n][j];
              if (EPI == EPI_GELU) v = gelu_tanh(v);
              o[n * 16] = f2bf(v);
            }
          }
      }
    } else if constexpr (EPI == EPI_RESID) {
#pragma unroll
      for (int m = 0; m < 4; ++m)
#pragma unroll
        for (int j = 0; j < 4; ++j) {
          int row = brow + wr * 64 + m * 16 + fq * 4 + j;
          int b = tok_batch(row);
          const float* g = p->mod + ((size_t)layer * 9 + b) * 6144 + 2048 + colbase + fr;
          float* o = p->xs + (size_t)row * D + colbase + fr;
          const float* xi = o;
          if (layer == 0 && gscale == 1.f)
            xi = ((row < TL) ? p->x + (size_t)row * D : p->ctx + (size_t)(row - TL) * D) + colbase + fr;
#pragma unroll
          for (int n = 0; n < 4; ++n) o[n * 16] = xi[n * 16] + gscale * g[n * 16] * acc[m][n][j];
        }
    } else if constexpr (EPI == EPI_INPROJ) {
      if (colbase >= 640 && colbase < 768) {
        int kvh = (colbase - 640) >> 6;
#pragma unroll
        for (int m = 0; m < 4; ++m) {
          int row0 = brow + wr * 64 + m * 16;
          bool latent = row0 < TL;
          int b = latent ? (row0 >> 12) : ((row0 - TL) >> 8);
          int kp16 = latent ? (CTX + (row0 & 4095)) : ((row0 - TL) & 255);
          int slot = kp16 + 8 * (fq & 1) + 4 * (fq >> 1);
#pragma unroll
          for (int n = 0; n < 4; ++n) {
            int dim = n * 16 + fr;
            uint2 o;
            o.x = pack2(acc[m][n][0], acc[m][n][1]);
            o.y = pack2(acc[m][n][2], acc[m][n][3]);
            *reinterpret_cast<uint2*>(p->vbuf + ((size_t)(b * 2 + kvh) * 64 + dim) * KVLEN + slot) = o;
          }
        }
      } else {
#pragma unroll
        for (int m = 0; m < 4; ++m)
#pragma unroll
          for (int j = 0; j < 4; ++j) {
            int row = brow + wr * 64 + m * 16 + fq * 4 + j;
            bool latent = row < TL;
            int b, pos;
            if (latent) {
              b = row >> 12;
              pos = row & 4095;
            } else {
              b = (row - TL) >> 8;
              pos = (row - TL) & 255;
            }
            float v0 = acc[m][0][j], v1 = acc[m][1][j], v2 = acc[m][2][j], v3 = acc[m][3][j];
            if (latent && colbase < 640) {
              float2 cr = p->cs[(pos >> 6) * 16 + fr];
              float2 cc = p->cs[(pos & 63) * 16 + fr];
              float a = v0, bb = v1;
              v0 = a * cr.x - bb * cr.y;
              v1 = bb * cr.x + a * cr.y;
              a = v2;
              bb = v3;
              v2 = a * cc.x - bb * cc.y;
              v3 = bb * cc.x + a * cc.y;
            }
            bf16_t* o;
            if (colbase < 512 || colbase >= 768) {
              o = p->P + (size_t)row * 2048 + colbase + fr;
            } else {
              int kvh = (colbase - 512) >> 6;
              int kp = latent ? (CTX + pos) : pos;
              o = p->kbuf + ((size_t)(b * 2 + kvh) * KVLEN + kp) * 64 + fr;
            }
            o[0] = f2bf(v0);
            o[16] = f2bf(v1);
            o[32] = f2bf(v2);
            o[48] = f2bf(v3);
          }
      }
    }
  }
}

constexpr int G8_HT = 128 * 64;
DEVI int g8_lds_byte(int r, int c) {
  int st = (r >> 4) * 2 + (c >> 5), rr = r & 15, cc = c & 31, ob = rr * 64 + cc * 2;
  return st * 1024 + (ob ^ (((ob >> 9) & 1) << 5));
}
DEVI void g8_stage_rc(int b, int& R, int& C) {
  int st = b / 1024, sb = b % 1024, swz = sb ^ (((sb >> 9) & 1) << 5);
  R = (st >> 1) * 16 + swz / 64;
  C = (st & 1) * 32 + (swz % 64) / 2;
}
template <int EPI, bool STAGED>
DEVI void gemm8_epilogue(PP p, f32x4 (&acc)[2][2][4][2], const f32x4* stg, int lane, int brow, int bcol, int wr, int wc, int fr, int fq, int layer, float gscale) {
#pragma unroll
  for (int ai_ = 0; ai_ < 2; ++ai_)
#pragma unroll
    for (int bj = 0; bj < 2; ++bj) {
      const int ai = STAGED ? 1 - ai_ : ai_;
      f32x4 q[4][2];
#pragma unroll
      for (int m = 0; m < 4; ++m)
#pragma unroll
        for (int n = 0; n < 2; ++n) q[m][n] = (STAGED && ai == 0) ? stg[(((bj * 4 + m) * 2 + n) * 64) + lane] : acc[ai][bj][m][n];
      const int r0 = brow + ai * 128 + wr * 64;
      const int c0 = bcol + bj * 128 + wc * 32;
      if constexpr (EPI == EPI_STORE) {
#pragma unroll
        for (int m = 0; m < 4; ++m)
#pragma unroll
          for (int j = 0; j < 4; ++j) {
            bf16_t* o = p->P + (size_t)(r0 + m * 16 + fq * 4 + j) * 2048 + c0 + fr;
            o[0] = f2bf(q[m][0][j]);
            o[16] = f2bf(q[m][1][j]);
          }
      } else if constexpr (EPI == EPI_GELU) {
        if (c0 >= 1024) {
          const int chunk = r0 >> 7;
          float* rsp = p->rowss + ((size_t)chunk * 32 + ((c0 - 1024) >> 5)) * 128;
#pragma unroll
          for (int m = 0; m < 4; ++m) {
            float ssq[4] = {0.f, 0.f, 0.f, 0.f};
            const int q0 = (r0 & 127) + m * 16 + fq * 4;
#pragma unroll
            for (int n = 0; n < 2; ++n) {
              int ch = c0 - 1024 + n * 16 + fr;
              float g0 = gelu_tanh(q[m][n][0]), g1 = gelu_tanh(q[m][n][1]);
              float g2 = gelu_tanh(q[m][n][2]), g3 = gelu_tanh(q[m][n][3]);
              ssq[0] += g0 * g0;
              ssq[1] += g1 * g1;
              ssq[2] += g2 * g2;
              ssq[3] += g3 * g3;
              uint2 o;
              o.x = pack2(g0, g1);
              o.y = pack2(g2, g3);
              *reinterpret_cast<uint2*>(p->zvT + ((size_t)chunk * 1024 + ch) * 128 + q0) = o;
            }
#pragma unroll
            for (int j = 0; j < 4; ++j) {
              float v = ssq[j];
              v += dpp_mov<0xB1>(v);
              v += dpp_mov<0x4E>(v);
              v += dpp_mov<0x141>(v);
              v += dpp_mov<0x140>(v);
              if (fr == 0) rsp[q0 + j] = v;
            }
          }
        } else {
#pragma unroll
          for (int m = 0; m < 4; ++m)
#pragma unroll
            for (int j = 0; j < 4; ++j) {
              bf16_t* o = p->P + (size_t)(r0 + m * 16 + fq * 4 + j) * 2048 + c0 + fr;
              o[0] = f2bf(gelu_tanh(q[m][0][j]));
              o[16] = f2bf(gelu_tanh(q[m][1][j]));
            }
        }
      } else if constexpr (EPI == EPI_RESID || EPI == EPI_RESID0) {
        const float* g = p->mod + ((size_t)layer * 9 + tok_batch(brow)) * 6144 + 2048 + c0 + fr;
        const float g0 = g[0], g1 = g[16];
        const float* xin = (brow < TL) ? p->x : p->ctx - (size_t)TL * D;
#pragma unroll
        for (int m = 0; m < 4; ++m)
#pragma unroll
          for (int j = 0; j < 4; ++j) {
            const size_t ro = (size_t)(r0 + m * 16 + fq * 4 + j) * D + c0 + fr;
            float* o = p->xs + ro;
            const float* xi = (EPI == EPI_RESID0) ? xin + ro : o;
            o[0] = xi[0] + g0 * q[m][0][j];
            o[16] = xi[16] + g1 * q[m][1][j];
          }
      } else if constexpr (EPI == EPI_INPROJ) {
        if (c0 >= 640 && c0 < 768) {
          const int kvh = (c0 - 640) >> 6, d0 = (c0 - 640) & 63;
#pragma unroll
          for (int m = 0; m < 4; ++m) {
            int row0 = r0 + m * 16;
            bool latent = row0 < TL;
            int b = latent ? (row0 >> 12) : ((row0 - TL) >> 8);
            int kp16 = latent ? (CTX + (row0 & 4095)) : ((row0 - TL) & 255);
            int slot = kp16 + 8 * (fq & 1) + 4 * (fq >> 1);
#pragma unroll
            for (int n = 0; n < 2; ++n) {
              int dim = d0 + n * 16 + fr;
              uint2 o;
              o.x = pack2(q[m][n][0], q[m][n][1]);
              o.y = pack2(q[m][n][2], q[m][n][3]);
              *reinterpret_cast<uint2*>(p->vbuf + ((size_t)(b * 2 + kvh) * 64 + dim) * KVLEN + slot) = o;
            }
          }
        } else {
          const int hsel = (c0 >> 5) & 1;
#pragma unroll
          for (int m = 0; m < 4; ++m)
#pragma unroll
            for (int j = 0; j < 4; ++j) {
              int row = r0 + m * 16 + fq * 4 + j;
              bool latent = row < TL;
              int b, pos;
              if (latent) {
                b = row >> 12;
                pos = row & 4095;
              } else {
                b = (row - TL) >> 8;
                pos = (row - TL) & 255;
              }
              float v0 = q[m][0][j], v1 = q[m][1][j];
              if (latent && c0 < 640) {
                float2 cs = p->cs[(hsel ? (pos & 63) : (pos >> 6)) * 16 + fr];
                float a = v0, bb = v1;
                v0 = a * cs.x - bb * cs.y;
                v1 = bb * cs.x + a * cs.y;
              }
              bf16_t* o;
              if (c0 < 512 || c0 >= 768) {
                o = p->P + (size_t)row * 2048 + c0 + fr;
              } else {
                int kvh = (c0 - 512) >> 6, d0 = (c0 - 512) & 63;
                int kp = latent ? (CTX + pos) : pos;
                o = p->kbuf + ((size_t)(b * 2 + kvh) * KVLEN + kp) * 64 + d0 + fr;
              }
              o[0] = f2bf(v0);
              o[16] = f2bf(v1);
            }
        }
      }
      __builtin_amdgcn_sched_barrier(0);
    }
}

DEVI int g8_perm32(int rho) { const int n = rho >> 4, i = rho & 15; return 8 * (i >> 2) + 4 * n + (i & 3); }
template <int EPI>
DEVI void gemm8_epilogue_tr(PP p, f32x4 (&acc)[2][2][4][2], int brow, int bcol, int wr, int wc, int fr, int fq, int layer, float gscale) {
  if constexpr (EPI == EPI_STORE) {
#pragma unroll
    for (int ai = 0; ai < 2; ++ai)
#pragma unroll
      for (int m = 0; m < 4; ++m) {
        bf16_t* o = p->P + (size_t)(brow + ai * 128 + wr * 64 + m * 16 + fr) * 2048 + bcol + wc * 32 + 8 * fq;
#pragma unroll
        for (int bj = 0; bj < 2; ++bj) {
          const f32x4 v0 = acc[ai][bj][m][0], v1 = acc[ai][bj][m][1];
          uint4 w;
          w.x = pack2(v0[0], v0[1]);
          w.y = pack2(v0[2], v0[3]);
          w.z = pack2(v1[0], v1[1]);
          w.w = pack2(v1[2], v1[3]);
          *reinterpret_cast<uint4*>(o + bj * 128) = w;
        }
      }
  } else if constexpr (EPI == EPI_RESID || EPI == EPI_RESID0) {
    const float* xin = (brow < TL) ? p->x : p->ctx - (size_t)TL * D;
#pragma unroll
    for (int bj = 0; bj < 2; ++bj) {
      const int c0 = bcol + bj * 128 + wc * 32 + 4 * fq;
      const float* g = p->mod + ((size_t)layer * 9 + tok_batch(brow)) * 6144 + 2048 + c0;
      const f32x4 g0 = *reinterpret_cast<const f32x4*>(g) * gscale, g1 = *reinterpret_cast<const f32x4*>(g + 16) * gscale;
      f32x4 xr[2][4][2];
#pragma unroll
      for (int ai = 0; ai < 2; ++ai)
#pragma unroll
        for (int m = 0; m < 4; ++m) {
          const size_t ro = (size_t)(brow + ai * 128 + wr * 64 + m * 16 + fr) * D + c0;
          const float* xi = (EPI == EPI_RESID0) ? xin + ro : p->xs + ro;
          xr[ai][m][0] = *reinterpret_cast<const f32x4*>(xi);
          xr[ai][m][1] = *reinterpret_cast<const f32x4*>(xi + 16);
        }
      __builtin_amdgcn_sched_barrier(0);
#pragma unroll
      for (int ai = 0; ai < 2; ++ai)
#pragma unroll
        for (int m = 0; m < 4; ++m) {
          float* o = p->xs + (size_t)(brow + ai * 128 + wr * 64 + m * 16 + fr) * D + c0;
          *reinterpret_cast<f32x4*>(o) = xr[ai][m][0] + g0 * acc[ai][bj][m][0];
          *reinterpret_cast<f32x4*>(o + 16) = xr[ai][m][1] + g1 * acc[ai][bj][m][1];
        }
      __builtin_amdgcn_sched_barrier(0);
    }
  } else if constexpr (EPI == EPI_INPROJ) {
    const bool latent = brow < TL;
#pragma unroll
    for (int bj = 0; bj < 2; ++bj) {
      const int c0 = bcol + bj * 128 + wc * 32;
      if (c0 >= 640 && c0 < 768) {
        const int kvh = (c0 - 640) >> 6, d0 = ((c0 - 640) & 63) + 4 * fq;
        const int so = 8 * ((fr >> 2) & 1) + 4 * (fr >> 3) + (fr & 3);
#pragma unroll
        for (int ai = 0; ai < 2; ++ai)
#pragma unroll
          for (int m = 0; m < 4; ++m) {
            const int row0 = brow + ai * 128 + wr * 64 + m * 16;
            const int b = latent ? (row0 >> 12) : ((row0 - TL) >> 8);
            const int kp16 = latent ? (CTX + (row0 & 4095)) : ((row0 - TL) & 255);
            bf16_t* o = p->vbuf + ((size_t)(b * 2 + kvh) * 64 + d0) * KVLEN + kp16 + so;
#pragma unroll
            for (int n = 0; n < 2; ++n)
#pragma unroll
              for (int j = 0; j < 4; ++j) o[(size_t)(n * 16 + j) * KVLEN] = f2bf(acc[ai][bj][m][n][j]);
          }
      } else {
        const int hsel = (c0 >> 5) & 1;
#pragma unroll
        for (int ai = 0; ai < 2; ++ai)
#pragma unroll
          for (int m = 0; m < 4; ++m) {
            const int row = brow + ai * 128 + wr * 64 + m * 16 + fr;
            const int b = latent ? (row >> 12) : ((row - TL) >> 8);
            const int pos = latent ? (row & 4095) : ((row - TL) & 255);
            f32x4 v0 = acc[ai][bj][m][0], v1 = acc[ai][bj][m][1];
            if (latent && c0 < 640) {
              const f32x4* cp = reinterpret_cast<const f32x4*>(p->cs + (hsel ? (pos & 63) : (pos >> 6)) * 16 + 4 * fq);
              const f32x4 ca = cp[0], cb = cp[1];
              const f32x4 a = v0, bb = v1;
              v0[0] = a[0] * ca[0] - bb[0] * ca[1];
              v1[0] = bb[0] * ca[0] + a[0] * ca[1];
              v0[1] = a[1] * ca[2] - bb[1] * ca[3];
              v1[1] = bb[1] * ca[2] + a[1] * ca[3];
              v0[2] = a[2] * cb[0] - bb[2] * cb[1];
              v1[2] = bb[2] * cb[0] + a[2] * cb[1];
              v0[3] = a[3] * cb[2] - bb[3] * cb[3];
              v1[3] = bb[3] * cb[2] + a[3] * cb[3];
            }
            bf16_t* o;
            if (c0 < 512 || c0 >= 768) {
              o = p->P + (size_t)row * 2048 + c0 + 4 * fq;
            } else {
              const int kvh = (c0 - 512) >> 6, d0 = (c0 - 512) & 63;
              const int kp = latent ? (CTX + pos) : pos;
              o = p->kbuf + ((size_t)(b * 2 + kvh) * KVLEN + kp) * 64 + d0 + 4 * fq;
            }
            uint2 w0, w1;
            w0.x = pack2(v0[0], v0[1]);
            w0.y = pack2(v0[2], v0[3]);
            w1.x = pack2(v1[0], v1[1]);
            w1.y = pack2(v1[2], v1[3]);
            *reinterpret_cast<uint2*>(o) = w0;
            *reinterpret_cast<uint2*>(o + 16) = w1;
          }
      }
      __builtin_amdgcn_sched_barrier(0);
    }
  }
}

template <int EPI>
DEVI void gemm8_phase(PP p, const bf16_t* __restrict__ A, int lda, const bf16_t* __restrict__ Bt, int ldb, int Mtiles, int Ntiles,
                      int K, int layer, unsigned char* lds_all, float gscale = 1.f) {
  constexpr bool TR = (EPI != EPI_GELU);
  constexpr bool PERM = (EPI == EPI_STORE);
  bf16_t* shm = reinterpret_cast<bf16_t*>(lds_all);
  const int tid = ptid();
  const int wid = __builtin_amdgcn_readfirstlane(tid >> 6), lane = tid & 63, wr = wid >> 2, wc = wid & 3, fr = lane & 15, fq = lane >> 4;
#define G8_SA(b, h) (shm + ((b) * 2 + (h)) * G8_HT)
#define G8_SB(b, h) (shm + (4 + (b) * 2 + (h)) * G8_HT)
  const __amdgpu_buffer_rsrc_t rsA = __builtin_amdgcn_make_buffer_rsrc((void*)A, (short)0, -1, 0x00020000);
  const __amdgpu_buffer_rsrc_t rsB = __builtin_amdgcn_make_buffer_rsrc((void*)Bt, (short)0, -1, 0x00020000);
  unsigned voA[2], voB[2];
#pragma unroll
  for (int i = 0; i < 2; ++i) {
    int r_, c_;
    g8_stage_rc(tid * 16 + i * 8192, r_, c_);
    const int rb_ = PERM ? ((r_ & ~31) + g8_perm32(r_ & 31)) : r_;
    voA[i] = (unsigned)((r_ * lda + c_) * 2);
    voB[i] = (unsigned)((rb_ * ldb + c_) * 2);
  }
#define G8_STAGE(P_, RS_, VO_, ld_, br_, kt_)                                                                         \
  do {                                                                                                                \
    const unsigned so_ = (unsigned)(((br_) * (ld_) + (kt_) * 64) * 2);                                                \
    _Pragma("unroll") for (int i_ = 0; i_ < 2; ++i_)                                                                  \
      __builtin_amdgcn_raw_ptr_buffer_load_lds(RS_, (__attribute__((address_space(3))) void*)((unsigned char*)(P_) + wid * 1024 + i_ * 8192), 16, VO_[i_], so_, 0, 0); \
  } while (0)
#define G8_LDA(dst, b, h)                                                                                             \
  _Pragma("unroll") for (int m_ = 0; m_ < 4; ++m_) _Pragma("unroll") for (int k_ = 0; k_ < 2; ++k_)                   \
      dst[m_][k_] = *reinterpret_cast<const bf16x8*>((const unsigned char*)G8_SA(b, h) + g8_lds_byte(wr * 64 + m_ * 16 + fr, k_ * 32 + fq * 8))
#define G8_LDB(dst, b, h)                                                                                             \
  _Pragma("unroll") for (int n_ = 0; n_ < 2; ++n_) _Pragma("unroll") for (int k_ = 0; k_ < 2; ++k_)                   \
      dst[n_][k_] = *reinterpret_cast<const bf16x8*>((const unsigned char*)G8_SB(b, h) + g8_lds_byte(wc * 32 + n_ * 16 + fr, k_ * 32 + fq * 8))
#define G8_MMA(ai, bj, At_, Bt_)                                                                                      \
  do {                                                                                                                \
    __builtin_amdgcn_s_setprio(1);                                                                                    \
    _Pragma("unroll") for (int m_ = 0; m_ < 4; ++m_) _Pragma("unroll") for (int n_ = 0; n_ < 2; ++n_)                 \
        _Pragma("unroll") for (int k_ = 0; k_ < 2; ++k_) acc[ai][bj][m_][n_] =                                        \
            TR ? __builtin_amdgcn_mfma_f32_16x16x32_bf16(Bt_[n_][k_], At_[m_][k_], acc[ai][bj][m_][n_], 0, 0, 0)      \
               : __builtin_amdgcn_mfma_f32_16x16x32_bf16(At_[m_][k_], Bt_[n_][k_], acc[ai][bj][m_][n_], 0, 0, 0);     \
    __builtin_amdgcn_s_setprio(0);                                                                                    \
  } while (0)
#define G8_WAIT_V(n) asm volatile("s_waitcnt vmcnt(" #n ")" ::: "memory")
#define G8_WAIT_L(n) asm volatile("s_waitcnt lgkmcnt(" #n ")" ::: "memory")
#define G8_BAR __builtin_amdgcn_s_barrier()
#define G8_SCHED __builtin_amdgcn_sched_barrier(0)
  const int nblk = pnblk(), bid = pbid();
  const int lb = ((nblk & 7) == 0) ? ((bid & 7) * (nblk >> 3) + (bid >> 3)) : bid;
  const int ntiles_all = Mtiles * Ntiles;
  const int ntiles = (ntiles_all / nblk) * nblk;
  const int nt = K / 64;
  if (lb < ntiles) {
    int t = lb;
    int brow = (t / Ntiles) * 256, bcol = (t % Ntiles) * 256;
    f32x4 acc[2][2][4][2];
#pragma unroll
    for (int a0 = 0; a0 < 2; ++a0)
#pragma unroll
      for (int b0 = 0; b0 < 2; ++b0)
#pragma unroll
        for (int m = 0; m < 4; ++m)
#pragma unroll
          for (int n = 0; n < 2; ++n) acc[a0][b0][m][n] = f32x4{0.f, 0.f, 0.f, 0.f};
    bf16x8 At[4][2], B0[2][2], B1[2][2];
    G8_STAGE(G8_SB(0, 0), rsB, voB, ldb, bcol, 0);
    G8_STAGE(G8_SA(0, 0), rsA, voA, lda, brow, 0);
    G8_STAGE(G8_SB(0, 1), rsB, voB, ldb, bcol + 128, 0);
    G8_STAGE(G8_SA(0, 1), rsA, voA, lda, brow + 128, 0);
    if (wr == 1) G8_BAR;
    G8_WAIT_V(4);
    G8_BAR;
    G8_STAGE(G8_SB(1, 0), rsB, voB, ldb, bcol, 1);
    G8_STAGE(G8_SA(1, 0), rsA, voA, lda, brow, 1);
    G8_STAGE(G8_SB(1, 1), rsB, voB, ldb, bcol + 128, 1);
    G8_WAIT_V(6);
    G8_BAR;
    for (;;) {
      const int tnx = t + nblk;
      const bool has_next = tnx < ntiles;
      const int nbrow = has_next ? (tnx / Ntiles) * 256 : brow, nbcol = has_next ? (tnx % Ntiles) * 256 : bcol;
      for (int kt = 0; kt < nt; kt += 2) {
        const bool last = (kt == nt - 2);
        const int a2 = last ? nbrow : brow, b2 = last ? nbcol : bcol, k2 = last ? 0 : kt + 2;
        G8_LDB(B0, 0, 0); G8_SCHED; G8_LDA(At, 0, 0); G8_STAGE(G8_SA(1, 1), rsA, voA, lda, brow + 128, kt + 1);
        G8_WAIT_L(8); G8_BAR; G8_WAIT_L(0); G8_MMA(0, 0, At, B0); G8_BAR; G8_SCHED;
        G8_LDB(B1, 0, 1); G8_STAGE(G8_SB(0, 0), rsB, voB, ldb, b2, k2);
        G8_BAR; G8_WAIT_L(0); G8_MMA(0, 1, At, B1); G8_BAR;
        G8_LDA(At, 0, 1); G8_STAGE(G8_SA(0, 0), rsA, voA, lda, a2, k2);
        G8_BAR; G8_WAIT_L(0); G8_MMA(1, 0, At, B0); G8_BAR; G8_SCHED;
        G8_STAGE(G8_SB(0, 1), rsB, voB, ldb, b2 + 128, k2);
        G8_WAIT_V(6); G8_BAR; G8_MMA(1, 1, At, B1); G8_BAR;
        G8_LDB(B0, 1, 0); G8_SCHED; G8_LDA(At, 1, 0); G8_STAGE(G8_SA(0, 1), rsA, voA, lda, a2 + 128, k2);
        G8_WAIT_L(8); G8_BAR; G8_WAIT_L(0); G8_MMA(0, 0, At, B0); G8_BAR; G8_SCHED;
        G8_LDB(B1, 1, 1); G8_STAGE(G8_SB(1, 0), rsB, voB, ldb, b2, k2 + 1);
        G8_BAR; G8_WAIT_L(0); G8_MMA(0, 1, At, B1); G8_BAR;
        G8_LDA(At, 1, 1); G8_STAGE(G8_SA(1, 0), rsA, voA, lda, a2, k2 + 1);
        G8_BAR; G8_WAIT_L(0); G8_MMA(1, 0, At, B0); G8_BAR; G8_SCHED;
        G8_STAGE(G8_SB(1, 1), rsB, voB, ldb, b2 + 128, k2 + 1);
        G8_WAIT_V(6); G8_BAR; G8_MMA(1, 1, At, B1); G8_BAR;
      }
      {
        int lane2 = lane_id();
        asm volatile("" : "+v"(lane2));
        const int fr2 = lane2 & 15, fq2 = lane2 >> 4;
        if constexpr (TR) gemm8_epilogue_tr<EPI>(p, acc, brow, bcol, wr, wc, fr2, fq2, layer, gscale);
        else gemm8_epilogue<EPI, false>(p, acc, nullptr, lane2, brow, bcol, wr, wc, fr2, fq2, layer, gscale);
      }
      if (!has_next) break;
#pragma unroll
      for (int a0 = 0; a0 < 2; ++a0)
#pragma unroll
        for (int b0 = 0; b0 < 2; ++b0)
#pragma unroll
          for (int m = 0; m < 4; ++m)
#pragma unroll
            for (int n = 0; n < 2; ++n) acc[a0][b0][m][n] = f32x4{0.f, 0.f, 0.f, 0.f};
      t = tnx;
      brow = nbrow;
      bcol = nbcol;
    }
    G8_WAIT_V(0);
    if (wr == 0) G8_BAR;
  }
  __syncthreads();
  if (ntiles < ntiles_all) {
    constexpr int EPI_T = (EPI == EPI_RESID0) ? EPI_RESID : EPI;
    gemm_phase<EPI_T>(p, A, lda, Bt, ldb, 0, 0, K, layer, lds_all + (wid >> 2) * LDS_HALF, gscale, ntiles, ntiles_all - ntiles, Ntiles);
  }
#undef G8_SA
#undef G8_SB
#undef G8_STAGE
#undef G8_LDA
#undef G8_LDB
#undef G8_MMA
#undef G8_WAIT_V
#undef G8_WAIT_L
#undef G8_BAR
#undef G8_SCHED
}

DEVI bf16x8 scale_q(uint4 u) {
  uint4 r;
  r.x = pack2(bflo(u.x) * 0.125f, bfhi(u.x) * 0.125f);
  r.y = pack2(bflo(u.y) * 0.125f, bfhi(u.y) * 0.125f);
  r.z = pack2(bflo(u.z) * 0.125f, bfhi(u.z) * 0.125f);
  r.w = pack2(bflo(u.w) * 0.125f, bfhi(u.w) * 0.125f);
  return __builtin_bit_cast(bf16x8, r);
}
DEVI void phase_attn(PP p, int layer, bool with_ctx_q, unsigned char* lds) {
  const int tid = ltid();
  const int lane = tid & 63, wid = __builtin_amdgcn_readfirstlane(tid >> 6), r = lane & 31, h = lane >> 5;
  const float* sinkp = p->attn_sink + (layer >> 1) * 8;
  const int nlat = NB * 2 * 128;
  const int nunits = nlat + (with_ctx_q ? NB * 2 * 8 : 0);
  for (int u = lbid(); u < nunits; u += lnblk()) {
    bool latent = u < nlat;
    int b, kvh, qg, tokbase;
    if (latent) {
      b = u >> 8;
      kvh = (u >> 7) & 1;
      qg = u & 127;
      tokbase = b * SEQ + qg * 32;
    } else {
      int v = u - nlat;
      b = v >> 4;
      kvh = (v >> 3) & 1;
      qg = v & 7;
      tokbase = TL + b * CTX + qg * 32;
    }
    const int hd = kvh * 4 + wid;
    const bf16_t* kb = p->kbuf + (size_t)(b * 2 + kvh) * KVLEN * 64;
    const bf16_t* vt = p->vbuf + (size_t)(b * 2 + kvh) * 64 * KVLEN;
    const int nch = latent ? 5 : 2;
    const int lbase = CTX + (qg - 4) * 32;
#define ATT_STAGE(c_, buf_)                                                                                           \
  {                                                                                                                   \
    const int kp0_ = ((c_) < 2) ? (c_) * 128 : lbase + ((c_) - 2) * 128;                                              \
    _Pragma("unroll") for (int i_ = 0; i_ < 4; ++i_) {                                                                \
      const int P_ = tid * 16 + i_ * 4096;                                                                            \
      const int krow_ = P_ >> 7, kslot_ = (P_ >> 4) & 7;                                                              \
      int kp_ = kp0_ + krow_;                                                                                         \
      kp_ = kp_ < 0 ? 0 : (kp_ > KVLEN - 1 ? KVLEN - 1 : kp_);                                                        \
      __builtin_amdgcn_global_load_lds((const unsigned*)(kb + (size_t)kp_ * 64 + ((kslot_ ^ ((krow_ >> 1) & 7)) << 3)), \
                                       (__attribute__((address_space(3))) unsigned*)(lds + (buf_) * 32768 + P_), 16, 0, 0); \
      const int vrow_ = P_ >> 8, vslot_ = (P_ >> 4) & 15;                                                             \
      int vp_ = kp0_ + ((vslot_ ^ (vrow_ & 15)) << 3);                                                                \
      vp_ = vp_ < 0 ? 0 : (vp_ > KVLEN - 8 ? KVLEN - 8 : vp_);                                                        \
      __builtin_amdgcn_global_load_lds((const unsigned*)(vt + (size_t)vrow_ * KVLEN + vp_),                           \
                                       (__attribute__((address_space(3))) unsigned*)(lds + (buf_) * 32768 + 16384 + P_), 16, 0, 0); \
    }                                                                                                                 \
  }
    __syncthreads();
    ATT_STAGE(0, 0)
    bf16x8 qf[4];
    {
      const bf16_t* qp = p->P + (size_t)(tokbase + r) * 2048 + hd * 64 + 8 * h;
#pragma unroll
      for (int st = 0; st < 4; ++st) qf[st] = scale_q(*reinterpret_cast<const uint4*>(qp + 16 * st));
    }
    f32x16 O0, O1;
#pragma unroll
    for (int i = 0; i < 16; ++i) {
      O0[i] = 0.f;
      O1[i] = 0.f;
    }
    float m_run = sinkp[hd];
    float l_run = (h == 0) ? 1.f : 0.f;
    for (int c = 0; c < nch; ++c) {
      const int buf = c & 1;
      asm volatile("s_waitcnt vmcnt(0)" ::: "memory");
      __syncthreads();
      if (c + 1 < nch) ATT_STAGE(c + 1, buf ^ 1)
      const unsigned char* LK = lds + buf * 32768;
      const unsigned char* LV = LK + 16384;
#pragma unroll 1
      for (int kbi = 0; kbi < 4; ++kbi) {
        int mode = 0;
        if (c >= 2) {
          const int d = (c - 2) * 4 + kbi - 4;
          const int kblk = qg + d;
          if (d > 4 || kblk < 0 || kblk > 127) continue;
          mode = (d == -4) ? 1 : ((d == 4) ? 2 : 0);
        }
        f32x16 S;
#pragma unroll
        for (int i = 0; i < 16; ++i) S[i] = 0.f;
        {
          const int krow = kbi * 32 + r;
#pragma unroll
          for (int st = 0; st < 4; ++st) {
            bf16x8 kf = *reinterpret_cast<const bf16x8*>(LK + krow * 128 + (((2 * st + h) ^ ((krow >> 1) & 7)) << 4));
            S = __builtin_amdgcn_mfma_f32_32x32x16_bf16(kf, qf[st], S, 0, 0, 0);
          }
        }
        if (mode) {
          float negbig;
          asm volatile("v_mov_b32 %0, 0xf149f2ca" : "=v"(negbig));
#pragma unroll
          for (int i = 0; i < 16; ++i) {
            int kk = (i & 3) + 8 * (i >> 2) + 4 * h;
            bool ok = (mode == 1) ? (kk >= r) : (kk <= r);
            if (!ok) S[i] = negbig;
          }
        }
        float bm = S[0];
#pragma unroll
        for (int i = 1; i < 16; ++i) bm = fmaxf(bm, S[i]);
        bm = fmaxf(bm, shx_f(bm, 32));
        float m_new = fmaxf(m_run, bm);
        const float L2E = 1.4426950408889634f;
        float nm = -m_new * L2E;
        float psum = 0.f;
#pragma unroll
        for (int i = 0; i < 16; ++i) {
          S[i] = __builtin_amdgcn_exp2f(fmaf(S[i], L2E, nm));
          psum += S[i];
        }
        if (__any(m_new > m_run)) {
          float alpha = __builtin_amdgcn_exp2f((m_run - m_new) * L2E);
          l_run *= alpha;
#pragma unroll
          for (int i = 0; i < 16; ++i) {
            O0[i] *= alpha;
            O1[i] *= alpha;
          }
        }
        l_run += psum;
        m_run = m_new;
#pragma unroll
        for (int sidx = 0; sidx < 2; ++sidx) {
          uint4 pk;
          pk.x = pack2(S[8 * sidx + 0], S[8 * sidx + 1]);
          pk.y = pack2(S[8 * sidx + 2], S[8 * sidx + 3]);
          pk.z = pack2(S[8 * sidx + 4], S[8 * sidx + 5]);
          pk.w = pack2(S[8 * sidx + 6], S[8 * sidx + 7]);
          bf16x8 pf = __builtin_bit_cast(bf16x8, pk);
          const int vch = 4 * kbi + 2 * sidx + h;
          bf16x8 v0 = *reinterpret_cast<const bf16x8*>(LV + r * 256 + ((vch ^ (r & 15)) << 4));
          bf16x8 v1 = *reinterpret_cast<const bf16x8*>(LV + (32 + r) * 256 + ((vch ^ (r & 15)) << 4));
          O0 = __builtin_amdgcn_mfma_f32_32x32x16_bf16(v0, pf, O0, 0, 0, 0);
          O1 = __builtin_amdgcn_mfma_f32_32x32x16_bf16(v1, pf, O1, 0, 0, 0);
        }
      }
    }
#undef ATT_STAGE
    float l_tot = l_run + shx_f(l_run, 32);
    float inv = 1.f / l_tot;
    bf16_t* op = p->mix + (size_t)(tokbase + r) * LDMIX + hd * 64 + 4 * h;
#pragma unroll
    for (int g4 = 0; g4 < 4; ++g4) {
      uint2 o;
      o.x = pack2(O0[4 * g4 + 0] * inv, O0[4 * g4 + 1] * inv);
      o.y = pack2(O0[4 * g4 + 2] * inv, O0[4 * g4 + 3] * inv);
      *reinterpret_cast<uint2*>(op + 8 * g4) = o;
      o.x = pack2(O1[4 * g4 + 0] * inv, O1[4 * g4 + 1] * inv);
      o.y = pack2(O1[4 * g4 + 2] * inv, O1[4 * g4 + 3] * inv);
      *reinterpret_cast<uint2*>(op + 32 + 8 * g4) = o;
    }
  }
  __syncthreads();
}

DEVI void fill_tw(float2* tw, int n) {
  for (int i = ltid(); i < n; i += NTHREADS) {
    float sn, cn;
    sincospif(2.f * (float)i / (float)n, &sn, &cn);
    tw[i] = make_float2(cn, sn);
  }
  __syncthreads();
}

DEVI bf16x8 lds_col8(const bf16_t* bp, int stride) {
  unsigned e0 = bp[0], e1 = bp[stride], e2 = bp[2 * stride], e3 = bp[3 * stride];
  unsigned e4 = bp[4 * stride], e5 = bp[5 * stride], e6 = bp[6 * stride], e7 = bp[7 * stride];
  uint4 pk;
  pk.x = e0 | (e1 << 16);
  pk.y = e2 | (e3 << 16);
  pk.z = e4 | (e5 << 16);
  pk.w = e6 | (e7 << 16);
  return __builtin_bit_cast(bf16x8, pk);
}

DEVI void phase_fft_a(PP p, unsigned char* lds) {
  const int tid = ltid();
  const int lane = tid & 63, wid = __builtin_amdgcn_readfirstlane(tid >> 6), fr = lane & 15, fq = lane >> 4;
  float2* tw = reinterpret_cast<float2*>(lds + 66560);
  fill_tw(tw, 64);
  bf16x8 af[2][2];
#pragma unroll
  for (int ks = 0; ks < 2; ++ks) {
    unsigned short cr[8], ci[8];
#pragma unroll
    for (int j = 0; j < 8; ++j) {
      int n1 = 32 * ks + 8 * fq + j, k1 = 16 * wid + fr;
      float2 t = tw[(k1 * n1) & 63];
      cr[j] = f2bf(t.x);
      ci[j] = f2bf(-t.y);
    }
    uint4 a0, a1;
    a0.x = cr[0] | ((unsigned)cr[1] << 16); a0.y = cr[2] | ((unsigned)cr[3] << 16);
    a0.z = cr[4] | ((unsigned)cr[5] << 16); a0.w = cr[6] | ((unsigned)cr[7] << 16);
    a1.x = ci[0] | ((unsigned)ci[1] << 16); a1.y = ci[2] | ((unsigned)ci[3] << 16);
    a1.z = ci[4] | ((unsigned)ci[5] << 16); a1.w = ci[6] | ((unsigned)ci[7] << 16);
    af[0][ks] = __builtin_bit_cast(bf16x8, a0);
    af[1][ks] = __builtin_bit_cast(bf16x8, a1);
  }
  const bf16_t* l16 = reinterpret_cast<const bf16_t*>(lds);
  for (int u = lbid(); u < NB * 64; u += lnblk()) {
    int b = u >> 6, n2 = u & 63;
    __syncthreads();
#pragma unroll
    for (int i = 0; i < 16; ++i) {
      int row = (tid >> 6) + 4 * i, piece = tid & 63;
      uint4 v = *reinterpret_cast<const uint4*>(p->P + (size_t)(b * SEQ + 64 * row + n2) * 2048 + 768 + piece * 8);
      *reinterpret_cast<uint4*>(lds + row * 1040 + piece * 16) = v;
    }
    __syncthreads();
    float tc[4], ts[4];
#pragma unroll
    for (int j = 0; j < 4; ++j) sincospif((float)(n2 * (16 * wid + 4 * fq + j)) / 2048.f, &ts[j], &tc[j]);
    for (int nb = 0; nb < 4; ++nb) {
      f32x4 acc[2][8];
#pragma unroll
      for (int n = 0; n < 8; ++n) {
        acc[0][n] = f32x4{0.f, 0.f, 0.f, 0.f};
        acc[1][n] = f32x4{0.f, 0.f, 0.f, 0.f};
      }
#pragma unroll
      for (int ks = 0; ks < 2; ++ks)
#pragma unroll
        for (int nf = 0; nf < 8; ++nf) {
          bf16x8 bfr = lds_col8(l16 + (32 * ks + 8 * fq) * 520 + 128 * nb + 16 * nf + fr, 520);
          acc[0][nf] = __builtin_amdgcn_mfma_f32_16x16x32_bf16(af[0][ks], bfr, acc[0][nf], 0, 0, 0);
          acc[1][nf] = __builtin_amdgcn_mfma_f32_16x16x32_bf16(af[1][ks], bfr, acc[1][nf], 0, 0, 0);
        }
#pragma unroll
      for (int j = 0; j < 4; ++j) {
        int k1 = 16 * wid + 4 * fq + j;
        bf16_t* o = p->fa + (size_t)(b * SEQ + k1 * 64 + n2) * 1024 + 128 * nb + fr;
#pragma unroll
        for (int nf = 0; nf < 8; ++nf) {
          float re = acc[0][nf][j], im = acc[1][nf][j];
          o[16 * nf] = f2bf(re * tc[j] + im * ts[j]);
          o[512 + 16 * nf] = f2bf(im * tc[j] - re * ts[j]);
        }
      }
    }
  }
  __syncthreads();
}

DEVI void phase_fft_b(PP p, unsigned char* lds) {
  const int tid = ltid();
  const int lane = tid & 63, wid = __builtin_amdgcn_readfirstlane(tid >> 6), fr = lane & 15, fq = lane >> 4;
  float2* tw = reinterpret_cast<float2*>(lds + 67584);
  fill_tw(tw, 64);
  bf16x8 wb[2][4];
#pragma unroll
  for (int ks = 0; ks < 4; ++ks) {
    unsigned short zr[8], zi[8];
#pragma unroll
    for (int j = 0; j < 8; ++j) {
      int k = 32 * ks + 8 * fq + j, part = k >> 6, n2 = k & 63, k2 = 16 * wid + fr;
      float2 t = tw[(k2 * n2) & 63];
      zr[j] = f2bf(part ? t.y : t.x);
      zi[j] = f2bf(part ? t.x : -t.y);
    }
    uint4 a0, a1;
    a0.x = zr[0] | ((unsigned)zr[1] << 16); a0.y = zr[2] | ((unsigned)zr[3] << 16);
    a0.z = zr[4] | ((unsigned)zr[5] << 16); a0.w = zr[6] | ((unsigned)zr[7] << 16);
    a1.x = zi[0] | ((unsigned)zi[1] << 16); a1.y = zi[2] | ((unsigned)zi[3] << 16);
    a1.z = zi[4] | ((unsigned)zi[5] << 16); a1.w = zi[6] | ((unsigned)zi[7] << 16);
    wb[0][ks] = __builtin_bit_cast(bf16x8, a0);
    wb[1][ks] = __builtin_bit_cast(bf16x8, a1);
  }
  const bf16_t* l16 = reinterpret_cast<const bf16_t*>(lds);
  const float scale = 0.0013810679320049757f;
  for (int u = lbid(); u < NB * 128; u += lnblk()) {
    int b = u >> 7, k1 = (u >> 1) & 63, hf = u & 1;
    __syncthreads();
#pragma unroll
    for (int i = 0; i < 16; ++i) {
      int row = (tid >> 5) + 8 * i, piece = tid & 31;
      int part = row >> 6, n2 = row & 63;
      uint4 v = *reinterpret_cast<const uint4*>(p->fa + (size_t)(b * SEQ + k1 * 64 + n2) * 1024 + part * 512 + hf * 256 + piece * 8);
      *reinterpret_cast<uint4*>(lds + row * 528 + piece * 16) = v;
    }
    __syncthreads();
    for (int nb = 0; nb < 2; ++nb) {
      f32x4 acc[2][8];
#pragma unroll
      for (int n = 0; n < 8; ++n) {
        acc[0][n] = f32x4{0.f, 0.f, 0.f, 0.f};
        acc[1][n] = f32x4{0.f, 0.f, 0.f, 0.f};
      }
#pragma unroll
      for (int ks = 0; ks < 4; ++ks)
#pragma unroll
        for (int nf = 0; nf < 8; ++nf) {
          bf16x8 bfr = lds_col8(l16 + (32 * ks + 8 * fq) * 264 + 128 * nb + 16 * nf + fr, 264);
          acc[0][nf] = __builtin_amdgcn_mfma_f32_16x16x32_bf16(wb[0][ks], bfr, acc[0][nf], 0, 0, 0);
          acc[1][nf] = __builtin_amdgcn_mfma_f32_16x16x32_bf16(wb[1][ks], bfr, acc[1][nf], 0, 0, 0);
        }
#pragma unroll
      for (int j = 0; j < 4; ++j) {
        int k2 = 16 * wid + 4 * fq + j;
        bf16_t* o = p->mix + (size_t)(b * SEQ + k1 + 64 * k2) * LDMIX + 512 + hf * 256 + 128 * nb + fr;
#pragma unroll
        for (int nf = 0; nf < 8; ++nf) {
          o[16 * nf] = f2bf(acc[0][nf][j] * scale);
          o[512 + 16 * nf] = f2bf(acc[1][nf][j] * scale);
        }
      }
    }
  }
  __syncthreads();
}

DEVI void phase_dft_ctx(PP p, unsigned char* lds) {
  float2* tw = reinterpret_cast<float2*>(lds);
  fill_tw(tw, 256);
  int tid = ltid();
  const float scale = 0.005524271728019903f;
  for (int u = lbid(); u < NB * 64; u += lnblk()) {
    int b = u >> 6, k0 = (u & 63) * 4;
    for (int pass = 0; pass < 2; ++pass) {
      int ch = tid + pass * 256;
      float zr[4], zi[4];
#pragma unroll
      for (int kk = 0; kk < 4; ++kk) zr[kk] = zi[kk] = 0.f;
#pragma unroll 8
      for (int n = 0; n < 256; ++n) {
        float v = bf2f(p->P[(size_t)(TL + b * CTX + n) * 2048 + 768 + ch]);
#pragma unroll
        for (int kk = 0; kk < 4; ++kk) {
          float2 t = tw[(n * (k0 + kk)) & 255];
          zr[kk] += v * t.x;
          zi[kk] -= v * t.y;
        }
      }
#pragma unroll
      for (int kk = 0; kk < 4; ++kk) {
        bf16_t* o = p->mix + (size_t)(TL + b * CTX + k0 + kk) * LDMIX;
        o[512 + ch] = f2bf(zr[kk] * scale);
        o[1024 + ch] = f2bf(zi[kk] * scale);
      }
    }
  }
  __syncthreads();
}

DEVI void phase_sgu(PP p, int j, int nchunks, unsigned char* lds) {
  float* rs = reinterpret_cast<float*>(lds);
  unsigned char* LA = lds + 1024;
  unsigned char* LB = lds + 1024 + 32768;
  const int tid = ltid();
  const int lane = tid & 63, wid = __builtin_amdgcn_readfirstlane(tid >> 6), fr = lane & 15, fq = lane >> 4;
  const float* nw = p->gs_norm_w + j * 1024;
  for (int u = lbid(); u < nchunks * 8; u += lnblk()) {
    const int chunk = u >> 3, g = u & 7;
    const int tok0 = chunk * 128;
    const bf16_t* vT = p->zvT + ((size_t)chunk * 1024 + g * 128) * 128;
    __syncthreads();
    if (tid < 128) {
      const float* rp = p->rowss + (size_t)chunk * 32 * 128 + tid;
      float ss = 0.f;
#pragma unroll
      for (int sl = 0; sl < 32; ++sl) ss += rp[sl * 128];
      rs[tid] = rsqrtf(ss * (1.f / 1024.f) + 1e-6f);
    }
#pragma unroll
    for (int i = 0; i < 8; ++i) {
      int idx = tid + 256 * i, row = idx >> 4, c = idx & 15;
      uint4 v = *reinterpret_cast<const uint4*>(vT + (size_t)row * 128 + c * 8);
      *reinterpret_cast<uint4*>(LB + row * 256 + ((c ^ (row & 15)) << 4)) = v;
    }
    __syncthreads();
    {
      const float* wsg = p->gs_w_s + ((size_t)j * 8 + g) * 128 * 128;
#pragma unroll
      for (int i = 0; i < 8; ++i) {
        int idx = tid + 256 * i, row = idx >> 4, c = idx & 15;
        const float4* wp = reinterpret_cast<const float4*>(wsg + (size_t)row * 128 + c * 8);
        float4 w0 = wp[0], w1 = wp[1];
        const float* rk = rs + c * 8;
        uint4 pk;
        pk.x = pack2(w0.x * rk[0], w0.y * rk[1]);
        pk.y = pack2(w0.z * rk[2], w0.w * rk[3]);
        pk.z = pack2(w1.x * rk[4], w1.y * rk[5]);
        pk.w = pack2(w1.z * rk[6], w1.w * rk[7]);
        *reinterpret_cast<uint4*>(LA + row * 256 + ((c ^ (row & 15)) << 4)) = pk;
      }
    }
    __syncthreads();
    f32x4 acc[2][8];
#pragma unroll
    for (int m = 0; m < 2; ++m)
#pragma unroll
      for (int n = 0; n < 8; ++n) acc[m][n] = f32x4{0.f, 0.f, 0.f, 0.f};
#pragma unroll
    for (int ks = 0; ks < 4; ++ks) {
      const int sl = ((4 * ks + fq) ^ fr) << 4;
      bf16x8 a0 = *reinterpret_cast<const bf16x8*>(LA + (32 * wid + fr) * 256 + sl);
      bf16x8 a1 = *reinterpret_cast<const bf16x8*>(LA + (32 * wid + 16 + fr) * 256 + sl);
#pragma unroll
      for (int n = 0; n < 8; ++n) {
        bf16x8 bfr = *reinterpret_cast<const bf16x8*>(LB + (16 * n + fr) * 256 + sl);
        acc[0][n] = __builtin_amdgcn_mfma_f32_16x16x32_bf16(a0, bfr, acc[0][n], 0, 0, 0);
        acc[1][n] = __builtin_amdgcn_mfma_f32_16x16x32_bf16(a1, bfr, acc[1][n], 0, 0, 0);
      }
    }
    __syncthreads();
    {
      const float* bsg = p->gs_b_s + ((size_t)j * 8 + g) * 128;
#pragma unroll
      for (int m = 0; m < 2; ++m)
#pragma unroll
        for (int jj = 0; jj < 4; ++jj) {
          const int pp = 32 * wid + 16 * m + 4 * fq + jj;
          const float bias = bsg[pp];
#pragma unroll
          for (int n = 0; n < 8; ++n) {
            const int c = 16 * n + fr;
            float sv = nw[g * 128 + c] * acc[m][n][jj] + bias;
            *reinterpret_cast<bf16_t*>(LA + pp * 256 + (((c >> 3) ^ (pp & 15)) << 4) + (c & 7) * 2) = f2bf(sv);
          }
        }
    }
    __syncthreads();
#pragma unroll
    for (int i = 0; i < 8; ++i) {
      int idx = tid + 256 * i, row = idx >> 4, c = idx & 15;
      uint4 sv8 = *reinterpret_cast<const uint4*>(LA + row * 256 + ((c ^ (row & 15)) << 4));
      uint4 u8 = *reinterpret_cast<const uint4*>(p->P + (size_t)(tok0 + row) * 2048 + g * 128 + c * 8);
      uint4 o;
      o.x = pack2(bflo(u8.x) * bflo(sv8.x), bfhi(u8.x) * bfhi(sv8.x));
      o.y = pack2(bflo(u8.y) * bflo(sv8.y), bfhi(u8.y) * bfhi(sv8.y));
      o.z = pack2(bflo(u8.z) * bflo(sv8.z), bfhi(u8.z) * bfhi(sv8.z));
      o.w = pack2(bflo(u8.w) * bflo(sv8.w), bfhi(u8.w) * bfhi(sv8.w));
      *reinterpret_cast<uint4*>(p->mix + (size_t)(tok0 + row) * LDMIX + g * 128 + c * 8) = o;
    }
  }
  __syncthreads();
}

DEVI float mkkey(float v, unsigned idx, unsigned mask) { return __uint_as_float((__float_as_uint(v) & ~mask) | idx); }
#define INSERT16(list, x)                                                                                               \
  {                                                                                                                     \
    _Pragma("unroll") for (int i_ = 15; i_ >= 1; --i_) list[i_] = __builtin_amdgcn_fmed3f(list[i_ - 1], list[i_], x); \
    list[0] = fmaxf(list[0], x);                                                                                        \
  }

DEVI float vmaxf(float a, float b) { float r; asm("v_max_f32 %0, %1, %2" : "=v"(r) : "v"(a), "v"(b)); return r; }
DEVI float vminf(float a, float b) { float r; asm("v_min_f32 %0, %1, %2" : "=v"(r) : "v"(a), "v"(b)); return r; }
DEVI void bitonic_merge16(float (&v)[16]) {
#pragma unroll
  for (int j = 8; j >= 1; j >>= 1)
#pragma unroll
    for (int i = 0; i < 16; ++i) {
      const int l = i ^ j;
      if (l > i) {
        const float hi = vmaxf(v[i], v[l]), lo = vminf(v[i], v[l]);
        v[i] = hi;
        v[l] = lo;
      }
    }
}
DEVI void bitonic_sort16(float (&v)[16]) {
#pragma unroll
  for (int k = 2; k <= 16; k <<= 1)
#pragma unroll
    for (int j = k >> 1; j >= 1; j >>= 1)
#pragma unroll
      for (int i = 0; i < 16; ++i) {
        const int l = i ^ j;
        if (l > i) {
          const float hi = vmaxf(v[i], v[l]), lo = vminf(v[i], v[l]);
          const bool desc = (i & k) == 0;
          v[i] = desc ? hi : lo;
          v[l] = desc ? lo : hi;
        }
      }
}

DEVI void phase_route(PP p, int layer, int ntok, unsigned char* lds) {
  const int tid = ltid();
  const int lane = tid & 63, wid = __builtin_amdgcn_readfirstlane(tid >> 6), fr = lane & 15, fq = lane >> 4;
  const int nb8 = lnblk() >> 3, bid = lbid();
  const int hh = bid & 7, slot = bid >> 3;
  const int ntiles = ntok / 64;
  const bool active = slot < nb8;
  float* sc = reinterpret_cast<float*>(lds + 32768);
  const float NEGK = -3.0e38f;
  for (int half = 0; half < 2; ++half) {
    __syncthreads();
    {
      const bf16_t* ksrc = p->keysb + ((size_t)((layer * 8 + hh) * 2 + half) * 128) * 128;
#pragma unroll
      for (int i = 0; i < 8; ++i) {
        int idx = tid + 256 * i, row = idx >> 4, c = idx & 15;
        uint4 v = *reinterpret_cast<const uint4*>(ksrc + (size_t)row * 128 + c * 8);
        *reinterpret_cast<uint4*>(lds + row * 256 + ((c ^ (row & 15)) << 4)) = v;
      }
    }
    __syncthreads();
    bf16x8 an[4];
    if (active && slot < ntiles) {
      const bf16_t* qa = p->P + (size_t)(slot * 64 + wid * 16 + fr) * 2048 + hh * 256 + half * 128 + fq * 8;
#pragma unroll
      for (int ks = 0; ks < 4; ++ks) an[ks] = *reinterpret_cast<const bf16x8*>(qa + ks * 32);
    }
    for (int tt = slot; active && tt < ntiles; tt += nb8) {
      const int tok0 = tt * 64;
      float list[16], lb[16];
      {
        bf16x8 a[4];
#pragma unroll
        for (int ks = 0; ks < 4; ++ks) a[ks] = an[ks];
        {
          const int ttn = (tt + nb8 < ntiles) ? tt + nb8 : tt;
          const bf16_t* qa = p->P + (size_t)(ttn * 64 + wid * 16 + fr) * 2048 + hh * 256 + half * 128 + fq * 8;
#pragma unroll
          for (int ks = 0; ks < 4; ++ks) an[ks] = *reinterpret_cast<const bf16x8*>(qa + ks * 32);
        }
#pragma unroll
        for (int nf = 0; nf < 8; ++nf) {
          f32x4 acc = f32x4{0.f, 0.f, 0.f, 0.f};
          const int krow = nf * 16 + fr;
#pragma unroll
          for (int ks = 0; ks < 4; ++ks) {
            bf16x8 bb = *reinterpret_cast<const bf16x8*>(lds + krow * 256 + (((4 * ks + fq) ^ (krow & 15)) << 4));
            acc = __builtin_amdgcn_mfma_f32_16x16x32_bf16(bb, a[ks], acc, 0, 0, 0);
          }
#pragma unroll
          for (int j = 0; j < 4; ++j) {
            const float kv = mkkey(acc[j], (unsigned)(nf * 16 + 4 * fq + j), 127u);
            if (nf < 4) list[nf * 4 + j] = kv;
            else lb[(nf - 4) * 4 + j] = kv;
          }
        }
      }
      const int prt = lane >> 4;
      bitonic_sort16(list);
      bitonic_sort16(lb);
#pragma unroll
      for (int i = 0; i < 16; ++i) list[i] = vmaxf(list[i], lb[15 - i]);
      bitonic_merge16(list);
#pragma unroll 1
      for (int step = 16; step <= 32; step <<= 1) {
        float other[16];
#pragma unroll
        for (int i = 0; i < 16; ++i) other[i] = shx_f(list[i], step);
#pragma unroll
        for (int i = 0; i < 16; ++i) list[i] = vmaxf(list[i], other[15 - i]);
        bitonic_merge16(list);
      }
      if (prt == 0) {
        float4* o = reinterpret_cast<float4*>(p->tops + ((size_t)(tok0 + wid * 16 + fr) * 16 + hh * 2 + half) * 16);
        o[0] = make_float4(list[0], list[1], list[2], list[3]);
        o[1] = make_float4(list[4], list[5], list[6], list[7]);
        o[2] = make_float4(list[8], list[9], list[10], list[11]);
        o[3] = make_float4(list[12], list[13], list[14], list[15]);
      }
    }
  }
  __syncthreads();
  float* fl = reinterpret_cast<float*>(lds);
  for (int t4 = slot; active && t4 < ntiles + 3 * nb8; t4 += 4 * nb8) {
    const int tt = t4 + (tid >> 6) * nb8;
    if (tt < ntiles) {
      const int tok = tt * 64 + (tid & 63);
      const float4* src = reinterpret_cast<const float4*>(p->tops + ((size_t)tok * 16 + hh * 2) * 16);
      float v0[16], v1[16];
#pragma unroll
      for (int i = 0; i < 4; ++i) {
        float4 a = src[i], bq = src[4 + i];
        v0[4 * i] = a.x; v0[4 * i + 1] = a.y; v0[4 * i + 2] = a.z; v0[4 * i + 3] = a.w;
        v1[4 * i] = bq.x; v1[4 * i + 1] = bq.y; v1[4 * i + 2] = bq.z; v1[4 * i + 3] = bq.w;
      }
      float* f0 = fl + tid * 33;
      float* f1 = f0 + 16;
#pragma unroll
      for (int i = 0; i < 16; ++i) {
        f0[i] = v0[i];
        f1[i] = v1[i];
      }
      float l2[16];
#pragma unroll
      for (int i = 0; i < 16; ++i) l2[i] = mkkey(v0[0] + v1[i], (unsigned)(15 - i), 255u);
#pragma unroll
      for (int a = 1; a < 16; ++a)
#pragma unroll
        for (int bq = 0; bq < 16; ++bq)
          if ((a + 1) * (bq + 1) <= 16) {
            float x = mkkey(v0[a] + v1[bq], (unsigned)(a * 16 + 15 - bq), 255u);
            INSERT16(l2, x)
          }
      float sv[16];
      int ev[16];
      float mx = NEGK;
#pragma unroll
      for (int k = 0; k < 16; ++k) {
        unsigned ab = __float_as_uint(l2[k]) & 255u;
        unsigned k0 = __float_as_uint(f0[ab >> 4]), k1 = __float_as_uint(f1[15u - (ab & 15u)]);
        sv[k] = __uint_as_float(k0 & ~127u) + __uint_as_float(k1 & ~127u);
        ev[k] = (int)((k0 & 127u) * 128u + (k1 & 127u));
        mx = fmaxf(mx, sv[k]);
      }
      float sum = 0.f;
#pragma unroll
      for (int k = 0; k < 16; ++k) {
        sv[k] = __expf(sv[k] - mx);
        sum += sv[k];
      }
      float inv = 1.f / sum;
      size_t o = (size_t)tok * 128 + hh * 16;
      int4* eo = reinterpret_cast<int4*>(p->eidx + o);
      float4* go = reinterpret_cast<float4*>(p->gate + o);
#pragma unroll
      for (int k4 = 0; k4 < 4; ++k4) {
        eo[k4] = make_int4(ev[4 * k4], ev[4 * k4 + 1], ev[4 * k4 + 2], ev[4 * k4 + 3]);
        go[k4] = make_float4(sv[4 * k4] * inv, sv[4 * k4 + 1] * inv, sv[4 * k4 + 2] * inv, sv[4 * k4 + 3] * inv);
      }
    }
  }
  __syncthreads();
}

typedef float v2f __attribute__((ext_vector_type(2)));
DEVI void dec16(uint4 q, v2f* f) {
  f[0] = __builtin_amdgcn_cvt_pk_f32_fp8((int)q.x, false);
  f[1] = __builtin_amdgcn_cvt_pk_f32_fp8((int)q.x, true);
  f[2] = __builtin_amdgcn_cvt_pk_f32_fp8((int)q.y, false);
  f[3] = __builtin_amdgcn_cvt_pk_f32_fp8((int)q.y, true);
  f[4] = __builtin_amdgcn_cvt_pk_f32_fp8((int)q.z, false);
  f[5] = __builtin_amdgcn_cvt_pk_f32_fp8((int)q.z, true);
  f[6] = __builtin_amdgcn_cvt_pk_f32_fp8((int)q.w, false);
  f[7] = __builtin_amdgcn_cvt_pk_f32_fp8((int)q.w, true);
}
struct ExpBuf {
  uint4 q[8];
  uint4 h0, h1;
};
DEVI void exp_load(ExpBuf& B, const unsigned char* tab, const signed char* hrow, const unsigned short* idp, int j8, bool want_x) {
  const uint4 idv = *reinterpret_cast<const uint4*>(idp);
  const unsigned idw[4] = {idv.x, idv.y, idv.z, idv.w};
#pragma unroll
  for (int i = 0; i < 8; ++i) {
    unsigned e = (i & 1) ? (idw[i >> 1] >> 16) : (idw[i >> 1] & 0xffffu);
    unsigned off = e * (unsigned)D + 16u * j8;
    B.q[i] = *reinterpret_cast<const uint4*>(tab + off);
  }
  if (want_x) B.h0 = *reinterpret_cast<const uint4*>(hrow + 16 * j8);
}
template <int CTRL>
DEVI int dpp_movi(int v) { return __builtin_amdgcn_mov_dpp(v, CTRL, 0xF, 0xF, true); }
DEVI void exp_u_compute(const ExpBuf& B, int* pp, int j8) {
  int s0 = 0;
#pragma unroll
  for (int i = 0; i < 8; ++i) {
    int d = __builtin_amdgcn_sdot4((int)B.q[i].x, (int)B.h0.x, 0, false);
    d = __builtin_amdgcn_sdot4((int)B.q[i].y, (int)B.h0.y, d, false);
    d = __builtin_amdgcn_sdot4((int)B.q[i].z, (int)B.h0.z, d, false);
    d = __builtin_amdgcn_sdot4((int)B.q[i].w, (int)B.h0.w, d, false);
    d += dpp_movi<0xB1>(d);
    d += dpp_movi<0x4E>(d);
    d += dpp_movi<0x141>(d);
    s0 = (j8 == i) ? d : s0;
  }
  pp[0] += s0;
}
DEVI void exp_v_accum(const ExpBuf& B, unsigned w0, unsigned w1, int* acc) {
#pragma unroll
  for (int ig = 0; ig < 2; ++ig) {
    const unsigned wq = ig ? w1 : w0;
    const uint4 R0 = B.q[4 * ig], R1 = B.q[4 * ig + 1], R2 = B.q[4 * ig + 2], R3 = B.q[4 * ig + 3];
    const unsigned r0[4] = {R0.x, R0.y, R0.z, R0.w}, r1[4] = {R1.x, R1.y, R1.z, R1.w};
    const unsigned r2[4] = {R2.x, R2.y, R2.z, R2.w}, r3[4] = {R3.x, R3.y, R3.z, R3.w};
#pragma unroll
    for (int q = 0; q < 4; ++q) {
      unsigned A = __builtin_amdgcn_perm(r1[q], r0[q], 0x05010400u);
      unsigned Bq = __builtin_amdgcn_perm(r1[q], r0[q], 0x07030602u);
      unsigned C = __builtin_amdgcn_perm(r3[q], r2[q], 0x05010400u);
      unsigned E = __builtin_amdgcn_perm(r3[q], r2[q], 0x07030602u);
      unsigned D0 = __builtin_amdgcn_perm(C, A, 0x05040100u);
      unsigned D1 = __builtin_amdgcn_perm(C, A, 0x07060302u);
      unsigned D2 = __builtin_amdgcn_perm(E, Bq, 0x05040100u);
      unsigned D3 = __builtin_amdgcn_perm(E, Bq, 0x07060302u);
      acc[4 * q + 0] = __builtin_amdgcn_sdot4((int)D0, (int)wq, acc[4 * q + 0], false);
      acc[4 * q + 1] = __builtin_amdgcn_sdot4((int)D1, (int)wq, acc[4 * q + 1], false);
      acc[4 * q + 2] = __builtin_amdgcn_sdot4((int)D2, (int)wq, acc[4 * q + 2], false);
      acc[4 * q + 3] = __builtin_amdgcn_sdot4((int)D3, (int)wq, acc[4 * q + 3], false);
    }
  }
}
DEVI void exp_v_finish(float4* xo, const float4* xq, const float4* gq, int* acc, float swt, int grp, float gscale) {
  float o[16];
#pragma unroll
  for (int k = 0; k < 16; ++k) {
    int a = acc[k];
    a += dpp_movi<0x128>(a);
    a += shx_i(a, 16);
    a += shx_i(a, 32);
    o[k] = (float)a;
    acc[k] = 0;
  }
  if (grp == 0) {
    const float sc = gscale * swt;
#pragma unroll
    for (int i4 = 0; i4 < 4; ++i4) {
      float4 r = xq[i4];
      r.x += sc * gq[i4].x * o[i4 * 4 + 0];
      r.y += sc * gq[i4].y * o[i4 * 4 + 1];
      r.z += sc * gq[i4].z * o[i4 * 4 + 2];
      r.w += sc * gq[i4].w * o[i4 * 4 + 3];
      xo[i4] = r;
    }
  }
}
DEVI void phase_expert(PP p, int layer, int ntok, unsigned char* lds, float gscale = 1.f, int idmask = 0xffff) {
  const int tid = ltid();
  const int lane = tid & 63, wid = __builtin_amdgcn_readfirstlane(tid >> 6), j8 = lane & 7, grp = lane >> 3;
  const int nb = lnblk(), bid = lbid();
  unsigned short* ids = reinterpret_cast<unsigned short*>(lds);
  float* part = reinterpret_cast<float*>(lds + TPB * 128 * 2);
  unsigned char* w8 = lds + TPB * 128 * 2 + TPB * 128 * 4;
  float* swl = reinterpret_cast<float*>(lds + TPB * 128 * 2 + TPB * 128 * 4 + TPB * 128);
  const unsigned char* ut = p->utab + (size_t)layer * NEXP * D;
  const unsigned char* vt = p->vtab + (size_t)layer * NEXP * D;
  int tpb = (ntok + nb - 1) / nb;
  if (tpb > TPB) tpb = TPB;
  const int npass = (ntok + nb * tpb - 1) / (nb * tpb);
  for (int pass = 0; pass < npass; ++pass) {
    const int tok0 = (pass * nb + bid) * tpb;
    int cnt = ntok - tok0;
    if (cnt > tpb) cnt = tpb;
    if (cnt < 0) cnt = 0;
    for (int i = tid; i < cnt * 128; i += NTHREADS) {
      {
        int k = i & 127, hf = k >> 6, kk = k & 63;
        ids[(i & ~127) + hf * 64 + (kk & 7) * 8 + (kk >> 3)] = (unsigned short)(p->eidx[(size_t)tok0 * 128 + i] & idmask);
      }
      part[i] = 0.f;
    }
    __syncthreads();
    const int ntw = (cnt - wid + 3) >> 2;
    const int npair = ntw * 8;

    if (!(REP_MODE == 1 && gscale != 1.f)) {
      ExpBuf B0, B1;
      int c0 = 0, k0 = 0;
      if (npair > 0) {
        const int t0 = wid;
        exp_load(B0, ut, p->h8 + (size_t)(tok0 + t0) * D, ids + t0 * 128 + grp * 8, j8, true);
      }
      for (int pr = 0; pr < npair; ++pr) {
        const int t0 = wid + 4 * k0;
        exp_load(B1, ut + 128 * c0, p->h8 + (size_t)(tok0 + t0) * D + 128 * c0, ids + t0 * 128 + 64 + grp * 8, j8, true);
        exp_u_compute(B0, reinterpret_cast<int*>(part) + t0 * 128 + 8 * j8 + grp, j8);
        int c1 = c0, k1 = k0;
        if (pr + 1 < npair) {
          k1 = k0 + 1;
          if (k1 == ntw) {
            k1 = 0;
            c1 = c0 + 1;
          }
        }
        {
          const int t1 = wid + 4 * k1;
          exp_load(B0, ut + 128 * c1, p->h8 + (size_t)(tok0 + t1) * D + 128 * c1, ids + t1 * 128 + grp * 8, j8, true);
        }
        exp_u_compute(B1, reinterpret_cast<int*>(part) + t0 * 128 + 64 + 8 * j8 + grp, j8);
        c0 = c1;
        k0 = k1;
      }
    }
    __syncthreads();
    for (int t = wid; t < cnt; t += 4) {
      float wv2[2];
      float am = 0.f;
#pragma unroll
      for (int hh = 0; hh < 2; ++hh) {
        int k = lane + 64 * hh;
        int e = ids[t * 128 + hh * 64 + (lane & 7) * 8 + (lane >> 3)];
        float dq = (float)reinterpret_cast<int*>(part)[t * 128 + k] * p->su[(size_t)layer * NEXP + e] * p->sx[tok0 + t];
        float wv = p->gate[(size_t)(tok0 + t) * 128 + k] * gelu_tanh(dq) * p->sv[(size_t)layer * NEXP + e];
        wv2[hh] = wv;
        am = fmaxf(am, fabsf(wv));
      }
      am = fmaxf(wave_max(am), 1e-30f);
      float qs = 127.f / am;
#pragma unroll
      for (int hh = 0; hh < 2; ++hh) {
        int k = lane + 64 * hh;
        int q = (int)rintf(wv2[hh] * qs);
        w8[t * 128 + (k & 7) * 16 + hh * 8 + ((k >> 3) & 7)] = (unsigned char)(q & 255);
      }
      if (lane == 0) swl[t] = am * (1.f / 127.f);
    }
    __syncthreads();
    if (!(REP_MODE == 2 && gscale != 1.f)) {
      ExpBuf B0, B1;
      int acc[16];
#pragma unroll
      for (int k = 0; k < 16; ++k) acc[k] = 0;
      int c0 = 0, k0 = 0;
      if (npair > 0) {
        const int t0 = wid;
        exp_load(B0, vt, (const signed char*)nullptr, ids + t0 * 128 + grp * 8, j8, false);
      }
      for (int pr = 0; pr < npair; ++pr) {
        const int t0 = wid + 4 * k0;
        float4 xq[4], gq[4];
        float4* xo = reinterpret_cast<float4*>(p->xs + (size_t)(tok0 + t0) * D + 128 * c0 + 16 * j8);
        {
          const float4* gf = reinterpret_cast<const float4*>(p->mod + ((size_t)layer * 9 + tok_batch(tok0 + t0)) * 6144 + 5 * 1024 + 128 * c0 + 16 * j8);
#pragma unroll
          for (int i4 = 0; i4 < 4; ++i4) {
            xq[i4] = xo[i4];
            gq[i4] = gf[i4];
          }
        }
        exp_load(B1, vt + 128 * c0, (const signed char*)nullptr, ids + t0 * 128 + 64 + grp * 8, j8, false);
        const uint4 wq = *reinterpret_cast<const uint4*>(w8 + t0 * 128 + grp * 16);
        exp_v_accum(B0, wq.x, wq.y, acc);
        int c1 = c0, k1 = k0;
        if (pr + 1 < npair) {
          k1 = k0 + 1;
          if (k1 == ntw) {
            k1 = 0;
            c1 = c0 + 1;
          }
        }
        {
          const int t1 = wid + 4 * k1;
          exp_load(B0, vt + 128 * c1, (const signed char*)nullptr, ids + t1 * 128 + grp * 8, j8, false);
        }
        exp_v_accum(B1, wq.z, wq.w, acc);
        exp_v_finish(xo, xq, gq, acc, swl[t0], grp, gscale);
        c0 = c1;
        k0 = k1;
      }
    }
    asm volatile("s_waitcnt vmcnt(0)" ::: "memory");
    __syncthreads();
    if (gscale == 1.f) {
      for (int t = wid; t < cnt; t += 4) {
        if (layer + 1 < DEPTH) norm_row(p, layer + 1, 0, tok0 + t, lane);
        else if (tok0 + t < TL) norm_row(p, 0, 2, tok0 + t, lane);
      }
    }
    __syncthreads();
  }
}

#define XB_TMO 128
#define XB_XCNT(j) (256 + 64 * (j))
#define XB_XSUB(j) (1280 + 64 * (j))
#define XB_XGEN(j) (2304 + 64 * (j))
#define XB_TOP 3328
#define XB_TOPGEN 3392
#define XCD_BAR_WORDS 3456
#define XB_SPIN_CAP (1u << 22)
#define LAS __attribute__((address_space(3)))
DEVI unsigned xb_ld(unsigned* p) { return __hip_atomic_load(p, __ATOMIC_RELAXED, __HIP_MEMORY_SCOPE_AGENT); }
DEVI unsigned xb_add(unsigned* p, unsigned v) { return __hip_atomic_fetch_add(p, v, __ATOMIC_RELAXED, __HIP_MEMORY_SCOPE_AGENT); }
DEVI unsigned xb_xcc_id() { return (unsigned)__builtin_amdgcn_s_getreg((3 << 11) | 20) & 0xFu; }
#define XB_SPIN(cond, bar)                                   \
  do {                                                       \
    unsigned _sp = 0;                                        \
    while (cond) {                                           \
      __builtin_amdgcn_s_sleep(1);                           \
      if ((++_sp & 255u) == 0u) {                            \
        if (xb_ld(&(bar)[XB_TMO])) break;                    \
        if (_sp > XB_SPIN_CAP) {                             \
          atomicAdd(&(bar)[XB_TMO], 1u);                     \
          break;                                             \
        }                                                    \
      }                                                      \
    }                                                        \
  } while (0)
struct XcdBarrier {
  unsigned* bar;
  unsigned x;
  volatile LAS unsigned* st;
};
DEVI XcdBarrier xcd_barrier_post(unsigned* bar, volatile LAS unsigned* st) {
  XcdBarrier b;
  b.bar = bar;
  b.x = xb_xcc_id();
  b.st = st;
  if (threadIdx.x == 0) (void)xb_add(&bar[XB_XCNT(b.x)], 1u);
  return b;
}
DEVI void xcd_barrier_complete(unsigned* bar, unsigned x, unsigned& nloc, unsigned& nx) {
  const unsigned G = gridDim.x * gridDim.y * gridDim.z;
  unsigned sum, cnt, mine, sp = 0u;
  for (;;) {
    sum = 0u;
    cnt = 0u;
    mine = 0u;
#pragma unroll
    for (unsigned j = 0; j < 16; ++j) {
      const unsigned c = xb_ld(&bar[XB_XCNT(j)]);
      sum += c;
      cnt += (c > 0u) ? 1u : 0u;
      mine = (j == x) ? c : mine;
    }
    if (sum == G) break;
    __builtin_amdgcn_s_sleep(1);
    if ((++sp & 255u) == 0u) {
      if (xb_ld(&bar[XB_TMO])) break;
      if (sp > XB_SPIN_CAP) {
        atomicAdd(&bar[XB_TMO], 1u);
        break;
      }
    }
  }
  nloc = mine > 0u ? mine : 1u;
  nx = cnt > 0u ? cnt : 1u;
}
DEVI void xcd_barrier(const XcdBarrier& b) {
  asm volatile("s_waitcnt vmcnt(0)" ::: "memory");
  __syncthreads();
  if (threadIdx.x == 0) {
    unsigned* bar = b.bar;
    __builtin_amdgcn_s_waitcnt(0);
    unsigned nloc = b.st[0], nx = b.st[1];
    if (nloc == 0u) {
      xcd_barrier_complete(bar, b.x, nloc, nx);
      b.st[0] = nloc;
      b.st[1] = nx;
    }
    const unsigned old = xb_add(&bar[XB_XSUB(b.x)], 1u);
    const unsigned gen = old / nloc;
    if (old + 1u == (gen + 1u) * nloc) {
      __builtin_amdgcn_fence(__ATOMIC_RELEASE, "agent");
      asm volatile("s_waitcnt vmcnt(0)" ::: "memory");
      const unsigned og = xb_add(&bar[XB_TOP], 1u);
      const unsigned tg = og / nx;
      if (og + 1u == (tg + 1u) * nx) xb_add(&bar[XB_TOPGEN], 1u);
      else XB_SPIN(xb_ld(&bar[XB_TOPGEN]) == tg, bar);
      __builtin_amdgcn_fence(__ATOMIC_ACQUIRE, "agent");
      xb_add(&bar[XB_XGEN(b.x)], 1u);
      asm volatile("s_waitcnt vmcnt(0)" ::: "memory");
    } else {
      XB_SPIN(xb_ld(&bar[XB_XGEN(b.x)]) == gen, bar);
      __builtin_amdgcn_fence(__ATOMIC_ACQUIRE, "agent");
      asm volatile("s_waitcnt vmcnt(0)" ::: "memory");
    }
  }
  __syncthreads();
}

DEVI bool step_active(int step) {
  if (step == 0) return true;
  if (step == NSTEPS - 1) return false;
  int layer = (step - 1) / STEPS_PER_LAYER, ph = (step - 1) % STEPS_PER_LAYER;
  if (ph == 3 && (layer & 1)) return false;
  if (ph == 0 && layer > 0) return false;
  return true;
}

DEVI void run_step(PP p, int step, unsigned char* lds, unsigned char* lds_all, float gscale = 1.f) {
  if (step == 0) {
    phase_prep(p, lds);
    return;
  }
  if (step == NSTEPS - 1) {
    phase_norm(p, 0, 2, TL);
    return;
  }
  int layer = (step - 1) / STEPS_PER_LAYER, ph = (step - 1) % STEPS_PER_LAYER;
  bool even = (layer & 1) == 0;
  int j = layer >> 1;
  bool upd_ctx = layer < 2;
  bool need_ctx = layer < 3;
  int nt_in = need_ctx ? TT : TL;
  int nt = upd_ctx ? TT : TL;
  switch (ph) {
    case 0: phase_norm(p, layer, 0, nt_in); break;
    case 1:
      if (even)
        gemm8_phase<EPI_INPROJ>(p, p->h, D, p->wt_in_ab + (size_t)j * 1280 * D, D, nt_in / 256, 5, D, layer, lds_all);
      else
        gemm8_phase<EPI_GELU>(p, p->h, D, p->wt_in_gs + (size_t)j * 2048 * D, D, nt / 256, 8, D, layer, lds_all);
      break;
    case 2:
      if (even) {
        phase_fft_a(p, lds);
        if (upd_ctx) phase_dft_ctx(p, lds);
        phase_attn(p, layer, upd_ctx, lds);
      } else {
        phase_sgu(p, j, nt / 128, lds);
      }
      break;
    case 3:
      if (even) phase_fft_b(p, lds);
      break;
    case 4:
      if (even)
      {
        if (layer == 0) gemm8_phase<EPI_RESID0>(p, p->mix, LDMIX, p->wt_out_ab + (size_t)j * D * LDMIX, LDMIX, nt / 256, 4, LDMIX, layer, lds_all, gscale);
        else gemm8_phase<EPI_RESID>(p, p->mix, LDMIX, p->wt_out_ab + (size_t)j * D * LDMIX, LDMIX, nt / 256, 4, LDMIX, layer, lds_all, gscale);
      }
      else
      {
        gemm8_phase<EPI_RESID>(p, p->mix, LDMIX, p->wt_out_gs + (size_t)j * D * D, D, nt / 256, 4, D, layer, lds_all, gscale);
      }
      break;
    case 5: phase_norm(p, layer, 1, nt); break;
    case 6: gemm8_phase<EPI_STORE>(p, p->h, D, p->wt_q + (size_t)layer * 2048 * D, D, nt / 256, 8, D, layer, lds_all); break;
    case 7: phase_route(p, layer, nt, lds); break;
    case 8: phase_expert(p, layer, nt, lds, gscale, (gscale == 1.f) ? 0xffff : REP_IDMASK); break;
  }
}

__global__ void __launch_bounds__(PHYS_THREADS, 2) mega(Params p_unused, int step_lo, int step_hi) {
  unsigned char* lds_all = g_lds;
  if ((threadIdx.x & 63) == 0) *reinterpret_cast<volatile int*>(g_lds + LDS_BYTES - 16 - 256 + 4 * hw_slot()) = (int)(threadIdx.x >> 6);
  __syncthreads();
  unsigned char* lds = lds_all + (wave_index() >> 2) * LDS_HALF;
  PP pp = (PP)__builtin_amdgcn_kernarg_segment_ptr();
  volatile LAS unsigned* st = (volatile LAS unsigned*)(lds_all + LDS_BYTES - 16);
  if (threadIdx.x == 0) {
    st[0] = 0u;
    st[1] = 0u;
  }
  __syncthreads();
  XcdBarrier xb = xcd_barrier_post(pp->bar, st);
  int nsync = 0;
  bool first = true;
  for (int s = step_lo; s < step_hi; ++s) {
    if (!step_active(s)) continue;
    if (!first) {
      if (nsync == 0) cg::this_grid().sync();
      else xcd_barrier(xb);
      ++nsync;
    }
    first = false;
    int nrep = 1;
    if (PROBE_PH) {
      if (s == 0) nrep += (PROBE_PH >> 15) & 1;
      else if (s < NSTEPS - 1) {
        const int lay_ = (s - 1) / STEPS_PER_LAYER, ph_ = (s - 1) % STEPS_PER_LAYER;
        nrep += (PROBE_PH >> ph_) & 1;
        if (ph_ == 2 && ((PROBE_PH >> 9) & 1) && !(lay_ & 1)) nrep = 2;
        if (ph_ == 2 && ((PROBE_PH >> 10) & 1) && (lay_ & 1)) nrep = 2;
        if (ph_ == 1 && ((PROBE_PH >> 12) & 1) && !(lay_ & 1)) nrep = 2;
        if (ph_ == 1 && ((PROBE_PH >> 13) & 1) && (lay_ & 1)) nrep = 2;
        if (ph_ == 4 && ((PROBE_PH >> 11) & 1) && !(lay_ & 1)) nrep = 2;
        if (ph_ == 4 && ((PROBE_PH >> 14) & 1) && (lay_ & 1)) nrep = 2;
      }
      asm volatile("" : "+s"(nrep));
    }
#pragma nounroll
    for (int rep = nrep - 1; rep >= 0; --rep) {
      if (rep != nrep - 1) xcd_barrier(xb);
      PP q = pp;
      asm volatile("" : "+s"(q));
      int gi = __builtin_amdgcn_readfirstlane(rep ? 0 : 0x3f800000);
      if (PROBE_PH) asm volatile("" : "+s"(gi));
      const float gs = __int_as_float(gi);
      if (PROBE_PH) run_step(q, s, lds, lds_all, gs);
      else run_step(q, s, lds, lds_all);
    }
  }
}

static size_t align_up(size_t v) { return (v + 255) & ~(size_t)255; }

extern "C" void kernel_launch(void* const* d_in, const int* in_sizes, int n_in, void* d_out, int out_size, void* d_ws,
                              size_t ws_size, hipStream_t stream) {
  Params p{};
  p.x = (const float*)d_in[0];
  p.c = (const float*)d_in[1];
  p.ctx = (const float*)d_in[2];
  p.c_ctx = (const float*)d_in[3];
  p.ada_w = (const float*)d_in[4];
  p.ada_b = (const float*)d_in[5];
  p.norm_mix_w = (const float*)d_in[6];
  p.norm_ffn_w = (const float*)d_in[7];
  p.ab_w_in = (const float*)d_in[8];
  p.ab_w_out = (const float*)d_in[9];
  p.attn_sink = (const float*)d_in[10];
  p.gs_w_in = (const float*)d_in[11];
  p.gs_norm_w = (const float*)d_in[12];
  p.gs_w_s = (const float*)d_in[13];
  p.gs_b_s = (const float*)d_in[14];
  p.gs_w_out = (const float*)d_in[15];
  p.peer_w_q = (const float*)d_in[16];
  p.peer_keys = (const float*)d_in[17];
  p.peer_u = (const float*)d_in[18];
  p.peer_v = (const float*)d_in[19];
  p.norm_out_w = (const float*)d_in[20];
  p.out = (float*)d_out;
  unsigned char* w = (unsigned char*)d_ws;
  size_t off = 0;
  auto take = [&](size_t bytes) {
    unsigned char* r = w + off;
    off = align_up(off + bytes);
    return r;
  };
  p.bar = (unsigned*)take((size_t)XCD_BAR_WORDS * 4);
  p.mod = (float*)take((size_t)DEPTH * 9 * 6144 * 4);
  p.cs = (float2*)take(64 * 16 * 8);
  p.xs = (float*)take((size_t)TT * D * 4);
  p.h = (bf16_t*)take((size_t)TT * D * 2);
  p.P = (bf16_t*)take((size_t)TT * 2048 * 2);
  p.kbuf = (bf16_t*)take((size_t)NB * 2 * KVLEN * 64 * 2);
  p.vbuf = (bf16_t*)take((size_t)NB * 2 * KVLEN * 64 * 2);
  p.zvT = (bf16_t*)take((size_t)TT * 1024 * 2);
  p.rowss = (float*)take((size_t)(TT / 128) * 32 * 128 * 4);
  p.mix = (bf16_t*)take((size_t)TT * LDMIX * 2);
  p.fa = (bf16_t*)take((size_t)TL * 1024 * 2);
  p.tops = (float*)take((size_t)TT * 256 * 4);
  p.eidx = (int*)take((size_t)TT * 128 * 4);
  p.gate = (float*)take((size_t)TT * 128 * 4);
  p.wt_in_ab = (bf16_t*)take((size_t)2 * 1280 * D * 2);
  p.wt_out_ab = (bf16_t*)take((size_t)2 * D * LDMIX * 2);
  p.wt_in_gs = (bf16_t*)take((size_t)2 * 2048 * D * 2);
  p.wt_out_gs = (bf16_t*)take((size_t)2 * D * D * 2);
  p.wt_q = (bf16_t*)take((size_t)DEPTH * 2048 * D * 2);
  p.keysb = (bf16_t*)take((size_t)DEPTH * 8 * 2 * 128 * 128 * 2);
  p.su = (float*)take((size_t)DEPTH * NEXP * 4);
  p.sv = (float*)take((size_t)DEPTH * NEXP * 4);
  p.h8 = (signed char*)take((size_t)TT * D);
  p.sx = (float*)take((size_t)TT * 4);
  p.utab = (unsigned char*)take((size_t)DEPTH * NEXP * D);
  p.vtab = (unsigned char*)take((size_t)DEPTH * NEXP * D);
  if (off > ws_size) {
    fprintf(stderr, "workspace too small: need %zu have %zu\n", off, ws_size);
    return;
  }
  hipMemsetAsync(p.bar, 0, (size_t)XCD_BAR_WORDS * 4, stream);
  static int grid_blocks = 0;
  if (!grid_blocks) {
    int dev = 0, cus = 0, per_cu = 0;
    hipGetDevice(&dev);
    hipDeviceGetAttribute(&cus, hipDeviceAttributeMultiprocessorCount, dev);
    hipOccupancyMaxActiveBlocksPerMultiprocessor(&per_cu, mega, PHYS_THREADS, 0);
    if (per_cu > 1) per_cu = 1;
    if (per_cu < 1) per_cu = 1;
    grid_blocks = cus * per_cu;
  }
#if ONE_LAUNCH
  int lo = 0, hi = NSTEPS;
  void* args[] = {&p, &lo, &hi};
  hipError_t e = hipLaunchCooperativeKernel((void*)mega, dim3(grid_blocks), dim3(PHYS_THREADS), args, 0, stream);
  if (e != hipSuccess) fprintf(stderr, "cooperative launch failed: %s (grid %d)\n", hipGetErrorString(e), grid_blocks);
#else
  for (int s = 0; s < NSTEPS; ++s) {
    if (s != 0 && s != NSTEPS - 1) {
      int layer = (s - 1) / STEPS_PER_LAYER, ph = (s - 1) % STEPS_PER_LAYER;
      if (ph == 3 && (layer & 1)) continue;
    }
    hipLaunchKernelGGL(mega, dim3(grid_blocks), dim3(NTHREADS), 0, stream, p, s, s + 1);
  }
#endif
}
```

```cpp
#include <hip/hip_runtime.h>
#include <hip/hip_bf16.h>
#include <hip/hip_cooperative_groups.h>
#include <cstdio>
namespace cg = cooperative_groups;

#ifndef PROBE_PH
#define PROBE_PH 0
#endif
#ifndef REP_MASK
#define REP_MASK 0
#endif
#ifndef REP_MODE
#define REP_MODE 0
#endif
#ifndef REP_IDMASK
#define REP_IDMASK 0xffff
#endif
#ifndef ONE_LAUNCH
#define ONE_LAUNCH 1
#endif

#define DEVI __device__ __forceinline__
typedef unsigned short bf16_t;
using bf16x8 = __attribute__((ext_vector_type(8))) short;
using f32x4 = __attribute__((ext_vector_type(4))) float;
using f32x16 = __attribute__((ext_vector_type(16))) float;

constexpr int D = 1024, NB = 8, SEQ = 4096, CTX = 256, DEPTH = 4;
constexpr int TL = NB * SEQ, TC = NB * CTX, TT = TL + TC;
constexpr int KVLEN = CTX + SEQ;
constexpr int NEXP = 16384;
constexpr int LDMIX = 1536;
constexpr float USCALE = 64.f, VSCALE = 8.f;
constexpr int TPB = 68;
constexpr int LDS_HALF = 68 * 1024;
constexpr int LDS_BYTES = 2 * LDS_HALF;
constexpr int PHYS_THREADS = 512;
constexpr int NTHREADS = 256;
constexpr int STEPS_PER_LAYER = 9;
constexpr int NSTEPS = 1 + DEPTH * STEPS_PER_LAYER + 1;

struct Params {
  const float *x, *c, *ctx, *c_ctx, *ada_w, *ada_b, *norm_mix_w, *norm_ffn_w, *ab_w_in, *ab_w_out, *attn_sink,
      *gs_w_in, *gs_norm_w, *gs_w_s, *gs_b_s, *gs_w_out, *peer_w_q, *peer_keys, *peer_u, *peer_v, *norm_out_w;
  float* out;
  float* mod;
  float2* cs;
  float* xs;
  bf16_t* h;
  bf16_t* P;
  bf16_t* kbuf;
  bf16_t* vbuf;
  float* rowss;
  bf16_t* zvT;
  bf16_t* mix;
  bf16_t* fa;
  unsigned* bar;
  float* tops;
  int* eidx;
  float* gate;
  bf16_t *wt_in_ab, *wt_out_ab, *wt_in_gs, *wt_out_gs, *wt_q, *keysb;
  unsigned char *utab, *vtab;
  float* su;
  float* sv;
  signed char* h8;
  float* sx;
};

typedef const __attribute__((address_space(4))) Params* PP;

__shared__ __attribute__((aligned(16))) unsigned char g_lds[LDS_BYTES];
DEVI int hw_slot() {
  int h = (int)(__builtin_amdgcn_s_getreg((6 - 1) << 11 | 0 << 6 | 4) & 63u);
  asm volatile("" : "+s"(h));
  return h;
}
DEVI int wave_index() {
  int w = *reinterpret_cast<volatile int*>(g_lds + LDS_BYTES - 16 - 256 + 4 * hw_slot());
  return __builtin_amdgcn_readfirstlane(w);
}
DEVI int lane_id() { return (int)__builtin_amdgcn_mbcnt_hi(~0u, __builtin_amdgcn_mbcnt_lo(~0u, 0u)); }
DEVI int ltid() { int t = ((wave_index() & 3) << 6) | lane_id(); asm volatile("" : "+v"(t)); return t; }
DEVI int lbid() { int t = 2 * blockIdx.x + (wave_index() >> 2); asm volatile("" : "+s"(t)); return t; }
DEVI int lnblk() { int t = 2 * gridDim.x; asm volatile("" : "+s"(t)); return t; }
DEVI int ptid() { int t = (wave_index() << 6) | lane_id(); asm volatile("" : "+v"(t)); return t; }
DEVI int pbid() { int t = blockIdx.x; asm volatile("" : "+s"(t)); return t; }
DEVI int pnblk() { int t = gridDim.x; asm volatile("" : "+s"(t)); return t; }

typedef __bf16 bf2v_t __attribute__((ext_vector_type(2)));
typedef float f2v_t __attribute__((ext_vector_type(2)));
DEVI bf16_t f2bf(float f) { return __builtin_bit_cast(unsigned short, (__bf16)f); }
DEVI float bf2f(bf16_t h) { return __uint_as_float(((unsigned)h) << 16); }
DEVI float bflo(unsigned u) { return __uint_as_float(u << 16); }
DEVI float bfhi(unsigned u) { return __uint_as_float(u & 0xffff0000u); }
DEVI unsigned pack2(float a, float b) {
  f2v_t v = {a, b};
  return __builtin_bit_cast(unsigned, __builtin_convertvector(v, bf2v_t));
}
DEVI float gelu_tanh(float x) {
  const float k1 = -2.f * 0.7978845608028654f * 1.4426950408889634f;
  const float a = x * __builtin_fmaf(x * x, k1 * 0.044715f, k1);
  return x * __builtin_amdgcn_rcpf(1.f + __builtin_amdgcn_exp2f(a));
}
template <int CTRL>
DEVI float dpp_mov(float v) {
  return __builtin_bit_cast(float, __builtin_amdgcn_mov_dpp(__builtin_bit_cast(int, v), CTRL, 0xF, 0xF, true));
}
DEVI int shx_i(int v, int m) { return __builtin_amdgcn_ds_bpermute((lane_id() ^ m) << 2, v); }
DEVI float shx_f(float v, int m) { return __builtin_bit_cast(float, shx_i(__builtin_bit_cast(int, v), m)); }
DEVI float wave_sum(float v) {
  v += dpp_mov<0xB1>(v);
  v += dpp_mov<0x4E>(v);
  v += dpp_mov<0x141>(v);
  v += dpp_mov<0x140>(v);
  v += shx_f(v, 16);
  v += shx_f(v, 32);
  return v;
}
DEVI float wave_max(float v) {
  v = fmaxf(v, dpp_mov<0xB1>(v));
  v = fmaxf(v, dpp_mov<0x4E>(v));
  v = fmaxf(v, dpp_mov<0x141>(v));
  v = fmaxf(v, dpp_mov<0x140>(v));
  v = fmaxf(v, shx_f(v, 16));
  v = fmaxf(v, shx_f(v, 32));
  return v;
}
DEVI int tok_batch(int r) { return r < TL ? (r >> 12) : 8; }

DEVI void prep_transpose_tile(const float* __restrict__ src, int N, bf16_t* __restrict__ dst, int ldk, int tk, int tn, float* tile, int tid) {
#pragma unroll
  for (int i = 0; i < 16; ++i) {
    int r = (tid >> 6) + 4 * i;
    tile[r * 65 + (tid & 63)] = src[(size_t)(tk * 64 + r) * N + tn * 64 + (tid & 63)];
  }
  __syncthreads();
#pragma unroll
  for (int i = 0; i < 16; ++i) {
    int n = (tid >> 6) + 4 * i, k = tid & 63;
    dst[(size_t)(tn * 64 + n) * ldk + tk * 64 + k] = f2bf(tile[k * 65 + n]);
  }
}

constexpr int PU_ADA = DEPTH * 96;
constexpr int PU_T_ABIN = 2 * 16 * 20;
constexpr int PU_T_GSIN = 2 * 16 * 32;
constexpr int PU_T_GSOUT = 2 * 16 * 16;
constexpr int PU_T_ABOUT = 2 * 8 * 16;
constexpr int PU_T_Q = DEPTH * 16 * 32;
constexpr int PU_FOLD = 2 * 4 * 16 * 2;
constexpr int PU_CONV = DEPTH * NEXP * D / 4 / 2048;
constexpr int PU_KEYS = DEPTH * 8 * 2 * 128 * 128 / 4 / 2048;
constexpr int PU_UROWS = DEPTH * NEXP / 32;
constexpr int PU_TOTAL = PU_ADA + PU_T_ABIN + PU_T_GSIN + PU_T_GSOUT + PU_T_ABOUT + PU_T_Q + PU_FOLD + 2 * PU_UROWS + PU_KEYS + 1;

DEVI void phase_prep(PP p, unsigned char* lds) {
  const int tid = ltid();
  float* fl = reinterpret_cast<float*>(lds);
  for (int u0 = lbid(); u0 < PU_TOTAL; u0 += lnblk()) {
    int u = u0;
    if (u < PU_ADA) {
      float* sl = fl;
      for (int i = tid; i < 9 * 1024; i += NTHREADS) {
        int r = i >> 10, k = i & 1023;
        float v = (r < 8) ? p->c[r * 1024 + k] : p->c_ctx[k];
        sl[i] = v / (1.f + __expf(-v));
      }
      __syncthreads();
      float* red = sl + 9 * 1024;
      int ks = tid >> 6, col = tid & 63;
      int layer = u / 96, c0 = (u % 96) * 64;
      const float* w = p->ada_w + (size_t)layer * D * 6144 + c0 + col;
      float acc[9];
#pragma unroll
      for (int r = 0; r < 9; ++r) acc[r] = 0.f;
      for (int k0 = ks * 256; k0 < ks * 256 + 256; k0 += 16) {
        float wv[16];
#pragma unroll
        for (int kk = 0; kk < 16; ++kk) wv[kk] = w[(size_t)(k0 + kk) * 6144];
#pragma unroll
        for (int kk = 0; kk < 16; ++kk)
#pragma unroll
          for (int r = 0; r < 9; ++r) acc[r] += sl[r * 1024 + k0 + kk] * wv[kk];
      }
#pragma unroll
      for (int r = 0; r < 9; ++r) red[(ks * 9 + r) * 64 + col] = acc[r];
      __syncthreads();
      for (int i = tid; i < 9 * 64; i += NTHREADS) {
        int r = i >> 6, cc = i & 63;
        float sm = red[(0 * 9 + r) * 64 + cc] + red[(1 * 9 + r) * 64 + cc] + red[(2 * 9 + r) * 64 + cc] + red[(3 * 9 + r) * 64 + cc];
        sm += p->ada_b[(size_t)layer * 6144 + c0 + cc];
        p->mod[((size_t)layer * 9 + r) * 6144 + c0 + cc] = sm;
      }
      __syncthreads();
      continue;
    }
    u -= PU_ADA;
    if (u < PU_T_ABIN) {
      int j = u / 320, t = u % 320;
      prep_transpose_tile(p->ab_w_in + (size_t)j * D * 1280, 1280, p->wt_in_ab + (size_t)j * 1280 * D, D, t / 20, t % 20, fl, tid);
      __syncthreads();
      continue;
    }
    u -= PU_T_ABIN;
    if (u < PU_T_GSIN) {
      int j = u / 512, t = u % 512;
      prep_transpose_tile(p->gs_w_in + (size_t)j * D * 2048, 2048, p->wt_in_gs + (size_t)j * 2048 * D, D, t / 32, t % 32, fl, tid);
      __syncthreads();
      continue;
    }
    u -= PU_T_GSIN;
    if (u < PU_T_GSOUT) {
      int j = u / 256, t = u % 256;
      prep_transpose_tile(p->gs_w_out + (size_t)j * D * D, D, p->wt_out_gs + (size_t)j * D * D, D, t / 16, t % 16, fl, tid);
      __syncthreads();
      continue;
    }
    u -= PU_T_GSOUT;
    if (u < PU_T_ABOUT) {
      int j = u / 128, t = u % 128;
      prep_transpose_tile(p->ab_w_out + (size_t)j * D * D, D, p->wt_out_ab + (size_t)j * D * LDMIX, LDMIX, t / 16, t % 16, fl, tid);
      __syncthreads();
      continue;
    }
    u -= PU_T_ABOUT;
    if (u < PU_T_Q) {
      int i = u / 512, t = u % 512;
      prep_transpose_tile(p->peer_w_q + (size_t)i * D * 2048, 2048, p->wt_q + (size_t)i * 2048 * D, D, t / 32, t % 32, fl, tid);
      __syncthreads();
      continue;
    }
    u -= PU_T_Q;
    if (u < PU_FOLD) {
      const int mh = u & 1, nc = (u >> 1) & 15, g = (u >> 5) & 3, j = u >> 7;
      float2* tw = reinterpret_cast<float2*>(lds);
      float* wt = reinterpret_cast<float*>(lds + 1024);
      if (tid < 128) {
        float sn, cn;
        sincospif((float)tid / 64.f, &sn, &cn);
        tw[tid] = make_float2(cn, sn);
      }
      {
        const float* wsrc = p->ab_w_out + (size_t)j * D * D + (size_t)(512 + g * 128) * D + nc * 64;
#pragma unroll 8
        for (int i = 0; i < 32; ++i) {
          int l = (tid >> 6) + 4 * i;
          wt[l * 64 + (tid & 63)] = wsrc[(size_t)l * D + (tid & 63)];
        }
      }
      __syncthreads();
      const int n = tid & 63, mq = __builtin_amdgcn_readfirstlane(tid >> 6);
      bf16_t* dst = p->wt_out_ab + (size_t)j * D * LDMIX + (size_t)(nc * 64 + n) * LDMIX + g * 128;
#pragma unroll 1
      for (int mi = 0; mi < 16; ++mi) {
        const int m = mh * 64 + mq * 16 + mi;
        float ar = 0.f, ai = 0.f;
#pragma unroll 16
        for (int l = 0; l < 128; ++l) {
          float2 t = tw[(m * l) & 127];
          float wv = wt[l * 64 + n];
          ar += t.x * wv;
          ai += t.y * wv;
        }
        dst[512 + m] = f2bf(ar);
        dst[1024 + m] = f2bf(ai);
      }
      __syncthreads();
      continue;
    }
    u -= PU_FOLD;
    if (u < 2 * PU_UROWS) {
      const bool isv = u >= PU_UROWS;
      if (isv) u -= PU_UROWS;
      const float* src = isv ? p->peer_v : p->peer_u;
      unsigned char* dst = isv ? p->vtab : p->utab;
      float* sdst = isv ? p->sv : p->su;
      const int lane = tid & 63, wv = tid >> 6;
#pragma unroll 1
      for (int rr = 0; rr < 8; rr += 4) {
        size_t row0 = (size_t)u * 32 + wv * 8 + rr;
        float4 v[4][4];
#pragma unroll
        for (int k = 0; k < 4; ++k)
#pragma unroll
          for (int i = 0; i < 4; ++i) v[k][i] = reinterpret_cast<const float4*>(src + (row0 + k) * D)[lane * 4 + i];
#pragma unroll
        for (int k = 0; k < 4; ++k) {
          float am = 0.f;
#pragma unroll
          for (int i = 0; i < 4; ++i)
            am = fmaxf(am, fmaxf(fmaxf(fabsf(v[k][i].x), fabsf(v[k][i].y)), fmaxf(fabsf(v[k][i].z), fabsf(v[k][i].w))));
          am = wave_max(am);
          am = fmaxf(am, 1e-30f);
          float qs = 127.f / am;
          uint4 o;
          unsigned* op = reinterpret_cast<unsigned*>(&o);
#pragma unroll
          for (int i = 0; i < 4; ++i) {
            int q0 = (int)rintf(v[k][i].x * qs), q1 = (int)rintf(v[k][i].y * qs), q2 = (int)rintf(v[k][i].z * qs), q3 = (int)rintf(v[k][i].w * qs);
            op[i] = (unsigned)(q0 & 255) | ((unsigned)(q1 & 255) << 8) | ((unsigned)(q2 & 255) << 16) | ((unsigned)(q3 & 255) << 24);
          }
          reinterpret_cast<uint4*>(dst + (row0 + k) * D)[lane] = o;
          if (lane == 0) sdst[row0 + k] = am * (1.f / 127.f);
        }
      }
      continue;
    }
    u -= 2 * PU_UROWS;
    if (u < PU_KEYS) {
      const float4* s4 = reinterpret_cast<const float4*>(p->peer_keys) + (size_t)u * 2048 + tid;
      uint2* d2 = reinterpret_cast<uint2*>(p->keysb) + (size_t)u * 2048 + tid;
#pragma unroll
      for (int k = 0; k < 8; ++k) {
        float4 v = s4[k * 256];
        uint2 o;
        o.x = pack2(v.x, v.y);
        o.y = pack2(v.z, v.w);
        d2[k * 256] = o;
      }
      continue;
    }
    for (int i = tid; i < 64 * 16; i += NTHREADS) {
      int pos = i >> 4, k = i & 15;
      float inv = powf(10000.f, -(float)k / 16.f);
      float ang = (float)pos * inv;
      float sn, cn;
      sincosf(ang, &sn, &cn);
      p->cs[i] = make_float2(cn, sn);
    }
  }
}

DEVI void norm_row(PP p, int layer, int which, int tok, int lane) {
  const float* w = which == 0 ? p->norm_mix_w + layer * D : (which == 1 ? p->norm_ffn_w + layer * D : p->norm_out_w);
  const float* xsrc = p->xs + (size_t)tok * D;
  if (which == 0 && layer == 0) xsrc = (tok < TL) ? p->x + (size_t)tok * D : p->ctx + (size_t)(tok - TL) * D;
  const float4* xr = reinterpret_cast<const float4*>(xsrc);
  float4 v[4];
  float ss = 0.f;
#pragma unroll
  for (int i = 0; i < 4; ++i) {
    v[i] = xr[lane + 64 * i];
    ss += v[i].x * v[i].x + v[i].y * v[i].y + v[i].z * v[i].z + v[i].w * v[i].w;
  }
  ss = wave_sum(ss);
  float rstd = rsqrtf(ss * (1.f / 1024.f) + 1e-6f);
  if (which == 2) {
    float4* o = reinterpret_cast<float4*>(p->out + (size_t)tok * D);
#pragma unroll
    for (int i = 0; i < 4; ++i) {
      float4 wv = reinterpret_cast<const float4*>(w)[lane + 64 * i];
      float4 r;
      r.x = v[i].x * rstd * wv.x;
      r.y = v[i].y * rstd * wv.y;
      r.z = v[i].z * rstd * wv.z;
      r.w = v[i].w * rstd * wv.w;
      o[lane + 64 * i] = r;
    }
  } else {
    int b = tok_batch(tok);
    const float* mb = p->mod + ((size_t)layer * 9 + b) * 6144 + (which == 0 ? 0 : 3072);
    uint2* o = reinterpret_cast<uint2*>(p->h + (size_t)tok * D);
    float av[4][4];
    float am = 0.f;
#pragma unroll
    for (int i = 0; i < 4; ++i) {
      float4 wv = reinterpret_cast<const float4*>(w)[lane + 64 * i];
      float4 sh = reinterpret_cast<const float4*>(mb)[lane + 64 * i];
      float4 sc = reinterpret_cast<const float4*>(mb + 1024)[lane + 64 * i];
      float a0 = v[i].x * rstd * wv.x * (1.f + sc.x) + sh.x;
      float a1 = v[i].y * rstd * wv.y * (1.f + sc.y) + sh.y;
      float a2 = v[i].z * rstd * wv.z * (1.f + sc.z) + sh.z;
      float a3 = v[i].w * rstd * wv.w * (1.f + sc.w) + sh.w;
      uint2 r;
      r.x = pack2(a0, a1);
      r.y = pack2(a2, a3);
      o[lane + 64 * i] = r;
      av[i][0] = a0; av[i][1] = a1; av[i][2] = a2; av[i][3] = a3;
      am = fmaxf(am, fmaxf(fmaxf(fabsf(a0), fabsf(a1)), fmaxf(fabsf(a2), fabsf(a3))));
    }
    if (which == 1) {
      am = fmaxf(wave_max(am), 1e-30f);
      float qs = 127.f / am;
      unsigned* o8 = reinterpret_cast<unsigned*>(p->h8 + (size_t)tok * D);
#pragma unroll
      for (int i = 0; i < 4; ++i) {
        int q0 = (int)rintf(av[i][0] * qs), q1 = (int)rintf(av[i][1] * qs), q2 = (int)rintf(av[i][2] * qs), q3 = (int)rintf(av[i][3] * qs);
        o8[lane + 64 * i] = (unsigned)(q0 & 255) | ((unsigned)(q1 & 255) << 8) | ((unsigned)(q2 & 255) << 16) | ((unsigned)(q3 & 255) << 24);
      }
      if (lane == 0) p->sx[tok] = am * (1.f / 127.f);
    }
  }
}

DEVI void phase_norm(PP p, int layer, int which, int ntok) {
  int lane = ltid() & 63;
  int gw = lbid() * 4 + __builtin_amdgcn_readfirstlane(ltid() >> 6), nw = lnblk() * 4;
  for (int tok = gw; tok < ntok; tok += nw) norm_row(p, layer, which, tok, lane);
}

enum { EPI_STORE = 0, EPI_GELU = 1, EPI_RESID = 2, EPI_INPROJ = 3, EPI_RESID0 = 4 };

template <int EPI>
DEVI void gemm_phase(PP p, const bf16_t* __restrict__ A, int lda, const bf16_t* __restrict__ Bt, int ldb,
                     int Mtiles, int Ntiles, int K, int layer, unsigned char* lds, float gscale = 1.f, int big_t0 = -1, int big_n = 0,
                     int big_ntn = 1) {
  const int tid = ltid();
  const int wid = __builtin_amdgcn_readfirstlane(tid >> 6), lane = tid & 63, wr = wid >> 1, wc = wid & 1, fr = lane & 15, fq = lane >> 4;
  int nblk = lnblk();
  int bid = lbid();
  int lb = bid;
  {
    const int pn = nblk >> 1, pb = bid >> 1;
    if ((pn & 7) == 0) lb = 2 * ((pb & 7) * (pn >> 3) + (pb >> 3)) + (bid & 1);
  }
  int ntiles = (big_t0 >= 0) ? 4 * big_n : Mtiles * Ntiles;
  const int nk = K / 64;
  const int srow = tid >> 3;
  const int scol = ((tid & 7) ^ ((tid >> 3) & 7)) * 8;
#define GEMM_STAGE(ga_, gb_, kt_, buf_)                                                                               \
  {                                                                                                                   \
    _Pragma("unroll") for (int i_ = 0; i_ < 4; ++i_) {                                                                \
      __builtin_amdgcn_global_load_lds((const unsigned*)((ga_) + (size_t)(32 * i_) * lda + (kt_) * 64),               \
                                       (__attribute__((address_space(3))) unsigned*)(lds + (buf_) * 32768 + tid * 16 + i_ * 4096), 16, 0, 0); \
      __builtin_amdgcn_global_load_lds((const unsigned*)((gb_) + (size_t)(32 * i_) * ldb + (kt_) * 64),               \
                                       (__attribute__((address_space(3))) unsigned*)(lds + (buf_) * 32768 + 16384 + tid * 16 + i_ * 4096), 16, 0, 0); \
    }                                                                                                                 \
  }
  auto tile_rc = [&](int t, int& tm_, int& tn_) {
    if (big_t0 >= 0) {
      int bt = big_t0 + (t >> 2), q = t & 3;
      tm_ = 2 * (bt / big_ntn) + (q >> 1);
      tn_ = 2 * (bt % big_ntn) + (q & 1);
    } else {
      tm_ = t / Ntiles;
      tn_ = t % Ntiles;
    }
  };
  if (lb < ntiles) {
    int tm0, tn0;
    tile_rc(lb, tm0, tn0);
    const bf16_t* ga0 = A + (size_t)(tm0 * 128 + srow) * lda + scol;
    const bf16_t* gb0 = Bt + (size_t)(tn0 * 128 + srow) * ldb + scol;
    GEMM_STAGE(ga0, gb0, 0, 0)
  }
  for (int t = lb; t < ntiles; t += nblk) {
    int tm, tn;
    tile_rc(t, tm, tn);
    int brow = tm * 128, bcol = tn * 128;
    f32x4 acc[4][4];
#pragma unroll
    for (int m = 0; m < 4; ++m)
#pragma unroll
      for (int n = 0; n < 4; ++n) acc[m][n] = f32x4{0.f, 0.f, 0.f, 0.f};
    const bf16_t* ga = A + (size_t)(brow + srow) * lda + scol;
    const bf16_t* gb = Bt + (size_t)(bcol + srow) * ldb + scol;
    for (int kt = 0; kt < nk; ++kt) {
      const int buf = kt & 1;
      asm volatile("s_waitcnt vmcnt(0)" ::: "memory");
      __syncthreads();
      if (kt + 1 < nk) GEMM_STAGE(ga, gb, kt + 1, buf ^ 1)
      const unsigned char* SA = lds + buf * 32768;
      const unsigned char* SB = SA + 16384;
      bf16x8 At[2][4], Bl[2][4];
#pragma unroll
      for (int ks = 0; ks < 2; ++ks)
#pragma unroll
        for (int m = 0; m < 4; ++m) {
          const int sl = ((ks * 4 + fq) ^ (fr & 7)) << 4;
          At[ks][m] = *reinterpret_cast<const bf16x8*>(SA + (wr * 64 + m * 16 + fr) * 128 + sl);
          Bl[ks][m] = *reinterpret_cast<const bf16x8*>(SB + (wc * 64 + m * 16 + fr) * 128 + sl);
        }
#pragma unroll
      for (int ks = 0; ks < 2; ++ks)
#pragma unroll
        for (int m = 0; m < 4; ++m)
#pragma unroll
          for (int n = 0; n < 4; ++n)
            acc[m][n] = __builtin_amdgcn_mfma_f32_16x16x32_bf16(At[ks][m], Bl[ks][n], acc[m][n], 0, 0, 0);
    }
    {
      int t2 = t + nblk;
      if (t2 < ntiles) {
        int tm2, tn2;
        tile_rc(t2, tm2, tn2);
        const bf16_t* ga2 = A + (size_t)(tm2 * 128 + srow) * lda + scol;
        const bf16_t* gb2 = Bt + (size_t)(tn2 * 128 + srow) * ldb + scol;
        GEMM_STAGE(ga2, gb2, 0, 0)
      }
    }
    const int colbase = bcol + wc * 64;
    if constexpr (EPI == EPI_STORE || EPI == EPI_GELU) {
      if (EPI == EPI_GELU && colbase >= 1024) {
        float* rsp = p->rowss + ((size_t)tm * 32 + ((colbase - 1024) >> 5)) * 128;
#pragma unroll
        for (int m = 0; m < 4; ++m) {
          float ssq[4] = {0.f, 0.f, 0.f, 0.f};
#pragma unroll
          for (int n = 0; n < 4; ++n) {
            int ch = colbase - 1024 + n * 16 + fr;
            int q0 = wr * 64 + m * 16 + fq * 4;
            float g0 = gelu_tanh(acc[m][n][0]), g1 = gelu_tanh(acc[m][n][1]), g2 = gelu_tanh(acc[m][n][2]), g3 = gelu_tanh(acc[m][n][3]);
            ssq[0] += g0 * g0;
            ssq[1] += g1 * g1;
            ssq[2] += g2 * g2;
            ssq[3] += g3 * g3;
            uint2 o;
            o.x = pack2(g0, g1);
            o.y = pack2(g2, g3);
            *reinterpret_cast<uint2*>(p->zvT + ((size_t)tm * 1024 + ch) * 128 + q0) = o;
          }
#pragma unroll
          for (int j = 0; j < 4; ++j) {
            float v = ssq[j];
            v += dpp_mov<0xB1>(v);
            v += dpp_mov<0x4E>(v);
            v += dpp_mov<0x141>(v);
            v += dpp_mov<0x140>(v);
            if (fr == 0) {
              rsp[wr * 64 + m * 16 + fq * 4 + j] = v;
              rsp[128 + wr * 64 + m * 16 + fq * 4 + j] = 0.f;
            }
          }
        }
      } else {
#pragma unroll
        for (int m = 0; m < 4; ++m)
#pragma unroll
          for (int j = 0; j < 4; ++j) {
            int row = brow + wr * 64 + m * 16 + fq * 4 + j;
            bf16_t* o = p->P + (size_t)row * 2048 + colbase + fr;
#pragma unroll
            for (int n = 0; n < 4; ++n) {
              float v = acc[m][n][j];
              if (EPI == EPI_GELU) v = gelu_tanh(v);
              o[n * 16] = f2bf(v);
            }
          }
      }
    } else if constexpr (EPI == EPI_RESID) {
#pragma unroll
      for (int m = 0; m < 4; ++m)
#pragma unroll
        for (int j = 0; j < 4; ++j) {
          int row = brow + wr * 64 + m * 16 + fq * 4 + j;
          int b = tok_batch(row);
          const float* g = p->mod + ((size_t)layer * 9 + b) * 6144 + 2048 + colbase + fr;
          float* o = p->xs + (size_t)row * D + colbase + fr;
          const float* xi = o;
          if (layer == 0 && gscale == 1.f)
            xi = ((row < TL) ? p->x + (size_t)row * D : p->ctx + (size_t)(row - TL) * D) + colbase + fr;
#pragma unroll
          for (int n = 0; n < 4; ++n) o[n * 16] = xi[n * 16] + gscale * g[n * 16] * acc[m][n][j];
        }
    } else if constexpr (EPI == EPI_INPROJ) {
      if (colbase >= 640 && colbase < 768) {
        int kvh = (colbase - 640) >> 6;
#pragma unroll
        for (int m = 0; m < 4; ++m) {
          int row0 = brow + wr * 64 + m * 16;
          bool latent = row0 < TL;
          int b = latent ? (row0 >> 12) : ((row0 - TL) >> 8);
          int kp16 = latent ? (CTX + (row0 & 4095)) : ((row0 - TL) & 255);
          int slot = kp16 + 8 * (fq & 1) + 4 * (fq >> 1);
#pragma unroll
          for (int n = 0; n < 4; ++n) {
            int dim = n * 16 + fr;
            uint2 o;
            o.x = pack2(acc[m][n][0], acc[m][n][1]);
            o.y = pack2(acc[m][n][2], acc[m][n][3]);
            *reinterpret_cast<uint2*>(p->vbuf + ((size_t)(b * 2 + kvh) * 64 + dim) * KVLEN + slot) = o;
          }
        }
      } else {
#pragma unroll
        for (int m = 0; m < 4; ++m)
#pragma unroll
          for (int j = 0; j < 4; ++j) {
            int row = brow + wr * 64 + m * 16 + fq * 4 + j;
            bool latent = row < TL;
            int b, pos;
            if (latent) {
              b = row >> 12;
              pos = row & 4095;
            } else {
              b = (row - TL) >> 8;
              pos = (row - TL) & 255;
            }
            float v0 = acc[m][0][j], v1 = acc[m][1][j], v2 = acc[m][2][j], v3 = acc[m][3][j];
            if (latent && colbase < 640) {
              float2 cr = p->cs[(pos >> 6) * 16 + fr];
              float2 cc = p->cs[(pos & 63) * 16 + fr];
              float a = v0, bb = v1;
              v0 = a * cr.x - bb * cr.y;
              v1 = bb * cr.x + a * cr.y;
              a = v2;
              bb = v3;
              v2 = a * cc.x - bb * cc.y;
              v3 = bb * cc.x + a * cc.y;
            }
            bf16_t* o;
            if (colbase < 512 || colbase >= 768) {
              o = p->P + (size_t)row * 2048 + colbase + fr;
            } else {
              int kvh = (colbase - 512) >> 6;
              int kp = latent ? (CTX + pos) : pos;
              o = p->kbuf + ((size_t)(b * 2 + kvh) * KVLEN + kp) * 64 + fr;
            }
            o[0] = f2bf(v0);
            o[16] = f2bf(v1);
            o[32] = f2bf(v2);
            o[48] = f2bf(v3);
          }
      }
    }
  }
}

constexpr int G8_HT = 128 * 64;
DEVI int g8_lds_byte(int r, int c) {
  int st = (r >> 4) * 2 + (c >> 5), rr = r & 15, cc = c & 31, ob = rr * 64 + cc * 2;
  return st * 1024 + (ob ^ (((ob >> 9) & 1) << 5));
}
DEVI void g8_stage_rc(int b, int& R, int& C) {
  int st = b / 1024, sb = b % 1024, swz = sb ^ (((sb >> 9) & 1) << 5);
  R = (st >> 1) * 16 + swz / 64;
  C = (st & 1) * 32 + (swz % 64) / 2;
}
template <int EPI, bool STAGED>
DEVI void gemm8_epilogue(PP p, f32x4 (&acc)[2][2][4][2], const f32x4* stg, int lane, int brow, int bcol, int wr, int wc, int fr, int fq, int layer, float gscale) {
#pragma unroll
  for (int ai_ = 0; ai_ < 2; ++ai_)
#pragma unroll
    for (int bj = 0; bj < 2; ++bj) {
      const int ai = STAGED ? 1 - ai_ : ai_;
      f32x4 q[4][2];
#pragma unroll
      for (int m = 0; m < 4; ++m)
#pragma unroll
        for (int n = 0; n < 2; ++n) q[m][n] = (STAGED && ai == 0) ? stg[(((bj * 4 + m) * 2 + n) * 64) + lane] : acc[ai][bj][m][n];
      const int r0 = brow + ai * 128 + wr * 64;
      const int c0 = bcol + bj * 128 + wc * 32;
      if constexpr (EPI == EPI_STORE) {
#pragma unroll
        for (int m = 0; m < 4; ++m)
#pragma unroll
          for (int j = 0; j < 4; ++j) {
            bf16_t* o = p->P + (size_t)(r0 + m * 16 + fq * 4 + j) * 2048 + c0 + fr;
            o[0] = f2bf(q[m][0][j]);
            o[16] = f2bf(q[m][1][j]);
          }
      } else if constexpr (EPI == EPI_GELU) {
        if (c0 >= 1024) {
          const int chunk = r0 >> 7;
          float* rsp = p->rowss + ((size_t)chunk * 32 + ((c0 - 1024) >> 5)) * 128;
#pragma unroll
          for (int m = 0; m < 4; ++m) {
            float ssq[4] = {0.f, 0.f, 0.f, 0.f};
            const int q0 = (r0 & 127) + m * 16 + fq * 4;
#pragma unroll
            for (int n = 0; n < 2; ++n) {
              int ch = c0 - 1024 + n * 16 + fr;
              float g0 = gelu_tanh(q[m][n][0]), g1 = gelu_tanh(q[m][n][1]);
              float g2 = gelu_tanh(q[m][n][2]), g3 = gelu_tanh(q[m][n][3]);
              ssq[0] += g0 * g0;
              ssq[1] += g1 * g1;
              ssq[2] += g2 * g2;
              ssq[3] += g3 * g3;
              uint2 o;
              o.x = pack2(g0, g1);
              o.y = pack2(g2, g3);
              *reinterpret_cast<uint2*>(p->zvT + ((size_t)chunk * 1024 + ch) * 128 + q0) = o;
            }
#pragma unroll
            for (int j = 0; j < 4; ++j) {
              float v = ssq[j];
              v += dpp_mov<0xB1>(v);
              v += dpp_mov<0x4E>(v);
              v += dpp_mov<0x141>(v);
              v += dpp_mov<0x140>(v);
              if (fr == 0) rsp[q0 + j] = v;
            }
          }
        } else {
#pragma unroll
          for (int m = 0; m < 4; ++m)
#pragma unroll
            for (int j = 0; j < 4; ++j) {
              bf16_t* o = p->P + (size_t)(r0 + m * 16 + fq * 4 + j) * 2048 + c0 + fr;
              o[0] = f2bf(gelu_tanh(q[m][0][j]));
              o[16] = f2bf(gelu_tanh(q[m][1][j]));
            }
        }
      } else if constexpr (EPI == EPI_RESID || EPI == EPI_RESID0) {
        const float* g = p->mod + ((size_t)layer * 9 + tok_batch(brow)) * 6144 + 2048 + c0 + fr;
        const float g0 = g[0], g1 = g[16];
        const float* xin = (brow < TL) ? p->x : p->ctx - (size_t)TL * D;
#pragma unroll
        for (int m = 0; m < 4; ++m)
#pragma unroll
          for (int j = 0; j < 4; ++j) {
            const size_t ro = (size_t)(r0 + m * 16 + fq * 4 + j) * D + c0 + fr;
            float* o = p->xs + ro;
            const float* xi = (EPI == EPI_RESID0) ? xin + ro : o;
            o[0] = xi[0] + g0 * q[m][0][j];
            o[16] = xi[16] + g1 * q[m][1][j];
          }
      } else if constexpr (EPI == EPI_INPROJ) {
        if (c0 >= 640 && c0 < 768) {
          const int kvh = (c0 - 640) >> 6, d0 = (c0 - 640) & 63;
#pragma unroll
          for (int m = 0; m < 4; ++m) {
            int row0 = r0 + m * 16;
            bool latent = row0 < TL;
            int b = latent ? (row0 >> 12) : ((row0 - TL) >> 8);
            int kp16 = latent ? (CTX + (row0 & 4095)) : ((row0 - TL) & 255);
            int slot = kp16 + 8 * (fq & 1) + 4 * (fq >> 1);
#pragma unroll
            for (int n = 0; n < 2; ++n) {
              int dim = d0 + n * 16 + fr;
              uint2 o;
              o.x = pack2(q[m][n][0], q[m][n][1]);
              o.y = pack2(q[m][n][2], q[m][n][3]);
              *reinterpret_cast<uint2*>(p->vbuf + ((size_t)(b * 2 + kvh) * 64 + dim) * KVLEN + slot) = o;
            }
          }
        } else {
          const int hsel = (c0 >> 5) & 1;
#pragma unroll
          for (int m = 0; m < 4; ++m)
#pragma unroll
            for (int j = 0; j < 4; ++j) {
              int row = r0 + m * 16 + fq * 4 + j;
              bool latent = row < TL;
              int b, pos;
              if (latent) {
                b = row >> 12;
                pos = row & 4095;
              } else {
                b = (row - TL) >> 8;
                pos = (row - TL) & 255;
              }
              float v0 = q[m][0][j], v1 = q[m][1][j];
              if (latent && c0 < 640) {
                float2 cs = p->cs[(hsel ? (pos & 63) : (pos >> 6)) * 16 + fr];
                float a = v0, bb = v1;
                v0 = a * cs.x - bb * cs.y;
                v1 = bb * cs.x + a * cs.y;
              }
              bf16_t* o;
              if (c0 < 512 || c0 >= 768) {
                o = p->P + (size_t)row * 2048 + c0 + fr;
              } else {
                int kvh = (c0 - 512) >> 6, d0 = (c0 - 512) & 63;
                int kp = latent ? (CTX + pos) : pos;
                o = p->kbuf + ((size_t)(b * 2 + kvh) * KVLEN + kp) * 64 + d0 + fr;
              }
              o[0] = f2bf(v0);
              o[16] = f2bf(v1);
            }
        }
      }
      __builtin_amdgcn_sched_barrier(0);
    }
}

DEVI int g8_perm32(int rho) { const int n = rho >> 4, i = rho & 15; return 8 * (i >> 2) + 4 * n + (i & 3); }
template <int EPI>
DEVI void gemm8_epilogue_tr(PP p, f32x4 (&acc)[2][2][4][2], int brow, int bcol, int wr, int wc, int fr, int fq, int layer, float gscale) {
  if constexpr (EPI == EPI_STORE) {
#pragma unroll
    for (int ai = 0; ai < 2; ++ai)
#pragma unroll
      for (int m = 0; m < 4; ++m) {
        bf16_t* o = p->P + (size_t)(brow + ai * 128 + wr * 64 + m * 16 + fr) * 2048 + bcol + wc * 32 + 8 * fq;
#pragma unroll
        for (int bj = 0; bj < 2; ++bj) {
          const f32x4 v0 = acc[ai][bj][m][0], v1 = acc[ai][bj][m][1];
          uint4 w;
          w.x = pack2(v0[0], v0[1]);
          w.y = pack2(v0[2], v0[3]);
          w.z = pack2(v1[0], v1[1]);
          w.w = pack2(v1[2], v1[3]);
          *reinterpret_cast<uint4*>(o + bj * 128) = w;
        }
      }
  } else if constexpr (EPI == EPI_RESID || EPI == EPI_RESID0) {
    const float* xin = (brow < TL) ? p->x : p->ctx - (size_t)TL * D;
    const unsigned loff = (unsigned)(fr * D + 4 * fq);
#pragma unroll
    for (int bj = 0; bj < 2; ++bj) {
      const int ucol = bcol + bj * 128 + wc * 32;
      const float* g = p->mod + ((size_t)layer * 9 + tok_batch(brow)) * 6144 + 2048 + ucol + 4 * fq;
      const f32x4 g0 = *reinterpret_cast<const f32x4*>(g) * gscale, g1 = *reinterpret_cast<const f32x4*>(g + 16) * gscale;
      f32x4 xr[2][4][2];
#pragma unroll
      for (int ai = 0; ai < 2; ++ai)
#pragma unroll
        for (int m = 0; m < 4; ++m) {
          const size_t ro = (size_t)(brow + ai * 128 + wr * 64 + m * 16) * D + ucol;
          const float* xi = ((EPI == EPI_RESID0) ? xin : p->xs) + ro;
          xr[ai][m][0] = *reinterpret_cast<const f32x4*>(xi + loff);
          xr[ai][m][1] = *reinterpret_cast<const f32x4*>(xi + loff + 16);
        }
      __builtin_amdgcn_sched_barrier(0);
#pragma unroll
      for (int ai = 0; ai < 2; ++ai)
#pragma unroll
        for (int m = 0; m < 4; ++m) {
          float* o = p->xs + (size_t)(brow + ai * 128 + wr * 64 + m * 16) * D + ucol;
          *reinterpret_cast<f32x4*>(o + loff) = xr[ai][m][0] + g0 * acc[ai][bj][m][0];
          *reinterpret_cast<f32x4*>(o + loff + 16) = xr[ai][m][1] + g1 * acc[ai][bj][m][1];
        }
      __builtin_amdgcn_sched_barrier(0);
    }
  } else if constexpr (EPI == EPI_INPROJ) {
    const bool latent = brow < TL;
#pragma unroll
    for (int bj = 0; bj < 2; ++bj) {
      const int c0 = bcol + bj * 128 + wc * 32;
      if (c0 >= 640 && c0 < 768) {
        const int kvh = (c0 - 640) >> 6, d0 = ((c0 - 640) & 63) + 4 * fq;
        const int so = 8 * ((fr >> 2) & 1) + 4 * (fr >> 3) + (fr & 3);
#pragma unroll
        for (int ai = 0; ai < 2; ++ai)
#pragma unroll
          for (int m = 0; m < 4; ++m) {
            const int row0 = brow + ai * 128 + wr * 64 + m * 16;
            const int b = latent ? (row0 >> 12) : ((row0 - TL) >> 8);
            const int kp16 = latent ? (CTX + (row0 & 4095)) : ((row0 - TL) & 255);
            bf16_t* o = p->vbuf + ((size_t)(b * 2 + kvh) * 64 + d0) * KVLEN + kp16 + so;
#pragma unroll
            for (int n = 0; n < 2; ++n)
#pragma unroll
              for (int j = 0; j < 4; ++j) o[(size_t)(n * 16 + j) * KVLEN] = f2bf(acc[ai][bj][m][n][j]);
          }
      } else {
        const int hsel = (c0 >> 5) & 1;
#pragma unroll
        for (int ai = 0; ai < 2; ++ai)
#pragma unroll
          for (int m = 0; m < 4; ++m) {
            const int row = brow + ai * 128 + wr * 64 + m * 16 + fr;
            const int b = latent ? (row >> 12) : ((row - TL) >> 8);
            const int pos = latent ? (row & 4095) : ((row - TL) & 255);
            f32x4 v0 = acc[ai][bj][m][0], v1 = acc[ai][bj][m][1];
            if (latent && c0 < 640) {
              const f32x4* cp = reinterpret_cast<const f32x4*>(p->cs + (hsel ? (pos & 63) : (pos >> 6)) * 16 + 4 * fq);
              const f32x4 ca = cp[0], cb = cp[1];
              const f32x4 a = v0, bb = v1;
              v0[0] = a[0] * ca[0] - bb[0] * ca[1];
              v1[0] = bb[0] * ca[0] + a[0] * ca[1];
              v0[1] = a[1] * ca[2] - bb[1] * ca[3];
              v1[1] = bb[1] * ca[2] + a[1] * ca[3];
              v0[2] = a[2] * cb[0] - bb[2] * cb[1];
              v1[2] = bb[2] * cb[0] + a[2] * cb[1];
              v0[3] = a[3] * cb[2] - bb[3] * cb[3];
              v1[3] = bb[3] * cb[2] + a[3] * cb[3];
            }
            bf16_t* o;
            if (c0 < 512 || c0 >= 768) {
              o = p->P + (size_t)row * 2048 + c0 + 4 * fq;
            } else {
              const int kvh = (c0 - 512) >> 6, d0 = (c0 - 512) & 63;
              const int kp = latent ? (CTX + pos) : pos;
              o = p->kbuf + ((size_t)(b * 2 + kvh) * KVLEN + kp) * 64 + d0 + 4 * fq;
            }
            uint2 w0, w1;
            w0.x = pack2(v0[0], v0[1]);
            w0.y = pack2(v0[2], v0[3]);
            w1.x = pack2(v1[0], v1[1]);
            w1.y = pack2(v1[2], v1[3]);
            *reinterpret_cast<uint2*>(o) = w0;
            *reinterpret_cast<uint2*>(o + 16) = w1;
          }
      }
      __builtin_amdgcn_sched_barrier(0);
    }
  }
}

template <int EPI>
DEVI void gemm8_phase(PP p, const bf16_t* __restrict__ A, int lda, const bf16_t* __restrict__ Bt, int ldb, int Mtiles, int Ntiles,
                      int K, int layer, unsigned char* lds_all, float gscale = 1.f) {
  constexpr bool TR = (EPI != EPI_GELU);
  constexpr bool PERM = (EPI == EPI_STORE);
  bf16_t* shm = reinterpret_cast<bf16_t*>(lds_all);
  const int tid = ptid();
  const int wid = __builtin_amdgcn_readfirstlane(tid >> 6), lane = tid & 63, wr = wid >> 2, wc = wid & 3, fr = lane & 15, fq = lane >> 4;
#define G8_SA(b, h) (shm + ((b) * 2 + (h)) * G8_HT)
#define G8_SB(b, h) (shm + (4 + (b) * 2 + (h)) * G8_HT)
  const __amdgpu_buffer_rsrc_t rsA = __builtin_amdgcn_make_buffer_rsrc((void*)A, (short)0, -1, 0x00020000);
  const __amdgpu_buffer_rsrc_t rsB = __builtin_amdgcn_make_buffer_rsrc((void*)Bt, (short)0, -1, 0x00020000);
  unsigned voA[2], voB[2];
#pragma unroll
  for (int i = 0; i < 2; ++i) {
    int r_, c_;
    g8_stage_rc(tid * 16 + i * 8192, r_, c_);
    const int rb_ = PERM ? ((r_ & ~31) + g8_perm32(r_ & 31)) : r_;
    voA[i] = (unsigned)((r_ * lda + c_) * 2);
    voB[i] = (unsigned)((rb_ * ldb + c_) * 2);
  }
#define G8_STAGE(P_, RS_, VO_, ld_, br_, kt_)                                                                         \
  do {                                                                                                                \
    const unsigned so_ = (unsigned)(((br_) * (ld_) + (kt_) * 64) * 2);                                                \
    _Pragma("unroll") for (int i_ = 0; i_ < 2; ++i_)                                                                  \
      __builtin_amdgcn_raw_ptr_buffer_load_lds(RS_, (__attribute__((address_space(3))) void*)((unsigned char*)(P_) + wid * 1024 + i_ * 8192), 16, VO_[i_], so_, 0, 0); \
  } while (0)
#define G8_LDA(dst, b, h)                                                                                             \
  _Pragma("unroll") for (int m_ = 0; m_ < 4; ++m_) _Pragma("unroll") for (int k_ = 0; k_ < 2; ++k_)                   \
      dst[m_][k_] = *reinterpret_cast<const bf16x8*>((const unsigned char*)G8_SA(b, h) + g8_lds_byte(wr * 64 + m_ * 16 + fr, k_ * 32 + fq * 8))
#define G8_LDB(dst, b, h)                                                                                             \
  _Pragma("unroll") for (int n_ = 0; n_ < 2; ++n_) _Pragma("unroll") for (int k_ = 0; k_ < 2; ++k_)                   \
      dst[n_][k_] = *reinterpret_cast<const bf16x8*>((const unsigned char*)G8_SB(b, h) + g8_lds_byte(wc * 32 + n_ * 16 + fr, k_ * 32 + fq * 8))
#define G8_MMA(ai, bj, At_, Bt_)                                                                                      \
  do {                                                                                                                \
    __builtin_amdgcn_s_setprio(1);                                                                                    \
    _Pragma("unroll") for (int m_ = 0; m_ < 4; ++m_) _Pragma("unroll") for (int n_ = 0; n_ < 2; ++n_)                 \
        _Pragma("unroll") for (int k_ = 0; k_ < 2; ++k_) acc[ai][bj][m_][n_] =                                        \
            TR ? __builtin_amdgcn_mfma_f32_16x16x32_bf16(Bt_[n_][k_], At_[m_][k_], acc[ai][bj][m_][n_], 0, 0, 0)      \
               : __builtin_amdgcn_mfma_f32_16x16x32_bf16(At_[m_][k_], Bt_[n_][k_], acc[ai][bj][m_][n_], 0, 0, 0);     \
    __builtin_amdgcn_s_setprio(0);                                                                                    \
  } while (0)
#define G8_WAIT_V(n) asm volatile("s_waitcnt vmcnt(" #n ")" ::: "memory")
#define G8_WAIT_L(n) asm volatile("s_waitcnt lgkmcnt(" #n ")" ::: "memory")
#define G8_BAR __builtin_amdgcn_s_barrier()
#define G8_SCHED __builtin_amdgcn_sched_barrier(0)
  const int nblk = pnblk(), bid = pbid();
  const int lb = ((nblk & 7) == 0) ? ((bid & 7) * (nblk >> 3) + (bid >> 3)) : bid;
  const int ntiles_all = Mtiles * Ntiles;
  const int ntiles = (ntiles_all / nblk) * nblk;
  const int nt = K / 64;
  if (lb < ntiles) {
    int t = lb;
    int brow = (t / Ntiles) * 256, bcol = (t % Ntiles) * 256;
    f32x4 acc[2][2][4][2];
#pragma unroll
    for (int a0 = 0; a0 < 2; ++a0)
#pragma unroll
      for (int b0 = 0; b0 < 2; ++b0)
#pragma unroll
        for (int m = 0; m < 4; ++m)
#pragma unroll
          for (int n = 0; n < 2; ++n) acc[a0][b0][m][n] = f32x4{0.f, 0.f, 0.f, 0.f};
    bf16x8 At[4][2], B0[2][2], B1[2][2];
    G8_STAGE(G8_SB(0, 0), rsB, voB, ldb, bcol, 0);
    G8_STAGE(G8_SA(0, 0), rsA, voA, lda, brow, 0);
    G8_STAGE(G8_SB(0, 1), rsB, voB, ldb, bcol + 128, 0);
    G8_STAGE(G8_SA(0, 1), rsA, voA, lda, brow + 128, 0);
    if (wr == 1) G8_BAR;
    G8_WAIT_V(4);
    G8_BAR;
    G8_STAGE(G8_SB(1, 0), rsB, voB, ldb, bcol, 1);
    G8_STAGE(G8_SA(1, 0), rsA, voA, lda, brow, 1);
    G8_STAGE(G8_SB(1, 1), rsB, voB, ldb, bcol + 128, 1);
    G8_WAIT_V(6);
    G8_BAR;
    for (;;) {
      const int tnx = t + nblk;
      const bool has_next = tnx < ntiles;
      const int nbrow = has_next ? (tnx / Ntiles) * 256 : brow, nbcol = has_next ? (tnx % Ntiles) * 256 : bcol;
      for (int kt = 0; kt < nt; kt += 2) {
        const bool last = (kt == nt - 2);
        const int a2 = last ? nbrow : brow, b2 = last ? nbcol : bcol, k2 = last ? 0 : kt + 2;
        G8_LDB(B0, 0, 0); G8_SCHED; G8_LDA(At, 0, 0); G8_STAGE(G8_SA(1, 1), rsA, voA, lda, brow + 128, kt + 1);
        G8_WAIT_L(8); G8_BAR; G8_WAIT_L(0); G8_MMA(0, 0, At, B0); G8_BAR; G8_SCHED;
        G8_LDB(B1, 0, 1); G8_STAGE(G8_SB(0, 0), rsB, voB, ldb, b2, k2);
        G8_BAR; G8_WAIT_L(0); G8_MMA(0, 1, At, B1); G8_BAR;
        G8_LDA(At, 0, 1); G8_STAGE(G8_SA(0, 0), rsA, voA, lda, a2, k2);
        G8_BAR; G8_WAIT_L(0); G8_MMA(1, 0, At, B0); G8_BAR; G8_SCHED;
        G8_STAGE(G8_SB(0, 1), rsB, voB, ldb, b2 + 128, k2);
        G8_WAIT_V(6); G8_BAR; G8_MMA(1, 1, At, B1); G8_BAR;
        G8_LDB(B0, 1, 0); G8_SCHED; G8_LDA(At, 1, 0); G8_STAGE(G8_SA(0, 1), rsA, voA, lda, a2 + 128, k2);
        G8_WAIT_L(8); G8_BAR; G8_WAIT_L(0); G8_MMA(0, 0, At, B0); G8_BAR; G8_SCHED;
        G8_LDB(B1, 1, 1); G8_STAGE(G8_SB(1, 0), rsB, voB, ldb, b2, k2 + 1);
        G8_BAR; G8_WAIT_L(0); G8_MMA(0, 1, At, B1); G8_BAR;
        G8_LDA(At, 1, 1); G8_STAGE(G8_SA(1, 0), rsA, voA, lda, a2, k2 + 1);
        G8_BAR; G8_WAIT_L(0); G8_MMA(1, 0, At, B0); G8_BAR; G8_SCHED;
        G8_STAGE(G8_SB(1, 1), rsB, voB, ldb, b2 + 128, k2 + 1);
        G8_WAIT_V(6); G8_BAR; G8_MMA(1, 1, At, B1); G8_BAR;
      }
      {
        int lane2 = lane_id();
        asm volatile("" : "+v"(lane2));
        const int fr2 = lane2 & 15, fq2 = lane2 >> 4;
        if constexpr (TR) gemm8_epilogue_tr<EPI>(p, acc, brow, bcol, wr, wc, fr2, fq2, layer, gscale);
        else gemm8_epilogue<EPI, false>(p, acc, nullptr, lane2, brow, bcol, wr, wc, fr2, fq2, layer, gscale);
      }
      if (!has_next) break;
#pragma unroll
      for (int a0 = 0; a0 < 2; ++a0)
#pragma unroll
        for (int b0 = 0; b0 < 2; ++b0)
#pragma unroll
          for (int m = 0; m < 4; ++m)
#pragma unroll
            for (int n = 0; n < 2; ++n) acc[a0][b0][m][n] = f32x4{0.f, 0.f, 0.f, 0.f};
      t = tnx;
      brow = nbrow;
      bcol = nbcol;
    }
    G8_WAIT_V(0);
    if (wr == 0) G8_BAR;
  }
  __syncthreads();
  if (ntiles < ntiles_all) {
    constexpr int EPI_T = (EPI == EPI_RESID0) ? EPI_RESID : EPI;
    gemm_phase<EPI_T>(p, A, lda, Bt, ldb, 0, 0, K, layer, lds_all + (wid >> 2) * LDS_HALF, gscale, ntiles, ntiles_all - ntiles, Ntiles);
  }
#undef G8_SA
#undef G8_SB
#undef G8_STAGE
#undef G8_LDA
#undef G8_LDB
#undef G8_MMA
#undef G8_WAIT_V
#undef G8_WAIT_L
#undef G8_BAR
#undef G8_SCHED
}

DEVI bf16x8 scale_q(uint4 u) {
  uint4 r;
  r.x = pack2(bflo(u.x) * 0.125f, bfhi(u.x) * 0.125f);
  r.y = pack2(bflo(u.y) * 0.125f, bfhi(u.y) * 0.125f);
  r.z = pack2(bflo(u.z) * 0.125f, bfhi(u.z) * 0.125f);
  r.w = pack2(bflo(u.w) * 0.125f, bfhi(u.w) * 0.125f);
  return __builtin_bit_cast(bf16x8, r);
}
DEVI void phase_attn(PP p, int layer, bool with_ctx_q, unsigned char* lds) {
  const int tid = ltid();
  const int lane = tid & 63, wid = __builtin_amdgcn_readfirstlane(tid >> 6), r = lane & 31, h = lane >> 5;
  const float* sinkp = p->attn_sink + (layer >> 1) * 8;
  const int nlat = NB * 2 * 128;
  const int nunits = nlat + (with_ctx_q ? NB * 2 * 8 : 0);
  for (int u = lbid(); u < nunits; u += lnblk()) {
    bool latent = u < nlat;
    int b, kvh, qg, tokbase;
    if (latent) {
      b = u >> 8;
      kvh = (u >> 7) & 1;
      qg = u & 127;
      tokbase = b * SEQ + qg * 32;
    } else {
      int v = u - nlat;
      b = v >> 4;
      kvh = (v >> 3) & 1;
      qg = v & 7;
      tokbase = TL + b * CTX + qg * 32;
    }
    const int hd = kvh * 4 + wid;
    const bf16_t* kb = p->kbuf + (size_t)(b * 2 + kvh) * KVLEN * 64;
    const bf16_t* vt = p->vbuf + (size_t)(b * 2 + kvh) * 64 * KVLEN;
    const int nch = latent ? 5 : 2;
    const int lbase = CTX + (qg - 4) * 32;
#define ATT_STAGE(c_, buf_)                                                                                           \
  {                                                                                                                   \
    const int kp0_ = ((c_) < 2) ? (c_) * 128 : lbase + ((c_) - 2) * 128;                                              \
    _Pragma("unroll") for (int i_ = 0; i_ < 4; ++i_) {                                                                \
      const int P_ = tid * 16 + i_ * 4096;                                                                            \
      const int krow_ = P_ >> 7, kslot_ = (P_ >> 4) & 7;                                                              \
      int kp_ = kp0_ + krow_;                                                                                         \
      kp_ = kp_ < 0 ? 0 : (kp_ > KVLEN - 1 ? KVLEN - 1 : kp_);                                                        \
      __builtin_amdgcn_global_load_lds((const unsigned*)(kb + (size_t)kp_ * 64 + ((kslot_ ^ ((krow_ >> 1) & 7)) << 3)), \
                                       (__attribute__((address_space(3))) unsigned*)(lds + (buf_) * 32768 + P_), 16, 0, 0); \
      const int vrow_ = P_ >> 8, vslot_ = (P_ >> 4) & 15;                                                             \
      int vp_ = kp0_ + ((vslot_ ^ (vrow_ & 15)) << 3);                                                                \
      vp_ = vp_ < 0 ? 0 : (vp_ > KVLEN - 8 ? KVLEN - 8 : vp_);                                                        \
      __builtin_amdgcn_global_load_lds((const unsigned*)(vt + (size_t)vrow_ * KVLEN + vp_),                           \
                                       (__attribute__((address_space(3))) unsigned*)(lds + (buf_) * 32768 + 16384 + P_), 16, 0, 0); \
    }                                                                                                                 \
  }
    __syncthreads();
    ATT_STAGE(0, 0)
    bf16x8 qf[4];
    {
      const bf16_t* qp = p->P + (size_t)(tokbase + r) * 2048 + hd * 64 + 8 * h;
#pragma unroll
      for (int st = 0; st < 4; ++st) qf[st] = scale_q(*reinterpret_cast<const uint4*>(qp + 16 * st));
    }
    f32x16 O0, O1;
#pragma unroll
    for (int i = 0; i < 16; ++i) {
      O0[i] = 0.f;
      O1[i] = 0.f;
    }
    float m_run = sinkp[hd];
    float l_run = (h == 0) ? 1.f : 0.f;
    for (int c = 0; c < nch; ++c) {
      const int buf = c & 1;
      asm volatile("s_waitcnt vmcnt(0)" ::: "memory");
      __syncthreads();
      if (c + 1 < nch) ATT_STAGE(c + 1, buf ^ 1)
      const unsigned char* LK = lds + buf * 32768;
      const unsigned char* LV = LK + 16384;
#pragma unroll 1
      for (int kbi = 0; kbi < 4; ++kbi) {
        int mode = 0;
        if (c >= 2) {
          const int d = (c - 2) * 4 + kbi - 4;
          const int kblk = qg + d;
          if (d > 4 || kblk < 0 || kblk > 127) continue;
          mode = (d == -4) ? 1 : ((d == 4) ? 2 : 0);
        }
        f32x16 S;
#pragma unroll
        for (int i = 0; i < 16; ++i) S[i] = 0.f;
        {
          const int krow = kbi * 32 + r;
#pragma unroll
          for (int st = 0; st < 4; ++st) {
            bf16x8 kf = *reinterpret_cast<const bf16x8*>(LK + krow * 128 + (((2 * st + h) ^ ((krow >> 1) & 7)) << 4));
            S = __builtin_amdgcn_mfma_f32_32x32x16_bf16(kf, qf[st], S, 0, 0, 0);
          }
        }
        if (mode) {
          float negbig;
          asm volatile("v_mov_b32 %0, 0xf149f2ca" : "=v"(negbig));
#pragma unroll
          for (int i = 0; i < 16; ++i) {
            int kk = (i & 3) + 8 * (i >> 2) + 4 * h;
            bool ok = (mode == 1) ? (kk >= r) : (kk <= r);
            if (!ok) S[i] = negbig;
          }
        }
        float bm = S[0];
#pragma unroll
        for (int i = 1; i < 16; ++i) bm = fmaxf(bm, S[i]);
        bm = fmaxf(bm, shx_f(bm, 32));
        float m_new = fmaxf(m_run, bm);
        const float L2E = 1.4426950408889634f;
        float nm = -m_new * L2E;
        float psum = 0.f;
#pragma unroll
        for (int i = 0; i < 16; ++i) {
          S[i] = __builtin_amdgcn_exp2f(fmaf(S[i], L2E, nm));
          psum += S[i];
        }
        if (__any(m_new > m_run)) {
          float alpha = __builtin_amdgcn_exp2f((m_run - m_new) * L2E);
          l_run *= alpha;
#pragma unroll
          for (int i = 0; i < 16; ++i) {
            O0[i] *= alpha;
            O1[i] *= alpha;
          }
        }
        l_run += psum;
        m_run = m_new;
#pragma unroll
        for (int sidx = 0; sidx < 2; ++sidx) {
          uint4 pk;
          pk.x = pack2(S[8 * sidx + 0], S[8 * sidx + 1]);
          pk.y = pack2(S[8 * sidx + 2], S[8 * sidx + 3]);
          pk.z = pack2(S[8 * sidx + 4], S[8 * sidx + 5]);
          pk.w = pack2(S[8 * sidx + 6], S[8 * sidx + 7]);
          bf16x8 pf = __builtin_bit_cast(bf16x8, pk);
          const int vch = 4 * kbi + 2 * sidx + h;
          bf16x8 v0 = *reinterpret_cast<const bf16x8*>(LV + r * 256 + ((vch ^ (r & 15)) << 4));
          bf16x8 v1 = *reinterpret_cast<const bf16x8*>(LV + (32 + r) * 256 + ((vch ^ (r & 15)) << 4));
          O0 = __builtin_amdgcn_mfma_f32_32x32x16_bf16(v0, pf, O0, 0, 0, 0);
          O1 = __builtin_amdgcn_mfma_f32_32x32x16_bf16(v1, pf, O1, 0, 0, 0);
        }
      }
    }
#undef ATT_STAGE
    float l_tot = l_run + shx_f(l_run, 32);
    float inv = 1.f / l_tot;
    bf16_t* op = p->mix + (size_t)(tokbase + r) * LDMIX + hd * 64 + 4 * h;
#pragma unroll
    for (int g4 = 0; g4 < 4; ++g4) {
      uint2 o;
      o.x = pack2(O0[4 * g4 + 0] * inv, O0[4 * g4 + 1] * inv);
      o.y = pack2(O0[4 * g4 + 2] * inv, O0[4 * g4 + 3] * inv);
      *reinterpret_cast<uint2*>(op + 8 * g4) = o;
      o.x = pack2(O1[4 * g4 + 0] * inv, O1[4 * g4 + 1] * inv);
      o.y = pack2(O1[4 * g4 + 2] * inv, O1[4 * g4 + 3] * inv);
      *reinterpret_cast<uint2*>(op + 32 + 8 * g4) = o;
    }
  }
  __syncthreads();
}

DEVI void fill_tw(float2* tw, int n) {
  for (int i = ltid(); i < n; i += NTHREADS) {
    float sn, cn;
    sincospif(2.f * (float)i / (float)n, &sn, &cn);
    tw[i] = make_float2(cn, sn);
  }
  __syncthreads();
}

DEVI bf16x8 lds_col8(const bf16_t* bp, int stride) {
  unsigned e0 = bp[0], e1 = bp[stride], e2 = bp[2 * stride], e3 = bp[3 * stride];
  unsigned e4 = bp[4 * stride], e5 = bp[5 * stride], e6 = bp[6 * stride], e7 = bp[7 * stride];
  uint4 pk;
  pk.x = e0 | (e1 << 16);
  pk.y = e2 | (e3 << 16);
  pk.z = e4 | (e5 << 16);
  pk.w = e6 | (e7 << 16);
  return __builtin_bit_cast(bf16x8, pk);
}

DEVI void phase_fft_a(PP p, unsigned char* lds) {
  const int tid = ltid();
  const int lane = tid & 63, wid = __builtin_amdgcn_readfirstlane(tid >> 6), fr = lane & 15, fq = lane >> 4;
  float2* tw = reinterpret_cast<float2*>(lds + 66560);
  fill_tw(tw, 64);
  bf16x8 af[2][2];
#pragma unroll
  for (int ks = 0; ks < 2; ++ks) {
    unsigned short cr[8], ci[8];
#pragma unroll
    for (int j = 0; j < 8; ++j) {
      int n1 = 32 * ks + 8 * fq + j, k1 = 16 * wid + fr;
      float2 t = tw[(k1 * n1) & 63];
      cr[j] = f2bf(t.x);
      ci[j] = f2bf(-t.y);
    }
    uint4 a0, a1;
    a0.x = cr[0] | ((unsigned)cr[1] << 16); a0.y = cr[2] | ((unsigned)cr[3] << 16);
    a0.z = cr[4] | ((unsigned)cr[5] << 16); a0.w = cr[6] | ((unsigned)cr[7] << 16);
    a1.x = ci[0] | ((unsigned)ci[1] << 16); a1.y = ci[2] | ((unsigned)ci[3] << 16);
    a1.z = ci[4] | ((unsigned)ci[5] << 16); a1.w = ci[6] | ((unsigned)ci[7] << 16);
    af[0][ks] = __builtin_bit_cast(bf16x8, a0);
    af[1][ks] = __builtin_bit_cast(bf16x8, a1);
  }
  const bf16_t* l16 = reinterpret_cast<const bf16_t*>(lds);
  for (int u = lbid(); u < NB * 64; u += lnblk()) {
    int b = u >> 6, n2 = u & 63;
    __syncthreads();
#pragma unroll
    for (int i = 0; i < 16; ++i) {
      int row = (tid >> 6) + 4 * i, piece = tid & 63;
      uint4 v = *reinterpret_cast<const uint4*>(p->P + (size_t)(b * SEQ + 64 * row + n2) * 2048 + 768 + piece * 8);
      *reinterpret_cast<uint4*>(lds + row * 1040 + piece * 16) = v;
    }
    __syncthreads();
    float tc[4], ts[4];
#pragma unroll
    for (int j = 0; j < 4; ++j) sincospif((float)(n2 * (16 * wid + 4 * fq + j)) / 2048.f, &ts[j], &tc[j]);
    for (int nb = 0; nb < 4; ++nb) {
      f32x4 acc[2][8];
#pragma unroll
      for (int n = 0; n < 8; ++n) {
        acc[0][n] = f32x4{0.f, 0.f, 0.f, 0.f};
        acc[1][n] = f32x4{0.f, 0.f, 0.f, 0.f};
      }
#pragma unroll
      for (int ks = 0; ks < 2; ++ks)
#pragma unroll
        for (int nf = 0; nf < 8; ++nf) {
          bf16x8 bfr = lds_col8(l16 + (32 * ks + 8 * fq) * 520 + 128 * nb + 16 * nf + fr, 520);
          acc[0][nf] = __builtin_amdgcn_mfma_f32_16x16x32_bf16(af[0][ks], bfr, acc[0][nf], 0, 0, 0);
          acc[1][nf] = __builtin_amdgcn_mfma_f32_16x16x32_bf16(af[1][ks], bfr, acc[1][nf], 0, 0, 0);
        }
#pragma unroll
      for (int j = 0; j < 4; ++j) {
        int k1 = 16 * wid + 4 * fq + j;
        bf16_t* o = p->fa + (size_t)(b * SEQ + k1 * 64 + n2) * 1024 + 128 * nb + fr;
#pragma unroll
        for (int nf = 0; nf < 8; ++nf) {
          float re = acc[0][nf][j], im = acc[1][nf][j];
          o[16 * nf] = f2bf(re * tc[j] + im * ts[j]);
          o[512 + 16 * nf] = f2bf(im * tc[j] - re * ts[j]);
        }
      }
    }
  }
  __syncthreads();
}

DEVI void phase_fft_b(PP p, unsigned char* lds) {
  const int tid = ltid();
  const int lane = tid & 63, wid = __builtin_amdgcn_readfirstlane(tid >> 6), fr = lane & 15, fq = lane >> 4;
  float2* tw = reinterpret_cast<float2*>(lds + 67584);
  fill_tw(tw, 64);
  bf16x8 wb[2][4];
#pragma unroll
  for (int ks = 0; ks < 4; ++ks) {
    unsigned short zr[8], zi[8];
#pragma unroll
    for (int j = 0; j < 8; ++j) {
      int k = 32 * ks + 8 * fq + j, part = k >> 6, n2 = k & 63, k2 = 16 * wid + fr;
      float2 t = tw[(k2 * n2) & 63];
      zr[j] = f2bf(part ? t.y : t.x);
      zi[j] = f2bf(part ? t.x : -t.y);
    }
    uint4 a0, a1;
    a0.x = zr[0] | ((unsigned)zr[1] << 16); a0.y = zr[2] | ((unsigned)zr[3] << 16);
    a0.z = zr[4] | ((unsigned)zr[5] << 16); a0.w = zr[6] | ((unsigned)zr[7] << 16);
    a1.x = zi[0] | ((unsigned)zi[1] << 16); a1.y = zi[2] | ((unsigned)zi[3] << 16);
    a1.z = zi[4] | ((unsigned)zi[5] << 16); a1.w = zi[6] | ((unsigned)zi[7] << 16);
    wb[0][ks] = __builtin_bit_cast(bf16x8, a0);
    wb[1][ks] = __builtin_bit_cast(bf16x8, a1);
  }
  const bf16_t* l16 = reinterpret_cast<const bf16_t*>(lds);
  const float scale = 0.0013810679320049757f;
  for (int u = lbid(); u < NB * 128; u += lnblk()) {
    int b = u >> 7, k1 = (u >> 1) & 63, hf = u & 1;
    __syncthreads();
#pragma unroll
    for (int i = 0; i < 16; ++i) {
      int row = (tid >> 5) + 8 * i, piece = tid & 31;
      int part = row >> 6, n2 = row & 63;
      uint4 v = *reinterpret_cast<const uint4*>(p->fa + (size_t)(b * SEQ + k1 * 64 + n2) * 1024 + part * 512 + hf * 256 + piece * 8);
      *reinterpret_cast<uint4*>(lds + row * 528 + piece * 16) = v;
    }
    __syncthreads();
    for (int nb = 0; nb < 2; ++nb) {
      f32x4 acc[2][8];
#pragma unroll
      for (int n = 0; n < 8; ++n) {
        acc[0][n] = f32x4{0.f, 0.f, 0.f, 0.f};
        acc[1][n] = f32x4{0.f, 0.f, 0.f, 0.f};
      }
#pragma unroll
      for (int ks = 0; ks < 4; ++ks)
#pragma unroll
        for (int nf = 0; nf < 8; ++nf) {
          bf16x8 bfr = lds_col8(l16 + (32 * ks + 8 * fq) * 264 + 128 * nb + 16 * nf + fr, 264);
          acc[0][nf] = __builtin_amdgcn_mfma_f32_16x16x32_bf16(wb[0][ks], bfr, acc[0][nf], 0, 0, 0);
          acc[1][nf] = __builtin_amdgcn_mfma_f32_16x16x32_bf16(wb[1][ks], bfr, acc[1][nf], 0, 0, 0);
        }
#pragma unroll
      for (int j = 0; j < 4; ++j) {
        int k2 = 16 * wid + 4 * fq + j;
        bf16_t* o = p->mix + (size_t)(b * SEQ + k1 + 64 * k2) * LDMIX + 512 + hf * 256 + 128 * nb + fr;
#pragma unroll
        for (int nf = 0; nf < 8; ++nf) {
          o[16 * nf] = f2bf(acc[0][nf][j] * scale);
          o[512 + 16 * nf] = f2bf(acc[1][nf][j] * scale);
        }
      }
    }
  }
  __syncthreads();
}

DEVI void phase_dft_ctx(PP p, unsigned char* lds) {
  float2* tw = reinterpret_cast<float2*>(lds);
  fill_tw(tw, 256);
  int tid = ltid();
  const float scale = 0.005524271728019903f;
  for (int u = lbid(); u < NB * 64; u += lnblk()) {
    int b = u >> 6, k0 = (u & 63) * 4;
    for (int pass = 0; pass < 2; ++pass) {
      int ch = tid + pass * 256;
      float zr[4], zi[4];
#pragma unroll
      for (int kk = 0; kk < 4; ++kk) zr[kk] = zi[kk] = 0.f;
#pragma unroll 8
      for (int n = 0; n < 256; ++n) {
        float v = bf2f(p->P[(size_t)(TL + b * CTX + n) * 2048 + 768 + ch]);
#pragma unroll
        for (int kk = 0; kk < 4; ++kk) {
          float2 t = tw[(n * (k0 + kk)) & 255];
          zr[kk] += v * t.x;
          zi[kk] -= v * t.y;
        }
      }
#pragma unroll
      for (int kk = 0; kk < 4; ++kk) {
        bf16_t* o = p->mix + (size_t)(TL + b * CTX + k0 + kk) * LDMIX;
        o[512 + ch] = f2bf(zr[kk] * scale);
        o[1024 + ch] = f2bf(zi[kk] * scale);
      }
    }
  }
  __syncthreads();
}

DEVI void phase_sgu(PP p, int j, int nchunks, unsigned char* lds) {
  float* rs = reinterpret_cast<float*>(lds);
  unsigned char* LA = lds + 1024;
  unsigned char* LB = lds + 1024 + 32768;
  const int tid = ltid();
  const int lane = tid & 63, wid = __builtin_amdgcn_readfirstlane(tid >> 6), fr = lane & 15, fq = lane >> 4;
  const float* nw = p->gs_norm_w + j * 1024;
  for (int u = lbid(); u < nchunks * 8; u += lnblk()) {
    const int chunk = u >> 3, g = u & 7;
    const int tok0 = chunk * 128;
    const bf16_t* vT = p->zvT + ((size_t)chunk * 1024 + g * 128) * 128;
    __syncthreads();
    if (tid < 128) {
      const float* rp = p->rowss + (size_t)chunk * 32 * 128 + tid;
      float ss = 0.f;
#pragma unroll
      for (int sl = 0; sl < 32; ++sl) ss += rp[sl * 128];
      rs[tid] = rsqrtf(ss * (1.f / 1024.f) + 1e-6f);
    }
#pragma unroll
    for (int i = 0; i < 8; ++i) {
      int idx = tid + 256 * i, row = idx >> 4, c = idx & 15;
      uint4 v = *reinterpret_cast<const uint4*>(vT + (size_t)row * 128 + c * 8);
      *reinterpret_cast<uint4*>(LB + row * 256 + ((c ^ (row & 15)) << 4)) = v;
    }
    __syncthreads();
    {
      const float* wsg = p->gs_w_s + ((size_t)j * 8 + g) * 128 * 128;
#pragma unroll
      for (int i = 0; i < 8; ++i) {
        int idx = tid + 256 * i, row = idx >> 4, c = idx & 15;
        const float4* wp = reinterpret_cast<const float4*>(wsg + (size_t)row * 128 + c * 8);
        float4 w0 = wp[0], w1 = wp[1];
        const float* rk = rs + c * 8;
        uint4 pk;
        pk.x = pack2(w0.x * rk[0], w0.y * rk[1]);
        pk.y = pack2(w0.z * rk[2], w0.w * rk[3]);
        pk.z = pack2(w1.x * rk[4], w1.y * rk[5]);
        pk.w = pack2(w1.z * rk[6], w1.w * rk[7]);
        *reinterpret_cast<uint4*>(LA + row * 256 + ((c ^ (row & 15)) << 4)) = pk;
      }
    }
    __syncthreads();
    f32x4 acc[2][8];
#pragma unroll
    for (int m = 0; m < 2; ++m)
#pragma unroll
      for (int n = 0; n < 8; ++n) acc[m][n] = f32x4{0.f, 0.f, 0.f, 0.f};
#pragma unroll
    for (int ks = 0; ks < 4; ++ks) {
      const int sl = ((4 * ks + fq) ^ fr) << 4;
      bf16x8 a0 = *reinterpret_cast<const bf16x8*>(LA + (32 * wid + fr) * 256 + sl);
      bf16x8 a1 = *reinterpret_cast<const bf16x8*>(LA + (32 * wid + 16 + fr) * 256 + sl);
#pragma unroll
      for (int n = 0; n < 8; ++n) {
        bf16x8 bfr = *reinterpret_cast<const bf16x8*>(LB + (16 * n + fr) * 256 + sl);
        acc[0][n] = __builtin_amdgcn_mfma_f32_16x16x32_bf16(a0, bfr, acc[0][n], 0, 0, 0);
        acc[1][n] = __builtin_amdgcn_mfma_f32_16x16x32_bf16(a1, bfr, acc[1][n], 0, 0, 0);
      }
    }
    __syncthreads();
    {
      const float* bsg = p->gs_b_s + ((size_t)j * 8 + g) * 128;
#pragma unroll
      for (int m = 0; m < 2; ++m)
#pragma unroll
        for (int jj = 0; jj < 4; ++jj) {
          const int pp = 32 * wid + 16 * m + 4 * fq + jj;
          const float bias = bsg[pp];
#pragma unroll
          for (int n = 0; n < 8; ++n) {
            const int c = 16 * n + fr;
            float sv = nw[g * 128 + c] * acc[m][n][jj] + bias;
            *reinterpret_cast<bf16_t*>(LA + pp * 256 + (((c >> 3) ^ (pp & 15)) << 4) + (c & 7) * 2) = f2bf(sv);
          }
        }
    }
    __syncthreads();
#pragma unroll
    for (int i = 0; i < 8; ++i) {
      int idx = tid + 256 * i, row = idx >> 4, c = idx & 15;
      uint4 sv8 = *reinterpret_cast<const uint4*>(LA + row * 256 + ((c ^ (row & 15)) << 4));
      uint4 u8 = *reinterpret_cast<const uint4*>(p->P + (size_t)(tok0 + row) * 2048 + g * 128 + c * 8);
      uint4 o;
      o.x = pack2(bflo(u8.x) * bflo(sv8.x), bfhi(u8.x) * bfhi(sv8.x));
      o.y = pack2(bflo(u8.y) * bflo(sv8.y), bfhi(u8.y) * bfhi(sv8.y));
      o.z = pack2(bflo(u8.z) * bflo(sv8.z), bfhi(u8.z) * bfhi(sv8.z));
      o.w = pack2(bflo(u8.w) * bflo(sv8.w), bfhi(u8.w) * bfhi(sv8.w));
      *reinterpret_cast<uint4*>(p->mix + (size_t)(tok0 + row) * LDMIX + g * 128 + c * 8) = o;
    }
  }
  __syncthreads();
}

DEVI float mkkey(float v, unsigned idx, unsigned mask) { return __uint_as_float((__float_as_uint(v) & ~mask) | idx); }
#define INSERT16(list, x)                                                                                               \
  {                                                                                                                     \
    _Pragma("unroll") for (int i_ = 15; i_ >= 1; --i_) list[i_] = __builtin_amdgcn_fmed3f(list[i_ - 1], list[i_], x); \
    list[0] = fmaxf(list[0], x);                                                                                        \
  }

DEVI float vmaxf(float a, float b) { float r; asm("v_max_f32 %0, %1, %2" : "=v"(r) : "v"(a), "v"(b)); return r; }
DEVI float vminf(float a, float b) { float r; asm("v_min_f32 %0, %1, %2" : "=v"(r) : "v"(a), "v"(b)); return r; }
DEVI void bitonic_merge16(float (&v)[16]) {
#pragma unroll
  for (int j = 8; j >= 1; j >>= 1)
#pragma unroll
    for (int i = 0; i < 16; ++i) {
      const int l = i ^ j;
      if (l > i) {
        const float hi = vmaxf(v[i], v[l]), lo = vminf(v[i], v[l]);
        v[i] = hi;
        v[l] = lo;
      }
    }
}
DEVI void bitonic_sort16(float (&v)[16]) {
#pragma unroll
  for (int k = 2; k <= 16; k <<= 1)
#pragma unroll
    for (int j = k >> 1; j >= 1; j >>= 1)
#pragma unroll
      for (int i = 0; i < 16; ++i) {
        const int l = i ^ j;
        if (l > i) {
          const float hi = vmaxf(v[i], v[l]), lo = vminf(v[i], v[l]);
          const bool desc = (i & k) == 0;
          v[i] = desc ? hi : lo;
          v[l] = desc ? lo : hi;
        }
      }
}

DEVI void phase_route(PP p, int layer, int ntok, unsigned char* lds) {
  const int tid = ltid();
  const int lane = tid & 63, wid = __builtin_amdgcn_readfirstlane(tid >> 6), fr = lane & 15, fq = lane >> 4;
  const int nb8 = lnblk() >> 3, bid = lbid();
  const int hh = bid & 7, slot = bid >> 3;
  const int ntiles = ntok / 64;
  const bool active = slot < nb8;
  float* sc = reinterpret_cast<float*>(lds + 32768);
  const float NEGK = -3.0e38f;
  for (int half = 0; half < 2; ++half) {
    __syncthreads();
    {
      const bf16_t* ksrc = p->keysb + ((size_t)((layer * 8 + hh) * 2 + half) * 128) * 128;
#pragma unroll
      for (int i = 0; i < 8; ++i) {
        int idx = tid + 256 * i, row = idx >> 4, c = idx & 15;
        uint4 v = *reinterpret_cast<const uint4*>(ksrc + (size_t)row * 128 + c * 8);
        *reinterpret_cast<uint4*>(lds + row * 256 + ((c ^ (row & 15)) << 4)) = v;
      }
    }
    __syncthreads();
    bf16x8 an[4];
    if (active && slot < ntiles) {
      const bf16_t* qa = p->P + (size_t)(slot * 64 + wid * 16 + fr) * 2048 + hh * 256 + half * 128 + fq * 8;
#pragma unroll
      for (int ks = 0; ks < 4; ++ks) an[ks] = *reinterpret_cast<const bf16x8*>(qa + ks * 32);
    }
    for (int tt = slot; active && tt < ntiles; tt += nb8) {
      const int tok0 = tt * 64;
      float list[16], lb[16];
      {
        bf16x8 a[4];
#pragma unroll
        for (int ks = 0; ks < 4; ++ks) a[ks] = an[ks];
        {
          const int ttn = (tt + nb8 < ntiles) ? tt + nb8 : tt;
          const bf16_t* qa = p->P + (size_t)(ttn * 64 + wid * 16 + fr) * 2048 + hh * 256 + half * 128 + fq * 8;
#pragma unroll
          for (int ks = 0; ks < 4; ++ks) an[ks] = *reinterpret_cast<const bf16x8*>(qa + ks * 32);
        }
#pragma unroll
        for (int nf = 0; nf < 8; ++nf) {
          f32x4 acc = f32x4{0.f, 0.f, 0.f, 0.f};
          const int krow = nf * 16 + fr;
#pragma unroll
          for (int ks = 0; ks < 4; ++ks) {
            bf16x8 bb = *reinterpret_cast<const bf16x8*>(lds + krow * 256 + (((4 * ks + fq) ^ (krow & 15)) << 4));
            acc = __builtin_amdgcn_mfma_f32_16x16x32_bf16(bb, a[ks], acc, 0, 0, 0);
          }
#pragma unroll
          for (int j = 0; j < 4; ++j) {
            const float kv = mkkey(acc[j], (unsigned)(nf * 16 + 4 * fq + j), 127u);
            if (nf < 4) list[nf * 4 + j] = kv;
            else lb[(nf - 4) * 4 + j] = kv;
          }
        }
      }
      const int prt = lane >> 4;
      bitonic_sort16(list);
      bitonic_sort16(lb);
#pragma unroll
      for (int i = 0; i < 16; ++i) list[i] = vmaxf(list[i], lb[15 - i]);
      bitonic_merge16(list);
#pragma unroll 1
      for (int step = 16; step <= 32; step <<= 1) {
        float other[16];
#pragma unroll
        for (int i = 0; i < 16; ++i) other[i] = shx_f(list[i], step);
#pragma unroll
        for (int i = 0; i < 16; ++i) list[i] = vmaxf(list[i], other[15 - i]);
        bitonic_merge16(list);
      }
      if (prt == 0) {
        float4* o = reinterpret_cast<float4*>(p->tops + ((size_t)(tok0 + wid * 16 + fr) * 16 + hh * 2 + half) * 16);
        o[0] = make_float4(list[0], list[1], list[2], list[3]);
        o[1] = make_float4(list[4], list[5], list[6], list[7]);
        o[2] = make_float4(list[8], list[9], list[10], list[11]);
        o[3] = make_float4(list[12], list[13], list[14], list[15]);
      }
    }
  }
  __syncthreads();
  float* fl = reinterpret_cast<float*>(lds);
  for (int t4 = slot; active && t4 < ntiles + 3 * nb8; t4 += 4 * nb8) {
    const int tt = t4 + (tid >> 6) * nb8;
    if (tt < ntiles) {
      const int tok = tt * 64 + (tid & 63);
      const float4* src = reinterpret_cast<const float4*>(p->tops + ((size_t)tok * 16 + hh * 2) * 16);
      float v0[16], v1[16];
#pragma unroll
      for (int i = 0; i < 4; ++i) {
        float4 a = src[i], bq = src[4 + i];
        v0[4 * i] = a.x; v0[4 * i + 1] = a.y; v0[4 * i + 2] = a.z; v0[4 * i + 3] = a.w;
        v1[4 * i] = bq.x; v1[4 * i + 1] = bq.y; v1[4 * i + 2] = bq.z; v1[4 * i + 3] = bq.w;
      }
      float* f0 = fl + tid * 33;
      float* f1 = f0 + 16;
#pragma unroll
      for (int i = 0; i < 16; ++i) {
        f0[i] = v0[i];
        f1[i] = v1[i];
      }
      float l2[16];
#pragma unroll
      for (int i = 0; i < 16; ++i) l2[i] = mkkey(v0[0] + v1[i], (unsigned)(15 - i), 255u);
#pragma unroll
      for (int a = 1; a < 16; ++a)
#pragma unroll
        for (int bq = 0; bq < 16; ++bq)
          if ((a + 1) * (bq + 1) <= 16) {
            float x = mkkey(v0[a] + v1[bq], (unsigned)(a * 16 + 15 - bq), 255u);
            INSERT16(l2, x)
          }
      float sv[16];
      int ev[16];
      float mx = NEGK;
#pragma unroll
      for (int k = 0; k < 16; ++k) {
        unsigned ab = __float_as_uint(l2[k]) & 255u;
        unsigned k0 = __float_as_uint(f0[ab >> 4]), k1 = __float_as_uint(f1[15u - (ab & 15u)]);
        sv[k] = __uint_as_float(k0 & ~127u) + __uint_as_float(k1 & ~127u);
        ev[k] = (int)((k0 & 127u) * 128u + (k1 & 127u));
        mx = fmaxf(mx, sv[k]);
      }
      float sum = 0.f;
#pragma unroll
      for (int k = 0; k < 16; ++k) {
        sv[k] = __expf(sv[k] - mx);
        sum += sv[k];
      }
      float inv = 1.f / sum;
      size_t o = (size_t)tok * 128 + hh * 16;
      int4* eo = reinterpret_cast<int4*>(p->eidx + o);
      float4* go = reinterpret_cast<float4*>(p->gate + o);
#pragma unroll
      for (int k4 = 0; k4 < 4; ++k4) {
        eo[k4] = make_int4(ev[4 * k4], ev[4 * k4 + 1], ev[4 * k4 + 2], ev[4 * k4 + 3]);
        go[k4] = make_float4(sv[4 * k4] * inv, sv[4 * k4 + 1] * inv, sv[4 * k4 + 2] * inv, sv[4 * k4 + 3] * inv);
      }
    }
  }
  __syncthreads();
}

typedef float v2f __attribute__((ext_vector_type(2)));
DEVI void dec16(uint4 q, v2f* f) {
  f[0] = __builtin_amdgcn_cvt_pk_f32_fp8((int)q.x, false);
  f[1] = __builtin_amdgcn_cvt_pk_f32_fp8((int)q.x, true);
  f[2] = __builtin_amdgcn_cvt_pk_f32_fp8((int)q.y, false);
  f[3] = __builtin_amdgcn_cvt_pk_f32_fp8((int)q.y, true);
  f[4] = __builtin_amdgcn_cvt_pk_f32_fp8((int)q.z, false);
  f[5] = __builtin_amdgcn_cvt_pk_f32_fp8((int)q.z, true);
  f[6] = __builtin_amdgcn_cvt_pk_f32_fp8((int)q.w, false);
  f[7] = __builtin_amdgcn_cvt_pk_f32_fp8((int)q.w, true);
}
struct ExpBuf {
  uint4 q[8];
  uint4 h0, h1;
};
DEVI void exp_load(ExpBuf& B, const unsigned char* tab, const signed char* hrow, const unsigned short* idp, int j8, bool want_x) {
  const uint4 idv = *reinterpret_cast<const uint4*>(idp);
  const unsigned idw[4] = {idv.x, idv.y, idv.z, idv.w};
#pragma unroll
  for (int i = 0; i < 8; ++i) {
    unsigned e = (i & 1) ? (idw[i >> 1] >> 16) : (idw[i >> 1] & 0xffffu);
    unsigned off = e * (unsigned)D + 16u * j8;
    B.q[i] = *reinterpret_cast<const uint4*>(tab + off);
  }
  if (want_x) B.h0 = *reinterpret_cast<const uint4*>(hrow + 16 * j8);
}
template <int CTRL>
DEVI int dpp_movi(int v) { return __builtin_amdgcn_mov_dpp(v, CTRL, 0xF, 0xF, true); }
DEVI void exp_u_compute(const ExpBuf& B, int* pp, int j8) {
  int s0 = 0;
#pragma unroll
  for (int i = 0; i < 8; ++i) {
    int d = __builtin_amdgcn_sdot4((int)B.q[i].x, (int)B.h0.x, 0, false);
    d = __builtin_amdgcn_sdot4((int)B.q[i].y, (int)B.h0.y, d, false);
    d = __builtin_amdgcn_sdot4((int)B.q[i].z, (int)B.h0.z, d, false);
    d = __builtin_amdgcn_sdot4((int)B.q[i].w, (int)B.h0.w, d, false);
    d += dpp_movi<0xB1>(d);
    d += dpp_movi<0x4E>(d);
    d += dpp_movi<0x141>(d);
    s0 = (j8 == i) ? d : s0;
  }
  pp[0] += s0;
}
DEVI void exp_v_accum(const ExpBuf& B, unsigned w0, unsigned w1, int* acc) {
#pragma unroll
  for (int ig = 0; ig < 2; ++ig) {
    const unsigned wq = ig ? w1 : w0;
    const uint4 R0 = B.q[4 * ig], R1 = B.q[4 * ig + 1], R2 = B.q[4 * ig + 2], R3 = B.q[4 * ig + 3];
    const unsigned r0[4] = {R0.x, R0.y, R0.z, R0.w}, r1[4] = {R1.x, R1.y, R1.z, R1.w};
    const unsigned r2[4] = {R2.x, R2.y, R2.z, R2.w}, r3[4] = {R3.x, R3.y, R3.z, R3.w};
#pragma unroll
    for (int q = 0; q < 4; ++q) {
      unsigned A = __builtin_amdgcn_perm(r1[q], r0[q], 0x05010400u);
      unsigned Bq = __builtin_amdgcn_perm(r1[q], r0[q], 0x07030602u);
      unsigned C = __builtin_amdgcn_perm(r3[q], r2[q], 0x05010400u);
      unsigned E = __builtin_amdgcn_perm(r3[q], r2[q], 0x07030602u);
      unsigned D0 = __builtin_amdgcn_perm(C, A, 0x05040100u);
      unsigned D1 = __builtin_amdgcn_perm(C, A, 0x07060302u);
      unsigned D2 = __builtin_amdgcn_perm(E, Bq, 0x05040100u);
      unsigned D3 = __builtin_amdgcn_perm(E, Bq, 0x07060302u);
      acc[4 * q + 0] = __builtin_amdgcn_sdot4((int)D0, (int)wq, acc[4 * q + 0], false);
      acc[4 * q + 1] = __builtin_amdgcn_sdot4((int)D1, (int)wq, acc[4 * q + 1], false);
      acc[4 * q + 2] = __builtin_amdgcn_sdot4((int)D2, (int)wq, acc[4 * q + 2], false);
      acc[4 * q + 3] = __builtin_amdgcn_sdot4((int)D3, (int)wq, acc[4 * q + 3], false);
    }
  }
}
DEVI void exp_v_finish(float4* xo, float4 xq, float4 gq, int* acc, float swt, int lane, float gscale) {
  int r[8], s4[4];
#pragma unroll
  for (int i = 0; i < 8; ++i) {
    auto t = __builtin_amdgcn_permlane32_swap((unsigned)acc[i], (unsigned)acc[8 + i], false, false);
    r[i] = (int)t[0] + (int)t[1];
  }
#pragma unroll
  for (int i = 0; i < 4; ++i) {
    auto t = __builtin_amdgcn_permlane16_swap((unsigned)r[i], (unsigned)r[4 + i], false, false);
    s4[i] = (int)t[0] + (int)t[1];
  }
#pragma unroll
  for (int i = 0; i < 4; ++i) s4[i] += dpp_movi<0x128>(s4[i]);
#pragma unroll
  for (int k = 0; k < 16; ++k) acc[k] = 0;
  if ((lane & 8) == 0) {
    const float sc = gscale * swt;
    float4 rr = xq;
    rr.x += sc * gq.x * (float)s4[0];
    rr.y += sc * gq.y * (float)s4[1];
    rr.z += sc * gq.z * (float)s4[2];
    rr.w += sc * gq.w * (float)s4[3];
    *xo = rr;
  }
}
DEVI void phase_expert(PP p, int layer, int ntok, unsigned char* lds, float gscale = 1.f, int idmask = 0xffff) {
  const int tid = ltid();
  const int lane = tid & 63, wid = __builtin_amdgcn_readfirstlane(tid >> 6), j8 = lane & 7, grp = lane >> 3;
  const int nb = lnblk(), bid = lbid();
  unsigned short* ids = reinterpret_cast<unsigned short*>(lds);
  float* part = reinterpret_cast<float*>(lds + TPB * 128 * 2);
  unsigned char* w8 = lds + TPB * 128 * 2 + TPB * 128 * 4;
  float* swl = reinterpret_cast<float*>(lds + TPB * 128 * 2 + TPB * 128 * 4 + TPB * 128);
  const unsigned char* ut = p->utab + (size_t)layer * NEXP * D;
  const unsigned char* vt = p->vtab + (size_t)layer * NEXP * D;
  int tpb = (ntok + nb - 1) / nb;
  if (tpb > TPB) tpb = TPB;
  const int npass = (ntok + nb * tpb - 1) / (nb * tpb);
  for (int pass = 0; pass < npass; ++pass) {
    const int tok0 = (pass * nb + bid) * tpb;
    int cnt = ntok - tok0;
    if (cnt > tpb) cnt = tpb;
    if (cnt < 0) cnt = 0;
    for (int i = tid; i < cnt * 128; i += NTHREADS) {
      {
        int k = i & 127, hf = k >> 6, kk = k & 63;
        ids[(i & ~127) + hf * 64 + (kk & 7) * 8 + (kk >> 3)] = (unsigned short)(p->eidx[(size_t)tok0 * 128 + i] & idmask);
      }
      part[i] = 0.f;
    }
    __syncthreads();
    const int ntw = (cnt - wid + 3) >> 2;
    const int npair = ntw * 8;

    if (!(REP_MODE == 1 && gscale != 1.f)) {
      ExpBuf B0, B1;
      int c0 = 0, k0 = 0;
      if (npair > 0) {
        const int t0 = wid;
        exp_load(B0, ut, p->h8 + (size_t)(tok0 + t0) * D, ids + t0 * 128 + grp * 8, j8, true);
      }
      for (int pr = 0; pr < npair; ++pr) {
        const int t0 = wid + 4 * k0;
        exp_load(B1, ut + 128 * c0, p->h8 + (size_t)(tok0 + t0) * D + 128 * c0, ids + t0 * 128 + 64 + grp * 8, j8, true);
        exp_u_compute(B0, reinterpret_cast<int*>(part) + t0 * 128 + 8 * j8 + grp, j8);
        int c1 = c0, k1 = k0;
        if (pr + 1 < npair) {
          k1 = k0 + 1;
          if (k1 == ntw) {
            k1 = 0;
            c1 = c0 + 1;
          }
        }
        {
          const int t1 = wid + 4 * k1;
          exp_load(B0, ut + 128 * c1, p->h8 + (size_t)(tok0 + t1) * D + 128 * c1, ids + t1 * 128 + grp * 8, j8, true);
        }
        exp_u_compute(B1, reinterpret_cast<int*>(part) + t0 * 128 + 64 + 8 * j8 + grp, j8);
        c0 = c1;
        k0 = k1;
      }
    }
    __syncthreads();
    for (int t = wid; t < cnt; t += 4) {
      float wv2[2];
      float am = 0.f;
#pragma unroll
      for (int hh = 0; hh < 2; ++hh) {
        int k = lane + 64 * hh;
        int e = ids[t * 128 + hh * 64 + (lane & 7) * 8 + (lane >> 3)];
        float dq = (float)reinterpret_cast<int*>(part)[t * 128 + k] * p->su[(size_t)layer * NEXP + e] * p->sx[tok0 + t];
        float wv = p->gate[(size_t)(tok0 + t) * 128 + k] * gelu_tanh(dq) * p->sv[(size_t)layer * NEXP + e];
        wv2[hh] = wv;
        am = fmaxf(am, fabsf(wv));
      }
      am = fmaxf(wave_max(am), 1e-30f);
      float qs = 127.f / am;
#pragma unroll
      for (int hh = 0; hh < 2; ++hh) {
        int k = lane + 64 * hh;
        int q = (int)rintf(wv2[hh] * qs);
        w8[t * 128 + (k & 7) * 16 + hh * 8 + ((k >> 3) & 7)] = (unsigned char)(q & 255);
      }
      if (lane == 0) swl[t] = am * (1.f / 127.f);
    }
    __syncthreads();
    if (!(REP_MODE == 2 && gscale != 1.f)) {
      ExpBuf B0, B1;
      int acc[16];
#pragma unroll
      for (int k = 0; k < 16; ++k) acc[k] = 0;
      int c0 = 0, k0 = 0;
      if (npair > 0) {
        const int t0 = wid;
        exp_load(B0, vt, (const signed char*)nullptr, ids + t0 * 128 + grp * 8, j8, false);
      }
      for (int pr = 0; pr < npair; ++pr) {
        const int t0 = wid + 4 * k0;
        const int dsub = 128 * c0 + 16 * j8 + 8 * (lane >> 5) + 4 * ((lane >> 4) & 1);
        float4* xo = reinterpret_cast<float4*>(p->xs + (size_t)(tok0 + t0) * D + dsub);
        const float4 xq = *xo;
        const float4 gq = *reinterpret_cast<const float4*>(p->mod + ((size_t)layer * 9 + tok_batch(tok0 + t0)) * 6144 + 5 * 1024 + dsub);
        exp_load(B1, vt + 128 * c0, (const signed char*)nullptr, ids + t0 * 128 + 64 + grp * 8, j8, false);
        const uint4 wq = *reinterpret_cast<const uint4*>(w8 + t0 * 128 + grp * 16);
        exp_v_accum(B0, wq.x, wq.y, acc);
        int c1 = c0, k1 = k0;
        if (pr + 1 < npair) {
          k1 = k0 + 1;
          if (k1 == ntw) {
            k1 = 0;
            c1 = c0 + 1;
          }
        }
        {
          const int t1 = wid + 4 * k1;
          exp_load(B0, vt + 128 * c1, (const signed char*)nullptr, ids + t1 * 128 + grp * 8, j8, false);
        }
        exp_v_accum(B1, wq.z, wq.w, acc);
        exp_v_finish(xo, xq, gq, acc, swl[t0], lane, gscale);
        c0 = c1;
        k0 = k1;
      }
    }
    asm volatile("s_waitcnt vmcnt(0)" ::: "memory");
    __syncthreads();
    if (gscale == 1.f) {
      for (int t = wid; t < cnt; t += 4) {
        if (layer + 1 < DEPTH) norm_row(p, layer + 1, 0, tok0 + t, lane);
        else if (tok0 + t < TL) norm_row(p, 0, 2, tok0 + t, lane);
      }
    }
    __syncthreads();
  }
}

#define XB_TMO 128
#define XB_XCNT(j) (256 + 64 * (j))
#define XB_XSUB(j) (1280 + 64 * (j))
#define XB_XGEN(j) (2304 + 64 * (j))
#define XB_TOP 3328
#define XB_TOPGEN 3392
#define XCD_BAR_WORDS 3456
#define XB_SPIN_CAP (1u << 22)
#define LAS __attribute__((address_space(3)))
DEVI unsigned xb_ld(unsigned* p) { return __hip_atomic_load(p, __ATOMIC_RELAXED, __HIP_MEMORY_SCOPE_AGENT); }
DEVI unsigned xb_add(unsigned* p, unsigned v) { return __hip_atomic_fetch_add(p, v, __ATOMIC_RELAXED, __HIP_MEMORY_SCOPE_AGENT); }
DEVI unsigned xb_xcc_id() { return (unsigned)__builtin_amdgcn_s_getreg((3 << 11) | 20) & 0xFu; }
#define XB_SPIN(cond, bar)                                   \
  do {                                                       \
    unsigned _sp = 0;                                        \
    while (cond) {                                           \
      __builtin_amdgcn_s_sleep(1);                           \
      if ((++_sp & 255u) == 0u) {                            \
        if (xb_ld(&(bar)[XB_TMO])) break;                    \
        if (_sp > XB_SPIN_CAP) {                             \
          atomicAdd(&(bar)[XB_TMO], 1u);                     \
          break;                                             \
        }                                                    \
      }                                                      \
    }                                                        \
  } while (0)
struct XcdBarrier {
  unsigned* bar;
  unsigned x;
  volatile LAS unsigned* st;
};
DEVI XcdBarrier xcd_barrier_post(unsigned* bar, volatile LAS unsigned* st) {
  XcdBarrier b;
  b.bar = bar;
  b.x = xb_xcc_id();
  b.st = st;
  if (threadIdx.x == 0) (void)xb_add(&bar[XB_XCNT(b.x)], 1u);
  return b;
}
DEVI void xcd_barrier_complete(unsigned* bar, unsigned x, unsigned& nloc, unsigned& nx) {
  const unsigned G = gridDim.x * gridDim.y * gridDim.z;
  unsigned sum, cnt, mine, sp = 0u;
  for (;;) {
    sum = 0u;
    cnt = 0u;
    mine = 0u;
#pragma unroll
    for (unsigned j = 0; j < 16; ++j) {
      const unsigned c = xb_ld(&bar[XB_XCNT(j)]);
      sum += c;
      cnt += (c > 0u) ? 1u : 0u;
      mine = (j == x) ? c : mine;
    }
    if (sum == G) break;
    __builtin_amdgcn_s_sleep(1);
    if ((++sp & 255u) == 0u) {
      if (xb_ld(&bar[XB_TMO])) break;
      if (sp > XB_SPIN_CAP) {
        atomicAdd(&bar[XB_TMO], 1u);
        break;
      }
    }
  }
  nloc = mine > 0u ? mine : 1u;
  nx = cnt > 0u ? cnt : 1u;
}
DEVI void xcd_barrier(const XcdBarrier& b) {
  asm volatile("s_waitcnt vmcnt(0)" ::: "memory");
  __syncthreads();
  if (threadIdx.x == 0) {
    unsigned* bar = b.bar;
    __builtin_amdgcn_s_waitcnt(0);
    unsigned nloc = b.st[0], nx = b.st[1];
    if (nloc == 0u) {
      xcd_barrier_complete(bar, b.x, nloc, nx);
      b.st[0] = nloc;
      b.st[1] = nx;
    }
    const unsigned old = xb_add(&bar[XB_XSUB(b.x)], 1u);
    const unsigned gen = old / nloc;
    if (old + 1u == (gen + 1u) * nloc) {
      __builtin_amdgcn_fence(__ATOMIC_RELEASE, "agent");
      asm volatile("s_waitcnt vmcnt(0)" ::: "memory");
      const unsigned og = xb_add(&bar[XB_TOP], 1u);
      const unsigned tg = og / nx;
      if (og + 1u == (tg + 1u) * nx) xb_add(&bar[XB_TOPGEN], 1u);
      else XB_SPIN(xb_ld(&bar[XB_TOPGEN]) == tg, bar);
      __builtin_amdgcn_fence(__ATOMIC_ACQUIRE, "agent");
      xb_add(&bar[XB_XGEN(b.x)], 1u);
      asm volatile("s_waitcnt vmcnt(0)" ::: "memory");
    } else {
      XB_SPIN(xb_ld(&bar[XB_XGEN(b.x)]) == gen, bar);
      __builtin_amdgcn_fence(__ATOMIC_ACQUIRE, "agent");
      asm volatile("s_waitcnt vmcnt(0)" ::: "memory");
    }
  }
  __syncthreads();
}

DEVI bool step_active(int step) {
  if (step == 0) return true;
  if (step == NSTEPS - 1) return false;
  int layer = (step - 1) / STEPS_PER_LAYER, ph = (step - 1) % STEPS_PER_LAYER;
  if (ph == 3 && (layer & 1)) return false;
  if (ph == 0 && layer > 0) return false;
  return true;
}

DEVI void run_step(PP p, int step, unsigned char* lds, unsigned char* lds_all, float gscale = 1.f) {
  if (step == 0) {
    phase_prep(p, lds);
    return;
  }
  if (step == NSTEPS - 1) {
    phase_norm(p, 0, 2, TL);
    return;
  }
  int layer = (step - 1) / STEPS_PER_LAYER, ph = (step - 1) % STEPS_PER_LAYER;
  bool even = (layer & 1) == 0;
  int j = layer >> 1;
  bool upd_ctx = layer < 2;
  bool need_ctx = layer < 3;
  int nt_in = need_ctx ? TT : TL;
  int nt = upd_ctx ? TT : TL;
  switch (ph) {
    case 0: phase_norm(p, layer, 0, nt_in); break;
    case 1:
      if (even)
        gemm8_phase<EPI_INPROJ>(p, p->h, D, p->wt_in_ab + (size_t)j * 1280 * D, D, nt_in / 256, 5, D, layer, lds_all);
      else
        gemm8_phase<EPI_GELU>(p, p->h, D, p->wt_in_gs + (size_t)j * 2048 * D, D, nt / 256, 8, D, layer, lds_all);
      break;
    case 2:
      if (even) {
        phase_fft_a(p, lds);
        if (upd_ctx) phase_dft_ctx(p, lds);
        phase_attn(p, layer, upd_ctx, lds);
      } else {
        phase_sgu(p, j, nt / 128, lds);
      }
      break;
    case 3:
      if (even) phase_fft_b(p, lds);
      break;
    case 4:
      if (even)
      {
        if (layer == 0) gemm8_phase<EPI_RESID0>(p, p->mix, LDMIX, p->wt_out_ab + (size_t)j * D * LDMIX, LDMIX, nt / 256, 4, LDMIX, layer, lds_all, gscale);
        else gemm8_phase<EPI_RESID>(p, p->mix, LDMIX, p->wt_out_ab + (size_t)j * D * LDMIX, LDMIX, nt / 256, 4, LDMIX, layer, lds_all, gscale);
      }
      else
      {
        gemm8_phase<EPI_RESID>(p, p->mix, LDMIX, p->wt_out_gs + (size_t)j * D * D, D, nt / 256, 4, D, layer, lds_all, gscale);
      }
      break;
    case 5: phase_norm(p, layer, 1, nt); break;
    case 6: gemm8_phase<EPI_STORE>(p, p->h, D, p->wt_q + (size_t)layer * 2048 * D, D, nt / 256, 8, D, layer, lds_all); break;
    case 7: phase_route(p, layer, nt, lds); break;
    case 8: phase_expert(p, layer, nt, lds, gscale, (gscale == 1.f) ? 0xffff : REP_IDMASK); break;
  }
}

__global__ void __launch_bounds__(PHYS_THREADS, 2) mega(Params p_unused, int step_lo, int step_hi) {
  unsigned char* lds_all = g_lds;
  if ((threadIdx.x & 63) == 0) *reinterpret_cast<volatile int*>(g_lds + LDS_BYTES - 16 - 256 + 4 * hw_slot()) = (int)(threadIdx.x >> 6);
  __syncthreads();
  unsigned char* lds = lds_all + (wave_index() >> 2) * LDS_HALF;
  PP pp = (PP)__builtin_amdgcn_kernarg_segment_ptr();
  volatile LAS unsigned* st = (volatile LAS unsigned*)(lds_all + LDS_BYTES - 16);
  if (threadIdx.x == 0) {
    st[0] = 0u;
    st[1] = 0u;
  }
  __syncthreads();
  XcdBarrier xb = xcd_barrier_post(pp->bar, st);
  int nsync = 0;
  bool first = true;
  for (int s = step_lo; s < step_hi; ++s) {
    if (!step_active(s)) continue;
    if (!first) {
      if (nsync == 0) cg::this_grid().sync();
      else xcd_barrier(xb);
      ++nsync;
    }
    first = false;
    int nrep = 1;
    if (PROBE_PH) {
      if (s == 0) nrep += (PROBE_PH >> 15) & 1;
      else if (s < NSTEPS - 1) {
        const int lay_ = (s - 1) / STEPS_PER_LAYER, ph_ = (s - 1) % STEPS_PER_LAYER;
        nrep += (PROBE_PH >> ph_) & 1;
        if (ph_ == 2 && ((PROBE_PH >> 9) & 1) && !(lay_ & 1)) nrep = 2;
        if (ph_ == 2 && ((PROBE_PH >> 10) & 1) && (lay_ & 1)) nrep = 2;
        if (ph_ == 1 && ((PROBE_PH >> 12) & 1) && !(lay_ & 1)) nrep = 2;
        if (ph_ == 1 && ((PROBE_PH >> 13) & 1) && (lay_ & 1)) nrep = 2;
        if (ph_ == 4 && ((PROBE_PH >> 11) & 1) && !(lay_ & 1)) nrep = 2;
        if (ph_ == 4 && ((PROBE_PH >> 14) & 1) && (lay_ & 1)) nrep = 2;
      }
      asm volatile("" : "+s"(nrep));
    }
#pragma nounroll
    for (int rep = nrep - 1; rep >= 0; --rep) {
      if (rep != nrep - 1) xcd_barrier(xb);
      PP q = pp;
      asm volatile("" : "+s"(q));
      int gi = __builtin_amdgcn_readfirstlane(rep ? 0 : 0x3f800000);
      if (PROBE_PH) asm volatile("" : "+s"(gi));
      const float gs = __int_as_float(gi);
      if (PROBE_PH) run_step(q, s, lds, lds_all, gs);
      else run_step(q, s, lds, lds_all);
    }
  }
}

static size_t align_up(size_t v) { return (v + 255) & ~(size_t)255; }

extern "C" void kernel_launch(void* const* d_in, const int* in_sizes, int n_in, void* d_out, int out_size, void* d_ws,
                              size_t ws_size, hipStream_t stream) {
  Params p{};
  p.x = (const float*)d_in[0];
  p.c = (const float*)d_in[1];
  p.ctx = (const float*)d_in[2];
  p.c_ctx = (const float*)d_in[3];
  p.ada_w = (const float*)d_in[4];
  p.ada_b = (const float*)d_in[5];
  p.norm_mix_w = (const float*)d_in[6];
  p.norm_ffn_w = (const float*)d_in[7];
  p.ab_w_in = (const float*)d_in[8];
  p.ab_w_out = (const float*)d_in[9];
  p.attn_sink = (const float*)d_in[10];
  p.gs_w_in = (const float*)d_in[11];
  p.gs_norm_w = (const float*)d_in[12];
  p.gs_w_s = (const float*)d_in[13];
  p.gs_b_s = (const float*)d_in[14];
  p.gs_w_out = (const float*)d_in[15];
  p.peer_w_q = (const float*)d_in[16];
  p.peer_keys = (const float*)d_in[17];
  p.peer_u = (const float*)d_in[18];
  p.peer_v = (const float*)d_in[19];
  p.norm_out_w = (const float*)d_in[20];
  p.out = (float*)d_out;
  unsigned char* w = (unsigned char*)d_ws;
  size_t off = 0;
  auto take = [&](size_t bytes) {
    unsigned char* r = w + off;
    off = align_up(off + bytes);
    return r;
  };
  p.bar = (unsigned*)take((size_t)XCD_BAR_WORDS * 4);
  p.mod = (float*)take((size_t)DEPTH * 9 * 6144 * 4);
  p.cs = (float2*)take(64 * 16 * 8);
  p.xs = (float*)take((size_t)TT * D * 4);
  p.h = (bf16_t*)take((size_t)TT * D * 2);
  p.P = (bf16_t*)take((size_t)TT * 2048 * 2);
  p.kbuf = (bf16_t*)take((size_t)NB * 2 * KVLEN * 64 * 2);
  p.vbuf = (bf16_t*)take((size_t)NB * 2 * KVLEN * 64 * 2);
  p.zvT = (bf16_t*)take((size_t)TT * 1024 * 2);
  p.rowss = (float*)take((size_t)(TT / 128) * 32 * 128 * 4);
  p.mix = (bf16_t*)take((size_t)TT * LDMIX * 2);
  p.fa = (bf16_t*)take((size_t)TL * 1024 * 2);
  p.tops = (float*)take((size_t)TT * 256 * 4);
  p.eidx = (int*)take((size_t)TT * 128 * 4);
  p.gate = (float*)take((size_t)TT * 128 * 4);
  p.wt_in_ab = (bf16_t*)take((size_t)2 * 1280 * D * 2);
  p.wt_out_ab = (bf16_t*)take((size_t)2 * D * LDMIX * 2);
  p.wt_in_gs = (bf16_t*)take((size_t)2 * 2048 * D * 2);
  p.wt_out_gs = (bf16_t*)take((size_t)2 * D * D * 2);
  p.wt_q = (bf16_t*)take((size_t)DEPTH * 2048 * D * 2);
  p.keysb = (bf16_t*)take((size_t)DEPTH * 8 * 2 * 128 * 128 * 2);
  p.su = (float*)take((size_t)DEPTH * NEXP * 4);
  p.sv = (float*)take((size_t)DEPTH * NEXP * 4);
  p.h8 = (signed char*)take((size_t)TT * D);
  p.sx = (float*)take((size_t)TT * 4);
  p.utab = (unsigned char*)take((size_t)DEPTH * NEXP * D);
  p.vtab = (unsigned char*)take((size_t)DEPTH * NEXP * D);
  if (off > ws_size) {
    fprintf(stderr, "workspace too small: need %zu have %zu\n", off, ws_size);
    return;
  }
  hipMemsetAsync(p.bar, 0, (size_t)XCD_BAR_WORDS * 4, stream);
  static int grid_blocks = 0;
  if (!grid_blocks) {
    int dev = 0, cus = 0, per_cu = 0;
    hipGetDevice(&dev);
    hipDeviceGetAttribute(&cus, hipDeviceAttributeMultiprocessorCount, dev);
    hipOccupancyMaxActiveBlocksPerMultiprocessor(&per_cu, mega, PHYS_THREADS, 0);
    if (per_cu > 1) per_cu = 1;
    if (per_cu < 1) per_cu = 1;
    grid_blocks = cus * per_cu;
  }
#if ONE_LAUNCH
  int lo = 0, hi = NSTEPS;
  void* args[] = {&p, &lo, &hi};
  hipError_t e = hipLaunchCooperativeKernel((void*)mega, dim3(grid_blocks), dim3(PHYS_THREADS), args, 0, stream);
  if (e != hipSuccess) fprintf(stderr, "cooperative launch failed: %s (grid %d)\n", hipGetErrorString(e), grid_blocks);
#else
  for (int s = 0; s < NSTEPS; ++s) {
    if (s != 0 && s != NSTEPS - 1) {
      int layer = (s - 1) / STEPS_PER_LAYER, ph = (s - 1) % STEPS_PER_LAYER;
      if (ph == 3 && (layer & 1)) continue;
    }
    hipLaunchKernelGGL(mega, dim3(grid_blocks), dim3(NTHREADS), 0, stream, p, s, s + 1);
  }
#endif
}
```

```cpp
#include <hip/hip_runtime.h>
#include <hip/hip_bf16.h>
#include <hip/hip_cooperative_groups.h>
#include <cstdio>
namespace cg = cooperative_groups;

#ifndef PROBE_PH
#define PROBE_PH 0
#endif
#ifndef PROBE_SKIP_EPI
#define PROBE_SKIP_EPI 0
#endif
#ifndef REP_MASK
#define REP_MASK 0
#endif
#ifndef REP_MODE
#define REP_MODE 0
#endif
#ifndef REP_IDMASK
#define REP_IDMASK 0xffff
#endif
#ifndef ONE_LAUNCH
#define ONE_LAUNCH 1
#endif

#define DEVI __device__ __forceinline__
typedef unsigned short bf16_t;
using bf16x8 = __attribute__((ext_vector_type(8))) short;
using f32x4 = __attribute__((ext_vector_type(4))) float;
using f32x16 = __attribute__((ext_vector_type(16))) float;

constexpr int D = 1024, NB = 8, SEQ = 4096, CTX = 256, DEPTH = 4;
constexpr int TL = NB * SEQ, TC = NB * CTX, TT = TL + TC;
constexpr int KVLEN = CTX + SEQ;
constexpr int NEXP = 16384;
constexpr int LDMIX = 1536;
constexpr float USCALE = 64.f, VSCALE = 8.f;
constexpr int TPB = 68;
constexpr int LDS_HALF = 68 * 1024;
constexpr int LDS_BYTES = 2 * LDS_HALF;
constexpr int PHYS_THREADS = 512;
constexpr int NTHREADS = 256;
constexpr int STEPS_PER_LAYER = 9;
constexpr int NSTEPS = 1 + DEPTH * STEPS_PER_LAYER + 1;

struct Params {
  const float *x, *c, *ctx, *c_ctx, *ada_w, *ada_b, *norm_mix_w, *norm_ffn_w, *ab_w_in, *ab_w_out, *attn_sink,
      *gs_w_in, *gs_norm_w, *gs_w_s, *gs_b_s, *gs_w_out, *peer_w_q, *peer_keys, *peer_u, *peer_v, *norm_out_w;
  float* out;
  float* mod;
  float2* cs;
  bf16_t* xs;
  bf16_t* h;
  bf16_t* P;
  bf16_t* kbuf;
  bf16_t* vbuf;
  float* rowss;
  bf16_t* zvT;
  bf16_t* mix;
  bf16_t* fa;
  unsigned* bar;
  float* tops;
  int* eidx;
  float* gate;
  bf16_t *wt_in_ab, *wt_out_ab, *wt_in_gs, *wt_out_gs, *wt_q, *keysb;
  unsigned char *utab, *vtab;
  float* su;
  float* sv;
  signed char* h8;
  float* sx;
};

typedef const __attribute__((address_space(4))) Params* PP;

__shared__ __attribute__((aligned(16))) unsigned char g_lds[LDS_BYTES];
DEVI int hw_slot() {
  int h = (int)(__builtin_amdgcn_s_getreg((6 - 1) << 11 | 0 << 6 | 4) & 63u);
  asm volatile("" : "+s"(h));
  return h;
}
DEVI int wave_index() {
  int w = *reinterpret_cast<volatile int*>(g_lds + LDS_BYTES - 16 - 256 + 4 * hw_slot());
  return __builtin_amdgcn_readfirstlane(w);
}
DEVI int lane_id() { return (int)__builtin_amdgcn_mbcnt_hi(~0u, __builtin_amdgcn_mbcnt_lo(~0u, 0u)); }
DEVI int ltid() { int t = ((wave_index() & 3) << 6) | lane_id(); asm volatile("" : "+v"(t)); return t; }
DEVI int lbid() { int t = 2 * blockIdx.x + (wave_index() >> 2); asm volatile("" : "+s"(t)); return t; }
DEVI int lnblk() { int t = 2 * gridDim.x; asm volatile("" : "+s"(t)); return t; }
DEVI int ptid() { int t = (wave_index() << 6) | lane_id(); asm volatile("" : "+v"(t)); return t; }
DEVI int pbid() { int t = blockIdx.x; asm volatile("" : "+s"(t)); return t; }
DEVI int pnblk() { int t = gridDim.x; asm volatile("" : "+s"(t)); return t; }

typedef __bf16 bf2v_t __attribute__((ext_vector_type(2)));
typedef float f2v_t __attribute__((ext_vector_type(2)));
DEVI bf16_t f2bf(float f) { return __builtin_bit_cast(unsigned short, (__bf16)f); }
DEVI float bf2f(bf16_t h) { return __uint_as_float(((unsigned)h) << 16); }
DEVI float bflo(unsigned u) { return __uint_as_float(u << 16); }
DEVI float bfhi(unsigned u) { return __uint_as_float(u & 0xffff0000u); }
DEVI unsigned pack2(float a, float b) {
  f2v_t v = {a, b};
  return __builtin_bit_cast(unsigned, __builtin_convertvector(v, bf2v_t));
}
DEVI float gelu_tanh(float x) {
  const float k1 = -2.f * 0.7978845608028654f * 1.4426950408889634f;
  const float a = x * __builtin_fmaf(x * x, k1 * 0.044715f, k1);
  return x * __builtin_amdgcn_rcpf(1.f + __builtin_amdgcn_exp2f(a));
}
template <int CTRL>
DEVI float dpp_mov(float v) {
  return __builtin_bit_cast(float, __builtin_amdgcn_mov_dpp(__builtin_bit_cast(int, v), CTRL, 0xF, 0xF, true));
}
DEVI int shx_i(int v, int m) { return __builtin_amdgcn_ds_bpermute((lane_id() ^ m) << 2, v); }
DEVI float shx_f(float v, int m) { return __builtin_bit_cast(float, shx_i(__builtin_bit_cast(int, v), m)); }
DEVI float wave_sum(float v) {
  v += dpp_mov<0xB1>(v);
  v += dpp_mov<0x4E>(v);
  v += dpp_mov<0x141>(v);
  v += dpp_mov<0x140>(v);
  v += shx_f(v, 16);
  v += shx_f(v, 32);
  return v;
}
DEVI float wave_max(float v) {
  v = fmaxf(v, dpp_mov<0xB1>(v));
  v = fmaxf(v, dpp_mov<0x4E>(v));
  v = fmaxf(v, dpp_mov<0x141>(v));
  v = fmaxf(v, dpp_mov<0x140>(v));
  v = fmaxf(v, shx_f(v, 16));
  v = fmaxf(v, shx_f(v, 32));
  return v;
}
DEVI int tok_batch(int r) { return r < TL ? (r >> 12) : 8; }

DEVI void prep_transpose_tile(const float* __restrict__ src, int N, bf16_t* __restrict__ dst, int ldk, int tk, int tn, float* tile, int tid) {
#pragma unroll
  for (int i = 0; i < 16; ++i) {
    int r = (tid >> 6) + 4 * i;
    tile[r * 65 + (tid & 63)] = src[(size_t)(tk * 64 + r) * N + tn * 64 + (tid & 63)];
  }
  __syncthreads();
#pragma unroll
  for (int i = 0; i < 16; ++i) {
    int n = (tid >> 6) + 4 * i, k = tid & 63;
    dst[(size_t)(tn * 64 + n) * ldk + tk * 64 + k] = f2bf(tile[k * 65 + n]);
  }
}

constexpr int PU_ADA = DEPTH * 96;
constexpr int PU_T_ABIN = 2 * 16 * 20;
constexpr int PU_T_GSIN = 2 * 16 * 32;
constexpr int PU_T_GSOUT = 2 * 16 * 16;
constexpr int PU_T_ABOUT = 2 * 8 * 16;
constexpr int PU_T_Q = DEPTH * 16 * 32;
constexpr int PU_FOLD = 2 * 4 * 16 * 2;
constexpr int PU_CONV = DEPTH * NEXP * D / 4 / 2048;
constexpr int PU_KEYS = DEPTH * 8 * 2 * 128 * 128 / 4 / 2048;
constexpr int PU_UROWS = DEPTH * NEXP / 32;
constexpr int PU_TOTAL = PU_ADA + PU_T_ABIN + PU_T_GSIN + PU_T_GSOUT + PU_T_ABOUT + PU_T_Q + PU_FOLD + 2 * PU_UROWS + PU_KEYS + 1;

DEVI void phase_prep(PP p, unsigned char* lds) {
  const int tid = ltid();
  float* fl = reinterpret_cast<float*>(lds);
  for (int u0 = lbid(); u0 < PU_TOTAL; u0 += lnblk()) {
    int u = u0;
    if (u < PU_ADA) {
      float* sl = fl;
      for (int i = tid; i < 9 * 1024; i += NTHREADS) {
        int r = i >> 10, k = i & 1023;
        float v = (r < 8) ? p->c[r * 1024 + k] : p->c_ctx[k];
        sl[i] = v / (1.f + __expf(-v));
      }
      __syncthreads();
      float* red = sl + 9 * 1024;
      int ks = tid >> 6, col = tid & 63;
      int layer = u / 96, c0 = (u % 96) * 64;
      const float* w = p->ada_w + (size_t)layer * D * 6144 + c0 + col;
      float acc[9];
#pragma unroll
      for (int r = 0; r < 9; ++r) acc[r] = 0.f;
      for (int k0 = ks * 256; k0 < ks * 256 + 256; k0 += 16) {
        float wv[16];
#pragma unroll
        for (int kk = 0; kk < 16; ++kk) wv[kk] = w[(size_t)(k0 + kk) * 6144];
#pragma unroll
        for (int kk = 0; kk < 16; ++kk)
#pragma unroll
          for (int r = 0; r < 9; ++r) acc[r] += sl[r * 1024 + k0 + kk] * wv[kk];
      }
#pragma unroll
      for (int r = 0; r < 9; ++r) red[(ks * 9 + r) * 64 + col] = acc[r];
      __syncthreads();
      for (int i = tid; i < 9 * 64; i += NTHREADS) {
        int r = i >> 6, cc = i & 63;
        float sm = red[(0 * 9 + r) * 64 + cc] + red[(1 * 9 + r) * 64 + cc] + red[(2 * 9 + r) * 64 + cc] + red[(3 * 9 + r) * 64 + cc];
        sm += p->ada_b[(size_t)layer * 6144 + c0 + cc];
        p->mod[((size_t)layer * 9 + r) * 6144 + c0 + cc] = sm;
      }
      __syncthreads();
      continue;
    }
    u -= PU_ADA;
    if (u < PU_T_ABIN) {
      int j = u / 320, t = u % 320;
      prep_transpose_tile(p->ab_w_in + (size_t)j * D * 1280, 1280, p->wt_in_ab + (size_t)j * 1280 * D, D, t / 20, t % 20, fl, tid);
      __syncthreads();
      continue;
    }
    u -= PU_T_ABIN;
    if (u < PU_T_GSIN) {
      int j = u / 512, t = u % 512;
      prep_transpose_tile(p->gs_w_in + (size_t)j * D * 2048, 2048, p->wt_in_gs + (size_t)j * 2048 * D, D, t / 32, t % 32, fl, tid);
      __syncthreads();
      continue;
    }
    u -= PU_T_GSIN;
    if (u < PU_T_GSOUT) {
      int j = u / 256, t = u % 256;
      prep_transpose_tile(p->gs_w_out + (size_t)j * D * D, D, p->wt_out_gs + (size_t)j * D * D, D, t / 16, t % 16, fl, tid);
      __syncthreads();
      continue;
    }
    u -= PU_T_GSOUT;
    if (u < PU_T_ABOUT) {
      int j = u / 128, t = u % 128;
      prep_transpose_tile(p->ab_w_out + (size_t)j * D * D, D, p->wt_out_ab + (size_t)j * D * LDMIX, LDMIX, t / 16, t % 16, fl, tid);
      __syncthreads();
      continue;
    }
    u -= PU_T_ABOUT;
    if (u < PU_T_Q) {
      int i = u / 512, t = u % 512;
      prep_transpose_tile(p->peer_w_q + (size_t)i * D * 2048, 2048, p->wt_q + (size_t)i * 2048 * D, D, t / 32, t % 32, fl, tid);
      __syncthreads();
      continue;
    }
    u -= PU_T_Q;
    if (u < PU_FOLD) {
      const int mh = u & 1, nc = (u >> 1) & 15, g = (u >> 5) & 3, j = u >> 7;
      float2* tw = reinterpret_cast<float2*>(lds);
      float* wt = reinterpret_cast<float*>(lds + 1024);
      if (tid < 128) {
        float sn, cn;
        sincospif((float)tid / 64.f, &sn, &cn);
        tw[tid] = make_float2(cn, sn);
      }
      {
        const float* wsrc = p->ab_w_out + (size_t)j * D * D + (size_t)(512 + g * 128) * D + nc * 64;
#pragma unroll 8
        for (int i = 0; i < 32; ++i) {
          int l = (tid >> 6) + 4 * i;
          wt[l * 64 + (tid & 63)] = wsrc[(size_t)l * D + (tid & 63)];
        }
      }
      __syncthreads();
      const int n = tid & 63, mq = __builtin_amdgcn_readfirstlane(tid >> 6);
      bf16_t* dst = p->wt_out_ab + (size_t)j * D * LDMIX + (size_t)(nc * 64 + n) * LDMIX + g * 128;
#pragma unroll 1
      for (int mi = 0; mi < 16; ++mi) {
        const int m = mh * 64 + mq * 16 + mi;
        float ar = 0.f, ai = 0.f;
#pragma unroll 16
        for (int l = 0; l < 128; ++l) {
          float2 t = tw[(m * l) & 127];
          float wv = wt[l * 64 + n];
          ar += t.x * wv;
          ai += t.y * wv;
        }
        dst[512 + m] = f2bf(ar);
        dst[1024 + m] = f2bf(ai);
      }
      __syncthreads();
      continue;
    }
    u -= PU_FOLD;
    if (u < 2 * PU_UROWS) {
      const bool isv = u >= PU_UROWS;
      if (isv) u -= PU_UROWS;
      const float* src = isv ? p->peer_v : p->peer_u;
      unsigned char* dst = isv ? p->vtab : p->utab;
      float* sdst = isv ? p->sv : p->su;
      const int lane = tid & 63, wv = tid >> 6;
#pragma unroll 1
      for (int rr = 0; rr < 8; rr += 4) {
        size_t row0 = (size_t)u * 32 + wv * 8 + rr;
        float4 v[4][4];
#pragma unroll
        for (int k = 0; k < 4; ++k)
#pragma unroll
          for (int i = 0; i < 4; ++i) v[k][i] = reinterpret_cast<const float4*>(src + (row0 + k) * D)[lane * 4 + i];
#pragma unroll
        for (int k = 0; k < 4; ++k) {
          float am = 0.f;
#pragma unroll
          for (int i = 0; i < 4; ++i)
            am = fmaxf(am, fmaxf(fmaxf(fabsf(v[k][i].x), fabsf(v[k][i].y)), fmaxf(fabsf(v[k][i].z), fabsf(v[k][i].w))));
          am = wave_max(am);
          am = fmaxf(am, 1e-30f);
          float qs = 127.f / am;
          uint4 o;
          unsigned* op = reinterpret_cast<unsigned*>(&o);
#pragma unroll
          for (int i = 0; i < 4; ++i) {
            int q0 = (int)rintf(v[k][i].x * qs), q1 = (int)rintf(v[k][i].y * qs), q2 = (int)rintf(v[k][i].z * qs), q3 = (int)rintf(v[k][i].w * qs);
            op[i] = (unsigned)(q0 & 255) | ((unsigned)(q1 & 255) << 8) | ((unsigned)(q2 & 255) << 16) | ((unsigned)(q3 & 255) << 24);
          }
          reinterpret_cast<uint4*>(dst + (row0 + k) * D)[lane] = o;
          if (lane == 0) sdst[row0 + k] = am * (1.f / 127.f);
        }
      }
      continue;
    }
    u -= 2 * PU_UROWS;
    if (u < PU_KEYS) {
      const float4* s4 = reinterpret_cast<const float4*>(p->peer_keys) + (size_t)u * 2048 + tid;
      uint2* d2 = reinterpret_cast<uint2*>(p->keysb) + (size_t)u * 2048 + tid;
#pragma unroll
      for (int k = 0; k < 8; ++k) {
        float4 v = s4[k * 256];
        uint2 o;
        o.x = pack2(v.x, v.y);
        o.y = pack2(v.z, v.w);
        d2[k * 256] = o;
      }
      continue;
    }
    for (int i = tid; i < 64 * 16; i += NTHREADS) {
      int pos = i >> 4, k = i & 15;
      float inv = powf(10000.f, -(float)k / 16.f);
      float ang = (float)pos * inv;
      float sn, cn;
      sincosf(ang, &sn, &cn);
      p->cs[i] = make_float2(cn, sn);
    }
  }
}

DEVI void norm_row(PP p, int layer, int which, int tok, int lane) {
  const float* w = which == 0 ? p->norm_mix_w + layer * D : (which == 1 ? p->norm_ffn_w + layer * D : p->norm_out_w);
  float4 v[4];
  float ss = 0.f;
  if (which == 0 && layer == 0) {
    const float4* xr = reinterpret_cast<const float4*>((tok < TL) ? p->x + (size_t)tok * D : p->ctx + (size_t)(tok - TL) * D);
#pragma unroll
    for (int i = 0; i < 4; ++i) v[i] = xr[lane + 64 * i];
  } else {
    const uint2* xr = reinterpret_cast<const uint2*>(p->xs + (size_t)tok * D);
#pragma unroll
    for (int i = 0; i < 4; ++i) {
      const uint2 u = xr[lane + 64 * i];
      v[i] = make_float4(bflo(u.x), bfhi(u.x), bflo(u.y), bfhi(u.y));
    }
  }
#pragma unroll
  for (int i = 0; i < 4; ++i) ss += v[i].x * v[i].x + v[i].y * v[i].y + v[i].z * v[i].z + v[i].w * v[i].w;
  ss = wave_sum(ss);
  float rstd = rsqrtf(ss * (1.f / 1024.f) + 1e-6f);
  if (which == 2) {
    float4* o = reinterpret_cast<float4*>(p->out + (size_t)tok * D);
#pragma unroll
    for (int i = 0; i < 4; ++i) {
      float4 wv = reinterpret_cast<const float4*>(w)[lane + 64 * i];
      float4 r;
      r.x = v[i].x * rstd * wv.x;
      r.y = v[i].y * rstd * wv.y;
      r.z = v[i].z * rstd * wv.z;
      r.w = v[i].w * rstd * wv.w;
      o[lane + 64 * i] = r;
    }
  } else {
    int b = tok_batch(tok);
    const float* mb = p->mod + ((size_t)layer * 9 + b) * 6144 + (which == 0 ? 0 : 3072);
    uint2* o = reinterpret_cast<uint2*>(p->h + (size_t)tok * D);
    float av[4][4];
    float am = 0.f;
#pragma unroll
    for (int i = 0; i < 4; ++i) {
      float4 wv = reinterpret_cast<const float4*>(w)[lane + 64 * i];
      float4 sh = reinterpret_cast<const float4*>(mb)[lane + 64 * i];
      float4 sc = reinterpret_cast<const float4*>(mb + 1024)[lane + 64 * i];
      float a0 = v[i].x * rstd * wv.x * (1.f + sc.x) + sh.x;
      float a1 = v[i].y * rstd * wv.y * (1.f + sc.y) + sh.y;
      float a2 = v[i].z * rstd * wv.z * (1.f + sc.z) + sh.z;
      float a3 = v[i].w * rstd * wv.w * (1.f + sc.w) + sh.w;
      uint2 r;
      r.x = pack2(a0, a1);
      r.y = pack2(a2, a3);
      o[lane + 64 * i] = r;
      av[i][0] = a0; av[i][1] = a1; av[i][2] = a2; av[i][3] = a3;
      am = fmaxf(am, fmaxf(fmaxf(fabsf(a0), fabsf(a1)), fmaxf(fabsf(a2), fabsf(a3))));
    }
    if (which == 1) {
      am = fmaxf(wave_max(am), 1e-30f);
      float qs = 127.f / am;
      unsigned* o8 = reinterpret_cast<unsigned*>(p->h8 + (size_t)tok * D);
#pragma unroll
      for (int i = 0; i < 4; ++i) {
        int q0 = (int)rintf(av[i][0] * qs), q1 = (int)rintf(av[i][1] * qs), q2 = (int)rintf(av[i][2] * qs), q3 = (int)rintf(av[i][3] * qs);
        o8[lane + 64 * i] = (unsigned)(q0 & 255) | ((unsigned)(q1 & 255) << 8) | ((unsigned)(q2 & 255) << 16) | ((unsigned)(q3 & 255) << 24);
      }
      if (lane == 0) p->sx[tok] = am * (1.f / 127.f);
    }
  }
}

DEVI void phase_norm(PP p, int layer, int which, int ntok) {
  int lane = ltid() & 63;
  int gw = lbid() * 4 + __builtin_amdgcn_readfirstlane(ltid() >> 6), nw = lnblk() * 4;
  for (int tok = gw; tok < ntok; tok += nw) norm_row(p, layer, which, tok, lane);
}

enum { EPI_STORE = 0, EPI_GELU = 1, EPI_RESID = 2, EPI_INPROJ = 3, EPI_RESID0 = 4 };

template <int EPI>
DEVI void gemm_phase(PP p, const bf16_t* __restrict__ A, int lda, const bf16_t* __restrict__ Bt, int ldb,
                     int Mtiles, int Ntiles, int K, int layer, unsigned char* lds, float gscale = 1.f, int big_t0 = -1, int big_n = 0,
                     int big_ntn = 1) {
  const int tid = ltid();
  const int wid = __builtin_amdgcn_readfirstlane(tid >> 6), lane = tid & 63, wr = wid >> 1, wc = wid & 1, fr = lane & 15, fq = lane >> 4;
  int nblk = lnblk();
  int bid = lbid();
  int lb = bid;
  {
    const int pn = nblk >> 1, pb = bid >> 1;
    if ((pn & 7) == 0) lb = 2 * ((pb & 7) * (pn >> 3) + (pb >> 3)) + (bid & 1);
  }
  int ntiles = (big_t0 >= 0) ? 4 * big_n : Mtiles * Ntiles;
  const int nk = K / 64;
  const int srow = tid >> 3;
  const int scol = ((tid & 7) ^ ((tid >> 3) & 7)) * 8;
#define GEMM_STAGE(ga_, gb_, kt_, buf_)                                                                               \
  {                                                                                                                   \
    _Pragma("unroll") for (int i_ = 0; i_ < 4; ++i_) {                                                                \
      __builtin_amdgcn_global_load_lds((const unsigned*)((ga_) + (size_t)(32 * i_) * lda + (kt_) * 64),               \
                                       (__attribute__((address_space(3))) unsigned*)(lds + (buf_) * 32768 + tid * 16 + i_ * 4096), 16, 0, 0); \
      __builtin_amdgcn_global_load_lds((const unsigned*)((gb_) + (size_t)(32 * i_) * ldb + (kt_) * 64),               \
                                       (__attribute__((address_space(3))) unsigned*)(lds + (buf_) * 32768 + 16384 + tid * 16 + i_ * 4096), 16, 0, 0); \
    }                                                                                                                 \
  }
  auto tile_rc = [&](int t, int& tm_, int& tn_) {
    if (big_t0 >= 0) {
      int bt = big_t0 + (t >> 2), q = t & 3;
      tm_ = 2 * (bt / big_ntn) + (q >> 1);
      tn_ = 2 * (bt % big_ntn) + (q & 1);
    } else {
      tm_ = t / Ntiles;
      tn_ = t % Ntiles;
    }
  };
  if (lb < ntiles) {
    int tm0, tn0;
    tile_rc(lb, tm0, tn0);
    const bf16_t* ga0 = A + (size_t)(tm0 * 128 + srow) * lda + scol;
    const bf16_t* gb0 = Bt + (size_t)(tn0 * 128 + srow) * ldb + scol;
    GEMM_STAGE(ga0, gb0, 0, 0)
  }
  for (int t = lb; t < ntiles; t += nblk) {
    int tm, tn;
    tile_rc(t, tm, tn);
    int brow = tm * 128, bcol = tn * 128;
    f32x4 acc[4][4];
#pragma unroll
    for (int m = 0; m < 4; ++m)
#pragma unroll
      for (int n = 0; n < 4; ++n) acc[m][n] = f32x4{0.f, 0.f, 0.f, 0.f};
    const bf16_t* ga = A + (size_t)(brow + srow) * lda + scol;
    const bf16_t* gb = Bt + (size_t)(bcol + srow) * ldb + scol;
    for (int kt = 0; kt < nk; ++kt) {
      const int buf = kt & 1;
      asm volatile("s_waitcnt vmcnt(0)" ::: "memory");
      __syncthreads();
      if (kt + 1 < nk) GEMM_STAGE(ga, gb, kt + 1, buf ^ 1)
      const unsigned char* SA = lds + buf * 32768;
      const unsigned char* SB = SA + 16384;
      bf16x8 At[2][4], Bl[2][4];
#pragma unroll
      for (int ks = 0; ks < 2; ++ks)
#pragma unroll
        for (int m = 0; m < 4; ++m) {
          const int sl = ((ks * 4 + fq) ^ (fr & 7)) << 4;
          At[ks][m] = *reinterpret_cast<const bf16x8*>(SA + (wr * 64 + m * 16 + fr) * 128 + sl);
          Bl[ks][m] = *reinterpret_cast<const bf16x8*>(SB + (wc * 64 + m * 16 + fr) * 128 + sl);
        }
#pragma unroll
      for (int ks = 0; ks < 2; ++ks)
#pragma unroll
        for (int m = 0; m < 4; ++m)
#pragma unroll
          for (int n = 0; n < 4; ++n)
            acc[m][n] = __builtin_amdgcn_mfma_f32_16x16x32_bf16(At[ks][m], Bl[ks][n], acc[m][n], 0, 0, 0);
    }
    {
      int t2 = t + nblk;
      if (t2 < ntiles) {
        int tm2, tn2;
        tile_rc(t2, tm2, tn2);
        const bf16_t* ga2 = A + (size_t)(tm2 * 128 + srow) * lda + scol;
        const bf16_t* gb2 = Bt + (size_t)(tn2 * 128 + srow) * ldb + scol;
        GEMM_STAGE(ga2, gb2, 0, 0)
      }
    }
    const int colbase = bcol + wc * 64;
    if constexpr (EPI == EPI_STORE || EPI == EPI_GELU) {
      if (EPI == EPI_GELU && colbase >= 1024) {
        float* rsp = p->rowss + ((size_t)tm * 32 + ((colbase - 1024) >> 5)) * 128;
#pragma unroll
        for (int m = 0; m < 4; ++m) {
          float ssq[4] = {0.f, 0.f, 0.f, 0.f};
#pragma unroll
          for (int n = 0; n < 4; ++n) {
            int ch = colbase - 1024 + n * 16 + fr;
            int q0 = wr * 64 + m * 16 + fq * 4;
            float g0 = gelu_tanh(acc[m][n][0]), g1 = gelu_tanh(acc[m][n][1]), g2 = gelu_tanh(acc[m][n][2]), g3 = gelu_tanh(acc[m][n][3]);
            ssq[0] += g0 * g0;
            ssq[1] += g1 * g1;
            ssq[2] += g2 * g2;
            ssq[3] += g3 * g3;
            uint2 o;
            o.x = pack2(g0, g1);
            o.y = pack2(g2, g3);
            *reinterpret_cast<uint2*>(p->zvT + ((size_t)tm * 1024 + ch) * 128 + q0) = o;
          }
#pragma unroll
          for (int j = 0; j < 4; ++j) {
            float v = ssq[j];
            v += dpp_mov<0xB1>(v);
            v += dpp_mov<0x4E>(v);
            v += dpp_mov<0x141>(v);
            v += dpp_mov<0x140>(v);
            if (fr == 0) {
              rsp[wr * 64 + m * 16 + fq * 4 + j] = v;
              rsp[128 + wr * 64 + m * 16 + fq * 4 + j] = 0.f;
            }
          }
        }
      } else {
#pragma unroll
        for (int m = 0; m < 4; ++m)
#pragma unroll
          for (int j = 0; j < 4; ++j) {
            int row = brow + wr * 64 + m * 16 + fq * 4 + j;
            bf16_t* o = p->P + (size_t)row * 2048 + colbase + fr;
#pragma unroll
            for (int n = 0; n < 4; ++n) {
              float v = acc[m][n][j];
              if (EPI == EPI_GELU) v = gelu_tanh(v);
              o[n * 16] = f2bf(v);
            }
          }
      }
    } else if constexpr (EPI == EPI_RESID) {
#pragma unroll
      for (int m = 0; m < 4; ++m)
#pragma unroll
        for (int j = 0; j < 4; ++j) {
          int row = brow + wr * 64 + m * 16 + fq * 4 + j;
          int b = tok_batch(row);
          const float* g = p->mod + ((size_t)layer * 9 + b) * 6144 + 2048 + colbase + fr;
          bf16_t* o = p->xs + (size_t)row * D + colbase + fr;
          if (layer == 0 && gscale == 1.f) {
            const float* xi = ((row < TL) ? p->x + (size_t)row * D : p->ctx + (size_t)(row - TL) * D) + colbase + fr;
#pragma unroll
            for (int n = 0; n < 4; ++n) o[n * 16] = f2bf(xi[n * 16] + gscale * g[n * 16] * acc[m][n][j]);
          } else {
#pragma unroll
            for (int n = 0; n < 4; ++n) o[n * 16] = f2bf(bf2f(o[n * 16]) + gscale * g[n * 16] * acc[m][n][j]);
          }
        }
    } else if constexpr (EPI == EPI_INPROJ) {
      if (colbase >= 640 && colbase < 768) {
        int kvh = (colbase - 640) >> 6;
#pragma unroll
        for (int m = 0; m < 4; ++m) {
          int row0 = brow + wr * 64 + m * 16;
          bool latent = row0 < TL;
          int b = latent ? (row0 >> 12) : ((row0 - TL) >> 8);
          int kp16 = latent ? (CTX + (row0 & 4095)) : ((row0 - TL) & 255);
          int slot = kp16 + 8 * (fq & 1) + 4 * (fq >> 1);
#pragma unroll
          for (int n = 0; n < 4; ++n) {
            int dim = n * 16 + fr;
            uint2 o;
            o.x = pack2(acc[m][n][0], acc[m][n][1]);
            o.y = pack2(acc[m][n][2], acc[m][n][3]);
            *reinterpret_cast<uint2*>(p->vbuf + ((size_t)(b * 2 + kvh) * 64 + dim) * KVLEN + slot) = o;
          }
        }
      } else {
#pragma unroll
        for (int m = 0; m < 4; ++m)
#pragma unroll
          for (int j = 0; j < 4; ++j) {
            int row = brow + wr * 64 + m * 16 + fq * 4 + j;
            bool latent = row < TL;
            int b, pos;
            if (latent) {
              b = row >> 12;
              pos = row & 4095;
            } else {
              b = (row - TL) >> 8;
              pos = (row - TL) & 255;
            }
            float v0 = acc[m][0][j], v1 = acc[m][1][j], v2 = acc[m][2][j], v3 = acc[m][3][j];
            if (latent && colbase < 640) {
              float2 cr = p->cs[(pos >> 6) * 16 + fr];
              float2 cc = p->cs[(pos & 63) * 16 + fr];
              float a = v0, bb = v1;
              v0 = a * cr.x - bb * cr.y;
              v1 = bb * cr.x + a * cr.y;
              a = v2;
              bb = v3;
              v2 = a * cc.x - bb * cc.y;
              v3 = bb * cc.x + a * cc.y;
            }
            bf16_t* o;
            if (colbase < 512 || colbase >= 768) {
              o = p->P + (size_t)row * 2048 + colbase + fr;
            } else {
              int kvh = (colbase - 512) >> 6;
              int kp = latent ? (CTX + pos) : pos;
              o = p->kbuf + ((size_t)(b * 2 + kvh) * KVLEN + kp) * 64 + fr;
            }
            o[0] = f2bf(v0);
            o[16] = f2bf(v1);
            o[32] = f2bf(v2);
            o[48] = f2bf(v3);
          }
      }
    }
  }
}

constexpr int G8_HT = 128 * 64;
DEVI int g8_lds_byte(int r, int c) {
  int st = (r >> 4) * 2 + (c >> 5), rr = r & 15, cc = c & 31, ob = rr * 64 + cc * 2;
  return st * 1024 + (ob ^ (((ob >> 9) & 1) << 5));
}
DEVI void g8_stage_rc(int b, int& R, int& C) {
  int st = b / 1024, sb = b % 1024, swz = sb ^ (((sb >> 9) & 1) << 5);
  R = (st >> 1) * 16 + swz / 64;
  C = (st & 1) * 32 + (swz % 64) / 2;
}
template <int EPI, bool STAGED>
DEVI void gemm8_epilogue(PP p, f32x4 (&acc)[2][2][4][2], const f32x4* stg, int lane, int brow, int bcol, int wr, int wc, int fr, int fq, int layer, float gscale) {
#pragma unroll
  for (int ai_ = 0; ai_ < 2; ++ai_)
#pragma unroll
    for (int bj = 0; bj < 2; ++bj) {
      const int ai = STAGED ? 1 - ai_ : ai_;
      f32x4 q[4][2];
#pragma unroll
      for (int m = 0; m < 4; ++m)
#pragma unroll
        for (int n = 0; n < 2; ++n) q[m][n] = (STAGED && ai == 0) ? stg[(((bj * 4 + m) * 2 + n) * 64) + lane] : acc[ai][bj][m][n];
      const int r0 = brow + ai * 128 + wr * 64;
      const int c0 = bcol + bj * 128 + wc * 32;
      if constexpr (EPI == EPI_STORE) {
#pragma unroll
        for (int m = 0; m < 4; ++m)
#pragma unroll
          for (int j = 0; j < 4; ++j) {
            bf16_t* o = p->P + (size_t)(r0 + m * 16 + fq * 4 + j) * 2048 + c0 + fr;
            o[0] = f2bf(q[m][0][j]);
            o[16] = f2bf(q[m][1][j]);
          }
      } else if constexpr (EPI == EPI_GELU) {
        if (c0 >= 1024) {
          const int chunk = r0 >> 7;
          float* rsp = p->rowss + ((size_t)chunk * 32 + ((c0 - 1024) >> 5)) * 128;
#pragma unroll
          for (int m = 0; m < 4; ++m) {
            float ssq[4] = {0.f, 0.f, 0.f, 0.f};
            const int q0 = (r0 & 127) + m * 16 + fq * 4;
#pragma unroll
            for (int n = 0; n < 2; ++n) {
              int ch = c0 - 1024 + n * 16 + fr;
              float g0 = gelu_tanh(q[m][n][0]), g1 = gelu_tanh(q[m][n][1]);
              float g2 = gelu_tanh(q[m][n][2]), g3 = gelu_tanh(q[m][n][3]);
              ssq[0] += g0 * g0;
              ssq[1] += g1 * g1;
              ssq[2] += g2 * g2;
              ssq[3] += g3 * g3;
              uint2 o;
              o.x = pack2(g0, g1);
              o.y = pack2(g2, g3);
              *reinterpret_cast<uint2*>(p->zvT + ((size_t)chunk * 1024 + ch) * 128 + q0) = o;
            }
#pragma unroll
            for (int j = 0; j < 4; ++j) {
              float v = ssq[j];
              v += dpp_mov<0xB1>(v);
              v += dpp_mov<0x4E>(v);
              v += dpp_mov<0x141>(v);
              v += dpp_mov<0x140>(v);
              if (fr == 0) rsp[q0 + j] = v;
            }
          }
        } else {
#pragma unroll
          for (int m = 0; m < 4; ++m)
#pragma unroll
            for (int j = 0; j < 4; ++j) {
              bf16_t* o = p->P + (size_t)(r0 + m * 16 + fq * 4 + j) * 2048 + c0 + fr;
              o[0] = f2bf(gelu_tanh(q[m][0][j]));
              o[16] = f2bf(gelu_tanh(q[m][1][j]));
            }
        }
      }
      __builtin_amdgcn_sched_barrier(0);
    }
}

DEVI int g8_perm32(int rho) { const int n = rho >> 4, i = rho & 15; return 8 * (i >> 2) + 4 * n + (i & 3); }
template <int EPI>
DEVI void gemm8_epilogue_tr(PP p, f32x4 (&acc)[2][2][4][2], int brow, int bcol, int wr, int wc, int fr, int fq, int layer, float gscale) {
  if constexpr (EPI == EPI_STORE) {
    if (PROBE_PH && PROBE_SKIP_EPI && gscale == 0.f) return;
#pragma unroll
    for (int ai = 0; ai < 2; ++ai)
#pragma unroll
      for (int m = 0; m < 4; ++m) {
        bf16_t* o = p->P + (size_t)(brow + ai * 128 + wr * 64 + m * 16 + fr) * 2048 + bcol + wc * 32 + 8 * fq;
#pragma unroll
        for (int bj = 0; bj < 2; ++bj) {
          const f32x4 v0 = acc[ai][bj][m][0], v1 = acc[ai][bj][m][1];
          uint4 w;
          w.x = pack2(v0[0], v0[1]);
          w.y = pack2(v0[2], v0[3]);
          w.z = pack2(v1[0], v1[1]);
          w.w = pack2(v1[2], v1[3]);
          *reinterpret_cast<uint4*>(o + bj * 128) = w;
        }
      }
  } else if constexpr (EPI == EPI_RESID || EPI == EPI_RESID0) {
    const unsigned loff = (unsigned)(fr * D + 8 * fq);
    const float* gb = p->mod + ((size_t)layer * 9 + tok_batch(brow)) * 6144 + 2048 + bcol + wc * 32 + 8 * fq;
    if constexpr (EPI == EPI_RESID0) {
      const float* xin = (brow < TL) ? p->x : p->ctx - (size_t)TL * D;
#pragma unroll
      for (int bj = 0; bj < 2; ++bj) {
        const int ucol = bcol + bj * 128 + wc * 32;
        const f32x4 g0 = *reinterpret_cast<const f32x4*>(gb + bj * 128) * gscale, g1 = *reinterpret_cast<const f32x4*>(gb + bj * 128 + 4) * gscale;
        f32x4 xr[2][4][2];
#pragma unroll
        for (int ai = 0; ai < 2; ++ai)
#pragma unroll
          for (int m = 0; m < 4; ++m) {
            const float* xi = xin + (size_t)(brow + ai * 128 + wr * 64 + m * 16) * D + ucol;
            xr[ai][m][0] = *reinterpret_cast<const f32x4*>(xi + loff);
            xr[ai][m][1] = *reinterpret_cast<const f32x4*>(xi + loff + 4);
          }
        __builtin_amdgcn_sched_barrier(0);
#pragma unroll
        for (int ai = 0; ai < 2; ++ai)
#pragma unroll
          for (int m = 0; m < 4; ++m) {
            bf16_t* o = p->xs + (size_t)(brow + ai * 128 + wr * 64 + m * 16) * D + ucol;
            const f32x4 r0 = xr[ai][m][0] + g0 * acc[ai][bj][m][0], r1 = xr[ai][m][1] + g1 * acc[ai][bj][m][1];
            uint4 w;
            w.x = pack2(r0[0], r0[1]);
            w.y = pack2(r0[2], r0[3]);
            w.z = pack2(r1[0], r1[1]);
            w.w = pack2(r1[2], r1[3]);
            *reinterpret_cast<uint4*>(o + loff) = w;
          }
        __builtin_amdgcn_sched_barrier(0);
      }
    } else {
      uint4 xr[2][2][4];
#pragma unroll
      for (int bj = 0; bj < 2; ++bj)
#pragma unroll
        for (int ai = 0; ai < 2; ++ai)
#pragma unroll
          for (int m = 0; m < 4; ++m)
            xr[bj][ai][m] = *reinterpret_cast<const uint4*>(p->xs + (size_t)(brow + ai * 128 + wr * 64 + m * 16) * D + bcol + bj * 128 + wc * 32 + loff);
      __builtin_amdgcn_sched_barrier(0);
#pragma unroll
      for (int bj = 0; bj < 2; ++bj) {
        const f32x4 g0 = *reinterpret_cast<const f32x4*>(gb + bj * 128) * gscale, g1 = *reinterpret_cast<const f32x4*>(gb + bj * 128 + 4) * gscale;
#pragma unroll
        for (int ai = 0; ai < 2; ++ai)
#pragma unroll
          for (int m = 0; m < 4; ++m) {
            const uint4 u = xr[bj][ai][m];
            const f32x4 x0 = {bflo(u.x), bfhi(u.x), bflo(u.y), bfhi(u.y)}, x1 = {bflo(u.z), bfhi(u.z), bflo(u.w), bfhi(u.w)};
            const f32x4 r0 = x0 + g0 * acc[ai][bj][m][0], r1 = x1 + g1 * acc[ai][bj][m][1];
            uint4 w;
            w.x = pack2(r0[0], r0[1]);
            w.y = pack2(r0[2], r0[3]);
            w.z = pack2(r1[0], r1[1]);
            w.w = pack2(r1[2], r1[3]);
            *reinterpret_cast<uint4*>(p->xs + (size_t)(brow + ai * 128 + wr * 64 + m * 16) * D + bcol + bj * 128 + wc * 32 + loff) = w;
          }
      }
      __builtin_amdgcn_sched_barrier(0);
    }
  } else if constexpr (EPI == EPI_INPROJ) {
    const bool latent = brow < TL;
#pragma unroll
    for (int bj = 0; bj < 2; ++bj) {
      const int c0 = bcol + bj * 128 + wc * 32;
      if (c0 >= 640 && c0 < 768) {
        const int kvh = (c0 - 640) >> 6, d0 = ((c0 - 640) & 63) + 4 * fq;
        const int so = 8 * ((fr >> 2) & 1) + 4 * (fr >> 3) + (fr & 3);
#pragma unroll
        for (int ai = 0; ai < 2; ++ai)
#pragma unroll
          for (int m = 0; m < 4; ++m) {
            const int row0 = brow + ai * 128 + wr * 64 + m * 16;
            const int b = latent ? (row0 >> 12) : ((row0 - TL) >> 8);
            const int kp16 = latent ? (CTX + (row0 & 4095)) : ((row0 - TL) & 255);
            bf16_t* o = p->vbuf + ((size_t)(b * 2 + kvh) * 64 + d0) * KVLEN + kp16 + so;
#pragma unroll
            for (int n = 0; n < 2; ++n)
#pragma unroll
              for (int j = 0; j < 4; ++j) o[(size_t)(n * 16 + j) * KVLEN] = f2bf(acc[ai][bj][m][n][j]);
          }
      } else {
        const int hsel = (c0 >> 5) & 1;
#pragma unroll
        for (int ai = 0; ai < 2; ++ai)
#pragma unroll
          for (int m = 0; m < 4; ++m) {
            const int row = brow + ai * 128 + wr * 64 + m * 16 + fr;
            const int b = latent ? (row >> 12) : ((row - TL) >> 8);
            const int pos = latent ? (row & 4095) : ((row - TL) & 255);
            f32x4 v0 = acc[ai][bj][m][0], v1 = acc[ai][bj][m][1];
            if (latent && c0 < 640) {
              const f32x4* cp = reinterpret_cast<const f32x4*>(p->cs + (hsel ? (pos & 63) : (pos >> 6)) * 16 + 4 * fq);
              const f32x4 ca = cp[0], cb = cp[1];
              const f32x4 a = v0, bb = v1;
              v0[0] = a[0] * ca[0] - bb[0] * ca[1];
              v1[0] = bb[0] * ca[0] + a[0] * ca[1];
              v0[1] = a[1] * ca[2] - bb[1] * ca[3];
              v1[1] = bb[1] * ca[2] + a[1] * ca[3];
              v0[2] = a[2] * cb[0] - bb[2] * cb[1];
              v1[2] = bb[2] * cb[0] + a[2] * cb[1];
              v0[3] = a[3] * cb[2] - bb[3] * cb[3];
              v1[3] = bb[3] * cb[2] + a[3] * cb[3];
            }
            bf16_t* o;
            if (c0 < 512 || c0 >= 768) {
              o = p->P + (size_t)row * 2048 + c0 + 4 * fq;
            } else {
              const int kvh = (c0 - 512) >> 6, d0 = (c0 - 512) & 63;
              const int kp = latent ? (CTX + pos) : pos;
              o = p->kbuf + ((size_t)(b * 2 + kvh) * KVLEN + kp) * 64 + d0 + 4 * fq;
            }
            uint2 w0, w1;
            w0.x = pack2(v0[0], v0[1]);
            w0.y = pack2(v0[2], v0[3]);
            w1.x = pack2(v1[0], v1[1]);
            w1.y = pack2(v1[2], v1[3]);
            *reinterpret_cast<uint2*>(o) = w0;
            *reinterpret_cast<uint2*>(o + 16) = w1;
          }
      }
      __builtin_amdgcn_sched_barrier(0);
    }
  }
}

template <int EPI>
DEVI void gemm8_phase(PP p, const bf16_t* __restrict__ A, int lda, const bf16_t* __restrict__ Bt, int ldb, int Mtiles, int Ntiles,
                      int K, int layer, unsigned char* lds_all, float gscale = 1.f) {
  constexpr bool TR = (EPI != EPI_GELU);
  constexpr bool PERM = (EPI == EPI_STORE || EPI == EPI_RESID || EPI == EPI_RESID0);
  bf16_t* shm = reinterpret_cast<bf16_t*>(lds_all);
  const int tid = ptid();
  const int wid = __builtin_amdgcn_readfirstlane(tid >> 6), lane = tid & 63, wr = wid >> 2, wc = wid & 3, fr = lane & 15, fq = lane >> 4;
#define G8_SA(b, h) (shm + ((b) * 2 + (h)) * G8_HT)
#define G8_SB(b, h) (shm + (4 + (b) * 2 + (h)) * G8_HT)
  const __amdgpu_buffer_rsrc_t rsA = __builtin_amdgcn_make_buffer_rsrc((void*)A, (short)0, -1, 0x00020000);
  const __amdgpu_buffer_rsrc_t rsB = __builtin_amdgcn_make_buffer_rsrc((void*)Bt, (short)0, -1, 0x00020000);
  unsigned voA[2], voB[2];
#pragma unroll
  for (int i = 0; i < 2; ++i) {
    int r_, c_;
    g8_stage_rc(tid * 16 + i * 8192, r_, c_);
    const int rb_ = PERM ? ((r_ & ~31) + g8_perm32(r_ & 31)) : r_;
    voA[i] = (unsigned)((r_ * lda + c_) * 2);
    voB[i] = (unsigned)((rb_ * ldb + c_) * 2);
  }
#define G8_STAGE(P_, RS_, VO_, ld_, br_, kt_)                                                                         \
  do {                                                                                                                \
    const unsigned so_ = (unsigned)(((br_) * (ld_) + (kt_) * 64) * 2);                                                \
    _Pragma("unroll") for (int i_ = 0; i_ < 2; ++i_)                                                                  \
      __builtin_amdgcn_raw_ptr_buffer_load_lds(RS_, (__attribute__((address_space(3))) void*)((unsigned char*)(P_) + wid * 1024 + i_ * 8192), 16, VO_[i_], so_, 0, 0); \
  } while (0)
#define G8_LDA(dst, b, h)                                                                                             \
  _Pragma("unroll") for (int m_ = 0; m_ < 4; ++m_) _Pragma("unroll") for (int k_ = 0; k_ < 2; ++k_)                   \
      dst[m_][k_] = *reinterpret_cast<const bf16x8*>((const unsigned char*)G8_SA(b, h) + g8_lds_byte(wr * 64 + m_ * 16 + fr, k_ * 32 + fq * 8))
#define G8_LDB(dst, b, h)                                                                                             \
  _Pragma("unroll") for (int n_ = 0; n_ < 2; ++n_) _Pragma("unroll") for (int k_ = 0; k_ < 2; ++k_)                   \
      dst[n_][k_] = *reinterpret_cast<const bf16x8*>((const unsigned char*)G8_SB(b, h) + g8_lds_byte(wc * 32 + n_ * 16 + fr, k_ * 32 + fq * 8))
#define G8_MMA(ai, bj, At_, Bt_)                                                                                      \
  do {                                                                                                                \
    __builtin_amdgcn_s_setprio(1);                                                                                    \
    _Pragma("unroll") for (int m_ = 0; m_ < 4; ++m_) _Pragma("unroll") for (int n_ = 0; n_ < 2; ++n_)                 \
        _Pragma("unroll") for (int k_ = 0; k_ < 2; ++k_) acc[ai][bj][m_][n_] =                                        \
            TR ? __builtin_amdgcn_mfma_f32_16x16x32_bf16(Bt_[n_][k_], At_[m_][k_], acc[ai][bj][m_][n_], 0, 0, 0)      \
               : __builtin_amdgcn_mfma_f32_16x16x32_bf16(At_[m_][k_], Bt_[n_][k_], acc[ai][bj][m_][n_], 0, 0, 0);     \
    __builtin_amdgcn_s_setprio(0);                                                                                    \
  } while (0)
#define G8_WAIT_V(n) asm volatile("s_waitcnt vmcnt(" #n ")" ::: "memory")
#define G8_WAIT_L(n) asm volatile("s_waitcnt lgkmcnt(" #n ")" ::: "memory")
#define G8_BAR __builtin_amdgcn_s_barrier()
#define G8_SCHED __builtin_amdgcn_sched_barrier(0)
  const int nblk = pnblk(), bid = pbid();
  const int lb = ((nblk & 7) == 0) ? ((bid & 7) * (nblk >> 3) + (bid >> 3)) : bid;
  const int ntiles_all = Mtiles * Ntiles;
  const int ntiles = (ntiles_all / nblk) * nblk;
  const int nt = K / 64;
  if (lb < ntiles) {
    int t = lb;
    int brow = (t / Ntiles) * 256, bcol = (t % Ntiles) * 256;
    f32x4 acc[2][2][4][2];
#pragma unroll
    for (int a0 = 0; a0 < 2; ++a0)
#pragma unroll
      for (int b0 = 0; b0 < 2; ++b0)
#pragma unroll
        for (int m = 0; m < 4; ++m)
#pragma unroll
          for (int n = 0; n < 2; ++n) acc[a0][b0][m][n] = f32x4{0.f, 0.f, 0.f, 0.f};
    bf16x8 At[4][2], B0[2][2], B1[2][2];
    G8_STAGE(G8_SB(0, 0), rsB, voB, ldb, bcol, 0);
    G8_STAGE(G8_SA(0, 0), rsA, voA, lda, brow, 0);
    G8_STAGE(G8_SB(0, 1), rsB, voB, ldb, bcol + 128, 0);
    G8_STAGE(G8_SA(0, 1), rsA, voA, lda, brow + 128, 0);
    if (wr == 1) G8_BAR;
    G8_WAIT_V(4);
    G8_BAR;
    G8_STAGE(G8_SB(1, 0), rsB, voB, ldb, bcol, 1);
    G8_STAGE(G8_SA(1, 0), rsA, voA, lda, brow, 1);
    G8_STAGE(G8_SB(1, 1), rsB, voB, ldb, bcol + 128, 1);
    G8_WAIT_V(6);
    G8_BAR;
    for (;;) {
      const int tnx = t + nblk;
      const bool has_next = tnx < ntiles;
      const int nbrow = has_next ? (tnx / Ntiles) * 256 : brow, nbcol = has_next ? (tnx % Ntiles) * 256 : bcol;
      for (int kt = 0; kt < nt; kt += 2) {
        const bool last = (kt == nt - 2);
        const int a2 = last ? nbrow : brow, b2 = last ? nbcol : bcol, k2 = last ? 0 : kt + 2;
        G8_LDB(B0, 0, 0); G8_SCHED; G8_LDA(At, 0, 0); G8_STAGE(G8_SA(1, 1), rsA, voA, lda, brow + 128, kt + 1);
        G8_WAIT_L(8); G8_BAR; G8_WAIT_L(0); G8_MMA(0, 0, At, B0); G8_BAR; G8_SCHED;
        G8_LDB(B1, 0, 1); G8_STAGE(G8_SB(0, 0), rsB, voB, ldb, b2, k2);
        G8_BAR; G8_WAIT_L(0); G8_MMA(0, 1, At, B1); G8_BAR;
        G8_LDA(At, 0, 1); G8_STAGE(G8_SA(0, 0), rsA, voA, lda, a2, k2);
        G8_BAR; G8_WAIT_L(0); G8_MMA(1, 0, At, B0); G8_BAR; G8_SCHED;
        G8_STAGE(G8_SB(0, 1), rsB, voB, ldb, b2 + 128, k2);
        G8_WAIT_V(6); G8_BAR; G8_MMA(1, 1, At, B1); G8_BAR;
        G8_LDB(B0, 1, 0); G8_SCHED; G8_LDA(At, 1, 0); G8_STAGE(G8_SA(0, 1), rsA, voA, lda, a2 + 128, k2);
        G8_WAIT_L(8); G8_BAR; G8_WAIT_L(0); G8_MMA(0, 0, At, B0); G8_BAR; G8_SCHED;
        G8_LDB(B1, 1, 1); G8_STAGE(G8_SB(1, 0), rsB, voB, ldb, b2, k2 + 1);
        G8_BAR; G8_WAIT_L(0); G8_MMA(0, 1, At, B1); G8_BAR;
        G8_LDA(At, 1, 1); G8_STAGE(G8_SA(1, 0), rsA, voA, lda, a2, k2 + 1);
        G8_BAR; G8_WAIT_L(0); G8_MMA(1, 0, At, B0); G8_BAR; G8_SCHED;
        G8_STAGE(G8_SB(1, 1), rsB, voB, ldb, b2 + 128, k2 + 1);
        G8_WAIT_V(6); G8_BAR; G8_MMA(1, 1, At, B1); G8_BAR;
      }
      {
        int lane2 = lane_id();
        asm volatile("" : "+v"(lane2));
        const int fr2 = lane2 & 15, fq2 = lane2 >> 4;
        if constexpr (TR) gemm8_epilogue_tr<EPI>(p, acc, brow, bcol, wr, wc, fr2, fq2, layer, gscale);
        else gemm8_epilogue<EPI, false>(p, acc, nullptr, lane2, brow, bcol, wr, wc, fr2, fq2, layer, gscale);
      }
      if (!has_next) break;
#pragma unroll
      for (int a0 = 0; a0 < 2; ++a0)
#pragma unroll
        for (int b0 = 0; b0 < 2; ++b0)
#pragma unroll
          for (int m = 0; m < 4; ++m)
#pragma unroll
            for (int n = 0; n < 2; ++n) acc[a0][b0][m][n] = f32x4{0.f, 0.f, 0.f, 0.f};
      t = tnx;
      brow = nbrow;
      bcol = nbcol;
    }
    G8_WAIT_V(0);
    if (wr == 0) G8_BAR;
  }
  __syncthreads();
  if (ntiles < ntiles_all) {
    constexpr int EPI_T = (EPI == EPI_RESID0) ? EPI_RESID : EPI;
    gemm_phase<EPI_T>(p, A, lda, Bt, ldb, 0, 0, K, layer, lds_all + (wid >> 2) * LDS_HALF, gscale, ntiles, ntiles_all - ntiles, Ntiles);
  }
#undef G8_SA
#undef G8_SB
#undef G8_STAGE
#undef G8_LDA
#undef G8_LDB
#undef G8_MMA
#undef G8_WAIT_V
#undef G8_WAIT_L
#undef G8_BAR
#undef G8_SCHED
}

DEVI bf16x8 scale_q(uint4 u) {
  uint4 r;
  r.x = pack2(bflo(u.x) * 0.125f, bfhi(u.x) * 0.125f);
  r.y = pack2(bflo(u.y) * 0.125f, bfhi(u.y) * 0.125f);
  r.z = pack2(bflo(u.z) * 0.125f, bfhi(u.z) * 0.125f);
  r.w = pack2(bflo(u.w) * 0.125f, bfhi(u.w) * 0.125f);
  return __builtin_bit_cast(bf16x8, r);
}
DEVI void phase_attn(PP p, int layer, bool with_ctx_q, unsigned char* lds) {
  const int tid = ltid();
  const int lane = tid & 63, wid = __builtin_amdgcn_readfirstlane(tid >> 6), r = lane & 31, h = lane >> 5;
  const float* sinkp = p->attn_sink + (layer >> 1) * 8;
  const int nlat = NB * 2 * 128;
  const int nunits = nlat + (with_ctx_q ? NB * 2 * 8 : 0);
  for (int u = lbid(); u < nunits; u += lnblk()) {
    bool latent = u < nlat;
    int b, kvh, qg, tokbase;
    if (latent) {
      b = u >> 8;
      kvh = (u >> 7) & 1;
      qg = u & 127;
      tokbase = b * SEQ + qg * 32;
    } else {
      int v = u - nlat;
      b = v >> 4;
      kvh = (v >> 3) & 1;
      qg = v & 7;
      tokbase = TL + b * CTX + qg * 32;
    }
    const int hd = kvh * 4 + wid;
    const bf16_t* kb = p->kbuf + (size_t)(b * 2 + kvh) * KVLEN * 64;
    const bf16_t* vt = p->vbuf + (size_t)(b * 2 + kvh) * 64 * KVLEN;
    const int nch = latent ? 5 : 2;
    const int lbase = CTX + (qg - 4) * 32;
#define ATT_STAGE(c_, buf_)                                                                                           \
  {                                                                                                                   \
    const int kp0_ = ((c_) < 2) ? (c_) * 128 : lbase + ((c_) - 2) * 128;                                              \
    _Pragma("unroll") for (int i_ = 0; i_ < 4; ++i_) {                                                                \
      const int P_ = tid * 16 + i_ * 4096;                                                                            \
      const int krow_ = P_ >> 7, kslot_ = (P_ >> 4) & 7;                                                              \
      int kp_ = kp0_ + krow_;                                                                                         \
      kp_ = kp_ < 0 ? 0 : (kp_ > KVLEN - 1 ? KVLEN - 1 : kp_);                                                        \
      __builtin_amdgcn_global_load_lds((const unsigned*)(kb + (size_t)kp_ * 64 + ((kslot_ ^ ((krow_ >> 1) & 7)) << 3)), \
                                       (__attribute__((address_space(3))) unsigned*)(lds + (buf_) * 32768 + P_), 16, 0, 0); \
      const int vrow_ = P_ >> 8, vslot_ = (P_ >> 4) & 15;                                                             \
      int vp_ = kp0_ + ((vslot_ ^ (vrow_ & 15)) << 3);                                                                \
      vp_ = vp_ < 0 ? 0 : (vp_ > KVLEN - 8 ? KVLEN - 8 : vp_);                                                        \
      __builtin_amdgcn_global_load_lds((const unsigned*)(vt + (size_t)vrow_ * KVLEN + vp_),                           \
                                       (__attribute__((address_space(3))) unsigned*)(lds + (buf_) * 32768 + 16384 + P_), 16, 0, 0); \
    }                                                                                                                 \
  }
    __syncthreads();
    ATT_STAGE(0, 0)
    bf16x8 qf[4];
    {
      const bf16_t* qp = p->P + (size_t)(tokbase + r) * 2048 + hd * 64 + 8 * h;
#pragma unroll
      for (int st = 0; st < 4; ++st) qf[st] = scale_q(*reinterpret_cast<const uint4*>(qp + 16 * st));
    }
    f32x16 O0, O1;
#pragma unroll
    for (int i = 0; i < 16; ++i) {
      O0[i] = 0.f;
      O1[i] = 0.f;
    }
    float m_run = sinkp[hd];
    float l_run = (h == 0) ? 1.f : 0.f;
    for (int c = 0; c < nch; ++c) {
      const int buf = c & 1;
      asm volatile("s_waitcnt vmcnt(0)" ::: "memory");
      __syncthreads();
      if (c + 1 < nch) ATT_STAGE(c + 1, buf ^ 1)
      const unsigned char* LK = lds + buf * 32768;
      const unsigned char* LV = LK + 16384;
#pragma unroll 1
      for (int kbi = 0; kbi < 4; ++kbi) {
        int mode = 0;
        if (c >= 2) {
          const int d = (c - 2) * 4 + kbi - 4;
          const int kblk = qg + d;
          if (d > 4 || kblk < 0 || kblk > 127) continue;
          mode = (d == -4) ? 1 : ((d == 4) ? 2 : 0);
        }
        f32x16 S;
#pragma unroll
        for (int i = 0; i < 16; ++i) S[i] = 0.f;
        {
          const int krow = kbi * 32 + r;
#pragma unroll
          for (int st = 0; st < 4; ++st) {
            bf16x8 kf = *reinterpret_cast<const bf16x8*>(LK + krow * 128 + (((2 * st + h) ^ ((krow >> 1) & 7)) << 4));
            S = __builtin_amdgcn_mfma_f32_32x32x16_bf16(kf, qf[st], S, 0, 0, 0);
          }
        }
        if (mode) {
          float negbig;
          asm volatile("v_mov_b32 %0, 0xf149f2ca" : "=v"(negbig));
#pragma unroll
          for (int i = 0; i < 16; ++i) {
            int kk = (i & 3) + 8 * (i >> 2) + 4 * h;
            bool ok = (mode == 1) ? (kk >= r) : (kk <= r);
            if (!ok) S[i] = negbig;
          }
        }
        float bm = S[0];
#pragma unroll
        for (int i = 1; i < 16; ++i) bm = fmaxf(bm, S[i]);
        bm = fmaxf(bm, shx_f(bm, 32));
        float m_new = fmaxf(m_run, bm);
        const float L2E = 1.4426950408889634f;
        float nm = -m_new * L2E;
        float psum = 0.f;
#pragma unroll
        for (int i = 0; i < 16; ++i) {
          S[i] = __builtin_amdgcn_exp2f(fmaf(S[i], L2E, nm));
          psum += S[i];
        }
        if (__any(m_new > m_run)) {
          float alpha = __builtin_amdgcn_exp2f((m_run - m_new) * L2E);
          l_run *= alpha;
#pragma unroll
          for (int i = 0; i < 16; ++i) {
            O0[i] *= alpha;
            O1[i] *= alpha;
          }
        }
        l_run += psum;
        m_run = m_new;
#pragma unroll
        for (int sidx = 0; sidx < 2; ++sidx) {
          uint4 pk;
          pk.x = pack2(S[8 * sidx + 0], S[8 * sidx + 1]);
          pk.y = pack2(S[8 * sidx + 2], S[8 * sidx + 3]);
          pk.z = pack2(S[8 * sidx + 4], S[8 * sidx + 5]);
          pk.w = pack2(S[8 * sidx + 6], S[8 * sidx + 7]);
          bf16x8 pf = __builtin_bit_cast(bf16x8, pk);
          const int vch = 4 * kbi + 2 * sidx + h;
          bf16x8 v0 = *reinterpret_cast<const bf16x8*>(LV + r * 256 + ((vch ^ (r & 15)) << 4));
          bf16x8 v1 = *reinterpret_cast<const bf16x8*>(LV + (32 + r) * 256 + ((vch ^ (r & 15)) << 4));
          O0 = __builtin_amdgcn_mfma_f32_32x32x16_bf16(v0, pf, O0, 0, 0, 0);
          O1 = __builtin_amdgcn_mfma_f32_32x32x16_bf16(v1, pf, O1, 0, 0, 0);
        }
      }
    }
#undef ATT_STAGE
    float l_tot = l_run + shx_f(l_run, 32);
    float inv = 1.f / l_tot;
    bf16_t* op = p->mix + (size_t)(tokbase + r) * LDMIX + hd * 64 + 4 * h;
#pragma unroll
    for (int g4 = 0; g4 < 4; ++g4) {
      uint2 o;
      o.x = pack2(O0[4 * g4 + 0] * inv, O0[4 * g4 + 1] * inv);
      o.y = pack2(O0[4 * g4 + 2] * inv, O0[4 * g4 + 3] * inv);
      *reinterpret_cast<uint2*>(op + 8 * g4) = o;
      o.x = pack2(O1[4 * g4 + 0] * inv, O1[4 * g4 + 1] * inv);
      o.y = pack2(O1[4 * g4 + 2] * inv, O1[4 * g4 + 3] * inv);
      *reinterpret_cast<uint2*>(op + 32 + 8 * g4) = o;
    }
  }
  __syncthreads();
}

DEVI void fill_tw(float2* tw, int n) {
  for (int i = ltid(); i < n; i += NTHREADS) {
    float sn, cn;
    sincospif(2.f * (float)i / (float)n, &sn, &cn);
    tw[i] = make_float2(cn, sn);
  }
  __syncthreads();
}

DEVI bf16x8 lds_col8(const bf16_t* bp, int stride) {
  unsigned e0 = bp[0], e1 = bp[stride], e2 = bp[2 * stride], e3 = bp[3 * stride];
  unsigned e4 = bp[4 * stride], e5 = bp[5 * stride], e6 = bp[6 * stride], e7 = bp[7 * stride];
  uint4 pk;
  pk.x = e0 | (e1 << 16);
  pk.y = e2 | (e3 << 16);
  pk.z = e4 | (e5 << 16);
  pk.w = e6 | (e7 << 16);
  return __builtin_bit_cast(bf16x8, pk);
}

DEVI void phase_fft_a(PP p, unsigned char* lds) {
  const int tid = ltid();
  const int lane = tid & 63, wid = __builtin_amdgcn_readfirstlane(tid >> 6), fr = lane & 15, fq = lane >> 4;
  float2* tw = reinterpret_cast<float2*>(lds + 66560);
  fill_tw(tw, 64);
  bf16x8 af[2][2];
#pragma unroll
  for (int ks = 0; ks < 2; ++ks) {
    unsigned short cr[8], ci[8];
#pragma unroll
    for (int j = 0; j < 8; ++j) {
      int n1 = 32 * ks + 8 * fq + j, k1 = 16 * wid + fr;
      float2 t = tw[(k1 * n1) & 63];
      cr[j] = f2bf(t.x);
      ci[j] = f2bf(-t.y);
    }
    uint4 a0, a1;
    a0.x = cr[0] | ((unsigned)cr[1] << 16); a0.y = cr[2] | ((unsigned)cr[3] << 16);
    a0.z = cr[4] | ((unsigned)cr[5] << 16); a0.w = cr[6] | ((unsigned)cr[7] << 16);
    a1.x = ci[0] | ((unsigned)ci[1] << 16); a1.y = ci[2] | ((unsigned)ci[3] << 16);
    a1.z = ci[4] | ((unsigned)ci[5] << 16); a1.w = ci[6] | ((unsigned)ci[7] << 16);
    af[0][ks] = __builtin_bit_cast(bf16x8, a0);
    af[1][ks] = __builtin_bit_cast(bf16x8, a1);
  }
  const bf16_t* l16 = reinterpret_cast<const bf16_t*>(lds);
  for (int u = lbid(); u < NB * 64; u += lnblk()) {
    int b = u >> 6, n2 = u & 63;
    __syncthreads();
#pragma unroll
    for (int i = 0; i < 16; ++i) {
      int row = (tid >> 6) + 4 * i, piece = tid & 63;
      uint4 v = *reinterpret_cast<const uint4*>(p->P + (size_t)(b * SEQ + 64 * row + n2) * 2048 + 768 + piece * 8);
      *reinterpret_cast<uint4*>(lds + row * 1040 + piece * 16) = v;
    }
    __syncthreads();
    float tc[4], ts[4];
#pragma unroll
    for (int j = 0; j < 4; ++j) sincospif((float)(n2 * (16 * wid + 4 * fq + j)) / 2048.f, &ts[j], &tc[j]);
    for (int nb = 0; nb < 4; ++nb) {
      f32x4 acc[2][8];
#pragma unroll
      for (int n = 0; n < 8; ++n) {
        acc[0][n] = f32x4{0.f, 0.f, 0.f, 0.f};
        acc[1][n] = f32x4{0.f, 0.f, 0.f, 0.f};
      }
#pragma unroll
      for (int ks = 0; ks < 2; ++ks)
#pragma unroll
        for (int nf = 0; nf < 8; ++nf) {
          bf16x8 bfr = lds_col8(l16 + (32 * ks + 8 * fq) * 520 + 128 * nb + 16 * nf + fr, 520);
          acc[0][nf] = __builtin_amdgcn_mfma_f32_16x16x32_bf16(af[0][ks], bfr, acc[0][nf], 0, 0, 0);
          acc[1][nf] = __builtin_amdgcn_mfma_f32_16x16x32_bf16(af[1][ks], bfr, acc[1][nf], 0, 0, 0);
        }
#pragma unroll
      for (int j = 0; j < 4; ++j) {
        int k1 = 16 * wid + 4 * fq + j;
        bf16_t* o = p->fa + (size_t)(b * SEQ + k1 * 64 + n2) * 1024 + 128 * nb + fr;
#pragma unroll
        for (int nf = 0; nf < 8; ++nf) {
          float re = acc[0][nf][j], im = acc[1][nf][j];
          o[16 * nf] = f2bf(re * tc[j] + im * ts[j]);
          o[512 + 16 * nf] = f2bf(im * tc[j] - re * ts[j]);
        }
      }
    }
  }
  __syncthreads();
}

DEVI void phase_fft_b(PP p, unsigned char* lds) {
  const int tid = ltid();
  const int lane = tid & 63, wid = __builtin_amdgcn_readfirstlane(tid >> 6), fr = lane & 15, fq = lane >> 4;
  float2* tw = reinterpret_cast<float2*>(lds + 67584);
  fill_tw(tw, 64);
  bf16x8 wb[2][4];
#pragma unroll
  for (int ks = 0; ks < 4; ++ks) {
    unsigned short zr[8], zi[8];
#pragma unroll
    for (int j = 0; j < 8; ++j) {
      int k = 32 * ks + 8 * fq + j, part = k >> 6, n2 = k & 63, k2 = 16 * wid + fr;
      float2 t = tw[(k2 * n2) & 63];
      zr[j] = f2bf(part ? t.y : t.x);
      zi[j] = f2bf(part ? t.x : -t.y);
    }
    uint4 a0, a1;
    a0.x = zr[0] | ((unsigned)zr[1] << 16); a0.y = zr[2] | ((unsigned)zr[3] << 16);
    a0.z = zr[4] | ((unsigned)zr[5] << 16); a0.w = zr[6] | ((unsigned)zr[7] << 16);
    a1.x = zi[0] | ((unsigned)zi[1] << 16); a1.y = zi[2] | ((unsigned)zi[3] << 16);
    a1.z = zi[4] | ((unsigned)zi[5] << 16); a1.w = zi[6] | ((unsigned)zi[7] << 16);
    wb[0][ks] = __builtin_bit_cast(bf16x8, a0);
    wb[1][ks] = __builtin_bit_cast(bf16x8, a1);
  }
  const bf16_t* l16 = reinterpret_cast<const bf16_t*>(lds);
  const float scale = 0.0013810679320049757f;
  for (int u = lbid(); u < NB * 128; u += lnblk()) {
    int b = u >> 7, k1 = (u >> 1) & 63, hf = u & 1;
    __syncthreads();
#pragma unroll
    for (int i = 0; i < 16; ++i) {
      int row = (tid >> 5) + 8 * i, piece = tid & 31;
      int part = row >> 6, n2 = row & 63;
      uint4 v = *reinterpret_cast<const uint4*>(p->fa + (size_t)(b * SEQ + k1 * 64 + n2) * 1024 + part * 512 + hf * 256 + piece * 8);
      *reinterpret_cast<uint4*>(lds + row * 528 + piece * 16) = v;
    }
    __syncthreads();
    for (int nb = 0; nb < 2; ++nb) {
      f32x4 acc[2][8];
#pragma unroll
      for (int n = 0; n < 8; ++n) {
        acc[0][n] = f32x4{0.f, 0.f, 0.f, 0.f};
        acc[1][n] = f32x4{0.f, 0.f, 0.f, 0.f};
      }
#pragma unroll
      for (int ks = 0; ks < 4; ++ks)
#pragma unroll
        for (int nf = 0; nf < 8; ++nf) {
          bf16x8 bfr = lds_col8(l16 + (32 * ks + 8 * fq) * 264 + 128 * nb + 16 * nf + fr, 264);
          acc[0][nf] = __builtin_amdgcn_mfma_f32_16x16x32_bf16(wb[0][ks], bfr, acc[0][nf], 0, 0, 0);
          acc[1][nf] = __builtin_amdgcn_mfma_f32_16x16x32_bf16(wb[1][ks], bfr, acc[1][nf], 0, 0, 0);
        }
#pragma unroll
      for (int j = 0; j < 4; ++j) {
        int k2 = 16 * wid + 4 * fq + j;
        bf16_t* o = p->mix + (size_t)(b * SEQ + k1 + 64 * k2) * LDMIX + 512 + hf * 256 + 128 * nb + fr;
#pragma unroll
        for (int nf = 0; nf < 8; ++nf) {
          o[16 * nf] = f2bf(acc[0][nf][j] * scale);
          o[512 + 16 * nf] = f2bf(acc[1][nf][j] * scale);
        }
      }
    }
  }
  __syncthreads();
}

DEVI void phase_dft_ctx(PP p, unsigned char* lds) {
  float2* tw = reinterpret_cast<float2*>(lds);
  fill_tw(tw, 256);
  int tid = ltid();
  const float scale = 0.005524271728019903f;
  for (int u = lbid(); u < NB * 64; u += lnblk()) {
    int b = u >> 6, k0 = (u & 63) * 4;
    for (int pass = 0; pass < 2; ++pass) {
      int ch = tid + pass * 256;
      float zr[4], zi[4];
#pragma unroll
      for (int kk = 0; kk < 4; ++kk) zr[kk] = zi[kk] = 0.f;
#pragma unroll 8
      for (int n = 0; n < 256; ++n) {
        float v = bf2f(p->P[(size_t)(TL + b * CTX + n) * 2048 + 768 + ch]);
#pragma unroll
        for (int kk = 0; kk < 4; ++kk) {
          float2 t = tw[(n * (k0 + kk)) & 255];
          zr[kk] += v * t.x;
          zi[kk] -= v * t.y;
        }
      }
#pragma unroll
      for (int kk = 0; kk < 4; ++kk) {
        bf16_t* o = p->mix + (size_t)(TL + b * CTX + k0 + kk) * LDMIX;
        o[512 + ch] = f2bf(zr[kk] * scale);
        o[1024 + ch] = f2bf(zi[kk] * scale);
      }
    }
  }
  __syncthreads();
}

DEVI void phase_sgu(PP p, int j, int nchunks, unsigned char* lds) {
  float* rs = reinterpret_cast<float*>(lds);
  unsigned char* LA = lds + 1024;
  unsigned char* LB = lds + 1024 + 32768;
  const int tid = ltid();
  const int lane = tid & 63, wid = __builtin_amdgcn_readfirstlane(tid >> 6), fr = lane & 15, fq = lane >> 4;
  const float* nw = p->gs_norm_w + j * 1024;
  for (int u = lbid(); u < nchunks * 8; u += lnblk()) {
    const int chunk = u >> 3, g = u & 7;
    const int tok0 = chunk * 128;
    const bf16_t* vT = p->zvT + ((size_t)chunk * 1024 + g * 128) * 128;
    __syncthreads();
    if (tid < 128) {
      const float* rp = p->rowss + (size_t)chunk * 32 * 128 + tid;
      float ss = 0.f;
#pragma unroll
      for (int sl = 0; sl < 32; ++sl) ss += rp[sl * 128];
      rs[tid] = rsqrtf(ss * (1.f / 1024.f) + 1e-6f);
    }
#pragma unroll
    for (int i = 0; i < 8; ++i) {
      int idx = tid + 256 * i, row = idx >> 4, c = idx & 15;
      uint4 v = *reinterpret_cast<const uint4*>(vT + (size_t)row * 128 + c * 8);
      *reinterpret_cast<uint4*>(LB + row * 256 + ((c ^ (row & 15)) << 4)) = v;
    }
    __syncthreads();
    {
      const float* wsg = p->gs_w_s + ((size_t)j * 8 + g) * 128 * 128;
#pragma unroll
      for (int i = 0; i < 8; ++i) {
        int idx = tid + 256 * i, row = idx >> 4, c = idx & 15;
        const float4* wp = reinterpret_cast<const float4*>(wsg + (size_t)row * 128 + c * 8);
        float4 w0 = wp[0], w1 = wp[1];
        const float* rk = rs + c * 8;
        uint4 pk;
        pk.x = pack2(w0.x * rk[0], w0.y * rk[1]);
        pk.y = pack2(w0.z * rk[2], w0.w * rk[3]);
        pk.z = pack2(w1.x * rk[4], w1.y * rk[5]);
        pk.w = pack2(w1.z * rk[6], w1.w * rk[7]);
        *reinterpret_cast<uint4*>(LA + row * 256 + ((c ^ (row & 15)) << 4)) = pk;
      }
    }
    __syncthreads();
    f32x4 acc[2][8];
#pragma unroll
    for (int m = 0; m < 2; ++m)
#pragma unroll
      for (int n = 0; n < 8; ++n) acc[m][n] = f32x4{0.f, 0.f, 0.f, 0.f};
#pragma unroll
    for (int ks = 0; ks < 4; ++ks) {
      const int sl = ((4 * ks + fq) ^ fr) << 4;
      bf16x8 a0 = *reinterpret_cast<const bf16x8*>(LA + (32 * wid + fr) * 256 + sl);
      bf16x8 a1 = *reinterpret_cast<const bf16x8*>(LA + (32 * wid + 16 + fr) * 256 + sl);
#pragma unroll
      for (int n = 0; n < 8; ++n) {
        bf16x8 bfr = *reinterpret_cast<const bf16x8*>(LB + (16 * n + fr) * 256 + sl);
        acc[0][n] = __builtin_amdgcn_mfma_f32_16x16x32_bf16(a0, bfr, acc[0][n], 0, 0, 0);
        acc[1][n] = __builtin_amdgcn_mfma_f32_16x16x32_bf16(a1, bfr, acc[1][n], 0, 0, 0);
      }
    }
    __syncthreads();
    {
      const float* bsg = p->gs_b_s + ((size_t)j * 8 + g) * 128;
#pragma unroll
      for (int m = 0; m < 2; ++m)
#pragma unroll
        for (int jj = 0; jj < 4; ++jj) {
          const int pp = 32 * wid + 16 * m + 4 * fq + jj;
          const float bias = bsg[pp];
#pragma unroll
          for (int n = 0; n < 8; ++n) {
            const int c = 16 * n + fr;
            float sv = nw[g * 128 + c] * acc[m][n][jj] + bias;
            *reinterpret_cast<bf16_t*>(LA + pp * 256 + (((c >> 3) ^ (pp & 15)) << 4) + (c & 7) * 2) = f2bf(sv);
          }
        }
    }
    __syncthreads();
#pragma unroll
    for (int i = 0; i < 8; ++i) {
      int idx = tid + 256 * i, row = idx >> 4, c = idx & 15;
      uint4 sv8 = *reinterpret_cast<const uint4*>(LA + row * 256 + ((c ^ (row & 15)) << 4));
      uint4 u8 = *reinterpret_cast<const uint4*>(p->P + (size_t)(tok0 + row) * 2048 + g * 128 + c * 8);
      uint4 o;
      o.x = pack2(bflo(u8.x) * bflo(sv8.x), bfhi(u8.x) * bfhi(sv8.x));
      o.y = pack2(bflo(u8.y) * bflo(sv8.y), bfhi(u8.y) * bfhi(sv8.y));
      o.z = pack2(bflo(u8.z) * bflo(sv8.z), bfhi(u8.z) * bfhi(sv8.z));
      o.w = pack2(bflo(u8.w) * bflo(sv8.w), bfhi(u8.w) * bfhi(sv8.w));
      *reinterpret_cast<uint4*>(p->mix + (size_t)(tok0 + row) * LDMIX + g * 128 + c * 8) = o;
    }
  }
  __syncthreads();
}

DEVI float mkkey(float v, unsigned idx, unsigned mask) { return __uint_as_float((__float_as_uint(v) & ~mask) | idx); }
#define INSERT16(list, x)                                                                                               \
  {                                                                                                                     \
    _Pragma("unroll") for (int i_ = 15; i_ >= 1; --i_) list[i_] = __builtin_amdgcn_fmed3f(list[i_ - 1], list[i_], x); \
    list[0] = fmaxf(list[0], x);                                                                                        \
  }

DEVI float vmaxf(float a, float b) { float r; asm("v_max_f32 %0, %1, %2" : "=v"(r) : "v"(a), "v"(b)); return r; }
DEVI float vminf(float a, float b) { float r; asm("v_min_f32 %0, %1, %2" : "=v"(r) : "v"(a), "v"(b)); return r; }
DEVI void bitonic_merge16(float (&v)[16]) {
#pragma unroll
  for (int j = 8; j >= 1; j >>= 1)
#pragma unroll
    for (int i = 0; i < 16; ++i) {
      const int l = i ^ j;
      if (l > i) {
        const float hi = vmaxf(v[i], v[l]), lo = vminf(v[i], v[l]);
        v[i] = hi;
        v[l] = lo;
      }
    }
}
DEVI void bitonic_sort16(float (&v)[16]) {
#pragma unroll
  for (int k = 2; k <= 16; k <<= 1)
#pragma unroll
    for (int j = k >> 1; j >= 1; j >>= 1)
#pragma unroll
      for (int i = 0; i < 16; ++i) {
        const int l = i ^ j;
        if (l > i) {
          const float hi = vmaxf(v[i], v[l]), lo = vminf(v[i], v[l]);
          const bool desc = (i & k) == 0;
          v[i] = desc ? hi : lo;
          v[l] = desc ? lo : hi;
        }
      }
}

DEVI void phase_route(PP p, int layer, int ntok, unsigned char* lds) {
  const int tid = ltid();
  const int lane = tid & 63, wid = __builtin_amdgcn_readfirstlane(tid >> 6), fr = lane & 15, fq = lane >> 4;
  const int nb8 = lnblk() >> 3, bid = lbid();
  const int hh = bid & 7, slot = bid >> 3;
  const int ntiles = ntok / 64;
  const bool active = slot < nb8;
  float* sc = reinterpret_cast<float*>(lds + 32768);
  const float NEGK = -3.0e38f;
  for (int half = 0; half < 2; ++half) {
    __syncthreads();
    {
      const bf16_t* ksrc = p->keysb + ((size_t)((layer * 8 + hh) * 2 + half) * 128) * 128;
#pragma unroll
      for (int i = 0; i < 8; ++i) {
        int idx = tid + 256 * i, row = idx >> 4, c = idx & 15;
        uint4 v = *reinterpret_cast<const uint4*>(ksrc + (size_t)row * 128 + c * 8);
        *reinterpret_cast<uint4*>(lds + row * 256 + ((c ^ (row & 15)) << 4)) = v;
      }
    }
    __syncthreads();
    bf16x8 an[4];
    if (active && slot < ntiles) {
      const bf16_t* qa = p->P + (size_t)(slot * 64 + wid * 16 + fr) * 2048 + hh * 256 + half * 128 + fq * 8;
#pragma unroll
      for (int ks = 0; ks < 4; ++ks) an[ks] = *reinterpret_cast<const bf16x8*>(qa + ks * 32);
    }
    for (int tt = slot; active && tt < ntiles; tt += nb8) {
      const int tok0 = tt * 64;
      float list[16], lb[16];
      {
        bf16x8 a[4];
#pragma unroll
        for (int ks = 0; ks < 4; ++ks) a[ks] = an[ks];
        {
          const int ttn = (tt + nb8 < ntiles) ? tt + nb8 : tt;
          const bf16_t* qa = p->P + (size_t)(ttn * 64 + wid * 16 + fr) * 2048 + hh * 256 + half * 128 + fq * 8;
#pragma unroll
          for (int ks = 0; ks < 4; ++ks) an[ks] = *reinterpret_cast<const bf16x8*>(qa + ks * 32);
        }
#pragma unroll
        for (int nf = 0; nf < 8; ++nf) {
          f32x4 acc = f32x4{0.f, 0.f, 0.f, 0.f};
          const int krow = nf * 16 + fr;
#pragma unroll
          for (int ks = 0; ks < 4; ++ks) {
            bf16x8 bb = *reinterpret_cast<const bf16x8*>(lds + krow * 256 + (((4 * ks + fq) ^ (krow & 15)) << 4));
            acc = __builtin_amdgcn_mfma_f32_16x16x32_bf16(bb, a[ks], acc, 0, 0, 0);
          }
#pragma unroll
          for (int j = 0; j < 4; ++j) {
            const float kv = mkkey(acc[j], (unsigned)(nf * 16 + 4 * fq + j), 127u);
            if (nf < 4) list[nf * 4 + j] = kv;
            else lb[(nf - 4) * 4 + j] = kv;
          }
        }
      }
      const int prt = lane >> 4;
      bitonic_sort16(list);
      bitonic_sort16(lb);
#pragma unroll
      for (int i = 0; i < 16; ++i) list[i] = vmaxf(list[i], lb[15 - i]);
      bitonic_merge16(list);
#pragma unroll 1
      for (int step = 16; step <= 32; step <<= 1) {
        float other[16];
#pragma unroll
        for (int i = 0; i < 16; ++i) other[i] = shx_f(list[i], step);
#pragma unroll
        for (int i = 0; i < 16; ++i) list[i] = vmaxf(list[i], other[15 - i]);
        bitonic_merge16(list);
      }
      if (prt == 0) {
        float4* o = reinterpret_cast<float4*>(p->tops + ((size_t)(tok0 + wid * 16 + fr) * 16 + hh * 2 + half) * 16);
        o[0] = make_float4(list[0], list[1], list[2], list[3]);
        o[1] = make_float4(list[4], list[5], list[6], list[7]);
        o[2] = make_float4(list[8], list[9], list[10], list[11]);
        o[3] = make_float4(list[12], list[13], list[14], list[15]);
      }
    }
  }
  __syncthreads();
  float* fl = reinterpret_cast<float*>(lds);
  for (int t4 = slot; active && t4 < ntiles + 3 * nb8; t4 += 4 * nb8) {
    const int tt = t4 + (tid >> 6) * nb8;
    if (tt < ntiles) {
      const int tok = tt * 64 + (tid & 63);
      const float4* src = reinterpret_cast<const float4*>(p->tops + ((size_t)tok * 16 + hh * 2) * 16);
      float v0[16], v1[16];
#pragma unroll
      for (int i = 0; i < 4; ++i) {
        float4 a = src[i], bq = src[4 + i];
        v0[4 * i] = a.x; v0[4 * i + 1] = a.y; v0[4 * i + 2] = a.z; v0[4 * i + 3] = a.w;
        v1[4 * i] = bq.x; v1[4 * i + 1] = bq.y; v1[4 * i + 2] = bq.z; v1[4 * i + 3] = bq.w;
      }
      float* f0 = fl + tid * 33;
      float* f1 = f0 + 16;
#pragma unroll
      for (int i = 0; i < 16; ++i) {
        f0[i] = v0[i];
        f1[i] = v1[i];
      }
      float l2[16];
#pragma unroll
      for (int i = 0; i < 16; ++i) l2[i] = mkkey(v0[0] + v1[i], (unsigned)(15 - i), 255u);
#pragma unroll
      for (int a = 1; a < 16; ++a)
#pragma unroll
        for (int bq = 0; bq < 16; ++bq)
          if ((a + 1) * (bq + 1) <= 16) {
            float x = mkkey(v0[a] + v1[bq], (unsigned)(a * 16 + 15 - bq), 255u);
            INSERT16(l2, x)
          }
      float sv[16];
      int ev[16];
      float mx = NEGK;
#pragma unroll
      for (int k = 0; k < 16; ++k) {
        unsigned ab = __float_as_uint(l2[k]) & 255u;
        unsigned k0 = __float_as_uint(f0[ab >> 4]), k1 = __float_as_uint(f1[15u - (ab & 15u)]);
        sv[k] = __uint_as_float(k0 & ~127u) + __uint_as_float(k1 & ~127u);
        ev[k] = (int)((k0 & 127u) * 128u + (k1 & 127u));
        mx = fmaxf(mx, sv[k]);
      }
      float sum = 0.f;
#pragma unroll
      for (int k = 0; k < 16; ++k) {
        sv[k] = __expf(sv[k] - mx);
        sum += sv[k];
      }
      float inv = 1.f / sum;
      size_t o = (size_t)tok * 128 + hh * 16;
      int4* eo = reinterpret_cast<int4*>(p->eidx + o);
      float4* go = reinterpret_cast<float4*>(p->gate + o);
#pragma unroll
      for (int k4 = 0; k4 < 4; ++k4) {
        eo[k4] = make_int4(ev[4 * k4], ev[4 * k4 + 1], ev[4 * k4 + 2], ev[4 * k4 + 3]);
        go[k4] = make_float4(sv[4 * k4] * inv, sv[4 * k4 + 1] * inv, sv[4 * k4 + 2] * inv, sv[4 * k4 + 3] * inv);
      }
    }
  }
  __syncthreads();
}

typedef float v2f __attribute__((ext_vector_type(2)));
DEVI void dec16(uint4 q, v2f* f) {
  f[0] = __builtin_amdgcn_cvt_pk_f32_fp8((int)q.x, false);
  f[1] = __builtin_amdgcn_cvt_pk_f32_fp8((int)q.x, true);
  f[2] = __builtin_amdgcn_cvt_pk_f32_fp8((int)q.y, false);
  f[3] = __builtin_amdgcn_cvt_pk_f32_fp8((int)q.y, true);
  f[4] = __builtin_amdgcn_cvt_pk_f32_fp8((int)q.z, false);
  f[5] = __builtin_amdgcn_cvt_pk_f32_fp8((int)q.z, true);
  f[6] = __builtin_amdgcn_cvt_pk_f32_fp8((int)q.w, false);
  f[7] = __builtin_amdgcn_cvt_pk_f32_fp8((int)q.w, true);
}
struct ExpBuf {
  uint4 q[8];
  uint4 h0, h1;
};
DEVI void exp_load(ExpBuf& B, const unsigned char* tab, const signed char* hrow, const unsigned short* idp, int j8, bool want_x) {
  const uint4 idv = *reinterpret_cast<const uint4*>(idp);
  const unsigned idw[4] = {idv.x, idv.y, idv.z, idv.w};
#pragma unroll
  for (int i = 0; i < 8; ++i) {
    unsigned e = (i & 1) ? (idw[i >> 1] >> 16) : (idw[i >> 1] & 0xffffu);
    unsigned off = e * (unsigned)D + 16u * j8;
    B.q[i] = *reinterpret_cast<const uint4*>(tab + off);
  }
  if (want_x) B.h0 = *reinterpret_cast<const uint4*>(hrow + 16 * j8);
}
template <int CTRL>
DEVI int dpp_movi(int v) { return __builtin_amdgcn_mov_dpp(v, CTRL, 0xF, 0xF, true); }
DEVI void exp_u_compute(const ExpBuf& B, int* pp, int j8) {
  int s0 = 0;
#pragma unroll
  for (int i = 0; i < 8; ++i) {
    int d = __builtin_amdgcn_sdot4((int)B.q[i].x, (int)B.h0.x, 0, false);
    d = __builtin_amdgcn_sdot4((int)B.q[i].y, (int)B.h0.y, d, false);
    d = __builtin_amdgcn_sdot4((int)B.q[i].z, (int)B.h0.z, d, false);
    d = __builtin_amdgcn_sdot4((int)B.q[i].w, (int)B.h0.w, d, false);
    d += dpp_movi<0xB1>(d);
    d += dpp_movi<0x4E>(d);
    d += dpp_movi<0x141>(d);
    s0 = (j8 == i) ? d : s0;
  }
  pp[0] += s0;
}
DEVI void exp_v_accum(const ExpBuf& B, unsigned w0, unsigned w1, int* acc) {
#pragma unroll
  for (int ig = 0; ig < 2; ++ig) {
    const unsigned wq = ig ? w1 : w0;
    const uint4 R0 = B.q[4 * ig], R1 = B.q[4 * ig + 1], R2 = B.q[4 * ig + 2], R3 = B.q[4 * ig + 3];
    const unsigned r0[4] = {R0.x, R0.y, R0.z, R0.w}, r1[4] = {R1.x, R1.y, R1.z, R1.w};
    const unsigned r2[4] = {R2.x, R2.y, R2.z, R2.w}, r3[4] = {R3.x, R3.y, R3.z, R3.w};
#pragma unroll
    for (int q = 0; q < 4; ++q) {
      unsigned A = __builtin_amdgcn_perm(r1[q], r0[q], 0x05010400u);
      unsigned Bq = __builtin_amdgcn_perm(r1[q], r0[q], 0x07030602u);
      unsigned C = __builtin_amdgcn_perm(r3[q], r2[q], 0x05010400u);
      unsigned E = __builtin_amdgcn_perm(r3[q], r2[q], 0x07030602u);
      unsigned D0 = __builtin_amdgcn_perm(C, A, 0x05040100u);
      unsigned D1 = __builtin_amdgcn_perm(C, A, 0x07060302u);
      unsigned D2 = __builtin_amdgcn_perm(E, Bq, 0x05040100u);
      unsigned D3 = __builtin_amdgcn_perm(E, Bq, 0x07060302u);
      acc[4 * q + 0] = __builtin_amdgcn_sdot4((int)D0, (int)wq, acc[4 * q + 0], false);
      acc[4 * q + 1] = __builtin_amdgcn_sdot4((int)D1, (int)wq, acc[4 * q + 1], false);
      acc[4 * q + 2] = __builtin_amdgcn_sdot4((int)D2, (int)wq, acc[4 * q + 2], false);
      acc[4 * q + 3] = __builtin_amdgcn_sdot4((int)D3, (int)wq, acc[4 * q + 3], false);
    }
  }
}
DEVI void exp_v_finish(uint2* xo, uint2 xq, float4 gq, int* acc, float swt, int lane, float gscale) {
  int r[8], s4[4];
#pragma unroll
  for (int i = 0; i < 8; ++i) {
    auto t = __builtin_amdgcn_permlane32_swap((unsigned)acc[i], (unsigned)acc[8 + i], false, false);
    r[i] = (int)t[0] + (int)t[1];
  }
#pragma unroll
  for (int i = 0; i < 4; ++i) {
    auto t = __builtin_amdgcn_permlane16_swap((unsigned)r[i], (unsigned)r[4 + i], false, false);
    s4[i] = (int)t[0] + (int)t[1];
  }
#pragma unroll
  for (int i = 0; i < 4; ++i) s4[i] += dpp_movi<0x128>(s4[i]);
#pragma unroll
  for (int k = 0; k < 16; ++k) acc[k] = 0;
  if ((lane & 8) == 0) {
    const float sc = gscale * swt;
    uint2 rr;
    rr.x = pack2(bflo(xq.x) + sc * gq.x * (float)s4[0], bfhi(xq.x) + sc * gq.y * (float)s4[1]);
    rr.y = pack2(bflo(xq.y) + sc * gq.z * (float)s4[2], bfhi(xq.y) + sc * gq.w * (float)s4[3]);
    *xo = rr;
  }
}
DEVI void phase_expert(PP p, int layer, int ntok, unsigned char* lds, float gscale = 1.f, int idmask = 0xffff) {
  const int tid = ltid();
  const int lane = tid & 63, wid = __builtin_amdgcn_readfirstlane(tid >> 6), j8 = lane & 7, grp = lane >> 3;
  const int nb = lnblk(), bid = lbid();
  unsigned short* ids = reinterpret_cast<unsigned short*>(lds);
  float* part = reinterpret_cast<float*>(lds + TPB * 128 * 2);
  unsigned char* w8 = lds + TPB * 128 * 2 + TPB * 128 * 4;
  float* swl = reinterpret_cast<float*>(lds + TPB * 128 * 2 + TPB * 128 * 4 + TPB * 128);
  const unsigned char* ut = p->utab + (size_t)layer * NEXP * D;
  const unsigned char* vt = p->vtab + (size_t)layer * NEXP * D;
  int tpb = (ntok + nb - 1) / nb;
  if (tpb > TPB) tpb = TPB;
  const int npass = (ntok + nb * tpb - 1) / (nb * tpb);
  for (int pass = 0; pass < npass; ++pass) {
    const int tok0 = (pass * nb + bid) * tpb;
    int cnt = ntok - tok0;
    if (cnt > tpb) cnt = tpb;
    if (cnt < 0) cnt = 0;
    for (int i = tid; i < cnt * 128; i += NTHREADS) {
      {
        int k = i & 127, hf = k >> 6, kk = k & 63;
        ids[(i & ~127) + hf * 64 + (kk & 7) * 8 + (kk >> 3)] = (unsigned short)(p->eidx[(size_t)tok0 * 128 + i] & idmask);
      }
      part[i] = 0.f;
    }
    __syncthreads();
    const int ntw = (cnt - wid + 3) >> 2;
    const int npair = ntw * 8;

    if (!(REP_MODE == 1 && gscale != 1.f)) {
      ExpBuf B0, B1;
      int c0 = 0, k0 = 0;
      if (npair > 0) {
        const int t0 = wid;
        exp_load(B0, ut, p->h8 + (size_t)(tok0 + t0) * D, ids + t0 * 128 + grp * 8, j8, true);
      }
      for (int pr = 0; pr < npair; ++pr) {
        const int t0 = wid + 4 * k0;
        exp_load(B1, ut + 128 * c0, p->h8 + (size_t)(tok0 + t0) * D + 128 * c0, ids + t0 * 128 + 64 + grp * 8, j8, true);
        exp_u_compute(B0, reinterpret_cast<int*>(part) + t0 * 128 + 8 * j8 + grp, j8);
        int c1 = c0, k1 = k0;
        if (pr + 1 < npair) {
          k1 = k0 + 1;
          if (k1 == ntw) {
            k1 = 0;
            c1 = c0 + 1;
          }
        }
        {
          const int t1 = wid + 4 * k1;
          exp_load(B0, ut + 128 * c1, p->h8 + (size_t)(tok0 + t1) * D + 128 * c1, ids + t1 * 128 + grp * 8, j8, true);
        }
        exp_u_compute(B1, reinterpret_cast<int*>(part) + t0 * 128 + 64 + 8 * j8 + grp, j8);
        c0 = c1;
        k0 = k1;
      }
    }
    __syncthreads();
    for (int t = wid; t < cnt; t += 4) {
      float wv2[2];
      float am = 0.f;
#pragma unroll
      for (int hh = 0; hh < 2; ++hh) {
        int k = lane + 64 * hh;
        int e = ids[t * 128 + hh * 64 + (lane & 7) * 8 + (lane >> 3)];
        float dq = (float)reinterpret_cast<int*>(part)[t * 128 + k] * p->su[(size_t)layer * NEXP + e] * p->sx[tok0 + t];
        float wv = p->gate[(size_t)(tok0 + t) * 128 + k] * gelu_tanh(dq) * p->sv[(size_t)layer * NEXP + e];
        wv2[hh] = wv;
        am = fmaxf(am, fabsf(wv));
      }
      am = fmaxf(wave_max(am), 1e-30f);
      float qs = 127.f / am;
#pragma unroll
      for (int hh = 0; hh < 2; ++hh) {
        int k = lane + 64 * hh;
        int q = (int)rintf(wv2[hh] * qs);
        w8[t * 128 + (k & 7) * 16 + hh * 8 + ((k >> 3) & 7)] = (unsigned char)(q & 255);
      }
      if (lane == 0) swl[t] = am * (1.f / 127.f);
    }
    __syncthreads();
    if (!(REP_MODE == 2 && gscale != 1.f)) {
      ExpBuf B0, B1;
      int acc[16];
#pragma unroll
      for (int k = 0; k < 16; ++k) acc[k] = 0;
      int c0 = 0, k0 = 0;
      if (npair > 0) {
        const int t0 = wid;
        exp_load(B0, vt, (const signed char*)nullptr, ids + t0 * 128 + grp * 8, j8, false);
      }
      for (int pr = 0; pr < npair; ++pr) {
        const int t0 = wid + 4 * k0;
        const int dsub = 128 * c0 + 16 * j8 + 8 * (lane >> 5) + 4 * ((lane >> 4) & 1);
        uint2* xo = reinterpret_cast<uint2*>(p->xs + (size_t)(tok0 + t0) * D + dsub);
        const uint2 xq = *xo;
        const float4 gq = *reinterpret_cast<const float4*>(p->mod + ((size_t)layer * 9 + tok_batch(tok0 + t0)) * 6144 + 5 * 1024 + dsub);
        exp_load(B1, vt + 128 * c0, (const signed char*)nullptr, ids + t0 * 128 + 64 + grp * 8, j8, false);
        const uint4 wq = *reinterpret_cast<const uint4*>(w8 + t0 * 128 + grp * 16);
        exp_v_accum(B0, wq.x, wq.y, acc);
        int c1 = c0, k1 = k0;
        if (pr + 1 < npair) {
          k1 = k0 + 1;
          if (k1 == ntw) {
            k1 = 0;
            c1 = c0 + 1;
          }
        }
        {
          const int t1 = wid + 4 * k1;
          exp_load(B0, vt + 128 * c1, (const signed char*)nullptr, ids + t1 * 128 + grp * 8, j8, false);
        }
        exp_v_accum(B1, wq.z, wq.w, acc);
        exp_v_finish(xo, xq, gq, acc, swl[t0], lane, gscale);
        c0 = c1;
        k0 = k1;
      }
    }
    asm volatile("s_waitcnt vmcnt(0)" ::: "memory");
    __syncthreads();
    if (gscale == 1.f) {
      for (int t = wid; t < cnt; t += 4) {
        if (layer + 1 < DEPTH) norm_row(p, layer + 1, 0, tok0 + t, lane);
        else if (tok0 + t < TL) norm_row(p, 0, 2, tok0 + t, lane);
      }
    }
    __syncthreads();
  }
}

#define XB_TMO 128
#define XB_XCNT(j) (256 + 64 * (j))
#define XB_XSUB(j) (1280 + 64 * (j))
#define XB_XGEN(j) (2304 + 64 * (j))
#define XB_TOP 3328
#define XB_TOPGEN 3392
#define XCD_BAR_WORDS 3456
#define XB_SPIN_CAP (1u << 22)
#define LAS __attribute__((address_space(3)))
DEVI unsigned xb_ld(unsigned* p) { return __hip_atomic_load(p, __ATOMIC_RELAXED, __HIP_MEMORY_SCOPE_AGENT); }
DEVI unsigned xb_add(unsigned* p, unsigned v) { return __hip_atomic_fetch_add(p, v, __ATOMIC_RELAXED, __HIP_MEMORY_SCOPE_AGENT); }
DEVI unsigned xb_xcc_id() { return (unsigned)__builtin_amdgcn_s_getreg((3 << 11) | 20) & 0xFu; }
#define XB_SPIN(cond, bar)                                   \
  do {                                                       \
    unsigned _sp = 0;                                        \
    while (cond) {                                           \
      __builtin_amdgcn_s_sleep(1);                           \
      if ((++_sp & 255u) == 0u) {                            \
        if (xb_ld(&(bar)[XB_TMO])) break;                    \
        if (_sp > XB_SPIN_CAP) {                             \
          atomicAdd(&(bar)[XB_TMO], 1u);                     \
          break;                                             \
        }                                                    \
      }                                                      \
    }                                                        \
  } while (0)
struct XcdBarrier {
  unsigned* bar;
  unsigned x;
  volatile LAS unsigned* st;
};
DEVI XcdBarrier xcd_barrier_post(unsigned* bar, volatile LAS unsigned* st) {
  XcdBarrier b;
  b.bar = bar;
  b.x = xb_xcc_id();
  b.st = st;
  if (threadIdx.x == 0) (void)xb_add(&bar[XB_XCNT(b.x)], 1u);
  return b;
}
DEVI void xcd_barrier_complete(unsigned* bar, unsigned x, unsigned& nloc, unsigned& nx) {
  const unsigned G = gridDim.x * gridDim.y * gridDim.z;
  unsigned sum, cnt, mine, sp = 0u;
  for (;;) {
    sum = 0u;
    cnt = 0u;
    mine = 0u;
#pragma unroll
    for (unsigned j = 0; j < 16; ++j) {
      const unsigned c = xb_ld(&bar[XB_XCNT(j)]);
      sum += c;
      cnt += (c > 0u) ? 1u : 0u;
      mine = (j == x) ? c : mine;
    }
    if (sum == G) break;
    __builtin_amdgcn_s_sleep(1);
    if ((++sp & 255u) == 0u) {
      if (xb_ld(&bar[XB_TMO])) break;
      if (sp > XB_SPIN_CAP) {
        atomicAdd(&bar[XB_TMO], 1u);
        break;
      }
    }
  }
  nloc = mine > 0u ? mine : 1u;
  nx = cnt > 0u ? cnt : 1u;
}
DEVI void xcd_barrier(const XcdBarrier& b) {
  asm volatile("s_waitcnt vmcnt(0)" ::: "memory");
  __syncthreads();
  if (threadIdx.x == 0) {
    unsigned* bar = b.bar;
    __builtin_amdgcn_s_waitcnt(0);
    unsigned nloc = b.st[0], nx = b.st[1];
    if (nloc == 0u) {
      xcd_barrier_complete(bar, b.x, nloc, nx);
      b.st[0] = nloc;
      b.st[1] = nx;
    }
    const unsigned old = xb_add(&bar[XB_XSUB(b.x)], 1u);
    const unsigned gen = old / nloc;
    if (old + 1u == (gen + 1u) * nloc) {
      __builtin_amdgcn_fence(__ATOMIC_RELEASE, "agent");
      asm volatile("s_waitcnt vmcnt(0)" ::: "memory");
      const unsigned og = xb_add(&bar[XB_TOP], 1u);
      const unsigned tg = og / nx;
      if (og + 1u == (tg + 1u) * nx) xb_add(&bar[XB_TOPGEN], 1u);
      else XB_SPIN(xb_ld(&bar[XB_TOPGEN]) == tg, bar);
      __builtin_amdgcn_fence(__ATOMIC_ACQUIRE, "agent");
      xb_add(&bar[XB_XGEN(b.x)], 1u);
      asm volatile("s_waitcnt vmcnt(0)" ::: "memory");
    } else {
      XB_SPIN(xb_ld(&bar[XB_XGEN(b.x)]) == gen, bar);
      __builtin_amdgcn_fence(__ATOMIC_ACQUIRE, "agent");
      asm volatile("s_waitcnt vmcnt(0)" ::: "memory");
    }
  }
  __syncthreads();
}

DEVI bool step_active(int step) {
  if (step == 0) return true;
  if (step == NSTEPS - 1) return false;
  int layer = (step - 1) / STEPS_PER_LAYER, ph = (step - 1) % STEPS_PER_LAYER;
  if (ph == 3 && (layer & 1)) return false;
  if (ph == 0 && layer > 0) return false;
  return true;
}

DEVI void run_step(PP p, int step, unsigned char* lds, unsigned char* lds_all, float gscale = 1.f) {
  if (step == 0) {
    phase_prep(p, lds);
    return;
  }
  if (step == NSTEPS - 1) {
    phase_norm(p, 0, 2, TL);
    return;
  }
  int layer = (step - 1) / STEPS_PER_LAYER, ph = (step - 1) % STEPS_PER_LAYER;
  bool even = (layer & 1) == 0;
  int j = layer >> 1;
  bool upd_ctx = layer < 2;
  bool need_ctx = layer < 3;
  int nt_in = need_ctx ? TT : TL;
  int nt = upd_ctx ? TT : TL;
  switch (ph) {
    case 0: phase_norm(p, layer, 0, nt_in); break;
    case 1:
      if (even)
        gemm8_phase<EPI_INPROJ>(p, p->h, D, p->wt_in_ab + (size_t)j * 1280 * D, D, nt_in / 256, 5, D, layer, lds_all);
      else
        gemm8_phase<EPI_GELU>(p, p->h, D, p->wt_in_gs + (size_t)j * 2048 * D, D, nt / 256, 8, D, layer, lds_all);
      break;
    case 2:
      if (even) {
        phase_fft_a(p, lds);
        if (upd_ctx) phase_dft_ctx(p, lds);
        phase_attn(p, layer, upd_ctx, lds);
      } else {
        phase_sgu(p, j, nt / 128, lds);
      }
      break;
    case 3:
      if (even) phase_fft_b(p, lds);
      break;
    case 4:
      if (even)
      {
        if (layer == 0) gemm8_phase<EPI_RESID0>(p, p->mix, LDMIX, p->wt_out_ab + (size_t)j * D * LDMIX, LDMIX, nt / 256, 4, LDMIX, layer, lds_all, gscale);
        else gemm8_phase<EPI_RESID>(p, p->mix, LDMIX, p->wt_out_ab + (size_t)j * D * LDMIX, LDMIX, nt / 256, 4, LDMIX, layer, lds_all, gscale);
      }
      else
      {
        gemm8_phase<EPI_RESID>(p, p->mix, LDMIX, p->wt_out_gs + (size_t)j * D * D, D, nt / 256, 4, D, layer, lds_all, gscale);
      }
      break;
    case 5: phase_norm(p, layer, 1, nt); break;
    case 6: gemm8_phase<EPI_STORE>(p, p->h, D, p->wt_q + (size_t)layer * 2048 * D, D, nt / 256, 8, D, layer, lds_all, gscale); break;
    case 7: phase_route(p, layer, nt, lds); break;
    case 8: phase_expert(p, layer, nt, lds, gscale, (gscale == 1.f) ? 0xffff : REP_IDMASK); break;
  }
}

__global__ void __launch_bounds__(PHYS_THREADS, 2) mega(Params p_unused, int step_lo, int step_hi) {
  unsigned char* lds_all = g_lds;
  if ((threadIdx.x & 63) == 0) *reinterpret_cast<volatile int*>(g_lds + LDS_BYTES - 16 - 256 + 4 * hw_slot()) = (int)(threadIdx.x >> 6);
  __syncthreads();
  unsigned char* lds = lds_all + (wave_index() >> 2) * LDS_HALF;
  PP pp = (PP)__builtin_amdgcn_kernarg_segment_ptr();
  volatile LAS unsigned* st = (volatile LAS unsigned*)(lds_all + LDS_BYTES - 16);
  if (threadIdx.x == 0) {
    st[0] = 0u;
    st[1] = 0u;
  }
  __syncthreads();
  XcdBarrier xb = xcd_barrier_post(pp->bar, st);
  int nsync = 0;
  bool first = true;
  for (int s = step_lo; s < step_hi; ++s) {
    if (!step_active(s)) continue;
    if (!first) {
      if (nsync == 0) cg::this_grid().sync();
      else xcd_barrier(xb);
      ++nsync;
    }
    first = false;
    int nrep = 1;
    if (PROBE_PH) {
      if (s == 0) nrep += (PROBE_PH >> 15) & 1;
      else if (s < NSTEPS - 1) {
        const int lay_ = (s - 1) / STEPS_PER_LAYER, ph_ = (s - 1) % STEPS_PER_LAYER;
        nrep += (PROBE_PH >> ph_) & 1;
        if (ph_ == 2 && ((PROBE_PH >> 9) & 1) && !(lay_ & 1)) nrep = 2;
        if (ph_ == 2 && ((PROBE_PH >> 10) & 1) && (lay_ & 1)) nrep = 2;
        if (ph_ == 1 && ((PROBE_PH >> 12) & 1) && !(lay_ & 1)) nrep = 2;
        if (ph_ == 1 && ((PROBE_PH >> 13) & 1) && (lay_ & 1)) nrep = 2;
        if (ph_ == 4 && ((PROBE_PH >> 11) & 1) && !(lay_ & 1)) nrep = 2;
        if (ph_ == 4 && ((PROBE_PH >> 14) & 1) && (lay_ & 1)) nrep = 2;
      }
      asm volatile("" : "+s"(nrep));
    }
#pragma nounroll
    for (int rep = nrep - 1; rep >= 0; --rep) {
      if (rep != nrep - 1) xcd_barrier(xb);
      PP q = pp;
      asm volatile("" : "+s"(q));
      int gi = __builtin_amdgcn_readfirstlane(rep ? 0 : 0x3f800000);
      if (PROBE_PH) asm volatile("" : "+s"(gi));
      const float gs = __int_as_float(gi);
      if (PROBE_PH) run_step(q, s, lds, lds_all, gs);
      else run_step(q, s, lds, lds_all);
    }
  }
}

static size_t align_up(size_t v) { return (v + 255) & ~(size_t)255; }

extern "C" void kernel_launch(void* const* d_in, const int* in_sizes, int n_in, void* d_out, int out_size, void* d_ws,
                              size_t ws_size, hipStream_t stream) {
  Params p{};
  p.x = (const float*)d_in[0];
  p.c = (const float*)d_in[1];
  p.ctx = (const float*)d_in[2];
  p.c_ctx = (const float*)d_in[3];
  p.ada_w = (const float*)d_in[4];
  p.ada_b = (const float*)d_in[5];
  p.norm_mix_w = (const float*)d_in[6];
  p.norm_ffn_w = (const float*)d_in[7];
  p.ab_w_in = (const float*)d_in[8];
  p.ab_w_out = (const float*)d_in[9];
  p.attn_sink = (const float*)d_in[10];
  p.gs_w_in = (const float*)d_in[11];
  p.gs_norm_w = (const float*)d_in[12];
  p.gs_w_s = (const float*)d_in[13];
  p.gs_b_s = (const float*)d_in[14];
  p.gs_w_out = (const float*)d_in[15];
  p.peer_w_q = (const float*)d_in[16];
  p.peer_keys = (const float*)d_in[17];
  p.peer_u = (const float*)d_in[18];
  p.peer_v = (const float*)d_in[19];
  p.norm_out_w = (const float*)d_in[20];
  p.out = (float*)d_out;
  unsigned char* w = (unsigned char*)d_ws;
  size_t off = 0;
  auto take = [&](size_t bytes) {
    unsigned char* r = w + off;
    off = align_up(off + bytes);
    return r;
  };
  p.bar = (unsigned*)take((size_t)XCD_BAR_WORDS * 4);
  p.mod = (float*)take((size_t)DEPTH * 9 * 6144 * 4);
  p.cs = (float2*)take(64 * 16 * 8);
  p.xs = (bf16_t*)take((size_t)TT * D * 2);
  p.h = (bf16_t*)take((size_t)TT * D * 2);
  p.P = (bf16_t*)take((size_t)TT * 2048 * 2);
  p.kbuf = (bf16_t*)take((size_t)NB * 2 * KVLEN * 64 * 2);
  p.vbuf = (bf16_t*)take((size_t)NB * 2 * KVLEN * 64 * 2);
  p.zvT = (bf16_t*)take((size_t)TT * 1024 * 2);
  p.rowss = (float*)take((size_t)(TT / 128) * 32 * 128 * 4);
  p.mix = (bf16_t*)take((size_t)TT * LDMIX * 2);
  p.fa = (bf16_t*)take((size_t)TL * 1024 * 2);
  p.tops = (float*)take((size_t)TT * 256 * 4);
  p.eidx = (int*)take((size_t)TT * 128 * 4);
  p.gate = (float*)take((size_t)TT * 128 * 4);
  p.wt_in_ab = (bf16_t*)take((size_t)2 * 1280 * D * 2);
  p.wt_out_ab = (bf16_t*)take((size_t)2 * D * LDMIX * 2);
  p.wt_in_gs = (bf16_t*)take((size_t)2 * 2048 * D * 2);
  p.wt_out_gs = (bf16_t*)take((size_t)2 * D * D * 2);
  p.wt_q = (bf16_t*)take((size_t)DEPTH * 2048 * D * 2);
  p.keysb = (bf16_t*)take((size_t)DEPTH * 8 * 2 * 128 * 128 * 2);
  p.su = (float*)take((size_t)DEPTH * NEXP * 4);
  p.sv = (float*)take((size_t)DEPTH * NEXP * 4);
  p.h8 = (signed char*)take((size_t)TT * D);
  p.sx = (float*)take((size_t)TT * 4);
  p.utab = (unsigned char*)take((size_t)DEPTH * NEXP * D);
  p.vtab = (unsigned char*)take((size_t)DEPTH * NEXP * D);
  if (off > ws_size) {
    fprintf(stderr, "workspace too small: need %zu have %zu\n", off, ws_size);
    return;
  }
  hipMemsetAsync(p.bar, 0, (size_t)XCD_BAR_WORDS * 4, stream);
  static int grid_blocks = 0;
  if (!grid_blocks) {
    int dev = 0, cus = 0, per_cu = 0;
    hipGetDevice(&dev);
    hipDeviceGetAttribute(&cus, hipDeviceAttributeMultiprocessorCount, dev);
    hipOccupancyMaxActiveBlocksPerMultiprocessor(&per_cu, mega, PHYS_THREADS, 0);
    if (per_cu > 1) per_cu = 1;
    if (per_cu < 1) per_cu = 1;
    grid_blocks = cus * per_cu;
  }
#if ONE_LAUNCH
  int lo = 0, hi = NSTEPS;
  void* args[] = {&p, &lo, &hi};
  hipError_t e = hipLaunchCooperativeKernel((void*)mega, dim3(grid_blocks), dim3(PHYS_THREADS), args, 0, stream);
  if (e != hipSuccess) fprintf(stderr, "cooperative launch failed: %s (grid %d)\n", hipGetErrorString(e), grid_blocks);
#else
  for (int s = 0; s < NSTEPS; ++s) {
    if (s != 0 && s != NSTEPS - 1) {
      int layer = (s - 1) / STEPS_PER_LAYER, ph = (s - 1) % STEPS_PER_LAYER;
      if (ph == 3 && (layer & 1)) continue;
    }
    hipLaunchKernelGGL(mega, dim3(grid_blocks), dim3(NTHREADS), 0, stream, p, s, s + 1);
  }
#endif
}
```

```cpp
#include <hip/hip_runtime.h>
#include <hip/hip_bf16.h>
#include <hip/hip_cooperative_groups.h>
#include <cstdio>
namespace cg = cooperative_groups;

#ifndef PROBE_PH
#define PROBE_PH 0
#endif
#ifndef PROBE_SKIP_EPI
#define PROBE_SKIP_EPI 0
#endif
#ifndef REP_MASK
#define REP_MASK 0
#endif
#ifndef REP_MODE
#define REP_MODE 0
#endif
#ifndef REP_IDMASK
#define REP_IDMASK 0xffff
#endif
#ifndef ONE_LAUNCH
#define ONE_LAUNCH 1
#endif

#define DEVI __device__ __forceinline__
typedef unsigned short bf16_t;
using bf16x8 = __attribute__((ext_vector_type(8))) short;
using f32x4 = __attribute__((ext_vector_type(4))) float;
using f32x16 = __attribute__((ext_vector_type(16))) float;

constexpr int D = 1024, NB = 8, SEQ = 4096, CTX = 256, DEPTH = 4;
constexpr int TL = NB * SEQ, TC = NB * CTX, TT = TL + TC;
constexpr int KVLEN = CTX + SEQ;
constexpr int NEXP = 16384;
constexpr int LDMIX = 1536;
constexpr float USCALE = 64.f, VSCALE = 8.f;
constexpr int TPB = 68;
constexpr int LDS_HALF = 68 * 1024;
constexpr int LDS_BYTES = 2 * LDS_HALF;
constexpr int PHYS_THREADS = 512;
constexpr int NTHREADS = 256;
constexpr int STEPS_PER_LAYER = 9;
constexpr int NSTEPS = 1 + DEPTH * STEPS_PER_LAYER + 1;

struct Params {
  const float *x, *c, *ctx, *c_ctx, *ada_w, *ada_b, *norm_mix_w, *norm_ffn_w, *ab_w_in, *ab_w_out, *attn_sink,
      *gs_w_in, *gs_norm_w, *gs_w_s, *gs_b_s, *gs_w_out, *peer_w_q, *peer_keys, *peer_u, *peer_v, *norm_out_w;
  float* out;
  float* mod;
  float2* cs;
  bf16_t* xs;
  bf16_t* h;
  bf16_t* P;
  bf16_t* kbuf;
  bf16_t* vbuf;
  float* rowss;
  bf16_t* zvT;
  bf16_t* mix;
  bf16_t* fa;
  unsigned* bar;
  float* tops;
  int* eidx;
  float* gate;
  bf16_t *wt_in_ab, *wt_out_ab, *wt_in_gs, *wt_out_gs, *wt_q, *keysb;
  unsigned char *utab, *vtab;
  float* su;
  float* sv;
  signed char* h8;
  float* sx;
  signed char* w8_in_ab;
  float* sw_in_ab;
  signed char* w8_in_gs;
  float* sw_in_gs;
  signed char* w8_q;
  float* sw_q;
};

typedef const __attribute__((address_space(4))) Params* PP;

constexpr int ROPE_LDS = LDS_BYTES;
__shared__ __attribute__((aligned(16))) unsigned char g_lds[LDS_BYTES + 8192];
DEVI int hw_slot() {
  int h = (int)(__builtin_amdgcn_s_getreg((6 - 1) << 11 | 0 << 6 | 4) & 63u);
  asm volatile("" : "+s"(h));
  return h;
}
DEVI int wave_index() {
  int w = *reinterpret_cast<volatile int*>(g_lds + LDS_BYTES - 16 - 256 + 4 * hw_slot());
  return __builtin_amdgcn_readfirstlane(w);
}
DEVI int lane_id() { return (int)__builtin_amdgcn_mbcnt_hi(~0u, __builtin_amdgcn_mbcnt_lo(~0u, 0u)); }
DEVI int ltid() { int t = ((wave_index() & 3) << 6) | lane_id(); asm volatile("" : "+v"(t)); return t; }
DEVI int lbid() { int t = 2 * blockIdx.x + (wave_index() >> 2); asm volatile("" : "+s"(t)); return t; }
DEVI int lnblk() { int t = 2 * gridDim.x; asm volatile("" : "+s"(t)); return t; }
DEVI int ptid() { int t = (wave_index() << 6) | lane_id(); asm volatile("" : "+v"(t)); return t; }
DEVI int pbid() { int t = blockIdx.x; asm volatile("" : "+s"(t)); return t; }
DEVI int pnblk() { int t = gridDim.x; asm volatile("" : "+s"(t)); return t; }

typedef __bf16 bf2v_t __attribute__((ext_vector_type(2)));
typedef float f2v_t __attribute__((ext_vector_type(2)));
DEVI bf16_t f2bf(float f) { return __builtin_bit_cast(unsigned short, (__bf16)f); }
DEVI float bf2f(bf16_t h) { return __uint_as_float(((unsigned)h) << 16); }
DEVI float bflo(unsigned u) { return __uint_as_float(u << 16); }
DEVI float bfhi(unsigned u) { return __uint_as_float(u & 0xffff0000u); }
DEVI unsigned pack2(float a, float b) {
  f2v_t v = {a, b};
  return __builtin_bit_cast(unsigned, __builtin_convertvector(v, bf2v_t));
}
DEVI float gelu_tanh(float x) {
  const float k1 = -2.f * 0.7978845608028654f * 1.4426950408889634f;
  const float a = x * __builtin_fmaf(x * x, k1 * 0.044715f, k1);
  return x * __builtin_amdgcn_rcpf(1.f + __builtin_amdgcn_exp2f(a));
}
typedef unsigned nt_u32x4 __attribute__((ext_vector_type(4)));
DEVI void st_nt(uint4* dst, uint4 w) { nt_u32x4 v = {w.x, w.y, w.z, w.w}; __builtin_nontemporal_store(v, reinterpret_cast<nt_u32x4*>(dst)); }
template <int CTRL>
DEVI float dpp_mov(float v) {
  return __builtin_bit_cast(float, __builtin_amdgcn_mov_dpp(__builtin_bit_cast(int, v), CTRL, 0xF, 0xF, true));
}
DEVI int shx_i(int v, int m) { return __builtin_amdgcn_ds_bpermute((lane_id() ^ m) << 2, v); }
DEVI float shx_f(float v, int m) { return __builtin_bit_cast(float, shx_i(__builtin_bit_cast(int, v), m)); }
DEVI float wave_sum(float v) {
  v += dpp_mov<0xB1>(v);
  v += dpp_mov<0x4E>(v);
  v += dpp_mov<0x141>(v);
  v += dpp_mov<0x140>(v);
  v += shx_f(v, 16);
  v += shx_f(v, 32);
  return v;
}
DEVI float wave_max(float v) {
  v = fmaxf(v, dpp_mov<0xB1>(v));
  v = fmaxf(v, dpp_mov<0x4E>(v));
  v = fmaxf(v, dpp_mov<0x141>(v));
  v = fmaxf(v, dpp_mov<0x140>(v));
  v = fmaxf(v, shx_f(v, 16));
  v = fmaxf(v, shx_f(v, 32));
  return v;
}
DEVI int tok_batch(int r) { return r < TL ? (r >> 12) : 8; }

DEVI void prep_transpose_tile(const float* __restrict__ src, int N, bf16_t* __restrict__ dst, int ldk, int tk, int tn2, float* tile, int tid) {
#pragma unroll
  for (int h = 0; h < 2; ++h)
#pragma unroll
    for (int i = 0; i < 16; ++i) {
      int r = (tid >> 6) + 4 * i;
      tile[h * 64 * 65 + r * 65 + (tid & 63)] = src[(size_t)(tk * 64 + r) * N + (2 * tn2 + h) * 64 + (tid & 63)];
    }
  __syncthreads();
#pragma unroll
  for (int h = 0; h < 2; ++h)
#pragma unroll
    for (int i = 0; i < 16; ++i) {
      int n = (tid >> 6) + 4 * i, k = tid & 63;
      dst[(size_t)((2 * tn2 + h) * 64 + n) * ldk + tk * 64 + k] = f2bf(tile[h * 64 * 65 + k * 65 + n]);
    }
}

constexpr int PU_ADA = DEPTH * 96;
constexpr int PU_T_ABIN = 0;
constexpr int PU_T_GSIN = 0;
constexpr int PU_T_GSOUT = 2 * 16 * 8;
constexpr int PU_T_ABOUT = 2 * 8 * 8;
constexpr int PU_T_Q = 0;
constexpr int PU_FOLD = 2 * 4 * 16 * 2;
constexpr int PU_CONV = DEPTH * NEXP * D / 4 / 2048;
constexpr int PU_KEYS = DEPTH * 8 * 2 * 128 * 128 / 4 / 2048;
constexpr int PU_UROWS = DEPTH * NEXP / 32;
constexpr int PU_W8 = 2 * 20 + 2 * 32 + DEPTH * 32;
constexpr int PU_TOTAL = PU_ADA + PU_T_ABIN + PU_T_GSIN + PU_T_GSOUT + PU_T_ABOUT + PU_T_Q + PU_FOLD + 2 * PU_UROWS + PU_KEYS + PU_W8 + 1;

DEVI void phase_prep(PP p, unsigned char* lds) {
  const int tid0 = ltid();
  float* fl = reinterpret_cast<float*>(lds);
  for (int u0 = lbid(); u0 < PU_TOTAL; u0 += lnblk()) {
    int u = u0;
    int tid = tid0;
    asm volatile("" : "+v"(tid));
    if (u < PU_ADA) {
      float* sl = fl;
      {
        float cv[36];
#pragma unroll
        for (int it = 0; it < 36; ++it) {
          const int i = tid + it * NTHREADS, r = i >> 10, k = i & 1023;
          cv[it] = (r < 8) ? p->c[r * 1024 + k] : p->c_ctx[k];
        }
#pragma unroll
        for (int it = 0; it < 36; ++it) sl[tid + it * NTHREADS] = cv[it] * __builtin_amdgcn_rcpf(1.f + __expf(-cv[it]));
      }
      __syncthreads();
      float* red = sl + 9 * 1024;
      const int ks = __builtin_amdgcn_readfirstlane(tid >> 6), r4 = (tid >> 4) & 3, c4 = tid & 15;
      const int layer = u / 96, c0 = (u % 96) * 64;
      const float* w = p->ada_w + (size_t)layer * D * 6144 + (size_t)(ks * 256) * 6144 + c0;
      const unsigned loff = (unsigned)(r4 * 6144 + 4 * c4);
      float acc[9][4];
#pragma unroll
      for (int r = 0; r < 9; ++r)
#pragma unroll
        for (int q = 0; q < 4; ++q) acc[r][q] = 0.f;
#pragma unroll 1
      for (int i0 = 0; i0 < 64; i0 += 16) {
        float4 wv[16];
#pragma unroll
        for (int kk = 0; kk < 16; ++kk) wv[kk] = *reinterpret_cast<const float4*>(w + (size_t)(i0 + kk) * 4 * 6144 + loff);
#pragma unroll
        for (int kk = 0; kk < 16; ++kk) {
          const int k = ks * 256 + (i0 + kk) * 4 + r4;
#pragma unroll
          for (int r = 0; r < 9; ++r) {
            const float sv = sl[r * 1024 + k];
            acc[r][0] += sv * wv[kk].x;
            acc[r][1] += sv * wv[kk].y;
            acc[r][2] += sv * wv[kk].z;
            acc[r][3] += sv * wv[kk].w;
          }
        }
      }
#pragma unroll
      for (int r = 0; r < 9; ++r)
#pragma unroll
        for (int q = 0; q < 4; ++q) {
          float v = acc[r][q];
          v += shx_f(v, 16);
          v += shx_f(v, 32);
          if (r4 == 0) red[(ks * 9 + r) * 64 + 4 * c4 + q] = v;
        }
      __syncthreads();
      for (int i = tid; i < 9 * 64; i += NTHREADS) {
        int r = i >> 6, cc = i & 63;
        float sm = red[(0 * 9 + r) * 64 + cc] + red[(1 * 9 + r) * 64 + cc] + red[(2 * 9 + r) * 64 + cc] + red[(3 * 9 + r) * 64 + cc];
        sm += p->ada_b[(size_t)layer * 6144 + c0 + cc];
        p->mod[((size_t)layer * 9 + r) * 6144 + c0 + cc] = sm;
      }
      __syncthreads();
      continue;
    }
    u -= PU_ADA;
    if (u < PU_W8) {
      const float* src;
      signed char* dst8;
      float* sdst;
      int N;
      if (u < 40) {
        const int j = u / 20, nb = u % 20;
        N = 1280;
        src = p->ab_w_in + (size_t)j * D * N + nb * 64;
        dst8 = p->w8_in_ab + ((size_t)j * N + nb * 64) * D;
        sdst = p->sw_in_ab + (size_t)j * N + nb * 64;
      } else if (u < 104) {
        const int v = u - 40, j = v / 32, nb = v % 32;
        N = 2048;
        src = p->gs_w_in + (size_t)j * D * N + nb * 64;
        dst8 = p->w8_in_gs + ((size_t)j * N + nb * 64) * D;
        sdst = p->sw_in_gs + (size_t)j * N + nb * 64;
      } else {
        const int v = u - 104, j = v / 32, nb = v % 32;
        N = 2048;
        src = p->peer_w_q + (size_t)j * D * N + nb * 64;
        dst8 = p->w8_q + ((size_t)j * N + nb * 64) * D;
        sdst = p->sw_q + (size_t)j * N + nb * 64;
      }
      float* tile = fl;
      float* red = fl + 64 * 65;
      {
        const int kr = tid >> 4, c4 = tid & 15;
        float am[4] = {0.f, 0.f, 0.f, 0.f};
#pragma unroll 16
        for (int i = 0; i < 64; ++i) {
          const float4 v = *reinterpret_cast<const float4*>(src + (size_t)(kr + 16 * i) * N + 4 * c4);
          am[0] = fmaxf(am[0], fabsf(v.x));
          am[1] = fmaxf(am[1], fabsf(v.y));
          am[2] = fmaxf(am[2], fabsf(v.z));
          am[3] = fmaxf(am[3], fabsf(v.w));
        }
#pragma unroll
        for (int q = 0; q < 4; ++q) red[kr * 64 + 4 * c4 + q] = am[q];
      }
      __syncthreads();
      if (tid < 64) {
        float m = 0.f;
#pragma unroll
        for (int r = 0; r < 16; ++r) m = fmaxf(m, red[r * 64 + tid]);
        m = fmaxf(m, 1e-30f);
        red[1024 + tid] = 127.f / m;
        sdst[tid] = m * (1.f / 127.f);
      }
      float cur[16];
#pragma unroll
      for (int i = 0; i < 16; ++i) cur[i] = src[(size_t)((tid >> 6) + 4 * i) * N + (tid & 63)];
#pragma unroll 1
      for (int kb = 0; kb < 16; ++kb) {
        __syncthreads();
#pragma unroll
        for (int i = 0; i < 16; ++i) tile[((tid >> 6) + 4 * i) * 65 + (tid & 63)] = cur[i];
        __syncthreads();
        {
          const int kn = (kb + 1 < 16) ? kb + 1 : kb;
#pragma unroll
          for (int i = 0; i < 16; ++i) cur[i] = src[(size_t)(kn * 64 + (tid >> 6) + 4 * i) * N + (tid & 63)];
        }
#pragma unroll
        for (int i = 0; i < 4; ++i) {
          const int n = (tid >> 4) + 16 * i, k4 = (tid & 15) * 4;
          const float qs = red[1024 + n];
          const int q0 = (int)rintf(tile[(k4 + 0) * 65 + n] * qs), q1 = (int)rintf(tile[(k4 + 1) * 65 + n] * qs);
          const int q2 = (int)rintf(tile[(k4 + 2) * 65 + n] * qs), q3 = (int)rintf(tile[(k4 + 3) * 65 + n] * qs);
          *reinterpret_cast<unsigned*>(dst8 + (size_t)n * D + kb * 64 + k4) =
              (unsigned)(q0 & 255) | ((unsigned)(q1 & 255) << 8) | ((unsigned)(q2 & 255) << 16) | ((unsigned)(q3 & 255) << 24);
        }
      }
      __syncthreads();
      continue;
    }
    u -= PU_W8;
    if (u < PU_T_ABIN) {
      int j = u / 160, t = u % 160;
      prep_transpose_tile(p->ab_w_in + (size_t)j * D * 1280, 1280, p->wt_in_ab + (size_t)j * 1280 * D, D, t / 10, t % 10, fl, tid);
      __syncthreads();
      continue;
    }
    u -= PU_T_ABIN;
    if (u < PU_T_GSIN) {
      int j = u / 256, t = u % 256;
      prep_transpose_tile(p->gs_w_in + (size_t)j * D * 2048, 2048, p->wt_in_gs + (size_t)j * 2048 * D, D, t / 16, t % 16, fl, tid);
      __syncthreads();
      continue;
    }
    u -= PU_T_GSIN;
    if (u < PU_T_GSOUT) {
      int j = u / 128, t = u % 128;
      prep_transpose_tile(p->gs_w_out + (size_t)j * D * D, D, p->wt_out_gs + (size_t)j * D * D, D, t / 8, t % 8, fl, tid);
      __syncthreads();
      continue;
    }
    u -= PU_T_GSOUT;
    if (u < PU_T_ABOUT) {
      int j = u / 64, t = u % 64;
      prep_transpose_tile(p->ab_w_out + (size_t)j * D * D, D, p->wt_out_ab + (size_t)j * D * LDMIX, LDMIX, t / 8, t % 8, fl, tid);
      __syncthreads();
      continue;
    }
    u -= PU_T_ABOUT;
    if (u < PU_T_Q) {
      int i = u / 256, t = u % 256;
      prep_transpose_tile(p->peer_w_q + (size_t)i * D * 2048, 2048, p->wt_q + (size_t)i * 2048 * D, D, t / 16, t % 16, fl, tid);
      __syncthreads();
      continue;
    }
    u -= PU_T_Q;
    if (u < PU_FOLD) {
      const int mh = u & 1, nc = (u >> 1) & 15, g = (u >> 5) & 3, j = u >> 7;
      float2* tw = reinterpret_cast<float2*>(lds);
      float* wt = reinterpret_cast<float*>(lds + 1024);
      if (tid < 128) {
        float sn, cn;
        sincospif((float)tid / 64.f, &sn, &cn);
        tw[tid] = make_float2(cn, sn);
      }
      {
        const float* wsrc = p->ab_w_out + (size_t)j * D * D + (size_t)(512 + g * 128) * D + nc * 64;
#pragma unroll 8
        for (int i = 0; i < 32; ++i) {
          int l = (tid >> 6) + 4 * i;
          wt[l * 64 + (tid & 63)] = wsrc[(size_t)l * D + (tid & 63)];
        }
      }
      __syncthreads();
      {
        const int lane = tid & 63, mq = __builtin_amdgcn_readfirstlane(tid >> 6), fr = lane & 15, fq = lane >> 4;
        const int m = mh * 64 + mq * 16 + fr;
        f32x4 acc[2][4];
#pragma unroll
        for (int q = 0; q < 2; ++q)
#pragma unroll
          for (int nt = 0; nt < 4; ++nt) acc[q][nt] = f32x4{0.f, 0.f, 0.f, 0.f};
#pragma unroll 4
        for (int ks = 0; ks < 32; ++ks) {
          const int l = 4 * ks + fq;
          const float2 t = tw[(m * l) & 127];
#pragma unroll
          for (int nt = 0; nt < 4; ++nt) {
            const float bv = wt[l * 64 + nt * 16 + fr];
            acc[0][nt] = __builtin_amdgcn_mfma_f32_16x16x4f32(t.x, bv, acc[0][nt], 0, 0, 0);
            acc[1][nt] = __builtin_amdgcn_mfma_f32_16x16x4f32(t.y, bv, acc[1][nt], 0, 0, 0);
          }
        }
        const int m0 = mh * 64 + mq * 16 + 4 * fq;
#pragma unroll
        for (int nt = 0; nt < 4; ++nt) {
          bf16_t* dst = p->wt_out_ab + (size_t)j * D * LDMIX + (size_t)(nc * 64 + nt * 16 + fr) * LDMIX + g * 128;
          uint2 w;
          w.x = pack2(acc[0][nt][0], acc[0][nt][1]);
          w.y = pack2(acc[0][nt][2], acc[0][nt][3]);
          *reinterpret_cast<uint2*>(dst + 512 + m0) = w;
          w.x = pack2(acc[1][nt][0], acc[1][nt][1]);
          w.y = pack2(acc[1][nt][2], acc[1][nt][3]);
          *reinterpret_cast<uint2*>(dst + 1024 + m0) = w;
        }
      }
      __syncthreads();
      continue;
    }
    u -= PU_FOLD;
    if (u < 2 * PU_UROWS) {
      const bool isv = u >= PU_UROWS;
      if (isv) u -= PU_UROWS;
      const float* src = isv ? p->peer_v : p->peer_u;
      unsigned char* dst = isv ? p->vtab : p->utab;
      float* sdst = isv ? p->sv : p->su;
      const int lane = tid & 63, wv = tid >> 6;
#pragma unroll 1
      for (int rr = 0; rr < 8; rr += 4) {
        size_t row0 = (size_t)u * 32 + wv * 8 + rr;
        float4 v[4][4];
#pragma unroll
        for (int k = 0; k < 4; ++k)
#pragma unroll
          for (int i = 0; i < 4; ++i) v[k][i] = reinterpret_cast<const float4*>(src + (row0 + k) * D)[lane * 4 + i];
#pragma unroll
        for (int k = 0; k < 4; ++k) {
          float am = 0.f;
#pragma unroll
          for (int i = 0; i < 4; ++i)
            am = fmaxf(am, fmaxf(fmaxf(fabsf(v[k][i].x), fabsf(v[k][i].y)), fmaxf(fabsf(v[k][i].z), fabsf(v[k][i].w))));
          am = wave_max(am);
          am = fmaxf(am, 1e-30f);
          float qs = 127.f / am;
          uint4 o;
          unsigned* op = reinterpret_cast<unsigned*>(&o);
#pragma unroll
          for (int i = 0; i < 4; ++i) {
            int q0 = (int)rintf(v[k][i].x * qs), q1 = (int)rintf(v[k][i].y * qs), q2 = (int)rintf(v[k][i].z * qs), q3 = (int)rintf(v[k][i].w * qs);
            op[i] = (unsigned)(q0 & 255) | ((unsigned)(q1 & 255) << 8) | ((unsigned)(q2 & 255) << 16) | ((unsigned)(q3 & 255) << 24);
          }
          reinterpret_cast<uint4*>(dst + (row0 + k) * D)[lane] = o;
          if (lane == 0) sdst[row0 + k] = am * (1.f / 127.f);
        }
      }
      continue;
    }
    u -= 2 * PU_UROWS;
    if (u < PU_KEYS) {
      const float4* s4 = reinterpret_cast<const float4*>(p->peer_keys) + (size_t)u * 2048 + tid;
      uint2* d2 = reinterpret_cast<uint2*>(p->keysb) + (size_t)u * 2048 + tid;
#pragma unroll
      for (int k = 0; k < 8; ++k) {
        float4 v = s4[k * 256];
        uint2 o;
        o.x = pack2(v.x, v.y);
        o.y = pack2(v.z, v.w);
        d2[k * 256] = o;
      }
      continue;
    }
    for (int i = tid; i < 64 * 16; i += NTHREADS) {
      int pos = i >> 4, k = i & 15;
      float inv = powf(10000.f, -(float)k / 16.f);
      float ang = (float)pos * inv;
      float sn, cn;
      sincosf(ang, &sn, &cn);
      p->cs[i] = make_float2(cn, sn);
    }
  }
}

DEVI void norm_load(PP p, int layer, int which, int tok, int lane, float4 (&v)[4]) {
  if (which == 0 && layer == 0) {
    const float4* xr = reinterpret_cast<const float4*>((tok < TL) ? p->x + (size_t)tok * D : p->ctx + (size_t)(tok - TL) * D);
#pragma unroll
    for (int i = 0; i < 4; ++i) v[i] = xr[lane + 64 * i];
  } else {
    const uint2* xr = reinterpret_cast<const uint2*>(p->xs + (size_t)tok * D);
#pragma unroll
    for (int i = 0; i < 4; ++i) {
      const uint2 u = xr[lane + 64 * i];
      v[i] = make_float4(bflo(u.x), bfhi(u.x), bflo(u.y), bfhi(u.y));
    }
  }
}
DEVI void norm_coef(PP p, int layer, int which, int b, int lane, float4 (&ca)[4], float4 (&cb)[4]) {
  const float* w = which == 0 ? p->norm_mix_w + layer * D : (which == 1 ? p->norm_ffn_w + layer * D : p->norm_out_w);
  const float* mb = p->mod + ((size_t)layer * 9 + b) * 6144 + (which == 0 ? 0 : 3072);
#pragma unroll
  for (int i = 0; i < 4; ++i) {
    const float4 wv = reinterpret_cast<const float4*>(w)[lane + 64 * i];
    if (which == 2) {
      ca[i] = wv;
      cb[i] = make_float4(0.f, 0.f, 0.f, 0.f);
    } else {
      const float4 sh = reinterpret_cast<const float4*>(mb)[lane + 64 * i];
      const float4 sc = reinterpret_cast<const float4*>(mb + 1024)[lane + 64 * i];
      ca[i] = make_float4(wv.x * (1.f + sc.x), wv.y * (1.f + sc.y), wv.z * (1.f + sc.z), wv.w * (1.f + sc.w));
      cb[i] = sh;
    }
  }
}
DEVI void norm_finish(PP p, int which, int tok, int lane, const float4 (&v)[4], const float4 (&ca)[4], const float4 (&cb)[4], int hfrom) {
  float ss = 0.f;
#pragma unroll
  for (int i = 0; i < 4; ++i) ss += v[i].x * v[i].x + v[i].y * v[i].y + v[i].z * v[i].z + v[i].w * v[i].w;
  ss = wave_sum(ss);
  float rstd = rsqrtf(ss * (1.f / 1024.f) + 1e-6f);
  if (which == 2) {
    float4* o = reinterpret_cast<float4*>(p->out + (size_t)tok * D);
#pragma unroll
    for (int i = 0; i < 4; ++i) {
      float4 r;
      r.x = v[i].x * rstd * ca[i].x;
      r.y = v[i].y * rstd * ca[i].y;
      r.z = v[i].z * rstd * ca[i].z;
      r.w = v[i].w * rstd * ca[i].w;
      o[lane + 64 * i] = r;
    }
  } else {
    uint2* o = reinterpret_cast<uint2*>(p->h + (size_t)tok * D);
    float av[4][4];
    float am = 0.f;
#pragma unroll
    for (int i = 0; i < 4; ++i) {
      float a0 = v[i].x * rstd * ca[i].x + cb[i].x;
      float a1 = v[i].y * rstd * ca[i].y + cb[i].y;
      float a2 = v[i].z * rstd * ca[i].z + cb[i].z;
      float a3 = v[i].w * rstd * ca[i].w + cb[i].w;
      if (tok >= hfrom) {
        uint2 r;
        r.x = pack2(a0, a1);
        r.y = pack2(a2, a3);
        o[lane + 64 * i] = r;
      }
      av[i][0] = a0; av[i][1] = a1; av[i][2] = a2; av[i][3] = a3;
      am = fmaxf(am, fmaxf(fmaxf(fabsf(a0), fabsf(a1)), fmaxf(fabsf(a2), fabsf(a3))));
    }
    {
      am = fmaxf(wave_max(am), 1e-30f);
      float qs = 127.f / am;
      unsigned* o8 = reinterpret_cast<unsigned*>(p->h8 + (size_t)tok * D);
#pragma unroll
      for (int i = 0; i < 4; ++i) {
        int q0 = (int)rintf(av[i][0] * qs), q1 = (int)rintf(av[i][1] * qs), q2 = (int)rintf(av[i][2] * qs), q3 = (int)rintf(av[i][3] * qs);
        o8[lane + 64 * i] = (unsigned)(q0 & 255) | ((unsigned)(q1 & 255) << 8) | ((unsigned)(q2 & 255) << 16) | ((unsigned)(q3 & 255) << 24);
      }
      if (lane == 0) p->sx[tok] = am * (1.f / 127.f);
    }
  }
}
DEVI void norm_rows(PP p, int layer, int which, int tok, int end, int stride, int lane, int hfrom) {
  if (tok >= end) return;
  float4 v[4], ca[4], cb[4];
  int bcur = -1;
  norm_load(p, layer, which, tok, lane, v);
  for (; tok < end; tok += stride) {
    const int nx = (tok + stride < end) ? tok + stride : tok;
    float4 vn[4];
    norm_load(p, layer, which, nx, lane, vn);
    const int b = tok_batch(tok);
    if (b != bcur) {
      norm_coef(p, layer, which, b, lane, ca, cb);
      bcur = b;
    }
    norm_finish(p, which, tok, lane, v, ca, cb, hfrom);
#pragma unroll
    for (int i = 0; i < 4; ++i) v[i] = vn[i];
  }
}
DEVI int gemm_tail_row0(int Mtiles, int Ntiles) {
  (void)Ntiles;
  return Mtiles * 256;
}
DEVI void phase_norm(PP p, int layer, int which, int ntok, int hfrom) {
  int lane = ltid() & 63;
  int gw = lbid() * 4 + __builtin_amdgcn_readfirstlane(ltid() >> 6), nw = lnblk() * 4;
  const int per = (ntok + nw - 1) / nw;
  const int t0 = gw * per, t1 = (t0 + per < ntok) ? t0 + per : ntok;
  norm_rows(p, layer, which, t0, t1, 1, lane, hfrom);
}

enum { EPI_STORE = 0, EPI_GELU = 1, EPI_RESID = 2, EPI_INPROJ = 3, EPI_RESID0 = 4 };

template <int EPI>
DEVI void gemm_phase(PP p, const bf16_t* __restrict__ A, int lda, const bf16_t* __restrict__ Bt, int ldb,
                     int Mtiles, int Ntiles, int K, int layer, unsigned char* lds, float gscale = 1.f, int big_t0 = -1, int big_n = 0,
                     int big_ntn = 1) {
  const int tid = ltid();
  const int wid = __builtin_amdgcn_readfirstlane(tid >> 6), lane = tid & 63, wr = wid >> 1, wc = wid & 1, fr = lane & 15, fq = lane >> 4;
  int nblk = lnblk();
  int bid = lbid();
  int lb = bid;
  {
    const int pn = nblk >> 1, pb = bid >> 1;
    if ((pn & 7) == 0) lb = 2 * ((pb & 7) * (pn >> 3) + (pb >> 3)) + (bid & 1);
  }
  int ntiles = (big_t0 >= 0) ? 4 * big_n : Mtiles * Ntiles;
  const int nk = K / 64;
  const int srow = tid >> 3;
  const int scol = ((tid & 7) ^ ((tid >> 3) & 7)) * 8;
#define GEMM_STAGE(ga_, gb_, kt_, buf_)                                                                               \
  {                                                                                                                   \
    _Pragma("unroll") for (int i_ = 0; i_ < 4; ++i_) {                                                                \
      __builtin_amdgcn_global_load_lds((const unsigned*)((ga_) + (size_t)(32 * i_) * lda + (kt_) * 64),               \
                                       (__attribute__((address_space(3))) unsigned*)(lds + (buf_) * 32768 + tid * 16 + i_ * 4096), 16, 0, 0); \
      __builtin_amdgcn_global_load_lds((const unsigned*)((gb_) + (size_t)(32 * i_) * ldb + (kt_) * 64),               \
                                       (__attribute__((address_space(3))) unsigned*)(lds + (buf_) * 32768 + 16384 + tid * 16 + i_ * 4096), 16, 0, 0); \
    }                                                                                                                 \
  }
  auto tile_rc = [&](int t, int& tm_, int& tn_) {
    if (big_t0 >= 0) {
      int bt = big_t0 + (t >> 2), q = t & 3;
      tm_ = 2 * (bt / big_ntn) + (q >> 1);
      tn_ = 2 * (bt % big_ntn) + (q & 1);
    } else {
      tm_ = t / Ntiles;
      tn_ = t % Ntiles;
    }
  };
  if (lb < ntiles) {
    int tm0, tn0;
    tile_rc(lb, tm0, tn0);
    const bf16_t* ga0 = A + (size_t)(tm0 * 128 + srow) * lda + scol;
    const bf16_t* gb0 = Bt + (size_t)(tn0 * 128 + srow) * ldb + scol;
    GEMM_STAGE(ga0, gb0, 0, 0)
  }
  for (int t = lb; t < ntiles; t += nblk) {
    int tm, tn;
    tile_rc(t, tm, tn);
    int brow = tm * 128, bcol = tn * 128;
    f32x4 acc[4][4];
#pragma unroll
    for (int m = 0; m < 4; ++m)
#pragma unroll
      for (int n = 0; n < 4; ++n) acc[m][n] = f32x4{0.f, 0.f, 0.f, 0.f};
    const bf16_t* ga = A + (size_t)(brow + srow) * lda + scol;
    const bf16_t* gb = Bt + (size_t)(bcol + srow) * ldb + scol;
    for (int kt = 0; kt < nk; ++kt) {
      const int buf = kt & 1;
      asm volatile("s_waitcnt vmcnt(0)" ::: "memory");
      __syncthreads();
      if (kt + 1 < nk) GEMM_STAGE(ga, gb, kt + 1, buf ^ 1)
      const unsigned char* SA = lds + buf * 32768;
      const unsigned char* SB = SA + 16384;
      bf16x8 At[2][4], Bl[2][4];
#pragma unroll
      for (int ks = 0; ks < 2; ++ks)
#pragma unroll
        for (int m = 0; m < 4; ++m) {
          const int sl = ((ks * 4 + fq) ^ (fr & 7)) << 4;
          At[ks][m] = *reinterpret_cast<const bf16x8*>(SA + (wr * 64 + m * 16 + fr) * 128 + sl);
          Bl[ks][m] = *reinterpret_cast<const bf16x8*>(SB + (wc * 64 + m * 16 + fr) * 128 + sl);
        }
#pragma unroll
      for (int ks = 0; ks < 2; ++ks)
#pragma unroll
        for (int m = 0; m < 4; ++m)
#pragma unroll
          for (int n = 0; n < 4; ++n)
            acc[m][n] = __builtin_amdgcn_mfma_f32_16x16x32_bf16(At[ks][m], Bl[ks][n], acc[m][n], 0, 0, 0);
    }
    {
      int t2 = t + nblk;
      if (t2 < ntiles) {
        int tm2, tn2;
        tile_rc(t2, tm2, tn2);
        const bf16_t* ga2 = A + (size_t)(tm2 * 128 + srow) * lda + scol;
        const bf16_t* gb2 = Bt + (size_t)(tn2 * 128 + srow) * ldb + scol;
        GEMM_STAGE(ga2, gb2, 0, 0)
      }
    }
    const int colbase = bcol + wc * 64;
    if constexpr (EPI == EPI_STORE || EPI == EPI_GELU) {
      if (EPI == EPI_GELU && colbase >= 1024) {
        float* rsp = p->rowss + ((size_t)tm * 32 + ((colbase - 1024) >> 5)) * 128;
#pragma unroll
        for (int m = 0; m < 4; ++m) {
          float ssq[4] = {0.f, 0.f, 0.f, 0.f};
#pragma unroll
          for (int n = 0; n < 4; ++n) {
            int ch = colbase - 1024 + n * 16 + fr;
            int q0 = wr * 64 + m * 16 + fq * 4;
            float g0 = gelu_tanh(acc[m][n][0]), g1 = gelu_tanh(acc[m][n][1]), g2 = gelu_tanh(acc[m][n][2]), g3 = gelu_tanh(acc[m][n][3]);
            ssq[0] += g0 * g0;
            ssq[1] += g1 * g1;
            ssq[2] += g2 * g2;
            ssq[3] += g3 * g3;
            uint2 o;
            o.x = pack2(g0, g1);
            o.y = pack2(g2, g3);
            *reinterpret_cast<uint2*>(p->zvT + ((size_t)tm * 1024 + ch) * 128 + q0) = o;
          }
#pragma unroll
          for (int j = 0; j < 4; ++j) {
            float v = ssq[j];
            v += dpp_mov<0xB1>(v);
            v += dpp_mov<0x4E>(v);
            v += dpp_mov<0x141>(v);
            v += dpp_mov<0x140>(v);
            if (fr == 0) {
              rsp[wr * 64 + m * 16 + fq * 4 + j] = v;
              rsp[128 + wr * 64 + m * 16 + fq * 4 + j] = 0.f;
            }
          }
        }
      } else {
#pragma unroll
        for (int m = 0; m < 4; ++m)
#pragma unroll
          for (int j = 0; j < 4; ++j) {
            int row = brow + wr * 64 + m * 16 + fq * 4 + j;
            bf16_t* o = p->P + (size_t)row * 2048 + colbase + fr;
#pragma unroll
            for (int n = 0; n < 4; ++n) {
              float v = acc[m][n][j];
              if (EPI == EPI_GELU) v = gelu_tanh(v);
              o[n * 16] = f2bf(v);
            }
          }
      }
    } else if constexpr (EPI == EPI_RESID) {
#pragma unroll
      for (int m = 0; m < 4; ++m)
#pragma unroll
        for (int j = 0; j < 4; ++j) {
          int row = brow + wr * 64 + m * 16 + fq * 4 + j;
          int b = tok_batch(row);
          const float* g = p->mod + ((size_t)layer * 9 + b) * 6144 + 2048 + colbase + fr;
          bf16_t* o = p->xs + (size_t)row * D + colbase + fr;
          if (layer == 0 && gscale == 1.f) {
            const float* xi = ((row < TL) ? p->x + (size_t)row * D : p->ctx + (size_t)(row - TL) * D) + colbase + fr;
#pragma unroll
            for (int n = 0; n < 4; ++n) o[n * 16] = f2bf(xi[n * 16] + gscale * g[n * 16] * acc[m][n][j]);
          } else {
#pragma unroll
            for (int n = 0; n < 4; ++n) o[n * 16] = f2bf(bf2f(o[n * 16]) + gscale * g[n * 16] * acc[m][n][j]);
          }
        }
    } else if constexpr (EPI == EPI_INPROJ) {
      if (colbase >= 640 && colbase < 768) {
        int kvh = (colbase - 640) >> 6;
#pragma unroll
        for (int m = 0; m < 4; ++m) {
          int row0 = brow + wr * 64 + m * 16;
          bool latent = row0 < TL;
          int b = latent ? (row0 >> 12) : ((row0 - TL) >> 8);
          int kp16 = latent ? (CTX + (row0 & 4095)) : ((row0 - TL) & 255);
          int slot = kp16 + 8 * (fq & 1) + 4 * (fq >> 1);
#pragma unroll
          for (int n = 0; n < 4; ++n) {
            int dim = n * 16 + fr;
            uint2 o;
            o.x = pack2(acc[m][n][0], acc[m][n][1]);
            o.y = pack2(acc[m][n][2], acc[m][n][3]);
            *reinterpret_cast<uint2*>(p->vbuf + ((size_t)(b * 2 + kvh) * 64 + dim) * KVLEN + slot) = o;
          }
        }
      } else {
#pragma unroll
        for (int m = 0; m < 4; ++m)
#pragma unroll
          for (int j = 0; j < 4; ++j) {
            int row = brow + wr * 64 + m * 16 + fq * 4 + j;
            bool latent = row < TL;
            int b, pos;
            if (latent) {
              b = row >> 12;
              pos = row & 4095;
            } else {
              b = (row - TL) >> 8;
              pos = (row - TL) & 255;
            }
            float v0 = acc[m][0][j], v1 = acc[m][1][j], v2 = acc[m][2][j], v3 = acc[m][3][j];
            if (latent && colbase < 640) {
              float2 cr = p->cs[(pos >> 6) * 16 + fr];
              float2 cc = p->cs[(pos & 63) * 16 + fr];
              float a = v0, bb = v1;
              v0 = a * cr.x - bb * cr.y;
              v1 = bb * cr.x + a * cr.y;
              a = v2;
              bb = v3;
              v2 = a * cc.x - bb * cc.y;
              v3 = bb * cc.x + a * cc.y;
            }
            bf16_t* o;
            if (colbase < 512 || colbase >= 768) {
              o = p->P + (size_t)row * 2048 + colbase + fr;
            } else {
              int kvh = (colbase - 512) >> 6;
              int kp = latent ? (CTX + pos) : pos;
              o = p->kbuf + ((size_t)(b * 2 + kvh) * KVLEN + kp) * 64 + fr;
            }
            o[0] = f2bf(v0);
            o[16] = f2bf(v1);
            o[32] = f2bf(v2);
            o[48] = f2bf(v3);
          }
      }
    }
  }
}

constexpr int G8_HT = 128 * 64;
DEVI int g8_lds_byte(int r, int c) {
  int st = (r >> 4) * 2 + (c >> 5), rr = r & 15, cc = c & 31, ob = rr * 64 + cc * 2;
  return st * 1024 + (ob ^ (((ob >> 9) & 1) << 5));
}
DEVI void g8_stage_rc(int b, int& R, int& C) {
  int st = b / 1024, sb = b % 1024, swz = sb ^ (((sb >> 9) & 1) << 5);
  R = (st >> 1) * 16 + swz / 64;
  C = (st & 1) * 32 + (swz % 64) / 2;
}
typedef int i32x4 __attribute__((ext_vector_type(4)));
DEVI void g8_quad(PP p, const f32x4 (&acc)[2][2][4][2], int ai, int bj, f32x4 (&q)[4][2], const float*, int, int, int, int) {
#pragma unroll
  for (int m = 0; m < 4; ++m)
#pragma unroll
    for (int n = 0; n < 2; ++n) q[m][n] = acc[ai][bj][m][n];
}
DEVI void g8_quad(PP p, const i32x4 (&acc)[2][2][4][2], int ai, int bj, f32x4 (&q)[4][2], const float* csw, int r0, int c0, int fr, int fq) {
  const float cs0 = csw[c0 + fr], cs1 = csw[c0 + 16 + fr];
#pragma unroll
  for (int m = 0; m < 4; ++m) {
    const f32x4 rs = *reinterpret_cast<const f32x4*>(p->sx + r0 + m * 16 + fq * 4);
#pragma unroll
    for (int jj = 0; jj < 4; ++jj) {
      q[m][0][jj] = (float)acc[ai][bj][m][0][jj] * (rs[jj] * cs0);
      q[m][1][jj] = (float)acc[ai][bj][m][1][jj] * (rs[jj] * cs1);
    }
  }
}
template <int EPI, bool STAGED, typename ACC>
DEVI void gemm8_epilogue(PP p, ACC (&acc)[2][2][4][2], const f32x4* stg, int lane, int brow, int bcol, int wr, int wc, int fr, int fq, int layer, float gscale,
                         const float* csw = nullptr) {
  constexpr bool I8A = __is_same(ACC, i32x4);
  float gcs[2][2];
  if constexpr (I8A) {
#pragma unroll
    for (int bj = 0; bj < 2; ++bj)
#pragma unroll
      for (int n = 0; n < 2; ++n) gcs[bj][n] = csw[bcol + bj * 128 + wc * 32 + n * 16 + fr];
  }
  f32x4 grs_n[4];
  if constexpr (I8A) {
#pragma unroll
    for (int m = 0; m < 4; ++m) grs_n[m] = *reinterpret_cast<const f32x4*>(p->sx + brow + wr * 64 + m * 16 + fq * 4);
  }
#pragma unroll
  for (int ai_ = 0; ai_ < 2; ++ai_) {
    f32x4 grs[4];
    if constexpr (I8A) {
#pragma unroll
      for (int m = 0; m < 4; ++m) grs[m] = grs_n[m];
    }
#pragma unroll
    for (int bj = 0; bj < 2; ++bj) {
      if constexpr (I8A) {
        if (ai_ == 0 && bj == 1) {
#pragma unroll
          for (int m = 0; m < 4; ++m) grs_n[m] = *reinterpret_cast<const f32x4*>(p->sx + brow + 128 + wr * 64 + m * 16 + fq * 4);
        }
      }
      const int ai = ai_;
      const int r0 = brow + ai * 128 + wr * 64;
      const int c0 = bcol + bj * 128 + wc * 32;
      f32x4 q[4][2];
      if constexpr (I8A) {
#pragma unroll
        for (int m = 0; m < 4; ++m)
#pragma unroll
          for (int jj = 0; jj < 4; ++jj) {
            q[m][0][jj] = (float)acc[ai][bj][m][0][jj] * (grs[m][jj] * gcs[bj][0]);
            q[m][1][jj] = (float)acc[ai][bj][m][1][jj] * (grs[m][jj] * gcs[bj][1]);
          }
      } else {
        g8_quad(p, acc, ai, bj, q, csw, r0, c0, fr, fq);
      }
      if constexpr (EPI == EPI_STORE) {
#pragma unroll
        for (int m = 0; m < 4; ++m)
#pragma unroll
          for (int j = 0; j < 4; ++j) {
            bf16_t* o = p->P + (size_t)(r0 + m * 16 + fq * 4 + j) * 2048 + c0 + fr;
            o[0] = f2bf(q[m][0][j]);
            o[16] = f2bf(q[m][1][j]);
          }
      } else if constexpr (EPI == EPI_GELU) {
        if (c0 >= 1024) {
          const int chunk = r0 >> 7;
          float* rsp = p->rowss + ((size_t)chunk * 32 + ((c0 - 1024) >> 5)) * 128;
#pragma unroll
          for (int m = 0; m < 4; ++m) {
            float ssq[4] = {0.f, 0.f, 0.f, 0.f};
            const int q0 = (r0 & 127) + m * 16 + fq * 4;
#pragma unroll
            for (int n = 0; n < 2; ++n) {
              int ch = c0 - 1024 + n * 16 + fr;
              float g0 = gelu_tanh(q[m][n][0]), g1 = gelu_tanh(q[m][n][1]);
              float g2 = gelu_tanh(q[m][n][2]), g3 = gelu_tanh(q[m][n][3]);
              ssq[0] += g0 * g0;
              ssq[1] += g1 * g1;
              ssq[2] += g2 * g2;
              ssq[3] += g3 * g3;
              uint2 o;
              o.x = pack2(g0, g1);
              o.y = pack2(g2, g3);
              *reinterpret_cast<uint2*>(p->zvT + ((size_t)chunk * 1024 + ch) * 128 + q0) = o;
            }
#pragma unroll
            for (int j = 0; j < 4; ++j) {
              float v = ssq[j];
              v += dpp_mov<0xB1>(v);
              v += dpp_mov<0x4E>(v);
              v += dpp_mov<0x141>(v);
              v += dpp_mov<0x140>(v);
              if (fr == 0) rsp[q0 + j] = v;
            }
          }
        } else {
#pragma unroll
          for (int m = 0; m < 4; ++m)
#pragma unroll
            for (int j = 0; j < 4; ++j) {
              bf16_t* o = p->P + (size_t)(r0 + m * 16 + fq * 4 + j) * 2048 + c0 + fr;
              o[0] = f2bf(gelu_tanh(q[m][0][j]));
              o[16] = f2bf(gelu_tanh(q[m][1][j]));
            }
        }
      }
      __builtin_amdgcn_sched_barrier(0);
    }
  }
}

DEVI int g8_perm32(int rho) { const int n = rho >> 4, i = rho & 15; return 8 * (i >> 2) + 4 * n + (i & 3); }
DEVI f32x4 g8_cv(f32x4 a, float, f32x4) { return a; }
DEVI f32x4 g8_cv(i32x4 a, float rs, f32x4 cs) { return f32x4{(float)a[0], (float)a[1], (float)a[2], (float)a[3]} * (cs * rs); }
template <int EPI, typename ACC>
DEVI void gemm8_epilogue_tr(PP p, ACC (&acc)[2][2][4][2], int brow, int bcol, int wr, int wc, int fr, int fq, int layer, float gscale,
                            const float* csw = nullptr, const float (*prs)[4] = nullptr, const f32x4 (*pcs)[2] = nullptr) {
  constexpr bool I8A = sizeof(ACC) == sizeof(i32x4) && !__is_same(ACC, f32x4);
  if constexpr (EPI == EPI_STORE) {
    if (PROBE_PH && PROBE_SKIP_EPI && gscale == 0.f) return;
#pragma unroll
    for (int ai = 0; ai < 2; ++ai)
#pragma unroll
      for (int m = 0; m < 4; ++m) {
        bf16_t* o = p->P + (size_t)(brow + ai * 128 + wr * 64 + m * 16 + fr) * 2048 + bcol + wc * 32 + 8 * fq;
        float rs = 1.f;
        if constexpr (I8A) rs = p->sx[brow + ai * 128 + wr * 64 + m * 16 + fr];
#pragma unroll
        for (int bj = 0; bj < 2; ++bj) {
          f32x4 cs0 = {1.f, 1.f, 1.f, 1.f}, cs1 = cs0;
          if constexpr (I8A) {
            cs0 = *reinterpret_cast<const f32x4*>(csw + bcol + bj * 128 + wc * 32 + 8 * fq);
            cs1 = *reinterpret_cast<const f32x4*>(csw + bcol + bj * 128 + wc * 32 + 8 * fq + 4);
          }
          const f32x4 v0 = g8_cv(acc[ai][bj][m][0], rs, cs0), v1 = g8_cv(acc[ai][bj][m][1], rs, cs1);
          uint4 w;
          w.x = pack2(v0[0], v0[1]);
          w.y = pack2(v0[2], v0[3]);
          w.z = pack2(v1[0], v1[1]);
          w.w = pack2(v1[2], v1[3]);
          st_nt(reinterpret_cast<uint4*>(o + bj * 128), w);
        }
      }
  } else if constexpr (EPI == EPI_RESID || EPI == EPI_RESID0) {
    const unsigned loff = (unsigned)(fr * D + 8 * fq);
    const float* gb = p->mod + ((size_t)layer * 9 + tok_batch(brow)) * 6144 + 2048 + bcol + wc * 32 + 8 * fq;
    if constexpr (EPI == EPI_RESID0) {
      const float* xin = (brow < TL) ? p->x : p->ctx - (size_t)TL * D;
#pragma unroll
      for (int bj = 0; bj < 2; ++bj) {
        const int ucol = bcol + bj * 128 + wc * 32;
        const f32x4 g0 = *reinterpret_cast<const f32x4*>(gb + bj * 128) * gscale, g1 = *reinterpret_cast<const f32x4*>(gb + bj * 128 + 4) * gscale;
        f32x4 xr[2][4][2];
#pragma unroll
        for (int ai = 0; ai < 2; ++ai)
#pragma unroll
          for (int m = 0; m < 4; ++m) {
            const float* xi = xin + (size_t)(brow + ai * 128 + wr * 64 + m * 16) * D + ucol;
            xr[ai][m][0] = *reinterpret_cast<const f32x4*>(xi + loff);
            xr[ai][m][1] = *reinterpret_cast<const f32x4*>(xi + loff + 4);
          }
        __builtin_amdgcn_sched_barrier(0);
#pragma unroll
        for (int ai = 0; ai < 2; ++ai)
#pragma unroll
          for (int m = 0; m < 4; ++m) {
            bf16_t* o = p->xs + (size_t)(brow + ai * 128 + wr * 64 + m * 16) * D + ucol;
            const f32x4 r0 = xr[ai][m][0] + g0 * acc[ai][bj][m][0], r1 = xr[ai][m][1] + g1 * acc[ai][bj][m][1];
            uint4 w;
            w.x = pack2(r0[0], r0[1]);
            w.y = pack2(r0[2], r0[3]);
            w.z = pack2(r1[0], r1[1]);
            w.w = pack2(r1[2], r1[3]);
            *reinterpret_cast<uint4*>(o + loff) = w;
          }
        __builtin_amdgcn_sched_barrier(0);
      }
    } else {
      uint4 xr[2][2][4];
#pragma unroll
      for (int bj = 0; bj < 2; ++bj)
#pragma unroll
        for (int ai = 0; ai < 2; ++ai)
#pragma unroll
          for (int m = 0; m < 4; ++m)
            xr[bj][ai][m] = *reinterpret_cast<const uint4*>(p->xs + (size_t)(brow + ai * 128 + wr * 64 + m * 16) * D + bcol + bj * 128 + wc * 32 + loff);
      __builtin_amdgcn_sched_barrier(0);
#pragma unroll
      for (int bj = 0; bj < 2; ++bj) {
        const f32x4 g0 = *reinterpret_cast<const f32x4*>(gb + bj * 128) * gscale, g1 = *reinterpret_cast<const f32x4*>(gb + bj * 128 + 4) * gscale;
#pragma unroll
        for (int ai = 0; ai < 2; ++ai)
#pragma unroll
          for (int m = 0; m < 4; ++m) {
            const uint4 u = xr[bj][ai][m];
            const f32x4 x0 = {bflo(u.x), bfhi(u.x), bflo(u.y), bfhi(u.y)}, x1 = {bflo(u.z), bfhi(u.z), bflo(u.w), bfhi(u.w)};
            const f32x4 r0 = x0 + g0 * acc[ai][bj][m][0], r1 = x1 + g1 * acc[ai][bj][m][1];
            uint4 w;
            w.x = pack2(r0[0], r0[1]);
            w.y = pack2(r0[2], r0[3]);
            w.z = pack2(r1[0], r1[1]);
            w.w = pack2(r1[2], r1[3]);
            *reinterpret_cast<uint4*>(p->xs + (size_t)(brow + ai * 128 + wr * 64 + m * 16) * D + bcol + bj * 128 + wc * 32 + loff) = w;
          }
      }
      __builtin_amdgcn_sched_barrier(0);
    }
  } else if constexpr (EPI == EPI_INPROJ) {
    const bool latent = brow < TL;
#pragma unroll
    for (int bj = 0; bj < 2; ++bj) {
      const int c0 = bcol + bj * 128 + wc * 32;
      f32x4 cs0 = {1.f, 1.f, 1.f, 1.f}, cs1 = cs0;
      if constexpr (I8A) {
        cs0 = pcs[bj][0];
        cs1 = pcs[bj][1];
      }
      if (c0 >= 640 && c0 < 768) {
        const int kvh = (c0 - 640) >> 6, d0 = ((c0 - 640) & 63) + 4 * fq;
        const int so = 8 * ((fr >> 2) & 1) + 4 * (fr >> 3) + (fr & 3);
#pragma unroll
        for (int ai = 0; ai < 2; ++ai)
#pragma unroll
          for (int m = 0; m < 4; ++m) {
            const int row0 = brow + ai * 128 + wr * 64 + m * 16;
            const int b = latent ? (row0 >> 12) : ((row0 - TL) >> 8);
            const int kp16 = latent ? (CTX + (row0 & 4095)) : ((row0 - TL) & 255);
            bf16_t* o = p->vbuf + ((size_t)(b * 2 + kvh) * 64 + d0) * KVLEN + kp16 + so;
            float rs = 1.f;
            if constexpr (I8A) rs = prs[ai][m];
            const f32x4 vv[2] = {g8_cv(acc[ai][bj][m][0], rs, cs0), g8_cv(acc[ai][bj][m][1], rs, cs1)};
#pragma unroll
            for (int n = 0; n < 2; ++n)
#pragma unroll
              for (int j = 0; j < 4; ++j) o[(size_t)(n * 16 + j) * KVLEN] = f2bf(vv[n][j]);
          }
      } else {
        const int hsel = (c0 >> 5) & 1;
#pragma unroll
        for (int ai = 0; ai < 2; ++ai)
#pragma unroll
          for (int m = 0; m < 4; ++m) {
            const int row = brow + ai * 128 + wr * 64 + m * 16 + fr;
            const int b = latent ? (row >> 12) : ((row - TL) >> 8);
            const int pos = latent ? (row & 4095) : ((row - TL) & 255);
            float rs = 1.f;
            if constexpr (I8A) rs = prs[ai][m];
            f32x4 v0 = g8_cv(acc[ai][bj][m][0], rs, cs0), v1 = g8_cv(acc[ai][bj][m][1], rs, cs1);
            if (latent && c0 < 640) {
              const f32x4* cp = reinterpret_cast<const f32x4*>(reinterpret_cast<const float2*>(g_lds + ROPE_LDS) + (hsel ? (pos & 63) : (pos >> 6)) * 16 + 4 * fq);
              const f32x4 ca = cp[0], cb = cp[1];
              const f32x4 a = v0, bb = v1;
              v0[0] = a[0] * ca[0] - bb[0] * ca[1];
              v1[0] = bb[0] * ca[0] + a[0] * ca[1];
              v0[1] = a[1] * ca[2] - bb[1] * ca[3];
              v1[1] = bb[1] * ca[2] + a[1] * ca[3];
              v0[2] = a[2] * cb[0] - bb[2] * cb[1];
              v1[2] = bb[2] * cb[0] + a[2] * cb[1];
              v0[3] = a[3] * cb[2] - bb[3] * cb[3];
              v1[3] = bb[3] * cb[2] + a[3] * cb[3];
            }
            bf16_t* o;
            if (c0 < 512 || c0 >= 768) {
              o = p->P + (size_t)row * 2048 + c0 + 4 * fq;
            } else {
              const int kvh = (c0 - 512) >> 6, d0 = (c0 - 512) & 63;
              const int kp = latent ? (CTX + pos) : pos;
              o = p->kbuf + ((size_t)(b * 2 + kvh) * KVLEN + kp) * 64 + d0 + 4 * fq;
            }
            uint2 w0, w1;
            w0.x = pack2(v0[0], v0[1]);
            w0.y = pack2(v0[2], v0[3]);
            w1.x = pack2(v1[0], v1[1]);
            w1.y = pack2(v1[2], v1[3]);
            *reinterpret_cast<uint2*>(o) = w0;
            *reinterpret_cast<uint2*>(o + 16) = w1;
          }
      }
      __builtin_amdgcn_sched_barrier(0);
    }
  }
}

DEVI void gemm8_epilogue_store_i8(PP p, i32x4 (&acc)[2][2][4][2], const float (&rs)[2][4], const f32x4 (&cs)[2][2], int brow, int bcol, int wr, int wc,
                                  int fr, int fq) {
#pragma unroll
  for (int ai = 0; ai < 2; ++ai)
#pragma unroll
    for (int m = 0; m < 4; ++m) {
      bf16_t* o = p->P + (size_t)(brow + ai * 128 + wr * 64 + m * 16 + fr) * 2048 + bcol + wc * 32 + 8 * fq;
#pragma unroll
      for (int bj = 0; bj < 2; ++bj) {
        const f32x4 v0 = g8_cv(acc[ai][bj][m][0], rs[ai][m], cs[bj][0]), v1 = g8_cv(acc[ai][bj][m][1], rs[ai][m], cs[bj][1]);
        uint4 w;
        w.x = pack2(v0[0], v0[1]);
        w.y = pack2(v0[2], v0[3]);
        w.z = pack2(v1[0], v1[1]);
        w.w = pack2(v1[2], v1[3]);
        st_nt(reinterpret_cast<uint4*>(o + bj * 128), w);
      }
    }
}
template <bool I8> struct G8Acc { typedef f32x4 type; };
template <> struct G8Acc<true> { typedef i32x4 type; };
template <bool TR>
DEVI f32x4 g8_mma(bf16x8 a, bf16x8 b, f32x4 c) {
  return TR ? __builtin_amdgcn_mfma_f32_16x16x32_bf16(b, a, c, 0, 0, 0) : __builtin_amdgcn_mfma_f32_16x16x32_bf16(a, b, c, 0, 0, 0);
}
template <bool TR>
DEVI i32x4 g8_mma(bf16x8 a, bf16x8 b, i32x4 c) {
  const i32x4 ai = __builtin_bit_cast(i32x4, a), bi = __builtin_bit_cast(i32x4, b);
  return TR ? __builtin_amdgcn_mfma_i32_16x16x64_i8(bi, ai, c, 0, 0, 0) : __builtin_amdgcn_mfma_i32_16x16x64_i8(ai, bi, c, 0, 0, 0);
}
template <int EPI, bool I8 = false>
DEVI void gemm8_phase(PP p, const bf16_t* __restrict__ A, int lda, const bf16_t* __restrict__ Bt, int ldb, int Mtiles, int Ntiles,
                      int K, int layer, unsigned char* lds_all, float gscale = 1.f, const float* csw = nullptr,
                      const bf16_t* A16 = nullptr, const bf16_t* B16 = nullptr, int ld16 = 0) {
  constexpr bool TR = (EPI != EPI_GELU);
  constexpr bool PERM = (EPI == EPI_STORE || EPI == EPI_RESID || EPI == EPI_RESID0);
  bf16_t* shm = reinterpret_cast<bf16_t*>(lds_all);
  const int tid = ptid();
  const int wid = __builtin_amdgcn_readfirstlane(tid >> 6), lane = tid & 63, wr = wid >> 2, wc = wid & 3, fr = lane & 15, fq = lane >> 4;
#define G8_SA(b, h) (shm + ((b) * 2 + (h)) * G8_HT)
#define G8_SB(b, h) (shm + (4 + (b) * 2 + (h)) * G8_HT)
  const __amdgpu_buffer_rsrc_t rsA = __builtin_amdgcn_make_buffer_rsrc((void*)A, (short)0, -1, 0x00020000);
  const __amdgpu_buffer_rsrc_t rsB = __builtin_amdgcn_make_buffer_rsrc((void*)Bt, (short)0, -1, 0x00020000);
  unsigned voA[2], voB[2];
#pragma unroll
  for (int i = 0; i < 2; ++i) {
    int r_, c_;
    g8_stage_rc(tid * 16 + i * 8192, r_, c_);
    const int rb_ = PERM ? ((r_ & ~31) + g8_perm32(r_ & 31)) : r_;
    voA[i] = (unsigned)((r_ * lda + c_) * 2);
    voB[i] = (unsigned)((rb_ * ldb + c_) * 2);
  }
#define G8_STAGE(P_, RS_, VO_, ld_, br_, kt_)                                                                         \
  do {                                                                                                                \
    const unsigned so_ = (unsigned)(((br_) * (ld_) + (kt_) * 64) * 2);                                                \
    _Pragma("unroll") for (int i_ = 0; i_ < 2; ++i_)                                                                  \
      __builtin_amdgcn_raw_ptr_buffer_load_lds(RS_, (__attribute__((address_space(3))) void*)((unsigned char*)(P_) + wid * 1024 + i_ * 8192), 16, VO_[i_], so_, 0, 0); \
  } while (0)
#define G8_LDA(dst, b, h)                                                                                             \
  _Pragma("unroll") for (int m_ = 0; m_ < 4; ++m_) _Pragma("unroll") for (int k_ = 0; k_ < 2; ++k_)                   \
      dst[m_][k_] = *reinterpret_cast<const bf16x8*>((const unsigned char*)G8_SA(b, h) + g8_lds_byte(wr * 64 + m_ * 16 + fr, k_ * 32 + fq * 8))
#define G8_LDB(dst, b, h)                                                                                             \
  _Pragma("unroll") for (int n_ = 0; n_ < 2; ++n_) _Pragma("unroll") for (int k_ = 0; k_ < 2; ++k_)                   \
      dst[n_][k_] = *reinterpret_cast<const bf16x8*>((const unsigned char*)G8_SB(b, h) + g8_lds_byte(wc * 32 + n_ * 16 + fr, k_ * 32 + fq * 8))
#define G8_MMA(ai, bj, At_, Bt_)                                                                                      \
  do {                                                                                                                \
    __builtin_amdgcn_s_setprio(1);                                                                                    \
    _Pragma("unroll") for (int m_ = 0; m_ < 4; ++m_) _Pragma("unroll") for (int n_ = 0; n_ < 2; ++n_)                 \
        _Pragma("unroll") for (int k_ = 0; k_ < 2; ++k_) acc[ai][bj][m_][n_] =                                        \
            g8_mma<TR>(At_[m_][k_], Bt_[n_][k_], acc[ai][bj][m_][n_]);                                                  \
    __builtin_amdgcn_s_setprio(0);                                                                                    \
  } while (0)
#define G8_WAIT_V(n) asm volatile("s_waitcnt vmcnt(" #n ")" ::: "memory")
#define G8_WAIT_L(n) asm volatile("s_waitcnt lgkmcnt(" #n ")" ::: "memory")
#define G8_BAR __builtin_amdgcn_s_barrier()
#define G8_SCHED __builtin_amdgcn_sched_barrier(0)
  const int nblk = pnblk(), bid = pbid();
  const int lb = ((nblk & 7) == 0) ? ((bid & 7) * (nblk >> 3) + (bid >> 3)) : bid;
  const int ntiles_all = Mtiles * Ntiles;
  const int rem_ = ntiles_all % nblk;
  const int ntiles = I8 ? ntiles_all : ntiles_all - rem_;
  const int nt = K / 64;
  const int full_ = ntiles / nblk, remt_ = ntiles - full_ * nblk;
#define G8_TILE(i_) ((i_) < full_ ? lb + (i_) * nblk : (((i_) == full_ && bid < remt_) ? full_ * nblk + bid : -1))
  int ui = 0;
  if (G8_TILE(0) >= 0) {
    int t = G8_TILE(0);
    int brow = (t / Ntiles) * 256, bcol = (t % Ntiles) * 256;
    typedef typename G8Acc<I8>::type acc_t;
    acc_t acc[2][2][4][2];
#pragma unroll
    for (int a0 = 0; a0 < 2; ++a0)
#pragma unroll
      for (int b0 = 0; b0 < 2; ++b0)
#pragma unroll
        for (int m = 0; m < 4; ++m)
#pragma unroll
          for (int n = 0; n < 2; ++n) acc[a0][b0][m][n] = acc_t{0, 0, 0, 0};
    bf16x8 At[4][2], B0[2][2], B1[2][2];
    G8_STAGE(G8_SB(0, 0), rsB, voB, ldb, bcol, 0);
    G8_STAGE(G8_SA(0, 0), rsA, voA, lda, brow, 0);
    G8_STAGE(G8_SB(0, 1), rsB, voB, ldb, bcol + 128, 0);
    G8_STAGE(G8_SA(0, 1), rsA, voA, lda, brow + 128, 0);
    if (wr == 1) G8_BAR;
    G8_WAIT_V(4);
    G8_BAR;
    G8_STAGE(G8_SB(1, 0), rsB, voB, ldb, bcol, 1);
    G8_STAGE(G8_SA(1, 0), rsA, voA, lda, brow, 1);
    G8_STAGE(G8_SB(1, 1), rsB, voB, ldb, bcol + 128, 1);
    G8_WAIT_V(6);
    G8_BAR;
    for (;;) {
      const int tnx = G8_TILE(ui + 1);
      const bool has_next = tnx >= 0;
      const int nbrow = has_next ? (tnx / Ntiles) * 256 : brow, nbcol = has_next ? (tnx % Ntiles) * 256 : bcol;
      constexpr bool PRESC = I8 && EPI == EPI_STORE;
      float prs[2][4];
      f32x4 pcs[2][2];
      constexpr bool PRESI = I8 && EPI == EPI_INPROJ;
      if constexpr (PRESC || PRESI) {
#pragma unroll
        for (int ai = 0; ai < 2; ++ai)
#pragma unroll
          for (int m = 0; m < 4; ++m) prs[ai][m] = p->sx[brow + ai * 128 + wr * 64 + m * 16 + fr];
#pragma unroll
        for (int bj = 0; bj < 2; ++bj) {
          if constexpr (PRESC) {
            pcs[bj][0] = *reinterpret_cast<const f32x4*>(csw + bcol + bj * 128 + wc * 32 + 8 * fq);
            pcs[bj][1] = *reinterpret_cast<const f32x4*>(csw + bcol + bj * 128 + wc * 32 + 8 * fq + 4);
          } else {
            pcs[bj][0] = *reinterpret_cast<const f32x4*>(csw + bcol + bj * 128 + wc * 32 + 4 * fq);
            pcs[bj][1] = *reinterpret_cast<const f32x4*>(csw + bcol + bj * 128 + wc * 32 + 16 + 4 * fq);
          }
        }
      }
      for (int kt = 0; kt < nt; kt += 2) {
        const bool last = (kt == nt - 2);
        const int a2 = last ? nbrow : brow, b2 = last ? nbcol : bcol, k2 = last ? 0 : kt + 2;
        G8_LDB(B0, 0, 0); G8_SCHED; G8_LDA(At, 0, 0); G8_STAGE(G8_SA(1, 1), rsA, voA, lda, brow + 128, kt + 1);
        G8_WAIT_L(8); G8_BAR; G8_WAIT_L(0); G8_MMA(0, 0, At, B0); G8_BAR; G8_SCHED;
        G8_LDB(B1, 0, 1); G8_STAGE(G8_SB(0, 0), rsB, voB, ldb, b2, k2);
        G8_BAR; G8_WAIT_L(0); G8_MMA(0, 1, At, B1); G8_BAR;
        G8_LDA(At, 0, 1); G8_STAGE(G8_SA(0, 0), rsA, voA, lda, a2, k2);
        G8_BAR; G8_WAIT_L(0); G8_MMA(1, 0, At, B0); G8_BAR; G8_SCHED;
        G8_STAGE(G8_SB(0, 1), rsB, voB, ldb, b2 + 128, k2);
        G8_WAIT_V(6); G8_BAR; G8_MMA(1, 1, At, B1); G8_BAR;
        G8_LDB(B0, 1, 0); G8_SCHED; G8_LDA(At, 1, 0); G8_STAGE(G8_SA(0, 1), rsA, voA, lda, a2 + 128, k2);
        G8_WAIT_L(8); G8_BAR; G8_WAIT_L(0); G8_MMA(0, 0, At, B0); G8_BAR; G8_SCHED;
        G8_LDB(B1, 1, 1); G8_STAGE(G8_SB(1, 0), rsB, voB, ldb, b2, k2 + 1);
        G8_BAR; G8_WAIT_L(0); G8_MMA(0, 1, At, B1); G8_BAR;
        G8_LDA(At, 1, 1); G8_STAGE(G8_SA(1, 0), rsA, voA, lda, a2, k2 + 1);
        G8_BAR; G8_WAIT_L(0); G8_MMA(1, 0, At, B0); G8_BAR; G8_SCHED;
        G8_STAGE(G8_SB(1, 1), rsB, voB, ldb, b2 + 128, k2 + 1);
        G8_WAIT_V(6); G8_BAR; G8_MMA(1, 1, At, B1); G8_BAR;
      }
      {
        int lane2 = lane_id();
        asm volatile("" : "+v"(lane2));
        const int fr2 = lane2 & 15, fq2 = lane2 >> 4;
        if constexpr (PRESC) {
          gemm8_epilogue_store_i8(p, acc, prs, pcs, brow, bcol, wr, wc, fr2, fq2);
        } else if constexpr (TR) {
          gemm8_epilogue_tr<EPI>(p, acc, brow, bcol, wr, wc, fr2, fq2, layer, gscale, csw, prs, pcs);
        } else {
          gemm8_epilogue<EPI, false>(p, acc, nullptr, lane2, brow, bcol, wr, wc, fr2, fq2, layer, gscale, csw);
        }
      }
      if (!has_next) break;
#pragma unroll
      for (int a0 = 0; a0 < 2; ++a0)
#pragma unroll
        for (int b0 = 0; b0 < 2; ++b0)
#pragma unroll
          for (int m = 0; m < 4; ++m)
#pragma unroll
            for (int n = 0; n < 2; ++n) acc[a0][b0][m][n] = acc_t{0, 0, 0, 0};
      t = tnx;
      ++ui;
      brow = nbrow;
      bcol = nbcol;
    }
    G8_WAIT_V(0);
    if (wr == 0) G8_BAR;
  }
  __syncthreads();
  if (ntiles < ntiles_all) {
    constexpr int EPI_T = (EPI == EPI_RESID0) ? EPI_RESID : EPI;
    if constexpr (I8) gemm_phase<EPI_T>(p, A16, ld16, B16, ld16, 0, 0, ld16, layer, lds_all + (wid >> 2) * LDS_HALF, gscale, ntiles, ntiles_all - ntiles, Ntiles);
    else gemm_phase<EPI_T>(p, A, lda, Bt, ldb, 0, 0, K, layer, lds_all + (wid >> 2) * LDS_HALF, gscale, ntiles, ntiles_all - ntiles, Ntiles);
  }
#undef G8_SA
#undef G8_SB
#undef G8_STAGE
#undef G8_LDA
#undef G8_LDB
#undef G8_MMA
#undef G8_WAIT_V
#undef G8_WAIT_L
#undef G8_BAR
#undef G8_SCHED
#undef G8_TILE
}

DEVI bf16x8 scale_q(uint4 u) {
  uint4 r;
  r.x = pack2(bflo(u.x) * 0.125f, bfhi(u.x) * 0.125f);
  r.y = pack2(bflo(u.y) * 0.125f, bfhi(u.y) * 0.125f);
  r.z = pack2(bflo(u.z) * 0.125f, bfhi(u.z) * 0.125f);
  r.w = pack2(bflo(u.w) * 0.125f, bfhi(u.w) * 0.125f);
  return __builtin_bit_cast(bf16x8, r);
}
DEVI void phase_attn(PP p, int layer, bool with_ctx_q, unsigned char* lds) {
  const int tid = ltid();
  const int lane = tid & 63, wid = __builtin_amdgcn_readfirstlane(tid >> 6), r = lane & 31, h = lane >> 5;
  const float* sinkp = p->attn_sink + (layer >> 1) * 8;
  const int nlat = NB * 2 * 128;
  const int nunits = nlat + (with_ctx_q ? NB * 2 * 8 : 0);
  for (int u = lbid(); u < nunits; u += lnblk()) {
    bool latent = u < nlat;
    int b, kvh, qg, tokbase;
    if (latent) {
      b = u >> 8;
      kvh = (u >> 7) & 1;
      qg = u & 127;
      tokbase = b * SEQ + qg * 32;
    } else {
      int v = u - nlat;
      b = v >> 4;
      kvh = (v >> 3) & 1;
      qg = v & 7;
      tokbase = TL + b * CTX + qg * 32;
    }
    const int hd = kvh * 4 + wid;
    const bf16_t* kb = p->kbuf + (size_t)(b * 2 + kvh) * KVLEN * 64;
    const bf16_t* vt = p->vbuf + (size_t)(b * 2 + kvh) * 64 * KVLEN;
    const int nch = latent ? 5 : 2;
    const int lbase = CTX + (qg - 4) * 32;
#define ATT_STAGE(c_, buf_)                                                                                           \
  {                                                                                                                   \
    const int kp0_ = ((c_) < 2) ? (c_) * 128 : lbase + ((c_) - 2) * 128;                                              \
    _Pragma("unroll") for (int i_ = 0; i_ < 4; ++i_) {                                                                \
      const int P_ = tid * 16 + i_ * 4096;                                                                            \
      const int krow_ = P_ >> 7, kslot_ = (P_ >> 4) & 7;                                                              \
      int kp_ = kp0_ + krow_;                                                                                         \
      kp_ = kp_ < 0 ? 0 : (kp_ > KVLEN - 1 ? KVLEN - 1 : kp_);                                                        \
      __builtin_amdgcn_global_load_lds((const unsigned*)(kb + (size_t)kp_ * 64 + ((kslot_ ^ ((krow_ >> 1) & 7)) << 3)), \
                                       (__attribute__((address_space(3))) unsigned*)(lds + (buf_) * 32768 + P_), 16, 0, 0); \
      const int vrow_ = P_ >> 8, vslot_ = (P_ >> 4) & 15;                                                             \
      int vp_ = kp0_ + ((vslot_ ^ (vrow_ & 15)) << 3);                                                                \
      vp_ = vp_ < 0 ? 0 : (vp_ > KVLEN - 8 ? KVLEN - 8 : vp_);                                                        \
      __builtin_amdgcn_global_load_lds((const unsigned*)(vt + (size_t)vrow_ * KVLEN + vp_),                           \
                                       (__attribute__((address_space(3))) unsigned*)(lds + (buf_) * 32768 + 16384 + P_), 16, 0, 0); \
    }                                                                                                                 \
  }
    __syncthreads();
    ATT_STAGE(0, 0)
    bf16x8 qf[4];
    {
      const bf16_t* qp = p->P + (size_t)(tokbase + r) * 2048 + hd * 64 + 8 * h;
#pragma unroll
      for (int st = 0; st < 4; ++st) qf[st] = scale_q(*reinterpret_cast<const uint4*>(qp + 16 * st));
    }
    f32x16 O0, O1;
#pragma unroll
    for (int i = 0; i < 16; ++i) {
      O0[i] = 0.f;
      O1[i] = 0.f;
    }
    float m_run = sinkp[hd];
    float l_run = (h == 0) ? 1.f : 0.f;
    for (int c = 0; c < nch; ++c) {
      const int buf = c & 1;
      asm volatile("s_waitcnt vmcnt(0)" ::: "memory");
      __syncthreads();
      if (c + 1 < nch) ATT_STAGE(c + 1, buf ^ 1)
      const unsigned char* LK = lds + buf * 32768;
      const unsigned char* LV = LK + 16384;
#pragma unroll 1
      for (int kbi = 0; kbi < 4; ++kbi) {
        int mode = 0;
        if (c >= 2) {
          const int d = (c - 2) * 4 + kbi - 4;
          const int kblk = qg + d;
          if (d > 4 || kblk < 0 || kblk > 127) continue;
          mode = (d == -4) ? 1 : ((d == 4) ? 2 : 0);
        }
        f32x16 S;
#pragma unroll
        for (int i = 0; i < 16; ++i) S[i] = 0.f;
        {
          const int krow = kbi * 32 + r;
#pragma unroll
          for (int st = 0; st < 4; ++st) {
            bf16x8 kf = *reinterpret_cast<const bf16x8*>(LK + krow * 128 + (((2 * st + h) ^ ((krow >> 1) & 7)) << 4));
            S = __builtin_amdgcn_mfma_f32_32x32x16_bf16(kf, qf[st], S, 0, 0, 0);
          }
        }
        if (mode) {
          float negbig;
          asm volatile("v_mov_b32 %0, 0xf149f2ca" : "=v"(negbig));
#pragma unroll
          for (int i = 0; i < 16; ++i) {
            int kk = (i & 3) + 8 * (i >> 2) + 4 * h;
            bool ok = (mode == 1) ? (kk >= r) : (kk <= r);
            if (!ok) S[i] = negbig;
          }
        }
        float bm = S[0];
#pragma unroll
        for (int i = 1; i < 16; ++i) bm = fmaxf(bm, S[i]);
        bm = fmaxf(bm, shx_f(bm, 32));
        float m_new = fmaxf(m_run, bm);
        const float L2E = 1.4426950408889634f;
        float nm = -m_new * L2E;
        float psum = 0.f;
#pragma unroll
        for (int i = 0; i < 16; ++i) {
          S[i] = __builtin_amdgcn_exp2f(fmaf(S[i], L2E, nm));
          psum += S[i];
        }
        if (__any(m_new > m_run)) {
          float alpha = __builtin_amdgcn_exp2f((m_run - m_new) * L2E);
          l_run *= alpha;
#pragma unroll
          for (int i = 0; i < 16; ++i) {
            O0[i] *= alpha;
            O1[i] *= alpha;
          }
        }
        l_run += psum;
        m_run = m_new;
#pragma unroll
        for (int sidx = 0; sidx < 2; ++sidx) {
          uint4 pk;
          pk.x = pack2(S[8 * sidx + 0], S[8 * sidx + 1]);
          pk.y = pack2(S[8 * sidx + 2], S[8 * sidx + 3]);
          pk.z = pack2(S[8 * sidx + 4], S[8 * sidx + 5]);
          pk.w = pack2(S[8 * sidx + 6], S[8 * sidx + 7]);
          bf16x8 pf = __builtin_bit_cast(bf16x8, pk);
          const int vch = 4 * kbi + 2 * sidx + h;
          bf16x8 v0 = *reinterpret_cast<const bf16x8*>(LV + r * 256 + ((vch ^ (r & 15)) << 4));
          bf16x8 v1 = *reinterpret_cast<const bf16x8*>(LV + (32 + r) * 256 + ((vch ^ (r & 15)) << 4));
          O0 = __builtin_amdgcn_mfma_f32_32x32x16_bf16(v0, pf, O0, 0, 0, 0);
          O1 = __builtin_amdgcn_mfma_f32_32x32x16_bf16(v1, pf, O1, 0, 0, 0);
        }
      }
    }
#undef ATT_STAGE
    float l_tot = l_run + shx_f(l_run, 32);
    float inv = 1.f / l_tot;
    bf16_t* op = p->mix + (size_t)(tokbase + r) * LDMIX + hd * 64 + 4 * h;
#pragma unroll
    for (int g4 = 0; g4 < 4; ++g4) {
      uint2 o;
      o.x = pack2(O0[4 * g4 + 0] * inv, O0[4 * g4 + 1] * inv);
      o.y = pack2(O0[4 * g4 + 2] * inv, O0[4 * g4 + 3] * inv);
      *reinterpret_cast<uint2*>(op + 8 * g4) = o;
      o.x = pack2(O1[4 * g4 + 0] * inv, O1[4 * g4 + 1] * inv);
      o.y = pack2(O1[4 * g4 + 2] * inv, O1[4 * g4 + 3] * inv);
      *reinterpret_cast<uint2*>(op + 32 + 8 * g4) = o;
    }
  }
  __syncthreads();
}

DEVI void fill_tw(float2* tw, int n) {
  for (int i = ltid(); i < n; i += NTHREADS) {
    float sn, cn;
    sincospif(2.f * (float)i / (float)n, &sn, &cn);
    tw[i] = make_float2(cn, sn);
  }
  __syncthreads();
}

DEVI bf16x8 lds_col8(const bf16_t* bp, int stride) {
  unsigned e0 = bp[0], e1 = bp[stride], e2 = bp[2 * stride], e3 = bp[3 * stride];
  unsigned e4 = bp[4 * stride], e5 = bp[5 * stride], e6 = bp[6 * stride], e7 = bp[7 * stride];
  uint4 pk;
  pk.x = e0 | (e1 << 16);
  pk.y = e2 | (e3 << 16);
  pk.z = e4 | (e5 << 16);
  pk.w = e6 | (e7 << 16);
  return __builtin_bit_cast(bf16x8, pk);
}

DEVI void phase_fft_a(PP p, unsigned char* lds) {
  const int tid = ltid();
  const int lane = tid & 63, wid = __builtin_amdgcn_readfirstlane(tid >> 6), fr = lane & 15, fq = lane >> 4;
  float2* tw = reinterpret_cast<float2*>(lds + 66560);
  fill_tw(tw, 64);
  bf16x8 af[2][2];
#pragma unroll
  for (int ks = 0; ks < 2; ++ks) {
    unsigned short cr[8], ci[8];
#pragma unroll
    for (int j = 0; j < 8; ++j) {
      int n1 = 32 * ks + 8 * fq + j, k1 = 16 * wid + fr;
      float2 t = tw[(k1 * n1) & 63];
      cr[j] = f2bf(t.x);
      ci[j] = f2bf(-t.y);
    }
    uint4 a0, a1;
    a0.x = cr[0] | ((unsigned)cr[1] << 16); a0.y = cr[2] | ((unsigned)cr[3] << 16);
    a0.z = cr[4] | ((unsigned)cr[5] << 16); a0.w = cr[6] | ((unsigned)cr[7] << 16);
    a1.x = ci[0] | ((unsigned)ci[1] << 16); a1.y = ci[2] | ((unsigned)ci[3] << 16);
    a1.z = ci[4] | ((unsigned)ci[5] << 16); a1.w = ci[6] | ((unsigned)ci[7] << 16);
    af[0][ks] = __builtin_bit_cast(bf16x8, a0);
    af[1][ks] = __builtin_bit_cast(bf16x8, a1);
  }
  const bf16_t* l16 = reinterpret_cast<const bf16_t*>(lds);
  for (int u = lbid(); u < NB * 64; u += lnblk()) {
    int b = u >> 6, n2 = u & 63;
    __syncthreads();
#pragma unroll
    for (int i = 0; i < 16; ++i) {
      int row = (tid >> 6) + 4 * i, piece = tid & 63;
      uint4 v = *reinterpret_cast<const uint4*>(p->P + (size_t)(b * SEQ + 64 * row + n2) * 2048 + 768 + piece * 8);
      *reinterpret_cast<uint4*>(lds + row * 1040 + piece * 16) = v;
    }
    __syncthreads();
    float tc[4], ts[4];
#pragma unroll
    for (int j = 0; j < 4; ++j) sincospif((float)(n2 * (16 * wid + 4 * fq + j)) / 2048.f, &ts[j], &tc[j]);
    for (int nb = 0; nb < 4; ++nb) {
      f32x4 acc[2][8];
#pragma unroll
      for (int n = 0; n < 8; ++n) {
        acc[0][n] = f32x4{0.f, 0.f, 0.f, 0.f};
        acc[1][n] = f32x4{0.f, 0.f, 0.f, 0.f};
      }
#pragma unroll
      for (int ks = 0; ks < 2; ++ks)
#pragma unroll
        for (int nf = 0; nf < 8; ++nf) {
          bf16x8 bfr = lds_col8(l16 + (32 * ks + 8 * fq) * 520 + 128 * nb + 16 * nf + fr, 520);
          acc[0][nf] = __builtin_amdgcn_mfma_f32_16x16x32_bf16(af[0][ks], bfr, acc[0][nf], 0, 0, 0);
          acc[1][nf] = __builtin_amdgcn_mfma_f32_16x16x32_bf16(af[1][ks], bfr, acc[1][nf], 0, 0, 0);
        }
#pragma unroll
      for (int j = 0; j < 4; ++j) {
        int k1 = 16 * wid + 4 * fq + j;
        bf16_t* o = p->fa + (size_t)(b * SEQ + k1 * 64 + n2) * 1024 + 128 * nb + fr;
#pragma unroll
        for (int nf = 0; nf < 8; ++nf) {
          float re = acc[0][nf][j], im = acc[1][nf][j];
          o[16 * nf] = f2bf(re * tc[j] + im * ts[j]);
          o[512 + 16 * nf] = f2bf(im * tc[j] - re * ts[j]);
        }
      }
    }
  }
  __syncthreads();
}

DEVI void phase_fft_b(PP p, unsigned char* lds) {
  const int tid = ltid();
  const int lane = tid & 63, wid = __builtin_amdgcn_readfirstlane(tid >> 6), fr = lane & 15, fq = lane >> 4;
  float2* tw = reinterpret_cast<float2*>(lds + 67584);
  fill_tw(tw, 64);
  bf16x8 wb[2][4];
#pragma unroll
  for (int ks = 0; ks < 4; ++ks) {
    unsigned short zr[8], zi[8];
#pragma unroll
    for (int j = 0; j < 8; ++j) {
      int k = 32 * ks + 8 * fq + j, part = k >> 6, n2 = k & 63, k2 = 16 * wid + fr;
      float2 t = tw[(k2 * n2) & 63];
      zr[j] = f2bf(part ? t.y : t.x);
      zi[j] = f2bf(part ? t.x : -t.y);
    }
    uint4 a0, a1;
    a0.x = zr[0] | ((unsigned)zr[1] << 16); a0.y = zr[2] | ((unsigned)zr[3] << 16);
    a0.z = zr[4] | ((unsigned)zr[5] << 16); a0.w = zr[6] | ((unsigned)zr[7] << 16);
    a1.x = zi[0] | ((unsigned)zi[1] << 16); a1.y = zi[2] | ((unsigned)zi[3] << 16);
    a1.z = zi[4] | ((unsigned)zi[5] << 16); a1.w = zi[6] | ((unsigned)zi[7] << 16);
    wb[0][ks] = __builtin_bit_cast(bf16x8, a0);
    wb[1][ks] = __builtin_bit_cast(bf16x8, a1);
  }
  const bf16_t* l16 = reinterpret_cast<const bf16_t*>(lds);
  const float scale = 0.0013810679320049757f;
  for (int u = lbid(); u < NB * 128; u += lnblk()) {
    int b = u >> 7, k1 = (u >> 1) & 63, hf = u & 1;
    __syncthreads();
#pragma unroll
    for (int i = 0; i < 16; ++i) {
      int row = (tid >> 5) + 8 * i, piece = tid & 31;
      int part = row >> 6, n2 = row & 63;
      uint4 v = *reinterpret_cast<const uint4*>(p->fa + (size_t)(b * SEQ + k1 * 64 + n2) * 1024 + part * 512 + hf * 256 + piece * 8);
      *reinterpret_cast<uint4*>(lds + row * 528 + piece * 16) = v;
    }
    __syncthreads();
    for (int nb = 0; nb < 2; ++nb) {
      f32x4 acc[2][8];
#pragma unroll
      for (int n = 0; n < 8; ++n) {
        acc[0][n] = f32x4{0.f, 0.f, 0.f, 0.f};
        acc[1][n] = f32x4{0.f, 0.f, 0.f, 0.f};
      }
#pragma unroll
      for (int ks = 0; ks < 4; ++ks)
#pragma unroll
        for (int nf = 0; nf < 8; ++nf) {
          bf16x8 bfr = lds_col8(l16 + (32 * ks + 8 * fq) * 264 + 128 * nb + 16 * nf + fr, 264);
          acc[0][nf] = __builtin_amdgcn_mfma_f32_16x16x32_bf16(wb[0][ks], bfr, acc[0][nf], 0, 0, 0);
          acc[1][nf] = __builtin_amdgcn_mfma_f32_16x16x32_bf16(wb[1][ks], bfr, acc[1][nf], 0, 0, 0);
        }
#pragma unroll
      for (int j = 0; j < 4; ++j) {
        int k2 = 16 * wid + 4 * fq + j;
        bf16_t* o = p->mix + (size_t)(b * SEQ + k1 + 64 * k2) * LDMIX + 512 + hf * 256 + 128 * nb + fr;
#pragma unroll
        for (int nf = 0; nf < 8; ++nf) {
          o[16 * nf] = f2bf(acc[0][nf][j] * scale);
          o[512 + 16 * nf] = f2bf(acc[1][nf][j] * scale);
        }
      }
    }
  }
  __syncthreads();
}

DEVI void phase_dft_ctx(PP p, unsigned char* lds) {
  const int tid = ltid();
  const int lane = tid & 63, wid = __builtin_amdgcn_readfirstlane(tid >> 6), fr = lane & 15, fq = lane >> 4;
  float2* tw = reinterpret_cast<float2*>(lds + 32768);
  fill_tw(tw, 256);
  const bf16_t* l16 = reinterpret_cast<const bf16_t*>(lds);
  constexpr int S = 40;
  const float scale = 0.005524271728019903f;
  for (int u = lbid(); u < NB * 64; u += lnblk()) {
    const int b = u >> 6, kb = (u >> 4) & 3, cb = u & 15;
    __syncthreads();
#pragma unroll
    for (int i = 0; i < 4; ++i) {
      const int idx = tid + 256 * i, row = idx >> 2, piece = idx & 3;
      const uint4 v = *reinterpret_cast<const uint4*>(p->P + (size_t)(TL + b * CTX + row) * 2048 + 768 + cb * 32 + piece * 8);
      *reinterpret_cast<uint4*>(lds + row * (S * 2) + piece * 16) = v;
    }
    __syncthreads();
    const int k = kb * 64 + wid * 16 + fr;
    f32x4 acc[2][2];
#pragma unroll
    for (int n = 0; n < 2; ++n) {
      acc[0][n] = f32x4{0.f, 0.f, 0.f, 0.f};
      acc[1][n] = f32x4{0.f, 0.f, 0.f, 0.f};
    }
#pragma unroll 2
    for (int ks = 0; ks < 8; ++ks) {
      unsigned cr[8], ci[8];
#pragma unroll
      for (int j = 0; j < 8; ++j) {
        const int n = 32 * ks + 8 * fq + j;
        const float2 t = tw[(k * n) & 255];
        cr[j] = f2bf(t.x);
        ci[j] = f2bf(-t.y);
      }
      uint4 a0, a1;
      a0.x = cr[0] | (cr[1] << 16); a0.y = cr[2] | (cr[3] << 16); a0.z = cr[4] | (cr[5] << 16); a0.w = cr[6] | (cr[7] << 16);
      a1.x = ci[0] | (ci[1] << 16); a1.y = ci[2] | (ci[3] << 16); a1.z = ci[4] | (ci[5] << 16); a1.w = ci[6] | (ci[7] << 16);
      const bf16x8 are = __builtin_bit_cast(bf16x8, a0), aim = __builtin_bit_cast(bf16x8, a1);
#pragma unroll
      for (int nf = 0; nf < 2; ++nf) {
        const bf16x8 bfr = lds_col8(l16 + (32 * ks + 8 * fq) * S + 16 * nf + fr, S);
        acc[0][nf] = __builtin_amdgcn_mfma_f32_16x16x32_bf16(bfr, are, acc[0][nf], 0, 0, 0);
        acc[1][nf] = __builtin_amdgcn_mfma_f32_16x16x32_bf16(bfr, aim, acc[1][nf], 0, 0, 0);
      }
    }
    bf16_t* o = p->mix + (size_t)(TL + b * CTX + k) * LDMIX + cb * 32 + 4 * fq;
#pragma unroll
    for (int nf = 0; nf < 2; ++nf) {
      uint2 w;
      w.x = pack2(acc[0][nf][0] * scale, acc[0][nf][1] * scale);
      w.y = pack2(acc[0][nf][2] * scale, acc[0][nf][3] * scale);
      *reinterpret_cast<uint2*>(o + 512 + 16 * nf) = w;
      w.x = pack2(acc[1][nf][0] * scale, acc[1][nf][1] * scale);
      w.y = pack2(acc[1][nf][2] * scale, acc[1][nf][3] * scale);
      *reinterpret_cast<uint2*>(o + 1024 + 16 * nf) = w;
    }
  }
  __syncthreads();
}

DEVI void phase_sgu(PP p, int j, int nchunks, unsigned char* lds) {
  float* rs = reinterpret_cast<float*>(lds);
  unsigned char* LA = lds + 1024;
  unsigned char* LB = lds + 1024 + 32768;
  const int tid = ltid();
  const int lane = tid & 63, wid = __builtin_amdgcn_readfirstlane(tid >> 6), fr = lane & 15, fq = lane >> 4;
  const float* nw = p->gs_norm_w + j * 1024;
  for (int u = lbid(); u < nchunks * 8; u += lnblk()) {
    const int chunk = u >> 3, g = u & 7;
    const int tok0 = chunk * 128;
    const bf16_t* vT = p->zvT + ((size_t)chunk * 1024 + g * 128) * 128;
    __syncthreads();
    const unsigned lo128 = (unsigned)((tid >> 4) * 128 + (tid & 15) * 8), lo2k = (unsigned)((tid >> 4) * 2048 + (tid & 15) * 8);
    float ssq[16];
    {
      const float* rp = p->rowss + (size_t)chunk * 32 * 128 + (size_t)(tid >> 7) * 16 * 128;
#pragma unroll
      for (int sl = 0; sl < 16; ++sl) ssq[sl] = (rp + sl * 128)[(unsigned)(tid & 127)];
    }
    uint4 bt[8];
#pragma unroll
    for (int i = 0; i < 8; ++i) bt[i] = *reinterpret_cast<const uint4*>((vT + (size_t)i * 16 * 128) + lo128);
    float4 wa[8][2];
    {
      const float* wsg = p->gs_w_s + ((size_t)j * 8 + g) * 128 * 128;
#pragma unroll
      for (int i = 0; i < 8; ++i) {
        const float* wp = (wsg + (size_t)i * 16 * 128) + lo128;
        wa[i][0] = *reinterpret_cast<const float4*>(wp);
        wa[i][1] = *reinterpret_cast<const float4*>(wp + 4);
      }
    }
    uint4 ut[8];
#pragma unroll
    for (int i = 0; i < 8; ++i) ut[i] = *reinterpret_cast<const uint4*>((p->P + (size_t)(tok0 + 16 * i) * 2048 + g * 128) + lo2k);
    {
      float ss = 0.f;
#pragma unroll
      for (int sl = 0; sl < 16; ++sl) ss += ssq[sl];
      rs[tid] = ss;
    }
#pragma unroll
    for (int i = 0; i < 8; ++i) {
      int idx = tid + 256 * i, row = idx >> 4, c = idx & 15;
      *reinterpret_cast<uint4*>(LB + row * 256 + ((c ^ (row & 15)) << 4)) = bt[i];
    }
    __syncthreads();
#pragma unroll
    for (int i = 0; i < 8; ++i) {
      int idx = tid + 256 * i, row = idx >> 4, c = idx & 15;
      const float4 w0 = wa[i][0], w1 = wa[i][1];
      float rk[8];
#pragma unroll
      for (int k = 0; k < 8; ++k) rk[k] = rsqrtf((rs[c * 8 + k] + rs[128 + c * 8 + k]) * (1.f / 1024.f) + 1e-6f);
      uint4 pk;
      pk.x = pack2(w0.x * rk[0], w0.y * rk[1]);
      pk.y = pack2(w0.z * rk[2], w0.w * rk[3]);
      pk.z = pack2(w1.x * rk[4], w1.y * rk[5]);
      pk.w = pack2(w1.z * rk[6], w1.w * rk[7]);
      *reinterpret_cast<uint4*>(LA + row * 256 + ((c ^ (row & 15)) << 4)) = pk;
    }
    __syncthreads();
    f32x4 acc[2][8];
#pragma unroll
    for (int m = 0; m < 2; ++m)
#pragma unroll
      for (int n = 0; n < 8; ++n) acc[m][n] = f32x4{0.f, 0.f, 0.f, 0.f};
#pragma unroll
    for (int ks = 0; ks < 4; ++ks) {
      const int sl = ((4 * ks + fq) ^ fr) << 4;
      bf16x8 a0 = *reinterpret_cast<const bf16x8*>(LA + (32 * wid + fr) * 256 + sl);
      bf16x8 a1 = *reinterpret_cast<const bf16x8*>(LA + (32 * wid + 16 + fr) * 256 + sl);
#pragma unroll
      for (int n = 0; n < 8; ++n) {
        bf16x8 bfr = *reinterpret_cast<const bf16x8*>(LB + (16 * n + fr) * 256 + sl);
        acc[0][n] = __builtin_amdgcn_mfma_f32_16x16x32_bf16(a0, bfr, acc[0][n], 0, 0, 0);
        acc[1][n] = __builtin_amdgcn_mfma_f32_16x16x32_bf16(a1, bfr, acc[1][n], 0, 0, 0);
      }
    }
    __syncthreads();
    {
      const float* bsg = p->gs_b_s + ((size_t)j * 8 + g) * 128;
#pragma unroll
      for (int m = 0; m < 2; ++m)
#pragma unroll
        for (int jj = 0; jj < 4; ++jj) {
          const int pp = 32 * wid + 16 * m + 4 * fq + jj;
          const float bias = bsg[pp];
#pragma unroll
          for (int n = 0; n < 8; ++n) {
            const int c = 16 * n + fr;
            float sv = nw[g * 128 + c] * acc[m][n][jj] + bias;
            *reinterpret_cast<bf16_t*>(LA + pp * 256 + (((c >> 3) ^ (pp & 15)) << 4) + (c & 7) * 2) = f2bf(sv);
          }
        }
    }
    __syncthreads();
#pragma unroll
    for (int i = 0; i < 8; ++i) {
      int idx = tid + 256 * i, row = idx >> 4, c = idx & 15;
      uint4 sv8 = *reinterpret_cast<const uint4*>(LA + row * 256 + ((c ^ (row & 15)) << 4));
      const uint4 u8 = ut[i];
      uint4 o;
      o.x = pack2(bflo(u8.x) * bflo(sv8.x), bfhi(u8.x) * bfhi(sv8.x));
      o.y = pack2(bflo(u8.y) * bflo(sv8.y), bfhi(u8.y) * bfhi(sv8.y));
      o.z = pack2(bflo(u8.z) * bflo(sv8.z), bfhi(u8.z) * bfhi(sv8.z));
      o.w = pack2(bflo(u8.w) * bflo(sv8.w), bfhi(u8.w) * bfhi(sv8.w));
      *reinterpret_cast<uint4*>(p->mix + (size_t)(tok0 + row) * LDMIX + g * 128 + c * 8) = o;
    }
  }
  __syncthreads();
}

DEVI float mkkey(float v, unsigned idx, unsigned mask) { return __uint_as_float((__float_as_uint(v) & ~mask) | idx); }
#define INSERT16(list, x)                                                                                               \
  {                                                                                                                     \
    _Pragma("unroll") for (int i_ = 15; i_ >= 1; --i_) list[i_] = __builtin_amdgcn_fmed3f(list[i_ - 1], list[i_], x); \
    list[0] = fmaxf(list[0], x);                                                                                        \
  }

DEVI float vmaxf(float a, float b) { float r; asm("v_max_f32 %0, %1, %2" : "=v"(r) : "v"(a), "v"(b)); return r; }
DEVI float vminf(float a, float b) { float r; asm("v_min_f32 %0, %1, %2" : "=v"(r) : "v"(a), "v"(b)); return r; }
DEVI void bitonic_merge16(float (&v)[16]) {
#pragma unroll
  for (int j = 8; j >= 1; j >>= 1)
#pragma unroll
    for (int i = 0; i < 16; ++i) {
      const int l = i ^ j;
      if (l > i) {
        const float hi = vmaxf(v[i], v[l]), lo = vminf(v[i], v[l]);
        v[i] = hi;
        v[l] = lo;
      }
    }
}
DEVI void bitonic_sort16(float (&v)[16]) {
#define CE_(a, b)                                         \
  {                                                       \
    const float hi_ = vmaxf(v[a], v[b]), lo_ = vminf(v[a], v[b]); \
    v[a] = hi_;                                           \
    v[b] = lo_;                                           \
  }
  CE_(0, 13) CE_(1, 12) CE_(2, 15) CE_(3, 14) CE_(4, 8) CE_(5, 6) CE_(7, 11) CE_(9, 10)
  CE_(0, 5) CE_(1, 7) CE_(2, 9) CE_(3, 4) CE_(6, 13) CE_(8, 14) CE_(10, 15) CE_(11, 12)
  CE_(0, 1) CE_(2, 3) CE_(4, 5) CE_(6, 8) CE_(7, 9) CE_(10, 11) CE_(12, 13) CE_(14, 15)
  CE_(0, 2) CE_(1, 3) CE_(4, 10) CE_(5, 11) CE_(6, 7) CE_(8, 9) CE_(12, 14) CE_(13, 15)
  CE_(1, 2) CE_(3, 12) CE_(4, 6) CE_(5, 7) CE_(8, 10) CE_(9, 11) CE_(13, 14)
  CE_(1, 4) CE_(2, 6) CE_(5, 8) CE_(7, 10) CE_(9, 13) CE_(11, 14)
  CE_(2, 4) CE_(3, 6) CE_(9, 12) CE_(11, 13)
  CE_(3, 5) CE_(6, 8) CE_(7, 9) CE_(10, 12)
  CE_(3, 4) CE_(5, 6) CE_(7, 8) CE_(9, 10) CE_(11, 12)
  CE_(6, 7) CE_(8, 9)
#undef CE_
}

DEVI void phase_route(PP p, int layer, int ntok, unsigned char* lds) {
  const int tid = ltid();
  const int lane = tid & 63, wid = __builtin_amdgcn_readfirstlane(tid >> 6), fr = lane & 15, fq = lane >> 4;
  const int nb8 = lnblk() >> 3, bid = lbid();
  const int hh = bid & 7, slot = bid >> 3;
  const int ntiles = ntok / 64;
  const bool active = slot < nb8;
  float* sc = reinterpret_cast<float*>(lds + 32768);
  const float NEGK = -3.0e38f;
  for (int half = 0; half < 2; ++half) {
    __syncthreads();
    {
      const bf16_t* ksrc = p->keysb + ((size_t)((layer * 8 + hh) * 2 + half) * 128) * 128;
#pragma unroll
      for (int i = 0; i < 8; ++i) {
        int idx = tid + 256 * i, row = idx >> 4, c = idx & 15;
        uint4 v = *reinterpret_cast<const uint4*>(ksrc + (size_t)row * 128 + c * 8);
        *reinterpret_cast<uint4*>(lds + row * 256 + ((c ^ (row & 15)) << 4)) = v;
      }
    }
    __syncthreads();
    bf16x8 an[4];
    if (active && slot < ntiles) {
      const bf16_t* qa = p->P + (size_t)(slot * 64 + wid * 16 + fr) * 2048 + hh * 256 + half * 128 + fq * 8;
#pragma unroll
      for (int ks = 0; ks < 4; ++ks) an[ks] = __builtin_nontemporal_load(reinterpret_cast<const bf16x8*>(qa + ks * 32));
    }
    for (int tt = slot; active && tt < ntiles; tt += nb8) {
      const int tok0 = tt * 64;
      float list[16], lb[16];
      {
        bf16x8 a[4];
#pragma unroll
        for (int ks = 0; ks < 4; ++ks) a[ks] = an[ks];
        {
          const int ttn = (tt + nb8 < ntiles) ? tt + nb8 : tt;
          const bf16_t* qa = p->P + (size_t)(ttn * 64 + wid * 16 + fr) * 2048 + hh * 256 + half * 128 + fq * 8;
#pragma unroll
          for (int ks = 0; ks < 4; ++ks) an[ks] = __builtin_nontemporal_load(reinterpret_cast<const bf16x8*>(qa + ks * 32));
        }
#pragma unroll
        for (int nf = 0; nf < 8; ++nf) {
          f32x4 acc = f32x4{0.f, 0.f, 0.f, 0.f};
          const int krow = nf * 16 + fr;
#pragma unroll
          for (int ks = 0; ks < 4; ++ks) {
            bf16x8 bb = *reinterpret_cast<const bf16x8*>(lds + krow * 256 + (((4 * ks + fq) ^ (krow & 15)) << 4));
            acc = __builtin_amdgcn_mfma_f32_16x16x32_bf16(bb, a[ks], acc, 0, 0, 0);
          }
#pragma unroll
          for (int j = 0; j < 4; ++j) {
            const float kv = mkkey(acc[j], (unsigned)(nf * 16 + 4 * fq + j), 127u);
            if (nf < 4) list[nf * 4 + j] = kv;
            else lb[(nf - 4) * 4 + j] = kv;
          }
        }
      }
      const int prt = lane >> 4;
      bitonic_sort16(list);
      bitonic_sort16(lb);
#pragma unroll
      for (int i = 0; i < 16; ++i) list[i] = vmaxf(list[i], lb[15 - i]);
      bitonic_merge16(list);
#pragma unroll 1
      for (int step = 16; step <= 32; step <<= 1) {
        float other[16];
#pragma unroll
        for (int i = 0; i < 16; ++i) other[i] = shx_f(list[i], step);
#pragma unroll
        for (int i = 0; i < 16; ++i) list[i] = vmaxf(list[i], other[15 - i]);
        bitonic_merge16(list);
      }
      if (prt == 0) {
        float4* o = reinterpret_cast<float4*>(p->tops + ((size_t)(tok0 + wid * 16 + fr) * 16 + hh * 2 + half) * 16);
        o[0] = make_float4(list[0], list[1], list[2], list[3]);
        o[1] = make_float4(list[4], list[5], list[6], list[7]);
        o[2] = make_float4(list[8], list[9], list[10], list[11]);
        o[3] = make_float4(list[12], list[13], list[14], list[15]);
      }
    }
  }
  __syncthreads();
  float* fl = reinterpret_cast<float*>(lds);
  for (int t4 = slot; active && t4 < ntiles + 3 * nb8; t4 += 4 * nb8) {
    const int tt = t4 + (tid >> 6) * nb8;
    if (tt < ntiles) {
      const int tok = tt * 64 + (tid & 63);
      const float4* src = reinterpret_cast<const float4*>(p->tops + ((size_t)tok * 16 + hh * 2) * 16);
      float v0[16], v1[16];
#pragma unroll
      for (int i = 0; i < 4; ++i) {
        float4 a = src[i], bq = src[4 + i];
        v0[4 * i] = a.x; v0[4 * i + 1] = a.y; v0[4 * i + 2] = a.z; v0[4 * i + 3] = a.w;
        v1[4 * i] = bq.x; v1[4 * i + 1] = bq.y; v1[4 * i + 2] = bq.z; v1[4 * i + 3] = bq.w;
      }
      float* f0 = fl + tid * 33;
      float* f1 = f0 + 16;
#pragma unroll
      for (int i = 0; i < 16; ++i) {
        f0[i] = v0[i];
        f1[i] = v1[i];
      }
      float l2[16];
#pragma unroll
      for (int i = 0; i < 16; ++i) l2[i] = mkkey(v0[0] + v1[i], (unsigned)(15 - i), 255u);
#pragma unroll
      for (int a = 1; a < 16; ++a)
#pragma unroll
        for (int bq = 0; bq < 16; ++bq)
          if ((a + 1) * (bq + 1) <= 16) {
            float x = mkkey(v0[a] + v1[bq], (unsigned)(a * 16 + 15 - bq), 255u);
            INSERT16(l2, x)
          }
      float sv[16];
      int ev[16];
      float mx = NEGK;
#pragma unroll
      for (int k = 0; k < 16; ++k) {
        unsigned ab = __float_as_uint(l2[k]) & 255u;
        unsigned k0 = __float_as_uint(f0[ab >> 4]), k1 = __float_as_uint(f1[15u - (ab & 15u)]);
        sv[k] = __uint_as_float(k0 & ~127u) + __uint_as_float(k1 & ~127u);
        ev[k] = (int)((k0 & 127u) * 128u + (k1 & 127u));
        mx = fmaxf(mx, sv[k]);
      }
      float sum = 0.f;
#pragma unroll
      for (int k = 0; k < 16; ++k) {
        sv[k] = __expf(sv[k] - mx);
        sum += sv[k];
      }
      float inv = 1.f / sum;
      size_t o = (size_t)tok * 128 + hh * 16;
      int4* eo = reinterpret_cast<int4*>(p->eidx + o);
      float4* go = reinterpret_cast<float4*>(p->gate + o);
#pragma unroll
      for (int k4 = 0; k4 < 4; ++k4) {
        eo[k4] = make_int4(ev[4 * k4], ev[4 * k4 + 1], ev[4 * k4 + 2], ev[4 * k4 + 3]);
        go[k4] = make_float4(sv[4 * k4] * inv, sv[4 * k4 + 1] * inv, sv[4 * k4 + 2] * inv, sv[4 * k4 + 3] * inv);
      }
    }
  }
  __syncthreads();
}

typedef float v2f __attribute__((ext_vector_type(2)));
DEVI void dec16(uint4 q, v2f* f) {
  f[0] = __builtin_amdgcn_cvt_pk_f32_fp8((int)q.x, false);
  f[1] = __builtin_amdgcn_cvt_pk_f32_fp8((int)q.x, true);
  f[2] = __builtin_amdgcn_cvt_pk_f32_fp8((int)q.y, false);
  f[3] = __builtin_amdgcn_cvt_pk_f32_fp8((int)q.y, true);
  f[4] = __builtin_amdgcn_cvt_pk_f32_fp8((int)q.z, false);
  f[5] = __builtin_amdgcn_cvt_pk_f32_fp8((int)q.z, true);
  f[6] = __builtin_amdgcn_cvt_pk_f32_fp8((int)q.w, false);
  f[7] = __builtin_amdgcn_cvt_pk_f32_fp8((int)q.w, true);
}
struct ExpBuf {
  uint4 q[8];
  uint4 h0, h1;
};
DEVI void exp_load(ExpBuf& B, const unsigned char* tab, const signed char* hrow, const unsigned short* idp, int j8, bool want_x) {
  const uint4 idv = *reinterpret_cast<const uint4*>(idp);
  const unsigned idw[4] = {idv.x, idv.y, idv.z, idv.w};
#pragma unroll
  for (int i = 0; i < 8; ++i) {
    unsigned e = (i & 1) ? (idw[i >> 1] >> 16) : (idw[i >> 1] & 0xffffu);
    unsigned off = e * (unsigned)D + 16u * j8;
    B.q[i] = *reinterpret_cast<const uint4*>(tab + off);
  }
  if (want_x) B.h0 = *reinterpret_cast<const uint4*>(hrow + 16 * j8);
}
template <int CTRL>
DEVI int dpp_movi(int v) { return __builtin_amdgcn_mov_dpp(v, CTRL, 0xF, 0xF, true); }
DEVI void exp_u_compute(const ExpBuf& B, int* pp, int j8) {
  int s0 = 0;
#pragma unroll
  for (int i = 0; i < 8; ++i) {
    int d = __builtin_amdgcn_sdot4((int)B.q[i].x, (int)B.h0.x, 0, false);
    d = __builtin_amdgcn_sdot4((int)B.q[i].y, (int)B.h0.y, d, false);
    d = __builtin_amdgcn_sdot4((int)B.q[i].z, (int)B.h0.z, d, false);
    d = __builtin_amdgcn_sdot4((int)B.q[i].w, (int)B.h0.w, d, false);
    d += dpp_movi<0xB1>(d);
    d += dpp_movi<0x4E>(d);
    d += dpp_movi<0x141>(d);
    s0 = (j8 == i) ? d : s0;
  }
  pp[0] += s0;
}
DEVI void exp_v_accum(const ExpBuf& B, unsigned w0, unsigned w1, int* acc) {
#pragma unroll
  for (int ig = 0; ig < 2; ++ig) {
    const unsigned wq = ig ? w1 : w0;
    const uint4 R0 = B.q[4 * ig], R1 = B.q[4 * ig + 1], R2 = B.q[4 * ig + 2], R3 = B.q[4 * ig + 3];
    const unsigned r0[4] = {R0.x, R0.y, R0.z, R0.w}, r1[4] = {R1.x, R1.y, R1.z, R1.w};
    const unsigned r2[4] = {R2.x, R2.y, R2.z, R2.w}, r3[4] = {R3.x, R3.y, R3.z, R3.w};
#pragma unroll
    for (int q = 0; q < 4; ++q) {
      unsigned A = __builtin_amdgcn_perm(r1[q], r0[q], 0x05010400u);
      unsigned Bq = __builtin_amdgcn_perm(r1[q], r0[q], 0x07030602u);
      unsigned C = __builtin_amdgcn_perm(r3[q], r2[q], 0x05010400u);
      unsigned E = __builtin_amdgcn_perm(r3[q], r2[q], 0x07030602u);
      unsigned D0 = __builtin_amdgcn_perm(C, A, 0x05040100u);
      unsigned D1 = __builtin_amdgcn_perm(C, A, 0x07060302u);
      unsigned D2 = __builtin_amdgcn_perm(E, Bq, 0x05040100u);
      unsigned D3 = __builtin_amdgcn_perm(E, Bq, 0x07060302u);
      acc[4 * q + 0] = __builtin_amdgcn_sdot4((int)D0, (int)wq, acc[4 * q + 0], false);
      acc[4 * q + 1] = __builtin_amdgcn_sdot4((int)D1, (int)wq, acc[4 * q + 1], false);
      acc[4 * q + 2] = __builtin_amdgcn_sdot4((int)D2, (int)wq, acc[4 * q + 2], false);
      acc[4 * q + 3] = __builtin_amdgcn_sdot4((int)D3, (int)wq, acc[4 * q + 3], false);
    }
  }
}
DEVI void exp_v_finish(uint2* xo, uint2 xq, float4 gq, int* acc, float swt, int lane, float gscale) {
  int r[8], s4[4];
#pragma unroll
  for (int i = 0; i < 8; ++i) {
    auto t = __builtin_amdgcn_permlane32_swap((unsigned)acc[i], (unsigned)acc[8 + i], false, false);
    r[i] = (int)t[0] + (int)t[1];
  }
#pragma unroll
  for (int i = 0; i < 4; ++i) {
    auto t = __builtin_amdgcn_permlane16_swap((unsigned)r[i], (unsigned)r[4 + i], false, false);
    s4[i] = (int)t[0] + (int)t[1];
  }
#pragma unroll
  for (int i = 0; i < 4; ++i) s4[i] += dpp_movi<0x128>(s4[i]);
#pragma unroll
  for (int k = 0; k < 16; ++k) acc[k] = 0;
  if ((lane & 8) == 0) {
    const float sc = gscale * swt;
    uint2 rr;
    rr.x = pack2(bflo(xq.x) + sc * gq.x * (float)s4[0], bfhi(xq.x) + sc * gq.y * (float)s4[1]);
    rr.y = pack2(bflo(xq.y) + sc * gq.z * (float)s4[2], bfhi(xq.y) + sc * gq.w * (float)s4[3]);
    *xo = rr;
  }
}
DEVI void phase_expert(PP p, int layer, int ntok, unsigned char* lds, float gscale = 1.f, int idmask = 0xffff) {
  const int tid = ltid();
  const int lane = tid & 63, wid = __builtin_amdgcn_readfirstlane(tid >> 6), j8 = lane & 7, grp = lane >> 3;
  const int nb = lnblk(), bid = lbid();
  unsigned short* ids = reinterpret_cast<unsigned short*>(lds);
  float* part = reinterpret_cast<float*>(lds + TPB * 128 * 2);
  unsigned char* w8 = lds + TPB * 128 * 2 + TPB * 128 * 4;
  float* swl = reinterpret_cast<float*>(lds + TPB * 128 * 2 + TPB * 128 * 4 + TPB * 128);
  const unsigned char* ut = p->utab + (size_t)layer * NEXP * D;
  const unsigned char* vt = p->vtab + (size_t)layer * NEXP * D;
  int tpb = (ntok + nb - 1) / nb;
  if (tpb > TPB) tpb = TPB;
  const int npass = (ntok + nb * tpb - 1) / (nb * tpb);
  for (int pass = 0; pass < npass; ++pass) {
    const int tok0 = (pass * nb + bid) * tpb;
    int cnt = ntok - tok0;
    if (cnt > tpb) cnt = tpb;
    if (cnt < 0) cnt = 0;
    {
      constexpr int NIT = (TPB * 32 + NTHREADS - 1) / NTHREADS;
      const int n4 = cnt * 32;
      const int4* esrc = reinterpret_cast<const int4*>(p->eidx + (size_t)tok0 * 128);
      if (n4 > 0) {
        int4 ev[NIT];
#pragma unroll
        for (int it = 0; it < NIT; ++it) {
          const int idx = tid + it * NTHREADS;
          ev[it] = esrc[idx < n4 ? idx : n4 - 1];
        }
#pragma unroll
        for (int it = 0; it < NIT; ++it) {
          const int idx0 = tid + it * NTHREADS, idx = idx0 < n4 ? idx0 : n4 - 1;
          const int evv[4] = {ev[it].x, ev[it].y, ev[it].z, ev[it].w};
#pragma unroll
          for (int j = 0; j < 4; ++j) {
            const int i = idx * 4 + j, k = i & 127, hf = k >> 6, kk = k & 63;
            ids[(i & ~127) + hf * 64 + (kk & 7) * 8 + (kk >> 3)] = (unsigned short)(evv[j] & idmask);
            part[i] = 0.f;
          }
        }
      }
    }
    __syncthreads();
    const int ntw = (cnt - wid + 3) >> 2;
    const int npair = ntw * 8;

    if (!(REP_MODE == 1 && gscale != 1.f)) {
      ExpBuf B0, B1;
      int c0 = 0, k0 = 0;
      if (npair > 0) {
        const int t0 = wid;
        exp_load(B0, ut, p->h8 + (size_t)(tok0 + t0) * D, ids + t0 * 128 + grp * 8, j8, true);
      }
      for (int pr = 0; pr < npair; ++pr) {
        const int t0 = wid + 4 * k0;
        exp_load(B1, ut + 128 * c0, p->h8 + (size_t)(tok0 + t0) * D + 128 * c0, ids + t0 * 128 + 64 + grp * 8, j8, true);
        exp_u_compute(B0, reinterpret_cast<int*>(part) + t0 * 128 + 8 * j8 + grp, j8);
        int c1 = c0, k1 = k0;
        if (pr + 1 < npair) {
          k1 = k0 + 1;
          if (k1 == ntw) {
            k1 = 0;
            c1 = c0 + 1;
          }
        }
        {
          const int t1 = wid + 4 * k1;
          exp_load(B0, ut + 128 * c1, p->h8 + (size_t)(tok0 + t1) * D + 128 * c1, ids + t1 * 128 + grp * 8, j8, true);
        }
        exp_u_compute(B1, reinterpret_cast<int*>(part) + t0 * 128 + 64 + 8 * j8 + grp, j8);
        c0 = c1;
        k0 = k1;
      }
    }
    __syncthreads();
    {
      float su_c[2], sv_c[2], gt_c[2], sx_c = 0.f;
      if (wid < cnt) {
#pragma unroll
        for (int hh = 0; hh < 2; ++hh) {
          const int e = ids[wid * 128 + hh * 64 + (lane & 7) * 8 + (lane >> 3)];
          su_c[hh] = p->su[(size_t)layer * NEXP + e];
          sv_c[hh] = p->sv[(size_t)layer * NEXP + e];
          gt_c[hh] = p->gate[(size_t)(tok0 + wid) * 128 + lane + 64 * hh];
        }
        sx_c = p->sx[tok0 + wid];
      }
      for (int t = wid; t < cnt; t += 4) {
        const int tn = (t + 4 < cnt) ? t + 4 : t;
        float su_n[2], sv_n[2], gt_n[2];
#pragma unroll
        for (int hh = 0; hh < 2; ++hh) {
          const int e = ids[tn * 128 + hh * 64 + (lane & 7) * 8 + (lane >> 3)];
          su_n[hh] = p->su[(size_t)layer * NEXP + e];
          sv_n[hh] = p->sv[(size_t)layer * NEXP + e];
          gt_n[hh] = p->gate[(size_t)(tok0 + tn) * 128 + lane + 64 * hh];
        }
        const float sx_n = p->sx[tok0 + tn];
        float wv2[2];
        float am = 0.f;
#pragma unroll
        for (int hh = 0; hh < 2; ++hh) {
          const int k = lane + 64 * hh;
          const float dq = (float)reinterpret_cast<int*>(part)[t * 128 + k] * su_c[hh] * sx_c;
          const float wv = gt_c[hh] * gelu_tanh(dq) * sv_c[hh];
          wv2[hh] = wv;
          am = fmaxf(am, fabsf(wv));
        }
        am = fmaxf(wave_max(am), 1e-30f);
        float qs = 127.f / am;
#pragma unroll
        for (int hh = 0; hh < 2; ++hh) {
          int k = lane + 64 * hh;
          int q = (int)rintf(wv2[hh] * qs);
          w8[t * 128 + (k & 7) * 16 + hh * 8 + ((k >> 3) & 7)] = (unsigned char)(q & 255);
        }
        if (lane == 0) swl[t] = am * (1.f / 127.f);
#pragma unroll
        for (int hh = 0; hh < 2; ++hh) {
          su_c[hh] = su_n[hh];
          sv_c[hh] = sv_n[hh];
          gt_c[hh] = gt_n[hh];
        }
        sx_c = sx_n;
      }
    }
    __syncthreads();
    if (!(REP_MODE == 2 && gscale != 1.f)) {
      ExpBuf B0, B1;
      int acc[16];
#pragma unroll
      for (int k = 0; k < 16; ++k) acc[k] = 0;
      int c0 = 0, k0 = 0;
      if (npair > 0) {
        const int t0 = wid;
        exp_load(B0, vt, (const signed char*)nullptr, ids + t0 * 128 + grp * 8, j8, false);
      }
      for (int pr = 0; pr < npair; ++pr) {
        const int t0 = wid + 4 * k0;
        const int dsub = 128 * c0 + 16 * j8 + 8 * (lane >> 5) + 4 * ((lane >> 4) & 1);
        uint2* xo = reinterpret_cast<uint2*>(p->xs + (size_t)(tok0 + t0) * D + dsub);
        const uint2 xq = *xo;
        const float4 gq = *reinterpret_cast<const float4*>(p->mod + ((size_t)layer * 9 + tok_batch(tok0 + t0)) * 6144 + 5 * 1024 + dsub);
        exp_load(B1, vt + 128 * c0, (const signed char*)nullptr, ids + t0 * 128 + 64 + grp * 8, j8, false);
        const uint4 wq = *reinterpret_cast<const uint4*>(w8 + t0 * 128 + grp * 16);
        exp_v_accum(B0, wq.x, wq.y, acc);
        int c1 = c0, k1 = k0;
        if (pr + 1 < npair) {
          k1 = k0 + 1;
          if (k1 == ntw) {
            k1 = 0;
            c1 = c0 + 1;
          }
        }
        {
          const int t1 = wid + 4 * k1;
          exp_load(B0, vt + 128 * c1, (const signed char*)nullptr, ids + t1 * 128 + grp * 8, j8, false);
        }
        exp_v_accum(B1, wq.z, wq.w, acc);
        exp_v_finish(xo, xq, gq, acc, swl[t0], lane, gscale);
        c0 = c1;
        k0 = k1;
      }
    }
    asm volatile("s_waitcnt vmcnt(0)" ::: "memory");
    __syncthreads();
    if (gscale == 1.f) {
      if (layer + 1 < DEPTH) {
        const int ln = layer + 1;
        const int hfrom = (ln & 1) ? gemm_tail_row0(((ln < 2) ? TT : TL) / 256, 8) : gemm_tail_row0(((ln < 3) ? TT : TL) / 256, 5);
        norm_rows(p, ln, 0, tok0 + wid, tok0 + cnt, 4, lane, hfrom);
      } else {
        norm_rows(p, 0, 2, tok0 + wid, (tok0 + cnt < TL) ? tok0 + cnt : TL, 4, lane, 0);
      }
    }
    __syncthreads();
  }
}

#define XB_TMO 128
#define XB_XCNT(j) (256 + 64 * (j))
#define XB_XSUB(j) (1280 + 64 * (j))
#define XB_XGEN(j) (2304 + 64 * (j))
#define XB_TOP 3328
#define XB_TOPGEN 3392
#define XCD_BAR_WORDS 3456
#define XB_SPIN_CAP (1u << 22)
#define LAS __attribute__((address_space(3)))
DEVI unsigned xb_ld(unsigned* p) { return __hip_atomic_load(p, __ATOMIC_RELAXED, __HIP_MEMORY_SCOPE_AGENT); }
DEVI unsigned xb_add(unsigned* p, unsigned v) { return __hip_atomic_fetch_add(p, v, __ATOMIC_RELAXED, __HIP_MEMORY_SCOPE_AGENT); }
DEVI unsigned xb_xcc_id() { return (unsigned)__builtin_amdgcn_s_getreg((3 << 11) | 20) & 0xFu; }
#define XB_SPIN(cond, bar)                                   \
  do {                                                       \
    unsigned _sp = 0;                                        \
    while (cond) {                                           \
      __builtin_amdgcn_s_sleep(1);                           \
      if ((++_sp & 255u) == 0u) {                            \
        if (xb_ld(&(bar)[XB_TMO])) break;                    \
        if (_sp > XB_SPIN_CAP) {                             \
          atomicAdd(&(bar)[XB_TMO], 1u);                     \
          break;                                             \
        }                                                    \
      }                                                      \
    }                                                        \
  } while (0)
struct XcdBarrier {
  unsigned* bar;
  unsigned x;
  volatile LAS unsigned* st;
};
DEVI XcdBarrier xcd_barrier_post(unsigned* bar, volatile LAS unsigned* st) {
  XcdBarrier b;
  b.bar = bar;
  b.x = xb_xcc_id();
  b.st = st;
  if (threadIdx.x == 0) (void)xb_add(&bar[XB_XCNT(b.x)], 1u);
  return b;
}
DEVI void xcd_barrier_complete(unsigned* bar, unsigned x, unsigned& nloc, unsigned& nx) {
  const unsigned G = gridDim.x * gridDim.y * gridDim.z;
  unsigned sum, cnt, mine, sp = 0u;
  for (;;) {
    sum = 0u;
    cnt = 0u;
    mine = 0u;
#pragma unroll
    for (unsigned j = 0; j < 16; ++j) {
      const unsigned c = xb_ld(&bar[XB_XCNT(j)]);
      sum += c;
      cnt += (c > 0u) ? 1u : 0u;
      mine = (j == x) ? c : mine;
    }
    if (sum == G) break;
    __builtin_amdgcn_s_sleep(1);
    if ((++sp & 255u) == 0u) {
      if (xb_ld(&bar[XB_TMO])) break;
      if (sp > XB_SPIN_CAP) {
        atomicAdd(&bar[XB_TMO], 1u);
        break;
      }
    }
  }
  nloc = mine > 0u ? mine : 1u;
  nx = cnt > 0u ? cnt : 1u;
}
DEVI void xcd_barrier(const XcdBarrier& b) {
  asm volatile("s_waitcnt vmcnt(0)" ::: "memory");
  __syncthreads();
  if (threadIdx.x == 0) {
    unsigned* bar = b.bar;
    __builtin_amdgcn_s_waitcnt(0);
    unsigned nloc = b.st[0], nx = b.st[1];
    if (nloc == 0u) {
      xcd_barrier_complete(bar, b.x, nloc, nx);
      b.st[0] = nloc;
      b.st[1] = nx;
    }
    const unsigned old = xb_add(&bar[XB_XSUB(b.x)], 1u);
    const unsigned gen = old / nloc;
    if (old + 1u == (gen + 1u) * nloc) {
      __builtin_amdgcn_fence(__ATOMIC_RELEASE, "agent");
      asm volatile("s_waitcnt vmcnt(0)" ::: "memory");
      const unsigned og = xb_add(&bar[XB_TOP], 1u);
      const unsigned tg = og / nx;
      if (og + 1u == (tg + 1u) * nx) xb_add(&bar[XB_TOPGEN], 1u);
      else XB_SPIN(xb_ld(&bar[XB_TOPGEN]) == tg, bar);
      __builtin_amdgcn_fence(__ATOMIC_ACQUIRE, "agent");
      xb_add(&bar[XB_XGEN(b.x)], 1u);
      asm volatile("s_waitcnt vmcnt(0)" ::: "memory");
    } else {
      XB_SPIN(xb_ld(&bar[XB_XGEN(b.x)]) == gen, bar);
      __builtin_amdgcn_fence(__ATOMIC_ACQUIRE, "agent");
      asm volatile("s_waitcnt vmcnt(0)" ::: "memory");
    }
  }
  __syncthreads();
}

DEVI bool step_active(int step) {
  if (step == 0) return true;
  if (step == NSTEPS - 1) return false;
  int layer = (step - 1) / STEPS_PER_LAYER, ph = (step - 1) % STEPS_PER_LAYER;
  if (ph == 3 && (layer & 1)) return false;
  if (ph == 0 && layer > 0) return false;
  return true;
}

DEVI void run_step(PP p, int step, unsigned char* lds, unsigned char* lds_all, float gscale = 1.f) {
  if (step == 0) {
    phase_prep(p, lds);
    return;
  }
  if (step == NSTEPS - 1) {
    phase_norm(p, 0, 2, TL, 0);
    return;
  }
  int layer = (step - 1) / STEPS_PER_LAYER, ph = (step - 1) % STEPS_PER_LAYER;
  bool even = (layer & 1) == 0;
  int j = layer >> 1;
  bool upd_ctx = layer < 2;
  bool need_ctx = layer < 3;
  int nt_in = need_ctx ? TT : TL;
  int nt = upd_ctx ? TT : TL;
  switch (ph) {
    case 0: phase_norm(p, layer, 0, nt_in, gemm_tail_row0(nt_in / 256, 5)); break;
    case 1:
      if (even) {
        {
          const int pt_ = ptid();
          *reinterpret_cast<uint4*>(g_lds + ROPE_LDS + pt_ * 16) = *(reinterpret_cast<const uint4*>(p->cs) + pt_);
          __syncthreads();
        }
        gemm8_phase<EPI_INPROJ, true>(p, reinterpret_cast<const bf16_t*>(p->h8), D / 2, reinterpret_cast<const bf16_t*>(p->w8_in_ab + (size_t)j * 1280 * D), D / 2,
                                      nt_in / 256, 5, D / 2, layer, lds_all, 1.f, p->sw_in_ab + (size_t)j * 1280, p->h, p->wt_in_ab + (size_t)j * 1280 * D, D);
      } else
        gemm8_phase<EPI_GELU, true>(p, reinterpret_cast<const bf16_t*>(p->h8), D / 2, reinterpret_cast<const bf16_t*>(p->w8_in_gs + (size_t)j * 2048 * D), D / 2,
                                    nt / 256, 8, D / 2, layer, lds_all, 1.f, p->sw_in_gs + (size_t)j * 2048, p->h, p->wt_in_gs + (size_t)j * 2048 * D, D);
      break;
    case 2:
      if (even) {
        phase_fft_a(p, lds);
        if (upd_ctx) phase_dft_ctx(p, lds);
        phase_attn(p, layer, upd_ctx, lds);
      } else {
        phase_sgu(p, j, nt / 128, lds);
      }
      break;
    case 3:
      if (even) phase_fft_b(p, lds);
      break;
    case 4:
      if (even)
      {
        if (layer == 0) gemm8_phase<EPI_RESID0>(p, p->mix, LDMIX, p->wt_out_ab + (size_t)j * D * LDMIX, LDMIX, nt / 256, 4, LDMIX, layer, lds_all, gscale);
        else gemm8_phase<EPI_RESID>(p, p->mix, LDMIX, p->wt_out_ab + (size_t)j * D * LDMIX, LDMIX, nt / 256, 4, LDMIX, layer, lds_all, gscale);
      }
      else
      {
        gemm8_phase<EPI_RESID>(p, p->mix, LDMIX, p->wt_out_gs + (size_t)j * D * D, D, nt / 256, 4, D, layer, lds_all, gscale);
      }
      break;
    case 5: phase_norm(p, layer, 1, nt, gemm_tail_row0(nt / 256, 8)); break;
    case 6:
      gemm8_phase<EPI_STORE, true>(p, reinterpret_cast<const bf16_t*>(p->h8), D / 2, reinterpret_cast<const bf16_t*>(p->w8_q + (size_t)layer * 2048 * D), D / 2, nt / 256, 8,
                                   D / 2, layer, lds_all, gscale, p->sw_q + (size_t)layer * 2048, p->h, p->wt_q + (size_t)layer * 2048 * D, D);
      break;
    case 7: phase_route(p, layer, nt, lds); break;
    case 8: phase_expert(p, layer, nt, lds, gscale, (gscale == 1.f) ? 0xffff : REP_IDMASK); break;
  }
}

__global__ void __launch_bounds__(PHYS_THREADS, 2) mega(Params p_unused, int step_lo, int step_hi) {
  unsigned char* lds_all = g_lds;
  if ((threadIdx.x & 63) == 0) *reinterpret_cast<volatile int*>(g_lds + LDS_BYTES - 16 - 256 + 4 * hw_slot()) = (int)(threadIdx.x >> 6);
  __syncthreads();
  unsigned char* lds = lds_all + (wave_index() >> 2) * LDS_HALF;
  PP pp = (PP)__builtin_amdgcn_kernarg_segment_ptr();
  volatile LAS unsigned* st = (volatile LAS unsigned*)(lds_all + LDS_BYTES - 16);
  if (threadIdx.x == 0) {
    st[0] = 0u;
    st[1] = 0u;
  }
  __syncthreads();
  XcdBarrier xb = xcd_barrier_post(pp->bar, st);
  int nsync = 0;
  bool first = true;
  for (int s = step_lo; s < step_hi; ++s) {
    if (!step_active(s)) continue;
    if (!first) {
      if (nsync == 0) cg::this_grid().sync();
      else xcd_barrier(xb);
      ++nsync;
    }
    first = false;
    int nrep = 1;
    if (PROBE_PH) {
      if (s == 0) nrep += (PROBE_PH >> 15) & 1;
      else if (s < NSTEPS - 1) {
        const int lay_ = (s - 1) / STEPS_PER_LAYER, ph_ = (s - 1) % STEPS_PER_LAYER;
        nrep += (PROBE_PH >> ph_) & 1;
        if (ph_ == 2 && ((PROBE_PH >> 9) & 1) && !(lay_ & 1)) nrep = 2;
        if (ph_ == 2 && ((PROBE_PH >> 10) & 1) && (lay_ & 1)) nrep = 2;
        if (ph_ == 1 && ((PROBE_PH >> 12) & 1) && !(lay_ & 1)) nrep = 2;
        if (ph_ == 1 && ((PROBE_PH >> 13) & 1) && (lay_ & 1)) nrep = 2;
        if (ph_ == 4 && ((PROBE_PH >> 11) & 1) && !(lay_ & 1)) nrep = 2;
        if (ph_ == 4 && ((PROBE_PH >> 14) & 1) && (lay_ & 1)) nrep = 2;
      }
      asm volatile("" : "+s"(nrep));
    }
#pragma nounroll
    for (int rep = nrep - 1; rep >= 0; --rep) {
      if (rep != nrep - 1) xcd_barrier(xb);
      PP q = pp;
      asm volatile("" : "+s"(q));
      int gi = __builtin_amdgcn_readfirstlane(rep ? 0 : 0x3f800000);
      if (PROBE_PH) asm volatile("" : "+s"(gi));
      const float gs = __int_as_float(gi);
      if (PROBE_PH) run_step(q, s, lds, lds_all, gs);
      else run_step(q, s, lds, lds_all);
    }
  }
}

static size_t align_up(size_t v) { return (v + 255) & ~(size_t)255; }

extern "C" void kernel_launch(void* const* d_in, const int* in_sizes, int n_in, void* d_out, int out_size, void* d_ws,
                              size_t ws_size, hipStream_t stream) {
  Params p{};
  p.x = (const float*)d_in[0];
  p.c = (const float*)d_in[1];
  p.ctx = (const float*)d_in[2];
  p.c_ctx = (const float*)d_in[3];
  p.ada_w = (const float*)d_in[4];
  p.ada_b = (const float*)d_in[5];
  p.norm_mix_w = (const float*)d_in[6];
  p.norm_ffn_w = (const float*)d_in[7];
  p.ab_w_in = (const float*)d_in[8];
  p.ab_w_out = (const float*)d_in[9];
  p.attn_sink = (const float*)d_in[10];
  p.gs_w_in = (const float*)d_in[11];
  p.gs_norm_w = (const float*)d_in[12];
  p.gs_w_s = (const float*)d_in[13];
  p.gs_b_s = (const float*)d_in[14];
  p.gs_w_out = (const float*)d_in[15];
  p.peer_w_q = (const float*)d_in[16];
  p.peer_keys = (const float*)d_in[17];
  p.peer_u = (const float*)d_in[18];
  p.peer_v = (const float*)d_in[19];
  p.norm_out_w = (const float*)d_in[20];
  p.out = (float*)d_out;
  unsigned char* w = (unsigned char*)d_ws;
  size_t off = 0;
  auto take = [&](size_t bytes) {
    unsigned char* r = w + off;
    off = align_up(off + bytes);
    return r;
  };
  p.bar = (unsigned*)take((size_t)XCD_BAR_WORDS * 4);
  p.mod = (float*)take((size_t)DEPTH * 9 * 6144 * 4);
  p.cs = (float2*)take(64 * 16 * 8);
  p.xs = (bf16_t*)take((size_t)TT * D * 2);
  p.h = (bf16_t*)take((size_t)TT * D * 2);
  p.P = (bf16_t*)take((size_t)TT * 2048 * 2);
  p.kbuf = (bf16_t*)take((size_t)NB * 2 * KVLEN * 64 * 2);
  p.vbuf = (bf16_t*)take((size_t)NB * 2 * KVLEN * 64 * 2);
  p.zvT = (bf16_t*)take((size_t)TT * 1024 * 2);
  p.rowss = (float*)take((size_t)(TT / 128) * 32 * 128 * 4);
  p.mix = (bf16_t*)take((size_t)TT * LDMIX * 2);
  p.fa = (bf16_t*)take((size_t)TL * 1024 * 2);
  p.tops = (float*)take((size_t)TT * 256 * 4);
  p.eidx = (int*)take((size_t)TT * 128 * 4);
  p.gate = (float*)take((size_t)TT * 128 * 4);
  p.wt_in_ab = (bf16_t*)take((size_t)2 * 1280 * D * 2);
  p.wt_out_ab = (bf16_t*)take((size_t)2 * D * LDMIX * 2);
  p.wt_in_gs = (bf16_t*)take((size_t)2 * 2048 * D * 2);
  p.wt_out_gs = (bf16_t*)take((size_t)2 * D * D * 2);
  p.wt_q = (bf16_t*)take((size_t)DEPTH * 2048 * D * 2);
  p.keysb = (bf16_t*)take((size_t)DEPTH * 8 * 2 * 128 * 128 * 2);
  p.su = (float*)take((size_t)DEPTH * NEXP * 4);
  p.sv = (float*)take((size_t)DEPTH * NEXP * 4);
  p.h8 = (signed char*)take((size_t)TT * D);
  p.sx = (float*)take((size_t)TT * 4);
  p.w8_in_ab = (signed char*)take((size_t)2 * 1280 * D);
  p.sw_in_ab = (float*)take((size_t)2 * 1280 * 4);
  p.w8_in_gs = (signed char*)take((size_t)2 * 2048 * D);
  p.sw_in_gs = (float*)take((size_t)2 * 2048 * 4);
  p.w8_q = (signed char*)take((size_t)DEPTH * 2048 * D);
  p.sw_q = (float*)take((size_t)DEPTH * 2048 * 4);
  p.utab = (unsigned char*)take((size_t)DEPTH * NEXP * D);
  p.vtab = (unsigned char*)take((size_t)DEPTH * NEXP * D);
  if (off > ws_size) {
    fprintf(stderr, "workspace too small: need %zu have %zu\n", off, ws_size);
    return;
  }
  hipMemsetAsync(p.bar, 0, (size_t)XCD_BAR_WORDS * 4, stream);
  static int grid_blocks = 0;
  if (!grid_blocks) {
    int dev = 0, cus = 0, per_cu = 0;
    hipGetDevice(&dev);
    hipDeviceGetAttribute(&cus, hipDeviceAttributeMultiprocessorCount, dev);
    hipOccupancyMaxActiveBlocksPerMultiprocessor(&per_cu, mega, PHYS_THREADS, 0);
    if (per_cu > 1) per_cu = 1;
    if (per_cu < 1) per_cu = 1;
    grid_blocks = cus * per_cu;
  }
#if ONE_LAUNCH
  int lo = 0, hi = NSTEPS;
  void* args[] = {&p, &lo, &hi};
  hipError_t e = hipLaunchCooperativeKernel((void*)mega, dim3(grid_blocks), dim3(PHYS_THREADS), args, 0, stream);
  if (e != hipSuccess) fprintf(stderr, "cooperative launch failed: %s (grid %d)\n", hipGetErrorString(e), grid_blocks);
#else
  for (int s = 0; s < NSTEPS; ++s) {
    if (s != 0 && s != NSTEPS - 1) {
      int layer = (s - 1) / STEPS_PER_LAYER, ph = (s - 1) % STEPS_PER_LAYER;
      if (ph == 3 && (layer & 1)) continue;
    }
    hipLaunchKernelGGL(mega, dim3(grid_blocks), dim3(NTHREADS), 0, stream, p, s, s + 1);
  }
#endif
}
```
